# Optimizing an MI355X kernel written in HIP

```python
import math
import jax, jax.numpy as jnp
from jax import lax
import numpy as np

D_MODEL = 2048
BATCH = 4
SEQ = 2048
DEPTH = 1

CHUNK = 64
Q_BLOCK = 128
TOKEN_BLOCK = 128
HEAD_DIM = 128
WIDTH_A = D_MODEL // 2
WIDTH_B = D_MODEL // 2
N_HEADS_A = WIDTH_A // HEAD_DIM
N_HEADS_B = WIDTH_B // HEAD_DIM
D_LAT = 256
N_IDX_HEADS = 16
D_IDX = 64
TOPK_MAX = 256
N_GROUPS = 8
EXPERTS_PER_GROUP = 8
N_EXPERTS = N_GROUPS * EXPERTS_PER_GROUP
TOP_K_IN_GROUP = 2
D_EXPERT = 512
N_BRANCHES = 2
RMS_EPS = 1e-6
IN_SIZES = (WIDTH_A, D_LAT, N_IDX_HEADS * D_IDX, D_IDX, N_IDX_HEADS,
            WIDTH_B, WIDTH_B, WIDTH_B, N_HEADS_B, N_BRANCHES * D_MODEL)
D_IN = sum(IN_SIZES)

kernel_name = "hybrid_dsa_fox_hiermoe_block"


def _split_points():
    return [int(v) for v in np.cumsum(np.array(IN_SIZES))[:-1]]


def rms_norm(x, g):
    xf = x.astype(jnp.float32)
    y = xf * lax.rsqrt(jnp.mean(xf * xf, axis=-1, keepdims=True) + RMS_EPS)
    return (y * g.astype(jnp.float32)).astype(x.dtype)


def _to_blocks(a):
    b, s = a.shape[:2]
    a = a.reshape((b, s // Q_BLOCK, Q_BLOCK) + a.shape[2:])
    return jnp.moveaxis(a, 1, 0)


def _from_blocks(a):
    a = jnp.moveaxis(a, 0, 1)
    return a.reshape((a.shape[0], a.shape[1] * a.shape[2]) + a.shape[3:])


def dsa_sparse_attention(q_a, c_kv, q_idx, k_idx, w_idx, w_uk, w_uv, g_qa, g_kv):
    b, s = q_a.shape[:2]
    topk = min(TOPK_MAX, s // 4)
    q_lat = rms_norm(jnp.einsum('bshd,hdl->bshl', q_a, w_uk), g_qa)
    kv = rms_norm(c_kv, g_kv)
    slopes = jnp.exp2(-8.0 * (jnp.arange(N_HEADS_A, dtype=jnp.float32) + 1.0) / N_HEADS_A)
    key_pos = jnp.arange(s)
    k_idx_f = k_idx.astype(jnp.float32)

    def block(args):
        i, ql, qi, wi = args
        q_pos = i * Q_BLOCK + jnp.arange(Q_BLOCK)
        admissible = (key_pos[None, :] // CHUNK) <= (q_pos[:, None] // CHUNK)
        dots = jnp.einsum('bqhd,bsd->bqhs', qi.astype(jnp.float32), k_idx_f) * (D_IDX ** -0.5)
        score = jnp.einsum('bqh,bqhs->bqs', wi.astype(jnp.float32) * (N_IDX_HEADS ** -0.5),
                           jax.nn.relu(dots))
        score = jnp.where(admissible[None], score, -jnp.inf)
        _, sel = lax.top_k(score, topk)
        kv_sel = jax.vmap(lambda kb, ib: kb[ib])(kv, sel)
        valid = (sel // CHUNK) <= (q_pos[None, :, None] // CHUNK)
        dist = jnp.abs(q_pos[None, :, None] - sel).astype(jnp.float32)
        logits = (jnp.einsum('bqhl,bqkl->bhqk', ql, kv_sel).astype(jnp.float32) * (D_LAT ** -0.5)
                  - slopes[None, :, None, None] * dist[:, None])
        logits = jnp.where(valid[:, None], logits, -jnp.inf)
        p = jax.nn.softmax(logits, axis=-1).astype(kv.dtype)
        return jnp.einsum('bhqk,bqkl->bqhl', p, kv_sel)

    nb = s // Q_BLOCK
    o_lat = _from_blocks(lax.map(block, (jnp.arange(nb), _to_blocks(q_lat),
                                         _to_blocks(q_idx), _to_blocks(w_idx))))
    return jnp.einsum('bshl,hld->bshd', o_lat, w_uv)


def forgetting_attention(q, k, v, f_logit, g_q, g_k):
    b, s = q.shape[:2]
    q = rms_norm(q, g_q)
    k = rms_norm(k, g_k)
    cum = jnp.cumsum(jax.nn.log_sigmoid(f_logit.astype(jnp.float32)), axis=1)
    cum_k = jnp.transpose(cum, (0, 2, 1))
    key_pos = jnp.arange(s)

    def block(args):
        i, qb, cq = args
        q_pos = i * Q_BLOCK + jnp.arange(Q_BLOCK)
        causal = key_pos[None, :] <= q_pos[:, None]
        decay = jnp.transpose(cq, (0, 2, 1))[..., None] - cum_k[:, :, None, :]
        logits = (jnp.einsum('bqhd,bshd->bhqs', qb, k).astype(jnp.float32) * (HEAD_DIM ** -0.5)
                  + decay)
        logits = jnp.where(causal[None, None], logits, -jnp.inf)
        p = jax.nn.softmax(logits, axis=-1).astype(v.dtype)
        return jnp.einsum('bhqs,bshd->bqhd', p, v)

    nb = s // Q_BLOCK
    return _from_blocks(lax.map(block, (jnp.arange(nb), _to_blocks(q), _to_blocks(cum))))


def hierarchical_moe(h, w_rg, b_rg, w_re, b_re, w1, w3, w2):
    b, s, d = h.shape
    t = h.reshape(b * s, d)
    n_tok = b * s
    g_logits = (t @ w_rg).astype(jnp.float32) + b_rg.astype(jnp.float32)
    g_prob = jax.nn.softmax(g_logits, axis=-1)
    g_idx = jnp.argmax(g_logits, axis=-1)
    g_w = jnp.take_along_axis(g_prob, g_idx[:, None], axis=1)
    e_logits = ((t @ w_re).astype(jnp.float32) + b_re.astype(jnp.float32)).reshape(
        n_tok, N_GROUPS, EXPERTS_PER_GROUP)
    e_in = jnp.take_along_axis(e_logits, g_idx[:, None, None], axis=1)[:, 0]
    top_v, top_i = lax.top_k(e_in, TOP_K_IN_GROUP)
    top_p = jax.nn.softmax(top_v, axis=-1) * g_w
    expert_id = g_idx[:, None] * EXPERTS_PER_GROUP + top_i
    gates = jnp.sum(jax.nn.one_hot(expert_id, N_EXPERTS, dtype=jnp.float32) * top_p[..., None],
                    axis=1)

    def ffn_block(args):
        tb, gb = args
        a = jnp.einsum('nd,edf->nef', tb, w1)
        u = jnp.einsum('nd,edf->nef', tb, w3)
        return jnp.einsum('nef,efd->nd', jax.nn.silu(a) * u * gb[..., None].astype(tb.dtype), w2)

    y = lax.map(ffn_block, (t.reshape(-1, TOKEN_BLOCK, d),
                            gates.reshape(-1, TOKEN_BLOCK, N_EXPERTS)))
    return y.reshape(b, s, d)


def setup_inputs(seed: int = 0) -> dict:
    key = jax.random.key(seed)
    ks = jax.random.split(key, 32)

    def nrm(k, shape, fan_in, scale=1.0):
        return jax.random.normal(k, shape, jnp.float32) * (scale * fan_in ** -0.5)

    def gain(k, shape):
        return 1.0 + 0.05 * jax.random.normal(k, shape, jnp.float32)

    def small(k, shape, scale=0.02):
        return scale * jax.random.normal(k, shape, jnp.float32)

    L = DEPTH
    return {
        "x": jax.random.normal(ks[0], (BATCH, SEQ, D_MODEL), jnp.float32),
        "c": jax.random.normal(ks[1], (BATCH, D_MODEL), jnp.float32),
        "w_ada": nrm(ks[2], (L, D_MODEL, 6 * D_MODEL), D_MODEL, 0.5),
        "b_ada": small(ks[3], (L, 6 * D_MODEL)),
        "g_mix": gain(ks[4], (L, D_MODEL)),
        "w_in": nrm(ks[5], (L, D_MODEL, D_IN), D_MODEL),
        "b_gate": small(ks[6], (L, N_BRANCHES * D_MODEL)),
        "b_forget": 2.0 + 0.5 * jax.random.normal(ks[7], (L, N_HEADS_B), jnp.float32),
        "w_uk": nrm(ks[8], (L, N_HEADS_A, HEAD_DIM, D_LAT), HEAD_DIM),
        "w_uv": nrm(ks[9], (L, N_HEADS_A, D_LAT, HEAD_DIM), D_LAT),
        "g_qa": gain(ks[10], (L, D_LAT)),
        "g_kv": gain(ks[11], (L, D_LAT)),
        "g_qb": gain(ks[12], (L, HEAD_DIM)),
        "g_kb": gain(ks[13], (L, HEAD_DIM)),
        "w_pa": nrm(ks[14], (L, WIDTH_A, D_MODEL), WIDTH_A),
        "w_pb": nrm(ks[15], (L, WIDTH_B, D_MODEL), WIDTH_B),
        "w_o": nrm(ks[16], (L, D_MODEL, D_MODEL), D_MODEL),
        "g_ffn": gain(ks[17], (L, D_MODEL)),
        "w_rg": nrm(ks[18], (L, D_MODEL, N_GROUPS), D_MODEL),
        "b_rg": small(ks[19], (L, N_GROUPS), 0.01),
        "w_re": nrm(ks[20], (L, D_MODEL, N_EXPERTS), D_MODEL),
        "b_re": small(ks[21], (L, N_EXPERTS), 0.01),
        "w1": nrm(ks[22], (L, N_EXPERTS, D_MODEL, D_EXPERT), D_MODEL),
        "w3": nrm(ks[23], (L, N_EXPERTS, D_MODEL, D_EXPERT), D_MODEL),
        "w2": nrm(ks[24], (L, N_EXPERTS, D_EXPERT, D_MODEL), D_EXPERT),
    }


def reference(x, c, w_ada, b_ada, g_mix, w_in, b_gate, b_forget, w_uk, w_uv, g_qa, g_kv,
              g_qb, g_kb, w_pa, w_pb, w_o, g_ffn, w_rg, b_rg, w_re, b_re, w1, w3, w2):
    b, s, d = x.shape
    cond = jax.nn.silu(c)
    for l in range(DEPTH):
        mod = (cond @ w_ada[l] + b_ada[l])[:, None, :]
        sh_m, sc_m, gt_m, sh_f, sc_f, gt_f = jnp.split(mod, 6, axis=-1)

        h = rms_norm(x, g_mix[l]) * (1.0 + sc_m) + sh_m
        proj = h @ w_in[l]
        (q_a, c_kv, q_idx, k_idx, w_idx, q_b, k_b, v_b, f_b, gate_logits) = jnp.split(
            proj, _split_points(), axis=-1)
        o_a = dsa_sparse_attention(
            q_a.reshape(b, s, N_HEADS_A, HEAD_DIM), c_kv,
            q_idx.reshape(b, s, N_IDX_HEADS, D_IDX), k_idx, w_idx,
            w_uk[l], w_uv[l], g_qa[l], g_kv[l])
        o_b = forgetting_attention(
            q_b.reshape(b, s, N_HEADS_B, HEAD_DIM), k_b.reshape(b, s, N_HEADS_B, HEAD_DIM),
            v_b.reshape(b, s, N_HEADS_B, HEAD_DIM), f_b + b_forget[l], g_qb[l], g_kb[l])
        g_a, g_b = jnp.split(jax.nn.sigmoid(gate_logits + b_gate[l]), 2, axis=-1)
        merged = (g_a * (o_a.reshape(b, s, WIDTH_A) @ w_pa[l])
                  + g_b * (o_b.reshape(b, s, WIDTH_B) @ w_pb[l]))
        x = x + gt_m * (merged @ w_o[l])

        h = rms_norm(x, g_ffn[l]) * (1.0 + sc_f) + sh_f
        x = x + gt_f * hierarchical_moe(h, w_rg[l], b_rg[l], w_re[l], b_re[l],
                                        w1[l], w3[l], w2[l])
    return x
```

```cpp
#include <hip/hip_runtime.h>
#include <cstdio>
#include <cstdint>
#include <cstring>

#ifndef MK_LAUNCHES
#define MK_LAUNCHES 1
#endif

#define LAS __attribute__((address_space(3)))
typedef unsigned short bf16_t;
typedef short bf16x8 __attribute__((ext_vector_type(8)));
typedef short s16x4 __attribute__((ext_vector_type(4)));
typedef float f32x4 __attribute__((ext_vector_type(4)));
typedef float f32x16 __attribute__((ext_vector_type(16)));
typedef unsigned u32x4 __attribute__((ext_vector_type(4)));
typedef unsigned u32x2 __attribute__((ext_vector_type(2)));

constexpr int DM = 2048, NBATCH = 4, SEQ = 2048, NTOK = NBATCH * SEQ;
constexpr int DIN = 9560, DINP = 9728;
constexpr int NEXP = 64, DEXP = 512, LCAP = 8192;
constexpr float RMS_EPS = 1e-6f;
constexpr float LOG2E = 1.4426950408889634f;
constexpr int NTHREADS = 512;
constexpr int LDS_BYTES = 163840 - 1024;
constexpr int LDS_BARW = LDS_BYTES - 16;
constexpr int LDS_TAB = 131072;

constexpr size_t al256(size_t x) { return (x + 255) / 256 * 256; }
constexpr size_t WS_BAR = 0;
constexpr size_t WS_CNT = 16384;
constexpr size_t WS_ZERO_BYTES = 16384 + 4096;
constexpr size_t WS_MOD = WS_ZERO_BYTES;
constexpr size_t WS_H = al256(WS_MOD + (size_t)4 * 12288 * 4);
constexpr size_t WS_WIN = al256(WS_H + (size_t)NTOK * DM * 2);
constexpr size_t WS_WPA = al256(WS_WIN + (size_t)DINP * DM * 2);
constexpr size_t WS_WPB = al256(WS_WPA + (size_t)2048 * 1024 * 2);
constexpr size_t WS_WO = al256(WS_WPB + (size_t)2048 * 1024 * 2);
constexpr size_t WS_WUK = al256(WS_WO + (size_t)2048 * 2048 * 2);
constexpr size_t WS_WUV = al256(WS_WUK + (size_t)8 * 256 * 128 * 2);
constexpr size_t WS_W13 = al256(WS_WUV + (size_t)8 * 128 * 256 * 2);
constexpr size_t WS_W2 = al256(WS_W13 + (size_t)64 * 1024 * 2048 * 2);
constexpr size_t WS_QA = al256(WS_W2 + (size_t)64 * 2048 * 512 * 2);
constexpr size_t WS_CKV = al256(WS_QA + (size_t)NTOK * 1024 * 2);
constexpr size_t WS_KV = al256(WS_CKV + (size_t)NTOK * 256 * 4);
constexpr size_t WS_QIDX = al256(WS_KV + (size_t)NTOK * 256 * 2);
constexpr size_t WS_MISC = al256(WS_QIDX + (size_t)NTOK * 1024 * 2);
constexpr size_t WS_QB = al256(WS_MISC + (size_t)NTOK * 256 * 4);
constexpr size_t WS_KB = al256(WS_QB + (size_t)NTOK * 1024 * 2);
constexpr size_t WS_VB = al256(WS_KB + (size_t)NTOK * 1024 * 2);
constexpr size_t WS_GATES = al256(WS_VB + (size_t)NTOK * 1024 * 2);
constexpr size_t WS_QLAT = al256(WS_GATES + (size_t)NTOK * 4096 * 2);
constexpr size_t WS_MASK = al256(WS_QLAT + (size_t)NTOK * 2048 * 2);
constexpr size_t WS_CUM = al256(WS_MASK + (size_t)NTOK * 256);
constexpr size_t WS_OLAT = al256(WS_CUM + (size_t)4 * 8 * 2048 * 4);
constexpr size_t WS_OA = al256(WS_OLAT + (size_t)NTOK * 2048 * 2);
constexpr size_t WS_OB = al256(WS_OA + (size_t)NTOK * 1024 * 2);
constexpr size_t WS_T1 = al256(WS_OB + (size_t)NTOK * 1024 * 2);
constexpr size_t WS_MERGED = al256(WS_T1 + (size_t)NTOK * 2048 * 4);
constexpr size_t WS_LTOK = al256(WS_MERGED + (size_t)NTOK * 2048 * 2);
constexpr size_t WS_LW = al256(WS_LTOK + (size_t)NEXP * LCAP * 4);
constexpr size_t WS_ACT = al256(WS_LW + (size_t)NEXP * LCAP * 4);
constexpr size_t WS_HLO = al256(WS_ACT + (size_t)32768 * 512 * 2);
constexpr size_t WS_WRH = al256(WS_HLO + (size_t)NTOK * DM * 2);
constexpr size_t WS_WRL = al256(WS_WRH + (size_t)80 * DM * 2);
constexpr size_t WS_END = al256(WS_WRL + (size_t)80 * DM * 2);
constexpr size_t WS_HG = WS_QA;
static_assert(WS_HG + (size_t)32768 * DM * 2 <= WS_QLAT, "hg alias must fit in the dead region");

struct TJob { const float* src; bf16_t* dst; int K, N, ldd, map, ntk, ntn, nbatch, tile0; long sbatch, dbatch; };
constexpr int NJOBS = 9;
struct Params {
    const float* in[25];
    float* out;
    unsigned char* ws;
    TJob jobs[NJOBS];
    int ntiles_total;
    int ph_lo, ph_hi;
};
enum { I_X = 0, I_C, I_WADA, I_BADA, I_GMIX, I_WIN, I_BGATE, I_BFORGET, I_WUK, I_WUV, I_GQA, I_GKV, I_GQB, I_GKB, I_WPA, I_WPB, I_WO, I_GFFN, I_WRG, I_BRG, I_WRE, I_BRE, I_W1, I_W3, I_W2 };

__device__ __forceinline__ unsigned cvt_pk_bf16(float lo, float hi) { unsigned r; asm volatile("v_cvt_pk_bf16_f32 %0, %1, %2" : "=v"(r) : "v"(lo), "v"(hi)); return r; }
__device__ __forceinline__ float bf_lo(unsigned w) { return __uint_as_float(w << 16); }
__device__ __forceinline__ float bf_hi(unsigned w) { return __uint_as_float(w & 0xffff0000u); }
__device__ __forceinline__ float wave_sum(float v) {
#pragma unroll
    for (int o = 32; o >= 1; o >>= 1) v += __shfl_xor(v, o);
    return v;
}
__device__ __forceinline__ float sigmoidf_(float x) { return 1.0f / (1.0f + __expf(-x)); }
__device__ __forceinline__ int crow(int r, int hi) { return (r & 3) + 8 * (r >> 2) + 4 * hi; }
#define SBAR() __builtin_amdgcn_sched_barrier(0)

#define XB_TMO      128
#define XB_XCNT(j)  (256  + 64 * (j))
#define XB_XSUB(j)  (1280 + 64 * (j))
#define XB_XGEN(j)  (2304 + 64 * (j))
#define XB_TOP      3328
#define XB_TOPGEN   3392
#define XCD_BAR_WORDS 3456
#define XB_SPIN_CAP (1u << 20)
__device__ __forceinline__ unsigned xb_ld(unsigned* p)              { return __hip_atomic_load(p, __ATOMIC_RELAXED, __HIP_MEMORY_SCOPE_AGENT); }
__device__ __forceinline__ unsigned xb_add(unsigned* p, unsigned v) { return __hip_atomic_fetch_add(p, v, __ATOMIC_RELAXED, __HIP_MEMORY_SCOPE_AGENT); }
__device__ __forceinline__ unsigned xb_xcc_id() { return (unsigned)__builtin_amdgcn_s_getreg((3 << 11) | 20) & 0xFu; }
#define XB_SPIN(cond, bar) do { unsigned _sp = 0; while (cond) { __builtin_amdgcn_s_sleep(1); \
    if ((++_sp & 255u) == 0u) { if (xb_ld(&(bar)[XB_TMO])) break; if (_sp > XB_SPIN_CAP) { atomicAdd(&(bar)[XB_TMO], 1u); break; } } } } while (0)
struct XcdBarrier { unsigned* bar; unsigned x; volatile LAS unsigned* st; };
__device__ __forceinline__ XcdBarrier xcd_barrier_post(unsigned* bar, volatile LAS unsigned* st) {
    XcdBarrier b; b.bar = bar; b.x = xb_xcc_id(); b.st = st;
    if (threadIdx.x == 0) (void)xb_add(&bar[XB_XCNT(b.x)], 1u);
    return b;
}
__device__ __forceinline__ void xcd_barrier_complete(unsigned* bar, unsigned x, unsigned& nloc, unsigned& nx) {
    const unsigned G = gridDim.x * gridDim.y * gridDim.z;
    unsigned sum, cnt, mine, sp = 0u;
    for (;;) {
        sum = 0u; cnt = 0u; mine = 0u;
#pragma unroll
        for (unsigned j = 0; j < 16; ++j) { const unsigned c = xb_ld(&bar[XB_XCNT(j)]); sum += c; cnt += (c > 0u) ? 1u : 0u; mine = (j == x) ? c : mine; }
        if (sum == G) break;
        __builtin_amdgcn_s_sleep(1);
        if ((++sp & 255u) == 0u) { if (xb_ld(&bar[XB_TMO])) break; if (sp > XB_SPIN_CAP) { atomicAdd(&bar[XB_TMO], 1u); break; } }
    }
    nloc = mine > 0u ? mine : 1u; nx = cnt > 0u ? cnt : 1u;
}
__device__ __forceinline__ void xcd_barrier(const XcdBarrier& b) {
    asm volatile("s_waitcnt vmcnt(0)" ::: "memory");
    __syncthreads();
    if (threadIdx.x == 0) {
        unsigned* bar = b.bar;
        __builtin_amdgcn_s_waitcnt(0);
        unsigned nloc = b.st[0], nx = b.st[1];
        if (nloc == 0u) { xcd_barrier_complete(bar, b.x, nloc, nx); b.st[0] = nloc; b.st[1] = nx; }
        const unsigned old = xb_add(&bar[XB_XSUB(b.x)], 1u);
        const unsigned gen = old / nloc;
        if (old + 1u == (gen + 1u) * nloc) {
            __builtin_amdgcn_fence(__ATOMIC_RELEASE, "agent");
            asm volatile("s_waitcnt vmcnt(0)" ::: "memory");
            const unsigned og = xb_add(&bar[XB_TOP], 1u);
            const unsigned tg = og / nx;
            if (og + 1u == (tg + 1u) * nx) xb_add(&bar[XB_TOPGEN], 1u);
            else XB_SPIN(xb_ld(&bar[XB_TOPGEN]) == tg, bar);
            __builtin_amdgcn_fence(__ATOMIC_ACQUIRE, "agent");
            xb_add(&bar[XB_XGEN(b.x)], 1u);
            asm volatile("s_waitcnt vmcnt(0)" ::: "memory");
        } else {
            XB_SPIN(xb_ld(&bar[XB_XGEN(b.x)]) == gen, bar);
            __builtin_amdgcn_fence(__ATOMIC_ACQUIRE, "agent");
            asm volatile("s_waitcnt vmcnt(0)" ::: "memory");
        }
    }
    __syncthreads();
}

namespace pg8 {
constexpr int BM = 256, BK = 64, HALF = 128, HTB = HALF * BK * 2, STAGE_BYTES = 8 * HTB, NXCD = 8, WGM = 8;
__host__ __device__ __forceinline__ int lds_byte(int r, int c) { const int st = (r >> 4) * 2 + (c >> 5), rr = r & 15, cc = c & 31, ob = rr * 64 + cc * 2; return st * 1024 + (ob ^ (((ob >> 9) & 1) << 5)); }
__host__ __device__ __forceinline__ void stage_rc(int b, int& R, int& C) { const int st = b / 1024, sb = b % 1024, swz = sb ^ (((sb >> 9) & 1) << 5); R = (st >> 1) * 16 + swz / 64; C = (st & 1) * 32 + (swz % 64) / 2; }
__host__ __device__ __forceinline__ int perm32(int rho) { const int n = rho >> 4, i = rho & 15; return 8 * (i >> 2) + 4 * n + (i & 3); }

struct Unit { int pm, pn; const char* a; const char* b; const int* gi; int nvalid; int aux; };

struct StaticOrder {
    int nM, nN, nwg, G, c, K; const char* A; const char* Bt;
    __device__ void init(const void* A_, const void* Bt_, int M, int N, int K_, int G_, int c_) { A = (const char*)A_; Bt = (const char*)Bt_; K = K_; nM = M / BM; nN = N / BM; nwg = nM * nN; G = G_; c = c_; }
    __device__ bool next(int i, Unit& u) const {
        const long L = (long)i * G + c; if (L >= nwg) return false;
        int wgid = (int)L; { const int q = nwg / NXCD, r = nwg % NXCD, xcd = wgid % NXCD, off = wgid / NXCD; wgid = (xcd < r ? xcd * (q + 1) : r * (q + 1) + (xcd - r) * q) + off; }
        const int nig = WGM * nN, gid = wgid / nig, fm = gid * WGM, gsz = (nM - fm) < WGM ? (nM - fm) : WGM;
        u.pm = fm + ((wgid % nig) % gsz); u.pn = (wgid % nig) / gsz;
        u.a = A + (size_t)u.pm * BM * K * 2; u.b = Bt + (size_t)u.pn * BM * K * 2; u.gi = nullptr; u.nvalid = BM; u.aux = 0; return true;
    }
};

template <class Epi, class Sched, bool GATHER>
__device__ __forceinline__ void gemm_phase(LAS unsigned char* lds, const int K, const Sched& S, const Epi& E) {
    const int tid = threadIdx.x, wid = __builtin_amdgcn_readfirstlane(tid >> 6), lane = tid & 63, wr = wid >> 2, wc = wid & 3, fr = lane & 15, fq = lane >> 4;
    const int nt = K / BK;
    unsigned voffA[2], voffB[2]; int RA[2], CA[2];
#pragma unroll
    for (int i = 0; i < 2; ++i) { int R, C; stage_rc(tid * 16 + i * 8192, R, C); const int Rb = ((R & ~31) + perm32(R & 31));
        RA[i] = R; CA[i] = C; voffA[i] = (unsigned)(R * K + C) * 2u; voffB[i] = (unsigned)(Rb * K + C) * 2u; }
    const size_t kstep = (size_t)(BK * 2);
    const size_t hstep = (size_t)HALF * K * 2;
    const unsigned ldsw = (unsigned)wid * 1024u;
    const int aoff = lds_byte(wr * 64 + fr, fq * 8), boff = lds_byte(wc * 32 + fr, fq * 8);
    unsigned gA[2][2], gN[2][2];
#define PG8_SA(b, h) (((b) * 2 + (h)) * HTB)
#define PG8_SB(b, h) ((4 + (b) * 2 + (h)) * HTB)
#define PG8_STAGE(bufoff, gbase, voff) do { _Pragma("unroll") for (int _i = 0; _i < 2; ++_i) \
        __builtin_amdgcn_global_load_lds((const unsigned*)((const char*)(gbase) + (voff)[_i]), (LAS unsigned*)(lds + (bufoff) + ldsw + _i * 8192), 16, 0, 0); } while (0)
#define PG8_STAGE_A(bufoff, gp, h, NX) do { if constexpr (GATHER) { if (NX) PG8_STAGE(bufoff, gp, gN[h]); else PG8_STAGE(bufoff, gp, gA[h]); } else PG8_STAGE(bufoff, (gp) + (h) * hstep, voffA); } while (0)
#define PG8_LDA(dst, b, h) do { _Pragma("unroll") for (int m = 0; m < 4; ++m) _Pragma("unroll") for (int k = 0; k < 2; ++k) dst[m][k] = *(const LAS bf16x8*)(lds + PG8_SA(b, h) + aoff + m * 2048 + k * 1024); } while (0)
#define PG8_LDB(dst, b, h) do { _Pragma("unroll") for (int n = 0; n < 2; ++n) _Pragma("unroll") for (int k = 0; k < 2; ++k) dst[n][k] = *(const LAS bf16x8*)(lds + PG8_SB(b, h) + boff + n * 2048 + k * 1024); } while (0)
#define PG8_MMA(ai, bj, At, Bt) do { __builtin_amdgcn_s_setprio(1); _Pragma("unroll") for (int m = 0; m < 4; ++m) _Pragma("unroll") for (int n = 0; n < 2; ++n) _Pragma("unroll") for (int k = 0; k < 2; ++k) \
        acc[ai][bj][m][n] = __builtin_amdgcn_mfma_f32_16x16x32_bf16(Bt[n][k], At[m][k], acc[ai][bj][m][n], 0, 0, 0); __builtin_amdgcn_s_setprio(0); } while (0)
#define PG8_WAIT_V(n) asm volatile("s_waitcnt vmcnt(" #n ")" ::: "memory")
#define PG8_WAIT_L(n) asm volatile("s_waitcnt lgkmcnt(" #n ")" ::: "memory")
#define PG8_BAR __builtin_amdgcn_s_barrier()
#define PG8_SCHED __builtin_amdgcn_sched_barrier(0)
#define PG8_GIDX(dst, u) do { if constexpr (GATHER) { _Pragma("unroll") for (int h = 0; h < 2; ++h) _Pragma("unroll") for (int i = 0; i < 2; ++i) { \
        const int rr = h * HALF + RA[i]; const int tok = rr < (u).nvalid ? (u).gi[rr] : 0; dst[h][i] = (unsigned)(tok * K + CA[i]) * 2u; } } } while (0)
    Unit cur, nxt; int ui = 0;
    if (!S.next(0, cur)) return;
    f32x4 acc[2][2][4][2];
#pragma unroll
    for (int a = 0; a < 2; ++a)
#pragma unroll
        for (int b = 0; b < 2; ++b)
#pragma unroll
            for (int m = 0; m < 4; ++m)
#pragma unroll
                for (int n = 0; n < 2; ++n) acc[a][b][m][n] = (f32x4){0.f, 0.f, 0.f, 0.f};
    bf16x8 At[4][2], B0[2][2], B1[2][2];
    const char* cA = cur.a; const char* cB = cur.b;
    PG8_GIDX(gA, cur);
    PG8_STAGE(PG8_SB(0, 0), cB, voffB); PG8_STAGE_A(PG8_SA(0, 0), cA, 0, false); PG8_STAGE(PG8_SB(0, 1), cB + hstep, voffB); PG8_STAGE_A(PG8_SA(0, 1), cA, 1, false);
    if (wr == 1) PG8_BAR;
    PG8_WAIT_V(4); PG8_BAR;
    PG8_STAGE(PG8_SB(1, 0), cB + kstep, voffB); PG8_STAGE_A(PG8_SA(1, 0), cA + kstep, 0, false); PG8_STAGE(PG8_SB(1, 1), cB + hstep + kstep, voffB);
    PG8_WAIT_V(6); PG8_BAR;
    for (;;) {
        const bool has_next = S.next(ui + 1, nxt);
        const char* nA = has_next ? nxt.a : cA; const char* nB = has_next ? nxt.b : cB;
        if constexpr (GATHER) { if (has_next) { PG8_GIDX(gN, nxt); } else {
#pragma unroll
            for (int h = 0; h < 2; ++h)
#pragma unroll
                for (int i = 0; i < 2; ++i) gN[h][i] = gA[h][i]; } }
        for (int t = 0; t < nt; t += 2) {
            const bool last = (t == nt - 2);
            const char* a1 = cA + (size_t)(t + 1) * kstep;
            const char* a2 = last ? nA : cA + (size_t)(t + 2) * kstep; const char* b2 = last ? nB : cB + (size_t)(t + 2) * kstep;
            const char* a3 = a2 + kstep; const char* b3 = b2 + kstep;
            PG8_LDB(B0, 0, 0); PG8_SCHED; PG8_LDA(At, 0, 0); PG8_STAGE_A(PG8_SA(1, 1), a1, 1, false);
            PG8_WAIT_L(8); PG8_BAR; PG8_WAIT_L(0); PG8_MMA(0, 0, At, B0); PG8_BAR; PG8_SCHED;
            PG8_LDB(B1, 0, 1); PG8_STAGE(PG8_SB(0, 0), b2, voffB);
            PG8_BAR; PG8_WAIT_L(0); PG8_MMA(0, 1, At, B1); PG8_BAR;
            PG8_LDA(At, 0, 1); PG8_STAGE_A(PG8_SA(0, 0), a2, 0, last);
            PG8_BAR; PG8_WAIT_L(0); PG8_MMA(1, 0, At, B0); PG8_BAR; PG8_SCHED;
            PG8_STAGE(PG8_SB(0, 1), b2 + hstep, voffB);
            PG8_WAIT_V(6); PG8_BAR; PG8_MMA(1, 1, At, B1); PG8_BAR;
            PG8_LDB(B0, 1, 0); PG8_SCHED; PG8_LDA(At, 1, 0); PG8_STAGE_A(PG8_SA(0, 1), a2, 1, last);
            PG8_WAIT_L(8); PG8_BAR; PG8_WAIT_L(0); PG8_MMA(0, 0, At, B0); PG8_BAR; PG8_SCHED;
            PG8_LDB(B1, 1, 1); PG8_STAGE(PG8_SB(1, 0), b3, voffB);
            PG8_BAR; PG8_WAIT_L(0); PG8_MMA(0, 1, At, B1); PG8_BAR;
            PG8_LDA(At, 1, 1); PG8_STAGE_A(PG8_SA(1, 0), a3, 0, last);
            PG8_BAR; PG8_WAIT_L(0); PG8_MMA(1, 0, At, B0); PG8_BAR; PG8_SCHED;
            PG8_STAGE(PG8_SB(1, 1), b3 + hstep, voffB);
            PG8_WAIT_V(6); PG8_BAR; PG8_MMA(1, 1, At, B1); PG8_BAR;
        }
        E(acc, cur, wr, wc, fr, fq);
        if (!has_next) break;
#pragma unroll
        for (int a = 0; a < 2; ++a)
#pragma unroll
            for (int b = 0; b < 2; ++b)
#pragma unroll
                for (int m = 0; m < 4; ++m)
#pragma unroll
                    for (int n = 0; n < 2; ++n) acc[a][b][m][n] = (f32x4){0.f, 0.f, 0.f, 0.f};
        cur = nxt; cA = nA; cB = nB; ++ui;
        if constexpr (GATHER) {
#pragma unroll
            for (int h = 0; h < 2; ++h)
#pragma unroll
                for (int i = 0; i < 2; ++i) gA[h][i] = gN[h][i]; }
    }
    PG8_WAIT_V(0);
    if (wr == 0) PG8_BAR;
    PG8_BAR;
#undef PG8_SA
#undef PG8_SB
#undef PG8_STAGE
#undef PG8_STAGE_A
#undef PG8_LDA
#undef PG8_LDB
#undef PG8_MMA
#undef PG8_WAIT_V
#undef PG8_WAIT_L
#undef PG8_BAR
#undef PG8_SCHED
#undef PG8_GIDX
}
}
using pg8::Unit;

#define EPI_LOOP(...) { int fr_ = fr, fq_ = fq; asm volatile("" : "+v"(fr_), "+v"(fq_)); _Pragma("unroll") for (int ai = 0; ai < 2; ++ai) _Pragma("unroll") for (int m = 0; m < 4; ++m) _Pragma("unroll") for (int bj = 0; bj < 2; ++bj) { \
        const int trow = ai * 128 + wr * 64 + m * 16 + fr_; const int tcol = bj * 128 + wc * 32 + fq_ * 8; const f32x4 v0 = acc[ai][bj][m][0], v1 = acc[ai][bj][m][1]; __VA_ARGS__ } }

__device__ __forceinline__ u32x4 pack8(const f32x4 a, const f32x4 b) { u32x4 w; w.x = cvt_pk_bf16(a[0], a[1]); w.y = cvt_pk_bf16(a[2], a[3]); w.z = cvt_pk_bf16(b[0], b[1]); w.w = cvt_pk_bf16(b[2], b[3]); return w; }

struct EpiProj {
    unsigned char* ws; const float* b_gate;
    __device__ __forceinline__ void operator()(const f32x4 (&acc)[2][2][4][2], const Unit& u, int wr, int wc, int fr, int fq) const {
        const int pn = u.pn; const size_t row0 = (size_t)u.pm * 256;
        if (pn == 4 || pn == 9) {
            float* dst = (float*)(ws + (pn == 4 ? WS_CKV : WS_MISC));
            EPI_LOOP({ float* p = dst + (row0 + trow) * 256 + tcol; *(f32x4*)p = v0; *(f32x4*)(p + 4) = v1; })
        } else if (pn < 22) {
            bf16_t* dst; int ct;
            if (pn < 4) { dst = (bf16_t*)(ws + WS_QA); ct = pn; } else if (pn < 9) { dst = (bf16_t*)(ws + WS_QIDX); ct = pn - 5; }
            else if (pn < 14) { dst = (bf16_t*)(ws + WS_QB); ct = pn - 10; } else if (pn < 18) { dst = (bf16_t*)(ws + WS_KB); ct = pn - 14; } else { dst = (bf16_t*)(ws + WS_VB); ct = pn - 18; }
            EPI_LOOP({ *(u32x4*)(dst + (row0 + trow) * 1024 + ct * 256 + tcol) = pack8(v0, v1); })
        } else {
            bf16_t* dst = (bf16_t*)(ws + WS_GATES); const int ct = pn - 22;
            EPI_LOOP({ const int col = ct * 256 + tcol; const f32x4 b0 = *(const f32x4*)(b_gate + col), b1 = *(const f32x4*)(b_gate + col + 4); f32x4 s0, s1;
                _Pragma("unroll") for (int j = 0; j < 4; ++j) { s0[j] = sigmoidf_(v0[j] + b0[j]); s1[j] = sigmoidf_(v1[j] + b1[j]); }
                *(u32x4*)(dst + (row0 + trow) * 4096 + col) = pack8(s0, s1); })
        }
    }
};
struct EpiGate1 {
    const bf16_t* gates; float* T1;
    __device__ __forceinline__ void operator()(const f32x4 (&acc)[2][2][4][2], const Unit& u, int wr, int wc, int fr, int fq) const {
        EPI_LOOP({ const size_t row = (size_t)u.pm * 256 + trow; const int col = u.pn * 256 + tcol; const u32x4 g = *(const u32x4*)(gates + row * 4096 + col);
            f32x4 o0 = {v0[0] * bf_lo(g.x), v0[1] * bf_hi(g.x), v0[2] * bf_lo(g.y), v0[3] * bf_hi(g.y)}; f32x4 o1 = {v1[0] * bf_lo(g.z), v1[1] * bf_hi(g.z), v1[2] * bf_lo(g.w), v1[3] * bf_hi(g.w)};
            float* p = T1 + row * 2048 + col; *(f32x4*)p = o0; *(f32x4*)(p + 4) = o1; })
    }
};
struct EpiGate2 {
    const bf16_t* gates; const float* T1; bf16_t* merged;
    __device__ __forceinline__ void operator()(const f32x4 (&acc)[2][2][4][2], const Unit& u, int wr, int wc, int fr, int fq) const {
        EPI_LOOP({ const size_t row = (size_t)u.pm * 256 + trow; const int col = u.pn * 256 + tcol; const u32x4 g = *(const u32x4*)(gates + row * 4096 + 2048 + col);
            const float* p = T1 + row * 2048 + col; const f32x4 t0 = *(const f32x4*)p, t1 = *(const f32x4*)(p + 4);
            f32x4 o0 = {t0[0] + v0[0] * bf_lo(g.x), t0[1] + v0[1] * bf_hi(g.x), t0[2] + v0[2] * bf_lo(g.y), t0[3] + v0[3] * bf_hi(g.y)};
            f32x4 o1 = {t1[0] + v1[0] * bf_lo(g.z), t1[1] + v1[1] * bf_hi(g.z), t1[2] + v1[2] * bf_lo(g.w), t1[3] + v1[3] * bf_hi(g.w)};
            *(u32x4*)(merged + row * 2048 + col) = pack8(o0, o1); })
    }
};
struct EpiWo {
    const float* x; const float* mod; float* out;
    __device__ __forceinline__ void operator()(const f32x4 (&acc)[2][2][4][2], const Unit& u, int wr, int wc, int fr, int fq) const {
        const float* gt = mod + (size_t)(u.pm >> 3) * 12288 + 4096;
        EPI_LOOP({ const size_t row = (size_t)u.pm * 256 + trow; const int col = u.pn * 256 + tcol; const float* px = x + row * 2048 + col;
            const f32x4 x0 = *(const f32x4*)px, x1 = *(const f32x4*)(px + 4), g0 = *(const f32x4*)(gt + col), g1 = *(const f32x4*)(gt + col + 4);
            float* po = out + row * 2048 + col; *(f32x4*)po = x0 + g0 * v0; *(f32x4*)(po + 4) = x1 + g1 * v1; })
    }
};
struct EpiMoeUp {
    bf16_t* act; const float* lw;
    __device__ __forceinline__ void operator()(const f32x4 (&acc)[2][2][4][2], const Unit& u, int wr, int wc, int fr, int fq) const {
        int fr_ = fr, fq_ = fq; asm volatile("" : "+v"(fr_), "+v"(fq_));
#pragma unroll
        for (int ai = 0; ai < 2; ++ai)
#pragma unroll
            for (int m = 0; m < 4; ++m) {
                const int trow = ai * 128 + wr * 64 + m * 16 + fr_; const int tcol = wc * 32 + fq_ * 8;
                const float gw = trow < u.nvalid ? lw[u.aux + trow] : 0.f;
                const f32x4 a0 = acc[ai][0][m][0], a1 = acc[ai][0][m][1], u0 = acc[ai][1][m][0], u1 = acc[ai][1][m][1]; f32x4 o0, o1;
#pragma unroll
                for (int j = 0; j < 4; ++j) { o0[j] = a0[j] * sigmoidf_(a0[j]) * u0[j] * gw; o1[j] = a1[j] * sigmoidf_(a1[j]) * u1[j] * gw; }
                *(u32x4*)(act + ((size_t)u.pm * 256 + trow) * 512 + u.pn * 128 + tcol) = pack8(o0, o1); SBAR();
            }
    }
};
struct EpiMoeDown {
    float* out; const float* mod;
    __device__ __forceinline__ void operator()(const f32x4 (&acc)[2][2][4][2], const Unit& u, int wr, int wc, int fr, int fq) const {
        EPI_LOOP({ if (trow < u.nvalid) { const int tok = u.gi[trow]; const int col = u.pn * 256 + tcol; const float* gt = mod + (size_t)(tok >> 11) * 12288 + 10240 + col;
            const f32x4 g0 = *(const f32x4*)gt, g1 = *(const f32x4*)(gt + 4); float* po = out + (size_t)tok * 2048 + col;
            _Pragma("unroll") for (int j = 0; j < 4; ++j) { unsafeAtomicAdd(po + j, g0[j] * v0[j]); unsafeAtomicAdd(po + 4 + j, g1[j] * v1[j]); } } })
    }
};

struct MoeOrder {
    const LAS int* pre;
    const LAS int* cnt;
    int G, c, ntn, K; const char* A; const char* Bt; size_t bstride; const int* ltok; bool down;
    __device__ bool next(int i, Unit& u) const {
        const int total = __builtin_amdgcn_readfirstlane(pre[64]) * ntn; const long L = (long)i * G + c; if (L >= total) return false;
        const int l = (int)L; const int mt = l / ntn, pn = l % ntn;
        int e = 0;
#pragma unroll 1
        for (int s = 32; s >= 1; s >>= 1) if (__builtin_amdgcn_readfirstlane(pre[e + s]) <= mt) e += s;
        const int lt = mt - __builtin_amdgcn_readfirstlane(pre[e]);
        u.pm = mt; u.pn = pn; u.aux = e * LCAP + lt * 256; u.gi = ltok + u.aux; { const int rem = __builtin_amdgcn_readfirstlane(cnt[e]) - lt * 256; u.nvalid = rem < 256 ? rem : 256; }
        u.a = down ? A + (size_t)mt * 256 * K * 2 : A; u.b = Bt + (size_t)e * bstride + (size_t)pn * 256 * K * 2; return true;
    }
};

__device__ __forceinline__ int map_row(int map, int n) {
    if (map == 0) return n;
    if (map == 1) { if (n < 2384) return n; if (n < 5456) return n + 176; if (n < 5464) return n - 3072; return n + 168; }
    if (map == 2) return (n >> 7) * 256 + (n & 127);
    return (n >> 7) * 256 + 128 + (n & 127);
}
__device__ void ph0_prologue(const Params& p, LAS unsigned char* lds) {
    const int tid = threadIdx.x, wid = tid >> 6, lane = tid & 63, G = gridDim.x, bx = blockIdx.x;
    if (bx < 192) {
        LAS float* sc = (LAS float*)lds;
        LAS float* red = (LAS float*)(lds + 32768);
        const float* c = p.in[I_C];
        for (int i = tid; i < 4 * 2048; i += NTHREADS) { const float v = c[i]; sc[i] = v / (1.0f + __expf(-v)); }
        __syncthreads();
        for (int item = bx; item < 192; item += G) {
            const int n0 = item * 64, cg = lane & 15, rs = lane >> 4;
            float acc[4][4];
#pragma unroll
            for (int b = 0; b < 4; ++b)
#pragma unroll
                for (int j = 0; j < 4; ++j) acc[b][j] = 0.f;
            const float* w = p.in[I_WADA] + n0 + cg * 4;
#pragma unroll 4
            for (int step = 0; step < 64; ++step) {
                const int k = step * 32 + wid * 4 + rs;
                const f32x4 wv = *(const f32x4*)(w + (size_t)k * 12288);
#pragma unroll
                for (int b = 0; b < 4; ++b) { const float s = sc[b * 2048 + k];
#pragma unroll
                    for (int j = 0; j < 4; ++j) acc[b][j] += s * wv[j]; }
            }
#pragma unroll
            for (int b = 0; b < 4; ++b)
#pragma unroll
                for (int j = 0; j < 4; ++j) { float v = acc[b][j]; v += __shfl_xor(v, 16); v += __shfl_xor(v, 32); acc[b][j] = v; }
            if (rs == 0) {
#pragma unroll
                for (int b = 0; b < 4; ++b)
#pragma unroll
                    for (int j = 0; j < 4; ++j) red[(wid * 16 + cg) * 16 + b * 4 + j] = acc[b][j]; }
            __syncthreads();
            if (tid < 256) { const int cg2 = tid >> 4, bj = tid & 15, b = bj >> 2, j = bj & 3; float s = 0.f;
#pragma unroll
                for (int w8 = 0; w8 < 8; ++w8) s += red[(w8 * 16 + cg2) * 16 + bj];
                const int n = n0 + cg2 * 4 + j; ((float*)(p.ws + WS_MOD))[b * 12288 + n] = s + p.in[I_BADA][n]; }
            __syncthreads();
        }
    }
    { u32x4* z = (u32x4*)(p.ws + WS_WIN + (size_t)2392 * 2048 * 2); const int n16 = 168 * 2048 * 2 / 16;
      for (int i = bx * NTHREADS + tid; i < n16; i += G * NTHREADS) z[i] = (u32x4){0u, 0u, 0u, 0u}; }
    { bf16_t* wh = (bf16_t*)(p.ws + WS_WRH); bf16_t* wl = (bf16_t*)(p.ws + WS_WRL);
      for (int i = bx * NTHREADS + tid; i < 80 * 2048; i += G * NTHREADS) { const int n = i >> 11, k = i & 2047;
          const float v = n < 8 ? p.in[I_WRG][k * 8 + n] : (n < 72 ? p.in[I_WRE][k * 64 + n - 8] : 0.f);
          const unsigned h = cvt_pk_bf16(v, 0.f) & 0xffffu; const unsigned l = cvt_pk_bf16(v - bf_lo(h), 0.f) & 0xffffu; wh[i] = (bf16_t)h; wl[i] = (bf16_t)l; } }
    LAS float* tile = (LAS float*)(lds + 65536);
    for (int ti = bx; ti < p.ntiles_total; ti += G) {
        int j = 0;
#pragma unroll 1
        for (int q = 1; q < NJOBS; ++q) if (ti >= p.jobs[q].tile0) j = q;
        const TJob& J = p.jobs[j];
        int l = ti - J.tile0; const int per = J.ntk * J.ntn; const int bt = l / per; l -= bt * per; const int tn = l / J.ntk, tk = l % J.ntk;
        const float* src = J.src + (size_t)bt * J.sbatch; bf16_t* dst = J.dst + (size_t)bt * J.dbatch;
        const int k0 = tk * 64, n0 = tn * 64;
#pragma unroll
        for (int i = 0; i < 2; ++i) { const int r = (tid >> 4) + 32 * i, c4 = (tid & 15) * 4;
            f32x4 v = {0.f, 0.f, 0.f, 0.f}; if (n0 + c4 < J.N) v = *(const f32x4*)(src + (size_t)(k0 + r) * J.N + n0 + c4);
#pragma unroll
            for (int q = 0; q < 4; ++q) tile[r * 65 + c4 + q] = v[q]; }
        __syncthreads();
        { const int n = tid >> 3, kq = (tid & 7) * 8;
          if (n0 + n < J.N) { float f[8];
#pragma unroll
              for (int q = 0; q < 8; ++q) f[q] = tile[(kq + q) * 65 + n];
              u32x4 w; w.x = cvt_pk_bf16(f[0], f[1]); w.y = cvt_pk_bf16(f[2], f[3]); w.z = cvt_pk_bf16(f[4], f[5]); w.w = cvt_pk_bf16(f[6], f[7]);
              *(u32x4*)(dst + (size_t)map_row(J.map, n0 + n) * J.ldd + k0 + kq) = w; } }
        __syncthreads();
    }
}

__device__ __forceinline__ void norm_row(const float* xr, const float* g, const float* sh, const float* sc, bf16_t* hr, int lane, float (&hv)[32]) {
    f32x4 v[8]; float ss = 0.f;
#pragma unroll
    for (int i = 0; i < 8; ++i) { v[i] = *(const f32x4*)(xr + i * 256 + lane * 4); ss += v[i][0] * v[i][0] + v[i][1] * v[i][1] + v[i][2] * v[i][2] + v[i][3] * v[i][3]; }
    ss = wave_sum(ss);
    const float rstd = rsqrtf(ss * (1.0f / 2048.0f) + RMS_EPS);
#pragma unroll
    for (int i = 0; i < 8; ++i) { const int col = i * 256 + lane * 4; const f32x4 gg = *(const f32x4*)(g + col), s1 = *(const f32x4*)(sc + col), s0 = *(const f32x4*)(sh + col);
#pragma unroll
        for (int j = 0; j < 4; ++j) hv[i * 4 + j] = v[i][j] * rstd * gg[j] * (1.0f + s1[j]) + s0[j];
        u32x2 w; w.x = cvt_pk_bf16(hv[i * 4], hv[i * 4 + 1]); w.y = cvt_pk_bf16(hv[i * 4 + 2], hv[i * 4 + 3]); *(u32x2*)(hr + col) = w; }
}
__device__ void ph1_norm(const Params& p) {
    const int lane = threadIdx.x & 63, gw = blockIdx.x * 8 + (threadIdx.x >> 6), nw = gridDim.x * 8;
    const float* mod = (const float*)(p.ws + WS_MOD);
    for (int t = gw; t < NTOK; t += nw) { const int b = t >> 11; float hv[32];
        norm_row(p.in[I_X] + (size_t)t * DM, p.in[I_GMIX], mod + b * 12288, mod + b * 12288 + 2048, (bf16_t*)(p.ws + WS_H) + (size_t)t * DM, lane, hv); }
}

template <int MB, int NB, int KS>
__device__ __forceinline__ void wave_gemm(const bf16_t* A, int lda, const bf16_t* Bt, int ldb, f32x4 (&acc)[MB][NB], int lane) {
    const int fr = lane & 15, fq = lane >> 4;
#pragma unroll
    for (int mb = 0; mb < MB; ++mb)
#pragma unroll
        for (int nb = 0; nb < NB; ++nb) acc[mb][nb] = (f32x4){0.f, 0.f, 0.f, 0.f};
#pragma unroll 1
    for (int ks = 0; ks < KS; ++ks) {
        bf16x8 af[MB];
#pragma unroll
        for (int mb = 0; mb < MB; ++mb) af[mb] = *(const bf16x8*)(A + (size_t)(mb * 16 + fr) * lda + ks * 32 + fq * 8);
#pragma unroll
        for (int nb = 0; nb < NB; ++nb) { const bf16x8 bf = *(const bf16x8*)(Bt + (size_t)(nb * 16 + fr) * ldb + ks * 32 + fq * 8);
#pragma unroll
            for (int mb = 0; mb < MB; ++mb) acc[mb][nb] = __builtin_amdgcn_mfma_f32_16x16x32_bf16(bf, af[mb], acc[mb][nb], 0, 0, 0); }
    }
}

__device__ void idx_item(const Params& p, LAS unsigned char* lds, int b, int c, int sub) {
    const int tid = threadIdx.x, wid = tid >> 6, lane = tid & 63, fr = lane & 15, fq = lane >> 4;
    constexpr int SCLD = 2052;
    LAS float* sc = (LAS float*)lds;
    const int q0 = c * 64 + sub * 16, nk = (c + 1) * 64, nkb = nk / 16;
    const bf16_t* qidx = (const bf16_t*)(p.ws + WS_QIDX) + (size_t)(b * SEQ + q0 + fr) * 1024;
    const float* misc = (const float*)(p.ws + WS_MISC);
    float wq[16];
    { const float* wp = misc + (size_t)(b * SEQ + q0 + fr) * 256 + 64;
#pragma unroll
      for (int i = 0; i < 4; ++i) { const f32x4 v = *(const f32x4*)(wp + i * 4); wq[i * 4] = v[0]; wq[i * 4 + 1] = v[1]; wq[i * 4 + 2] = v[2]; wq[i * 4 + 3] = v[3]; } }
#pragma unroll
    for (int hp = 0; hp < 2; ++hp) {
        bf16x8 qf[8][2];
#pragma unroll
        for (int h = 0; h < 8; ++h)
#pragma unroll
            for (int ks = 0; ks < 2; ++ks) qf[h][ks] = *(const bf16x8*)(qidx + (hp * 8 + h) * 64 + ks * 32 + fq * 8);
#pragma unroll 1
        for (int kb = wid; kb < nkb; kb += 8) {
            const float* kp = misc + (size_t)(b * SEQ + kb * 16 + fr) * 256 + fq * 8;
            bf16x8 kf[2];
#pragma unroll
            for (int ks = 0; ks < 2; ++ks) { const f32x4 a = *(const f32x4*)(kp + ks * 32), bq = *(const f32x4*)(kp + ks * 32 + 4);
                u32x4 w; w.x = cvt_pk_bf16(a[0], a[1]); w.y = cvt_pk_bf16(a[2], a[3]); w.z = cvt_pk_bf16(bq[0], bq[1]); w.w = cvt_pk_bf16(bq[2], bq[3]); kf[ks] = *(bf16x8*)&w; }
            LAS f32x4* sp = (LAS f32x4*)(sc + fr * SCLD + kb * 16 + fq * 4);
            f32x4 s = {0.f, 0.f, 0.f, 0.f}; if (hp) s = *sp;
#pragma unroll
            for (int h = 0; h < 8; ++h) {
                f32x4 a = {0.f, 0.f, 0.f, 0.f};
                a = __builtin_amdgcn_mfma_f32_16x16x32_bf16(kf[0], qf[h][0], a, 0, 0, 0);
                a = __builtin_amdgcn_mfma_f32_16x16x32_bf16(kf[1], qf[h][1], a, 0, 0, 0);
#pragma unroll
                for (int j = 0; j < 4; ++j) s[j] += wq[hp * 8 + h] * fmaxf(a[j], 0.f);
            }
            *sp = s;
        }
    }
    __syncthreads();
    unsigned long long* mask = (unsigned long long*)(p.ws + WS_MASK);
    for (int qq = 0; qq < 2; ++qq) {
        const int ql = wid * 2 + qq; const size_t qg = (size_t)b * SEQ + q0 + ql;
        unsigned long long myword = 0ull;
        if (nk <= 256) { if (lane <= c) myword = ~0ull; }
        else {
            LAS unsigned* sk = (LAS unsigned*)(sc + ql * SCLD) + lane;
#pragma unroll 4
            for (int i = 0; i <= c; ++i) { unsigned u = sk[i * 64]; u = (u & 0x80000000u) ? ~u : (u | 0x80000000u); sk[i * 64] = u; }
            unsigned v = 0u;
#pragma unroll 1
            for (int bit = 31; bit >= 0; --bit) {
                const unsigned cand = v | (1u << bit); int cnt = 0;
#pragma unroll 4
                for (int i = 0; i <= c; ++i) cnt += __popcll(__ballot(sk[i * 64] >= cand));
                if (cnt >= 256) { v = cand; if (cnt == 256) break; }
            }
#pragma unroll 4
            for (int i = 0; i <= c; ++i) { const unsigned long long bm = __ballot(sk[i * 64] >= v); if (lane == i) myword = bm; }
        }
        if (lane < 32) mask[qg * 32 + lane] = myword;
    }
    __syncthreads();
}
__device__ void ph3_prep(const Params& p, LAS unsigned char* lds) {
    const int tid = threadIdx.x, wid = tid >> 6, lane = tid & 63, bx = blockIdx.x, G = gridDim.x;
    for (int it = bx; it < 256; it += G) {
        const int b = it >> 6, r = it & 63, cp = r >> 2, sub = r & 3;
        idx_item(p, lds, b, 31 - cp, sub); idx_item(p, lds, b, cp, sub);
    }
    const int gw = bx * 8 + wid, nw = G * 8;
    for (int it = gw; it < 2048; it += nw) {
        const int rt = it >> 3, h = it & 7, fr = lane & 15, fq = lane >> 4;
        f32x4 acc[2][16];
        wave_gemm<2, 16, 4>((const bf16_t*)(p.ws + WS_QA) + (size_t)rt * 32 * 1024 + h * 128, 1024, (const bf16_t*)(p.ws + WS_WUK) + (size_t)h * 256 * 128, 128, acc, lane);
#pragma unroll
        for (int mb = 0; mb < 2; ++mb) { float ss = 0.f;
#pragma unroll
            for (int nb = 0; nb < 16; ++nb)
#pragma unroll
                for (int j = 0; j < 4; ++j) ss += acc[mb][nb][j] * acc[mb][nb][j];
            ss += __shfl_xor(ss, 16); ss += __shfl_xor(ss, 32);
            const float rs = rsqrtf(ss * (1.0f / 256.0f) + RMS_EPS) * 0.0625f;
            bf16_t* o = (bf16_t*)(p.ws + WS_QLAT) + (size_t)(rt * 32 + mb * 16 + fr) * 2048 + h * 256;
#pragma unroll
            for (int nb = 0; nb < 16; ++nb) { const int col = nb * 16 + fq * 4; const f32x4 g = *(const f32x4*)(p.in[I_GQA] + col);
                u32x2 w; w.x = cvt_pk_bf16(acc[mb][nb][0] * rs * g[0], acc[mb][nb][1] * rs * g[1]); w.y = cvt_pk_bf16(acc[mb][nb][2] * rs * g[2], acc[mb][nb][3] * rs * g[3]); *(u32x2*)(o + col) = w; } }
    }
    for (int t = gw; t < NTOK; t += nw) {
        { const f32x4 v = *(const f32x4*)((const float*)(p.ws + WS_CKV) + (size_t)t * 256 + lane * 4); float ss = wave_sum(v[0] * v[0] + v[1] * v[1] + v[2] * v[2] + v[3] * v[3]);
          const float rs = rsqrtf(ss * (1.0f / 256.0f) + RMS_EPS); const f32x4 g = *(const f32x4*)(p.in[I_GKV] + lane * 4);
          u32x2 w; w.x = cvt_pk_bf16(v[0] * rs * g[0], v[1] * rs * g[1]); w.y = cvt_pk_bf16(v[2] * rs * g[2], v[3] * rs * g[3]); *(u32x2*)((bf16_t*)(p.ws + WS_KV) + (size_t)t * 256 + lane * 4) = w; }
#pragma unroll
        for (int which = 0; which < 2; ++which) {
            bf16_t* row = (bf16_t*)(p.ws + (which ? WS_KB : WS_QB)) + (size_t)t * 1024 + lane * 16; const float* g = p.in[which ? I_GKB : I_GQB] + (lane & 7) * 16;
            u32x4 a = *(u32x4*)row, c2 = *(u32x4*)(row + 8); float f[16];
            f[0] = bf_lo(a.x); f[1] = bf_hi(a.x); f[2] = bf_lo(a.y); f[3] = bf_hi(a.y); f[4] = bf_lo(a.z); f[5] = bf_hi(a.z); f[6] = bf_lo(a.w); f[7] = bf_hi(a.w);
            f[8] = bf_lo(c2.x); f[9] = bf_hi(c2.x); f[10] = bf_lo(c2.y); f[11] = bf_hi(c2.y); f[12] = bf_lo(c2.z); f[13] = bf_hi(c2.z); f[14] = bf_lo(c2.w); f[15] = bf_hi(c2.w);
            float ss = 0.f;
#pragma unroll
            for (int j = 0; j < 16; ++j) ss += f[j] * f[j];
            ss += __shfl_xor(ss, 1); ss += __shfl_xor(ss, 2); ss += __shfl_xor(ss, 4);
            const float rs = rsqrtf(ss * (1.0f / 128.0f) + RMS_EPS) * (which ? 1.0f : 0.08838834764831845f);
#pragma unroll
            for (int j = 0; j < 16; ++j) f[j] *= rs * g[j];
            a.x = cvt_pk_bf16(f[0], f[1]); a.y = cvt_pk_bf16(f[2], f[3]); a.z = cvt_pk_bf16(f[4], f[5]); a.w = cvt_pk_bf16(f[6], f[7]);
            c2.x = cvt_pk_bf16(f[8], f[9]); c2.y = cvt_pk_bf16(f[10], f[11]); c2.z = cvt_pk_bf16(f[12], f[13]); c2.w = cvt_pk_bf16(f[14], f[15]);
            *(u32x4*)row = a; *(u32x4*)(row + 8) = c2;
        }
    }
    for (int it = gw; it < 32; it += nw) {
        const int b = it >> 3, h = it & 7; const float bf = p.in[I_BFORGET][h]; const float* fp = (const float*)(p.ws + WS_MISC) + (size_t)(b * SEQ + lane * 32) * 256 + 80 + h;
        float ls[32]; float run = 0.f;
#pragma unroll
        for (int j = 0; j < 32; ++j) { const float z = fp[(size_t)j * 256] + bf; run += fminf(z, 0.f) - log1pf(__expf(-fabsf(z))); ls[j] = run; }
        float incl = run;
#pragma unroll
        for (int o = 1; o < 64; o <<= 1) { const float t2 = __shfl_up(incl, o); if (lane >= o) incl += t2; }
        const float off = incl - run; float* cp = (float*)(p.ws + WS_CUM) + (size_t)(b * 8 + h) * SEQ + lane * 32;
#pragma unroll
        for (int j = 0; j < 32; ++j) cp[j] = ls[j] + off;
    }
}

template <int OFF> __device__ __forceinline__ s16x4 tr_read(int vb) { s16x4 r; asm volatile("ds_read_b64_tr_b16 %0, %1 offset:%2" : "=&v"(r) : "v"(vb), "i"(OFF) : "memory"); return r; }
__device__ __forceinline__ int v_rd_base(int lane) { return ((lane & 3) << 3) | (((lane >> 2) & 3) << 6) | (((lane >> 4) & 1) << 5) | (((lane >> 5) & 1) << 8); }
template <int NCB> __device__ __forceinline__ int v_st(int k, int c) { const int kk = (k & ~0xC) | ((k & 4) << 1) | ((k & 8) >> 1); return ((kk >> 3) * NCB + (c >> 5)) * 512 + ((kk & 7) * 32 + (c & 31)) * 2; }
#define PK4(P, BASE, OUT) do { unsigned a0 = cvt_pk_bf16(P[BASE + 0], P[BASE + 1]), a1 = cvt_pk_bf16(P[BASE + 2], P[BASE + 3]);   \
    unsigned b0 = cvt_pk_bf16(P[BASE + 4], P[BASE + 5]), b1 = cvt_pk_bf16(P[BASE + 6], P[BASE + 7]);                              \
    auto r0 = __builtin_amdgcn_permlane32_swap(a0, b0, false, false); auto r1 = __builtin_amdgcn_permlane32_swap(a1, b1, false, false); \
    u32x4 w = {r0[0], r1[0], r0[1], r1[1]}; OUT = *reinterpret_cast<bf16x8*>(&w); } while (0)
#define PKV(L, H) (bf16x8){L[0], L[1], L[2], L[3], H[0], H[1], H[2], H[3]}
template <int NCB, int D0, int KS> __device__ __forceinline__ void pv_step(f32x16& od, int vb, bf16x8 pa) {
    const s16x4 l = tr_read<D0 * 512 + KS * (2 * NCB * 512)>(vb), h = tr_read<D0 * 512 + KS * (2 * NCB * 512) + NCB * 512>(vb);
    asm volatile("s_waitcnt lgkmcnt(0)" ::: "memory"); SBAR();
    od = __builtin_amdgcn_mfma_f32_32x32x16_bf16(pa, PKV(l, h), od, 0, 0, 0);
}
template <int NCB, int KS0, int D0> struct PvBlocks { static __device__ __forceinline__ void run(f32x16* o, int vb, bf16x8 pa0, bf16x8 pa1) {
    pv_step<NCB, D0, KS0>(o[D0], vb, pa0); pv_step<NCB, D0, KS0 + 1>(o[D0], vb, pa1); if constexpr (D0 + 1 < NCB) PvBlocks<NCB, KS0, D0 + 1>::run(o, vb, pa0, pa1); } };

constexpr int FOX_V = 0, FOX_K = 16384, FOX_CK = 32768, FOX_AL = 33024, FOX_LI = 34048;
__device__ void fox_item(const Params& p, LAS unsigned char* lds, int b, int h, int qb) {
    const int tid = threadIdx.x, wid = tid >> 6, lane = tid & 63, r32 = lane & 31, hi = lane >> 5;
    const bf16_t* Q = (const bf16_t*)(p.ws + WS_QB); const bf16_t* Kg = (const bf16_t*)(p.ws + WS_KB); const bf16_t* Vg = (const bf16_t*)(p.ws + WS_VB);
    const float* cum = (const float*)(p.ws + WS_CUM) + (size_t)(b * 8 + h) * SEQ;
    const int qpos = qb * 256 + wid * 32 + r32;
    bf16x8 qr[8];
    { const bf16_t* qp = Q + (size_t)(b * SEQ + qpos) * 1024 + h * 128 + hi * 8;
#pragma unroll
      for (int d0 = 0; d0 < 8; ++d0) qr[d0] = *(const bf16x8*)(qp + d0 * 16); }
    const float cq = cum[qpos] * LOG2E;
    float m_reg = -1e30f, l_reg = 0.f; f32x16 o[4];
#pragma unroll
    for (int d = 0; d < 4; ++d)
#pragma unroll
        for (int r = 0; r < 16; ++r) o[d][r] = 0.f;
    LAS float* ck = (LAS float*)(lds + FOX_CK); LAS float* al_l = (LAS float*)(lds + FOX_AL) + wid * 32; LAS float* li_l = (LAS float*)(lds + FOX_LI) + wid * 32;
    const int vb = (int)(uintptr_t)(lds + FOX_V) + v_rd_base(lane);
    const int sr = tid >> 4, scol = (tid & 15) * 8;
    const int ntiles = qb * 4 + 4, mylast = qb * 4 + (wid >> 1);
    for (int kt = 0; kt < ntiles; ++kt) {
        __syncthreads();
#pragma unroll
        for (int i = 0; i < 2; ++i) { const int row = sr + 32 * i; const size_t g = (size_t)(b * SEQ + kt * 64 + row) * 1024 + h * 128 + scol;
            const u32x4 kv = *(const u32x4*)(Kg + g), vv = *(const u32x4*)(Vg + g);
            *(LAS u32x4*)(lds + FOX_K + row * 256 + ((scol * 2) ^ ((row & 7) << 4))) = kv; *(LAS u32x4*)(lds + FOX_V + v_st<4>(row, scol)) = vv; }
        if (tid < 64) ck[tid] = cum[kt * 64 + tid] * LOG2E;
        __syncthreads();
        if (kt <= mylast) {
            f32x16 p0, p1;
#pragma unroll
            for (int r = 0; r < 16; ++r) { p0[r] = 0.f; p1[r] = 0.f; }
#pragma unroll
            for (int d0 = 0; d0 < 8; ++d0) { const int cb = (d0 * 16 + hi * 8) * 2;
                const bf16x8 b0 = *(const LAS bf16x8*)(lds + FOX_K + r32 * 256 + (cb ^ ((r32 & 7) << 4)));
                const bf16x8 b1 = *(const LAS bf16x8*)(lds + FOX_K + (32 + r32) * 256 + (cb ^ ((r32 & 7) << 4)));
                p0 = __builtin_amdgcn_mfma_f32_32x32x16_bf16(b0, qr[d0], p0, 0, 0, 0); p1 = __builtin_amdgcn_mfma_f32_32x32x16_bf16(b1, qr[d0], p1, 0, 0, 0); }
            const bool diag = (kt * 64 + 63 > qb * 256 + wid * 32);
            float pmax = -INFINITY;
#pragma unroll
            for (int g4 = 0; g4 < 4; ++g4) { const f32x4 c0 = *(const LAS f32x4*)(ck + 8 * g4 + 4 * hi), c1 = *(const LAS f32x4*)(ck + 32 + 8 * g4 + 4 * hi);
#pragma unroll
                for (int j = 0; j < 4; ++j) { const int r = g4 * 4 + j; float t0 = fmaf(p0[r], LOG2E, cq) - c0[j], t1 = fmaf(p1[r], LOG2E, cq) - c1[j];
                    if (diag) { const int kp = kt * 64 + crow(r, hi); if (kp > qpos) t0 = -INFINITY; if (kp + 32 > qpos) t1 = -INFINITY; }
                    p0[r] = t0; p1[r] = t1; pmax = fmaxf(pmax, fmaxf(t0, t1)); } }
            { auto rr = __builtin_amdgcn_permlane32_swap(__float_as_uint(pmax), __float_as_uint(pmax), false, false); pmax = fmaxf(__uint_as_float(rr[0]), __uint_as_float(rr[1])); }
            const float mn = fmaxf(m_reg, pmax); const float alpha = __builtin_amdgcn_exp2f(m_reg - mn); m_reg = mn;
            float ps = 0.f;
#pragma unroll
            for (int r = 0; r < 16; ++r) { p0[r] = __builtin_amdgcn_exp2f(p0[r] - mn); p1[r] = __builtin_amdgcn_exp2f(p1[r] - mn); ps += p0[r] + p1[r]; }
            { auto rr = __builtin_amdgcn_permlane32_swap(__float_as_uint(ps), __float_as_uint(ps), false, false); ps = __uint_as_float(rr[0]) + __uint_as_float(rr[1]); }
            l_reg = l_reg * alpha + ps;
            if (__any(alpha < 1.f)) { if (hi == 0) al_l[r32] = alpha; asm volatile("s_waitcnt lgkmcnt(0)" ::: "memory");
#pragma unroll
                for (int r = 0; r < 16; ++r) { const float a = al_l[crow(r, hi)];
#pragma unroll
                    for (int d = 0; d < 4; ++d) o[d][r] *= a; } }
            bf16x8 pa0, pa1, pa2, pa3; PK4(p0, 0, pa0); PK4(p0, 8, pa1); PK4(p1, 0, pa2); PK4(p1, 8, pa3);
            PvBlocks<4, 0, 0>::run(o, vb, pa0, pa1); PvBlocks<4, 2, 0>::run(o, vb, pa2, pa3);
        }
    }
    if (hi == 0) li_l[r32] = l_reg; asm volatile("s_waitcnt lgkmcnt(0)" ::: "memory");
    bf16_t* O = (bf16_t*)(p.ws + WS_OB) + (size_t)(b * SEQ + qb * 256 + wid * 32) * 1024 + h * 128;
#pragma unroll
    for (int r = 0; r < 16; ++r) { const float rl = __builtin_amdgcn_rcpf(li_l[crow(r, hi)]); const int orow = crow(r, hi);
#pragma unroll
        for (int d0 = 0; d0 < 4; ++d0) O[(size_t)orow * 1024 + d0 * 32 + r32] = (bf16_t)(cvt_pk_bf16(o[d0][r] * rl, 0.f) & 0xffffu); }
}

constexpr int DSA_V = 0, DSA_K = 32768, DSA_AL = 65536, DSA_LI = 66560, DSA_Q = 67584;
__device__ void dsa_item(const Params& p, LAS unsigned char* lds, int b, int qt) {
    const int tid = threadIdx.x, wid = tid >> 6, lane = tid & 63, r32 = lane & 31, hi = lane >> 5, h = wid;
    const bf16_t* KV = (const bf16_t*)(p.ws + WS_KV) + (size_t)b * SEQ * 256;
    const int qpos = qt * 32 + r32; const size_t qg = (size_t)b * SEQ + qpos;
    const unsigned* mask = (const unsigned*)(p.ws + WS_MASK) + qg * 64;
    bf16x8 qr[8];
    LAS unsigned char* qlds = lds + DSA_Q + wid * 8192 + lane * 16;
    __syncthreads();
    { const bf16_t* qp = (const bf16_t*)(p.ws + WS_QLAT) + qg * 2048 + h * 256 + hi * 8;
#pragma unroll
      for (int d0 = 0; d0 < 8; ++d0) qr[d0] = *(const bf16x8*)(qp + d0 * 16);
#pragma unroll
      for (int d0 = 8; d0 < 16; ++d0) *(LAS bf16x8*)(qlds + (d0 - 8) * 1024) = *(const bf16x8*)(qp + d0 * 16); }
    const float slopeL = exp2f(-(float)(h + 1)) * LOG2E;
    float m_reg = -1e30f, l_reg = 0.f; f32x16 o[8];
#pragma unroll
    for (int d = 0; d < 8; ++d)
#pragma unroll
        for (int r = 0; r < 16; ++r) o[d][r] = 0.f;
    LAS float* al_l = (LAS float*)(lds + DSA_AL) + wid * 32; LAS float* li_l = (LAS float*)(lds + DSA_LI) + wid * 32;
    const int vb = (int)(uintptr_t)(lds + DSA_V) + v_rd_base(lane);
    const int ntiles = (qt >> 1) + 1;
    for (int kt = 0; kt < ntiles; ++kt) {
        __syncthreads();
#pragma unroll
        for (int i = 0; i < 4; ++i) { const int row = (tid >> 5) + 16 * i, col = (tid & 31) * 8;
            const u32x4 v = *(const u32x4*)(KV + (size_t)(kt * 64 + row) * 256 + col);
            *(LAS u32x4*)(lds + DSA_K + row * 512 + ((col * 2) ^ ((row & 15) << 4))) = v; *(LAS u32x4*)(lds + DSA_V + v_st<8>(row, col)) = v; }
        const u32x2 mw = *(const u32x2*)(mask + kt * 2);
        __syncthreads();
#pragma unroll
        for (int half = 0; half < 2; ++half) {
            f32x16 pp;
#pragma unroll
            for (int r = 0; r < 16; ++r) pp[r] = 0.f;
#pragma unroll
            for (int d0 = 0; d0 < 16; ++d0) { const int cb = (d0 * 16 + hi * 8) * 2; const int row = half * 32 + r32;
                const bf16x8 kf = *(const LAS bf16x8*)(lds + DSA_K + row * 512 + (cb ^ ((row & 15) << 4)));
                bf16x8 qf; if (d0 < 8) qf = qr[d0 & 7]; else qf = *(const LAS bf16x8*)(qlds + (d0 - 8) * 1024);
                pp = __builtin_amdgcn_mfma_f32_32x32x16_bf16(kf, qf, pp, 0, 0, 0); if ((d0 & 1) == 1) SBAR(); }
            const unsigned wsh = (half ? mw.y : mw.x) >> (4 * hi);
            const float df = (float)(qpos - (kt * 64 + half * 32 + 4 * hi));
            float pmax = -INFINITY;
#pragma unroll
            for (int r = 0; r < 16; ++r) { const int cb = (r & 3) + 8 * (r >> 2); const float dd = df - (float)cb;
                float t = fmaf(-slopeL, fabsf(dd), pp[r] * LOG2E); if (!((wsh >> cb) & 1u)) t = -INFINITY; pp[r] = t; pmax = fmaxf(pmax, t); }
            { auto rr = __builtin_amdgcn_permlane32_swap(__float_as_uint(pmax), __float_as_uint(pmax), false, false); pmax = fmaxf(__uint_as_float(rr[0]), __uint_as_float(rr[1])); }
            const float mn = fmaxf(m_reg, pmax); const float alpha = __builtin_amdgcn_exp2f(m_reg - mn); m_reg = mn;
            float ps = 0.f;
#pragma unroll
            for (int r = 0; r < 16; ++r) { pp[r] = __builtin_amdgcn_exp2f(pp[r] - mn); ps += pp[r]; }
            { auto rr = __builtin_amdgcn_permlane32_swap(__float_as_uint(ps), __float_as_uint(ps), false, false); ps = __uint_as_float(rr[0]) + __uint_as_float(rr[1]); }
            l_reg = l_reg * alpha + ps;
            if (__any(alpha < 1.f)) { if (hi == 0) al_l[r32] = alpha; asm volatile("s_waitcnt lgkmcnt(0)" ::: "memory");
#pragma unroll
                for (int r = 0; r < 16; ++r) { const float a = al_l[crow(r, hi)];
#pragma unroll
                    for (int d = 0; d < 8; ++d) o[d][r] *= a; } }
            bf16x8 pa0, pa1; PK4(pp, 0, pa0); PK4(pp, 8, pa1);
            if (half == 0) PvBlocks<8, 0, 0>::run(o, vb, pa0, pa1); else PvBlocks<8, 2, 0>::run(o, vb, pa0, pa1);
        }
    }
    if (hi == 0) li_l[r32] = l_reg; asm volatile("s_waitcnt lgkmcnt(0)" ::: "memory");
    bf16_t* O = (bf16_t*)(p.ws + WS_OLAT) + ((size_t)b * SEQ + qt * 32) * 2048 + h * 256;
#pragma unroll
    for (int r = 0; r < 16; ++r) { const float rl = __builtin_amdgcn_rcpf(li_l[crow(r, hi)]); const int orow = crow(r, hi);
#pragma unroll
        for (int d0 = 0; d0 < 8; ++d0) O[(size_t)orow * 2048 + d0 * 32 + r32] = (bf16_t)(cvt_pk_bf16(o[d0][r] * rl, 0.f) & 0xffffu); }
}
__device__ void ph4_attn(const Params& p, LAS unsigned char* lds) {
    const int r = blockIdx.x;
    if (r < 256) { const int c = 31 - (r >> 3), w8 = r & 7, b = w8 >> 1, half = w8 & 1; dsa_item(p, lds, b, c * 2 + half); }
    __syncthreads();
    if (r < 256) { const int qb = r >> 5, bh = r & 31; fox_item(p, lds, bh >> 3, bh & 7, qb); }
}

__device__ void ph5_oa(const Params& p) {
    const int lane = threadIdx.x & 63, gw = blockIdx.x * 8 + (threadIdx.x >> 6), nw = gridDim.x * 8, fr = lane & 15, fq = lane >> 4;
    for (int it = gw; it < 2048; it += nw) {
        const int rt = it >> 3, h = it & 7;
        f32x4 acc[2][8];
        wave_gemm<2, 8, 8>((const bf16_t*)(p.ws + WS_OLAT) + (size_t)rt * 32 * 2048 + h * 256, 2048, (const bf16_t*)(p.ws + WS_WUV) + (size_t)h * 128 * 256, 256, acc, lane);
#pragma unroll
        for (int mb = 0; mb < 2; ++mb) { bf16_t* o = (bf16_t*)(p.ws + WS_OA) + (size_t)(rt * 32 + mb * 16 + fr) * 1024 + h * 128;
#pragma unroll
            for (int nb = 0; nb < 8; ++nb) { u32x2 w; w.x = cvt_pk_bf16(acc[mb][nb][0], acc[mb][nb][1]); w.y = cvt_pk_bf16(acc[mb][nb][2], acc[mb][nb][3]); *(u32x2*)(o + nb * 16 + fq * 4) = w; } }
    }
}

__device__ void ph8_router(const Params& p, LAS unsigned char* lds) {
    const int tid = threadIdx.x, wid = tid >> 6, lane = tid & 63, fr = lane & 15, fq = lane >> 4;
    const float* mod = (const float*)(p.ws + WS_MOD);
    bf16_t* H = (bf16_t*)(p.ws + WS_H); bf16_t* HL = (bf16_t*)(p.ws + WS_HLO);
    int* cnt = (int*)(p.ws + WS_CNT); int* ltok = (int*)(p.ws + WS_LTOK); float* lw = (float*)(p.ws + WS_LW);
    LAS float* lg = (LAS float*)lds;
    for (int blk = blockIdx.x; blk < NTOK / 32; blk += gridDim.x) {
        const int t0 = blk * 32;
        for (int rr = 0; rr < 4; ++rr) { const int t = t0 + wid * 4 + rr, b = t >> 11; float hv[32];
            norm_row(p.out + (size_t)t * DM, p.in[I_GFFN], mod + b * 12288 + 6144, mod + b * 12288 + 8192, H + (size_t)t * DM, lane, hv);
#pragma unroll
            for (int i = 0; i < 8; ++i) { float lo[4];
#pragma unroll
                for (int j = 0; j < 4; j += 2) { const unsigned w = cvt_pk_bf16(hv[i * 4 + j], hv[i * 4 + j + 1]); lo[j] = hv[i * 4 + j] - bf_lo(w); lo[j + 1] = hv[i * 4 + j + 1] - bf_hi(w); }
                u32x2 w2; w2.x = cvt_pk_bf16(lo[0], lo[1]); w2.y = cvt_pk_bf16(lo[2], lo[3]); *(u32x2*)(HL + (size_t)t * DM + i * 256 + lane * 4) = w2; } }
        asm volatile("s_waitcnt vmcnt(0)" ::: "memory");
        __syncthreads();
        if (wid < 2) {
            const bf16_t* Ah = H + (size_t)(t0 + wid * 16 + fr) * DM + fq * 8; const bf16_t* Al = HL + (size_t)(t0 + wid * 16 + fr) * DM + fq * 8;
            const bf16_t* Wh = (const bf16_t*)(p.ws + WS_WRH) + (size_t)fr * DM + fq * 8; const bf16_t* Wl = (const bf16_t*)(p.ws + WS_WRL) + (size_t)fr * DM + fq * 8;
            f32x4 acc[5];
#pragma unroll
            for (int nb = 0; nb < 5; ++nb) acc[nb] = (f32x4){0.f, 0.f, 0.f, 0.f};
#pragma unroll 2
            for (int ks = 0; ks < 64; ++ks) {
                const bf16x8 ah = *(const bf16x8*)(Ah + ks * 32), al = *(const bf16x8*)(Al + ks * 32);
#pragma unroll
                for (int nb = 0; nb < 5; ++nb) { const bf16x8 wh = *(const bf16x8*)(Wh + (size_t)nb * 16 * DM + ks * 32), wl = *(const bf16x8*)(Wl + (size_t)nb * 16 * DM + ks * 32);
                    acc[nb] = __builtin_amdgcn_mfma_f32_16x16x32_bf16(wh, ah, acc[nb], 0, 0, 0);
                    acc[nb] = __builtin_amdgcn_mfma_f32_16x16x32_bf16(wl, ah, acc[nb], 0, 0, 0);
                    acc[nb] = __builtin_amdgcn_mfma_f32_16x16x32_bf16(wh, al, acc[nb], 0, 0, 0); }
            }
#pragma unroll
            for (int nb = 0; nb < 5; ++nb) *(LAS f32x4*)(lg + (wid * 16 + fr) * 80 + nb * 16 + fq * 4) = acc[nb];
        }
        __syncthreads();
        if (tid < 32) {
            const int t = t0 + tid; const LAS float* L = lg + tid * 80;
            float gl[8]; int gi = 0; float gm = -INFINITY;
#pragma unroll
            for (int g = 0; g < 8; ++g) { gl[g] = L[g] + p.in[I_BRG][g]; if (gl[g] > gm) { gm = gl[g]; gi = g; } }
            float se = 0.f;
#pragma unroll
            for (int g = 0; g < 8; ++g) se += __expf(gl[g] - gm);
            const float gwt = 1.0f / se;
            float v1 = -INFINITY, v2 = -INFINITY; int i1 = 0, i2 = 0;
            for (int e = 0; e < 8; ++e) { const float v = L[8 + gi * 8 + e] + p.in[I_BRE][gi * 8 + e];
                if (v > v1) { v2 = v1; i2 = i1; v1 = v; i1 = e; } else if (v > v2) { v2 = v; i2 = e; } }
            const float e2 = __expf(v2 - v1); const float p1 = gwt / (1.0f + e2), p2 = gwt * e2 / (1.0f + e2);
            const int ea = gi * 8 + i1, eb = gi * 8 + i2;
            const int pa = atomicAdd(cnt + ea, 1); ltok[ea * LCAP + pa] = t; lw[ea * LCAP + pa] = p1;
            const int pb = atomicAdd(cnt + eb, 1); ltok[eb * LCAP + pb] = t; lw[eb * LCAP + pb] = p2;
        }
        __syncthreads();
    }
}

__device__ __forceinline__ void moe_table(const Params& p, LAS unsigned char* lds) {
    LAS int* pre = (LAS int*)(lds + LDS_TAB);
    if (threadIdx.x == 0) { const int* cnt = (const int*)(p.ws + WS_CNT); int s = 0; for (int e = 0; e < 64; ++e) { const int ce = cnt[e]; pre[e] = s; pre[80 + e] = ce; s += (ce + 255) >> 8; } pre[64] = s; }
    __syncthreads();
}
__device__ void ph9_gather(const Params& p, LAS unsigned char* lds) {
    moe_table(p, lds);
    const LAS int* pre = (const LAS int*)(lds + LDS_TAB); const LAS int* cnt = pre + 80; const int* ltok = (const int*)(p.ws + WS_LTOK);
    const int lane = threadIdx.x & 63, gw = blockIdx.x * 8 + (threadIdx.x >> 6), nw = gridDim.x * 8, nrows = pre[64] * 256;
    const bf16_t* H = (const bf16_t*)(p.ws + WS_H); bf16_t* HG = (bf16_t*)(p.ws + WS_HG);
    for (int r = gw; r < nrows; r += nw) {
        const int mt = r >> 8; int e = 0;
#pragma unroll 1
        for (int s = 32; s >= 1; s >>= 1) if (pre[e + s] <= mt) e += s;
        const int pos = (mt - pre[e]) * 256 + (r & 255);
        u32x4 v[4];
        if (pos < cnt[e]) { const int tok = ltok[e * LCAP + pos];
#pragma unroll
            for (int i = 0; i < 4; ++i) v[i] = *(const u32x4*)(H + (size_t)tok * DM + i * 512 + lane * 8); }
        else {
#pragma unroll
            for (int i = 0; i < 4; ++i) v[i] = (u32x4){0u, 0u, 0u, 0u}; }
#pragma unroll
        for (int i = 0; i < 4; ++i) *(u32x4*)(HG + (size_t)r * DM + i * 512 + lane * 8) = v[i];
    }
}

__global__ void __launch_bounds__(NTHREADS, 2) mk_fwd(Params p) {
    extern __shared__ __attribute__((aligned(16))) unsigned char shm[];
    LAS unsigned char* lds = (LAS unsigned char*)shm;
    const int lo = p.ph_lo, hi = p.ph_hi;
    if (threadIdx.x < 4) ((LAS unsigned*)(lds + LDS_BARW))[threadIdx.x] = 0u;
    __syncthreads();
    XcdBarrier bar; bar.bar = (unsigned*)(p.ws + WS_BAR); bar.x = 0; bar.st = nullptr;
    if (hi - lo > 1) bar = xcd_barrier_post((unsigned*)(p.ws + WS_BAR), (volatile LAS unsigned*)(lds + LDS_BARW));
#ifndef SKIP_MASK
#define SKIP_MASK 0
#endif
#define IN(k) (!((SKIP_MASK >> (k)) & 1) && lo <= (k) && (k) < hi)
#define SEAM(k) do { if (IN(k) && IN((k) + 1)) xcd_barrier(bar); } while (0)
    const int G = gridDim.x, bx = blockIdx.x;
    if (IN(0)) { ph0_prologue(p, lds); } SEAM(0);
    if (IN(1)) { ph1_norm(p); } SEAM(1);
    if (IN(2)) { pg8::StaticOrder S; S.init(p.ws + WS_H, p.ws + WS_WIN, NTOK, DINP, DM, G, bx); EpiProj E{p.ws, p.in[I_BGATE]};
                 pg8::gemm_phase<EpiProj, pg8::StaticOrder, false>(lds, DM, S, E); } SEAM(2);
    if (IN(3)) { ph3_prep(p, lds); } SEAM(3);
    if (IN(4)) { ph4_attn(p, lds); } SEAM(4);
    if (IN(5)) { ph5_oa(p); } SEAM(5);
    if (IN(6)) { { pg8::StaticOrder S; S.init(p.ws + WS_OA, p.ws + WS_WPA, NTOK, DM, 1024, G, bx); EpiGate1 E{(const bf16_t*)(p.ws + WS_GATES), (float*)(p.ws + WS_T1)};
                   pg8::gemm_phase<EpiGate1, pg8::StaticOrder, false>(lds, 1024, S, E); }
                 { pg8::StaticOrder S; S.init(p.ws + WS_OB, p.ws + WS_WPB, NTOK, DM, 1024, G, bx); EpiGate2 E{(const bf16_t*)(p.ws + WS_GATES), (const float*)(p.ws + WS_T1), (bf16_t*)(p.ws + WS_MERGED)};
                   pg8::gemm_phase<EpiGate2, pg8::StaticOrder, false>(lds, 1024, S, E); } } SEAM(6);
    if (IN(7)) { pg8::StaticOrder S; S.init(p.ws + WS_MERGED, p.ws + WS_WO, NTOK, DM, DM, G, bx); EpiWo E{p.in[I_X], (const float*)(p.ws + WS_MOD), p.out};
                 pg8::gemm_phase<EpiWo, pg8::StaticOrder, false>(lds, DM, S, E); } SEAM(7);
    if (IN(8)) { ph8_router(p, lds); } SEAM(8);
    if (IN(9)) { ph9_gather(p, lds); } SEAM(9);
    if (IN(10)) { moe_table(p, lds);
                 MoeOrder S{(const LAS int*)(lds + LDS_TAB), (const LAS int*)(lds + LDS_TAB) + 80, G, bx, 4, DM, (const char*)(p.ws + WS_HG), (const char*)(p.ws + WS_W13), (size_t)1024 * 2048 * 2, (const int*)(p.ws + WS_LTOK), true};
                 EpiMoeUp E{(bf16_t*)(p.ws + WS_ACT), (const float*)(p.ws + WS_LW)};
                 pg8::gemm_phase<EpiMoeUp, MoeOrder, false>(lds, DM, S, E); } SEAM(10);
    if (IN(11)) { moe_table(p, lds);
                 MoeOrder S{(const LAS int*)(lds + LDS_TAB), (const LAS int*)(lds + LDS_TAB) + 80, G, bx, 8, DEXP, (const char*)(p.ws + WS_ACT), (const char*)(p.ws + WS_W2), (size_t)2048 * 512 * 2, (const int*)(p.ws + WS_LTOK), true};
                 EpiMoeDown E{p.out, (const float*)(p.ws + WS_MOD)};
                 pg8::gemm_phase<EpiMoeDown, MoeOrder, false>(lds, DEXP, S, E); }
#undef IN
#undef SEAM
}

constexpr int NPHASES = 12;
extern "C" void kernel_launch(void* const* d_in, const int* in_sizes, int n_in, void* d_out, int out_size, void* d_ws, size_t ws_size, hipStream_t stream) {
    static int grid = 0;
    if (grid == 0) {
        if (n_in != 25 || in_sizes[0] != NTOK * DM || out_size != NTOK * DM || ws_size < WS_END) {
            fprintf(stderr, "kernel_launch: shape mismatch: n_in %d in0 %d out %d ws %zu (need %zu)\n", n_in, n_in > 0 ? in_sizes[0] : -1, out_size, ws_size, (size_t)WS_END); grid = -1; return; }
        int dev = 0, cus = 0, per_cu = 0;
        if (hipGetDevice(&dev) != hipSuccess || hipDeviceGetAttribute(&cus, hipDeviceAttributeMultiprocessorCount, dev) != hipSuccess) { fprintf(stderr, "kernel_launch: device query failed\n"); grid = -1; return; }
        if (hipFuncSetAttribute((const void*)mk_fwd, hipFuncAttributeMaxDynamicSharedMemorySize, LDS_BYTES) != hipSuccess) { fprintf(stderr, "kernel_launch: hipFuncSetAttribute failed\n"); grid = -1; return; }
        if (hipOccupancyMaxActiveBlocksPerMultiprocessor(&per_cu, (const void*)mk_fwd, NTHREADS, LDS_BYTES) != hipSuccess || per_cu < 1) { fprintf(stderr, "kernel_launch: occupancy query says %d blocks per CU\n", per_cu); }
        (void)hipGetLastError();
        grid = cus;
    }
    if (grid < 0) return;
    if (hipMemsetAsync((char*)d_ws + WS_BAR, 0, WS_ZERO_BYTES, stream) != hipSuccess) { fprintf(stderr, "kernel_launch: memset failed\n"); return; }
    Params p; memset(&p, 0, sizeof(p));
    for (int i = 0; i < 25; ++i) p.in[i] = (const float*)d_in[i];
    p.out = (float*)d_out; p.ws = (unsigned char*)d_ws;
    unsigned char* ws = (unsigned char*)d_ws;
    auto job = [&](int j, const float* src, size_t dst_off, int K, int N, int ldd, int map, int nbatch, long sbatch, long dbatch) {
        TJob& J = p.jobs[j]; J.src = src; J.dst = (bf16_t*)(ws + dst_off); J.K = K; J.N = N; J.ldd = ldd; J.map = map; J.ntk = K / 64; J.ntn = (N + 63) / 64; J.nbatch = nbatch; J.sbatch = sbatch; J.dbatch = dbatch; };
    job(0, p.in[I_WIN], WS_WIN, 2048, DIN, 2048, 1, 1, 0, 0);
    job(1, p.in[I_WPA], WS_WPA, 1024, 2048, 1024, 0, 1, 0, 0);
    job(2, p.in[I_WPB], WS_WPB, 1024, 2048, 1024, 0, 1, 0, 0);
    job(3, p.in[I_WO], WS_WO, 2048, 2048, 2048, 0, 1, 0, 0);
    job(4, p.in[I_WUK], WS_WUK, 128, 256, 128, 0, 8, 128L * 256, 256L * 128);
    job(5, p.in[I_WUV], WS_WUV, 256, 128, 256, 0, 8, 256L * 128, 128L * 256);
    job(6, p.in[I_W1], WS_W13, 2048, 512, 2048, 2, 64, 2048L * 512, 1024L * 2048);
    job(7, p.in[I_W3], WS_W13, 2048, 512, 2048, 3, 64, 2048L * 512, 1024L * 2048);
    job(8, p.in[I_W2], WS_W2, 512, 2048, 512, 0, 64, 512L * 2048, 2048L * 512);
    int t0 = 0; for (int j = 0; j < NJOBS; ++j) { p.jobs[j].tile0 = t0; t0 += p.jobs[j].ntk * p.jobs[j].ntn * p.jobs[j].nbatch; }
    p.ntiles_total = t0;
#if MK_LAUNCHES == 1
    p.ph_lo = 0; p.ph_hi = NPHASES;
    hipLaunchKernelGGL(mk_fwd, dim3(grid), dim3(NTHREADS), LDS_BYTES, stream, p);
#else
    for (int k = 0; k < NPHASES; ++k) { p.ph_lo = k; p.ph_hi = k + 1; hipLaunchKernelGGL(mk_fwd, dim3(grid), dim3(NTHREADS), LDS_BYTES, stream, p); }
#endif
    const hipError_t le = hipPeekAtLastError();
    if (le != hipSuccess) fprintf(stderr, "kernel_launch: launch failed: %s\n", hipGetErrorName(le));
}

#ifdef DIAG_PHASES
template <int PH> __global__ void __launch_bounds__(NTHREADS, 2) k_ph(Params p) {
    extern __shared__ __attribute__((aligned(16))) unsigned char shm[];
    LAS unsigned char* lds = (LAS unsigned char*)shm; const int G = gridDim.x, bx = blockIdx.x;
    if constexpr (PH == 0) ph0_prologue(p, lds);
    if constexpr (PH == 1) ph1_norm(p);
    if constexpr (PH == 2) { pg8::StaticOrder S; S.init(p.ws + WS_H, p.ws + WS_WIN, NTOK, DINP, DM, G, bx); EpiProj E{p.ws, p.in[I_BGATE]}; pg8::gemm_phase<EpiProj, pg8::StaticOrder, false>(lds, DM, S, E); }
    if constexpr (PH == 3) ph3_prep(p, lds);
    if constexpr (PH == 4) ph4_attn(p, lds);
    if constexpr (PH == 5) ph5_oa(p);
    if constexpr (PH == 6) { pg8::StaticOrder S; S.init(p.ws + WS_OA, p.ws + WS_WPA, NTOK, DM, 1024, G, bx); EpiGate1 E{(const bf16_t*)(p.ws + WS_GATES), (float*)(p.ws + WS_T1)}; pg8::gemm_phase<EpiGate1, pg8::StaticOrder, false>(lds, 1024, S, E); }
    if constexpr (PH == 7) { pg8::StaticOrder S; S.init(p.ws + WS_MERGED, p.ws + WS_WO, NTOK, DM, DM, G, bx); EpiWo E{p.in[I_X], (const float*)(p.ws + WS_MOD), p.out}; pg8::gemm_phase<EpiWo, pg8::StaticOrder, false>(lds, DM, S, E); }
    if constexpr (PH == 8) ph8_router(p, lds);
    if constexpr (PH == 9) ph9_gather(p, lds);
    if constexpr (PH == 10) { moe_table(p, lds); MoeOrder S{(const LAS int*)(lds + LDS_TAB), (const LAS int*)(lds + LDS_TAB) + 80, G, bx, 4, DM, (const char*)(p.ws + WS_HG), (const char*)(p.ws + WS_W13), (size_t)1024 * 2048 * 2, (const int*)(p.ws + WS_LTOK), true};
                 EpiMoeUp E{(bf16_t*)(p.ws + WS_ACT), (const float*)(p.ws + WS_LW)}; pg8::gemm_phase<EpiMoeUp, MoeOrder, false>(lds, DM, S, E); }
    if constexpr (PH == 11) { moe_table(p, lds); MoeOrder S{(const LAS int*)(lds + LDS_TAB), (const LAS int*)(lds + LDS_TAB) + 80, G, bx, 8, DEXP, (const char*)(p.ws + WS_ACT), (const char*)(p.ws + WS_W2), (size_t)2048 * 512 * 2, (const int*)(p.ws + WS_LTOK), true};
                 EpiMoeDown E{p.out, (const float*)(p.ws + WS_MOD)}; pg8::gemm_phase<EpiMoeDown, MoeOrder, false>(lds, DEXP, S, E); }
    if constexpr (PH == 12) { const int r = bx; dsa_item(p, lds, r & 3, r >> 2); }
    if constexpr (PH == 13) { const int r = bx; fox_item(p, lds, r & 3, (r >> 2) & 7, r >> 5); }
    if constexpr (PH == 14) { idx_item(p, lds, bx & 3, (bx >> 2) & 31, bx >> 7); }
}
template __global__ void k_ph<0>(Params); template __global__ void k_ph<1>(Params); template __global__ void k_ph<2>(Params); template __global__ void k_ph<3>(Params);
template __global__ void k_ph<4>(Params); template __global__ void k_ph<5>(Params); template __global__ void k_ph<6>(Params); template __global__ void k_ph<7>(Params);
template __global__ void k_ph<8>(Params); template __global__ void k_ph<9>(Params); template __global__ void k_ph<10>(Params); template __global__ void k_ph<11>(Params);
template __global__ void k_ph<12>(Params); template __global__ void k_ph<13>(Params); template __global__ void k_ph<14>(Params);
#endif
```

```cpp
#include <hip/hip_runtime.h>
#include <cstdio>
#include <cstdint>
#include <cstring>

#ifndef MK_LAUNCHES
#define MK_LAUNCHES 1
#endif

#define LAS __attribute__((address_space(3)))
typedef unsigned short bf16_t;
typedef short bf16x8 __attribute__((ext_vector_type(8)));
typedef short s16x4 __attribute__((ext_vector_type(4)));
typedef float f32x4 __attribute__((ext_vector_type(4)));
typedef float f32x16 __attribute__((ext_vector_type(16)));
typedef unsigned u32x4 __attribute__((ext_vector_type(4)));
typedef unsigned u32x2 __attribute__((ext_vector_type(2)));

constexpr int DM = 2048, NBATCH = 4, SEQ = 2048, NTOK = NBATCH * SEQ;
constexpr int DIN = 9560, DINP = 9728;
constexpr int NEXP = 64, DEXP = 512, LCAP = 8192;
constexpr float RMS_EPS = 1e-6f;
constexpr float LOG2E = 1.4426950408889634f;
constexpr int NTHREADS = 512;
constexpr int LDS_BYTES = 163840 - 1024;
constexpr int LDS_BARW = LDS_BYTES - 16;
constexpr int LDS_TAB = 131072;

constexpr size_t al256(size_t x) { return (x + 255) / 256 * 256; }
constexpr size_t WS_BAR = 0;
constexpr size_t WS_CNT = 16384;
constexpr size_t WS_ZERO_BYTES = 16384 + 4096;
constexpr size_t WS_MOD = WS_ZERO_BYTES;
constexpr size_t WS_H = al256(WS_MOD + (size_t)4 * 12288 * 4);
constexpr size_t WS_WIN = al256(WS_H + (size_t)NTOK * DM * 2);
constexpr size_t WS_WPA = al256(WS_WIN + (size_t)DINP * DM * 2);
constexpr size_t WS_WPB = al256(WS_WPA + (size_t)2048 * 1024 * 2);
constexpr size_t WS_WO = al256(WS_WPB + (size_t)2048 * 1024 * 2);
constexpr size_t WS_WUK = al256(WS_WO + (size_t)2048 * 2048 * 2);
constexpr size_t WS_WUV = al256(WS_WUK + (size_t)8 * 256 * 128 * 2);
constexpr size_t WS_W13 = al256(WS_WUV + (size_t)8 * 128 * 256 * 2);
constexpr size_t WS_W2 = al256(WS_W13 + (size_t)64 * 1024 * 2048 * 2);
constexpr size_t WS_QA = al256(WS_W2 + (size_t)64 * 2048 * 512 * 2);
constexpr size_t WS_CKV = al256(WS_QA + (size_t)NTOK * 1024 * 2);
constexpr size_t WS_KV = al256(WS_CKV + (size_t)NTOK * 256 * 4);
constexpr size_t WS_QIDX = al256(WS_KV + (size_t)NTOK * 256 * 2);
constexpr size_t WS_MISC = al256(WS_QIDX + (size_t)NTOK * 1024 * 2);
constexpr size_t WS_QB = al256(WS_MISC + (size_t)NTOK * 256 * 4);
constexpr size_t WS_KB = al256(WS_QB + (size_t)NTOK * 1024 * 2);
constexpr size_t WS_VB = al256(WS_KB + (size_t)NTOK * 1024 * 2);
constexpr size_t WS_GATES = al256(WS_VB + (size_t)NTOK * 1024 * 2);
constexpr size_t WS_QLAT = al256(WS_GATES + (size_t)NTOK * 4096 * 2);
constexpr size_t WS_MASK = al256(WS_QLAT + (size_t)NTOK * 2048 * 2);
constexpr size_t WS_CUM = al256(WS_MASK + (size_t)NTOK * 256);
constexpr size_t WS_OLAT = al256(WS_CUM + (size_t)4 * 8 * 2048 * 4);
constexpr size_t WS_OA = al256(WS_OLAT + (size_t)NTOK * 2048 * 2);
constexpr size_t WS_OB = al256(WS_OA + (size_t)NTOK * 1024 * 2);
constexpr size_t WS_T1 = al256(WS_OB + (size_t)NTOK * 1024 * 2);
constexpr size_t WS_MERGED = al256(WS_T1 + (size_t)NTOK * 2048 * 4);
constexpr size_t WS_LTOK = al256(WS_MERGED + (size_t)NTOK * 2048 * 2);
constexpr size_t WS_LW = al256(WS_LTOK + (size_t)NEXP * LCAP * 4);
constexpr size_t WS_ACT = al256(WS_LW + (size_t)NEXP * LCAP * 4);
constexpr size_t WS_HLO = al256(WS_ACT + (size_t)32768 * 512 * 2);
constexpr size_t WS_WRH = al256(WS_HLO + (size_t)NTOK * DM * 2);
constexpr size_t WS_WRL = al256(WS_WRH + (size_t)80 * DM * 2);
constexpr size_t WS_END = al256(WS_WRL + (size_t)80 * DM * 2);
constexpr size_t WS_HG = WS_QA;
static_assert(WS_HG + (size_t)32768 * DM * 2 <= WS_QLAT, "hg alias must fit in the dead region");

struct TJob { const float* src; bf16_t* dst; int K, N, ldd, map, ntk, ntn, nbatch, tile0; long sbatch, dbatch; };
constexpr int NJOBS = 6;
struct Params {
    const float* in[25];
    float* out;
    unsigned char* ws;
    TJob jobs[NJOBS];
    int ntiles_total;
    int ph_lo, ph_hi;
};
enum { I_X = 0, I_C, I_WADA, I_BADA, I_GMIX, I_WIN, I_BGATE, I_BFORGET, I_WUK, I_WUV, I_GQA, I_GKV, I_GQB, I_GKB, I_WPA, I_WPB, I_WO, I_GFFN, I_WRG, I_BRG, I_WRE, I_BRE, I_W1, I_W3, I_W2 };

__device__ __forceinline__ unsigned cvt_pk_bf16(float lo, float hi) { unsigned r; asm volatile("v_cvt_pk_bf16_f32 %0, %1, %2" : "=v"(r) : "v"(lo), "v"(hi)); return r; }
__device__ __forceinline__ float bf_lo(unsigned w) { return __uint_as_float(w << 16); }
__device__ __forceinline__ float bf_hi(unsigned w) { return __uint_as_float(w & 0xffff0000u); }
__device__ __forceinline__ float wave_sum(float v) {
#pragma unroll
    for (int o = 32; o >= 1; o >>= 1) v += __shfl_xor(v, o);
    return v;
}
__device__ __forceinline__ float sigmoidf_(float x) { return 1.0f / (1.0f + __expf(-x)); }
__device__ __forceinline__ int crow(int r, int hi) { return (r & 3) + 8 * (r >> 2) + 4 * hi; }
#define SBAR() __builtin_amdgcn_sched_barrier(0)

#define XB_TMO      128
#define XB_XCNT(j)  (256  + 64 * (j))
#define XB_XSUB(j)  (1280 + 64 * (j))
#define XB_XGEN(j)  (2304 + 64 * (j))
#define XB_TOP      3328
#define XB_TOPGEN   3392
#define XCD_BAR_WORDS 3456
#define XB_SPIN_CAP (1u << 20)
__device__ __forceinline__ unsigned xb_ld(unsigned* p)              { return __hip_atomic_load(p, __ATOMIC_RELAXED, __HIP_MEMORY_SCOPE_AGENT); }
__device__ __forceinline__ unsigned xb_add(unsigned* p, unsigned v) { return __hip_atomic_fetch_add(p, v, __ATOMIC_RELAXED, __HIP_MEMORY_SCOPE_AGENT); }
__device__ __forceinline__ unsigned xb_xcc_id() { return (unsigned)__builtin_amdgcn_s_getreg((3 << 11) | 20) & 0xFu; }
#define XB_SPIN(cond, bar) do { unsigned _sp = 0; while (cond) { __builtin_amdgcn_s_sleep(1); \
    if ((++_sp & 255u) == 0u) { if (xb_ld(&(bar)[XB_TMO])) break; if (_sp > XB_SPIN_CAP) { atomicAdd(&(bar)[XB_TMO], 1u); break; } } } } while (0)
struct XcdBarrier { unsigned* bar; unsigned x; volatile LAS unsigned* st; };
__device__ __forceinline__ XcdBarrier xcd_barrier_post(unsigned* bar, volatile LAS unsigned* st) {
    XcdBarrier b; b.bar = bar; b.x = xb_xcc_id(); b.st = st;
    if (threadIdx.x == 0) (void)xb_add(&bar[XB_XCNT(b.x)], 1u);
    return b;
}
__device__ __forceinline__ void xcd_barrier_complete(unsigned* bar, unsigned x, unsigned& nloc, unsigned& nx) {
    const unsigned G = gridDim.x * gridDim.y * gridDim.z;
    unsigned sum, cnt, mine, sp = 0u;
    for (;;) {
        sum = 0u; cnt = 0u; mine = 0u;
#pragma unroll
        for (unsigned j = 0; j < 16; ++j) { const unsigned c = xb_ld(&bar[XB_XCNT(j)]); sum += c; cnt += (c > 0u) ? 1u : 0u; mine = (j == x) ? c : mine; }
        if (sum == G) break;
        __builtin_amdgcn_s_sleep(1);
        if ((++sp & 255u) == 0u) { if (xb_ld(&bar[XB_TMO])) break; if (sp > XB_SPIN_CAP) { atomicAdd(&bar[XB_TMO], 1u); break; } }
    }
    nloc = mine > 0u ? mine : 1u; nx = cnt > 0u ? cnt : 1u;
}
__device__ __forceinline__ void xcd_barrier(const XcdBarrier& b) {
    asm volatile("s_waitcnt vmcnt(0)" ::: "memory");
    __syncthreads();
    if (threadIdx.x == 0) {
        unsigned* bar = b.bar;
        __builtin_amdgcn_s_waitcnt(0);
        unsigned nloc = b.st[0], nx = b.st[1];
        if (nloc == 0u) { xcd_barrier_complete(bar, b.x, nloc, nx); b.st[0] = nloc; b.st[1] = nx; }
        const unsigned old = xb_add(&bar[XB_XSUB(b.x)], 1u);
        const unsigned gen = old / nloc;
        if (old + 1u == (gen + 1u) * nloc) {
            __builtin_amdgcn_fence(__ATOMIC_RELEASE, "agent");
            asm volatile("s_waitcnt vmcnt(0)" ::: "memory");
            const unsigned og = xb_add(&bar[XB_TOP], 1u);
            const unsigned tg = og / nx;
            if (og + 1u == (tg + 1u) * nx) xb_add(&bar[XB_TOPGEN], 1u);
            else XB_SPIN(xb_ld(&bar[XB_TOPGEN]) == tg, bar);
            __builtin_amdgcn_fence(__ATOMIC_ACQUIRE, "agent");
            xb_add(&bar[XB_XGEN(b.x)], 1u);
            asm volatile("s_waitcnt vmcnt(0)" ::: "memory");
        } else {
            XB_SPIN(xb_ld(&bar[XB_XGEN(b.x)]) == gen, bar);
            __builtin_amdgcn_fence(__ATOMIC_ACQUIRE, "agent");
            asm volatile("s_waitcnt vmcnt(0)" ::: "memory");
        }
    }
    __syncthreads();
}

namespace pg8 {
constexpr int BM = 256, BK = 64, HALF = 128, HTB = HALF * BK * 2, STAGE_BYTES = 8 * HTB, NXCD = 8, WGM = 8;
__host__ __device__ __forceinline__ int lds_byte(int r, int c) { const int st = (r >> 4) * 2 + (c >> 5), rr = r & 15, cc = c & 31, ob = rr * 64 + cc * 2; return st * 1024 + (ob ^ (((ob >> 9) & 1) << 5)); }
__host__ __device__ __forceinline__ void stage_rc(int b, int& R, int& C) { const int st = b / 1024, sb = b % 1024, swz = sb ^ (((sb >> 9) & 1) << 5); R = (st >> 1) * 16 + swz / 64; C = (st & 1) * 32 + (swz % 64) / 2; }
__host__ __device__ __forceinline__ int perm32(int rho) { const int n = rho >> 4, i = rho & 15; return 8 * (i >> 2) + 4 * n + (i & 3); }

struct Unit { int pm, pn; const char* a; const char* b; const int* gi; int nvalid; int aux; };

struct StaticOrder {
    int nM, nN, nwg, G, c, K; const char* A; const char* Bt;
    __device__ void init(const void* A_, const void* Bt_, int M, int N, int K_, int G_, int c_) { A = (const char*)A_; Bt = (const char*)Bt_; K = K_; nM = M / BM; nN = N / BM; nwg = nM * nN; G = G_; c = c_; }
    __device__ bool next(int i, Unit& u) const {
        const long L = (long)i * G + c; if (L >= nwg) return false;
        int wgid = (int)L; { const int q = nwg / NXCD, r = nwg % NXCD, xcd = wgid % NXCD, off = wgid / NXCD; wgid = (xcd < r ? xcd * (q + 1) : r * (q + 1) + (xcd - r) * q) + off; }
        const int nig = WGM * nN, gid = wgid / nig, fm = gid * WGM, gsz = (nM - fm) < WGM ? (nM - fm) : WGM;
        u.pm = fm + ((wgid % nig) % gsz); u.pn = (wgid % nig) / gsz;
        u.a = A + (size_t)u.pm * BM * K * 2; u.b = Bt + (size_t)u.pn * BM * K * 2; u.gi = nullptr; u.nvalid = BM; u.aux = 0; return true;
    }
};

template <class Epi, class Sched, bool GATHER>
__device__ __forceinline__ void gemm_phase(LAS unsigned char* lds, const int K, const Sched& S, const Epi& E) {
    const int tid = threadIdx.x, wid = __builtin_amdgcn_readfirstlane(tid >> 6), lane = tid & 63, wr = wid >> 2, wc = wid & 3, fr = lane & 15, fq = lane >> 4;
    const int nt = K / BK;
    unsigned voffA[2], voffB[2]; int RA[2], CA[2];
#pragma unroll
    for (int i = 0; i < 2; ++i) { int R, C; stage_rc(tid * 16 + i * 8192, R, C); const int Rb = ((R & ~31) + perm32(R & 31));
        RA[i] = R; CA[i] = C; voffA[i] = (unsigned)(R * K + C) * 2u; voffB[i] = (unsigned)(Rb * K + C) * 2u; }
    const size_t kstep = (size_t)(BK * 2);
    const size_t hstep = (size_t)HALF * K * 2;
    const unsigned ldsw = (unsigned)wid * 1024u;
    const int aoff = lds_byte(wr * 64 + fr, fq * 8), boff = lds_byte(wc * 32 + fr, fq * 8);
    unsigned gA[2][2], gN[2][2];
#define PG8_SA(b, h) (((b) * 2 + (h)) * HTB)
#define PG8_SB(b, h) ((4 + (b) * 2 + (h)) * HTB)
#define PG8_STAGE(bufoff, gbase, voff) do { _Pragma("unroll") for (int _i = 0; _i < 2; ++_i) \
        __builtin_amdgcn_global_load_lds((const unsigned*)((const char*)(gbase) + (voff)[_i]), (LAS unsigned*)(lds + (bufoff) + ldsw + _i * 8192), 16, 0, 0); } while (0)
#define PG8_STAGE_A(bufoff, gp, h, NX) do { if constexpr (GATHER) { if (NX) PG8_STAGE(bufoff, gp, gN[h]); else PG8_STAGE(bufoff, gp, gA[h]); } else PG8_STAGE(bufoff, (gp) + (h) * hstep, voffA); } while (0)
#define PG8_LDA(dst, b, h) do { _Pragma("unroll") for (int m = 0; m < 4; ++m) _Pragma("unroll") for (int k = 0; k < 2; ++k) dst[m][k] = *(const LAS bf16x8*)(lds + PG8_SA(b, h) + aoff + m * 2048 + k * 1024); } while (0)
#define PG8_LDB(dst, b, h) do { _Pragma("unroll") for (int n = 0; n < 2; ++n) _Pragma("unroll") for (int k = 0; k < 2; ++k) dst[n][k] = *(const LAS bf16x8*)(lds + PG8_SB(b, h) + boff + n * 2048 + k * 1024); } while (0)
#define PG8_MMA(ai, bj, At, Bt) do { __builtin_amdgcn_s_setprio(1); _Pragma("unroll") for (int m = 0; m < 4; ++m) _Pragma("unroll") for (int n = 0; n < 2; ++n) _Pragma("unroll") for (int k = 0; k < 2; ++k) \
        acc[ai][bj][m][n] = __builtin_amdgcn_mfma_f32_16x16x32_bf16(Bt[n][k], At[m][k], acc[ai][bj][m][n], 0, 0, 0); __builtin_amdgcn_s_setprio(0); } while (0)
#define PG8_WAIT_V(n) asm volatile("s_waitcnt vmcnt(" #n ")" ::: "memory")
#define PG8_WAIT_L(n) asm volatile("s_waitcnt lgkmcnt(" #n ")" ::: "memory")
#define PG8_BAR __builtin_amdgcn_s_barrier()
#define PG8_SCHED __builtin_amdgcn_sched_barrier(0)
#define PG8_GIDX(dst, u) do { if constexpr (GATHER) { _Pragma("unroll") for (int h = 0; h < 2; ++h) _Pragma("unroll") for (int i = 0; i < 2; ++i) { \
        const int rr = h * HALF + RA[i]; const int tok = rr < (u).nvalid ? (u).gi[rr] : 0; dst[h][i] = (unsigned)(tok * K + CA[i]) * 2u; } } } while (0)
    Unit cur, nxt; int ui = 0;
    if (!S.next(0, cur)) return;
    f32x4 acc[2][2][4][2];
#pragma unroll
    for (int a = 0; a < 2; ++a)
#pragma unroll
        for (int b = 0; b < 2; ++b)
#pragma unroll
            for (int m = 0; m < 4; ++m)
#pragma unroll
                for (int n = 0; n < 2; ++n) acc[a][b][m][n] = (f32x4){0.f, 0.f, 0.f, 0.f};
    bf16x8 At[4][2], B0[2][2], B1[2][2];
    const char* cA = cur.a; const char* cB = cur.b;
    PG8_GIDX(gA, cur);
    PG8_STAGE(PG8_SB(0, 0), cB, voffB); PG8_STAGE_A(PG8_SA(0, 0), cA, 0, false); PG8_STAGE(PG8_SB(0, 1), cB + hstep, voffB); PG8_STAGE_A(PG8_SA(0, 1), cA, 1, false);
    if (wr == 1) PG8_BAR;
    PG8_WAIT_V(4); PG8_BAR;
    PG8_STAGE(PG8_SB(1, 0), cB + kstep, voffB); PG8_STAGE_A(PG8_SA(1, 0), cA + kstep, 0, false); PG8_STAGE(PG8_SB(1, 1), cB + hstep + kstep, voffB);
    PG8_WAIT_V(6); PG8_BAR;
    for (;;) {
        const bool has_next = S.next(ui + 1, nxt);
        const char* nA = has_next ? nxt.a : cA; const char* nB = has_next ? nxt.b : cB;
        if constexpr (GATHER) { if (has_next) { PG8_GIDX(gN, nxt); } else {
#pragma unroll
            for (int h = 0; h < 2; ++h)
#pragma unroll
                for (int i = 0; i < 2; ++i) gN[h][i] = gA[h][i]; } }
        for (int t = 0; t < nt; t += 2) {
            const bool last = (t == nt - 2);
            const char* a1 = cA + (size_t)(t + 1) * kstep;
            const char* a2 = last ? nA : cA + (size_t)(t + 2) * kstep; const char* b2 = last ? nB : cB + (size_t)(t + 2) * kstep;
            const char* a3 = a2 + kstep; const char* b3 = b2 + kstep;
            PG8_LDB(B0, 0, 0); PG8_SCHED; PG8_LDA(At, 0, 0); PG8_STAGE_A(PG8_SA(1, 1), a1, 1, false);
            PG8_WAIT_L(8); PG8_BAR; PG8_WAIT_L(0); PG8_MMA(0, 0, At, B0); PG8_BAR; PG8_SCHED;
            PG8_LDB(B1, 0, 1); PG8_STAGE(PG8_SB(0, 0), b2, voffB);
            PG8_BAR; PG8_WAIT_L(0); PG8_MMA(0, 1, At, B1); PG8_BAR;
            PG8_LDA(At, 0, 1); PG8_STAGE_A(PG8_SA(0, 0), a2, 0, last);
            PG8_BAR; PG8_WAIT_L(0); PG8_MMA(1, 0, At, B0); PG8_BAR; PG8_SCHED;
            PG8_STAGE(PG8_SB(0, 1), b2 + hstep, voffB);
            PG8_WAIT_V(6); PG8_BAR; PG8_MMA(1, 1, At, B1); PG8_BAR;
            PG8_LDB(B0, 1, 0); PG8_SCHED; PG8_LDA(At, 1, 0); PG8_STAGE_A(PG8_SA(0, 1), a2, 1, last);
            PG8_WAIT_L(8); PG8_BAR; PG8_WAIT_L(0); PG8_MMA(0, 0, At, B0); PG8_BAR; PG8_SCHED;
            PG8_LDB(B1, 1, 1); PG8_STAGE(PG8_SB(1, 0), b3, voffB);
            PG8_BAR; PG8_WAIT_L(0); PG8_MMA(0, 1, At, B1); PG8_BAR;
            PG8_LDA(At, 1, 1); PG8_STAGE_A(PG8_SA(1, 0), a3, 0, last);
            PG8_BAR; PG8_WAIT_L(0); PG8_MMA(1, 0, At, B0); PG8_BAR; PG8_SCHED;
            PG8_STAGE(PG8_SB(1, 1), b3 + hstep, voffB);
            PG8_WAIT_V(6); PG8_BAR; PG8_MMA(1, 1, At, B1); PG8_BAR;
        }
        E(acc, cur, wr, wc, fr, fq);
        if (!has_next) break;
#pragma unroll
        for (int a = 0; a < 2; ++a)
#pragma unroll
            for (int b = 0; b < 2; ++b)
#pragma unroll
                for (int m = 0; m < 4; ++m)
#pragma unroll
                    for (int n = 0; n < 2; ++n) acc[a][b][m][n] = (f32x4){0.f, 0.f, 0.f, 0.f};
        cur = nxt; cA = nA; cB = nB; ++ui;
        if constexpr (GATHER) {
#pragma unroll
            for (int h = 0; h < 2; ++h)
#pragma unroll
                for (int i = 0; i < 2; ++i) gA[h][i] = gN[h][i]; }
    }
    PG8_WAIT_V(0);
    if (wr == 0) PG8_BAR;
    PG8_BAR;
#undef PG8_SA
#undef PG8_SB
#undef PG8_STAGE
#undef PG8_STAGE_A
#undef PG8_LDA
#undef PG8_LDB
#undef PG8_MMA
#undef PG8_WAIT_V
#undef PG8_WAIT_L
#undef PG8_BAR
#undef PG8_SCHED
#undef PG8_GIDX
}
}
using pg8::Unit;

#define EPI_LOOP(...) { int fr_ = fr, fq_ = fq; asm volatile("" : "+v"(fr_), "+v"(fq_)); _Pragma("unroll") for (int ai = 0; ai < 2; ++ai) _Pragma("unroll") for (int m = 0; m < 4; ++m) _Pragma("unroll") for (int bj = 0; bj < 2; ++bj) { \
        const int trow = ai * 128 + wr * 64 + m * 16 + fr_; const int tcol = bj * 128 + wc * 32 + fq_ * 8; const f32x4 v0 = acc[ai][bj][m][0], v1 = acc[ai][bj][m][1]; __VA_ARGS__ } }

__device__ __forceinline__ u32x4 pack8(const f32x4 a, const f32x4 b) { u32x4 w; w.x = cvt_pk_bf16(a[0], a[1]); w.y = cvt_pk_bf16(a[2], a[3]); w.z = cvt_pk_bf16(b[0], b[1]); w.w = cvt_pk_bf16(b[2], b[3]); return w; }

struct EpiProj {
    unsigned char* ws; const float* b_gate;
    __device__ __forceinline__ void operator()(const f32x4 (&acc)[2][2][4][2], const Unit& u, int wr, int wc, int fr, int fq) const {
        const int pn = u.pn; const size_t row0 = (size_t)u.pm * 256;
        if (pn == 4 || pn == 9) {
            float* dst = (float*)(ws + (pn == 4 ? WS_CKV : WS_MISC));
            EPI_LOOP({ float* p = dst + (row0 + trow) * 256 + tcol; *(f32x4*)p = v0; *(f32x4*)(p + 4) = v1; })
        } else if (pn < 22) {
            bf16_t* dst; int ct;
            if (pn < 4) { dst = (bf16_t*)(ws + WS_QA); ct = pn; } else if (pn < 9) { dst = (bf16_t*)(ws + WS_QIDX); ct = pn - 5; }
            else if (pn < 14) { dst = (bf16_t*)(ws + WS_QB); ct = pn - 10; } else if (pn < 18) { dst = (bf16_t*)(ws + WS_KB); ct = pn - 14; } else { dst = (bf16_t*)(ws + WS_VB); ct = pn - 18; }
            EPI_LOOP({ *(u32x4*)(dst + (row0 + trow) * 1024 + ct * 256 + tcol) = pack8(v0, v1); })
        } else {
            bf16_t* dst = (bf16_t*)(ws + WS_GATES); const int ct = pn - 22;
            EPI_LOOP({ const int col = ct * 256 + tcol; const f32x4 b0 = *(const f32x4*)(b_gate + col), b1 = *(const f32x4*)(b_gate + col + 4); f32x4 s0, s1;
                _Pragma("unroll") for (int j = 0; j < 4; ++j) { s0[j] = sigmoidf_(v0[j] + b0[j]); s1[j] = sigmoidf_(v1[j] + b1[j]); }
                *(u32x4*)(dst + (row0 + trow) * 4096 + col) = pack8(s0, s1); })
        }
    }
};
struct EpiGate1 {
    const bf16_t* gates; float* T1;
    __device__ __forceinline__ void operator()(const f32x4 (&acc)[2][2][4][2], const Unit& u, int wr, int wc, int fr, int fq) const {
        EPI_LOOP({ const size_t row = (size_t)u.pm * 256 + trow; const int col = u.pn * 256 + tcol; const u32x4 g = *(const u32x4*)(gates + row * 4096 + col);
            f32x4 o0 = {v0[0] * bf_lo(g.x), v0[1] * bf_hi(g.x), v0[2] * bf_lo(g.y), v0[3] * bf_hi(g.y)}; f32x4 o1 = {v1[0] * bf_lo(g.z), v1[1] * bf_hi(g.z), v1[2] * bf_lo(g.w), v1[3] * bf_hi(g.w)};
            float* p = T1 + row * 2048 + col; *(f32x4*)p = o0; *(f32x4*)(p + 4) = o1; })
    }
};
struct EpiGate2 {
    const bf16_t* gates; const float* T1; bf16_t* merged;
    __device__ __forceinline__ void operator()(const f32x4 (&acc)[2][2][4][2], const Unit& u, int wr, int wc, int fr, int fq) const {
        EPI_LOOP({ const size_t row = (size_t)u.pm * 256 + trow; const int col = u.pn * 256 + tcol; const u32x4 g = *(const u32x4*)(gates + row * 4096 + 2048 + col);
            const float* p = T1 + row * 2048 + col; const f32x4 t0 = *(const f32x4*)p, t1 = *(const f32x4*)(p + 4);
            f32x4 o0 = {t0[0] + v0[0] * bf_lo(g.x), t0[1] + v0[1] * bf_hi(g.x), t0[2] + v0[2] * bf_lo(g.y), t0[3] + v0[3] * bf_hi(g.y)};
            f32x4 o1 = {t1[0] + v1[0] * bf_lo(g.z), t1[1] + v1[1] * bf_hi(g.z), t1[2] + v1[2] * bf_lo(g.w), t1[3] + v1[3] * bf_hi(g.w)};
            *(u32x4*)(merged + row * 2048 + col) = pack8(o0, o1); })
    }
};
struct EpiWo {
    const float* x; const float* mod; float* out;
    __device__ __forceinline__ void operator()(const f32x4 (&acc)[2][2][4][2], const Unit& u, int wr, int wc, int fr, int fq) const {
        const float* gt = mod + (size_t)(u.pm >> 3) * 12288 + 4096;
        EPI_LOOP({ const size_t row = (size_t)u.pm * 256 + trow; const int col = u.pn * 256 + tcol; const float* px = x + row * 2048 + col;
            const f32x4 x0 = *(const f32x4*)px, x1 = *(const f32x4*)(px + 4), g0 = *(const f32x4*)(gt + col), g1 = *(const f32x4*)(gt + col + 4);
            float* po = out + row * 2048 + col; *(f32x4*)po = x0 + g0 * v0; *(f32x4*)(po + 4) = x1 + g1 * v1; })
    }
};
struct EpiMoeUp {
    bf16_t* act; const float* lw;
    __device__ __forceinline__ void operator()(const f32x4 (&acc)[2][2][4][2], const Unit& u, int wr, int wc, int fr, int fq) const {
        int fr_ = fr, fq_ = fq; asm volatile("" : "+v"(fr_), "+v"(fq_));
#pragma unroll
        for (int ai = 0; ai < 2; ++ai)
#pragma unroll
            for (int m = 0; m < 4; ++m) {
                const int trow = ai * 128 + wr * 64 + m * 16 + fr_; const int tcol = wc * 32 + fq_ * 8;
                const float gw = trow < u.nvalid ? lw[u.aux + trow] : 0.f;
                const f32x4 a0 = acc[ai][0][m][0], a1 = acc[ai][0][m][1], u0 = acc[ai][1][m][0], u1 = acc[ai][1][m][1]; f32x4 o0, o1;
#pragma unroll
                for (int j = 0; j < 4; ++j) { o0[j] = a0[j] * sigmoidf_(a0[j]) * u0[j] * gw; o1[j] = a1[j] * sigmoidf_(a1[j]) * u1[j] * gw; }
                *(u32x4*)(act + ((size_t)u.pm * 256 + trow) * 512 + u.pn * 128 + tcol) = pack8(o0, o1); SBAR();
            }
    }
};
struct EpiMoeDown {
    float* out; const float* mod;
    __device__ __forceinline__ void operator()(const f32x4 (&acc)[2][2][4][2], const Unit& u, int wr, int wc, int fr, int fq) const {
        EPI_LOOP({ if (trow < u.nvalid) { const int tok = u.gi[trow]; const int col = u.pn * 256 + tcol; const float* gt = mod + (size_t)(tok >> 11) * 12288 + 10240 + col;
            const f32x4 g0 = *(const f32x4*)gt, g1 = *(const f32x4*)(gt + 4); float* po = out + (size_t)tok * 2048 + col;
            _Pragma("unroll") for (int j = 0; j < 4; ++j) { unsafeAtomicAdd(po + j, g0[j] * v0[j]); unsafeAtomicAdd(po + 4 + j, g1[j] * v1[j]); } } })
    }
};

struct MoeOrder {
    const LAS int* pre;
    const LAS int* cnt;
    int G, c, ntn, K; const char* A; const char* Bt; size_t bstride; const int* ltok; bool down;
    __device__ bool next(int i, Unit& u) const {
        const int total = __builtin_amdgcn_readfirstlane(pre[64]) * ntn; const long L = (long)i * G + c; if (L >= total) return false;
        const int l = (int)L; const int mt = l / ntn, pn = l % ntn;
        int e = 0;
#pragma unroll 1
        for (int s = 32; s >= 1; s >>= 1) if (__builtin_amdgcn_readfirstlane(pre[e + s]) <= mt) e += s;
        const int lt = mt - __builtin_amdgcn_readfirstlane(pre[e]);
        u.pm = mt; u.pn = pn; u.aux = e * LCAP + lt * 256; u.gi = ltok + u.aux; { const int rem = __builtin_amdgcn_readfirstlane(cnt[e]) - lt * 256; u.nvalid = rem < 256 ? rem : 256; }
        u.a = down ? A + (size_t)mt * 256 * K * 2 : A; u.b = Bt + (size_t)e * bstride + (size_t)pn * 256 * K * 2; return true;
    }
};

__device__ __forceinline__ int map_row(int map, int n) {
    if (map == 0) return n;
    if (map == 1) { if (n < 2384) return n; if (n < 5456) return n + 176; if (n < 5464) return n - 3072; return n + 168; }
    if (map == 2) return (n >> 7) * 256 + (n & 127);
    return (n >> 7) * 256 + 128 + (n & 127);
}
__device__ void ph0_prologue(const Params& p, LAS unsigned char* lds) {
    const int tid = threadIdx.x, wid = tid >> 6, lane = tid & 63, G = gridDim.x, bx = blockIdx.x;
    if (bx < 192) {
        LAS float* sc = (LAS float*)lds;
        LAS float* red = (LAS float*)(lds + 32768);
        const float* c = p.in[I_C];
        for (int i = tid; i < 4 * 2048; i += NTHREADS) { const float v = c[i]; sc[i] = v / (1.0f + __expf(-v)); }
        __syncthreads();
        for (int item = bx; item < 192; item += G) {
            const int n0 = item * 64, cg = lane & 15, rs = lane >> 4;
            float acc[4][4];
#pragma unroll
            for (int b = 0; b < 4; ++b)
#pragma unroll
                for (int j = 0; j < 4; ++j) acc[b][j] = 0.f;
            const float* w = p.in[I_WADA] + n0 + cg * 4;
#pragma unroll 4
            for (int step = 0; step < 64; ++step) {
                const int k = step * 32 + wid * 4 + rs;
                const f32x4 wv = *(const f32x4*)(w + (size_t)k * 12288);
#pragma unroll
                for (int b = 0; b < 4; ++b) { const float s = sc[b * 2048 + k];
#pragma unroll
                    for (int j = 0; j < 4; ++j) acc[b][j] += s * wv[j]; }
            }
#pragma unroll
            for (int b = 0; b < 4; ++b)
#pragma unroll
                for (int j = 0; j < 4; ++j) { float v = acc[b][j]; v += __shfl_xor(v, 16); v += __shfl_xor(v, 32); acc[b][j] = v; }
            if (rs == 0) {
#pragma unroll
                for (int b = 0; b < 4; ++b)
#pragma unroll
                    for (int j = 0; j < 4; ++j) red[(wid * 16 + cg) * 16 + b * 4 + j] = acc[b][j]; }
            __syncthreads();
            if (tid < 256) { const int cg2 = tid >> 4, bj = tid & 15, b = bj >> 2, j = bj & 3; float s = 0.f;
#pragma unroll
                for (int w8 = 0; w8 < 8; ++w8) s += red[(w8 * 16 + cg2) * 16 + bj];
                const int n = n0 + cg2 * 4 + j; ((float*)(p.ws + WS_MOD))[b * 12288 + n] = s + p.in[I_BADA][n]; }
            __syncthreads();
        }
    }
    { u32x4* z = (u32x4*)(p.ws + WS_WIN + (size_t)2392 * 2048 * 2); const int n16 = 168 * 2048 * 2 / 16;
      for (int i = bx * NTHREADS + tid; i < n16; i += G * NTHREADS) z[i] = (u32x4){0u, 0u, 0u, 0u}; }
    { bf16_t* wh = (bf16_t*)(p.ws + WS_WRH); bf16_t* wl = (bf16_t*)(p.ws + WS_WRL);
      for (int i = bx * NTHREADS + tid; i < 80 * 2048; i += G * NTHREADS) { const int n = i >> 11, k = i & 2047;
          const float v = n < 8 ? p.in[I_WRG][k * 8 + n] : (n < 72 ? p.in[I_WRE][k * 64 + n - 8] : 0.f);
          const unsigned h = cvt_pk_bf16(v, 0.f) & 0xffffu; const unsigned l = cvt_pk_bf16(v - bf_lo(h), 0.f) & 0xffffu; wh[i] = (bf16_t)h; wl[i] = (bf16_t)l; } }
    LAS float* tile = (LAS float*)(lds + 65536);
    for (int ti = bx; ti < p.ntiles_total; ti += G) {
        int j = 0;
#pragma unroll 1
        for (int q = 1; q < NJOBS; ++q) if (ti >= p.jobs[q].tile0) j = q;
        const TJob& J = p.jobs[j];
        int l = ti - J.tile0; const int per = J.ntk * J.ntn; const int bt = l / per; l -= bt * per; const int tn = l / J.ntk, tk = l % J.ntk;
        const float* src = J.src + (size_t)bt * J.sbatch; bf16_t* dst = J.dst + (size_t)bt * J.dbatch;
        const int k0 = tk * 64, n0 = tn * 64;
#pragma unroll
        for (int i = 0; i < 2; ++i) { const int r = (tid >> 4) + 32 * i, c4 = (tid & 15) * 4;
            f32x4 v = {0.f, 0.f, 0.f, 0.f}; if (n0 + c4 < J.N) v = *(const f32x4*)(src + (size_t)(k0 + r) * J.N + n0 + c4);
#pragma unroll
            for (int q = 0; q < 4; ++q) tile[r * 65 + c4 + q] = v[q]; }
        __syncthreads();
        { const int n = tid >> 3, kq = (tid & 7) * 8;
          if (n0 + n < J.N) { float f[8];
#pragma unroll
              for (int q = 0; q < 8; ++q) f[q] = tile[(kq + q) * 65 + n];
              u32x4 w; w.x = cvt_pk_bf16(f[0], f[1]); w.y = cvt_pk_bf16(f[2], f[3]); w.z = cvt_pk_bf16(f[4], f[5]); w.w = cvt_pk_bf16(f[6], f[7]);
              *(u32x4*)(dst + (size_t)map_row(J.map, n0 + n) * J.ldd + k0 + kq) = w; } }
        __syncthreads();
    }
}

__device__ __forceinline__ void norm_row(const float* xr, const float* g, const float* sh, const float* sc, bf16_t* hr, int lane, float (&hv)[32]) {
    f32x4 v[8]; float ss = 0.f;
#pragma unroll
    for (int i = 0; i < 8; ++i) { v[i] = *(const f32x4*)(xr + i * 256 + lane * 4); ss += v[i][0] * v[i][0] + v[i][1] * v[i][1] + v[i][2] * v[i][2] + v[i][3] * v[i][3]; }
    ss = wave_sum(ss);
    const float rstd = rsqrtf(ss * (1.0f / 2048.0f) + RMS_EPS);
#pragma unroll
    for (int i = 0; i < 8; ++i) { const int col = i * 256 + lane * 4; const f32x4 gg = *(const f32x4*)(g + col), s1 = *(const f32x4*)(sc + col), s0 = *(const f32x4*)(sh + col);
#pragma unroll
        for (int j = 0; j < 4; ++j) hv[i * 4 + j] = v[i][j] * rstd * gg[j] * (1.0f + s1[j]) + s0[j];
        u32x2 w; w.x = cvt_pk_bf16(hv[i * 4], hv[i * 4 + 1]); w.y = cvt_pk_bf16(hv[i * 4 + 2], hv[i * 4 + 3]); *(u32x2*)(hr + col) = w; }
}
__device__ void ph1_norm(const Params& p) {
    const int lane = threadIdx.x & 63, gw = blockIdx.x * 8 + (threadIdx.x >> 6), nw = gridDim.x * 8;
    const float* mod = (const float*)(p.ws + WS_MOD);
    for (int t = gw; t < NTOK; t += nw) { const int b = t >> 11; float hv[32];
        norm_row(p.in[I_X] + (size_t)t * DM, p.in[I_GMIX], mod + b * 12288, mod + b * 12288 + 2048, (bf16_t*)(p.ws + WS_H) + (size_t)t * DM, lane, hv); }
}

template <int MB, int NB, int KS>
__device__ __forceinline__ void wave_gemm(const bf16_t* A, int lda, const bf16_t* Bt, int ldb, f32x4 (&acc)[MB][NB], int lane) {
    const int fr = lane & 15, fq = lane >> 4;
#pragma unroll
    for (int mb = 0; mb < MB; ++mb)
#pragma unroll
        for (int nb = 0; nb < NB; ++nb) acc[mb][nb] = (f32x4){0.f, 0.f, 0.f, 0.f};
#pragma unroll 1
    for (int ks = 0; ks < KS; ++ks) {
        bf16x8 af[MB];
#pragma unroll
        for (int mb = 0; mb < MB; ++mb) af[mb] = *(const bf16x8*)(A + (size_t)(mb * 16 + fr) * lda + ks * 32 + fq * 8);
#pragma unroll
        for (int nb = 0; nb < NB; ++nb) { const bf16x8 bf = *(const bf16x8*)(Bt + (size_t)(nb * 16 + fr) * ldb + ks * 32 + fq * 8);
#pragma unroll
            for (int mb = 0; mb < MB; ++mb) acc[mb][nb] = __builtin_amdgcn_mfma_f32_16x16x32_bf16(bf, af[mb], acc[mb][nb], 0, 0, 0); }
    }
}

__device__ void idx_item(const Params& p, LAS unsigned char* lds, int b, int c, int sub) {
    const int tid = threadIdx.x, wid = tid >> 6, lane = tid & 63, fr = lane & 15, fq = lane >> 4;
    constexpr int SCLD = 2052;
    LAS float* sc = (LAS float*)lds;
    const int q0 = c * 64 + sub * 16, nk = (c + 1) * 64, nkb = nk / 16;
    const bf16_t* qidx = (const bf16_t*)(p.ws + WS_QIDX) + (size_t)(b * SEQ + q0 + fr) * 1024;
    const float* misc = (const float*)(p.ws + WS_MISC);
    float wq[16];
    { const float* wp = misc + (size_t)(b * SEQ + q0 + fr) * 256 + 64;
#pragma unroll
      for (int i = 0; i < 4; ++i) { const f32x4 v = *(const f32x4*)(wp + i * 4); wq[i * 4] = v[0]; wq[i * 4 + 1] = v[1]; wq[i * 4 + 2] = v[2]; wq[i * 4 + 3] = v[3]; } }
#pragma unroll
    for (int hp = 0; hp < 2; ++hp) {
        bf16x8 qf[8][2];
#pragma unroll
        for (int h = 0; h < 8; ++h)
#pragma unroll
            for (int ks = 0; ks < 2; ++ks) qf[h][ks] = *(const bf16x8*)(qidx + (hp * 8 + h) * 64 + ks * 32 + fq * 8);
#pragma unroll 1
        for (int kb = wid; kb < nkb; kb += 8) {
            const float* kp = misc + (size_t)(b * SEQ + kb * 16 + fr) * 256 + fq * 8;
            bf16x8 kf[2];
#pragma unroll
            for (int ks = 0; ks < 2; ++ks) { const f32x4 a = *(const f32x4*)(kp + ks * 32), bq = *(const f32x4*)(kp + ks * 32 + 4);
                u32x4 w; w.x = cvt_pk_bf16(a[0], a[1]); w.y = cvt_pk_bf16(a[2], a[3]); w.z = cvt_pk_bf16(bq[0], bq[1]); w.w = cvt_pk_bf16(bq[2], bq[3]); kf[ks] = *(bf16x8*)&w; }
            LAS f32x4* sp = (LAS f32x4*)(sc + fr * SCLD + kb * 16 + fq * 4);
            f32x4 s = {0.f, 0.f, 0.f, 0.f}; if (hp) s = *sp;
#pragma unroll
            for (int h = 0; h < 8; ++h) {
                f32x4 a = {0.f, 0.f, 0.f, 0.f};
                a = __builtin_amdgcn_mfma_f32_16x16x32_bf16(kf[0], qf[h][0], a, 0, 0, 0);
                a = __builtin_amdgcn_mfma_f32_16x16x32_bf16(kf[1], qf[h][1], a, 0, 0, 0);
#pragma unroll
                for (int j = 0; j < 4; ++j) s[j] += wq[hp * 8 + h] * fmaxf(a[j], 0.f);
            }
            *sp = s;
        }
    }
    __syncthreads();
    unsigned long long* mask = (unsigned long long*)(p.ws + WS_MASK);
    for (int qq = 0; qq < 2; ++qq) {
        const int ql = wid * 2 + qq; const size_t qg = (size_t)b * SEQ + q0 + ql;
        unsigned long long myword = 0ull;
        if (nk <= 256) { if (lane <= c) myword = ~0ull; }
        else {
            LAS unsigned* sk = (LAS unsigned*)(sc + ql * SCLD) + lane;
#pragma unroll 4
            for (int i = 0; i <= c; ++i) { unsigned u = sk[i * 64]; u = (u & 0x80000000u) ? ~u : (u | 0x80000000u); sk[i * 64] = u; }
            unsigned v = 0u;
#pragma unroll 1
            for (int bit = 31; bit >= 0; --bit) {
                const unsigned cand = v | (1u << bit); int cnt = 0;
#pragma unroll 4
                for (int i = 0; i <= c; ++i) cnt += __popcll(__ballot(sk[i * 64] >= cand));
                if (cnt >= 256) { v = cand; if (cnt == 256) break; }
            }
#pragma unroll 4
            for (int i = 0; i <= c; ++i) { const unsigned long long bm = __ballot(sk[i * 64] >= v); if (lane == i) myword = bm; }
        }
        if (lane < 32) mask[qg * 32 + lane] = myword;
    }
    __syncthreads();
}
__device__ void ph3_prep(const Params& p, LAS unsigned char* lds, const int rep) {
    const int tid = threadIdx.x, wid = tid >> 6, lane = tid & 63, bx = blockIdx.x, G = gridDim.x;
    for (int it = bx; it < 256; it += G) {
        const int b = it >> 6, r = it & 63, cp = r >> 2, sub = r & 3;
        idx_item(p, lds, b, 31 - cp, sub); idx_item(p, lds, b, cp, sub);
    }
    const int gw = bx * 8 + wid, nw = G * 8;
    for (int it = gw; it < 2048; it += nw) {
        const int rt = it >> 3, h = it & 7, fr = lane & 15, fq = lane >> 4;
        f32x4 acc[2][16];
        wave_gemm<2, 16, 4>((const bf16_t*)(p.ws + WS_QA) + (size_t)rt * 32 * 1024 + h * 128, 1024, (const bf16_t*)(p.ws + WS_WUK) + (size_t)h * 256 * 128, 128, acc, lane);
#pragma unroll
        for (int mb = 0; mb < 2; ++mb) { float ss = 0.f;
#pragma unroll
            for (int nb = 0; nb < 16; ++nb)
#pragma unroll
                for (int j = 0; j < 4; ++j) ss += acc[mb][nb][j] * acc[mb][nb][j];
            ss += __shfl_xor(ss, 16); ss += __shfl_xor(ss, 32);
            const float rs = rsqrtf(ss * (1.0f / 256.0f) + RMS_EPS) * 0.0625f;
            bf16_t* o = (bf16_t*)(p.ws + WS_QLAT) + (size_t)(rt * 32 + mb * 16 + fr) * 2048 + h * 256;
#pragma unroll
            for (int nb = 0; nb < 16; ++nb) { const int col = nb * 16 + fq * 4; const f32x4 g = *(const f32x4*)(p.in[I_GQA] + col);
                u32x2 w; w.x = cvt_pk_bf16(acc[mb][nb][0] * rs * g[0], acc[mb][nb][1] * rs * g[1]); w.y = cvt_pk_bf16(acc[mb][nb][2] * rs * g[2], acc[mb][nb][3] * rs * g[3]); *(u32x2*)(o + col) = w; } }
    }
    for (int t = gw; t < NTOK; t += nw) {
        { const f32x4 v = *(const f32x4*)((const float*)(p.ws + WS_CKV) + (size_t)t * 256 + lane * 4); float ss = wave_sum(v[0] * v[0] + v[1] * v[1] + v[2] * v[2] + v[3] * v[3]);
          const float rs = rsqrtf(ss * (1.0f / 256.0f) + RMS_EPS); const f32x4 g = *(const f32x4*)(p.in[I_GKV] + lane * 4);
          u32x2 w; w.x = cvt_pk_bf16(v[0] * rs * g[0], v[1] * rs * g[1]); w.y = cvt_pk_bf16(v[2] * rs * g[2], v[3] * rs * g[3]); *(u32x2*)((bf16_t*)(p.ws + WS_KV) + (size_t)t * 256 + lane * 4) = w; }
#pragma unroll
        for (int which = 0; which < 2; ++which) {
            if (rep) continue;
            bf16_t* row = (bf16_t*)(p.ws + (which ? WS_KB : WS_QB)) + (size_t)t * 1024 + lane * 16; const float* g = p.in[which ? I_GKB : I_GQB] + (lane & 7) * 16;
            u32x4 a = *(u32x4*)row, c2 = *(u32x4*)(row + 8); float f[16];
            f[0] = bf_lo(a.x); f[1] = bf_hi(a.x); f[2] = bf_lo(a.y); f[3] = bf_hi(a.y); f[4] = bf_lo(a.z); f[5] = bf_hi(a.z); f[6] = bf_lo(a.w); f[7] = bf_hi(a.w);
            f[8] = bf_lo(c2.x); f[9] = bf_hi(c2.x); f[10] = bf_lo(c2.y); f[11] = bf_hi(c2.y); f[12] = bf_lo(c2.z); f[13] = bf_hi(c2.z); f[14] = bf_lo(c2.w); f[15] = bf_hi(c2.w);
            float ss = 0.f;
#pragma unroll
            for (int j = 0; j < 16; ++j) ss += f[j] * f[j];
            ss += __shfl_xor(ss, 1); ss += __shfl_xor(ss, 2); ss += __shfl_xor(ss, 4);
            const float rs = rsqrtf(ss * (1.0f / 128.0f) + RMS_EPS) * (which ? 1.0f : 0.08838834764831845f);
#pragma unroll
            for (int j = 0; j < 16; ++j) f[j] *= rs * g[j];
            a.x = cvt_pk_bf16(f[0], f[1]); a.y = cvt_pk_bf16(f[2], f[3]); a.z = cvt_pk_bf16(f[4], f[5]); a.w = cvt_pk_bf16(f[6], f[7]);
            c2.x = cvt_pk_bf16(f[8], f[9]); c2.y = cvt_pk_bf16(f[10], f[11]); c2.z = cvt_pk_bf16(f[12], f[13]); c2.w = cvt_pk_bf16(f[14], f[15]);
            *(u32x4*)row = a; *(u32x4*)(row + 8) = c2;
        }
    }
    for (int it = gw; it < 32; it += nw) {
        const int b = it >> 3, h = it & 7; const float bf = p.in[I_BFORGET][h]; const float* fp = (const float*)(p.ws + WS_MISC) + (size_t)(b * SEQ + lane * 32) * 256 + 80 + h;
        float ls[32]; float run = 0.f;
#pragma unroll
        for (int j = 0; j < 32; ++j) { const float z = fp[(size_t)j * 256] + bf; run += fminf(z, 0.f) - log1pf(__expf(-fabsf(z))); ls[j] = run; }
        float incl = run;
#pragma unroll
        for (int o = 1; o < 64; o <<= 1) { const float t2 = __shfl_up(incl, o); if (lane >= o) incl += t2; }
        const float off = incl - run; float* cp = (float*)(p.ws + WS_CUM) + (size_t)(b * 8 + h) * SEQ + lane * 32;
#pragma unroll
        for (int j = 0; j < 32; ++j) cp[j] = ls[j] + off;
    }
}

template <int OFF> __device__ __forceinline__ s16x4 tr_read(int vb) { s16x4 r; asm volatile("ds_read_b64_tr_b16 %0, %1 offset:%2" : "=&v"(r) : "v"(vb), "i"(OFF) : "memory"); return r; }
__device__ __forceinline__ int v_rd_base(int lane) { return ((lane & 3) << 3) | (((lane >> 2) & 3) << 6) | (((lane >> 4) & 1) << 5) | (((lane >> 5) & 1) << 8); }
template <int NCB> __device__ __forceinline__ int v_st(int k, int c) { const int kk = (k & ~0xC) | ((k & 4) << 1) | ((k & 8) >> 1); return ((kk >> 3) * NCB + (c >> 5)) * 512 + ((kk & 7) * 32 + (c & 31)) * 2; }
#define PK4(P, BASE, OUT) do { unsigned a0 = cvt_pk_bf16(P[BASE + 0], P[BASE + 1]), a1 = cvt_pk_bf16(P[BASE + 2], P[BASE + 3]);   \
    unsigned b0 = cvt_pk_bf16(P[BASE + 4], P[BASE + 5]), b1 = cvt_pk_bf16(P[BASE + 6], P[BASE + 7]);                              \
    auto r0 = __builtin_amdgcn_permlane32_swap(a0, b0, false, false); auto r1 = __builtin_amdgcn_permlane32_swap(a1, b1, false, false); \
    u32x4 w = {r0[0], r1[0], r0[1], r1[1]}; OUT = *reinterpret_cast<bf16x8*>(&w); } while (0)
#define PKV(L, H) (bf16x8){L[0], L[1], L[2], L[3], H[0], H[1], H[2], H[3]}
template <int NCB, int D0, int KS> __device__ __forceinline__ void pv_step(f32x16& od, int vb, bf16x8 pa) {
    const s16x4 l = tr_read<D0 * 512 + KS * (2 * NCB * 512)>(vb), h = tr_read<D0 * 512 + KS * (2 * NCB * 512) + NCB * 512>(vb);
    asm volatile("s_waitcnt lgkmcnt(0)" ::: "memory"); SBAR();
    od = __builtin_amdgcn_mfma_f32_32x32x16_bf16(pa, PKV(l, h), od, 0, 0, 0);
}
template <int NCB, int KS0, int D0> struct PvBlocks { static __device__ __forceinline__ void run(f32x16* o, int vb, bf16x8 pa0, bf16x8 pa1) {
    pv_step<NCB, D0, KS0>(o[D0], vb, pa0); pv_step<NCB, D0, KS0 + 1>(o[D0], vb, pa1); if constexpr (D0 + 1 < NCB) PvBlocks<NCB, KS0, D0 + 1>::run(o, vb, pa0, pa1); } };

constexpr int FOX_V = 0, FOX_K = 16384, FOX_CK = 32768, FOX_AL = 33024, FOX_LI = 34048;
__device__ void fox_item(const Params& p, LAS unsigned char* lds, int b, int h, int qb) {
    const int tid = threadIdx.x, wid = tid >> 6, lane = tid & 63, r32 = lane & 31, hi = lane >> 5;
    const bf16_t* Q = (const bf16_t*)(p.ws + WS_QB); const bf16_t* Kg = (const bf16_t*)(p.ws + WS_KB); const bf16_t* Vg = (const bf16_t*)(p.ws + WS_VB);
    const float* cum = (const float*)(p.ws + WS_CUM) + (size_t)(b * 8 + h) * SEQ;
    const int qpos = qb * 256 + wid * 32 + r32;
    bf16x8 qr[8];
    { const bf16_t* qp = Q + (size_t)(b * SEQ + qpos) * 1024 + h * 128 + hi * 8;
#pragma unroll
      for (int d0 = 0; d0 < 8; ++d0) qr[d0] = *(const bf16x8*)(qp + d0 * 16); }
    const float cq = cum[qpos] * LOG2E;
    float m_reg = -1e30f, l_reg = 0.f; f32x16 o[4];
#pragma unroll
    for (int d = 0; d < 4; ++d)
#pragma unroll
        for (int r = 0; r < 16; ++r) o[d][r] = 0.f;
    LAS float* ck = (LAS float*)(lds + FOX_CK); LAS float* al_l = (LAS float*)(lds + FOX_AL) + wid * 32; LAS float* li_l = (LAS float*)(lds + FOX_LI) + wid * 32;
    const int vb = (int)(uintptr_t)(lds + FOX_V) + v_rd_base(lane);
    const int sr = tid >> 4, scol = (tid & 15) * 8;
    const int ntiles = qb * 4 + 4, mylast = qb * 4 + (wid >> 1);
    for (int kt = 0; kt < ntiles; ++kt) {
        __syncthreads();
#pragma unroll
        for (int i = 0; i < 2; ++i) { const int row = sr + 32 * i; const size_t g = (size_t)(b * SEQ + kt * 64 + row) * 1024 + h * 128 + scol;
            const u32x4 kv = *(const u32x4*)(Kg + g), vv = *(const u32x4*)(Vg + g);
            *(LAS u32x4*)(lds + FOX_K + row * 256 + ((scol * 2) ^ ((row & 7) << 4))) = kv; *(LAS u32x4*)(lds + FOX_V + v_st<4>(row, scol)) = vv; }
        if (tid < 64) ck[tid] = cum[kt * 64 + tid] * LOG2E;
        __syncthreads();
        if (kt <= mylast) {
            f32x16 p0, p1;
#pragma unroll
            for (int r = 0; r < 16; ++r) { p0[r] = 0.f; p1[r] = 0.f; }
#pragma unroll
            for (int d0 = 0; d0 < 8; ++d0) { const int cb = (d0 * 16 + hi * 8) * 2;
                const bf16x8 b0 = *(const LAS bf16x8*)(lds + FOX_K + r32 * 256 + (cb ^ ((r32 & 7) << 4)));
                const bf16x8 b1 = *(const LAS bf16x8*)(lds + FOX_K + (32 + r32) * 256 + (cb ^ ((r32 & 7) << 4)));
                p0 = __builtin_amdgcn_mfma_f32_32x32x16_bf16(b0, qr[d0], p0, 0, 0, 0); p1 = __builtin_amdgcn_mfma_f32_32x32x16_bf16(b1, qr[d0], p1, 0, 0, 0); }
            const bool diag = (kt * 64 + 63 > qb * 256 + wid * 32);
            float pmax = -INFINITY;
#pragma unroll
            for (int g4 = 0; g4 < 4; ++g4) { const f32x4 c0 = *(const LAS f32x4*)(ck + 8 * g4 + 4 * hi), c1 = *(const LAS f32x4*)(ck + 32 + 8 * g4 + 4 * hi);
#pragma unroll
                for (int j = 0; j < 4; ++j) { const int r = g4 * 4 + j; float t0 = fmaf(p0[r], LOG2E, cq) - c0[j], t1 = fmaf(p1[r], LOG2E, cq) - c1[j];
                    if (diag) { const int kp = kt * 64 + crow(r, hi); if (kp > qpos) t0 = -INFINITY; if (kp + 32 > qpos) t1 = -INFINITY; }
                    p0[r] = t0; p1[r] = t1; pmax = fmaxf(pmax, fmaxf(t0, t1)); } }
            { auto rr = __builtin_amdgcn_permlane32_swap(__float_as_uint(pmax), __float_as_uint(pmax), false, false); pmax = fmaxf(__uint_as_float(rr[0]), __uint_as_float(rr[1])); }
            const float mn = fmaxf(m_reg, pmax); const float alpha = __builtin_amdgcn_exp2f(m_reg - mn); m_reg = mn;
            float ps = 0.f;
#pragma unroll
            for (int r = 0; r < 16; ++r) { p0[r] = __builtin_amdgcn_exp2f(p0[r] - mn); p1[r] = __builtin_amdgcn_exp2f(p1[r] - mn); ps += p0[r] + p1[r]; }
            { auto rr = __builtin_amdgcn_permlane32_swap(__float_as_uint(ps), __float_as_uint(ps), false, false); ps = __uint_as_float(rr[0]) + __uint_as_float(rr[1]); }
            l_reg = l_reg * alpha + ps;
            if (__any(alpha < 1.f)) { if (hi == 0) al_l[r32] = alpha; asm volatile("s_waitcnt lgkmcnt(0)" ::: "memory");
#pragma unroll
                for (int r = 0; r < 16; ++r) { const float a = al_l[crow(r, hi)];
#pragma unroll
                    for (int d = 0; d < 4; ++d) o[d][r] *= a; } }
            bf16x8 pa0, pa1, pa2, pa3; PK4(p0, 0, pa0); PK4(p0, 8, pa1); PK4(p1, 0, pa2); PK4(p1, 8, pa3);
            PvBlocks<4, 0, 0>::run(o, vb, pa0, pa1); PvBlocks<4, 2, 0>::run(o, vb, pa2, pa3);
        }
    }
    if (hi == 0) li_l[r32] = l_reg; asm volatile("s_waitcnt lgkmcnt(0)" ::: "memory");
    bf16_t* O = (bf16_t*)(p.ws + WS_OB) + (size_t)(b * SEQ + qb * 256 + wid * 32) * 1024 + h * 128;
#pragma unroll
    for (int r = 0; r < 16; ++r) { const float rl = __builtin_amdgcn_rcpf(li_l[crow(r, hi)]); const int orow = crow(r, hi);
#pragma unroll
        for (int d0 = 0; d0 < 4; ++d0) O[(size_t)orow * 1024 + d0 * 32 + r32] = (bf16_t)(cvt_pk_bf16(o[d0][r] * rl, 0.f) & 0xffffu); }
}

constexpr int DSA_V = 0, DSA_K = 32768, DSA_AL = 65536, DSA_LI = 66560, DSA_Q = 67584;
__device__ void dsa_item(const Params& p, LAS unsigned char* lds, int b, int qt) {
    const int tid = threadIdx.x, wid = tid >> 6, lane = tid & 63, r32 = lane & 31, hi = lane >> 5, h = wid;
    const bf16_t* KV = (const bf16_t*)(p.ws + WS_KV) + (size_t)b * SEQ * 256;
    const int qpos = qt * 32 + r32; const size_t qg = (size_t)b * SEQ + qpos;
    const unsigned* mask = (const unsigned*)(p.ws + WS_MASK) + qg * 64;
    bf16x8 qr[8];
    LAS unsigned char* qlds = lds + DSA_Q + wid * 8192 + lane * 16;
    __syncthreads();
    { const bf16_t* qp = (const bf16_t*)(p.ws + WS_QLAT) + qg * 2048 + h * 256 + hi * 8;
#pragma unroll
      for (int d0 = 0; d0 < 8; ++d0) qr[d0] = *(const bf16x8*)(qp + d0 * 16);
#pragma unroll
      for (int d0 = 8; d0 < 16; ++d0) *(LAS bf16x8*)(qlds + (d0 - 8) * 1024) = *(const bf16x8*)(qp + d0 * 16); }
    const float slopeL = exp2f(-(float)(h + 1)) * LOG2E;
    float m_reg = -1e30f, l_reg = 0.f; f32x16 o[8];
#pragma unroll
    for (int d = 0; d < 8; ++d)
#pragma unroll
        for (int r = 0; r < 16; ++r) o[d][r] = 0.f;
    LAS float* al_l = (LAS float*)(lds + DSA_AL) + wid * 32; LAS float* li_l = (LAS float*)(lds + DSA_LI) + wid * 32;
    const int vb = (int)(uintptr_t)(lds + DSA_V) + v_rd_base(lane);
    const int ntiles = (qt >> 1) + 1;
    for (int kt = 0; kt < ntiles; ++kt) {
        __syncthreads();
#pragma unroll
        for (int i = 0; i < 4; ++i) { const int row = (tid >> 5) + 16 * i, col = (tid & 31) * 8;
            const u32x4 v = *(const u32x4*)(KV + (size_t)(kt * 64 + row) * 256 + col);
            *(LAS u32x4*)(lds + DSA_K + row * 512 + ((col * 2) ^ ((row & 15) << 4))) = v; *(LAS u32x4*)(lds + DSA_V + v_st<8>(row, col)) = v; }
        const u32x2 mw = *(const u32x2*)(mask + kt * 2);
        __syncthreads();
#pragma unroll
        for (int half = 0; half < 2; ++half) {
            f32x16 pp;
#pragma unroll
            for (int r = 0; r < 16; ++r) pp[r] = 0.f;
#pragma unroll
            for (int d0 = 0; d0 < 16; ++d0) { const int cb = (d0 * 16 + hi * 8) * 2; const int row = half * 32 + r32;
                const bf16x8 kf = *(const LAS bf16x8*)(lds + DSA_K + row * 512 + (cb ^ ((row & 15) << 4)));
                bf16x8 qf; if (d0 < 8) qf = qr[d0 & 7]; else qf = *(const LAS bf16x8*)(qlds + (d0 - 8) * 1024);
                pp = __builtin_amdgcn_mfma_f32_32x32x16_bf16(kf, qf, pp, 0, 0, 0); if ((d0 & 1) == 1) SBAR(); }
            const unsigned wsh = (half ? mw.y : mw.x) >> (4 * hi);
            const float df = (float)(qpos - (kt * 64 + half * 32 + 4 * hi));
            float pmax = -INFINITY;
#pragma unroll
            for (int r = 0; r < 16; ++r) { const int cb = (r & 3) + 8 * (r >> 2); const float dd = df - (float)cb;
                float t = fmaf(-slopeL, fabsf(dd), pp[r] * LOG2E); if (!((wsh >> cb) & 1u)) t = -INFINITY; pp[r] = t; pmax = fmaxf(pmax, t); }
            { auto rr = __builtin_amdgcn_permlane32_swap(__float_as_uint(pmax), __float_as_uint(pmax), false, false); pmax = fmaxf(__uint_as_float(rr[0]), __uint_as_float(rr[1])); }
            const float mn = fmaxf(m_reg, pmax); const float alpha = __builtin_amdgcn_exp2f(m_reg - mn); m_reg = mn;
            float ps = 0.f;
#pragma unroll
            for (int r = 0; r < 16; ++r) { pp[r] = __builtin_amdgcn_exp2f(pp[r] - mn); ps += pp[r]; }
            { auto rr = __builtin_amdgcn_permlane32_swap(__float_as_uint(ps), __float_as_uint(ps), false, false); ps = __uint_as_float(rr[0]) + __uint_as_float(rr[1]); }
            l_reg = l_reg * alpha + ps;
            if (__any(alpha < 1.f)) { if (hi == 0) al_l[r32] = alpha; asm volatile("s_waitcnt lgkmcnt(0)" ::: "memory");
#pragma unroll
                for (int r = 0; r < 16; ++r) { const float a = al_l[crow(r, hi)];
#pragma unroll
                    for (int d = 0; d < 8; ++d) o[d][r] *= a; } }
            bf16x8 pa0, pa1; PK4(pp, 0, pa0); PK4(pp, 8, pa1);
            if (half == 0) PvBlocks<8, 0, 0>::run(o, vb, pa0, pa1); else PvBlocks<8, 2, 0>::run(o, vb, pa0, pa1);
        }
    }
    if (hi == 0) li_l[r32] = l_reg; asm volatile("s_waitcnt lgkmcnt(0)" ::: "memory");
    bf16_t* O = (bf16_t*)(p.ws + WS_OLAT) + ((size_t)b * SEQ + qt * 32) * 2048 + h * 256;
#pragma unroll
    for (int r = 0; r < 16; ++r) { const float rl = __builtin_amdgcn_rcpf(li_l[crow(r, hi)]); const int orow = crow(r, hi);
#pragma unroll
        for (int d0 = 0; d0 < 8; ++d0) O[(size_t)orow * 2048 + d0 * 32 + r32] = (bf16_t)(cvt_pk_bf16(o[d0][r] * rl, 0.f) & 0xffffu); }
}
__device__ void ph4_attn(const Params& p, LAS unsigned char* lds) {
    const int r = blockIdx.x;
    if (r < 256) { const int c = 31 - (r >> 3), w8 = r & 7, b = w8 >> 1, half = w8 & 1; dsa_item(p, lds, b, c * 2 + half); }
    __syncthreads();
    if (r < 256) { const int qb = r >> 5, bh = r & 31; fox_item(p, lds, bh >> 3, bh & 7, qb); }
}

__device__ void ph5_oa(const Params& p) {
    const int lane = threadIdx.x & 63, gw = blockIdx.x * 8 + (threadIdx.x >> 6), nw = gridDim.x * 8, fr = lane & 15, fq = lane >> 4;
    for (int it = gw; it < 2048; it += nw) {
        const int rt = it >> 3, h = it & 7;
        f32x4 acc[2][8];
        wave_gemm<2, 8, 8>((const bf16_t*)(p.ws + WS_OLAT) + (size_t)rt * 32 * 2048 + h * 256, 2048, (const bf16_t*)(p.ws + WS_WUV) + (size_t)h * 128 * 256, 256, acc, lane);
#pragma unroll
        for (int mb = 0; mb < 2; ++mb) { bf16_t* o = (bf16_t*)(p.ws + WS_OA) + (size_t)(rt * 32 + mb * 16 + fr) * 1024 + h * 128;
#pragma unroll
            for (int nb = 0; nb < 8; ++nb) { u32x2 w; w.x = cvt_pk_bf16(acc[mb][nb][0], acc[mb][nb][1]); w.y = cvt_pk_bf16(acc[mb][nb][2], acc[mb][nb][3]); *(u32x2*)(o + nb * 16 + fq * 4) = w; } }
    }
}

__device__ void ph8_router(const Params& p, LAS unsigned char* lds, const int rep) {
    const int tid = threadIdx.x, wid = tid >> 6, lane = tid & 63, fr = lane & 15, fq = lane >> 4;
    const float* mod = (const float*)(p.ws + WS_MOD);
    bf16_t* H = (bf16_t*)(p.ws + WS_H); bf16_t* HL = (bf16_t*)(p.ws + WS_HLO);
    int* cnt = (int*)(p.ws + WS_CNT) + rep * 256; int* ltok = rep ? (int*)(p.ws + WS_T1) : (int*)(p.ws + WS_LTOK); float* lw = rep ? (float*)(p.ws + WS_T1 + (4u << 20)) : (float*)(p.ws + WS_LW);
    LAS float* lg = (LAS float*)lds;
    for (int blk = blockIdx.x; blk < NTOK / 32; blk += gridDim.x) {
        const int t0 = blk * 32;
        for (int rr = 0; rr < 4; ++rr) { const int t = t0 + wid * 4 + rr, b = t >> 11; float hv[32];
            norm_row(p.out + (size_t)t * DM, p.in[I_GFFN], mod + b * 12288 + 6144, mod + b * 12288 + 8192, H + (size_t)t * DM, lane, hv);
#pragma unroll
            for (int i = 0; i < 8; ++i) { float lo[4];
#pragma unroll
                for (int j = 0; j < 4; j += 2) { const unsigned w = cvt_pk_bf16(hv[i * 4 + j], hv[i * 4 + j + 1]); lo[j] = hv[i * 4 + j] - bf_lo(w); lo[j + 1] = hv[i * 4 + j + 1] - bf_hi(w); }
                u32x2 w2; w2.x = cvt_pk_bf16(lo[0], lo[1]); w2.y = cvt_pk_bf16(lo[2], lo[3]); *(u32x2*)(HL + (size_t)t * DM + i * 256 + lane * 4) = w2; } }
        asm volatile("s_waitcnt vmcnt(0)" ::: "memory");
        __syncthreads();
        if (wid < 2) {
            const bf16_t* Ah = H + (size_t)(t0 + wid * 16 + fr) * DM + fq * 8; const bf16_t* Al = HL + (size_t)(t0 + wid * 16 + fr) * DM + fq * 8;
            const bf16_t* Wh = (const bf16_t*)(p.ws + WS_WRH) + (size_t)fr * DM + fq * 8; const bf16_t* Wl = (const bf16_t*)(p.ws + WS_WRL) + (size_t)fr * DM + fq * 8;
            f32x4 acc[5];
#pragma unroll
            for (int nb = 0; nb < 5; ++nb) acc[nb] = (f32x4){0.f, 0.f, 0.f, 0.f};
#pragma unroll 2
            for (int ks = 0; ks < 64; ++ks) {
                const bf16x8 ah = *(const bf16x8*)(Ah + ks * 32), al = *(const bf16x8*)(Al + ks * 32);
#pragma unroll
                for (int nb = 0; nb < 5; ++nb) { const bf16x8 wh = *(const bf16x8*)(Wh + (size_t)nb * 16 * DM + ks * 32), wl = *(const bf16x8*)(Wl + (size_t)nb * 16 * DM + ks * 32);
                    acc[nb] = __builtin_amdgcn_mfma_f32_16x16x32_bf16(wh, ah, acc[nb], 0, 0, 0);
                    acc[nb] = __builtin_amdgcn_mfma_f32_16x16x32_bf16(wl, ah, acc[nb], 0, 0, 0);
                    acc[nb] = __builtin_amdgcn_mfma_f32_16x16x32_bf16(wh, al, acc[nb], 0, 0, 0); }
            }
#pragma unroll
            for (int nb = 0; nb < 5; ++nb) *(LAS f32x4*)(lg + (wid * 16 + fr) * 80 + nb * 16 + fq * 4) = acc[nb];
        }
        __syncthreads();
        if (tid < 32) {
            const int t = t0 + tid; const LAS float* L = lg + tid * 80;
            float gl[8]; int gi = 0; float gm = -INFINITY;
#pragma unroll
            for (int g = 0; g < 8; ++g) { gl[g] = L[g] + p.in[I_BRG][g]; if (gl[g] > gm) { gm = gl[g]; gi = g; } }
            float se = 0.f;
#pragma unroll
            for (int g = 0; g < 8; ++g) se += __expf(gl[g] - gm);
            const float gwt = 1.0f / se;
            float v1 = -INFINITY, v2 = -INFINITY; int i1 = 0, i2 = 0;
            for (int e = 0; e < 8; ++e) { const float v = L[8 + gi * 8 + e] + p.in[I_BRE][gi * 8 + e];
                if (v > v1) { v2 = v1; i2 = i1; v1 = v; i1 = e; } else if (v > v2) { v2 = v; i2 = e; } }
            const float e2 = __expf(v2 - v1); const float p1 = gwt / (1.0f + e2), p2 = gwt * e2 / (1.0f + e2);
            const int ea = gi * 8 + i1, eb = gi * 8 + i2;
            const int pa = atomicAdd(cnt + ea, 1); ltok[ea * LCAP + pa] = t; lw[ea * LCAP + pa] = p1;
            const int pb = atomicAdd(cnt + eb, 1); ltok[eb * LCAP + pb] = t; lw[eb * LCAP + pb] = p2;
        }
        __syncthreads();
    }
}

__device__ __forceinline__ void moe_table(const Params& p, LAS unsigned char* lds) {
    LAS int* pre = (LAS int*)(lds + LDS_TAB);
    if (threadIdx.x == 0) { const int* cnt = (const int*)(p.ws + WS_CNT); int s = 0; for (int e = 0; e < 64; ++e) { const int ce = cnt[e]; pre[e] = s; pre[80 + e] = ce; s += (ce + 255) >> 8; } pre[64] = s; }
    __syncthreads();
}
__device__ void ph9_gather(const Params& p, LAS unsigned char* lds) {
    moe_table(p, lds);
    const LAS int* pre = (const LAS int*)(lds + LDS_TAB); const LAS int* cnt = pre + 80; const int* ltok = (const int*)(p.ws + WS_LTOK);
    const int lane = threadIdx.x & 63, gw = blockIdx.x * 8 + (threadIdx.x >> 6), nw = gridDim.x * 8, nrows = pre[64] * 256;
    const bf16_t* H = (const bf16_t*)(p.ws + WS_H); bf16_t* HG = (bf16_t*)(p.ws + WS_HG);
    for (int r = gw; r < nrows; r += nw) {
        const int mt = r >> 8; int e = 0;
#pragma unroll 1
        for (int s = 32; s >= 1; s >>= 1) if (pre[e + s] <= mt) e += s;
        const int pos = (mt - pre[e]) * 256 + (r & 255);
        u32x4 v[4];
        if (pos < cnt[e]) { const int tok = ltok[e * LCAP + pos];
#pragma unroll
            for (int i = 0; i < 4; ++i) v[i] = *(const u32x4*)(H + (size_t)tok * DM + i * 512 + lane * 8); }
        else {
#pragma unroll
            for (int i = 0; i < 4; ++i) v[i] = (u32x4){0u, 0u, 0u, 0u}; }
#pragma unroll
        for (int i = 0; i < 4; ++i) *(u32x4*)(HG + (size_t)r * DM + i * 512 + lane * 8) = v[i];
    }
}


#define MOE_GLOAD(dst, ptr) asm volatile("global_load_dwordx4 %0, %1, off" : "=v"(dst) : "v"(ptr) : "memory")
template <bool UP>
__device__ void moe_gemm(const Params& p, LAS unsigned char* lds, const int rep) {
    constexpr int K = UP ? 2048 : 512, NKT = K / 32, NS = UP ? 8 : 16, LDW = UP ? 512 : 2048;
    constexpr int OFF_A = 0, OFF_B = 98304;
    const int tid = threadIdx.x, w = __builtin_amdgcn_readfirstlane(tid >> 6), l = tid & 63, r32 = l & 31, hi = l >> 5;
    LAS int* tab = (LAS int*)(lds + LDS_TAB);
    if (tid == 0) { const int* cnt = (const int*)(p.ws + WS_CNT); int s = 0, ro = 0; for (int e = 0; e < 64; ++e) { const int ce = cnt[e]; tab[e] = s; tab[80 + e] = ce; tab[160 + e] = ro; ro += ce; const int np = (ce + 511) >> 9; s += np > 0 ? np : 1; } tab[64] = s; }
    __syncthreads();
    const int total = __builtin_amdgcn_readfirstlane(tab[64]) * NS;
    const int q = (w & 3) * 8 + (l & 7), g = (w >> 2) * 8 + (l >> 3);
    const unsigned bwoff = (unsigned)(q * 256 + (((g >> 2) ^ (q & 3)) * 16) + (g & 3) * 4);
    const unsigned frag_sw = (unsigned)((r32 >> 2) & 3);
    const int* ltok = (const int*)(p.ws + WS_LTOK); const float* lw = (const float*)(p.ws + WS_LW);
    for (int unit = blockIdx.x; unit < total; unit += gridDim.x) {
        const int pm = unit / NS, ns = unit - pm * NS; int e = 0;
#pragma unroll 1
        for (int s = 32; s >= 1; s >>= 1) if (__builtin_amdgcn_readfirstlane(tab[e + s]) <= pm) e += s;
        const int mp = pm - __builtin_amdgcn_readfirstlane(tab[e]); const int cnt_e = __builtin_amdgcn_readfirstlane(tab[80 + e]), rowoff = __builtin_amdgcn_readfirstlane(tab[160 + e]);
        int nrows = cnt_e - mp * 512; nrows = nrows > 512 ? 512 : nrows; const bool two = nrows > 256;
        const char* abase = UP ? (const char*)(p.ws + WS_H) : (const char*)(p.ws + WS_ACT);
        unsigned aoff[4];
#pragma unroll
        for (int i = 0; i < 4; ++i) { const int row = ((i >> 1) * 16 + 2 * w + (i & 1)) * 16 + (l >> 2); const int c = (l & 3) ^ ((l >> 4) & 3);
            int src; if (UP) src = row < nrows ? ltok[e * LCAP + mp * 512 + row] : 0; else src = rowoff + mp * 512 + (row < nrows ? row : 0);
            aoff[i] = (unsigned)(src * K + c * 8) * 2u; }
        const float* bsrc = UP ? (q < 16 ? p.in[I_W1] : p.in[I_W3]) + (size_t)e * 2048 * 512 + ns * 64 + (q & 15) * 4 + (size_t)(2 * g) * LDW
                               : p.in[I_W2] + (size_t)e * 512 * 2048 + ns * 128 + q * 4 + (size_t)(2 * g) * LDW;
        f32x16 acc[2][4];
#pragma unroll
        for (int a = 0; a < 2; ++a)
#pragma unroll
            for (int b = 0; b < 4; ++b)
#pragma unroll
                for (int r = 0; r < 16; ++r) acc[a][b][r] = 0.f;
        f32x4 br[4][2];
#define MOE_ISSUE_B(j, t) do { const int tt_ = (t) < NKT ? (t) : NKT - 1; const float* bp_ = bsrc + (size_t)tt_ * 32 * LDW; MOE_GLOAD(br[j][0], bp_); MOE_GLOAD(br[j][1], bp_ + LDW); } while (0)
#define MOE_ISSUE_A(t) do { int tt_ = (t) < 0 ? 0 : (t); const int bi_ = (tt_ % 3); tt_ = tt_ < NKT ? tt_ : NKT - 1; const char* ap_ = abase + (size_t)tt_ * 64; \
        LAS unsigned char* ab_ = lds + OFF_A + bi_ * 32768 + 2 * w * 1024; \
        __builtin_amdgcn_global_load_lds((const unsigned*)(ap_ + aoff[0]), (LAS unsigned*)(ab_), 16, 0, 0); __builtin_amdgcn_global_load_lds((const unsigned*)(ap_ + aoff[1]), (LAS unsigned*)(ab_ + 1024), 16, 0, 0); \
        __builtin_amdgcn_global_load_lds((const unsigned*)(ap_ + aoff[2]), (LAS unsigned*)(ab_ + 16384), 16, 0, 0); __builtin_amdgcn_global_load_lds((const unsigned*)(ap_ + aoff[3]), (LAS unsigned*)(ab_ + 16384 + 1024), 16, 0, 0); } while (0)
        MOE_ISSUE_B(0, 0); MOE_ISSUE_A(-2); MOE_ISSUE_B(1, 1); MOE_ISSUE_A(-1); MOE_ISSUE_B(2, 2); MOE_ISSUE_A(0); MOE_ISSUE_B(3, 3); MOE_ISSUE_A(1);
#define MOE_ITER(j, t) do { \
        asm volatile("s_waitcnt vmcnt(22)" : "+v"(br[j][0]), "+v"(br[j][1]) :: "memory"); \
        { LAS unsigned char* bb_ = lds + OFF_B + ((t) & 1) * 8192 + bwoff; _Pragma("unroll") for (int jj = 0; jj < 4; ++jj) *(LAS unsigned*)(bb_ + jj * 64) = cvt_pk_bf16(br[j][0][jj], br[j][1][jj]); } \
        MOE_ISSUE_B(j, (t) + 4); \
        asm volatile("s_waitcnt vmcnt(8)" ::: "memory"); \
        asm volatile("s_waitcnt lgkmcnt(0)" ::: "memory"); __builtin_amdgcn_s_barrier(); asm volatile("" ::: "memory"); \
        MOE_ISSUE_A((t) + 2); \
        { const LAS unsigned char* ab_ = lds + OFF_A + ((t) % 3) * 32768 + (32 * w + r32) * 64; const LAS unsigned char* bb_ = lds + OFF_B + ((t) & 1) * 8192 + r32 * 64; \
          _Pragma("unroll") for (int ks = 0; ks < 2; ++ks) { const unsigned co_ = ((unsigned)(ks * 2 + hi) ^ frag_sw) * 16u; \
            bf16x8 bf_[4]; _Pragma("unroll") for (int nb = 0; nb < 4; ++nb) bf_[nb] = *(const LAS bf16x8*)(bb_ + nb * 2048 + co_); \
            const bf16x8 a0_ = *(const LAS bf16x8*)(ab_ + co_); \
            _Pragma("unroll") for (int nb = 0; nb < 4; ++nb) acc[0][nb] = UP ? __builtin_amdgcn_mfma_f32_32x32x16_bf16(bf_[nb], a0_, acc[0][nb], 0, 0, 0) : __builtin_amdgcn_mfma_f32_32x32x16_bf16(a0_, bf_[nb], acc[0][nb], 0, 0, 0); \
            if (two) { const bf16x8 a1_ = *(const LAS bf16x8*)(ab_ + 16384 + co_); \
              _Pragma("unroll") for (int nb = 0; nb < 4; ++nb) acc[1][nb] = UP ? __builtin_amdgcn_mfma_f32_32x32x16_bf16(bf_[nb], a1_, acc[1][nb], 0, 0, 0) : __builtin_amdgcn_mfma_f32_32x32x16_bf16(a1_, bf_[nb], acc[1][nb], 0, 0, 0); } } } \
        } while (0)
#pragma unroll 1
        for (int t = 0; t < NKT; t += 4) { MOE_ITER(0, t); MOE_ITER(1, t + 1); MOE_ITER(2, t + 2); MOE_ITER(3, t + 3); }
        asm volatile("s_waitcnt vmcnt(0)" ::: "memory");
        if constexpr (UP) {
#pragma unroll
            for (int mt = 0; mt < 2; ++mt) {
                const int rl = mt * 256 + 32 * w + r32;
                if (rl < nrows) {
                    const float gw = lw[e * LCAP + mp * 512 + rl]; bf16_t* orow = (bf16_t*)(p.ws + WS_ACT) + (size_t)(rowoff + mp * 512 + rl) * 512 + ns * 64 + 4 * hi;
#pragma unroll
                    for (int nb = 0; nb < 2; ++nb)
#pragma unroll
                        for (int g4 = 0; g4 < 4; ++g4) { float o[4];
#pragma unroll
                            for (int j = 0; j < 4; ++j) { const float a = acc[mt][nb][g4 * 4 + j], u = acc[mt][nb + 2][g4 * 4 + j]; o[j] = a * sigmoidf_(a) * u * gw; }
                            u32x2 pk; pk.x = cvt_pk_bf16(o[0], o[1]); pk.y = cvt_pk_bf16(o[2], o[3]); *(u32x2*)(orow + nb * 32 + g4 * 8) = pk; }
                }
            }
        } else {
            LAS float* gtl = (LAS float*)(lds + LDS_TAB + 1024); LAS int* tokl = (LAS int*)(lds + LDS_TAB + 1024 + 2048) + w * 64;
            gtl[tid] = ((const float*)(p.ws + WS_MOD))[(size_t)(tid >> 7) * 12288 + 10240 + ns * 128 + (tid & 127)];
            { const int rl = hi * 256 + 32 * w + r32; tokl[l] = rl < nrows ? ltok[e * LCAP + mp * 512 + rl] : -1; }
            __syncthreads();
            float* obase = (rep ? (float*)(p.ws + WS_T1) : p.out) + ns * 128 + r32;
#pragma unroll
            for (int mt = 0; mt < 2; ++mt) {
                if (mt * 256 + 32 * w < nrows) {
#pragma unroll
                    for (int r = 0; r < 16; ++r) { const int tok = tokl[mt * 32 + crow(r, hi)];
                        if (tok >= 0) { float* orow = obase + (size_t)tok * 2048; const LAS float* gt = gtl + (tok >> 11) * 128 + r32;
#pragma unroll
                            for (int nb = 0; nb < 4; ++nb) unsafeAtomicAdd(orow + nb * 32, gt[nb * 32] * acc[mt][nb][r]); } }
                }
            }
        }
        asm volatile("s_waitcnt vmcnt(0)" ::: "memory");
        __syncthreads();
    }
#undef MOE_ISSUE_A
#undef MOE_ISSUE_B
#undef MOE_ITER
}

__global__ void __launch_bounds__(NTHREADS, 2) mk_fwd(Params p) {
    extern __shared__ __attribute__((aligned(16))) unsigned char shm[];
    LAS unsigned char* lds = (LAS unsigned char*)shm;
    const int lo = p.ph_lo, hi = p.ph_hi;
    if (threadIdx.x < 4) ((LAS unsigned*)(lds + LDS_BARW))[threadIdx.x] = 0u;
    __syncthreads();
    XcdBarrier bar; bar.bar = (unsigned*)(p.ws + WS_BAR); bar.x = 0; bar.st = nullptr;
    if (hi - lo > 1) bar = xcd_barrier_post((unsigned*)(p.ws + WS_BAR), (volatile LAS unsigned*)(lds + LDS_BARW));
#ifndef SKIP_MASK
#define SKIP_MASK 0
#endif
#define IN(k) (!((SKIP_MASK >> (k)) & 1) && lo <= (k) && (k) < hi)
#define SEAM(k) do { if (IN(k) && IN((k) + 1)) xcd_barrier(bar); } while (0)
    const int G = gridDim.x, bx = blockIdx.x;
#ifndef REP_PHASE
#define REP_PHASE 0
#endif
#define RUN(k, ...) do { if (IN(k)) { { const int rep = 0; (void)rep; __VA_ARGS__ } if ((REP_PHASE >> (k)) & 1) { xcd_barrier(bar); { const int rep = 1; (void)rep; __VA_ARGS__ } } } SEAM(k); } while (0)
    RUN(0, ph0_prologue(p, lds););
    RUN(1, ph1_norm(p););
    RUN(2, pg8::StaticOrder S; S.init(p.ws + WS_H, p.ws + WS_WIN, NTOK, DINP, DM, G, bx); EpiProj E{p.ws, p.in[I_BGATE]};
           pg8::gemm_phase<EpiProj, pg8::StaticOrder, false>(lds, DM, S, E););
    RUN(3, ph3_prep(p, lds, rep););
    RUN(4, ph4_attn(p, lds););
    RUN(5, ph5_oa(p););
    RUN(6, { pg8::StaticOrder S; S.init(p.ws + WS_OA, p.ws + WS_WPA, NTOK, DM, 1024, G, bx); EpiGate1 E{(const bf16_t*)(p.ws + WS_GATES), (float*)(p.ws + WS_T1)};
             pg8::gemm_phase<EpiGate1, pg8::StaticOrder, false>(lds, 1024, S, E); }
           { pg8::StaticOrder S; S.init(p.ws + WS_OB, p.ws + WS_WPB, NTOK, DM, 1024, G, bx); EpiGate2 E{(const bf16_t*)(p.ws + WS_GATES), (const float*)(p.ws + WS_T1), (bf16_t*)(p.ws + WS_MERGED)};
             pg8::gemm_phase<EpiGate2, pg8::StaticOrder, false>(lds, 1024, S, E); });
    RUN(7, pg8::StaticOrder S; S.init(p.ws + WS_MERGED, p.ws + WS_WO, NTOK, DM, DM, G, bx); EpiWo E{p.in[I_X], (const float*)(p.ws + WS_MOD), p.out};
           pg8::gemm_phase<EpiWo, pg8::StaticOrder, false>(lds, DM, S, E););
    RUN(8, ph8_router(p, lds, rep););
    RUN(9, moe_gemm<true>(p, lds, rep););
    RUN(10, moe_gemm<false>(p, lds, rep););
#undef RUN
#undef IN
#undef SEAM
}

constexpr int NPHASES = 11;
extern "C" void kernel_launch(void* const* d_in, const int* in_sizes, int n_in, void* d_out, int out_size, void* d_ws, size_t ws_size, hipStream_t stream) {
    static int grid = 0;
    if (grid == 0) {
        if (n_in != 25 || in_sizes[0] != NTOK * DM || out_size != NTOK * DM || ws_size < WS_END) {
            fprintf(stderr, "kernel_launch: shape mismatch: n_in %d in0 %d out %d ws %zu (need %zu)\n", n_in, n_in > 0 ? in_sizes[0] : -1, out_size, ws_size, (size_t)WS_END); grid = -1; return; }
        int dev = 0, cus = 0, per_cu = 0;
        if (hipGetDevice(&dev) != hipSuccess || hipDeviceGetAttribute(&cus, hipDeviceAttributeMultiprocessorCount, dev) != hipSuccess) { fprintf(stderr, "kernel_launch: device query failed\n"); grid = -1; return; }
        if (hipFuncSetAttribute((const void*)mk_fwd, hipFuncAttributeMaxDynamicSharedMemorySize, LDS_BYTES) != hipSuccess) { fprintf(stderr, "kernel_launch: hipFuncSetAttribute failed\n"); grid = -1; return; }
        if (hipOccupancyMaxActiveBlocksPerMultiprocessor(&per_cu, (const void*)mk_fwd, NTHREADS, LDS_BYTES) != hipSuccess || per_cu < 1) { fprintf(stderr, "kernel_launch: occupancy query says %d blocks per CU\n", per_cu); }
        (void)hipGetLastError();
        grid = cus;
    }
    if (grid < 0) return;
    if (hipMemsetAsync((char*)d_ws + WS_BAR, 0, WS_ZERO_BYTES, stream) != hipSuccess) { fprintf(stderr, "kernel_launch: memset failed\n"); return; }
    Params p; memset(&p, 0, sizeof(p));
    for (int i = 0; i < 25; ++i) p.in[i] = (const float*)d_in[i];
    p.out = (float*)d_out; p.ws = (unsigned char*)d_ws;
    unsigned char* ws = (unsigned char*)d_ws;
    auto job = [&](int j, const float* src, size_t dst_off, int K, int N, int ldd, int map, int nbatch, long sbatch, long dbatch) {
        TJob& J = p.jobs[j]; J.src = src; J.dst = (bf16_t*)(ws + dst_off); J.K = K; J.N = N; J.ldd = ldd; J.map = map; J.ntk = K / 64; J.ntn = (N + 63) / 64; J.nbatch = nbatch; J.sbatch = sbatch; J.dbatch = dbatch; };
    job(0, p.in[I_WIN], WS_WIN, 2048, DIN, 2048, 1, 1, 0, 0);
    job(1, p.in[I_WPA], WS_WPA, 1024, 2048, 1024, 0, 1, 0, 0);
    job(2, p.in[I_WPB], WS_WPB, 1024, 2048, 1024, 0, 1, 0, 0);
    job(3, p.in[I_WO], WS_WO, 2048, 2048, 2048, 0, 1, 0, 0);
    job(4, p.in[I_WUK], WS_WUK, 128, 256, 128, 0, 8, 128L * 256, 256L * 128);
    job(5, p.in[I_WUV], WS_WUV, 256, 128, 256, 0, 8, 256L * 128, 128L * 256);
    int t0 = 0; for (int j = 0; j < NJOBS; ++j) { p.jobs[j].tile0 = t0; t0 += p.jobs[j].ntk * p.jobs[j].ntn * p.jobs[j].nbatch; }
    p.ntiles_total = t0;
#if MK_LAUNCHES == 1
    p.ph_lo = 0; p.ph_hi = NPHASES;
    hipLaunchKernelGGL(mk_fwd, dim3(grid), dim3(NTHREADS), LDS_BYTES, stream, p);
#else
    for (int k = 0; k < NPHASES; ++k) { p.ph_lo = k; p.ph_hi = k + 1; hipLaunchKernelGGL(mk_fwd, dim3(grid), dim3(NTHREADS), LDS_BYTES, stream, p); }
#endif
    const hipError_t le = hipPeekAtLastError();
    if (le != hipSuccess) fprintf(stderr, "kernel_launch: launch failed: %s\n", hipGetErrorName(le));
}

#ifdef DIAG_PHASES
template <int PH> __global__ void __launch_bounds__(NTHREADS, 2) k_ph(Params p) {
    extern __shared__ __attribute__((aligned(16))) unsigned char shm[];
    LAS unsigned char* lds = (LAS unsigned char*)shm; const int G = gridDim.x, bx = blockIdx.x;
    if constexpr (PH == 0) ph0_prologue(p, lds);
    if constexpr (PH == 1) ph1_norm(p);
    if constexpr (PH == 2) { pg8::StaticOrder S; S.init(p.ws + WS_H, p.ws + WS_WIN, NTOK, DINP, DM, G, bx); EpiProj E{p.ws, p.in[I_BGATE]}; pg8::gemm_phase<EpiProj, pg8::StaticOrder, false>(lds, DM, S, E); }
    if constexpr (PH == 3) ph3_prep(p, lds, 0);
    if constexpr (PH == 4) ph4_attn(p, lds);
    if constexpr (PH == 5) ph5_oa(p);
    if constexpr (PH == 6) { pg8::StaticOrder S; S.init(p.ws + WS_OA, p.ws + WS_WPA, NTOK, DM, 1024, G, bx); EpiGate1 E{(const bf16_t*)(p.ws + WS_GATES), (float*)(p.ws + WS_T1)}; pg8::gemm_phase<EpiGate1, pg8::StaticOrder, false>(lds, 1024, S, E); }
    if constexpr (PH == 7) { pg8::StaticOrder S; S.init(p.ws + WS_MERGED, p.ws + WS_WO, NTOK, DM, DM, G, bx); EpiWo E{p.in[I_X], (const float*)(p.ws + WS_MOD), p.out}; pg8::gemm_phase<EpiWo, pg8::StaticOrder, false>(lds, DM, S, E); }
    if constexpr (PH == 8) ph8_router(p, lds, 0);
    if constexpr (PH == 9) moe_gemm<true>(p, lds, 0);
    if constexpr (PH == 10) moe_gemm<false>(p, lds, 0);
    if constexpr (PH == 12) { const int r = bx; dsa_item(p, lds, r & 3, r >> 2); }
    if constexpr (PH == 13) { const int r = bx; fox_item(p, lds, r & 3, (r >> 2) & 7, r >> 5); }
    if constexpr (PH == 14) { idx_item(p, lds, bx & 3, (bx >> 2) & 31, bx >> 7); }
}
template __global__ void k_ph<0>(Params); template __global__ void k_ph<1>(Params); template __global__ void k_ph<2>(Params); template __global__ void k_ph<3>(Params);
template __global__ void k_ph<4>(Params); template __global__ void k_ph<5>(Params); template __global__ void k_ph<6>(Params); template __global__ void k_ph<7>(Params);
template __global__ void k_ph<8>(Params); template __global__ void k_ph<9>(Params); template __global__ void k_ph<10>(Params); template __global__ void k_ph<11>(Params);
template __global__ void k_ph<12>(Params); template __global__ void k_ph<13>(Params); template __global__ void k_ph<14>(Params);
#endif
```

```cpp
#include <hip/hip_runtime.h>
#include <cstdio>
#include <cstdint>
#include <cstring>

#ifndef MK_LAUNCHES
#define MK_LAUNCHES 1
#endif

#define LAS __attribute__((address_space(3)))
typedef unsigned short bf16_t;
typedef short bf16x8 __attribute__((ext_vector_type(8)));
typedef short s16x4 __attribute__((ext_vector_type(4)));
typedef float f32x4 __attribute__((ext_vector_type(4)));
typedef float f32x16 __attribute__((ext_vector_type(16)));
typedef unsigned u32x4 __attribute__((ext_vector_type(4)));
typedef unsigned u32x2 __attribute__((ext_vector_type(2)));

constexpr int DM = 2048, NBATCH = 4, SEQ = 2048, NTOK = NBATCH * SEQ;
constexpr int DIN = 9560, DINP = 9728;
constexpr int NEXP = 64, DEXP = 512, LCAP = 8192;
constexpr float RMS_EPS = 1e-6f;
constexpr float LOG2E = 1.4426950408889634f;
constexpr int NTHREADS = 512;
constexpr int LDS_BYTES = 163840 - 1024;
constexpr int LDS_BARW = LDS_BYTES - 16;
constexpr int LDS_TAB = 131072;

constexpr size_t al256(size_t x) { return (x + 255) / 256 * 256; }
constexpr size_t WS_BAR = 0;
constexpr size_t WS_CNT = 16384;
constexpr size_t WS_ZERO_BYTES = 16384 + 4096;
constexpr size_t WS_MOD = WS_ZERO_BYTES;
constexpr size_t WS_H = al256(WS_MOD + (size_t)4 * 12288 * 4);
constexpr size_t WS_WIN = al256(WS_H + (size_t)NTOK * DM * 2);
constexpr size_t WS_WPA = al256(WS_WIN + (size_t)DINP * DM * 2);
constexpr size_t WS_WPB = al256(WS_WPA + (size_t)2048 * 1024 * 2);
constexpr size_t WS_WO = al256(WS_WPB + (size_t)2048 * 1024 * 2);
constexpr size_t WS_WUK = al256(WS_WO + (size_t)2048 * 2048 * 2);
constexpr size_t WS_WUV = al256(WS_WUK + (size_t)8 * 256 * 128 * 2);
constexpr size_t WS_W13 = al256(WS_WUV + (size_t)8 * 128 * 256 * 2);
constexpr size_t WS_W2 = al256(WS_W13 + (size_t)64 * 1024 * 2048 * 2);
constexpr size_t WS_QA = al256(WS_W2 + (size_t)64 * 2048 * 512 * 2);
constexpr size_t WS_CKV = al256(WS_QA + (size_t)NTOK * 1024 * 2);
constexpr size_t WS_KV = al256(WS_CKV + (size_t)NTOK * 256 * 4);
constexpr size_t WS_QIDX = al256(WS_KV + (size_t)NTOK * 256 * 2);
constexpr size_t WS_MISC = al256(WS_QIDX + (size_t)NTOK * 1024 * 2);
constexpr size_t WS_QB = al256(WS_MISC + (size_t)NTOK * 256 * 4);
constexpr size_t WS_KB = al256(WS_QB + (size_t)NTOK * 1024 * 2);
constexpr size_t WS_VB = al256(WS_KB + (size_t)NTOK * 1024 * 2);
constexpr size_t WS_GATES = al256(WS_VB + (size_t)NTOK * 1024 * 2);
constexpr size_t WS_QLAT = al256(WS_GATES + (size_t)NTOK * 4096 * 2);
constexpr size_t WS_MASK = al256(WS_QLAT + (size_t)NTOK * 2048 * 2);
constexpr size_t WS_CUM = al256(WS_MASK + (size_t)NTOK * 256);
constexpr size_t WS_OLAT = al256(WS_CUM + (size_t)4 * 8 * 2048 * 4);
constexpr size_t WS_OA = al256(WS_OLAT + (size_t)NTOK * 2048 * 2);
constexpr size_t WS_OB = al256(WS_OA + (size_t)NTOK * 1024 * 2);
constexpr size_t WS_T1 = al256(WS_OB + (size_t)NTOK * 1024 * 2);
constexpr size_t WS_MERGED = al256(WS_T1 + (size_t)NTOK * 2048 * 4);
constexpr size_t WS_LTOK = al256(WS_MERGED + (size_t)NTOK * 2048 * 2);
constexpr size_t WS_LW = al256(WS_LTOK + (size_t)NEXP * LCAP * 4);
constexpr size_t WS_ACT = al256(WS_LW + (size_t)NEXP * LCAP * 4);
constexpr size_t WS_HLO = al256(WS_ACT + (size_t)32768 * 512 * 2);
constexpr size_t WS_WRH = al256(WS_HLO + (size_t)NTOK * DM * 2);
constexpr size_t WS_WRL = al256(WS_WRH + (size_t)80 * DM * 2);
constexpr size_t WS_END = al256(WS_WRL + (size_t)80 * DM * 2);
constexpr size_t WS_KIDX = WS_END;
constexpr size_t WS_END2 = al256(WS_KIDX + (size_t)NTOK * 64 * 2);
constexpr size_t WS_HG = WS_QA;
static_assert(WS_HG + (size_t)32768 * DM * 2 <= WS_QLAT, "hg alias must fit in the dead region");

struct TJob { const float* src; bf16_t* dst; int K, N, ldd, map, ntk, ntn, nbatch, tile0; long sbatch, dbatch; };
constexpr int NJOBS = 6;
struct Params {
    const float* in[25];
    float* out;
    unsigned char* ws;
    TJob jobs[NJOBS];
    int ntiles_total;
    int ph_lo, ph_hi;
};
enum { I_X = 0, I_C, I_WADA, I_BADA, I_GMIX, I_WIN, I_BGATE, I_BFORGET, I_WUK, I_WUV, I_GQA, I_GKV, I_GQB, I_GKB, I_WPA, I_WPB, I_WO, I_GFFN, I_WRG, I_BRG, I_WRE, I_BRE, I_W1, I_W3, I_W2 };

__device__ __forceinline__ unsigned cvt_pk_bf16(float lo, float hi) { unsigned r; asm volatile("v_cvt_pk_bf16_f32 %0, %1, %2" : "=v"(r) : "v"(lo), "v"(hi)); return r; }
__device__ __forceinline__ float bf_lo(unsigned w) { return __uint_as_float(w << 16); }
__device__ __forceinline__ float bf_hi(unsigned w) { return __uint_as_float(w & 0xffff0000u); }
__device__ __forceinline__ float wave_sum(float v) {
#pragma unroll
    for (int o = 32; o >= 1; o >>= 1) v += __shfl_xor(v, o);
    return v;
}
__device__ __forceinline__ float sigmoidf_(float x) { return 1.0f / (1.0f + __expf(-x)); }
__device__ __forceinline__ int crow(int r, int hi) { return (r & 3) + 8 * (r >> 2) + 4 * hi; }
#define SBAR() __builtin_amdgcn_sched_barrier(0)

#define XB_TMO      128
#define XB_XCNT(j)  (256  + 64 * (j))
#define XB_XSUB(j)  (1280 + 64 * (j))
#define XB_XGEN(j)  (2304 + 64 * (j))
#define XB_TOP      3328
#define XB_TOPGEN   3392
#define XCD_BAR_WORDS 3456
#define XB_SPIN_CAP (1u << 20)
__device__ __forceinline__ unsigned xb_ld(unsigned* p)              { return __hip_atomic_load(p, __ATOMIC_RELAXED, __HIP_MEMORY_SCOPE_AGENT); }
__device__ __forceinline__ unsigned xb_add(unsigned* p, unsigned v) { return __hip_atomic_fetch_add(p, v, __ATOMIC_RELAXED, __HIP_MEMORY_SCOPE_AGENT); }
__device__ __forceinline__ unsigned xb_xcc_id() { return (unsigned)__builtin_amdgcn_s_getreg((3 << 11) | 20) & 0xFu; }
#define XB_SPIN(cond, bar) do { unsigned _sp = 0; while (cond) { __builtin_amdgcn_s_sleep(1); \
    if ((++_sp & 255u) == 0u) { if (xb_ld(&(bar)[XB_TMO])) break; if (_sp > XB_SPIN_CAP) { atomicAdd(&(bar)[XB_TMO], 1u); break; } } } } while (0)
struct XcdBarrier { unsigned* bar; unsigned x; volatile LAS unsigned* st; };
__device__ __forceinline__ XcdBarrier xcd_barrier_post(unsigned* bar, volatile LAS unsigned* st) {
    XcdBarrier b; b.bar = bar; b.x = xb_xcc_id(); b.st = st;
    if (threadIdx.x == 0) (void)xb_add(&bar[XB_XCNT(b.x)], 1u);
    return b;
}
__device__ __forceinline__ void xcd_barrier_complete(unsigned* bar, unsigned x, unsigned& nloc, unsigned& nx) {
    const unsigned G = gridDim.x * gridDim.y * gridDim.z;
    unsigned sum, cnt, mine, sp = 0u;
    for (;;) {
        sum = 0u; cnt = 0u; mine = 0u;
#pragma unroll
        for (unsigned j = 0; j < 16; ++j) { const unsigned c = xb_ld(&bar[XB_XCNT(j)]); sum += c; cnt += (c > 0u) ? 1u : 0u; mine = (j == x) ? c : mine; }
        if (sum == G) break;
        __builtin_amdgcn_s_sleep(1);
        if ((++sp & 255u) == 0u) { if (xb_ld(&bar[XB_TMO])) break; if (sp > XB_SPIN_CAP) { atomicAdd(&bar[XB_TMO], 1u); break; } }
    }
    nloc = mine > 0u ? mine : 1u; nx = cnt > 0u ? cnt : 1u;
}
__device__ __forceinline__ void xcd_barrier(const XcdBarrier& b) {
    asm volatile("s_waitcnt vmcnt(0)" ::: "memory");
    __syncthreads();
    if (threadIdx.x == 0) {
        unsigned* bar = b.bar;
        __builtin_amdgcn_s_waitcnt(0);
        unsigned nloc = b.st[0], nx = b.st[1];
        if (nloc == 0u) { xcd_barrier_complete(bar, b.x, nloc, nx); b.st[0] = nloc; b.st[1] = nx; }
        const unsigned old = xb_add(&bar[XB_XSUB(b.x)], 1u);
        const unsigned gen = old / nloc;
        if (old + 1u == (gen + 1u) * nloc) {
            __builtin_amdgcn_fence(__ATOMIC_RELEASE, "agent");
            asm volatile("s_waitcnt vmcnt(0)" ::: "memory");
            const unsigned og = xb_add(&bar[XB_TOP], 1u);
            const unsigned tg = og / nx;
            if (og + 1u == (tg + 1u) * nx) xb_add(&bar[XB_TOPGEN], 1u);
            else XB_SPIN(xb_ld(&bar[XB_TOPGEN]) == tg, bar);
            __builtin_amdgcn_fence(__ATOMIC_ACQUIRE, "agent");
            xb_add(&bar[XB_XGEN(b.x)], 1u);
            asm volatile("s_waitcnt vmcnt(0)" ::: "memory");
        } else {
            XB_SPIN(xb_ld(&bar[XB_XGEN(b.x)]) == gen, bar);
            __builtin_amdgcn_fence(__ATOMIC_ACQUIRE, "agent");
            asm volatile("s_waitcnt vmcnt(0)" ::: "memory");
        }
    }
    __syncthreads();
}

namespace pg8 {
constexpr int BM = 256, BK = 64, HALF = 128, HTB = HALF * BK * 2, STAGE_BYTES = 8 * HTB, NXCD = 8, WGM = 8;
__host__ __device__ __forceinline__ int lds_byte(int r, int c) { const int st = (r >> 4) * 2 + (c >> 5), rr = r & 15, cc = c & 31, ob = rr * 64 + cc * 2; return st * 1024 + (ob ^ (((ob >> 9) & 1) << 5)); }
__host__ __device__ __forceinline__ void stage_rc(int b, int& R, int& C) { const int st = b / 1024, sb = b % 1024, swz = sb ^ (((sb >> 9) & 1) << 5); R = (st >> 1) * 16 + swz / 64; C = (st & 1) * 32 + (swz % 64) / 2; }
__host__ __device__ __forceinline__ int perm32(int rho) { const int n = rho >> 4, i = rho & 15; return 8 * (i >> 2) + 4 * n + (i & 3); }

struct Unit { int pm, pn; const char* a; const char* b; const int* gi; int nvalid; int aux; };

struct StaticOrder {
    int nM, nN, nwg, G, c, K; const char* A; const char* Bt;
    __device__ void init(const void* A_, const void* Bt_, int M, int N, int K_, int G_, int c_) { A = (const char*)A_; Bt = (const char*)Bt_; K = K_; nM = M / BM; nN = N / BM; nwg = nM * nN; G = G_; c = c_; }
    __device__ bool next(int i, Unit& u) const {
        const long L = (long)i * G + c; if (L >= nwg) return false;
        int wgid = (int)L; { const int q = nwg / NXCD, r = nwg % NXCD, xcd = wgid % NXCD, off = wgid / NXCD; wgid = (xcd < r ? xcd * (q + 1) : r * (q + 1) + (xcd - r) * q) + off; }
        const int nig = WGM * nN, gid = wgid / nig, fm = gid * WGM, gsz = (nM - fm) < WGM ? (nM - fm) : WGM;
        u.pm = fm + ((wgid % nig) % gsz); u.pn = (wgid % nig) / gsz;
        u.a = A + (size_t)u.pm * BM * K * 2; u.b = Bt + (size_t)u.pn * BM * K * 2; u.gi = nullptr; u.nvalid = BM; u.aux = 0; return true;
    }
};

template <class Epi, class Sched, bool GATHER>
__device__ __forceinline__ void gemm_phase(LAS unsigned char* lds, const int K, const Sched& S, const Epi& E) {
    const int tid = threadIdx.x, wid = __builtin_amdgcn_readfirstlane(tid >> 6), lane = tid & 63, wr = wid >> 2, wc = wid & 3, fr = lane & 15, fq = lane >> 4;
    const int nt = K / BK;
    unsigned voffA[2], voffB[2]; int RA[2], CA[2];
#pragma unroll
    for (int i = 0; i < 2; ++i) { int R, C; stage_rc(tid * 16 + i * 8192, R, C); const int Rb = ((R & ~31) + perm32(R & 31));
        RA[i] = R; CA[i] = C; voffA[i] = (unsigned)(R * K + C) * 2u; voffB[i] = (unsigned)(Rb * K + C) * 2u; }
    const size_t kstep = (size_t)(BK * 2);
    const size_t hstep = (size_t)HALF * K * 2;
    const unsigned ldsw = (unsigned)wid * 1024u;
    const int aoff = lds_byte(wr * 64 + fr, fq * 8), boff = lds_byte(wc * 32 + fr, fq * 8);
    unsigned gA[2][2], gN[2][2];
#define PG8_SA(b, h) (((b) * 2 + (h)) * HTB)
#define PG8_SB(b, h) ((4 + (b) * 2 + (h)) * HTB)
#define PG8_STAGE(bufoff, gbase, voff) do { _Pragma("unroll") for (int _i = 0; _i < 2; ++_i) \
        __builtin_amdgcn_global_load_lds((const unsigned*)((const char*)(gbase) + (voff)[_i]), (LAS unsigned*)(lds + (bufoff) + ldsw + _i * 8192), 16, 0, 0); } while (0)
#define PG8_STAGE_A(bufoff, gp, h, NX) do { if constexpr (GATHER) { if (NX) PG8_STAGE(bufoff, gp, gN[h]); else PG8_STAGE(bufoff, gp, gA[h]); } else PG8_STAGE(bufoff, (gp) + (h) * hstep, voffA); } while (0)
#define PG8_LDA(dst, b, h) do { _Pragma("unroll") for (int m = 0; m < 4; ++m) _Pragma("unroll") for (int k = 0; k < 2; ++k) dst[m][k] = *(const LAS bf16x8*)(lds + PG8_SA(b, h) + aoff + m * 2048 + k * 1024); } while (0)
#define PG8_LDB(dst, b, h) do { _Pragma("unroll") for (int n = 0; n < 2; ++n) _Pragma("unroll") for (int k = 0; k < 2; ++k) dst[n][k] = *(const LAS bf16x8*)(lds + PG8_SB(b, h) + boff + n * 2048 + k * 1024); } while (0)
#define PG8_MMA(ai, bj, At, Bt) do { __builtin_amdgcn_s_setprio(1); _Pragma("unroll") for (int m = 0; m < 4; ++m) _Pragma("unroll") for (int n = 0; n < 2; ++n) _Pragma("unroll") for (int k = 0; k < 2; ++k) \
        acc[ai][bj][m][n] = __builtin_amdgcn_mfma_f32_16x16x32_bf16(Bt[n][k], At[m][k], acc[ai][bj][m][n], 0, 0, 0); __builtin_amdgcn_s_setprio(0); } while (0)
#define PG8_WAIT_V(n) asm volatile("s_waitcnt vmcnt(" #n ")" ::: "memory")
#define PG8_WAIT_L(n) asm volatile("s_waitcnt lgkmcnt(" #n ")" ::: "memory")
#define PG8_BAR __builtin_amdgcn_s_barrier()
#define PG8_SCHED __builtin_amdgcn_sched_barrier(0)
#define PG8_GIDX(dst, u) do { if constexpr (GATHER) { _Pragma("unroll") for (int h = 0; h < 2; ++h) _Pragma("unroll") for (int i = 0; i < 2; ++i) { \
        const int rr = h * HALF + RA[i]; const int tok = rr < (u).nvalid ? (u).gi[rr] : 0; dst[h][i] = (unsigned)(tok * K + CA[i]) * 2u; } } } while (0)
    Unit cur, nxt; int ui = 0;
    if (!S.next(0, cur)) return;
    f32x4 acc[2][2][4][2];
#pragma unroll
    for (int a = 0; a < 2; ++a)
#pragma unroll
        for (int b = 0; b < 2; ++b)
#pragma unroll
            for (int m = 0; m < 4; ++m)
#pragma unroll
                for (int n = 0; n < 2; ++n) acc[a][b][m][n] = (f32x4){0.f, 0.f, 0.f, 0.f};
    bf16x8 At[4][2], B0[2][2], B1[2][2];
    const char* cA = cur.a; const char* cB = cur.b;
    PG8_GIDX(gA, cur);
    PG8_STAGE(PG8_SB(0, 0), cB, voffB); PG8_STAGE_A(PG8_SA(0, 0), cA, 0, false); PG8_STAGE(PG8_SB(0, 1), cB + hstep, voffB); PG8_STAGE_A(PG8_SA(0, 1), cA, 1, false);
    if (wr == 1) PG8_BAR;
    PG8_WAIT_V(4); PG8_BAR;
    PG8_STAGE(PG8_SB(1, 0), cB + kstep, voffB); PG8_STAGE_A(PG8_SA(1, 0), cA + kstep, 0, false); PG8_STAGE(PG8_SB(1, 1), cB + hstep + kstep, voffB);
    PG8_WAIT_V(6); PG8_BAR;
    for (;;) {
        const bool has_next = S.next(ui + 1, nxt);
        const char* nA = has_next ? nxt.a : cA; const char* nB = has_next ? nxt.b : cB;
        if constexpr (GATHER) { if (has_next) { PG8_GIDX(gN, nxt); } else {
#pragma unroll
            for (int h = 0; h < 2; ++h)
#pragma unroll
                for (int i = 0; i < 2; ++i) gN[h][i] = gA[h][i]; } }
        for (int t = 0; t < nt; t += 2) {
            const bool last = (t == nt - 2);
            const char* a1 = cA + (size_t)(t + 1) * kstep;
            const char* a2 = last ? nA : cA + (size_t)(t + 2) * kstep; const char* b2 = last ? nB : cB + (size_t)(t + 2) * kstep;
            const char* a3 = a2 + kstep; const char* b3 = b2 + kstep;
            PG8_LDB(B0, 0, 0); PG8_SCHED; PG8_LDA(At, 0, 0); PG8_STAGE_A(PG8_SA(1, 1), a1, 1, false);
            PG8_WAIT_L(8); PG8_BAR; PG8_WAIT_L(0); PG8_MMA(0, 0, At, B0); PG8_BAR; PG8_SCHED;
            PG8_LDB(B1, 0, 1); PG8_STAGE(PG8_SB(0, 0), b2, voffB);
            PG8_BAR; PG8_WAIT_L(0); PG8_MMA(0, 1, At, B1); PG8_BAR;
            PG8_LDA(At, 0, 1); PG8_STAGE_A(PG8_SA(0, 0), a2, 0, last);
            PG8_BAR; PG8_WAIT_L(0); PG8_MMA(1, 0, At, B0); PG8_BAR; PG8_SCHED;
            PG8_STAGE(PG8_SB(0, 1), b2 + hstep, voffB);
            PG8_WAIT_V(6); PG8_BAR; PG8_MMA(1, 1, At, B1); PG8_BAR;
            PG8_LDB(B0, 1, 0); PG8_SCHED; PG8_LDA(At, 1, 0); PG8_STAGE_A(PG8_SA(0, 1), a2, 1, last);
            PG8_WAIT_L(8); PG8_BAR; PG8_WAIT_L(0); PG8_MMA(0, 0, At, B0); PG8_BAR; PG8_SCHED;
            PG8_LDB(B1, 1, 1); PG8_STAGE(PG8_SB(1, 0), b3, voffB);
            PG8_BAR; PG8_WAIT_L(0); PG8_MMA(0, 1, At, B1); PG8_BAR;
            PG8_LDA(At, 1, 1); PG8_STAGE_A(PG8_SA(1, 0), a3, 0, last);
            PG8_BAR; PG8_WAIT_L(0); PG8_MMA(1, 0, At, B0); PG8_BAR; PG8_SCHED;
            PG8_STAGE(PG8_SB(1, 1), b3 + hstep, voffB);
            PG8_WAIT_V(6); PG8_BAR; PG8_MMA(1, 1, At, B1); PG8_BAR;
        }
        E(acc, cur, wr, wc, fr, fq);
        if (!has_next) break;
#pragma unroll
        for (int a = 0; a < 2; ++a)
#pragma unroll
            for (int b = 0; b < 2; ++b)
#pragma unroll
                for (int m = 0; m < 4; ++m)
#pragma unroll
                    for (int n = 0; n < 2; ++n) acc[a][b][m][n] = (f32x4){0.f, 0.f, 0.f, 0.f};
        cur = nxt; cA = nA; cB = nB; ++ui;
        if constexpr (GATHER) {
#pragma unroll
            for (int h = 0; h < 2; ++h)
#pragma unroll
                for (int i = 0; i < 2; ++i) gA[h][i] = gN[h][i]; }
    }
    PG8_WAIT_V(0);
    if (wr == 0) PG8_BAR;
    PG8_BAR;
#undef PG8_SA
#undef PG8_SB
#undef PG8_STAGE
#undef PG8_STAGE_A
#undef PG8_LDA
#undef PG8_LDB
#undef PG8_MMA
#undef PG8_WAIT_V
#undef PG8_WAIT_L
#undef PG8_BAR
#undef PG8_SCHED
#undef PG8_GIDX
}
}
using pg8::Unit;

#define EPI_LOOP(...) { int fr_ = fr, fq_ = fq; asm volatile("" : "+v"(fr_), "+v"(fq_)); _Pragma("unroll") for (int ai = 0; ai < 2; ++ai) _Pragma("unroll") for (int m = 0; m < 4; ++m) _Pragma("unroll") for (int bj = 0; bj < 2; ++bj) { \
        const int trow = ai * 128 + wr * 64 + m * 16 + fr_; const int tcol = bj * 128 + wc * 32 + fq_ * 8; const f32x4 v0 = acc[ai][bj][m][0], v1 = acc[ai][bj][m][1]; __VA_ARGS__ } }

__device__ __forceinline__ u32x4 pack8(const f32x4 a, const f32x4 b) { u32x4 w; w.x = cvt_pk_bf16(a[0], a[1]); w.y = cvt_pk_bf16(a[2], a[3]); w.z = cvt_pk_bf16(b[0], b[1]); w.w = cvt_pk_bf16(b[2], b[3]); return w; }

struct EpiProj {
    unsigned char* ws; const float* b_gate;
    __device__ __forceinline__ void operator()(const f32x4 (&acc)[2][2][4][2], const Unit& u, int wr, int wc, int fr, int fq) const {
        const int pn = u.pn; const size_t row0 = (size_t)u.pm * 256;
        if (pn == 4 || pn == 9) {
            float* dst = (float*)(ws + (pn == 4 ? WS_CKV : WS_MISC));
            EPI_LOOP({ float* p = dst + (row0 + trow) * 256 + tcol; *(f32x4*)p = v0; *(f32x4*)(p + 4) = v1;
                if (pn == 9 && tcol < 64) *(u32x4*)((bf16_t*)(ws + WS_KIDX) + (row0 + trow) * 64 + tcol) = pack8(v0, v1); })
        } else if (pn < 22) {
            bf16_t* dst; int ct;
            if (pn < 4) { dst = (bf16_t*)(ws + WS_QA); ct = pn; } else if (pn < 9) { dst = (bf16_t*)(ws + WS_QIDX); ct = pn - 5; }
            else if (pn < 14) { dst = (bf16_t*)(ws + WS_QB); ct = pn - 10; } else if (pn < 18) { dst = (bf16_t*)(ws + WS_KB); ct = pn - 14; } else { dst = (bf16_t*)(ws + WS_VB); ct = pn - 18; }
            EPI_LOOP({ *(u32x4*)(dst + (row0 + trow) * 1024 + ct * 256 + tcol) = pack8(v0, v1); })
        } else {
            bf16_t* dst = (bf16_t*)(ws + WS_GATES); const int ct = pn - 22;
            EPI_LOOP({ const int col = ct * 256 + tcol; const f32x4 b0 = *(const f32x4*)(b_gate + col), b1 = *(const f32x4*)(b_gate + col + 4); f32x4 s0, s1;
                _Pragma("unroll") for (int j = 0; j < 4; ++j) { s0[j] = sigmoidf_(v0[j] + b0[j]); s1[j] = sigmoidf_(v1[j] + b1[j]); }
                *(u32x4*)(dst + (row0 + trow) * 4096 + col) = pack8(s0, s1); })
        }
    }
};
struct EpiGate1 {
    const bf16_t* gates; float* T1;
    __device__ __forceinline__ void operator()(const f32x4 (&acc)[2][2][4][2], const Unit& u, int wr, int wc, int fr, int fq) const {
        EPI_LOOP({ const size_t row = (size_t)u.pm * 256 + trow; const int col = u.pn * 256 + tcol; const u32x4 g = *(const u32x4*)(gates + row * 4096 + col);
            f32x4 o0 = {v0[0] * bf_lo(g.x), v0[1] * bf_hi(g.x), v0[2] * bf_lo(g.y), v0[3] * bf_hi(g.y)}; f32x4 o1 = {v1[0] * bf_lo(g.z), v1[1] * bf_hi(g.z), v1[2] * bf_lo(g.w), v1[3] * bf_hi(g.w)};
            float* p = T1 + row * 2048 + col; *(f32x4*)p = o0; *(f32x4*)(p + 4) = o1; })
    }
};
struct EpiGate2 {
    const bf16_t* gates; const float* T1; bf16_t* merged;
    __device__ __forceinline__ void operator()(const f32x4 (&acc)[2][2][4][2], const Unit& u, int wr, int wc, int fr, int fq) const {
        EPI_LOOP({ const size_t row = (size_t)u.pm * 256 + trow; const int col = u.pn * 256 + tcol; const u32x4 g = *(const u32x4*)(gates + row * 4096 + 2048 + col);
            const float* p = T1 + row * 2048 + col; const f32x4 t0 = *(const f32x4*)p, t1 = *(const f32x4*)(p + 4);
            f32x4 o0 = {t0[0] + v0[0] * bf_lo(g.x), t0[1] + v0[1] * bf_hi(g.x), t0[2] + v0[2] * bf_lo(g.y), t0[3] + v0[3] * bf_hi(g.y)};
            f32x4 o1 = {t1[0] + v1[0] * bf_lo(g.z), t1[1] + v1[1] * bf_hi(g.z), t1[2] + v1[2] * bf_lo(g.w), t1[3] + v1[3] * bf_hi(g.w)};
            *(u32x4*)(merged + row * 2048 + col) = pack8(o0, o1); })
    }
};
struct EpiWo {
    const float* x; const float* mod; float* out;
    __device__ __forceinline__ void operator()(const f32x4 (&acc)[2][2][4][2], const Unit& u, int wr, int wc, int fr, int fq) const {
        const float* gt = mod + (size_t)(u.pm >> 3) * 12288 + 4096;
        EPI_LOOP({ const size_t row = (size_t)u.pm * 256 + trow; const int col = u.pn * 256 + tcol; const float* px = x + row * 2048 + col;
            const f32x4 x0 = *(const f32x4*)px, x1 = *(const f32x4*)(px + 4), g0 = *(const f32x4*)(gt + col), g1 = *(const f32x4*)(gt + col + 4);
            float* po = out + row * 2048 + col; *(f32x4*)po = x0 + g0 * v0; *(f32x4*)(po + 4) = x1 + g1 * v1; })
    }
};
struct EpiMoeUp {
    bf16_t* act; const float* lw;
    __device__ __forceinline__ void operator()(const f32x4 (&acc)[2][2][4][2], const Unit& u, int wr, int wc, int fr, int fq) const {
        int fr_ = fr, fq_ = fq; asm volatile("" : "+v"(fr_), "+v"(fq_));
#pragma unroll
        for (int ai = 0; ai < 2; ++ai)
#pragma unroll
            for (int m = 0; m < 4; ++m) {
                const int trow = ai * 128 + wr * 64 + m * 16 + fr_; const int tcol = wc * 32 + fq_ * 8;
                const float gw = trow < u.nvalid ? lw[u.aux + trow] : 0.f;
                const f32x4 a0 = acc[ai][0][m][0], a1 = acc[ai][0][m][1], u0 = acc[ai][1][m][0], u1 = acc[ai][1][m][1]; f32x4 o0, o1;
#pragma unroll
                for (int j = 0; j < 4; ++j) { o0[j] = a0[j] * sigmoidf_(a0[j]) * u0[j] * gw; o1[j] = a1[j] * sigmoidf_(a1[j]) * u1[j] * gw; }
                *(u32x4*)(act + ((size_t)u.pm * 256 + trow) * 512 + u.pn * 128 + tcol) = pack8(o0, o1); SBAR();
            }
    }
};
struct EpiMoeDown {
    float* out; const float* mod;
    __device__ __forceinline__ void operator()(const f32x4 (&acc)[2][2][4][2], const Unit& u, int wr, int wc, int fr, int fq) const {
        EPI_LOOP({ if (trow < u.nvalid) { const int tok = u.gi[trow]; const int col = u.pn * 256 + tcol; const float* gt = mod + (size_t)(tok >> 11) * 12288 + 10240 + col;
            const f32x4 g0 = *(const f32x4*)gt, g1 = *(const f32x4*)(gt + 4); float* po = out + (size_t)tok * 2048 + col;
            _Pragma("unroll") for (int j = 0; j < 4; ++j) { unsafeAtomicAdd(po + j, g0[j] * v0[j]); unsafeAtomicAdd(po + 4 + j, g1[j] * v1[j]); } } })
    }
};

struct MoeOrder {
    const LAS int* pre;
    const LAS int* cnt;
    int G, c, ntn, K; const char* A; const char* Bt; size_t bstride; const int* ltok; bool down;
    __device__ bool next(int i, Unit& u) const {
        const int total = __builtin_amdgcn_readfirstlane(pre[64]) * ntn; const long L = (long)i * G + c; if (L >= total) return false;
        const int l = (int)L; const int mt = l / ntn, pn = l % ntn;
        int e = 0;
#pragma unroll 1
        for (int s = 32; s >= 1; s >>= 1) if (__builtin_amdgcn_readfirstlane(pre[e + s]) <= mt) e += s;
        const int lt = mt - __builtin_amdgcn_readfirstlane(pre[e]);
        u.pm = mt; u.pn = pn; u.aux = e * LCAP + lt * 256; u.gi = ltok + u.aux; { const int rem = __builtin_amdgcn_readfirstlane(cnt[e]) - lt * 256; u.nvalid = rem < 256 ? rem : 256; }
        u.a = down ? A + (size_t)mt * 256 * K * 2 : A; u.b = Bt + (size_t)e * bstride + (size_t)pn * 256 * K * 2; return true;
    }
};

__device__ __forceinline__ int map_row(int map, int n) {
    if (map == 0) return n;
    if (map == 1) { if (n < 2384) return n; if (n < 5456) return n + 176; if (n < 5464) return n - 3072; return n + 168; }
    if (map == 2) return (n >> 7) * 256 + (n & 127);
    return (n >> 7) * 256 + 128 + (n & 127);
}
__device__ void ph0_prologue(const Params& p, LAS unsigned char* lds) {
    const int tid = threadIdx.x, wid = tid >> 6, lane = tid & 63, G = gridDim.x, bx = blockIdx.x;
    if (bx < 192) {
        LAS float* sc = (LAS float*)lds;
        LAS float* red = (LAS float*)(lds + 32768);
        const float* c = p.in[I_C];
        for (int i = tid; i < 4 * 2048; i += NTHREADS) { const float v = c[i]; sc[i] = v / (1.0f + __expf(-v)); }
        __syncthreads();
        for (int item = bx; item < 192; item += G) {
            const int n0 = item * 64, cg = lane & 15, rs = lane >> 4;
            float acc[4][4];
#pragma unroll
            for (int b = 0; b < 4; ++b)
#pragma unroll
                for (int j = 0; j < 4; ++j) acc[b][j] = 0.f;
            const float* w = p.in[I_WADA] + n0 + cg * 4;
#pragma unroll 4
            for (int step = 0; step < 64; ++step) {
                const int k = step * 32 + wid * 4 + rs;
                const f32x4 wv = *(const f32x4*)(w + (size_t)k * 12288);
#pragma unroll
                for (int b = 0; b < 4; ++b) { const float s = sc[b * 2048 + k];
#pragma unroll
                    for (int j = 0; j < 4; ++j) acc[b][j] += s * wv[j]; }
            }
#pragma unroll
            for (int b = 0; b < 4; ++b)
#pragma unroll
                for (int j = 0; j < 4; ++j) { float v = acc[b][j]; v += __shfl_xor(v, 16); v += __shfl_xor(v, 32); acc[b][j] = v; }
            if (rs == 0) {
#pragma unroll
                for (int b = 0; b < 4; ++b)
#pragma unroll
                    for (int j = 0; j < 4; ++j) red[(wid * 16 + cg) * 16 + b * 4 + j] = acc[b][j]; }
            __syncthreads();
            if (tid < 256) { const int cg2 = tid >> 4, bj = tid & 15, b = bj >> 2, j = bj & 3; float s = 0.f;
#pragma unroll
                for (int w8 = 0; w8 < 8; ++w8) s += red[(w8 * 16 + cg2) * 16 + bj];
                const int n = n0 + cg2 * 4 + j; ((float*)(p.ws + WS_MOD))[b * 12288 + n] = s + p.in[I_BADA][n]; }
            __syncthreads();
        }
    }
    { u32x4* z = (u32x4*)(p.ws + WS_WIN + (size_t)2392 * 2048 * 2); const int n16 = 168 * 2048 * 2 / 16;
      for (int i = bx * NTHREADS + tid; i < n16; i += G * NTHREADS) z[i] = (u32x4){0u, 0u, 0u, 0u}; }
    { bf16_t* wh = (bf16_t*)(p.ws + WS_WRH); bf16_t* wl = (bf16_t*)(p.ws + WS_WRL);
      for (int i = bx * NTHREADS + tid; i < 80 * 2048; i += G * NTHREADS) { const int n = i >> 11, k = i & 2047;
          const float v = n < 8 ? p.in[I_WRG][k * 8 + n] : (n < 72 ? p.in[I_WRE][k * 64 + n - 8] : 0.f);
          const unsigned h = cvt_pk_bf16(v, 0.f) & 0xffffu; const unsigned l = cvt_pk_bf16(v - bf_lo(h), 0.f) & 0xffffu; wh[i] = (bf16_t)h; wl[i] = (bf16_t)l; } }
    LAS float* tile = (LAS float*)(lds + 65536);
    for (int ti = bx; ti < p.ntiles_total; ti += G) {
        int j = 0;
#pragma unroll 1
        for (int q = 1; q < NJOBS; ++q) if (ti >= p.jobs[q].tile0) j = q;
        const TJob& J = p.jobs[j];
        int l = ti - J.tile0; const int per = J.ntk * J.ntn; const int bt = l / per; l -= bt * per; const int tn = l / J.ntk, tk = l % J.ntk;
        const float* src = J.src + (size_t)bt * J.sbatch; bf16_t* dst = J.dst + (size_t)bt * J.dbatch;
        const int k0 = tk * 64, n0 = tn * 64;
#pragma unroll
        for (int i = 0; i < 2; ++i) { const int r = (tid >> 4) + 32 * i, c4 = (tid & 15) * 4;
            f32x4 v = {0.f, 0.f, 0.f, 0.f}; if (n0 + c4 < J.N) v = *(const f32x4*)(src + (size_t)(k0 + r) * J.N + n0 + c4);
#pragma unroll
            for (int q = 0; q < 4; ++q) tile[r * 65 + c4 + q] = v[q]; }
        __syncthreads();
        { const int n = tid >> 3, kq = (tid & 7) * 8;
          if (n0 + n < J.N) { float f[8];
#pragma unroll
              for (int q = 0; q < 8; ++q) f[q] = tile[(kq + q) * 65 + n];
              u32x4 w; w.x = cvt_pk_bf16(f[0], f[1]); w.y = cvt_pk_bf16(f[2], f[3]); w.z = cvt_pk_bf16(f[4], f[5]); w.w = cvt_pk_bf16(f[6], f[7]);
              *(u32x4*)(dst + (size_t)map_row(J.map, n0 + n) * J.ldd + k0 + kq) = w; } }
        __syncthreads();
    }
}

__device__ __forceinline__ void norm_row(const float* xr, const float* g, const float* sh, const float* sc, bf16_t* hr, int lane, float (&hv)[32]) {
    f32x4 v[8]; float ss = 0.f;
#pragma unroll
    for (int i = 0; i < 8; ++i) { v[i] = *(const f32x4*)(xr + i * 256 + lane * 4); ss += v[i][0] * v[i][0] + v[i][1] * v[i][1] + v[i][2] * v[i][2] + v[i][3] * v[i][3]; }
    ss = wave_sum(ss);
    const float rstd = rsqrtf(ss * (1.0f / 2048.0f) + RMS_EPS);
#pragma unroll
    for (int i = 0; i < 8; ++i) { const int col = i * 256 + lane * 4; const f32x4 gg = *(const f32x4*)(g + col), s1 = *(const f32x4*)(sc + col), s0 = *(const f32x4*)(sh + col);
#pragma unroll
        for (int j = 0; j < 4; ++j) hv[i * 4 + j] = v[i][j] * rstd * gg[j] * (1.0f + s1[j]) + s0[j];
        u32x2 w; w.x = cvt_pk_bf16(hv[i * 4], hv[i * 4 + 1]); w.y = cvt_pk_bf16(hv[i * 4 + 2], hv[i * 4 + 3]); *(u32x2*)(hr + col) = w; }
}
__device__ void ph1_norm(const Params& p) {
    const int lane = threadIdx.x & 63, gw = blockIdx.x * 8 + (threadIdx.x >> 6), nw = gridDim.x * 8;
    const float* mod = (const float*)(p.ws + WS_MOD);
    for (int t = gw; t < NTOK; t += nw) { const int b = t >> 11; float hv[32];
        norm_row(p.in[I_X] + (size_t)t * DM, p.in[I_GMIX], mod + b * 12288, mod + b * 12288 + 2048, (bf16_t*)(p.ws + WS_H) + (size_t)t * DM, lane, hv); }
}

template <int MB, int NB, int KS>
__device__ __forceinline__ void wave_gemm(const bf16_t* A, int lda, const bf16_t* Bt, int ldb, f32x4 (&acc)[MB][NB], int lane) {
    const int fr = lane & 15, fq = lane >> 4;
#pragma unroll
    for (int mb = 0; mb < MB; ++mb)
#pragma unroll
        for (int nb = 0; nb < NB; ++nb) acc[mb][nb] = (f32x4){0.f, 0.f, 0.f, 0.f};
#pragma unroll 1
    for (int ks = 0; ks < KS; ++ks) {
        bf16x8 af[MB];
#pragma unroll
        for (int mb = 0; mb < MB; ++mb) af[mb] = *(const bf16x8*)(A + (size_t)(mb * 16 + fr) * lda + ks * 32 + fq * 8);
#pragma unroll
        for (int nb = 0; nb < NB; ++nb) { const bf16x8 bf = *(const bf16x8*)(Bt + (size_t)(nb * 16 + fr) * ldb + ks * 32 + fq * 8);
#pragma unroll
            for (int mb = 0; mb < MB; ++mb) acc[mb][nb] = __builtin_amdgcn_mfma_f32_16x16x32_bf16(bf, af[mb], acc[mb][nb], 0, 0, 0); }
    }
}


__device__ __forceinline__ int wave_total_i32(int v) {
    v += __builtin_amdgcn_update_dpp(0, v, 0x111, 0xf, 0xf, true); v += __builtin_amdgcn_update_dpp(0, v, 0x112, 0xf, 0xf, true);
    v += __builtin_amdgcn_update_dpp(0, v, 0x114, 0xf, 0xf, true); v += __builtin_amdgcn_update_dpp(0, v, 0x118, 0xf, 0xf, true);
    v += __builtin_amdgcn_update_dpp(0, v, 0x142, 0xa, 0xf, false); v += __builtin_amdgcn_update_dpp(0, v, 0x143, 0xc, 0xf, false);
    return __builtin_amdgcn_readlane(v, 63);
}
template <int NI> __device__ __forceinline__ unsigned long long topk_words(const LAS float* srow, int c, int lane) {
    unsigned key[NI];
#pragma unroll
    for (int i = 0; i < NI; ++i) { unsigned u = 0u; if (i <= c) { u = __float_as_uint(srow[i * 64 + lane]); u = (u & 0x80000000u) ? ~u : (u | 0x80000000u); } key[i] = u; }
    unsigned v = 0u;
#pragma unroll 1
    for (int bit = 31; bit >= 0; --bit) {
        const unsigned cand = v | (1u << bit); int cl = 0;
#pragma unroll
        for (int i = 0; i < NI; ++i) cl += (key[i] >= cand) ? 1 : 0;
        const int tot = wave_total_i32(cl);
        if (tot >= 256) { v = cand; if (tot == 256) break; }
    }
    unsigned long long myword = 0ull;
#pragma unroll
    for (int i = 0; i < NI; ++i) { const unsigned long long bm = __ballot(key[i] >= v); if (lane == i) myword = bm; if ((i & 3) == 3) SBAR(); }
    return myword;
}
__device__ void idx_item(const Params& p, LAS unsigned char* lds, int b, int c, int sub) {
    const int tid = threadIdx.x, wid = tid >> 6, lane = tid & 63, fr = lane & 15, fq = lane >> 4;
    constexpr int SCLD = 2052;
    LAS float* sc = (LAS float*)lds;
    const int q0 = c * 64 + sub * 16, nk = (c + 1) * 64, nkb = nk / 16;
    const bf16_t* qidx = (const bf16_t*)(p.ws + WS_QIDX) + (size_t)(b * SEQ + q0 + fr) * 1024;
    const float* misc = (const float*)(p.ws + WS_MISC);
    float wq[16];
    { const float* wp = misc + (size_t)(b * SEQ + q0 + fr) * 256 + 64;
#pragma unroll
      for (int i = 0; i < 4; ++i) { const f32x4 v = *(const f32x4*)(wp + i * 4); wq[i * 4] = v[0]; wq[i * 4 + 1] = v[1]; wq[i * 4 + 2] = v[2]; wq[i * 4 + 3] = v[3]; } }
#pragma unroll
    for (int hp = 0; hp < 2; ++hp) {
        bf16x8 qf[8][2];
#pragma unroll
        for (int h = 0; h < 8; ++h)
#pragma unroll
            for (int ks = 0; ks < 2; ++ks) qf[h][ks] = *(const bf16x8*)(qidx + (hp * 8 + h) * 64 + ks * 32 + fq * 8);
        const bf16_t* kbase = (const bf16_t*)(p.ws + WS_KIDX) + (size_t)(b * SEQ + fr) * 64 + fq * 8;
        bf16x8 kf[2];
        if (wid < nkb) { kf[0] = *(const bf16x8*)(kbase + (size_t)wid * 16 * 64); kf[1] = *(const bf16x8*)(kbase + (size_t)wid * 16 * 64 + 32); }
#pragma unroll 1
        for (int kb = wid; kb < nkb; kb += 8) {
            const int kn = kb + 8 < nkb ? kb + 8 : kb;
            const bf16x8 kn0 = *(const bf16x8*)(kbase + (size_t)kn * 16 * 64), kn1 = *(const bf16x8*)(kbase + (size_t)kn * 16 * 64 + 32);
            LAS f32x4* sp = (LAS f32x4*)(sc + fr * SCLD + kb * 16 + fq * 4);
            f32x4 s = {0.f, 0.f, 0.f, 0.f}; if (hp) s = *sp;
#pragma unroll
            for (int h = 0; h < 8; ++h) {
                f32x4 a = {0.f, 0.f, 0.f, 0.f};
                a = __builtin_amdgcn_mfma_f32_16x16x32_bf16(kf[0], qf[h][0], a, 0, 0, 0);
                a = __builtin_amdgcn_mfma_f32_16x16x32_bf16(kf[1], qf[h][1], a, 0, 0, 0);
#pragma unroll
                for (int j = 0; j < 4; ++j) s[j] += wq[hp * 8 + h] * fmaxf(a[j], 0.f);
            }
            *sp = s; kf[0] = kn0; kf[1] = kn1;
        }
    }
    __syncthreads();
    unsigned long long* mask = (unsigned long long*)(p.ws + WS_MASK);
    for (int qq = 0; qq < 2; ++qq) {
        const int ql = wid * 2 + qq; const size_t qg = (size_t)b * SEQ + q0 + ql;
        unsigned long long myword = 0ull;
        if (nk <= 256) { if (lane <= c) myword = ~0ull; }
        else { const LAS float* srow = sc + ql * SCLD;
            if (c < 8) myword = topk_words<8>(srow, c, lane); else if (c < 16) myword = topk_words<16>(srow, c, lane);
            else if (c < 24) myword = topk_words<24>(srow, c, lane); else myword = topk_words<32>(srow, c, lane); }
        if (lane < 32) mask[qg * 32 + lane] = myword;
    }
    __syncthreads();
}
#ifndef REP_SUB
#define REP_SUB 15
#endif
__device__ void ph3_prep(const Params& p, LAS unsigned char* lds, const int rep) {
#define P3ON(bit) (!rep || ((REP_SUB) & (bit)))
    const int tid = threadIdx.x, wid = tid >> 6, lane = tid & 63, bx = blockIdx.x, G = gridDim.x;
    if (P3ON(1)) for (int it = bx; it < 256; it += G) {
        const int b = it >> 6, r = it & 63, cp = r >> 2, sub = r & 3;
        idx_item(p, lds, b, 31 - cp, sub); idx_item(p, lds, b, cp, sub);
    }
    const int gw = bx * 8 + wid, nw = G * 8;
    if (P3ON(2)) for (int it = gw; it < 2048; it += nw) {
        const int rt = it >> 3, h = it & 7, fr = lane & 15, fq = lane >> 4;
        f32x4 acc[2][16];
        wave_gemm<2, 16, 4>((const bf16_t*)(p.ws + WS_QA) + (size_t)rt * 32 * 1024 + h * 128, 1024, (const bf16_t*)(p.ws + WS_WUK) + (size_t)h * 256 * 128, 128, acc, lane);
#pragma unroll
        for (int mb = 0; mb < 2; ++mb) { float ss = 0.f;
#pragma unroll
            for (int nb = 0; nb < 16; ++nb)
#pragma unroll
                for (int j = 0; j < 4; ++j) ss += acc[mb][nb][j] * acc[mb][nb][j];
            ss += __shfl_xor(ss, 16); ss += __shfl_xor(ss, 32);
            const float rs = rsqrtf(ss * (1.0f / 256.0f) + RMS_EPS) * 0.0625f;
            bf16_t* o = (bf16_t*)(p.ws + WS_QLAT) + (size_t)(rt * 32 + mb * 16 + fr) * 2048 + h * 256;
#pragma unroll
            for (int nb = 0; nb < 16; ++nb) { const int col = nb * 16 + fq * 4; const f32x4 g = *(const f32x4*)(p.in[I_GQA] + col);
                u32x2 w; w.x = cvt_pk_bf16(acc[mb][nb][0] * rs * g[0], acc[mb][nb][1] * rs * g[1]); w.y = cvt_pk_bf16(acc[mb][nb][2] * rs * g[2], acc[mb][nb][3] * rs * g[3]); *(u32x2*)(o + col) = w; } }
    }
    if (P3ON(4)) for (int t = gw; t < NTOK; t += nw) {
        { const f32x4 v = *(const f32x4*)((const float*)(p.ws + WS_CKV) + (size_t)t * 256 + lane * 4); float ss = wave_sum(v[0] * v[0] + v[1] * v[1] + v[2] * v[2] + v[3] * v[3]);
          const float rs = rsqrtf(ss * (1.0f / 256.0f) + RMS_EPS); const f32x4 g = *(const f32x4*)(p.in[I_GKV] + lane * 4);
          u32x2 w; w.x = cvt_pk_bf16(v[0] * rs * g[0], v[1] * rs * g[1]); w.y = cvt_pk_bf16(v[2] * rs * g[2], v[3] * rs * g[3]); *(u32x2*)((bf16_t*)(p.ws + WS_KV) + (size_t)t * 256 + lane * 4) = w; }
#pragma unroll
        for (int which = 0; which < 2; ++which) {
            bf16_t* row = (bf16_t*)(p.ws + (which ? WS_KB : WS_QB)) + (size_t)t * 1024 + lane * 16; const float* g = p.in[which ? I_GKB : I_GQB] + (lane & 7) * 16;
            u32x4 a = *(u32x4*)row, c2 = *(u32x4*)(row + 8); float f[16];
            f[0] = bf_lo(a.x); f[1] = bf_hi(a.x); f[2] = bf_lo(a.y); f[3] = bf_hi(a.y); f[4] = bf_lo(a.z); f[5] = bf_hi(a.z); f[6] = bf_lo(a.w); f[7] = bf_hi(a.w);
            f[8] = bf_lo(c2.x); f[9] = bf_hi(c2.x); f[10] = bf_lo(c2.y); f[11] = bf_hi(c2.y); f[12] = bf_lo(c2.z); f[13] = bf_hi(c2.z); f[14] = bf_lo(c2.w); f[15] = bf_hi(c2.w);
            float ss = 0.f;
#pragma unroll
            for (int j = 0; j < 16; ++j) ss += f[j] * f[j];
            ss += __shfl_xor(ss, 1); ss += __shfl_xor(ss, 2); ss += __shfl_xor(ss, 4);
            const float rs = rsqrtf(ss * (1.0f / 128.0f) + RMS_EPS) * (which ? 1.0f : 0.08838834764831845f);
#pragma unroll
            for (int j = 0; j < 16; ++j) f[j] *= rs * g[j];
            a.x = cvt_pk_bf16(f[0], f[1]); a.y = cvt_pk_bf16(f[2], f[3]); a.z = cvt_pk_bf16(f[4], f[5]); a.w = cvt_pk_bf16(f[6], f[7]);
            c2.x = cvt_pk_bf16(f[8], f[9]); c2.y = cvt_pk_bf16(f[10], f[11]); c2.z = cvt_pk_bf16(f[12], f[13]); c2.w = cvt_pk_bf16(f[14], f[15]);
            if (!rep) { *(u32x4*)row = a; *(u32x4*)(row + 8) = c2; } else if (a.x == 0x12345678u) *(u32x4*)row = c2;
        }
    }
    if (P3ON(8) && bx < NBATCH) {
        const int b = bx; const float* fp = (const float*)(p.ws + WS_MISC) + (size_t)(b * SEQ + 4 * tid) * 256 + 80;
        float ls[4][8];
#pragma unroll
        for (int j = 0; j < 4; ++j) { const f32x4 a = *(const f32x4*)(fp + j * 256), c4 = *(const f32x4*)(fp + j * 256 + 4);
#pragma unroll
            for (int h = 0; h < 8; ++h) { const float z = (h < 4 ? a[h & 3] : c4[h & 3]) + p.in[I_BFORGET][h]; ls[j][h] = fminf(z, 0.f) - log1pf(__expf(-fabsf(z))); } }
        LAS float* wt = (LAS float*)lds;
        float off[8];
#pragma unroll
        for (int h = 0; h < 8; ++h) { ls[1][h] += ls[0][h]; ls[2][h] += ls[1][h]; ls[3][h] += ls[2][h];
            float incl = ls[3][h];
#pragma unroll
            for (int o = 1; o < 64; o <<= 1) { const float t2 = __shfl_up(incl, o); if (lane >= o) incl += t2; }
            if (lane == 63) wt[wid * 8 + h] = incl;
            off[h] = incl - ls[3][h]; }
        __syncthreads();
#pragma unroll
        for (int h = 0; h < 8; ++h) { float wo = 0.f; for (int w8 = 0; w8 < wid; ++w8) wo += wt[w8 * 8 + h];
            float* cp = (float*)(p.ws + WS_CUM) + (size_t)(b * 8 + h) * SEQ + 4 * tid;
            *(f32x4*)cp = (f32x4){ls[0][h] + off[h] + wo, ls[1][h] + off[h] + wo, ls[2][h] + off[h] + wo, ls[3][h] + off[h] + wo}; }
        __syncthreads();
    }
}

template <int OFF> __device__ __forceinline__ s16x4 tr_read(int vb) { s16x4 r; asm volatile("ds_read_b64_tr_b16 %0, %1 offset:%2" : "=&v"(r) : "v"(vb), "i"(OFF) : "memory"); return r; }
__device__ __forceinline__ int v_rd_base(int lane) { return ((lane & 3) << 3) | (((lane >> 2) & 3) << 6) | (((lane >> 4) & 1) << 5) | (((lane >> 5) & 1) << 8); }
template <int NCB> __device__ __forceinline__ int v_st(int k, int c) { const int kk = (k & ~0xC) | ((k & 4) << 1) | ((k & 8) >> 1); return ((kk >> 3) * NCB + (c >> 5)) * 512 + ((kk & 7) * 32 + (c & 31)) * 2; }
#define PK4(P, BASE, OUT) do { unsigned a0 = cvt_pk_bf16(P[BASE + 0], P[BASE + 1]), a1 = cvt_pk_bf16(P[BASE + 2], P[BASE + 3]);   \
    unsigned b0 = cvt_pk_bf16(P[BASE + 4], P[BASE + 5]), b1 = cvt_pk_bf16(P[BASE + 6], P[BASE + 7]);                              \
    auto r0 = __builtin_amdgcn_permlane32_swap(a0, b0, false, false); auto r1 = __builtin_amdgcn_permlane32_swap(a1, b1, false, false); \
    u32x4 w = {r0[0], r1[0], r0[1], r1[1]}; OUT = *reinterpret_cast<bf16x8*>(&w); } while (0)
#define PKV(L, H) (bf16x8){L[0], L[1], L[2], L[3], H[0], H[1], H[2], H[3]}
template <int NCB, int D0, int KS> __device__ __forceinline__ void pv_step(f32x16& od, int vb, bf16x8 pa) {
    const s16x4 l = tr_read<D0 * 512 + KS * (2 * NCB * 512)>(vb), h = tr_read<D0 * 512 + KS * (2 * NCB * 512) + NCB * 512>(vb);
    asm volatile("s_waitcnt lgkmcnt(0)" ::: "memory"); SBAR();
    od = __builtin_amdgcn_mfma_f32_32x32x16_bf16(pa, PKV(l, h), od, 0, 0, 0);
}
template <int NCB, int KS0, int D0> struct PvBlocks { static __device__ __forceinline__ void run(f32x16* o, int vb, bf16x8 pa0, bf16x8 pa1) {
    pv_step<NCB, D0, KS0>(o[D0], vb, pa0); pv_step<NCB, D0, KS0 + 1>(o[D0], vb, pa1); if constexpr (D0 + 1 < NCB) PvBlocks<NCB, KS0, D0 + 1>::run(o, vb, pa0, pa1); } };

constexpr int FOX_V = 0, FOX_K = 16384, FOX_CK = 32768, FOX_AL = 33024, FOX_LI = 34048;
__device__ void fox_item(const Params& p, LAS unsigned char* lds, int b, int h, int qb) {
    const int tid = threadIdx.x, wid = tid >> 6, lane = tid & 63, r32 = lane & 31, hi = lane >> 5;
    const bf16_t* Q = (const bf16_t*)(p.ws + WS_QB); const bf16_t* Kg = (const bf16_t*)(p.ws + WS_KB); const bf16_t* Vg = (const bf16_t*)(p.ws + WS_VB);
    const float* cum = (const float*)(p.ws + WS_CUM) + (size_t)(b * 8 + h) * SEQ;
    const int qpos = qb * 256 + wid * 32 + r32;
    bf16x8 qr[8];
    { const bf16_t* qp = Q + (size_t)(b * SEQ + qpos) * 1024 + h * 128 + hi * 8;
#pragma unroll
      for (int d0 = 0; d0 < 8; ++d0) qr[d0] = *(const bf16x8*)(qp + d0 * 16); }
    const float cq = cum[qpos] * LOG2E;
    float m_reg = -1e30f, l_reg = 0.f; f32x16 o[4];
#pragma unroll
    for (int d = 0; d < 4; ++d)
#pragma unroll
        for (int r = 0; r < 16; ++r) o[d][r] = 0.f;
    LAS float* ck = (LAS float*)(lds + FOX_CK); LAS float* al_l = (LAS float*)(lds + FOX_AL) + wid * 32; LAS float* li_l = (LAS float*)(lds + FOX_LI) + wid * 32;
    const int vb = (int)(uintptr_t)(lds + FOX_V) + v_rd_base(lane);
    const int sr = tid >> 4, scol = (tid & 15) * 8;
    const int ntiles = qb * 4 + 4, mylast = qb * 4 + (wid >> 1);
    for (int kt = 0; kt < ntiles; ++kt) {
        __syncthreads();
#pragma unroll
        for (int i = 0; i < 2; ++i) { const int row = sr + 32 * i; const size_t g = (size_t)(b * SEQ + kt * 64 + row) * 1024 + h * 128 + scol;
            const u32x4 kv = *(const u32x4*)(Kg + g), vv = *(const u32x4*)(Vg + g);
            *(LAS u32x4*)(lds + FOX_K + row * 256 + ((scol * 2) ^ ((row & 7) << 4))) = kv; *(LAS u32x4*)(lds + FOX_V + v_st<4>(row, scol)) = vv; }
        if (tid < 64) ck[tid] = cum[kt * 64 + tid] * LOG2E;
        __syncthreads();
        if (kt <= mylast) {
            f32x16 p0, p1;
#pragma unroll
            for (int r = 0; r < 16; ++r) { p0[r] = 0.f; p1[r] = 0.f; }
#pragma unroll
            for (int d0 = 0; d0 < 8; ++d0) { const int cb = (d0 * 16 + hi * 8) * 2;
                const bf16x8 b0 = *(const LAS bf16x8*)(lds + FOX_K + r32 * 256 + (cb ^ ((r32 & 7) << 4)));
                const bf16x8 b1 = *(const LAS bf16x8*)(lds + FOX_K + (32 + r32) * 256 + (cb ^ ((r32 & 7) << 4)));
                p0 = __builtin_amdgcn_mfma_f32_32x32x16_bf16(b0, qr[d0], p0, 0, 0, 0); p1 = __builtin_amdgcn_mfma_f32_32x32x16_bf16(b1, qr[d0], p1, 0, 0, 0); }
            const bool diag = (kt * 64 + 63 > qb * 256 + wid * 32);
            float pmax = -INFINITY;
#pragma unroll
            for (int g4 = 0; g4 < 4; ++g4) { const f32x4 c0 = *(const LAS f32x4*)(ck + 8 * g4 + 4 * hi), c1 = *(const LAS f32x4*)(ck + 32 + 8 * g4 + 4 * hi);
#pragma unroll
                for (int j = 0; j < 4; ++j) { const int r = g4 * 4 + j; float t0 = fmaf(p0[r], LOG2E, cq) - c0[j], t1 = fmaf(p1[r], LOG2E, cq) - c1[j];
                    if (diag) { const int kp = kt * 64 + crow(r, hi); if (kp > qpos) t0 = -INFINITY; if (kp + 32 > qpos) t1 = -INFINITY; }
                    p0[r] = t0; p1[r] = t1; pmax = fmaxf(pmax, fmaxf(t0, t1)); } }
            { auto rr = __builtin_amdgcn_permlane32_swap(__float_as_uint(pmax), __float_as_uint(pmax), false, false); pmax = fmaxf(__uint_as_float(rr[0]), __uint_as_float(rr[1])); }
            const float mn = fmaxf(m_reg, pmax); const float alpha = __builtin_amdgcn_exp2f(m_reg - mn); m_reg = mn;
            float ps = 0.f;
#pragma unroll
            for (int r = 0; r < 16; ++r) { p0[r] = __builtin_amdgcn_exp2f(p0[r] - mn); p1[r] = __builtin_amdgcn_exp2f(p1[r] - mn); ps += p0[r] + p1[r]; }
            { auto rr = __builtin_amdgcn_permlane32_swap(__float_as_uint(ps), __float_as_uint(ps), false, false); ps = __uint_as_float(rr[0]) + __uint_as_float(rr[1]); }
            l_reg = l_reg * alpha + ps;
            if (__any(alpha < 1.f)) { if (hi == 0) al_l[r32] = alpha; asm volatile("s_waitcnt lgkmcnt(0)" ::: "memory");
#pragma unroll
                for (int r = 0; r < 16; ++r) { const float a = al_l[crow(r, hi)];
#pragma unroll
                    for (int d = 0; d < 4; ++d) o[d][r] *= a; } }
            bf16x8 pa0, pa1, pa2, pa3; PK4(p0, 0, pa0); PK4(p0, 8, pa1); PK4(p1, 0, pa2); PK4(p1, 8, pa3);
            PvBlocks<4, 0, 0>::run(o, vb, pa0, pa1); PvBlocks<4, 2, 0>::run(o, vb, pa2, pa3);
        }
    }
    if (hi == 0) li_l[r32] = l_reg; asm volatile("s_waitcnt lgkmcnt(0)" ::: "memory");
    bf16_t* O = (bf16_t*)(p.ws + WS_OB) + (size_t)(b * SEQ + qb * 256 + wid * 32) * 1024 + h * 128;
#pragma unroll
    for (int r = 0; r < 16; ++r) { const float rl = __builtin_amdgcn_rcpf(li_l[crow(r, hi)]); const int orow = crow(r, hi);
#pragma unroll
        for (int d0 = 0; d0 < 4; ++d0) O[(size_t)orow * 1024 + d0 * 32 + r32] = (bf16_t)(cvt_pk_bf16(o[d0][r] * rl, 0.f) & 0xffffu); }
}

constexpr int DSA_V = 0, DSA_K = 32768, DSA_AL = 65536, DSA_LI = 66560, DSA_Q = 67584;
__device__ void dsa_item(const Params& p, LAS unsigned char* lds, int b, int qt) {
    const int tid = threadIdx.x, wid = tid >> 6, lane = tid & 63, r32 = lane & 31, hi = lane >> 5, h = wid;
    const bf16_t* KV = (const bf16_t*)(p.ws + WS_KV) + (size_t)b * SEQ * 256;
    const int qpos = qt * 32 + r32; const size_t qg = (size_t)b * SEQ + qpos;
    const unsigned* mask = (const unsigned*)(p.ws + WS_MASK) + qg * 64;
    bf16x8 qr[8];
    LAS unsigned char* qlds = lds + DSA_Q + wid * 8192 + lane * 16;
    __syncthreads();
    { const bf16_t* qp = (const bf16_t*)(p.ws + WS_QLAT) + qg * 2048 + h * 256 + hi * 8;
#pragma unroll
      for (int d0 = 0; d0 < 8; ++d0) qr[d0] = *(const bf16x8*)(qp + d0 * 16);
#pragma unroll
      for (int d0 = 8; d0 < 16; ++d0) *(LAS bf16x8*)(qlds + (d0 - 8) * 1024) = *(const bf16x8*)(qp + d0 * 16); }
    const float slopeL = exp2f(-(float)(h + 1)) * LOG2E;
    float m_reg = -1e30f, l_reg = 0.f; f32x16 o[8];
#pragma unroll
    for (int d = 0; d < 8; ++d)
#pragma unroll
        for (int r = 0; r < 16; ++r) o[d][r] = 0.f;
    LAS float* al_l = (LAS float*)(lds + DSA_AL) + wid * 32; LAS float* li_l = (LAS float*)(lds + DSA_LI) + wid * 32;
    const int vb = (int)(uintptr_t)(lds + DSA_V) + v_rd_base(lane);
    const int ntiles = (qt >> 1) + 1;
    for (int kt = 0; kt < ntiles; ++kt) {
        __syncthreads();
#pragma unroll
        for (int i = 0; i < 4; ++i) { const int row = (tid >> 5) + 16 * i, col = (tid & 31) * 8;
            const u32x4 v = *(const u32x4*)(KV + (size_t)(kt * 64 + row) * 256 + col);
            *(LAS u32x4*)(lds + DSA_K + row * 512 + ((col * 2) ^ ((row & 15) << 4))) = v; *(LAS u32x4*)(lds + DSA_V + v_st<8>(row, col)) = v; }
        const u32x2 mw = *(const u32x2*)(mask + kt * 2);
        __syncthreads();
#pragma unroll
        for (int half = 0; half < 2; ++half) {
            f32x16 pp;
#pragma unroll
            for (int r = 0; r < 16; ++r) pp[r] = 0.f;
#pragma unroll
            for (int d0 = 0; d0 < 16; ++d0) { const int cb = (d0 * 16 + hi * 8) * 2; const int row = half * 32 + r32;
                const bf16x8 kf = *(const LAS bf16x8*)(lds + DSA_K + row * 512 + (cb ^ ((row & 15) << 4)));
                bf16x8 qf; if (d0 < 8) qf = qr[d0 & 7]; else qf = *(const LAS bf16x8*)(qlds + (d0 - 8) * 1024);
                pp = __builtin_amdgcn_mfma_f32_32x32x16_bf16(kf, qf, pp, 0, 0, 0); if ((d0 & 1) == 1) SBAR(); }
            const unsigned wsh = (half ? mw.y : mw.x) >> (4 * hi);
            const float df = (float)(qpos - (kt * 64 + half * 32 + 4 * hi));
            float pmax = -INFINITY;
#pragma unroll
            for (int r = 0; r < 16; ++r) { const int cb = (r & 3) + 8 * (r >> 2); const float dd = df - (float)cb;
                float t = fmaf(-slopeL, fabsf(dd), pp[r] * LOG2E); if (!((wsh >> cb) & 1u)) t = -INFINITY; pp[r] = t; pmax = fmaxf(pmax, t); }
            { auto rr = __builtin_amdgcn_permlane32_swap(__float_as_uint(pmax), __float_as_uint(pmax), false, false); pmax = fmaxf(__uint_as_float(rr[0]), __uint_as_float(rr[1])); }
            const float mn = fmaxf(m_reg, pmax); const float alpha = __builtin_amdgcn_exp2f(m_reg - mn); m_reg = mn;
            float ps = 0.f;
#pragma unroll
            for (int r = 0; r < 16; ++r) { pp[r] = __builtin_amdgcn_exp2f(pp[r] - mn); ps += pp[r]; }
            { auto rr = __builtin_amdgcn_permlane32_swap(__float_as_uint(ps), __float_as_uint(ps), false, false); ps = __uint_as_float(rr[0]) + __uint_as_float(rr[1]); }
            l_reg = l_reg * alpha + ps;
            if (__any(alpha < 1.f)) { if (hi == 0) al_l[r32] = alpha; asm volatile("s_waitcnt lgkmcnt(0)" ::: "memory");
#pragma unroll
                for (int r = 0; r < 16; ++r) { const float a = al_l[crow(r, hi)];
#pragma unroll
                    for (int d = 0; d < 8; ++d) o[d][r] *= a; } }
            bf16x8 pa0, pa1; PK4(pp, 0, pa0); PK4(pp, 8, pa1);
            if (half == 0) PvBlocks<8, 0, 0>::run(o, vb, pa0, pa1); else PvBlocks<8, 2, 0>::run(o, vb, pa0, pa1);
        }
    }
    if (hi == 0) li_l[r32] = l_reg; asm volatile("s_waitcnt lgkmcnt(0)" ::: "memory");
    bf16_t* O = (bf16_t*)(p.ws + WS_OLAT) + ((size_t)b * SEQ + qt * 32) * 2048 + h * 256;
#pragma unroll
    for (int r = 0; r < 16; ++r) { const float rl = __builtin_amdgcn_rcpf(li_l[crow(r, hi)]); const int orow = crow(r, hi);
#pragma unroll
        for (int d0 = 0; d0 < 8; ++d0) O[(size_t)orow * 2048 + d0 * 32 + r32] = (bf16_t)(cvt_pk_bf16(o[d0][r] * rl, 0.f) & 0xffffu); }
}
__device__ void ph4_attn(const Params& p, LAS unsigned char* lds) {
    const int r = blockIdx.x;
    if (r < 256) { const int c = 31 - (r >> 3), w8 = r & 7, b = w8 >> 1, half = w8 & 1; dsa_item(p, lds, b, c * 2 + half); }
    __syncthreads();
    if (r < 256) { const int qb = r >> 5, bh = r & 31; fox_item(p, lds, bh >> 3, bh & 7, qb); }
}

__device__ void ph5_oa(const Params& p) {
    const int lane = threadIdx.x & 63, gw = blockIdx.x * 8 + (threadIdx.x >> 6), nw = gridDim.x * 8, fr = lane & 15, fq = lane >> 4;
    for (int it = gw; it < 2048; it += nw) {
        const int rt = it >> 3, h = it & 7;
        f32x4 acc[2][8];
        wave_gemm<2, 8, 8>((const bf16_t*)(p.ws + WS_OLAT) + (size_t)rt * 32 * 2048 + h * 256, 2048, (const bf16_t*)(p.ws + WS_WUV) + (size_t)h * 128 * 256, 256, acc, lane);
#pragma unroll
        for (int mb = 0; mb < 2; ++mb) { bf16_t* o = (bf16_t*)(p.ws + WS_OA) + (size_t)(rt * 32 + mb * 16 + fr) * 1024 + h * 128;
#pragma unroll
            for (int nb = 0; nb < 8; ++nb) { u32x2 w; w.x = cvt_pk_bf16(acc[mb][nb][0], acc[mb][nb][1]); w.y = cvt_pk_bf16(acc[mb][nb][2], acc[mb][nb][3]); *(u32x2*)(o + nb * 16 + fq * 4) = w; } }
    }
}

__device__ void ph8_router(const Params& p, LAS unsigned char* lds, const int rep) {
    const int tid = threadIdx.x, wid = tid >> 6, lane = tid & 63, fr = lane & 15, fq = lane >> 4;
    const float* mod = (const float*)(p.ws + WS_MOD);
    bf16_t* H = (bf16_t*)(p.ws + WS_H); bf16_t* HL = (bf16_t*)(p.ws + WS_HLO);
    int* cnt = (int*)(p.ws + WS_CNT) + rep * 256; int* ltok = rep ? (int*)(p.ws + WS_T1) : (int*)(p.ws + WS_LTOK); float* lw = rep ? (float*)(p.ws + WS_T1 + (4u << 20)) : (float*)(p.ws + WS_LW);
    LAS float* slab = (LAS float*)lds + wid * 2560;
    LAS float* lg = (LAS float*)lds + 8 * 2560;
    for (int blk = blockIdx.x; blk < NTOK / 32; blk += gridDim.x) {
        const int t0 = blk * 32;
        for (int rr = 0; rr < 4; ++rr) { const int t = t0 + wid * 4 + rr, b = t >> 11; float hv[32];
            norm_row(p.out + (size_t)t * DM, p.in[I_GFFN], mod + b * 12288 + 6144, mod + b * 12288 + 8192, H + (size_t)t * DM, lane, hv);
#pragma unroll
            for (int i = 0; i < 8; ++i) { float lo[4];
#pragma unroll
                for (int j = 0; j < 4; j += 2) { const unsigned w = cvt_pk_bf16(hv[i * 4 + j], hv[i * 4 + j + 1]); lo[j] = hv[i * 4 + j] - bf_lo(w); lo[j + 1] = hv[i * 4 + j + 1] - bf_hi(w); }
                u32x2 w2; w2.x = cvt_pk_bf16(lo[0], lo[1]); w2.y = cvt_pk_bf16(lo[2], lo[3]); *(u32x2*)(HL + (size_t)t * DM + i * 256 + lane * 4) = w2; } }
        asm volatile("s_waitcnt vmcnt(0)" ::: "memory");
        __syncthreads();
        {
            const bf16_t* Ah = H + (size_t)(t0 + fr) * DM + wid * 256 + fq * 8; const bf16_t* Al = HL + (size_t)(t0 + fr) * DM + wid * 256 + fq * 8;
            const bf16_t* Wh = (const bf16_t*)(p.ws + WS_WRH) + (size_t)fr * DM + wid * 256 + fq * 8; const bf16_t* Wl = (const bf16_t*)(p.ws + WS_WRL) + (size_t)fr * DM + wid * 256 + fq * 8;
            f32x4 acc[2][5];
#pragma unroll
            for (int mb = 0; mb < 2; ++mb)
#pragma unroll
                for (int nb = 0; nb < 5; ++nb) acc[mb][nb] = (f32x4){0.f, 0.f, 0.f, 0.f};
#pragma unroll 2
            for (int ks = 0; ks < 8; ++ks) {
                bf16x8 ah[2], al[2];
#pragma unroll
                for (int mb = 0; mb < 2; ++mb) { ah[mb] = *(const bf16x8*)(Ah + (size_t)mb * 16 * DM + ks * 32); al[mb] = *(const bf16x8*)(Al + (size_t)mb * 16 * DM + ks * 32); }
#pragma unroll
                for (int nb = 0; nb < 5; ++nb) { const bf16x8 wh = *(const bf16x8*)(Wh + (size_t)nb * 16 * DM + ks * 32), wl = *(const bf16x8*)(Wl + (size_t)nb * 16 * DM + ks * 32);
#pragma unroll
                    for (int mb = 0; mb < 2; ++mb) {
                        acc[mb][nb] = __builtin_amdgcn_mfma_f32_16x16x32_bf16(wh, ah[mb], acc[mb][nb], 0, 0, 0);
                        acc[mb][nb] = __builtin_amdgcn_mfma_f32_16x16x32_bf16(wl, ah[mb], acc[mb][nb], 0, 0, 0);
                        acc[mb][nb] = __builtin_amdgcn_mfma_f32_16x16x32_bf16(wh, al[mb], acc[mb][nb], 0, 0, 0); } }
            }
#pragma unroll
            for (int mb = 0; mb < 2; ++mb)
#pragma unroll
                for (int nb = 0; nb < 5; ++nb) *(LAS f32x4*)(slab + (mb * 16 + fr) * 80 + nb * 16 + fq * 4) = acc[mb][nb];
        }
        __syncthreads();
        for (int o = tid; o < 2560; o += NTHREADS) { float s = 0.f;
#pragma unroll
            for (int w8 = 0; w8 < 8; ++w8) s += ((LAS float*)lds)[w8 * 2560 + o];
            lg[o] = s; }
        __syncthreads();
        if (tid < 32) {
            const int t = t0 + tid; const LAS float* L = lg + tid * 80;
            float gl[8]; int gi = 0; float gm = -INFINITY;
#pragma unroll
            for (int g = 0; g < 8; ++g) { gl[g] = L[g] + p.in[I_BRG][g]; if (gl[g] > gm) { gm = gl[g]; gi = g; } }
            float se = 0.f;
#pragma unroll
            for (int g = 0; g < 8; ++g) se += __expf(gl[g] - gm);
            const float gwt = 1.0f / se;
            float v1 = -INFINITY, v2 = -INFINITY; int i1 = 0, i2 = 0;
            for (int e = 0; e < 8; ++e) { const float v = L[8 + gi * 8 + e] + p.in[I_BRE][gi * 8 + e];
                if (v > v1) { v2 = v1; i2 = i1; v1 = v; i1 = e; } else if (v > v2) { v2 = v; i2 = e; } }
            const float e2 = __expf(v2 - v1); const float p1 = gwt / (1.0f + e2), p2 = gwt * e2 / (1.0f + e2);
            const int ea = gi * 8 + i1, eb = gi * 8 + i2;
            const int pa = atomicAdd(cnt + ea, 1); ltok[ea * LCAP + pa] = t; lw[ea * LCAP + pa] = p1;
            const int pb = atomicAdd(cnt + eb, 1); ltok[eb * LCAP + pb] = t; lw[eb * LCAP + pb] = p2;
        }
        __syncthreads();
    }
}

__device__ __forceinline__ void moe_table(const Params& p, LAS unsigned char* lds) {
    LAS int* pre = (LAS int*)(lds + LDS_TAB);
    if (threadIdx.x == 0) { const int* cnt = (const int*)(p.ws + WS_CNT); int s = 0; for (int e = 0; e < 64; ++e) { const int ce = cnt[e]; pre[e] = s; pre[80 + e] = ce; s += (ce + 255) >> 8; } pre[64] = s; }
    __syncthreads();
}
__device__ void ph9_gather(const Params& p, LAS unsigned char* lds) {
    moe_table(p, lds);
    const LAS int* pre = (const LAS int*)(lds + LDS_TAB); const LAS int* cnt = pre + 80; const int* ltok = (const int*)(p.ws + WS_LTOK);
    const int lane = threadIdx.x & 63, gw = blockIdx.x * 8 + (threadIdx.x >> 6), nw = gridDim.x * 8, nrows = pre[64] * 256;
    const bf16_t* H = (const bf16_t*)(p.ws + WS_H); bf16_t* HG = (bf16_t*)(p.ws + WS_HG);
    for (int r = gw; r < nrows; r += nw) {
        const int mt = r >> 8; int e = 0;
#pragma unroll 1
        for (int s = 32; s >= 1; s >>= 1) if (pre[e + s] <= mt) e += s;
        const int pos = (mt - pre[e]) * 256 + (r & 255);
        u32x4 v[4];
        if (pos < cnt[e]) { const int tok = ltok[e * LCAP + pos];
#pragma unroll
            for (int i = 0; i < 4; ++i) v[i] = *(const u32x4*)(H + (size_t)tok * DM + i * 512 + lane * 8); }
        else {
#pragma unroll
            for (int i = 0; i < 4; ++i) v[i] = (u32x4){0u, 0u, 0u, 0u}; }
#pragma unroll
        for (int i = 0; i < 4; ++i) *(u32x4*)(HG + (size_t)r * DM + i * 512 + lane * 8) = v[i];
    }
}


#define MOE_GLOAD(dst, ptr) asm volatile("global_load_dwordx4 %0, %1, off" : "=v"(dst) : "v"(ptr) : "memory")
template <bool UP>
__device__ void moe_gemm(const Params& p, LAS unsigned char* lds, const int rep) {
    constexpr int K = UP ? 2048 : 512, NKT = K / 32, NS = UP ? 8 : 16, LDW = UP ? 512 : 2048;
    constexpr int OFF_A = 0, OFF_B = 98304;
    const int tid = threadIdx.x, w = __builtin_amdgcn_readfirstlane(tid >> 6), l = tid & 63, r32 = l & 31, hi = l >> 5;
    LAS int* tab = (LAS int*)(lds + LDS_TAB);
    if (tid == 0) { const int* cnt = (const int*)(p.ws + WS_CNT); int s = 0, ro = 0; for (int e = 0; e < 64; ++e) { const int ce = cnt[e]; tab[e] = s; tab[80 + e] = ce; tab[160 + e] = ro; ro += ce; const int np = (ce + 511) >> 9; s += np > 0 ? np : 1; } tab[64] = s; }
    __syncthreads();
    const int total = __builtin_amdgcn_readfirstlane(tab[64]) * NS;
    const int q = (w & 3) * 8 + (l & 7), g = (w >> 2) * 8 + (l >> 3);
    const unsigned bwoff = (unsigned)(q * 256 + (((g >> 2) ^ (q & 3)) * 16) + (g & 3) * 4);
    const unsigned frag_sw = (unsigned)((r32 >> 2) & 3);
    const int* ltok = (const int*)(p.ws + WS_LTOK); const float* lw = (const float*)(p.ws + WS_LW);
    for (int unit = blockIdx.x; unit < total; unit += gridDim.x) {
        const int pm = unit / NS, ns = unit - pm * NS; int e = 0;
#pragma unroll 1
        for (int s = 32; s >= 1; s >>= 1) if (__builtin_amdgcn_readfirstlane(tab[e + s]) <= pm) e += s;
        const int mp = pm - __builtin_amdgcn_readfirstlane(tab[e]); const int cnt_e = __builtin_amdgcn_readfirstlane(tab[80 + e]), rowoff = __builtin_amdgcn_readfirstlane(tab[160 + e]);
        int nrows = cnt_e - mp * 512; nrows = nrows > 512 ? 512 : nrows; const bool two = nrows > 256;
        const char* abase = UP ? (const char*)(p.ws + WS_H) : (const char*)(p.ws + WS_ACT);
        unsigned aoff[4];
#pragma unroll
        for (int i = 0; i < 4; ++i) { const int row = ((i >> 1) * 16 + 2 * w + (i & 1)) * 16 + (l >> 2); const int c = (l & 3) ^ ((l >> 4) & 3);
            int src; if (UP) src = row < nrows ? ltok[e * LCAP + mp * 512 + row] : 0; else src = rowoff + mp * 512 + (row < nrows ? row : 0);
            aoff[i] = (unsigned)(src * K + c * 8) * 2u; }
        const float* bsrc = UP ? (q < 16 ? p.in[I_W1] : p.in[I_W3]) + (size_t)e * 2048 * 512 + ns * 64 + (q & 15) * 4 + (size_t)(2 * g) * LDW
                               : p.in[I_W2] + (size_t)e * 512 * 2048 + ns * 128 + q * 4 + (size_t)(2 * g) * LDW;
        f32x16 acc[2][4];
#pragma unroll
        for (int a = 0; a < 2; ++a)
#pragma unroll
            for (int b = 0; b < 4; ++b)
#pragma unroll
                for (int r = 0; r < 16; ++r) acc[a][b][r] = 0.f;
        f32x4 br[4][2];
#define MOE_ISSUE_B(j, t) do { const int tt_ = (t) < NKT ? (t) : NKT - 1; const float* bp_ = bsrc + (size_t)tt_ * 32 * LDW; MOE_GLOAD(br[j][0], bp_); MOE_GLOAD(br[j][1], bp_ + LDW); } while (0)
#define MOE_ISSUE_A(t) do { int tt_ = (t) < 0 ? 0 : (t); const int bi_ = (tt_ % 3); tt_ = tt_ < NKT ? tt_ : NKT - 1; const char* ap_ = abase + (size_t)tt_ * 64; \
        LAS unsigned char* ab_ = lds + OFF_A + bi_ * 32768 + 2 * w * 1024; \
        __builtin_amdgcn_global_load_lds((const unsigned*)(ap_ + aoff[0]), (LAS unsigned*)(ab_), 16, 0, 0); __builtin_amdgcn_global_load_lds((const unsigned*)(ap_ + aoff[1]), (LAS unsigned*)(ab_ + 1024), 16, 0, 0); \
        __builtin_amdgcn_global_load_lds((const unsigned*)(ap_ + aoff[2]), (LAS unsigned*)(ab_ + 16384), 16, 0, 0); __builtin_amdgcn_global_load_lds((const unsigned*)(ap_ + aoff[3]), (LAS unsigned*)(ab_ + 16384 + 1024), 16, 0, 0); } while (0)
        MOE_ISSUE_B(0, 0); MOE_ISSUE_A(-2); MOE_ISSUE_B(1, 1); MOE_ISSUE_A(-1); MOE_ISSUE_B(2, 2); MOE_ISSUE_A(0); MOE_ISSUE_B(3, 3); MOE_ISSUE_A(1);
#define MOE_ITER(j, t) do { \
        asm volatile("s_waitcnt vmcnt(22)" : "+v"(br[j][0]), "+v"(br[j][1]) :: "memory"); \
        { LAS unsigned char* bb_ = lds + OFF_B + ((t) & 1) * 8192 + bwoff; _Pragma("unroll") for (int jj = 0; jj < 4; ++jj) *(LAS unsigned*)(bb_ + jj * 64) = cvt_pk_bf16(br[j][0][jj], br[j][1][jj]); } \
        MOE_ISSUE_B(j, (t) + 4); \
        asm volatile("s_waitcnt vmcnt(8)" ::: "memory"); \
        asm volatile("s_waitcnt lgkmcnt(0)" ::: "memory"); __builtin_amdgcn_s_barrier(); asm volatile("" ::: "memory"); \
        MOE_ISSUE_A((t) + 2); \
        { const LAS unsigned char* ab_ = lds + OFF_A + ((t) % 3) * 32768 + (32 * w + r32) * 64; const LAS unsigned char* bb_ = lds + OFF_B + ((t) & 1) * 8192 + r32 * 64; \
          _Pragma("unroll") for (int ks = 0; ks < 2; ++ks) { const unsigned co_ = ((unsigned)(ks * 2 + hi) ^ frag_sw) * 16u; \
            bf16x8 bf_[4]; _Pragma("unroll") for (int nb = 0; nb < 4; ++nb) bf_[nb] = *(const LAS bf16x8*)(bb_ + nb * 2048 + co_); \
            const bf16x8 a0_ = *(const LAS bf16x8*)(ab_ + co_); \
            _Pragma("unroll") for (int nb = 0; nb < 4; ++nb) acc[0][nb] = UP ? __builtin_amdgcn_mfma_f32_32x32x16_bf16(bf_[nb], a0_, acc[0][nb], 0, 0, 0) : __builtin_amdgcn_mfma_f32_32x32x16_bf16(a0_, bf_[nb], acc[0][nb], 0, 0, 0); \
            if (two) { const bf16x8 a1_ = *(const LAS bf16x8*)(ab_ + 16384 + co_); \
              _Pragma("unroll") for (int nb = 0; nb < 4; ++nb) acc[1][nb] = UP ? __builtin_amdgcn_mfma_f32_32x32x16_bf16(bf_[nb], a1_, acc[1][nb], 0, 0, 0) : __builtin_amdgcn_mfma_f32_32x32x16_bf16(a1_, bf_[nb], acc[1][nb], 0, 0, 0); } } } \
        } while (0)
#pragma unroll 1
        for (int t = 0; t < NKT; t += 4) { MOE_ITER(0, t); MOE_ITER(1, t + 1); MOE_ITER(2, t + 2); MOE_ITER(3, t + 3); }
        asm volatile("s_waitcnt vmcnt(0)" ::: "memory");
        if constexpr (UP) {
#pragma unroll
            for (int mt = 0; mt < 2; ++mt) {
                const int rl = mt * 256 + 32 * w + r32;
                if (rl < nrows) {
                    const float gw = lw[e * LCAP + mp * 512 + rl]; bf16_t* orow = (bf16_t*)(p.ws + WS_ACT) + (size_t)(rowoff + mp * 512 + rl) * 512 + ns * 64 + 4 * hi;
#pragma unroll
                    for (int nb = 0; nb < 2; ++nb)
#pragma unroll
                        for (int g4 = 0; g4 < 4; ++g4) { float o[4];
#pragma unroll
                            for (int j = 0; j < 4; ++j) { const float a = acc[mt][nb][g4 * 4 + j], u = acc[mt][nb + 2][g4 * 4 + j]; o[j] = a * sigmoidf_(a) * u * gw; }
                            u32x2 pk; pk.x = cvt_pk_bf16(o[0], o[1]); pk.y = cvt_pk_bf16(o[2], o[3]); *(u32x2*)(orow + nb * 32 + g4 * 8) = pk; }
                }
            }
        } else {
            LAS float* gtl = (LAS float*)(lds + LDS_TAB + 1024); LAS int* tokl = (LAS int*)(lds + LDS_TAB + 1024 + 2048) + w * 64;
            gtl[tid] = ((const float*)(p.ws + WS_MOD))[(size_t)(tid >> 7) * 12288 + 10240 + ns * 128 + (tid & 127)];
            { const int rl = hi * 256 + 32 * w + r32; tokl[l] = rl < nrows ? ltok[e * LCAP + mp * 512 + rl] : -1; }
            __syncthreads();
            float* obase = (rep ? (float*)(p.ws + WS_T1) : p.out) + ns * 128 + r32;
#pragma unroll
            for (int mt = 0; mt < 2; ++mt) {
                if (mt * 256 + 32 * w < nrows) {
#pragma unroll
                    for (int r = 0; r < 16; ++r) { const int tok = tokl[mt * 32 + crow(r, hi)];
                        if (tok >= 0) { float* orow = obase + (size_t)tok * 2048; const LAS float* gt = gtl + (tok >> 11) * 128 + r32;
#pragma unroll
                            for (int nb = 0; nb < 4; ++nb) unsafeAtomicAdd(orow + nb * 32, gt[nb * 32] * acc[mt][nb][r]); } }
                }
            }
        }
        asm volatile("s_waitcnt vmcnt(0)" ::: "memory");
        __syncthreads();
    }
#undef MOE_ISSUE_A
#undef MOE_ISSUE_B
#undef MOE_ITER
}

__global__ void __launch_bounds__(NTHREADS, 2) mk_fwd(Params p) {
    extern __shared__ __attribute__((aligned(16))) unsigned char shm[];
    LAS unsigned char* lds = (LAS unsigned char*)shm;
    const int lo = p.ph_lo, hi = p.ph_hi;
    if (threadIdx.x < 4) ((LAS unsigned*)(lds + LDS_BARW))[threadIdx.x] = 0u;
    __syncthreads();
    XcdBarrier bar; bar.bar = (unsigned*)(p.ws + WS_BAR); bar.x = 0; bar.st = nullptr;
    if (hi - lo > 1) bar = xcd_barrier_post((unsigned*)(p.ws + WS_BAR), (volatile LAS unsigned*)(lds + LDS_BARW));
#ifndef SKIP_MASK
#define SKIP_MASK 0
#endif
#define IN(k) (!((SKIP_MASK >> (k)) & 1) && lo <= (k) && (k) < hi)
#define SEAM(k) do { if (IN(k) && IN((k) + 1)) xcd_barrier(bar); } while (0)
    const int G = gridDim.x, bx = blockIdx.x;
#ifndef REP_PHASE
#define REP_PHASE 0
#endif
#define RUN(k, ...) do { if (IN(k)) { { const int rep = 0; (void)rep; __VA_ARGS__ } if ((REP_PHASE >> (k)) & 1) { xcd_barrier(bar); { const int rep = 1; (void)rep; __VA_ARGS__ } } } SEAM(k); } while (0)
    RUN(0, ph0_prologue(p, lds););
    RUN(1, ph1_norm(p););
    RUN(2, pg8::StaticOrder S; S.init(p.ws + WS_H, p.ws + WS_WIN, NTOK, DINP, DM, G, bx); EpiProj E{p.ws, p.in[I_BGATE]};
           pg8::gemm_phase<EpiProj, pg8::StaticOrder, false>(lds, DM, S, E););
    RUN(3, ph3_prep(p, lds, rep););
    RUN(4, ph4_attn(p, lds););
    RUN(5, ph5_oa(p););
    RUN(6, { pg8::StaticOrder S; S.init(p.ws + WS_OA, p.ws + WS_WPA, NTOK, DM, 1024, G, bx); EpiGate1 E{(const bf16_t*)(p.ws + WS_GATES), (float*)(p.ws + WS_T1)};
             pg8::gemm_phase<EpiGate1, pg8::StaticOrder, false>(lds, 1024, S, E); }
           { pg8::StaticOrder S; S.init(p.ws + WS_OB, p.ws + WS_WPB, NTOK, DM, 1024, G, bx); EpiGate2 E{(const bf16_t*)(p.ws + WS_GATES), (const float*)(p.ws + WS_T1), (bf16_t*)(p.ws + WS_MERGED)};
             pg8::gemm_phase<EpiGate2, pg8::StaticOrder, false>(lds, 1024, S, E); });
    RUN(7, pg8::StaticOrder S; S.init(p.ws + WS_MERGED, p.ws + WS_WO, NTOK, DM, DM, G, bx); EpiWo E{p.in[I_X], (const float*)(p.ws + WS_MOD), p.out};
           pg8::gemm_phase<EpiWo, pg8::StaticOrder, false>(lds, DM, S, E););
    RUN(8, ph8_router(p, lds, rep););
    RUN(9, moe_gemm<true>(p, lds, rep););
    RUN(10, moe_gemm<false>(p, lds, rep););
#undef RUN
#undef IN
#undef SEAM
}

constexpr int NPHASES = 11;
extern "C" void kernel_launch(void* const* d_in, const int* in_sizes, int n_in, void* d_out, int out_size, void* d_ws, size_t ws_size, hipStream_t stream) {
    static int grid = 0;
    if (grid == 0) {
        if (n_in != 25 || in_sizes[0] != NTOK * DM || out_size != NTOK * DM || ws_size < WS_END2) {
            fprintf(stderr, "kernel_launch: shape mismatch: n_in %d in0 %d out %d ws %zu (need %zu)\n", n_in, n_in > 0 ? in_sizes[0] : -1, out_size, ws_size, (size_t)WS_END2); grid = -1; return; }
        int dev = 0, cus = 0, per_cu = 0;
        if (hipGetDevice(&dev) != hipSuccess || hipDeviceGetAttribute(&cus, hipDeviceAttributeMultiprocessorCount, dev) != hipSuccess) { fprintf(stderr, "kernel_launch: device query failed\n"); grid = -1; return; }
        if (hipFuncSetAttribute((const void*)mk_fwd, hipFuncAttributeMaxDynamicSharedMemorySize, LDS_BYTES) != hipSuccess) { fprintf(stderr, "kernel_launch: hipFuncSetAttribute failed\n"); grid = -1; return; }
        if (hipOccupancyMaxActiveBlocksPerMultiprocessor(&per_cu, (const void*)mk_fwd, NTHREADS, LDS_BYTES) != hipSuccess || per_cu < 1) { fprintf(stderr, "kernel_launch: occupancy query says %d blocks per CU\n", per_cu); }
        (void)hipGetLastError();
        grid = cus;
    }
    if (grid < 0) return;
    if (hipMemsetAsync((char*)d_ws + WS_BAR, 0, WS_ZERO_BYTES, stream) != hipSuccess) { fprintf(stderr, "kernel_launch: memset failed\n"); return; }
    Params p; memset(&p, 0, sizeof(p));
    for (int i = 0; i < 25; ++i) p.in[i] = (const float*)d_in[i];
    p.out = (float*)d_out; p.ws = (unsigned char*)d_ws;
    unsigned char* ws = (unsigned char*)d_ws;
    auto job = [&](int j, const float* src, size_t dst_off, int K, int N, int ldd, int map, int nbatch, long sbatch, long dbatch) {
        TJob& J = p.jobs[j]; J.src = src; J.dst = (bf16_t*)(ws + dst_off); J.K = K; J.N = N; J.ldd = ldd; J.map = map; J.ntk = K / 64; J.ntn = (N + 63) / 64; J.nbatch = nbatch; J.sbatch = sbatch; J.dbatch = dbatch; };
    job(0, p.in[I_WIN], WS_WIN, 2048, DIN, 2048, 1, 1, 0, 0);
    job(1, p.in[I_WPA], WS_WPA, 1024, 2048, 1024, 0, 1, 0, 0);
    job(2, p.in[I_WPB], WS_WPB, 1024, 2048, 1024, 0, 1, 0, 0);
    job(3, p.in[I_WO], WS_WO, 2048, 2048, 2048, 0, 1, 0, 0);
    job(4, p.in[I_WUK], WS_WUK, 128, 256, 128, 0, 8, 128L * 256, 256L * 128);
    job(5, p.in[I_WUV], WS_WUV, 256, 128, 256, 0, 8, 256L * 128, 128L * 256);
    int t0 = 0; for (int j = 0; j < NJOBS; ++j) { p.jobs[j].tile0 = t0; t0 += p.jobs[j].ntk * p.jobs[j].ntn * p.jobs[j].nbatch; }
    p.ntiles_total = t0;
#if MK_LAUNCHES == 1
    p.ph_lo = 0; p.ph_hi = NPHASES;
    hipLaunchKernelGGL(mk_fwd, dim3(grid), dim3(NTHREADS), LDS_BYTES, stream, p);
#else
    for (int k = 0; k < NPHASES; ++k) { p.ph_lo = k; p.ph_hi = k + 1; hipLaunchKernelGGL(mk_fwd, dim3(grid), dim3(NTHREADS), LDS_BYTES, stream, p); }
#endif
    const hipError_t le = hipPeekAtLastError();
    if (le != hipSuccess) fprintf(stderr, "kernel_launch: launch failed: %s\n", hipGetErrorName(le));
}

#ifdef DIAG_PHASES
template <int PH> __global__ void __launch_bounds__(NTHREADS, 2) k_ph(Params p) {
    extern __shared__ __attribute__((aligned(16))) unsigned char shm[];
    LAS unsigned char* lds = (LAS unsigned char*)shm; const int G = gridDim.x, bx = blockIdx.x;
    if constexpr (PH == 0) ph0_prologue(p, lds);
    if constexpr (PH == 1) ph1_norm(p);
    if constexpr (PH == 2) { pg8::StaticOrder S; S.init(p.ws + WS_H, p.ws + WS_WIN, NTOK, DINP, DM, G, bx); EpiProj E{p.ws, p.in[I_BGATE]}; pg8::gemm_phase<EpiProj, pg8::StaticOrder, false>(lds, DM, S, E); }
    if constexpr (PH == 3) ph3_prep(p, lds, 0);
    if constexpr (PH == 4) ph4_attn(p, lds);
    if constexpr (PH == 5) ph5_oa(p);
    if constexpr (PH == 6) { pg8::StaticOrder S; S.init(p.ws + WS_OA, p.ws + WS_WPA, NTOK, DM, 1024, G, bx); EpiGate1 E{(const bf16_t*)(p.ws + WS_GATES), (float*)(p.ws + WS_T1)}; pg8::gemm_phase<EpiGate1, pg8::StaticOrder, false>(lds, 1024, S, E); }
    if constexpr (PH == 7) { pg8::StaticOrder S; S.init(p.ws + WS_MERGED, p.ws + WS_WO, NTOK, DM, DM, G, bx); EpiWo E{p.in[I_X], (const float*)(p.ws + WS_MOD), p.out}; pg8::gemm_phase<EpiWo, pg8::StaticOrder, false>(lds, DM, S, E); }
    if constexpr (PH == 8) ph8_router(p, lds, 0);
    if constexpr (PH == 9) moe_gemm<true>(p, lds, 0);
    if constexpr (PH == 10) moe_gemm<false>(p, lds, 0);
    if constexpr (PH == 12) { const int r = bx; dsa_item(p, lds, r & 3, r >> 2); }
    if constexpr (PH == 13) { const int r = bx; fox_item(p, lds, r & 3, (r >> 2) & 7, r >> 5); }
    if constexpr (PH == 14) { idx_item(p, lds, bx & 3, (bx >> 2) & 31, bx >> 7); }
}
template __global__ void k_ph<0>(Params); template __global__ void k_ph<1>(Params); template __global__ void k_ph<2>(Params); template __global__ void k_ph<3>(Params);
template __global__ void k_ph<4>(Params); template __global__ void k_ph<5>(Params); template __global__ void k_ph<6>(Params); template __global__ void k_ph<7>(Params);
template __global__ void k_ph<8>(Params); template __global__ void k_ph<9>(Params); template __global__ void k_ph<10>(Params); template __global__ void k_ph<11>(Params);
template __global__ void k_ph<12>(Params); template __global__ void k_ph<13>(Params); template __global__ void k_ph<14>(Params);
#endif
```

```cpp
#include <hip/hip_runtime.h>
#include <cstdio>
#include <cstdint>
#include <cstring>

#ifndef MK_LAUNCHES
#define MK_LAUNCHES 1
#endif

#define LAS __attribute__((address_space(3)))
typedef unsigned short bf16_t;
typedef short bf16x8 __attribute__((ext_vector_type(8)));
typedef short s16x4 __attribute__((ext_vector_type(4)));
typedef float f32x4 __attribute__((ext_vector_type(4)));
typedef float f32x16 __attribute__((ext_vector_type(16)));
typedef unsigned u32x4 __attribute__((ext_vector_type(4)));
typedef unsigned u32x2 __attribute__((ext_vector_type(2)));

constexpr int DM = 2048, NBATCH = 4, SEQ = 2048, NTOK = NBATCH * SEQ;
constexpr int DIN = 9560, DINP = 9728;
constexpr int NEXP = 64, DEXP = 512, LCAP = 8192;
constexpr float RMS_EPS = 1e-6f;
constexpr float LOG2E = 1.4426950408889634f;
constexpr int NTHREADS = 512;
constexpr int LDS_BYTES = 163840 - 1024;
constexpr int LDS_BARW = LDS_BYTES - 16;
constexpr int LDS_TAB = 131072;

constexpr size_t al256(size_t x) { return (x + 255) / 256 * 256; }
constexpr size_t WS_BAR = 0;
constexpr size_t WS_CNT = 16384;
constexpr size_t WS_ZERO_BYTES = 16384 + 4096;
constexpr size_t WS_MOD = WS_ZERO_BYTES;
constexpr size_t WS_H = al256(WS_MOD + (size_t)4 * 12288 * 4);
constexpr size_t WS_WIN = al256(WS_H + (size_t)NTOK * DM * 2);
constexpr size_t WS_WPA = al256(WS_WIN + (size_t)DINP * DM * 2);
constexpr size_t WS_WPB = al256(WS_WPA + (size_t)2048 * 1024 * 2);
constexpr size_t WS_WO = al256(WS_WPB + (size_t)2048 * 1024 * 2);
constexpr size_t WS_WUK = al256(WS_WO + (size_t)2048 * 2048 * 2);
constexpr size_t WS_WUV = al256(WS_WUK + (size_t)8 * 256 * 128 * 2);
constexpr size_t WS_W13 = al256(WS_WUV + (size_t)8 * 128 * 256 * 2);
constexpr size_t WS_W2 = al256(WS_W13 + (size_t)64 * 1024 * 2048 * 2);
constexpr size_t WS_QA = al256(WS_W2 + (size_t)64 * 2048 * 512 * 2);
constexpr size_t WS_CKV = al256(WS_QA + (size_t)NTOK * 1024 * 2);
constexpr size_t WS_KV = al256(WS_CKV + (size_t)NTOK * 256 * 4);
constexpr size_t WS_QIDX = al256(WS_KV + (size_t)NTOK * 256 * 2);
constexpr size_t WS_MISC = al256(WS_QIDX + (size_t)NTOK * 1024 * 2);
constexpr size_t WS_QB = al256(WS_MISC + (size_t)NTOK * 256 * 4);
constexpr size_t WS_KB = al256(WS_QB + (size_t)NTOK * 1024 * 2);
constexpr size_t WS_VB = al256(WS_KB + (size_t)NTOK * 1024 * 2);
constexpr size_t WS_GATES = al256(WS_VB + (size_t)NTOK * 1024 * 2);
constexpr size_t WS_QLAT = al256(WS_GATES + (size_t)NTOK * 4096 * 2);
constexpr size_t WS_MASK = al256(WS_QLAT + (size_t)NTOK * 2048 * 2);
constexpr size_t WS_CUM = al256(WS_MASK + (size_t)NTOK * 256);
constexpr size_t WS_OLAT = al256(WS_CUM + (size_t)4 * 8 * 2048 * 4);
constexpr size_t WS_OA = al256(WS_OLAT + (size_t)NTOK * 2048 * 2);
constexpr size_t WS_OB = al256(WS_OA + (size_t)NTOK * 1024 * 2);
constexpr size_t WS_T1 = al256(WS_OB + (size_t)NTOK * 1024 * 2);
constexpr size_t WS_MERGED = al256(WS_T1 + (size_t)NTOK * 2048 * 4);
constexpr size_t WS_LTOK = al256(WS_MERGED + (size_t)NTOK * 2048 * 2);
constexpr size_t WS_LW = al256(WS_LTOK + (size_t)NEXP * LCAP * 4);
constexpr size_t WS_ACT = al256(WS_LW + (size_t)NEXP * LCAP * 4);
constexpr size_t WS_HLO = al256(WS_ACT + (size_t)32768 * 512 * 2);
constexpr size_t WS_WRH = al256(WS_HLO + (size_t)NTOK * DM * 2);
constexpr size_t WS_WRL = al256(WS_WRH + (size_t)80 * DM * 2);
constexpr size_t WS_END = al256(WS_WRL + (size_t)80 * DM * 2);
constexpr size_t WS_KIDX = WS_END;
constexpr size_t WS_END2 = al256(WS_KIDX + (size_t)NTOK * 64 * 2);
constexpr size_t WS_YS = WS_T1;
constexpr size_t WS_HG = WS_QA;
static_assert(WS_HG + (size_t)32768 * DM * 2 <= WS_QLAT, "hg alias must fit in the dead region");

struct TJob { const float* src; bf16_t* dst; int K, N, ldd, map, ntk, ntn, nbatch, tile0; long sbatch, dbatch; };
constexpr int NJOBS = 6;
struct Params {
    const float* in[25];
    float* out;
    unsigned char* ws;
    TJob jobs[NJOBS];
    int ntiles_total;
    int ph_lo, ph_hi;
};
enum { I_X = 0, I_C, I_WADA, I_BADA, I_GMIX, I_WIN, I_BGATE, I_BFORGET, I_WUK, I_WUV, I_GQA, I_GKV, I_GQB, I_GKB, I_WPA, I_WPB, I_WO, I_GFFN, I_WRG, I_BRG, I_WRE, I_BRE, I_W1, I_W3, I_W2 };

__device__ __forceinline__ unsigned cvt_pk_bf16(float lo, float hi) { unsigned r; asm volatile("v_cvt_pk_bf16_f32 %0, %1, %2" : "=v"(r) : "v"(lo), "v"(hi)); return r; }
__device__ __forceinline__ float bf_lo(unsigned w) { return __uint_as_float(w << 16); }
__device__ __forceinline__ float bf_hi(unsigned w) { return __uint_as_float(w & 0xffff0000u); }
__device__ __forceinline__ float wave_sum(float v) {
#pragma unroll
    for (int o = 32; o >= 1; o >>= 1) v += __shfl_xor(v, o);
    return v;
}
__device__ __forceinline__ float sigmoidf_(float x) { return 1.0f / (1.0f + __expf(-x)); }
__device__ __forceinline__ int crow(int r, int hi) { return (r & 3) + 8 * (r >> 2) + 4 * hi; }
#define SBAR() __builtin_amdgcn_sched_barrier(0)

#define XB_TMO      128
#define XB_XCNT(j)  (256  + 64 * (j))
#define XB_XSUB(j)  (1280 + 64 * (j))
#define XB_XGEN(j)  (2304 + 64 * (j))
#define XB_TOP      3328
#define XB_TOPGEN   3392
#define XCD_BAR_WORDS 3456
#define XB_SPIN_CAP (1u << 20)
__device__ __forceinline__ unsigned xb_ld(unsigned* p)              { return __hip_atomic_load(p, __ATOMIC_RELAXED, __HIP_MEMORY_SCOPE_AGENT); }
__device__ __forceinline__ unsigned xb_add(unsigned* p, unsigned v) { return __hip_atomic_fetch_add(p, v, __ATOMIC_RELAXED, __HIP_MEMORY_SCOPE_AGENT); }
__device__ __forceinline__ unsigned xb_xcc_id() { return (unsigned)__builtin_amdgcn_s_getreg((3 << 11) | 20) & 0xFu; }
#define XB_SPIN(cond, bar) do { unsigned _sp = 0; while (cond) { __builtin_amdgcn_s_sleep(1); \
    if ((++_sp & 255u) == 0u) { if (xb_ld(&(bar)[XB_TMO])) break; if (_sp > XB_SPIN_CAP) { atomicAdd(&(bar)[XB_TMO], 1u); break; } } } } while (0)
struct XcdBarrier { unsigned* bar; unsigned x; volatile LAS unsigned* st; };
__device__ __forceinline__ XcdBarrier xcd_barrier_post(unsigned* bar, volatile LAS unsigned* st) {
    XcdBarrier b; b.bar = bar; b.x = xb_xcc_id(); b.st = st;
    if (threadIdx.x == 0) (void)xb_add(&bar[XB_XCNT(b.x)], 1u);
    return b;
}
__device__ __forceinline__ void xcd_barrier_complete(unsigned* bar, unsigned x, unsigned& nloc, unsigned& nx) {
    const unsigned G = gridDim.x * gridDim.y * gridDim.z;
    unsigned sum, cnt, mine, sp = 0u;
    for (;;) {
        sum = 0u; cnt = 0u; mine = 0u;
#pragma unroll
        for (unsigned j = 0; j < 16; ++j) { const unsigned c = xb_ld(&bar[XB_XCNT(j)]); sum += c; cnt += (c > 0u) ? 1u : 0u; mine = (j == x) ? c : mine; }
        if (sum == G) break;
        __builtin_amdgcn_s_sleep(1);
        if ((++sp & 255u) == 0u) { if (xb_ld(&bar[XB_TMO])) break; if (sp > XB_SPIN_CAP) { atomicAdd(&bar[XB_TMO], 1u); break; } }
    }
    nloc = mine > 0u ? mine : 1u; nx = cnt > 0u ? cnt : 1u;
}
__device__ __forceinline__ void xcd_barrier(const XcdBarrier& b) {
    asm volatile("s_waitcnt vmcnt(0)" ::: "memory");
    __syncthreads();
    if (threadIdx.x == 0) {
        unsigned* bar = b.bar;
        __builtin_amdgcn_s_waitcnt(0);
        unsigned nloc = b.st[0], nx = b.st[1];
        if (nloc == 0u) { xcd_barrier_complete(bar, b.x, nloc, nx); b.st[0] = nloc; b.st[1] = nx; }
        const unsigned old = xb_add(&bar[XB_XSUB(b.x)], 1u);
        const unsigned gen = old / nloc;
        if (old + 1u == (gen + 1u) * nloc) {
            __builtin_amdgcn_fence(__ATOMIC_RELEASE, "agent");
            asm volatile("s_waitcnt vmcnt(0)" ::: "memory");
            const unsigned og = xb_add(&bar[XB_TOP], 1u);
            const unsigned tg = og / nx;
            if (og + 1u == (tg + 1u) * nx) xb_add(&bar[XB_TOPGEN], 1u);
            else XB_SPIN(xb_ld(&bar[XB_TOPGEN]) == tg, bar);
            __builtin_amdgcn_fence(__ATOMIC_ACQUIRE, "agent");
            xb_add(&bar[XB_XGEN(b.x)], 1u);
            asm volatile("s_waitcnt vmcnt(0)" ::: "memory");
        } else {
            XB_SPIN(xb_ld(&bar[XB_XGEN(b.x)]) == gen, bar);
            __builtin_amdgcn_fence(__ATOMIC_ACQUIRE, "agent");
            asm volatile("s_waitcnt vmcnt(0)" ::: "memory");
        }
    }
    __syncthreads();
}

namespace pg8 {
constexpr int BM = 256, BK = 64, HALF = 128, HTB = HALF * BK * 2, STAGE_BYTES = 8 * HTB, NXCD = 8, WGM = 8;
__host__ __device__ __forceinline__ int lds_byte(int r, int c) { const int st = (r >> 4) * 2 + (c >> 5), rr = r & 15, cc = c & 31, ob = rr * 64 + cc * 2; return st * 1024 + (ob ^ (((ob >> 9) & 1) << 5)); }
__host__ __device__ __forceinline__ void stage_rc(int b, int& R, int& C) { const int st = b / 1024, sb = b % 1024, swz = sb ^ (((sb >> 9) & 1) << 5); R = (st >> 1) * 16 + swz / 64; C = (st & 1) * 32 + (swz % 64) / 2; }
__host__ __device__ __forceinline__ int perm32(int rho) { const int n = rho >> 4, i = rho & 15; return 8 * (i >> 2) + 4 * n + (i & 3); }

struct Unit { int pm, pn; const char* a; const char* b; const int* gi; int nvalid; int aux; };

struct StaticOrder {
    int nM, nN, nwg, G, c, K; const char* A; const char* Bt;
    __device__ void init(const void* A_, const void* Bt_, int M, int N, int K_, int G_, int c_) { A = (const char*)A_; Bt = (const char*)Bt_; K = K_; nM = M / BM; nN = N / BM; nwg = nM * nN; G = G_; c = c_; }
    __device__ bool next(int i, Unit& u) const {
        const long L = (long)i * G + c; if (L >= nwg) return false;
        int wgid = (int)L; { const int q = nwg / NXCD, r = nwg % NXCD, xcd = wgid % NXCD, off = wgid / NXCD; wgid = (xcd < r ? xcd * (q + 1) : r * (q + 1) + (xcd - r) * q) + off; }
        const int nig = WGM * nN, gid = wgid / nig, fm = gid * WGM, gsz = (nM - fm) < WGM ? (nM - fm) : WGM;
        u.pm = fm + ((wgid % nig) % gsz); u.pn = (wgid % nig) / gsz;
        u.a = A + (size_t)u.pm * BM * K * 2; u.b = Bt + (size_t)u.pn * BM * K * 2; u.gi = nullptr; u.nvalid = BM; u.aux = 0; return true;
    }
};

template <class Epi, class Sched, bool GATHER>
__device__ __forceinline__ void gemm_phase(LAS unsigned char* lds, const int K, const Sched& S, const Epi& E) {
    const int tid = threadIdx.x, wid = __builtin_amdgcn_readfirstlane(tid >> 6), lane = tid & 63, wr = wid >> 2, wc = wid & 3, fr = lane & 15, fq = lane >> 4;
    const int nt = K / BK;
    unsigned voffA[2], voffB[2]; int RA[2], CA[2];
#pragma unroll
    for (int i = 0; i < 2; ++i) { int R, C; stage_rc(tid * 16 + i * 8192, R, C); const int Rb = ((R & ~31) + perm32(R & 31));
        RA[i] = R; CA[i] = C; voffA[i] = (unsigned)(R * K + C) * 2u; voffB[i] = (unsigned)(Rb * K + C) * 2u; }
    const size_t kstep = (size_t)(BK * 2);
    const size_t hstep = (size_t)HALF * K * 2;
    const unsigned ldsw = (unsigned)wid * 1024u;
    const int aoff = lds_byte(wr * 64 + fr, fq * 8), boff = lds_byte(wc * 32 + fr, fq * 8);
    unsigned gA[2][2], gN[2][2];
#define PG8_SA(b, h) (((b) * 2 + (h)) * HTB)
#define PG8_SB(b, h) ((4 + (b) * 2 + (h)) * HTB)
#define PG8_STAGE(bufoff, gbase, voff) do { _Pragma("unroll") for (int _i = 0; _i < 2; ++_i) \
        __builtin_amdgcn_global_load_lds((const unsigned*)((const char*)(gbase) + (voff)[_i]), (LAS unsigned*)(lds + (bufoff) + ldsw + _i * 8192), 16, 0, 0); } while (0)
#define PG8_STAGE_A(bufoff, gp, h, NX) do { if constexpr (GATHER) { if (NX) PG8_STAGE(bufoff, gp, gN[h]); else PG8_STAGE(bufoff, gp, gA[h]); } else PG8_STAGE(bufoff, (gp) + (h) * hstep, voffA); } while (0)
#define PG8_LDA(dst, b, h) do { _Pragma("unroll") for (int m = 0; m < 4; ++m) _Pragma("unroll") for (int k = 0; k < 2; ++k) dst[m][k] = *(const LAS bf16x8*)(lds + PG8_SA(b, h) + aoff + m * 2048 + k * 1024); } while (0)
#define PG8_LDB(dst, b, h) do { _Pragma("unroll") for (int n = 0; n < 2; ++n) _Pragma("unroll") for (int k = 0; k < 2; ++k) dst[n][k] = *(const LAS bf16x8*)(lds + PG8_SB(b, h) + boff + n * 2048 + k * 1024); } while (0)
#define PG8_MMA(ai, bj, At, Bt) do { __builtin_amdgcn_s_setprio(1); _Pragma("unroll") for (int m = 0; m < 4; ++m) _Pragma("unroll") for (int n = 0; n < 2; ++n) _Pragma("unroll") for (int k = 0; k < 2; ++k) \
        acc[ai][bj][m][n] = __builtin_amdgcn_mfma_f32_16x16x32_bf16(Bt[n][k], At[m][k], acc[ai][bj][m][n], 0, 0, 0); __builtin_amdgcn_s_setprio(0); } while (0)
#define PG8_WAIT_V(n) asm volatile("s_waitcnt vmcnt(" #n ")" ::: "memory")
#define PG8_WAIT_L(n) asm volatile("s_waitcnt lgkmcnt(" #n ")" ::: "memory")
#define PG8_BAR __builtin_amdgcn_s_barrier()
#define PG8_SCHED __builtin_amdgcn_sched_barrier(0)
#define PG8_GIDX(dst, u) do { if constexpr (GATHER) { _Pragma("unroll") for (int h = 0; h < 2; ++h) _Pragma("unroll") for (int i = 0; i < 2; ++i) { \
        const int rr = h * HALF + RA[i]; const int tok = rr < (u).nvalid ? (u).gi[rr] : 0; dst[h][i] = (unsigned)(tok * K + CA[i]) * 2u; } } } while (0)
    Unit cur, nxt; int ui = 0;
    if (!S.next(0, cur)) return;
    f32x4 acc[2][2][4][2];
#pragma unroll
    for (int a = 0; a < 2; ++a)
#pragma unroll
        for (int b = 0; b < 2; ++b)
#pragma unroll
            for (int m = 0; m < 4; ++m)
#pragma unroll
                for (int n = 0; n < 2; ++n) acc[a][b][m][n] = (f32x4){0.f, 0.f, 0.f, 0.f};
    bf16x8 At[4][2], B0[2][2], B1[2][2];
    const char* cA = cur.a; const char* cB = cur.b;
    PG8_GIDX(gA, cur);
    PG8_STAGE(PG8_SB(0, 0), cB, voffB); PG8_STAGE_A(PG8_SA(0, 0), cA, 0, false); PG8_STAGE(PG8_SB(0, 1), cB + hstep, voffB); PG8_STAGE_A(PG8_SA(0, 1), cA, 1, false);
    if (wr == 1) PG8_BAR;
    PG8_WAIT_V(4); PG8_BAR;
    PG8_STAGE(PG8_SB(1, 0), cB + kstep, voffB); PG8_STAGE_A(PG8_SA(1, 0), cA + kstep, 0, false); PG8_STAGE(PG8_SB(1, 1), cB + hstep + kstep, voffB);
    PG8_WAIT_V(6); PG8_BAR;
    for (;;) {
        const bool has_next = S.next(ui + 1, nxt);
        const char* nA = has_next ? nxt.a : cA; const char* nB = has_next ? nxt.b : cB;
        if constexpr (GATHER) { if (has_next) { PG8_GIDX(gN, nxt); } else {
#pragma unroll
            for (int h = 0; h < 2; ++h)
#pragma unroll
                for (int i = 0; i < 2; ++i) gN[h][i] = gA[h][i]; } }
        for (int t = 0; t < nt; t += 2) {
            const bool last = (t == nt - 2);
            const char* a1 = cA + (size_t)(t + 1) * kstep;
            const char* a2 = last ? nA : cA + (size_t)(t + 2) * kstep; const char* b2 = last ? nB : cB + (size_t)(t + 2) * kstep;
            const char* a3 = a2 + kstep; const char* b3 = b2 + kstep;
            PG8_LDB(B0, 0, 0); PG8_SCHED; PG8_LDA(At, 0, 0); PG8_STAGE_A(PG8_SA(1, 1), a1, 1, false);
            PG8_WAIT_L(8); PG8_BAR; PG8_WAIT_L(0); PG8_MMA(0, 0, At, B0); PG8_BAR; PG8_SCHED;
            PG8_LDB(B1, 0, 1); PG8_STAGE(PG8_SB(0, 0), b2, voffB);
            PG8_BAR; PG8_WAIT_L(0); PG8_MMA(0, 1, At, B1); PG8_BAR;
            PG8_LDA(At, 0, 1); PG8_STAGE_A(PG8_SA(0, 0), a2, 0, last);
            PG8_BAR; PG8_WAIT_L(0); PG8_MMA(1, 0, At, B0); PG8_BAR; PG8_SCHED;
            PG8_STAGE(PG8_SB(0, 1), b2 + hstep, voffB);
            PG8_WAIT_V(6); PG8_BAR; PG8_MMA(1, 1, At, B1); PG8_BAR;
            PG8_LDB(B0, 1, 0); PG8_SCHED; PG8_LDA(At, 1, 0); PG8_STAGE_A(PG8_SA(0, 1), a2, 1, last);
            PG8_WAIT_L(8); PG8_BAR; PG8_WAIT_L(0); PG8_MMA(0, 0, At, B0); PG8_BAR; PG8_SCHED;
            PG8_LDB(B1, 1, 1); PG8_STAGE(PG8_SB(1, 0), b3, voffB);
            PG8_BAR; PG8_WAIT_L(0); PG8_MMA(0, 1, At, B1); PG8_BAR;
            PG8_LDA(At, 1, 1); PG8_STAGE_A(PG8_SA(1, 0), a3, 0, last);
            PG8_BAR; PG8_WAIT_L(0); PG8_MMA(1, 0, At, B0); PG8_BAR; PG8_SCHED;
            PG8_STAGE(PG8_SB(1, 1), b3 + hstep, voffB);
            PG8_WAIT_V(6); PG8_BAR; PG8_MMA(1, 1, At, B1); PG8_BAR;
        }
        E(acc, cur, wr, wc, fr, fq);
        if (!has_next) break;
#pragma unroll
        for (int a = 0; a < 2; ++a)
#pragma unroll
            for (int b = 0; b < 2; ++b)
#pragma unroll
                for (int m = 0; m < 4; ++m)
#pragma unroll
                    for (int n = 0; n < 2; ++n) acc[a][b][m][n] = (f32x4){0.f, 0.f, 0.f, 0.f};
        cur = nxt; cA = nA; cB = nB; ++ui;
        if constexpr (GATHER) {
#pragma unroll
            for (int h = 0; h < 2; ++h)
#pragma unroll
                for (int i = 0; i < 2; ++i) gA[h][i] = gN[h][i]; }
    }
    PG8_WAIT_V(0);
    if (wr == 0) PG8_BAR;
    PG8_BAR;
#undef PG8_SA
#undef PG8_SB
#undef PG8_STAGE
#undef PG8_STAGE_A
#undef PG8_LDA
#undef PG8_LDB
#undef PG8_MMA
#undef PG8_WAIT_V
#undef PG8_WAIT_L
#undef PG8_BAR
#undef PG8_SCHED
#undef PG8_GIDX
}
}
using pg8::Unit;

#define EPI_LOOP(...) { int fr_ = fr, fq_ = fq; asm volatile("" : "+v"(fr_), "+v"(fq_)); _Pragma("unroll") for (int ai = 0; ai < 2; ++ai) _Pragma("unroll") for (int m = 0; m < 4; ++m) _Pragma("unroll") for (int bj = 0; bj < 2; ++bj) { \
        const int trow = ai * 128 + wr * 64 + m * 16 + fr_; const int tcol = bj * 128 + wc * 32 + fq_ * 8; const f32x4 v0 = acc[ai][bj][m][0], v1 = acc[ai][bj][m][1]; __VA_ARGS__ } }

__device__ __forceinline__ u32x4 pack8(const f32x4 a, const f32x4 b) { u32x4 w; w.x = cvt_pk_bf16(a[0], a[1]); w.y = cvt_pk_bf16(a[2], a[3]); w.z = cvt_pk_bf16(b[0], b[1]); w.w = cvt_pk_bf16(b[2], b[3]); return w; }

struct EpiProj {
    unsigned char* ws; const float* b_gate;
    __device__ __forceinline__ void operator()(const f32x4 (&acc)[2][2][4][2], const Unit& u, int wr, int wc, int fr, int fq) const {
        const int pn = u.pn; const size_t row0 = (size_t)u.pm * 256;
        if (pn == 4 || pn == 9) {
            float* dst = (float*)(ws + (pn == 4 ? WS_CKV : WS_MISC));
            EPI_LOOP({ float* p = dst + (row0 + trow) * 256 + tcol; *(f32x4*)p = v0; *(f32x4*)(p + 4) = v1;
                if (pn == 9 && tcol < 64) *(u32x4*)((bf16_t*)(ws + WS_KIDX) + (row0 + trow) * 64 + tcol) = pack8(v0, v1); })
        } else if (pn < 22) {
            bf16_t* dst; int ct;
            if (pn < 4) { dst = (bf16_t*)(ws + WS_QA); ct = pn; } else if (pn < 9) { dst = (bf16_t*)(ws + WS_QIDX); ct = pn - 5; }
            else if (pn < 14) { dst = (bf16_t*)(ws + WS_QB); ct = pn - 10; } else if (pn < 18) { dst = (bf16_t*)(ws + WS_KB); ct = pn - 14; } else { dst = (bf16_t*)(ws + WS_VB); ct = pn - 18; }
            EPI_LOOP({ *(u32x4*)(dst + (row0 + trow) * 1024 + ct * 256 + tcol) = pack8(v0, v1); })
        } else {
            bf16_t* dst = (bf16_t*)(ws + WS_GATES); const int ct = pn - 22;
            EPI_LOOP({ const int col = ct * 256 + tcol; const f32x4 b0 = *(const f32x4*)(b_gate + col), b1 = *(const f32x4*)(b_gate + col + 4); f32x4 s0, s1;
                _Pragma("unroll") for (int j = 0; j < 4; ++j) { s0[j] = sigmoidf_(v0[j] + b0[j]); s1[j] = sigmoidf_(v1[j] + b1[j]); }
                *(u32x4*)(dst + (row0 + trow) * 4096 + col) = pack8(s0, s1); })
        }
    }
};
struct EpiGate1 {
    const bf16_t* gates; float* T1;
    __device__ __forceinline__ void operator()(const f32x4 (&acc)[2][2][4][2], const Unit& u, int wr, int wc, int fr, int fq) const {
        EPI_LOOP({ const size_t row = (size_t)u.pm * 256 + trow; const int col = u.pn * 256 + tcol; const u32x4 g = *(const u32x4*)(gates + row * 4096 + col);
            f32x4 o0 = {v0[0] * bf_lo(g.x), v0[1] * bf_hi(g.x), v0[2] * bf_lo(g.y), v0[3] * bf_hi(g.y)}; f32x4 o1 = {v1[0] * bf_lo(g.z), v1[1] * bf_hi(g.z), v1[2] * bf_lo(g.w), v1[3] * bf_hi(g.w)};
            float* p = T1 + row * 2048 + col; *(f32x4*)p = o0; *(f32x4*)(p + 4) = o1; })
    }
};
struct EpiGate2 {
    const bf16_t* gates; const float* T1; bf16_t* merged;
    __device__ __forceinline__ void operator()(const f32x4 (&acc)[2][2][4][2], const Unit& u, int wr, int wc, int fr, int fq) const {
        EPI_LOOP({ const size_t row = (size_t)u.pm * 256 + trow; const int col = u.pn * 256 + tcol; const u32x4 g = *(const u32x4*)(gates + row * 4096 + 2048 + col);
            const float* p = T1 + row * 2048 + col; const f32x4 t0 = *(const f32x4*)p, t1 = *(const f32x4*)(p + 4);
            f32x4 o0 = {t0[0] + v0[0] * bf_lo(g.x), t0[1] + v0[1] * bf_hi(g.x), t0[2] + v0[2] * bf_lo(g.y), t0[3] + v0[3] * bf_hi(g.y)};
            f32x4 o1 = {t1[0] + v1[0] * bf_lo(g.z), t1[1] + v1[1] * bf_hi(g.z), t1[2] + v1[2] * bf_lo(g.w), t1[3] + v1[3] * bf_hi(g.w)};
            *(u32x4*)(merged + row * 2048 + col) = pack8(o0, o1); })
    }
};
struct EpiWo {
    const float* x; const float* mod; float* out;
    __device__ __forceinline__ void operator()(const f32x4 (&acc)[2][2][4][2], const Unit& u, int wr, int wc, int fr, int fq) const {
        const float* gt = mod + (size_t)(u.pm >> 3) * 12288 + 4096;
        EPI_LOOP({ const size_t row = (size_t)u.pm * 256 + trow; const int col = u.pn * 256 + tcol; const float* px = x + row * 2048 + col;
            const f32x4 x0 = *(const f32x4*)px, x1 = *(const f32x4*)(px + 4), g0 = *(const f32x4*)(gt + col), g1 = *(const f32x4*)(gt + col + 4);
            float* po = out + row * 2048 + col; *(f32x4*)po = x0 + g0 * v0; *(f32x4*)(po + 4) = x1 + g1 * v1; })
    }
};
struct EpiMoeUp {
    bf16_t* act; const float* lw;
    __device__ __forceinline__ void operator()(const f32x4 (&acc)[2][2][4][2], const Unit& u, int wr, int wc, int fr, int fq) const {
        int fr_ = fr, fq_ = fq; asm volatile("" : "+v"(fr_), "+v"(fq_));
#pragma unroll
        for (int ai = 0; ai < 2; ++ai)
#pragma unroll
            for (int m = 0; m < 4; ++m) {
                const int trow = ai * 128 + wr * 64 + m * 16 + fr_; const int tcol = wc * 32 + fq_ * 8;
                const float gw = trow < u.nvalid ? lw[u.aux + trow] : 0.f;
                const f32x4 a0 = acc[ai][0][m][0], a1 = acc[ai][0][m][1], u0 = acc[ai][1][m][0], u1 = acc[ai][1][m][1]; f32x4 o0, o1;
#pragma unroll
                for (int j = 0; j < 4; ++j) { o0[j] = a0[j] * sigmoidf_(a0[j]) * u0[j] * gw; o1[j] = a1[j] * sigmoidf_(a1[j]) * u1[j] * gw; }
                *(u32x4*)(act + ((size_t)u.pm * 256 + trow) * 512 + u.pn * 128 + tcol) = pack8(o0, o1); SBAR();
            }
    }
};
struct EpiMoeDown {
    float* out; const float* mod;
    __device__ __forceinline__ void operator()(const f32x4 (&acc)[2][2][4][2], const Unit& u, int wr, int wc, int fr, int fq) const {
        EPI_LOOP({ if (trow < u.nvalid) { const int tok = u.gi[trow]; const int col = u.pn * 256 + tcol; const float* gt = mod + (size_t)(tok >> 11) * 12288 + 10240 + col;
            const f32x4 g0 = *(const f32x4*)gt, g1 = *(const f32x4*)(gt + 4); float* po = out + (size_t)tok * 2048 + col;
            _Pragma("unroll") for (int j = 0; j < 4; ++j) { unsafeAtomicAdd(po + j, g0[j] * v0[j]); unsafeAtomicAdd(po + 4 + j, g1[j] * v1[j]); } } })
    }
};

struct MoeOrder {
    const LAS int* pre;
    const LAS int* cnt;
    int G, c, ntn, K; const char* A; const char* Bt; size_t bstride; const int* ltok; bool down;
    __device__ bool next(int i, Unit& u) const {
        const int total = __builtin_amdgcn_readfirstlane(pre[64]) * ntn; const long L = (long)i * G + c; if (L >= total) return false;
        const int l = (int)L; const int mt = l / ntn, pn = l % ntn;
        int e = 0;
#pragma unroll 1
        for (int s = 32; s >= 1; s >>= 1) if (__builtin_amdgcn_readfirstlane(pre[e + s]) <= mt) e += s;
        const int lt = mt - __builtin_amdgcn_readfirstlane(pre[e]);
        u.pm = mt; u.pn = pn; u.aux = e * LCAP + lt * 256; u.gi = ltok + u.aux; { const int rem = __builtin_amdgcn_readfirstlane(cnt[e]) - lt * 256; u.nvalid = rem < 256 ? rem : 256; }
        u.a = down ? A + (size_t)mt * 256 * K * 2 : A; u.b = Bt + (size_t)e * bstride + (size_t)pn * 256 * K * 2; return true;
    }
};

__device__ __forceinline__ int map_row(int map, int n) {
    if (map == 0) return n;
    if (map == 1) { if (n < 2384) return n; if (n < 5456) return n + 176; if (n < 5464) return n - 3072; return n + 168; }
    if (map == 2) return (n >> 7) * 256 + (n & 127);
    return (n >> 7) * 256 + 128 + (n & 127);
}
__device__ void ph0_prologue(const Params& p, LAS unsigned char* lds) {
    const int tid = threadIdx.x, wid = tid >> 6, lane = tid & 63, G = gridDim.x, bx = blockIdx.x;
    if (bx < 192) {
        LAS float* sc = (LAS float*)lds;
        LAS float* red = (LAS float*)(lds + 32768);
        const float* c = p.in[I_C];
        for (int i = tid; i < 4 * 2048; i += NTHREADS) { const float v = c[i]; sc[i] = v / (1.0f + __expf(-v)); }
        __syncthreads();
        for (int item = bx; item < 192; item += G) {
            const int n0 = item * 64, cg = lane & 15, rs = lane >> 4;
            float acc[4][4];
#pragma unroll
            for (int b = 0; b < 4; ++b)
#pragma unroll
                for (int j = 0; j < 4; ++j) acc[b][j] = 0.f;
            const float* w = p.in[I_WADA] + n0 + cg * 4;
#pragma unroll 4
            for (int step = 0; step < 64; ++step) {
                const int k = step * 32 + wid * 4 + rs;
                const f32x4 wv = *(const f32x4*)(w + (size_t)k * 12288);
#pragma unroll
                for (int b = 0; b < 4; ++b) { const float s = sc[b * 2048 + k];
#pragma unroll
                    for (int j = 0; j < 4; ++j) acc[b][j] += s * wv[j]; }
            }
#pragma unroll
            for (int b = 0; b < 4; ++b)
#pragma unroll
                for (int j = 0; j < 4; ++j) { float v = acc[b][j]; v += __shfl_xor(v, 16); v += __shfl_xor(v, 32); acc[b][j] = v; }
            if (rs == 0) {
#pragma unroll
                for (int b = 0; b < 4; ++b)
#pragma unroll
                    for (int j = 0; j < 4; ++j) red[(wid * 16 + cg) * 16 + b * 4 + j] = acc[b][j]; }
            __syncthreads();
            if (tid < 256) { const int cg2 = tid >> 4, bj = tid & 15, b = bj >> 2, j = bj & 3; float s = 0.f;
#pragma unroll
                for (int w8 = 0; w8 < 8; ++w8) s += red[(w8 * 16 + cg2) * 16 + bj];
                const int n = n0 + cg2 * 4 + j; ((float*)(p.ws + WS_MOD))[b * 12288 + n] = s + p.in[I_BADA][n]; }
            __syncthreads();
        }
    }
    { u32x4* z = (u32x4*)(p.ws + WS_WIN + (size_t)2392 * 2048 * 2); const int n16 = 168 * 2048 * 2 / 16;
      for (int i = bx * NTHREADS + tid; i < n16; i += G * NTHREADS) z[i] = (u32x4){0u, 0u, 0u, 0u}; }
    { bf16_t* wh = (bf16_t*)(p.ws + WS_WRH); bf16_t* wl = (bf16_t*)(p.ws + WS_WRL);
      for (int i = bx * NTHREADS + tid; i < 80 * 2048; i += G * NTHREADS) { const int n = i >> 11, k = i & 2047;
          const float v = n < 8 ? p.in[I_WRG][k * 8 + n] : (n < 72 ? p.in[I_WRE][k * 64 + n - 8] : 0.f);
          const unsigned h = cvt_pk_bf16(v, 0.f) & 0xffffu; const unsigned l = cvt_pk_bf16(v - bf_lo(h), 0.f) & 0xffffu; wh[i] = (bf16_t)h; wl[i] = (bf16_t)l; } }
    LAS float* tile = (LAS float*)(lds + 65536);
    for (int ti = bx; ti < p.ntiles_total; ti += G) {
        int j = 0;
#pragma unroll 1
        for (int q = 1; q < NJOBS; ++q) if (ti >= p.jobs[q].tile0) j = q;
        const TJob& J = p.jobs[j];
        int l = ti - J.tile0; const int per = J.ntk * J.ntn; const int bt = l / per; l -= bt * per; const int tn = l / J.ntk, tk = l % J.ntk;
        const float* src = J.src + (size_t)bt * J.sbatch; bf16_t* dst = J.dst + (size_t)bt * J.dbatch;
        const int k0 = tk * 64, n0 = tn * 64;
#pragma unroll
        for (int i = 0; i < 2; ++i) { const int r = (tid >> 4) + 32 * i, c4 = (tid & 15) * 4;
            f32x4 v = {0.f, 0.f, 0.f, 0.f}; if (n0 + c4 < J.N) v = *(const f32x4*)(src + (size_t)(k0 + r) * J.N + n0 + c4);
#pragma unroll
            for (int q = 0; q < 4; ++q) tile[r * 65 + c4 + q] = v[q]; }
        __syncthreads();
        { const int n = tid >> 3, kq = (tid & 7) * 8;
          if (n0 + n < J.N) { float f[8];
#pragma unroll
              for (int q = 0; q < 8; ++q) f[q] = tile[(kq + q) * 65 + n];
              u32x4 w; w.x = cvt_pk_bf16(f[0], f[1]); w.y = cvt_pk_bf16(f[2], f[3]); w.z = cvt_pk_bf16(f[4], f[5]); w.w = cvt_pk_bf16(f[6], f[7]);
              *(u32x4*)(dst + (size_t)map_row(J.map, n0 + n) * J.ldd + k0 + kq) = w; } }
        __syncthreads();
    }
}

__device__ __forceinline__ void norm_row(const float* xr, const float* g, const float* sh, const float* sc, bf16_t* hr, int lane, float (&hv)[32]) {
    f32x4 v[8]; float ss = 0.f;
#pragma unroll
    for (int i = 0; i < 8; ++i) { v[i] = *(const f32x4*)(xr + i * 256 + lane * 4); ss += v[i][0] * v[i][0] + v[i][1] * v[i][1] + v[i][2] * v[i][2] + v[i][3] * v[i][3]; }
    ss = wave_sum(ss);
    const float rstd = rsqrtf(ss * (1.0f / 2048.0f) + RMS_EPS);
#pragma unroll
    for (int i = 0; i < 8; ++i) { const int col = i * 256 + lane * 4; const f32x4 gg = *(const f32x4*)(g + col), s1 = *(const f32x4*)(sc + col), s0 = *(const f32x4*)(sh + col);
#pragma unroll
        for (int j = 0; j < 4; ++j) hv[i * 4 + j] = v[i][j] * rstd * gg[j] * (1.0f + s1[j]) + s0[j];
        u32x2 w; w.x = cvt_pk_bf16(hv[i * 4], hv[i * 4 + 1]); w.y = cvt_pk_bf16(hv[i * 4 + 2], hv[i * 4 + 3]); *(u32x2*)(hr + col) = w; }
}
__device__ void ph1_norm(const Params& p) {
    const int lane = threadIdx.x & 63, gw = blockIdx.x * 8 + (threadIdx.x >> 6), nw = gridDim.x * 8;
    const float* mod = (const float*)(p.ws + WS_MOD);
    for (int t = gw; t < NTOK; t += nw) { const int b = t >> 11; float hv[32];
        norm_row(p.in[I_X] + (size_t)t * DM, p.in[I_GMIX], mod + b * 12288, mod + b * 12288 + 2048, (bf16_t*)(p.ws + WS_H) + (size_t)t * DM, lane, hv); }
}

template <int MB, int NB, int KS>
__device__ __forceinline__ void wave_gemm(const bf16_t* A, int lda, const bf16_t* Bt, int ldb, f32x4 (&acc)[MB][NB], int lane) {
    const int fr = lane & 15, fq = lane >> 4;
#pragma unroll
    for (int mb = 0; mb < MB; ++mb)
#pragma unroll
        for (int nb = 0; nb < NB; ++nb) acc[mb][nb] = (f32x4){0.f, 0.f, 0.f, 0.f};
#pragma unroll 1
    for (int ks = 0; ks < KS; ++ks) {
        bf16x8 af[MB];
#pragma unroll
        for (int mb = 0; mb < MB; ++mb) af[mb] = *(const bf16x8*)(A + (size_t)(mb * 16 + fr) * lda + ks * 32 + fq * 8);
#pragma unroll
        for (int nb = 0; nb < NB; ++nb) { const bf16x8 bf = *(const bf16x8*)(Bt + (size_t)(nb * 16 + fr) * ldb + ks * 32 + fq * 8);
#pragma unroll
            for (int mb = 0; mb < MB; ++mb) acc[mb][nb] = __builtin_amdgcn_mfma_f32_16x16x32_bf16(bf, af[mb], acc[mb][nb], 0, 0, 0); }
    }
}


__device__ __forceinline__ int wave_total_i32(int v) {
    v += __builtin_amdgcn_update_dpp(0, v, 0x111, 0xf, 0xf, true); v += __builtin_amdgcn_update_dpp(0, v, 0x112, 0xf, 0xf, true);
    v += __builtin_amdgcn_update_dpp(0, v, 0x114, 0xf, 0xf, true); v += __builtin_amdgcn_update_dpp(0, v, 0x118, 0xf, 0xf, true);
    v += __builtin_amdgcn_update_dpp(0, v, 0x142, 0xa, 0xf, false); v += __builtin_amdgcn_update_dpp(0, v, 0x143, 0xc, 0xf, false);
    return __builtin_amdgcn_readlane(v, 63);
}
template <int NI> __device__ __forceinline__ unsigned long long topk_words(const LAS float* srow, int c, int lane) {
    unsigned key[NI];
#pragma unroll
    for (int i = 0; i < NI; ++i) { unsigned u = 0u; if (i <= c) { u = __float_as_uint(srow[i * 64 + lane]); u = (u & 0x80000000u) ? ~u : (u | 0x80000000u); } key[i] = u; }
    unsigned v = 0u;
#pragma unroll 1
    for (int bit = 31; bit >= 0; --bit) {
        const unsigned cand = v | (1u << bit); int cl = 0;
#pragma unroll
        for (int i = 0; i < NI; ++i) cl += (key[i] >= cand) ? 1 : 0;
        const int tot = wave_total_i32(cl);
        if (tot >= 256) { v = cand; if (tot == 256) break; }
    }
    unsigned long long myword = 0ull;
#pragma unroll
    for (int i = 0; i < NI; ++i) { const unsigned long long bm = __ballot(key[i] >= v); if (lane == i) myword = bm; if ((i & 3) == 3) SBAR(); }
    return myword;
}
__device__ void idx_item(const Params& p, LAS unsigned char* lds, int b, int c, int sub) {
    const int tid = threadIdx.x, wid = tid >> 6, lane = tid & 63, fr = lane & 15, fq = lane >> 4;
    constexpr int SCLD = 2052;
    LAS float* sc = (LAS float*)lds;
    const int q0 = c * 64 + sub * 16, nk = (c + 1) * 64, nkb = nk / 16;
    const bf16_t* qidx = (const bf16_t*)(p.ws + WS_QIDX) + (size_t)(b * SEQ + q0 + fr) * 1024;
    const float* misc = (const float*)(p.ws + WS_MISC);
    float wq[16];
    { const float* wp = misc + (size_t)(b * SEQ + q0 + fr) * 256 + 64;
#pragma unroll
      for (int i = 0; i < 4; ++i) { const f32x4 v = *(const f32x4*)(wp + i * 4); wq[i * 4] = v[0]; wq[i * 4 + 1] = v[1]; wq[i * 4 + 2] = v[2]; wq[i * 4 + 3] = v[3]; } }
#pragma unroll
    for (int hp = 0; hp < 2; ++hp) {
        bf16x8 qf[8][2];
#pragma unroll
        for (int h = 0; h < 8; ++h)
#pragma unroll
            for (int ks = 0; ks < 2; ++ks) qf[h][ks] = *(const bf16x8*)(qidx + (hp * 8 + h) * 64 + ks * 32 + fq * 8);
        const bf16_t* kbase = (const bf16_t*)(p.ws + WS_KIDX) + (size_t)(b * SEQ + fr) * 64 + fq * 8;
        bf16x8 kf[2];
        if (wid < nkb) { kf[0] = *(const bf16x8*)(kbase + (size_t)wid * 16 * 64); kf[1] = *(const bf16x8*)(kbase + (size_t)wid * 16 * 64 + 32); }
#pragma unroll 1
        for (int kb = wid; kb < nkb; kb += 8) {
            const int kn = kb + 8 < nkb ? kb + 8 : kb;
            const bf16x8 kn0 = *(const bf16x8*)(kbase + (size_t)kn * 16 * 64), kn1 = *(const bf16x8*)(kbase + (size_t)kn * 16 * 64 + 32);
            LAS f32x4* sp = (LAS f32x4*)(sc + fr * SCLD + kb * 16 + fq * 4);
            f32x4 s = {0.f, 0.f, 0.f, 0.f}; if (hp) s = *sp;
#pragma unroll
            for (int h = 0; h < 8; ++h) {
                f32x4 a = {0.f, 0.f, 0.f, 0.f};
                a = __builtin_amdgcn_mfma_f32_16x16x32_bf16(kf[0], qf[h][0], a, 0, 0, 0);
                a = __builtin_amdgcn_mfma_f32_16x16x32_bf16(kf[1], qf[h][1], a, 0, 0, 0);
#pragma unroll
                for (int j = 0; j < 4; ++j) s[j] += wq[hp * 8 + h] * fmaxf(a[j], 0.f);
            }
            *sp = s; kf[0] = kn0; kf[1] = kn1;
        }
    }
    __syncthreads();
    unsigned long long* mask = (unsigned long long*)(p.ws + WS_MASK);
    for (int qq = 0; qq < 2; ++qq) {
        const int ql = wid * 2 + qq; const size_t qg = (size_t)b * SEQ + q0 + ql;
        unsigned long long myword = 0ull;
        if (nk <= 256) { if (lane <= c) myword = ~0ull; }
        else { const LAS float* srow = sc + ql * SCLD;
            if (c < 8) myword = topk_words<8>(srow, c, lane); else if (c < 16) myword = topk_words<16>(srow, c, lane);
            else if (c < 24) myword = topk_words<24>(srow, c, lane); else myword = topk_words<32>(srow, c, lane); }
        if (lane < 32) mask[qg * 32 + lane] = myword;
    }
    __syncthreads();
}
#ifndef REP_SUB
#define REP_SUB 15
#endif
__device__ void ph3_prep(const Params& p, LAS unsigned char* lds, const int rep) {
#define P3ON(bit) (!rep || ((REP_SUB) & (bit)))
    const int tid = threadIdx.x, wid = tid >> 6, lane = tid & 63, bx = blockIdx.x, G = gridDim.x;
    if (P3ON(1)) for (int it = bx; it < 256; it += G) {
        const int b = it >> 6, r = it & 63, cp = r >> 2, sub = r & 3;
        idx_item(p, lds, b, 31 - cp, sub); idx_item(p, lds, b, cp, sub);
    }
    const int gw = bx * 8 + wid, nw = G * 8;
    if (P3ON(2)) for (int it = gw; it < 2048; it += nw) {
        const int rt = it >> 3, h = it & 7, fr = lane & 15, fq = lane >> 4;
        f32x4 acc[2][16];
        wave_gemm<2, 16, 4>((const bf16_t*)(p.ws + WS_QA) + (size_t)rt * 32 * 1024 + h * 128, 1024, (const bf16_t*)(p.ws + WS_WUK) + (size_t)h * 256 * 128, 128, acc, lane);
#pragma unroll
        for (int mb = 0; mb < 2; ++mb) { float ss = 0.f;
#pragma unroll
            for (int nb = 0; nb < 16; ++nb)
#pragma unroll
                for (int j = 0; j < 4; ++j) ss += acc[mb][nb][j] * acc[mb][nb][j];
            ss += __shfl_xor(ss, 16); ss += __shfl_xor(ss, 32);
            const float rs = rsqrtf(ss * (1.0f / 256.0f) + RMS_EPS) * 0.0625f;
            bf16_t* o = (bf16_t*)(p.ws + WS_QLAT) + (size_t)(rt * 32 + mb * 16 + fr) * 2048 + h * 256;
#pragma unroll
            for (int nb = 0; nb < 16; ++nb) { const int col = nb * 16 + fq * 4; const f32x4 g = *(const f32x4*)(p.in[I_GQA] + col);
                u32x2 w; w.x = cvt_pk_bf16(acc[mb][nb][0] * rs * g[0], acc[mb][nb][1] * rs * g[1]); w.y = cvt_pk_bf16(acc[mb][nb][2] * rs * g[2], acc[mb][nb][3] * rs * g[3]); *(u32x2*)(o + col) = w; } }
    }
    if (P3ON(4)) for (int t = gw; t < NTOK; t += nw) {
        { const f32x4 v = *(const f32x4*)((const float*)(p.ws + WS_CKV) + (size_t)t * 256 + lane * 4); float ss = wave_sum(v[0] * v[0] + v[1] * v[1] + v[2] * v[2] + v[3] * v[3]);
          const float rs = rsqrtf(ss * (1.0f / 256.0f) + RMS_EPS); const f32x4 g = *(const f32x4*)(p.in[I_GKV] + lane * 4);
          u32x2 w; w.x = cvt_pk_bf16(v[0] * rs * g[0], v[1] * rs * g[1]); w.y = cvt_pk_bf16(v[2] * rs * g[2], v[3] * rs * g[3]); *(u32x2*)((bf16_t*)(p.ws + WS_KV) + (size_t)t * 256 + lane * 4) = w; }
#pragma unroll
        for (int which = 0; which < 2; ++which) {
            bf16_t* row = (bf16_t*)(p.ws + (which ? WS_KB : WS_QB)) + (size_t)t * 1024 + lane * 16; const float* g = p.in[which ? I_GKB : I_GQB] + (lane & 7) * 16;
            u32x4 a = *(u32x4*)row, c2 = *(u32x4*)(row + 8); float f[16];
            f[0] = bf_lo(a.x); f[1] = bf_hi(a.x); f[2] = bf_lo(a.y); f[3] = bf_hi(a.y); f[4] = bf_lo(a.z); f[5] = bf_hi(a.z); f[6] = bf_lo(a.w); f[7] = bf_hi(a.w);
            f[8] = bf_lo(c2.x); f[9] = bf_hi(c2.x); f[10] = bf_lo(c2.y); f[11] = bf_hi(c2.y); f[12] = bf_lo(c2.z); f[13] = bf_hi(c2.z); f[14] = bf_lo(c2.w); f[15] = bf_hi(c2.w);
            float ss = 0.f;
#pragma unroll
            for (int j = 0; j < 16; ++j) ss += f[j] * f[j];
            ss += __shfl_xor(ss, 1); ss += __shfl_xor(ss, 2); ss += __shfl_xor(ss, 4);
            const float rs = rsqrtf(ss * (1.0f / 128.0f) + RMS_EPS) * (which ? 1.0f : 0.08838834764831845f);
#pragma unroll
            for (int j = 0; j < 16; ++j) f[j] *= rs * g[j];
            a.x = cvt_pk_bf16(f[0], f[1]); a.y = cvt_pk_bf16(f[2], f[3]); a.z = cvt_pk_bf16(f[4], f[5]); a.w = cvt_pk_bf16(f[6], f[7]);
            c2.x = cvt_pk_bf16(f[8], f[9]); c2.y = cvt_pk_bf16(f[10], f[11]); c2.z = cvt_pk_bf16(f[12], f[13]); c2.w = cvt_pk_bf16(f[14], f[15]);
            if (!rep) { *(u32x4*)row = a; *(u32x4*)(row + 8) = c2; } else if (a.x == 0x12345678u) *(u32x4*)row = c2;
        }
    }
    if (P3ON(8) && bx < NBATCH) {
        const int b = bx; const float* fp = (const float*)(p.ws + WS_MISC) + (size_t)(b * SEQ + 4 * tid) * 256 + 80;
        float ls[4][8];
#pragma unroll
        for (int j = 0; j < 4; ++j) { const f32x4 a = *(const f32x4*)(fp + j * 256), c4 = *(const f32x4*)(fp + j * 256 + 4);
#pragma unroll
            for (int h = 0; h < 8; ++h) { const float z = (h < 4 ? a[h & 3] : c4[h & 3]) + p.in[I_BFORGET][h]; ls[j][h] = fminf(z, 0.f) - log1pf(__expf(-fabsf(z))); } }
        LAS float* wt = (LAS float*)lds;
        float off[8];
#pragma unroll
        for (int h = 0; h < 8; ++h) { ls[1][h] += ls[0][h]; ls[2][h] += ls[1][h]; ls[3][h] += ls[2][h];
            float incl = ls[3][h];
#pragma unroll
            for (int o = 1; o < 64; o <<= 1) { const float t2 = __shfl_up(incl, o); if (lane >= o) incl += t2; }
            if (lane == 63) wt[wid * 8 + h] = incl;
            off[h] = incl - ls[3][h]; }
        __syncthreads();
#pragma unroll
        for (int h = 0; h < 8; ++h) { float wo = 0.f; for (int w8 = 0; w8 < wid; ++w8) wo += wt[w8 * 8 + h];
            float* cp = (float*)(p.ws + WS_CUM) + (size_t)(b * 8 + h) * SEQ + 4 * tid;
            *(f32x4*)cp = (f32x4){ls[0][h] + off[h] + wo, ls[1][h] + off[h] + wo, ls[2][h] + off[h] + wo, ls[3][h] + off[h] + wo}; }
        __syncthreads();
    }
}

template <int OFF> __device__ __forceinline__ s16x4 tr_read(int vb) { s16x4 r; asm volatile("ds_read_b64_tr_b16 %0, %1 offset:%2" : "=&v"(r) : "v"(vb), "i"(OFF) : "memory"); return r; }
__device__ __forceinline__ int v_rd_base(int lane) { return ((lane & 3) << 3) | (((lane >> 2) & 3) << 6) | (((lane >> 4) & 1) << 5) | (((lane >> 5) & 1) << 8); }
template <int NCB> __device__ __forceinline__ int v_st(int k, int c) { const int kk = (k & ~0xC) | ((k & 4) << 1) | ((k & 8) >> 1); return ((kk >> 3) * NCB + (c >> 5)) * 512 + ((kk & 7) * 32 + (c & 31)) * 2; }
#define PK4(P, BASE, OUT) do { unsigned a0 = cvt_pk_bf16(P[BASE + 0], P[BASE + 1]), a1 = cvt_pk_bf16(P[BASE + 2], P[BASE + 3]);   \
    unsigned b0 = cvt_pk_bf16(P[BASE + 4], P[BASE + 5]), b1 = cvt_pk_bf16(P[BASE + 6], P[BASE + 7]);                              \
    auto r0 = __builtin_amdgcn_permlane32_swap(a0, b0, false, false); auto r1 = __builtin_amdgcn_permlane32_swap(a1, b1, false, false); \
    u32x4 w = {r0[0], r1[0], r0[1], r1[1]}; OUT = *reinterpret_cast<bf16x8*>(&w); } while (0)
#define PKV(L, H) (bf16x8){L[0], L[1], L[2], L[3], H[0], H[1], H[2], H[3]}
template <int NCB, int D0, int KS> __device__ __forceinline__ void pv_step(f32x16& od, int vb, bf16x8 pa) {
    const s16x4 l = tr_read<D0 * 512 + KS * (2 * NCB * 512)>(vb), h = tr_read<D0 * 512 + KS * (2 * NCB * 512) + NCB * 512>(vb);
    asm volatile("s_waitcnt lgkmcnt(0)" ::: "memory"); SBAR();
    od = __builtin_amdgcn_mfma_f32_32x32x16_bf16(pa, PKV(l, h), od, 0, 0, 0);
}
template <int NCB, int KS0, int D0> struct PvBlocks { static __device__ __forceinline__ void run(f32x16* o, int vb, bf16x8 pa0, bf16x8 pa1) {
    pv_step<NCB, D0, KS0>(o[D0], vb, pa0); pv_step<NCB, D0, KS0 + 1>(o[D0], vb, pa1); if constexpr (D0 + 1 < NCB) PvBlocks<NCB, KS0, D0 + 1>::run(o, vb, pa0, pa1); } };
template <int NCB, int KS0, int D0> struct PvPairs { static __device__ __forceinline__ void run(f32x16* o, int vb, bf16x8 pa0, bf16x8 pa1) {
    constexpr int S = 2 * NCB * 512, H = NCB * 512;
    const s16x4 l00 = tr_read<D0 * 512 + KS0 * S>(vb), h00 = tr_read<D0 * 512 + KS0 * S + H>(vb), l01 = tr_read<D0 * 512 + (KS0 + 1) * S>(vb), h01 = tr_read<D0 * 512 + (KS0 + 1) * S + H>(vb);
    const s16x4 l10 = tr_read<(D0 + 1) * 512 + KS0 * S>(vb), h10 = tr_read<(D0 + 1) * 512 + KS0 * S + H>(vb), l11 = tr_read<(D0 + 1) * 512 + (KS0 + 1) * S>(vb), h11 = tr_read<(D0 + 1) * 512 + (KS0 + 1) * S + H>(vb);
    asm volatile("s_waitcnt lgkmcnt(0)" ::: "memory"); SBAR();
    o[D0] = __builtin_amdgcn_mfma_f32_32x32x16_bf16(pa0, PKV(l00, h00), o[D0], 0, 0, 0); o[D0 + 1] = __builtin_amdgcn_mfma_f32_32x32x16_bf16(pa0, PKV(l10, h10), o[D0 + 1], 0, 0, 0);
    o[D0] = __builtin_amdgcn_mfma_f32_32x32x16_bf16(pa1, PKV(l01, h01), o[D0], 0, 0, 0); o[D0 + 1] = __builtin_amdgcn_mfma_f32_32x32x16_bf16(pa1, PKV(l11, h11), o[D0 + 1], 0, 0, 0);
    if constexpr (D0 + 2 < NCB) PvPairs<NCB, KS0, D0 + 2>::run(o, vb, pa0, pa1); } };
__device__ __forceinline__ int swap23(int k) { return (k & ~0xC) | ((k & 4) << 1) | ((k & 8) >> 1); }
constexpr int FOX_STAGE = 33024;
constexpr int FOX_AL = 2 * FOX_STAGE, FOX_LI = FOX_AL + 1024;
__device__ void fox_item(const Params& p, LAS unsigned char* lds, int b, int h, int qb) {
    const int tid = threadIdx.x, wid = __builtin_amdgcn_readfirstlane(tid >> 6), lane = tid & 63, r32 = lane & 31, hi = lane >> 5;
    const bf16_t* Q = (const bf16_t*)(p.ws + WS_QB);
    const char* Kg = (const char*)(p.ws + WS_KB) + ((size_t)b * SEQ * 1024 + h * 128) * 2; const char* Vg = (const char*)(p.ws + WS_VB) + ((size_t)b * SEQ * 1024 + h * 128) * 2;
    const float* cum = (const float*)(p.ws + WS_CUM) + (size_t)(b * 8 + h) * SEQ;
    const int qpos = qb * 256 + wid * 32 + r32;
    bf16x8 qr[8];
    { const bf16_t* qp = Q + (size_t)(b * SEQ + qpos) * 1024 + h * 128 + hi * 8;
#pragma unroll
      for (int d0 = 0; d0 < 8; ++d0) qr[d0] = *(const bf16x8*)(qp + d0 * 16); }
    const float cq = cum[qpos] * LOG2E;
    unsigned ksrc[2], vsrc[2];
#pragma unroll
    for (int i = 0; i < 2; ++i) { const int pos = (i * 512 + tid) * 16;
        { const int row = pos >> 8; const int cb = (pos & 255) ^ ((row & 7) << 4); ksrc[i] = (unsigned)(row * 2048 + cb); }
        { const int sub = pos >> 9, within = pos & 511; const int kk = (sub >> 2) * 8 + (within >> 6); const int c = (sub & 3) * 32 + ((within & 63) >> 1); vsrc[i] = (unsigned)(swap23(kk) * 2048 + c * 2); } }
    float m_reg = -1e30f, l_reg = 0.f; f32x16 o[4];
#pragma unroll
    for (int d = 0; d < 4; ++d)
#pragma unroll
        for (int r = 0; r < 16; ++r) o[d][r] = 0.f;
    LAS float* al_l = (LAS float*)(lds + FOX_AL) + wid * 32; LAS float* li_l = (LAS float*)(lds + FOX_LI) + wid * 32;
    const int ntiles = qb * 4 + 4, mylast = qb * 4 + (wid >> 1);
#define FOX_DMA(kt) do { LAS unsigned char* sb_ = lds + ((kt) & 1) * FOX_STAGE; const size_t go_ = (size_t)(kt) * 64 * 2048; \
        _Pragma("unroll") for (int i = 0; i < 2; ++i) { \
            __builtin_amdgcn_global_load_lds((const unsigned*)(Kg + go_ + ksrc[i]), (LAS unsigned*)(sb_ + 16384 + (i * 512 + wid * 64) * 16), 16, 0, 0); \
            __builtin_amdgcn_global_load_lds((const unsigned*)(Vg + go_ + vsrc[i]), (LAS unsigned*)(sb_ + (i * 512 + wid * 64) * 16), 16, 0, 0); } \
        if (wid == 0) __builtin_amdgcn_global_load_lds((const unsigned*)(cum + (kt) * 64 + lane), (LAS unsigned*)(sb_ + 32768), 4, 0, 0); } while (0)
    __syncthreads();
    FOX_DMA(0);
    for (int kt = 0; kt < ntiles; ++kt) {
        asm volatile("s_waitcnt vmcnt(0)" ::: "memory");
        __syncthreads();
        if (kt + 1 < ntiles) FOX_DMA(kt + 1);
        if (kt <= mylast) {
            const LAS unsigned char* sb = lds + (kt & 1) * FOX_STAGE; const LAS float* ck = (const LAS float*)(sb + 32768);
            const int vb = (int)(uintptr_t)sb + v_rd_base(lane);
            f32x16 p0, p1;
#pragma unroll
            for (int r = 0; r < 16; ++r) { p0[r] = 0.f; p1[r] = 0.f; }
#pragma unroll
            for (int d0 = 0; d0 < 8; ++d0) { const int cb = (d0 * 16 + hi * 8) * 2;
                const bf16x8 b0 = *(const LAS bf16x8*)(sb + 16384 + r32 * 256 + (cb ^ ((r32 & 7) << 4)));
                const bf16x8 b1 = *(const LAS bf16x8*)(sb + 16384 + (32 + r32) * 256 + (cb ^ ((r32 & 7) << 4)));
                p0 = __builtin_amdgcn_mfma_f32_32x32x16_bf16(b0, qr[d0], p0, 0, 0, 0); p1 = __builtin_amdgcn_mfma_f32_32x32x16_bf16(b1, qr[d0], p1, 0, 0, 0); }
            const bool diag = (kt * 64 + 63 > qb * 256 + wid * 32);
            float pmax = -INFINITY;
#pragma unroll
            for (int g4 = 0; g4 < 4; ++g4) { const f32x4 c0 = *(const LAS f32x4*)(ck + 8 * g4 + 4 * hi), c1 = *(const LAS f32x4*)(ck + 32 + 8 * g4 + 4 * hi);
#pragma unroll
                for (int j = 0; j < 4; ++j) { const int r = g4 * 4 + j; float t0 = fmaf(p0[r], LOG2E, cq) - c0[j] * LOG2E, t1 = fmaf(p1[r], LOG2E, cq) - c1[j] * LOG2E;
                    if (diag) { const int kp = kt * 64 + crow(r, hi); if (kp > qpos) t0 = -INFINITY; if (kp + 32 > qpos) t1 = -INFINITY; }
                    p0[r] = t0; p1[r] = t1; pmax = fmaxf(pmax, fmaxf(t0, t1)); } }
            { auto rr = __builtin_amdgcn_permlane32_swap(__float_as_uint(pmax), __float_as_uint(pmax), false, false); pmax = fmaxf(__uint_as_float(rr[0]), __uint_as_float(rr[1])); }
            const float mn = fmaxf(m_reg, pmax); const float alpha = __builtin_amdgcn_exp2f(m_reg - mn); m_reg = mn;
            float ps = 0.f;
#pragma unroll
            for (int r = 0; r < 16; ++r) { p0[r] = __builtin_amdgcn_exp2f(p0[r] - mn); p1[r] = __builtin_amdgcn_exp2f(p1[r] - mn); ps += p0[r] + p1[r]; }
            { auto rr = __builtin_amdgcn_permlane32_swap(__float_as_uint(ps), __float_as_uint(ps), false, false); ps = __uint_as_float(rr[0]) + __uint_as_float(rr[1]); }
            l_reg = l_reg * alpha + ps;
            if (__any(alpha < 1.f)) { if (hi == 0) al_l[r32] = alpha; asm volatile("s_waitcnt lgkmcnt(0)" ::: "memory");
#pragma unroll
                for (int r = 0; r < 16; ++r) { const float a = al_l[crow(r, hi)];
#pragma unroll
                    for (int d = 0; d < 4; ++d) o[d][r] *= a; } }
            bf16x8 pa0, pa1, pa2, pa3; PK4(p0, 0, pa0); PK4(p0, 8, pa1); PK4(p1, 0, pa2); PK4(p1, 8, pa3);
            PvPairs<4, 0, 0>::run(o, vb, pa0, pa1); PvPairs<4, 2, 0>::run(o, vb, pa2, pa3);
        }
    }
#undef FOX_DMA
    if (hi == 0) li_l[r32] = l_reg; asm volatile("s_waitcnt lgkmcnt(0)" ::: "memory");
    bf16_t* O = (bf16_t*)(p.ws + WS_OB) + (size_t)(b * SEQ + qb * 256 + wid * 32) * 1024 + h * 128;
#pragma unroll
    for (int r = 0; r < 16; ++r) { const float rl = __builtin_amdgcn_rcpf(li_l[crow(r, hi)]); const int orow = crow(r, hi);
#pragma unroll
        for (int d0 = 0; d0 < 4; ++d0) O[(size_t)orow * 1024 + d0 * 32 + r32] = (bf16_t)(cvt_pk_bf16(o[d0][r] * rl, 0.f) & 0xffffu); }
}

constexpr int DSA_STAGE = 32768;
constexpr int DSA_AL = 2 * DSA_STAGE, DSA_LI = DSA_AL + 1024, DSA_Q = DSA_LI + 1024;
__device__ void dsa_item(const Params& p, LAS unsigned char* lds, int b, int qt) {
    const int tid = threadIdx.x, wid = __builtin_amdgcn_readfirstlane(tid >> 6), lane = tid & 63, r32 = lane & 31, hi = lane >> 5, h = wid;
    const char* KV = (const char*)(p.ws + WS_KV) + (size_t)b * SEQ * 512;
    const int qpos = qt * 32 + r32; const size_t qg = (size_t)b * SEQ + qpos;
    const unsigned* mask = (const unsigned*)(p.ws + WS_MASK) + qg * 64;
    bf16x8 qr[8];
    LAS unsigned char* qlds = lds + DSA_Q + wid * 8192 + lane * 16;
    __syncthreads();
    { const bf16_t* qp = (const bf16_t*)(p.ws + WS_QLAT) + qg * 2048 + h * 256 + hi * 8;
#pragma unroll
      for (int d0 = 0; d0 < 8; ++d0) qr[d0] = *(const bf16x8*)(qp + d0 * 16);
#pragma unroll
      for (int d0 = 8; d0 < 16; ++d0) *(LAS bf16x8*)(qlds + (d0 - 8) * 1024) = *(const bf16x8*)(qp + d0 * 16); }
    unsigned ksrc[2], vsrc[2];
#pragma unroll
    for (int i = 0; i < 2; ++i) { const int pos = (i * 512 + tid) * 16;
        { const int row = pos >> 9; const int cb = (pos & 511) ^ ((row & 15) << 4); ksrc[i] = (unsigned)(row * 512 + cb); }
        { const int sub = pos >> 9, within = pos & 511; const int kk = (sub >> 3) * 8 + (within >> 6); const int c = (sub & 7) * 32 + ((within & 63) >> 1); vsrc[i] = (unsigned)(swap23(kk) * 512 + c * 2); } }
    const float slopeL = exp2f(-(float)(h + 1)) * LOG2E;
    float m_reg = -1e30f, l_reg = 0.f; f32x16 o[8];
#pragma unroll
    for (int d = 0; d < 8; ++d)
#pragma unroll
        for (int r = 0; r < 16; ++r) o[d][r] = 0.f;
    LAS float* al_l = (LAS float*)(lds + DSA_AL) + wid * 32; LAS float* li_l = (LAS float*)(lds + DSA_LI) + wid * 32;
    const int ntiles = ((qt >> 1) + 1) * 2;
#define DSA_DMA(kt) do { LAS unsigned char* sb_ = lds + ((kt) & 1) * DSA_STAGE; const size_t go_ = (size_t)(kt) * 32 * 512; \
        _Pragma("unroll") for (int i = 0; i < 2; ++i) { \
            __builtin_amdgcn_global_load_lds((const unsigned*)(KV + go_ + ksrc[i]), (LAS unsigned*)(sb_ + 16384 + (i * 512 + wid * 64) * 16), 16, 0, 0); \
            __builtin_amdgcn_global_load_lds((const unsigned*)(KV + go_ + vsrc[i]), (LAS unsigned*)(sb_ + (i * 512 + wid * 64) * 16), 16, 0, 0); } } while (0)
    unsigned mw = mask[0];
    DSA_DMA(0);
    for (int kt = 0; kt < ntiles; ++kt) {
        asm volatile("s_waitcnt vmcnt(0)" ::: "memory");
        __syncthreads();
        const unsigned mcur = mw;
        if (kt + 1 < ntiles) { mw = mask[kt + 1]; DSA_DMA(kt + 1); }
        const LAS unsigned char* sb = lds + (kt & 1) * DSA_STAGE; const int vb = (int)(uintptr_t)sb + v_rd_base(lane);
        f32x16 pp;
#pragma unroll
        for (int r = 0; r < 16; ++r) pp[r] = 0.f;
        {
            const LAS unsigned char* kb_ = sb + 16384 + r32 * 512; const int sw_ = (r32 & 15) << 4;
#define DSA_KF(d0) (*(const LAS bf16x8*)(kb_ + ((((d0) * 16 + hi * 8) * 2) ^ sw_)))
#define DSA_QF(d0) ((d0) < 8 ? qr[(d0) & 7] : *(const LAS bf16x8*)(qlds + (((d0) - 8) & 7) * 1024))
            bf16x8 k0 = DSA_KF(0), k1 = DSA_KF(1), q0 = DSA_QF(0), q1 = DSA_QF(1);
#pragma unroll
            for (int d0 = 0; d0 < 16; d0 += 2) {
                bf16x8 nk0 = k0, nk1 = k1, nq0 = q0, nq1 = q1;
                if (d0 + 2 < 16) { nk0 = DSA_KF(d0 + 2); nk1 = DSA_KF(d0 + 3); nq0 = DSA_QF(d0 + 2); nq1 = DSA_QF(d0 + 3); }
                pp = __builtin_amdgcn_mfma_f32_32x32x16_bf16(k0, q0, pp, 0, 0, 0); pp = __builtin_amdgcn_mfma_f32_32x32x16_bf16(k1, q1, pp, 0, 0, 0);
                k0 = nk0; k1 = nk1; q0 = nq0; q1 = nq1; SBAR();
            }
#undef DSA_KF
#undef DSA_QF
        }
        const unsigned wsh = mcur >> (4 * hi);
        const float df = (float)(qpos - (kt * 32 + 4 * hi));
        float pmax = -INFINITY;
#pragma unroll
        for (int r = 0; r < 16; ++r) { const int cb = (r & 3) + 8 * (r >> 2); const float dd = df - (float)cb;
            float t = fmaf(-slopeL, fabsf(dd), pp[r] * LOG2E); if (!((wsh >> cb) & 1u)) t = -INFINITY; pp[r] = t; pmax = fmaxf(pmax, t); }
        { auto rr = __builtin_amdgcn_permlane32_swap(__float_as_uint(pmax), __float_as_uint(pmax), false, false); pmax = fmaxf(__uint_as_float(rr[0]), __uint_as_float(rr[1])); }
        const float mn = fmaxf(m_reg, pmax); const float alpha = __builtin_amdgcn_exp2f(m_reg - mn); m_reg = mn;
        float ps = 0.f;
#pragma unroll
        for (int r = 0; r < 16; ++r) { pp[r] = __builtin_amdgcn_exp2f(pp[r] - mn); ps += pp[r]; }
        { auto rr = __builtin_amdgcn_permlane32_swap(__float_as_uint(ps), __float_as_uint(ps), false, false); ps = __uint_as_float(rr[0]) + __uint_as_float(rr[1]); }
        l_reg = l_reg * alpha + ps;
        if (__any(alpha < 1.f)) { if (hi == 0) al_l[r32] = alpha; asm volatile("s_waitcnt lgkmcnt(0)" ::: "memory");
#pragma unroll
            for (int r = 0; r < 16; ++r) { const float a = al_l[crow(r, hi)];
#pragma unroll
                for (int d = 0; d < 8; ++d) o[d][r] *= a; } }
        bf16x8 pa0, pa1; PK4(pp, 0, pa0); PK4(pp, 8, pa1);
        PvPairs<8, 0, 0>::run(o, vb, pa0, pa1);
    }
#undef DSA_DMA
    if (hi == 0) li_l[r32] = l_reg; asm volatile("s_waitcnt lgkmcnt(0)" ::: "memory");
    float rl[16];
#pragma unroll
    for (int r = 0; r < 16; ++r) rl[r] = __builtin_amdgcn_rcpf(li_l[crow(r, hi)]);
    __syncthreads();
    LAS bf16_t* os = (LAS bf16_t*)(lds + wid * 16896);
#pragma unroll
    for (int r = 0; r < 16; ++r)
#pragma unroll
        for (int d0 = 0; d0 < 8; ++d0) os[crow(r, hi) * 264 + d0 * 32 + r32] = (bf16_t)(cvt_pk_bf16(o[d0][r] * rl[r], 0.f) & 0xffffu);
    asm volatile("s_waitcnt lgkmcnt(0)" ::: "memory");
    f32x16 ya[4];
#pragma unroll
    for (int nb = 0; nb < 4; ++nb)
#pragma unroll
        for (int r = 0; r < 16; ++r) ya[nb][r] = 0.f;
    const bf16_t* wv = (const bf16_t*)(p.ws + WS_WUV) + (size_t)(h * 128 + r32) * 256 + hi * 8;
#pragma unroll 4
    for (int ks = 0; ks < 16; ++ks) {
        const bf16x8 af = *(const LAS bf16x8*)(os + r32 * 264 + ks * 16 + hi * 8);
#pragma unroll
        for (int nb = 0; nb < 4; ++nb) { const bf16x8 wf = *(const bf16x8*)(wv + (size_t)nb * 32 * 256 + ks * 16); ya[nb] = __builtin_amdgcn_mfma_f32_32x32x16_bf16(wf, af, ya[nb], 0, 0, 0); }
    }
    bf16_t* O = (bf16_t*)(p.ws + WS_OA) + ((size_t)b * SEQ + qt * 32 + r32) * 1024 + h * 128 + 4 * hi;
#pragma unroll
    for (int nb = 0; nb < 4; ++nb)
#pragma unroll
        for (int g4 = 0; g4 < 4; ++g4) { u32x2 pk; pk.x = cvt_pk_bf16(ya[nb][g4 * 4], ya[nb][g4 * 4 + 1]); pk.y = cvt_pk_bf16(ya[nb][g4 * 4 + 2], ya[nb][g4 * 4 + 3]); *(u32x2*)(O + nb * 32 + g4 * 8) = pk; }
}
__device__ void ph4_attn(const Params& p, LAS unsigned char* lds) {
    const int r = blockIdx.x;
    if (r < 256) { const int c = 31 - (r >> 3), w8 = r & 7, b = w8 >> 1, half = w8 & 1; dsa_item(p, lds, b, c * 2 + half); }
    __syncthreads();
    if (r < 256) { const int qb = r >> 5, bh = r & 31; fox_item(p, lds, bh >> 3, bh & 7, qb); }
}

__device__ void ph5_oa(const Params& p) {
    const int lane = threadIdx.x & 63, gw = blockIdx.x * 8 + (threadIdx.x >> 6), nw = gridDim.x * 8, fr = lane & 15, fq = lane >> 4;
    for (int it = gw; it < 2048; it += nw) {
        const int rt = it >> 3, h = it & 7;
        f32x4 acc[2][8];
        wave_gemm<2, 8, 8>((const bf16_t*)(p.ws + WS_OLAT) + (size_t)rt * 32 * 2048 + h * 256, 2048, (const bf16_t*)(p.ws + WS_WUV) + (size_t)h * 128 * 256, 256, acc, lane);
#pragma unroll
        for (int mb = 0; mb < 2; ++mb) { bf16_t* o = (bf16_t*)(p.ws + WS_OA) + (size_t)(rt * 32 + mb * 16 + fr) * 1024 + h * 128;
#pragma unroll
            for (int nb = 0; nb < 8; ++nb) { u32x2 w; w.x = cvt_pk_bf16(acc[mb][nb][0], acc[mb][nb][1]); w.y = cvt_pk_bf16(acc[mb][nb][2], acc[mb][nb][3]); *(u32x2*)(o + nb * 16 + fq * 4) = w; } }
    }
}

__device__ void ph8_router(const Params& p, LAS unsigned char* lds, const int rep) {
    const int tid = threadIdx.x, wid = tid >> 6, lane = tid & 63, fr = lane & 15, fq = lane >> 4;
    const float* mod = (const float*)(p.ws + WS_MOD);
    bf16_t* H = (bf16_t*)(p.ws + WS_H); bf16_t* HL = (bf16_t*)(p.ws + WS_HLO);
    int* cnt = (int*)(p.ws + WS_CNT) + rep * 256; int* ltok = rep ? (int*)(p.ws + WS_T1) : (int*)(p.ws + WS_LTOK); float* lw = rep ? (float*)(p.ws + WS_T1 + (4u << 20)) : (float*)(p.ws + WS_LW);
    LAS float* slab = (LAS float*)lds + wid * 2560;
    LAS float* lg = (LAS float*)lds + 8 * 2560;
    for (int blk = blockIdx.x; blk < NTOK / 32; blk += gridDim.x) {
        const int t0 = blk * 32;
        {
            const int tb = t0 + wid * 4, b = tb >> 11;
            const float* sh = mod + b * 12288 + 6144; const float* sc = mod + b * 12288 + 8192;
            f32x4 xv[4][8];
#pragma unroll
            for (int rr = 0; rr < 4; ++rr)
#pragma unroll
                for (int i = 0; i < 8; ++i) xv[rr][i] = *(const f32x4*)(p.out + (size_t)(tb + rr) * DM + i * 256 + lane * 4);
#pragma unroll
            for (int rr = 0; rr < 4; ++rr) {
                float ss = 0.f;
#pragma unroll
                for (int i = 0; i < 8; ++i) ss += xv[rr][i][0] * xv[rr][i][0] + xv[rr][i][1] * xv[rr][i][1] + xv[rr][i][2] * xv[rr][i][2] + xv[rr][i][3] * xv[rr][i][3];
                ss = wave_sum(ss);
                const float rstd = rsqrtf(ss * (1.0f / 2048.0f) + RMS_EPS);
#pragma unroll
                for (int i = 0; i < 8; ++i) { const int col = i * 256 + lane * 4; const f32x4 gg = *(const f32x4*)(p.in[I_GFFN] + col), s1 = *(const f32x4*)(sc + col), s0 = *(const f32x4*)(sh + col);
                    float hv[4], lo[4];
#pragma unroll
                    for (int j = 0; j < 4; ++j) hv[j] = xv[rr][i][j] * rstd * gg[j] * (1.0f + s1[j]) + s0[j];
                    u32x2 wh; wh.x = cvt_pk_bf16(hv[0], hv[1]); wh.y = cvt_pk_bf16(hv[2], hv[3]);
                    lo[0] = hv[0] - bf_lo(wh.x); lo[1] = hv[1] - bf_hi(wh.x); lo[2] = hv[2] - bf_lo(wh.y); lo[3] = hv[3] - bf_hi(wh.y);
                    u32x2 wl; wl.x = cvt_pk_bf16(lo[0], lo[1]); wl.y = cvt_pk_bf16(lo[2], lo[3]);
                    *(u32x2*)(H + (size_t)(tb + rr) * DM + col) = wh; *(u32x2*)(HL + (size_t)(tb + rr) * DM + col) = wl; }
            }
        }
        asm volatile("s_waitcnt vmcnt(0)" ::: "memory");
        __syncthreads();
        {
            const bf16_t* Ah = H + (size_t)(t0 + fr) * DM + wid * 256 + fq * 8; const bf16_t* Al = HL + (size_t)(t0 + fr) * DM + wid * 256 + fq * 8;
            const bf16_t* Wh = (const bf16_t*)(p.ws + WS_WRH) + (size_t)fr * DM + wid * 256 + fq * 8; const bf16_t* Wl = (const bf16_t*)(p.ws + WS_WRL) + (size_t)fr * DM + wid * 256 + fq * 8;
            f32x4 acc[2][5];
#pragma unroll
            for (int mb = 0; mb < 2; ++mb)
#pragma unroll
                for (int nb = 0; nb < 5; ++nb) acc[mb][nb] = (f32x4){0.f, 0.f, 0.f, 0.f};
#pragma unroll 4
            for (int ks = 0; ks < 8; ++ks) {
                bf16x8 ah[2], al[2];
#pragma unroll
                for (int mb = 0; mb < 2; ++mb) { ah[mb] = *(const bf16x8*)(Ah + (size_t)mb * 16 * DM + ks * 32); al[mb] = *(const bf16x8*)(Al + (size_t)mb * 16 * DM + ks * 32); }
#pragma unroll
                for (int nb = 0; nb < 5; ++nb) { const bf16x8 wh = *(const bf16x8*)(Wh + (size_t)nb * 16 * DM + ks * 32), wl = *(const bf16x8*)(Wl + (size_t)nb * 16 * DM + ks * 32);
#pragma unroll
                    for (int mb = 0; mb < 2; ++mb) {
                        acc[mb][nb] = __builtin_amdgcn_mfma_f32_16x16x32_bf16(wh, ah[mb], acc[mb][nb], 0, 0, 0);
                        acc[mb][nb] = __builtin_amdgcn_mfma_f32_16x16x32_bf16(wl, ah[mb], acc[mb][nb], 0, 0, 0);
                        acc[mb][nb] = __builtin_amdgcn_mfma_f32_16x16x32_bf16(wh, al[mb], acc[mb][nb], 0, 0, 0); } }
            }
#pragma unroll
            for (int mb = 0; mb < 2; ++mb)
#pragma unroll
                for (int nb = 0; nb < 5; ++nb) *(LAS f32x4*)(slab + (mb * 16 + fr) * 80 + nb * 16 + fq * 4) = acc[mb][nb];
        }
        __syncthreads();
        for (int o = tid; o < 2560; o += NTHREADS) { float s = 0.f;
#pragma unroll
            for (int w8 = 0; w8 < 8; ++w8) s += ((LAS float*)lds)[w8 * 2560 + o];
            lg[o] = s; }
        __syncthreads();
        if (tid < 32) {
            const int t = t0 + tid; const LAS float* L = lg + tid * 80;
            float gl[8]; int gi = 0; float gm = -INFINITY;
#pragma unroll
            for (int g = 0; g < 8; ++g) { gl[g] = L[g] + p.in[I_BRG][g]; if (gl[g] > gm) { gm = gl[g]; gi = g; } }
            float se = 0.f;
#pragma unroll
            for (int g = 0; g < 8; ++g) se += __expf(gl[g] - gm);
            const float gwt = 1.0f / se;
            float v1 = -INFINITY, v2 = -INFINITY; int i1 = 0, i2 = 0;
            for (int e = 0; e < 8; ++e) { const float v = L[8 + gi * 8 + e] + p.in[I_BRE][gi * 8 + e];
                if (v > v1) { v2 = v1; i2 = i1; v1 = v; i1 = e; } else if (v > v2) { v2 = v; i2 = e; } }
            const float e2 = __expf(v2 - v1); const float p1 = gwt / (1.0f + e2), p2 = gwt * e2 / (1.0f + e2);
            const int ea = gi * 8 + i1, eb = gi * 8 + i2;
            const int pa = atomicAdd(cnt + ea, 1); ltok[ea * LCAP + pa] = t; lw[ea * LCAP + pa] = p1;
            const int pb = atomicAdd(cnt + eb, 1); ltok[eb * LCAP + pb] = t | 0x10000; lw[eb * LCAP + pb] = p2;
        }
        __syncthreads();
    }
}

__device__ __forceinline__ void moe_table(const Params& p, LAS unsigned char* lds) {
    LAS int* pre = (LAS int*)(lds + LDS_TAB);
    if (threadIdx.x == 0) { const int* cnt = (const int*)(p.ws + WS_CNT); int s = 0; for (int e = 0; e < 64; ++e) { const int ce = cnt[e]; pre[e] = s; pre[80 + e] = ce; s += (ce + 255) >> 8; } pre[64] = s; }
    __syncthreads();
}
__device__ void ph9_gather(const Params& p, LAS unsigned char* lds) {
    moe_table(p, lds);
    const LAS int* pre = (const LAS int*)(lds + LDS_TAB); const LAS int* cnt = pre + 80; const int* ltok = (const int*)(p.ws + WS_LTOK);
    const int lane = threadIdx.x & 63, gw = blockIdx.x * 8 + (threadIdx.x >> 6), nw = gridDim.x * 8, nrows = pre[64] * 256;
    const bf16_t* H = (const bf16_t*)(p.ws + WS_H); bf16_t* HG = (bf16_t*)(p.ws + WS_HG);
    for (int r = gw; r < nrows; r += nw) {
        const int mt = r >> 8; int e = 0;
#pragma unroll 1
        for (int s = 32; s >= 1; s >>= 1) if (pre[e + s] <= mt) e += s;
        const int pos = (mt - pre[e]) * 256 + (r & 255);
        u32x4 v[4];
        if (pos < cnt[e]) { const int tok = ltok[e * LCAP + pos];
#pragma unroll
            for (int i = 0; i < 4; ++i) v[i] = *(const u32x4*)(H + (size_t)tok * DM + i * 512 + lane * 8); }
        else {
#pragma unroll
            for (int i = 0; i < 4; ++i) v[i] = (u32x4){0u, 0u, 0u, 0u}; }
#pragma unroll
        for (int i = 0; i < 4; ++i) *(u32x4*)(HG + (size_t)r * DM + i * 512 + lane * 8) = v[i];
    }
}


#define MOE_GLOAD(dst, ptr) asm volatile("global_load_dwordx4 %0, %1, off nt" : "=v"(dst) : "v"(ptr) : "memory")
template <bool UP>
__device__ void moe_gemm(const Params& p, LAS unsigned char* lds, const int rep) {
    constexpr int K = UP ? 2048 : 512, NKT = K / 32, NS = UP ? 8 : 16, LDW = UP ? 512 : 2048;
    constexpr int OFF_A = 0, OFF_B = 98304;
    const int tid = threadIdx.x, w = __builtin_amdgcn_readfirstlane(tid >> 6), l = tid & 63, r32 = l & 31, hi = l >> 5;
    LAS int* tab = (LAS int*)(lds + LDS_TAB);
    if (tid == 0) { const int* cnt = (const int*)(p.ws + WS_CNT); int s = 0, ro = 0; for (int e = 0; e < 64; ++e) { const int ce = cnt[e]; tab[e] = s; tab[80 + e] = ce; tab[160 + e] = ro; ro += ce; const int np = (ce + 511) >> 9; s += np > 0 ? np : 1; } tab[64] = s; }
    __syncthreads();
    const int total = __builtin_amdgcn_readfirstlane(tab[64]) * NS;
    const int q = (w & 3) * 8 + (l & 7), g = (w >> 2) * 8 + (l >> 3);
    const unsigned bwoff = (unsigned)(q * 256 + (((g >> 2) ^ (q & 3)) * 16) + (g & 3) * 4);
    const unsigned frag_sw = (unsigned)((r32 >> 2) & 3);
    const int* ltok = (const int*)(p.ws + WS_LTOK); const float* lw = (const float*)(p.ws + WS_LW);
    for (int unit = blockIdx.x; unit < total; unit += gridDim.x) {
        const int pm = unit / NS, ns = unit - pm * NS; int e = 0;
#pragma unroll 1
        for (int s = 32; s >= 1; s >>= 1) if (__builtin_amdgcn_readfirstlane(tab[e + s]) <= pm) e += s;
        const int mp = pm - __builtin_amdgcn_readfirstlane(tab[e]); const int cnt_e = __builtin_amdgcn_readfirstlane(tab[80 + e]), rowoff = __builtin_amdgcn_readfirstlane(tab[160 + e]);
        int nrows = cnt_e - mp * 512; nrows = nrows > 512 ? 512 : nrows; const bool two = nrows > 256;
        const char* abase = UP ? (const char*)(p.ws + WS_H) : (const char*)(p.ws + WS_ACT);
        unsigned aoff[4];
#pragma unroll
        for (int i = 0; i < 4; ++i) { const int row = ((i >> 1) * 16 + 2 * w + (i & 1)) * 16 + (l >> 2); const int c = (l & 3) ^ ((l >> 4) & 3);
            int src; if (UP) src = row < nrows ? (ltok[e * LCAP + mp * 512 + row] & 0xffff) : 0; else src = rowoff + mp * 512 + (row < nrows ? row : 0);
            aoff[i] = (unsigned)(src * K + c * 8) * 2u; }
        const float* bsrc = UP ? (q < 16 ? p.in[I_W1] : p.in[I_W3]) + (size_t)e * 2048 * 512 + ns * 64 + (q & 15) * 4 + (size_t)(2 * g) * LDW
                               : p.in[I_W2] + (size_t)e * 512 * 2048 + ns * 128 + q * 4 + (size_t)(2 * g) * LDW;
        f32x16 acc[2][4];
#pragma unroll
        for (int a = 0; a < 2; ++a)
#pragma unroll
            for (int b = 0; b < 4; ++b)
#pragma unroll
                for (int r = 0; r < 16; ++r) acc[a][b][r] = 0.f;
        f32x4 br[4][2];
#define MOE_ISSUE_B(j, t) do { const int tt_ = (t) < NKT ? (t) : NKT - 1; const float* bp_ = bsrc + (size_t)tt_ * 32 * LDW; MOE_GLOAD(br[j][0], bp_); MOE_GLOAD(br[j][1], bp_ + LDW); } while (0)
#define MOE_ISSUE_A(t, TWO) do { int tt_ = (t) < 0 ? 0 : (t); const int bi_ = (tt_ % 3); tt_ = tt_ < NKT ? tt_ : NKT - 1; const char* ap_ = abase + (size_t)tt_ * 64; \
        LAS unsigned char* ab_ = lds + OFF_A + bi_ * 32768 + 2 * w * 1024; \
        __builtin_amdgcn_global_load_lds((const unsigned*)(ap_ + aoff[0]), (LAS unsigned*)(ab_), 16, 0, 0); __builtin_amdgcn_global_load_lds((const unsigned*)(ap_ + aoff[1]), (LAS unsigned*)(ab_ + 1024), 16, 0, 0); \
        if (TWO) { __builtin_amdgcn_global_load_lds((const unsigned*)(ap_ + aoff[2]), (LAS unsigned*)(ab_ + 16384), 16, 0, 0); __builtin_amdgcn_global_load_lds((const unsigned*)(ap_ + aoff[3]), (LAS unsigned*)(ab_ + 16384 + 1024), 16, 0, 0); } } while (0)
        const bool two_w = (256 + 32 * w) < nrows;
#define MOE_FRAGS(ks, TWO) do { const unsigned co_ = ((unsigned)((ks) * 2 + hi) ^ frag_sw) * 16u; \
            _Pragma("unroll") for (int nb = 0; nb < 4; ++nb) bf_[nb] = *(const LAS bf16x8*)(bb_ + nb * 2048 + co_); \
            a0_ = *(const LAS bf16x8*)(ab_ + co_); if (TWO) a1_ = *(const LAS bf16x8*)(ab_ + 16384 + co_); } while (0)
#define MOE_MMAS(TWO) do { \
            _Pragma("unroll") for (int nb = 0; nb < 4; ++nb) acc[0][nb] = __builtin_amdgcn_mfma_f32_32x32x16_bf16(bf_[nb], a0_, acc[0][nb], 0, 0, 0); \
            if (TWO) { _Pragma("unroll") for (int nb = 0; nb < 4; ++nb) acc[1][nb] = __builtin_amdgcn_mfma_f32_32x32x16_bf16(bf_[nb], a1_, acc[1][nb], 0, 0, 0); } } while (0)
#define MOE_ITER(jn, t, COMPUTE, TWO, WB, WA) do { \
        bf16x8 bf_[4], a0_, a1_; \
        const LAS unsigned char* ab_ = lds + OFF_A + (((t) + 3) % 3) * 32768 + (32 * w + r32) * 64; const LAS unsigned char* bb_ = lds + OFF_B + ((t) & 1) * 8192 + r32 * 64; \
        if (COMPUTE) { MOE_FRAGS(0, TWO); } SBAR(); \
        asm volatile("s_waitcnt vmcnt(" WB ")" : "+v"(br[jn][0]), "+v"(br[jn][1]) :: "memory"); \
        { LAS unsigned char* bw_ = lds + OFF_B + (((t) + 1) & 1) * 8192 + bwoff; _Pragma("unroll") for (int jj = 0; jj < 4; ++jj) *(LAS unsigned*)(bw_ + jj * 64) = cvt_pk_bf16(br[jn][0][jj], br[jn][1][jj]); } \
        MOE_ISSUE_B(jn, (t) + 5); SBAR(); \
        if (COMPUTE) { MOE_MMAS(TWO); SBAR(); MOE_FRAGS(1, TWO); MOE_MMAS(TWO); } SBAR(); \
        asm volatile("s_waitcnt vmcnt(" WA ")" ::: "memory"); \
        asm volatile("s_waitcnt lgkmcnt(0)" ::: "memory"); __builtin_amdgcn_s_barrier(); asm volatile("" ::: "memory"); \
        MOE_ISSUE_A((t) + 3, TWO); \
        } while (0)
#define MOE_PIPE(TWO, WB, WA) do { \
        MOE_ISSUE_B(0, 0); MOE_ISSUE_A(-1, TWO); MOE_ISSUE_B(1, 1); MOE_ISSUE_A(-1, TWO); MOE_ISSUE_B(2, 2); MOE_ISSUE_A(0, TWO); MOE_ISSUE_B(3, 3); MOE_ISSUE_A(1, TWO); \
        MOE_ITER(0, -1, false, TWO, WB, WA); \
        _Pragma("unroll 1") for (int t = 0; t < NKT; t += 4) { MOE_ITER(1, t, true, TWO, WB, WA); MOE_ITER(2, t + 1, true, TWO, WB, WA); MOE_ITER(3, t + 2, true, TWO, WB, WA); MOE_ITER(0, t + 3, true, TWO, WB, WA); } \
          \
        asm volatile("s_waitcnt vmcnt(0)" : "+v"(br[0][0]), "+v"(br[0][1]), "+v"(br[1][0]), "+v"(br[1][1]), "+v"(br[2][0]), "+v"(br[2][1]), "+v"(br[3][0]), "+v"(br[3][1]) :: "memory"); \
        } while (0)
        if (two_w) MOE_PIPE(true, "22", "8"); else MOE_PIPE(false, "14", "6");
        asm volatile("s_waitcnt vmcnt(0)" ::: "memory");
        if constexpr (UP) {
#pragma unroll
            for (int mt = 0; mt < 2; ++mt) {
                const int rl = mt * 256 + 32 * w + r32;
                if (rl < nrows) {
                    const float gw = lw[e * LCAP + mp * 512 + rl]; bf16_t* orow = (bf16_t*)(p.ws + WS_ACT) + (size_t)(rowoff + mp * 512 + rl) * 512 + ns * 64 + 4 * hi;
#pragma unroll
                    for (int nb = 0; nb < 2; ++nb)
#pragma unroll
                        for (int g4 = 0; g4 < 4; ++g4) { float o[4];
#pragma unroll
                            for (int j = 0; j < 4; ++j) { const float a = acc[mt][nb][g4 * 4 + j], u = acc[mt][nb + 2][g4 * 4 + j]; o[j] = a * sigmoidf_(a) * u * gw; }
                            u32x2 pk; pk.x = cvt_pk_bf16(o[0], o[1]); pk.y = cvt_pk_bf16(o[2], o[3]); *(u32x2*)(orow + nb * 32 + g4 * 8) = pk; }
                }
            }
        } else {
#pragma unroll
            for (int mt = 0; mt < 2; ++mt) {
                const int rl = mt * 256 + 32 * w + r32;
                if (rl < nrows) {
                    const int ent = ltok[e * LCAP + mp * 512 + rl]; bf16_t* orow = (bf16_t*)(p.ws + WS_YS) + ((size_t)(ent >> 16) * NTOK + (ent & 0xffff)) * 2048 + ns * 128 + 4 * hi;
#pragma unroll
                    for (int nb = 0; nb < 4; ++nb)
#pragma unroll
                        for (int g4 = 0; g4 < 4; ++g4) { u32x2 pk; pk.x = cvt_pk_bf16(acc[mt][nb][g4 * 4], acc[mt][nb][g4 * 4 + 1]); pk.y = cvt_pk_bf16(acc[mt][nb][g4 * 4 + 2], acc[mt][nb][g4 * 4 + 3]); *(u32x2*)(orow + nb * 32 + g4 * 8) = pk; }
                }
            }
        }
        asm volatile("s_waitcnt vmcnt(0)" ::: "memory");
        __syncthreads();
    }
#undef MOE_ISSUE_A
#undef MOE_ISSUE_B
#undef MOE_ITER
#undef MOE_FRAGS
#undef MOE_MMAS
#undef MOE_PIPE
}


__device__ void ph11_combine(const Params& p) {
    const bf16_t* Y0 = (const bf16_t*)(p.ws + WS_YS); const bf16_t* Y1 = Y0 + (size_t)NTOK * 2048; const float* mod = (const float*)(p.ws + WS_MOD);
    const size_t n8 = (size_t)NTOK * 2048 / 8;
    for (size_t i = (size_t)blockIdx.x * NTHREADS + threadIdx.x; i < n8; i += (size_t)gridDim.x * NTHREADS) {
        const size_t e0 = i * 8; const int col = (int)(e0 & 2047), b = (int)(e0 >> 22);
        const u32x4 a = *(const u32x4*)(Y0 + e0), c = *(const u32x4*)(Y1 + e0);
        const float* gt = mod + (size_t)b * 12288 + 10240 + col; const f32x4 g0 = *(const f32x4*)gt, g1 = *(const f32x4*)(gt + 4);
        float* po = p.out + e0; f32x4 o0 = *(const f32x4*)po, o1 = *(const f32x4*)(po + 4);
        o0[0] += g0[0] * (bf_lo(a.x) + bf_lo(c.x)); o0[1] += g0[1] * (bf_hi(a.x) + bf_hi(c.x)); o0[2] += g0[2] * (bf_lo(a.y) + bf_lo(c.y)); o0[3] += g0[3] * (bf_hi(a.y) + bf_hi(c.y));
        o1[0] += g1[0] * (bf_lo(a.z) + bf_lo(c.z)); o1[1] += g1[1] * (bf_hi(a.z) + bf_hi(c.z)); o1[2] += g1[2] * (bf_lo(a.w) + bf_lo(c.w)); o1[3] += g1[3] * (bf_hi(a.w) + bf_hi(c.w));
        *(f32x4*)po = o0; *(f32x4*)(po + 4) = o1;
    }
}

__global__ void __launch_bounds__(NTHREADS, 2) mk_fwd(Params p) {
    extern __shared__ __attribute__((aligned(16))) unsigned char shm[];
    LAS unsigned char* lds = (LAS unsigned char*)shm;
    const int lo = p.ph_lo, hi = p.ph_hi;
    if (threadIdx.x < 4) ((LAS unsigned*)(lds + LDS_BARW))[threadIdx.x] = 0u;
    __syncthreads();
    XcdBarrier bar; bar.bar = (unsigned*)(p.ws + WS_BAR); bar.x = 0; bar.st = nullptr;
    if (hi - lo > 1) bar = xcd_barrier_post((unsigned*)(p.ws + WS_BAR), (volatile LAS unsigned*)(lds + LDS_BARW));
#ifndef SKIP_MASK
#define SKIP_MASK 0
#endif
#define IN(k) (!((SKIP_MASK >> (k)) & 1) && lo <= (k) && (k) < hi)
#define SEAM(k) do { if (IN(k) && IN((k) + 1)) xcd_barrier(bar); } while (0)
    const int G = gridDim.x, bx = blockIdx.x;
#ifndef REP_PHASE
#define REP_PHASE 0
#endif
#define RUN(k, ...) do { if (IN(k)) { { const int rep = 0; (void)rep; __VA_ARGS__ } if ((REP_PHASE >> (k)) & 1) { xcd_barrier(bar); { const int rep = 1; (void)rep; __VA_ARGS__ } } } SEAM(k); } while (0)
    RUN(0, ph0_prologue(p, lds););
    RUN(1, ph1_norm(p););
    RUN(2, pg8::StaticOrder S; S.init(p.ws + WS_H, p.ws + WS_WIN, NTOK, DINP, DM, G, bx); EpiProj E{p.ws, p.in[I_BGATE]};
           pg8::gemm_phase<EpiProj, pg8::StaticOrder, false>(lds, DM, S, E););
    RUN(3, ph3_prep(p, lds, rep););
    RUN(4, ph4_attn(p, lds););
    RUN(5, { pg8::StaticOrder S; S.init(p.ws + WS_OA, p.ws + WS_WPA, NTOK, DM, 1024, G, bx); EpiGate1 E{(const bf16_t*)(p.ws + WS_GATES), (float*)(p.ws + WS_T1)};
             pg8::gemm_phase<EpiGate1, pg8::StaticOrder, false>(lds, 1024, S, E); }
           { pg8::StaticOrder S; S.init(p.ws + WS_OB, p.ws + WS_WPB, NTOK, DM, 1024, G, bx); EpiGate2 E{(const bf16_t*)(p.ws + WS_GATES), (const float*)(p.ws + WS_T1), (bf16_t*)(p.ws + WS_MERGED)};
             pg8::gemm_phase<EpiGate2, pg8::StaticOrder, false>(lds, 1024, S, E); });
    RUN(6, pg8::StaticOrder S; S.init(p.ws + WS_MERGED, p.ws + WS_WO, NTOK, DM, DM, G, bx); EpiWo E{p.in[I_X], (const float*)(p.ws + WS_MOD), p.out};
           pg8::gemm_phase<EpiWo, pg8::StaticOrder, false>(lds, DM, S, E););
    RUN(7, ph8_router(p, lds, rep););
    RUN(8, moe_gemm<true>(p, lds, rep););
    RUN(9, moe_gemm<false>(p, lds, rep););
    RUN(10, if (!rep) ph11_combine(p););
#undef RUN
#undef IN
#undef SEAM
}

constexpr int NPHASES = 11;
extern "C" void kernel_launch(void* const* d_in, const int* in_sizes, int n_in, void* d_out, int out_size, void* d_ws, size_t ws_size, hipStream_t stream) {
    static int grid = 0;
    if (grid == 0) {
        if (n_in != 25 || in_sizes[0] != NTOK * DM || out_size != NTOK * DM || ws_size < WS_END2) {
            fprintf(stderr, "kernel_launch: shape mismatch: n_in %d in0 %d out %d ws %zu (need %zu)\n", n_in, n_in > 0 ? in_sizes[0] : -1, out_size, ws_size, (size_t)WS_END2); grid = -1; return; }
        int dev = 0, cus = 0, per_cu = 0;
        if (hipGetDevice(&dev) != hipSuccess || hipDeviceGetAttribute(&cus, hipDeviceAttributeMultiprocessorCount, dev) != hipSuccess) { fprintf(stderr, "kernel_launch: device query failed\n"); grid = -1; return; }
        if (hipFuncSetAttribute((const void*)mk_fwd, hipFuncAttributeMaxDynamicSharedMemorySize, LDS_BYTES) != hipSuccess) { fprintf(stderr, "kernel_launch: hipFuncSetAttribute failed\n"); grid = -1; return; }
        if (hipOccupancyMaxActiveBlocksPerMultiprocessor(&per_cu, (const void*)mk_fwd, NTHREADS, LDS_BYTES) != hipSuccess || per_cu < 1) { fprintf(stderr, "kernel_launch: occupancy query says %d blocks per CU\n", per_cu); }
        (void)hipGetLastError();
        grid = cus;
    }
    if (grid < 0) return;
    if (hipMemsetAsync((char*)d_ws + WS_BAR, 0, WS_ZERO_BYTES, stream) != hipSuccess) { fprintf(stderr, "kernel_launch: memset failed\n"); return; }
    Params p; memset(&p, 0, sizeof(p));
    for (int i = 0; i < 25; ++i) p.in[i] = (const float*)d_in[i];
    p.out = (float*)d_out; p.ws = (unsigned char*)d_ws;
    unsigned char* ws = (unsigned char*)d_ws;
    auto job = [&](int j, const float* src, size_t dst_off, int K, int N, int ldd, int map, int nbatch, long sbatch, long dbatch) {
        TJob& J = p.jobs[j]; J.src = src; J.dst = (bf16_t*)(ws + dst_off); J.K = K; J.N = N; J.ldd = ldd; J.map = map; J.ntk = K / 64; J.ntn = (N + 63) / 64; J.nbatch = nbatch; J.sbatch = sbatch; J.dbatch = dbatch; };
    job(0, p.in[I_WIN], WS_WIN, 2048, DIN, 2048, 1, 1, 0, 0);
    job(1, p.in[I_WPA], WS_WPA, 1024, 2048, 1024, 0, 1, 0, 0);
    job(2, p.in[I_WPB], WS_WPB, 1024, 2048, 1024, 0, 1, 0, 0);
    job(3, p.in[I_WO], WS_WO, 2048, 2048, 2048, 0, 1, 0, 0);
    job(4, p.in[I_WUK], WS_WUK, 128, 256, 128, 0, 8, 128L * 256, 256L * 128);
    job(5, p.in[I_WUV], WS_WUV, 256, 128, 256, 0, 8, 256L * 128, 128L * 256);
    int t0 = 0; for (int j = 0; j < NJOBS; ++j) { p.jobs[j].tile0 = t0; t0 += p.jobs[j].ntk * p.jobs[j].ntn * p.jobs[j].nbatch; }
    p.ntiles_total = t0;
#if MK_LAUNCHES == 1
    p.ph_lo = 0; p.ph_hi = NPHASES;
    hipLaunchKernelGGL(mk_fwd, dim3(grid), dim3(NTHREADS), LDS_BYTES, stream, p);
#else
    for (int k = 0; k < NPHASES; ++k) { p.ph_lo = k; p.ph_hi = k + 1; hipLaunchKernelGGL(mk_fwd, dim3(grid), dim3(NTHREADS), LDS_BYTES, stream, p); }
#endif
    const hipError_t le = hipPeekAtLastError();
    if (le != hipSuccess) fprintf(stderr, "kernel_launch: launch failed: %s\n", hipGetErrorName(le));
}

#ifdef DIAG_PHASES
template <int PH> __global__ void __launch_bounds__(NTHREADS, 2) k_ph(Params p) {
    extern __shared__ __attribute__((aligned(16))) unsigned char shm[];
    LAS unsigned char* lds = (LAS unsigned char*)shm; const int G = gridDim.x, bx = blockIdx.x;
    if constexpr (PH == 0) ph0_prologue(p, lds);
    if constexpr (PH == 1) ph1_norm(p);
    if constexpr (PH == 2) { pg8::StaticOrder S; S.init(p.ws + WS_H, p.ws + WS_WIN, NTOK, DINP, DM, G, bx); EpiProj E{p.ws, p.in[I_BGATE]}; pg8::gemm_phase<EpiProj, pg8::StaticOrder, false>(lds, DM, S, E); }
    if constexpr (PH == 3) ph3_prep(p, lds, 0);
    if constexpr (PH == 4) ph4_attn(p, lds);
    if constexpr (PH == 5) ph5_oa(p);
    if constexpr (PH == 6) { pg8::StaticOrder S; S.init(p.ws + WS_OA, p.ws + WS_WPA, NTOK, DM, 1024, G, bx); EpiGate1 E{(const bf16_t*)(p.ws + WS_GATES), (float*)(p.ws + WS_T1)}; pg8::gemm_phase<EpiGate1, pg8::StaticOrder, false>(lds, 1024, S, E); }
    if constexpr (PH == 7) { pg8::StaticOrder S; S.init(p.ws + WS_MERGED, p.ws + WS_WO, NTOK, DM, DM, G, bx); EpiWo E{p.in[I_X], (const float*)(p.ws + WS_MOD), p.out}; pg8::gemm_phase<EpiWo, pg8::StaticOrder, false>(lds, DM, S, E); }
    if constexpr (PH == 8) ph8_router(p, lds, 0);
    if constexpr (PH == 9) moe_gemm<true>(p, lds, 0);
    if constexpr (PH == 10) moe_gemm<false>(p, lds, 0);
    if constexpr (PH == 12) { const int r = bx; dsa_item(p, lds, r & 3, r >> 2); }
    if constexpr (PH == 13) { const int r = bx; fox_item(p, lds, r & 3, (r >> 2) & 7, r >> 5); }
    if constexpr (PH == 14) { idx_item(p, lds, bx & 3, (bx >> 2) & 31, bx >> 7); }
}
template __global__ void k_ph<0>(Params); template __global__ void k_ph<1>(Params); template __global__ void k_ph<2>(Params); template __global__ void k_ph<3>(Params);
template __global__ void k_ph<4>(Params); template __global__ void k_ph<5>(Params); template __global__ void k_ph<6>(Params); template __global__ void k_ph<7>(Params);
template __global__ void k_ph<8>(Params); template __global__ void k_ph<9>(Params); template __global__ void k_ph<10>(Params); template __global__ void k_ph<11>(Params);
template __global__ void k_ph<12>(Params); template __global__ void k_ph<13>(Params); template __global__ void k_ph<14>(Params);
#endif
```

```cpp
#include <hip/hip_runtime.h>
#include <cstdio>
#include <cstdint>
#include <cstring>

#ifndef MK_LAUNCHES
#define MK_LAUNCHES 1
#endif

#define LAS __attribute__((address_space(3)))
typedef unsigned short bf16_t;
typedef short bf16x8 __attribute__((ext_vector_type(8)));
typedef short s16x4 __attribute__((ext_vector_type(4)));
typedef float f32x4 __attribute__((ext_vector_type(4)));
typedef float f32x16 __attribute__((ext_vector_type(16)));
typedef unsigned u32x4 __attribute__((ext_vector_type(4)));
typedef unsigned u32x2 __attribute__((ext_vector_type(2)));

constexpr int DM = 2048, NBATCH = 4, SEQ = 2048, NTOK = NBATCH * SEQ;
constexpr int DIN = 9560, DINP = 9728;
constexpr int NEXP = 64, DEXP = 512, LCAP = 8192;
constexpr float RMS_EPS = 1e-6f;
constexpr float LOG2E = 1.4426950408889634f;
constexpr int NTHREADS = 512;
constexpr int LDS_BYTES = 163840 - 1024;
constexpr int LDS_BARW = LDS_BYTES - 16;
constexpr int LDS_TAB = 131072;

constexpr size_t al256(size_t x) { return (x + 255) / 256 * 256; }
constexpr size_t WS_BAR = 0;
constexpr size_t WS_CNT = 16384;
constexpr size_t WS_ZERO_BYTES = 16384 + 4096;
constexpr size_t WS_MOD = WS_ZERO_BYTES;
constexpr size_t WS_H = al256(WS_MOD + (size_t)4 * 12288 * 4);
constexpr size_t WS_WIN = al256(WS_H + (size_t)NTOK * DM * 2);
constexpr size_t WS_WPA = al256(WS_WIN + (size_t)DINP * DM * 2);
constexpr size_t WS_WPB = al256(WS_WPA + (size_t)2048 * 1024 * 2);
constexpr size_t WS_WO = al256(WS_WPB + (size_t)2048 * 1024 * 2);
constexpr size_t WS_WUK = al256(WS_WO + (size_t)2048 * 2048 * 2);
constexpr size_t WS_WUV = al256(WS_WUK + (size_t)8 * 256 * 128 * 2);
constexpr size_t WS_W13 = al256(WS_WUV + (size_t)8 * 128 * 256 * 2);
constexpr size_t WS_W2 = al256(WS_W13 + (size_t)64 * 1024 * 2048 * 2);
constexpr size_t WS_QA = al256(WS_W2 + (size_t)64 * 2048 * 512 * 2);
constexpr size_t WS_CKV = al256(WS_QA + (size_t)NTOK * 1024 * 2);
constexpr size_t WS_KV = al256(WS_CKV + (size_t)NTOK * 256 * 4);
constexpr size_t WS_QIDX = al256(WS_KV + (size_t)NTOK * 256 * 2);
constexpr size_t WS_MISC = al256(WS_QIDX + (size_t)NTOK * 1024 * 2);
constexpr size_t WS_QB = al256(WS_MISC + (size_t)NTOK * 256 * 4);
constexpr size_t WS_KB = al256(WS_QB + (size_t)NTOK * 1024 * 2);
constexpr size_t WS_VB = al256(WS_KB + (size_t)NTOK * 1024 * 2);
constexpr size_t WS_GATES = al256(WS_VB + (size_t)NTOK * 1024 * 2);
constexpr size_t WS_QLAT = al256(WS_GATES + (size_t)NTOK * 4096 * 2);
constexpr size_t WS_MASK = al256(WS_QLAT + (size_t)NTOK * 2048 * 2);
constexpr size_t WS_CUM = al256(WS_MASK + (size_t)NTOK * 256);
constexpr size_t WS_OLAT = al256(WS_CUM + (size_t)4 * 8 * 2048 * 4);
constexpr size_t WS_OA = al256(WS_OLAT + (size_t)NTOK * 2048 * 2);
constexpr size_t WS_OB = al256(WS_OA + (size_t)NTOK * 1024 * 2);
constexpr size_t WS_T1 = al256(WS_OB + (size_t)NTOK * 1024 * 2);
constexpr size_t WS_MERGED = al256(WS_T1 + (size_t)NTOK * 2048 * 4);
constexpr size_t WS_LTOK = al256(WS_MERGED + (size_t)NTOK * 2048 * 2);
constexpr size_t WS_LW = al256(WS_LTOK + (size_t)NEXP * LCAP * 4);
constexpr size_t WS_ACT = al256(WS_LW + (size_t)NEXP * LCAP * 4);
constexpr size_t WS_HLO = al256(WS_ACT + (size_t)32768 * 512 * 2);
constexpr size_t WS_WRH = al256(WS_HLO + (size_t)NTOK * DM * 2);
constexpr size_t WS_WRL = al256(WS_WRH + (size_t)80 * DM * 2);
constexpr size_t WS_END = al256(WS_WRL + (size_t)80 * DM * 2);
constexpr size_t WS_KIDX = WS_END;
constexpr size_t WS_END2 = al256(WS_KIDX + (size_t)NTOK * 64 * 2);
constexpr size_t WS_H8 = WS_END2;
constexpr size_t WS_ACT8 = al256(WS_H8 + (size_t)NTOK * DM);
constexpr size_t WS_END3 = al256(WS_ACT8 + (size_t)16384 * 512);
constexpr size_t WS_YS = WS_T1;
constexpr size_t WS_HG = WS_QA;
static_assert(WS_HG + (size_t)32768 * DM * 2 <= WS_QLAT, "hg alias must fit in the dead region");

struct TJob { const float* src; bf16_t* dst; int K, N, ldd, map, ntk, ntn, nbatch, tile0; long sbatch, dbatch; };
constexpr int NJOBS = 6;
struct Params {
    const float* in[25];
    float* out;
    unsigned char* ws;
    TJob jobs[NJOBS];
    int ntiles_total;
    int ph_lo, ph_hi;
};
enum { I_X = 0, I_C, I_WADA, I_BADA, I_GMIX, I_WIN, I_BGATE, I_BFORGET, I_WUK, I_WUV, I_GQA, I_GKV, I_GQB, I_GKB, I_WPA, I_WPB, I_WO, I_GFFN, I_WRG, I_BRG, I_WRE, I_BRE, I_W1, I_W3, I_W2 };

__device__ __forceinline__ unsigned cvt_pk_bf16(float lo, float hi) { unsigned r; asm volatile("v_cvt_pk_bf16_f32 %0, %1, %2" : "=v"(r) : "v"(lo), "v"(hi)); return r; }
__device__ __forceinline__ float bf_lo(unsigned w) { return __uint_as_float(w << 16); }
__device__ __forceinline__ float bf_hi(unsigned w) { return __uint_as_float(w & 0xffff0000u); }
typedef float f32x2 __attribute__((ext_vector_type(2)));
__device__ __forceinline__ unsigned pack_fp8x4(float a, float b, float c, float d) { int w = __builtin_amdgcn_cvt_pk_fp8_f32(a, b, 0, false); w = __builtin_amdgcn_cvt_pk_fp8_f32(c, d, w, true); return (unsigned)w; }
__device__ __forceinline__ bf16x8 fp8x8_to_bf16(u32x2 v) {
    const f32x2 a = __builtin_amdgcn_cvt_pk_f32_fp8((int)v.x, false), b = __builtin_amdgcn_cvt_pk_f32_fp8((int)v.x, true), c = __builtin_amdgcn_cvt_pk_f32_fp8((int)v.y, false), d = __builtin_amdgcn_cvt_pk_f32_fp8((int)v.y, true);
    u32x4 w; w.x = cvt_pk_bf16(a.x, a.y); w.y = cvt_pk_bf16(b.x, b.y); w.z = cvt_pk_bf16(c.x, c.y); w.w = cvt_pk_bf16(d.x, d.y); return *reinterpret_cast<bf16x8*>(&w); }
__device__ __forceinline__ float wave_sum(float v) {
#pragma unroll
    for (int o = 32; o >= 1; o >>= 1) v += __shfl_xor(v, o);
    return v;
}
__device__ __forceinline__ float sigmoidf_(float x) { return 1.0f / (1.0f + __expf(-x)); }
__device__ __forceinline__ int crow(int r, int hi) { return (r & 3) + 8 * (r >> 2) + 4 * hi; }
#define SBAR() __builtin_amdgcn_sched_barrier(0)

#define XB_TMO      128
#define XB_XCNT(j)  (256  + 64 * (j))
#define XB_XSUB(j)  (1280 + 64 * (j))
#define XB_XGEN(j)  (2304 + 64 * (j))
#define XB_TOP      3328
#define XB_TOPGEN   3392
#define XCD_BAR_WORDS 3456
#define XB_SPIN_CAP (1u << 20)
__device__ __forceinline__ unsigned xb_ld(unsigned* p)              { return __hip_atomic_load(p, __ATOMIC_RELAXED, __HIP_MEMORY_SCOPE_AGENT); }
__device__ __forceinline__ unsigned xb_add(unsigned* p, unsigned v) { return __hip_atomic_fetch_add(p, v, __ATOMIC_RELAXED, __HIP_MEMORY_SCOPE_AGENT); }
__device__ __forceinline__ unsigned xb_xcc_id() { return (unsigned)__builtin_amdgcn_s_getreg((3 << 11) | 20) & 0xFu; }
#define XB_SPIN(cond, bar) do { unsigned _sp = 0; while (cond) { __builtin_amdgcn_s_sleep(1); \
    if ((++_sp & 255u) == 0u) { if (xb_ld(&(bar)[XB_TMO])) break; if (_sp > XB_SPIN_CAP) { atomicAdd(&(bar)[XB_TMO], 1u); break; } } } } while (0)
struct XcdBarrier { unsigned* bar; unsigned x; volatile LAS unsigned* st; };
__device__ __forceinline__ XcdBarrier xcd_barrier_post(unsigned* bar, volatile LAS unsigned* st) {
    XcdBarrier b; b.bar = bar; b.x = xb_xcc_id(); b.st = st;
    if (threadIdx.x == 0) (void)xb_add(&bar[XB_XCNT(b.x)], 1u);
    return b;
}
__device__ __forceinline__ void xcd_barrier_complete(unsigned* bar, unsigned x, unsigned& nloc, unsigned& nx) {
    const unsigned G = gridDim.x * gridDim.y * gridDim.z;
    unsigned sum, cnt, mine, sp = 0u;
    for (;;) {
        sum = 0u; cnt = 0u; mine = 0u;
#pragma unroll
        for (unsigned j = 0; j < 16; ++j) { const unsigned c = xb_ld(&bar[XB_XCNT(j)]); sum += c; cnt += (c > 0u) ? 1u : 0u; mine = (j == x) ? c : mine; }
        if (sum == G) break;
        __builtin_amdgcn_s_sleep(1);
        if ((++sp & 255u) == 0u) { if (xb_ld(&bar[XB_TMO])) break; if (sp > XB_SPIN_CAP) { atomicAdd(&bar[XB_TMO], 1u); break; } }
    }
    nloc = mine > 0u ? mine : 1u; nx = cnt > 0u ? cnt : 1u;
}
__device__ __forceinline__ void xcd_barrier(const XcdBarrier& b) {
    asm volatile("s_waitcnt vmcnt(0)" ::: "memory");
    __syncthreads();
    if (threadIdx.x == 0) {
        unsigned* bar = b.bar;
        __builtin_amdgcn_s_waitcnt(0);
        unsigned nloc = b.st[0], nx = b.st[1];
        if (nloc == 0u) { xcd_barrier_complete(bar, b.x, nloc, nx); b.st[0] = nloc; b.st[1] = nx; }
        const unsigned old = xb_add(&bar[XB_XSUB(b.x)], 1u);
        const unsigned gen = old / nloc;
        if (old + 1u == (gen + 1u) * nloc) {
            __builtin_amdgcn_fence(__ATOMIC_RELEASE, "agent");
            asm volatile("s_waitcnt vmcnt(0)" ::: "memory");
            const unsigned og = xb_add(&bar[XB_TOP], 1u);
            const unsigned tg = og / nx;
            if (og + 1u == (tg + 1u) * nx) xb_add(&bar[XB_TOPGEN], 1u);
            else XB_SPIN(xb_ld(&bar[XB_TOPGEN]) == tg, bar);
            __builtin_amdgcn_fence(__ATOMIC_ACQUIRE, "agent");
            xb_add(&bar[XB_XGEN(b.x)], 1u);
            asm volatile("s_waitcnt vmcnt(0)" ::: "memory");
        } else {
            XB_SPIN(xb_ld(&bar[XB_XGEN(b.x)]) == gen, bar);
            __builtin_amdgcn_fence(__ATOMIC_ACQUIRE, "agent");
            asm volatile("s_waitcnt vmcnt(0)" ::: "memory");
        }
    }
    __syncthreads();
}

namespace pg8 {
constexpr int BM = 256, BK = 64, HALF = 128, HTB = HALF * BK * 2, STAGE_BYTES = 8 * HTB, NXCD = 8, WGM = 8;
__host__ __device__ __forceinline__ int lds_byte(int r, int c) { const int st = (r >> 4) * 2 + (c >> 5), rr = r & 15, cc = c & 31, ob = rr * 64 + cc * 2; return st * 1024 + (ob ^ (((ob >> 9) & 1) << 5)); }
__host__ __device__ __forceinline__ void stage_rc(int b, int& R, int& C) { const int st = b / 1024, sb = b % 1024, swz = sb ^ (((sb >> 9) & 1) << 5); R = (st >> 1) * 16 + swz / 64; C = (st & 1) * 32 + (swz % 64) / 2; }
__host__ __device__ __forceinline__ int perm32(int rho) { const int n = rho >> 4, i = rho & 15; return 8 * (i >> 2) + 4 * n + (i & 3); }

struct Unit { int pm, pn; const char* a; const char* b; const int* gi; int nvalid; int aux; };

struct StaticOrder {
    int nM, nN, nwg, G, c, K; const char* A; const char* Bt;
    __device__ void init(const void* A_, const void* Bt_, int M, int N, int K_, int G_, int c_) { A = (const char*)A_; Bt = (const char*)Bt_; K = K_; nM = M / BM; nN = N / BM; nwg = nM * nN; G = G_; c = c_; }
    __device__ bool next(int i, Unit& u) const {
        const long L = (long)i * G + c; if (L >= nwg) return false;
        int wgid = (int)L; { const int q = nwg / NXCD, r = nwg % NXCD, xcd = wgid % NXCD, off = wgid / NXCD; wgid = (xcd < r ? xcd * (q + 1) : r * (q + 1) + (xcd - r) * q) + off; }
        const int nig = WGM * nN, gid = wgid / nig, fm = gid * WGM, gsz = (nM - fm) < WGM ? (nM - fm) : WGM;
        u.pm = fm + ((wgid % nig) % gsz); u.pn = (wgid % nig) / gsz;
        u.a = A + (size_t)u.pm * BM * K * 2; u.b = Bt + (size_t)u.pn * BM * K * 2; u.gi = nullptr; u.nvalid = BM; u.aux = 0; return true;
    }
};

template <class Epi, class Sched, bool GATHER>
__device__ __forceinline__ void gemm_phase(LAS unsigned char* lds, const int K, const Sched& S, const Epi& E) {
    const int tid = threadIdx.x, wid = __builtin_amdgcn_readfirstlane(tid >> 6), lane = tid & 63, wr = wid >> 2, wc = wid & 3, fr = lane & 15, fq = lane >> 4;
    const int nt = K / BK;
    unsigned voffA[2], voffB[2]; int RA[2], CA[2];
#pragma unroll
    for (int i = 0; i < 2; ++i) { int R, C; stage_rc(tid * 16 + i * 8192, R, C); const int Rb = ((R & ~31) + perm32(R & 31));
        RA[i] = R; CA[i] = C; voffA[i] = (unsigned)(R * K + C) * 2u; voffB[i] = (unsigned)(Rb * K + C) * 2u; }
    const size_t kstep = (size_t)(BK * 2);
    const size_t hstep = (size_t)HALF * K * 2;
    const unsigned ldsw = (unsigned)wid * 1024u;
    const int aoff = lds_byte(wr * 64 + fr, fq * 8), boff = lds_byte(wc * 32 + fr, fq * 8);
    unsigned gA[2][2], gN[2][2];
#define PG8_SA(b, h) (((b) * 2 + (h)) * HTB)
#define PG8_SB(b, h) ((4 + (b) * 2 + (h)) * HTB)
#define PG8_STAGE(bufoff, gbase, voff) do { _Pragma("unroll") for (int _i = 0; _i < 2; ++_i) \
        __builtin_amdgcn_global_load_lds((const unsigned*)((const char*)(gbase) + (voff)[_i]), (LAS unsigned*)(lds + (bufoff) + ldsw + _i * 8192), 16, 0, 0); } while (0)
#define PG8_STAGE_A(bufoff, gp, h, NX) do { if constexpr (GATHER) { if (NX) PG8_STAGE(bufoff, gp, gN[h]); else PG8_STAGE(bufoff, gp, gA[h]); } else PG8_STAGE(bufoff, (gp) + (h) * hstep, voffA); } while (0)
#define PG8_LDA(dst, b, h) do { _Pragma("unroll") for (int m = 0; m < 4; ++m) _Pragma("unroll") for (int k = 0; k < 2; ++k) dst[m][k] = *(const LAS bf16x8*)(lds + PG8_SA(b, h) + aoff + m * 2048 + k * 1024); } while (0)
#define PG8_LDB(dst, b, h) do { _Pragma("unroll") for (int n = 0; n < 2; ++n) _Pragma("unroll") for (int k = 0; k < 2; ++k) dst[n][k] = *(const LAS bf16x8*)(lds + PG8_SB(b, h) + boff + n * 2048 + k * 1024); } while (0)
#define PG8_MMA(ai, bj, At, Bt) do { __builtin_amdgcn_s_setprio(1); _Pragma("unroll") for (int m = 0; m < 4; ++m) _Pragma("unroll") for (int n = 0; n < 2; ++n) _Pragma("unroll") for (int k = 0; k < 2; ++k) \
        acc[ai][bj][m][n] = __builtin_amdgcn_mfma_f32_16x16x32_bf16(Bt[n][k], At[m][k], acc[ai][bj][m][n], 0, 0, 0); __builtin_amdgcn_s_setprio(0); } while (0)
#define PG8_WAIT_V(n) asm volatile("s_waitcnt vmcnt(" #n ")" ::: "memory")
#define PG8_WAIT_L(n) asm volatile("s_waitcnt lgkmcnt(" #n ")" ::: "memory")
#define PG8_BAR __builtin_amdgcn_s_barrier()
#define PG8_SCHED __builtin_amdgcn_sched_barrier(0)
#define PG8_GIDX(dst, u) do { if constexpr (GATHER) { _Pragma("unroll") for (int h = 0; h < 2; ++h) _Pragma("unroll") for (int i = 0; i < 2; ++i) { \
        const int rr = h * HALF + RA[i]; const int tok = rr < (u).nvalid ? (u).gi[rr] : 0; dst[h][i] = (unsigned)(tok * K + CA[i]) * 2u; } } } while (0)
    Unit cur, nxt; int ui = 0;
    if (!S.next(0, cur)) return;
    f32x4 acc[2][2][4][2];
#pragma unroll
    for (int a = 0; a < 2; ++a)
#pragma unroll
        for (int b = 0; b < 2; ++b)
#pragma unroll
            for (int m = 0; m < 4; ++m)
#pragma unroll
                for (int n = 0; n < 2; ++n) acc[a][b][m][n] = (f32x4){0.f, 0.f, 0.f, 0.f};
    bf16x8 At[4][2], B0[2][2], B1[2][2];
    const char* cA = cur.a; const char* cB = cur.b;
    PG8_GIDX(gA, cur);
    PG8_STAGE(PG8_SB(0, 0), cB, voffB); PG8_STAGE_A(PG8_SA(0, 0), cA, 0, false); PG8_STAGE(PG8_SB(0, 1), cB + hstep, voffB); PG8_STAGE_A(PG8_SA(0, 1), cA, 1, false);
    if (wr == 1) PG8_BAR;
    PG8_WAIT_V(4); PG8_BAR;
    PG8_STAGE(PG8_SB(1, 0), cB + kstep, voffB); PG8_STAGE_A(PG8_SA(1, 0), cA + kstep, 0, false); PG8_STAGE(PG8_SB(1, 1), cB + hstep + kstep, voffB);
    PG8_WAIT_V(6); PG8_BAR;
    for (;;) {
        const bool has_next = S.next(ui + 1, nxt);
        const char* nA = has_next ? nxt.a : cA; const char* nB = has_next ? nxt.b : cB;
        if constexpr (GATHER) { if (has_next) { PG8_GIDX(gN, nxt); } else {
#pragma unroll
            for (int h = 0; h < 2; ++h)
#pragma unroll
                for (int i = 0; i < 2; ++i) gN[h][i] = gA[h][i]; } }
        for (int t = 0; t < nt; t += 2) {
            const bool last = (t == nt - 2);
            const char* a1 = cA + (size_t)(t + 1) * kstep;
            const char* a2 = last ? nA : cA + (size_t)(t + 2) * kstep; const char* b2 = last ? nB : cB + (size_t)(t + 2) * kstep;
            const char* a3 = a2 + kstep; const char* b3 = b2 + kstep;
            PG8_LDB(B0, 0, 0); PG8_SCHED; PG8_LDA(At, 0, 0); PG8_STAGE_A(PG8_SA(1, 1), a1, 1, false);
            PG8_WAIT_L(8); PG8_BAR; PG8_WAIT_L(0); PG8_MMA(0, 0, At, B0); PG8_BAR; PG8_SCHED;
            PG8_LDB(B1, 0, 1); PG8_STAGE(PG8_SB(0, 0), b2, voffB);
            PG8_BAR; PG8_WAIT_L(0); PG8_MMA(0, 1, At, B1); PG8_BAR;
            PG8_LDA(At, 0, 1); PG8_STAGE_A(PG8_SA(0, 0), a2, 0, last);
            PG8_BAR; PG8_WAIT_L(0); PG8_MMA(1, 0, At, B0); PG8_BAR; PG8_SCHED;
            PG8_STAGE(PG8_SB(0, 1), b2 + hstep, voffB);
            PG8_WAIT_V(6); PG8_BAR; PG8_MMA(1, 1, At, B1); PG8_BAR;
            PG8_LDB(B0, 1, 0); PG8_SCHED; PG8_LDA(At, 1, 0); PG8_STAGE_A(PG8_SA(0, 1), a2, 1, last);
            PG8_WAIT_L(8); PG8_BAR; PG8_WAIT_L(0); PG8_MMA(0, 0, At, B0); PG8_BAR; PG8_SCHED;
            PG8_LDB(B1, 1, 1); PG8_STAGE(PG8_SB(1, 0), b3, voffB);
            PG8_BAR; PG8_WAIT_L(0); PG8_MMA(0, 1, At, B1); PG8_BAR;
            PG8_LDA(At, 1, 1); PG8_STAGE_A(PG8_SA(1, 0), a3, 0, last);
            PG8_BAR; PG8_WAIT_L(0); PG8_MMA(1, 0, At, B0); PG8_BAR; PG8_SCHED;
            PG8_STAGE(PG8_SB(1, 1), b3 + hstep, voffB);
            PG8_WAIT_V(6); PG8_BAR; PG8_MMA(1, 1, At, B1); PG8_BAR;
        }
        bool keep_acc = false;
        if constexpr (Epi::DUAL) { if (cur.aux) { E.mid(acc, cur, wr, wc, fr, fq); keep_acc = true; } else E(acc, cur, wr, wc, fr, fq); } else E(acc, cur, wr, wc, fr, fq);
        if (!has_next) break;
        if (!keep_acc)
#pragma unroll
        for (int a = 0; a < 2; ++a)
#pragma unroll
            for (int b = 0; b < 2; ++b)
#pragma unroll
                for (int m = 0; m < 4; ++m)
#pragma unroll
                    for (int n = 0; n < 2; ++n) acc[a][b][m][n] = (f32x4){0.f, 0.f, 0.f, 0.f};
        cur = nxt; cA = nA; cB = nB; ++ui;
        if constexpr (GATHER) {
#pragma unroll
            for (int h = 0; h < 2; ++h)
#pragma unroll
                for (int i = 0; i < 2; ++i) gA[h][i] = gN[h][i]; }
    }
    PG8_WAIT_V(0);
    if (wr == 0) PG8_BAR;
    PG8_BAR;
#undef PG8_SA
#undef PG8_SB
#undef PG8_STAGE
#undef PG8_STAGE_A
#undef PG8_LDA
#undef PG8_LDB
#undef PG8_MMA
#undef PG8_WAIT_V
#undef PG8_WAIT_L
#undef PG8_BAR
#undef PG8_SCHED
#undef PG8_GIDX
}
}
using pg8::Unit;

#define EPI_LOOP(...) { int fr_ = fr, fq_ = fq; asm volatile("" : "+v"(fr_), "+v"(fq_)); _Pragma("unroll") for (int ai = 0; ai < 2; ++ai) _Pragma("unroll") for (int m = 0; m < 4; ++m) _Pragma("unroll") for (int bj = 0; bj < 2; ++bj) { \
        const int trow = ai * 128 + wr * 64 + m * 16 + fr_; const int tcol = bj * 128 + wc * 32 + fq_ * 8; const f32x4 v0 = acc[ai][bj][m][0], v1 = acc[ai][bj][m][1]; __VA_ARGS__ } }

__device__ __forceinline__ u32x4 pack8(const f32x4 a, const f32x4 b) { u32x4 w; w.x = cvt_pk_bf16(a[0], a[1]); w.y = cvt_pk_bf16(a[2], a[3]); w.z = cvt_pk_bf16(b[0], b[1]); w.w = cvt_pk_bf16(b[2], b[3]); return w; }

struct EpiProj { static constexpr bool DUAL = false;
    unsigned char* ws; const float* b_gate;
    __device__ __forceinline__ void operator()(const f32x4 (&acc)[2][2][4][2], const Unit& u, int wr, int wc, int fr, int fq) const {
        const int pn = u.pn; const size_t row0 = (size_t)u.pm * 256;
        if (pn == 4 || pn == 9) {
            float* dst = (float*)(ws + (pn == 4 ? WS_CKV : WS_MISC));
            EPI_LOOP({ float* p = dst + (row0 + trow) * 256 + tcol; *(f32x4*)p = v0; *(f32x4*)(p + 4) = v1;
                if (pn == 9 && tcol < 64) *(u32x4*)((bf16_t*)(ws + WS_KIDX) + (row0 + trow) * 64 + tcol) = pack8(v0, v1); })
        } else if (pn < 22) {
            bf16_t* dst; int ct;
            if (pn < 4) { dst = (bf16_t*)(ws + WS_QA); ct = pn; } else if (pn < 9) { dst = (bf16_t*)(ws + WS_QIDX); ct = pn - 5; }
            else if (pn < 14) { dst = (bf16_t*)(ws + WS_QB); ct = pn - 10; } else if (pn < 18) { dst = (bf16_t*)(ws + WS_KB); ct = pn - 14; } else { dst = (bf16_t*)(ws + WS_VB); ct = pn - 18; }
            EPI_LOOP({ *(u32x4*)(dst + (row0 + trow) * 1024 + ct * 256 + tcol) = pack8(v0, v1); })
        } else {
            bf16_t* dst = (bf16_t*)(ws + WS_GATES); const int ct = pn - 22;
            EPI_LOOP({ const int col = ct * 256 + tcol; const f32x4 b0 = *(const f32x4*)(b_gate + col), b1 = *(const f32x4*)(b_gate + col + 4); f32x4 s0, s1;
                _Pragma("unroll") for (int j = 0; j < 4; ++j) { s0[j] = sigmoidf_(v0[j] + b0[j]); s1[j] = sigmoidf_(v1[j] + b1[j]); }
                *(u32x4*)(dst + (row0 + trow) * 4096 + col) = pack8(s0, s1); })
        }
    }
};
struct EpiGate1 { static constexpr bool DUAL = false;
    const bf16_t* gates; float* T1;
    __device__ __forceinline__ void operator()(const f32x4 (&acc)[2][2][4][2], const Unit& u, int wr, int wc, int fr, int fq) const {
        EPI_LOOP({ const size_t row = (size_t)u.pm * 256 + trow; const int col = u.pn * 256 + tcol; const u32x4 g = *(const u32x4*)(gates + row * 4096 + col);
            f32x4 o0 = {v0[0] * bf_lo(g.x), v0[1] * bf_hi(g.x), v0[2] * bf_lo(g.y), v0[3] * bf_hi(g.y)}; f32x4 o1 = {v1[0] * bf_lo(g.z), v1[1] * bf_hi(g.z), v1[2] * bf_lo(g.w), v1[3] * bf_hi(g.w)};
            float* p = T1 + row * 2048 + col; *(f32x4*)p = o0; *(f32x4*)(p + 4) = o1; })
    }
};
struct EpiGate2 { static constexpr bool DUAL = false;
    const bf16_t* gates; const float* T1; bf16_t* merged;
    __device__ __forceinline__ void operator()(const f32x4 (&acc)[2][2][4][2], const Unit& u, int wr, int wc, int fr, int fq) const {
        EPI_LOOP({ const size_t row = (size_t)u.pm * 256 + trow; const int col = u.pn * 256 + tcol; const u32x4 g = *(const u32x4*)(gates + row * 4096 + 2048 + col);
            const float* p = T1 + row * 2048 + col; const f32x4 t0 = *(const f32x4*)p, t1 = *(const f32x4*)(p + 4);
            f32x4 o0 = {t0[0] + v0[0] * bf_lo(g.x), t0[1] + v0[1] * bf_hi(g.x), t0[2] + v0[2] * bf_lo(g.y), t0[3] + v0[3] * bf_hi(g.y)};
            f32x4 o1 = {t1[0] + v1[0] * bf_lo(g.z), t1[1] + v1[1] * bf_hi(g.z), t1[2] + v1[2] * bf_lo(g.w), t1[3] + v1[3] * bf_hi(g.w)};
            *(u32x4*)(merged + row * 2048 + col) = pack8(o0, o1); })
    }
};
struct EpiWo { static constexpr bool DUAL = false;
    const float* x; const float* mod; float* out;
    __device__ __forceinline__ void operator()(const f32x4 (&acc)[2][2][4][2], const Unit& u, int wr, int wc, int fr, int fq) const {
        const float* gt = mod + (size_t)(u.pm >> 3) * 12288 + 4096;
        EPI_LOOP({ const size_t row = (size_t)u.pm * 256 + trow; const int col = u.pn * 256 + tcol; const float* px = x + row * 2048 + col;
            const f32x4 x0 = *(const f32x4*)px, x1 = *(const f32x4*)(px + 4), g0 = *(const f32x4*)(gt + col), g1 = *(const f32x4*)(gt + col + 4);
            float* po = out + row * 2048 + col; *(f32x4*)po = x0 + g0 * v0; *(f32x4*)(po + 4) = x1 + g1 * v1; })
    }
};
struct EpiMoeUp { static constexpr bool DUAL = false;
    bf16_t* act; const float* lw;
    __device__ __forceinline__ void operator()(const f32x4 (&acc)[2][2][4][2], const Unit& u, int wr, int wc, int fr, int fq) const {
        int fr_ = fr, fq_ = fq; asm volatile("" : "+v"(fr_), "+v"(fq_));
#pragma unroll
        for (int ai = 0; ai < 2; ++ai)
#pragma unroll
            for (int m = 0; m < 4; ++m) {
                const int trow = ai * 128 + wr * 64 + m * 16 + fr_; const int tcol = wc * 32 + fq_ * 8;
                const float gw = trow < u.nvalid ? lw[u.aux + trow] : 0.f;
                const f32x4 a0 = acc[ai][0][m][0], a1 = acc[ai][0][m][1], u0 = acc[ai][1][m][0], u1 = acc[ai][1][m][1]; f32x4 o0, o1;
#pragma unroll
                for (int j = 0; j < 4; ++j) { o0[j] = a0[j] * sigmoidf_(a0[j]) * u0[j] * gw; o1[j] = a1[j] * sigmoidf_(a1[j]) * u1[j] * gw; }
                *(u32x4*)(act + ((size_t)u.pm * 256 + trow) * 512 + u.pn * 128 + tcol) = pack8(o0, o1); SBAR();
            }
    }
};
struct EpiMoeDown { static constexpr bool DUAL = false;
    float* out; const float* mod;
    __device__ __forceinline__ void operator()(const f32x4 (&acc)[2][2][4][2], const Unit& u, int wr, int wc, int fr, int fq) const {
        EPI_LOOP({ if (trow < u.nvalid) { const int tok = u.gi[trow]; const int col = u.pn * 256 + tcol; const float* gt = mod + (size_t)(tok >> 11) * 12288 + 10240 + col;
            const f32x4 g0 = *(const f32x4*)gt, g1 = *(const f32x4*)(gt + 4); float* po = out + (size_t)tok * 2048 + col;
            _Pragma("unroll") for (int j = 0; j < 4; ++j) { unsafeAtomicAdd(po + j, g0[j] * v0[j]); unsafeAtomicAdd(po + 4 + j, g1[j] * v1[j]); } } })
    }
};


struct DualOrder {
    pg8::StaticOrder S0, S1;
    __device__ bool next(int i, Unit& u) const { const bool ok = (i & 1) ? S1.next(i >> 1, u) : S0.next(i >> 1, u); u.aux = (i & 1) ? 0 : 1; return ok; }
};
struct EpiGate12 { static constexpr bool DUAL = false;
    EpiGate1 e1; EpiGate2 e2;
    __device__ __forceinline__ void operator()(const f32x4 (&acc)[2][2][4][2], const Unit& u, int wr, int wc, int fr, int fq) const { if (u.aux) e1(acc, u, wr, wc, fr, fq); else e2(acc, u, wr, wc, fr, fq); }
};
struct MoeOrder {
    const LAS int* pre;
    const LAS int* cnt;
    int G, c, ntn, K; const char* A; const char* Bt; size_t bstride; const int* ltok; bool down;
    __device__ bool next(int i, Unit& u) const {
        const int total = __builtin_amdgcn_readfirstlane(pre[64]) * ntn; const long L = (long)i * G + c; if (L >= total) return false;
        const int l = (int)L; const int mt = l / ntn, pn = l % ntn;
        int e = 0;
#pragma unroll 1
        for (int s = 32; s >= 1; s >>= 1) if (__builtin_amdgcn_readfirstlane(pre[e + s]) <= mt) e += s;
        const int lt = mt - __builtin_amdgcn_readfirstlane(pre[e]);
        u.pm = mt; u.pn = pn; u.aux = e * LCAP + lt * 256; u.gi = ltok + u.aux; { const int rem = __builtin_amdgcn_readfirstlane(cnt[e]) - lt * 256; u.nvalid = rem < 256 ? rem : 256; }
        u.a = down ? A + (size_t)mt * 256 * K * 2 : A; u.b = Bt + (size_t)e * bstride + (size_t)pn * 256 * K * 2; return true;
    }
};

__device__ __forceinline__ int map_row(int map, int n) {
    if (map == 0) return n;
    if (map == 1) { if (n < 2384) return n; if (n < 5456) return n + 176; if (n < 5464) return n - 3072; return n + 168; }
    if (map == 2) return (n >> 7) * 256 + (n & 127);
    return (n >> 7) * 256 + 128 + (n & 127);
}
__device__ void ph0_prologue(const Params& p, LAS unsigned char* lds) {
    const int tid = threadIdx.x, wid = tid >> 6, lane = tid & 63, G = gridDim.x, bx = blockIdx.x;
    if (bx < 192) {
        LAS float* sc = (LAS float*)lds;
        LAS float* red = (LAS float*)(lds + 32768);
        const float* c = p.in[I_C];
        for (int i = tid; i < 4 * 2048; i += NTHREADS) { const float v = c[i]; sc[i] = v / (1.0f + __expf(-v)); }
        __syncthreads();
        for (int item = bx; item < 192; item += G) {
            const int n0 = item * 64, cg = lane & 15, rs = lane >> 4;
            float acc[4][4];
#pragma unroll
            for (int b = 0; b < 4; ++b)
#pragma unroll
                for (int j = 0; j < 4; ++j) acc[b][j] = 0.f;
            const float* w = p.in[I_WADA] + n0 + cg * 4;
#pragma unroll 4
            for (int step = 0; step < 64; ++step) {
                const int k = step * 32 + wid * 4 + rs;
                const f32x4 wv = *(const f32x4*)(w + (size_t)k * 12288);
#pragma unroll
                for (int b = 0; b < 4; ++b) { const float s = sc[b * 2048 + k];
#pragma unroll
                    for (int j = 0; j < 4; ++j) acc[b][j] += s * wv[j]; }
            }
#pragma unroll
            for (int b = 0; b < 4; ++b)
#pragma unroll
                for (int j = 0; j < 4; ++j) { float v = acc[b][j]; v += __shfl_xor(v, 16); v += __shfl_xor(v, 32); acc[b][j] = v; }
            if (rs == 0) {
#pragma unroll
                for (int b = 0; b < 4; ++b)
#pragma unroll
                    for (int j = 0; j < 4; ++j) red[(wid * 16 + cg) * 16 + b * 4 + j] = acc[b][j]; }
            __syncthreads();
            if (tid < 256) { const int cg2 = tid >> 4, bj = tid & 15, b = bj >> 2, j = bj & 3; float s = 0.f;
#pragma unroll
                for (int w8 = 0; w8 < 8; ++w8) s += red[(w8 * 16 + cg2) * 16 + bj];
                const int n = n0 + cg2 * 4 + j; ((float*)(p.ws + WS_MOD))[b * 12288 + n] = s + p.in[I_BADA][n]; }
            __syncthreads();
        }
    }
    { u32x4* z = (u32x4*)(p.ws + WS_WIN + (size_t)2392 * 2048 * 2); const int n16 = 168 * 2048 * 2 / 16;
      for (int i = bx * NTHREADS + tid; i < n16; i += G * NTHREADS) z[i] = (u32x4){0u, 0u, 0u, 0u}; }
    { bf16_t* wh = (bf16_t*)(p.ws + WS_WRH); bf16_t* wl = (bf16_t*)(p.ws + WS_WRL);
      for (int i = bx * NTHREADS + tid; i < 80 * 2048; i += G * NTHREADS) { const int n = i >> 11, k = i & 2047;
          const float v = n < 8 ? p.in[I_WRG][k * 8 + n] : (n < 72 ? p.in[I_WRE][k * 64 + n - 8] : 0.f);
          const unsigned h = cvt_pk_bf16(v, 0.f) & 0xffffu; const unsigned l = cvt_pk_bf16(v - bf_lo(h), 0.f) & 0xffffu; wh[i] = (bf16_t)h; wl[i] = (bf16_t)l; } }
    LAS float* tile = (LAS float*)(lds + 65536);
    for (int ti = bx; ti < p.ntiles_total; ti += G) {
        int j = 0;
#pragma unroll 1
        for (int q = 1; q < NJOBS; ++q) if (ti >= p.jobs[q].tile0) j = q;
        const TJob& J = p.jobs[j];
        int l = ti - J.tile0; const int per = J.ntk * J.ntn; const int bt = l / per; l -= bt * per; const int tn = l / J.ntk, tk = l % J.ntk;
        const float* src = J.src + (size_t)bt * J.sbatch; bf16_t* dst = J.dst + (size_t)bt * J.dbatch;
        const int k0 = tk * 64, n0 = tn * 64;
#pragma unroll
        for (int i = 0; i < 2; ++i) { const int r = (tid >> 4) + 32 * i, c4 = (tid & 15) * 4;
            f32x4 v = {0.f, 0.f, 0.f, 0.f}; if (n0 + c4 < J.N) v = *(const f32x4*)(src + (size_t)(k0 + r) * J.N + n0 + c4);
#pragma unroll
            for (int q = 0; q < 4; ++q) tile[r * 65 + c4 + q] = v[q]; }
        __syncthreads();
        { const int n = tid >> 3, kq = (tid & 7) * 8;
          if (n0 + n < J.N) { float f[8];
#pragma unroll
              for (int q = 0; q < 8; ++q) f[q] = tile[(kq + q) * 65 + n];
              u32x4 w; w.x = cvt_pk_bf16(f[0], f[1]); w.y = cvt_pk_bf16(f[2], f[3]); w.z = cvt_pk_bf16(f[4], f[5]); w.w = cvt_pk_bf16(f[6], f[7]);
              *(u32x4*)(dst + (size_t)map_row(J.map, n0 + n) * J.ldd + k0 + kq) = w; } }
        __syncthreads();
    }
}

__device__ __forceinline__ void norm_row(const float* xr, const float* g, const float* sh, const float* sc, bf16_t* hr, int lane, float (&hv)[32]) {
    f32x4 v[8]; float ss = 0.f;
#pragma unroll
    for (int i = 0; i < 8; ++i) { v[i] = *(const f32x4*)(xr + i * 256 + lane * 4); ss += v[i][0] * v[i][0] + v[i][1] * v[i][1] + v[i][2] * v[i][2] + v[i][3] * v[i][3]; }
    ss = wave_sum(ss);
    const float rstd = rsqrtf(ss * (1.0f / 2048.0f) + RMS_EPS);
#pragma unroll
    for (int i = 0; i < 8; ++i) { const int col = i * 256 + lane * 4; const f32x4 gg = *(const f32x4*)(g + col), s1 = *(const f32x4*)(sc + col), s0 = *(const f32x4*)(sh + col);
#pragma unroll
        for (int j = 0; j < 4; ++j) hv[i * 4 + j] = v[i][j] * rstd * gg[j] * (1.0f + s1[j]) + s0[j];
        u32x2 w; w.x = cvt_pk_bf16(hv[i * 4], hv[i * 4 + 1]); w.y = cvt_pk_bf16(hv[i * 4 + 2], hv[i * 4 + 3]); *(u32x2*)(hr + col) = w; }
}
__device__ void ph1_norm(const Params& p) {
    const int lane = threadIdx.x & 63, gw = blockIdx.x * 8 + (threadIdx.x >> 6), nw = gridDim.x * 8;
    const float* mod = (const float*)(p.ws + WS_MOD);
    for (int t = gw; t < NTOK; t += nw) { const int b = t >> 11; float hv[32];
        norm_row(p.in[I_X] + (size_t)t * DM, p.in[I_GMIX], mod + b * 12288, mod + b * 12288 + 2048, (bf16_t*)(p.ws + WS_H) + (size_t)t * DM, lane, hv); }
}

template <int MB, int NB, int KS>
__device__ __forceinline__ void wave_gemm(const bf16_t* A, int lda, const bf16_t* Bt, int ldb, f32x4 (&acc)[MB][NB], int lane) {
    const int fr = lane & 15, fq = lane >> 4;
#pragma unroll
    for (int mb = 0; mb < MB; ++mb)
#pragma unroll
        for (int nb = 0; nb < NB; ++nb) acc[mb][nb] = (f32x4){0.f, 0.f, 0.f, 0.f};
#pragma unroll 1
    for (int ks = 0; ks < KS; ++ks) {
        bf16x8 af[MB];
#pragma unroll
        for (int mb = 0; mb < MB; ++mb) af[mb] = *(const bf16x8*)(A + (size_t)(mb * 16 + fr) * lda + ks * 32 + fq * 8);
#pragma unroll
        for (int nb = 0; nb < NB; ++nb) { const bf16x8 bf = *(const bf16x8*)(Bt + (size_t)(nb * 16 + fr) * ldb + ks * 32 + fq * 8);
#pragma unroll
            for (int mb = 0; mb < MB; ++mb) acc[mb][nb] = __builtin_amdgcn_mfma_f32_16x16x32_bf16(bf, af[mb], acc[mb][nb], 0, 0, 0); }
    }
}


__device__ __forceinline__ int wave_total_i32(int v) {
    v += __builtin_amdgcn_update_dpp(0, v, 0x111, 0xf, 0xf, true); v += __builtin_amdgcn_update_dpp(0, v, 0x112, 0xf, 0xf, true);
    v += __builtin_amdgcn_update_dpp(0, v, 0x114, 0xf, 0xf, true); v += __builtin_amdgcn_update_dpp(0, v, 0x118, 0xf, 0xf, true);
    v += __builtin_amdgcn_update_dpp(0, v, 0x142, 0xa, 0xf, false); v += __builtin_amdgcn_update_dpp(0, v, 0x143, 0xc, 0xf, false);
    return __builtin_amdgcn_readlane(v, 63);
}
template <int NI> __device__ __forceinline__ unsigned long long topk_words(const LAS float* srow, int c, int lane) {
    unsigned key[NI];
#pragma unroll
    for (int i = 0; i < NI; ++i) { unsigned u = 0u; if (i <= c) { u = __float_as_uint(srow[i * 64 + lane]); u = (u & 0x80000000u) ? ~u : (u | 0x80000000u); } key[i] = u; }
    unsigned v = 0u;
#pragma unroll 1
    for (int bit = 31; bit >= 0; --bit) {
        const unsigned cand = v | (1u << bit); int cl = 0;
#pragma unroll
        for (int i = 0; i < NI; ++i) cl += (key[i] >= cand) ? 1 : 0;
        const int tot = wave_total_i32(cl);
        if (tot >= 256) { v = cand; if (tot == 256) break; }
    }
    unsigned long long myword = 0ull;
#pragma unroll
    for (int i = 0; i < NI; ++i) { const unsigned long long bm = __ballot(key[i] >= v); if (lane == i) myword = bm; if ((i & 3) == 3) SBAR(); }
    return myword;
}
__device__ void idx_item(const Params& p, LAS unsigned char* lds, int b, int c, int sub) {
    const int tid = threadIdx.x, wid = tid >> 6, lane = tid & 63, fr = lane & 15, fq = lane >> 4;
    constexpr int SCLD = 2052;
    LAS float* sc = (LAS float*)lds;
    const int q0 = c * 64 + sub * 16, nk = (c + 1) * 64, nkb = nk / 16;
    const bf16_t* qidx = (const bf16_t*)(p.ws + WS_QIDX) + (size_t)(b * SEQ + q0 + fr) * 1024;
    const float* misc = (const float*)(p.ws + WS_MISC);
    float wq[16];
    { const float* wp = misc + (size_t)(b * SEQ + q0 + fr) * 256 + 64;
#pragma unroll
      for (int i = 0; i < 4; ++i) { const f32x4 v = *(const f32x4*)(wp + i * 4); wq[i * 4] = v[0]; wq[i * 4 + 1] = v[1]; wq[i * 4 + 2] = v[2]; wq[i * 4 + 3] = v[3]; } }
#pragma unroll
    for (int hp = 0; hp < 2; ++hp) {
        bf16x8 qf[8][2];
#pragma unroll
        for (int h = 0; h < 8; ++h)
#pragma unroll
            for (int ks = 0; ks < 2; ++ks) qf[h][ks] = *(const bf16x8*)(qidx + (hp * 8 + h) * 64 + ks * 32 + fq * 8);
        const bf16_t* kbase = (const bf16_t*)(p.ws + WS_KIDX) + (size_t)(b * SEQ + fr) * 64 + fq * 8;
        bf16x8 kf[2];
        if (wid < nkb) { kf[0] = *(const bf16x8*)(kbase + (size_t)wid * 16 * 64); kf[1] = *(const bf16x8*)(kbase + (size_t)wid * 16 * 64 + 32); }
#pragma unroll 1
        for (int kb = wid; kb < nkb; kb += 8) {
            const int kn = kb + 8 < nkb ? kb + 8 : kb;
            const bf16x8 kn0 = *(const bf16x8*)(kbase + (size_t)kn * 16 * 64), kn1 = *(const bf16x8*)(kbase + (size_t)kn * 16 * 64 + 32);
            LAS f32x4* sp = (LAS f32x4*)(sc + fr * SCLD + kb * 16 + fq * 4);
            f32x4 s = {0.f, 0.f, 0.f, 0.f}; if (hp) s = *sp;
#pragma unroll
            for (int h = 0; h < 8; ++h) {
                f32x4 a = {0.f, 0.f, 0.f, 0.f};
                a = __builtin_amdgcn_mfma_f32_16x16x32_bf16(kf[0], qf[h][0], a, 0, 0, 0);
                a = __builtin_amdgcn_mfma_f32_16x16x32_bf16(kf[1], qf[h][1], a, 0, 0, 0);
#pragma unroll
                for (int j = 0; j < 4; ++j) s[j] += wq[hp * 8 + h] * fmaxf(a[j], 0.f);
            }
            *sp = s; kf[0] = kn0; kf[1] = kn1;
        }
    }
    __syncthreads();
    unsigned long long* mask = (unsigned long long*)(p.ws + WS_MASK);
    for (int qq = 0; qq < 2; ++qq) {
        const int ql = wid * 2 + qq; const size_t qg = (size_t)b * SEQ + q0 + ql;
        unsigned long long myword = 0ull;
        if (nk <= 256) { if (lane <= c) myword = ~0ull; }
        else { const LAS float* srow = sc + ql * SCLD;
            if (c < 8) myword = topk_words<8>(srow, c, lane); else if (c < 16) myword = topk_words<16>(srow, c, lane);
            else if (c < 24) myword = topk_words<24>(srow, c, lane); else myword = topk_words<32>(srow, c, lane); }
        if (lane < 32) mask[qg * 32 + lane] = myword;
    }
    __syncthreads();
}
#ifndef REP_SUB
#define REP_SUB 15
#endif
__device__ void ph3_prep(const Params& p, LAS unsigned char* lds, const int rep) {
#define P3ON(bit) (!rep || ((REP_SUB) & (bit)))
    const int tid = threadIdx.x, wid = tid >> 6, lane = tid & 63, bx = blockIdx.x, G = gridDim.x;
    if (P3ON(1)) for (int it = bx; it < 256; it += G) {
        const int b = it >> 6, r = it & 63, cp = r >> 2, sub = r & 3;
        idx_item(p, lds, b, 31 - cp, sub); idx_item(p, lds, b, cp, sub);
    }
    const int gw = bx * 8 + wid, nw = G * 8;
    if (P3ON(2)) for (int it = gw; it < 2048; it += nw) {
        const int rt = it >> 3, h = it & 7, fr = lane & 15, fq = lane >> 4;
        f32x4 acc[2][16];
        wave_gemm<2, 16, 4>((const bf16_t*)(p.ws + WS_QA) + (size_t)rt * 32 * 1024 + h * 128, 1024, (const bf16_t*)(p.ws + WS_WUK) + (size_t)h * 256 * 128, 128, acc, lane);
#pragma unroll
        for (int mb = 0; mb < 2; ++mb) { float ss = 0.f;
#pragma unroll
            for (int nb = 0; nb < 16; ++nb)
#pragma unroll
                for (int j = 0; j < 4; ++j) ss += acc[mb][nb][j] * acc[mb][nb][j];
            ss += __shfl_xor(ss, 16); ss += __shfl_xor(ss, 32);
            const float rs = rsqrtf(ss * (1.0f / 256.0f) + RMS_EPS) * 0.0625f;
            bf16_t* o = (bf16_t*)(p.ws + WS_QLAT) + (size_t)(rt * 32 + mb * 16 + fr) * 2048 + h * 256;
#pragma unroll
            for (int nb = 0; nb < 16; ++nb) { const int col = nb * 16 + fq * 4; const f32x4 g = *(const f32x4*)(p.in[I_GQA] + col);
                u32x2 w; w.x = cvt_pk_bf16(acc[mb][nb][0] * rs * g[0], acc[mb][nb][1] * rs * g[1]); w.y = cvt_pk_bf16(acc[mb][nb][2] * rs * g[2], acc[mb][nb][3] * rs * g[3]); *(u32x2*)(o + col) = w; } }
    }
    if (P3ON(4)) for (int t = gw; t < NTOK; t += nw) {
        { const f32x4 v = *(const f32x4*)((const float*)(p.ws + WS_CKV) + (size_t)t * 256 + lane * 4); float ss = wave_sum(v[0] * v[0] + v[1] * v[1] + v[2] * v[2] + v[3] * v[3]);
          const float rs = rsqrtf(ss * (1.0f / 256.0f) + RMS_EPS); const f32x4 g = *(const f32x4*)(p.in[I_GKV] + lane * 4);
          u32x2 w; w.x = cvt_pk_bf16(v[0] * rs * g[0], v[1] * rs * g[1]); w.y = cvt_pk_bf16(v[2] * rs * g[2], v[3] * rs * g[3]); *(u32x2*)((bf16_t*)(p.ws + WS_KV) + (size_t)t * 256 + lane * 4) = w; }
#pragma unroll
        for (int which = 0; which < 2; ++which) {
            bf16_t* row = (bf16_t*)(p.ws + (which ? WS_KB : WS_QB)) + (size_t)t * 1024 + lane * 16; const float* g = p.in[which ? I_GKB : I_GQB] + (lane & 7) * 16;
            u32x4 a = *(u32x4*)row, c2 = *(u32x4*)(row + 8); float f[16];
            f[0] = bf_lo(a.x); f[1] = bf_hi(a.x); f[2] = bf_lo(a.y); f[3] = bf_hi(a.y); f[4] = bf_lo(a.z); f[5] = bf_hi(a.z); f[6] = bf_lo(a.w); f[7] = bf_hi(a.w);
            f[8] = bf_lo(c2.x); f[9] = bf_hi(c2.x); f[10] = bf_lo(c2.y); f[11] = bf_hi(c2.y); f[12] = bf_lo(c2.z); f[13] = bf_hi(c2.z); f[14] = bf_lo(c2.w); f[15] = bf_hi(c2.w);
            float ss = 0.f;
#pragma unroll
            for (int j = 0; j < 16; ++j) ss += f[j] * f[j];
            ss += __shfl_xor(ss, 1); ss += __shfl_xor(ss, 2); ss += __shfl_xor(ss, 4);
            const float rs = rsqrtf(ss * (1.0f / 128.0f) + RMS_EPS) * (which ? 1.0f : 0.08838834764831845f);
#pragma unroll
            for (int j = 0; j < 16; ++j) f[j] *= rs * g[j];
            a.x = cvt_pk_bf16(f[0], f[1]); a.y = cvt_pk_bf16(f[2], f[3]); a.z = cvt_pk_bf16(f[4], f[5]); a.w = cvt_pk_bf16(f[6], f[7]);
            c2.x = cvt_pk_bf16(f[8], f[9]); c2.y = cvt_pk_bf16(f[10], f[11]); c2.z = cvt_pk_bf16(f[12], f[13]); c2.w = cvt_pk_bf16(f[14], f[15]);
            if (!rep) { *(u32x4*)row = a; *(u32x4*)(row + 8) = c2; } else if (a.x == 0x12345678u) *(u32x4*)row = c2;
        }
    }
    if (P3ON(8) && bx < NBATCH) {
        const int b = bx; const float* fp = (const float*)(p.ws + WS_MISC) + (size_t)(b * SEQ + 4 * tid) * 256 + 80;
        float ls[4][8];
#pragma unroll
        for (int j = 0; j < 4; ++j) { const f32x4 a = *(const f32x4*)(fp + j * 256), c4 = *(const f32x4*)(fp + j * 256 + 4);
#pragma unroll
            for (int h = 0; h < 8; ++h) { const float z = (h < 4 ? a[h & 3] : c4[h & 3]) + p.in[I_BFORGET][h]; ls[j][h] = fminf(z, 0.f) - log1pf(__expf(-fabsf(z))); } }
        LAS float* wt = (LAS float*)lds;
        float off[8];
#pragma unroll
        for (int h = 0; h < 8; ++h) { ls[1][h] += ls[0][h]; ls[2][h] += ls[1][h]; ls[3][h] += ls[2][h];
            float incl = ls[3][h];
#pragma unroll
            for (int o = 1; o < 64; o <<= 1) { const float t2 = __shfl_up(incl, o); if (lane >= o) incl += t2; }
            if (lane == 63) wt[wid * 8 + h] = incl;
            off[h] = incl - ls[3][h]; }
        __syncthreads();
#pragma unroll
        for (int h = 0; h < 8; ++h) { float wo = 0.f; for (int w8 = 0; w8 < wid; ++w8) wo += wt[w8 * 8 + h];
            float* cp = (float*)(p.ws + WS_CUM) + (size_t)(b * 8 + h) * SEQ + 4 * tid;
            *(f32x4*)cp = (f32x4){ls[0][h] + off[h] + wo, ls[1][h] + off[h] + wo, ls[2][h] + off[h] + wo, ls[3][h] + off[h] + wo}; }
        __syncthreads();
    }
}

template <int OFF> __device__ __forceinline__ s16x4 tr_read(int vb) { s16x4 r; asm volatile("ds_read_b64_tr_b16 %0, %1 offset:%2" : "=&v"(r) : "v"(vb), "i"(OFF) : "memory"); return r; }
__device__ __forceinline__ int v_rd_base(int lane) { return ((lane & 3) << 3) | (((lane >> 2) & 3) << 6) | (((lane >> 4) & 1) << 5) | (((lane >> 5) & 1) << 8); }
template <int NCB> __device__ __forceinline__ int v_st(int k, int c) { const int kk = (k & ~0xC) | ((k & 4) << 1) | ((k & 8) >> 1); return ((kk >> 3) * NCB + (c >> 5)) * 512 + ((kk & 7) * 32 + (c & 31)) * 2; }
#define PK4(P, BASE, OUT) do { unsigned a0 = cvt_pk_bf16(P[BASE + 0], P[BASE + 1]), a1 = cvt_pk_bf16(P[BASE + 2], P[BASE + 3]);   \
    unsigned b0 = cvt_pk_bf16(P[BASE + 4], P[BASE + 5]), b1 = cvt_pk_bf16(P[BASE + 6], P[BASE + 7]);                              \
    auto r0 = __builtin_amdgcn_permlane32_swap(a0, b0, false, false); auto r1 = __builtin_amdgcn_permlane32_swap(a1, b1, false, false); \
    u32x4 w = {r0[0], r1[0], r0[1], r1[1]}; OUT = *reinterpret_cast<bf16x8*>(&w); } while (0)
#define PKV(L, H) (bf16x8){L[0], L[1], L[2], L[3], H[0], H[1], H[2], H[3]}
template <int NCB, int D0, int KS> __device__ __forceinline__ void pv_step(f32x16& od, int vb, bf16x8 pa) {
    const s16x4 l = tr_read<D0 * 512 + KS * (2 * NCB * 512)>(vb), h = tr_read<D0 * 512 + KS * (2 * NCB * 512) + NCB * 512>(vb);
    asm volatile("s_waitcnt lgkmcnt(0)" ::: "memory"); SBAR();
    od = __builtin_amdgcn_mfma_f32_32x32x16_bf16(pa, PKV(l, h), od, 0, 0, 0);
}
template <int NCB, int KS0, int D0> struct PvBlocks { static __device__ __forceinline__ void run(f32x16* o, int vb, bf16x8 pa0, bf16x8 pa1) {
    pv_step<NCB, D0, KS0>(o[D0], vb, pa0); pv_step<NCB, D0, KS0 + 1>(o[D0], vb, pa1); if constexpr (D0 + 1 < NCB) PvBlocks<NCB, KS0, D0 + 1>::run(o, vb, pa0, pa1); } };
template <int NCB, int KS0, int D0> struct PvPairs { static __device__ __forceinline__ void run(f32x16* o, int vb, bf16x8 pa0, bf16x8 pa1) {
    constexpr int S = 2 * NCB * 512, H = NCB * 512;
    const s16x4 l00 = tr_read<D0 * 512 + KS0 * S>(vb), h00 = tr_read<D0 * 512 + KS0 * S + H>(vb), l01 = tr_read<D0 * 512 + (KS0 + 1) * S>(vb), h01 = tr_read<D0 * 512 + (KS0 + 1) * S + H>(vb);
    const s16x4 l10 = tr_read<(D0 + 1) * 512 + KS0 * S>(vb), h10 = tr_read<(D0 + 1) * 512 + KS0 * S + H>(vb), l11 = tr_read<(D0 + 1) * 512 + (KS0 + 1) * S>(vb), h11 = tr_read<(D0 + 1) * 512 + (KS0 + 1) * S + H>(vb);
    asm volatile("s_waitcnt lgkmcnt(0)" ::: "memory"); SBAR();
    o[D0] = __builtin_amdgcn_mfma_f32_32x32x16_bf16(pa0, PKV(l00, h00), o[D0], 0, 0, 0); o[D0 + 1] = __builtin_amdgcn_mfma_f32_32x32x16_bf16(pa0, PKV(l10, h10), o[D0 + 1], 0, 0, 0);
    o[D0] = __builtin_amdgcn_mfma_f32_32x32x16_bf16(pa1, PKV(l01, h01), o[D0], 0, 0, 0); o[D0 + 1] = __builtin_amdgcn_mfma_f32_32x32x16_bf16(pa1, PKV(l11, h11), o[D0 + 1], 0, 0, 0);
    if constexpr (D0 + 2 < NCB) PvPairs<NCB, KS0, D0 + 2>::run(o, vb, pa0, pa1); } };
__device__ __forceinline__ int swap23(int k) { return (k & ~0xC) | ((k & 4) << 1) | ((k & 8) >> 1); }
constexpr int FOX_STAGE = 33024;
constexpr int FOX_AL = 2 * FOX_STAGE, FOX_LI = FOX_AL + 1024;
__device__ void fox_item(const Params& p, LAS unsigned char* lds, int b, int h, int qb) {
    const int tid = threadIdx.x, wid = __builtin_amdgcn_readfirstlane(tid >> 6), lane = tid & 63, r32 = lane & 31, hi = lane >> 5;
    const bf16_t* Q = (const bf16_t*)(p.ws + WS_QB);
    const char* Kg = (const char*)(p.ws + WS_KB) + ((size_t)b * SEQ * 1024 + h * 128) * 2; const char* Vg = (const char*)(p.ws + WS_VB) + ((size_t)b * SEQ * 1024 + h * 128) * 2;
    const float* cum = (const float*)(p.ws + WS_CUM) + (size_t)(b * 8 + h) * SEQ;
    const int qpos = qb * 256 + wid * 32 + r32;
    bf16x8 qr[8];
    { const bf16_t* qp = Q + (size_t)(b * SEQ + qpos) * 1024 + h * 128 + hi * 8;
#pragma unroll
      for (int d0 = 0; d0 < 8; ++d0) qr[d0] = *(const bf16x8*)(qp + d0 * 16); }
    const float cq = cum[qpos] * LOG2E;
    unsigned ksrc[2], vsrc[2];
#pragma unroll
    for (int i = 0; i < 2; ++i) { const int pos = (i * 512 + tid) * 16;
        { const int row = pos >> 8; const int cb = (pos & 255) ^ ((row & 7) << 4); ksrc[i] = (unsigned)(row * 2048 + cb); }
        { const int sub = pos >> 9, within = pos & 511; const int kk = (sub >> 2) * 8 + (within >> 6); const int c = (sub & 3) * 32 + ((within & 63) >> 1); vsrc[i] = (unsigned)(swap23(kk) * 2048 + c * 2); } }
    float m_reg = -1e30f, l_reg = 0.f; f32x16 o[4];
#pragma unroll
    for (int d = 0; d < 4; ++d)
#pragma unroll
        for (int r = 0; r < 16; ++r) o[d][r] = 0.f;
    LAS float* al_l = (LAS float*)(lds + FOX_AL) + wid * 32; LAS float* li_l = (LAS float*)(lds + FOX_LI) + wid * 32;
    const int ntiles = qb * 4 + 4, mylast = qb * 4 + (wid >> 1);
#define FOX_DMA(kt) do { LAS unsigned char* sb_ = lds + ((kt) & 1) * FOX_STAGE; const size_t go_ = (size_t)(kt) * 64 * 2048; \
        _Pragma("unroll") for (int i = 0; i < 2; ++i) { \
            __builtin_amdgcn_global_load_lds((const unsigned*)(Kg + go_ + ksrc[i]), (LAS unsigned*)(sb_ + 16384 + (i * 512 + wid * 64) * 16), 16, 0, 0); \
            __builtin_amdgcn_global_load_lds((const unsigned*)(Vg + go_ + vsrc[i]), (LAS unsigned*)(sb_ + (i * 512 + wid * 64) * 16), 16, 0, 0); } \
        if (wid == 0) __builtin_amdgcn_global_load_lds((const unsigned*)(cum + (kt) * 64 + lane), (LAS unsigned*)(sb_ + 32768), 4, 0, 0); } while (0)
    __syncthreads();
    FOX_DMA(0);
    for (int kt = 0; kt < ntiles; ++kt) {
        asm volatile("s_waitcnt vmcnt(0)" ::: "memory");
        __syncthreads();
        if (kt + 1 < ntiles) FOX_DMA(kt + 1);
        if (kt <= mylast) {
            const LAS unsigned char* sb = lds + (kt & 1) * FOX_STAGE; const LAS float* ck = (const LAS float*)(sb + 32768);
            const int vb = (int)(uintptr_t)sb + v_rd_base(lane);
            f32x16 p0, p1;
#pragma unroll
            for (int r = 0; r < 16; ++r) { p0[r] = 0.f; p1[r] = 0.f; }
#pragma unroll
            for (int d0 = 0; d0 < 8; ++d0) { const int cb = (d0 * 16 + hi * 8) * 2;
                const bf16x8 b0 = *(const LAS bf16x8*)(sb + 16384 + r32 * 256 + (cb ^ ((r32 & 7) << 4)));
                const bf16x8 b1 = *(const LAS bf16x8*)(sb + 16384 + (32 + r32) * 256 + (cb ^ ((r32 & 7) << 4)));
                p0 = __builtin_amdgcn_mfma_f32_32x32x16_bf16(b0, qr[d0], p0, 0, 0, 0); p1 = __builtin_amdgcn_mfma_f32_32x32x16_bf16(b1, qr[d0], p1, 0, 0, 0); }
            const bool diag = (kt * 64 + 63 > qb * 256 + wid * 32);
            float pmax = -INFINITY;
#pragma unroll
            for (int g4 = 0; g4 < 4; ++g4) { const f32x4 c0 = *(const LAS f32x4*)(ck + 8 * g4 + 4 * hi), c1 = *(const LAS f32x4*)(ck + 32 + 8 * g4 + 4 * hi);
#pragma unroll
                for (int j = 0; j < 4; ++j) { const int r = g4 * 4 + j; float t0 = fmaf(p0[r], LOG2E, cq) - c0[j] * LOG2E, t1 = fmaf(p1[r], LOG2E, cq) - c1[j] * LOG2E;
                    if (diag) { const int kp = kt * 64 + crow(r, hi); if (kp > qpos) t0 = -INFINITY; if (kp + 32 > qpos) t1 = -INFINITY; }
                    p0[r] = t0; p1[r] = t1; pmax = fmaxf(pmax, fmaxf(t0, t1)); } }
            { auto rr = __builtin_amdgcn_permlane32_swap(__float_as_uint(pmax), __float_as_uint(pmax), false, false); pmax = fmaxf(__uint_as_float(rr[0]), __uint_as_float(rr[1])); }
            const float mn = fmaxf(m_reg, pmax); const float alpha = __builtin_amdgcn_exp2f(m_reg - mn); m_reg = mn;
            float ps = 0.f;
#pragma unroll
            for (int r = 0; r < 16; ++r) { p0[r] = __builtin_amdgcn_exp2f(p0[r] - mn); p1[r] = __builtin_amdgcn_exp2f(p1[r] - mn); ps += p0[r] + p1[r]; }
            { auto rr = __builtin_amdgcn_permlane32_swap(__float_as_uint(ps), __float_as_uint(ps), false, false); ps = __uint_as_float(rr[0]) + __uint_as_float(rr[1]); }
            l_reg = l_reg * alpha + ps;
            if (__any(alpha < 1.f)) { if (hi == 0) al_l[r32] = alpha; asm volatile("s_waitcnt lgkmcnt(0)" ::: "memory");
#pragma unroll
                for (int r = 0; r < 16; ++r) { const float a = al_l[crow(r, hi)];
#pragma unroll
                    for (int d = 0; d < 4; ++d) o[d][r] *= a; } }
            bf16x8 pa0, pa1, pa2, pa3; PK4(p0, 0, pa0); PK4(p0, 8, pa1); PK4(p1, 0, pa2); PK4(p1, 8, pa3);
            PvPairs<4, 0, 0>::run(o, vb, pa0, pa1); PvPairs<4, 2, 0>::run(o, vb, pa2, pa3);
        }
    }
#undef FOX_DMA
    if (hi == 0) li_l[r32] = l_reg; asm volatile("s_waitcnt lgkmcnt(0)" ::: "memory");
    bf16_t* O = (bf16_t*)(p.ws + WS_OB) + (size_t)(b * SEQ + qb * 256 + wid * 32) * 1024 + h * 128;
#pragma unroll
    for (int r = 0; r < 16; ++r) { const float rl = __builtin_amdgcn_rcpf(li_l[crow(r, hi)]); const int orow = crow(r, hi);
#pragma unroll
        for (int d0 = 0; d0 < 4; ++d0) O[(size_t)orow * 1024 + d0 * 32 + r32] = (bf16_t)(cvt_pk_bf16(o[d0][r] * rl, 0.f) & 0xffffu); }
}

constexpr int DSA_STAGE = 32768;
constexpr int DSA_AL = 2 * DSA_STAGE, DSA_LI = DSA_AL + 1024, DSA_Q = DSA_LI + 1024;
__device__ void dsa_item(const Params& p, LAS unsigned char* lds, int b, int qt) {
    const int tid = threadIdx.x, wid = __builtin_amdgcn_readfirstlane(tid >> 6), lane = tid & 63, r32 = lane & 31, hi = lane >> 5, h = wid;
    const char* KV = (const char*)(p.ws + WS_KV) + (size_t)b * SEQ * 512;
    const int qpos = qt * 32 + r32; const size_t qg = (size_t)b * SEQ + qpos;
    const unsigned* mask = (const unsigned*)(p.ws + WS_MASK) + qg * 64;
    bf16x8 qr[8];
    LAS unsigned char* qlds = lds + DSA_Q + wid * 8192 + lane * 16;
    __syncthreads();
    { const bf16_t* qp = (const bf16_t*)(p.ws + WS_QLAT) + qg * 2048 + h * 256 + hi * 8;
#pragma unroll
      for (int d0 = 0; d0 < 8; ++d0) qr[d0] = *(const bf16x8*)(qp + d0 * 16);
#pragma unroll
      for (int d0 = 8; d0 < 16; ++d0) *(LAS bf16x8*)(qlds + (d0 - 8) * 1024) = *(const bf16x8*)(qp + d0 * 16); }
    unsigned ksrc[2], vsrc[2];
#pragma unroll
    for (int i = 0; i < 2; ++i) { const int pos = (i * 512 + tid) * 16;
        { const int row = pos >> 9; const int cb = (pos & 511) ^ ((row & 15) << 4); ksrc[i] = (unsigned)(row * 512 + cb); }
        { const int sub = pos >> 9, within = pos & 511; const int kk = (sub >> 3) * 8 + (within >> 6); const int c = (sub & 7) * 32 + ((within & 63) >> 1); vsrc[i] = (unsigned)(swap23(kk) * 512 + c * 2); } }
    const float slopeL = exp2f(-(float)(h + 1)) * LOG2E;
    float m_reg = -1e30f, l_reg = 0.f; f32x16 o[8];
#pragma unroll
    for (int d = 0; d < 8; ++d)
#pragma unroll
        for (int r = 0; r < 16; ++r) o[d][r] = 0.f;
    LAS float* al_l = (LAS float*)(lds + DSA_AL) + wid * 32; LAS float* li_l = (LAS float*)(lds + DSA_LI) + wid * 32;
    const int ntiles = ((qt >> 1) + 1) * 2;
#define DSA_DMA(kt) do { LAS unsigned char* sb_ = lds + ((kt) & 1) * DSA_STAGE; const size_t go_ = (size_t)(kt) * 32 * 512; \
        _Pragma("unroll") for (int i = 0; i < 2; ++i) { \
            __builtin_amdgcn_global_load_lds((const unsigned*)(KV + go_ + ksrc[i]), (LAS unsigned*)(sb_ + 16384 + (i * 512 + wid * 64) * 16), 16, 0, 0); \
            __builtin_amdgcn_global_load_lds((const unsigned*)(KV + go_ + vsrc[i]), (LAS unsigned*)(sb_ + (i * 512 + wid * 64) * 16), 16, 0, 0); } } while (0)
    unsigned mw = mask[0];
    DSA_DMA(0);
    for (int kt = 0; kt < ntiles; ++kt) {
        asm volatile("s_waitcnt vmcnt(0)" ::: "memory");
        __syncthreads();
        const unsigned mcur = mw;
        if (kt + 1 < ntiles) { mw = mask[kt + 1]; DSA_DMA(kt + 1); }
        const LAS unsigned char* sb = lds + (kt & 1) * DSA_STAGE; const int vb = (int)(uintptr_t)sb + v_rd_base(lane);
        f32x16 pp;
#pragma unroll
        for (int r = 0; r < 16; ++r) pp[r] = 0.f;
        {
            const LAS unsigned char* kb_ = sb + 16384 + r32 * 512; const int sw_ = (r32 & 15) << 4;
#define DSA_KF(d0) (*(const LAS bf16x8*)(kb_ + ((((d0) * 16 + hi * 8) * 2) ^ sw_)))
#define DSA_QF(d0) ((d0) < 8 ? qr[(d0) & 7] : *(const LAS bf16x8*)(qlds + (((d0) - 8) & 7) * 1024))
            bf16x8 k0 = DSA_KF(0), k1 = DSA_KF(1), q0 = DSA_QF(0), q1 = DSA_QF(1);
#pragma unroll
            for (int d0 = 0; d0 < 16; d0 += 2) {
                bf16x8 nk0 = k0, nk1 = k1, nq0 = q0, nq1 = q1;
                if (d0 + 2 < 16) { nk0 = DSA_KF(d0 + 2); nk1 = DSA_KF(d0 + 3); nq0 = DSA_QF(d0 + 2); nq1 = DSA_QF(d0 + 3); }
                pp = __builtin_amdgcn_mfma_f32_32x32x16_bf16(k0, q0, pp, 0, 0, 0); pp = __builtin_amdgcn_mfma_f32_32x32x16_bf16(k1, q1, pp, 0, 0, 0);
                k0 = nk0; k1 = nk1; q0 = nq0; q1 = nq1; SBAR();
            }
#undef DSA_KF
#undef DSA_QF
        }
        const unsigned wsh = mcur >> (4 * hi);
        const float df = (float)(qpos - (kt * 32 + 4 * hi));
        float pmax = -INFINITY;
#pragma unroll
        for (int r = 0; r < 16; ++r) { const int cb = (r & 3) + 8 * (r >> 2); const float dd = df - (float)cb;
            float t = fmaf(-slopeL, fabsf(dd), pp[r] * LOG2E); if (!((wsh >> cb) & 1u)) t = -INFINITY; pp[r] = t; pmax = fmaxf(pmax, t); }
        { auto rr = __builtin_amdgcn_permlane32_swap(__float_as_uint(pmax), __float_as_uint(pmax), false, false); pmax = fmaxf(__uint_as_float(rr[0]), __uint_as_float(rr[1])); }
        const float mn = fmaxf(m_reg, pmax); const float alpha = __builtin_amdgcn_exp2f(m_reg - mn); m_reg = mn;
        float ps = 0.f;
#pragma unroll
        for (int r = 0; r < 16; ++r) { pp[r] = __builtin_amdgcn_exp2f(pp[r] - mn); ps += pp[r]; }
        { auto rr = __builtin_amdgcn_permlane32_swap(__float_as_uint(ps), __float_as_uint(ps), false, false); ps = __uint_as_float(rr[0]) + __uint_as_float(rr[1]); }
        l_reg = l_reg * alpha + ps;
        if (__any(alpha < 1.f)) { if (hi == 0) al_l[r32] = alpha; asm volatile("s_waitcnt lgkmcnt(0)" ::: "memory");
#pragma unroll
            for (int r = 0; r < 16; ++r) { const float a = al_l[crow(r, hi)];
#pragma unroll
                for (int d = 0; d < 8; ++d) o[d][r] *= a; } }
        bf16x8 pa0, pa1; PK4(pp, 0, pa0); PK4(pp, 8, pa1);
        PvPairs<8, 0, 0>::run(o, vb, pa0, pa1);
    }
#undef DSA_DMA
    if (hi == 0) li_l[r32] = l_reg; asm volatile("s_waitcnt lgkmcnt(0)" ::: "memory");
    float rl[16];
#pragma unroll
    for (int r = 0; r < 16; ++r) rl[r] = __builtin_amdgcn_rcpf(li_l[crow(r, hi)]);
    __syncthreads();
    LAS bf16_t* os = (LAS bf16_t*)(lds + wid * 16896);
#pragma unroll
    for (int r = 0; r < 16; ++r)
#pragma unroll
        for (int d0 = 0; d0 < 8; ++d0) os[crow(r, hi) * 264 + d0 * 32 + r32] = (bf16_t)(cvt_pk_bf16(o[d0][r] * rl[r], 0.f) & 0xffffu);
    asm volatile("s_waitcnt lgkmcnt(0)" ::: "memory");
    f32x16 ya[4];
#pragma unroll
    for (int nb = 0; nb < 4; ++nb)
#pragma unroll
        for (int r = 0; r < 16; ++r) ya[nb][r] = 0.f;
    const bf16_t* wv = (const bf16_t*)(p.ws + WS_WUV) + (size_t)(h * 128 + r32) * 256 + hi * 8;
#pragma unroll 4
    for (int ks = 0; ks < 16; ++ks) {
        const bf16x8 af = *(const LAS bf16x8*)(os + r32 * 264 + ks * 16 + hi * 8);
#pragma unroll
        for (int nb = 0; nb < 4; ++nb) { const bf16x8 wf = *(const bf16x8*)(wv + (size_t)nb * 32 * 256 + ks * 16); ya[nb] = __builtin_amdgcn_mfma_f32_32x32x16_bf16(wf, af, ya[nb], 0, 0, 0); }
    }
    bf16_t* O = (bf16_t*)(p.ws + WS_OA) + ((size_t)b * SEQ + qt * 32 + r32) * 1024 + h * 128 + 4 * hi;
#pragma unroll
    for (int nb = 0; nb < 4; ++nb)
#pragma unroll
        for (int g4 = 0; g4 < 4; ++g4) { u32x2 pk; pk.x = cvt_pk_bf16(ya[nb][g4 * 4], ya[nb][g4 * 4 + 1]); pk.y = cvt_pk_bf16(ya[nb][g4 * 4 + 2], ya[nb][g4 * 4 + 3]); *(u32x2*)(O + nb * 32 + g4 * 8) = pk; }
}
__device__ void ph4_attn(const Params& p, LAS unsigned char* lds) {
    const int r = blockIdx.x;
    if (r < 256) { const int c = 31 - (r >> 3), w8 = r & 7, b = w8 >> 1, half = w8 & 1; dsa_item(p, lds, b, c * 2 + half); }
    __syncthreads();
    if (r < 256) { const int qb = r >> 5, bh = r & 31; fox_item(p, lds, bh >> 3, bh & 7, qb); }
}

__device__ void ph5_oa(const Params& p) {
    const int lane = threadIdx.x & 63, gw = blockIdx.x * 8 + (threadIdx.x >> 6), nw = gridDim.x * 8, fr = lane & 15, fq = lane >> 4;
    for (int it = gw; it < 2048; it += nw) {
        const int rt = it >> 3, h = it & 7;
        f32x4 acc[2][8];
        wave_gemm<2, 8, 8>((const bf16_t*)(p.ws + WS_OLAT) + (size_t)rt * 32 * 2048 + h * 256, 2048, (const bf16_t*)(p.ws + WS_WUV) + (size_t)h * 128 * 256, 256, acc, lane);
#pragma unroll
        for (int mb = 0; mb < 2; ++mb) { bf16_t* o = (bf16_t*)(p.ws + WS_OA) + (size_t)(rt * 32 + mb * 16 + fr) * 1024 + h * 128;
#pragma unroll
            for (int nb = 0; nb < 8; ++nb) { u32x2 w; w.x = cvt_pk_bf16(acc[mb][nb][0], acc[mb][nb][1]); w.y = cvt_pk_bf16(acc[mb][nb][2], acc[mb][nb][3]); *(u32x2*)(o + nb * 16 + fq * 4) = w; } }
    }
}

__device__ void ph8_router(const Params& p, LAS unsigned char* lds, const int rep) {
    const int tid = threadIdx.x, wid = tid >> 6, lane = tid & 63, fr = lane & 15, fq = lane >> 4;
    const float* mod = (const float*)(p.ws + WS_MOD);
    bf16_t* H = (bf16_t*)(p.ws + WS_H); bf16_t* HL = (bf16_t*)(p.ws + WS_HLO);
    int* cnt = (int*)(p.ws + WS_CNT) + rep * 256; int* ltok = rep ? (int*)(p.ws + WS_T1) : (int*)(p.ws + WS_LTOK); float* lw = rep ? (float*)(p.ws + WS_T1 + (4u << 20)) : (float*)(p.ws + WS_LW);
    LAS float* slab = (LAS float*)lds + wid * 2560;
    LAS float* lg = (LAS float*)lds + 8 * 2560;
    for (int blk = blockIdx.x; blk < NTOK / 32; blk += gridDim.x) {
        const int t0 = blk * 32;
        {
            const int tb = t0 + wid * 4, b = tb >> 11;
            const float* sh = mod + b * 12288 + 6144; const float* sc = mod + b * 12288 + 8192;
            f32x4 xv[4][8];
#pragma unroll
            for (int rr = 0; rr < 4; ++rr)
#pragma unroll
                for (int i = 0; i < 8; ++i) xv[rr][i] = *(const f32x4*)(p.out + (size_t)(tb + rr) * DM + i * 256 + lane * 4);
#pragma unroll
            for (int rr = 0; rr < 4; ++rr) {
                float ss = 0.f;
#pragma unroll
                for (int i = 0; i < 8; ++i) ss += xv[rr][i][0] * xv[rr][i][0] + xv[rr][i][1] * xv[rr][i][1] + xv[rr][i][2] * xv[rr][i][2] + xv[rr][i][3] * xv[rr][i][3];
                ss = wave_sum(ss);
                const float rstd = rsqrtf(ss * (1.0f / 2048.0f) + RMS_EPS);
#pragma unroll
                for (int i = 0; i < 8; ++i) { const int col = i * 256 + lane * 4; const f32x4 gg = *(const f32x4*)(p.in[I_GFFN] + col), s1 = *(const f32x4*)(sc + col), s0 = *(const f32x4*)(sh + col);
                    float hv[4], lo[4];
#pragma unroll
                    for (int j = 0; j < 4; ++j) hv[j] = xv[rr][i][j] * rstd * gg[j] * (1.0f + s1[j]) + s0[j];
                    u32x2 wh; wh.x = cvt_pk_bf16(hv[0], hv[1]); wh.y = cvt_pk_bf16(hv[2], hv[3]);
                    lo[0] = hv[0] - bf_lo(wh.x); lo[1] = hv[1] - bf_hi(wh.x); lo[2] = hv[2] - bf_lo(wh.y); lo[3] = hv[3] - bf_hi(wh.y);
                    u32x2 wl; wl.x = cvt_pk_bf16(lo[0], lo[1]); wl.y = cvt_pk_bf16(lo[2], lo[3]);
                    *(u32x2*)(H + (size_t)(tb + rr) * DM + col) = wh; *(u32x2*)(HL + (size_t)(tb + rr) * DM + col) = wl;
                    *(unsigned*)(p.ws + WS_H8 + (size_t)(tb + rr) * DM + col) = pack_fp8x4(hv[0], hv[1], hv[2], hv[3]); }
            }
        }
        asm volatile("s_waitcnt vmcnt(0)" ::: "memory");
        __syncthreads();
        {
            const bf16_t* Ah = H + (size_t)(t0 + fr) * DM + wid * 256 + fq * 8; const bf16_t* Al = HL + (size_t)(t0 + fr) * DM + wid * 256 + fq * 8;
            const bf16_t* Wh = (const bf16_t*)(p.ws + WS_WRH) + (size_t)fr * DM + wid * 256 + fq * 8; const bf16_t* Wl = (const bf16_t*)(p.ws + WS_WRL) + (size_t)fr * DM + wid * 256 + fq * 8;
            f32x4 acc[2][5];
#pragma unroll
            for (int mb = 0; mb < 2; ++mb)
#pragma unroll
                for (int nb = 0; nb < 5; ++nb) acc[mb][nb] = (f32x4){0.f, 0.f, 0.f, 0.f};
#pragma unroll 4
            for (int ks = 0; ks < 8; ++ks) {
                bf16x8 ah[2], al[2];
#pragma unroll
                for (int mb = 0; mb < 2; ++mb) { ah[mb] = *(const bf16x8*)(Ah + (size_t)mb * 16 * DM + ks * 32); al[mb] = *(const bf16x8*)(Al + (size_t)mb * 16 * DM + ks * 32); }
#pragma unroll
                for (int nb = 0; nb < 5; ++nb) { const bf16x8 wh = *(const bf16x8*)(Wh + (size_t)nb * 16 * DM + ks * 32), wl = *(const bf16x8*)(Wl + (size_t)nb * 16 * DM + ks * 32);
#pragma unroll
                    for (int mb = 0; mb < 2; ++mb) {
                        acc[mb][nb] = __builtin_amdgcn_mfma_f32_16x16x32_bf16(wh, ah[mb], acc[mb][nb], 0, 0, 0);
                        acc[mb][nb] = __builtin_amdgcn_mfma_f32_16x16x32_bf16(wl, ah[mb], acc[mb][nb], 0, 0, 0);
                        acc[mb][nb] = __builtin_amdgcn_mfma_f32_16x16x32_bf16(wh, al[mb], acc[mb][nb], 0, 0, 0); } }
            }
#pragma unroll
            for (int mb = 0; mb < 2; ++mb)
#pragma unroll
                for (int nb = 0; nb < 5; ++nb) *(LAS f32x4*)(slab + (mb * 16 + fr) * 80 + nb * 16 + fq * 4) = acc[mb][nb];
        }
        __syncthreads();
        for (int o = tid; o < 2560; o += NTHREADS) { float s = 0.f;
#pragma unroll
            for (int w8 = 0; w8 < 8; ++w8) s += ((LAS float*)lds)[w8 * 2560 + o];
            lg[o] = s; }
        __syncthreads();
        if (tid < 32) {
            const int t = t0 + tid; const LAS float* L = lg + tid * 80;
            float gl[8]; int gi = 0; float gm = -INFINITY;
#pragma unroll
            for (int g = 0; g < 8; ++g) { gl[g] = L[g] + p.in[I_BRG][g]; if (gl[g] > gm) { gm = gl[g]; gi = g; } }
            float se = 0.f;
#pragma unroll
            for (int g = 0; g < 8; ++g) se += __expf(gl[g] - gm);
            const float gwt = 1.0f / se;
            float v1 = -INFINITY, v2 = -INFINITY; int i1 = 0, i2 = 0;
            for (int e = 0; e < 8; ++e) { const float v = L[8 + gi * 8 + e] + p.in[I_BRE][gi * 8 + e];
                if (v > v1) { v2 = v1; i2 = i1; v1 = v; i1 = e; } else if (v > v2) { v2 = v; i2 = e; } }
            const float e2 = __expf(v2 - v1); const float p1 = gwt / (1.0f + e2), p2 = gwt * e2 / (1.0f + e2);
            const int ea = gi * 8 + i1, eb = gi * 8 + i2;
            const int pa = atomicAdd(cnt + ea, 1); ltok[ea * LCAP + pa] = t; lw[ea * LCAP + pa] = p1;
            const int pb = atomicAdd(cnt + eb, 1); ltok[eb * LCAP + pb] = t | 0x10000; lw[eb * LCAP + pb] = p2;
        }
        __syncthreads();
    }
}

__device__ __forceinline__ void moe_table(const Params& p, LAS unsigned char* lds) {
    LAS int* pre = (LAS int*)(lds + LDS_TAB);
    if (threadIdx.x == 0) { const int* cnt = (const int*)(p.ws + WS_CNT); int s = 0; for (int e = 0; e < 64; ++e) { const int ce = cnt[e]; pre[e] = s; pre[80 + e] = ce; s += (ce + 255) >> 8; } pre[64] = s; }
    __syncthreads();
}
__device__ void ph9_gather(const Params& p, LAS unsigned char* lds) {
    moe_table(p, lds);
    const LAS int* pre = (const LAS int*)(lds + LDS_TAB); const LAS int* cnt = pre + 80; const int* ltok = (const int*)(p.ws + WS_LTOK);
    const int lane = threadIdx.x & 63, gw = blockIdx.x * 8 + (threadIdx.x >> 6), nw = gridDim.x * 8, nrows = pre[64] * 256;
    const bf16_t* H = (const bf16_t*)(p.ws + WS_H); bf16_t* HG = (bf16_t*)(p.ws + WS_HG);
    for (int r = gw; r < nrows; r += nw) {
        const int mt = r >> 8; int e = 0;
#pragma unroll 1
        for (int s = 32; s >= 1; s >>= 1) if (pre[e + s] <= mt) e += s;
        const int pos = (mt - pre[e]) * 256 + (r & 255);
        u32x4 v[4];
        if (pos < cnt[e]) { const int tok = ltok[e * LCAP + pos];
#pragma unroll
            for (int i = 0; i < 4; ++i) v[i] = *(const u32x4*)(H + (size_t)tok * DM + i * 512 + lane * 8); }
        else {
#pragma unroll
            for (int i = 0; i < 4; ++i) v[i] = (u32x4){0u, 0u, 0u, 0u}; }
#pragma unroll
        for (int i = 0; i < 4; ++i) *(u32x4*)(HG + (size_t)r * DM + i * 512 + lane * 8) = v[i];
    }
}


#define MOE_GLOAD(dst, ptr) asm volatile("global_load_dwordx4 %0, %1, off nt" : "=v"(dst) : "v"(ptr) : "memory")
template <bool UP>
__device__ void moe_gemm(const Params& p, LAS unsigned char* lds, const int rep) {
    constexpr int K = UP ? 2048 : 512, NKT = K / 32, NS = UP ? 8 : 16, LDW = UP ? 512 : 2048;
    constexpr int NSTA = 3, OFF_A = 0, OFF_B = NSTA * 16384;
    const int tid = threadIdx.x, w = __builtin_amdgcn_readfirstlane(tid >> 6), l = tid & 63, r32 = l & 31, hi = l >> 5;
    LAS int* tab = (LAS int*)(lds + LDS_TAB);
    if (tid == 0) { const int* cnt = (const int*)(p.ws + WS_CNT); int s = 0, ro = 0; for (int e = 0; e < 64; ++e) { const int ce = cnt[e]; tab[e] = s; tab[80 + e] = ce; tab[160 + e] = ro; ro += ce; const int np = (ce + 511) >> 9; s += np > 0 ? np : 1; } tab[64] = s; }
    __syncthreads();
    const int total = __builtin_amdgcn_readfirstlane(tab[64]) * NS;
    const int q = (w & 3) * 8 + (l & 7), g = (w >> 2) * 8 + (l >> 3);
    const unsigned bwoff = (unsigned)(q * 256 + (((g >> 2) ^ (q & 3)) * 16) + (g & 3) * 4);
    const unsigned frag_sw = (unsigned)((r32 >> 2) & 3);
    const int* ltok = (const int*)(p.ws + WS_LTOK); const float* lw = (const float*)(p.ws + WS_LW);
    for (int unit = blockIdx.x; unit < total; unit += gridDim.x) {
        const int pm = unit / NS, ns = unit - pm * NS; int e = 0;
#pragma unroll 1
        for (int s = 32; s >= 1; s >>= 1) if (__builtin_amdgcn_readfirstlane(tab[e + s]) <= pm) e += s;
        const int mp = pm - __builtin_amdgcn_readfirstlane(tab[e]); const int cnt_e = __builtin_amdgcn_readfirstlane(tab[80 + e]), rowoff = __builtin_amdgcn_readfirstlane(tab[160 + e]);
        int nrows = cnt_e - mp * 512; nrows = nrows > 512 ? 512 : nrows; const bool two = nrows > 256;
        const char* abase = UP ? (const char*)(p.ws + WS_H8) : (const char*)(p.ws + WS_ACT8);
        unsigned aoff[2];
#pragma unroll
        for (int i = 0; i < 2; ++i) { const int row = (i * 8 + w) * 32 + (l >> 1); const int hs = (l & 1) ^ ((l >> 4) & 1);
            int src; if (UP) src = row < nrows ? (ltok[e * LCAP + mp * 512 + row] & 0xffff) : 0; else src = rowoff + mp * 512 + (row < nrows ? row : 0);
            aoff[i] = (unsigned)(src * K + hs * 16); }
        const float* bsrc = UP ? (q < 16 ? p.in[I_W1] : p.in[I_W3]) + (size_t)e * 2048 * 512 + ns * 64 + (q & 15) * 4 + (size_t)(2 * g) * LDW
                               : p.in[I_W2] + (size_t)e * 512 * 2048 + ns * 128 + q * 4 + (size_t)(2 * g) * LDW;
        f32x16 acc[2][4];
#pragma unroll
        for (int a = 0; a < 2; ++a)
#pragma unroll
            for (int b = 0; b < 4; ++b)
#pragma unroll
                for (int r = 0; r < 16; ++r) acc[a][b][r] = 0.f;
        f32x4 br[4][2];
#define MOE_ISSUE_B(j, t) do { const int tt_ = (t) < NKT ? (t) : NKT - 1; const float* bp_ = bsrc + (size_t)tt_ * 32 * LDW; MOE_GLOAD(br[j][0], bp_); MOE_GLOAD(br[j][1], bp_ + LDW); } while (0)
#define MOE_ISSUE_A(t, TWO) do { int tt_ = (t) < 0 ? 0 : (t); const int bi_ = (tt_ % NSTA); tt_ = tt_ < NKT ? tt_ : NKT - 1; const char* ap_ = abase + (size_t)tt_ * 32; \
        LAS unsigned char* ab_ = lds + OFF_A + bi_ * 16384 + w * 1024; \
        __builtin_amdgcn_global_load_lds((const unsigned*)(ap_ + aoff[0]), (LAS unsigned*)(ab_), 16, 0, 0); \
        if (TWO) __builtin_amdgcn_global_load_lds((const unsigned*)(ap_ + aoff[1]), (LAS unsigned*)(ab_ + 8192), 16, 0, 0); } while (0)
        const bool two_w = (256 + 32 * w) < nrows;
#define MOE_FRAGS(ks, TWO) do { const unsigned co_ = ((unsigned)((ks) * 2 + hi) ^ frag_sw) * 16u; \
            _Pragma("unroll") for (int nb = 0; nb < 4; ++nb) bf_[nb] = *(const LAS bf16x8*)(bb_ + nb * 2048 + co_); \
            { const unsigned ao_ = ((unsigned)(ks) ^ ((unsigned)(r32 >> 3) & 1u)) * 16u + (unsigned)hi * 8u; a0_ = fp8x8_to_bf16(*(const LAS u32x2*)(ab_ + ao_)); if (TWO) a1_ = fp8x8_to_bf16(*(const LAS u32x2*)(ab_ + 8192 + ao_)); } } while (0)
#define MOE_MMAS(TWO) do { \
            _Pragma("unroll") for (int nb = 0; nb < 4; ++nb) acc[0][nb] = __builtin_amdgcn_mfma_f32_32x32x16_bf16(bf_[nb], a0_, acc[0][nb], 0, 0, 0); \
            if (TWO) { _Pragma("unroll") for (int nb = 0; nb < 4; ++nb) acc[1][nb] = __builtin_amdgcn_mfma_f32_32x32x16_bf16(bf_[nb], a1_, acc[1][nb], 0, 0, 0); } } while (0)
#define MOE_ITER(jn, t, COMPUTE, TWO, WB, WA) do { \
        bf16x8 bf_[4], a0_, a1_; \
        const LAS unsigned char* ab_ = lds + OFF_A + (((t) + 3) % 3) * 16384 + w * 1024 + r32 * 32; const LAS unsigned char* bb_ = lds + OFF_B + ((t) & 1) * 8192 + r32 * 64; \
        if (COMPUTE) { MOE_FRAGS(0, TWO); } SBAR(); \
        asm volatile("s_waitcnt vmcnt(" WB ")" : "+v"(br[jn][0]), "+v"(br[jn][1]) :: "memory"); \
        { LAS unsigned char* bw_ = lds + OFF_B + (((t) + 1) & 1) * 8192 + bwoff; _Pragma("unroll") for (int jj = 0; jj < 4; ++jj) *(LAS unsigned*)(bw_ + jj * 64) = cvt_pk_bf16(br[jn][0][jj], br[jn][1][jj]); } \
        MOE_ISSUE_B(jn, (t) + 5); SBAR(); \
        if (COMPUTE) { MOE_MMAS(TWO); SBAR(); MOE_FRAGS(1, TWO); MOE_MMAS(TWO); } SBAR(); \
        asm volatile("s_waitcnt vmcnt(" WA ")" ::: "memory"); \
        asm volatile("s_waitcnt lgkmcnt(0)" ::: "memory"); __builtin_amdgcn_s_barrier(); asm volatile("" ::: "memory"); \
        MOE_ISSUE_A((t) + 3, TWO); \
        } while (0)
#define MOE_PIPE(TWO, WB, WA) do { \
        MOE_ISSUE_B(0, 0); MOE_ISSUE_A(-1, TWO); MOE_ISSUE_B(1, 1); MOE_ISSUE_A(-1, TWO); MOE_ISSUE_B(2, 2); MOE_ISSUE_A(0, TWO); MOE_ISSUE_B(3, 3); MOE_ISSUE_A(1, TWO); \
        MOE_ITER(0, -1, false, TWO, WB, WA); \
        _Pragma("unroll 1") for (int t = 0; t < NKT; t += 4) { MOE_ITER(1, t, true, TWO, WB, WA); MOE_ITER(2, t + 1, true, TWO, WB, WA); MOE_ITER(3, t + 2, true, TWO, WB, WA); MOE_ITER(0, t + 3, true, TWO, WB, WA); } \
          \
        asm volatile("s_waitcnt vmcnt(0)" : "+v"(br[0][0]), "+v"(br[0][1]), "+v"(br[1][0]), "+v"(br[1][1]), "+v"(br[2][0]), "+v"(br[2][1]), "+v"(br[3][0]), "+v"(br[3][1]) :: "memory"); \
        } while (0)
        if (two_w) MOE_PIPE(true, "14", "6"); else MOE_PIPE(false, "10", "5");
        asm volatile("s_waitcnt vmcnt(0)" ::: "memory");
        if constexpr (UP) {
#pragma unroll
            for (int mt = 0; mt < 2; ++mt) {
                const int rl = mt * 256 + 32 * w + r32;
                if (rl < nrows) {
                    const float gw = lw[e * LCAP + mp * 512 + rl] * 16.0f; unsigned char* orow = (unsigned char*)(p.ws + (rep ? WS_QLAT : WS_ACT8)) + (size_t)(rowoff + mp * 512 + rl) * 512 + ns * 64 + 4 * hi;
#pragma unroll
                    for (int nb = 0; nb < 2; ++nb)
#pragma unroll
                        for (int g4 = 0; g4 < 4; ++g4) { float o[4];
#pragma unroll
                            for (int j = 0; j < 4; ++j) { const float a = acc[mt][nb][g4 * 4 + j], u = acc[mt][nb + 2][g4 * 4 + j]; o[j] = a * sigmoidf_(a) * u * gw; }
                            *(unsigned*)(orow + nb * 32 + g4 * 8) = pack_fp8x4(o[0], o[1], o[2], o[3]); }
                }
            }
        } else {
#pragma unroll
            for (int mt = 0; mt < 2; ++mt) {
                const int rl = mt * 256 + 32 * w + r32;
                if (rl < nrows) {
                    const int ent = ltok[e * LCAP + mp * 512 + rl]; bf16_t* orow = (bf16_t*)(p.ws + WS_YS) + ((size_t)(ent >> 16) * NTOK + (ent & 0xffff)) * 2048 + ns * 128 + 4 * hi;
#pragma unroll
                    for (int nb = 0; nb < 4; ++nb)
#pragma unroll
                        for (int g4 = 0; g4 < 4; ++g4) { u32x2 pk; pk.x = cvt_pk_bf16(acc[mt][nb][g4 * 4] * 0.0625f, acc[mt][nb][g4 * 4 + 1] * 0.0625f); pk.y = cvt_pk_bf16(acc[mt][nb][g4 * 4 + 2] * 0.0625f, acc[mt][nb][g4 * 4 + 3] * 0.0625f); *(u32x2*)(orow + nb * 32 + g4 * 8) = pk; }
                }
            }
        }
        asm volatile("s_waitcnt vmcnt(0)" ::: "memory");
        __syncthreads();
    }
#undef MOE_ISSUE_A
#undef MOE_ISSUE_B
#undef MOE_ITER
#undef MOE_FRAGS
#undef MOE_MMAS
#undef MOE_PIPE
}


__device__ void ph11_combine(const Params& p) {
    const bf16_t* Y0 = (const bf16_t*)(p.ws + WS_YS); const bf16_t* Y1 = Y0 + (size_t)NTOK * 2048; const float* mod = (const float*)(p.ws + WS_MOD);
    const size_t n8 = (size_t)NTOK * 2048 / 8;
    for (size_t i = (size_t)blockIdx.x * NTHREADS + threadIdx.x; i < n8; i += (size_t)gridDim.x * NTHREADS) {
        const size_t e0 = i * 8; const int col = (int)(e0 & 2047), b = (int)(e0 >> 22);
        const u32x4 a = *(const u32x4*)(Y0 + e0), c = *(const u32x4*)(Y1 + e0);
        const float* gt = mod + (size_t)b * 12288 + 10240 + col; const f32x4 g0 = *(const f32x4*)gt, g1 = *(const f32x4*)(gt + 4);
        float* po = p.out + e0; f32x4 o0 = *(const f32x4*)po, o1 = *(const f32x4*)(po + 4);
        o0[0] += g0[0] * (bf_lo(a.x) + bf_lo(c.x)); o0[1] += g0[1] * (bf_hi(a.x) + bf_hi(c.x)); o0[2] += g0[2] * (bf_lo(a.y) + bf_lo(c.y)); o0[3] += g0[3] * (bf_hi(a.y) + bf_hi(c.y));
        o1[0] += g1[0] * (bf_lo(a.z) + bf_lo(c.z)); o1[1] += g1[1] * (bf_hi(a.z) + bf_hi(c.z)); o1[2] += g1[2] * (bf_lo(a.w) + bf_lo(c.w)); o1[3] += g1[3] * (bf_hi(a.w) + bf_hi(c.w));
        *(f32x4*)po = o0; *(f32x4*)(po + 4) = o1;
    }
}

__global__ void __launch_bounds__(NTHREADS, 2) mk_fwd(Params p) {
    extern __shared__ __attribute__((aligned(16))) unsigned char shm[];
    LAS unsigned char* lds = (LAS unsigned char*)shm;
    const int lo = p.ph_lo, hi = p.ph_hi;
    if (threadIdx.x < 4) ((LAS unsigned*)(lds + LDS_BARW))[threadIdx.x] = 0u;
    __syncthreads();
    XcdBarrier bar; bar.bar = (unsigned*)(p.ws + WS_BAR); bar.x = 0; bar.st = nullptr;
    if (hi - lo > 1) bar = xcd_barrier_post((unsigned*)(p.ws + WS_BAR), (volatile LAS unsigned*)(lds + LDS_BARW));
#ifndef SKIP_MASK
#define SKIP_MASK 0
#endif
#define IN(k) (!((SKIP_MASK >> (k)) & 1) && lo <= (k) && (k) < hi)
#define SEAM(k) do { if (IN(k) && IN((k) + 1)) xcd_barrier(bar); } while (0)
    const int G = gridDim.x, bx = blockIdx.x;
#ifndef REP_PHASE
#define REP_PHASE 0
#endif
#define RUN(k, ...) do { if (IN(k)) { { const int rep = 0; (void)rep; __VA_ARGS__ } if ((REP_PHASE >> (k)) & 1) { xcd_barrier(bar); { const int rep = 1; (void)rep; __VA_ARGS__ } } } SEAM(k); } while (0)
    RUN(0, ph0_prologue(p, lds););
    RUN(1, ph1_norm(p););
    RUN(2, pg8::StaticOrder S; S.init(p.ws + WS_H, p.ws + WS_WIN, NTOK, DINP, DM, G, bx); EpiProj E{p.ws, p.in[I_BGATE]};
           pg8::gemm_phase<EpiProj, pg8::StaticOrder, false>(lds, DM, S, E););
    RUN(3, ph3_prep(p, lds, rep););
    RUN(4, ph4_attn(p, lds););
    RUN(5, DualOrder S; S.S0.init(p.ws + WS_OA, p.ws + WS_WPA, NTOK, DM, 1024, G, bx); S.S1.init(p.ws + WS_OB, p.ws + WS_WPB, NTOK, DM, 1024, G, bx);
           EpiGate12 E{EpiGate1{(const bf16_t*)(p.ws + WS_GATES), (float*)(p.ws + WS_T1)}, EpiGate2{(const bf16_t*)(p.ws + WS_GATES), (const float*)(p.ws + WS_T1), (bf16_t*)(p.ws + WS_MERGED)}};
           pg8::gemm_phase<EpiGate12, DualOrder, false>(lds, 1024, S, E););
    RUN(6, pg8::StaticOrder S; S.init(p.ws + WS_MERGED, p.ws + WS_WO, NTOK, DM, DM, G, bx); EpiWo E{p.in[I_X], (const float*)(p.ws + WS_MOD), p.out};
           pg8::gemm_phase<EpiWo, pg8::StaticOrder, false>(lds, DM, S, E););
    RUN(7, ph8_router(p, lds, rep););
    RUN(8, moe_gemm<true>(p, lds, rep););
    RUN(9, moe_gemm<false>(p, lds, rep););
    RUN(10, if (!rep) ph11_combine(p););
#undef RUN
#undef IN
#undef SEAM
}

constexpr int NPHASES = 11;
extern "C" void kernel_launch(void* const* d_in, const int* in_sizes, int n_in, void* d_out, int out_size, void* d_ws, size_t ws_size, hipStream_t stream) {
    static int grid = 0;
    if (grid == 0) {
        if (n_in != 25 || in_sizes[0] != NTOK * DM || out_size != NTOK * DM || ws_size < WS_END3) {
            fprintf(stderr, "kernel_launch: shape mismatch: n_in %d in0 %d out %d ws %zu (need %zu)\n", n_in, n_in > 0 ? in_sizes[0] : -1, out_size, ws_size, (size_t)WS_END3); grid = -1; return; }
        int dev = 0, cus = 0, per_cu = 0;
        if (hipGetDevice(&dev) != hipSuccess || hipDeviceGetAttribute(&cus, hipDeviceAttributeMultiprocessorCount, dev) != hipSuccess) { fprintf(stderr, "kernel_launch: device query failed\n"); grid = -1; return; }
        if (hipFuncSetAttribute((const void*)mk_fwd, hipFuncAttributeMaxDynamicSharedMemorySize, LDS_BYTES) != hipSuccess) { fprintf(stderr, "kernel_launch: hipFuncSetAttribute failed\n"); grid = -1; return; }
        if (hipOccupancyMaxActiveBlocksPerMultiprocessor(&per_cu, (const void*)mk_fwd, NTHREADS, LDS_BYTES) != hipSuccess || per_cu < 1) { fprintf(stderr, "kernel_launch: occupancy query says %d blocks per CU\n", per_cu); }
        (void)hipGetLastError();
        grid = cus;
    }
    if (grid < 0) return;
    if (hipMemsetAsync((char*)d_ws + WS_BAR, 0, WS_ZERO_BYTES, stream) != hipSuccess) { fprintf(stderr, "kernel_launch: memset failed\n"); return; }
    Params p; memset(&p, 0, sizeof(p));
    for (int i = 0; i < 25; ++i) p.in[i] = (const float*)d_in[i];
    p.out = (float*)d_out; p.ws = (unsigned char*)d_ws;
    unsigned char* ws = (unsigned char*)d_ws;
    auto job = [&](int j, const float* src, size_t dst_off, int K, int N, int ldd, int map, int nbatch, long sbatch, long dbatch) {
        TJob& J = p.jobs[j]; J.src = src; J.dst = (bf16_t*)(ws + dst_off); J.K = K; J.N = N; J.ldd = ldd; J.map = map; J.ntk = K / 64; J.ntn = (N + 63) / 64; J.nbatch = nbatch; J.sbatch = sbatch; J.dbatch = dbatch; };
    job(0, p.in[I_WIN], WS_WIN, 2048, DIN, 2048, 1, 1, 0, 0);
    job(1, p.in[I_WPA], WS_WPA, 1024, 2048, 1024, 0, 1, 0, 0);
    job(2, p.in[I_WPB], WS_WPB, 1024, 2048, 1024, 0, 1, 0, 0);
    job(3, p.in[I_WO], WS_WO, 2048, 2048, 2048, 0, 1, 0, 0);
    job(4, p.in[I_WUK], WS_WUK, 128, 256, 128, 0, 8, 128L * 256, 256L * 128);
    job(5, p.in[I_WUV], WS_WUV, 256, 128, 256, 0, 8, 256L * 128, 128L * 256);
    int t0 = 0; for (int j = 0; j < NJOBS; ++j) { p.jobs[j].tile0 = t0; t0 += p.jobs[j].ntk * p.jobs[j].ntn * p.jobs[j].nbatch; }
    p.ntiles_total = t0;
#if MK_LAUNCHES == 1
    p.ph_lo = 0; p.ph_hi = NPHASES;
    hipLaunchKernelGGL(mk_fwd, dim3(grid), dim3(NTHREADS), LDS_BYTES, stream, p);
#else
    for (int k = 0; k < NPHASES; ++k) { p.ph_lo = k; p.ph_hi = k + 1; hipLaunchKernelGGL(mk_fwd, dim3(grid), dim3(NTHREADS), LDS_BYTES, stream, p); }
#endif
    const hipError_t le = hipPeekAtLastError();
    if (le != hipSuccess) fprintf(stderr, "kernel_launch: launch failed: %s\n", hipGetErrorName(le));
}

#ifdef DIAG_PHASES
template <int PH> __global__ void __launch_bounds__(NTHREADS, 2) k_ph(Params p) {
    extern __shared__ __attribute__((aligned(16))) unsigned char shm[];
    LAS unsigned char* lds = (LAS unsigned char*)shm; const int G = gridDim.x, bx = blockIdx.x;
    if constexpr (PH == 0) ph0_prologue(p, lds);
    if constexpr (PH == 1) ph1_norm(p);
    if constexpr (PH == 2) { pg8::StaticOrder S; S.init(p.ws + WS_H, p.ws + WS_WIN, NTOK, DINP, DM, G, bx); EpiProj E{p.ws, p.in[I_BGATE]}; pg8::gemm_phase<EpiProj, pg8::StaticOrder, false>(lds, DM, S, E); }
    if constexpr (PH == 3) ph3_prep(p, lds, 0);
    if constexpr (PH == 4) ph4_attn(p, lds);
    if constexpr (PH == 5) ph5_oa(p);
    if constexpr (PH == 6) { pg8::StaticOrder S; S.init(p.ws + WS_OA, p.ws + WS_WPA, NTOK, DM, 1024, G, bx); EpiGate1 E{(const bf16_t*)(p.ws + WS_GATES), (float*)(p.ws + WS_T1)}; pg8::gemm_phase<EpiGate1, pg8::StaticOrder, false>(lds, 1024, S, E); }
    if constexpr (PH == 7) { pg8::StaticOrder S; S.init(p.ws + WS_MERGED, p.ws + WS_WO, NTOK, DM, DM, G, bx); EpiWo E{p.in[I_X], (const float*)(p.ws + WS_MOD), p.out}; pg8::gemm_phase<EpiWo, pg8::StaticOrder, false>(lds, DM, S, E); }
    if constexpr (PH == 8) ph8_router(p, lds, 0);
    if constexpr (PH == 9) moe_gemm<true>(p, lds, 0);
    if constexpr (PH == 10) moe_gemm<false>(p, lds, 0);
    if constexpr (PH == 12) { const int r = bx; dsa_item(p, lds, r & 3, r >> 2); }
    if constexpr (PH == 13) { const int r = bx; fox_item(p, lds, r & 3, (r >> 2) & 7, r >> 5); }
    if constexpr (PH == 14) { idx_item(p, lds, bx & 3, (bx >> 2) & 31, bx >> 7); }
}
template __global__ void k_ph<0>(Params); template __global__ void k_ph<1>(Params); template __global__ void k_ph<2>(Params); template __global__ void k_ph<3>(Params);
template __global__ void k_ph<4>(Params); template __global__ void k_ph<5>(Params); template __global__ void k_ph<6>(Params); template __global__ void k_ph<7>(Params);
template __global__ void k_ph<8>(Params); template __global__ void k_ph<9>(Params); template __global__ void k_ph<10>(Params); template __global__ void k_ph<11>(Params);
template __global__ void k_ph<12>(Params); template __global__ void k_ph<13>(Params); template __global__ void k_ph<14>(Params);
#endif
```

```cpp
#include <hip/hip_runtime.h>
#include <cstdio>
#include <cstdint>
#include <cstring>

#ifndef MK_LAUNCHES
#define MK_LAUNCHES 1
#endif

#define LAS __attribute__((address_space(3)))
typedef unsigned short bf16_t;
typedef short bf16x8 __attribute__((ext_vector_type(8)));
typedef short s16x4 __attribute__((ext_vector_type(4)));
typedef float f32x4 __attribute__((ext_vector_type(4)));
typedef float f32x16 __attribute__((ext_vector_type(16)));
typedef unsigned u32x4 __attribute__((ext_vector_type(4)));
typedef unsigned u32x2 __attribute__((ext_vector_type(2)));

constexpr int DM = 2048, NBATCH = 4, SEQ = 2048, NTOK = NBATCH * SEQ;
constexpr int DIN = 9560, DINP = 9728;
constexpr int NEXP = 64, DEXP = 512, LCAP = 8192;
constexpr float RMS_EPS = 1e-6f;
constexpr float LOG2E = 1.4426950408889634f;
constexpr int NTHREADS = 512;
constexpr int LDS_BYTES = 163840 - 1024;
constexpr int LDS_BARW = LDS_BYTES - 16;
constexpr int LDS_TAB = 131072;

constexpr size_t al256(size_t x) { return (x + 255) / 256 * 256; }
constexpr size_t WS_BAR = 0;
constexpr size_t WS_CNT = 16384;
constexpr size_t WS_ZERO_BYTES = 16384 + 4096;
constexpr size_t WS_MOD = WS_ZERO_BYTES;
constexpr size_t WS_H = al256(WS_MOD + (size_t)4 * 12288 * 4);
constexpr size_t WS_WIN = al256(WS_H + (size_t)NTOK * DM * 2);
constexpr size_t WS_WPA = al256(WS_WIN + (size_t)DINP * DM * 2);
constexpr size_t WS_WPB = al256(WS_WPA + (size_t)2048 * 1024 * 2);
constexpr size_t WS_WO = al256(WS_WPB + (size_t)2048 * 1024 * 2);
constexpr size_t WS_WUK = al256(WS_WO + (size_t)2048 * 2048 * 2);
constexpr size_t WS_WUV = al256(WS_WUK + (size_t)8 * 256 * 128 * 2);
constexpr size_t WS_W13 = al256(WS_WUV + (size_t)8 * 128 * 256 * 2);
constexpr size_t WS_W2 = al256(WS_W13 + (size_t)64 * 1024 * 2048 * 2);
constexpr size_t WS_QA = al256(WS_W2 + (size_t)64 * 2048 * 512 * 2);
constexpr size_t WS_CKV = al256(WS_QA + (size_t)NTOK * 1024 * 2);
constexpr size_t WS_KV = al256(WS_CKV + (size_t)NTOK * 256 * 4);
constexpr size_t WS_QIDX = al256(WS_KV + (size_t)NTOK * 256 * 2);
constexpr size_t WS_MISC = al256(WS_QIDX + (size_t)NTOK * 1024 * 2);
constexpr size_t WS_QB = al256(WS_MISC + (size_t)NTOK * 256 * 4);
constexpr size_t WS_KB = al256(WS_QB + (size_t)NTOK * 1024 * 2);
constexpr size_t WS_VB = al256(WS_KB + (size_t)NTOK * 1024 * 2);
constexpr size_t WS_GATES = al256(WS_VB + (size_t)NTOK * 1024 * 2);
constexpr size_t WS_QLAT = al256(WS_GATES + (size_t)NTOK * 4096 * 2);
constexpr size_t WS_MASK = al256(WS_QLAT + (size_t)NTOK * 2048 * 2);
constexpr size_t WS_CUM = al256(WS_MASK + (size_t)NTOK * 256);
constexpr size_t WS_OLAT = al256(WS_CUM + (size_t)4 * 8 * 2048 * 4);
constexpr size_t WS_OA = al256(WS_OLAT + (size_t)NTOK * 2048 * 2);
constexpr size_t WS_OB = al256(WS_OA + (size_t)NTOK * 1024 * 2);
constexpr size_t WS_T1 = al256(WS_OB + (size_t)NTOK * 1024 * 2);
constexpr size_t WS_MERGED = al256(WS_T1 + (size_t)NTOK * 2048 * 4);
constexpr size_t WS_LTOK = al256(WS_MERGED + (size_t)NTOK * 2048 * 2);
constexpr size_t WS_LW = al256(WS_LTOK + (size_t)NEXP * LCAP * 4);
constexpr size_t WS_ACT = al256(WS_LW + (size_t)NEXP * LCAP * 4);
constexpr size_t WS_HLO = al256(WS_ACT + (size_t)32768 * 512 * 2);
constexpr size_t WS_WRH = al256(WS_HLO + (size_t)NTOK * DM * 2);
constexpr size_t WS_WRL = al256(WS_WRH + (size_t)80 * DM * 2);
constexpr size_t WS_END = al256(WS_WRL + (size_t)80 * DM * 2);
constexpr size_t WS_KIDX = WS_END;
constexpr size_t WS_END2 = al256(WS_KIDX + (size_t)NTOK * 64 * 2);
constexpr size_t WS_H8 = WS_END2;
constexpr size_t WS_ACT8 = al256(WS_H8 + (size_t)NTOK * DM);
constexpr size_t WS_END3 = al256(WS_ACT8 + (size_t)16384 * 512);
constexpr size_t WS_HF8 = WS_END3;
constexpr size_t WS_WIN8 = al256(WS_HF8 + (size_t)NTOK * DM);
constexpr size_t WS_END4 = al256(WS_WIN8 + (size_t)6144 * DM);
constexpr size_t WS_YS = WS_T1;
constexpr size_t WS_HG = WS_QA;
static_assert(WS_HG + (size_t)32768 * DM * 2 <= WS_QLAT, "hg alias must fit in the dead region");

struct TJob { const float* src; bf16_t* dst; int K, N, ldd, map, ntk, ntn, nbatch, tile0; long sbatch, dbatch; int ld, fp8; };
constexpr int NJOBS = 8;
struct Params {
    const float* in[25];
    float* out;
    unsigned char* ws;
    TJob jobs[NJOBS];
    int ntiles_total;
    int ph_lo, ph_hi;
};
enum { I_X = 0, I_C, I_WADA, I_BADA, I_GMIX, I_WIN, I_BGATE, I_BFORGET, I_WUK, I_WUV, I_GQA, I_GKV, I_GQB, I_GKB, I_WPA, I_WPB, I_WO, I_GFFN, I_WRG, I_BRG, I_WRE, I_BRE, I_W1, I_W3, I_W2 };

__device__ __forceinline__ unsigned cvt_pk_bf16(float lo, float hi) { unsigned r; asm volatile("v_cvt_pk_bf16_f32 %0, %1, %2" : "=v"(r) : "v"(lo), "v"(hi)); return r; }
__device__ __forceinline__ float bf_lo(unsigned w) { return __uint_as_float(w << 16); }
__device__ __forceinline__ float bf_hi(unsigned w) { return __uint_as_float(w & 0xffff0000u); }
typedef float f32x2 __attribute__((ext_vector_type(2)));
__device__ __forceinline__ unsigned pack_fp8x4(float a, float b, float c, float d) { int w = __builtin_amdgcn_cvt_pk_fp8_f32(a, b, 0, false); w = __builtin_amdgcn_cvt_pk_fp8_f32(c, d, w, true); return (unsigned)w; }
__device__ __forceinline__ bf16x8 fp8x8_to_bf16(u32x2 v) {
    const f32x2 a = __builtin_amdgcn_cvt_pk_f32_fp8((int)v.x, false), b = __builtin_amdgcn_cvt_pk_f32_fp8((int)v.x, true), c = __builtin_amdgcn_cvt_pk_f32_fp8((int)v.y, false), d = __builtin_amdgcn_cvt_pk_f32_fp8((int)v.y, true);
    u32x4 w; w.x = cvt_pk_bf16(a.x, a.y); w.y = cvt_pk_bf16(b.x, b.y); w.z = cvt_pk_bf16(c.x, c.y); w.w = cvt_pk_bf16(d.x, d.y); return *reinterpret_cast<bf16x8*>(&w); }
__device__ __forceinline__ float wave_sum(float v) {
#pragma unroll
    for (int o = 32; o >= 1; o >>= 1) v += __shfl_xor(v, o);
    return v;
}
__device__ __forceinline__ float sigmoidf_(float x) { return 1.0f / (1.0f + __expf(-x)); }
__device__ __forceinline__ int crow(int r, int hi) { return (r & 3) + 8 * (r >> 2) + 4 * hi; }
#define SBAR() __builtin_amdgcn_sched_barrier(0)

#define XB_TMO      128
#define XB_XCNT(j)  (256  + 64 * (j))
#define XB_XSUB(j)  (1280 + 64 * (j))
#define XB_XGEN(j)  (2304 + 64 * (j))
#define XB_TOP      3328
#define XB_TOPGEN   3392
#define XCD_BAR_WORDS 3456
#define XB_SPIN_CAP (1u << 20)
__device__ __forceinline__ unsigned xb_ld(unsigned* p)              { return __hip_atomic_load(p, __ATOMIC_RELAXED, __HIP_MEMORY_SCOPE_AGENT); }
__device__ __forceinline__ unsigned xb_add(unsigned* p, unsigned v) { return __hip_atomic_fetch_add(p, v, __ATOMIC_RELAXED, __HIP_MEMORY_SCOPE_AGENT); }
__device__ __forceinline__ unsigned xb_xcc_id() { return (unsigned)__builtin_amdgcn_s_getreg((3 << 11) | 20) & 0xFu; }
#define XB_SPIN(cond, bar) do { unsigned _sp = 0; while (cond) { __builtin_amdgcn_s_sleep(1); \
    if ((++_sp & 255u) == 0u) { if (xb_ld(&(bar)[XB_TMO])) break; if (_sp > XB_SPIN_CAP) { atomicAdd(&(bar)[XB_TMO], 1u); break; } } } } while (0)
struct XcdBarrier { unsigned* bar; unsigned x; volatile LAS unsigned* st; };
__device__ __forceinline__ XcdBarrier xcd_barrier_post(unsigned* bar, volatile LAS unsigned* st) {
    XcdBarrier b; b.bar = bar; b.x = xb_xcc_id(); b.st = st;
    if (threadIdx.x == 0) (void)xb_add(&bar[XB_XCNT(b.x)], 1u);
    return b;
}
__device__ __forceinline__ void xcd_barrier_complete(unsigned* bar, unsigned x, unsigned& nloc, unsigned& nx) {
    const unsigned G = gridDim.x * gridDim.y * gridDim.z;
    unsigned sum, cnt, mine, sp = 0u;
    for (;;) {
        sum = 0u; cnt = 0u; mine = 0u;
#pragma unroll
        for (unsigned j = 0; j < 16; ++j) { const unsigned c = xb_ld(&bar[XB_XCNT(j)]); sum += c; cnt += (c > 0u) ? 1u : 0u; mine = (j == x) ? c : mine; }
        if (sum == G) break;
        __builtin_amdgcn_s_sleep(1);
        if ((++sp & 255u) == 0u) { if (xb_ld(&bar[XB_TMO])) break; if (sp > XB_SPIN_CAP) { atomicAdd(&bar[XB_TMO], 1u); break; } }
    }
    nloc = mine > 0u ? mine : 1u; nx = cnt > 0u ? cnt : 1u;
}
__device__ __forceinline__ void xcd_barrier(const XcdBarrier& b) {
    asm volatile("s_waitcnt vmcnt(0)" ::: "memory");
    __syncthreads();
    if (threadIdx.x == 0) {
        unsigned* bar = b.bar;
        __builtin_amdgcn_s_waitcnt(0);
        unsigned nloc = b.st[0], nx = b.st[1];
        if (nloc == 0u) { xcd_barrier_complete(bar, b.x, nloc, nx); b.st[0] = nloc; b.st[1] = nx; }
        const unsigned old = xb_add(&bar[XB_XSUB(b.x)], 1u);
        const unsigned gen = old / nloc;
        if (old + 1u == (gen + 1u) * nloc) {
            __builtin_amdgcn_fence(__ATOMIC_RELEASE, "agent");
            asm volatile("s_waitcnt vmcnt(0)" ::: "memory");
            const unsigned og = xb_add(&bar[XB_TOP], 1u);
            const unsigned tg = og / nx;
            if (og + 1u == (tg + 1u) * nx) xb_add(&bar[XB_TOPGEN], 1u);
            else XB_SPIN(xb_ld(&bar[XB_TOPGEN]) == tg, bar);
            __builtin_amdgcn_fence(__ATOMIC_ACQUIRE, "agent");
            xb_add(&bar[XB_XGEN(b.x)], 1u);
            asm volatile("s_waitcnt vmcnt(0)" ::: "memory");
        } else {
            XB_SPIN(xb_ld(&bar[XB_XGEN(b.x)]) == gen, bar);
            __builtin_amdgcn_fence(__ATOMIC_ACQUIRE, "agent");
            asm volatile("s_waitcnt vmcnt(0)" ::: "memory");
        }
    }
    __syncthreads();
}

namespace pg8 {
constexpr int BM = 256, BK = 64, HALF = 128, HTB = HALF * BK * 2, STAGE_BYTES = 8 * HTB, NXCD = 8, WGM = 8;
__host__ __device__ __forceinline__ int lds_byte(int r, int c) { const int st = (r >> 4) * 2 + (c >> 5), rr = r & 15, cc = c & 31, ob = rr * 64 + cc * 2; return st * 1024 + (ob ^ (((ob >> 9) & 1) << 5)); }
__host__ __device__ __forceinline__ void stage_rc(int b, int& R, int& C) { const int st = b / 1024, sb = b % 1024, swz = sb ^ (((sb >> 9) & 1) << 5); R = (st >> 1) * 16 + swz / 64; C = (st & 1) * 32 + (swz % 64) / 2; }
__host__ __device__ __forceinline__ int perm32(int rho) { const int n = rho >> 4, i = rho & 15; return 8 * (i >> 2) + 4 * n + (i & 3); }

struct Unit { int pm, pn; const char* a; const char* b; const int* gi; int nvalid; int aux; };

struct StaticOrder {
    int nM, nN, nwg, G, c, RS; const char* A; const char* Bt;
    __device__ void init(const void* A_, const void* Bt_, int M, int N, int RS_, int G_, int c_) { A = (const char*)A_; Bt = (const char*)Bt_; RS = RS_; nM = M / BM; nN = N / BM; nwg = nM * nN; G = G_; c = c_; }
    __device__ bool next(int i, Unit& u) const {
        const long L = (long)i * G + c; if (L >= nwg) return false;
        int wgid = (int)L; { const int q = nwg / NXCD, r = nwg % NXCD, xcd = wgid % NXCD, off = wgid / NXCD; wgid = (xcd < r ? xcd * (q + 1) : r * (q + 1) + (xcd - r) * q) + off; }
        const int nig = WGM * nN, gid = wgid / nig, fm = gid * WGM, gsz = (nM - fm) < WGM ? (nM - fm) : WGM;
        u.pm = fm + ((wgid % nig) % gsz); u.pn = (wgid % nig) / gsz;
        u.a = A + (size_t)u.pm * BM * RS; u.b = Bt + (size_t)u.pn * BM * RS; u.gi = nullptr; u.nvalid = BM; u.aux = 0; return true;
    }
};

typedef int i32x8 __attribute__((ext_vector_type(8)));
typedef int i32x4v __attribute__((ext_vector_type(4)));
__device__ __forceinline__ i32x8 cat16(bf16x8 lo, bf16x8 hi) { const i32x4v a = *reinterpret_cast<const i32x4v*>(&lo), b = *reinterpret_cast<const i32x4v*>(&hi); return __builtin_shufflevector(a, b, 0, 1, 2, 3, 4, 5, 6, 7); }
template <class Epi, class Sched, bool GATHER, bool FP8 = false>
__device__ __forceinline__ void gemm_phase(LAS unsigned char* lds, const int RS, const Sched& S, const Epi& E, const int scale_b = 0x7f7f7f7f) {
    int tid = threadIdx.x; asm volatile("" : "+v"(tid));
    const int wid = __builtin_amdgcn_readfirstlane(tid >> 6), lane = tid & 63, wr = wid >> 2, wc = wid & 3, fr = lane & 15, fq = lane >> 4;
    const int nt = RS / (BK * 2); const int K = RS;
    unsigned voffA[2], voffB[2]; int RA[2], CA[2];
#pragma unroll
    for (int i = 0; i < 2; ++i) { int R, C; stage_rc(tid * 16 + i * 8192, R, C); const int Rb = ((R & ~31) + perm32(R & 31));
        RA[i] = R; CA[i] = C; voffA[i] = (unsigned)(R * RS + C * 2); voffB[i] = (unsigned)(Rb * RS + C * 2); }
    const size_t kstep = (size_t)(BK * 2);
    const size_t hstep = (size_t)HALF * RS;
    const unsigned ldsw = (unsigned)wid * 1024u;
    const int aoff = lds_byte(wr * 64 + fr, fq * 8), boff = lds_byte(wc * 32 + fr, fq * 8);
    unsigned gA[2][2], gN[2][2];
#define PG8_SA(b, h) (((b) * 2 + (h)) * HTB)
#define PG8_SB(b, h) ((4 + (b) * 2 + (h)) * HTB)
#define PG8_STAGE(bufoff, gbase, voff) do { _Pragma("unroll") for (int _i = 0; _i < 2; ++_i) \
        __builtin_amdgcn_global_load_lds((const unsigned*)((const char*)(gbase) + (voff)[_i]), (LAS unsigned*)(lds + (bufoff) + ldsw + _i * 8192), 16, 0, 0); } while (0)
#define PG8_STAGE_A(bufoff, gp, h, NX) do { if constexpr (GATHER) { if (NX) PG8_STAGE(bufoff, gp, gN[h]); else PG8_STAGE(bufoff, gp, gA[h]); } else PG8_STAGE(bufoff, (gp) + (h) * hstep, voffA); } while (0)
#define PG8_LD8(p_) __builtin_shufflevector(*(const LAS i32x4v*)(p_), *(const LAS i32x4v*)((p_) + 1024), 0, 1, 2, 3, 4, 5, 6, 7)
#define PG8_LDA(dst, b, h) do { if constexpr (FP8) { _Pragma("unroll") for (int m = 0; m < 4; ++m) dst##8[m] = PG8_LD8(lds + PG8_SA(b, h) + aoff + m * 2048); } \
        else { _Pragma("unroll") for (int m = 0; m < 4; ++m) _Pragma("unroll") for (int k = 0; k < 2; ++k) dst[m][k] = *(const LAS bf16x8*)(lds + PG8_SA(b, h) + aoff + m * 2048 + k * 1024); } } while (0)
#define PG8_LDB(dst, b, h) do { if constexpr (FP8) { _Pragma("unroll") for (int n = 0; n < 2; ++n) dst##8[n] = PG8_LD8(lds + PG8_SB(b, h) + boff + n * 2048); } \
        else { _Pragma("unroll") for (int n = 0; n < 2; ++n) _Pragma("unroll") for (int k = 0; k < 2; ++k) dst[n][k] = *(const LAS bf16x8*)(lds + PG8_SB(b, h) + boff + n * 2048 + k * 1024); } } while (0)
#define PG8_MMA(ai, bj, At, Bt) do { __builtin_amdgcn_s_setprio(1); \
        if constexpr (FP8) { _Pragma("unroll") for (int m = 0; m < 4; ++m) _Pragma("unroll") for (int n = 0; n < 2; ++n) \
            asm volatile("v_mfma_scale_f32_16x16x128_f8f6f4 %0, %1, %2, %0, %3, %4 op_sel_hi:[0,0,0]" : "+v"(acc[ai][bj][m][n]) : "v"(Bt##8[n]), "v"(At##8[m]), "v"(sc_b), "v"(sc_a)); } \
        else { _Pragma("unroll") for (int m = 0; m < 4; ++m) _Pragma("unroll") for (int n = 0; n < 2; ++n) _Pragma("unroll") for (int k = 0; k < 2; ++k) \
            acc[ai][bj][m][n] = __builtin_amdgcn_mfma_f32_16x16x32_bf16(Bt[n][k], At[m][k], acc[ai][bj][m][n], 0, 0, 0); } \
        __builtin_amdgcn_s_setprio(0); } while (0)
#define PG8_WAIT_V(n) asm volatile("s_waitcnt vmcnt(" #n ")" ::: "memory")
#define PG8_WAIT_L(n) asm volatile("s_waitcnt lgkmcnt(" #n ")" ::: "memory")
#define PG8_BAR __builtin_amdgcn_s_barrier()
#define PG8_SCHED __builtin_amdgcn_sched_barrier(0)
#define PG8_GIDX(dst, u) do { if constexpr (GATHER) { _Pragma("unroll") for (int h = 0; h < 2; ++h) _Pragma("unroll") for (int i = 0; i < 2; ++i) { \
        const int rr = h * HALF + RA[i]; const int tok = rr < (u).nvalid ? (u).gi[rr] : 0; dst[h][i] = (unsigned)(tok * K + CA[i] * 2); } } } while (0)
    Unit cur, nxt; int ui = 0;
    if (!S.next(0, cur)) return;
    f32x4 acc[2][2][4][2];
#pragma unroll
    for (int a = 0; a < 2; ++a)
#pragma unroll
        for (int b = 0; b < 2; ++b)
#pragma unroll
            for (int m = 0; m < 4; ++m)
#pragma unroll
                for (int n = 0; n < 2; ++n) acc[a][b][m][n] = (f32x4){0.f, 0.f, 0.f, 0.f};
    const int sc_b = scale_b, sc_a = 0x7f7f7f7f;
    bf16x8 At[4][2], B0[2][2], B1[2][2]; i32x8 At8[4], B08[2], B18[2];
    const char* cA = cur.a; const char* cB = cur.b;
    PG8_GIDX(gA, cur);
    PG8_STAGE(PG8_SB(0, 0), cB, voffB); PG8_STAGE_A(PG8_SA(0, 0), cA, 0, false); PG8_STAGE(PG8_SB(0, 1), cB + hstep, voffB); PG8_STAGE_A(PG8_SA(0, 1), cA, 1, false);
    if (wr == 1) PG8_BAR;
    PG8_WAIT_V(4); PG8_BAR;
    PG8_STAGE(PG8_SB(1, 0), cB + kstep, voffB); PG8_STAGE_A(PG8_SA(1, 0), cA + kstep, 0, false); PG8_STAGE(PG8_SB(1, 1), cB + hstep + kstep, voffB);
    PG8_WAIT_V(6); PG8_BAR;
    for (;;) {
        const bool has_next = S.next(ui + 1, nxt);
        const char* nA = has_next ? nxt.a : cA; const char* nB = has_next ? nxt.b : cB;
        if constexpr (GATHER) { if (has_next) { PG8_GIDX(gN, nxt); } else {
#pragma unroll
            for (int h = 0; h < 2; ++h)
#pragma unroll
                for (int i = 0; i < 2; ++i) gN[h][i] = gA[h][i]; } }
        for (int t = 0; t < nt; t += 2) {
            const bool last = (t == nt - 2);
            const char* a1 = cA + (size_t)(t + 1) * kstep;
            const char* a2 = last ? nA : cA + (size_t)(t + 2) * kstep; const char* b2 = last ? nB : cB + (size_t)(t + 2) * kstep;
            const char* a3 = a2 + kstep; const char* b3 = b2 + kstep;
            PG8_LDB(B0, 0, 0); PG8_SCHED; PG8_LDA(At, 0, 0); PG8_STAGE_A(PG8_SA(1, 1), a1, 1, false);
            PG8_WAIT_L(8); PG8_BAR; PG8_WAIT_L(0); PG8_MMA(0, 0, At, B0); PG8_BAR; PG8_SCHED;
            PG8_LDB(B1, 0, 1); PG8_STAGE(PG8_SB(0, 0), b2, voffB);
            PG8_BAR; PG8_WAIT_L(0); PG8_MMA(0, 1, At, B1); PG8_BAR;
            PG8_LDA(At, 0, 1); PG8_STAGE_A(PG8_SA(0, 0), a2, 0, last);
            PG8_BAR; PG8_WAIT_L(0); PG8_MMA(1, 0, At, B0); PG8_BAR; PG8_SCHED;
            PG8_STAGE(PG8_SB(0, 1), b2 + hstep, voffB);
            PG8_WAIT_V(6); PG8_BAR; PG8_MMA(1, 1, At, B1); PG8_BAR;
            PG8_LDB(B0, 1, 0); PG8_SCHED; PG8_LDA(At, 1, 0); PG8_STAGE_A(PG8_SA(0, 1), a2, 1, last);
            PG8_WAIT_L(8); PG8_BAR; PG8_WAIT_L(0); PG8_MMA(0, 0, At, B0); PG8_BAR; PG8_SCHED;
            PG8_LDB(B1, 1, 1); PG8_STAGE(PG8_SB(1, 0), b3, voffB);
            PG8_BAR; PG8_WAIT_L(0); PG8_MMA(0, 1, At, B1); PG8_BAR;
            PG8_LDA(At, 1, 1); PG8_STAGE_A(PG8_SA(1, 0), a3, 0, last);
            PG8_BAR; PG8_WAIT_L(0); PG8_MMA(1, 0, At, B0); PG8_BAR; PG8_SCHED;
            PG8_STAGE(PG8_SB(1, 1), b3 + hstep, voffB);
            PG8_WAIT_V(6); PG8_BAR; PG8_MMA(1, 1, At, B1); PG8_BAR;
        }
        bool keep_acc = false;
        if constexpr (FP8) asm volatile("s_nop 15\n\ts_nop 15" ::: "memory");
        if constexpr (Epi::DUAL) { if (cur.aux) { E.mid(acc, cur, wr, wc, fr, fq); keep_acc = true; } else E(acc, cur, wr, wc, fr, fq); } else E(acc, cur, wr, wc, fr, fq);
        if (!has_next) break;
        if (!keep_acc)
#pragma unroll
        for (int a = 0; a < 2; ++a)
#pragma unroll
            for (int b = 0; b < 2; ++b)
#pragma unroll
                for (int m = 0; m < 4; ++m)
#pragma unroll
                    for (int n = 0; n < 2; ++n) acc[a][b][m][n] = (f32x4){0.f, 0.f, 0.f, 0.f};
        cur = nxt; cA = nA; cB = nB; ++ui;
        if constexpr (GATHER) {
#pragma unroll
            for (int h = 0; h < 2; ++h)
#pragma unroll
                for (int i = 0; i < 2; ++i) gA[h][i] = gN[h][i]; }
    }
    PG8_WAIT_V(0);
    if (wr == 0) PG8_BAR;
    PG8_BAR;
#undef PG8_SA
#undef PG8_SB
#undef PG8_STAGE
#undef PG8_STAGE_A
#undef PG8_LDA
#undef PG8_LD8
#undef PG8_LDB
#undef PG8_MMA
#undef PG8_WAIT_V
#undef PG8_WAIT_L
#undef PG8_BAR
#undef PG8_SCHED
#undef PG8_GIDX
}
}
using pg8::Unit;

#define EPI_LOOP(...) { int fr_ = fr, fq_ = fq; asm volatile("" : "+v"(fr_), "+v"(fq_)); _Pragma("unroll") for (int ai = 0; ai < 2; ++ai) _Pragma("unroll") for (int m = 0; m < 4; ++m) _Pragma("unroll") for (int bj = 0; bj < 2; ++bj) { \
        const int trow = ai * 128 + wr * 64 + m * 16 + fr_; const int tcol = bj * 128 + wc * 32 + fq_ * 8; const f32x4 v0 = acc[ai][bj][m][0], v1 = acc[ai][bj][m][1]; __VA_ARGS__ } }

__device__ __forceinline__ u32x4 pack8(const f32x4 a, const f32x4 b) { u32x4 w; w.x = cvt_pk_bf16(a[0], a[1]); w.y = cvt_pk_bf16(a[2], a[3]); w.z = cvt_pk_bf16(b[0], b[1]); w.w = cvt_pk_bf16(b[2], b[3]); return w; }

struct EpiProj { static constexpr bool DUAL = false;
    unsigned char* ws; const float* b_gate;
    __device__ __forceinline__ void operator()(const f32x4 (&acc)[2][2][4][2], const Unit& u, int wr, int wc, int fr, int fq) const {
        const int pn = u.pn; const size_t row0 = (size_t)u.pm * 256;
        if (pn == 4 || pn == 9) {
            float* dst = (float*)(ws + (pn == 4 ? WS_CKV : WS_MISC));
            EPI_LOOP({ float* p = dst + (row0 + trow) * 256 + tcol; *(f32x4*)p = v0; *(f32x4*)(p + 4) = v1;
                if (pn == 9 && tcol < 64) *(u32x4*)((bf16_t*)(ws + WS_KIDX) + (row0 + trow) * 64 + tcol) = pack8(v0, v1); })
        } else if (pn < 22) {
            bf16_t* dst; int ct;
            if (pn < 4) { dst = (bf16_t*)(ws + WS_QA); ct = pn; } else if (pn < 9) { dst = (bf16_t*)(ws + WS_QIDX); ct = pn - 5; }
            else if (pn < 14) { dst = (bf16_t*)(ws + WS_QB); ct = pn - 10; } else if (pn < 18) { dst = (bf16_t*)(ws + WS_KB); ct = pn - 14; } else { dst = (bf16_t*)(ws + WS_VB); ct = pn - 18; }
            EPI_LOOP({ *(u32x4*)(dst + (row0 + trow) * 1024 + ct * 256 + tcol) = pack8(v0, v1); })
        } else {
            bf16_t* dst = (bf16_t*)(ws + WS_GATES); const int ct = pn - 22;
            EPI_LOOP({ const int col = ct * 256 + tcol; const f32x4 b0 = *(const f32x4*)(b_gate + col), b1 = *(const f32x4*)(b_gate + col + 4); f32x4 s0, s1;
                _Pragma("unroll") for (int j = 0; j < 4; ++j) { s0[j] = sigmoidf_(v0[j] + b0[j]); s1[j] = sigmoidf_(v1[j] + b1[j]); }
                *(u32x4*)(dst + (row0 + trow) * 4096 + col) = pack8(s0, s1); })
        }
    }
};
struct EpiGate1 { static constexpr bool DUAL = false;
    const bf16_t* gates; float* T1;
    __device__ __forceinline__ void operator()(const f32x4 (&acc)[2][2][4][2], const Unit& u, int wr, int wc, int fr, int fq) const {
        EPI_LOOP({ const size_t row = (size_t)u.pm * 256 + trow; const int col = u.pn * 256 + tcol; const u32x4 g = *(const u32x4*)(gates + row * 4096 + col);
            f32x4 o0 = {v0[0] * bf_lo(g.x), v0[1] * bf_hi(g.x), v0[2] * bf_lo(g.y), v0[3] * bf_hi(g.y)}; f32x4 o1 = {v1[0] * bf_lo(g.z), v1[1] * bf_hi(g.z), v1[2] * bf_lo(g.w), v1[3] * bf_hi(g.w)};
            float* p = T1 + row * 2048 + col; *(f32x4*)p = o0; *(f32x4*)(p + 4) = o1; })
    }
};
struct EpiGate2 { static constexpr bool DUAL = false;
    const bf16_t* gates; const float* T1; bf16_t* merged;
    __device__ __forceinline__ void operator()(const f32x4 (&acc)[2][2][4][2], const Unit& u, int wr, int wc, int fr, int fq) const {
        EPI_LOOP({ const size_t row = (size_t)u.pm * 256 + trow; const int col = u.pn * 256 + tcol; const u32x4 g = *(const u32x4*)(gates + row * 4096 + 2048 + col);
            const float* p = T1 + row * 2048 + col; const f32x4 t0 = *(const f32x4*)p, t1 = *(const f32x4*)(p + 4);
            f32x4 o0 = {t0[0] + v0[0] * bf_lo(g.x), t0[1] + v0[1] * bf_hi(g.x), t0[2] + v0[2] * bf_lo(g.y), t0[3] + v0[3] * bf_hi(g.y)};
            f32x4 o1 = {t1[0] + v1[0] * bf_lo(g.z), t1[1] + v1[1] * bf_hi(g.z), t1[2] + v1[2] * bf_lo(g.w), t1[3] + v1[3] * bf_hi(g.w)};
            *(u32x4*)(merged + row * 2048 + col) = pack8(o0, o1); })
    }
};
struct EpiWo { static constexpr bool DUAL = false;
    const float* x; const float* mod; float* out;
    __device__ __forceinline__ void operator()(const f32x4 (&acc)[2][2][4][2], const Unit& u, int wr, int wc, int fr, int fq) const {
        const float* gt = mod + (size_t)(u.pm >> 3) * 12288 + 4096;
        EPI_LOOP({ const size_t row = (size_t)u.pm * 256 + trow; const int col = u.pn * 256 + tcol; const float* px = x + row * 2048 + col;
            const f32x4 x0 = *(const f32x4*)px, x1 = *(const f32x4*)(px + 4), g0 = *(const f32x4*)(gt + col), g1 = *(const f32x4*)(gt + col + 4);
            float* po = out + row * 2048 + col; *(f32x4*)po = x0 + g0 * v0; *(f32x4*)(po + 4) = x1 + g1 * v1; })
    }
};
struct EpiMoeUp { static constexpr bool DUAL = false;
    bf16_t* act; const float* lw;
    __device__ __forceinline__ void operator()(const f32x4 (&acc)[2][2][4][2], const Unit& u, int wr, int wc, int fr, int fq) const {
        int fr_ = fr, fq_ = fq; asm volatile("" : "+v"(fr_), "+v"(fq_));
#pragma unroll
        for (int ai = 0; ai < 2; ++ai)
#pragma unroll
            for (int m = 0; m < 4; ++m) {
                const int trow = ai * 128 + wr * 64 + m * 16 + fr_; const int tcol = wc * 32 + fq_ * 8;
                const float gw = trow < u.nvalid ? lw[u.aux + trow] : 0.f;
                const f32x4 a0 = acc[ai][0][m][0], a1 = acc[ai][0][m][1], u0 = acc[ai][1][m][0], u1 = acc[ai][1][m][1]; f32x4 o0, o1;
#pragma unroll
                for (int j = 0; j < 4; ++j) { o0[j] = a0[j] * sigmoidf_(a0[j]) * u0[j] * gw; o1[j] = a1[j] * sigmoidf_(a1[j]) * u1[j] * gw; }
                *(u32x4*)(act + ((size_t)u.pm * 256 + trow) * 512 + u.pn * 128 + tcol) = pack8(o0, o1); SBAR();
            }
    }
};
struct EpiMoeDown { static constexpr bool DUAL = false;
    float* out; const float* mod;
    __device__ __forceinline__ void operator()(const f32x4 (&acc)[2][2][4][2], const Unit& u, int wr, int wc, int fr, int fq) const {
        EPI_LOOP({ if (trow < u.nvalid) { const int tok = u.gi[trow]; const int col = u.pn * 256 + tcol; const float* gt = mod + (size_t)(tok >> 11) * 12288 + 10240 + col;
            const f32x4 g0 = *(const f32x4*)gt, g1 = *(const f32x4*)(gt + 4); float* po = out + (size_t)tok * 2048 + col;
            _Pragma("unroll") for (int j = 0; j < 4; ++j) { unsafeAtomicAdd(po + j, g0[j] * v0[j]); unsafeAtomicAdd(po + 4 + j, g1[j] * v1[j]); } } })
    }
};


struct DualOrder {
    pg8::StaticOrder S0, S1;
    __device__ bool next(int i, Unit& u) const { const bool ok = (i & 1) ? S1.next(i >> 1, u) : S0.next(i >> 1, u); u.aux = (i & 1) ? 0 : 1; return ok; }
};
struct EpiGate12 { static constexpr bool DUAL = false;
    EpiGate1 e1; EpiGate2 e2;
    __device__ __forceinline__ void operator()(const f32x4 (&acc)[2][2][4][2], const Unit& u, int wr, int wc, int fr, int fq) const { if (u.aux) e1(acc, u, wr, wc, fr, fq); else e2(acc, u, wr, wc, fr, fq); }
};

struct ProjOrder {
    pg8::StaticOrder S; int fp8; const char* Bfull;
    __device__ bool next(int i, Unit& u) const {
        if (!S.next(i, u)) return false;
        if (fp8) u.pn += 18;
        return true;
    }
};
struct MoeOrder {
    const LAS int* pre;
    const LAS int* cnt;
    int G, c, ntn, K; const char* A; const char* Bt; size_t bstride; const int* ltok; bool down;
    __device__ bool next(int i, Unit& u) const {
        const int total = __builtin_amdgcn_readfirstlane(pre[64]) * ntn; const long L = (long)i * G + c; if (L >= total) return false;
        const int l = (int)L; const int mt = l / ntn, pn = l % ntn;
        int e = 0;
#pragma unroll 1
        for (int s = 32; s >= 1; s >>= 1) if (__builtin_amdgcn_readfirstlane(pre[e + s]) <= mt) e += s;
        const int lt = mt - __builtin_amdgcn_readfirstlane(pre[e]);
        u.pm = mt; u.pn = pn; u.aux = e * LCAP + lt * 256; u.gi = ltok + u.aux; { const int rem = __builtin_amdgcn_readfirstlane(cnt[e]) - lt * 256; u.nvalid = rem < 256 ? rem : 256; }
        u.a = down ? A + (size_t)mt * 256 * K * 2 : A; u.b = Bt + (size_t)e * bstride + (size_t)pn * 256 * K * 2; return true;
    }
};

__device__ __forceinline__ int map_row(int map, int n) {
    if (map == 0) return n;
    if (map == 1) { if (n < 2384) return n; if (n < 5456) return n + 176; if (n < 5464) return n - 3072; return n + 168; }
    if (map == 2) return (n >> 7) * 256 + (n & 127);
    return (n >> 7) * 256 + 128 + (n & 127);
}
__device__ void ph0_prologue(const Params& p, LAS unsigned char* lds) {
    const int tid = threadIdx.x, wid = tid >> 6, lane = tid & 63, G = gridDim.x, bx = blockIdx.x;
    if (bx < 192) {
        LAS float* sc = (LAS float*)lds;
        LAS float* red = (LAS float*)(lds + 32768);
        const float* c = p.in[I_C];
        for (int i = tid; i < 4 * 2048; i += NTHREADS) { const float v = c[i]; sc[i] = v / (1.0f + __expf(-v)); }
        __syncthreads();
        for (int item = bx; item < 192; item += G) {
            const int n0 = item * 64, cg = lane & 15, rs = lane >> 4;
            float acc[4][4];
#pragma unroll
            for (int b = 0; b < 4; ++b)
#pragma unroll
                for (int j = 0; j < 4; ++j) acc[b][j] = 0.f;
            const float* w = p.in[I_WADA] + n0 + cg * 4;
#pragma unroll 4
            for (int step = 0; step < 64; ++step) {
                const int k = step * 32 + wid * 4 + rs;
                const f32x4 wv = *(const f32x4*)(w + (size_t)k * 12288);
#pragma unroll
                for (int b = 0; b < 4; ++b) { const float s = sc[b * 2048 + k];
#pragma unroll
                    for (int j = 0; j < 4; ++j) acc[b][j] += s * wv[j]; }
            }
#pragma unroll
            for (int b = 0; b < 4; ++b)
#pragma unroll
                for (int j = 0; j < 4; ++j) { float v = acc[b][j]; v += __shfl_xor(v, 16); v += __shfl_xor(v, 32); acc[b][j] = v; }
            if (rs == 0) {
#pragma unroll
                for (int b = 0; b < 4; ++b)
#pragma unroll
                    for (int j = 0; j < 4; ++j) red[(wid * 16 + cg) * 16 + b * 4 + j] = acc[b][j]; }
            __syncthreads();
            if (tid < 256) { const int cg2 = tid >> 4, bj = tid & 15, b = bj >> 2, j = bj & 3; float s = 0.f;
#pragma unroll
                for (int w8 = 0; w8 < 8; ++w8) s += red[(w8 * 16 + cg2) * 16 + bj];
                const int n = n0 + cg2 * 4 + j; ((float*)(p.ws + WS_MOD))[b * 12288 + n] = s + p.in[I_BADA][n]; }
            __syncthreads();
        }
    }
    { u32x4* z = (u32x4*)(p.ws + WS_WIN + (size_t)2392 * 2048 * 2); const int n16 = 168 * 2048 * 2 / 16;
      for (int i = bx * NTHREADS + tid; i < n16; i += G * NTHREADS) z[i] = (u32x4){0u, 0u, 0u, 0u}; }
    { bf16_t* wh = (bf16_t*)(p.ws + WS_WRH); bf16_t* wl = (bf16_t*)(p.ws + WS_WRL);
      for (int i = bx * NTHREADS + tid; i < 80 * 2048; i += G * NTHREADS) { const int n = i >> 11, k = i & 2047;
          const float v = n < 8 ? p.in[I_WRG][k * 8 + n] : (n < 72 ? p.in[I_WRE][k * 64 + n - 8] : 0.f);
          const unsigned h = cvt_pk_bf16(v, 0.f) & 0xffffu; const unsigned l = cvt_pk_bf16(v - bf_lo(h), 0.f) & 0xffffu; wh[i] = (bf16_t)h; wl[i] = (bf16_t)l; } }
    LAS float* tile = (LAS float*)(lds + 65536);
    for (int ti = bx; ti < p.ntiles_total; ti += G) {
        int j = 0;
#pragma unroll 1
        for (int q = 1; q < NJOBS; ++q) if (ti >= p.jobs[q].tile0) j = q;
        const TJob& J = p.jobs[j];
        int l = ti - J.tile0; const int per = J.ntk * J.ntn; const int bt = l / per; l -= bt * per; const int tn = l / J.ntk, tk = l % J.ntk;
        const float* src = J.src + (size_t)bt * J.sbatch; bf16_t* dst = J.dst + (size_t)bt * J.dbatch;
        const int k0 = tk * 64, n0 = tn * 128;
        f32x4 v[4];
#pragma unroll
        for (int i = 0; i < 4; ++i) { const int r = (tid >> 5) + 16 * i, c4 = (tid & 31) * 4;
            v[i] = (f32x4){0.f, 0.f, 0.f, 0.f}; if (n0 + c4 < J.N) v[i] = *(const f32x4*)(src + (size_t)(k0 + r) * J.ld + n0 + c4); }
#pragma unroll
        for (int i = 0; i < 4; ++i) { const int r = (tid >> 5) + 16 * i, c4 = (tid & 31) * 4;
#pragma unroll
            for (int q = 0; q < 4; ++q) tile[r * 129 + c4 + q] = v[i][q]; }
        __syncthreads();
        { const int n = tid >> 2, kq = (tid & 3) * 16;
          if (n0 + n < J.N) { float f[16];
#pragma unroll
              for (int q = 0; q < 16; ++q) f[q] = tile[(kq + q) * 129 + n];
              u32x4 w0, w1; w0.x = cvt_pk_bf16(f[0], f[1]); w0.y = cvt_pk_bf16(f[2], f[3]); w0.z = cvt_pk_bf16(f[4], f[5]); w0.w = cvt_pk_bf16(f[6], f[7]);
              w1.x = cvt_pk_bf16(f[8], f[9]); w1.y = cvt_pk_bf16(f[10], f[11]); w1.z = cvt_pk_bf16(f[12], f[13]); w1.w = cvt_pk_bf16(f[14], f[15]);
              if (J.fp8) { u32x4 w8; w8.x = pack_fp8x4(f[0] * 64.f, f[1] * 64.f, f[2] * 64.f, f[3] * 64.f); w8.y = pack_fp8x4(f[4] * 64.f, f[5] * 64.f, f[6] * 64.f, f[7] * 64.f);
                  w8.z = pack_fp8x4(f[8] * 64.f, f[9] * 64.f, f[10] * 64.f, f[11] * 64.f); w8.w = pack_fp8x4(f[12] * 64.f, f[13] * 64.f, f[14] * 64.f, f[15] * 64.f);
                  *(u32x4*)((unsigned char*)dst + (size_t)(n0 + n) * J.ldd + k0 + kq) = w8; }
              else { bf16_t* d = dst + (size_t)map_row(J.map, n0 + n) * J.ldd + k0 + kq; *(u32x4*)d = w0; *(u32x4*)(d + 8) = w1; } } }
        __syncthreads();
    }
}

__device__ __forceinline__ void norm_row(const float* xr, const float* g, const float* sh, const float* sc, bf16_t* hr, unsigned char* h8, int lane, float (&hv)[32]) {
    f32x4 v[8]; float ss = 0.f;
#pragma unroll
    for (int i = 0; i < 8; ++i) { v[i] = *(const f32x4*)(xr + i * 256 + lane * 4); ss += v[i][0] * v[i][0] + v[i][1] * v[i][1] + v[i][2] * v[i][2] + v[i][3] * v[i][3]; }
    ss = wave_sum(ss);
    const float rstd = rsqrtf(ss * (1.0f / 2048.0f) + RMS_EPS);
#pragma unroll
    for (int i = 0; i < 8; ++i) { const int col = i * 256 + lane * 4; const f32x4 gg = *(const f32x4*)(g + col), s1 = *(const f32x4*)(sc + col), s0 = *(const f32x4*)(sh + col);
#pragma unroll
        for (int j = 0; j < 4; ++j) hv[i * 4 + j] = v[i][j] * rstd * gg[j] * (1.0f + s1[j]) + s0[j];
        u32x2 w; w.x = cvt_pk_bf16(hv[i * 4], hv[i * 4 + 1]); w.y = cvt_pk_bf16(hv[i * 4 + 2], hv[i * 4 + 3]); *(u32x2*)(hr + col) = w;
        if (h8) *(unsigned*)(h8 + col) = pack_fp8x4(hv[i * 4], hv[i * 4 + 1], hv[i * 4 + 2], hv[i * 4 + 3]); }
}
__device__ void ph1_norm(const Params& p) {
    const int lane = threadIdx.x & 63, gw = blockIdx.x * 8 + (threadIdx.x >> 6), nw = gridDim.x * 8;
    const float* mod = (const float*)(p.ws + WS_MOD);
    for (int t = gw; t < NTOK; t += nw) { const int b = t >> 11; float hv[32];
        norm_row(p.in[I_X] + (size_t)t * DM, p.in[I_GMIX], mod + b * 12288, mod + b * 12288 + 2048, (bf16_t*)(p.ws + WS_H) + (size_t)t * DM, (unsigned char*)(p.ws + WS_HF8) + (size_t)t * DM, lane, hv); }
}

template <int MB, int NB, int KS>
__device__ __forceinline__ void wave_gemm(const bf16_t* A, int lda, const bf16_t* Bt, int ldb, f32x4 (&acc)[MB][NB], int lane) {
    const int fr = lane & 15, fq = lane >> 4;
#pragma unroll
    for (int mb = 0; mb < MB; ++mb)
#pragma unroll
        for (int nb = 0; nb < NB; ++nb) acc[mb][nb] = (f32x4){0.f, 0.f, 0.f, 0.f};
#pragma unroll 1
    for (int ks = 0; ks < KS; ++ks) {
        bf16x8 af[MB];
#pragma unroll
        for (int mb = 0; mb < MB; ++mb) af[mb] = *(const bf16x8*)(A + (size_t)(mb * 16 + fr) * lda + ks * 32 + fq * 8);
#pragma unroll
        for (int nb = 0; nb < NB; ++nb) { const bf16x8 bf = *(const bf16x8*)(Bt + (size_t)(nb * 16 + fr) * ldb + ks * 32 + fq * 8);
#pragma unroll
            for (int mb = 0; mb < MB; ++mb) acc[mb][nb] = __builtin_amdgcn_mfma_f32_16x16x32_bf16(bf, af[mb], acc[mb][nb], 0, 0, 0); }
    }
}


__device__ __forceinline__ int wave_total_i32(int v) {
    v += __builtin_amdgcn_update_dpp(0, v, 0x111, 0xf, 0xf, true); v += __builtin_amdgcn_update_dpp(0, v, 0x112, 0xf, 0xf, true);
    v += __builtin_amdgcn_update_dpp(0, v, 0x114, 0xf, 0xf, true); v += __builtin_amdgcn_update_dpp(0, v, 0x118, 0xf, 0xf, true);
    v += __builtin_amdgcn_update_dpp(0, v, 0x142, 0xa, 0xf, false); v += __builtin_amdgcn_update_dpp(0, v, 0x143, 0xc, 0xf, false);
    return __builtin_amdgcn_readlane(v, 63);
}
template <int NI> __device__ __forceinline__ unsigned long long topk_words(const LAS float* srow, int c, int lane) {
    unsigned key[NI];
#pragma unroll
    for (int i = 0; i < NI; ++i) { unsigned u = 0u; if (i <= c) { u = __float_as_uint(srow[i * 64 + lane]); u = (u & 0x80000000u) ? ~u : (u | 0x80000000u); } key[i] = u; }
    unsigned v = 0u;
#pragma unroll 1
    for (int bit = 31; bit >= 0; --bit) {
        const unsigned cand = v | (1u << bit); int cl = 0;
#pragma unroll
        for (int i = 0; i < NI; ++i) cl += (key[i] >= cand) ? 1 : 0;
        const int tot = wave_total_i32(cl);
        if (tot >= 256) { v = cand; if (tot == 256) break; }
    }
    unsigned long long myword = 0ull;
#pragma unroll
    for (int i = 0; i < NI; ++i) { const unsigned long long bm = __ballot(key[i] >= v); if (lane == i) myword = bm; if ((i & 3) == 3) SBAR(); }
    return myword;
}
__device__ void idx_item(const Params& p, LAS unsigned char* lds, int b, int c, int sub) {
    const int tid = threadIdx.x, wid = tid >> 6, lane = tid & 63, fr = lane & 15, fq = lane >> 4;
    constexpr int SCLD = 2052;
    LAS float* sc = (LAS float*)lds;
    const int q0 = c * 64 + sub * 16, nk = (c + 1) * 64, nkb = nk / 16;
    const bf16_t* qidx = (const bf16_t*)(p.ws + WS_QIDX) + (size_t)(b * SEQ + q0 + fr) * 1024;
    const float* misc = (const float*)(p.ws + WS_MISC);
    float wq[16];
    { const float* wp = misc + (size_t)(b * SEQ + q0 + fr) * 256 + 64;
#pragma unroll
      for (int i = 0; i < 4; ++i) { const f32x4 v = *(const f32x4*)(wp + i * 4); wq[i * 4] = v[0]; wq[i * 4 + 1] = v[1]; wq[i * 4 + 2] = v[2]; wq[i * 4 + 3] = v[3]; } }
#pragma unroll
    for (int hp = 0; hp < 2; ++hp) {
        bf16x8 qf[8][2];
#pragma unroll
        for (int h = 0; h < 8; ++h)
#pragma unroll
            for (int ks = 0; ks < 2; ++ks) qf[h][ks] = *(const bf16x8*)(qidx + (hp * 8 + h) * 64 + ks * 32 + fq * 8);
        const bf16_t* kbase = (const bf16_t*)(p.ws + WS_KIDX) + (size_t)(b * SEQ + fr) * 64 + fq * 8;
        bf16x8 kf[2];
        if (wid < nkb) { kf[0] = *(const bf16x8*)(kbase + (size_t)wid * 16 * 64); kf[1] = *(const bf16x8*)(kbase + (size_t)wid * 16 * 64 + 32); }
#pragma unroll 1
        for (int kb = wid; kb < nkb; kb += 8) {
            const int kn = kb + 8 < nkb ? kb + 8 : kb;
            const bf16x8 kn0 = *(const bf16x8*)(kbase + (size_t)kn * 16 * 64), kn1 = *(const bf16x8*)(kbase + (size_t)kn * 16 * 64 + 32);
            LAS f32x4* sp = (LAS f32x4*)(sc + fr * SCLD + kb * 16 + fq * 4);
            f32x4 s = {0.f, 0.f, 0.f, 0.f}; if (hp) s = *sp;
#pragma unroll
            for (int h = 0; h < 8; ++h) {
                f32x4 a = {0.f, 0.f, 0.f, 0.f};
                a = __builtin_amdgcn_mfma_f32_16x16x32_bf16(kf[0], qf[h][0], a, 0, 0, 0);
                a = __builtin_amdgcn_mfma_f32_16x16x32_bf16(kf[1], qf[h][1], a, 0, 0, 0);
#pragma unroll
                for (int j = 0; j < 4; ++j) s[j] += wq[hp * 8 + h] * fmaxf(a[j], 0.f);
            }
            *sp = s; kf[0] = kn0; kf[1] = kn1;
        }
    }
    __syncthreads();
    unsigned long long* mask = (unsigned long long*)(p.ws + WS_MASK);
    for (int qq = 0; qq < 2; ++qq) {
        const int ql = wid * 2 + qq; const size_t qg = (size_t)b * SEQ + q0 + ql;
        unsigned long long myword = 0ull;
        if (nk <= 256) { if (lane <= c) myword = ~0ull; }
        else { const LAS float* srow = sc + ql * SCLD;
            if (c < 8) myword = topk_words<8>(srow, c, lane); else if (c < 16) myword = topk_words<16>(srow, c, lane);
            else if (c < 24) myword = topk_words<24>(srow, c, lane); else myword = topk_words<32>(srow, c, lane); }
        if (lane < 32) mask[qg * 32 + lane] = myword;
    }
    __syncthreads();
}
#ifndef REP_SUB
#define REP_SUB 15
#endif
__device__ void ph3_prep(const Params& p, LAS unsigned char* lds, const int rep) {
#define P3ON(bit) (!rep || ((REP_SUB) & (bit)))
    const int tid = threadIdx.x, wid = tid >> 6, lane = tid & 63, bx = blockIdx.x, G = gridDim.x;
    if (P3ON(1)) for (int it = bx; it < 256; it += G) {
        const int b = it >> 6, r = it & 63, cp = r >> 2, sub = r & 3;
        idx_item(p, lds, b, 31 - cp, sub); idx_item(p, lds, b, cp, sub);
    }
    const int gw = bx * 8 + wid, nw = G * 8;
    if (P3ON(2)) for (int it = gw; it < 2048; it += nw) {
        const int rt = it >> 3, h = it & 7, fr = lane & 15, fq = lane >> 4;
        f32x4 acc[2][16];
        wave_gemm<2, 16, 4>((const bf16_t*)(p.ws + WS_QA) + (size_t)rt * 32 * 1024 + h * 128, 1024, (const bf16_t*)(p.ws + WS_WUK) + (size_t)h * 256 * 128, 128, acc, lane);
#pragma unroll
        for (int mb = 0; mb < 2; ++mb) { float ss = 0.f;
#pragma unroll
            for (int nb = 0; nb < 16; ++nb)
#pragma unroll
                for (int j = 0; j < 4; ++j) ss += acc[mb][nb][j] * acc[mb][nb][j];
            ss += __shfl_xor(ss, 16); ss += __shfl_xor(ss, 32);
            const float rs = rsqrtf(ss * (1.0f / 256.0f) + RMS_EPS) * 0.0625f;
            bf16_t* o = (bf16_t*)(p.ws + WS_QLAT) + (size_t)(rt * 32 + mb * 16 + fr) * 2048 + h * 256;
#pragma unroll
            for (int nb = 0; nb < 16; ++nb) { const int col = nb * 16 + fq * 4; const f32x4 g = *(const f32x4*)(p.in[I_GQA] + col);
                u32x2 w; w.x = cvt_pk_bf16(acc[mb][nb][0] * rs * g[0], acc[mb][nb][1] * rs * g[1]); w.y = cvt_pk_bf16(acc[mb][nb][2] * rs * g[2], acc[mb][nb][3] * rs * g[3]); *(u32x2*)(o + col) = w; } }
    }
    if (P3ON(4)) for (int t = gw; t < NTOK; t += nw) {
        { const f32x4 v = *(const f32x4*)((const float*)(p.ws + WS_CKV) + (size_t)t * 256 + lane * 4); float ss = wave_sum(v[0] * v[0] + v[1] * v[1] + v[2] * v[2] + v[3] * v[3]);
          const float rs = rsqrtf(ss * (1.0f / 256.0f) + RMS_EPS); const f32x4 g = *(const f32x4*)(p.in[I_GKV] + lane * 4);
          u32x2 w; w.x = cvt_pk_bf16(v[0] * rs * g[0], v[1] * rs * g[1]); w.y = cvt_pk_bf16(v[2] * rs * g[2], v[3] * rs * g[3]); *(u32x2*)((bf16_t*)(p.ws + WS_KV) + (size_t)t * 256 + lane * 4) = w; }
#pragma unroll
        for (int which = 0; which < 2; ++which) {
            bf16_t* row = (bf16_t*)(p.ws + (which ? WS_KB : WS_QB)) + (size_t)t * 1024 + lane * 16; const float* g = p.in[which ? I_GKB : I_GQB] + (lane & 7) * 16;
            u32x4 a = *(u32x4*)row, c2 = *(u32x4*)(row + 8); float f[16];
            f[0] = bf_lo(a.x); f[1] = bf_hi(a.x); f[2] = bf_lo(a.y); f[3] = bf_hi(a.y); f[4] = bf_lo(a.z); f[5] = bf_hi(a.z); f[6] = bf_lo(a.w); f[7] = bf_hi(a.w);
            f[8] = bf_lo(c2.x); f[9] = bf_hi(c2.x); f[10] = bf_lo(c2.y); f[11] = bf_hi(c2.y); f[12] = bf_lo(c2.z); f[13] = bf_hi(c2.z); f[14] = bf_lo(c2.w); f[15] = bf_hi(c2.w);
            float ss = 0.f;
#pragma unroll
            for (int j = 0; j < 16; ++j) ss += f[j] * f[j];
            ss += __shfl_xor(ss, 1); ss += __shfl_xor(ss, 2); ss += __shfl_xor(ss, 4);
            const float rs = rsqrtf(ss * (1.0f / 128.0f) + RMS_EPS) * (which ? 1.0f : 0.08838834764831845f);
#pragma unroll
            for (int j = 0; j < 16; ++j) f[j] *= rs * g[j];
            a.x = cvt_pk_bf16(f[0], f[1]); a.y = cvt_pk_bf16(f[2], f[3]); a.z = cvt_pk_bf16(f[4], f[5]); a.w = cvt_pk_bf16(f[6], f[7]);
            c2.x = cvt_pk_bf16(f[8], f[9]); c2.y = cvt_pk_bf16(f[10], f[11]); c2.z = cvt_pk_bf16(f[12], f[13]); c2.w = cvt_pk_bf16(f[14], f[15]);
            if (!rep) { *(u32x4*)row = a; *(u32x4*)(row + 8) = c2; } else if (a.x == 0x12345678u) *(u32x4*)row = c2;
        }
    }
    if (P3ON(8) && bx < NBATCH) {
        const int b = bx; const float* fp = (const float*)(p.ws + WS_MISC) + (size_t)(b * SEQ + 4 * tid) * 256 + 80;
        float ls[4][8];
#pragma unroll
        for (int j = 0; j < 4; ++j) { const f32x4 a = *(const f32x4*)(fp + j * 256), c4 = *(const f32x4*)(fp + j * 256 + 4);
#pragma unroll
            for (int h = 0; h < 8; ++h) { const float z = (h < 4 ? a[h & 3] : c4[h & 3]) + p.in[I_BFORGET][h]; ls[j][h] = fminf(z, 0.f) - log1pf(__expf(-fabsf(z))); } }
        LAS float* wt = (LAS float*)lds;
        float off[8];
#pragma unroll
        for (int h = 0; h < 8; ++h) { ls[1][h] += ls[0][h]; ls[2][h] += ls[1][h]; ls[3][h] += ls[2][h];
            float incl = ls[3][h];
#pragma unroll
            for (int o = 1; o < 64; o <<= 1) { const float t2 = __shfl_up(incl, o); if (lane >= o) incl += t2; }
            if (lane == 63) wt[wid * 8 + h] = incl;
            off[h] = incl - ls[3][h]; }
        __syncthreads();
#pragma unroll
        for (int h = 0; h < 8; ++h) { float wo = 0.f; for (int w8 = 0; w8 < wid; ++w8) wo += wt[w8 * 8 + h];
            float* cp = (float*)(p.ws + WS_CUM) + (size_t)(b * 8 + h) * SEQ + 4 * tid;
            *(f32x4*)cp = (f32x4){ls[0][h] + off[h] + wo, ls[1][h] + off[h] + wo, ls[2][h] + off[h] + wo, ls[3][h] + off[h] + wo}; }
        __syncthreads();
    }
}

template <int OFF> __device__ __forceinline__ s16x4 tr_read(int vb) { s16x4 r; asm volatile("ds_read_b64_tr_b16 %0, %1 offset:%2" : "=&v"(r) : "v"(vb), "i"(OFF) : "memory"); return r; }
__device__ __forceinline__ int v_rd_base(int lane) { return ((lane & 3) << 3) | (((lane >> 2) & 3) << 6) | (((lane >> 4) & 1) << 5) | (((lane >> 5) & 1) << 8); }
template <int NCB> __device__ __forceinline__ int v_st(int k, int c) { const int kk = (k & ~0xC) | ((k & 4) << 1) | ((k & 8) >> 1); return ((kk >> 3) * NCB + (c >> 5)) * 512 + ((kk & 7) * 32 + (c & 31)) * 2; }
#define PK4(P, BASE, OUT) do { unsigned a0 = cvt_pk_bf16(P[BASE + 0], P[BASE + 1]), a1 = cvt_pk_bf16(P[BASE + 2], P[BASE + 3]);   \
    unsigned b0 = cvt_pk_bf16(P[BASE + 4], P[BASE + 5]), b1 = cvt_pk_bf16(P[BASE + 6], P[BASE + 7]);                              \
    auto r0 = __builtin_amdgcn_permlane32_swap(a0, b0, false, false); auto r1 = __builtin_amdgcn_permlane32_swap(a1, b1, false, false); \
    u32x4 w = {r0[0], r1[0], r0[1], r1[1]}; OUT = *reinterpret_cast<bf16x8*>(&w); } while (0)
#define PKV(L, H) (bf16x8){L[0], L[1], L[2], L[3], H[0], H[1], H[2], H[3]}
template <int NCB, int D0, int KS> __device__ __forceinline__ void pv_step(f32x16& od, int vb, bf16x8 pa) {
    const s16x4 l = tr_read<D0 * 512 + KS * (2 * NCB * 512)>(vb), h = tr_read<D0 * 512 + KS * (2 * NCB * 512) + NCB * 512>(vb);
    asm volatile("s_waitcnt lgkmcnt(0)" ::: "memory"); SBAR();
    od = __builtin_amdgcn_mfma_f32_32x32x16_bf16(pa, PKV(l, h), od, 0, 0, 0);
}
template <int NCB, int KS0, int D0> struct PvBlocks { static __device__ __forceinline__ void run(f32x16* o, int vb, bf16x8 pa0, bf16x8 pa1) {
    pv_step<NCB, D0, KS0>(o[D0], vb, pa0); pv_step<NCB, D0, KS0 + 1>(o[D0], vb, pa1); if constexpr (D0 + 1 < NCB) PvBlocks<NCB, KS0, D0 + 1>::run(o, vb, pa0, pa1); } };
template <int NCB, int KS0, int D0> struct PvPairs { static __device__ __forceinline__ void run(f32x16* o, int vb, bf16x8 pa0, bf16x8 pa1) {
    constexpr int S = 2 * NCB * 512, H = NCB * 512;
    const s16x4 l00 = tr_read<D0 * 512 + KS0 * S>(vb), h00 = tr_read<D0 * 512 + KS0 * S + H>(vb), l01 = tr_read<D0 * 512 + (KS0 + 1) * S>(vb), h01 = tr_read<D0 * 512 + (KS0 + 1) * S + H>(vb);
    const s16x4 l10 = tr_read<(D0 + 1) * 512 + KS0 * S>(vb), h10 = tr_read<(D0 + 1) * 512 + KS0 * S + H>(vb), l11 = tr_read<(D0 + 1) * 512 + (KS0 + 1) * S>(vb), h11 = tr_read<(D0 + 1) * 512 + (KS0 + 1) * S + H>(vb);
    asm volatile("s_waitcnt lgkmcnt(0)" ::: "memory"); SBAR();
    o[D0] = __builtin_amdgcn_mfma_f32_32x32x16_bf16(pa0, PKV(l00, h00), o[D0], 0, 0, 0); o[D0 + 1] = __builtin_amdgcn_mfma_f32_32x32x16_bf16(pa0, PKV(l10, h10), o[D0 + 1], 0, 0, 0);
    o[D0] = __builtin_amdgcn_mfma_f32_32x32x16_bf16(pa1, PKV(l01, h01), o[D0], 0, 0, 0); o[D0 + 1] = __builtin_amdgcn_mfma_f32_32x32x16_bf16(pa1, PKV(l11, h11), o[D0 + 1], 0, 0, 0);
    if constexpr (D0 + 2 < NCB) PvPairs<NCB, KS0, D0 + 2>::run(o, vb, pa0, pa1); } };
__device__ __forceinline__ int swap23(int k) { return (k & ~0xC) | ((k & 4) << 1) | ((k & 8) >> 1); }
constexpr int FOX_STAGE = 33024;
constexpr int FOX_AL = 2 * FOX_STAGE, FOX_LI = FOX_AL + 1024;
__device__ void fox_item(const Params& p, LAS unsigned char* lds, int b, int h, int qb) {
    int tid = threadIdx.x; asm volatile("" : "+v"(tid));
    const int wid = __builtin_amdgcn_readfirstlane(tid >> 6), lane = tid & 63, r32 = lane & 31, hi = lane >> 5;
    const bf16_t* Q = (const bf16_t*)(p.ws + WS_QB);
    const char* Kg = (const char*)(p.ws + WS_KB) + ((size_t)b * SEQ * 1024 + h * 128) * 2; const char* Vg = (const char*)(p.ws + WS_VB) + ((size_t)b * SEQ * 1024 + h * 128) * 2;
    const float* cum = (const float*)(p.ws + WS_CUM) + (size_t)(b * 8 + h) * SEQ;
    const int qpos = qb * 256 + wid * 32 + r32;
    bf16x8 qr[8];
    { const bf16_t* qp = Q + (size_t)(b * SEQ + qpos) * 1024 + h * 128 + hi * 8;
#pragma unroll
      for (int d0 = 0; d0 < 8; ++d0) qr[d0] = *(const bf16x8*)(qp + d0 * 16); }
    const float cq = cum[qpos] * LOG2E;
    unsigned ksrc[2], vsrc[2];
#pragma unroll
    for (int i = 0; i < 2; ++i) { const int pos = (i * 512 + tid) * 16;
        { const int row = pos >> 8; const int cb = (pos & 255) ^ ((row & 7) << 4); ksrc[i] = (unsigned)(row * 2048 + cb); }
        { const int sub = pos >> 9, within = pos & 511; const int kk = (sub >> 2) * 8 + (within >> 6); const int c = (sub & 3) * 32 + ((within & 63) >> 1); vsrc[i] = (unsigned)(swap23(kk) * 2048 + c * 2); } }
    float m_reg = -1e30f, l_reg = 0.f; f32x16 o[4];
#pragma unroll
    for (int d = 0; d < 4; ++d)
#pragma unroll
        for (int r = 0; r < 16; ++r) o[d][r] = 0.f;
    LAS float* al_l = (LAS float*)(lds + FOX_AL) + wid * 32; LAS float* li_l = (LAS float*)(lds + FOX_LI) + wid * 32;
    const int ntiles = qb * 4 + 4, mylast = qb * 4 + (wid >> 1);
#define FOX_DMA(kt) do { LAS unsigned char* sb_ = lds + ((kt) & 1) * FOX_STAGE; const size_t go_ = (size_t)(kt) * 64 * 2048; \
        _Pragma("unroll") for (int i = 0; i < 2; ++i) { \
            __builtin_amdgcn_global_load_lds((const unsigned*)(Kg + go_ + ksrc[i]), (LAS unsigned*)(sb_ + 16384 + (i * 512 + wid * 64) * 16), 16, 0, 0); \
            __builtin_amdgcn_global_load_lds((const unsigned*)(Vg + go_ + vsrc[i]), (LAS unsigned*)(sb_ + (i * 512 + wid * 64) * 16), 16, 0, 0); } \
        if (wid == 0) __builtin_amdgcn_global_load_lds((const unsigned*)(cum + (kt) * 64 + lane), (LAS unsigned*)(sb_ + 32768), 4, 0, 0); } while (0)
    __syncthreads();
    FOX_DMA(0);
    for (int kt = 0; kt < ntiles; ++kt) {
        asm volatile("s_waitcnt vmcnt(0)" ::: "memory");
        __syncthreads();
        if (kt + 1 < ntiles) FOX_DMA(kt + 1);
        if (kt <= mylast) {
            const LAS unsigned char* sb = lds + (kt & 1) * FOX_STAGE; const LAS float* ck = (const LAS float*)(sb + 32768);
            const int vb = (int)(uintptr_t)sb + v_rd_base(lane);
            f32x16 p0, p1;
#pragma unroll
            for (int r = 0; r < 16; ++r) { p0[r] = 0.f; p1[r] = 0.f; }
            int fsw = (r32 & 7) << 4; asm volatile("" : "+v"(fsw));
#pragma unroll
            for (int d0 = 0; d0 < 8; ++d0) { const int cb = (d0 * 16 + hi * 8) * 2;
                const bf16x8 b0 = *(const LAS bf16x8*)(sb + 16384 + r32 * 256 + (cb ^ fsw));
                const bf16x8 b1 = *(const LAS bf16x8*)(sb + 16384 + (32 + r32) * 256 + (cb ^ fsw));
                p0 = __builtin_amdgcn_mfma_f32_32x32x16_bf16(b0, qr[d0], p0, 0, 0, 0); p1 = __builtin_amdgcn_mfma_f32_32x32x16_bf16(b1, qr[d0], p1, 0, 0, 0); }
            const bool diag = (kt * 64 + 63 > qb * 256 + wid * 32);
            float pmax = -INFINITY;
#pragma unroll
            for (int g4 = 0; g4 < 4; ++g4) { const f32x4 c0 = *(const LAS f32x4*)(ck + 8 * g4 + 4 * hi), c1 = *(const LAS f32x4*)(ck + 32 + 8 * g4 + 4 * hi);
#pragma unroll
                for (int j = 0; j < 4; ++j) { const int r = g4 * 4 + j; float t0 = fmaf(p0[r], LOG2E, cq) - c0[j] * LOG2E, t1 = fmaf(p1[r], LOG2E, cq) - c1[j] * LOG2E;
                    if (diag) { const int kp = kt * 64 + crow(r, hi); if (kp > qpos) t0 = -INFINITY; if (kp + 32 > qpos) t1 = -INFINITY; }
                    p0[r] = t0; p1[r] = t1; pmax = fmaxf(pmax, fmaxf(t0, t1)); } }
            { auto rr = __builtin_amdgcn_permlane32_swap(__float_as_uint(pmax), __float_as_uint(pmax), false, false); pmax = fmaxf(__uint_as_float(rr[0]), __uint_as_float(rr[1])); }
            const float mn = fmaxf(m_reg, pmax); const float alpha = __builtin_amdgcn_exp2f(m_reg - mn); m_reg = mn;
            float ps = 0.f;
#pragma unroll
            for (int r = 0; r < 16; ++r) { p0[r] = __builtin_amdgcn_exp2f(p0[r] - mn); p1[r] = __builtin_amdgcn_exp2f(p1[r] - mn); ps += p0[r] + p1[r]; }
            { auto rr = __builtin_amdgcn_permlane32_swap(__float_as_uint(ps), __float_as_uint(ps), false, false); ps = __uint_as_float(rr[0]) + __uint_as_float(rr[1]); }
            l_reg = l_reg * alpha + ps;
            if (__any(alpha < 1.f)) { if (hi == 0) al_l[r32] = alpha; asm volatile("s_waitcnt lgkmcnt(0)" ::: "memory");
#pragma unroll
                for (int r = 0; r < 16; ++r) { const float a = al_l[crow(r, hi)];
#pragma unroll
                    for (int d = 0; d < 4; ++d) o[d][r] *= a; } }
            bf16x8 pa0, pa1, pa2, pa3; PK4(p0, 0, pa0); PK4(p0, 8, pa1); PK4(p1, 0, pa2); PK4(p1, 8, pa3);
            PvPairs<4, 0, 0>::run(o, vb, pa0, pa1); PvPairs<4, 2, 0>::run(o, vb, pa2, pa3);
        }
    }
#undef FOX_DMA
    if (hi == 0) li_l[r32] = l_reg; asm volatile("s_waitcnt lgkmcnt(0)" ::: "memory");
    bf16_t* O = (bf16_t*)(p.ws + WS_OB) + (size_t)(b * SEQ + qb * 256 + wid * 32) * 1024 + h * 128;
#pragma unroll
    for (int r = 0; r < 16; ++r) { const float rl = __builtin_amdgcn_rcpf(li_l[crow(r, hi)]); const int orow = crow(r, hi);
#pragma unroll
        for (int d0 = 0; d0 < 4; ++d0) O[(size_t)orow * 1024 + d0 * 32 + r32] = (bf16_t)(cvt_pk_bf16(o[d0][r] * rl, 0.f) & 0xffffu); }
}

constexpr int DSA_STAGE = 32768;
constexpr int DSA_AL = 2 * DSA_STAGE, DSA_LI = DSA_AL + 1024, DSA_Q = DSA_LI + 1024;
__device__ void dsa_item(const Params& p, LAS unsigned char* lds, int b, int qt) {
    int tid = threadIdx.x; asm volatile("" : "+v"(tid));
    const int wid = __builtin_amdgcn_readfirstlane(tid >> 6), lane = tid & 63, r32 = lane & 31, hi = lane >> 5, h = wid;
    const char* KV = (const char*)(p.ws + WS_KV) + (size_t)b * SEQ * 512;
    const int qpos = qt * 32 + r32; const size_t qg = (size_t)b * SEQ + qpos;
    const unsigned* mask = (const unsigned*)(p.ws + WS_MASK) + qg * 64;
    bf16x8 qr[8];
    LAS unsigned char* qlds = lds + DSA_Q + wid * 8192 + lane * 16;
    __syncthreads();
    { const bf16_t* qp = (const bf16_t*)(p.ws + WS_QLAT) + qg * 2048 + h * 256 + hi * 8;
#pragma unroll
      for (int d0 = 0; d0 < 8; ++d0) qr[d0] = *(const bf16x8*)(qp + d0 * 16);
#pragma unroll
      for (int d0 = 8; d0 < 16; ++d0) *(LAS bf16x8*)(qlds + (d0 - 8) * 1024) = *(const bf16x8*)(qp + d0 * 16); }
    unsigned ksrc[2], vsrc[2];
#pragma unroll
    for (int i = 0; i < 2; ++i) { const int pos = (i * 512 + tid) * 16;
        { const int row = pos >> 9; const int cb = (pos & 511) ^ ((row & 15) << 4); ksrc[i] = (unsigned)(row * 512 + cb); }
        { const int sub = pos >> 9, within = pos & 511; const int kk = (sub >> 3) * 8 + (within >> 6); const int c = (sub & 7) * 32 + ((within & 63) >> 1); vsrc[i] = (unsigned)(swap23(kk) * 512 + c * 2); } }
    const float slopeL = exp2f(-(float)(h + 1)) * LOG2E;
    float m_reg = -1e30f, l_reg = 0.f; f32x16 o[8];
#pragma unroll
    for (int d = 0; d < 8; ++d)
#pragma unroll
        for (int r = 0; r < 16; ++r) o[d][r] = 0.f;
    LAS float* al_l = (LAS float*)(lds + DSA_AL) + wid * 32; LAS float* li_l = (LAS float*)(lds + DSA_LI) + wid * 32;
    const int ntiles = ((qt >> 1) + 1) * 2;
#define DSA_DMA(kt) do { LAS unsigned char* sb_ = lds + ((kt) & 1) * DSA_STAGE; const size_t go_ = (size_t)(kt) * 32 * 512; \
        _Pragma("unroll") for (int i = 0; i < 2; ++i) { \
            __builtin_amdgcn_global_load_lds((const unsigned*)(KV + go_ + ksrc[i]), (LAS unsigned*)(sb_ + 16384 + (i * 512 + wid * 64) * 16), 16, 0, 0); \
            __builtin_amdgcn_global_load_lds((const unsigned*)(KV + go_ + vsrc[i]), (LAS unsigned*)(sb_ + (i * 512 + wid * 64) * 16), 16, 0, 0); } } while (0)
    unsigned mw = mask[0];
    DSA_DMA(0);
    for (int kt = 0; kt < ntiles; ++kt) {
        asm volatile("s_waitcnt vmcnt(0)" ::: "memory");
        __syncthreads();
        const unsigned mcur = mw;
        if (kt + 1 < ntiles) { mw = mask[kt + 1]; DSA_DMA(kt + 1); }
        const LAS unsigned char* sb = lds + (kt & 1) * DSA_STAGE; const int vb = (int)(uintptr_t)sb + v_rd_base(lane);
        f32x16 pp;
#pragma unroll
        for (int r = 0; r < 16; ++r) pp[r] = 0.f;
        {
            const LAS unsigned char* kb_ = sb + 16384 + r32 * 512; int sw_ = (r32 & 15) << 4; asm volatile("" : "+v"(sw_));
#define DSA_KF(d0) (*(const LAS bf16x8*)(kb_ + ((((d0) * 16 + hi * 8) * 2) ^ sw_)))
#define DSA_QF(d0) ((d0) < 8 ? qr[(d0) & 7] : *(const LAS bf16x8*)(qlds + (((d0) - 8) & 7) * 1024))
            bf16x8 k0 = DSA_KF(0), k1 = DSA_KF(1), q0 = DSA_QF(0), q1 = DSA_QF(1);
#pragma unroll
            for (int d0 = 0; d0 < 16; d0 += 2) {
                bf16x8 nk0 = k0, nk1 = k1, nq0 = q0, nq1 = q1;
                if (d0 + 2 < 16) { nk0 = DSA_KF(d0 + 2); nk1 = DSA_KF(d0 + 3); nq0 = DSA_QF(d0 + 2); nq1 = DSA_QF(d0 + 3); }
                pp = __builtin_amdgcn_mfma_f32_32x32x16_bf16(k0, q0, pp, 0, 0, 0); pp = __builtin_amdgcn_mfma_f32_32x32x16_bf16(k1, q1, pp, 0, 0, 0);
                k0 = nk0; k1 = nk1; q0 = nq0; q1 = nq1; SBAR();
            }
#undef DSA_KF
#undef DSA_QF
        }
        const unsigned wsh = mcur >> (4 * hi);
        const float df = (float)(qpos - (kt * 32 + 4 * hi));
        float pmax = -INFINITY;
#pragma unroll
        for (int r = 0; r < 16; ++r) { const int cb = (r & 3) + 8 * (r >> 2); const float dd = df - (float)cb;
            float t = fmaf(-slopeL, fabsf(dd), pp[r] * LOG2E); if (!((wsh >> cb) & 1u)) t = -INFINITY; pp[r] = t; pmax = fmaxf(pmax, t); }
        { auto rr = __builtin_amdgcn_permlane32_swap(__float_as_uint(pmax), __float_as_uint(pmax), false, false); pmax = fmaxf(__uint_as_float(rr[0]), __uint_as_float(rr[1])); }
        const float mn = fmaxf(m_reg, pmax); const float alpha = __builtin_amdgcn_exp2f(m_reg - mn); m_reg = mn;
        float ps = 0.f;
#pragma unroll
        for (int r = 0; r < 16; ++r) { pp[r] = __builtin_amdgcn_exp2f(pp[r] - mn); ps += pp[r]; }
        { auto rr = __builtin_amdgcn_permlane32_swap(__float_as_uint(ps), __float_as_uint(ps), false, false); ps = __uint_as_float(rr[0]) + __uint_as_float(rr[1]); }
        l_reg = l_reg * alpha + ps;
        if (__any(alpha < 1.f)) { if (hi == 0) al_l[r32] = alpha; asm volatile("s_waitcnt lgkmcnt(0)" ::: "memory");
#pragma unroll
            for (int r = 0; r < 16; ++r) { const float a = al_l[crow(r, hi)];
#pragma unroll
                for (int d = 0; d < 8; ++d) o[d][r] *= a; } }
        bf16x8 pa0, pa1; PK4(pp, 0, pa0); PK4(pp, 8, pa1);
        PvPairs<8, 0, 0>::run(o, vb, pa0, pa1);
    }
#undef DSA_DMA
    if (hi == 0) li_l[r32] = l_reg; asm volatile("s_waitcnt lgkmcnt(0)" ::: "memory");
    float rl[16];
#pragma unroll
    for (int r = 0; r < 16; ++r) rl[r] = __builtin_amdgcn_rcpf(li_l[crow(r, hi)]);
    __syncthreads();
    LAS bf16_t* os = (LAS bf16_t*)(lds + wid * 16896);
#pragma unroll
    for (int r = 0; r < 16; ++r)
#pragma unroll
        for (int d0 = 0; d0 < 8; ++d0) os[crow(r, hi) * 264 + d0 * 32 + r32] = (bf16_t)(cvt_pk_bf16(o[d0][r] * rl[r], 0.f) & 0xffffu);
    asm volatile("s_waitcnt lgkmcnt(0)" ::: "memory");
    f32x16 ya[4];
#pragma unroll
    for (int nb = 0; nb < 4; ++nb)
#pragma unroll
        for (int r = 0; r < 16; ++r) ya[nb][r] = 0.f;
    const bf16_t* wv = (const bf16_t*)(p.ws + WS_WUV) + (size_t)(h * 128 + r32) * 256 + hi * 8;
#pragma unroll 4
    for (int ks = 0; ks < 16; ++ks) {
        const bf16x8 af = *(const LAS bf16x8*)(os + r32 * 264 + ks * 16 + hi * 8);
#pragma unroll
        for (int nb = 0; nb < 4; ++nb) { const bf16x8 wf = *(const bf16x8*)(wv + (size_t)nb * 32 * 256 + ks * 16); ya[nb] = __builtin_amdgcn_mfma_f32_32x32x16_bf16(wf, af, ya[nb], 0, 0, 0); }
    }
    bf16_t* O = (bf16_t*)(p.ws + WS_OA) + ((size_t)b * SEQ + qt * 32 + r32) * 1024 + h * 128 + 4 * hi;
#pragma unroll
    for (int nb = 0; nb < 4; ++nb)
#pragma unroll
        for (int g4 = 0; g4 < 4; ++g4) { u32x2 pk; pk.x = cvt_pk_bf16(ya[nb][g4 * 4], ya[nb][g4 * 4 + 1]); pk.y = cvt_pk_bf16(ya[nb][g4 * 4 + 2], ya[nb][g4 * 4 + 3]); *(u32x2*)(O + nb * 32 + g4 * 8) = pk; }
}
__device__ void ph4_attn(const Params& p, LAS unsigned char* lds) {
    const int r = blockIdx.x;
    if (r < 256) { const int c = 31 - (r >> 3), w8 = r & 7, b = w8 >> 1, half = w8 & 1; dsa_item(p, lds, b, c * 2 + half); }
    int* qhead = (int*)(p.ws + WS_CNT) + 512;
    LAS int* slot = (LAS int*)(lds + LDS_BARW - 16);
    for (;;) {
        __syncthreads();
        if (threadIdx.x == 0) *slot = atomicAdd(qhead, 1);
        __syncthreads();
        const int it = __builtin_amdgcn_readfirstlane(*slot);
        if (it >= 256) break;
        const int qb = 7 - (it >> 5), bh = it & 31;
        fox_item(p, lds, bh >> 3, bh & 7, qb);
    }
}

__device__ void ph5_oa(const Params& p) {
    const int lane = threadIdx.x & 63, gw = blockIdx.x * 8 + (threadIdx.x >> 6), nw = gridDim.x * 8, fr = lane & 15, fq = lane >> 4;
    for (int it = gw; it < 2048; it += nw) {
        const int rt = it >> 3, h = it & 7;
        f32x4 acc[2][8];
        wave_gemm<2, 8, 8>((const bf16_t*)(p.ws + WS_OLAT) + (size_t)rt * 32 * 2048 + h * 256, 2048, (const bf16_t*)(p.ws + WS_WUV) + (size_t)h * 128 * 256, 256, acc, lane);
#pragma unroll
        for (int mb = 0; mb < 2; ++mb) { bf16_t* o = (bf16_t*)(p.ws + WS_OA) + (size_t)(rt * 32 + mb * 16 + fr) * 1024 + h * 128;
#pragma unroll
            for (int nb = 0; nb < 8; ++nb) { u32x2 w; w.x = cvt_pk_bf16(acc[mb][nb][0], acc[mb][nb][1]); w.y = cvt_pk_bf16(acc[mb][nb][2], acc[mb][nb][3]); *(u32x2*)(o + nb * 16 + fq * 4) = w; } }
    }
}

__device__ void ph8_router(const Params& p, LAS unsigned char* lds, const int rep) {
    const int tid = threadIdx.x, wid = tid >> 6, lane = tid & 63, fr = lane & 15, fq = lane >> 4;
    const float* mod = (const float*)(p.ws + WS_MOD);
    bf16_t* H = (bf16_t*)(p.ws + WS_H); bf16_t* HL = (bf16_t*)(p.ws + WS_HLO);
    int* cnt = (int*)(p.ws + WS_CNT) + rep * 256; int* ltok = rep ? (int*)(p.ws + WS_T1) : (int*)(p.ws + WS_LTOK); float* lw = rep ? (float*)(p.ws + WS_T1 + (4u << 20)) : (float*)(p.ws + WS_LW);
    LAS float* slab = (LAS float*)lds + wid * 2560;
    LAS float* lg = (LAS float*)lds + 8 * 2560;
    for (int blk = blockIdx.x; blk < NTOK / 32; blk += gridDim.x) {
        const int t0 = blk * 32;
        {
            const int tb = t0 + wid * 4, b = tb >> 11;
            const float* sh = mod + b * 12288 + 6144; const float* sc = mod + b * 12288 + 8192;
            f32x4 xv[4][8];
#pragma unroll
            for (int rr = 0; rr < 4; ++rr)
#pragma unroll
                for (int i = 0; i < 8; ++i) xv[rr][i] = *(const f32x4*)(p.out + (size_t)(tb + rr) * DM + i * 256 + lane * 4);
#pragma unroll
            for (int rr = 0; rr < 4; ++rr) {
                float ss = 0.f;
#pragma unroll
                for (int i = 0; i < 8; ++i) ss += xv[rr][i][0] * xv[rr][i][0] + xv[rr][i][1] * xv[rr][i][1] + xv[rr][i][2] * xv[rr][i][2] + xv[rr][i][3] * xv[rr][i][3];
                ss = wave_sum(ss);
                const float rstd = rsqrtf(ss * (1.0f / 2048.0f) + RMS_EPS);
#pragma unroll
                for (int i = 0; i < 8; ++i) { const int col = i * 256 + lane * 4; const f32x4 gg = *(const f32x4*)(p.in[I_GFFN] + col), s1 = *(const f32x4*)(sc + col), s0 = *(const f32x4*)(sh + col);
                    float hv[4], lo[4];
#pragma unroll
                    for (int j = 0; j < 4; ++j) hv[j] = xv[rr][i][j] * rstd * gg[j] * (1.0f + s1[j]) + s0[j];
                    u32x2 wh; wh.x = cvt_pk_bf16(hv[0], hv[1]); wh.y = cvt_pk_bf16(hv[2], hv[3]);
                    lo[0] = hv[0] - bf_lo(wh.x); lo[1] = hv[1] - bf_hi(wh.x); lo[2] = hv[2] - bf_lo(wh.y); lo[3] = hv[3] - bf_hi(wh.y);
                    u32x2 wl; wl.x = cvt_pk_bf16(lo[0], lo[1]); wl.y = cvt_pk_bf16(lo[2], lo[3]);
                    *(u32x2*)(H + (size_t)(tb + rr) * DM + col) = wh; *(u32x2*)(HL + (size_t)(tb + rr) * DM + col) = wl;
                    *(unsigned*)(p.ws + WS_H8 + (size_t)(tb + rr) * DM + col) = pack_fp8x4(hv[0], hv[1], hv[2], hv[3]); }
            }
        }
        asm volatile("s_waitcnt vmcnt(0)" ::: "memory");
        __syncthreads();
        {
            const bf16_t* Ah = H + (size_t)(t0 + fr) * DM + wid * 256 + fq * 8; const bf16_t* Al = HL + (size_t)(t0 + fr) * DM + wid * 256 + fq * 8;
            const bf16_t* Wh = (const bf16_t*)(p.ws + WS_WRH) + (size_t)fr * DM + wid * 256 + fq * 8; const bf16_t* Wl = (const bf16_t*)(p.ws + WS_WRL) + (size_t)fr * DM + wid * 256 + fq * 8;
            f32x4 acc[2][5];
#pragma unroll
            for (int mb = 0; mb < 2; ++mb)
#pragma unroll
                for (int nb = 0; nb < 5; ++nb) acc[mb][nb] = (f32x4){0.f, 0.f, 0.f, 0.f};
#pragma unroll 4
            for (int ks = 0; ks < 8; ++ks) {
                bf16x8 ah[2], al[2];
#pragma unroll
                for (int mb = 0; mb < 2; ++mb) { ah[mb] = *(const bf16x8*)(Ah + (size_t)mb * 16 * DM + ks * 32); al[mb] = *(const bf16x8*)(Al + (size_t)mb * 16 * DM + ks * 32); }
#pragma unroll
                for (int nb = 0; nb < 5; ++nb) { const bf16x8 wh = *(const bf16x8*)(Wh + (size_t)nb * 16 * DM + ks * 32), wl = *(const bf16x8*)(Wl + (size_t)nb * 16 * DM + ks * 32);
#pragma unroll
                    for (int mb = 0; mb < 2; ++mb) {
                        acc[mb][nb] = __builtin_amdgcn_mfma_f32_16x16x32_bf16(wh, ah[mb], acc[mb][nb], 0, 0, 0);
                        acc[mb][nb] = __builtin_amdgcn_mfma_f32_16x16x32_bf16(wl, ah[mb], acc[mb][nb], 0, 0, 0);
                        acc[mb][nb] = __builtin_amdgcn_mfma_f32_16x16x32_bf16(wh, al[mb], acc[mb][nb], 0, 0, 0); } }
            }
#pragma unroll
            for (int mb = 0; mb < 2; ++mb)
#pragma unroll
                for (int nb = 0; nb < 5; ++nb) *(LAS f32x4*)(slab + (mb * 16 + fr) * 80 + nb * 16 + fq * 4) = acc[mb][nb];
        }
        __syncthreads();
        for (int o = tid; o < 2560; o += NTHREADS) { float s = 0.f;
#pragma unroll
            for (int w8 = 0; w8 < 8; ++w8) s += ((LAS float*)lds)[w8 * 2560 + o];
            lg[o] = s; }
        __syncthreads();
        if (tid < 32) {
            const int t = t0 + tid; const LAS float* L = lg + tid * 80;
            float gl[8]; int gi = 0; float gm = -INFINITY;
#pragma unroll
            for (int g = 0; g < 8; ++g) { gl[g] = L[g] + p.in[I_BRG][g]; if (gl[g] > gm) { gm = gl[g]; gi = g; } }
            float se = 0.f;
#pragma unroll
            for (int g = 0; g < 8; ++g) se += __expf(gl[g] - gm);
            const float gwt = 1.0f / se;
            float v1 = -INFINITY, v2 = -INFINITY; int i1 = 0, i2 = 0;
            for (int e = 0; e < 8; ++e) { const float v = L[8 + gi * 8 + e] + p.in[I_BRE][gi * 8 + e];
                if (v > v1) { v2 = v1; i2 = i1; v1 = v; i1 = e; } else if (v > v2) { v2 = v; i2 = e; } }
            const float e2 = __expf(v2 - v1); const float p1 = gwt / (1.0f + e2), p2 = gwt * e2 / (1.0f + e2);
            const int ea = gi * 8 + i1, eb = gi * 8 + i2;
            const int pa = atomicAdd(cnt + ea, 1); const int pb = atomicAdd(cnt + eb, 1);
            ltok[ea * LCAP + pa] = t; lw[ea * LCAP + pa] = p1;
            ltok[eb * LCAP + pb] = t | 0x10000; lw[eb * LCAP + pb] = p2;
        }
        __syncthreads();
    }
}

__device__ __forceinline__ void moe_table(const Params& p, LAS unsigned char* lds) {
    LAS int* pre = (LAS int*)(lds + LDS_TAB);
    if (threadIdx.x == 0) { const int* cnt = (const int*)(p.ws + WS_CNT); int s = 0; for (int e = 0; e < 64; ++e) { const int ce = cnt[e]; pre[e] = s; pre[80 + e] = ce; s += (ce + 255) >> 8; } pre[64] = s; }
    __syncthreads();
}
__device__ void ph9_gather(const Params& p, LAS unsigned char* lds) {
    moe_table(p, lds);
    const LAS int* pre = (const LAS int*)(lds + LDS_TAB); const LAS int* cnt = pre + 80; const int* ltok = (const int*)(p.ws + WS_LTOK);
    const int lane = threadIdx.x & 63, gw = blockIdx.x * 8 + (threadIdx.x >> 6), nw = gridDim.x * 8, nrows = pre[64] * 256;
    const bf16_t* H = (const bf16_t*)(p.ws + WS_H); bf16_t* HG = (bf16_t*)(p.ws + WS_HG);
    for (int r = gw; r < nrows; r += nw) {
        const int mt = r >> 8; int e = 0;
#pragma unroll 1
        for (int s = 32; s >= 1; s >>= 1) if (pre[e + s] <= mt) e += s;
        const int pos = (mt - pre[e]) * 256 + (r & 255);
        u32x4 v[4];
        if (pos < cnt[e]) { const int tok = ltok[e * LCAP + pos];
#pragma unroll
            for (int i = 0; i < 4; ++i) v[i] = *(const u32x4*)(H + (size_t)tok * DM + i * 512 + lane * 8); }
        else {
#pragma unroll
            for (int i = 0; i < 4; ++i) v[i] = (u32x4){0u, 0u, 0u, 0u}; }
#pragma unroll
        for (int i = 0; i < 4; ++i) *(u32x4*)(HG + (size_t)r * DM + i * 512 + lane * 8) = v[i];
    }
}


#define MOE_GLOAD(dst, ptr) asm volatile("global_load_dwordx4 %0, %1, off nt" : "=v"(dst) : "v"(ptr) : "memory")
template <bool UP>
__device__ void moe_gemm(const Params& p, LAS unsigned char* lds, const int rep) {
    constexpr int K = UP ? 2048 : 512, NKT = K / 32, NS = UP ? 8 : 16, LDW = UP ? 512 : 2048;
    constexpr int NSTA = 3, OFF_A = 0, OFF_B = NSTA * 16384;
    int tid = threadIdx.x; asm volatile("" : "+v"(tid));
    const int w = __builtin_amdgcn_readfirstlane(tid >> 6), l = tid & 63, r32 = l & 31, hi = l >> 5;
    LAS int* tab = (LAS int*)(lds + LDS_TAB);
    if (tid == 0) { const int* cnt = (const int*)(p.ws + WS_CNT); int s = 0, ro = 0; for (int e = 0; e < 64; ++e) { const int ce = cnt[e]; tab[e] = s; tab[80 + e] = ce; tab[160 + e] = ro; ro += ce; const int np = (ce + 511) >> 9; s += np > 0 ? np : 1; } tab[64] = s; }
    __syncthreads();
    const int total = __builtin_amdgcn_readfirstlane(tab[64]) * NS;
    const int q = (w & 3) * 8 + (l & 7), g = (w >> 2) * 8 + (l >> 3);
    const unsigned bwoff = (unsigned)(q * 256 + (((g >> 2) ^ (q & 3)) * 16) + (g & 3) * 4);
    const unsigned frag_sw = (unsigned)((r32 >> 2) & 3);
    const int* ltok = (const int*)(p.ws + WS_LTOK); const float* lw = (const float*)(p.ws + WS_LW);
    for (int unit = blockIdx.x; unit < total; unit += gridDim.x) {
        const int pm = unit / NS, ns = unit - pm * NS; int e = 0;
#pragma unroll 1
        for (int s = 32; s >= 1; s >>= 1) if (__builtin_amdgcn_readfirstlane(tab[e + s]) <= pm) e += s;
        const int mp = pm - __builtin_amdgcn_readfirstlane(tab[e]); const int cnt_e = __builtin_amdgcn_readfirstlane(tab[80 + e]), rowoff = __builtin_amdgcn_readfirstlane(tab[160 + e]);
        int nrows = cnt_e - mp * 512; nrows = nrows > 512 ? 512 : nrows; const bool two = nrows > 256;
        const char* abase = UP ? (const char*)(p.ws + WS_H8) : (const char*)(p.ws + WS_ACT8);
        unsigned aoff[2];
#pragma unroll
        for (int i = 0; i < 2; ++i) { const int row = (i * 8 + w) * 32 + (l >> 1); const int hs = (l & 1) ^ ((l >> 4) & 1);
            int src; if (UP) src = row < nrows ? (ltok[e * LCAP + mp * 512 + row] & 0xffff) : 0; else src = rowoff + mp * 512 + (row < nrows ? row : 0);
            aoff[i] = (unsigned)(src * K + hs * 16); }
        const float* bsrc = UP ? (q < 16 ? p.in[I_W1] : p.in[I_W3]) + (size_t)e * 2048 * 512 + ns * 64 + (q & 15) * 4 + (size_t)(2 * g) * LDW
                               : p.in[I_W2] + (size_t)e * 512 * 2048 + ns * 128 + q * 4 + (size_t)(2 * g) * LDW;
        f32x16 acc[2][4];
#pragma unroll
        for (int a = 0; a < 2; ++a)
#pragma unroll
            for (int b = 0; b < 4; ++b)
#pragma unroll
                for (int r = 0; r < 16; ++r) acc[a][b][r] = 0.f;
        f32x4 br[2][2];
#define MOE_ISSUE_B(j, t) do { const int tt_ = (t) < NKT ? (t) : NKT - 1; const float* bp_ = bsrc + (size_t)tt_ * 32 * LDW; MOE_GLOAD(br[j][0], bp_); MOE_GLOAD(br[j][1], bp_ + LDW); } while (0)
#define MOE_ISSUE_A(t, TWO) do { int tt_ = (t) < 0 ? 0 : (t); const int bi_ = (tt_ % NSTA); tt_ = tt_ < NKT ? tt_ : NKT - 1; const char* ap_ = abase + (size_t)tt_ * 32; \
        LAS unsigned char* ab_ = lds + OFF_A + bi_ * 16384 + w * 1024; \
        __builtin_amdgcn_global_load_lds((const unsigned*)(ap_ + aoff[0]), (LAS unsigned*)(ab_), 16, 0, 0); \
        if (TWO) __builtin_amdgcn_global_load_lds((const unsigned*)(ap_ + aoff[1]), (LAS unsigned*)(ab_ + 8192), 16, 0, 0); } while (0)
        const bool two_w = (256 + 32 * w) < nrows;
#define MOE_FRAGS(ks, TWO) do { const unsigned co_ = ((unsigned)((ks) * 2 + hi) ^ frag_sw) * 16u; \
            _Pragma("unroll") for (int nb = 0; nb < 4; ++nb) bf_[nb] = *(const LAS bf16x8*)(bb_ + nb * 2048 + co_); \
            { const unsigned ao_ = ((unsigned)(ks) ^ ((unsigned)(r32 >> 3) & 1u)) * 16u + (unsigned)hi * 8u; a0_ = fp8x8_to_bf16(*(const LAS u32x2*)(ab_ + ao_)); if (TWO) a1_ = fp8x8_to_bf16(*(const LAS u32x2*)(ab_ + 8192 + ao_)); } } while (0)
#define MOE_MMAS(TWO) do { \
            _Pragma("unroll") for (int nb = 0; nb < 4; ++nb) acc[0][nb] = __builtin_amdgcn_mfma_f32_32x32x16_bf16(bf_[nb], a0_, acc[0][nb], 0, 0, 0); \
            if (TWO) { _Pragma("unroll") for (int nb = 0; nb < 4; ++nb) acc[1][nb] = __builtin_amdgcn_mfma_f32_32x32x16_bf16(bf_[nb], a1_, acc[1][nb], 0, 0, 0); } } while (0)
#define MOE_ITER(jn, t, COMPUTE, TWO, WB, WA) do { \
        bf16x8 bf_[4], a0_, a1_; \
        const LAS unsigned char* ab_ = lds + OFF_A + (((t) + 3) % 3) * 16384 + w * 1024 + r32 * 32; const LAS unsigned char* bb_ = lds + OFF_B + ((t) & 1) * 8192 + r32 * 64; \
        if (COMPUTE) { MOE_FRAGS(0, TWO); } SBAR(); \
        asm volatile("s_waitcnt vmcnt(" WB ")" : "+v"(br[jn][0]), "+v"(br[jn][1]) :: "memory"); \
        { LAS unsigned char* bw_ = lds + OFF_B + (((t) + 1) & 1) * 8192 + bwoff; _Pragma("unroll") for (int jj = 0; jj < 4; ++jj) *(LAS unsigned*)(bw_ + jj * 64) = cvt_pk_bf16(br[jn][0][jj], br[jn][1][jj]); } \
        MOE_ISSUE_B(jn, (t) + 3); SBAR(); \
        if (COMPUTE) { MOE_MMAS(TWO); SBAR(); MOE_FRAGS(1, TWO); MOE_MMAS(TWO); } SBAR(); \
        asm volatile("s_waitcnt vmcnt(" WA ")" ::: "memory"); \
        asm volatile("s_waitcnt lgkmcnt(0)" ::: "memory"); __builtin_amdgcn_s_barrier(); asm volatile("" ::: "memory"); \
        MOE_ISSUE_A((t) + 3, TWO); \
        } while (0)
#define MOE_PIPE(TWO, WB, WA) do { \
        MOE_ISSUE_B(0, 0); MOE_ISSUE_A(0, TWO); MOE_ISSUE_B(1, 1); MOE_ISSUE_A(1, TWO); \
        MOE_ITER(0, -1, false, TWO, WB, WA); \
        _Pragma("unroll 1") for (int t = 0; t < NKT; t += 2) { MOE_ITER(1, t, true, TWO, WB, WA); MOE_ITER(0, t + 1, true, TWO, WB, WA); } \
          \
        asm volatile("s_waitcnt vmcnt(0)" : "+v"(br[0][0]), "+v"(br[0][1]), "+v"(br[1][0]), "+v"(br[1][1]) :: "memory"); \
        } while (0)
        if (two_w) MOE_PIPE(true, "6", "6"); else MOE_PIPE(false, "4", "5");
        asm volatile("s_waitcnt vmcnt(0)" ::: "memory");
        if constexpr (UP) {
#pragma unroll
            for (int mt = 0; mt < 2; ++mt) {
                const int rl = mt * 256 + 32 * w + r32;
                if (rl < nrows) {
                    const float gw = lw[e * LCAP + mp * 512 + rl] * 16.0f; unsigned char* orow = (unsigned char*)(p.ws + (rep ? WS_QLAT : WS_ACT8)) + (size_t)(rowoff + mp * 512 + rl) * 512 + ns * 64 + 4 * hi;
#pragma unroll
                    for (int nb = 0; nb < 2; ++nb)
#pragma unroll
                        for (int g4 = 0; g4 < 4; ++g4) { float o[4];
#pragma unroll
                            for (int j = 0; j < 4; ++j) { const float a = acc[mt][nb][g4 * 4 + j], u = acc[mt][nb + 2][g4 * 4 + j]; o[j] = a * sigmoidf_(a) * u * gw; }
                            *(unsigned*)(orow + nb * 32 + g4 * 8) = pack_fp8x4(o[0], o[1], o[2], o[3]); }
                }
            }
        } else {
#pragma unroll
            for (int mt = 0; mt < 2; ++mt) {
                const int rl = mt * 256 + 32 * w + r32;
                if (rl < nrows) {
                    const int ent = ltok[e * LCAP + mp * 512 + rl]; bf16_t* orow = (bf16_t*)(p.ws + WS_YS) + ((size_t)(ent >> 16) * NTOK + (ent & 0xffff)) * 2048 + ns * 128 + 4 * hi;
#pragma unroll
                    for (int nb = 0; nb < 4; ++nb)
#pragma unroll
                        for (int g4 = 0; g4 < 4; ++g4) { u32x2 pk; pk.x = cvt_pk_bf16(acc[mt][nb][g4 * 4] * 0.0625f, acc[mt][nb][g4 * 4 + 1] * 0.0625f); pk.y = cvt_pk_bf16(acc[mt][nb][g4 * 4 + 2] * 0.0625f, acc[mt][nb][g4 * 4 + 3] * 0.0625f); *(u32x2*)(orow + nb * 32 + g4 * 8) = pk; }
                }
            }
        }
        asm volatile("s_waitcnt vmcnt(0)" ::: "memory");
        __syncthreads();
    }
#undef MOE_ISSUE_A
#undef MOE_ISSUE_B
#undef MOE_ITER
#undef MOE_FRAGS
#undef MOE_MMAS
#undef MOE_PIPE
}


__device__ void ph11_combine(const Params& p) {
    const bf16_t* Y0 = (const bf16_t*)(p.ws + WS_YS); const bf16_t* Y1 = Y0 + (size_t)NTOK * 2048; const float* mod = (const float*)(p.ws + WS_MOD);
    const size_t n8 = (size_t)NTOK * 2048 / 8;
    for (size_t i = (size_t)blockIdx.x * NTHREADS + threadIdx.x; i < n8; i += (size_t)gridDim.x * NTHREADS) {
        const size_t e0 = i * 8; const int col = (int)(e0 & 2047), b = (int)(e0 >> 22);
        const u32x4 a = *(const u32x4*)(Y0 + e0), c = *(const u32x4*)(Y1 + e0);
        const float* gt = mod + (size_t)b * 12288 + 10240 + col; const f32x4 g0 = *(const f32x4*)gt, g1 = *(const f32x4*)(gt + 4);
        float* po = p.out + e0; f32x4 o0 = *(const f32x4*)po, o1 = *(const f32x4*)(po + 4);
        o0[0] += g0[0] * (bf_lo(a.x) + bf_lo(c.x)); o0[1] += g0[1] * (bf_hi(a.x) + bf_hi(c.x)); o0[2] += g0[2] * (bf_lo(a.y) + bf_lo(c.y)); o0[3] += g0[3] * (bf_hi(a.y) + bf_hi(c.y));
        o1[0] += g1[0] * (bf_lo(a.z) + bf_lo(c.z)); o1[1] += g1[1] * (bf_hi(a.z) + bf_hi(c.z)); o1[2] += g1[2] * (bf_lo(a.w) + bf_lo(c.w)); o1[3] += g1[3] * (bf_hi(a.w) + bf_hi(c.w));
        *(f32x4*)po = o0; *(f32x4*)(po + 4) = o1;
    }
}

__global__ void __launch_bounds__(NTHREADS, 2) mk_fwd(Params p) {
    extern __shared__ __attribute__((aligned(16))) unsigned char shm[];
    LAS unsigned char* lds = (LAS unsigned char*)shm;
    const int lo = p.ph_lo, hi = p.ph_hi;
    if (threadIdx.x < 4) ((LAS unsigned*)(lds + LDS_BARW))[threadIdx.x] = 0u;
    __syncthreads();
    XcdBarrier bar; bar.bar = (unsigned*)(p.ws + WS_BAR); bar.x = 0; bar.st = nullptr;
    if (hi - lo > 1) bar = xcd_barrier_post((unsigned*)(p.ws + WS_BAR), (volatile LAS unsigned*)(lds + LDS_BARW));
#ifndef SKIP_MASK
#define SKIP_MASK 0
#endif
#define IN(k) (!((SKIP_MASK >> (k)) & 1) && lo <= (k) && (k) < hi)
#define SEAM(k) do { if (IN(k) && IN((k) + 1)) xcd_barrier(bar); } while (0)
    const int G = gridDim.x, bx = blockIdx.x;
#ifndef REP_PHASE
#define REP_PHASE 0
#endif
#define RUN(k, ...) do { if (IN(k)) { { const int rep = 0; (void)rep; __VA_ARGS__ } if ((REP_PHASE >> (k)) & 1) { xcd_barrier(bar); { const int rep = 1; (void)rep; __VA_ARGS__ } } } SEAM(k); } while (0)
    RUN(0, ph0_prologue(p, lds););
    RUN(1, ph1_norm(p););
    RUN(2, EpiProj E{p.ws, p.in[I_BGATE]};
           { ProjOrder S; S.S.init(p.ws + WS_H, p.ws + WS_WIN, NTOK, 18 * 256, DM * 2, G, bx); S.fp8 = 0; S.Bfull = nullptr;
             pg8::gemm_phase<EpiProj, ProjOrder, false, false>(lds, DM * 2, S, E); }
           { ProjOrder S; S.S.init(p.ws + WS_HF8, p.ws + WS_WIN8, NTOK, 20 * 256, DM, G, (G - 1) - bx); S.fp8 = 1; S.Bfull = nullptr;
             pg8::gemm_phase<EpiProj, ProjOrder, false, true>(lds, DM, S, E, 0x79797979); });
    RUN(3, ph3_prep(p, lds, rep););
    RUN(4, ph4_attn(p, lds););
    RUN(5, DualOrder S; S.S0.init(p.ws + WS_OA, p.ws + WS_WPA, NTOK, DM, 2048, G, bx); S.S1.init(p.ws + WS_OB, p.ws + WS_WPB, NTOK, DM, 2048, G, bx);
           EpiGate12 E{EpiGate1{(const bf16_t*)(p.ws + WS_GATES), (float*)(p.ws + WS_T1)}, EpiGate2{(const bf16_t*)(p.ws + WS_GATES), (const float*)(p.ws + WS_T1), (bf16_t*)(p.ws + WS_MERGED)}};
           pg8::gemm_phase<EpiGate12, DualOrder, false>(lds, 2048, S, E););
    RUN(6, pg8::StaticOrder S; S.init(p.ws + WS_MERGED, p.ws + WS_WO, NTOK, DM, DM * 2, G, bx); EpiWo E{p.in[I_X], (const float*)(p.ws + WS_MOD), p.out};
           pg8::gemm_phase<EpiWo, pg8::StaticOrder, false>(lds, DM * 2, S, E););
    RUN(7, ph8_router(p, lds, rep););
    RUN(8, moe_gemm<true>(p, lds, rep););
    RUN(9, moe_gemm<false>(p, lds, rep););
    RUN(10, if (!rep) ph11_combine(p););
#undef RUN
#undef IN
#undef SEAM
}

constexpr int NPHASES = 11;
extern "C" void kernel_launch(void* const* d_in, const int* in_sizes, int n_in, void* d_out, int out_size, void* d_ws, size_t ws_size, hipStream_t stream) {
    static int grid = 0;
    if (grid == 0) {
        if (n_in != 25 || in_sizes[0] != NTOK * DM || out_size != NTOK * DM || ws_size < WS_END4) {
            fprintf(stderr, "kernel_launch: shape mismatch: n_in %d in0 %d out %d ws %zu (need %zu)\n", n_in, n_in > 0 ? in_sizes[0] : -1, out_size, ws_size, (size_t)WS_END4); grid = -1; return; }
        int dev = 0, cus = 0, per_cu = 0;
        if (hipGetDevice(&dev) != hipSuccess || hipDeviceGetAttribute(&cus, hipDeviceAttributeMultiprocessorCount, dev) != hipSuccess) { fprintf(stderr, "kernel_launch: device query failed\n"); grid = -1; return; }
        if (hipFuncSetAttribute((const void*)mk_fwd, hipFuncAttributeMaxDynamicSharedMemorySize, LDS_BYTES) != hipSuccess) { fprintf(stderr, "kernel_launch: hipFuncSetAttribute failed\n"); grid = -1; return; }
        if (hipOccupancyMaxActiveBlocksPerMultiprocessor(&per_cu, (const void*)mk_fwd, NTHREADS, LDS_BYTES) != hipSuccess || per_cu < 1) { fprintf(stderr, "kernel_launch: occupancy query says %d blocks per CU\n", per_cu); }
        (void)hipGetLastError();
        grid = cus;
    }
    if (grid < 0) return;
    if (hipMemsetAsync((char*)d_ws + WS_BAR, 0, WS_ZERO_BYTES, stream) != hipSuccess) { fprintf(stderr, "kernel_launch: memset failed\n"); return; }
    Params p; memset(&p, 0, sizeof(p));
    for (int i = 0; i < 25; ++i) p.in[i] = (const float*)d_in[i];
    p.out = (float*)d_out; p.ws = (unsigned char*)d_ws;
    unsigned char* ws = (unsigned char*)d_ws;
    auto job = [&](int j, const float* src, size_t dst_off, int K, int N, int ldd, int map, int nbatch, long sbatch, long dbatch) {
        TJob& J = p.jobs[j]; J.src = src; J.dst = (bf16_t*)(ws + dst_off); J.K = K; J.N = N; J.ldd = ldd; J.map = map; J.ntk = K / 64; J.ntn = (N + 127) / 128; J.nbatch = nbatch; J.sbatch = sbatch; J.dbatch = dbatch; J.ld = N; J.fp8 = 0; };
    job(0, p.in[I_WIN], WS_WIN, 2048, DIN, 2048, 1, 1, 0, 0);
    job(1, p.in[I_WPA], WS_WPA, 1024, 2048, 1024, 0, 1, 0, 0);
    job(2, p.in[I_WPB], WS_WPB, 1024, 2048, 1024, 0, 1, 0, 0);
    job(3, p.in[I_WO], WS_WO, 2048, 2048, 2048, 0, 1, 0, 0);
    job(4, p.in[I_WUK], WS_WUK, 128, 256, 128, 0, 8, 128L * 256, 256L * 128);
    job(5, p.in[I_WUV], WS_WUV, 256, 128, 256, 0, 8, 256L * 128, 128L * 256);
    job(6, p.in[I_WIN] + 4432, WS_WIN8, 2048, 1024, 2048, 0, 1, 0, 0); job(7, p.in[I_WIN] + 5464, WS_WIN8 + (size_t)1024 * 2048, 2048, 4096, 2048, 0, 1, 0, 0);
    for (int j = 6; j < 8; ++j) { p.jobs[j].ld = DIN; p.jobs[j].fp8 = 1; }
    int t0 = 0; for (int j = 0; j < NJOBS; ++j) { p.jobs[j].tile0 = t0; t0 += p.jobs[j].ntk * p.jobs[j].ntn * p.jobs[j].nbatch; }
    p.ntiles_total = t0;
#if MK_LAUNCHES == 1
    p.ph_lo = 0; p.ph_hi = NPHASES;
    hipLaunchKernelGGL(mk_fwd, dim3(grid), dim3(NTHREADS), LDS_BYTES, stream, p);
#else
    for (int k = 0; k < NPHASES; ++k) { p.ph_lo = k; p.ph_hi = k + 1; hipLaunchKernelGGL(mk_fwd, dim3(grid), dim3(NTHREADS), LDS_BYTES, stream, p); }
#endif
    const hipError_t le = hipPeekAtLastError();
    if (le != hipSuccess) fprintf(stderr, "kernel_launch: launch failed: %s\n", hipGetErrorName(le));
}

#ifdef DIAG_PHASES
template <int PH> __global__ void __launch_bounds__(NTHREADS, 2) k_ph(Params p) {
    extern __shared__ __attribute__((aligned(16))) unsigned char shm[];
    LAS unsigned char* lds = (LAS unsigned char*)shm; const int G = gridDim.x, bx = blockIdx.x;
    if constexpr (PH == 0) { EpiProj E{p.ws, p.in[I_BGATE]}; ProjOrder S; S.S.init(p.ws + WS_HF8, p.ws + WS_WIN8, NTOK, 24 * 256, DM, G, (G - 1) - bx); S.fp8 = 1; S.Bfull = nullptr;
             pg8::gemm_phase<EpiProj, ProjOrder, false, true>(lds, DM, S, E, 0x79797979); }
    if constexpr (PH == 1) { EpiProj E{p.ws, p.in[I_BGATE]}; ProjOrder S; S.S.init(p.ws + WS_H, p.ws + WS_WIN, NTOK, 18 * 256, DM * 2, G, bx); S.fp8 = 0; S.Bfull = nullptr;
             pg8::gemm_phase<EpiProj, ProjOrder, false, false>(lds, DM * 2, S, E); }
}
template __global__ void k_ph<0>(Params); template __global__ void k_ph<1>(Params);
#endif
```

```cpp
#include <hip/hip_runtime.h>
#include <cstdio>
#include <cstdint>
#include <cstring>

#ifndef MK_LAUNCHES
#define MK_LAUNCHES 1
#endif

#define LAS __attribute__((address_space(3)))
typedef unsigned short bf16_t;
typedef short bf16x8 __attribute__((ext_vector_type(8)));
typedef short s16x4 __attribute__((ext_vector_type(4)));
typedef float f32x4 __attribute__((ext_vector_type(4)));
typedef float f32x16 __attribute__((ext_vector_type(16)));
typedef unsigned u32x4 __attribute__((ext_vector_type(4)));
typedef unsigned u32x2 __attribute__((ext_vector_type(2)));

constexpr int DM = 2048, NBATCH = 4, SEQ = 2048, NTOK = NBATCH * SEQ;
constexpr int DIN = 9560, DINP = 9728;
constexpr int NEXP = 64, DEXP = 512, LCAP = 8192;
constexpr float RMS_EPS = 1e-6f;
constexpr float LOG2E = 1.4426950408889634f;
constexpr int NTHREADS = 512;
constexpr int LDS_BYTES = 163840 - 1024;
constexpr int LDS_BARW = LDS_BYTES - 16;
constexpr int LDS_TAB = 131072;

constexpr size_t al256(size_t x) { return (x + 255) / 256 * 256; }
constexpr size_t WS_BAR = 0;
constexpr size_t WS_CNT = 16384;
constexpr size_t WS_ZERO_BYTES = 16384 + 4096;
constexpr size_t WS_MOD = WS_ZERO_BYTES;
constexpr size_t WS_H = al256(WS_MOD + (size_t)4 * 12288 * 4);
constexpr size_t WS_WIN = al256(WS_H + (size_t)NTOK * DM * 2);
constexpr size_t WS_WPA = al256(WS_WIN + (size_t)DINP * DM * 2);
constexpr size_t WS_WPB = al256(WS_WPA + (size_t)2048 * 1024 * 2);
constexpr size_t WS_WO = al256(WS_WPB + (size_t)2048 * 1024 * 2);
constexpr size_t WS_WUK = al256(WS_WO + (size_t)2048 * 2048 * 2);
constexpr size_t WS_WUV = al256(WS_WUK + (size_t)8 * 256 * 128 * 2);
constexpr size_t WS_W13 = al256(WS_WUV + (size_t)8 * 128 * 256 * 2);
constexpr size_t WS_W2 = al256(WS_W13 + (size_t)64 * 1024 * 2048 * 2);
constexpr size_t WS_QA = al256(WS_W2 + (size_t)64 * 2048 * 512 * 2);
constexpr size_t WS_CKV = al256(WS_QA + (size_t)NTOK * 1024 * 2);
constexpr size_t WS_KV = al256(WS_CKV + (size_t)NTOK * 256 * 4);
constexpr size_t WS_QIDX = al256(WS_KV + (size_t)NTOK * 256 * 2);
constexpr size_t WS_MISC = al256(WS_QIDX + (size_t)NTOK * 1024 * 2);
constexpr size_t WS_QB = al256(WS_MISC + (size_t)NTOK * 256 * 4);
constexpr size_t WS_KB = al256(WS_QB + (size_t)NTOK * 1024 * 2);
constexpr size_t WS_VB = al256(WS_KB + (size_t)NTOK * 1024 * 2);
constexpr size_t WS_GATES = al256(WS_VB + (size_t)NTOK * 1024 * 2);
constexpr size_t WS_QLAT = al256(WS_GATES + (size_t)NTOK * 4096 * 2);
constexpr size_t WS_MASK = al256(WS_QLAT + (size_t)NTOK * 2048 * 2);
constexpr size_t WS_CUM = al256(WS_MASK + (size_t)NTOK * 256);
constexpr size_t WS_OLAT = al256(WS_CUM + (size_t)4 * 8 * 2048 * 4);
constexpr size_t WS_OA = al256(WS_OLAT + (size_t)NTOK * 2048 * 2);
constexpr size_t WS_OB = al256(WS_OA + (size_t)NTOK * 1024 * 2);
constexpr size_t WS_T1 = al256(WS_OB + (size_t)NTOK * 1024 * 2);
constexpr size_t WS_MERGED = al256(WS_T1 + (size_t)NTOK * 2048 * 4);
constexpr size_t WS_LTOK = al256(WS_MERGED + (size_t)NTOK * 2048 * 2);
constexpr size_t WS_LW = al256(WS_LTOK + (size_t)NEXP * LCAP * 4);
constexpr size_t WS_ACT = al256(WS_LW + (size_t)NEXP * LCAP * 4);
constexpr size_t WS_HLO = al256(WS_ACT + (size_t)32768 * 512 * 2);
constexpr size_t WS_WRH = al256(WS_HLO + (size_t)NTOK * DM * 2);
constexpr size_t WS_WRL = al256(WS_WRH + (size_t)80 * DM * 2);
constexpr size_t WS_END = al256(WS_WRL + (size_t)80 * DM * 2);
constexpr size_t WS_KIDX = WS_END;
constexpr size_t WS_END2 = al256(WS_KIDX + (size_t)NTOK * 64 * 2);
constexpr size_t WS_H8 = WS_END2;
constexpr size_t WS_ACT8 = al256(WS_H8 + (size_t)NTOK * DM);
constexpr size_t WS_END3 = al256(WS_ACT8 + (size_t)16384 * 512);
constexpr size_t WS_HF8 = WS_END3;
constexpr size_t WS_WIN8 = al256(WS_HF8 + (size_t)NTOK * DM);
constexpr size_t WS_END4 = al256(WS_WIN8 + (size_t)7680 * DM);
constexpr size_t WS_MRG8 = WS_END4;
constexpr size_t WS_WO8 = al256(WS_MRG8 + (size_t)NTOK * DM);
constexpr size_t WS_END5 = al256(WS_WO8 + (size_t)2048 * 2048);
constexpr size_t WS_YS = WS_T1;
constexpr size_t WS_HG = WS_QA;
static_assert(WS_HG + (size_t)32768 * DM * 2 <= WS_QLAT, "hg alias must fit in the dead region");

struct TJob { const float* src; bf16_t* dst; int K, N, ldd, map, ntk, ntn, nbatch, tile0; long sbatch, dbatch; int ld, fp8; };
constexpr int NJOBS = 10;
struct Params {
    const float* in[25];
    float* out;
    unsigned char* ws;
    TJob jobs[NJOBS];
    int ntiles_total;
    int ph_lo, ph_hi;
};
enum { I_X = 0, I_C, I_WADA, I_BADA, I_GMIX, I_WIN, I_BGATE, I_BFORGET, I_WUK, I_WUV, I_GQA, I_GKV, I_GQB, I_GKB, I_WPA, I_WPB, I_WO, I_GFFN, I_WRG, I_BRG, I_WRE, I_BRE, I_W1, I_W3, I_W2 };

__device__ __forceinline__ unsigned cvt_pk_bf16(float lo, float hi) { unsigned r; asm volatile("v_cvt_pk_bf16_f32 %0, %1, %2" : "=v"(r) : "v"(lo), "v"(hi)); return r; }
__device__ __forceinline__ float bf_lo(unsigned w) { return __uint_as_float(w << 16); }
__device__ __forceinline__ float bf_hi(unsigned w) { return __uint_as_float(w & 0xffff0000u); }
typedef float f32x2 __attribute__((ext_vector_type(2)));
__device__ __forceinline__ unsigned pack_fp8x4(float a, float b, float c, float d) { int w = __builtin_amdgcn_cvt_pk_fp8_f32(a, b, 0, false); w = __builtin_amdgcn_cvt_pk_fp8_f32(c, d, w, true); return (unsigned)w; }
__device__ __forceinline__ bf16x8 fp8x8_to_bf16(u32x2 v) {
    const f32x2 a = __builtin_amdgcn_cvt_pk_f32_fp8((int)v.x, false), b = __builtin_amdgcn_cvt_pk_f32_fp8((int)v.x, true), c = __builtin_amdgcn_cvt_pk_f32_fp8((int)v.y, false), d = __builtin_amdgcn_cvt_pk_f32_fp8((int)v.y, true);
    u32x4 w; w.x = cvt_pk_bf16(a.x, a.y); w.y = cvt_pk_bf16(b.x, b.y); w.z = cvt_pk_bf16(c.x, c.y); w.w = cvt_pk_bf16(d.x, d.y); return *reinterpret_cast<bf16x8*>(&w); }
__device__ __forceinline__ float wave_sum(float v) {
#pragma unroll
    for (int o = 32; o >= 1; o >>= 1) v += __shfl_xor(v, o);
    return v;
}
__device__ __forceinline__ float sigmoidf_(float x) { return 1.0f / (1.0f + __expf(-x)); }
__device__ __forceinline__ int crow(int r, int hi) { return (r & 3) + 8 * (r >> 2) + 4 * hi; }
#define SBAR() __builtin_amdgcn_sched_barrier(0)

#define XB_TMO      128
#define XB_XCNT(j)  (256  + 64 * (j))
#define XB_XSUB(j)  (1280 + 64 * (j))
#define XB_XGEN(j)  (2304 + 64 * (j))
#define XB_TOP      3328
#define XB_TOPGEN   3392
#define XCD_BAR_WORDS 3456
#define XB_SPIN_CAP (1u << 20)
__device__ __forceinline__ unsigned xb_ld(unsigned* p)              { return __hip_atomic_load(p, __ATOMIC_RELAXED, __HIP_MEMORY_SCOPE_AGENT); }
__device__ __forceinline__ unsigned xb_add(unsigned* p, unsigned v) { return __hip_atomic_fetch_add(p, v, __ATOMIC_RELAXED, __HIP_MEMORY_SCOPE_AGENT); }
__device__ __forceinline__ unsigned xb_xcc_id() { return (unsigned)__builtin_amdgcn_s_getreg((3 << 11) | 20) & 0xFu; }
#define XB_SPIN(cond, bar) do { unsigned _sp = 0; while (cond) { __builtin_amdgcn_s_sleep(1); \
    if ((++_sp & 255u) == 0u) { if (xb_ld(&(bar)[XB_TMO])) break; if (_sp > XB_SPIN_CAP) { atomicAdd(&(bar)[XB_TMO], 1u); break; } } } } while (0)
struct XcdBarrier { unsigned* bar; unsigned x; volatile LAS unsigned* st; };
__device__ __forceinline__ XcdBarrier xcd_barrier_post(unsigned* bar, volatile LAS unsigned* st) {
    XcdBarrier b; b.bar = bar; b.x = xb_xcc_id(); b.st = st;
    if (threadIdx.x == 0) (void)xb_add(&bar[XB_XCNT(b.x)], 1u);
    return b;
}
__device__ __forceinline__ void xcd_barrier_complete(unsigned* bar, unsigned x, unsigned& nloc, unsigned& nx) {
    const unsigned G = gridDim.x * gridDim.y * gridDim.z;
    unsigned sum, cnt, mine, sp = 0u;
    for (;;) {
        sum = 0u; cnt = 0u; mine = 0u;
#pragma unroll
        for (unsigned j = 0; j < 16; ++j) { const unsigned c = xb_ld(&bar[XB_XCNT(j)]); sum += c; cnt += (c > 0u) ? 1u : 0u; mine = (j == x) ? c : mine; }
        if (sum == G) break;
        __builtin_amdgcn_s_sleep(1);
        if ((++sp & 255u) == 0u) { if (xb_ld(&bar[XB_TMO])) break; if (sp > XB_SPIN_CAP) { atomicAdd(&bar[XB_TMO], 1u); break; } }
    }
    nloc = mine > 0u ? mine : 1u; nx = cnt > 0u ? cnt : 1u;
}
__device__ __forceinline__ void xcd_barrier(const XcdBarrier& b) {
    asm volatile("s_waitcnt vmcnt(0)" ::: "memory");
    __syncthreads();
    if (threadIdx.x == 0) {
        unsigned* bar = b.bar;
        __builtin_amdgcn_s_waitcnt(0);
        unsigned nloc = b.st[0], nx = b.st[1];
        if (nloc == 0u) { xcd_barrier_complete(bar, b.x, nloc, nx); b.st[0] = nloc; b.st[1] = nx; }
        const unsigned old = xb_add(&bar[XB_XSUB(b.x)], 1u);
        const unsigned gen = old / nloc;
        if (old + 1u == (gen + 1u) * nloc) {
            __builtin_amdgcn_fence(__ATOMIC_RELEASE, "agent");
            asm volatile("s_waitcnt vmcnt(0)" ::: "memory");
            const unsigned og = xb_add(&bar[XB_TOP], 1u);
            const unsigned tg = og / nx;
            if (og + 1u == (tg + 1u) * nx) xb_add(&bar[XB_TOPGEN], 1u);
            else XB_SPIN(xb_ld(&bar[XB_TOPGEN]) == tg, bar);
            __builtin_amdgcn_fence(__ATOMIC_ACQUIRE, "agent");
            xb_add(&bar[XB_XGEN(b.x)], 1u);
            asm volatile("s_waitcnt vmcnt(0)" ::: "memory");
        } else {
            XB_SPIN(xb_ld(&bar[XB_XGEN(b.x)]) == gen, bar);
            __builtin_amdgcn_fence(__ATOMIC_ACQUIRE, "agent");
            asm volatile("s_waitcnt vmcnt(0)" ::: "memory");
        }
    }
    __syncthreads();
}

namespace pg8 {
constexpr int BM = 256, BK = 64, HALF = 128, HTB = HALF * BK * 2, STAGE_BYTES = 8 * HTB, NXCD = 8, WGM = 8;
__host__ __device__ __forceinline__ int lds_byte(int r, int c) { const int st = (r >> 4) * 2 + (c >> 5), rr = r & 15, cc = c & 31, ob = rr * 64 + cc * 2; return st * 1024 + (ob ^ (((ob >> 9) & 1) << 5)); }
__host__ __device__ __forceinline__ void stage_rc(int b, int& R, int& C) { const int st = b / 1024, sb = b % 1024, swz = sb ^ (((sb >> 9) & 1) << 5); R = (st >> 1) * 16 + swz / 64; C = (st & 1) * 32 + (swz % 64) / 2; }
__host__ __device__ __forceinline__ int perm32(int rho) { const int n = rho >> 4, i = rho & 15; return 8 * (i >> 2) + 4 * n + (i & 3); }

struct Unit { int pm, pn; const char* a; const char* b; const int* gi; int nvalid; int aux; };

struct StaticOrder {
    int nM, nN, nwg, G, c, RS; const char* A; const char* Bt;
    __device__ void init(const void* A_, const void* Bt_, int M, int N, int RS_, int G_, int c_) { A = (const char*)A_; Bt = (const char*)Bt_; RS = RS_; nM = M / BM; nN = N / BM; nwg = nM * nN; G = G_; c = c_; }
    __device__ bool next(int i, Unit& u) const {
        const long L = (long)i * G + c; if (L >= nwg) return false;
        int wgid = (int)L; { const int q = nwg / NXCD, r = nwg % NXCD, xcd = wgid % NXCD, off = wgid / NXCD; wgid = (xcd < r ? xcd * (q + 1) : r * (q + 1) + (xcd - r) * q) + off; }
        const int nig = WGM * nN, gid = wgid / nig, fm = gid * WGM, gsz = (nM - fm) < WGM ? (nM - fm) : WGM;
        u.pm = fm + ((wgid % nig) % gsz); u.pn = (wgid % nig) / gsz;
        u.a = A + (size_t)u.pm * BM * RS; u.b = Bt + (size_t)u.pn * BM * RS; u.gi = nullptr; u.nvalid = BM; u.aux = 0; return true;
    }
};

typedef int i32x8 __attribute__((ext_vector_type(8)));
typedef int i32x4v __attribute__((ext_vector_type(4)));
__device__ __forceinline__ i32x8 cat16(bf16x8 lo, bf16x8 hi) { const i32x4v a = *reinterpret_cast<const i32x4v*>(&lo), b = *reinterpret_cast<const i32x4v*>(&hi); return __builtin_shufflevector(a, b, 0, 1, 2, 3, 4, 5, 6, 7); }
template <class Epi, class Sched, bool GATHER, bool FP8 = false>
__device__ __forceinline__ void gemm_phase(LAS unsigned char* lds, const int RS, const Sched& S, const Epi& E, const int scale_b = 0x7f7f7f7f, const int scale_a = 0x7f7f7f7f) {
    int tid = threadIdx.x; asm volatile("" : "+v"(tid));
    const int wid = __builtin_amdgcn_readfirstlane(tid >> 6), lane = tid & 63, wr = wid >> 2, wc = wid & 3, fr = lane & 15, fq = lane >> 4;
    const int nt = RS / (BK * 2); const int K = RS;
    unsigned voffA[2], voffB[2]; int RA[2], CA[2];
#pragma unroll
    for (int i = 0; i < 2; ++i) { int R, C; stage_rc(tid * 16 + i * 8192, R, C); const int Rb = ((R & ~31) + perm32(R & 31));
        RA[i] = R; CA[i] = C; voffA[i] = (unsigned)(R * RS + C * 2); voffB[i] = (unsigned)(Rb * RS + C * 2); }
    const size_t kstep = (size_t)(BK * 2);
    const size_t hstep = (size_t)HALF * RS;
    const unsigned ldsw = (unsigned)wid * 1024u;
    const int aoff = lds_byte(wr * 64 + fr, fq * 8), boff = lds_byte(wc * 32 + fr, fq * 8);
    unsigned gA[2][2], gN[2][2];
#define PG8_SA(b, h) (((b) * 2 + (h)) * HTB)
#define PG8_SB(b, h) ((4 + (b) * 2 + (h)) * HTB)
#define PG8_STAGE(bufoff, gbase, voff) do { _Pragma("unroll") for (int _i = 0; _i < 2; ++_i) \
        __builtin_amdgcn_global_load_lds((const unsigned*)((const char*)(gbase) + (voff)[_i]), (LAS unsigned*)(lds + (bufoff) + ldsw + _i * 8192), 16, 0, 0); } while (0)
#define PG8_STAGE_A(bufoff, gp, h, NX) do { if constexpr (GATHER) { if (NX) PG8_STAGE(bufoff, gp, gN[h]); else PG8_STAGE(bufoff, gp, gA[h]); } else PG8_STAGE(bufoff, (gp) + (h) * hstep, voffA); } while (0)
#define PG8_LD8(p_) __builtin_shufflevector(*(const LAS i32x4v*)(p_), *(const LAS i32x4v*)((p_) + 1024), 0, 1, 2, 3, 4, 5, 6, 7)
#define PG8_LDA(dst, b, h) do { if constexpr (FP8) { _Pragma("unroll") for (int m = 0; m < 4; ++m) dst##8[m] = PG8_LD8(lds + PG8_SA(b, h) + aoff + m * 2048); } \
        else { _Pragma("unroll") for (int m = 0; m < 4; ++m) _Pragma("unroll") for (int k = 0; k < 2; ++k) dst[m][k] = *(const LAS bf16x8*)(lds + PG8_SA(b, h) + aoff + m * 2048 + k * 1024); } } while (0)
#define PG8_LDB(dst, b, h) do { if constexpr (FP8) { _Pragma("unroll") for (int n = 0; n < 2; ++n) dst##8[n] = PG8_LD8(lds + PG8_SB(b, h) + boff + n * 2048); } \
        else { _Pragma("unroll") for (int n = 0; n < 2; ++n) _Pragma("unroll") for (int k = 0; k < 2; ++k) dst[n][k] = *(const LAS bf16x8*)(lds + PG8_SB(b, h) + boff + n * 2048 + k * 1024); } } while (0)
#define PG8_MMA(ai, bj, At, Bt) do { __builtin_amdgcn_s_setprio(1); \
        if constexpr (FP8) { _Pragma("unroll") for (int m = 0; m < 4; ++m) _Pragma("unroll") for (int n = 0; n < 2; ++n) \
            asm volatile("v_mfma_scale_f32_16x16x128_f8f6f4 %0, %1, %2, %0, %3, %4 op_sel_hi:[0,0,0]" : "+v"(acc[ai][bj][m][n]) : "v"(Bt##8[n]), "v"(At##8[m]), "v"(sc_b), "v"(sc_a)); } \
        else { _Pragma("unroll") for (int m = 0; m < 4; ++m) _Pragma("unroll") for (int n = 0; n < 2; ++n) _Pragma("unroll") for (int k = 0; k < 2; ++k) \
            acc[ai][bj][m][n] = __builtin_amdgcn_mfma_f32_16x16x32_bf16(Bt[n][k], At[m][k], acc[ai][bj][m][n], 0, 0, 0); } \
        __builtin_amdgcn_s_setprio(0); } while (0)
#define PG8_WAIT_V(n) asm volatile("s_waitcnt vmcnt(" #n ")" ::: "memory")
#define PG8_WAIT_L(n) asm volatile("s_waitcnt lgkmcnt(" #n ")" ::: "memory")
#define PG8_BAR __builtin_amdgcn_s_barrier()
#define PG8_SCHED __builtin_amdgcn_sched_barrier(0)
#define PG8_GIDX(dst, u) do { if constexpr (GATHER) { _Pragma("unroll") for (int h = 0; h < 2; ++h) _Pragma("unroll") for (int i = 0; i < 2; ++i) { \
        const int rr = h * HALF + RA[i]; const int tok = rr < (u).nvalid ? (u).gi[rr] : 0; dst[h][i] = (unsigned)(tok * K + CA[i] * 2); } } } while (0)
    Unit cur, nxt; int ui = 0;
    if (!S.next(0, cur)) return;
    f32x4 acc[2][2][4][2];
#pragma unroll
    for (int a = 0; a < 2; ++a)
#pragma unroll
        for (int b = 0; b < 2; ++b)
#pragma unroll
            for (int m = 0; m < 4; ++m)
#pragma unroll
                for (int n = 0; n < 2; ++n) acc[a][b][m][n] = (f32x4){0.f, 0.f, 0.f, 0.f};
    const int sc_b = scale_b, sc_a = scale_a;
    bf16x8 At[4][2], B0[2][2], B1[2][2]; i32x8 At8[4], B08[2], B18[2];
    const char* cA = cur.a; const char* cB = cur.b;
    PG8_GIDX(gA, cur);
    PG8_STAGE(PG8_SB(0, 0), cB, voffB); PG8_STAGE_A(PG8_SA(0, 0), cA, 0, false); PG8_STAGE(PG8_SB(0, 1), cB + hstep, voffB); PG8_STAGE_A(PG8_SA(0, 1), cA, 1, false);
    if (wr == 1) PG8_BAR;
    PG8_WAIT_V(4); PG8_BAR;
    PG8_STAGE(PG8_SB(1, 0), cB + kstep, voffB); PG8_STAGE_A(PG8_SA(1, 0), cA + kstep, 0, false); PG8_STAGE(PG8_SB(1, 1), cB + hstep + kstep, voffB);
    PG8_WAIT_V(6); PG8_BAR;
    for (;;) {
        const bool has_next = S.next(ui + 1, nxt);
        const char* nA = has_next ? nxt.a : cA; const char* nB = has_next ? nxt.b : cB;
        if constexpr (GATHER) { if (has_next) { PG8_GIDX(gN, nxt); } else {
#pragma unroll
            for (int h = 0; h < 2; ++h)
#pragma unroll
                for (int i = 0; i < 2; ++i) gN[h][i] = gA[h][i]; } }
        for (int t = 0; t < nt; t += 2) {
            const bool last = (t == nt - 2);
            const char* a1 = cA + (size_t)(t + 1) * kstep;
            const char* a2 = last ? nA : cA + (size_t)(t + 2) * kstep; const char* b2 = last ? nB : cB + (size_t)(t + 2) * kstep;
            const char* a3 = a2 + kstep; const char* b3 = b2 + kstep;
            PG8_LDB(B0, 0, 0); PG8_SCHED; PG8_LDA(At, 0, 0); PG8_STAGE_A(PG8_SA(1, 1), a1, 1, false);
            PG8_WAIT_L(8); PG8_BAR; PG8_WAIT_L(0); PG8_MMA(0, 0, At, B0); PG8_BAR; PG8_SCHED;
            PG8_LDB(B1, 0, 1); PG8_STAGE(PG8_SB(0, 0), b2, voffB);
            PG8_BAR; PG8_WAIT_L(0); PG8_MMA(0, 1, At, B1); PG8_BAR;
            PG8_LDA(At, 0, 1); PG8_STAGE_A(PG8_SA(0, 0), a2, 0, last);
            PG8_BAR; PG8_WAIT_L(0); PG8_MMA(1, 0, At, B0); PG8_BAR; PG8_SCHED;
            PG8_STAGE(PG8_SB(0, 1), b2 + hstep, voffB);
            PG8_WAIT_V(6); PG8_BAR; PG8_MMA(1, 1, At, B1); PG8_BAR;
            PG8_LDB(B0, 1, 0); PG8_SCHED; PG8_LDA(At, 1, 0); PG8_STAGE_A(PG8_SA(0, 1), a2, 1, last);
            PG8_WAIT_L(8); PG8_BAR; PG8_WAIT_L(0); PG8_MMA(0, 0, At, B0); PG8_BAR; PG8_SCHED;
            PG8_LDB(B1, 1, 1); PG8_STAGE(PG8_SB(1, 0), b3, voffB);
            PG8_BAR; PG8_WAIT_L(0); PG8_MMA(0, 1, At, B1); PG8_BAR;
            PG8_LDA(At, 1, 1); PG8_STAGE_A(PG8_SA(1, 0), a3, 0, last);
            PG8_BAR; PG8_WAIT_L(0); PG8_MMA(1, 0, At, B0); PG8_BAR; PG8_SCHED;
            PG8_STAGE(PG8_SB(1, 1), b3 + hstep, voffB);
            PG8_WAIT_V(6); PG8_BAR; PG8_MMA(1, 1, At, B1); PG8_BAR;
        }
        bool keep_acc = false;
        if constexpr (FP8) asm volatile("s_nop 15\n\ts_nop 15" ::: "memory");
        if constexpr (Epi::DUAL) { if (cur.aux) { E.mid(acc, cur, wr, wc, fr, fq); keep_acc = true; } else E(acc, cur, wr, wc, fr, fq); } else E(acc, cur, wr, wc, fr, fq);
        if (!has_next) break;
        if (!keep_acc)
#pragma unroll
        for (int a = 0; a < 2; ++a)
#pragma unroll
            for (int b = 0; b < 2; ++b)
#pragma unroll
                for (int m = 0; m < 4; ++m)
#pragma unroll
                    for (int n = 0; n < 2; ++n) acc[a][b][m][n] = (f32x4){0.f, 0.f, 0.f, 0.f};
        cur = nxt; cA = nA; cB = nB; ++ui;
        if constexpr (GATHER) {
#pragma unroll
            for (int h = 0; h < 2; ++h)
#pragma unroll
                for (int i = 0; i < 2; ++i) gA[h][i] = gN[h][i]; }
    }
    PG8_WAIT_V(0);
    if (wr == 0) PG8_BAR;
    PG8_BAR;
#undef PG8_SA
#undef PG8_SB
#undef PG8_STAGE
#undef PG8_STAGE_A
#undef PG8_LDA
#undef PG8_LD8
#undef PG8_LDB
#undef PG8_MMA
#undef PG8_WAIT_V
#undef PG8_WAIT_L
#undef PG8_BAR
#undef PG8_SCHED
#undef PG8_GIDX
}
}
using pg8::Unit;

#define EPI_LOOP(...) { int fr_ = fr, fq_ = fq; asm volatile("" : "+v"(fr_), "+v"(fq_)); _Pragma("unroll") for (int ai = 0; ai < 2; ++ai) _Pragma("unroll") for (int m = 0; m < 4; ++m) _Pragma("unroll") for (int bj = 0; bj < 2; ++bj) { \
        const int trow = ai * 128 + wr * 64 + m * 16 + fr_; const int tcol = bj * 128 + wc * 32 + fq_ * 8; const f32x4 v0 = acc[ai][bj][m][0], v1 = acc[ai][bj][m][1]; __VA_ARGS__ } }

__device__ __forceinline__ u32x4 pack8(const f32x4 a, const f32x4 b) { u32x4 w; w.x = cvt_pk_bf16(a[0], a[1]); w.y = cvt_pk_bf16(a[2], a[3]); w.z = cvt_pk_bf16(b[0], b[1]); w.w = cvt_pk_bf16(b[2], b[3]); return w; }

struct EpiProj { static constexpr bool DUAL = false;
    unsigned char* ws; const float* b_gate;
    __device__ __forceinline__ void operator()(const f32x4 (&acc)[2][2][4][2], const Unit& u, int wr, int wc, int fr, int fq) const {
        const int pn = u.pn; const size_t row0 = (size_t)u.pm * 256;
        if (pn == 4 || pn == 9) {
            float* dst = (float*)(ws + (pn == 4 ? WS_CKV : WS_MISC));
            EPI_LOOP({ float* p = dst + (row0 + trow) * 256 + tcol; *(f32x4*)p = v0; *(f32x4*)(p + 4) = v1;
                if (pn == 9 && tcol < 64) *(u32x4*)((bf16_t*)(ws + WS_KIDX) + (row0 + trow) * 64 + tcol) = pack8(v0, v1); })
        } else if (pn < 22) {
            bf16_t* dst; int ct;
            if (pn < 4) { dst = (bf16_t*)(ws + WS_QA); ct = pn; } else if (pn < 9) { dst = (bf16_t*)(ws + WS_QIDX); ct = pn - 5; }
            else if (pn < 14) { dst = (bf16_t*)(ws + WS_QB); ct = pn - 10; } else if (pn < 18) { dst = (bf16_t*)(ws + WS_KB); ct = pn - 14; } else { dst = (bf16_t*)(ws + WS_VB); ct = pn - 18; }
            EPI_LOOP({ *(u32x4*)(dst + (row0 + trow) * 1024 + ct * 256 + tcol) = pack8(v0, v1); })
        } else {
            bf16_t* dst = (bf16_t*)(ws + WS_GATES); const int ct = pn - 22;
            EPI_LOOP({ const int col = ct * 256 + tcol; const f32x4 b0 = *(const f32x4*)(b_gate + col), b1 = *(const f32x4*)(b_gate + col + 4); f32x4 s0, s1;
                _Pragma("unroll") for (int j = 0; j < 4; ++j) { s0[j] = sigmoidf_(v0[j] + b0[j]); s1[j] = sigmoidf_(v1[j] + b1[j]); }
                *(u32x4*)(dst + (row0 + trow) * 4096 + col) = pack8(s0, s1); })
        }
    }
};
struct EpiGate1 { static constexpr bool DUAL = false;
    const bf16_t* gates; float* T1;
    __device__ __forceinline__ void operator()(const f32x4 (&acc)[2][2][4][2], const Unit& u, int wr, int wc, int fr, int fq) const {
        EPI_LOOP({ const size_t row = (size_t)u.pm * 256 + trow; const int col = u.pn * 256 + tcol; const u32x4 g = *(const u32x4*)(gates + row * 4096 + col);
            f32x4 o0 = {v0[0] * bf_lo(g.x), v0[1] * bf_hi(g.x), v0[2] * bf_lo(g.y), v0[3] * bf_hi(g.y)}; f32x4 o1 = {v1[0] * bf_lo(g.z), v1[1] * bf_hi(g.z), v1[2] * bf_lo(g.w), v1[3] * bf_hi(g.w)};
            float* p = T1 + row * 2048 + col; *(f32x4*)p = o0; *(f32x4*)(p + 4) = o1; })
    }
};
struct EpiGate2 { static constexpr bool DUAL = false;
    const bf16_t* gates; const float* T1; bf16_t* merged;
    __device__ __forceinline__ void operator()(const f32x4 (&acc)[2][2][4][2], const Unit& u, int wr, int wc, int fr, int fq) const {
        EPI_LOOP({ const size_t row = (size_t)u.pm * 256 + trow; const int col = u.pn * 256 + tcol; const u32x4 g = *(const u32x4*)(gates + row * 4096 + 2048 + col);
            const float* p = T1 + row * 2048 + col; const f32x4 t0 = *(const f32x4*)p, t1 = *(const f32x4*)(p + 4);
            f32x4 o0 = {t0[0] + v0[0] * bf_lo(g.x), t0[1] + v0[1] * bf_hi(g.x), t0[2] + v0[2] * bf_lo(g.y), t0[3] + v0[3] * bf_hi(g.y)};
            f32x4 o1 = {t1[0] + v1[0] * bf_lo(g.z), t1[1] + v1[1] * bf_hi(g.z), t1[2] + v1[2] * bf_lo(g.w), t1[3] + v1[3] * bf_hi(g.w)};
            u32x2 w8; w8.x = pack_fp8x4(o0[0] * 4.f, o0[1] * 4.f, o0[2] * 4.f, o0[3] * 4.f); w8.y = pack_fp8x4(o1[0] * 4.f, o1[1] * 4.f, o1[2] * 4.f, o1[3] * 4.f);
            *(u32x2*)((unsigned char*)merged + row * 2048 + col) = w8; })
    }
};
struct EpiWo { static constexpr bool DUAL = false;
    const float* mod; bf16_t* y;
    __device__ __forceinline__ void operator()(const f32x4 (&acc)[2][2][4][2], const Unit& u, int wr, int wc, int fr, int fq) const {
        const float* gt = mod + (size_t)(u.pm >> 3) * 12288 + 4096;
        EPI_LOOP({ const size_t row = (size_t)u.pm * 256 + trow; const int col = u.pn * 256 + tcol;
            const f32x4 g0 = *(const f32x4*)(gt + col), g1 = *(const f32x4*)(gt + col + 4);
            *(u32x4*)(y + row * 2048 + col) = pack8(g0 * v0, g1 * v1); })
    }
};
struct EpiMoeUp { static constexpr bool DUAL = false;
    bf16_t* act; const float* lw;
    __device__ __forceinline__ void operator()(const f32x4 (&acc)[2][2][4][2], const Unit& u, int wr, int wc, int fr, int fq) const {
        int fr_ = fr, fq_ = fq; asm volatile("" : "+v"(fr_), "+v"(fq_));
#pragma unroll
        for (int ai = 0; ai < 2; ++ai)
#pragma unroll
            for (int m = 0; m < 4; ++m) {
                const int trow = ai * 128 + wr * 64 + m * 16 + fr_; const int tcol = wc * 32 + fq_ * 8;
                const float gw = trow < u.nvalid ? lw[u.aux + trow] : 0.f;
                const f32x4 a0 = acc[ai][0][m][0], a1 = acc[ai][0][m][1], u0 = acc[ai][1][m][0], u1 = acc[ai][1][m][1]; f32x4 o0, o1;
#pragma unroll
                for (int j = 0; j < 4; ++j) { o0[j] = a0[j] * sigmoidf_(a0[j]) * u0[j] * gw; o1[j] = a1[j] * sigmoidf_(a1[j]) * u1[j] * gw; }
                *(u32x4*)(act + ((size_t)u.pm * 256 + trow) * 512 + u.pn * 128 + tcol) = pack8(o0, o1); SBAR();
            }
    }
};
struct EpiMoeDown { static constexpr bool DUAL = false;
    float* out; const float* mod;
    __device__ __forceinline__ void operator()(const f32x4 (&acc)[2][2][4][2], const Unit& u, int wr, int wc, int fr, int fq) const {
        EPI_LOOP({ if (trow < u.nvalid) { const int tok = u.gi[trow]; const int col = u.pn * 256 + tcol; const float* gt = mod + (size_t)(tok >> 11) * 12288 + 10240 + col;
            const f32x4 g0 = *(const f32x4*)gt, g1 = *(const f32x4*)(gt + 4); float* po = out + (size_t)tok * 2048 + col;
            _Pragma("unroll") for (int j = 0; j < 4; ++j) { unsafeAtomicAdd(po + j, g0[j] * v0[j]); unsafeAtomicAdd(po + 4 + j, g1[j] * v1[j]); } } })
    }
};


struct DualOrder {
    pg8::StaticOrder S0, S1;
    __device__ bool next(int i, Unit& u) const { const bool ok = (i & 1) ? S1.next(i >> 1, u) : S0.next(i >> 1, u); u.aux = (i & 1) ? 0 : 1; return ok; }
};
struct EpiGate12 { static constexpr bool DUAL = false;
    EpiGate1 e1; EpiGate2 e2;
    __device__ __forceinline__ void operator()(const f32x4 (&acc)[2][2][4][2], const Unit& u, int wr, int wc, int fr, int fq) const { if (u.aux) e1(acc, u, wr, wc, fr, fq); else e2(acc, u, wr, wc, fr, fq); }
};

struct ProjOrder {
    pg8::StaticOrder S; int fp8; const char* Bfull;
    __device__ bool next(int i, Unit& u) const {
        if (!S.next(i, u)) return false;
        if (fp8) { if (u.pn >= 2) u.pn += 8; } else u.pn += 2;
        return true;
    }
};
struct MoeOrder {
    const LAS int* pre;
    const LAS int* cnt;
    int G, c, ntn, K; const char* A; const char* Bt; size_t bstride; const int* ltok; bool down;
    __device__ bool next(int i, Unit& u) const {
        const int total = __builtin_amdgcn_readfirstlane(pre[64]) * ntn; const long L = (long)i * G + c; if (L >= total) return false;
        const int l = (int)L; const int mt = l / ntn, pn = l % ntn;
        int e = 0;
#pragma unroll 1
        for (int s = 32; s >= 1; s >>= 1) if (__builtin_amdgcn_readfirstlane(pre[e + s]) <= mt) e += s;
        const int lt = mt - __builtin_amdgcn_readfirstlane(pre[e]);
        u.pm = mt; u.pn = pn; u.aux = e * LCAP + lt * 256; u.gi = ltok + u.aux; { const int rem = __builtin_amdgcn_readfirstlane(cnt[e]) - lt * 256; u.nvalid = rem < 256 ? rem : 256; }
        u.a = down ? A + (size_t)mt * 256 * K * 2 : A; u.b = Bt + (size_t)e * bstride + (size_t)pn * 256 * K * 2; return true;
    }
};

__device__ __forceinline__ int map_row(int map, int n) {
    if (map == 0) return n;
    if (map == 1) { if (n < 2384) return n; if (n < 5456) return n + 176; if (n < 5464) return n - 3072; return n + 168; }
    if (map == 2) return (n >> 7) * 256 + (n & 127);
    return (n >> 7) * 256 + 128 + (n & 127);
}
__device__ void ph0_prologue(const Params& p, LAS unsigned char* lds) {
    const int tid = threadIdx.x, wid = tid >> 6, lane = tid & 63, G = gridDim.x, bx = blockIdx.x;
    if (bx < 192) {
        LAS float* sc = (LAS float*)lds;
        LAS float* red = (LAS float*)(lds + 32768);
        const float* c = p.in[I_C];
        for (int i = tid; i < 4 * 2048; i += NTHREADS) { const float v = c[i]; sc[i] = v / (1.0f + __expf(-v)); }
        __syncthreads();
        for (int item = bx; item < 192; item += G) {
            const int n0 = item * 64, cg = lane & 15, rs = lane >> 4;
            float acc[4][4];
#pragma unroll
            for (int b = 0; b < 4; ++b)
#pragma unroll
                for (int j = 0; j < 4; ++j) acc[b][j] = 0.f;
            const float* w = p.in[I_WADA] + n0 + cg * 4;
#pragma unroll 4
            for (int step = 0; step < 64; ++step) {
                const int k = step * 32 + wid * 4 + rs;
                const f32x4 wv = *(const f32x4*)(w + (size_t)k * 12288);
#pragma unroll
                for (int b = 0; b < 4; ++b) { const float s = sc[b * 2048 + k];
#pragma unroll
                    for (int j = 0; j < 4; ++j) acc[b][j] += s * wv[j]; }
            }
#pragma unroll
            for (int b = 0; b < 4; ++b)
#pragma unroll
                for (int j = 0; j < 4; ++j) { float v = acc[b][j]; v += __shfl_xor(v, 16); v += __shfl_xor(v, 32); acc[b][j] = v; }
            if (rs == 0) {
#pragma unroll
                for (int b = 0; b < 4; ++b)
#pragma unroll
                    for (int j = 0; j < 4; ++j) red[(wid * 16 + cg) * 16 + b * 4 + j] = acc[b][j]; }
            __syncthreads();
            if (tid < 256) { const int cg2 = tid >> 4, bj = tid & 15, b = bj >> 2, j = bj & 3; float s = 0.f;
#pragma unroll
                for (int w8 = 0; w8 < 8; ++w8) s += red[(w8 * 16 + cg2) * 16 + bj];
                const int n = n0 + cg2 * 4 + j; ((float*)(p.ws + WS_MOD))[b * 12288 + n] = s + p.in[I_BADA][n]; }
            __syncthreads();
        }
    }
    { u32x4* z = (u32x4*)(p.ws + WS_WIN + (size_t)2392 * 2048 * 2); const int n16 = 168 * 2048 * 2 / 16;
      for (int i = bx * NTHREADS + tid; i < n16; i += G * NTHREADS) z[i] = (u32x4){0u, 0u, 0u, 0u}; }
    { bf16_t* wh = (bf16_t*)(p.ws + WS_WRH); bf16_t* wl = (bf16_t*)(p.ws + WS_WRL);
      for (int i = bx * NTHREADS + tid; i < 80 * 2048; i += G * NTHREADS) { const int n = i >> 11, k = i & 2047;
          const float v = n < 8 ? p.in[I_WRG][k * 8 + n] : (n < 72 ? p.in[I_WRE][k * 64 + n - 8] : 0.f);
          const unsigned h = cvt_pk_bf16(v, 0.f) & 0xffffu; const unsigned l = cvt_pk_bf16(v - bf_lo(h), 0.f) & 0xffffu; wh[i] = (bf16_t)h; wl[i] = (bf16_t)l; } }
    LAS float* tile = (LAS float*)(lds + 65536);
    for (int ti = bx; ti < p.ntiles_total; ti += G) {
        int j = 0;
#pragma unroll 1
        for (int q = 1; q < NJOBS; ++q) if (ti >= p.jobs[q].tile0) j = q;
        const TJob& J = p.jobs[j];
        int l = ti - J.tile0; const int per = J.ntk * J.ntn; const int bt = l / per; l -= bt * per; const int tn = l / J.ntk, tk = l % J.ntk;
        const float* src = J.src + (size_t)bt * J.sbatch; bf16_t* dst = J.dst + (size_t)bt * J.dbatch;
        const int k0 = tk * 64, n0 = tn * 128;
        f32x4 v[4];
#pragma unroll
        for (int i = 0; i < 4; ++i) { const int r = (tid >> 5) + 16 * i, c4 = (tid & 31) * 4;
            v[i] = (f32x4){0.f, 0.f, 0.f, 0.f}; if (n0 + c4 < J.N) v[i] = *(const f32x4*)(src + (size_t)(k0 + r) * J.ld + n0 + c4); }
#pragma unroll
        for (int i = 0; i < 4; ++i) { const int r = (tid >> 5) + 16 * i, c4 = (tid & 31) * 4;
#pragma unroll
            for (int q = 0; q < 4; ++q) tile[r * 129 + c4 + q] = v[i][q]; }
        __syncthreads();
        { const int n = tid >> 2, kq = (tid & 3) * 16;
          if (n0 + n < J.N) { float f[16];
#pragma unroll
              for (int q = 0; q < 16; ++q) f[q] = tile[(kq + q) * 129 + n];
              u32x4 w0, w1; w0.x = cvt_pk_bf16(f[0], f[1]); w0.y = cvt_pk_bf16(f[2], f[3]); w0.z = cvt_pk_bf16(f[4], f[5]); w0.w = cvt_pk_bf16(f[6], f[7]);
              w1.x = cvt_pk_bf16(f[8], f[9]); w1.y = cvt_pk_bf16(f[10], f[11]); w1.z = cvt_pk_bf16(f[12], f[13]); w1.w = cvt_pk_bf16(f[14], f[15]);
              if (J.fp8) { u32x4 w8; w8.x = pack_fp8x4(f[0] * 64.f, f[1] * 64.f, f[2] * 64.f, f[3] * 64.f); w8.y = pack_fp8x4(f[4] * 64.f, f[5] * 64.f, f[6] * 64.f, f[7] * 64.f);
                  w8.z = pack_fp8x4(f[8] * 64.f, f[9] * 64.f, f[10] * 64.f, f[11] * 64.f); w8.w = pack_fp8x4(f[12] * 64.f, f[13] * 64.f, f[14] * 64.f, f[15] * 64.f);
                  *(u32x4*)((unsigned char*)dst + (size_t)(n0 + n) * J.ldd + k0 + kq) = w8; }
              else { bf16_t* d = dst + (size_t)map_row(J.map, n0 + n) * J.ldd + k0 + kq; *(u32x4*)d = w0; *(u32x4*)(d + 8) = w1; } } }
        __syncthreads();
    }
}

__device__ __forceinline__ void norm_row(const float* xr, const float* g, const float* sh, const float* sc, bf16_t* hr, unsigned char* h8, int lane, float (&hv)[32]) {
    f32x4 v[8]; float ss = 0.f;
#pragma unroll
    for (int i = 0; i < 8; ++i) { v[i] = *(const f32x4*)(xr + i * 256 + lane * 4); ss += v[i][0] * v[i][0] + v[i][1] * v[i][1] + v[i][2] * v[i][2] + v[i][3] * v[i][3]; }
    ss = wave_sum(ss);
    const float rstd = rsqrtf(ss * (1.0f / 2048.0f) + RMS_EPS);
#pragma unroll
    for (int i = 0; i < 8; ++i) { const int col = i * 256 + lane * 4; const f32x4 gg = *(const f32x4*)(g + col), s1 = *(const f32x4*)(sc + col), s0 = *(const f32x4*)(sh + col);
#pragma unroll
        for (int j = 0; j < 4; ++j) hv[i * 4 + j] = v[i][j] * rstd * gg[j] * (1.0f + s1[j]) + s0[j];
        u32x2 w; w.x = cvt_pk_bf16(hv[i * 4], hv[i * 4 + 1]); w.y = cvt_pk_bf16(hv[i * 4 + 2], hv[i * 4 + 3]); *(u32x2*)(hr + col) = w;
        if (h8) *(unsigned*)(h8 + col) = pack_fp8x4(hv[i * 4], hv[i * 4 + 1], hv[i * 4 + 2], hv[i * 4 + 3]); }
}
__device__ void ph1_norm(const Params& p) {
    const int lane = threadIdx.x & 63, gw = blockIdx.x * 8 + (threadIdx.x >> 6), nw = gridDim.x * 8;
    const float* mod = (const float*)(p.ws + WS_MOD);
    for (int t = gw; t < NTOK; t += nw) { const int b = t >> 11; float hv[32];
        norm_row(p.in[I_X] + (size_t)t * DM, p.in[I_GMIX], mod + b * 12288, mod + b * 12288 + 2048, (bf16_t*)(p.ws + WS_H) + (size_t)t * DM, (unsigned char*)(p.ws + WS_HF8) + (size_t)t * DM, lane, hv); }
}

template <int MB, int NB, int KS>
__device__ __forceinline__ void wave_gemm(const bf16_t* A, int lda, const bf16_t* Bt, int ldb, f32x4 (&acc)[MB][NB], int lane) {
    const int fr = lane & 15, fq = lane >> 4;
#pragma unroll
    for (int mb = 0; mb < MB; ++mb)
#pragma unroll
        for (int nb = 0; nb < NB; ++nb) acc[mb][nb] = (f32x4){0.f, 0.f, 0.f, 0.f};
#pragma unroll 1
    for (int ks = 0; ks < KS; ++ks) {
        bf16x8 af[MB];
#pragma unroll
        for (int mb = 0; mb < MB; ++mb) af[mb] = *(const bf16x8*)(A + (size_t)(mb * 16 + fr) * lda + ks * 32 + fq * 8);
#pragma unroll
        for (int nb = 0; nb < NB; ++nb) { const bf16x8 bf = *(const bf16x8*)(Bt + (size_t)(nb * 16 + fr) * ldb + ks * 32 + fq * 8);
#pragma unroll
            for (int mb = 0; mb < MB; ++mb) acc[mb][nb] = __builtin_amdgcn_mfma_f32_16x16x32_bf16(bf, af[mb], acc[mb][nb], 0, 0, 0); }
    }
}


__device__ __forceinline__ int wave_total_i32(int v) {
    v += __builtin_amdgcn_update_dpp(0, v, 0x111, 0xf, 0xf, true); v += __builtin_amdgcn_update_dpp(0, v, 0x112, 0xf, 0xf, true);
    v += __builtin_amdgcn_update_dpp(0, v, 0x114, 0xf, 0xf, true); v += __builtin_amdgcn_update_dpp(0, v, 0x118, 0xf, 0xf, true);
    v += __builtin_amdgcn_update_dpp(0, v, 0x142, 0xa, 0xf, false); v += __builtin_amdgcn_update_dpp(0, v, 0x143, 0xc, 0xf, false);
    return __builtin_amdgcn_readlane(v, 63);
}
template <int NI> __device__ __forceinline__ unsigned long long topk_words(const LAS float* srow, int c, int lane) {
    unsigned key[NI];
#pragma unroll
    for (int i = 0; i < NI; ++i) { unsigned u = 0u; if (i <= c) { u = __float_as_uint(srow[i * 64 + lane]); u = (u & 0x80000000u) ? ~u : (u | 0x80000000u); } key[i] = u; }
    unsigned v = 0u;
#pragma unroll 1
    for (int bit = 31; bit >= 0; --bit) {
        const unsigned cand = v | (1u << bit); int cl = 0;
#pragma unroll
        for (int i = 0; i < NI; ++i) cl += (key[i] >= cand) ? 1 : 0;
        const int tot = wave_total_i32(cl);
        if (tot >= 256) { v = cand; if (tot == 256) break; }
    }
    unsigned long long myword = 0ull;
#pragma unroll
    for (int i = 0; i < NI; ++i) { const unsigned long long bm = __ballot(key[i] >= v); if (lane == i) myword = bm; if ((i & 3) == 3) SBAR(); }
    return myword;
}
__device__ void idx_item(const Params& p, LAS unsigned char* lds, int b, int c, int sub) {
    const int tid = threadIdx.x, wid = tid >> 6, lane = tid & 63, fr = lane & 15, fq = lane >> 4;
    constexpr int SCLD = 2052;
    LAS float* sc = (LAS float*)lds;
    const int q0 = c * 64 + sub * 16, nk = (c + 1) * 64, nkb = nk / 16;
    const bf16_t* qidx = (const bf16_t*)(p.ws + WS_QIDX) + (size_t)(b * SEQ + q0 + fr) * 1024;
    const float* misc = (const float*)(p.ws + WS_MISC);
    float wq[16];
    { const float* wp = misc + (size_t)(b * SEQ + q0 + fr) * 256 + 64;
#pragma unroll
      for (int i = 0; i < 4; ++i) { const f32x4 v = *(const f32x4*)(wp + i * 4); wq[i * 4] = v[0]; wq[i * 4 + 1] = v[1]; wq[i * 4 + 2] = v[2]; wq[i * 4 + 3] = v[3]; } }
#pragma unroll
    for (int hp = 0; hp < 2; ++hp) {
        bf16x8 qf[8][2];
#pragma unroll
        for (int h = 0; h < 8; ++h)
#pragma unroll
            for (int ks = 0; ks < 2; ++ks) qf[h][ks] = *(const bf16x8*)(qidx + (hp * 8 + h) * 64 + ks * 32 + fq * 8);
        const bf16_t* kbase = (const bf16_t*)(p.ws + WS_KIDX) + (size_t)(b * SEQ + fr) * 64 + fq * 8;
        bf16x8 kf[2];
        if (wid < nkb) { kf[0] = *(const bf16x8*)(kbase + (size_t)wid * 16 * 64); kf[1] = *(const bf16x8*)(kbase + (size_t)wid * 16 * 64 + 32); }
#pragma unroll 1
        for (int kb = wid; kb < nkb; kb += 8) {
            const int kn = kb + 8 < nkb ? kb + 8 : kb;
            const bf16x8 kn0 = *(const bf16x8*)(kbase + (size_t)kn * 16 * 64), kn1 = *(const bf16x8*)(kbase + (size_t)kn * 16 * 64 + 32);
            LAS f32x4* sp = (LAS f32x4*)(sc + fr * SCLD + kb * 16 + fq * 4);
            f32x4 s = {0.f, 0.f, 0.f, 0.f}; if (hp) s = *sp;
#pragma unroll
            for (int h = 0; h < 8; ++h) {
                f32x4 a = {0.f, 0.f, 0.f, 0.f};
                a = __builtin_amdgcn_mfma_f32_16x16x32_bf16(kf[0], qf[h][0], a, 0, 0, 0);
                a = __builtin_amdgcn_mfma_f32_16x16x32_bf16(kf[1], qf[h][1], a, 0, 0, 0);
#pragma unroll
                for (int j = 0; j < 4; ++j) s[j] += wq[hp * 8 + h] * fmaxf(a[j], 0.f);
            }
            *sp = s; kf[0] = kn0; kf[1] = kn1;
        }
    }
    __syncthreads();
    unsigned long long* mask = (unsigned long long*)(p.ws + WS_MASK);
    for (int qq = 0; qq < 2; ++qq) {
        const int ql = wid * 2 + qq; const size_t qg = (size_t)b * SEQ + q0 + ql;
        unsigned long long myword = 0ull;
        if (nk <= 256) { if (lane <= c) myword = ~0ull; }
        else { const LAS float* srow = sc + ql * SCLD;
            if (c < 8) myword = topk_words<8>(srow, c, lane); else if (c < 16) myword = topk_words<16>(srow, c, lane);
            else if (c < 24) myword = topk_words<24>(srow, c, lane); else myword = topk_words<32>(srow, c, lane); }
        if (lane < 32) mask[qg * 32 + lane] = myword;
    }
    __syncthreads();
}
#ifndef REP_SUB
#define REP_SUB 15
#endif
__device__ void ph3_prep(const Params& p, LAS unsigned char* lds, const int rep) {
#define P3ON(bit) (!rep || ((REP_SUB) & (bit)))
    const int tid = threadIdx.x, wid = tid >> 6, lane = tid & 63, bx = blockIdx.x, G = gridDim.x;
    if (P3ON(1)) for (int it = bx; it < 256; it += G) {
        const int b = it >> 6, r = it & 63, cp = r >> 2, sub = r & 3;
        idx_item(p, lds, b, 31 - cp, sub); idx_item(p, lds, b, cp, sub);
    }
    const int gw = bx * 8 + wid, nw = G * 8;
    if (P3ON(2)) for (int it = gw; it < 2048; it += nw) {
        const int rt = it >> 3, h = it & 7, fr = lane & 15, fq = lane >> 4;
        f32x4 acc[2][16];
        wave_gemm<2, 16, 4>((const bf16_t*)(p.ws + WS_QA) + (size_t)rt * 32 * 1024 + h * 128, 1024, (const bf16_t*)(p.ws + WS_WUK) + (size_t)h * 256 * 128, 128, acc, lane);
#pragma unroll
        for (int mb = 0; mb < 2; ++mb) { float ss = 0.f;
#pragma unroll
            for (int nb = 0; nb < 16; ++nb)
#pragma unroll
                for (int j = 0; j < 4; ++j) ss += acc[mb][nb][j] * acc[mb][nb][j];
            ss += __shfl_xor(ss, 16); ss += __shfl_xor(ss, 32);
            const float rs = rsqrtf(ss * (1.0f / 256.0f) + RMS_EPS) * 0.0625f;
            bf16_t* o = (bf16_t*)(p.ws + WS_QLAT) + (size_t)(rt * 32 + mb * 16 + fr) * 2048 + h * 256;
#pragma unroll
            for (int nb = 0; nb < 16; ++nb) { const int col = nb * 16 + fq * 4; const f32x4 g = *(const f32x4*)(p.in[I_GQA] + col);
                u32x2 w; w.x = cvt_pk_bf16(acc[mb][nb][0] * rs * g[0], acc[mb][nb][1] * rs * g[1]); w.y = cvt_pk_bf16(acc[mb][nb][2] * rs * g[2], acc[mb][nb][3] * rs * g[3]); *(u32x2*)(o + col) = w; } }
    }
    if (P3ON(4)) for (int t = gw; t < NTOK; t += nw) {
        { const f32x4 v = *(const f32x4*)((const float*)(p.ws + WS_CKV) + (size_t)t * 256 + lane * 4); float ss = wave_sum(v[0] * v[0] + v[1] * v[1] + v[2] * v[2] + v[3] * v[3]);
          const float rs = rsqrtf(ss * (1.0f / 256.0f) + RMS_EPS); const f32x4 g = *(const f32x4*)(p.in[I_GKV] + lane * 4);
          u32x2 w; w.x = cvt_pk_bf16(v[0] * rs * g[0], v[1] * rs * g[1]); w.y = cvt_pk_bf16(v[2] * rs * g[2], v[3] * rs * g[3]); *(u32x2*)((bf16_t*)(p.ws + WS_KV) + (size_t)t * 256 + lane * 4) = w; }
#pragma unroll
        for (int which = 0; which < 2; ++which) {
            bf16_t* row = (bf16_t*)(p.ws + (which ? WS_KB : WS_QB)) + (size_t)t * 1024 + lane * 16; const float* g = p.in[which ? I_GKB : I_GQB] + (lane & 7) * 16;
            u32x4 a = *(u32x4*)row, c2 = *(u32x4*)(row + 8); float f[16];
            f[0] = bf_lo(a.x); f[1] = bf_hi(a.x); f[2] = bf_lo(a.y); f[3] = bf_hi(a.y); f[4] = bf_lo(a.z); f[5] = bf_hi(a.z); f[6] = bf_lo(a.w); f[7] = bf_hi(a.w);
            f[8] = bf_lo(c2.x); f[9] = bf_hi(c2.x); f[10] = bf_lo(c2.y); f[11] = bf_hi(c2.y); f[12] = bf_lo(c2.z); f[13] = bf_hi(c2.z); f[14] = bf_lo(c2.w); f[15] = bf_hi(c2.w);
            float ss = 0.f;
#pragma unroll
            for (int j = 0; j < 16; ++j) ss += f[j] * f[j];
            ss += __shfl_xor(ss, 1); ss += __shfl_xor(ss, 2); ss += __shfl_xor(ss, 4);
            const float rs = rsqrtf(ss * (1.0f / 128.0f) + RMS_EPS) * (which ? 1.0f : 0.08838834764831845f);
#pragma unroll
            for (int j = 0; j < 16; ++j) f[j] *= rs * g[j];
            a.x = cvt_pk_bf16(f[0], f[1]); a.y = cvt_pk_bf16(f[2], f[3]); a.z = cvt_pk_bf16(f[4], f[5]); a.w = cvt_pk_bf16(f[6], f[7]);
            c2.x = cvt_pk_bf16(f[8], f[9]); c2.y = cvt_pk_bf16(f[10], f[11]); c2.z = cvt_pk_bf16(f[12], f[13]); c2.w = cvt_pk_bf16(f[14], f[15]);
            if (!rep) { *(u32x4*)row = a; *(u32x4*)(row + 8) = c2; } else if (a.x == 0x12345678u) *(u32x4*)row = c2;
        }
    }
    if (P3ON(8) && bx < NBATCH) {
        const int b = bx; const float* fp = (const float*)(p.ws + WS_MISC) + (size_t)(b * SEQ + 4 * tid) * 256 + 80;
        float ls[4][8];
#pragma unroll
        for (int j = 0; j < 4; ++j) { const f32x4 a = *(const f32x4*)(fp + j * 256), c4 = *(const f32x4*)(fp + j * 256 + 4);
#pragma unroll
            for (int h = 0; h < 8; ++h) { const float z = (h < 4 ? a[h & 3] : c4[h & 3]) + p.in[I_BFORGET][h]; ls[j][h] = fminf(z, 0.f) - log1pf(__expf(-fabsf(z))); } }
        LAS float* wt = (LAS float*)lds;
        float off[8];
#pragma unroll
        for (int h = 0; h < 8; ++h) { ls[1][h] += ls[0][h]; ls[2][h] += ls[1][h]; ls[3][h] += ls[2][h];
            float incl = ls[3][h];
#pragma unroll
            for (int o = 1; o < 64; o <<= 1) { const float t2 = __shfl_up(incl, o); if (lane >= o) incl += t2; }
            if (lane == 63) wt[wid * 8 + h] = incl;
            off[h] = incl - ls[3][h]; }
        __syncthreads();
#pragma unroll
        for (int h = 0; h < 8; ++h) { float wo = 0.f; for (int w8 = 0; w8 < wid; ++w8) wo += wt[w8 * 8 + h];
            float* cp = (float*)(p.ws + WS_CUM) + (size_t)(b * 8 + h) * SEQ + 4 * tid;
            *(f32x4*)cp = (f32x4){ls[0][h] + off[h] + wo, ls[1][h] + off[h] + wo, ls[2][h] + off[h] + wo, ls[3][h] + off[h] + wo}; }
        __syncthreads();
    }
}

template <int OFF> __device__ __forceinline__ s16x4 tr_read(int vb) { s16x4 r; asm volatile("ds_read_b64_tr_b16 %0, %1 offset:%2" : "=&v"(r) : "v"(vb), "i"(OFF) : "memory"); return r; }
__device__ __forceinline__ int v_rd_base(int lane) { return ((lane & 3) << 3) | (((lane >> 2) & 3) << 6) | (((lane >> 4) & 1) << 5) | (((lane >> 5) & 1) << 8); }
template <int NCB> __device__ __forceinline__ int v_st(int k, int c) { const int kk = (k & ~0xC) | ((k & 4) << 1) | ((k & 8) >> 1); return ((kk >> 3) * NCB + (c >> 5)) * 512 + ((kk & 7) * 32 + (c & 31)) * 2; }
#define PK4(P, BASE, OUT) do { unsigned a0 = cvt_pk_bf16(P[BASE + 0], P[BASE + 1]), a1 = cvt_pk_bf16(P[BASE + 2], P[BASE + 3]);   \
    unsigned b0 = cvt_pk_bf16(P[BASE + 4], P[BASE + 5]), b1 = cvt_pk_bf16(P[BASE + 6], P[BASE + 7]);                              \
    auto r0 = __builtin_amdgcn_permlane32_swap(a0, b0, false, false); auto r1 = __builtin_amdgcn_permlane32_swap(a1, b1, false, false); \
    u32x4 w = {r0[0], r1[0], r0[1], r1[1]}; OUT = *reinterpret_cast<bf16x8*>(&w); } while (0)
#define PKV(L, H) (bf16x8){L[0], L[1], L[2], L[3], H[0], H[1], H[2], H[3]}
template <int NCB, int D0, int KS> __device__ __forceinline__ void pv_step(f32x16& od, int vb, bf16x8 pa) {
    const s16x4 l = tr_read<D0 * 512 + KS * (2 * NCB * 512)>(vb), h = tr_read<D0 * 512 + KS * (2 * NCB * 512) + NCB * 512>(vb);
    asm volatile("s_waitcnt lgkmcnt(0)" ::: "memory"); SBAR();
    od = __builtin_amdgcn_mfma_f32_32x32x16_bf16(pa, PKV(l, h), od, 0, 0, 0);
}
template <int NCB, int KS0, int D0> struct PvBlocks { static __device__ __forceinline__ void run(f32x16* o, int vb, bf16x8 pa0, bf16x8 pa1) {
    pv_step<NCB, D0, KS0>(o[D0], vb, pa0); pv_step<NCB, D0, KS0 + 1>(o[D0], vb, pa1); if constexpr (D0 + 1 < NCB) PvBlocks<NCB, KS0, D0 + 1>::run(o, vb, pa0, pa1); } };
template <int NCB, int KS0, int D0> struct PvPairs { static __device__ __forceinline__ void run(f32x16* o, int vb, bf16x8 pa0, bf16x8 pa1) {
    constexpr int S = 2 * NCB * 512, H = NCB * 512;
    const s16x4 l00 = tr_read<D0 * 512 + KS0 * S>(vb), h00 = tr_read<D0 * 512 + KS0 * S + H>(vb), l01 = tr_read<D0 * 512 + (KS0 + 1) * S>(vb), h01 = tr_read<D0 * 512 + (KS0 + 1) * S + H>(vb);
    const s16x4 l10 = tr_read<(D0 + 1) * 512 + KS0 * S>(vb), h10 = tr_read<(D0 + 1) * 512 + KS0 * S + H>(vb), l11 = tr_read<(D0 + 1) * 512 + (KS0 + 1) * S>(vb), h11 = tr_read<(D0 + 1) * 512 + (KS0 + 1) * S + H>(vb);
    asm volatile("s_waitcnt lgkmcnt(0)" ::: "memory"); SBAR();
    o[D0] = __builtin_amdgcn_mfma_f32_32x32x16_bf16(pa0, PKV(l00, h00), o[D0], 0, 0, 0); o[D0 + 1] = __builtin_amdgcn_mfma_f32_32x32x16_bf16(pa0, PKV(l10, h10), o[D0 + 1], 0, 0, 0);
    o[D0] = __builtin_amdgcn_mfma_f32_32x32x16_bf16(pa1, PKV(l01, h01), o[D0], 0, 0, 0); o[D0 + 1] = __builtin_amdgcn_mfma_f32_32x32x16_bf16(pa1, PKV(l11, h11), o[D0 + 1], 0, 0, 0);
    if constexpr (D0 + 2 < NCB) PvPairs<NCB, KS0, D0 + 2>::run(o, vb, pa0, pa1); } };
__device__ __forceinline__ int swap23(int k) { return (k & ~0xC) | ((k & 4) << 1) | ((k & 8) >> 1); }
constexpr int FOX_STAGE = 33024;
constexpr int FOX_AL = 2 * FOX_STAGE, FOX_LI = FOX_AL + 1024;
__device__ void fox_item(const Params& p, LAS unsigned char* lds, int b, int h, int qb) {
    int tid = threadIdx.x; asm volatile("" : "+v"(tid));
    const int wid = __builtin_amdgcn_readfirstlane(tid >> 6), lane = tid & 63, r32 = lane & 31, hi = lane >> 5;
    const bf16_t* Q = (const bf16_t*)(p.ws + WS_QB);
    const char* Kg = (const char*)(p.ws + WS_KB) + ((size_t)b * SEQ * 1024 + h * 128) * 2; const char* Vg = (const char*)(p.ws + WS_VB) + ((size_t)b * SEQ * 1024 + h * 128) * 2;
    const float* cum = (const float*)(p.ws + WS_CUM) + (size_t)(b * 8 + h) * SEQ;
    const int qpos = qb * 256 + wid * 32 + r32;
    bf16x8 qr[8];
    { const bf16_t* qp = Q + (size_t)(b * SEQ + qpos) * 1024 + h * 128 + hi * 8;
#pragma unroll
      for (int d0 = 0; d0 < 8; ++d0) qr[d0] = *(const bf16x8*)(qp + d0 * 16); }
    const float cq = cum[qpos] * LOG2E;
    unsigned ksrc[2], vsrc[2];
#pragma unroll
    for (int i = 0; i < 2; ++i) { const int pos = (i * 512 + tid) * 16;
        { const int row = pos >> 8; const int cb = (pos & 255) ^ ((row & 7) << 4); ksrc[i] = (unsigned)(row * 2048 + cb); }
        { const int sub = pos >> 9, within = pos & 511; const int kk = (sub >> 2) * 8 + (within >> 6); const int c = (sub & 3) * 32 + ((within & 63) >> 1); vsrc[i] = (unsigned)(swap23(kk) * 2048 + c * 2); } }
    float m_reg = -1e30f, l_reg = 0.f; f32x16 o[4];
#pragma unroll
    for (int d = 0; d < 4; ++d)
#pragma unroll
        for (int r = 0; r < 16; ++r) o[d][r] = 0.f;
    LAS float* al_l = (LAS float*)(lds + FOX_AL) + wid * 32; LAS float* li_l = (LAS float*)(lds + FOX_LI) + wid * 32;
    const int ntiles = qb * 4 + 4, mylast = qb * 4 + (wid >> 1);
#define FOX_DMA(kt) do { LAS unsigned char* sb_ = lds + ((kt) & 1) * FOX_STAGE; const size_t go_ = (size_t)(kt) * 64 * 2048; \
        _Pragma("unroll") for (int i = 0; i < 2; ++i) { \
            __builtin_amdgcn_global_load_lds((const unsigned*)(Kg + go_ + ksrc[i]), (LAS unsigned*)(sb_ + 16384 + (i * 512 + wid * 64) * 16), 16, 0, 0); \
            __builtin_amdgcn_global_load_lds((const unsigned*)(Vg + go_ + vsrc[i]), (LAS unsigned*)(sb_ + (i * 512 + wid * 64) * 16), 16, 0, 0); } \
        if (wid == 0) __builtin_amdgcn_global_load_lds((const unsigned*)(cum + (kt) * 64 + lane), (LAS unsigned*)(sb_ + 32768), 4, 0, 0); } while (0)
    __syncthreads();
    FOX_DMA(0);
    for (int kt = 0; kt < ntiles; ++kt) {
        asm volatile("s_waitcnt vmcnt(0)" ::: "memory");
        __syncthreads();
        if (kt + 1 < ntiles) FOX_DMA(kt + 1);
        if (kt <= mylast) {
            const LAS unsigned char* sb = lds + (kt & 1) * FOX_STAGE; const LAS float* ck = (const LAS float*)(sb + 32768);
            const int vb = (int)(uintptr_t)sb + v_rd_base(lane);
            f32x16 p0, p1;
#pragma unroll
            for (int r = 0; r < 16; ++r) { p0[r] = 0.f; p1[r] = 0.f; }
            int fsw = (r32 & 7) << 4; asm volatile("" : "+v"(fsw));
#pragma unroll
            for (int d0 = 0; d0 < 8; ++d0) { const int cb = (d0 * 16 + hi * 8) * 2;
                const bf16x8 b0 = *(const LAS bf16x8*)(sb + 16384 + r32 * 256 + (cb ^ fsw));
                const bf16x8 b1 = *(const LAS bf16x8*)(sb + 16384 + (32 + r32) * 256 + (cb ^ fsw));
                p0 = __builtin_amdgcn_mfma_f32_32x32x16_bf16(b0, qr[d0], p0, 0, 0, 0); p1 = __builtin_amdgcn_mfma_f32_32x32x16_bf16(b1, qr[d0], p1, 0, 0, 0); }
            const bool diag = (kt * 64 + 63 > qb * 256 + wid * 32);
            float pmax = -INFINITY;
#pragma unroll
            for (int g4 = 0; g4 < 4; ++g4) { const f32x4 c0 = *(const LAS f32x4*)(ck + 8 * g4 + 4 * hi), c1 = *(const LAS f32x4*)(ck + 32 + 8 * g4 + 4 * hi);
#pragma unroll
                for (int j = 0; j < 4; ++j) { const int r = g4 * 4 + j; float t0 = fmaf(p0[r], LOG2E, cq) - c0[j] * LOG2E, t1 = fmaf(p1[r], LOG2E, cq) - c1[j] * LOG2E;
                    if (diag) { const int kp = kt * 64 + crow(r, hi); if (kp > qpos) t0 = -INFINITY; if (kp + 32 > qpos) t1 = -INFINITY; }
                    p0[r] = t0; p1[r] = t1; pmax = fmaxf(pmax, fmaxf(t0, t1)); } }
            { auto rr = __builtin_amdgcn_permlane32_swap(__float_as_uint(pmax), __float_as_uint(pmax), false, false); pmax = fmaxf(__uint_as_float(rr[0]), __uint_as_float(rr[1])); }
            const float mn = fmaxf(m_reg, pmax); const float alpha = __builtin_amdgcn_exp2f(m_reg - mn); m_reg = mn;
            float ps = 0.f;
#pragma unroll
            for (int r = 0; r < 16; ++r) { p0[r] = __builtin_amdgcn_exp2f(p0[r] - mn); p1[r] = __builtin_amdgcn_exp2f(p1[r] - mn); ps += p0[r] + p1[r]; }
            { auto rr = __builtin_amdgcn_permlane32_swap(__float_as_uint(ps), __float_as_uint(ps), false, false); ps = __uint_as_float(rr[0]) + __uint_as_float(rr[1]); }
            l_reg = l_reg * alpha + ps;
            if (__any(alpha < 1.f)) { if (hi == 0) al_l[r32] = alpha; asm volatile("s_waitcnt lgkmcnt(0)" ::: "memory");
#pragma unroll
                for (int r = 0; r < 16; ++r) { const float a = al_l[crow(r, hi)];
#pragma unroll
                    for (int d = 0; d < 4; ++d) o[d][r] *= a; } }
            bf16x8 pa0, pa1, pa2, pa3; PK4(p0, 0, pa0); PK4(p0, 8, pa1); PK4(p1, 0, pa2); PK4(p1, 8, pa3);
            PvPairs<4, 0, 0>::run(o, vb, pa0, pa1); PvPairs<4, 2, 0>::run(o, vb, pa2, pa3);
        }
    }
#undef FOX_DMA
    if (hi == 0) li_l[r32] = l_reg; asm volatile("s_waitcnt lgkmcnt(0)" ::: "memory");
    bf16_t* O = (bf16_t*)(p.ws + WS_OB) + (size_t)(b * SEQ + qb * 256 + wid * 32) * 1024 + h * 128;
#pragma unroll
    for (int r = 0; r < 16; ++r) { const float rl = __builtin_amdgcn_rcpf(li_l[crow(r, hi)]); const int orow = crow(r, hi);
#pragma unroll
        for (int d0 = 0; d0 < 4; ++d0) O[(size_t)orow * 1024 + d0 * 32 + r32] = (bf16_t)(cvt_pk_bf16(o[d0][r] * rl, 0.f) & 0xffffu); }
}

constexpr int DSA_STAGE = 32768;
constexpr int DSA_AL = 2 * DSA_STAGE, DSA_LI = DSA_AL + 1024, DSA_Q = DSA_LI + 1024;
__device__ void dsa_item(const Params& p, LAS unsigned char* lds, int b, int qt) {
    int tid = threadIdx.x; asm volatile("" : "+v"(tid));
    const int wid = __builtin_amdgcn_readfirstlane(tid >> 6), lane = tid & 63, r32 = lane & 31, hi = lane >> 5, h = wid;
    const char* KV = (const char*)(p.ws + WS_KV) + (size_t)b * SEQ * 512;
    const int qpos = qt * 32 + r32; const size_t qg = (size_t)b * SEQ + qpos;
    const unsigned* mask = (const unsigned*)(p.ws + WS_MASK) + qg * 64;
    bf16x8 qr[8];
    LAS unsigned char* qlds = lds + DSA_Q + wid * 8192 + lane * 16;
    __syncthreads();
    { const bf16_t* qp = (const bf16_t*)(p.ws + WS_QLAT) + qg * 2048 + h * 256 + hi * 8;
#pragma unroll
      for (int d0 = 0; d0 < 8; ++d0) qr[d0] = *(const bf16x8*)(qp + d0 * 16);
#pragma unroll
      for (int d0 = 8; d0 < 16; ++d0) *(LAS bf16x8*)(qlds + (d0 - 8) * 1024) = *(const bf16x8*)(qp + d0 * 16); }
    unsigned ksrc[2], vsrc[2];
#pragma unroll
    for (int i = 0; i < 2; ++i) { const int pos = (i * 512 + tid) * 16;
        { const int row = pos >> 9; const int cb = (pos & 511) ^ ((row & 15) << 4); ksrc[i] = (unsigned)(row * 512 + cb); }
        { const int sub = pos >> 9, within = pos & 511; const int kk = (sub >> 3) * 8 + (within >> 6); const int c = (sub & 7) * 32 + ((within & 63) >> 1); vsrc[i] = (unsigned)(swap23(kk) * 512 + c * 2); } }
    const float slopeL = exp2f(-(float)(h + 1)) * LOG2E;
    float m_reg = -1e30f, l_reg = 0.f; f32x16 o[8];
#pragma unroll
    for (int d = 0; d < 8; ++d)
#pragma unroll
        for (int r = 0; r < 16; ++r) o[d][r] = 0.f;
    LAS float* al_l = (LAS float*)(lds + DSA_AL) + wid * 32; LAS float* li_l = (LAS float*)(lds + DSA_LI) + wid * 32;
    const int ntiles = ((qt >> 1) + 1) * 2;
#define DSA_DMA(kt) do { LAS unsigned char* sb_ = lds + ((kt) & 1) * DSA_STAGE; const size_t go_ = (size_t)(kt) * 32 * 512; \
        _Pragma("unroll") for (int i = 0; i < 2; ++i) { \
            __builtin_amdgcn_global_load_lds((const unsigned*)(KV + go_ + ksrc[i]), (LAS unsigned*)(sb_ + 16384 + (i * 512 + wid * 64) * 16), 16, 0, 0); \
            __builtin_amdgcn_global_load_lds((const unsigned*)(KV + go_ + vsrc[i]), (LAS unsigned*)(sb_ + (i * 512 + wid * 64) * 16), 16, 0, 0); } } while (0)
    unsigned mw = mask[0];
    DSA_DMA(0);
    for (int kt = 0; kt < ntiles; ++kt) {
        asm volatile("s_waitcnt vmcnt(0)" ::: "memory");
        __syncthreads();
        const unsigned mcur = mw;
        if (kt + 1 < ntiles) { mw = mask[kt + 1]; DSA_DMA(kt + 1); }
        const LAS unsigned char* sb = lds + (kt & 1) * DSA_STAGE; const int vb = (int)(uintptr_t)sb + v_rd_base(lane);
        f32x16 pp;
#pragma unroll
        for (int r = 0; r < 16; ++r) pp[r] = 0.f;
        {
            const LAS unsigned char* kb_ = sb + 16384 + r32 * 512; int sw_ = (r32 & 15) << 4; asm volatile("" : "+v"(sw_));
#define DSA_KF(d0) (*(const LAS bf16x8*)(kb_ + ((((d0) * 16 + hi * 8) * 2) ^ sw_)))
#define DSA_QF(d0) ((d0) < 8 ? qr[(d0) & 7] : *(const LAS bf16x8*)(qlds + (((d0) - 8) & 7) * 1024))
            bf16x8 k0 = DSA_KF(0), k1 = DSA_KF(1), q0 = DSA_QF(0), q1 = DSA_QF(1);
#pragma unroll
            for (int d0 = 0; d0 < 16; d0 += 2) {
                bf16x8 nk0 = k0, nk1 = k1, nq0 = q0, nq1 = q1;
                if (d0 + 2 < 16) { nk0 = DSA_KF(d0 + 2); nk1 = DSA_KF(d0 + 3); nq0 = DSA_QF(d0 + 2); nq1 = DSA_QF(d0 + 3); }
                pp = __builtin_amdgcn_mfma_f32_32x32x16_bf16(k0, q0, pp, 0, 0, 0); pp = __builtin_amdgcn_mfma_f32_32x32x16_bf16(k1, q1, pp, 0, 0, 0);
                k0 = nk0; k1 = nk1; q0 = nq0; q1 = nq1; SBAR();
            }
#undef DSA_KF
#undef DSA_QF
        }
        const unsigned wsh = mcur >> (4 * hi);
        const float df = (float)(qpos - (kt * 32 + 4 * hi));
        float pmax = -INFINITY;
#pragma unroll
        for (int r = 0; r < 16; ++r) { const int cb = (r & 3) + 8 * (r >> 2); const float dd = df - (float)cb;
            float t = fmaf(-slopeL, fabsf(dd), pp[r] * LOG2E); if (!((wsh >> cb) & 1u)) t = -INFINITY; pp[r] = t; pmax = fmaxf(pmax, t); }
        { auto rr = __builtin_amdgcn_permlane32_swap(__float_as_uint(pmax), __float_as_uint(pmax), false, false); pmax = fmaxf(__uint_as_float(rr[0]), __uint_as_float(rr[1])); }
        const float mn = fmaxf(m_reg, pmax); const float alpha = __builtin_amdgcn_exp2f(m_reg - mn); m_reg = mn;
        float ps = 0.f;
#pragma unroll
        for (int r = 0; r < 16; ++r) { pp[r] = __builtin_amdgcn_exp2f(pp[r] - mn); ps += pp[r]; }
        { auto rr = __builtin_amdgcn_permlane32_swap(__float_as_uint(ps), __float_as_uint(ps), false, false); ps = __uint_as_float(rr[0]) + __uint_as_float(rr[1]); }
        l_reg = l_reg * alpha + ps;
        if (__any(alpha < 1.f)) { if (hi == 0) al_l[r32] = alpha; asm volatile("s_waitcnt lgkmcnt(0)" ::: "memory");
#pragma unroll
            for (int r = 0; r < 16; ++r) { const float a = al_l[crow(r, hi)];
#pragma unroll
                for (int d = 0; d < 8; ++d) o[d][r] *= a; } }
        bf16x8 pa0, pa1; PK4(pp, 0, pa0); PK4(pp, 8, pa1);
        PvPairs<8, 0, 0>::run(o, vb, pa0, pa1);
    }
#undef DSA_DMA
    if (hi == 0) li_l[r32] = l_reg; asm volatile("s_waitcnt lgkmcnt(0)" ::: "memory");
    float rl[16];
#pragma unroll
    for (int r = 0; r < 16; ++r) rl[r] = __builtin_amdgcn_rcpf(li_l[crow(r, hi)]);
    __syncthreads();
    LAS bf16_t* os = (LAS bf16_t*)(lds + wid * 16896);
#pragma unroll
    for (int r = 0; r < 16; ++r)
#pragma unroll
        for (int d0 = 0; d0 < 8; ++d0) os[crow(r, hi) * 264 + d0 * 32 + r32] = (bf16_t)(cvt_pk_bf16(o[d0][r] * rl[r], 0.f) & 0xffffu);
    asm volatile("s_waitcnt lgkmcnt(0)" ::: "memory");
    f32x16 ya[4];
#pragma unroll
    for (int nb = 0; nb < 4; ++nb)
#pragma unroll
        for (int r = 0; r < 16; ++r) ya[nb][r] = 0.f;
    const bf16_t* wv = (const bf16_t*)(p.ws + WS_WUV) + (size_t)(h * 128 + r32) * 256 + hi * 8;
#pragma unroll 4
    for (int ks = 0; ks < 16; ++ks) {
        const bf16x8 af = *(const LAS bf16x8*)(os + r32 * 264 + ks * 16 + hi * 8);
#pragma unroll
        for (int nb = 0; nb < 4; ++nb) { const bf16x8 wf = *(const bf16x8*)(wv + (size_t)nb * 32 * 256 + ks * 16); ya[nb] = __builtin_amdgcn_mfma_f32_32x32x16_bf16(wf, af, ya[nb], 0, 0, 0); }
    }
    bf16_t* O = (bf16_t*)(p.ws + WS_OA) + ((size_t)b * SEQ + qt * 32 + r32) * 1024 + h * 128 + 4 * hi;
#pragma unroll
    for (int nb = 0; nb < 4; ++nb)
#pragma unroll
        for (int g4 = 0; g4 < 4; ++g4) { u32x2 pk; pk.x = cvt_pk_bf16(ya[nb][g4 * 4], ya[nb][g4 * 4 + 1]); pk.y = cvt_pk_bf16(ya[nb][g4 * 4 + 2], ya[nb][g4 * 4 + 3]); *(u32x2*)(O + nb * 32 + g4 * 8) = pk; }
}
__device__ void ph4_attn(const Params& p, LAS unsigned char* lds) {
    const int r = blockIdx.x;
    if (r < 256) { const int c = 31 - (r >> 3), w8 = r & 7, b = w8 >> 1, half = w8 & 1; dsa_item(p, lds, b, c * 2 + half); }
    int* qhead = (int*)(p.ws + WS_CNT) + 512;
    LAS int* slot = (LAS int*)(lds + LDS_BARW - 16);
    for (;;) {
        __syncthreads();
        if (threadIdx.x == 0) *slot = atomicAdd(qhead, 1);
        __syncthreads();
        const int it = __builtin_amdgcn_readfirstlane(*slot);
        if (it >= 256) break;
        const int qb = 7 - (it >> 5), bh = it & 31;
        fox_item(p, lds, bh >> 3, bh & 7, qb);
    }
}

__device__ void ph5_oa(const Params& p) {
    const int lane = threadIdx.x & 63, gw = blockIdx.x * 8 + (threadIdx.x >> 6), nw = gridDim.x * 8, fr = lane & 15, fq = lane >> 4;
    for (int it = gw; it < 2048; it += nw) {
        const int rt = it >> 3, h = it & 7;
        f32x4 acc[2][8];
        wave_gemm<2, 8, 8>((const bf16_t*)(p.ws + WS_OLAT) + (size_t)rt * 32 * 2048 + h * 256, 2048, (const bf16_t*)(p.ws + WS_WUV) + (size_t)h * 128 * 256, 256, acc, lane);
#pragma unroll
        for (int mb = 0; mb < 2; ++mb) { bf16_t* o = (bf16_t*)(p.ws + WS_OA) + (size_t)(rt * 32 + mb * 16 + fr) * 1024 + h * 128;
#pragma unroll
            for (int nb = 0; nb < 8; ++nb) { u32x2 w; w.x = cvt_pk_bf16(acc[mb][nb][0], acc[mb][nb][1]); w.y = cvt_pk_bf16(acc[mb][nb][2], acc[mb][nb][3]); *(u32x2*)(o + nb * 16 + fq * 4) = w; } }
    }
}

__device__ void ph8_router(const Params& p, LAS unsigned char* lds, const int rep) {
    const int tid = threadIdx.x, wid = tid >> 6, lane = tid & 63, fr = lane & 15, fq = lane >> 4;
    const float* mod = (const float*)(p.ws + WS_MOD);
    bf16_t* H = (bf16_t*)(p.ws + WS_H); bf16_t* HL = (bf16_t*)(p.ws + WS_HLO);
    int* cnt = (int*)(p.ws + WS_CNT) + rep * 256; int* ltok = rep ? (int*)(p.ws + WS_T1) : (int*)(p.ws + WS_LTOK); float* lw = rep ? (float*)(p.ws + WS_T1 + (4u << 20)) : (float*)(p.ws + WS_LW);
    LAS float* slab = (LAS float*)lds + wid * 2560;
    LAS float* lg = (LAS float*)lds + 8 * 2560;
    for (int blk = blockIdx.x; blk < NTOK / 32; blk += gridDim.x) {
        const int t0 = blk * 32;
        {
            const int tb = t0 + wid * 4, b = tb >> 11;
            const float* sh = mod + b * 12288 + 6144; const float* sc = mod + b * 12288 + 8192;
            f32x4 xv[4][8];
#pragma unroll
            for (int rr = 0; rr < 4; ++rr)
#pragma unroll
                for (int i = 0; i < 8; ++i) { const size_t eo = (size_t)(tb + rr) * DM + i * 256 + lane * 4; const u32x2 yb = *(const u32x2*)((const bf16_t*)(p.ws + WS_MERGED) + eo);
                    xv[rr][i] = *(const f32x4*)(p.in[I_X] + eo) + (f32x4){bf_lo(yb.x), bf_hi(yb.x), bf_lo(yb.y), bf_hi(yb.y)}; }
#pragma unroll
            for (int rr = 0; rr < 4; ++rr) {
                float ss = 0.f;
#pragma unroll
                for (int i = 0; i < 8; ++i) ss += xv[rr][i][0] * xv[rr][i][0] + xv[rr][i][1] * xv[rr][i][1] + xv[rr][i][2] * xv[rr][i][2] + xv[rr][i][3] * xv[rr][i][3];
                ss = wave_sum(ss);
                const float rstd = rsqrtf(ss * (1.0f / 2048.0f) + RMS_EPS);
#pragma unroll
                for (int i = 0; i < 8; ++i) { const int col = i * 256 + lane * 4; const f32x4 gg = *(const f32x4*)(p.in[I_GFFN] + col), s1 = *(const f32x4*)(sc + col), s0 = *(const f32x4*)(sh + col);
                    float hv[4], lo[4];
#pragma unroll
                    for (int j = 0; j < 4; ++j) hv[j] = xv[rr][i][j] * rstd * gg[j] * (1.0f + s1[j]) + s0[j];
                    u32x2 wh; wh.x = cvt_pk_bf16(hv[0], hv[1]); wh.y = cvt_pk_bf16(hv[2], hv[3]);
                    lo[0] = hv[0] - bf_lo(wh.x); lo[1] = hv[1] - bf_hi(wh.x); lo[2] = hv[2] - bf_lo(wh.y); lo[3] = hv[3] - bf_hi(wh.y);
                    u32x2 wl; wl.x = cvt_pk_bf16(lo[0], lo[1]); wl.y = cvt_pk_bf16(lo[2], lo[3]);
                    *(u32x2*)(H + (size_t)(tb + rr) * DM + col) = wh; *(u32x2*)(HL + (size_t)(tb + rr) * DM + col) = wl;
                    *(unsigned*)(p.ws + WS_H8 + (size_t)(tb + rr) * DM + col) = pack_fp8x4(hv[0], hv[1], hv[2], hv[3]); }
            }
        }
        asm volatile("s_waitcnt vmcnt(0)" ::: "memory");
        __syncthreads();
        {
            const bf16_t* Ah = H + (size_t)(t0 + fr) * DM + wid * 256 + fq * 8; const bf16_t* Al = HL + (size_t)(t0 + fr) * DM + wid * 256 + fq * 8;
            const bf16_t* Wh = (const bf16_t*)(p.ws + WS_WRH) + (size_t)fr * DM + wid * 256 + fq * 8; const bf16_t* Wl = (const bf16_t*)(p.ws + WS_WRL) + (size_t)fr * DM + wid * 256 + fq * 8;
            f32x4 acc[2][5];
#pragma unroll
            for (int mb = 0; mb < 2; ++mb)
#pragma unroll
                for (int nb = 0; nb < 5; ++nb) acc[mb][nb] = (f32x4){0.f, 0.f, 0.f, 0.f};
#pragma unroll 4
            for (int ks = 0; ks < 8; ++ks) {
                bf16x8 ah[2], al[2];
#pragma unroll
                for (int mb = 0; mb < 2; ++mb) { ah[mb] = *(const bf16x8*)(Ah + (size_t)mb * 16 * DM + ks * 32); al[mb] = *(const bf16x8*)(Al + (size_t)mb * 16 * DM + ks * 32); }
#pragma unroll
                for (int nb = 0; nb < 5; ++nb) { const bf16x8 wh = *(const bf16x8*)(Wh + (size_t)nb * 16 * DM + ks * 32), wl = *(const bf16x8*)(Wl + (size_t)nb * 16 * DM + ks * 32);
#pragma unroll
                    for (int mb = 0; mb < 2; ++mb) {
                        acc[mb][nb] = __builtin_amdgcn_mfma_f32_16x16x32_bf16(wh, ah[mb], acc[mb][nb], 0, 0, 0);
                        acc[mb][nb] = __builtin_amdgcn_mfma_f32_16x16x32_bf16(wl, ah[mb], acc[mb][nb], 0, 0, 0);
                        acc[mb][nb] = __builtin_amdgcn_mfma_f32_16x16x32_bf16(wh, al[mb], acc[mb][nb], 0, 0, 0); } }
            }
#pragma unroll
            for (int mb = 0; mb < 2; ++mb)
#pragma unroll
                for (int nb = 0; nb < 5; ++nb) *(LAS f32x4*)(slab + (mb * 16 + fr) * 80 + nb * 16 + fq * 4) = acc[mb][nb];
        }
        __syncthreads();
        for (int o = tid; o < 2560; o += NTHREADS) { float s = 0.f;
#pragma unroll
            for (int w8 = 0; w8 < 8; ++w8) s += ((LAS float*)lds)[w8 * 2560 + o];
            lg[o] = s; }
        __syncthreads();
        if (tid < 32) {
            const int t = t0 + tid; const LAS float* L = lg + tid * 80;
            float gl[8]; int gi = 0; float gm = -INFINITY;
#pragma unroll
            for (int g = 0; g < 8; ++g) { gl[g] = L[g] + p.in[I_BRG][g]; if (gl[g] > gm) { gm = gl[g]; gi = g; } }
            float se = 0.f;
#pragma unroll
            for (int g = 0; g < 8; ++g) se += __expf(gl[g] - gm);
            const float gwt = 1.0f / se;
            float v1 = -INFINITY, v2 = -INFINITY; int i1 = 0, i2 = 0;
            for (int e = 0; e < 8; ++e) { const float v = L[8 + gi * 8 + e] + p.in[I_BRE][gi * 8 + e];
                if (v > v1) { v2 = v1; i2 = i1; v1 = v; i1 = e; } else if (v > v2) { v2 = v; i2 = e; } }
            const float e2 = __expf(v2 - v1); const float p1 = gwt / (1.0f + e2), p2 = gwt * e2 / (1.0f + e2);
            const int ea = gi * 8 + i1, eb = gi * 8 + i2;
            const int pa = atomicAdd(cnt + ea, 1); const int pb = atomicAdd(cnt + eb, 1);
            ltok[ea * LCAP + pa] = t; lw[ea * LCAP + pa] = p1;
            ltok[eb * LCAP + pb] = t | 0x10000; lw[eb * LCAP + pb] = p2;
        }
        __syncthreads();
    }
}

__device__ __forceinline__ void moe_table(const Params& p, LAS unsigned char* lds) {
    LAS int* pre = (LAS int*)(lds + LDS_TAB);
    if (threadIdx.x == 0) { const int* cnt = (const int*)(p.ws + WS_CNT); int s = 0; for (int e = 0; e < 64; ++e) { const int ce = cnt[e]; pre[e] = s; pre[80 + e] = ce; s += (ce + 255) >> 8; } pre[64] = s; }
    __syncthreads();
}
__device__ void ph9_gather(const Params& p, LAS unsigned char* lds) {
    moe_table(p, lds);
    const LAS int* pre = (const LAS int*)(lds + LDS_TAB); const LAS int* cnt = pre + 80; const int* ltok = (const int*)(p.ws + WS_LTOK);
    const int lane = threadIdx.x & 63, gw = blockIdx.x * 8 + (threadIdx.x >> 6), nw = gridDim.x * 8, nrows = pre[64] * 256;
    const bf16_t* H = (const bf16_t*)(p.ws + WS_H); bf16_t* HG = (bf16_t*)(p.ws + WS_HG);
    for (int r = gw; r < nrows; r += nw) {
        const int mt = r >> 8; int e = 0;
#pragma unroll 1
        for (int s = 32; s >= 1; s >>= 1) if (pre[e + s] <= mt) e += s;
        const int pos = (mt - pre[e]) * 256 + (r & 255);
        u32x4 v[4];
        if (pos < cnt[e]) { const int tok = ltok[e * LCAP + pos];
#pragma unroll
            for (int i = 0; i < 4; ++i) v[i] = *(const u32x4*)(H + (size_t)tok * DM + i * 512 + lane * 8); }
        else {
#pragma unroll
            for (int i = 0; i < 4; ++i) v[i] = (u32x4){0u, 0u, 0u, 0u}; }
#pragma unroll
        for (int i = 0; i < 4; ++i) *(u32x4*)(HG + (size_t)r * DM + i * 512 + lane * 8) = v[i];
    }
}


#define MOE_GLOAD(dst, ptr) asm volatile("global_load_dwordx4 %0, %1, off nt" : "=v"(dst) : "v"(ptr) : "memory")
template <bool UP>
__device__ void moe_gemm(const Params& p, LAS unsigned char* lds, const int rep) {
    constexpr int K = UP ? 2048 : 512, NKT = K / 32, NS = UP ? 8 : 16, LDW = UP ? 512 : 2048;
    constexpr int NSTA = 3, OFF_A = 0, OFF_B = NSTA * 16384;
    int tid = threadIdx.x; asm volatile("" : "+v"(tid));
    const int w = __builtin_amdgcn_readfirstlane(tid >> 6), l = tid & 63, r32 = l & 31, hi = l >> 5;
    LAS int* tab = (LAS int*)(lds + LDS_TAB);
    if (tid == 0) { const int* cnt = (const int*)(p.ws + WS_CNT); int s = 0, ro = 0; for (int e = 0; e < 64; ++e) { const int ce = cnt[e]; tab[e] = s; tab[80 + e] = ce; tab[160 + e] = ro; ro += ce; const int np = (ce + 511) >> 9; s += np > 0 ? np : 1; } tab[64] = s; }
    __syncthreads();
    const int total = __builtin_amdgcn_readfirstlane(tab[64]) * NS;
    const int q = (w & 3) * 8 + (l & 7), g = (w >> 2) * 8 + (l >> 3);
    const unsigned bwoff = (unsigned)(q * 256 + (((g >> 2) ^ (q & 3)) * 16) + (g & 3) * 4);
    const unsigned frag_sw = (unsigned)((r32 >> 2) & 3);
    const int* ltok = (const int*)(p.ws + WS_LTOK); const float* lw = (const float*)(p.ws + WS_LW);
    for (int unit = blockIdx.x; unit < total; unit += gridDim.x) {
        const int pm = unit / NS, ns = unit - pm * NS; int e = 0;
#pragma unroll 1
        for (int s = 32; s >= 1; s >>= 1) if (__builtin_amdgcn_readfirstlane(tab[e + s]) <= pm) e += s;
        const int mp = pm - __builtin_amdgcn_readfirstlane(tab[e]); const int cnt_e = __builtin_amdgcn_readfirstlane(tab[80 + e]), rowoff = __builtin_amdgcn_readfirstlane(tab[160 + e]);
        int nrows = cnt_e - mp * 512; nrows = nrows > 512 ? 512 : nrows; const bool two = nrows > 256;
        const char* abase = UP ? (const char*)(p.ws + WS_H8) : (const char*)(p.ws + WS_ACT8);
        unsigned aoff[2];
#pragma unroll
        for (int i = 0; i < 2; ++i) { const int row = (i * 8 + w) * 32 + (l >> 1); const int hs = (l & 1) ^ ((l >> 4) & 1);
            int src; if (UP) src = row < nrows ? (ltok[e * LCAP + mp * 512 + row] & 0xffff) : 0; else src = rowoff + mp * 512 + (row < nrows ? row : 0);
            aoff[i] = (unsigned)(src * K + hs * 16); }
        const float* bsrc = UP ? (q < 16 ? p.in[I_W1] : p.in[I_W3]) + (size_t)e * 2048 * 512 + ns * 64 + (q & 15) * 4 + (size_t)(2 * g) * LDW
                               : p.in[I_W2] + (size_t)e * 512 * 2048 + ns * 128 + q * 4 + (size_t)(2 * g) * LDW;
        f32x16 acc[2][4];
#pragma unroll
        for (int a = 0; a < 2; ++a)
#pragma unroll
            for (int b = 0; b < 4; ++b)
#pragma unroll
                for (int r = 0; r < 16; ++r) acc[a][b][r] = 0.f;
        f32x4 br[2][2];
#define MOE_ISSUE_B(j, t) do { const int tt_ = (t) < NKT ? (t) : NKT - 1; const float* bp_ = bsrc + (size_t)tt_ * 32 * LDW; MOE_GLOAD(br[j][0], bp_); MOE_GLOAD(br[j][1], bp_ + LDW); } while (0)
#define MOE_ISSUE_A(t, TWO) do { int tt_ = (t) < 0 ? 0 : (t); const int bi_ = (tt_ % NSTA); tt_ = tt_ < NKT ? tt_ : NKT - 1; const char* ap_ = abase + (size_t)tt_ * 32; \
        LAS unsigned char* ab_ = lds + OFF_A + bi_ * 16384 + w * 1024; \
        __builtin_amdgcn_global_load_lds((const unsigned*)(ap_ + aoff[0]), (LAS unsigned*)(ab_), 16, 0, 0); \
        if (TWO) __builtin_amdgcn_global_load_lds((const unsigned*)(ap_ + aoff[1]), (LAS unsigned*)(ab_ + 8192), 16, 0, 0); } while (0)
        const bool two_w = (256 + 32 * w) < nrows;
#define MOE_FRAGS(ks, TWO) do { const unsigned co_ = ((unsigned)((ks) * 2 + hi) ^ frag_sw) * 16u; \
            _Pragma("unroll") for (int nb = 0; nb < 4; ++nb) bf_[nb] = *(const LAS bf16x8*)(bb_ + nb * 2048 + co_); \
            { const unsigned ao_ = ((unsigned)(ks) ^ ((unsigned)(r32 >> 3) & 1u)) * 16u + (unsigned)hi * 8u; a0_ = fp8x8_to_bf16(*(const LAS u32x2*)(ab_ + ao_)); if (TWO) a1_ = fp8x8_to_bf16(*(const LAS u32x2*)(ab_ + 8192 + ao_)); } } while (0)
#define MOE_MMAS(TWO) do { \
            _Pragma("unroll") for (int nb = 0; nb < 4; ++nb) acc[0][nb] = __builtin_amdgcn_mfma_f32_32x32x16_bf16(bf_[nb], a0_, acc[0][nb], 0, 0, 0); \
            if (TWO) { _Pragma("unroll") for (int nb = 0; nb < 4; ++nb) acc[1][nb] = __builtin_amdgcn_mfma_f32_32x32x16_bf16(bf_[nb], a1_, acc[1][nb], 0, 0, 0); } } while (0)
#define MOE_ITER(jn, t, COMPUTE, TWO, WB, WA) do { \
        bf16x8 bf_[4], a0_, a1_; \
        const LAS unsigned char* ab_ = lds + OFF_A + (((t) + 3) % 3) * 16384 + w * 1024 + r32 * 32; const LAS unsigned char* bb_ = lds + OFF_B + ((t) & 1) * 8192 + r32 * 64; \
        if (COMPUTE) { MOE_FRAGS(0, TWO); } SBAR(); \
        asm volatile("s_waitcnt vmcnt(" WB ")" : "+v"(br[jn][0]), "+v"(br[jn][1]) :: "memory"); \
        { LAS unsigned char* bw_ = lds + OFF_B + (((t) + 1) & 1) * 8192 + bwoff; _Pragma("unroll") for (int jj = 0; jj < 4; ++jj) *(LAS unsigned*)(bw_ + jj * 64) = cvt_pk_bf16(br[jn][0][jj], br[jn][1][jj]); } \
        MOE_ISSUE_B(jn, (t) + 3); SBAR(); \
        if (COMPUTE) { MOE_MMAS(TWO); SBAR(); MOE_FRAGS(1, TWO); MOE_MMAS(TWO); } SBAR(); \
        asm volatile("s_waitcnt vmcnt(" WA ")" ::: "memory"); \
        asm volatile("s_waitcnt lgkmcnt(0)" ::: "memory"); __builtin_amdgcn_s_barrier(); asm volatile("" ::: "memory"); \
        MOE_ISSUE_A((t) + 3, TWO); \
        } while (0)
#define MOE_PIPE(TWO, WB, WA) do { \
        MOE_ISSUE_B(0, 0); MOE_ISSUE_A(0, TWO); MOE_ISSUE_B(1, 1); MOE_ISSUE_A(1, TWO); \
        MOE_ITER(0, -1, false, TWO, WB, WA); \
        _Pragma("unroll 1") for (int t = 0; t < NKT; t += 2) { MOE_ITER(1, t, true, TWO, WB, WA); MOE_ITER(0, t + 1, true, TWO, WB, WA); } \
          \
        asm volatile("s_waitcnt vmcnt(0)" : "+v"(br[0][0]), "+v"(br[0][1]), "+v"(br[1][0]), "+v"(br[1][1]) :: "memory"); \
        } while (0)
        if (two_w) MOE_PIPE(true, "6", "6"); else MOE_PIPE(false, "4", "5");
        asm volatile("s_waitcnt vmcnt(0)" ::: "memory");
        if constexpr (UP) {
#pragma unroll
            for (int mt = 0; mt < 2; ++mt) {
                const int rl = mt * 256 + 32 * w + r32;
                if (rl < nrows) {
                    const float gw = lw[e * LCAP + mp * 512 + rl] * 16.0f; unsigned char* orow = (unsigned char*)(p.ws + (rep ? WS_QLAT : WS_ACT8)) + (size_t)(rowoff + mp * 512 + rl) * 512 + ns * 64 + 4 * hi;
#pragma unroll
                    for (int nb = 0; nb < 2; ++nb)
#pragma unroll
                        for (int g4 = 0; g4 < 4; ++g4) { float o[4];
#pragma unroll
                            for (int j = 0; j < 4; ++j) { const float a = acc[mt][nb][g4 * 4 + j], u = acc[mt][nb + 2][g4 * 4 + j]; o[j] = a * sigmoidf_(a) * u * gw; }
                            *(unsigned*)(orow + nb * 32 + g4 * 8) = pack_fp8x4(o[0], o[1], o[2], o[3]); }
                }
            }
        } else {
#pragma unroll
            for (int mt = 0; mt < 2; ++mt) {
                const int rl = mt * 256 + 32 * w + r32;
                if (rl < nrows) {
                    const int ent = ltok[e * LCAP + mp * 512 + rl]; bf16_t* orow = (bf16_t*)(p.ws + WS_YS) + ((size_t)(ent >> 16) * NTOK + (ent & 0xffff)) * 2048 + ns * 128 + 4 * hi;
#pragma unroll
                    for (int nb = 0; nb < 4; ++nb)
#pragma unroll
                        for (int g4 = 0; g4 < 4; ++g4) { u32x2 pk; pk.x = cvt_pk_bf16(acc[mt][nb][g4 * 4] * 0.0625f, acc[mt][nb][g4 * 4 + 1] * 0.0625f); pk.y = cvt_pk_bf16(acc[mt][nb][g4 * 4 + 2] * 0.0625f, acc[mt][nb][g4 * 4 + 3] * 0.0625f); *(u32x2*)(orow + nb * 32 + g4 * 8) = pk; }
                }
            }
        }
        asm volatile("s_waitcnt vmcnt(0)" ::: "memory");
        __syncthreads();
    }
#undef MOE_ISSUE_A
#undef MOE_ISSUE_B
#undef MOE_ITER
#undef MOE_FRAGS
#undef MOE_MMAS
#undef MOE_PIPE
}


__device__ void ph11_combine(const Params& p) {
    const bf16_t* Y0 = (const bf16_t*)(p.ws + WS_YS); const bf16_t* Y1 = Y0 + (size_t)NTOK * 2048; const bf16_t* YM = (const bf16_t*)(p.ws + WS_MERGED); const float* mod = (const float*)(p.ws + WS_MOD);
    const size_t n8 = (size_t)NTOK * 2048 / 8;
    for (size_t i = (size_t)blockIdx.x * NTHREADS + threadIdx.x; i < n8; i += (size_t)gridDim.x * NTHREADS) {
        const size_t e0 = i * 8; const int col = (int)(e0 & 2047), b = (int)(e0 >> 22);
        const u32x4 a = *(const u32x4*)(Y0 + e0), c = *(const u32x4*)(Y1 + e0), m = *(const u32x4*)(YM + e0);
        const float* gt = mod + (size_t)b * 12288 + 10240 + col; const f32x4 g0 = *(const f32x4*)gt, g1 = *(const f32x4*)(gt + 4);
        const float* px = p.in[I_X] + e0; f32x4 o0 = *(const f32x4*)px, o1 = *(const f32x4*)(px + 4);
        o0[0] += bf_lo(m.x) + g0[0] * (bf_lo(a.x) + bf_lo(c.x)); o0[1] += bf_hi(m.x) + g0[1] * (bf_hi(a.x) + bf_hi(c.x)); o0[2] += bf_lo(m.y) + g0[2] * (bf_lo(a.y) + bf_lo(c.y)); o0[3] += bf_hi(m.y) + g0[3] * (bf_hi(a.y) + bf_hi(c.y));
        o1[0] += bf_lo(m.z) + g1[0] * (bf_lo(a.z) + bf_lo(c.z)); o1[1] += bf_hi(m.z) + g1[1] * (bf_hi(a.z) + bf_hi(c.z)); o1[2] += bf_lo(m.w) + g1[2] * (bf_lo(a.w) + bf_lo(c.w)); o1[3] += bf_hi(m.w) + g1[3] * (bf_hi(a.w) + bf_hi(c.w));
        float* po = p.out + e0; *(f32x4*)po = o0; *(f32x4*)(po + 4) = o1;
    }
}

__global__ void __launch_bounds__(NTHREADS, 2) mk_fwd(Params p) {
    extern __shared__ __attribute__((aligned(16))) unsigned char shm[];
    LAS unsigned char* lds = (LAS unsigned char*)shm;
    const int lo = p.ph_lo, hi = p.ph_hi;
    if (threadIdx.x < 4) ((LAS unsigned*)(lds + LDS_BARW))[threadIdx.x] = 0u;
    __syncthreads();
    XcdBarrier bar; bar.bar = (unsigned*)(p.ws + WS_BAR); bar.x = 0; bar.st = nullptr;
    if (hi - lo > 1) bar = xcd_barrier_post((unsigned*)(p.ws + WS_BAR), (volatile LAS unsigned*)(lds + LDS_BARW));
#ifndef SKIP_MASK
#define SKIP_MASK 0
#endif
#define IN(k) (!((SKIP_MASK >> (k)) & 1) && lo <= (k) && (k) < hi)
#define SEAM(k) do { if (IN(k) && IN((k) + 1)) xcd_barrier(bar); } while (0)
    const int G = gridDim.x, bx = blockIdx.x;
#ifndef REP_PHASE
#define REP_PHASE 0
#endif
#define RUN(k, ...) do { if (IN(k)) { { const int rep = 0; (void)rep; __VA_ARGS__ } if ((REP_PHASE >> (k)) & 1) { xcd_barrier(bar); { const int rep = 1; (void)rep; __VA_ARGS__ } } } SEAM(k); } while (0)
    RUN(0, ph0_prologue(p, lds););
    RUN(1, ph1_norm(p););
    RUN(2, EpiProj E{p.ws, p.in[I_BGATE]};
           { ProjOrder S; S.S.init(p.ws + WS_H, p.ws + WS_WIN + (size_t)2 * 256 * DM * 2, NTOK, 8 * 256, DM * 2, G, bx); S.fp8 = 0; S.Bfull = nullptr;
             pg8::gemm_phase<EpiProj, ProjOrder, false, false>(lds, DM * 2, S, E); }
           { ProjOrder S; S.S.init(p.ws + WS_HF8, p.ws + WS_WIN8, NTOK, 30 * 256, DM, G, (G - 1) - bx); S.fp8 = 1; S.Bfull = nullptr;
             pg8::gemm_phase<EpiProj, ProjOrder, false, true>(lds, DM, S, E, 0x79797979); });
    RUN(3, ph3_prep(p, lds, rep););
    RUN(4, ph4_attn(p, lds););
    RUN(5, DualOrder S; S.S0.init(p.ws + WS_OA, p.ws + WS_WPA, NTOK, DM, 2048, G, bx); S.S1.init(p.ws + WS_OB, p.ws + WS_WPB, NTOK, DM, 2048, G, bx);
           EpiGate12 E{EpiGate1{(const bf16_t*)(p.ws + WS_GATES), (float*)(p.ws + WS_T1)}, EpiGate2{(const bf16_t*)(p.ws + WS_GATES), (const float*)(p.ws + WS_T1), (bf16_t*)(p.ws + WS_MRG8)}};
           pg8::gemm_phase<EpiGate12, DualOrder, false>(lds, 2048, S, E););
    RUN(6, pg8::StaticOrder S; S.init(p.ws + WS_MRG8, p.ws + WS_WO8, NTOK, DM, DM, G, bx); EpiWo E{(const float*)(p.ws + WS_MOD), (bf16_t*)(p.ws + WS_MERGED)};
           pg8::gemm_phase<EpiWo, pg8::StaticOrder, false, true>(lds, DM, S, E, 0x79797979, 0x7d7d7d7d););
    RUN(7, ph8_router(p, lds, rep););
    RUN(8, moe_gemm<true>(p, lds, rep););
    RUN(9, moe_gemm<false>(p, lds, rep););
    RUN(10, if (!rep) ph11_combine(p););
#undef RUN
#undef IN
#undef SEAM
}

constexpr int NPHASES = 11;
extern "C" void kernel_launch(void* const* d_in, const int* in_sizes, int n_in, void* d_out, int out_size, void* d_ws, size_t ws_size, hipStream_t stream) {
    static int grid = 0;
    if (grid == 0) {
        if (n_in != 25 || in_sizes[0] != NTOK * DM || out_size != NTOK * DM || ws_size < WS_END5) {
            fprintf(stderr, "kernel_launch: shape mismatch: n_in %d in0 %d out %d ws %zu (need %zu)\n", n_in, n_in > 0 ? in_sizes[0] : -1, out_size, ws_size, (size_t)WS_END5); grid = -1; return; }
        int dev = 0, cus = 0, per_cu = 0;
        if (hipGetDevice(&dev) != hipSuccess || hipDeviceGetAttribute(&cus, hipDeviceAttributeMultiprocessorCount, dev) != hipSuccess) { fprintf(stderr, "kernel_launch: device query failed\n"); grid = -1; return; }
        if (hipFuncSetAttribute((const void*)mk_fwd, hipFuncAttributeMaxDynamicSharedMemorySize, LDS_BYTES) != hipSuccess) { fprintf(stderr, "kernel_launch: hipFuncSetAttribute failed\n"); grid = -1; return; }
        if (hipOccupancyMaxActiveBlocksPerMultiprocessor(&per_cu, (const void*)mk_fwd, NTHREADS, LDS_BYTES) != hipSuccess || per_cu < 1) { fprintf(stderr, "kernel_launch: occupancy query says %d blocks per CU\n", per_cu); }
        (void)hipGetLastError();
        grid = cus;
    }
    if (grid < 0) return;
    if (hipMemsetAsync((char*)d_ws + WS_BAR, 0, WS_ZERO_BYTES, stream) != hipSuccess) { fprintf(stderr, "kernel_launch: memset failed\n"); return; }
    Params p; memset(&p, 0, sizeof(p));
    for (int i = 0; i < 25; ++i) p.in[i] = (const float*)d_in[i];
    p.out = (float*)d_out; p.ws = (unsigned char*)d_ws;
    unsigned char* ws = (unsigned char*)d_ws;
    auto job = [&](int j, const float* src, size_t dst_off, int K, int N, int ldd, int map, int nbatch, long sbatch, long dbatch) {
        TJob& J = p.jobs[j]; J.src = src; J.dst = (bf16_t*)(ws + dst_off); J.K = K; J.N = N; J.ldd = ldd; J.map = map; J.ntk = K / 64; J.ntn = (N + 127) / 128; J.nbatch = nbatch; J.sbatch = sbatch; J.dbatch = dbatch; J.ld = N; J.fp8 = 0; };
    job(0, p.in[I_WIN], WS_WIN, 2048, DIN, 2048, 1, 1, 0, 0);
    job(1, p.in[I_WPA], WS_WPA, 1024, 2048, 1024, 0, 1, 0, 0);
    job(2, p.in[I_WPB], WS_WPB, 1024, 2048, 1024, 0, 1, 0, 0);
    job(3, p.in[I_WO], WS_WO, 2048, 2048, 2048, 0, 1, 0, 0);
    job(4, p.in[I_WUK], WS_WUK, 128, 256, 128, 0, 8, 128L * 256, 256L * 128);
    job(5, p.in[I_WUV], WS_WUV, 256, 128, 256, 0, 8, 256L * 128, 128L * 256);
    job(6, p.in[I_WIN], WS_WIN8, 2048, 512, 2048, 0, 1, 0, 0); job(7, p.in[I_WIN] + 2384, WS_WIN8 + (size_t)512 * 2048, 2048, 3072, 2048, 0, 1, 0, 0); job(8, p.in[I_WIN] + 5464, WS_WIN8 + (size_t)3584 * 2048, 2048, 4096, 2048, 0, 1, 0, 0);
    for (int j = 6; j < 9; ++j) { p.jobs[j].ld = DIN; p.jobs[j].fp8 = 1; }
    job(9, p.in[I_WO], WS_WO8, 2048, 2048, 2048, 0, 1, 0, 0); p.jobs[9].fp8 = 1;
    int t0 = 0; for (int j = 0; j < NJOBS; ++j) { p.jobs[j].tile0 = t0; t0 += p.jobs[j].ntk * p.jobs[j].ntn * p.jobs[j].nbatch; }
    p.ntiles_total = t0;
#if MK_LAUNCHES == 1
    p.ph_lo = 0; p.ph_hi = NPHASES;
    hipLaunchKernelGGL(mk_fwd, dim3(grid), dim3(NTHREADS), LDS_BYTES, stream, p);
#else
    for (int k = 0; k < NPHASES; ++k) { p.ph_lo = k; p.ph_hi = k + 1; hipLaunchKernelGGL(mk_fwd, dim3(grid), dim3(NTHREADS), LDS_BYTES, stream, p); }
#endif
    const hipError_t le = hipPeekAtLastError();
    if (le != hipSuccess) fprintf(stderr, "kernel_launch: launch failed: %s\n", hipGetErrorName(le));
}

#ifdef DIAG_PHASES
template <int PH> __global__ void __launch_bounds__(NTHREADS, 2) k_ph(Params p) {
    extern __shared__ __attribute__((aligned(16))) unsigned char shm[];
    LAS unsigned char* lds = (LAS unsigned char*)shm; const int G = gridDim.x, bx = blockIdx.x;
    if constexpr (PH == 0) { EpiProj E{p.ws, p.in[I_BGATE]}; ProjOrder S; S.S.init(p.ws + WS_HF8, p.ws + WS_WIN8, NTOK, 24 * 256, DM, G, (G - 1) - bx); S.fp8 = 1; S.Bfull = nullptr;
             pg8::gemm_phase<EpiProj, ProjOrder, false, true>(lds, DM, S, E, 0x79797979); }
    if constexpr (PH == 1) { EpiProj E{p.ws, p.in[I_BGATE]}; ProjOrder S; S.S.init(p.ws + WS_H, p.ws + WS_WIN + (size_t)2 * 256 * DM * 2, NTOK, 8 * 256, DM * 2, G, bx); S.fp8 = 0; S.Bfull = nullptr;
             pg8::gemm_phase<EpiProj, ProjOrder, false, false>(lds, DM * 2, S, E); }
}
template __global__ void k_ph<0>(Params); template __global__ void k_ph<1>(Params);
#endif
```

```cpp
#include <hip/hip_runtime.h>
#include <cstdio>
#include <cstdint>
#include <cstring>

#ifndef MK_LAUNCHES
#define MK_LAUNCHES 1
#endif

#define LAS __attribute__((address_space(3)))
typedef unsigned short bf16_t;
typedef short bf16x8 __attribute__((ext_vector_type(8)));
typedef short s16x4 __attribute__((ext_vector_type(4)));
typedef float f32x4 __attribute__((ext_vector_type(4)));
typedef float f32x16 __attribute__((ext_vector_type(16)));
typedef unsigned u32x4 __attribute__((ext_vector_type(4)));
typedef unsigned u32x2 __attribute__((ext_vector_type(2)));

constexpr int DM = 2048, NBATCH = 4, SEQ = 2048, NTOK = NBATCH * SEQ;
constexpr int DIN = 9560, DINP = 9728;
constexpr int NEXP = 64, DEXP = 512, LCAP = 8192;
constexpr float RMS_EPS = 1e-6f;
constexpr float LOG2E = 1.4426950408889634f;
constexpr int NTHREADS = 512;
constexpr int LDS_BYTES = 163840 - 1024;
constexpr int LDS_BARW = LDS_BYTES - 16;
constexpr int LDS_TAB = 131072;

constexpr size_t al256(size_t x) { return (x + 255) / 256 * 256; }
constexpr size_t WS_BAR = 0;
constexpr size_t WS_CNT = 16384;
constexpr size_t WS_ZERO_BYTES = 16384 + 4096;
constexpr size_t WS_MOD = WS_ZERO_BYTES;
constexpr size_t WS_H = al256(WS_MOD + (size_t)4 * 12288 * 4);
constexpr size_t WS_WIN = al256(WS_H + (size_t)NTOK * DM * 2);
constexpr size_t WS_WPA = al256(WS_WIN + (size_t)DINP * DM * 2);
constexpr size_t WS_WPB = al256(WS_WPA + (size_t)2048 * 1024 * 2);
constexpr size_t WS_WO = al256(WS_WPB + (size_t)2048 * 1024 * 2);
constexpr size_t WS_WUK = al256(WS_WO + (size_t)2048 * 2048 * 2);
constexpr size_t WS_WUV = al256(WS_WUK + (size_t)8 * 256 * 128 * 2);
constexpr size_t WS_W13 = al256(WS_WUV + (size_t)8 * 128 * 256 * 2);
constexpr size_t WS_W2 = al256(WS_W13 + (size_t)64 * 1024 * 2048 * 2);
constexpr size_t WS_QA = al256(WS_W2 + (size_t)64 * 2048 * 512 * 2);
constexpr size_t WS_CKV = al256(WS_QA + (size_t)NTOK * 1024 * 2);
constexpr size_t WS_KV = al256(WS_CKV + (size_t)NTOK * 256 * 4);
constexpr size_t WS_QIDX = al256(WS_KV + (size_t)NTOK * 256 * 2);
constexpr size_t WS_MISC = al256(WS_QIDX + (size_t)NTOK * 1024 * 2);
constexpr size_t WS_QB = al256(WS_MISC + (size_t)NTOK * 256 * 4);
constexpr size_t WS_KB = al256(WS_QB + (size_t)NTOK * 1024 * 2);
constexpr size_t WS_VB = al256(WS_KB + (size_t)NTOK * 1024 * 2);
constexpr size_t WS_GATES = al256(WS_VB + (size_t)NTOK * 1024 * 2);
constexpr size_t WS_QLAT = al256(WS_GATES + (size_t)NTOK * 4096 * 2);
constexpr size_t WS_MASK = al256(WS_QLAT + (size_t)NTOK * 2048 * 2);
constexpr size_t WS_CUM = al256(WS_MASK + (size_t)NTOK * 256);
constexpr size_t WS_OLAT = al256(WS_CUM + (size_t)4 * 8 * 2048 * 4);
constexpr size_t WS_OA = al256(WS_OLAT + (size_t)NTOK * 2048 * 2);
constexpr size_t WS_OB = al256(WS_OA + (size_t)NTOK * 1024 * 2);
constexpr size_t WS_T1 = al256(WS_OB + (size_t)NTOK * 1024 * 2);
constexpr size_t WS_MERGED = al256(WS_T1 + (size_t)NTOK * 2048 * 4);
constexpr size_t WS_LTOK = al256(WS_MERGED + (size_t)NTOK * 2048 * 2);
constexpr size_t WS_LW = al256(WS_LTOK + (size_t)NEXP * LCAP * 4);
constexpr size_t WS_ACT = al256(WS_LW + (size_t)NEXP * LCAP * 4);
constexpr size_t WS_HLO = al256(WS_ACT + (size_t)32768 * 512 * 2);
constexpr size_t WS_WRH = al256(WS_HLO + (size_t)NTOK * DM * 2);
constexpr size_t WS_WRL = al256(WS_WRH + (size_t)80 * DM * 2);
constexpr size_t WS_END = al256(WS_WRL + (size_t)80 * DM * 2);
constexpr size_t WS_KIDX = WS_END;
constexpr size_t WS_END2 = al256(WS_KIDX + (size_t)NTOK * 64 * 2);
constexpr size_t WS_H8 = WS_END2;
constexpr size_t WS_ACT8 = al256(WS_H8 + (size_t)NTOK * DM);
constexpr size_t WS_END3 = al256(WS_ACT8 + (size_t)16384 * 512);
constexpr size_t WS_HF8 = WS_END3;
constexpr size_t WS_WIN8 = al256(WS_HF8 + (size_t)NTOK * DM);
constexpr size_t WS_END4 = al256(WS_WIN8 + (size_t)7680 * DM);
constexpr size_t WS_MRG8 = WS_END4;
constexpr size_t WS_WO8 = al256(WS_MRG8 + (size_t)NTOK * DM);
constexpr size_t WS_END5 = al256(WS_WO8 + (size_t)2048 * 2048);
constexpr size_t WS_OA8 = WS_END5;
constexpr size_t WS_OB8 = al256(WS_OA8 + (size_t)NTOK * 1024);
constexpr size_t WS_WPA8 = al256(WS_OB8 + (size_t)NTOK * 1024);
constexpr size_t WS_WPB8 = al256(WS_WPA8 + (size_t)2048 * 1024);
constexpr size_t WS_END6 = al256(WS_WPB8 + (size_t)2048 * 1024);
constexpr size_t WS_YS = WS_T1;
constexpr size_t WS_HG = WS_QA;
static_assert(WS_HG + (size_t)32768 * DM * 2 <= WS_QLAT, "hg alias must fit in the dead region");

struct TJob { const float* src; bf16_t* dst; int K, N, ldd, map, ntk, ntn, nbatch, tile0; long sbatch, dbatch; int ld, fp8; };
constexpr int NJOBS = 10;
struct Params {
    const float* in[25];
    float* out;
    unsigned char* ws;
    TJob jobs[NJOBS];
    int ntiles_total;
    int ph_lo, ph_hi;
};
enum { I_X = 0, I_C, I_WADA, I_BADA, I_GMIX, I_WIN, I_BGATE, I_BFORGET, I_WUK, I_WUV, I_GQA, I_GKV, I_GQB, I_GKB, I_WPA, I_WPB, I_WO, I_GFFN, I_WRG, I_BRG, I_WRE, I_BRE, I_W1, I_W3, I_W2 };

__device__ __forceinline__ unsigned cvt_pk_bf16(float lo, float hi) { unsigned r; asm volatile("v_cvt_pk_bf16_f32 %0, %1, %2" : "=v"(r) : "v"(lo), "v"(hi)); return r; }
__device__ __forceinline__ float bf_lo(unsigned w) { return __uint_as_float(w << 16); }
__device__ __forceinline__ float bf_hi(unsigned w) { return __uint_as_float(w & 0xffff0000u); }
typedef float f32x2 __attribute__((ext_vector_type(2)));
__device__ __forceinline__ unsigned pack_fp8x4(float a, float b, float c, float d) { int w = __builtin_amdgcn_cvt_pk_fp8_f32(a, b, 0, false); w = __builtin_amdgcn_cvt_pk_fp8_f32(c, d, w, true); return (unsigned)w; }
__device__ __forceinline__ bf16x8 fp8x8_to_bf16(u32x2 v) {
    const f32x2 a = __builtin_amdgcn_cvt_pk_f32_fp8((int)v.x, false), b = __builtin_amdgcn_cvt_pk_f32_fp8((int)v.x, true), c = __builtin_amdgcn_cvt_pk_f32_fp8((int)v.y, false), d = __builtin_amdgcn_cvt_pk_f32_fp8((int)v.y, true);
    u32x4 w; w.x = cvt_pk_bf16(a.x, a.y); w.y = cvt_pk_bf16(b.x, b.y); w.z = cvt_pk_bf16(c.x, c.y); w.w = cvt_pk_bf16(d.x, d.y); return *reinterpret_cast<bf16x8*>(&w); }
__device__ __forceinline__ float wave_sum(float v) {
#pragma unroll
    for (int o = 32; o >= 1; o >>= 1) v += __shfl_xor(v, o);
    return v;
}
__device__ __forceinline__ float sigmoidf_(float x) { return 1.0f / (1.0f + __expf(-x)); }
__device__ __forceinline__ int crow(int r, int hi) { return (r & 3) + 8 * (r >> 2) + 4 * hi; }
#define SBAR() __builtin_amdgcn_sched_barrier(0)

#define XB_TMO      128
#define XB_XCNT(j)  (256  + 64 * (j))
#define XB_XSUB(j)  (1280 + 64 * (j))
#define XB_XGEN(j)  (2304 + 64 * (j))
#define XB_TOP      3328
#define XB_TOPGEN   3392
#define XCD_BAR_WORDS 3456
#define XB_SPIN_CAP (1u << 20)
__device__ __forceinline__ unsigned xb_ld(unsigned* p)              { return __hip_atomic_load(p, __ATOMIC_RELAXED, __HIP_MEMORY_SCOPE_AGENT); }
__device__ __forceinline__ unsigned xb_add(unsigned* p, unsigned v) { return __hip_atomic_fetch_add(p, v, __ATOMIC_RELAXED, __HIP_MEMORY_SCOPE_AGENT); }
__device__ __forceinline__ unsigned xb_xcc_id() { return (unsigned)__builtin_amdgcn_s_getreg((3 << 11) | 20) & 0xFu; }
#define XB_SPIN(cond, bar) do { unsigned _sp = 0; while (cond) { __builtin_amdgcn_s_sleep(1); \
    if ((++_sp & 255u) == 0u) { if (xb_ld(&(bar)[XB_TMO])) break; if (_sp > XB_SPIN_CAP) { atomicAdd(&(bar)[XB_TMO], 1u); break; } } } } while (0)
struct XcdBarrier { unsigned* bar; unsigned x; volatile LAS unsigned* st; };
__device__ __forceinline__ XcdBarrier xcd_barrier_post(unsigned* bar, volatile LAS unsigned* st) {
    XcdBarrier b; b.bar = bar; b.x = xb_xcc_id(); b.st = st;
    if (threadIdx.x == 0) (void)xb_add(&bar[XB_XCNT(b.x)], 1u);
    return b;
}
__device__ __forceinline__ void xcd_barrier_complete(unsigned* bar, unsigned x, unsigned& nloc, unsigned& nx) {
    const unsigned G = gridDim.x * gridDim.y * gridDim.z;
    unsigned sum, cnt, mine, sp = 0u;
    for (;;) {
        sum = 0u; cnt = 0u; mine = 0u;
#pragma unroll
        for (unsigned j = 0; j < 16; ++j) { const unsigned c = xb_ld(&bar[XB_XCNT(j)]); sum += c; cnt += (c > 0u) ? 1u : 0u; mine = (j == x) ? c : mine; }
        if (sum == G) break;
        __builtin_amdgcn_s_sleep(1);
        if ((++sp & 255u) == 0u) { if (xb_ld(&bar[XB_TMO])) break; if (sp > XB_SPIN_CAP) { atomicAdd(&bar[XB_TMO], 1u); break; } }
    }
    nloc = mine > 0u ? mine : 1u; nx = cnt > 0u ? cnt : 1u;
}
__device__ __forceinline__ void xcd_barrier(const XcdBarrier& b) {
    asm volatile("s_waitcnt vmcnt(0)" ::: "memory");
    __syncthreads();
    if (threadIdx.x == 0) {
        unsigned* bar = b.bar;
        __builtin_amdgcn_s_waitcnt(0);
        unsigned nloc = b.st[0], nx = b.st[1];
        if (nloc == 0u) { xcd_barrier_complete(bar, b.x, nloc, nx); b.st[0] = nloc; b.st[1] = nx; }
        const unsigned old = xb_add(&bar[XB_XSUB(b.x)], 1u);
        const unsigned gen = old / nloc;
        if (old + 1u == (gen + 1u) * nloc) {
            __builtin_amdgcn_fence(__ATOMIC_RELEASE, "agent");
            asm volatile("s_waitcnt vmcnt(0)" ::: "memory");
            const unsigned og = xb_add(&bar[XB_TOP], 1u);
            const unsigned tg = og / nx;
            if (og + 1u == (tg + 1u) * nx) xb_add(&bar[XB_TOPGEN], 1u);
            else XB_SPIN(xb_ld(&bar[XB_TOPGEN]) == tg, bar);
            __builtin_amdgcn_fence(__ATOMIC_ACQUIRE, "agent");
            xb_add(&bar[XB_XGEN(b.x)], 1u);
            asm volatile("s_waitcnt vmcnt(0)" ::: "memory");
        } else {
            XB_SPIN(xb_ld(&bar[XB_XGEN(b.x)]) == gen, bar);
            __builtin_amdgcn_fence(__ATOMIC_ACQUIRE, "agent");
            asm volatile("s_waitcnt vmcnt(0)" ::: "memory");
        }
    }
    __syncthreads();
}

namespace pg8 {
constexpr int BM = 256, BK = 64, HALF = 128, HTB = HALF * BK * 2, STAGE_BYTES = 8 * HTB, NXCD = 8, WGM = 8;
__host__ __device__ __forceinline__ int lds_byte(int r, int c) { const int st = (r >> 4) * 2 + (c >> 5), rr = r & 15, cc = c & 31, ob = rr * 64 + cc * 2; return st * 1024 + (ob ^ (((ob >> 9) & 1) << 5)); }
__host__ __device__ __forceinline__ void stage_rc(int b, int& R, int& C) { const int st = b / 1024, sb = b % 1024, swz = sb ^ (((sb >> 9) & 1) << 5); R = (st >> 1) * 16 + swz / 64; C = (st & 1) * 32 + (swz % 64) / 2; }
__host__ __device__ __forceinline__ int perm32(int rho) { const int n = rho >> 4, i = rho & 15; return 8 * (i >> 2) + 4 * n + (i & 3); }

struct Unit { int pm, pn; const char* a; const char* b; const int* gi; int nvalid; int aux; };

struct StaticOrder {
    int nM, nN, nwg, G, c, RS; const char* A; const char* Bt;
    __device__ void init(const void* A_, const void* Bt_, int M, int N, int RS_, int G_, int c_) { A = (const char*)A_; Bt = (const char*)Bt_; RS = RS_; nM = M / BM; nN = N / BM; nwg = nM * nN; G = G_; c = c_; }
    __device__ bool next(int i, Unit& u) const {
        const long L = (long)i * G + c; if (L >= nwg) return false;
        int wgid = (int)L; { const int q = nwg / NXCD, r = nwg % NXCD, xcd = wgid % NXCD, off = wgid / NXCD; wgid = (xcd < r ? xcd * (q + 1) : r * (q + 1) + (xcd - r) * q) + off; }
        const int nig = WGM * nN, gid = wgid / nig, fm = gid * WGM, gsz = (nM - fm) < WGM ? (nM - fm) : WGM;
        u.pm = fm + ((wgid % nig) % gsz); u.pn = (wgid % nig) / gsz;
        u.a = A + (size_t)u.pm * BM * RS; u.b = Bt + (size_t)u.pn * BM * RS; u.gi = nullptr; u.nvalid = BM; u.aux = 0; return true;
    }
};

typedef int i32x8 __attribute__((ext_vector_type(8)));
typedef int i32x4v __attribute__((ext_vector_type(4)));
template <class Epi, class Sched, bool GATHER, bool FP8 = false>
__device__ __forceinline__ void gemm_phase(LAS unsigned char* lds, const int RS, const Sched& S, const Epi& E, const int scale_b = 0x7f7f7f7f, const int scale_a = 0x7f7f7f7f) {
    int tid = threadIdx.x; asm volatile("" : "+v"(tid));
    const int wid = __builtin_amdgcn_readfirstlane(tid >> 6), lane = tid & 63, wr = wid >> 2, wc = wid & 3, fr = lane & 15, fq = lane >> 4;
    const int nt = RS / (BK * 2); const int K = RS;
    unsigned voffA[2], voffB[2]; int RA[2], CA[2];
#pragma unroll
    for (int i = 0; i < 2; ++i) { int R, C; stage_rc(tid * 16 + i * 8192, R, C); const int Rb = ((R & ~31) + perm32(R & 31));
        RA[i] = R; CA[i] = C; voffA[i] = (unsigned)(R * RS + C * 2); voffB[i] = (unsigned)(Rb * RS + C * 2); }
    const size_t kstep = (size_t)(BK * 2);
    const size_t hstep = (size_t)HALF * RS;
    const unsigned ldsw = (unsigned)wid * 1024u;
    const int aoff = lds_byte(wr * 64 + fr, fq * 8), boff = lds_byte(wc * 32 + fr, fq * 8);
    unsigned gA[2][2], gN[2][2];
#define PG8_SA(b, h) (((b) * 2 + (h)) * HTB)
#define PG8_SB(b, h) ((4 + (b) * 2 + (h)) * HTB)
#define PG8_STAGE(bufoff, gbase, voff) do { _Pragma("unroll") for (int _i = 0; _i < 2; ++_i) \
        __builtin_amdgcn_global_load_lds((const unsigned*)((const char*)(gbase) + (voff)[_i]), (LAS unsigned*)(lds + (bufoff) + ldsw + _i * 8192), 16, 0, 0); } while (0)
#define PG8_STAGE_A(bufoff, gp, h, NX) do { if constexpr (GATHER) { if (NX) PG8_STAGE(bufoff, gp, gN[h]); else PG8_STAGE(bufoff, gp, gA[h]); } else PG8_STAGE(bufoff, (gp) + (h) * hstep, voffA); } while (0)
#define PG8_LD8(p_) __builtin_shufflevector(*(const LAS i32x4v*)(p_), *(const LAS i32x4v*)((p_) + 1024), 0, 1, 2, 3, 4, 5, 6, 7)
#define PG8_LDA(dst, b, h) do { if constexpr (FP8) { _Pragma("unroll") for (int m = 0; m < 4; ++m) dst##8[m] = PG8_LD8(lds + PG8_SA(b, h) + aoff + m * 2048); } \
        else { _Pragma("unroll") for (int m = 0; m < 4; ++m) _Pragma("unroll") for (int k = 0; k < 2; ++k) dst[m][k] = *(const LAS bf16x8*)(lds + PG8_SA(b, h) + aoff + m * 2048 + k * 1024); } } while (0)
#define PG8_LDB(dst, b, h) do { if constexpr (FP8) { _Pragma("unroll") for (int n = 0; n < 2; ++n) dst##8[n] = PG8_LD8(lds + PG8_SB(b, h) + boff + n * 2048); } \
        else { _Pragma("unroll") for (int n = 0; n < 2; ++n) _Pragma("unroll") for (int k = 0; k < 2; ++k) dst[n][k] = *(const LAS bf16x8*)(lds + PG8_SB(b, h) + boff + n * 2048 + k * 1024); } } while (0)
#define PG8_MMA(ai, bj, At, Bt) do { __builtin_amdgcn_s_setprio(1); \
        if constexpr (FP8) { _Pragma("unroll") for (int m = 0; m < 4; ++m) _Pragma("unroll") for (int n = 0; n < 2; ++n) \
            asm volatile("v_mfma_scale_f32_16x16x128_f8f6f4 %0, %1, %2, %0, %3, %4 op_sel_hi:[0,0,0]" : "+v"(acc[ai][bj][m][n]) : "v"(Bt##8[n]), "v"(At##8[m]), "v"(sc_b), "v"(sc_a)); } \
        else { _Pragma("unroll") for (int m = 0; m < 4; ++m) _Pragma("unroll") for (int n = 0; n < 2; ++n) _Pragma("unroll") for (int k = 0; k < 2; ++k) \
            acc[ai][bj][m][n] = __builtin_amdgcn_mfma_f32_16x16x32_bf16(Bt[n][k], At[m][k], acc[ai][bj][m][n], 0, 0, 0); } \
        __builtin_amdgcn_s_setprio(0); } while (0)
#define PG8_WAIT_V(n) asm volatile("s_waitcnt vmcnt(" #n ")" ::: "memory")
#define PG8_WAIT_L(n) asm volatile("s_waitcnt lgkmcnt(" #n ")" ::: "memory")
#define PG8_BAR __builtin_amdgcn_s_barrier()
#define PG8_SCHED __builtin_amdgcn_sched_barrier(0)
#define PG8_GIDX(dst, u) do { if constexpr (GATHER) { _Pragma("unroll") for (int h = 0; h < 2; ++h) _Pragma("unroll") for (int i = 0; i < 2; ++i) { \
        const int rr = h * HALF + RA[i]; const int tok = rr < (u).nvalid ? (u).gi[rr] : 0; dst[h][i] = (unsigned)(tok * K + CA[i] * 2); } } } while (0)
    Unit cur, nxt; int ui = 0;
    if (!S.next(0, cur)) return;
    f32x4 acc[2][2][4][2];
#pragma unroll
    for (int a = 0; a < 2; ++a)
#pragma unroll
        for (int b = 0; b < 2; ++b)
#pragma unroll
            for (int m = 0; m < 4; ++m)
#pragma unroll
                for (int n = 0; n < 2; ++n) acc[a][b][m][n] = (f32x4){0.f, 0.f, 0.f, 0.f};
    const int sc_b = scale_b, sc_a = scale_a;
    bf16x8 At[4][2], B0[2][2], B1[2][2]; i32x8 At8[4], B08[2], B18[2];
    const char* cA = cur.a; const char* cB = cur.b;
    PG8_GIDX(gA, cur);
    PG8_STAGE(PG8_SB(0, 0), cB, voffB); PG8_STAGE_A(PG8_SA(0, 0), cA, 0, false); PG8_STAGE(PG8_SB(0, 1), cB + hstep, voffB); PG8_STAGE_A(PG8_SA(0, 1), cA, 1, false);
    if (wr == 1) PG8_BAR;
    PG8_WAIT_V(4); PG8_BAR;
    PG8_STAGE(PG8_SB(1, 0), cB + kstep, voffB); PG8_STAGE_A(PG8_SA(1, 0), cA + kstep, 0, false); PG8_STAGE(PG8_SB(1, 1), cB + hstep + kstep, voffB);
    PG8_WAIT_V(6); PG8_BAR;
    for (;;) {
        const bool has_next = S.next(ui + 1, nxt);
        const char* nA = has_next ? nxt.a : cA; const char* nB = has_next ? nxt.b : cB;
        if constexpr (GATHER) { if (has_next) { PG8_GIDX(gN, nxt); } else {
#pragma unroll
            for (int h = 0; h < 2; ++h)
#pragma unroll
                for (int i = 0; i < 2; ++i) gN[h][i] = gA[h][i]; } }
        for (int t = 0; t < nt; t += 2) {
            const bool last = (t == nt - 2);
            const char* a1 = cA + (size_t)(t + 1) * kstep;
            const char* a2 = last ? nA : cA + (size_t)(t + 2) * kstep; const char* b2 = last ? nB : cB + (size_t)(t + 2) * kstep;
            const char* a3 = a2 + kstep; const char* b3 = b2 + kstep;
            PG8_LDB(B0, 0, 0); PG8_SCHED; PG8_LDA(At, 0, 0); PG8_STAGE_A(PG8_SA(1, 1), a1, 1, false);
            PG8_WAIT_L(8); PG8_BAR; PG8_WAIT_L(0); PG8_MMA(0, 0, At, B0); PG8_BAR; PG8_SCHED;
            PG8_LDB(B1, 0, 1); PG8_STAGE(PG8_SB(0, 0), b2, voffB);
            PG8_BAR; PG8_WAIT_L(0); PG8_MMA(0, 1, At, B1); PG8_BAR;
            PG8_LDA(At, 0, 1); PG8_STAGE_A(PG8_SA(0, 0), a2, 0, last);
            PG8_BAR; PG8_WAIT_L(0); PG8_MMA(1, 0, At, B0); PG8_BAR; PG8_SCHED;
            PG8_STAGE(PG8_SB(0, 1), b2 + hstep, voffB);
            PG8_WAIT_V(6); PG8_BAR; PG8_MMA(1, 1, At, B1); PG8_BAR;
            PG8_LDB(B0, 1, 0); PG8_SCHED; PG8_LDA(At, 1, 0); PG8_STAGE_A(PG8_SA(0, 1), a2, 1, last);
            PG8_WAIT_L(8); PG8_BAR; PG8_WAIT_L(0); PG8_MMA(0, 0, At, B0); PG8_BAR; PG8_SCHED;
            PG8_LDB(B1, 1, 1); PG8_STAGE(PG8_SB(1, 0), b3, voffB);
            PG8_BAR; PG8_WAIT_L(0); PG8_MMA(0, 1, At, B1); PG8_BAR;
            PG8_LDA(At, 1, 1); PG8_STAGE_A(PG8_SA(1, 0), a3, 0, last);
            PG8_BAR; PG8_WAIT_L(0); PG8_MMA(1, 0, At, B0); PG8_BAR; PG8_SCHED;
            PG8_STAGE(PG8_SB(1, 1), b3 + hstep, voffB);
            PG8_WAIT_V(6); PG8_BAR; PG8_MMA(1, 1, At, B1); PG8_BAR;
        }
        bool keep_acc = false;
        if constexpr (FP8) asm volatile("s_nop 15\n\ts_nop 15" ::: "memory");
        if constexpr (Epi::DUAL) { if (cur.aux) { E.mid(acc, cur, wr, wc, fr, fq); keep_acc = true; } else E(acc, cur, wr, wc, fr, fq); } else E(acc, cur, wr, wc, fr, fq);
        if (!has_next) break;
        if (!keep_acc)
#pragma unroll
        for (int a = 0; a < 2; ++a)
#pragma unroll
            for (int b = 0; b < 2; ++b)
#pragma unroll
                for (int m = 0; m < 4; ++m)
#pragma unroll
                    for (int n = 0; n < 2; ++n) acc[a][b][m][n] = (f32x4){0.f, 0.f, 0.f, 0.f};
        cur = nxt; cA = nA; cB = nB; ++ui;
        if constexpr (GATHER) {
#pragma unroll
            for (int h = 0; h < 2; ++h)
#pragma unroll
                for (int i = 0; i < 2; ++i) gA[h][i] = gN[h][i]; }
    }
    PG8_WAIT_V(0);
    if (wr == 0) PG8_BAR;
    PG8_BAR;
#undef PG8_SA
#undef PG8_SB
#undef PG8_STAGE
#undef PG8_STAGE_A
#undef PG8_LDA
#undef PG8_LD8
#undef PG8_LDB
#undef PG8_MMA
#undef PG8_WAIT_V
#undef PG8_WAIT_L
#undef PG8_BAR
#undef PG8_SCHED
#undef PG8_GIDX
}
}
using pg8::Unit;

#define EPI_LOOP(...) { int fr_ = fr, fq_ = fq; asm volatile("" : "+v"(fr_), "+v"(fq_)); _Pragma("unroll") for (int ai = 0; ai < 2; ++ai) _Pragma("unroll") for (int m = 0; m < 4; ++m) _Pragma("unroll") for (int bj = 0; bj < 2; ++bj) { \
        const int trow = ai * 128 + wr * 64 + m * 16 + fr_; const int tcol = bj * 128 + wc * 32 + fq_ * 8; const f32x4 v0 = acc[ai][bj][m][0], v1 = acc[ai][bj][m][1]; __VA_ARGS__ } }

__device__ __forceinline__ u32x4 pack8(const f32x4 a, const f32x4 b) { u32x4 w; w.x = cvt_pk_bf16(a[0], a[1]); w.y = cvt_pk_bf16(a[2], a[3]); w.z = cvt_pk_bf16(b[0], b[1]); w.w = cvt_pk_bf16(b[2], b[3]); return w; }

struct EpiProj { static constexpr bool DUAL = false;
    unsigned char* ws; const float* b_gate;
    __device__ __forceinline__ void operator()(const f32x4 (&acc)[2][2][4][2], const Unit& u, int wr, int wc, int fr, int fq) const {
        const int pn = u.pn; const size_t row0 = (size_t)u.pm * 256;
        if (pn == 4 || pn == 9) {
            float* dst = (float*)(ws + (pn == 4 ? WS_CKV : WS_MISC));
            EPI_LOOP({ float* p = dst + (row0 + trow) * 256 + tcol; *(f32x4*)p = v0; *(f32x4*)(p + 4) = v1;
                if (pn == 9 && tcol < 64) *(u32x4*)((bf16_t*)(ws + WS_KIDX) + (row0 + trow) * 64 + tcol) = pack8(v0, v1); })
        } else if (pn < 22) {
            bf16_t* dst; int ct;
            if (pn < 4) { dst = (bf16_t*)(ws + WS_QA); ct = pn; } else if (pn < 9) { dst = (bf16_t*)(ws + WS_QIDX); ct = pn - 5; }
            else if (pn < 14) { dst = (bf16_t*)(ws + WS_QB); ct = pn - 10; } else if (pn < 18) { dst = (bf16_t*)(ws + WS_KB); ct = pn - 14; } else { dst = (bf16_t*)(ws + WS_VB); ct = pn - 18; }
            EPI_LOOP({ *(u32x4*)(dst + (row0 + trow) * 1024 + ct * 256 + tcol) = pack8(v0, v1); })
        } else {
            bf16_t* dst = (bf16_t*)(ws + WS_GATES); const int ct = pn - 22;
            EPI_LOOP({ const int col = ct * 256 + tcol; const f32x4 b0 = *(const f32x4*)(b_gate + col), b1 = *(const f32x4*)(b_gate + col + 4); f32x4 s0, s1;
                _Pragma("unroll") for (int j = 0; j < 4; ++j) { s0[j] = sigmoidf_(v0[j] + b0[j]); s1[j] = sigmoidf_(v1[j] + b1[j]); }
                *(u32x4*)(dst + (row0 + trow) * 4096 + col) = pack8(s0, s1); })
        }
    }
};
struct EpiGate1 { static constexpr bool DUAL = false;
    const bf16_t* gates; float* T1;
    __device__ __forceinline__ void operator()(const f32x4 (&acc)[2][2][4][2], const Unit& u, int wr, int wc, int fr, int fq) const {
        EPI_LOOP({ const size_t row = (size_t)u.pm * 256 + trow; const int col = u.pn * 256 + tcol; const u32x4 g = *(const u32x4*)(gates + row * 4096 + col);
            f32x4 o0 = {v0[0] * bf_lo(g.x), v0[1] * bf_hi(g.x), v0[2] * bf_lo(g.y), v0[3] * bf_hi(g.y)}; f32x4 o1 = {v1[0] * bf_lo(g.z), v1[1] * bf_hi(g.z), v1[2] * bf_lo(g.w), v1[3] * bf_hi(g.w)};
            float* p = T1 + row * 2048 + col; *(f32x4*)p = o0; *(f32x4*)(p + 4) = o1; })
    }
};
struct EpiGate2 { static constexpr bool DUAL = false;
    const bf16_t* gates; const float* T1; bf16_t* merged;
    __device__ __forceinline__ void operator()(const f32x4 (&acc)[2][2][4][2], const Unit& u, int wr, int wc, int fr, int fq) const {
        EPI_LOOP({ const size_t row = (size_t)u.pm * 256 + trow; const int col = u.pn * 256 + tcol; const u32x4 g = *(const u32x4*)(gates + row * 4096 + 2048 + col);
            const float* p = T1 + row * 2048 + col; const f32x4 t0 = *(const f32x4*)p, t1 = *(const f32x4*)(p + 4);
            f32x4 o0 = {t0[0] + v0[0] * bf_lo(g.x), t0[1] + v0[1] * bf_hi(g.x), t0[2] + v0[2] * bf_lo(g.y), t0[3] + v0[3] * bf_hi(g.y)};
            f32x4 o1 = {t1[0] + v1[0] * bf_lo(g.z), t1[1] + v1[1] * bf_hi(g.z), t1[2] + v1[2] * bf_lo(g.w), t1[3] + v1[3] * bf_hi(g.w)};
            u32x2 w8; w8.x = pack_fp8x4(o0[0] * 4.f, o0[1] * 4.f, o0[2] * 4.f, o0[3] * 4.f); w8.y = pack_fp8x4(o1[0] * 4.f, o1[1] * 4.f, o1[2] * 4.f, o1[3] * 4.f);
            *(u32x2*)((unsigned char*)merged + row * 2048 + col) = w8; })
    }
};
struct EpiWo { static constexpr bool DUAL = false;
    const float* mod; bf16_t* y;
    __device__ __forceinline__ void operator()(const f32x4 (&acc)[2][2][4][2], const Unit& u, int wr, int wc, int fr, int fq) const {
        const float* gt = mod + (size_t)(u.pm >> 3) * 12288 + 4096;
        EPI_LOOP({ const size_t row = (size_t)u.pm * 256 + trow; const int col = u.pn * 256 + tcol;
            const f32x4 g0 = *(const f32x4*)(gt + col), g1 = *(const f32x4*)(gt + col + 4);
            *(u32x4*)(y + row * 2048 + col) = pack8(g0 * v0, g1 * v1); })
    }
};
struct DualOrder {
    pg8::StaticOrder S0, S1;
    __device__ bool next(int i, Unit& u) const { const bool ok = (i & 1) ? S1.next(i >> 1, u) : S0.next(i >> 1, u); u.aux = (i & 1) ? 0 : 1; return ok; }
};
struct EpiGate12 { static constexpr bool DUAL = false;
    EpiGate1 e1; EpiGate2 e2;
    __device__ __forceinline__ void operator()(const f32x4 (&acc)[2][2][4][2], const Unit& u, int wr, int wc, int fr, int fq) const { if (u.aux) e1(acc, u, wr, wc, fr, fq); else e2(acc, u, wr, wc, fr, fq); }
};

struct ProjOrder {
    pg8::StaticOrder S; int fp8; const char* Bfull;
    __device__ bool next(int i, Unit& u) const {
        if (!S.next(i, u)) return false;
        if (fp8) { if (u.pn >= 2) u.pn += 8; } else u.pn += 2;
        return true;
    }
};
__device__ __forceinline__ int map_row(int map, int n) {
    if (map == 0) return n;
    if (map == 1) { if (n < 2384) return n; if (n < 5456) return n + 176; if (n < 5464) return n - 3072; return n + 168; }
    if (map == 4) return n + 512;
    return n + 2384;
}
__device__ void ph0_prologue(const Params& p, LAS unsigned char* lds) {
    const int tid = threadIdx.x, wid = tid >> 6, lane = tid & 63, G = gridDim.x, bx = blockIdx.x;
    if (bx < 192) {
        LAS float* sc = (LAS float*)lds;
        LAS float* red = (LAS float*)(lds + 32768);
        const float* c = p.in[I_C];
        for (int i = tid; i < 4 * 2048; i += NTHREADS) { const float v = c[i]; sc[i] = v / (1.0f + __expf(-v)); }
        __syncthreads();
        for (int item = bx; item < 192; item += G) {
            const int n0 = item * 64, cg = lane & 15, rs = lane >> 4;
            float acc[4][4];
#pragma unroll
            for (int b = 0; b < 4; ++b)
#pragma unroll
                for (int j = 0; j < 4; ++j) acc[b][j] = 0.f;
            const float* w = p.in[I_WADA] + n0 + cg * 4;
#pragma unroll 4
            for (int step = 0; step < 64; ++step) {
                const int k = step * 32 + wid * 4 + rs;
                const f32x4 wv = *(const f32x4*)(w + (size_t)k * 12288);
#pragma unroll
                for (int b = 0; b < 4; ++b) { const float s = sc[b * 2048 + k];
#pragma unroll
                    for (int j = 0; j < 4; ++j) acc[b][j] += s * wv[j]; }
            }
#pragma unroll
            for (int b = 0; b < 4; ++b)
#pragma unroll
                for (int j = 0; j < 4; ++j) { float v = acc[b][j]; v += __shfl_xor(v, 16); v += __shfl_xor(v, 32); acc[b][j] = v; }
            if (rs == 0) {
#pragma unroll
                for (int b = 0; b < 4; ++b)
#pragma unroll
                    for (int j = 0; j < 4; ++j) red[(wid * 16 + cg) * 16 + b * 4 + j] = acc[b][j]; }
            __syncthreads();
            if (tid < 256) { const int cg2 = tid >> 4, bj = tid & 15, b = bj >> 2, j = bj & 3; float s = 0.f;
#pragma unroll
                for (int w8 = 0; w8 < 8; ++w8) s += red[(w8 * 16 + cg2) * 16 + bj];
                const int n = n0 + cg2 * 4 + j; ((float*)(p.ws + WS_MOD))[b * 12288 + n] = s + p.in[I_BADA][n]; }
            __syncthreads();
        }
    }
    { u32x4* z = (u32x4*)(p.ws + WS_WIN + (size_t)2392 * 2048 * 2); const int n16 = 168 * 2048 * 2 / 16;
      for (int i = bx * NTHREADS + tid; i < n16; i += G * NTHREADS) z[i] = (u32x4){0u, 0u, 0u, 0u}; }
    { bf16_t* wh = (bf16_t*)(p.ws + WS_WRH); bf16_t* wl = (bf16_t*)(p.ws + WS_WRL);
      for (int i = bx * NTHREADS + tid; i < 80 * 2048; i += G * NTHREADS) { const int n = i >> 11, k = i & 2047;
          const float v = n < 8 ? p.in[I_WRG][k * 8 + n] : (n < 72 ? p.in[I_WRE][k * 64 + n - 8] : 0.f);
          const unsigned h = cvt_pk_bf16(v, 0.f) & 0xffffu; const unsigned l = cvt_pk_bf16(v - bf_lo(h), 0.f) & 0xffffu; wh[i] = (bf16_t)h; wl[i] = (bf16_t)l; } }
    LAS float* tile = (LAS float*)(lds + 65536);
    for (int ti = bx; ti < p.ntiles_total; ti += G) {
        int j = 0;
#pragma unroll 1
        for (int q = 1; q < NJOBS; ++q) if (ti >= p.jobs[q].tile0) j = q;
        const TJob& J = p.jobs[j];
        int l = ti - J.tile0; const int per = J.ntk * J.ntn; const int bt = l / per; l -= bt * per; const int tn = l / J.ntk, tk = l % J.ntk;
        const float* src = J.src + (size_t)bt * J.sbatch; bf16_t* dst = J.dst + (size_t)bt * J.dbatch;
        const int k0 = tk * 64, n0 = tn * 128;
        f32x4 v[4];
#pragma unroll
        for (int i = 0; i < 4; ++i) { const int r = (tid >> 5) + 16 * i, c4 = (tid & 31) * 4;
            v[i] = (f32x4){0.f, 0.f, 0.f, 0.f}; if (n0 + c4 < J.N) v[i] = *(const f32x4*)(src + (size_t)(k0 + r) * J.ld + n0 + c4); }
#pragma unroll
        for (int i = 0; i < 4; ++i) { const int r = (tid >> 5) + 16 * i, c4 = (tid & 31) * 4;
#pragma unroll
            for (int q = 0; q < 4; ++q) tile[r * 129 + c4 + q] = v[i][q]; }
        __syncthreads();
        { const int n = tid >> 2, kq = (tid & 3) * 16;
          if (n0 + n < J.N) { float f[16];
#pragma unroll
              for (int q = 0; q < 16; ++q) f[q] = tile[(kq + q) * 129 + n];
              u32x4 w0, w1; w0.x = cvt_pk_bf16(f[0], f[1]); w0.y = cvt_pk_bf16(f[2], f[3]); w0.z = cvt_pk_bf16(f[4], f[5]); w0.w = cvt_pk_bf16(f[6], f[7]);
              w1.x = cvt_pk_bf16(f[8], f[9]); w1.y = cvt_pk_bf16(f[10], f[11]); w1.z = cvt_pk_bf16(f[12], f[13]); w1.w = cvt_pk_bf16(f[14], f[15]);
              if (J.fp8) { u32x4 w8; w8.x = pack_fp8x4(f[0] * 64.f, f[1] * 64.f, f[2] * 64.f, f[3] * 64.f); w8.y = pack_fp8x4(f[4] * 64.f, f[5] * 64.f, f[6] * 64.f, f[7] * 64.f);
                  w8.z = pack_fp8x4(f[8] * 64.f, f[9] * 64.f, f[10] * 64.f, f[11] * 64.f); w8.w = pack_fp8x4(f[12] * 64.f, f[13] * 64.f, f[14] * 64.f, f[15] * 64.f);
                  *(u32x4*)((unsigned char*)dst + (size_t)(n0 + n) * J.ldd + k0 + kq) = w8; }
              else { bf16_t* d = dst + (size_t)map_row(J.map, n0 + n) * J.ldd + k0 + kq; *(u32x4*)d = w0; *(u32x4*)(d + 8) = w1; } } }
        __syncthreads();
    }
}

__device__ __forceinline__ void norm_row(const float* xr, const float* g, const float* sh, const float* sc, bf16_t* hr, unsigned char* h8, int lane, float (&hv)[32]) {
    f32x4 v[8]; float ss = 0.f;
#pragma unroll
    for (int i = 0; i < 8; ++i) { v[i] = *(const f32x4*)(xr + i * 256 + lane * 4); ss += v[i][0] * v[i][0] + v[i][1] * v[i][1] + v[i][2] * v[i][2] + v[i][3] * v[i][3]; }
    ss = wave_sum(ss);
    const float rstd = rsqrtf(ss * (1.0f / 2048.0f) + RMS_EPS);
#pragma unroll
    for (int i = 0; i < 8; ++i) { const int col = i * 256 + lane * 4; const f32x4 gg = *(const f32x4*)(g + col), s1 = *(const f32x4*)(sc + col), s0 = *(const f32x4*)(sh + col);
#pragma unroll
        for (int j = 0; j < 4; ++j) hv[i * 4 + j] = v[i][j] * rstd * gg[j] * (1.0f + s1[j]) + s0[j];
        u32x2 w; w.x = cvt_pk_bf16(hv[i * 4], hv[i * 4 + 1]); w.y = cvt_pk_bf16(hv[i * 4 + 2], hv[i * 4 + 3]); *(u32x2*)(hr + col) = w;
        if (h8) *(unsigned*)(h8 + col) = pack_fp8x4(hv[i * 4], hv[i * 4 + 1], hv[i * 4 + 2], hv[i * 4 + 3]); }
}
__device__ void ph1_norm(const Params& p) {
    const int lane = threadIdx.x & 63, gw = blockIdx.x * 8 + (threadIdx.x >> 6), nw = gridDim.x * 8;
    const float* mod = (const float*)(p.ws + WS_MOD);
    for (int t = gw; t < NTOK; t += nw) { const int b = t >> 11; float hv[32];
        norm_row(p.in[I_X] + (size_t)t * DM, p.in[I_GMIX], mod + b * 12288, mod + b * 12288 + 2048, (bf16_t*)(p.ws + WS_H) + (size_t)t * DM, (unsigned char*)(p.ws + WS_HF8) + (size_t)t * DM, lane, hv); }
}

template <int MB, int NB, int KS>
__device__ __forceinline__ void wave_gemm(const bf16_t* A, int lda, const bf16_t* Bt, int ldb, f32x4 (&acc)[MB][NB], int lane) {
    const int fr = lane & 15, fq = lane >> 4;
#pragma unroll
    for (int mb = 0; mb < MB; ++mb)
#pragma unroll
        for (int nb = 0; nb < NB; ++nb) acc[mb][nb] = (f32x4){0.f, 0.f, 0.f, 0.f};
#pragma unroll 1
    for (int ks = 0; ks < KS; ++ks) {
        bf16x8 af[MB];
#pragma unroll
        for (int mb = 0; mb < MB; ++mb) af[mb] = *(const bf16x8*)(A + (size_t)(mb * 16 + fr) * lda + ks * 32 + fq * 8);
#pragma unroll
        for (int nb = 0; nb < NB; ++nb) { const bf16x8 bf = *(const bf16x8*)(Bt + (size_t)(nb * 16 + fr) * ldb + ks * 32 + fq * 8);
#pragma unroll
            for (int mb = 0; mb < MB; ++mb) acc[mb][nb] = __builtin_amdgcn_mfma_f32_16x16x32_bf16(bf, af[mb], acc[mb][nb], 0, 0, 0); }
    }
}


__device__ __forceinline__ int wave_total_i32(int v) {
    v += __builtin_amdgcn_update_dpp(0, v, 0x111, 0xf, 0xf, true); v += __builtin_amdgcn_update_dpp(0, v, 0x112, 0xf, 0xf, true);
    v += __builtin_amdgcn_update_dpp(0, v, 0x114, 0xf, 0xf, true); v += __builtin_amdgcn_update_dpp(0, v, 0x118, 0xf, 0xf, true);
    v += __builtin_amdgcn_update_dpp(0, v, 0x142, 0xa, 0xf, false); v += __builtin_amdgcn_update_dpp(0, v, 0x143, 0xc, 0xf, false);
    return __builtin_amdgcn_readlane(v, 63);
}
template <int NI> __device__ __forceinline__ unsigned long long topk_words(const LAS float* srow, int c, int lane) {
    unsigned key[NI];
#pragma unroll
    for (int i = 0; i < NI; ++i) { unsigned u = 0u; if (i <= c) { u = __float_as_uint(srow[i * 64 + lane]); u = (u & 0x80000000u) ? ~u : (u | 0x80000000u); } key[i] = u; }
    unsigned v = 0u;
#pragma unroll 1
    for (int bit = 31; bit >= 0; --bit) {
        const unsigned cand = v | (1u << bit); int cl = 0;
#pragma unroll
        for (int i = 0; i < NI; ++i) cl += (key[i] >= cand) ? 1 : 0;
        const int tot = wave_total_i32(cl);
        if (tot >= 256) { v = cand; if (tot == 256) break; }
    }
    unsigned long long myword = 0ull;
#pragma unroll
    for (int i = 0; i < NI; ++i) { const unsigned long long bm = __ballot(key[i] >= v); if (lane == i) myword = bm; if ((i & 3) == 3) SBAR(); }
    return myword;
}
__device__ void idx_item(const Params& p, LAS unsigned char* lds, int b, int c, int sub) {
    const int tid = threadIdx.x, wid = tid >> 6, lane = tid & 63, fr = lane & 15, fq = lane >> 4;
    constexpr int SCLD = 2052;
    LAS float* sc = (LAS float*)lds;
    const int q0 = c * 64 + sub * 16, nk = (c + 1) * 64, nkb = nk / 16;
    const bf16_t* qidx = (const bf16_t*)(p.ws + WS_QIDX) + (size_t)(b * SEQ + q0 + fr) * 1024;
    const float* misc = (const float*)(p.ws + WS_MISC);
    float wq[16];
    { const float* wp = misc + (size_t)(b * SEQ + q0 + fr) * 256 + 64;
#pragma unroll
      for (int i = 0; i < 4; ++i) { const f32x4 v = *(const f32x4*)(wp + i * 4); wq[i * 4] = v[0]; wq[i * 4 + 1] = v[1]; wq[i * 4 + 2] = v[2]; wq[i * 4 + 3] = v[3]; } }
#pragma unroll
    for (int hp = 0; hp < 2; ++hp) {
        bf16x8 qf[8][2];
#pragma unroll
        for (int h = 0; h < 8; ++h)
#pragma unroll
            for (int ks = 0; ks < 2; ++ks) qf[h][ks] = *(const bf16x8*)(qidx + (hp * 8 + h) * 64 + ks * 32 + fq * 8);
        const bf16_t* kbase = (const bf16_t*)(p.ws + WS_KIDX) + (size_t)(b * SEQ + fr) * 64 + fq * 8;
        bf16x8 kf[2];
        if (wid < nkb) { kf[0] = *(const bf16x8*)(kbase + (size_t)wid * 16 * 64); kf[1] = *(const bf16x8*)(kbase + (size_t)wid * 16 * 64 + 32); }
#pragma unroll 1
        for (int kb = wid; kb < nkb; kb += 8) {
            const int kn = kb + 8 < nkb ? kb + 8 : kb;
            const bf16x8 kn0 = *(const bf16x8*)(kbase + (size_t)kn * 16 * 64), kn1 = *(const bf16x8*)(kbase + (size_t)kn * 16 * 64 + 32);
            LAS f32x4* sp = (LAS f32x4*)(sc + fr * SCLD + kb * 16 + fq * 4);
            f32x4 s = {0.f, 0.f, 0.f, 0.f}; if (hp) s = *sp;
#pragma unroll
            for (int h = 0; h < 8; ++h) {
                f32x4 a = {0.f, 0.f, 0.f, 0.f};
                a = __builtin_amdgcn_mfma_f32_16x16x32_bf16(kf[0], qf[h][0], a, 0, 0, 0);
                a = __builtin_amdgcn_mfma_f32_16x16x32_bf16(kf[1], qf[h][1], a, 0, 0, 0);
#pragma unroll
                for (int j = 0; j < 4; ++j) s[j] += wq[hp * 8 + h] * fmaxf(a[j], 0.f);
            }
            *sp = s; kf[0] = kn0; kf[1] = kn1;
        }
    }
    __syncthreads();
    unsigned long long* mask = (unsigned long long*)(p.ws + WS_MASK);
    for (int qq = 0; qq < 2; ++qq) {
        const int ql = wid * 2 + qq; const size_t qg = (size_t)b * SEQ + q0 + ql;
        unsigned long long myword = 0ull;
        if (nk <= 256) { if (lane <= c) myword = ~0ull; }
        else { const LAS float* srow = sc + ql * SCLD;
            if (c < 8) myword = topk_words<8>(srow, c, lane); else if (c < 16) myword = topk_words<16>(srow, c, lane);
            else if (c < 24) myword = topk_words<24>(srow, c, lane); else myword = topk_words<32>(srow, c, lane); }
        if (lane < 32) mask[qg * 32 + lane] = myword;
    }
    __syncthreads();
}
#ifndef REP_SUB
#define REP_SUB 15
#endif
__device__ void ph3_prep(const Params& p, LAS unsigned char* lds, const int rep) {
#define P3ON(bit) (!rep || ((REP_SUB) & (bit)))
    const int tid = threadIdx.x, wid = tid >> 6, lane = tid & 63, bx = blockIdx.x, G = gridDim.x;
    if (P3ON(1)) for (int it = bx; it < 256; it += G) {
        const int b = it >> 6, r = it & 63, cp = r >> 2, sub = r & 3;
        idx_item(p, lds, b, 31 - cp, sub); idx_item(p, lds, b, cp, sub);
    }
    const int gw = bx * 8 + wid, nw = G * 8;
    if (P3ON(2)) for (int it = gw; it < 2048; it += nw) {
        const int rt = it >> 3, h = it & 7, fr = lane & 15, fq = lane >> 4;
        f32x4 acc[2][16];
        wave_gemm<2, 16, 4>((const bf16_t*)(p.ws + WS_QA) + (size_t)rt * 32 * 1024 + h * 128, 1024, (const bf16_t*)(p.ws + WS_WUK) + (size_t)h * 256 * 128, 128, acc, lane);
#pragma unroll
        for (int mb = 0; mb < 2; ++mb) { float ss = 0.f;
#pragma unroll
            for (int nb = 0; nb < 16; ++nb)
#pragma unroll
                for (int j = 0; j < 4; ++j) ss += acc[mb][nb][j] * acc[mb][nb][j];
            ss += __shfl_xor(ss, 16); ss += __shfl_xor(ss, 32);
            const float rs = rsqrtf(ss * (1.0f / 256.0f) + RMS_EPS) * 0.0625f;
            bf16_t* o = (bf16_t*)(p.ws + WS_QLAT) + (size_t)(rt * 32 + mb * 16 + fr) * 2048 + h * 256;
#pragma unroll
            for (int nb = 0; nb < 16; ++nb) { const int col = nb * 16 + fq * 4; const f32x4 g = *(const f32x4*)(p.in[I_GQA] + col);
                u32x2 w; w.x = cvt_pk_bf16(acc[mb][nb][0] * rs * g[0], acc[mb][nb][1] * rs * g[1]); w.y = cvt_pk_bf16(acc[mb][nb][2] * rs * g[2], acc[mb][nb][3] * rs * g[3]); *(u32x2*)(o + col) = w; } }
    }
    if (P3ON(4)) for (int t = gw; t < NTOK; t += nw) {
        { const f32x4 v = *(const f32x4*)((const float*)(p.ws + WS_CKV) + (size_t)t * 256 + lane * 4); float ss = wave_sum(v[0] * v[0] + v[1] * v[1] + v[2] * v[2] + v[3] * v[3]);
          const float rs = rsqrtf(ss * (1.0f / 256.0f) + RMS_EPS); const f32x4 g = *(const f32x4*)(p.in[I_GKV] + lane * 4);
          u32x2 w; w.x = cvt_pk_bf16(v[0] * rs * g[0], v[1] * rs * g[1]); w.y = cvt_pk_bf16(v[2] * rs * g[2], v[3] * rs * g[3]); *(u32x2*)((bf16_t*)(p.ws + WS_KV) + (size_t)t * 256 + lane * 4) = w; }
#pragma unroll
        for (int which = 0; which < 2; ++which) {
            bf16_t* row = (bf16_t*)(p.ws + (which ? WS_KB : WS_QB)) + (size_t)t * 1024 + lane * 16; const float* g = p.in[which ? I_GKB : I_GQB] + (lane & 7) * 16;
            u32x4 a = *(u32x4*)row, c2 = *(u32x4*)(row + 8); float f[16];
            f[0] = bf_lo(a.x); f[1] = bf_hi(a.x); f[2] = bf_lo(a.y); f[3] = bf_hi(a.y); f[4] = bf_lo(a.z); f[5] = bf_hi(a.z); f[6] = bf_lo(a.w); f[7] = bf_hi(a.w);
            f[8] = bf_lo(c2.x); f[9] = bf_hi(c2.x); f[10] = bf_lo(c2.y); f[11] = bf_hi(c2.y); f[12] = bf_lo(c2.z); f[13] = bf_hi(c2.z); f[14] = bf_lo(c2.w); f[15] = bf_hi(c2.w);
            float ss = 0.f;
#pragma unroll
            for (int j = 0; j < 16; ++j) ss += f[j] * f[j];
            ss += __shfl_xor(ss, 1); ss += __shfl_xor(ss, 2); ss += __shfl_xor(ss, 4);
            const float rs = rsqrtf(ss * (1.0f / 128.0f) + RMS_EPS) * (which ? 1.0f : 0.08838834764831845f);
#pragma unroll
            for (int j = 0; j < 16; ++j) f[j] *= rs * g[j];
            a.x = cvt_pk_bf16(f[0], f[1]); a.y = cvt_pk_bf16(f[2], f[3]); a.z = cvt_pk_bf16(f[4], f[5]); a.w = cvt_pk_bf16(f[6], f[7]);
            c2.x = cvt_pk_bf16(f[8], f[9]); c2.y = cvt_pk_bf16(f[10], f[11]); c2.z = cvt_pk_bf16(f[12], f[13]); c2.w = cvt_pk_bf16(f[14], f[15]);
            if (!rep) { *(u32x4*)row = a; *(u32x4*)(row + 8) = c2; } else if (a.x == 0x12345678u) *(u32x4*)row = c2;
        }
    }
    if (P3ON(8) && bx < NBATCH) {
        const int b = bx; const float* fp = (const float*)(p.ws + WS_MISC) + (size_t)(b * SEQ + 4 * tid) * 256 + 80;
        float ls[4][8];
#pragma unroll
        for (int j = 0; j < 4; ++j) { const f32x4 a = *(const f32x4*)(fp + j * 256), c4 = *(const f32x4*)(fp + j * 256 + 4);
#pragma unroll
            for (int h = 0; h < 8; ++h) { const float z = (h < 4 ? a[h & 3] : c4[h & 3]) + p.in[I_BFORGET][h]; ls[j][h] = fminf(z, 0.f) - log1pf(__expf(-fabsf(z))); } }
        LAS float* wt = (LAS float*)lds;
        float off[8];
#pragma unroll
        for (int h = 0; h < 8; ++h) { ls[1][h] += ls[0][h]; ls[2][h] += ls[1][h]; ls[3][h] += ls[2][h];
            float incl = ls[3][h];
#pragma unroll
            for (int o = 1; o < 64; o <<= 1) { const float t2 = __shfl_up(incl, o); if (lane >= o) incl += t2; }
            if (lane == 63) wt[wid * 8 + h] = incl;
            off[h] = incl - ls[3][h]; }
        __syncthreads();
#pragma unroll
        for (int h = 0; h < 8; ++h) { float wo = 0.f; for (int w8 = 0; w8 < wid; ++w8) wo += wt[w8 * 8 + h];
            float* cp = (float*)(p.ws + WS_CUM) + (size_t)(b * 8 + h) * SEQ + 4 * tid;
            *(f32x4*)cp = (f32x4){ls[0][h] + off[h] + wo, ls[1][h] + off[h] + wo, ls[2][h] + off[h] + wo, ls[3][h] + off[h] + wo}; }
        __syncthreads();
    }
}

template <int OFF> __device__ __forceinline__ s16x4 tr_read(int vb) { s16x4 r; asm volatile("ds_read_b64_tr_b16 %0, %1 offset:%2" : "=&v"(r) : "v"(vb), "i"(OFF) : "memory"); return r; }
__device__ __forceinline__ int v_rd_base(int lane) { return ((lane & 3) << 3) | (((lane >> 2) & 3) << 6) | (((lane >> 4) & 1) << 5) | (((lane >> 5) & 1) << 8); }
#define PK4(P, BASE, OUT) do { unsigned a0 = cvt_pk_bf16(P[BASE + 0], P[BASE + 1]), a1 = cvt_pk_bf16(P[BASE + 2], P[BASE + 3]);   \
    unsigned b0 = cvt_pk_bf16(P[BASE + 4], P[BASE + 5]), b1 = cvt_pk_bf16(P[BASE + 6], P[BASE + 7]);                              \
    auto r0 = __builtin_amdgcn_permlane32_swap(a0, b0, false, false); auto r1 = __builtin_amdgcn_permlane32_swap(a1, b1, false, false); \
    u32x4 w = {r0[0], r1[0], r0[1], r1[1]}; OUT = *reinterpret_cast<bf16x8*>(&w); } while (0)
#define PKV(L, H) (bf16x8){L[0], L[1], L[2], L[3], H[0], H[1], H[2], H[3]}
template <int NCB, int KS0, int D0> struct PvPairs { static __device__ __forceinline__ void run(f32x16* o, int vb, bf16x8 pa0, bf16x8 pa1) {
    constexpr int S = 2 * NCB * 512, H = NCB * 512;
    const s16x4 l00 = tr_read<D0 * 512 + KS0 * S>(vb), h00 = tr_read<D0 * 512 + KS0 * S + H>(vb), l01 = tr_read<D0 * 512 + (KS0 + 1) * S>(vb), h01 = tr_read<D0 * 512 + (KS0 + 1) * S + H>(vb);
    const s16x4 l10 = tr_read<(D0 + 1) * 512 + KS0 * S>(vb), h10 = tr_read<(D0 + 1) * 512 + KS0 * S + H>(vb), l11 = tr_read<(D0 + 1) * 512 + (KS0 + 1) * S>(vb), h11 = tr_read<(D0 + 1) * 512 + (KS0 + 1) * S + H>(vb);
    asm volatile("s_waitcnt lgkmcnt(0)" ::: "memory"); SBAR();
    o[D0] = __builtin_amdgcn_mfma_f32_32x32x16_bf16(pa0, PKV(l00, h00), o[D0], 0, 0, 0); o[D0 + 1] = __builtin_amdgcn_mfma_f32_32x32x16_bf16(pa0, PKV(l10, h10), o[D0 + 1], 0, 0, 0);
    o[D0] = __builtin_amdgcn_mfma_f32_32x32x16_bf16(pa1, PKV(l01, h01), o[D0], 0, 0, 0); o[D0 + 1] = __builtin_amdgcn_mfma_f32_32x32x16_bf16(pa1, PKV(l11, h11), o[D0 + 1], 0, 0, 0);
    if constexpr (D0 + 2 < NCB) PvPairs<NCB, KS0, D0 + 2>::run(o, vb, pa0, pa1); } };
__device__ __forceinline__ int swap23(int k) { return (k & ~0xC) | ((k & 4) << 1) | ((k & 8) >> 1); }
constexpr int FOX_STAGE = 33024;
constexpr int FOX_AL = 2 * FOX_STAGE, FOX_LI = FOX_AL + 1024;
__device__ void fox_item(const Params& p, LAS unsigned char* lds, int b, int h, int qb) {
    int tid = threadIdx.x; asm volatile("" : "+v"(tid));
    const int wid = __builtin_amdgcn_readfirstlane(tid >> 6), lane = tid & 63, r32 = lane & 31, hi = lane >> 5;
    const bf16_t* Q = (const bf16_t*)(p.ws + WS_QB);
    const char* Kg = (const char*)(p.ws + WS_KB) + ((size_t)b * SEQ * 1024 + h * 128) * 2; const char* Vg = (const char*)(p.ws + WS_VB) + ((size_t)b * SEQ * 1024 + h * 128) * 2;
    const float* cum = (const float*)(p.ws + WS_CUM) + (size_t)(b * 8 + h) * SEQ;
    const int qpos = qb * 256 + wid * 32 + r32;
    bf16x8 qr[8];
    { const bf16_t* qp = Q + (size_t)(b * SEQ + qpos) * 1024 + h * 128 + hi * 8;
#pragma unroll
      for (int d0 = 0; d0 < 8; ++d0) qr[d0] = *(const bf16x8*)(qp + d0 * 16); }
    const float cq = cum[qpos] * LOG2E;
    unsigned ksrc[2], vsrc[2];
#pragma unroll
    for (int i = 0; i < 2; ++i) { const int pos = (i * 512 + tid) * 16;
        { const int row = pos >> 8; const int cb = (pos & 255) ^ ((row & 7) << 4); ksrc[i] = (unsigned)(row * 2048 + cb); }
        { const int sub = pos >> 9, within = pos & 511; const int kk = (sub >> 2) * 8 + (within >> 6); const int c = (sub & 3) * 32 + ((within & 63) >> 1); vsrc[i] = (unsigned)(swap23(kk) * 2048 + c * 2); } }
    float m_reg = -1e30f, l_reg = 0.f; f32x16 o[4];
#pragma unroll
    for (int d = 0; d < 4; ++d)
#pragma unroll
        for (int r = 0; r < 16; ++r) o[d][r] = 0.f;
    LAS float* al_l = (LAS float*)(lds + FOX_AL) + wid * 32; LAS float* li_l = (LAS float*)(lds + FOX_LI) + wid * 32;
    const int ntiles = qb * 4 + 4, mylast = qb * 4 + (wid >> 1);
#define FOX_DMA(kt) do { LAS unsigned char* sb_ = lds + ((kt) & 1) * FOX_STAGE; const size_t go_ = (size_t)(kt) * 64 * 2048; \
        _Pragma("unroll") for (int i = 0; i < 2; ++i) { \
            __builtin_amdgcn_global_load_lds((const unsigned*)(Kg + go_ + ksrc[i]), (LAS unsigned*)(sb_ + 16384 + (i * 512 + wid * 64) * 16), 16, 0, 0); \
            __builtin_amdgcn_global_load_lds((const unsigned*)(Vg + go_ + vsrc[i]), (LAS unsigned*)(sb_ + (i * 512 + wid * 64) * 16), 16, 0, 0); } \
        if (wid == 0) __builtin_amdgcn_global_load_lds((const unsigned*)(cum + (kt) * 64 + lane), (LAS unsigned*)(sb_ + 32768), 4, 0, 0); } while (0)
    __syncthreads();
    FOX_DMA(0);
    for (int kt = 0; kt < ntiles; ++kt) {
        asm volatile("s_waitcnt vmcnt(0)" ::: "memory");
        __syncthreads();
        if (kt + 1 < ntiles) FOX_DMA(kt + 1);
        if (kt <= mylast) {
            const LAS unsigned char* sb = lds + (kt & 1) * FOX_STAGE; const LAS float* ck = (const LAS float*)(sb + 32768);
            const int vb = (int)(uintptr_t)sb + v_rd_base(lane);
            f32x16 p0, p1;
#pragma unroll
            for (int r = 0; r < 16; ++r) { p0[r] = 0.f; p1[r] = 0.f; }
            int fsw = (r32 & 7) << 4; asm volatile("" : "+v"(fsw));
#pragma unroll
            for (int d0 = 0; d0 < 8; ++d0) { const int cb = (d0 * 16 + hi * 8) * 2;
                const bf16x8 b0 = *(const LAS bf16x8*)(sb + 16384 + r32 * 256 + (cb ^ fsw));
                const bf16x8 b1 = *(const LAS bf16x8*)(sb + 16384 + (32 + r32) * 256 + (cb ^ fsw));
                p0 = __builtin_amdgcn_mfma_f32_32x32x16_bf16(b0, qr[d0], p0, 0, 0, 0); p1 = __builtin_amdgcn_mfma_f32_32x32x16_bf16(b1, qr[d0], p1, 0, 0, 0); }
            const bool diag = (kt * 64 + 63 > qb * 256 + wid * 32);
            float pmax = -INFINITY;
#pragma unroll
            for (int g4 = 0; g4 < 4; ++g4) { const f32x4 c0 = *(const LAS f32x4*)(ck + 8 * g4 + 4 * hi), c1 = *(const LAS f32x4*)(ck + 32 + 8 * g4 + 4 * hi);
#pragma unroll
                for (int j = 0; j < 4; ++j) { const int r = g4 * 4 + j; float t0 = fmaf(p0[r], LOG2E, cq) - c0[j] * LOG2E, t1 = fmaf(p1[r], LOG2E, cq) - c1[j] * LOG2E;
                    if (diag) { const int kp = kt * 64 + crow(r, hi); if (kp > qpos) t0 = -INFINITY; if (kp + 32 > qpos) t1 = -INFINITY; }
                    p0[r] = t0; p1[r] = t1; pmax = fmaxf(pmax, fmaxf(t0, t1)); } }
            { auto rr = __builtin_amdgcn_permlane32_swap(__float_as_uint(pmax), __float_as_uint(pmax), false, false); pmax = fmaxf(__uint_as_float(rr[0]), __uint_as_float(rr[1])); }
            const float mn = fmaxf(m_reg, pmax); const float alpha = __builtin_amdgcn_exp2f(m_reg - mn); m_reg = mn;
            float ps = 0.f;
#pragma unroll
            for (int r = 0; r < 16; ++r) { p0[r] = __builtin_amdgcn_exp2f(p0[r] - mn); p1[r] = __builtin_amdgcn_exp2f(p1[r] - mn); ps += p0[r] + p1[r]; }
            { auto rr = __builtin_amdgcn_permlane32_swap(__float_as_uint(ps), __float_as_uint(ps), false, false); ps = __uint_as_float(rr[0]) + __uint_as_float(rr[1]); }
            l_reg = l_reg * alpha + ps;
            if (__any(alpha < 1.f)) { if (hi == 0) al_l[r32] = alpha; asm volatile("s_waitcnt lgkmcnt(0)" ::: "memory");
#pragma unroll
                for (int r = 0; r < 16; ++r) { const float a = al_l[crow(r, hi)];
#pragma unroll
                    for (int d = 0; d < 4; ++d) o[d][r] *= a; } }
            bf16x8 pa0, pa1, pa2, pa3; PK4(p0, 0, pa0); PK4(p0, 8, pa1); PK4(p1, 0, pa2); PK4(p1, 8, pa3);
            PvPairs<4, 0, 0>::run(o, vb, pa0, pa1); PvPairs<4, 2, 0>::run(o, vb, pa2, pa3);
        }
    }
#undef FOX_DMA
    if (hi == 0) li_l[r32] = l_reg; asm volatile("s_waitcnt lgkmcnt(0)" ::: "memory");
    unsigned char* O8 = (unsigned char*)(p.ws + WS_OB8) + (size_t)(b * SEQ + qb * 256 + wid * 32) * 1024 + h * 128;
#pragma unroll
    for (int r = 0; r < 16; ++r) { const float rl = __builtin_amdgcn_rcpf(li_l[crow(r, hi)]); const int orow = crow(r, hi);
#pragma unroll
        for (int d0 = 0; d0 < 4; ++d0) O8[(size_t)orow * 1024 + d0 * 32 + r32] = (unsigned char)(pack_fp8x4(o[d0][r] * rl * 8.f, 0.f, 0.f, 0.f) & 0xffu); }
}

constexpr int DSA_STAGE = 32768;
constexpr int DSA_AL = 2 * DSA_STAGE, DSA_LI = DSA_AL + 1024, DSA_Q = DSA_LI + 1024;
__device__ void dsa_item(const Params& p, LAS unsigned char* lds, int b, int qt) {
    int tid = threadIdx.x; asm volatile("" : "+v"(tid));
    const int wid = __builtin_amdgcn_readfirstlane(tid >> 6), lane = tid & 63, r32 = lane & 31, hi = lane >> 5, h = wid;
    const char* KV = (const char*)(p.ws + WS_KV) + (size_t)b * SEQ * 512;
    const int qpos = qt * 32 + r32; const size_t qg = (size_t)b * SEQ + qpos;
    const unsigned* mask = (const unsigned*)(p.ws + WS_MASK) + qg * 64;
    bf16x8 qr[8];
    LAS unsigned char* qlds = lds + DSA_Q + wid * 8192 + lane * 16;
    __syncthreads();
    { const bf16_t* qp = (const bf16_t*)(p.ws + WS_QLAT) + qg * 2048 + h * 256 + hi * 8;
#pragma unroll
      for (int d0 = 0; d0 < 8; ++d0) qr[d0] = *(const bf16x8*)(qp + d0 * 16);
#pragma unroll
      for (int d0 = 8; d0 < 16; ++d0) *(LAS bf16x8*)(qlds + (d0 - 8) * 1024) = *(const bf16x8*)(qp + d0 * 16); }
    unsigned ksrc[2], vsrc[2];
#pragma unroll
    for (int i = 0; i < 2; ++i) { const int pos = (i * 512 + tid) * 16;
        { const int row = pos >> 9; const int cb = (pos & 511) ^ ((row & 15) << 4); ksrc[i] = (unsigned)(row * 512 + cb); }
        { const int sub = pos >> 9, within = pos & 511; const int kk = (sub >> 3) * 8 + (within >> 6); const int c = (sub & 7) * 32 + ((within & 63) >> 1); vsrc[i] = (unsigned)(swap23(kk) * 512 + c * 2); } }
    const float slopeL = exp2f(-(float)(h + 1)) * LOG2E;
    float m_reg = -1e30f, l_reg = 0.f; f32x16 o[8];
#pragma unroll
    for (int d = 0; d < 8; ++d)
#pragma unroll
        for (int r = 0; r < 16; ++r) o[d][r] = 0.f;
    LAS float* al_l = (LAS float*)(lds + DSA_AL) + wid * 32; LAS float* li_l = (LAS float*)(lds + DSA_LI) + wid * 32;
    const int ntiles = ((qt >> 1) + 1) * 2;
#define DSA_DMA(kt) do { LAS unsigned char* sb_ = lds + ((kt) & 1) * DSA_STAGE; const size_t go_ = (size_t)(kt) * 32 * 512; \
        _Pragma("unroll") for (int i = 0; i < 2; ++i) { \
            __builtin_amdgcn_global_load_lds((const unsigned*)(KV + go_ + ksrc[i]), (LAS unsigned*)(sb_ + 16384 + (i * 512 + wid * 64) * 16), 16, 0, 0); \
            __builtin_amdgcn_global_load_lds((const unsigned*)(KV + go_ + vsrc[i]), (LAS unsigned*)(sb_ + (i * 512 + wid * 64) * 16), 16, 0, 0); } } while (0)
    unsigned mw = mask[0];
    DSA_DMA(0);
    for (int kt = 0; kt < ntiles; ++kt) {
        asm volatile("s_waitcnt vmcnt(0)" ::: "memory");
        __syncthreads();
        const unsigned mcur = mw;
        if (kt + 1 < ntiles) { mw = mask[kt + 1]; DSA_DMA(kt + 1); }
        const LAS unsigned char* sb = lds + (kt & 1) * DSA_STAGE; const int vb = (int)(uintptr_t)sb + v_rd_base(lane);
        f32x16 pp;
#pragma unroll
        for (int r = 0; r < 16; ++r) pp[r] = 0.f;
        {
            const LAS unsigned char* kb_ = sb + 16384 + r32 * 512; int sw_ = (r32 & 15) << 4; asm volatile("" : "+v"(sw_));
#define DSA_KF(d0) (*(const LAS bf16x8*)(kb_ + ((((d0) * 16 + hi * 8) * 2) ^ sw_)))
#define DSA_QF(d0) ((d0) < 8 ? qr[(d0) & 7] : *(const LAS bf16x8*)(qlds + (((d0) - 8) & 7) * 1024))
            bf16x8 k0 = DSA_KF(0), k1 = DSA_KF(1), q0 = DSA_QF(0), q1 = DSA_QF(1);
#pragma unroll
            for (int d0 = 0; d0 < 16; d0 += 2) {
                bf16x8 nk0 = k0, nk1 = k1, nq0 = q0, nq1 = q1;
                if (d0 + 2 < 16) { nk0 = DSA_KF(d0 + 2); nk1 = DSA_KF(d0 + 3); nq0 = DSA_QF(d0 + 2); nq1 = DSA_QF(d0 + 3); }
                pp = __builtin_amdgcn_mfma_f32_32x32x16_bf16(k0, q0, pp, 0, 0, 0); pp = __builtin_amdgcn_mfma_f32_32x32x16_bf16(k1, q1, pp, 0, 0, 0);
                k0 = nk0; k1 = nk1; q0 = nq0; q1 = nq1; SBAR();
            }
#undef DSA_KF
#undef DSA_QF
        }
        const unsigned wsh = mcur >> (4 * hi);
        const float df = (float)(qpos - (kt * 32 + 4 * hi));
        float pmax = -INFINITY;
#pragma unroll
        for (int r = 0; r < 16; ++r) { const int cb = (r & 3) + 8 * (r >> 2); const float dd = df - (float)cb;
            float t = fmaf(-slopeL, fabsf(dd), pp[r] * LOG2E); if (!((wsh >> cb) & 1u)) t = -INFINITY; pp[r] = t; pmax = fmaxf(pmax, t); }
        { auto rr = __builtin_amdgcn_permlane32_swap(__float_as_uint(pmax), __float_as_uint(pmax), false, false); pmax = fmaxf(__uint_as_float(rr[0]), __uint_as_float(rr[1])); }
        const float mn = fmaxf(m_reg, pmax); const float alpha = __builtin_amdgcn_exp2f(m_reg - mn); m_reg = mn;
        float ps = 0.f;
#pragma unroll
        for (int r = 0; r < 16; ++r) { pp[r] = __builtin_amdgcn_exp2f(pp[r] - mn); ps += pp[r]; }
        { auto rr = __builtin_amdgcn_permlane32_swap(__float_as_uint(ps), __float_as_uint(ps), false, false); ps = __uint_as_float(rr[0]) + __uint_as_float(rr[1]); }
        l_reg = l_reg * alpha + ps;
        if (__any(alpha < 1.f)) { if (hi == 0) al_l[r32] = alpha; asm volatile("s_waitcnt lgkmcnt(0)" ::: "memory");
#pragma unroll
            for (int r = 0; r < 16; ++r) { const float a = al_l[crow(r, hi)];
#pragma unroll
                for (int d = 0; d < 8; ++d) o[d][r] *= a; } }
        bf16x8 pa0, pa1; PK4(pp, 0, pa0); PK4(pp, 8, pa1);
        PvPairs<8, 0, 0>::run(o, vb, pa0, pa1);
    }
#undef DSA_DMA
    if (hi == 0) li_l[r32] = l_reg; asm volatile("s_waitcnt lgkmcnt(0)" ::: "memory");
    float rl[16];
#pragma unroll
    for (int r = 0; r < 16; ++r) rl[r] = __builtin_amdgcn_rcpf(li_l[crow(r, hi)]);
    __syncthreads();
    LAS bf16_t* os = (LAS bf16_t*)(lds + wid * 16896);
#pragma unroll
    for (int r = 0; r < 16; ++r)
#pragma unroll
        for (int d0 = 0; d0 < 8; ++d0) os[crow(r, hi) * 264 + d0 * 32 + r32] = (bf16_t)(cvt_pk_bf16(o[d0][r] * rl[r], 0.f) & 0xffffu);
    asm volatile("s_waitcnt lgkmcnt(0)" ::: "memory");
    f32x16 ya[4];
#pragma unroll
    for (int nb = 0; nb < 4; ++nb)
#pragma unroll
        for (int r = 0; r < 16; ++r) ya[nb][r] = 0.f;
    const bf16_t* wv = (const bf16_t*)(p.ws + WS_WUV) + (size_t)(h * 128 + r32) * 256 + hi * 8;
#pragma unroll 4
    for (int ks = 0; ks < 16; ++ks) {
        const bf16x8 af = *(const LAS bf16x8*)(os + r32 * 264 + ks * 16 + hi * 8);
#pragma unroll
        for (int nb = 0; nb < 4; ++nb) { const bf16x8 wf = *(const bf16x8*)(wv + (size_t)nb * 32 * 256 + ks * 16); ya[nb] = __builtin_amdgcn_mfma_f32_32x32x16_bf16(wf, af, ya[nb], 0, 0, 0); }
    }
    unsigned char* O8 = (unsigned char*)(p.ws + WS_OA8) + ((size_t)b * SEQ + qt * 32 + r32) * 1024 + h * 128 + 4 * hi;
#pragma unroll
    for (int nb = 0; nb < 4; ++nb)
#pragma unroll
        for (int g4 = 0; g4 < 4; ++g4) *(unsigned*)(O8 + nb * 32 + g4 * 8) = pack_fp8x4(ya[nb][g4 * 4] * 8.f, ya[nb][g4 * 4 + 1] * 8.f, ya[nb][g4 * 4 + 2] * 8.f, ya[nb][g4 * 4 + 3] * 8.f);
}
__device__ void ph4_attn(const Params& p, LAS unsigned char* lds) {
    const int r = blockIdx.x;
    if (r < 256) { const int c = 31 - (r >> 3), w8 = r & 7, b = w8 >> 1, half = w8 & 1; dsa_item(p, lds, b, c * 2 + half); }
    int* qhead = (int*)(p.ws + WS_CNT) + 512;
    LAS int* slot = (LAS int*)(lds + LDS_BARW - 16);
    for (;;) {
        __syncthreads();
        if (threadIdx.x == 0) *slot = atomicAdd(qhead, 1);
        __syncthreads();
        const int it = __builtin_amdgcn_readfirstlane(*slot);
        if (it >= 256) break;
        const int qb = 7 - (it >> 5), bh = it & 31;
        fox_item(p, lds, bh >> 3, bh & 7, qb);
    }
}

__device__ void ph8_router(const Params& p, LAS unsigned char* lds, const int rep) {
    const int tid = threadIdx.x, wid = tid >> 6, lane = tid & 63, fr = lane & 15, fq = lane >> 4;
    const float* mod = (const float*)(p.ws + WS_MOD);
    bf16_t* H = (bf16_t*)(p.ws + WS_H); bf16_t* HL = (bf16_t*)(p.ws + WS_HLO);
    int* cnt = (int*)(p.ws + WS_CNT) + rep * 256; int* ltok = rep ? (int*)(p.ws + WS_T1) : (int*)(p.ws + WS_LTOK); float* lw = rep ? (float*)(p.ws + WS_T1 + (4u << 20)) : (float*)(p.ws + WS_LW);
    LAS float* slab = (LAS float*)lds + wid * 2560;
    LAS float* lg = (LAS float*)lds + 8 * 2560;
    for (int blk = blockIdx.x; blk < NTOK / 32; blk += gridDim.x) {
        const int t0 = blk * 32;
        {
            const int tb = t0 + wid * 4, b = tb >> 11;
            const float* sh = mod + b * 12288 + 6144; const float* sc = mod + b * 12288 + 8192;
            f32x4 xv[4][8];
#pragma unroll
            for (int rr = 0; rr < 4; ++rr)
#pragma unroll
                for (int i = 0; i < 8; ++i) { const size_t eo = (size_t)(tb + rr) * DM + i * 256 + lane * 4; const u32x2 yb = *(const u32x2*)((const bf16_t*)(p.ws + WS_MERGED) + eo);
                    xv[rr][i] = *(const f32x4*)(p.in[I_X] + eo) + (f32x4){bf_lo(yb.x), bf_hi(yb.x), bf_lo(yb.y), bf_hi(yb.y)}; }
#pragma unroll
            for (int rr = 0; rr < 4; ++rr) {
                float ss = 0.f;
#pragma unroll
                for (int i = 0; i < 8; ++i) ss += xv[rr][i][0] * xv[rr][i][0] + xv[rr][i][1] * xv[rr][i][1] + xv[rr][i][2] * xv[rr][i][2] + xv[rr][i][3] * xv[rr][i][3];
                ss = wave_sum(ss);
                const float rstd = rsqrtf(ss * (1.0f / 2048.0f) + RMS_EPS);
#pragma unroll
                for (int i = 0; i < 8; ++i) { const int col = i * 256 + lane * 4; const f32x4 gg = *(const f32x4*)(p.in[I_GFFN] + col), s1 = *(const f32x4*)(sc + col), s0 = *(const f32x4*)(sh + col);
                    float hv[4], lo[4];
#pragma unroll
                    for (int j = 0; j < 4; ++j) hv[j] = xv[rr][i][j] * rstd * gg[j] * (1.0f + s1[j]) + s0[j];
                    u32x2 wh; wh.x = cvt_pk_bf16(hv[0], hv[1]); wh.y = cvt_pk_bf16(hv[2], hv[3]);
                    lo[0] = hv[0] - bf_lo(wh.x); lo[1] = hv[1] - bf_hi(wh.x); lo[2] = hv[2] - bf_lo(wh.y); lo[3] = hv[3] - bf_hi(wh.y);
                    u32x2 wl; wl.x = cvt_pk_bf16(lo[0], lo[1]); wl.y = cvt_pk_bf16(lo[2], lo[3]);
                    *(u32x2*)(H + (size_t)(tb + rr) * DM + col) = wh; *(u32x2*)(HL + (size_t)(tb + rr) * DM + col) = wl;
                    *(unsigned*)(p.ws + WS_H8 + (size_t)(tb + rr) * DM + col) = pack_fp8x4(hv[0], hv[1], hv[2], hv[3]); }
            }
        }
        asm volatile("s_waitcnt vmcnt(0)" ::: "memory");
        __syncthreads();
        {
            const bf16_t* Ah = H + (size_t)(t0 + fr) * DM + wid * 256 + fq * 8; const bf16_t* Al = HL + (size_t)(t0 + fr) * DM + wid * 256 + fq * 8;
            const bf16_t* Wh = (const bf16_t*)(p.ws + WS_WRH) + (size_t)fr * DM + wid * 256 + fq * 8; const bf16_t* Wl = (const bf16_t*)(p.ws + WS_WRL) + (size_t)fr * DM + wid * 256 + fq * 8;
            f32x4 acc[2][5];
#pragma unroll
            for (int mb = 0; mb < 2; ++mb)
#pragma unroll
                for (int nb = 0; nb < 5; ++nb) acc[mb][nb] = (f32x4){0.f, 0.f, 0.f, 0.f};
#pragma unroll 4
            for (int ks = 0; ks < 8; ++ks) {
                bf16x8 ah[2], al[2];
#pragma unroll
                for (int mb = 0; mb < 2; ++mb) { ah[mb] = *(const bf16x8*)(Ah + (size_t)mb * 16 * DM + ks * 32); al[mb] = *(const bf16x8*)(Al + (size_t)mb * 16 * DM + ks * 32); }
#pragma unroll
                for (int nb = 0; nb < 5; ++nb) { const bf16x8 wh = *(const bf16x8*)(Wh + (size_t)nb * 16 * DM + ks * 32), wl = *(const bf16x8*)(Wl + (size_t)nb * 16 * DM + ks * 32);
#pragma unroll
                    for (int mb = 0; mb < 2; ++mb) {
                        acc[mb][nb] = __builtin_amdgcn_mfma_f32_16x16x32_bf16(wh, ah[mb], acc[mb][nb], 0, 0, 0);
                        acc[mb][nb] = __builtin_amdgcn_mfma_f32_16x16x32_bf16(wl, ah[mb], acc[mb][nb], 0, 0, 0);
                        acc[mb][nb] = __builtin_amdgcn_mfma_f32_16x16x32_bf16(wh, al[mb], acc[mb][nb], 0, 0, 0); } }
            }
#pragma unroll
            for (int mb = 0; mb < 2; ++mb)
#pragma unroll
                for (int nb = 0; nb < 5; ++nb) *(LAS f32x4*)(slab + (mb * 16 + fr) * 80 + nb * 16 + fq * 4) = acc[mb][nb];
        }
        __syncthreads();
        for (int o = tid; o < 2560; o += NTHREADS) { float s = 0.f;
#pragma unroll
            for (int w8 = 0; w8 < 8; ++w8) s += ((LAS float*)lds)[w8 * 2560 + o];
            lg[o] = s; }
        __syncthreads();
        if (tid < 32) {
            const int t = t0 + tid; const LAS float* L = lg + tid * 80;
            float gl[8]; int gi = 0; float gm = -INFINITY;
#pragma unroll
            for (int g = 0; g < 8; ++g) { gl[g] = L[g] + p.in[I_BRG][g]; if (gl[g] > gm) { gm = gl[g]; gi = g; } }
            float se = 0.f;
#pragma unroll
            for (int g = 0; g < 8; ++g) se += __expf(gl[g] - gm);
            const float gwt = 1.0f / se;
            float v1 = -INFINITY, v2 = -INFINITY; int i1 = 0, i2 = 0;
            for (int e = 0; e < 8; ++e) { const float v = L[8 + gi * 8 + e] + p.in[I_BRE][gi * 8 + e];
                if (v > v1) { v2 = v1; i2 = i1; v1 = v; i1 = e; } else if (v > v2) { v2 = v; i2 = e; } }
            const float e2 = __expf(v2 - v1); const float p1 = gwt / (1.0f + e2), p2 = gwt * e2 / (1.0f + e2);
            const int ea = gi * 8 + i1, eb = gi * 8 + i2;
            const int pa = atomicAdd(cnt + ea, 1); const int pb = atomicAdd(cnt + eb, 1);
            ltok[ea * LCAP + pa] = t; lw[ea * LCAP + pa] = p1;
            ltok[eb * LCAP + pb] = t | 0x10000; lw[eb * LCAP + pb] = p2;
        }
        __syncthreads();
    }
}

#define MOE_GLOAD(dst, ptr) asm volatile("global_load_dwordx4 %0, %1, off nt" : "=v"(dst) : "v"(ptr) : "memory")
template <bool UP>
__device__ void moe_gemm(const Params& p, LAS unsigned char* lds, const int rep) {
    constexpr int K = UP ? 2048 : 512, NKT = K / 32, NS = UP ? 8 : 16, LDW = UP ? 512 : 2048;
    constexpr int NSTA = 3, OFF_A = 0, OFF_B = NSTA * 16384;
    int tid = threadIdx.x; asm volatile("" : "+v"(tid));
    const int w = __builtin_amdgcn_readfirstlane(tid >> 6), l = tid & 63, r32 = l & 31, hi = l >> 5;
    LAS int* tab = (LAS int*)(lds + LDS_TAB);
    if (tid == 0) { const int* cnt = (const int*)(p.ws + WS_CNT); int s = 0, ro = 0; for (int e = 0; e < 64; ++e) { const int ce = cnt[e]; tab[e] = s; tab[80 + e] = ce; tab[160 + e] = ro; ro += ce; const int np = (ce + 511) >> 9; s += np > 0 ? np : 1; } tab[64] = s; }
    __syncthreads();
    const int total = __builtin_amdgcn_readfirstlane(tab[64]) * NS;
    const int q = (w & 3) * 8 + (l & 7), g = (w >> 2) * 8 + (l >> 3);
    const unsigned bwoff = (unsigned)(q * 256 + (((g >> 2) ^ (q & 3)) * 16) + (g & 3) * 4);
    const unsigned frag_sw = (unsigned)((r32 >> 2) & 3);
    const int* ltok = (const int*)(p.ws + WS_LTOK); const float* lw = (const float*)(p.ws + WS_LW);
    for (int unit = blockIdx.x; unit < total; unit += gridDim.x) {
        const int pm = unit / NS, ns = unit - pm * NS; int e = 0;
#pragma unroll 1
        for (int s = 32; s >= 1; s >>= 1) if (__builtin_amdgcn_readfirstlane(tab[e + s]) <= pm) e += s;
        const int mp = pm - __builtin_amdgcn_readfirstlane(tab[e]); const int cnt_e = __builtin_amdgcn_readfirstlane(tab[80 + e]), rowoff = __builtin_amdgcn_readfirstlane(tab[160 + e]);
        int nrows = cnt_e - mp * 512; nrows = nrows > 512 ? 512 : nrows; const bool two = nrows > 256;
        const char* abase = UP ? (const char*)(p.ws + WS_H8) : (const char*)(p.ws + WS_ACT8);
        unsigned aoff[2];
#pragma unroll
        for (int i = 0; i < 2; ++i) { const int row = (i * 8 + w) * 32 + (l >> 1); const int hs = (l & 1) ^ ((l >> 4) & 1);
            int src; if (UP) src = row < nrows ? (ltok[e * LCAP + mp * 512 + row] & 0xffff) : 0; else src = rowoff + mp * 512 + (row < nrows ? row : 0);
            aoff[i] = (unsigned)(src * K + hs * 16); }
        const float* bsrc = UP ? (q < 16 ? p.in[I_W1] : p.in[I_W3]) + (size_t)e * 2048 * 512 + ns * 64 + (q & 15) * 4 + (size_t)(2 * g) * LDW
                               : p.in[I_W2] + (size_t)e * 512 * 2048 + ns * 128 + q * 4 + (size_t)(2 * g) * LDW;
        f32x16 acc[2][4];
#pragma unroll
        for (int a = 0; a < 2; ++a)
#pragma unroll
            for (int b = 0; b < 4; ++b)
#pragma unroll
                for (int r = 0; r < 16; ++r) acc[a][b][r] = 0.f;
        f32x4 br[2][2];
#define MOE_ISSUE_B(j, t) do { const int tt_ = (t) < NKT ? (t) : NKT - 1; const float* bp_ = bsrc + (size_t)tt_ * 32 * LDW; MOE_GLOAD(br[j][0], bp_); MOE_GLOAD(br[j][1], bp_ + LDW); } while (0)
#define MOE_ISSUE_A(t, TWO) do { int tt_ = (t) < 0 ? 0 : (t); const int bi_ = (tt_ % NSTA); tt_ = tt_ < NKT ? tt_ : NKT - 1; const char* ap_ = abase + (size_t)tt_ * 32; \
        LAS unsigned char* ab_ = lds + OFF_A + bi_ * 16384 + w * 1024; \
        __builtin_amdgcn_global_load_lds((const unsigned*)(ap_ + aoff[0]), (LAS unsigned*)(ab_), 16, 0, 0); \
        if (TWO) __builtin_amdgcn_global_load_lds((const unsigned*)(ap_ + aoff[1]), (LAS unsigned*)(ab_ + 8192), 16, 0, 0); } while (0)
        const bool two_w = (256 + 32 * w) < nrows;
#define MOE_FRAGS(ks, TWO) do { const unsigned co_ = ((unsigned)((ks) * 2 + hi) ^ frag_sw) * 16u; \
            _Pragma("unroll") for (int nb = 0; nb < 4; ++nb) bf_[nb] = *(const LAS bf16x8*)(bb_ + nb * 2048 + co_); \
            { const unsigned ao_ = ((unsigned)(ks) ^ ((unsigned)(r32 >> 3) & 1u)) * 16u + (unsigned)hi * 8u; a0_ = fp8x8_to_bf16(*(const LAS u32x2*)(ab_ + ao_)); if (TWO) a1_ = fp8x8_to_bf16(*(const LAS u32x2*)(ab_ + 8192 + ao_)); } } while (0)
#define MOE_MMAS(TWO) do { \
            _Pragma("unroll") for (int nb = 0; nb < 4; ++nb) acc[0][nb] = __builtin_amdgcn_mfma_f32_32x32x16_bf16(bf_[nb], a0_, acc[0][nb], 0, 0, 0); \
            if (TWO) { _Pragma("unroll") for (int nb = 0; nb < 4; ++nb) acc[1][nb] = __builtin_amdgcn_mfma_f32_32x32x16_bf16(bf_[nb], a1_, acc[1][nb], 0, 0, 0); } } while (0)
#define MOE_ITER(jn, t, COMPUTE, TWO, WB, WA) do { \
        bf16x8 bf_[4], a0_, a1_; \
        const LAS unsigned char* ab_ = lds + OFF_A + (((t) + 3) % 3) * 16384 + w * 1024 + r32 * 32; const LAS unsigned char* bb_ = lds + OFF_B + ((t) & 1) * 8192 + r32 * 64; \
        if (COMPUTE) { MOE_FRAGS(0, TWO); } SBAR(); \
        asm volatile("s_waitcnt vmcnt(" WB ")" : "+v"(br[jn][0]), "+v"(br[jn][1]) :: "memory"); \
        { LAS unsigned char* bw_ = lds + OFF_B + (((t) + 1) & 1) * 8192 + bwoff; _Pragma("unroll") for (int jj = 0; jj < 4; ++jj) *(LAS unsigned*)(bw_ + jj * 64) = cvt_pk_bf16(br[jn][0][jj], br[jn][1][jj]); } \
        MOE_ISSUE_B(jn, (t) + 3); SBAR(); \
        if (COMPUTE) { MOE_MMAS(TWO); SBAR(); MOE_FRAGS(1, TWO); MOE_MMAS(TWO); } SBAR(); \
        asm volatile("s_waitcnt vmcnt(" WA ")" ::: "memory"); \
        asm volatile("s_waitcnt lgkmcnt(0)" ::: "memory"); __builtin_amdgcn_s_barrier(); asm volatile("" ::: "memory"); \
        MOE_ISSUE_A((t) + 3, TWO); \
        } while (0)
#define MOE_PIPE(TWO, WB, WA) do { \
        MOE_ISSUE_B(0, 0); MOE_ISSUE_A(0, TWO); MOE_ISSUE_B(1, 1); MOE_ISSUE_A(1, TWO); \
        MOE_ITER(0, -1, false, TWO, WB, WA); \
        _Pragma("unroll 1") for (int t = 0; t < NKT; t += 2) { MOE_ITER(1, t, true, TWO, WB, WA); MOE_ITER(0, t + 1, true, TWO, WB, WA); } \
          \
        asm volatile("s_waitcnt vmcnt(0)" : "+v"(br[0][0]), "+v"(br[0][1]), "+v"(br[1][0]), "+v"(br[1][1]) :: "memory"); \
        } while (0)
        if (two_w) MOE_PIPE(true, "6", "6"); else MOE_PIPE(false, "4", "5");
        asm volatile("s_waitcnt vmcnt(0)" ::: "memory");
        if constexpr (UP) {
#pragma unroll
            for (int mt = 0; mt < 2; ++mt) {
                const int rl = mt * 256 + 32 * w + r32;
                if (rl < nrows) {
                    const float gw = lw[e * LCAP + mp * 512 + rl] * 16.0f; unsigned char* orow = (unsigned char*)(p.ws + (rep ? WS_QLAT : WS_ACT8)) + (size_t)(rowoff + mp * 512 + rl) * 512 + ns * 64 + 4 * hi;
#pragma unroll
                    for (int nb = 0; nb < 2; ++nb)
#pragma unroll
                        for (int g4 = 0; g4 < 4; ++g4) { float o[4];
#pragma unroll
                            for (int j = 0; j < 4; ++j) { const float a = acc[mt][nb][g4 * 4 + j], u = acc[mt][nb + 2][g4 * 4 + j]; o[j] = a * sigmoidf_(a) * u * gw; }
                            *(unsigned*)(orow + nb * 32 + g4 * 8) = pack_fp8x4(o[0], o[1], o[2], o[3]); }
                }
            }
        } else {
#pragma unroll
            for (int mt = 0; mt < 2; ++mt) {
                const int rl = mt * 256 + 32 * w + r32;
                if (rl < nrows) {
                    const int ent = ltok[e * LCAP + mp * 512 + rl]; bf16_t* orow = (bf16_t*)(p.ws + WS_YS) + ((size_t)(ent >> 16) * NTOK + (ent & 0xffff)) * 2048 + ns * 128 + 4 * hi;
#pragma unroll
                    for (int nb = 0; nb < 4; ++nb)
#pragma unroll
                        for (int g4 = 0; g4 < 4; ++g4) { u32x2 pk; pk.x = cvt_pk_bf16(acc[mt][nb][g4 * 4] * 0.0625f, acc[mt][nb][g4 * 4 + 1] * 0.0625f); pk.y = cvt_pk_bf16(acc[mt][nb][g4 * 4 + 2] * 0.0625f, acc[mt][nb][g4 * 4 + 3] * 0.0625f); *(u32x2*)(orow + nb * 32 + g4 * 8) = pk; }
                }
            }
        }
        asm volatile("s_waitcnt vmcnt(0)" ::: "memory");
        __syncthreads();
    }
#undef MOE_ISSUE_A
#undef MOE_ISSUE_B
#undef MOE_ITER
#undef MOE_FRAGS
#undef MOE_MMAS
#undef MOE_PIPE
}


__device__ void ph11_combine(const Params& p) {
    const bf16_t* Y0 = (const bf16_t*)(p.ws + WS_YS); const bf16_t* Y1 = Y0 + (size_t)NTOK * 2048; const bf16_t* YM = (const bf16_t*)(p.ws + WS_MERGED); const float* mod = (const float*)(p.ws + WS_MOD);
    const size_t n8 = (size_t)NTOK * 2048 / 8;
    for (size_t i = (size_t)blockIdx.x * NTHREADS + threadIdx.x; i < n8; i += (size_t)gridDim.x * NTHREADS) {
        const size_t e0 = i * 8; const int col = (int)(e0 & 2047), b = (int)(e0 >> 22);
        const u32x4 a = *(const u32x4*)(Y0 + e0), c = *(const u32x4*)(Y1 + e0), m = *(const u32x4*)(YM + e0);
        const float* gt = mod + (size_t)b * 12288 + 10240 + col; const f32x4 g0 = *(const f32x4*)gt, g1 = *(const f32x4*)(gt + 4);
        const float* px = p.in[I_X] + e0; f32x4 o0 = *(const f32x4*)px, o1 = *(const f32x4*)(px + 4);
        o0[0] += bf_lo(m.x) + g0[0] * (bf_lo(a.x) + bf_lo(c.x)); o0[1] += bf_hi(m.x) + g0[1] * (bf_hi(a.x) + bf_hi(c.x)); o0[2] += bf_lo(m.y) + g0[2] * (bf_lo(a.y) + bf_lo(c.y)); o0[3] += bf_hi(m.y) + g0[3] * (bf_hi(a.y) + bf_hi(c.y));
        o1[0] += bf_lo(m.z) + g1[0] * (bf_lo(a.z) + bf_lo(c.z)); o1[1] += bf_hi(m.z) + g1[1] * (bf_hi(a.z) + bf_hi(c.z)); o1[2] += bf_lo(m.w) + g1[2] * (bf_lo(a.w) + bf_lo(c.w)); o1[3] += bf_hi(m.w) + g1[3] * (bf_hi(a.w) + bf_hi(c.w));
        float* po = p.out + e0; *(f32x4*)po = o0; *(f32x4*)(po + 4) = o1;
    }
}

__global__ void __launch_bounds__(NTHREADS, 2) mk_fwd(Params p) {
    extern __shared__ __attribute__((aligned(16))) unsigned char shm[];
    LAS unsigned char* lds = (LAS unsigned char*)shm;
    const int lo = p.ph_lo, hi = p.ph_hi;
    if (threadIdx.x < 4) ((LAS unsigned*)(lds + LDS_BARW))[threadIdx.x] = 0u;
    __syncthreads();
    XcdBarrier bar; bar.bar = (unsigned*)(p.ws + WS_BAR); bar.x = 0; bar.st = nullptr;
    if (hi - lo > 1) bar = xcd_barrier_post((unsigned*)(p.ws + WS_BAR), (volatile LAS unsigned*)(lds + LDS_BARW));
#ifndef SKIP_MASK
#define SKIP_MASK 0
#endif
#define IN(k) (!((SKIP_MASK >> (k)) & 1) && lo <= (k) && (k) < hi)
#define SEAM(k) do { if (IN(k) && IN((k) + 1)) xcd_barrier(bar); } while (0)
    const int G = gridDim.x, bx = blockIdx.x;
#ifndef REP_PHASE
#define REP_PHASE 0
#endif
#define RUN(k, ...) do { if (IN(k)) { { const int rep = 0; (void)rep; __VA_ARGS__ } if ((REP_PHASE >> (k)) & 1) { xcd_barrier(bar); { const int rep = 1; (void)rep; __VA_ARGS__ } } } SEAM(k); } while (0)
    RUN(0, ph0_prologue(p, lds););
    RUN(1, ph1_norm(p););
    RUN(2, EpiProj E{p.ws, p.in[I_BGATE]};
           { ProjOrder S; S.S.init(p.ws + WS_H, p.ws + WS_WIN + (size_t)2 * 256 * DM * 2, NTOK, 8 * 256, DM * 2, G, bx); S.fp8 = 0; S.Bfull = nullptr;
             pg8::gemm_phase<EpiProj, ProjOrder, false, false>(lds, DM * 2, S, E); }
           { ProjOrder S; S.S.init(p.ws + WS_HF8, p.ws + WS_WIN8, NTOK, 30 * 256, DM, G, (G - 1) - bx); S.fp8 = 1; S.Bfull = nullptr;
             pg8::gemm_phase<EpiProj, ProjOrder, false, true>(lds, DM, S, E, 0x79797979); });
    RUN(3, ph3_prep(p, lds, rep););
    RUN(4, ph4_attn(p, lds););
    RUN(5, DualOrder S; S.S0.init(p.ws + WS_OA8, p.ws + WS_WPA8, NTOK, DM, 1024, G, bx); S.S1.init(p.ws + WS_OB8, p.ws + WS_WPB8, NTOK, DM, 1024, G, bx);
           EpiGate12 E{EpiGate1{(const bf16_t*)(p.ws + WS_GATES), (float*)(p.ws + WS_T1)}, EpiGate2{(const bf16_t*)(p.ws + WS_GATES), (const float*)(p.ws + WS_T1), (bf16_t*)(p.ws + WS_MRG8)}};
           pg8::gemm_phase<EpiGate12, DualOrder, false, true>(lds, 1024, S, E, 0x79797979, 0x7c7c7c7c););
    RUN(6, pg8::StaticOrder S; S.init(p.ws + WS_MRG8, p.ws + WS_WO8, NTOK, DM, DM, G, bx); EpiWo E{(const float*)(p.ws + WS_MOD), (bf16_t*)(p.ws + WS_MERGED)};
           pg8::gemm_phase<EpiWo, pg8::StaticOrder, false, true>(lds, DM, S, E, 0x79797979, 0x7d7d7d7d););
    RUN(7, ph8_router(p, lds, rep););
    RUN(8, moe_gemm<true>(p, lds, rep););
    RUN(9, moe_gemm<false>(p, lds, rep););
    RUN(10, if (!rep) ph11_combine(p););
#undef RUN
#undef IN
#undef SEAM
}

constexpr int NPHASES = 11;
extern "C" void kernel_launch(void* const* d_in, const int* in_sizes, int n_in, void* d_out, int out_size, void* d_ws, size_t ws_size, hipStream_t stream) {
    static int grid = 0;
    if (grid == 0) {
        if (n_in != 25 || in_sizes[0] != NTOK * DM || out_size != NTOK * DM || ws_size < WS_END6) {
            fprintf(stderr, "kernel_launch: shape mismatch: n_in %d in0 %d out %d ws %zu (need %zu)\n", n_in, n_in > 0 ? in_sizes[0] : -1, out_size, ws_size, (size_t)WS_END6); grid = -1; return; }
        int dev = 0, cus = 0, per_cu = 0;
        if (hipGetDevice(&dev) != hipSuccess || hipDeviceGetAttribute(&cus, hipDeviceAttributeMultiprocessorCount, dev) != hipSuccess) { fprintf(stderr, "kernel_launch: device query failed\n"); grid = -1; return; }
        if (hipFuncSetAttribute((const void*)mk_fwd, hipFuncAttributeMaxDynamicSharedMemorySize, LDS_BYTES) != hipSuccess) { fprintf(stderr, "kernel_launch: hipFuncSetAttribute failed\n"); grid = -1; return; }
        if (hipOccupancyMaxActiveBlocksPerMultiprocessor(&per_cu, (const void*)mk_fwd, NTHREADS, LDS_BYTES) != hipSuccess || per_cu < 1) { fprintf(stderr, "kernel_launch: occupancy query says %d blocks per CU\n", per_cu); }
        (void)hipGetLastError();
        grid = cus;
    }
    if (grid < 0) return;
    if (hipMemsetAsync((char*)d_ws + WS_BAR, 0, WS_ZERO_BYTES, stream) != hipSuccess) { fprintf(stderr, "kernel_launch: memset failed\n"); return; }
    Params p; memset(&p, 0, sizeof(p));
    for (int i = 0; i < 25; ++i) p.in[i] = (const float*)d_in[i];
    p.out = (float*)d_out; p.ws = (unsigned char*)d_ws;
    unsigned char* ws = (unsigned char*)d_ws;
    auto job = [&](int j, const float* src, size_t dst_off, int K, int N, int ldd, int map, int nbatch, long sbatch, long dbatch) {
        TJob& J = p.jobs[j]; J.src = src; J.dst = (bf16_t*)(ws + dst_off); J.K = K; J.N = N; J.ldd = ldd; J.map = map; J.ntk = K / 64; J.ntn = (N + 127) / 128; J.nbatch = nbatch; J.sbatch = sbatch; J.dbatch = dbatch; J.ld = N; J.fp8 = 0; };
    job(0, p.in[I_WIN] + 512, WS_WIN, 2048, 1872, 2048, 4, 1, 0, 0); p.jobs[0].ld = DIN;
    job(1, p.in[I_WIN] + 5456, WS_WIN, 2048, 8, 2048, 5, 1, 0, 0); p.jobs[1].ld = DIN;
    job(2, p.in[I_WUK], WS_WUK, 128, 256, 128, 0, 8, 128L * 256, 256L * 128);
    job(3, p.in[I_WUV], WS_WUV, 256, 128, 256, 0, 8, 256L * 128, 128L * 256);
    job(4, p.in[I_WIN], WS_WIN8, 2048, 512, 2048, 0, 1, 0, 0); job(5, p.in[I_WIN] + 2384, WS_WIN8 + (size_t)512 * 2048, 2048, 3072, 2048, 0, 1, 0, 0); job(6, p.in[I_WIN] + 5464, WS_WIN8 + (size_t)3584 * 2048, 2048, 4096, 2048, 0, 1, 0, 0);
    for (int j = 4; j < 7; ++j) { p.jobs[j].ld = DIN; p.jobs[j].fp8 = 1; }
    job(7, p.in[I_WO], WS_WO8, 2048, 2048, 2048, 0, 1, 0, 0); p.jobs[7].fp8 = 1;
    job(8, p.in[I_WPA], WS_WPA8, 1024, 2048, 1024, 0, 1, 0, 0); p.jobs[8].fp8 = 1; job(9, p.in[I_WPB], WS_WPB8, 1024, 2048, 1024, 0, 1, 0, 0); p.jobs[9].fp8 = 1;
    int t0 = 0; for (int j = 0; j < NJOBS; ++j) { p.jobs[j].tile0 = t0; t0 += p.jobs[j].ntk * p.jobs[j].ntn * p.jobs[j].nbatch; }
    p.ntiles_total = t0;
#if MK_LAUNCHES == 1
    p.ph_lo = 0; p.ph_hi = NPHASES;
    hipLaunchKernelGGL(mk_fwd, dim3(grid), dim3(NTHREADS), LDS_BYTES, stream, p);
#else
    for (int k = 0; k < NPHASES; ++k) { p.ph_lo = k; p.ph_hi = k + 1; hipLaunchKernelGGL(mk_fwd, dim3(grid), dim3(NTHREADS), LDS_BYTES, stream, p); }
#endif
    const hipError_t le = hipPeekAtLastError();
    if (le != hipSuccess) fprintf(stderr, "kernel_launch: launch failed: %s\n", hipGetErrorName(le));
}
```

```cpp
#include <hip/hip_runtime.h>
#include <cstdio>
#include <cstdint>
#include <cstring>

#ifndef MK_LAUNCHES
#define MK_LAUNCHES 1
#endif

#define LAS __attribute__((address_space(3)))
typedef unsigned short bf16_t;
typedef short bf16x8 __attribute__((ext_vector_type(8)));
typedef short s16x4 __attribute__((ext_vector_type(4)));
typedef float f32x4 __attribute__((ext_vector_type(4)));
typedef float f32x16 __attribute__((ext_vector_type(16)));
typedef unsigned u32x4 __attribute__((ext_vector_type(4)));
typedef unsigned u32x2 __attribute__((ext_vector_type(2)));

constexpr int DM = 2048, NBATCH = 4, SEQ = 2048, NTOK = NBATCH * SEQ;
constexpr int DIN = 9560, DINP = 9728;
constexpr int NEXP = 64, DEXP = 512, LCAP = 8192;
constexpr float RMS_EPS = 1e-6f;
constexpr float LOG2E = 1.4426950408889634f;
constexpr int NTHREADS = 512;
constexpr int LDS_BYTES = 163840 - 1024;
constexpr int LDS_BARW = LDS_BYTES - 16;
constexpr int LDS_TAB = 131072;

constexpr size_t al256(size_t x) { return (x + 255) / 256 * 256; }
constexpr size_t WS_BAR = 0;
constexpr size_t WS_CNT = 16384;
constexpr size_t WS_ZERO_BYTES = 16384 + 4096;
constexpr size_t WS_MOD = WS_ZERO_BYTES;
constexpr size_t WS_H = al256(WS_MOD + (size_t)4 * 12288 * 4);
constexpr size_t WS_WIN = al256(WS_H + (size_t)NTOK * DM * 2);
constexpr size_t WS_WPA = al256(WS_WIN + (size_t)DINP * DM * 2);
constexpr size_t WS_WPB = al256(WS_WPA + (size_t)2048 * 1024 * 2);
constexpr size_t WS_WO = al256(WS_WPB + (size_t)2048 * 1024 * 2);
constexpr size_t WS_WUK = al256(WS_WO + (size_t)2048 * 2048 * 2);
constexpr size_t WS_WUV = al256(WS_WUK + (size_t)8 * 256 * 128 * 2);
constexpr size_t WS_W13 = al256(WS_WUV + (size_t)8 * 128 * 256 * 2);
constexpr size_t WS_W2 = al256(WS_W13 + (size_t)64 * 1024 * 2048 * 2);
constexpr size_t WS_QA = al256(WS_W2 + (size_t)64 * 2048 * 512 * 2);
constexpr size_t WS_CKV = al256(WS_QA + (size_t)NTOK * 1024 * 2);
constexpr size_t WS_KV = al256(WS_CKV + (size_t)NTOK * 256 * 4);
constexpr size_t WS_QIDX = al256(WS_KV + (size_t)NTOK * 256 * 2);
constexpr size_t WS_MISC = al256(WS_QIDX + (size_t)NTOK * 1024 * 2);
constexpr size_t WS_QB = al256(WS_MISC + (size_t)NTOK * 256 * 4);
constexpr size_t WS_KB = al256(WS_QB + (size_t)NTOK * 1024 * 2);
constexpr size_t WS_VB = al256(WS_KB + (size_t)NTOK * 1024 * 2);
constexpr size_t WS_GATES = al256(WS_VB + (size_t)NTOK * 1024 * 2);
constexpr size_t WS_QLAT = al256(WS_GATES + (size_t)NTOK * 4096 * 2);
constexpr size_t WS_MASK = al256(WS_QLAT + (size_t)NTOK * 2048 * 2);
constexpr size_t WS_CUM = al256(WS_MASK + (size_t)NTOK * 256);
constexpr size_t WS_OLAT = al256(WS_CUM + (size_t)4 * 8 * 2048 * 4);
constexpr size_t WS_OA = al256(WS_OLAT + (size_t)NTOK * 2048 * 2);
constexpr size_t WS_OB = al256(WS_OA + (size_t)NTOK * 1024 * 2);
constexpr size_t WS_T1 = al256(WS_OB + (size_t)NTOK * 1024 * 2);
constexpr size_t WS_MERGED = al256(WS_T1 + (size_t)NTOK * 2048 * 4);
constexpr size_t WS_LTOK = al256(WS_MERGED + (size_t)NTOK * 2048 * 2);
constexpr size_t WS_LW = al256(WS_LTOK + (size_t)NEXP * LCAP * 4);
constexpr size_t WS_ACT = al256(WS_LW + (size_t)NEXP * LCAP * 4);
constexpr size_t WS_HLO = al256(WS_ACT + (size_t)32768 * 512 * 2);
constexpr size_t WS_WRH = al256(WS_HLO + (size_t)NTOK * DM * 2);
constexpr size_t WS_WRL = al256(WS_WRH + (size_t)80 * DM * 2);
constexpr size_t WS_END = al256(WS_WRL + (size_t)80 * DM * 2);
constexpr size_t WS_KIDX = WS_END;
constexpr size_t WS_END2 = al256(WS_KIDX + (size_t)NTOK * 64 * 2);
constexpr size_t WS_H8 = WS_END2;
constexpr size_t WS_ACT8 = al256(WS_H8 + (size_t)NTOK * DM);
constexpr size_t WS_END3 = al256(WS_ACT8 + (size_t)16384 * 512);
constexpr size_t WS_HF8 = WS_END3;
constexpr size_t WS_WIN8 = al256(WS_HF8 + (size_t)NTOK * DM);
constexpr size_t WS_END4 = al256(WS_WIN8 + (size_t)7680 * DM);
constexpr size_t WS_MRG8 = WS_END4;
constexpr size_t WS_WO8 = al256(WS_MRG8 + (size_t)NTOK * DM);
constexpr size_t WS_END5 = al256(WS_WO8 + (size_t)2048 * 2048);
constexpr size_t WS_OA8 = WS_END5;
constexpr size_t WS_OB8 = al256(WS_OA8 + (size_t)NTOK * 1024);
constexpr size_t WS_WPA8 = al256(WS_OB8 + (size_t)NTOK * 1024);
constexpr size_t WS_WPB8 = al256(WS_WPA8 + (size_t)2048 * 1024);
constexpr size_t WS_END6 = al256(WS_WPB8 + (size_t)2048 * 1024);
constexpr size_t WS_YS = WS_T1;
constexpr size_t WS_HG = WS_QA;
static_assert(WS_HG + (size_t)32768 * DM * 2 <= WS_QLAT, "hg alias must fit in the dead region");

struct TJob { const float* src; bf16_t* dst; int K, N, ldd, map, ntk, ntn, nbatch, tile0; long sbatch, dbatch; int ld, fp8; };
constexpr int NJOBS = 10;
struct Params {
    const float* in[25];
    float* out;
    unsigned char* ws;
    TJob jobs[NJOBS];
    int ntiles_total;
    int ph_lo, ph_hi;
};
enum { I_X = 0, I_C, I_WADA, I_BADA, I_GMIX, I_WIN, I_BGATE, I_BFORGET, I_WUK, I_WUV, I_GQA, I_GKV, I_GQB, I_GKB, I_WPA, I_WPB, I_WO, I_GFFN, I_WRG, I_BRG, I_WRE, I_BRE, I_W1, I_W3, I_W2 };

__device__ __forceinline__ unsigned cvt_pk_bf16(float lo, float hi) { unsigned r; asm volatile("v_cvt_pk_bf16_f32 %0, %1, %2" : "=v"(r) : "v"(lo), "v"(hi)); return r; }
__device__ __forceinline__ float bf_lo(unsigned w) { return __uint_as_float(w << 16); }
__device__ __forceinline__ float bf_hi(unsigned w) { return __uint_as_float(w & 0xffff0000u); }
typedef float f32x2 __attribute__((ext_vector_type(2)));
__device__ __forceinline__ unsigned pack_fp8x4(float a, float b, float c, float d) { int w = __builtin_amdgcn_cvt_pk_fp8_f32(a, b, 0, false); w = __builtin_amdgcn_cvt_pk_fp8_f32(c, d, w, true); return (unsigned)w; }
__device__ __forceinline__ bf16x8 fp8x8_to_bf16(u32x2 v) {
    const f32x2 a = __builtin_amdgcn_cvt_pk_f32_fp8((int)v.x, false), b = __builtin_amdgcn_cvt_pk_f32_fp8((int)v.x, true), c = __builtin_amdgcn_cvt_pk_f32_fp8((int)v.y, false), d = __builtin_amdgcn_cvt_pk_f32_fp8((int)v.y, true);
    u32x4 w; w.x = cvt_pk_bf16(a.x, a.y); w.y = cvt_pk_bf16(b.x, b.y); w.z = cvt_pk_bf16(c.x, c.y); w.w = cvt_pk_bf16(d.x, d.y); return *reinterpret_cast<bf16x8*>(&w); }
__device__ __forceinline__ float wave_sum(float v) {
#pragma unroll
    for (int o = 32; o >= 1; o >>= 1) v += __shfl_xor(v, o);
    return v;
}
__device__ __forceinline__ float sigmoidf_(float x) { return __builtin_amdgcn_rcpf(1.0f + __builtin_amdgcn_exp2f(-1.4426950408889634f * x)); }
__device__ __forceinline__ int crow(int r, int hi) { return (r & 3) + 8 * (r >> 2) + 4 * hi; }
#define SBAR() __builtin_amdgcn_sched_barrier(0)

#define XB_TMO      128
#define XB_XCNT(j)  (256  + 64 * (j))
#define XB_XSUB(j)  (1280 + 64 * (j))
#define XB_XGEN(j)  (2304 + 64 * (j))
#define XB_TOP      3328
#define XB_TOPGEN   3392
#define XCD_BAR_WORDS 3456
#define XB_SPIN_CAP (1u << 20)
__device__ __forceinline__ unsigned xb_ld(unsigned* p)              { return __hip_atomic_load(p, __ATOMIC_RELAXED, __HIP_MEMORY_SCOPE_AGENT); }
__device__ __forceinline__ unsigned xb_add(unsigned* p, unsigned v) { return __hip_atomic_fetch_add(p, v, __ATOMIC_RELAXED, __HIP_MEMORY_SCOPE_AGENT); }
__device__ __forceinline__ unsigned xb_xcc_id() { return (unsigned)__builtin_amdgcn_s_getreg((3 << 11) | 20) & 0xFu; }
#define XB_SPIN(cond, bar) do { unsigned _sp = 0; while (cond) { __builtin_amdgcn_s_sleep(1); \
    if ((++_sp & 255u) == 0u) { if (xb_ld(&(bar)[XB_TMO])) break; if (_sp > XB_SPIN_CAP) { atomicAdd(&(bar)[XB_TMO], 1u); break; } } } } while (0)
struct XcdBarrier { unsigned* bar; unsigned x; volatile LAS unsigned* st; };
__device__ __forceinline__ XcdBarrier xcd_barrier_post(unsigned* bar, volatile LAS unsigned* st) {
    XcdBarrier b; b.bar = bar; b.x = xb_xcc_id(); b.st = st;
    if (threadIdx.x == 0) (void)xb_add(&bar[XB_XCNT(b.x)], 1u);
    return b;
}
__device__ __forceinline__ void xcd_barrier_complete(unsigned* bar, unsigned x, unsigned& nloc, unsigned& nx) {
    const unsigned G = gridDim.x * gridDim.y * gridDim.z;
    unsigned sum, cnt, mine, sp = 0u;
    for (;;) {
        sum = 0u; cnt = 0u; mine = 0u;
#pragma unroll
        for (unsigned j = 0; j < 16; ++j) { const unsigned c = xb_ld(&bar[XB_XCNT(j)]); sum += c; cnt += (c > 0u) ? 1u : 0u; mine = (j == x) ? c : mine; }
        if (sum == G) break;
        __builtin_amdgcn_s_sleep(1);
        if ((++sp & 255u) == 0u) { if (xb_ld(&bar[XB_TMO])) break; if (sp > XB_SPIN_CAP) { atomicAdd(&bar[XB_TMO], 1u); break; } }
    }
    nloc = mine > 0u ? mine : 1u; nx = cnt > 0u ? cnt : 1u;
}
__device__ __forceinline__ void xcd_barrier(const XcdBarrier& b) {
    asm volatile("s_waitcnt vmcnt(0)" ::: "memory");
    __syncthreads();
    if (threadIdx.x == 0) {
        unsigned* bar = b.bar;
        __builtin_amdgcn_s_waitcnt(0);
        unsigned nloc = b.st[0], nx = b.st[1];
        if (nloc == 0u) { xcd_barrier_complete(bar, b.x, nloc, nx); b.st[0] = nloc; b.st[1] = nx; }
        const unsigned old = xb_add(&bar[XB_XSUB(b.x)], 1u);
        const unsigned gen = old / nloc;
        if (old + 1u == (gen + 1u) * nloc) {
            __builtin_amdgcn_fence(__ATOMIC_RELEASE, "agent");
            asm volatile("s_waitcnt vmcnt(0)" ::: "memory");
            const unsigned og = xb_add(&bar[XB_TOP], 1u);
            const unsigned tg = og / nx;
            if (og + 1u == (tg + 1u) * nx) xb_add(&bar[XB_TOPGEN], 1u);
            else XB_SPIN(xb_ld(&bar[XB_TOPGEN]) == tg, bar);
            __builtin_amdgcn_fence(__ATOMIC_ACQUIRE, "agent");
            xb_add(&bar[XB_XGEN(b.x)], 1u);
            asm volatile("s_waitcnt vmcnt(0)" ::: "memory");
        } else {
            XB_SPIN(xb_ld(&bar[XB_XGEN(b.x)]) == gen, bar);
            __builtin_amdgcn_fence(__ATOMIC_ACQUIRE, "agent");
            asm volatile("s_waitcnt vmcnt(0)" ::: "memory");
        }
    }
    __syncthreads();
}

namespace pg8 {
constexpr int BM = 256, BK = 64, HALF = 128, HTB = HALF * BK * 2, STAGE_BYTES = 8 * HTB, NXCD = 8, WGM = 8;
__host__ __device__ __forceinline__ int lds_byte(int r, int c) { const int st = (r >> 4) * 2 + (c >> 5), rr = r & 15, cc = c & 31, ob = rr * 64 + cc * 2; return st * 1024 + (ob ^ (((ob >> 9) & 1) << 5)); }
__host__ __device__ __forceinline__ void stage_rc(int b, int& R, int& C) { const int st = b / 1024, sb = b % 1024, swz = sb ^ (((sb >> 9) & 1) << 5); R = (st >> 1) * 16 + swz / 64; C = (st & 1) * 32 + (swz % 64) / 2; }
__host__ __device__ __forceinline__ int perm32(int rho) { const int n = rho >> 4, i = rho & 15; return 8 * (i >> 2) + 4 * n + (i & 3); }

struct Unit { int pm, pn; const char* a; const char* b; const int* gi; int nvalid; int aux; };

struct StaticOrder {
    int nM, nN, nwg, G, c, RS; const char* A; const char* Bt;
    __device__ void init(const void* A_, const void* Bt_, int M, int N, int RS_, int G_, int c_) { A = (const char*)A_; Bt = (const char*)Bt_; RS = RS_; nM = M / BM; nN = N / BM; nwg = nM * nN; G = G_; c = c_; }
    __device__ bool next(int i, Unit& u) const {
        const long L = (long)i * G + c; if (L >= nwg) return false;
        int wgid = (int)L; { const int q = nwg / NXCD, r = nwg % NXCD, xcd = wgid % NXCD, off = wgid / NXCD; wgid = (xcd < r ? xcd * (q + 1) : r * (q + 1) + (xcd - r) * q) + off; }
        const int nig = WGM * nN, gid = wgid / nig, fm = gid * WGM, gsz = (nM - fm) < WGM ? (nM - fm) : WGM;
        u.pm = fm + ((wgid % nig) % gsz); u.pn = (wgid % nig) / gsz;
        u.a = A + (size_t)u.pm * BM * RS; u.b = Bt + (size_t)u.pn * BM * RS; u.gi = nullptr; u.nvalid = BM; u.aux = 0; return true;
    }
};

typedef int i32x8 __attribute__((ext_vector_type(8)));
typedef int i32x4v __attribute__((ext_vector_type(4)));
template <class Epi, class Sched, bool GATHER, bool FP8 = false>
__device__ __forceinline__ void gemm_phase(LAS unsigned char* lds, const int RS, const Sched& S, const Epi& E, const int scale_b = 0x7f7f7f7f, const int scale_a = 0x7f7f7f7f) {
    int tid = threadIdx.x; asm volatile("" : "+v"(tid));
    const int wid = __builtin_amdgcn_readfirstlane(tid >> 6), lane = tid & 63, wr = wid >> 2, wc = wid & 3, fr = lane & 15, fq = lane >> 4;
    const int nt = RS / (BK * 2); const int K = RS;
    unsigned voffA[2], voffB[2]; int RA[2], CA[2];
#pragma unroll
    for (int i = 0; i < 2; ++i) { int R, C; stage_rc(tid * 16 + i * 8192, R, C); const int Rb = ((R & ~31) + perm32(R & 31));
        RA[i] = R; CA[i] = C; voffA[i] = (unsigned)(R * RS + C * 2); voffB[i] = (unsigned)(Rb * RS + C * 2); }
    const size_t kstep = (size_t)(BK * 2);
    const size_t hstep = (size_t)HALF * RS;
    const unsigned ldsw = (unsigned)wid * 1024u;
    const int aoff = lds_byte(wr * 64 + fr, fq * 8), boff = lds_byte(wc * 32 + fr, fq * 8);
    unsigned gA[2][2], gN[2][2];
#define PG8_SA(b, h) (((b) * 2 + (h)) * HTB)
#define PG8_SB(b, h) ((4 + (b) * 2 + (h)) * HTB)
#define PG8_STAGE(bufoff, gbase, voff) do { _Pragma("unroll") for (int _i = 0; _i < 2; ++_i) \
        __builtin_amdgcn_global_load_lds((const unsigned*)((const char*)(gbase) + (voff)[_i]), (LAS unsigned*)(lds + (bufoff) + ldsw + _i * 8192), 16, 0, 0); } while (0)
#define PG8_STAGE_A(bufoff, gp, h, NX) do { if constexpr (GATHER) { if (NX) PG8_STAGE(bufoff, gp, gN[h]); else PG8_STAGE(bufoff, gp, gA[h]); } else PG8_STAGE(bufoff, (gp) + (h) * hstep, voffA); } while (0)
#define PG8_LD8(p_) __builtin_shufflevector(*(const LAS i32x4v*)(p_), *(const LAS i32x4v*)((p_) + 1024), 0, 1, 2, 3, 4, 5, 6, 7)
#define PG8_LDA(dst, b, h) do { if constexpr (FP8) { _Pragma("unroll") for (int m = 0; m < 4; ++m) dst##8[m] = PG8_LD8(lds + PG8_SA(b, h) + aoff + m * 2048); } \
        else { _Pragma("unroll") for (int m = 0; m < 4; ++m) _Pragma("unroll") for (int k = 0; k < 2; ++k) dst[m][k] = *(const LAS bf16x8*)(lds + PG8_SA(b, h) + aoff + m * 2048 + k * 1024); } } while (0)
#define PG8_LDB(dst, b, h) do { if constexpr (FP8) { _Pragma("unroll") for (int n = 0; n < 2; ++n) dst##8[n] = PG8_LD8(lds + PG8_SB(b, h) + boff + n * 2048); } \
        else { _Pragma("unroll") for (int n = 0; n < 2; ++n) _Pragma("unroll") for (int k = 0; k < 2; ++k) dst[n][k] = *(const LAS bf16x8*)(lds + PG8_SB(b, h) + boff + n * 2048 + k * 1024); } } while (0)
#define PG8_MMA(ai, bj, At, Bt) do { __builtin_amdgcn_s_setprio(1); \
        if constexpr (FP8) { _Pragma("unroll") for (int m = 0; m < 4; ++m) _Pragma("unroll") for (int n = 0; n < 2; ++n) \
            asm volatile("v_mfma_scale_f32_16x16x128_f8f6f4 %0, %1, %2, %0, %3, %4 op_sel_hi:[0,0,0]" : "+v"(acc[ai][bj][m][n]) : "v"(Bt##8[n]), "v"(At##8[m]), "v"(sc_b), "v"(sc_a)); } \
        else { _Pragma("unroll") for (int m = 0; m < 4; ++m) _Pragma("unroll") for (int n = 0; n < 2; ++n) _Pragma("unroll") for (int k = 0; k < 2; ++k) \
            acc[ai][bj][m][n] = __builtin_amdgcn_mfma_f32_16x16x32_bf16(Bt[n][k], At[m][k], acc[ai][bj][m][n], 0, 0, 0); } \
        __builtin_amdgcn_s_setprio(0); } while (0)
#define PG8_WAIT_V(n) asm volatile("s_waitcnt vmcnt(" #n ")" ::: "memory")
#define PG8_WAIT_L(n) asm volatile("s_waitcnt lgkmcnt(" #n ")" ::: "memory")
#define PG8_BAR __builtin_amdgcn_s_barrier()
#define PG8_SCHED __builtin_amdgcn_sched_barrier(0)
#define PG8_GIDX(dst, u) do { if constexpr (GATHER) { _Pragma("unroll") for (int h = 0; h < 2; ++h) _Pragma("unroll") for (int i = 0; i < 2; ++i) { \
        const int rr = h * HALF + RA[i]; const int tok = rr < (u).nvalid ? (u).gi[rr] : 0; dst[h][i] = (unsigned)(tok * K + CA[i] * 2); } } } while (0)
    Unit cur, nxt; int ui = 0;
    if (!S.next(0, cur)) return;
    f32x4 acc[2][2][4][2];
#pragma unroll
    for (int a = 0; a < 2; ++a)
#pragma unroll
        for (int b = 0; b < 2; ++b)
#pragma unroll
            for (int m = 0; m < 4; ++m)
#pragma unroll
                for (int n = 0; n < 2; ++n) acc[a][b][m][n] = (f32x4){0.f, 0.f, 0.f, 0.f};
    const int sc_b = scale_b, sc_a = scale_a;
    bf16x8 At[4][2], B0[2][2], B1[2][2]; i32x8 At8[4], B08[2], B18[2];
    const char* cA = cur.a; const char* cB = cur.b;
    PG8_GIDX(gA, cur);
    PG8_STAGE(PG8_SB(0, 0), cB, voffB); PG8_STAGE_A(PG8_SA(0, 0), cA, 0, false); PG8_STAGE(PG8_SB(0, 1), cB + hstep, voffB); PG8_STAGE_A(PG8_SA(0, 1), cA, 1, false);
    if (wr == 1) PG8_BAR;
    PG8_WAIT_V(4); PG8_BAR;
    PG8_STAGE(PG8_SB(1, 0), cB + kstep, voffB); PG8_STAGE_A(PG8_SA(1, 0), cA + kstep, 0, false); PG8_STAGE(PG8_SB(1, 1), cB + hstep + kstep, voffB);
    PG8_WAIT_V(6); PG8_BAR;
    for (;;) {
        const bool has_next = S.next(ui + 1, nxt);
        const char* nA = has_next ? nxt.a : cA; const char* nB = has_next ? nxt.b : cB;
        if constexpr (GATHER) { if (has_next) { PG8_GIDX(gN, nxt); } else {
#pragma unroll
            for (int h = 0; h < 2; ++h)
#pragma unroll
                for (int i = 0; i < 2; ++i) gN[h][i] = gA[h][i]; } }
        for (int t = 0; t < nt; t += 2) {
            const bool last = (t == nt - 2);
            const char* a1 = cA + (size_t)(t + 1) * kstep;
            const char* a2 = last ? nA : cA + (size_t)(t + 2) * kstep; const char* b2 = last ? nB : cB + (size_t)(t + 2) * kstep;
            const char* a3 = a2 + kstep; const char* b3 = b2 + kstep;
            PG8_LDB(B0, 0, 0); PG8_SCHED; PG8_LDA(At, 0, 0); PG8_STAGE_A(PG8_SA(1, 1), a1, 1, false);
            PG8_WAIT_L(8); PG8_BAR; PG8_WAIT_L(0); PG8_MMA(0, 0, At, B0); PG8_BAR; PG8_SCHED;
            PG8_LDB(B1, 0, 1); PG8_STAGE(PG8_SB(0, 0), b2, voffB);
            PG8_BAR; PG8_WAIT_L(0); PG8_MMA(0, 1, At, B1); PG8_BAR;
            PG8_LDA(At, 0, 1); PG8_STAGE_A(PG8_SA(0, 0), a2, 0, last);
            PG8_BAR; PG8_WAIT_L(0); PG8_MMA(1, 0, At, B0); PG8_BAR; PG8_SCHED;
            PG8_STAGE(PG8_SB(0, 1), b2 + hstep, voffB);
            PG8_WAIT_V(6); PG8_BAR; PG8_MMA(1, 1, At, B1); PG8_BAR;
            PG8_LDB(B0, 1, 0); PG8_SCHED; PG8_LDA(At, 1, 0); PG8_STAGE_A(PG8_SA(0, 1), a2, 1, last);
            PG8_WAIT_L(8); PG8_BAR; PG8_WAIT_L(0); PG8_MMA(0, 0, At, B0); PG8_BAR; PG8_SCHED;
            PG8_LDB(B1, 1, 1); PG8_STAGE(PG8_SB(1, 0), b3, voffB);
            PG8_BAR; PG8_WAIT_L(0); PG8_MMA(0, 1, At, B1); PG8_BAR;
            PG8_LDA(At, 1, 1); PG8_STAGE_A(PG8_SA(1, 0), a3, 0, last);
            PG8_BAR; PG8_WAIT_L(0); PG8_MMA(1, 0, At, B0); PG8_BAR; PG8_SCHED;
            PG8_STAGE(PG8_SB(1, 1), b3 + hstep, voffB);
            PG8_WAIT_V(6); PG8_BAR; PG8_MMA(1, 1, At, B1); PG8_BAR;
        }
        bool keep_acc = false;
        if constexpr (FP8) asm volatile("s_nop 15\n\ts_nop 15" ::: "memory");
        if constexpr (Epi::DUAL) { if (cur.aux) { E.mid(acc, cur, wr, wc, fr, fq); keep_acc = true; } else E(acc, cur, wr, wc, fr, fq); } else E(acc, cur, wr, wc, fr, fq);
        if (!has_next) break;
        if (!keep_acc)
#pragma unroll
        for (int a = 0; a < 2; ++a)
#pragma unroll
            for (int b = 0; b < 2; ++b)
#pragma unroll
                for (int m = 0; m < 4; ++m)
#pragma unroll
                    for (int n = 0; n < 2; ++n) acc[a][b][m][n] = (f32x4){0.f, 0.f, 0.f, 0.f};
        cur = nxt; cA = nA; cB = nB; ++ui;
        if constexpr (GATHER) {
#pragma unroll
            for (int h = 0; h < 2; ++h)
#pragma unroll
                for (int i = 0; i < 2; ++i) gA[h][i] = gN[h][i]; }
    }
    PG8_WAIT_V(0);
    if (wr == 0) PG8_BAR;
    PG8_BAR;
#undef PG8_SA
#undef PG8_SB
#undef PG8_STAGE
#undef PG8_STAGE_A
#undef PG8_LDA
#undef PG8_LD8
#undef PG8_LDB
#undef PG8_MMA
#undef PG8_WAIT_V
#undef PG8_WAIT_L
#undef PG8_BAR
#undef PG8_SCHED
#undef PG8_GIDX
}
}
using pg8::Unit;

#define EPI_LOOP(...) { int fr_ = fr, fq_ = fq; asm volatile("" : "+v"(fr_), "+v"(fq_)); _Pragma("unroll") for (int ai = 0; ai < 2; ++ai) _Pragma("unroll") for (int m = 0; m < 4; ++m) _Pragma("unroll") for (int bj = 0; bj < 2; ++bj) { \
        const int trow = ai * 128 + wr * 64 + m * 16 + fr_; const int tcol = bj * 128 + wc * 32 + fq_ * 8; const f32x4 v0 = acc[ai][bj][m][0], v1 = acc[ai][bj][m][1]; __VA_ARGS__ } }

__device__ __forceinline__ u32x4 pack8(const f32x4 a, const f32x4 b) { u32x4 w; w.x = cvt_pk_bf16(a[0], a[1]); w.y = cvt_pk_bf16(a[2], a[3]); w.z = cvt_pk_bf16(b[0], b[1]); w.w = cvt_pk_bf16(b[2], b[3]); return w; }

struct EpiProj { static constexpr bool DUAL = false;
    unsigned char* ws; const float* b_gate;
    __device__ __forceinline__ void operator()(const f32x4 (&acc)[2][2][4][2], const Unit& u, int wr, int wc, int fr, int fq) const {
        const int pn = u.pn; const size_t row0 = (size_t)u.pm * 256;
        if (pn == 4 || pn == 9) {
            float* dst = (float*)(ws + (pn == 4 ? WS_CKV : WS_MISC));
            EPI_LOOP({ float* p = dst + (row0 + trow) * 256 + tcol; *(f32x4*)p = v0; *(f32x4*)(p + 4) = v1;
                if (pn == 9 && tcol < 64) *(u32x4*)((bf16_t*)(ws + WS_KIDX) + (row0 + trow) * 64 + tcol) = pack8(v0, v1); })
        } else if (pn < 22) {
            bf16_t* dst; int ct;
            if (pn < 4) { dst = (bf16_t*)(ws + WS_QA); ct = pn; } else if (pn < 9) { dst = (bf16_t*)(ws + WS_QIDX); ct = pn - 5; }
            else if (pn < 14) { dst = (bf16_t*)(ws + WS_QB); ct = pn - 10; } else if (pn < 18) { dst = (bf16_t*)(ws + WS_KB); ct = pn - 14; } else { dst = (bf16_t*)(ws + WS_VB); ct = pn - 18; }
            EPI_LOOP({ *(u32x4*)(dst + (row0 + trow) * 1024 + ct * 256 + tcol) = pack8(v0, v1); })
        } else {
            bf16_t* dst = (bf16_t*)(ws + WS_GATES); const int ct = pn - 22;
            EPI_LOOP({ const int col = ct * 256 + tcol; const f32x4 b0 = *(const f32x4*)(b_gate + col), b1 = *(const f32x4*)(b_gate + col + 4); f32x4 s0, s1;
                _Pragma("unroll") for (int j = 0; j < 4; ++j) { s0[j] = sigmoidf_(v0[j] + b0[j]); s1[j] = sigmoidf_(v1[j] + b1[j]); }
                *(u32x4*)(dst + (row0 + trow) * 4096 + col) = pack8(s0, s1); })
        }
    }
};
struct EpiGate1 { static constexpr bool DUAL = false;
    const bf16_t* gates; float* T1;
    __device__ __forceinline__ void operator()(const f32x4 (&acc)[2][2][4][2], const Unit& u, int wr, int wc, int fr, int fq) const {
        EPI_LOOP({ const size_t row = (size_t)u.pm * 256 + trow; const int col = u.pn * 256 + tcol; const u32x4 g = *(const u32x4*)(gates + row * 4096 + col);
            f32x4 o0 = {v0[0] * bf_lo(g.x), v0[1] * bf_hi(g.x), v0[2] * bf_lo(g.y), v0[3] * bf_hi(g.y)}; f32x4 o1 = {v1[0] * bf_lo(g.z), v1[1] * bf_hi(g.z), v1[2] * bf_lo(g.w), v1[3] * bf_hi(g.w)};
            float* p = T1 + row * 2048 + col; *(f32x4*)p = o0; *(f32x4*)(p + 4) = o1; })
    }
};
struct EpiGate2 { static constexpr bool DUAL = false;
    const bf16_t* gates; const float* T1; bf16_t* merged;
    __device__ __forceinline__ void operator()(const f32x4 (&acc)[2][2][4][2], const Unit& u, int wr, int wc, int fr, int fq) const {
        EPI_LOOP({ const size_t row = (size_t)u.pm * 256 + trow; const int col = u.pn * 256 + tcol; const u32x4 g = *(const u32x4*)(gates + row * 4096 + 2048 + col);
            const float* p = T1 + row * 2048 + col; const f32x4 t0 = *(const f32x4*)p, t1 = *(const f32x4*)(p + 4);
            f32x4 o0 = {t0[0] + v0[0] * bf_lo(g.x), t0[1] + v0[1] * bf_hi(g.x), t0[2] + v0[2] * bf_lo(g.y), t0[3] + v0[3] * bf_hi(g.y)};
            f32x4 o1 = {t1[0] + v1[0] * bf_lo(g.z), t1[1] + v1[1] * bf_hi(g.z), t1[2] + v1[2] * bf_lo(g.w), t1[3] + v1[3] * bf_hi(g.w)};
            u32x2 w8; w8.x = pack_fp8x4(o0[0] * 4.f, o0[1] * 4.f, o0[2] * 4.f, o0[3] * 4.f); w8.y = pack_fp8x4(o1[0] * 4.f, o1[1] * 4.f, o1[2] * 4.f, o1[3] * 4.f);
            *(u32x2*)((unsigned char*)merged + row * 2048 + col) = w8; })
    }
};
struct EpiWo { static constexpr bool DUAL = false;
    const float* mod; bf16_t* y;
    __device__ __forceinline__ void operator()(const f32x4 (&acc)[2][2][4][2], const Unit& u, int wr, int wc, int fr, int fq) const {
        const float* gt = mod + (size_t)(u.pm >> 3) * 12288 + 4096;
        EPI_LOOP({ const size_t row = (size_t)u.pm * 256 + trow; const int col = u.pn * 256 + tcol;
            const f32x4 g0 = *(const f32x4*)(gt + col), g1 = *(const f32x4*)(gt + col + 4);
            *(u32x4*)(y + row * 2048 + col) = pack8(g0 * v0, g1 * v1); })
    }
};
struct DualOrder {
    pg8::StaticOrder S0, S1;
    __device__ bool next(int i, Unit& u) const { const bool ok = (i & 1) ? S1.next(i >> 1, u) : S0.next(i >> 1, u); u.aux = (i & 1) ? 0 : 1; return ok; }
};
struct EpiGate12 { static constexpr bool DUAL = false;
    EpiGate1 e1; EpiGate2 e2;
    __device__ __forceinline__ void operator()(const f32x4 (&acc)[2][2][4][2], const Unit& u, int wr, int wc, int fr, int fq) const { if (u.aux) e1(acc, u, wr, wc, fr, fq); else e2(acc, u, wr, wc, fr, fq); }
};

struct ProjOrder {
    pg8::StaticOrder S; int fp8; const char* Bfull;
    __device__ bool next(int i, Unit& u) const {
        if (!S.next(i, u)) return false;
        if (fp8) { if (u.pn >= 2) u.pn += 8; } else u.pn += 2;
        return true;
    }
};
__device__ __forceinline__ int map_row(int map, int n) {
    if (map == 0) return n;
    if (map == 1) { if (n < 2384) return n; if (n < 5456) return n + 176; if (n < 5464) return n - 3072; return n + 168; }
    if (map == 4) return n + 512;
    return n + 2384;
}
__device__ void ph0_prologue(const Params& p, LAS unsigned char* lds) {
    const int tid = threadIdx.x, wid = tid >> 6, lane = tid & 63, G = gridDim.x, bx = blockIdx.x;
    if (bx < 192) {
        LAS float* sc = (LAS float*)lds;
        LAS float* red = (LAS float*)(lds + 32768);
        const float* c = p.in[I_C];
        for (int i = tid; i < 4 * 2048; i += NTHREADS) { const float v = c[i]; sc[i] = v / (1.0f + __expf(-v)); }
        __syncthreads();
        for (int item = bx; item < 192; item += G) {
            const int n0 = item * 64, cg = lane & 15, rs = lane >> 4;
            float acc[4][4];
#pragma unroll
            for (int b = 0; b < 4; ++b)
#pragma unroll
                for (int j = 0; j < 4; ++j) acc[b][j] = 0.f;
            const float* w = p.in[I_WADA] + n0 + cg * 4;
#pragma unroll 4
            for (int step = 0; step < 64; ++step) {
                const int k = step * 32 + wid * 4 + rs;
                const f32x4 wv = *(const f32x4*)(w + (size_t)k * 12288);
#pragma unroll
                for (int b = 0; b < 4; ++b) { const float s = sc[b * 2048 + k];
#pragma unroll
                    for (int j = 0; j < 4; ++j) acc[b][j] += s * wv[j]; }
            }
#pragma unroll
            for (int b = 0; b < 4; ++b)
#pragma unroll
                for (int j = 0; j < 4; ++j) { float v = acc[b][j]; v += __shfl_xor(v, 16); v += __shfl_xor(v, 32); acc[b][j] = v; }
            if (rs == 0) {
#pragma unroll
                for (int b = 0; b < 4; ++b)
#pragma unroll
                    for (int j = 0; j < 4; ++j) red[(wid * 16 + cg) * 16 + b * 4 + j] = acc[b][j]; }
            __syncthreads();
            if (tid < 256) { const int cg2 = tid >> 4, bj = tid & 15, b = bj >> 2, j = bj & 3; float s = 0.f;
#pragma unroll
                for (int w8 = 0; w8 < 8; ++w8) s += red[(w8 * 16 + cg2) * 16 + bj];
                const int n = n0 + cg2 * 4 + j; ((float*)(p.ws + WS_MOD))[b * 12288 + n] = s + p.in[I_BADA][n]; }
            __syncthreads();
        }
    }
    { u32x4* z = (u32x4*)(p.ws + WS_WIN + (size_t)2392 * 2048 * 2); const int n16 = 168 * 2048 * 2 / 16;
      for (int i = bx * NTHREADS + tid; i < n16; i += G * NTHREADS) z[i] = (u32x4){0u, 0u, 0u, 0u}; }
    { bf16_t* wh = (bf16_t*)(p.ws + WS_WRH); bf16_t* wl = (bf16_t*)(p.ws + WS_WRL);
      for (int i = bx * NTHREADS + tid; i < 80 * 2048; i += G * NTHREADS) { const int n = i >> 11, k = i & 2047;
          const float v = n < 8 ? p.in[I_WRG][k * 8 + n] : (n < 72 ? p.in[I_WRE][k * 64 + n - 8] : 0.f);
          const unsigned h = cvt_pk_bf16(v, 0.f) & 0xffffu; const unsigned l = cvt_pk_bf16(v - bf_lo(h), 0.f) & 0xffffu; wh[i] = (bf16_t)h; wl[i] = (bf16_t)l; } }
    LAS float* tile = (LAS float*)(lds + 65536);
    for (int ti = bx; ti < p.ntiles_total; ti += G) {
        int j = 0;
#pragma unroll 1
        for (int q = 1; q < NJOBS; ++q) if (ti >= p.jobs[q].tile0) j = q;
        const TJob& J = p.jobs[j];
        int l = ti - J.tile0; const int per = J.ntk * J.ntn; const int bt = l / per; l -= bt * per; const int tn = l / J.ntk, tk = l % J.ntk;
        const float* src = J.src + (size_t)bt * J.sbatch; bf16_t* dst = J.dst + (size_t)bt * J.dbatch;
        const int k0 = tk * 64, n0 = tn * 128;
        f32x4 v[4];
#pragma unroll
        for (int i = 0; i < 4; ++i) { const int r = (tid >> 5) + 16 * i, c4 = (tid & 31) * 4;
            v[i] = (f32x4){0.f, 0.f, 0.f, 0.f}; if (n0 + c4 < J.N) v[i] = *(const f32x4*)(src + (size_t)(k0 + r) * J.ld + n0 + c4); }
#pragma unroll
        for (int i = 0; i < 4; ++i) { const int r = (tid >> 5) + 16 * i, c4 = (tid & 31) * 4;
#pragma unroll
            for (int q = 0; q < 4; ++q) tile[r * 129 + c4 + q] = v[i][q]; }
        __syncthreads();
        { const int n = tid >> 2, kq = (tid & 3) * 16;
          if (n0 + n < J.N) { float f[16];
#pragma unroll
              for (int q = 0; q < 16; ++q) f[q] = tile[(kq + q) * 129 + n];
              u32x4 w0, w1; w0.x = cvt_pk_bf16(f[0], f[1]); w0.y = cvt_pk_bf16(f[2], f[3]); w0.z = cvt_pk_bf16(f[4], f[5]); w0.w = cvt_pk_bf16(f[6], f[7]);
              w1.x = cvt_pk_bf16(f[8], f[9]); w1.y = cvt_pk_bf16(f[10], f[11]); w1.z = cvt_pk_bf16(f[12], f[13]); w1.w = cvt_pk_bf16(f[14], f[15]);
              if (J.fp8) { u32x4 w8; w8.x = pack_fp8x4(f[0] * 64.f, f[1] * 64.f, f[2] * 64.f, f[3] * 64.f); w8.y = pack_fp8x4(f[4] * 64.f, f[5] * 64.f, f[6] * 64.f, f[7] * 64.f);
                  w8.z = pack_fp8x4(f[8] * 64.f, f[9] * 64.f, f[10] * 64.f, f[11] * 64.f); w8.w = pack_fp8x4(f[12] * 64.f, f[13] * 64.f, f[14] * 64.f, f[15] * 64.f);
                  *(u32x4*)((unsigned char*)dst + (size_t)(n0 + n) * J.ldd + k0 + kq) = w8; }
              else { bf16_t* d = dst + (size_t)map_row(J.map, n0 + n) * J.ldd + k0 + kq; *(u32x4*)d = w0; *(u32x4*)(d + 8) = w1; } } }
        __syncthreads();
    }
}

__device__ __forceinline__ void norm_row(const float* xr, const float* g, const float* sh, const float* sc, bf16_t* hr, unsigned char* h8, int lane, float (&hv)[32]) {
    f32x4 v[8]; float ss = 0.f;
#pragma unroll
    for (int i = 0; i < 8; ++i) { v[i] = *(const f32x4*)(xr + i * 256 + lane * 4); ss += v[i][0] * v[i][0] + v[i][1] * v[i][1] + v[i][2] * v[i][2] + v[i][3] * v[i][3]; }
    ss = wave_sum(ss);
    const float rstd = rsqrtf(ss * (1.0f / 2048.0f) + RMS_EPS);
#pragma unroll
    for (int i = 0; i < 8; ++i) { const int col = i * 256 + lane * 4; const f32x4 gg = *(const f32x4*)(g + col), s1 = *(const f32x4*)(sc + col), s0 = *(const f32x4*)(sh + col);
#pragma unroll
        for (int j = 0; j < 4; ++j) hv[i * 4 + j] = v[i][j] * rstd * gg[j] * (1.0f + s1[j]) + s0[j];
        u32x2 w; w.x = cvt_pk_bf16(hv[i * 4], hv[i * 4 + 1]); w.y = cvt_pk_bf16(hv[i * 4 + 2], hv[i * 4 + 3]); *(u32x2*)(hr + col) = w;
        if (h8) *(unsigned*)(h8 + col) = pack_fp8x4(hv[i * 4], hv[i * 4 + 1], hv[i * 4 + 2], hv[i * 4 + 3]); }
}
__device__ void ph1_norm(const Params& p) {
    const int lane = threadIdx.x & 63, gw = blockIdx.x * 8 + (threadIdx.x >> 6), nw = gridDim.x * 8;
    const float* mod = (const float*)(p.ws + WS_MOD);
    for (int t = gw; t < NTOK; t += nw) { const int b = t >> 11; float hv[32];
        norm_row(p.in[I_X] + (size_t)t * DM, p.in[I_GMIX], mod + b * 12288, mod + b * 12288 + 2048, (bf16_t*)(p.ws + WS_H) + (size_t)t * DM, (unsigned char*)(p.ws + WS_HF8) + (size_t)t * DM, lane, hv); }
}

template <int MB, int NB, int KS>
__device__ __forceinline__ void wave_gemm(const bf16_t* A, int lda, const bf16_t* Bt, int ldb, f32x4 (&acc)[MB][NB], int lane) {
    const int fr = lane & 15, fq = lane >> 4;
#pragma unroll
    for (int mb = 0; mb < MB; ++mb)
#pragma unroll
        for (int nb = 0; nb < NB; ++nb) acc[mb][nb] = (f32x4){0.f, 0.f, 0.f, 0.f};
#pragma unroll 1
    for (int ks = 0; ks < KS; ++ks) {
        bf16x8 af[MB];
#pragma unroll
        for (int mb = 0; mb < MB; ++mb) af[mb] = *(const bf16x8*)(A + (size_t)(mb * 16 + fr) * lda + ks * 32 + fq * 8);
#pragma unroll
        for (int nb = 0; nb < NB; ++nb) { const bf16x8 bf = *(const bf16x8*)(Bt + (size_t)(nb * 16 + fr) * ldb + ks * 32 + fq * 8);
#pragma unroll
            for (int mb = 0; mb < MB; ++mb) acc[mb][nb] = __builtin_amdgcn_mfma_f32_16x16x32_bf16(bf, af[mb], acc[mb][nb], 0, 0, 0); }
    }
}


__device__ __forceinline__ int wave_total_i32(int v) {
    v += __builtin_amdgcn_update_dpp(0, v, 0x111, 0xf, 0xf, true); v += __builtin_amdgcn_update_dpp(0, v, 0x112, 0xf, 0xf, true);
    v += __builtin_amdgcn_update_dpp(0, v, 0x114, 0xf, 0xf, true); v += __builtin_amdgcn_update_dpp(0, v, 0x118, 0xf, 0xf, true);
    v += __builtin_amdgcn_update_dpp(0, v, 0x142, 0xa, 0xf, false); v += __builtin_amdgcn_update_dpp(0, v, 0x143, 0xc, 0xf, false);
    return __builtin_amdgcn_readlane(v, 63);
}
template <int NI> __device__ __forceinline__ unsigned long long topk_words(const LAS float* srow, int c, int lane) {
    unsigned key[NI];
#pragma unroll
    for (int i = 0; i < NI; ++i) { unsigned u = 0u; if (i <= c) { u = __float_as_uint(srow[i * 64 + lane]); u = (u & 0x80000000u) ? ~u : (u | 0x80000000u); } key[i] = u; }
    unsigned v = 0u;
#pragma unroll 1
    for (int bit = 31; bit >= 0; --bit) {
        const unsigned cand = v | (1u << bit); int cl = 0;
#pragma unroll
        for (int i = 0; i < NI; ++i) cl += (key[i] >= cand) ? 1 : 0;
        const int tot = wave_total_i32(cl);
        if (tot >= 256) { v = cand; if (tot == 256) break; }
    }
    unsigned long long myword = 0ull;
#pragma unroll
    for (int i = 0; i < NI; ++i) { const unsigned long long bm = __ballot(key[i] >= v); if (lane == i) myword = bm; if ((i & 3) == 3) SBAR(); }
    return myword;
}
__device__ void idx_item(const Params& p, LAS unsigned char* lds, int b, int c, int sub) {
    const int tid = threadIdx.x, wid = tid >> 6, lane = tid & 63, fr = lane & 15, fq = lane >> 4;
    constexpr int SCLD = 2052;
    LAS float* sc = (LAS float*)lds;
    const int q0 = c * 64 + sub * 16, nk = (c + 1) * 64, nkb = nk / 16;
    const bf16_t* qidx = (const bf16_t*)(p.ws + WS_QIDX) + (size_t)(b * SEQ + q0 + fr) * 1024;
    const float* misc = (const float*)(p.ws + WS_MISC);
    float wq[16];
    { const float* wp = misc + (size_t)(b * SEQ + q0 + fr) * 256 + 64;
#pragma unroll
      for (int i = 0; i < 4; ++i) { const f32x4 v = *(const f32x4*)(wp + i * 4); wq[i * 4] = v[0]; wq[i * 4 + 1] = v[1]; wq[i * 4 + 2] = v[2]; wq[i * 4 + 3] = v[3]; } }
#pragma unroll
    for (int hp = 0; hp < 2; ++hp) {
        bf16x8 qf[8][2];
#pragma unroll
        for (int h = 0; h < 8; ++h)
#pragma unroll
            for (int ks = 0; ks < 2; ++ks) qf[h][ks] = *(const bf16x8*)(qidx + (hp * 8 + h) * 64 + ks * 32 + fq * 8);
        const bf16_t* kbase = (const bf16_t*)(p.ws + WS_KIDX) + (size_t)(b * SEQ + fr) * 64 + fq * 8;
        bf16x8 kf[2];
        if (wid < nkb) { kf[0] = *(const bf16x8*)(kbase + (size_t)wid * 16 * 64); kf[1] = *(const bf16x8*)(kbase + (size_t)wid * 16 * 64 + 32); }
#pragma unroll 1
        for (int kb = wid; kb < nkb; kb += 8) {
            const int kn = kb + 8 < nkb ? kb + 8 : kb;
            const bf16x8 kn0 = *(const bf16x8*)(kbase + (size_t)kn * 16 * 64), kn1 = *(const bf16x8*)(kbase + (size_t)kn * 16 * 64 + 32);
            LAS f32x4* sp = (LAS f32x4*)(sc + fr * SCLD + kb * 16 + fq * 4);
            f32x4 s = {0.f, 0.f, 0.f, 0.f}; if (hp) s = *sp;
#pragma unroll
            for (int h = 0; h < 8; ++h) {
                f32x4 a = {0.f, 0.f, 0.f, 0.f};
                a = __builtin_amdgcn_mfma_f32_16x16x32_bf16(kf[0], qf[h][0], a, 0, 0, 0);
                a = __builtin_amdgcn_mfma_f32_16x16x32_bf16(kf[1], qf[h][1], a, 0, 0, 0);
#pragma unroll
                for (int j = 0; j < 4; ++j) s[j] += wq[hp * 8 + h] * fmaxf(a[j], 0.f);
            }
            *sp = s; kf[0] = kn0; kf[1] = kn1;
        }
    }
    __syncthreads();
    unsigned long long* mask = (unsigned long long*)(p.ws + WS_MASK);
    for (int qq = 0; qq < 2; ++qq) {
        const int ql = wid * 2 + qq; const size_t qg = (size_t)b * SEQ + q0 + ql;
        unsigned long long myword = 0ull;
        if (nk <= 256) { if (lane <= c) myword = ~0ull; }
        else { const LAS float* srow = sc + ql * SCLD;
            if (c < 8) myword = topk_words<8>(srow, c, lane); else if (c < 16) myword = topk_words<16>(srow, c, lane);
            else if (c < 24) myword = topk_words<24>(srow, c, lane); else myword = topk_words<32>(srow, c, lane); }
        if (lane < 32) mask[qg * 32 + lane] = myword;
    }
    __syncthreads();
}
#ifndef REP_SUB
#define REP_SUB 15
#endif
__device__ void ph3_prep(const Params& p, LAS unsigned char* lds, const int rep) {
#define P3ON(bit) (!rep || ((REP_SUB) & (bit)))
    const int tid = threadIdx.x, wid = tid >> 6, lane = tid & 63, bx = blockIdx.x, G = gridDim.x;
    if (P3ON(1)) for (int it = bx; it < 256; it += G) {
        const int b = it >> 6, r = it & 63, cp = r >> 2, sub = r & 3;
        idx_item(p, lds, b, 31 - cp, sub); idx_item(p, lds, b, cp, sub);
    }
    const int gw = bx * 8 + wid, nw = G * 8;
    if (P3ON(2)) for (int it = gw; it < 2048; it += nw) {
        const int rt = it >> 3, h = it & 7, fr = lane & 15, fq = lane >> 4;
        f32x4 acc[2][16];
        wave_gemm<2, 16, 4>((const bf16_t*)(p.ws + WS_QA) + (size_t)rt * 32 * 1024 + h * 128, 1024, (const bf16_t*)(p.ws + WS_WUK) + (size_t)h * 256 * 128, 128, acc, lane);
#pragma unroll
        for (int mb = 0; mb < 2; ++mb) { float ss = 0.f;
#pragma unroll
            for (int nb = 0; nb < 16; ++nb)
#pragma unroll
                for (int j = 0; j < 4; ++j) ss += acc[mb][nb][j] * acc[mb][nb][j];
            ss += __shfl_xor(ss, 16); ss += __shfl_xor(ss, 32);
            const float rs = rsqrtf(ss * (1.0f / 256.0f) + RMS_EPS) * 0.0625f;
            bf16_t* o = (bf16_t*)(p.ws + WS_QLAT) + (size_t)(rt * 32 + mb * 16 + fr) * 2048 + h * 256;
#pragma unroll
            for (int nb = 0; nb < 16; ++nb) { const int col = nb * 16 + fq * 4; const f32x4 g = *(const f32x4*)(p.in[I_GQA] + col);
                u32x2 w; w.x = cvt_pk_bf16(acc[mb][nb][0] * rs * g[0], acc[mb][nb][1] * rs * g[1]); w.y = cvt_pk_bf16(acc[mb][nb][2] * rs * g[2], acc[mb][nb][3] * rs * g[3]); *(u32x2*)(o + col) = w; } }
    }
    if (P3ON(4)) for (int t = gw; t < NTOK; t += nw) {
        { const f32x4 v = *(const f32x4*)((const float*)(p.ws + WS_CKV) + (size_t)t * 256 + lane * 4); float ss = wave_sum(v[0] * v[0] + v[1] * v[1] + v[2] * v[2] + v[3] * v[3]);
          const float rs = rsqrtf(ss * (1.0f / 256.0f) + RMS_EPS); const f32x4 g = *(const f32x4*)(p.in[I_GKV] + lane * 4);
          u32x2 w; w.x = cvt_pk_bf16(v[0] * rs * g[0], v[1] * rs * g[1]); w.y = cvt_pk_bf16(v[2] * rs * g[2], v[3] * rs * g[3]); *(u32x2*)((bf16_t*)(p.ws + WS_KV) + (size_t)t * 256 + lane * 4) = w; }
#pragma unroll
        for (int which = 0; which < 2; ++which) {
            bf16_t* row = (bf16_t*)(p.ws + (which ? WS_KB : WS_QB)) + (size_t)t * 1024 + lane * 16; const float* g = p.in[which ? I_GKB : I_GQB] + (lane & 7) * 16;
            u32x4 a = *(u32x4*)row, c2 = *(u32x4*)(row + 8); float f[16];
            f[0] = bf_lo(a.x); f[1] = bf_hi(a.x); f[2] = bf_lo(a.y); f[3] = bf_hi(a.y); f[4] = bf_lo(a.z); f[5] = bf_hi(a.z); f[6] = bf_lo(a.w); f[7] = bf_hi(a.w);
            f[8] = bf_lo(c2.x); f[9] = bf_hi(c2.x); f[10] = bf_lo(c2.y); f[11] = bf_hi(c2.y); f[12] = bf_lo(c2.z); f[13] = bf_hi(c2.z); f[14] = bf_lo(c2.w); f[15] = bf_hi(c2.w);
            float ss = 0.f;
#pragma unroll
            for (int j = 0; j < 16; ++j) ss += f[j] * f[j];
            ss += __shfl_xor(ss, 1); ss += __shfl_xor(ss, 2); ss += __shfl_xor(ss, 4);
            const float rs = rsqrtf(ss * (1.0f / 128.0f) + RMS_EPS) * (which ? 1.0f : 0.08838834764831845f);
#pragma unroll
            for (int j = 0; j < 16; ++j) f[j] *= rs * g[j];
            a.x = cvt_pk_bf16(f[0], f[1]); a.y = cvt_pk_bf16(f[2], f[3]); a.z = cvt_pk_bf16(f[4], f[5]); a.w = cvt_pk_bf16(f[6], f[7]);
            c2.x = cvt_pk_bf16(f[8], f[9]); c2.y = cvt_pk_bf16(f[10], f[11]); c2.z = cvt_pk_bf16(f[12], f[13]); c2.w = cvt_pk_bf16(f[14], f[15]);
            if (!rep) { *(u32x4*)row = a; *(u32x4*)(row + 8) = c2; } else if (a.x == 0x12345678u) *(u32x4*)row = c2;
        }
    }
    if (P3ON(8) && bx < NBATCH) {
        const int b = bx; const float* fp = (const float*)(p.ws + WS_MISC) + (size_t)(b * SEQ + 4 * tid) * 256 + 80;
        float ls[4][8];
#pragma unroll
        for (int j = 0; j < 4; ++j) { const f32x4 a = *(const f32x4*)(fp + j * 256), c4 = *(const f32x4*)(fp + j * 256 + 4);
#pragma unroll
            for (int h = 0; h < 8; ++h) { const float z = (h < 4 ? a[h & 3] : c4[h & 3]) + p.in[I_BFORGET][h]; ls[j][h] = fminf(z, 0.f) - log1pf(__expf(-fabsf(z))); } }
        LAS float* wt = (LAS float*)lds;
        float off[8];
#pragma unroll
        for (int h = 0; h < 8; ++h) { ls[1][h] += ls[0][h]; ls[2][h] += ls[1][h]; ls[3][h] += ls[2][h];
            float incl = ls[3][h];
#pragma unroll
            for (int o = 1; o < 64; o <<= 1) { const float t2 = __shfl_up(incl, o); if (lane >= o) incl += t2; }
            if (lane == 63) wt[wid * 8 + h] = incl;
            off[h] = incl - ls[3][h]; }
        __syncthreads();
#pragma unroll
        for (int h = 0; h < 8; ++h) { float wo = 0.f; for (int w8 = 0; w8 < wid; ++w8) wo += wt[w8 * 8 + h];
            float* cp = (float*)(p.ws + WS_CUM) + (size_t)(b * 8 + h) * SEQ + 4 * tid;
            *(f32x4*)cp = (f32x4){ls[0][h] + off[h] + wo, ls[1][h] + off[h] + wo, ls[2][h] + off[h] + wo, ls[3][h] + off[h] + wo}; }
        __syncthreads();
    }
}

template <int OFF> __device__ __forceinline__ s16x4 tr_read(int vb) { s16x4 r; asm volatile("ds_read_b64_tr_b16 %0, %1 offset:%2" : "=&v"(r) : "v"(vb), "i"(OFF) : "memory"); return r; }
__device__ __forceinline__ int v_rd_base(int lane) { return ((lane & 3) << 3) | (((lane >> 2) & 3) << 6) | (((lane >> 4) & 1) << 5) | (((lane >> 5) & 1) << 8); }
#define PK4(P, BASE, OUT) do { unsigned a0 = cvt_pk_bf16(P[BASE + 0], P[BASE + 1]), a1 = cvt_pk_bf16(P[BASE + 2], P[BASE + 3]);   \
    unsigned b0 = cvt_pk_bf16(P[BASE + 4], P[BASE + 5]), b1 = cvt_pk_bf16(P[BASE + 6], P[BASE + 7]);                              \
    auto r0 = __builtin_amdgcn_permlane32_swap(a0, b0, false, false); auto r1 = __builtin_amdgcn_permlane32_swap(a1, b1, false, false); \
    u32x4 w = {r0[0], r1[0], r0[1], r1[1]}; OUT = *reinterpret_cast<bf16x8*>(&w); } while (0)
#define PKV(L, H) (bf16x8){L[0], L[1], L[2], L[3], H[0], H[1], H[2], H[3]}
template <int NCB, int KS0, int D0> struct PvPairs { static __device__ __forceinline__ void run(f32x16* o, int vb, bf16x8 pa0, bf16x8 pa1) {
    constexpr int S = 2 * NCB * 512, H = NCB * 512;
    const s16x4 l00 = tr_read<D0 * 512 + KS0 * S>(vb), h00 = tr_read<D0 * 512 + KS0 * S + H>(vb), l01 = tr_read<D0 * 512 + (KS0 + 1) * S>(vb), h01 = tr_read<D0 * 512 + (KS0 + 1) * S + H>(vb);
    const s16x4 l10 = tr_read<(D0 + 1) * 512 + KS0 * S>(vb), h10 = tr_read<(D0 + 1) * 512 + KS0 * S + H>(vb), l11 = tr_read<(D0 + 1) * 512 + (KS0 + 1) * S>(vb), h11 = tr_read<(D0 + 1) * 512 + (KS0 + 1) * S + H>(vb);
    asm volatile("s_waitcnt lgkmcnt(0)" ::: "memory"); SBAR();
    o[D0] = __builtin_amdgcn_mfma_f32_32x32x16_bf16(pa0, PKV(l00, h00), o[D0], 0, 0, 0); o[D0 + 1] = __builtin_amdgcn_mfma_f32_32x32x16_bf16(pa0, PKV(l10, h10), o[D0 + 1], 0, 0, 0);
    o[D0] = __builtin_amdgcn_mfma_f32_32x32x16_bf16(pa1, PKV(l01, h01), o[D0], 0, 0, 0); o[D0 + 1] = __builtin_amdgcn_mfma_f32_32x32x16_bf16(pa1, PKV(l11, h11), o[D0 + 1], 0, 0, 0);
    if constexpr (D0 + 2 < NCB) PvPairs<NCB, KS0, D0 + 2>::run(o, vb, pa0, pa1); } };
__device__ __forceinline__ int swap23(int k) { return (k & ~0xC) | ((k & 4) << 1) | ((k & 8) >> 1); }
constexpr int FOX_STAGE = 33024;
constexpr int FOX_AL = 2 * FOX_STAGE, FOX_LI = FOX_AL + 1024;
__device__ void fox_item(const Params& p, LAS unsigned char* lds, int b, int h, int qb) {
    int tid = threadIdx.x; asm volatile("" : "+v"(tid));
    const int wid = __builtin_amdgcn_readfirstlane(tid >> 6), lane = tid & 63, r32 = lane & 31, hi = lane >> 5;
    const bf16_t* Q = (const bf16_t*)(p.ws + WS_QB);
    const char* Kg = (const char*)(p.ws + WS_KB) + ((size_t)b * SEQ * 1024 + h * 128) * 2; const char* Vg = (const char*)(p.ws + WS_VB) + ((size_t)b * SEQ * 1024 + h * 128) * 2;
    const float* cum = (const float*)(p.ws + WS_CUM) + (size_t)(b * 8 + h) * SEQ;
    const int qpos = qb * 256 + wid * 32 + r32;
    bf16x8 qr[8];
    { const bf16_t* qp = Q + (size_t)(b * SEQ + qpos) * 1024 + h * 128 + hi * 8;
#pragma unroll
      for (int d0 = 0; d0 < 8; ++d0) qr[d0] = *(const bf16x8*)(qp + d0 * 16); }
    const float cq = cum[qpos] * LOG2E;
    unsigned ksrc[2], vsrc[2];
#pragma unroll
    for (int i = 0; i < 2; ++i) { const int pos = (i * 512 + tid) * 16;
        { const int row = pos >> 8; const int cb = (pos & 255) ^ ((row & 7) << 4); ksrc[i] = (unsigned)(row * 2048 + cb); }
        { const int sub = pos >> 9, within = pos & 511; const int kk = (sub >> 2) * 8 + (within >> 6); const int c = (sub & 3) * 32 + ((within & 63) >> 1); vsrc[i] = (unsigned)(swap23(kk) * 2048 + c * 2); } }
    float m_reg = -1e30f, l_reg = 0.f; f32x16 o[4];
#pragma unroll
    for (int d = 0; d < 4; ++d)
#pragma unroll
        for (int r = 0; r < 16; ++r) o[d][r] = 0.f;
    LAS float* al_l = (LAS float*)(lds + FOX_AL) + wid * 32; LAS float* li_l = (LAS float*)(lds + FOX_LI) + wid * 32;
    const int ntiles = qb * 4 + 4, mylast = qb * 4 + (wid >> 1);
#define FOX_DMA(kt) do { LAS unsigned char* sb_ = lds + ((kt) & 1) * FOX_STAGE; const size_t go_ = (size_t)(kt) * 64 * 2048; \
        _Pragma("unroll") for (int i = 0; i < 2; ++i) { \
            __builtin_amdgcn_global_load_lds((const unsigned*)(Kg + go_ + ksrc[i]), (LAS unsigned*)(sb_ + 16384 + (i * 512 + wid * 64) * 16), 16, 0, 0); \
            __builtin_amdgcn_global_load_lds((const unsigned*)(Vg + go_ + vsrc[i]), (LAS unsigned*)(sb_ + (i * 512 + wid * 64) * 16), 16, 0, 0); } \
        if (wid == 0) __builtin_amdgcn_global_load_lds((const unsigned*)(cum + (kt) * 64 + lane), (LAS unsigned*)(sb_ + 32768), 4, 0, 0); } while (0)
    __syncthreads();
    FOX_DMA(0);
    for (int kt = 0; kt < ntiles; ++kt) {
        asm volatile("s_waitcnt vmcnt(0)" ::: "memory");
        __syncthreads();
        if (kt + 1 < ntiles) FOX_DMA(kt + 1);
        if (kt <= mylast) {
            const LAS unsigned char* sb = lds + (kt & 1) * FOX_STAGE; const LAS float* ck = (const LAS float*)(sb + 32768);
            const int vb = (int)(uintptr_t)sb + v_rd_base(lane);
            f32x16 p0, p1;
#pragma unroll
            for (int r = 0; r < 16; ++r) { p0[r] = 0.f; p1[r] = 0.f; }
            int fsw = (r32 & 7) << 4; asm volatile("" : "+v"(fsw));
#pragma unroll
            for (int d0 = 0; d0 < 8; ++d0) { const int cb = (d0 * 16 + hi * 8) * 2;
                const bf16x8 b0 = *(const LAS bf16x8*)(sb + 16384 + r32 * 256 + (cb ^ fsw));
                const bf16x8 b1 = *(const LAS bf16x8*)(sb + 16384 + (32 + r32) * 256 + (cb ^ fsw));
                p0 = __builtin_amdgcn_mfma_f32_32x32x16_bf16(b0, qr[d0], p0, 0, 0, 0); p1 = __builtin_amdgcn_mfma_f32_32x32x16_bf16(b1, qr[d0], p1, 0, 0, 0); }
            const bool diag = (kt * 64 + 63 > qb * 256 + wid * 32);
            float pmax = -INFINITY;
#pragma unroll
            for (int g4 = 0; g4 < 4; ++g4) { const f32x4 c0 = *(const LAS f32x4*)(ck + 8 * g4 + 4 * hi), c1 = *(const LAS f32x4*)(ck + 32 + 8 * g4 + 4 * hi);
#pragma unroll
                for (int j = 0; j < 4; ++j) { const int r = g4 * 4 + j; float t0 = fmaf(p0[r], LOG2E, cq) - c0[j] * LOG2E, t1 = fmaf(p1[r], LOG2E, cq) - c1[j] * LOG2E;
                    if (diag) { const int kp = kt * 64 + crow(r, hi); if (kp > qpos) t0 = -INFINITY; if (kp + 32 > qpos) t1 = -INFINITY; }
                    p0[r] = t0; p1[r] = t1; pmax = fmaxf(pmax, fmaxf(t0, t1)); } }
            { auto rr = __builtin_amdgcn_permlane32_swap(__float_as_uint(pmax), __float_as_uint(pmax), false, false); pmax = fmaxf(__uint_as_float(rr[0]), __uint_as_float(rr[1])); }
            const float mn = fmaxf(m_reg, pmax); const float alpha = __builtin_amdgcn_exp2f(m_reg - mn); m_reg = mn;
            float ps = 0.f;
#pragma unroll
            for (int r = 0; r < 16; ++r) { p0[r] = __builtin_amdgcn_exp2f(p0[r] - mn); p1[r] = __builtin_amdgcn_exp2f(p1[r] - mn); ps += p0[r] + p1[r]; }
            { auto rr = __builtin_amdgcn_permlane32_swap(__float_as_uint(ps), __float_as_uint(ps), false, false); ps = __uint_as_float(rr[0]) + __uint_as_float(rr[1]); }
            l_reg = l_reg * alpha + ps;
            if (__any(alpha < 1.f)) { if (hi == 0) al_l[r32] = alpha; asm volatile("s_waitcnt lgkmcnt(0)" ::: "memory");
#pragma unroll
                for (int r = 0; r < 16; ++r) { const float a = al_l[crow(r, hi)];
#pragma unroll
                    for (int d = 0; d < 4; ++d) o[d][r] *= a; } }
            bf16x8 pa0, pa1, pa2, pa3; PK4(p0, 0, pa0); PK4(p0, 8, pa1); PK4(p1, 0, pa2); PK4(p1, 8, pa3);
            PvPairs<4, 0, 0>::run(o, vb, pa0, pa1); PvPairs<4, 2, 0>::run(o, vb, pa2, pa3);
        }
    }
#undef FOX_DMA
    if (hi == 0) li_l[r32] = l_reg; asm volatile("s_waitcnt lgkmcnt(0)" ::: "memory");
    unsigned char* O8 = (unsigned char*)(p.ws + WS_OB8) + (size_t)(b * SEQ + qb * 256 + wid * 32) * 1024 + h * 128;
#pragma unroll
    for (int r = 0; r < 16; ++r) { const float rl = __builtin_amdgcn_rcpf(li_l[crow(r, hi)]); const int orow = crow(r, hi);
#pragma unroll
        for (int d0 = 0; d0 < 4; ++d0) O8[(size_t)orow * 1024 + d0 * 32 + r32] = (unsigned char)(pack_fp8x4(o[d0][r] * rl * 8.f, 0.f, 0.f, 0.f) & 0xffu); }
}

constexpr int DSA_STAGE = 32768;
constexpr int DSA_AL = 2 * DSA_STAGE, DSA_LI = DSA_AL + 1024, DSA_Q = DSA_LI + 1024;
__device__ void dsa_item(const Params& p, LAS unsigned char* lds, int b, int qt) {
    int tid = threadIdx.x; asm volatile("" : "+v"(tid));
    const int wid = __builtin_amdgcn_readfirstlane(tid >> 6), lane = tid & 63, r32 = lane & 31, hi = lane >> 5, h = wid;
    const char* KV = (const char*)(p.ws + WS_KV) + (size_t)b * SEQ * 512;
    const int qpos = qt * 32 + r32; const size_t qg = (size_t)b * SEQ + qpos;
    const unsigned* mask = (const unsigned*)(p.ws + WS_MASK) + qg * 64;
    bf16x8 qr[8];
    LAS unsigned char* qlds = lds + DSA_Q + wid * 8192 + lane * 16;
    __syncthreads();
    { const bf16_t* qp = (const bf16_t*)(p.ws + WS_QLAT) + qg * 2048 + h * 256 + hi * 8;
#pragma unroll
      for (int d0 = 0; d0 < 8; ++d0) qr[d0] = *(const bf16x8*)(qp + d0 * 16);
#pragma unroll
      for (int d0 = 8; d0 < 16; ++d0) *(LAS bf16x8*)(qlds + (d0 - 8) * 1024) = *(const bf16x8*)(qp + d0 * 16); }
    unsigned ksrc[2], vsrc[2];
#pragma unroll
    for (int i = 0; i < 2; ++i) { const int pos = (i * 512 + tid) * 16;
        { const int row = pos >> 9; const int cb = (pos & 511) ^ ((row & 15) << 4); ksrc[i] = (unsigned)(row * 512 + cb); }
        { const int sub = pos >> 9, within = pos & 511; const int kk = (sub >> 3) * 8 + (within >> 6); const int c = (sub & 7) * 32 + ((within & 63) >> 1); vsrc[i] = (unsigned)(swap23(kk) * 512 + c * 2); } }
    const float slopeL = exp2f(-(float)(h + 1)) * LOG2E;
    float m_reg = -1e30f, l_reg = 0.f; f32x16 o[8];
#pragma unroll
    for (int d = 0; d < 8; ++d)
#pragma unroll
        for (int r = 0; r < 16; ++r) o[d][r] = 0.f;
    LAS float* al_l = (LAS float*)(lds + DSA_AL) + wid * 32; LAS float* li_l = (LAS float*)(lds + DSA_LI) + wid * 32;
    const int ntiles = ((qt >> 1) + 1) * 2;
#define DSA_DMA(kt) do { LAS unsigned char* sb_ = lds + ((kt) & 1) * DSA_STAGE; const size_t go_ = (size_t)(kt) * 32 * 512; \
        _Pragma("unroll") for (int i = 0; i < 2; ++i) { \
            __builtin_amdgcn_global_load_lds((const unsigned*)(KV + go_ + ksrc[i]), (LAS unsigned*)(sb_ + 16384 + (i * 512 + wid * 64) * 16), 16, 0, 0); \
            __builtin_amdgcn_global_load_lds((const unsigned*)(KV + go_ + vsrc[i]), (LAS unsigned*)(sb_ + (i * 512 + wid * 64) * 16), 16, 0, 0); } } while (0)
    unsigned mw = mask[0];
    DSA_DMA(0);
    for (int kt = 0; kt < ntiles; ++kt) {
        asm volatile("s_waitcnt vmcnt(0)" ::: "memory");
        __syncthreads();
        const unsigned mcur = mw;
        if (kt + 1 < ntiles) { mw = mask[kt + 1]; DSA_DMA(kt + 1); }
        const LAS unsigned char* sb = lds + (kt & 1) * DSA_STAGE; const int vb = (int)(uintptr_t)sb + v_rd_base(lane);
        f32x16 pp;
#pragma unroll
        for (int r = 0; r < 16; ++r) pp[r] = 0.f;
        {
            const LAS unsigned char* kb_ = sb + 16384 + r32 * 512; int sw_ = (r32 & 15) << 4; asm volatile("" : "+v"(sw_));
#define DSA_KF(d0) (*(const LAS bf16x8*)(kb_ + ((((d0) * 16 + hi * 8) * 2) ^ sw_)))
#define DSA_QF(d0) ((d0) < 8 ? qr[(d0) & 7] : *(const LAS bf16x8*)(qlds + (((d0) - 8) & 7) * 1024))
            bf16x8 k0 = DSA_KF(0), k1 = DSA_KF(1), q0 = DSA_QF(0), q1 = DSA_QF(1);
#pragma unroll
            for (int d0 = 0; d0 < 16; d0 += 2) {
                bf16x8 nk0 = k0, nk1 = k1, nq0 = q0, nq1 = q1;
                if (d0 + 2 < 16) { nk0 = DSA_KF(d0 + 2); nk1 = DSA_KF(d0 + 3); nq0 = DSA_QF(d0 + 2); nq1 = DSA_QF(d0 + 3); }
                pp = __builtin_amdgcn_mfma_f32_32x32x16_bf16(k0, q0, pp, 0, 0, 0); pp = __builtin_amdgcn_mfma_f32_32x32x16_bf16(k1, q1, pp, 0, 0, 0);
                k0 = nk0; k1 = nk1; q0 = nq0; q1 = nq1; SBAR();
            }
#undef DSA_KF
#undef DSA_QF
        }
        const unsigned wsh = mcur >> (4 * hi);
        const float df = (float)(qpos - (kt * 32 + 4 * hi));
        float pmax = -INFINITY;
#pragma unroll
        for (int r = 0; r < 16; ++r) { const int cb = (r & 3) + 8 * (r >> 2); const float dd = df - (float)cb;
            float t = fmaf(-slopeL, fabsf(dd), pp[r] * LOG2E); if (!((wsh >> cb) & 1u)) t = -INFINITY; pp[r] = t; pmax = fmaxf(pmax, t); }
        { auto rr = __builtin_amdgcn_permlane32_swap(__float_as_uint(pmax), __float_as_uint(pmax), false, false); pmax = fmaxf(__uint_as_float(rr[0]), __uint_as_float(rr[1])); }
        const float mn = fmaxf(m_reg, pmax); const float alpha = __builtin_amdgcn_exp2f(m_reg - mn); m_reg = mn;
        float ps = 0.f;
#pragma unroll
        for (int r = 0; r < 16; ++r) { pp[r] = __builtin_amdgcn_exp2f(pp[r] - mn); ps += pp[r]; }
        { auto rr = __builtin_amdgcn_permlane32_swap(__float_as_uint(ps), __float_as_uint(ps), false, false); ps = __uint_as_float(rr[0]) + __uint_as_float(rr[1]); }
        l_reg = l_reg * alpha + ps;
        if (__any(alpha < 1.f)) { if (hi == 0) al_l[r32] = alpha; asm volatile("s_waitcnt lgkmcnt(0)" ::: "memory");
#pragma unroll
            for (int r = 0; r < 16; ++r) { const float a = al_l[crow(r, hi)];
#pragma unroll
                for (int d = 0; d < 8; ++d) o[d][r] *= a; } }
        bf16x8 pa0, pa1; PK4(pp, 0, pa0); PK4(pp, 8, pa1);
        PvPairs<8, 0, 0>::run(o, vb, pa0, pa1);
    }
#undef DSA_DMA
    if (hi == 0) li_l[r32] = l_reg; asm volatile("s_waitcnt lgkmcnt(0)" ::: "memory");
    float rl[16];
#pragma unroll
    for (int r = 0; r < 16; ++r) rl[r] = __builtin_amdgcn_rcpf(li_l[crow(r, hi)]);
    __syncthreads();
    LAS bf16_t* os = (LAS bf16_t*)(lds + wid * 16896);
#pragma unroll
    for (int r = 0; r < 16; ++r)
#pragma unroll
        for (int d0 = 0; d0 < 8; ++d0) os[crow(r, hi) * 264 + d0 * 32 + r32] = (bf16_t)(cvt_pk_bf16(o[d0][r] * rl[r], 0.f) & 0xffffu);
    asm volatile("s_waitcnt lgkmcnt(0)" ::: "memory");
    f32x16 ya[4];
#pragma unroll
    for (int nb = 0; nb < 4; ++nb)
#pragma unroll
        for (int r = 0; r < 16; ++r) ya[nb][r] = 0.f;
    const bf16_t* wv = (const bf16_t*)(p.ws + WS_WUV) + (size_t)(h * 128 + r32) * 256 + hi * 8;
#pragma unroll 4
    for (int ks = 0; ks < 16; ++ks) {
        const bf16x8 af = *(const LAS bf16x8*)(os + r32 * 264 + ks * 16 + hi * 8);
#pragma unroll
        for (int nb = 0; nb < 4; ++nb) { const bf16x8 wf = *(const bf16x8*)(wv + (size_t)nb * 32 * 256 + ks * 16); ya[nb] = __builtin_amdgcn_mfma_f32_32x32x16_bf16(wf, af, ya[nb], 0, 0, 0); }
    }
    unsigned char* O8 = (unsigned char*)(p.ws + WS_OA8) + ((size_t)b * SEQ + qt * 32 + r32) * 1024 + h * 128 + 4 * hi;
#pragma unroll
    for (int nb = 0; nb < 4; ++nb)
#pragma unroll
        for (int g4 = 0; g4 < 4; ++g4) *(unsigned*)(O8 + nb * 32 + g4 * 8) = pack_fp8x4(ya[nb][g4 * 4] * 8.f, ya[nb][g4 * 4 + 1] * 8.f, ya[nb][g4 * 4 + 2] * 8.f, ya[nb][g4 * 4 + 3] * 8.f);
}
__device__ void ph4_attn(const Params& p, LAS unsigned char* lds) {
    const int r = blockIdx.x;
    if (r < 256) { const int c = 31 - (r >> 3), w8 = r & 7, b = w8 >> 1, half = w8 & 1; dsa_item(p, lds, b, c * 2 + half); }
    int* qhead = (int*)(p.ws + WS_CNT) + 512;
    LAS int* slot = (LAS int*)(lds + LDS_BARW - 16);
    for (;;) {
        __syncthreads();
        if (threadIdx.x == 0) *slot = atomicAdd(qhead, 1);
        __syncthreads();
        const int it = __builtin_amdgcn_readfirstlane(*slot);
        if (it >= 256) break;
        const int qb = 7 - (it >> 5), bh = it & 31;
        fox_item(p, lds, bh >> 3, bh & 7, qb);
    }
}

__device__ void ph8_router(const Params& p, LAS unsigned char* lds, const int rep) {
    const int tid = threadIdx.x, wid = tid >> 6, lane = tid & 63, fr = lane & 15, fq = lane >> 4;
    const float* mod = (const float*)(p.ws + WS_MOD);
    bf16_t* H = (bf16_t*)(p.ws + WS_H); bf16_t* HL = (bf16_t*)(p.ws + WS_HLO);
    int* cnt = (int*)(p.ws + WS_CNT) + rep * 256; int* ltok = rep ? (int*)(p.ws + WS_T1) : (int*)(p.ws + WS_LTOK); float* lw = rep ? (float*)(p.ws + WS_T1 + (4u << 20)) : (float*)(p.ws + WS_LW);
    LAS float* slab = (LAS float*)lds + wid * 2560;
    LAS float* lg = (LAS float*)lds + 8 * 2560;
    for (int blk = blockIdx.x; blk < NTOK / 32; blk += gridDim.x) {
        const int t0 = blk * 32;
        {
            const int tb = t0 + wid * 4, b = tb >> 11;
            const float* sh = mod + b * 12288 + 6144; const float* sc = mod + b * 12288 + 8192;
            f32x4 xv[4][8];
#pragma unroll
            for (int rr = 0; rr < 4; ++rr)
#pragma unroll
                for (int i = 0; i < 8; ++i) { const size_t eo = (size_t)(tb + rr) * DM + i * 256 + lane * 4; const u32x2 yb = *(const u32x2*)((const bf16_t*)(p.ws + WS_MERGED) + eo);
                    xv[rr][i] = *(const f32x4*)(p.in[I_X] + eo) + (f32x4){bf_lo(yb.x), bf_hi(yb.x), bf_lo(yb.y), bf_hi(yb.y)}; }
#pragma unroll
            for (int rr = 0; rr < 4; ++rr) {
                float ss = 0.f;
#pragma unroll
                for (int i = 0; i < 8; ++i) ss += xv[rr][i][0] * xv[rr][i][0] + xv[rr][i][1] * xv[rr][i][1] + xv[rr][i][2] * xv[rr][i][2] + xv[rr][i][3] * xv[rr][i][3];
                ss = wave_sum(ss);
                const float rstd = rsqrtf(ss * (1.0f / 2048.0f) + RMS_EPS);
#pragma unroll
                for (int i = 0; i < 8; ++i) { const int col = i * 256 + lane * 4; const f32x4 gg = *(const f32x4*)(p.in[I_GFFN] + col), s1 = *(const f32x4*)(sc + col), s0 = *(const f32x4*)(sh + col);
                    float hv[4], lo[4];
#pragma unroll
                    for (int j = 0; j < 4; ++j) hv[j] = xv[rr][i][j] * rstd * gg[j] * (1.0f + s1[j]) + s0[j];
                    u32x2 wh; wh.x = cvt_pk_bf16(hv[0], hv[1]); wh.y = cvt_pk_bf16(hv[2], hv[3]);
                    lo[0] = hv[0] - bf_lo(wh.x); lo[1] = hv[1] - bf_hi(wh.x); lo[2] = hv[2] - bf_lo(wh.y); lo[3] = hv[3] - bf_hi(wh.y);
                    u32x2 wl; wl.x = cvt_pk_bf16(lo[0], lo[1]); wl.y = cvt_pk_bf16(lo[2], lo[3]);
                    *(u32x2*)(H + (size_t)(tb + rr) * DM + col) = wh; *(u32x2*)(HL + (size_t)(tb + rr) * DM + col) = wl;
                    *(unsigned*)(p.ws + WS_H8 + (size_t)(tb + rr) * DM + col) = pack_fp8x4(hv[0], hv[1], hv[2], hv[3]); }
            }
        }
        asm volatile("s_waitcnt vmcnt(0)" ::: "memory");
        __syncthreads();
        {
            const bf16_t* Ah = H + (size_t)(t0 + fr) * DM + wid * 256 + fq * 8; const bf16_t* Al = HL + (size_t)(t0 + fr) * DM + wid * 256 + fq * 8;
            const bf16_t* Wh = (const bf16_t*)(p.ws + WS_WRH) + (size_t)fr * DM + wid * 256 + fq * 8; const bf16_t* Wl = (const bf16_t*)(p.ws + WS_WRL) + (size_t)fr * DM + wid * 256 + fq * 8;
            f32x4 acc[2][5];
#pragma unroll
            for (int mb = 0; mb < 2; ++mb)
#pragma unroll
                for (int nb = 0; nb < 5; ++nb) acc[mb][nb] = (f32x4){0.f, 0.f, 0.f, 0.f};
#pragma unroll 4
            for (int ks = 0; ks < 8; ++ks) {
                bf16x8 ah[2], al[2];
#pragma unroll
                for (int mb = 0; mb < 2; ++mb) { ah[mb] = *(const bf16x8*)(Ah + (size_t)mb * 16 * DM + ks * 32); al[mb] = *(const bf16x8*)(Al + (size_t)mb * 16 * DM + ks * 32); }
#pragma unroll
                for (int nb = 0; nb < 5; ++nb) { const bf16x8 wh = *(const bf16x8*)(Wh + (size_t)nb * 16 * DM + ks * 32), wl = *(const bf16x8*)(Wl + (size_t)nb * 16 * DM + ks * 32);
#pragma unroll
                    for (int mb = 0; mb < 2; ++mb) {
                        acc[mb][nb] = __builtin_amdgcn_mfma_f32_16x16x32_bf16(wh, ah[mb], acc[mb][nb], 0, 0, 0);
                        acc[mb][nb] = __builtin_amdgcn_mfma_f32_16x16x32_bf16(wl, ah[mb], acc[mb][nb], 0, 0, 0);
                        acc[mb][nb] = __builtin_amdgcn_mfma_f32_16x16x32_bf16(wh, al[mb], acc[mb][nb], 0, 0, 0); } }
            }
#pragma unroll
            for (int mb = 0; mb < 2; ++mb)
#pragma unroll
                for (int nb = 0; nb < 5; ++nb) *(LAS f32x4*)(slab + (mb * 16 + fr) * 80 + nb * 16 + fq * 4) = acc[mb][nb];
        }
        __syncthreads();
        for (int o = tid; o < 2560; o += NTHREADS) { float s = 0.f;
#pragma unroll
            for (int w8 = 0; w8 < 8; ++w8) s += ((LAS float*)lds)[w8 * 2560 + o];
            lg[o] = s; }
        __syncthreads();
        if (tid < 32) {
            const int t = t0 + tid; const LAS float* L = lg + tid * 80;
            float gl[8]; int gi = 0; float gm = -INFINITY;
#pragma unroll
            for (int g = 0; g < 8; ++g) { gl[g] = L[g] + p.in[I_BRG][g]; if (gl[g] > gm) { gm = gl[g]; gi = g; } }
            float se = 0.f;
#pragma unroll
            for (int g = 0; g < 8; ++g) se += __expf(gl[g] - gm);
            const float gwt = 1.0f / se;
            float v1 = -INFINITY, v2 = -INFINITY; int i1 = 0, i2 = 0;
            for (int e = 0; e < 8; ++e) { const float v = L[8 + gi * 8 + e] + p.in[I_BRE][gi * 8 + e];
                if (v > v1) { v2 = v1; i2 = i1; v1 = v; i1 = e; } else if (v > v2) { v2 = v; i2 = e; } }
            const float e2 = __expf(v2 - v1); const float p1 = gwt / (1.0f + e2), p2 = gwt * e2 / (1.0f + e2);
            const int ea = gi * 8 + i1, eb = gi * 8 + i2;
            const int pa = atomicAdd(cnt + ea, 1); const int pb = atomicAdd(cnt + eb, 1);
            ltok[ea * LCAP + pa] = t; lw[ea * LCAP + pa] = p1;
            ltok[eb * LCAP + pb] = t | 0x10000; lw[eb * LCAP + pb] = p2;
        }
        __syncthreads();
    }
}

#define MOE_GLOAD(dst, ptr) asm volatile("global_load_dwordx4 %0, %1, off nt" : "=v"(dst) : "v"(ptr) : "memory")
template <bool UP>
__device__ void moe_gemm(const Params& p, LAS unsigned char* lds, const int rep) {
    constexpr int K = UP ? 2048 : 512, NKT = K / 32, NS = UP ? 8 : 16, LDW = UP ? 512 : 2048;
    constexpr int NSTA = 3, OFF_A = 0, OFF_B = NSTA * 16384;
    int tid = threadIdx.x; asm volatile("" : "+v"(tid));
    const int w = __builtin_amdgcn_readfirstlane(tid >> 6), l = tid & 63, r32 = l & 31, hi = l >> 5;
    LAS int* tab = (LAS int*)(lds + LDS_TAB);
    if (tid == 0) { const int* cnt = (const int*)(p.ws + WS_CNT); int s = 0, ro = 0; for (int e = 0; e < 64; ++e) { const int ce = cnt[e]; tab[e] = s; tab[80 + e] = ce; tab[160 + e] = ro; ro += ce; const int np = (ce + 511) >> 9; s += np > 0 ? np : 1; } tab[64] = s; }
    __syncthreads();
    const int total = __builtin_amdgcn_readfirstlane(tab[64]) * NS;
    const int q = (w & 3) * 8 + (l & 7), g = (w >> 2) * 8 + (l >> 3);
    const unsigned bwoff = (unsigned)(q * 256 + (((g >> 2) ^ (q & 3)) * 16) + (g & 3) * 4);
    const unsigned frag_sw = (unsigned)((r32 >> 2) & 3);
    const int* ltok = (const int*)(p.ws + WS_LTOK); const float* lw = (const float*)(p.ws + WS_LW);
    for (int unit = blockIdx.x; unit < total; unit += gridDim.x) {
        const int pm = unit / NS, ns = unit - pm * NS; int e = 0;
#pragma unroll 1
        for (int s = 32; s >= 1; s >>= 1) if (__builtin_amdgcn_readfirstlane(tab[e + s]) <= pm) e += s;
        const int mp = pm - __builtin_amdgcn_readfirstlane(tab[e]); const int cnt_e = __builtin_amdgcn_readfirstlane(tab[80 + e]), rowoff = __builtin_amdgcn_readfirstlane(tab[160 + e]);
        int nrows = cnt_e - mp * 512; nrows = nrows > 512 ? 512 : nrows; const bool two = nrows > 256;
        const char* abase = UP ? (const char*)(p.ws + WS_H8) : (const char*)(p.ws + WS_ACT8);
        unsigned aoff[2];
#pragma unroll
        for (int i = 0; i < 2; ++i) { const int row = (i * 8 + w) * 32 + (l >> 1); const int hs = (l & 1) ^ ((l >> 4) & 1);
            int src; if (UP) src = row < nrows ? (ltok[e * LCAP + mp * 512 + row] & 0xffff) : 0; else src = rowoff + mp * 512 + (row < nrows ? row : 0);
            aoff[i] = (unsigned)(src * K + hs * 16); }
        const float* bsrc = UP ? (q < 16 ? p.in[I_W1] : p.in[I_W3]) + (size_t)e * 2048 * 512 + ns * 64 + (q & 15) * 4 + (size_t)(2 * g) * LDW
                               : p.in[I_W2] + (size_t)e * 512 * 2048 + ns * 128 + q * 4 + (size_t)(2 * g) * LDW;
        f32x16 acc[2][4];
#pragma unroll
        for (int a = 0; a < 2; ++a)
#pragma unroll
            for (int b = 0; b < 4; ++b)
#pragma unroll
                for (int r = 0; r < 16; ++r) acc[a][b][r] = 0.f;
        f32x4 br[2][2];
#define MOE_ISSUE_B(j, t) do { const int tt_ = (t) < NKT ? (t) : NKT - 1; const float* bp_ = bsrc + (size_t)tt_ * 32 * LDW; MOE_GLOAD(br[j][0], bp_); MOE_GLOAD(br[j][1], bp_ + LDW); } while (0)
#define MOE_ISSUE_A(t, TWO) do { int tt_ = (t) < 0 ? 0 : (t); const int bi_ = (tt_ % NSTA); tt_ = tt_ < NKT ? tt_ : NKT - 1; const char* ap_ = abase + (size_t)tt_ * 32; \
        LAS unsigned char* ab_ = lds + OFF_A + bi_ * 16384 + w * 1024; \
        __builtin_amdgcn_global_load_lds((const unsigned*)(ap_ + aoff[0]), (LAS unsigned*)(ab_), 16, 0, 0); \
        if (TWO) __builtin_amdgcn_global_load_lds((const unsigned*)(ap_ + aoff[1]), (LAS unsigned*)(ab_ + 8192), 16, 0, 0); } while (0)
        const bool two_w = (256 + 32 * w) < nrows;
#define MOE_FRAGS(ks, TWO) do { const unsigned co_ = ((unsigned)((ks) * 2 + hi) ^ frag_sw) * 16u; \
            _Pragma("unroll") for (int nb = 0; nb < 4; ++nb) bf_[nb] = *(const LAS bf16x8*)(bb_ + nb * 2048 + co_); \
            { const unsigned ao_ = ((unsigned)(ks) ^ ((unsigned)(r32 >> 3) & 1u)) * 16u + (unsigned)hi * 8u; a0_ = fp8x8_to_bf16(*(const LAS u32x2*)(ab_ + ao_)); if (TWO) a1_ = fp8x8_to_bf16(*(const LAS u32x2*)(ab_ + 8192 + ao_)); } } while (0)
#define MOE_MMAS(TWO) do { \
            _Pragma("unroll") for (int nb = 0; nb < 4; ++nb) acc[0][nb] = __builtin_amdgcn_mfma_f32_32x32x16_bf16(bf_[nb], a0_, acc[0][nb], 0, 0, 0); \
            if (TWO) { _Pragma("unroll") for (int nb = 0; nb < 4; ++nb) acc[1][nb] = __builtin_amdgcn_mfma_f32_32x32x16_bf16(bf_[nb], a1_, acc[1][nb], 0, 0, 0); } } while (0)
#define MOE_ITER(jn, t, COMPUTE, TWO, WB, WA) do { \
        bf16x8 bf_[4], a0_, a1_; \
        const LAS unsigned char* ab_ = lds + OFF_A + (((t) + 3) % 3) * 16384 + w * 1024 + r32 * 32; const LAS unsigned char* bb_ = lds + OFF_B + ((t) & 1) * 8192 + r32 * 64; \
        if (COMPUTE) { MOE_FRAGS(0, TWO); } SBAR(); \
        asm volatile("s_waitcnt vmcnt(" WB ")" : "+v"(br[jn][0]), "+v"(br[jn][1]) :: "memory"); \
        { LAS unsigned char* bw_ = lds + OFF_B + (((t) + 1) & 1) * 8192 + bwoff; _Pragma("unroll") for (int jj = 0; jj < 4; ++jj) *(LAS unsigned*)(bw_ + jj * 64) = cvt_pk_bf16(br[jn][0][jj], br[jn][1][jj]); } \
        MOE_ISSUE_B(jn, (t) + 3); SBAR(); \
        if (COMPUTE) { MOE_MMAS(TWO); SBAR(); MOE_FRAGS(1, TWO); MOE_MMAS(TWO); } SBAR(); \
        asm volatile("s_waitcnt vmcnt(" WA ")" ::: "memory"); \
        asm volatile("s_waitcnt lgkmcnt(0)" ::: "memory"); __builtin_amdgcn_s_barrier(); asm volatile("" ::: "memory"); \
        MOE_ISSUE_A((t) + 3, TWO); \
        } while (0)
#define MOE_PIPE(TWO, WB, WA) do { \
        MOE_ISSUE_B(0, 0); MOE_ISSUE_A(0, TWO); MOE_ISSUE_B(1, 1); MOE_ISSUE_A(1, TWO); \
        MOE_ITER(0, -1, false, TWO, WB, WA); \
        _Pragma("unroll 1") for (int t = 0; t < NKT; t += 2) { MOE_ITER(1, t, true, TWO, WB, WA); MOE_ITER(0, t + 1, true, TWO, WB, WA); } \
          \
        asm volatile("s_waitcnt vmcnt(0)" : "+v"(br[0][0]), "+v"(br[0][1]), "+v"(br[1][0]), "+v"(br[1][1]) :: "memory"); \
        } while (0)
        if (two_w) MOE_PIPE(true, "6", "6"); else MOE_PIPE(false, "4", "5");
        asm volatile("s_waitcnt vmcnt(0)" ::: "memory");
        if constexpr (UP) {
#pragma unroll
            for (int mt = 0; mt < 2; ++mt) {
                const int rl = mt * 256 + 32 * w + r32;
                if (rl < nrows) {
                    const float gw = lw[e * LCAP + mp * 512 + rl] * 16.0f; unsigned char* orow = (unsigned char*)(p.ws + (rep ? WS_QLAT : WS_ACT8)) + (size_t)(rowoff + mp * 512 + rl) * 512 + ns * 64 + 4 * hi;
#pragma unroll
                    for (int nb = 0; nb < 2; ++nb)
#pragma unroll
                        for (int g4 = 0; g4 < 4; ++g4) { float o[4];
#pragma unroll
                            for (int j = 0; j < 4; ++j) { const float a = acc[mt][nb][g4 * 4 + j], u = acc[mt][nb + 2][g4 * 4 + j]; o[j] = a * sigmoidf_(a) * u * gw; }
                            *(unsigned*)(orow + nb * 32 + g4 * 8) = pack_fp8x4(o[0], o[1], o[2], o[3]); }
                }
            }
        } else {
#pragma unroll
            for (int mt = 0; mt < 2; ++mt) {
                const int rl = mt * 256 + 32 * w + r32;
                if (rl < nrows) {
                    const int ent = ltok[e * LCAP + mp * 512 + rl]; bf16_t* orow = (bf16_t*)(p.ws + WS_YS) + ((size_t)(ent >> 16) * NTOK + (ent & 0xffff)) * 2048 + ns * 128 + 4 * hi;
#pragma unroll
                    for (int nb = 0; nb < 4; ++nb)
#pragma unroll
                        for (int g4 = 0; g4 < 4; ++g4) { u32x2 pk; pk.x = cvt_pk_bf16(acc[mt][nb][g4 * 4] * 0.0625f, acc[mt][nb][g4 * 4 + 1] * 0.0625f); pk.y = cvt_pk_bf16(acc[mt][nb][g4 * 4 + 2] * 0.0625f, acc[mt][nb][g4 * 4 + 3] * 0.0625f); *(u32x2*)(orow + nb * 32 + g4 * 8) = pk; }
                }
            }
        }
        asm volatile("s_waitcnt vmcnt(0)" ::: "memory");
        __syncthreads();
    }
#undef MOE_ISSUE_A
#undef MOE_ISSUE_B
#undef MOE_ITER
#undef MOE_FRAGS
#undef MOE_MMAS
#undef MOE_PIPE
}


__device__ void ph11_combine(const Params& p) {
    const bf16_t* Y0 = (const bf16_t*)(p.ws + WS_YS); const bf16_t* Y1 = Y0 + (size_t)NTOK * 2048; const bf16_t* YM = (const bf16_t*)(p.ws + WS_MERGED); const float* mod = (const float*)(p.ws + WS_MOD);
    const size_t n8 = (size_t)NTOK * 2048 / 8;
    for (size_t i = (size_t)blockIdx.x * NTHREADS + threadIdx.x; i < n8; i += (size_t)gridDim.x * NTHREADS) {
        const size_t e0 = i * 8; const int col = (int)(e0 & 2047), b = (int)(e0 >> 22);
        const u32x4 a = *(const u32x4*)(Y0 + e0), c = *(const u32x4*)(Y1 + e0), m = *(const u32x4*)(YM + e0);
        const float* gt = mod + (size_t)b * 12288 + 10240 + col; const f32x4 g0 = *(const f32x4*)gt, g1 = *(const f32x4*)(gt + 4);
        const float* px = p.in[I_X] + e0; f32x4 o0 = *(const f32x4*)px, o1 = *(const f32x4*)(px + 4);
        o0[0] += bf_lo(m.x) + g0[0] * (bf_lo(a.x) + bf_lo(c.x)); o0[1] += bf_hi(m.x) + g0[1] * (bf_hi(a.x) + bf_hi(c.x)); o0[2] += bf_lo(m.y) + g0[2] * (bf_lo(a.y) + bf_lo(c.y)); o0[3] += bf_hi(m.y) + g0[3] * (bf_hi(a.y) + bf_hi(c.y));
        o1[0] += bf_lo(m.z) + g1[0] * (bf_lo(a.z) + bf_lo(c.z)); o1[1] += bf_hi(m.z) + g1[1] * (bf_hi(a.z) + bf_hi(c.z)); o1[2] += bf_lo(m.w) + g1[2] * (bf_lo(a.w) + bf_lo(c.w)); o1[3] += bf_hi(m.w) + g1[3] * (bf_hi(a.w) + bf_hi(c.w));
        float* po = p.out + e0; *(f32x4*)po = o0; *(f32x4*)(po + 4) = o1;
    }
}

__global__ void __launch_bounds__(NTHREADS, 2) mk_fwd(Params p) {
    extern __shared__ __attribute__((aligned(16))) unsigned char shm[];
    LAS unsigned char* lds = (LAS unsigned char*)shm;
    const int lo = p.ph_lo, hi = p.ph_hi;
    if (threadIdx.x < 4) ((LAS unsigned*)(lds + LDS_BARW))[threadIdx.x] = 0u;
    __syncthreads();
    XcdBarrier bar; bar.bar = (unsigned*)(p.ws + WS_BAR); bar.x = 0; bar.st = nullptr;
    if (hi - lo > 1) bar = xcd_barrier_post((unsigned*)(p.ws + WS_BAR), (volatile LAS unsigned*)(lds + LDS_BARW));
#ifndef SKIP_MASK
#define SKIP_MASK 0
#endif
#define IN(k) (!((SKIP_MASK >> (k)) & 1) && lo <= (k) && (k) < hi)
#define SEAM(k) do { if (IN(k) && IN((k) + 1)) xcd_barrier(bar); } while (0)
    const int G = gridDim.x, bx = blockIdx.x;
#ifndef REP_PHASE
#define REP_PHASE 0
#endif
#define RUN(k, ...) do { if (IN(k)) { { const int rep = 0; (void)rep; __VA_ARGS__ } if ((REP_PHASE >> (k)) & 1) { xcd_barrier(bar); { const int rep = 1; (void)rep; __VA_ARGS__ } } } SEAM(k); } while (0)
    RUN(0, ph0_prologue(p, lds););
    RUN(1, ph1_norm(p););
    RUN(2, EpiProj E{p.ws, p.in[I_BGATE]};
           { ProjOrder S; S.S.init(p.ws + WS_H, p.ws + WS_WIN + (size_t)2 * 256 * DM * 2, NTOK, 8 * 256, DM * 2, G, bx); S.fp8 = 0; S.Bfull = nullptr;
             pg8::gemm_phase<EpiProj, ProjOrder, false, false>(lds, DM * 2, S, E); }
           { ProjOrder S; S.S.init(p.ws + WS_HF8, p.ws + WS_WIN8, NTOK, 30 * 256, DM, G, (G - 1) - bx); S.fp8 = 1; S.Bfull = nullptr;
             pg8::gemm_phase<EpiProj, ProjOrder, false, true>(lds, DM, S, E, 0x79797979); });
    RUN(3, ph3_prep(p, lds, rep););
    RUN(4, ph4_attn(p, lds););
    RUN(5, DualOrder S; S.S0.init(p.ws + WS_OA8, p.ws + WS_WPA8, NTOK, DM, 1024, G, bx); S.S1.init(p.ws + WS_OB8, p.ws + WS_WPB8, NTOK, DM, 1024, G, bx);
           EpiGate12 E{EpiGate1{(const bf16_t*)(p.ws + WS_GATES), (float*)(p.ws + WS_T1)}, EpiGate2{(const bf16_t*)(p.ws + WS_GATES), (const float*)(p.ws + WS_T1), (bf16_t*)(p.ws + WS_MRG8)}};
           pg8::gemm_phase<EpiGate12, DualOrder, false, true>(lds, 1024, S, E, 0x79797979, 0x7c7c7c7c););
    RUN(6, pg8::StaticOrder S; S.init(p.ws + WS_MRG8, p.ws + WS_WO8, NTOK, DM, DM, G, bx); EpiWo E{(const float*)(p.ws + WS_MOD), (bf16_t*)(p.ws + WS_MERGED)};
           pg8::gemm_phase<EpiWo, pg8::StaticOrder, false, true>(lds, DM, S, E, 0x79797979, 0x7d7d7d7d););
    RUN(7, ph8_router(p, lds, rep););
    RUN(8, moe_gemm<true>(p, lds, rep););
    RUN(9, moe_gemm<false>(p, lds, rep););
    RUN(10, if (!rep) ph11_combine(p););
#undef RUN
#undef IN
#undef SEAM
}

constexpr int NPHASES = 11;
extern "C" void kernel_launch(void* const* d_in, const int* in_sizes, int n_in, void* d_out, int out_size, void* d_ws, size_t ws_size, hipStream_t stream) {
    static int grid = 0;
    if (grid == 0) {
        if (n_in != 25 || in_sizes[0] != NTOK * DM || out_size != NTOK * DM || ws_size < WS_END6) {
            fprintf(stderr, "kernel_launch: shape mismatch: n_in %d in0 %d out %d ws %zu (need %zu)\n", n_in, n_in > 0 ? in_sizes[0] : -1, out_size, ws_size, (size_t)WS_END6); grid = -1; return; }
        int dev = 0, cus = 0, per_cu = 0;
        if (hipGetDevice(&dev) != hipSuccess || hipDeviceGetAttribute(&cus, hipDeviceAttributeMultiprocessorCount, dev) != hipSuccess) { fprintf(stderr, "kernel_launch: device query failed\n"); grid = -1; return; }
        if (hipFuncSetAttribute((const void*)mk_fwd, hipFuncAttributeMaxDynamicSharedMemorySize, LDS_BYTES) != hipSuccess) { fprintf(stderr, "kernel_launch: hipFuncSetAttribute failed\n"); grid = -1; return; }
        if (hipOccupancyMaxActiveBlocksPerMultiprocessor(&per_cu, (const void*)mk_fwd, NTHREADS, LDS_BYTES) != hipSuccess || per_cu < 1) { fprintf(stderr, "kernel_launch: occupancy query says %d blocks per CU\n", per_cu); }
        (void)hipGetLastError();
        grid = cus;
    }
    if (grid < 0) return;
    if (hipMemsetAsync((char*)d_ws + WS_BAR, 0, WS_ZERO_BYTES, stream) != hipSuccess) { fprintf(stderr, "kernel_launch: memset failed\n"); return; }
    Params p; memset(&p, 0, sizeof(p));
    for (int i = 0; i < 25; ++i) p.in[i] = (const float*)d_in[i];
    p.out = (float*)d_out; p.ws = (unsigned char*)d_ws;
    unsigned char* ws = (unsigned char*)d_ws;
    auto job = [&](int j, const float* src, size_t dst_off, int K, int N, int ldd, int map, int nbatch, long sbatch, long dbatch) {
        TJob& J = p.jobs[j]; J.src = src; J.dst = (bf16_t*)(ws + dst_off); J.K = K; J.N = N; J.ldd = ldd; J.map = map; J.ntk = K / 64; J.ntn = (N + 127) / 128; J.nbatch = nbatch; J.sbatch = sbatch; J.dbatch = dbatch; J.ld = N; J.fp8 = 0; };
    job(0, p.in[I_WIN] + 512, WS_WIN, 2048, 1872, 2048, 4, 1, 0, 0); p.jobs[0].ld = DIN;
    job(1, p.in[I_WIN] + 5456, WS_WIN, 2048, 8, 2048, 5, 1, 0, 0); p.jobs[1].ld = DIN;
    job(2, p.in[I_WUK], WS_WUK, 128, 256, 128, 0, 8, 128L * 256, 256L * 128);
    job(3, p.in[I_WUV], WS_WUV, 256, 128, 256, 0, 8, 256L * 128, 128L * 256);
    job(4, p.in[I_WIN], WS_WIN8, 2048, 512, 2048, 0, 1, 0, 0); job(5, p.in[I_WIN] + 2384, WS_WIN8 + (size_t)512 * 2048, 2048, 3072, 2048, 0, 1, 0, 0); job(6, p.in[I_WIN] + 5464, WS_WIN8 + (size_t)3584 * 2048, 2048, 4096, 2048, 0, 1, 0, 0);
    for (int j = 4; j < 7; ++j) { p.jobs[j].ld = DIN; p.jobs[j].fp8 = 1; }
    job(7, p.in[I_WO], WS_WO8, 2048, 2048, 2048, 0, 1, 0, 0); p.jobs[7].fp8 = 1;
    job(8, p.in[I_WPA], WS_WPA8, 1024, 2048, 1024, 0, 1, 0, 0); p.jobs[8].fp8 = 1; job(9, p.in[I_WPB], WS_WPB8, 1024, 2048, 1024, 0, 1, 0, 0); p.jobs[9].fp8 = 1;
    int t0 = 0; for (int j = 0; j < NJOBS; ++j) { p.jobs[j].tile0 = t0; t0 += p.jobs[j].ntk * p.jobs[j].ntn * p.jobs[j].nbatch; }
    p.ntiles_total = t0;
#if MK_LAUNCHES == 1
    p.ph_lo = 0; p.ph_hi = NPHASES;
    hipLaunchKernelGGL(mk_fwd, dim3(grid), dim3(NTHREADS), LDS_BYTES, stream, p);
#else
    for (int k = 0; k < NPHASES; ++k) { p.ph_lo = k; p.ph_hi = k + 1; hipLaunchKernelGGL(mk_fwd, dim3(grid), dim3(NTHREADS), LDS_BYTES, stream, p); }
#endif
    const hipError_t le = hipPeekAtLastError();
    if (le != hipSuccess) fprintf(stderr, "kernel_launch: launch failed: %s\n", hipGetErrorName(le));
}
```

```cpp
#include <hip/hip_runtime.h>
#include <cstdio>
#include <cstdint>
#include <cstring>

#ifndef MK_LAUNCHES
#define MK_LAUNCHES 1
#endif

#define LAS __attribute__((address_space(3)))
typedef unsigned short bf16_t;
typedef short bf16x8 __attribute__((ext_vector_type(8)));
typedef short s16x4 __attribute__((ext_vector_type(4)));
typedef float f32x4 __attribute__((ext_vector_type(4)));
typedef float f32x16 __attribute__((ext_vector_type(16)));
typedef unsigned u32x4 __attribute__((ext_vector_type(4)));
typedef unsigned u32x2 __attribute__((ext_vector_type(2)));

constexpr int DM = 2048, NBATCH = 4, SEQ = 2048, NTOK = NBATCH * SEQ;
constexpr int DIN = 9560, DINP = 9728;
constexpr int NEXP = 64, DEXP = 512, LCAP = 8192;
constexpr float RMS_EPS = 1e-6f;
constexpr float LOG2E = 1.4426950408889634f;
constexpr int NTHREADS = 512;
constexpr int LDS_BYTES = 163840 - 1024;
constexpr int LDS_BARW = LDS_BYTES - 16;
constexpr int LDS_TAB = 131072;

constexpr size_t al256(size_t x) { return (x + 255) / 256 * 256; }
constexpr size_t WS_BAR = 0;
constexpr size_t WS_CNT = 16384;
constexpr size_t WS_ZERO_BYTES = 16384 + 4096;
constexpr size_t WS_MOD = WS_ZERO_BYTES;
constexpr size_t WS_H = al256(WS_MOD + (size_t)4 * 12288 * 4);
constexpr size_t WS_WIN = al256(WS_H + (size_t)NTOK * DM * 2);
constexpr size_t WS_WPA = al256(WS_WIN + (size_t)DINP * DM * 2);
constexpr size_t WS_WPB = al256(WS_WPA + (size_t)2048 * 1024 * 2);
constexpr size_t WS_WO = al256(WS_WPB + (size_t)2048 * 1024 * 2);
constexpr size_t WS_WUK = al256(WS_WO + (size_t)2048 * 2048 * 2);
constexpr size_t WS_WUV = al256(WS_WUK + (size_t)8 * 256 * 128 * 2);
constexpr size_t WS_W13 = al256(WS_WUV + (size_t)8 * 128 * 256 * 2);
constexpr size_t WS_W2 = al256(WS_W13 + (size_t)64 * 1024 * 2048 * 2);
constexpr size_t WS_QA = al256(WS_W2 + (size_t)64 * 2048 * 512 * 2);
constexpr size_t WS_CKV = al256(WS_QA + (size_t)NTOK * 1024 * 2);
constexpr size_t WS_KV = al256(WS_CKV + (size_t)NTOK * 256 * 4);
constexpr size_t WS_QIDX = al256(WS_KV + (size_t)NTOK * 256 * 2);
constexpr size_t WS_MISC = al256(WS_QIDX + (size_t)NTOK * 1024 * 2);
constexpr size_t WS_QB = al256(WS_MISC + (size_t)NTOK * 256 * 4);
constexpr size_t WS_KB = al256(WS_QB + (size_t)NTOK * 1024 * 2);
constexpr size_t WS_VB = al256(WS_KB + (size_t)NTOK * 1024 * 2);
constexpr size_t WS_GATES = al256(WS_VB + (size_t)NTOK * 1024 * 2);
constexpr size_t WS_QLAT = al256(WS_GATES + (size_t)NTOK * 4096 * 2);
constexpr size_t WS_MASK = al256(WS_QLAT + (size_t)NTOK * 2048 * 2);
constexpr size_t WS_CUM = al256(WS_MASK + (size_t)NTOK * 256);
constexpr size_t WS_OLAT = al256(WS_CUM + (size_t)4 * 8 * 2048 * 4);
constexpr size_t WS_OA = al256(WS_OLAT + (size_t)NTOK * 2048 * 2);
constexpr size_t WS_OB = al256(WS_OA + (size_t)NTOK * 1024 * 2);
constexpr size_t WS_T1 = al256(WS_OB + (size_t)NTOK * 1024 * 2);
constexpr size_t WS_MERGED = al256(WS_T1 + (size_t)NTOK * 2048 * 4);
constexpr size_t WS_LTOK = al256(WS_MERGED + (size_t)NTOK * 2048 * 2);
constexpr size_t WS_LW = al256(WS_LTOK + (size_t)NEXP * LCAP * 4);
constexpr size_t WS_ACT = al256(WS_LW + (size_t)NEXP * LCAP * 4);
constexpr size_t WS_HLO = al256(WS_ACT + (size_t)32768 * 512 * 2);
constexpr size_t WS_WRH = al256(WS_HLO + (size_t)NTOK * DM * 2);
constexpr size_t WS_WRL = al256(WS_WRH + (size_t)80 * DM * 2);
constexpr size_t WS_END = al256(WS_WRL + (size_t)80 * DM * 2);
constexpr size_t WS_KIDX = WS_END;
constexpr size_t WS_END2 = al256(WS_KIDX + (size_t)NTOK * 64 * 2);
constexpr size_t WS_H8 = WS_END2;
constexpr size_t WS_ACT8 = al256(WS_H8 + (size_t)NTOK * DM);
constexpr size_t WS_END3 = al256(WS_ACT8 + (size_t)16384 * 512);
constexpr size_t WS_HF8 = WS_END3;
constexpr size_t WS_WIN8 = al256(WS_HF8 + (size_t)NTOK * DM);
constexpr size_t WS_END4 = al256(WS_WIN8 + (size_t)7680 * DM);
constexpr size_t WS_MRG8 = WS_END4;
constexpr size_t WS_WO8 = al256(WS_MRG8 + (size_t)NTOK * DM);
constexpr size_t WS_END5 = al256(WS_WO8 + (size_t)2048 * 2048);
constexpr size_t WS_OA8 = WS_END5;
constexpr size_t WS_OB8 = al256(WS_OA8 + (size_t)NTOK * 1024);
constexpr size_t WS_WPA8 = al256(WS_OB8 + (size_t)NTOK * 1024);
constexpr size_t WS_WPB8 = al256(WS_WPA8 + (size_t)2048 * 1024);
constexpr size_t WS_END6 = al256(WS_WPB8 + (size_t)2048 * 1024);
constexpr size_t WS_YS = WS_T1;
constexpr size_t WS_HG = WS_QA;
static_assert(WS_HG + (size_t)32768 * DM * 2 <= WS_QLAT, "hg alias must fit in the dead region");

struct TJob { const float* src; bf16_t* dst; int K, N, ldd, map, ntk, ntn, nbatch, tile0; long sbatch, dbatch; int ld, fp8; };
constexpr int NJOBS = 10;
struct Params {
    const float* in[25];
    float* out;
    unsigned char* ws;
    TJob jobs[NJOBS];
    int ntiles_total;
    int ph_lo, ph_hi;
};
enum { I_X = 0, I_C, I_WADA, I_BADA, I_GMIX, I_WIN, I_BGATE, I_BFORGET, I_WUK, I_WUV, I_GQA, I_GKV, I_GQB, I_GKB, I_WPA, I_WPB, I_WO, I_GFFN, I_WRG, I_BRG, I_WRE, I_BRE, I_W1, I_W3, I_W2 };

__device__ __forceinline__ unsigned cvt_pk_bf16(float lo, float hi) { unsigned r; asm volatile("v_cvt_pk_bf16_f32 %0, %1, %2" : "=v"(r) : "v"(lo), "v"(hi)); return r; }
__device__ __forceinline__ float bf_lo(unsigned w) { return __uint_as_float(w << 16); }
__device__ __forceinline__ float bf_hi(unsigned w) { return __uint_as_float(w & 0xffff0000u); }
typedef float f32x2 __attribute__((ext_vector_type(2)));
__device__ __forceinline__ unsigned pack_fp8x4(float a, float b, float c, float d) { int w = __builtin_amdgcn_cvt_pk_fp8_f32(a, b, 0, false); w = __builtin_amdgcn_cvt_pk_fp8_f32(c, d, w, true); return (unsigned)w; }
__device__ __forceinline__ bf16x8 fp8x8_to_bf16(u32x2 v) {
    const f32x2 a = __builtin_amdgcn_cvt_pk_f32_fp8((int)v.x, false), b = __builtin_amdgcn_cvt_pk_f32_fp8((int)v.x, true), c = __builtin_amdgcn_cvt_pk_f32_fp8((int)v.y, false), d = __builtin_amdgcn_cvt_pk_f32_fp8((int)v.y, true);
    u32x4 w; w.x = cvt_pk_bf16(a.x, a.y); w.y = cvt_pk_bf16(b.x, b.y); w.z = cvt_pk_bf16(c.x, c.y); w.w = cvt_pk_bf16(d.x, d.y); return *reinterpret_cast<bf16x8*>(&w); }
__device__ __forceinline__ float wave_sum(float v) {
#pragma unroll
    for (int o = 32; o >= 1; o >>= 1) v += __shfl_xor(v, o);
    return v;
}
__device__ __forceinline__ float sigmoidf_(float x) { return __builtin_amdgcn_rcpf(1.0f + __builtin_amdgcn_exp2f(-1.4426950408889634f * x)); }
__device__ __forceinline__ int crow(int r, int hi) { return (r & 3) + 8 * (r >> 2) + 4 * hi; }
#define SBAR() __builtin_amdgcn_sched_barrier(0)

#define XB_TMO      128
#define XB_XCNT(j)  (256  + 64 * (j))
#define XB_XSUB(j)  (1280 + 64 * (j))
#define XB_XGEN(j)  (2304 + 64 * (j))
#define XB_TOP      3328
#define XB_TOPGEN   3392
#define XCD_BAR_WORDS 3456
#define XB_SPIN_CAP (1u << 20)
__device__ __forceinline__ unsigned xb_ld(unsigned* p)              { return __hip_atomic_load(p, __ATOMIC_RELAXED, __HIP_MEMORY_SCOPE_AGENT); }
__device__ __forceinline__ unsigned xb_add(unsigned* p, unsigned v) { return __hip_atomic_fetch_add(p, v, __ATOMIC_RELAXED, __HIP_MEMORY_SCOPE_AGENT); }
__device__ __forceinline__ unsigned xb_xcc_id() { return (unsigned)__builtin_amdgcn_s_getreg((3 << 11) | 20) & 0xFu; }
#define XB_SPIN(cond, bar) do { unsigned _sp = 0; while (cond) { __builtin_amdgcn_s_sleep(1); \
    if ((++_sp & 255u) == 0u) { if (xb_ld(&(bar)[XB_TMO])) break; if (_sp > XB_SPIN_CAP) { atomicAdd(&(bar)[XB_TMO], 1u); break; } } } } while (0)
struct XcdBarrier { unsigned* bar; unsigned x; volatile LAS unsigned* st; };
__device__ __forceinline__ XcdBarrier xcd_barrier_post(unsigned* bar, volatile LAS unsigned* st) {
    XcdBarrier b; b.bar = bar; b.x = xb_xcc_id(); b.st = st;
    if (threadIdx.x == 0) (void)xb_add(&bar[XB_XCNT(b.x)], 1u);
    return b;
}
__device__ __forceinline__ void xcd_barrier_complete(unsigned* bar, unsigned x, unsigned& nloc, unsigned& nx) {
    const unsigned G = gridDim.x * gridDim.y * gridDim.z;
    unsigned sum, cnt, mine, sp = 0u;
    for (;;) {
        sum = 0u; cnt = 0u; mine = 0u;
#pragma unroll
        for (unsigned j = 0; j < 16; ++j) { const unsigned c = xb_ld(&bar[XB_XCNT(j)]); sum += c; cnt += (c > 0u) ? 1u : 0u; mine = (j == x) ? c : mine; }
        if (sum == G) break;
        __builtin_amdgcn_s_sleep(1);
        if ((++sp & 255u) == 0u) { if (xb_ld(&bar[XB_TMO])) break; if (sp > XB_SPIN_CAP) { atomicAdd(&bar[XB_TMO], 1u); break; } }
    }
    nloc = mine > 0u ? mine : 1u; nx = cnt > 0u ? cnt : 1u;
}
__device__ __forceinline__ void xcd_barrier(const XcdBarrier& b) {
    asm volatile("s_waitcnt vmcnt(0)" ::: "memory");
    __syncthreads();
    if (threadIdx.x == 0) {
        unsigned* bar = b.bar;
        __builtin_amdgcn_s_waitcnt(0);
        unsigned nloc = b.st[0], nx = b.st[1];
        if (nloc == 0u) { xcd_barrier_complete(bar, b.x, nloc, nx); b.st[0] = nloc; b.st[1] = nx; }
        const unsigned old = xb_add(&bar[XB_XSUB(b.x)], 1u);
        const unsigned gen = old / nloc;
        if (old + 1u == (gen + 1u) * nloc) {
            __builtin_amdgcn_fence(__ATOMIC_RELEASE, "agent");
            asm volatile("s_waitcnt vmcnt(0)" ::: "memory");
            const unsigned og = xb_add(&bar[XB_TOP], 1u);
            const unsigned tg = og / nx;
            if (og + 1u == (tg + 1u) * nx) xb_add(&bar[XB_TOPGEN], 1u);
            else XB_SPIN(xb_ld(&bar[XB_TOPGEN]) == tg, bar);
            __builtin_amdgcn_fence(__ATOMIC_ACQUIRE, "agent");
            xb_add(&bar[XB_XGEN(b.x)], 1u);
            asm volatile("s_waitcnt vmcnt(0)" ::: "memory");
        } else {
            XB_SPIN(xb_ld(&bar[XB_XGEN(b.x)]) == gen, bar);
            __builtin_amdgcn_fence(__ATOMIC_ACQUIRE, "agent");
            asm volatile("s_waitcnt vmcnt(0)" ::: "memory");
        }
    }
    __syncthreads();
}

namespace pg8 {
constexpr int BM = 256, BK = 64, HALF = 128, HTB = HALF * BK * 2, STAGE_BYTES = 8 * HTB, NXCD = 8, WGM = 8;
__host__ __device__ __forceinline__ int lds_byte(int r, int c) { const int st = (r >> 4) * 2 + (c >> 5), rr = r & 15, cc = c & 31, ob = rr * 64 + cc * 2; return st * 1024 + (ob ^ (((ob >> 9) & 1) << 5)); }
__host__ __device__ __forceinline__ void stage_rc(int b, int& R, int& C) { const int st = b / 1024, sb = b % 1024, swz = sb ^ (((sb >> 9) & 1) << 5); R = (st >> 1) * 16 + swz / 64; C = (st & 1) * 32 + (swz % 64) / 2; }
__host__ __device__ __forceinline__ int perm32(int rho) { const int n = rho >> 4, i = rho & 15; return 8 * (i >> 2) + 4 * n + (i & 3); }

struct Unit { int pm, pn; const char* a; const char* b; const int* gi; int nvalid; int aux; };

struct StaticOrder {
    int nM, nN, nwg, G, c, RS; const char* A; const char* Bt;
    __device__ void init(const void* A_, const void* Bt_, int M, int N, int RS_, int G_, int c_) { A = (const char*)A_; Bt = (const char*)Bt_; RS = RS_; nM = M / BM; nN = N / BM; nwg = nM * nN; G = G_; c = c_; }
    __device__ bool next(int i, Unit& u) const {
        const long L = (long)i * G + c; if (L >= nwg) return false;
        int wgid = (int)L; { const int q = nwg / NXCD, r = nwg % NXCD, xcd = wgid % NXCD, off = wgid / NXCD; wgid = (xcd < r ? xcd * (q + 1) : r * (q + 1) + (xcd - r) * q) + off; }
        const int nig = WGM * nN, gid = wgid / nig, fm = gid * WGM, gsz = (nM - fm) < WGM ? (nM - fm) : WGM;
        u.pm = fm + ((wgid % nig) % gsz); u.pn = (wgid % nig) / gsz;
        u.a = A + (size_t)u.pm * BM * RS; u.b = Bt + (size_t)u.pn * BM * RS; u.gi = nullptr; u.nvalid = BM; u.aux = 0; return true;
    }
};

typedef int i32x8 __attribute__((ext_vector_type(8)));
typedef int i32x4v __attribute__((ext_vector_type(4)));
template <class Epi, class Sched, bool GATHER, bool FP8 = false>
__device__ __forceinline__ void gemm_phase(LAS unsigned char* lds, const int RS, const Sched& S, const Epi& E, const int scale_b = 0x7f7f7f7f, const int scale_a = 0x7f7f7f7f) {
    int tid = threadIdx.x; asm volatile("" : "+v"(tid));
    const int wid = __builtin_amdgcn_readfirstlane(tid >> 6), lane = tid & 63, wr = wid >> 2, wc = wid & 3, fr = lane & 15, fq = lane >> 4;
    const int nt = RS / (BK * 2); const int K = RS;
    unsigned voffA[2], voffB[2]; int RA[2], CA[2];
#pragma unroll
    for (int i = 0; i < 2; ++i) { int R, C; stage_rc(tid * 16 + i * 8192, R, C); const int Rb = ((R & ~31) + perm32(R & 31));
        RA[i] = R; CA[i] = C; voffA[i] = (unsigned)(R * RS + C * 2); voffB[i] = (unsigned)(Rb * RS + C * 2); }
    const size_t kstep = (size_t)(BK * 2);
    const size_t hstep = (size_t)HALF * RS;
    const unsigned ldsw = (unsigned)wid * 1024u;
    const int aoff = lds_byte(wr * 64 + fr, fq * 8), boff = lds_byte(wc * 32 + fr, fq * 8);
    unsigned gA[2][2], gN[2][2];
#define PG8_SA(b, h) (((b) * 2 + (h)) * HTB)
#define PG8_SB(b, h) ((4 + (b) * 2 + (h)) * HTB)
#define PG8_STAGE(bufoff, gbase, voff) do { _Pragma("unroll") for (int _i = 0; _i < 2; ++_i) \
        __builtin_amdgcn_global_load_lds((const unsigned*)((const char*)(gbase) + (voff)[_i]), (LAS unsigned*)(lds + (bufoff) + ldsw + _i * 8192), 16, 0, 0); } while (0)
#define PG8_STAGE_A(bufoff, gp, h, NX) do { if constexpr (GATHER) { if (NX) PG8_STAGE(bufoff, gp, gN[h]); else PG8_STAGE(bufoff, gp, gA[h]); } else PG8_STAGE(bufoff, (gp) + (h) * hstep, voffA); } while (0)
#define PG8_LD8(p_) __builtin_shufflevector(*(const LAS i32x4v*)(p_), *(const LAS i32x4v*)((p_) + 1024), 0, 1, 2, 3, 4, 5, 6, 7)
#define PG8_LDA(dst, b, h) do { if constexpr (FP8) { _Pragma("unroll") for (int m = 0; m < 4; ++m) dst##8[m] = PG8_LD8(lds + PG8_SA(b, h) + aoff + m * 2048); } \
        else { _Pragma("unroll") for (int m = 0; m < 4; ++m) _Pragma("unroll") for (int k = 0; k < 2; ++k) dst[m][k] = *(const LAS bf16x8*)(lds + PG8_SA(b, h) + aoff + m * 2048 + k * 1024); } } while (0)
#define PG8_LDB(dst, b, h) do { if constexpr (FP8) { _Pragma("unroll") for (int n = 0; n < 2; ++n) dst##8[n] = PG8_LD8(lds + PG8_SB(b, h) + boff + n * 2048); } \
        else { _Pragma("unroll") for (int n = 0; n < 2; ++n) _Pragma("unroll") for (int k = 0; k < 2; ++k) dst[n][k] = *(const LAS bf16x8*)(lds + PG8_SB(b, h) + boff + n * 2048 + k * 1024); } } while (0)
#define PG8_MMA(ai, bj, At, Bt) do { __builtin_amdgcn_s_setprio(1); \
        if constexpr (FP8) { _Pragma("unroll") for (int m = 0; m < 4; ++m) _Pragma("unroll") for (int n = 0; n < 2; ++n) \
            asm volatile("v_mfma_scale_f32_16x16x128_f8f6f4 %0, %1, %2, %0, %3, %4 op_sel_hi:[0,0,0]" : "+v"(acc[ai][bj][m][n]) : "v"(Bt##8[n]), "v"(At##8[m]), "v"(sc_b), "v"(sc_a)); } \
        else { _Pragma("unroll") for (int m = 0; m < 4; ++m) _Pragma("unroll") for (int n = 0; n < 2; ++n) _Pragma("unroll") for (int k = 0; k < 2; ++k) \
            acc[ai][bj][m][n] = __builtin_amdgcn_mfma_f32_16x16x32_bf16(Bt[n][k], At[m][k], acc[ai][bj][m][n], 0, 0, 0); } \
        __builtin_amdgcn_s_setprio(0); } while (0)
#define PG8_WAIT_V(n) asm volatile("s_waitcnt vmcnt(" #n ")" ::: "memory")
#define PG8_WAIT_L(n) asm volatile("s_waitcnt lgkmcnt(" #n ")" ::: "memory")
#define PG8_BAR __builtin_amdgcn_s_barrier()
#define PG8_SCHED __builtin_amdgcn_sched_barrier(0)
#define PG8_GIDX(dst, u) do { if constexpr (GATHER) { _Pragma("unroll") for (int h = 0; h < 2; ++h) _Pragma("unroll") for (int i = 0; i < 2; ++i) { \
        const int rr = h * HALF + RA[i]; const int tok = rr < (u).nvalid ? (u).gi[rr] : 0; dst[h][i] = (unsigned)(tok * K + CA[i] * 2); } } } while (0)
    Unit cur, nxt; int ui = 0;
    if (!S.next(0, cur)) return;
    f32x4 acc[2][2][4][2];
#pragma unroll
    for (int a = 0; a < 2; ++a)
#pragma unroll
        for (int b = 0; b < 2; ++b)
#pragma unroll
            for (int m = 0; m < 4; ++m)
#pragma unroll
                for (int n = 0; n < 2; ++n) acc[a][b][m][n] = (f32x4){0.f, 0.f, 0.f, 0.f};
    const int sc_b = scale_b, sc_a = scale_a;
    bf16x8 At[4][2], B0[2][2], B1[2][2]; i32x8 At8[4], B08[2], B18[2];
    const char* cA = cur.a; const char* cB = cur.b;
    PG8_GIDX(gA, cur);
    PG8_STAGE(PG8_SB(0, 0), cB, voffB); PG8_STAGE_A(PG8_SA(0, 0), cA, 0, false); PG8_STAGE(PG8_SB(0, 1), cB + hstep, voffB); PG8_STAGE_A(PG8_SA(0, 1), cA, 1, false);
    if (wr == 1) PG8_BAR;
    PG8_WAIT_V(4); PG8_BAR;
    PG8_STAGE(PG8_SB(1, 0), cB + kstep, voffB); PG8_STAGE_A(PG8_SA(1, 0), cA + kstep, 0, false); PG8_STAGE(PG8_SB(1, 1), cB + hstep + kstep, voffB);
    PG8_WAIT_V(6); PG8_BAR;
    for (;;) {
        const bool has_next = S.next(ui + 1, nxt);
        const char* nA = has_next ? nxt.a : cA; const char* nB = has_next ? nxt.b : cB;
        if constexpr (GATHER) { if (has_next) { PG8_GIDX(gN, nxt); } else {
#pragma unroll
            for (int h = 0; h < 2; ++h)
#pragma unroll
                for (int i = 0; i < 2; ++i) gN[h][i] = gA[h][i]; } }
        for (int t = 0; t < nt; t += 2) {
            const bool last = (t == nt - 2);
            const char* a1 = cA + (size_t)(t + 1) * kstep;
            const char* a2 = last ? nA : cA + (size_t)(t + 2) * kstep; const char* b2 = last ? nB : cB + (size_t)(t + 2) * kstep;
            const char* a3 = a2 + kstep; const char* b3 = b2 + kstep;
            PG8_LDB(B0, 0, 0); PG8_SCHED; PG8_LDA(At, 0, 0); PG8_STAGE_A(PG8_SA(1, 1), a1, 1, false);
            PG8_WAIT_L(8); PG8_BAR; PG8_WAIT_L(0); PG8_MMA(0, 0, At, B0); PG8_BAR; PG8_SCHED;
            PG8_LDB(B1, 0, 1); PG8_STAGE(PG8_SB(0, 0), b2, voffB);
            PG8_BAR; PG8_WAIT_L(0); PG8_MMA(0, 1, At, B1); PG8_BAR;
            PG8_LDA(At, 0, 1); PG8_STAGE_A(PG8_SA(0, 0), a2, 0, last);
            PG8_BAR; PG8_WAIT_L(0); PG8_MMA(1, 0, At, B0); PG8_BAR; PG8_SCHED;
            PG8_STAGE(PG8_SB(0, 1), b2 + hstep, voffB);
            PG8_WAIT_V(6); PG8_BAR; PG8_MMA(1, 1, At, B1); PG8_BAR;
            PG8_LDB(B0, 1, 0); PG8_SCHED; PG8_LDA(At, 1, 0); PG8_STAGE_A(PG8_SA(0, 1), a2, 1, last);
            PG8_WAIT_L(8); PG8_BAR; PG8_WAIT_L(0); PG8_MMA(0, 0, At, B0); PG8_BAR; PG8_SCHED;
            PG8_LDB(B1, 1, 1); PG8_STAGE(PG8_SB(1, 0), b3, voffB);
            PG8_BAR; PG8_WAIT_L(0); PG8_MMA(0, 1, At, B1); PG8_BAR;
            PG8_LDA(At, 1, 1); PG8_STAGE_A(PG8_SA(1, 0), a3, 0, last);
            PG8_BAR; PG8_WAIT_L(0); PG8_MMA(1, 0, At, B0); PG8_BAR; PG8_SCHED;
            PG8_STAGE(PG8_SB(1, 1), b3 + hstep, voffB);
            PG8_WAIT_V(6); PG8_BAR; PG8_MMA(1, 1, At, B1); PG8_BAR;
        }
        bool keep_acc = false;
        if constexpr (FP8) asm volatile("s_nop 15\n\ts_nop 15" ::: "memory");
        if constexpr (Epi::DUAL) { if (cur.aux) { E.mid(acc, cur, wr, wc, fr, fq); keep_acc = true; } else E(acc, cur, wr, wc, fr, fq); } else E(acc, cur, wr, wc, fr, fq);
        if (!has_next) break;
        if (!keep_acc)
#pragma unroll
        for (int a = 0; a < 2; ++a)
#pragma unroll
            for (int b = 0; b < 2; ++b)
#pragma unroll
                for (int m = 0; m < 4; ++m)
#pragma unroll
                    for (int n = 0; n < 2; ++n) acc[a][b][m][n] = (f32x4){0.f, 0.f, 0.f, 0.f};
        cur = nxt; cA = nA; cB = nB; ++ui;
        if constexpr (GATHER) {
#pragma unroll
            for (int h = 0; h < 2; ++h)
#pragma unroll
                for (int i = 0; i < 2; ++i) gA[h][i] = gN[h][i]; }
    }
    PG8_WAIT_V(0);
    if (wr == 0) PG8_BAR;
    PG8_BAR;
#undef PG8_SA
#undef PG8_SB
#undef PG8_STAGE
#undef PG8_STAGE_A
#undef PG8_LDA
#undef PG8_LD8
#undef PG8_LDB
#undef PG8_MMA
#undef PG8_WAIT_V
#undef PG8_WAIT_L
#undef PG8_BAR
#undef PG8_SCHED
#undef PG8_GIDX
}
}
using pg8::Unit;

#define EPI_LOOP(...) { int fr_ = fr, fq_ = fq; asm volatile("" : "+v"(fr_), "+v"(fq_)); _Pragma("unroll") for (int ai = 0; ai < 2; ++ai) _Pragma("unroll") for (int m = 0; m < 4; ++m) _Pragma("unroll") for (int bj = 0; bj < 2; ++bj) { \
        const int trow = ai * 128 + wr * 64 + m * 16 + fr_; const int tcol = bj * 128 + wc * 32 + fq_ * 8; const f32x4 v0 = acc[ai][bj][m][0], v1 = acc[ai][bj][m][1]; __VA_ARGS__ } }

__device__ __forceinline__ u32x4 pack8(const f32x4 a, const f32x4 b) { u32x4 w; w.x = cvt_pk_bf16(a[0], a[1]); w.y = cvt_pk_bf16(a[2], a[3]); w.z = cvt_pk_bf16(b[0], b[1]); w.w = cvt_pk_bf16(b[2], b[3]); return w; }

struct EpiProj { static constexpr bool DUAL = false;
    unsigned char* ws; const float* b_gate;
    __device__ __forceinline__ void operator()(const f32x4 (&acc)[2][2][4][2], const Unit& u, int wr, int wc, int fr, int fq) const {
        const int pn = u.pn; const size_t row0 = (size_t)u.pm * 256;
        if (pn == 4 || pn == 9) {
            float* dst = (float*)(ws + (pn == 4 ? WS_CKV : WS_MISC));
            EPI_LOOP({ float* p = dst + (row0 + trow) * 256 + tcol; *(f32x4*)p = v0; *(f32x4*)(p + 4) = v1;
                if (pn == 9 && tcol < 64) *(u32x4*)((bf16_t*)(ws + WS_KIDX) + (row0 + trow) * 64 + tcol) = pack8(v0, v1); })
        } else if (pn < 22) {
            bf16_t* dst; int ct;
            if (pn < 4) { dst = (bf16_t*)(ws + WS_QA); ct = pn; } else if (pn < 9) { dst = (bf16_t*)(ws + WS_QIDX); ct = pn - 5; }
            else if (pn < 14) { dst = (bf16_t*)(ws + WS_QB); ct = pn - 10; } else if (pn < 18) { dst = (bf16_t*)(ws + WS_KB); ct = pn - 14; } else { dst = (bf16_t*)(ws + WS_VB); ct = pn - 18; }
            EPI_LOOP({ *(u32x4*)(dst + (row0 + trow) * 1024 + ct * 256 + tcol) = pack8(v0, v1); })
        } else {
            bf16_t* dst = (bf16_t*)(ws + WS_GATES); const int ct = pn - 22;
            EPI_LOOP({ const int col = ct * 256 + tcol; const f32x4 b0 = *(const f32x4*)(b_gate + col), b1 = *(const f32x4*)(b_gate + col + 4); f32x4 s0, s1;
                _Pragma("unroll") for (int j = 0; j < 4; ++j) { s0[j] = sigmoidf_(v0[j] + b0[j]); s1[j] = sigmoidf_(v1[j] + b1[j]); }
                *(u32x4*)(dst + (row0 + trow) * 4096 + col) = pack8(s0, s1); })
        }
    }
};
struct EpiGate1 { static constexpr bool DUAL = false;
    const bf16_t* gates; float* T1;
    __device__ __forceinline__ void operator()(const f32x4 (&acc)[2][2][4][2], const Unit& u, int wr, int wc, int fr, int fq) const {
        EPI_LOOP({ const size_t row = (size_t)u.pm * 256 + trow; const int col = u.pn * 256 + tcol; const u32x4 g = *(const u32x4*)(gates + row * 4096 + col);
            f32x4 o0 = {v0[0] * bf_lo(g.x), v0[1] * bf_hi(g.x), v0[2] * bf_lo(g.y), v0[3] * bf_hi(g.y)}; f32x4 o1 = {v1[0] * bf_lo(g.z), v1[1] * bf_hi(g.z), v1[2] * bf_lo(g.w), v1[3] * bf_hi(g.w)};
            float* p = T1 + row * 2048 + col; *(f32x4*)p = o0; *(f32x4*)(p + 4) = o1; })
    }
};
struct EpiGate2 { static constexpr bool DUAL = false;
    const bf16_t* gates; const float* T1; bf16_t* merged;
    __device__ __forceinline__ void operator()(const f32x4 (&acc)[2][2][4][2], const Unit& u, int wr, int wc, int fr, int fq) const {
        EPI_LOOP({ const size_t row = (size_t)u.pm * 256 + trow; const int col = u.pn * 256 + tcol; const u32x4 g = *(const u32x4*)(gates + row * 4096 + 2048 + col);
            const float* p = T1 + row * 2048 + col; const f32x4 t0 = *(const f32x4*)p, t1 = *(const f32x4*)(p + 4);
            f32x4 o0 = {t0[0] + v0[0] * bf_lo(g.x), t0[1] + v0[1] * bf_hi(g.x), t0[2] + v0[2] * bf_lo(g.y), t0[3] + v0[3] * bf_hi(g.y)};
            f32x4 o1 = {t1[0] + v1[0] * bf_lo(g.z), t1[1] + v1[1] * bf_hi(g.z), t1[2] + v1[2] * bf_lo(g.w), t1[3] + v1[3] * bf_hi(g.w)};
            u32x2 w8; w8.x = pack_fp8x4(o0[0] * 4.f, o0[1] * 4.f, o0[2] * 4.f, o0[3] * 4.f); w8.y = pack_fp8x4(o1[0] * 4.f, o1[1] * 4.f, o1[2] * 4.f, o1[3] * 4.f);
            *(u32x2*)((unsigned char*)merged + row * 2048 + col) = w8; })
    }
};
struct EpiWo { static constexpr bool DUAL = false;
    const float* mod; bf16_t* y;
    __device__ __forceinline__ void operator()(const f32x4 (&acc)[2][2][4][2], const Unit& u, int wr, int wc, int fr, int fq) const {
        const float* gt = mod + (size_t)(u.pm >> 3) * 12288 + 4096;
        EPI_LOOP({ const size_t row = (size_t)u.pm * 256 + trow; const int col = u.pn * 256 + tcol;
            const f32x4 g0 = *(const f32x4*)(gt + col), g1 = *(const f32x4*)(gt + col + 4);
            *(u32x4*)(y + row * 2048 + col) = pack8(g0 * v0, g1 * v1); })
    }
};
struct DualOrder {
    pg8::StaticOrder S0, S1;
    __device__ bool next(int i, Unit& u) const { const bool ok = (i & 1) ? S1.next(i >> 1, u) : S0.next(i >> 1, u); u.aux = (i & 1) ? 0 : 1; return ok; }
};
struct EpiGate12 { static constexpr bool DUAL = false;
    EpiGate1 e1; EpiGate2 e2;
    __device__ __forceinline__ void operator()(const f32x4 (&acc)[2][2][4][2], const Unit& u, int wr, int wc, int fr, int fq) const { if (u.aux) e1(acc, u, wr, wc, fr, fq); else e2(acc, u, wr, wc, fr, fq); }
};

struct ProjOrder {
    pg8::StaticOrder S; int fp8; const char* Bfull;
    __device__ bool next(int i, Unit& u) const {
        if (!S.next(i, u)) return false;
        if (fp8) { if (u.pn >= 2) u.pn += 8; } else u.pn += 2;
        return true;
    }
};
__device__ __forceinline__ int map_row(int map, int n) {
    if (map == 0) return n;
    if (map == 1) { if (n < 2384) return n; if (n < 5456) return n + 176; if (n < 5464) return n - 3072; return n + 168; }
    if (map == 4) return n + 512;
    return n + 2384;
}
__device__ void ph0_prologue(const Params& p, LAS unsigned char* lds) {
    const int tid = threadIdx.x, wid = tid >> 6, lane = tid & 63, G = gridDim.x, bx = blockIdx.x;
    if (bx < 192) {
        LAS float* sc = (LAS float*)lds;
        LAS float* red = (LAS float*)(lds + 32768);
        const float* c = p.in[I_C];
        for (int i = tid; i < 4 * 2048; i += NTHREADS) { const float v = c[i]; sc[i] = v / (1.0f + __expf(-v)); }
        __syncthreads();
        for (int item = bx; item < 192; item += G) {
            const int n0 = item * 64, cg = lane & 15, rs = lane >> 4;
            float acc[4][4];
#pragma unroll
            for (int b = 0; b < 4; ++b)
#pragma unroll
                for (int j = 0; j < 4; ++j) acc[b][j] = 0.f;
            const float* w = p.in[I_WADA] + n0 + cg * 4;
#pragma unroll 4
            for (int step = 0; step < 64; ++step) {
                const int k = step * 32 + wid * 4 + rs;
                const f32x4 wv = *(const f32x4*)(w + (size_t)k * 12288);
#pragma unroll
                for (int b = 0; b < 4; ++b) { const float s = sc[b * 2048 + k];
#pragma unroll
                    for (int j = 0; j < 4; ++j) acc[b][j] += s * wv[j]; }
            }
#pragma unroll
            for (int b = 0; b < 4; ++b)
#pragma unroll
                for (int j = 0; j < 4; ++j) { float v = acc[b][j]; v += __shfl_xor(v, 16); v += __shfl_xor(v, 32); acc[b][j] = v; }
            if (rs == 0) {
#pragma unroll
                for (int b = 0; b < 4; ++b)
#pragma unroll
                    for (int j = 0; j < 4; ++j) red[(wid * 16 + cg) * 16 + b * 4 + j] = acc[b][j]; }
            __syncthreads();
            if (tid < 256) { const int cg2 = tid >> 4, bj = tid & 15, b = bj >> 2, j = bj & 3; float s = 0.f;
#pragma unroll
                for (int w8 = 0; w8 < 8; ++w8) s += red[(w8 * 16 + cg2) * 16 + bj];
                const int n = n0 + cg2 * 4 + j; ((float*)(p.ws + WS_MOD))[b * 12288 + n] = s + p.in[I_BADA][n]; }
            __syncthreads();
        }
    }
    { u32x4* z = (u32x4*)(p.ws + WS_WIN + (size_t)2392 * 2048 * 2); const int n16 = 168 * 2048 * 2 / 16;
      for (int i = bx * NTHREADS + tid; i < n16; i += G * NTHREADS) z[i] = (u32x4){0u, 0u, 0u, 0u}; }
    { bf16_t* wh = (bf16_t*)(p.ws + WS_WRH); bf16_t* wl = (bf16_t*)(p.ws + WS_WRL);
      for (int i = bx * NTHREADS + tid; i < 80 * 2048; i += G * NTHREADS) { const int n = i >> 11, k = i & 2047;
          const float v = n < 8 ? p.in[I_WRG][k * 8 + n] : (n < 72 ? p.in[I_WRE][k * 64 + n - 8] : 0.f);
          const unsigned h = cvt_pk_bf16(v, 0.f) & 0xffffu; const unsigned l = cvt_pk_bf16(v - bf_lo(h), 0.f) & 0xffffu; wh[i] = (bf16_t)h; wl[i] = (bf16_t)l; } }
    LAS float* tile = (LAS float*)(lds + 65536);
    for (int ti = bx; ti < p.ntiles_total; ti += G) {
        int j = 0;
#pragma unroll 1
        for (int q = 1; q < NJOBS; ++q) if (ti >= p.jobs[q].tile0) j = q;
        const TJob& J = p.jobs[j];
        int l = ti - J.tile0; const int per = J.ntk * J.ntn; const int bt = l / per; l -= bt * per; const int tn = l / J.ntk, tk = l % J.ntk;
        const float* src = J.src + (size_t)bt * J.sbatch; bf16_t* dst = J.dst + (size_t)bt * J.dbatch;
        const int k0 = tk * 64, n0 = tn * 128;
        f32x4 v[4];
#pragma unroll
        for (int i = 0; i < 4; ++i) { const int r = (tid >> 5) + 16 * i, c4 = (tid & 31) * 4;
            v[i] = (f32x4){0.f, 0.f, 0.f, 0.f}; if (n0 + c4 < J.N) v[i] = *(const f32x4*)(src + (size_t)(k0 + r) * J.ld + n0 + c4); }
#pragma unroll
        for (int i = 0; i < 4; ++i) { const int r = (tid >> 5) + 16 * i, c4 = (tid & 31) * 4;
#pragma unroll
            for (int q = 0; q < 4; ++q) tile[r * 129 + c4 + q] = v[i][q]; }
        __syncthreads();
        { const int n = tid >> 2, kq = (tid & 3) * 16;
          if (n0 + n < J.N) { float f[16];
#pragma unroll
              for (int q = 0; q < 16; ++q) f[q] = tile[(kq + q) * 129 + n];
              u32x4 w0, w1; w0.x = cvt_pk_bf16(f[0], f[1]); w0.y = cvt_pk_bf16(f[2], f[3]); w0.z = cvt_pk_bf16(f[4], f[5]); w0.w = cvt_pk_bf16(f[6], f[7]);
              w1.x = cvt_pk_bf16(f[8], f[9]); w1.y = cvt_pk_bf16(f[10], f[11]); w1.z = cvt_pk_bf16(f[12], f[13]); w1.w = cvt_pk_bf16(f[14], f[15]);
              if (J.fp8) { u32x4 w8; w8.x = pack_fp8x4(f[0] * 64.f, f[1] * 64.f, f[2] * 64.f, f[3] * 64.f); w8.y = pack_fp8x4(f[4] * 64.f, f[5] * 64.f, f[6] * 64.f, f[7] * 64.f);
                  w8.z = pack_fp8x4(f[8] * 64.f, f[9] * 64.f, f[10] * 64.f, f[11] * 64.f); w8.w = pack_fp8x4(f[12] * 64.f, f[13] * 64.f, f[14] * 64.f, f[15] * 64.f);
                  *(u32x4*)((unsigned char*)dst + (size_t)(n0 + n) * J.ldd + k0 + kq) = w8; }
              else { bf16_t* d = dst + (size_t)map_row(J.map, n0 + n) * J.ldd + k0 + kq; *(u32x4*)d = w0; *(u32x4*)(d + 8) = w1; } } }
        __syncthreads();
    }
}

__device__ __forceinline__ void norm_row(const float* xr, const float* g, const float* sh, const float* sc, bf16_t* hr, unsigned char* h8, int lane, float (&hv)[32]) {
    f32x4 v[8]; float ss = 0.f;
#pragma unroll
    for (int i = 0; i < 8; ++i) { v[i] = *(const f32x4*)(xr + i * 256 + lane * 4); ss += v[i][0] * v[i][0] + v[i][1] * v[i][1] + v[i][2] * v[i][2] + v[i][3] * v[i][3]; }
    ss = wave_sum(ss);
    const float rstd = rsqrtf(ss * (1.0f / 2048.0f) + RMS_EPS);
#pragma unroll
    for (int i = 0; i < 8; ++i) { const int col = i * 256 + lane * 4; const f32x4 gg = *(const f32x4*)(g + col), s1 = *(const f32x4*)(sc + col), s0 = *(const f32x4*)(sh + col);
#pragma unroll
        for (int j = 0; j < 4; ++j) hv[i * 4 + j] = v[i][j] * rstd * gg[j] * (1.0f + s1[j]) + s0[j];
        u32x2 w; w.x = cvt_pk_bf16(hv[i * 4], hv[i * 4 + 1]); w.y = cvt_pk_bf16(hv[i * 4 + 2], hv[i * 4 + 3]); *(u32x2*)(hr + col) = w;
        if (h8) *(unsigned*)(h8 + col) = pack_fp8x4(hv[i * 4], hv[i * 4 + 1], hv[i * 4 + 2], hv[i * 4 + 3]); }
}
__device__ void ph1_norm(const Params& p) {
    const int lane = threadIdx.x & 63, gw = blockIdx.x * 8 + (threadIdx.x >> 6), nw = gridDim.x * 8;
    const float* mod = (const float*)(p.ws + WS_MOD);
    for (int t = gw; t < NTOK; t += nw) { const int b = t >> 11; float hv[32];
        norm_row(p.in[I_X] + (size_t)t * DM, p.in[I_GMIX], mod + b * 12288, mod + b * 12288 + 2048, (bf16_t*)(p.ws + WS_H) + (size_t)t * DM, (unsigned char*)(p.ws + WS_HF8) + (size_t)t * DM, lane, hv); }
}

template <int MB, int NB, int KS>
__device__ __forceinline__ void wave_gemm(const bf16_t* A, int lda, const bf16_t* Bt, int ldb, f32x4 (&acc)[MB][NB], int lane) {
    const int fr = lane & 15, fq = lane >> 4;
#pragma unroll
    for (int mb = 0; mb < MB; ++mb)
#pragma unroll
        for (int nb = 0; nb < NB; ++nb) acc[mb][nb] = (f32x4){0.f, 0.f, 0.f, 0.f};
#pragma unroll 1
    for (int ks = 0; ks < KS; ++ks) {
        bf16x8 af[MB];
#pragma unroll
        for (int mb = 0; mb < MB; ++mb) af[mb] = *(const bf16x8*)(A + (size_t)(mb * 16 + fr) * lda + ks * 32 + fq * 8);
#pragma unroll
        for (int nb = 0; nb < NB; ++nb) { const bf16x8 bf = *(const bf16x8*)(Bt + (size_t)(nb * 16 + fr) * ldb + ks * 32 + fq * 8);
#pragma unroll
            for (int mb = 0; mb < MB; ++mb) acc[mb][nb] = __builtin_amdgcn_mfma_f32_16x16x32_bf16(bf, af[mb], acc[mb][nb], 0, 0, 0); }
    }
}


__device__ __forceinline__ int wave_total_i32(int v) {
    v += __builtin_amdgcn_update_dpp(0, v, 0x111, 0xf, 0xf, true); v += __builtin_amdgcn_update_dpp(0, v, 0x112, 0xf, 0xf, true);
    v += __builtin_amdgcn_update_dpp(0, v, 0x114, 0xf, 0xf, true); v += __builtin_amdgcn_update_dpp(0, v, 0x118, 0xf, 0xf, true);
    v += __builtin_amdgcn_update_dpp(0, v, 0x142, 0xa, 0xf, false); v += __builtin_amdgcn_update_dpp(0, v, 0x143, 0xc, 0xf, false);
    return __builtin_amdgcn_readlane(v, 63);
}
template <int NI> __device__ __forceinline__ void topk_words2(const LAS float* srow0, const LAS float* srow1, int c, int lane, unsigned long long& w0, unsigned long long& w1) {
    unsigned ka[NI], kb[NI];
#pragma unroll
    for (int i = 0; i < NI; ++i) { unsigned u = 0u, x = 0u; if (i <= c) { u = __float_as_uint(srow0[i * 64 + lane]); u = (u & 0x80000000u) ? ~u : (u | 0x80000000u);
            x = __float_as_uint(srow1[i * 64 + lane]); x = (x & 0x80000000u) ? ~x : (x | 0x80000000u); } ka[i] = u; kb[i] = x; }
    unsigned va = 0u, vb = 0u; bool da = false, db = false;
#pragma unroll 1
    for (int bit = 31; bit >= 0; --bit) {
        const unsigned ca = va | (1u << bit), cb = vb | (1u << bit); int a0 = 0, a1 = 0, b0 = 0, b1 = 0;
#pragma unroll
        for (int i = 0; i < NI; i += 2) { a0 += (ka[i] >= ca) ? 1 : 0; a1 += (ka[i + 1] >= ca) ? 1 : 0; b0 += (kb[i] >= cb) ? 1 : 0; b1 += (kb[i + 1] >= cb) ? 1 : 0; }
        const int ta = wave_total_i32(a0 + a1), tb = wave_total_i32(b0 + b1);
        if (!da && ta >= 256) { va = ca; da = (ta == 256); }
        if (!db && tb >= 256) { vb = cb; db = (tb == 256); }
        if (da && db) break;
    }
    w0 = 0ull; w1 = 0ull;
#pragma unroll
    for (int i = 0; i < NI; ++i) { const unsigned long long ma = __ballot(ka[i] >= va), mb = __ballot(kb[i] >= vb); if (lane == i) { w0 = ma; w1 = mb; } if ((i & 3) == 3) SBAR(); }
}

__device__ void idx_item(const Params& p, LAS unsigned char* lds, int b, int c, int sub) {
    const int tid = threadIdx.x, wid = tid >> 6, lane = tid & 63, fr = lane & 15, fq = lane >> 4;
    constexpr int SCLD = 2052;
    LAS float* sc = (LAS float*)lds;
    const int q0 = c * 64 + sub * 16, nk = (c + 1) * 64, nkb = nk / 16;
    const bf16_t* qidx = (const bf16_t*)(p.ws + WS_QIDX) + (size_t)(b * SEQ + q0 + fr) * 1024;
    const float* misc = (const float*)(p.ws + WS_MISC);
    float wq[16];
    { const float* wp = misc + (size_t)(b * SEQ + q0 + fr) * 256 + 64;
#pragma unroll
      for (int i = 0; i < 4; ++i) { const f32x4 v = *(const f32x4*)(wp + i * 4); wq[i * 4] = v[0]; wq[i * 4 + 1] = v[1]; wq[i * 4 + 2] = v[2]; wq[i * 4 + 3] = v[3]; } }
#pragma unroll
    for (int hp = 0; hp < 2; ++hp) {
        bf16x8 qf[8][2];
#pragma unroll
        for (int h = 0; h < 8; ++h)
#pragma unroll
            for (int ks = 0; ks < 2; ++ks) qf[h][ks] = *(const bf16x8*)(qidx + (hp * 8 + h) * 64 + ks * 32 + fq * 8);
        const bf16_t* kbase = (const bf16_t*)(p.ws + WS_KIDX) + (size_t)(b * SEQ + fr) * 64 + fq * 8;
        bf16x8 kf[2];
        if (wid < nkb) { kf[0] = *(const bf16x8*)(kbase + (size_t)wid * 16 * 64); kf[1] = *(const bf16x8*)(kbase + (size_t)wid * 16 * 64 + 32); }
#pragma unroll 1
        for (int kb = wid; kb < nkb; kb += 8) {
            const int kn = kb + 8 < nkb ? kb + 8 : kb;
            const bf16x8 kn0 = *(const bf16x8*)(kbase + (size_t)kn * 16 * 64), kn1 = *(const bf16x8*)(kbase + (size_t)kn * 16 * 64 + 32);
            LAS f32x4* sp = (LAS f32x4*)(sc + fr * SCLD + kb * 16 + fq * 4);
            f32x4 s = {0.f, 0.f, 0.f, 0.f}; if (hp) s = *sp;
#pragma unroll
            for (int h = 0; h < 8; ++h) {
                f32x4 a = {0.f, 0.f, 0.f, 0.f};
                a = __builtin_amdgcn_mfma_f32_16x16x32_bf16(kf[0], qf[h][0], a, 0, 0, 0);
                a = __builtin_amdgcn_mfma_f32_16x16x32_bf16(kf[1], qf[h][1], a, 0, 0, 0);
#pragma unroll
                for (int j = 0; j < 4; ++j) s[j] += wq[hp * 8 + h] * fmaxf(a[j], 0.f);
            }
            *sp = s; kf[0] = kn0; kf[1] = kn1;
        }
    }
    __syncthreads();
    unsigned long long* mask = (unsigned long long*)(p.ws + WS_MASK);
    {
        const int ql = wid * 2; const size_t qg = (size_t)b * SEQ + q0 + ql;
        unsigned long long w0 = 0ull, w1 = 0ull;
        if (nk <= 256) { if (lane <= c) { w0 = ~0ull; w1 = ~0ull; } }
        else { const LAS float* s0 = sc + ql * SCLD; const LAS float* s1 = s0 + SCLD;
            if (c < 8) topk_words2<8>(s0, s1, c, lane, w0, w1); else if (c < 16) topk_words2<16>(s0, s1, c, lane, w0, w1);
            else if (c < 24) topk_words2<24>(s0, s1, c, lane, w0, w1); else topk_words2<32>(s0, s1, c, lane, w0, w1); }
        if (lane < 32) { mask[qg * 32 + lane] = w0; mask[(qg + 1) * 32 + lane] = w1; }
    }
    __syncthreads();
}
#ifndef REP_SUB
#define REP_SUB 15
#endif
__device__ void ph3_prep(const Params& p, LAS unsigned char* lds, const int rep) {
#define P3ON(bit) (!rep || ((REP_SUB) & (bit)))
    const int tid = threadIdx.x, wid = tid >> 6, lane = tid & 63, bx = blockIdx.x, G = gridDim.x;
    if (P3ON(1)) for (int it = bx; it < 256; it += G) {
        const int b = it >> 6, r = it & 63, cp = r >> 2, sub = r & 3;
        idx_item(p, lds, b, 31 - cp, sub); idx_item(p, lds, b, cp, sub);
    }
    const int gw = bx * 8 + wid, nw = G * 8;
    if (P3ON(2)) for (int it = gw; it < 2048; it += nw) {
        const int rt = it >> 3, h = it & 7, fr = lane & 15, fq = lane >> 4;
        f32x4 acc[2][16];
        wave_gemm<2, 16, 4>((const bf16_t*)(p.ws + WS_QA) + (size_t)rt * 32 * 1024 + h * 128, 1024, (const bf16_t*)(p.ws + WS_WUK) + (size_t)h * 256 * 128, 128, acc, lane);
#pragma unroll
        for (int mb = 0; mb < 2; ++mb) { float ss = 0.f;
#pragma unroll
            for (int nb = 0; nb < 16; ++nb)
#pragma unroll
                for (int j = 0; j < 4; ++j) ss += acc[mb][nb][j] * acc[mb][nb][j];
            ss += __shfl_xor(ss, 16); ss += __shfl_xor(ss, 32);
            const float rs = rsqrtf(ss * (1.0f / 256.0f) + RMS_EPS) * 0.0625f;
            bf16_t* o = (bf16_t*)(p.ws + WS_QLAT) + (size_t)(rt * 32 + mb * 16 + fr) * 2048 + h * 256;
#pragma unroll
            for (int nb = 0; nb < 16; ++nb) { const int col = nb * 16 + fq * 4; const f32x4 g = *(const f32x4*)(p.in[I_GQA] + col);
                u32x2 w; w.x = cvt_pk_bf16(acc[mb][nb][0] * rs * g[0], acc[mb][nb][1] * rs * g[1]); w.y = cvt_pk_bf16(acc[mb][nb][2] * rs * g[2], acc[mb][nb][3] * rs * g[3]); *(u32x2*)(o + col) = w; } }
    }
    if (P3ON(4))
#pragma unroll 4
    for (int t = gw; t < NTOK; t += nw) {
        { const f32x4 v = *(const f32x4*)((const float*)(p.ws + WS_CKV) + (size_t)t * 256 + lane * 4); float ss = wave_sum(v[0] * v[0] + v[1] * v[1] + v[2] * v[2] + v[3] * v[3]);
          const float rs = rsqrtf(ss * (1.0f / 256.0f) + RMS_EPS); const f32x4 g = *(const f32x4*)(p.in[I_GKV] + lane * 4);
          u32x2 w; w.x = cvt_pk_bf16(v[0] * rs * g[0], v[1] * rs * g[1]); w.y = cvt_pk_bf16(v[2] * rs * g[2], v[3] * rs * g[3]); *(u32x2*)((bf16_t*)(p.ws + WS_KV) + (size_t)t * 256 + lane * 4) = w; }
#pragma unroll
        for (int which = 0; which < 2; ++which) {
            bf16_t* row = (bf16_t*)(p.ws + (which ? WS_KB : WS_QB)) + (size_t)t * 1024 + lane * 16; const float* g = p.in[which ? I_GKB : I_GQB] + (lane & 7) * 16;
            u32x4 a = *(u32x4*)row, c2 = *(u32x4*)(row + 8); float f[16];
            f[0] = bf_lo(a.x); f[1] = bf_hi(a.x); f[2] = bf_lo(a.y); f[3] = bf_hi(a.y); f[4] = bf_lo(a.z); f[5] = bf_hi(a.z); f[6] = bf_lo(a.w); f[7] = bf_hi(a.w);
            f[8] = bf_lo(c2.x); f[9] = bf_hi(c2.x); f[10] = bf_lo(c2.y); f[11] = bf_hi(c2.y); f[12] = bf_lo(c2.z); f[13] = bf_hi(c2.z); f[14] = bf_lo(c2.w); f[15] = bf_hi(c2.w);
            float ss = 0.f;
#pragma unroll
            for (int j = 0; j < 16; ++j) ss += f[j] * f[j];
            ss += __shfl_xor(ss, 1); ss += __shfl_xor(ss, 2); ss += __shfl_xor(ss, 4);
            const float rs = rsqrtf(ss * (1.0f / 128.0f) + RMS_EPS) * (which ? 1.0f : 0.08838834764831845f);
#pragma unroll
            for (int j = 0; j < 16; ++j) f[j] *= rs * g[j];
            a.x = cvt_pk_bf16(f[0], f[1]); a.y = cvt_pk_bf16(f[2], f[3]); a.z = cvt_pk_bf16(f[4], f[5]); a.w = cvt_pk_bf16(f[6], f[7]);
            c2.x = cvt_pk_bf16(f[8], f[9]); c2.y = cvt_pk_bf16(f[10], f[11]); c2.z = cvt_pk_bf16(f[12], f[13]); c2.w = cvt_pk_bf16(f[14], f[15]);
            if (!rep) { *(u32x4*)row = a; *(u32x4*)(row + 8) = c2; } else if (a.x == 0x12345678u) *(u32x4*)row = c2;
        }
    }
    if (P3ON(8) && bx < NBATCH) {
        const int b = bx; const float* fp = (const float*)(p.ws + WS_MISC) + (size_t)(b * SEQ + 4 * tid) * 256 + 80;
        float ls[4][8];
#pragma unroll
        for (int j = 0; j < 4; ++j) { const f32x4 a = *(const f32x4*)(fp + j * 256), c4 = *(const f32x4*)(fp + j * 256 + 4);
#pragma unroll
            for (int h = 0; h < 8; ++h) { const float z = (h < 4 ? a[h & 3] : c4[h & 3]) + p.in[I_BFORGET][h]; ls[j][h] = fminf(z, 0.f) - log1pf(__expf(-fabsf(z))); } }
        LAS float* wt = (LAS float*)lds;
        float off[8];
#pragma unroll
        for (int h = 0; h < 8; ++h) { ls[1][h] += ls[0][h]; ls[2][h] += ls[1][h]; ls[3][h] += ls[2][h];
            float incl = ls[3][h];
#pragma unroll
            for (int o = 1; o < 64; o <<= 1) { const float t2 = __shfl_up(incl, o); if (lane >= o) incl += t2; }
            if (lane == 63) wt[wid * 8 + h] = incl;
            off[h] = incl - ls[3][h]; }
        __syncthreads();
#pragma unroll
        for (int h = 0; h < 8; ++h) { float wo = 0.f; for (int w8 = 0; w8 < wid; ++w8) wo += wt[w8 * 8 + h];
            float* cp = (float*)(p.ws + WS_CUM) + (size_t)(b * 8 + h) * SEQ + 4 * tid;
            *(f32x4*)cp = (f32x4){ls[0][h] + off[h] + wo, ls[1][h] + off[h] + wo, ls[2][h] + off[h] + wo, ls[3][h] + off[h] + wo}; }
        __syncthreads();
    }
}

template <int OFF> __device__ __forceinline__ s16x4 tr_read(int vb) { s16x4 r; asm volatile("ds_read_b64_tr_b16 %0, %1 offset:%2" : "=&v"(r) : "v"(vb), "i"(OFF) : "memory"); return r; }
__device__ __forceinline__ int v_rd_base(int lane) { return ((lane & 3) << 3) | (((lane >> 2) & 3) << 6) | (((lane >> 4) & 1) << 5) | (((lane >> 5) & 1) << 8); }
#define PK4(P, BASE, OUT) do { unsigned a0 = cvt_pk_bf16(P[BASE + 0], P[BASE + 1]), a1 = cvt_pk_bf16(P[BASE + 2], P[BASE + 3]);   \
    unsigned b0 = cvt_pk_bf16(P[BASE + 4], P[BASE + 5]), b1 = cvt_pk_bf16(P[BASE + 6], P[BASE + 7]);                              \
    auto r0 = __builtin_amdgcn_permlane32_swap(a0, b0, false, false); auto r1 = __builtin_amdgcn_permlane32_swap(a1, b1, false, false); \
    u32x4 w = {r0[0], r1[0], r0[1], r1[1]}; OUT = *reinterpret_cast<bf16x8*>(&w); } while (0)
#define PKV(L, H) (bf16x8){L[0], L[1], L[2], L[3], H[0], H[1], H[2], H[3]}
template <int NCB, int KS0, int D0> struct PvPairs { static __device__ __forceinline__ void run(f32x16* o, int vb, bf16x8 pa0, bf16x8 pa1) {
    constexpr int S = 2 * NCB * 512, H = NCB * 512;
    const s16x4 l00 = tr_read<D0 * 512 + KS0 * S>(vb), h00 = tr_read<D0 * 512 + KS0 * S + H>(vb), l01 = tr_read<D0 * 512 + (KS0 + 1) * S>(vb), h01 = tr_read<D0 * 512 + (KS0 + 1) * S + H>(vb);
    const s16x4 l10 = tr_read<(D0 + 1) * 512 + KS0 * S>(vb), h10 = tr_read<(D0 + 1) * 512 + KS0 * S + H>(vb), l11 = tr_read<(D0 + 1) * 512 + (KS0 + 1) * S>(vb), h11 = tr_read<(D0 + 1) * 512 + (KS0 + 1) * S + H>(vb);
    asm volatile("s_waitcnt lgkmcnt(0)" ::: "memory"); SBAR();
    o[D0] = __builtin_amdgcn_mfma_f32_32x32x16_bf16(pa0, PKV(l00, h00), o[D0], 0, 0, 0); o[D0 + 1] = __builtin_amdgcn_mfma_f32_32x32x16_bf16(pa0, PKV(l10, h10), o[D0 + 1], 0, 0, 0);
    o[D0] = __builtin_amdgcn_mfma_f32_32x32x16_bf16(pa1, PKV(l01, h01), o[D0], 0, 0, 0); o[D0 + 1] = __builtin_amdgcn_mfma_f32_32x32x16_bf16(pa1, PKV(l11, h11), o[D0 + 1], 0, 0, 0);
    if constexpr (D0 + 2 < NCB) PvPairs<NCB, KS0, D0 + 2>::run(o, vb, pa0, pa1); } };
__device__ __forceinline__ int swap23(int k) { return (k & ~0xC) | ((k & 4) << 1) | ((k & 8) >> 1); }
constexpr int FOX_STAGE = 33024;
constexpr int FOX_AL = 2 * FOX_STAGE, FOX_LI = FOX_AL + 1024;
__device__ void fox_item(const Params& p, LAS unsigned char* lds, int b, int h, int qb) {
    int tid = threadIdx.x; asm volatile("" : "+v"(tid));
    const int wid = __builtin_amdgcn_readfirstlane(tid >> 6), lane = tid & 63, r32 = lane & 31, hi = lane >> 5;
    const bf16_t* Q = (const bf16_t*)(p.ws + WS_QB);
    const char* Kg = (const char*)(p.ws + WS_KB) + ((size_t)b * SEQ * 1024 + h * 128) * 2; const char* Vg = (const char*)(p.ws + WS_VB) + ((size_t)b * SEQ * 1024 + h * 128) * 2;
    const float* cum = (const float*)(p.ws + WS_CUM) + (size_t)(b * 8 + h) * SEQ;
    const int qpos = qb * 256 + wid * 32 + r32;
    bf16x8 qr[8];
    { const bf16_t* qp = Q + (size_t)(b * SEQ + qpos) * 1024 + h * 128 + hi * 8;
#pragma unroll
      for (int d0 = 0; d0 < 8; ++d0) qr[d0] = *(const bf16x8*)(qp + d0 * 16); }
    const float cq = cum[qpos] * LOG2E;
    unsigned ksrc[2], vsrc[2];
#pragma unroll
    for (int i = 0; i < 2; ++i) { const int pos = (i * 512 + tid) * 16;
        { const int row = pos >> 8; const int cb = (pos & 255) ^ ((row & 7) << 4); ksrc[i] = (unsigned)(row * 2048 + cb); }
        { const int sub = pos >> 9, within = pos & 511; const int kk = (sub >> 2) * 8 + (within >> 6); const int c = (sub & 3) * 32 + ((within & 63) >> 1); vsrc[i] = (unsigned)(swap23(kk) * 2048 + c * 2); } }
    float m_reg = -1e30f, l_reg = 0.f; f32x16 o[4];
#pragma unroll
    for (int d = 0; d < 4; ++d)
#pragma unroll
        for (int r = 0; r < 16; ++r) o[d][r] = 0.f;
    LAS float* al_l = (LAS float*)(lds + FOX_AL) + wid * 32; LAS float* li_l = (LAS float*)(lds + FOX_LI) + wid * 32;
    const int ntiles = qb * 4 + 4, mylast = qb * 4 + (wid >> 1);
#define FOX_DMA(kt) do { LAS unsigned char* sb_ = lds + ((kt) & 1) * FOX_STAGE; const size_t go_ = (size_t)(kt) * 64 * 2048; \
        _Pragma("unroll") for (int i = 0; i < 2; ++i) { \
            __builtin_amdgcn_global_load_lds((const unsigned*)(Kg + go_ + ksrc[i]), (LAS unsigned*)(sb_ + 16384 + (i * 512 + wid * 64) * 16), 16, 0, 0); \
            __builtin_amdgcn_global_load_lds((const unsigned*)(Vg + go_ + vsrc[i]), (LAS unsigned*)(sb_ + (i * 512 + wid * 64) * 16), 16, 0, 0); } \
        if (wid == 0) __builtin_amdgcn_global_load_lds((const unsigned*)(cum + (kt) * 64 + lane), (LAS unsigned*)(sb_ + 32768), 4, 0, 0); } while (0)
    __syncthreads();
    FOX_DMA(0);
    for (int kt = 0; kt < ntiles; ++kt) {
        asm volatile("s_waitcnt vmcnt(0)" ::: "memory");
        __syncthreads();
        if (kt + 1 < ntiles) FOX_DMA(kt + 1);
        if (kt <= mylast) {
            const LAS unsigned char* sb = lds + (kt & 1) * FOX_STAGE; const LAS float* ck = (const LAS float*)(sb + 32768);
            const int vb = (int)(uintptr_t)sb + v_rd_base(lane);
            f32x16 p0, p1;
#pragma unroll
            for (int r = 0; r < 16; ++r) { p0[r] = 0.f; p1[r] = 0.f; }
            int fsw = (r32 & 7) << 4; asm volatile("" : "+v"(fsw));
#pragma unroll
            for (int d0 = 0; d0 < 8; ++d0) { const int cb = (d0 * 16 + hi * 8) * 2;
                const bf16x8 b0 = *(const LAS bf16x8*)(sb + 16384 + r32 * 256 + (cb ^ fsw));
                const bf16x8 b1 = *(const LAS bf16x8*)(sb + 16384 + (32 + r32) * 256 + (cb ^ fsw));
                p0 = __builtin_amdgcn_mfma_f32_32x32x16_bf16(b0, qr[d0], p0, 0, 0, 0); p1 = __builtin_amdgcn_mfma_f32_32x32x16_bf16(b1, qr[d0], p1, 0, 0, 0); }
            const bool diag = (kt * 64 + 63 > qb * 256 + wid * 32);
            float pmax = -INFINITY;
#pragma unroll
            for (int g4 = 0; g4 < 4; ++g4) { const f32x4 c0 = *(const LAS f32x4*)(ck + 8 * g4 + 4 * hi), c1 = *(const LAS f32x4*)(ck + 32 + 8 * g4 + 4 * hi);
#pragma unroll
                for (int j = 0; j < 4; ++j) { const int r = g4 * 4 + j; float t0 = fmaf(p0[r], LOG2E, cq) - c0[j] * LOG2E, t1 = fmaf(p1[r], LOG2E, cq) - c1[j] * LOG2E;
                    if (diag) { const int kp = kt * 64 + crow(r, hi); if (kp > qpos) t0 = -INFINITY; if (kp + 32 > qpos) t1 = -INFINITY; }
                    p0[r] = t0; p1[r] = t1; pmax = fmaxf(pmax, fmaxf(t0, t1)); } }
            { auto rr = __builtin_amdgcn_permlane32_swap(__float_as_uint(pmax), __float_as_uint(pmax), false, false); pmax = fmaxf(__uint_as_float(rr[0]), __uint_as_float(rr[1])); }
            const float mn = fmaxf(m_reg, pmax); const float alpha = __builtin_amdgcn_exp2f(m_reg - mn); m_reg = mn;
            float ps = 0.f;
#pragma unroll
            for (int r = 0; r < 16; ++r) { p0[r] = __builtin_amdgcn_exp2f(p0[r] - mn); p1[r] = __builtin_amdgcn_exp2f(p1[r] - mn); ps += p0[r] + p1[r]; }
            { auto rr = __builtin_amdgcn_permlane32_swap(__float_as_uint(ps), __float_as_uint(ps), false, false); ps = __uint_as_float(rr[0]) + __uint_as_float(rr[1]); }
            l_reg = l_reg * alpha + ps;
            if (__any(alpha < 1.f)) { if (hi == 0) al_l[r32] = alpha; asm volatile("s_waitcnt lgkmcnt(0)" ::: "memory");
#pragma unroll
                for (int r = 0; r < 16; ++r) { const float a = al_l[crow(r, hi)];
#pragma unroll
                    for (int d = 0; d < 4; ++d) o[d][r] *= a; } }
            bf16x8 pa0, pa1, pa2, pa3; PK4(p0, 0, pa0); PK4(p0, 8, pa1); PK4(p1, 0, pa2); PK4(p1, 8, pa3);
            PvPairs<4, 0, 0>::run(o, vb, pa0, pa1); PvPairs<4, 2, 0>::run(o, vb, pa2, pa3);
        }
    }
#undef FOX_DMA
    if (hi == 0) li_l[r32] = l_reg; asm volatile("s_waitcnt lgkmcnt(0)" ::: "memory");
    unsigned char* O8 = (unsigned char*)(p.ws + WS_OB8) + (size_t)(b * SEQ + qb * 256 + wid * 32) * 1024 + h * 128;
#pragma unroll
    for (int r = 0; r < 16; ++r) { const float rl = __builtin_amdgcn_rcpf(li_l[crow(r, hi)]); const int orow = crow(r, hi);
#pragma unroll
        for (int d0 = 0; d0 < 4; ++d0) O8[(size_t)orow * 1024 + d0 * 32 + r32] = (unsigned char)(pack_fp8x4(o[d0][r] * rl * 8.f, 0.f, 0.f, 0.f) & 0xffu); }
}

constexpr int DSA_STAGE = 32768;
constexpr int DSA_AL = 2 * DSA_STAGE, DSA_LI = DSA_AL + 1024, DSA_Q = DSA_LI + 1024;
__device__ void dsa_item(const Params& p, LAS unsigned char* lds, int b, int qt) {
    int tid = threadIdx.x; asm volatile("" : "+v"(tid));
    const int wid = __builtin_amdgcn_readfirstlane(tid >> 6), lane = tid & 63, r32 = lane & 31, hi = lane >> 5, h = wid;
    const char* KV = (const char*)(p.ws + WS_KV) + (size_t)b * SEQ * 512;
    const int qpos = qt * 32 + r32; const size_t qg = (size_t)b * SEQ + qpos;
    const unsigned* mask = (const unsigned*)(p.ws + WS_MASK) + qg * 64;
    bf16x8 qr[8];
    LAS unsigned char* qlds = lds + DSA_Q + wid * 8192 + lane * 16;
    __syncthreads();
    { const bf16_t* qp = (const bf16_t*)(p.ws + WS_QLAT) + qg * 2048 + h * 256 + hi * 8;
#pragma unroll
      for (int d0 = 0; d0 < 8; ++d0) qr[d0] = *(const bf16x8*)(qp + d0 * 16);
#pragma unroll
      for (int d0 = 8; d0 < 16; ++d0) *(LAS bf16x8*)(qlds + (d0 - 8) * 1024) = *(const bf16x8*)(qp + d0 * 16); }
    unsigned ksrc[2], vsrc[2];
#pragma unroll
    for (int i = 0; i < 2; ++i) { const int pos = (i * 512 + tid) * 16;
        { const int row = pos >> 9; const int cb = (pos & 511) ^ ((row & 15) << 4); ksrc[i] = (unsigned)(row * 512 + cb); }
        { const int sub = pos >> 9, within = pos & 511; const int kk = (sub >> 3) * 8 + (within >> 6); const int c = (sub & 7) * 32 + ((within & 63) >> 1); vsrc[i] = (unsigned)(swap23(kk) * 512 + c * 2); } }
    const float slopeL = exp2f(-(float)(h + 1)) * LOG2E;
    float m_reg = -1e30f, l_reg = 0.f; f32x16 o[8];
#pragma unroll
    for (int d = 0; d < 8; ++d)
#pragma unroll
        for (int r = 0; r < 16; ++r) o[d][r] = 0.f;
    LAS float* al_l = (LAS float*)(lds + DSA_AL) + wid * 32; LAS float* li_l = (LAS float*)(lds + DSA_LI) + wid * 32;
    const int ntiles = ((qt >> 1) + 1) * 2;
#define DSA_DMA(kt) do { LAS unsigned char* sb_ = lds + ((kt) & 1) * DSA_STAGE; const size_t go_ = (size_t)(kt) * 32 * 512; \
        _Pragma("unroll") for (int i = 0; i < 2; ++i) { \
            __builtin_amdgcn_global_load_lds((const unsigned*)(KV + go_ + ksrc[i]), (LAS unsigned*)(sb_ + 16384 + (i * 512 + wid * 64) * 16), 16, 0, 0); \
            __builtin_amdgcn_global_load_lds((const unsigned*)(KV + go_ + vsrc[i]), (LAS unsigned*)(sb_ + (i * 512 + wid * 64) * 16), 16, 0, 0); } } while (0)
    unsigned mw = mask[0];
    DSA_DMA(0);
    for (int kt = 0; kt < ntiles; ++kt) {
        asm volatile("s_waitcnt vmcnt(0)" ::: "memory");
        __syncthreads();
        const unsigned mcur = mw;
        if (kt + 1 < ntiles) { mw = mask[kt + 1]; DSA_DMA(kt + 1); }
        const LAS unsigned char* sb = lds + (kt & 1) * DSA_STAGE; const int vb = (int)(uintptr_t)sb + v_rd_base(lane);
        f32x16 pp;
#pragma unroll
        for (int r = 0; r < 16; ++r) pp[r] = 0.f;
        {
            const LAS unsigned char* kb_ = sb + 16384 + r32 * 512; int sw_ = (r32 & 15) << 4; asm volatile("" : "+v"(sw_));
#define DSA_KF(d0) (*(const LAS bf16x8*)(kb_ + ((((d0) * 16 + hi * 8) * 2) ^ sw_)))
#define DSA_QF(d0) ((d0) < 8 ? qr[(d0) & 7] : *(const LAS bf16x8*)(qlds + (((d0) - 8) & 7) * 1024))
            bf16x8 k0 = DSA_KF(0), k1 = DSA_KF(1), q0 = DSA_QF(0), q1 = DSA_QF(1);
#pragma unroll
            for (int d0 = 0; d0 < 16; d0 += 2) {
                bf16x8 nk0 = k0, nk1 = k1, nq0 = q0, nq1 = q1;
                if (d0 + 2 < 16) { nk0 = DSA_KF(d0 + 2); nk1 = DSA_KF(d0 + 3); nq0 = DSA_QF(d0 + 2); nq1 = DSA_QF(d0 + 3); }
                pp = __builtin_amdgcn_mfma_f32_32x32x16_bf16(k0, q0, pp, 0, 0, 0); pp = __builtin_amdgcn_mfma_f32_32x32x16_bf16(k1, q1, pp, 0, 0, 0);
                k0 = nk0; k1 = nk1; q0 = nq0; q1 = nq1; SBAR();
            }
#undef DSA_KF
#undef DSA_QF
        }
        const unsigned wsh = mcur >> (4 * hi);
        const float df = (float)(qpos - (kt * 32 + 4 * hi));
        float pmax = -INFINITY;
#pragma unroll
        for (int r = 0; r < 16; ++r) { const int cb = (r & 3) + 8 * (r >> 2); const float dd = df - (float)cb;
            float t = fmaf(-slopeL, fabsf(dd), pp[r] * LOG2E); if (!((wsh >> cb) & 1u)) t = -INFINITY; pp[r] = t; pmax = fmaxf(pmax, t); }
        { auto rr = __builtin_amdgcn_permlane32_swap(__float_as_uint(pmax), __float_as_uint(pmax), false, false); pmax = fmaxf(__uint_as_float(rr[0]), __uint_as_float(rr[1])); }
        const float mn = fmaxf(m_reg, pmax); const float alpha = __builtin_amdgcn_exp2f(m_reg - mn); m_reg = mn;
        float ps = 0.f;
#pragma unroll
        for (int r = 0; r < 16; ++r) { pp[r] = __builtin_amdgcn_exp2f(pp[r] - mn); ps += pp[r]; }
        { auto rr = __builtin_amdgcn_permlane32_swap(__float_as_uint(ps), __float_as_uint(ps), false, false); ps = __uint_as_float(rr[0]) + __uint_as_float(rr[1]); }
        l_reg = l_reg * alpha + ps;
        if (__any(alpha < 1.f)) { if (hi == 0) al_l[r32] = alpha; asm volatile("s_waitcnt lgkmcnt(0)" ::: "memory");
#pragma unroll
            for (int r = 0; r < 16; ++r) { const float a = al_l[crow(r, hi)];
#pragma unroll
                for (int d = 0; d < 8; ++d) o[d][r] *= a; } }
        bf16x8 pa0, pa1; PK4(pp, 0, pa0); PK4(pp, 8, pa1);
        PvPairs<8, 0, 0>::run(o, vb, pa0, pa1);
    }
#undef DSA_DMA
    if (hi == 0) li_l[r32] = l_reg; asm volatile("s_waitcnt lgkmcnt(0)" ::: "memory");
    float rl[16];
#pragma unroll
    for (int r = 0; r < 16; ++r) rl[r] = __builtin_amdgcn_rcpf(li_l[crow(r, hi)]);
    __syncthreads();
    LAS bf16_t* os = (LAS bf16_t*)(lds + wid * 16896);
#pragma unroll
    for (int r = 0; r < 16; ++r)
#pragma unroll
        for (int d0 = 0; d0 < 8; ++d0) os[crow(r, hi) * 264 + d0 * 32 + r32] = (bf16_t)(cvt_pk_bf16(o[d0][r] * rl[r], 0.f) & 0xffffu);
    asm volatile("s_waitcnt lgkmcnt(0)" ::: "memory");
    f32x16 ya[4];
#pragma unroll
    for (int nb = 0; nb < 4; ++nb)
#pragma unroll
        for (int r = 0; r < 16; ++r) ya[nb][r] = 0.f;
    const bf16_t* wv = (const bf16_t*)(p.ws + WS_WUV) + (size_t)(h * 128 + r32) * 256 + hi * 8;
#pragma unroll 4
    for (int ks = 0; ks < 16; ++ks) {
        const bf16x8 af = *(const LAS bf16x8*)(os + r32 * 264 + ks * 16 + hi * 8);
#pragma unroll
        for (int nb = 0; nb < 4; ++nb) { const bf16x8 wf = *(const bf16x8*)(wv + (size_t)nb * 32 * 256 + ks * 16); ya[nb] = __builtin_amdgcn_mfma_f32_32x32x16_bf16(wf, af, ya[nb], 0, 0, 0); }
    }
    unsigned char* O8 = (unsigned char*)(p.ws + WS_OA8) + ((size_t)b * SEQ + qt * 32 + r32) * 1024 + h * 128 + 4 * hi;
#pragma unroll
    for (int nb = 0; nb < 4; ++nb)
#pragma unroll
        for (int g4 = 0; g4 < 4; ++g4) *(unsigned*)(O8 + nb * 32 + g4 * 8) = pack_fp8x4(ya[nb][g4 * 4] * 8.f, ya[nb][g4 * 4 + 1] * 8.f, ya[nb][g4 * 4 + 2] * 8.f, ya[nb][g4 * 4 + 3] * 8.f);
}
__device__ void ph4_attn(const Params& p, LAS unsigned char* lds) {
    const int r = blockIdx.x;
    if (r < 256) { const int c = 31 - (r >> 3), w8 = r & 7, b = w8 >> 1, half = w8 & 1; dsa_item(p, lds, b, c * 2 + half); }
    int* qhead = (int*)(p.ws + WS_CNT) + 512;
    LAS int* slot = (LAS int*)(lds + LDS_BARW - 16);
    for (;;) {
        __syncthreads();
        if (threadIdx.x == 0) *slot = atomicAdd(qhead, 1);
        __syncthreads();
        const int it = __builtin_amdgcn_readfirstlane(*slot);
        if (it >= 256) break;
        const int qb = 7 - (it >> 5), bh = it & 31;
        fox_item(p, lds, bh >> 3, bh & 7, qb);
    }
}

__device__ void ph8_router(const Params& p, LAS unsigned char* lds, const int rep) {
    const int tid = threadIdx.x, wid = tid >> 6, lane = tid & 63, fr = lane & 15, fq = lane >> 4;
    const float* mod = (const float*)(p.ws + WS_MOD);
    int* cnt = (int*)(p.ws + WS_CNT) + rep * 256; int* ltok = rep ? (int*)(p.ws + WS_QLAT) : (int*)(p.ws + WS_LTOK); float* lw = rep ? (float*)(p.ws + WS_QLAT + (4u << 20)) : (float*)(p.ws + WS_LW);
    LAS unsigned char* AH = lds; LAS unsigned char* AL = lds + 65536;
    LAS float* slab = (LAS float*)(lds + 131072);
    LAS float* lg = (LAS float*)(lds + 131072 + 20480);
    const bf16_t* WH = (const bf16_t*)(p.ws + WS_WRH); const bf16_t* WL = (const bf16_t*)(p.ws + WS_WRL);
    for (int blk = blockIdx.x; blk < NTOK / 32; blk += gridDim.x) {
#pragma unroll 1
        for (int half = 0; half < 2; ++half) {
            const int t0 = blk * 32 + half * 16, tb = t0 + wid * 2, b = tb >> 11;
            const float* sh = mod + b * 12288 + 6144; const float* sc = mod + b * 12288 + 8192;
            f32x4 xv[2][8];
#pragma unroll
            for (int rr = 0; rr < 2; ++rr)
#pragma unroll
                for (int i = 0; i < 8; ++i) { const size_t eo = (size_t)(tb + rr) * DM + i * 256 + lane * 4; const u32x2 yb = *(const u32x2*)((const bf16_t*)(p.ws + WS_MERGED) + eo);
                    xv[rr][i] = *(const f32x4*)(p.in[I_X] + eo) + (f32x4){bf_lo(yb.x), bf_hi(yb.x), bf_lo(yb.y), bf_hi(yb.y)}; }
            float rstd[2];
#pragma unroll
            for (int rr = 0; rr < 2; ++rr) { float ss = 0.f;
#pragma unroll
                for (int i = 0; i < 8; ++i) ss += xv[rr][i][0] * xv[rr][i][0] + xv[rr][i][1] * xv[rr][i][1] + xv[rr][i][2] * xv[rr][i][2] + xv[rr][i][3] * xv[rr][i][3];
                rstd[rr] = rsqrtf(wave_sum(ss) * (1.0f / 2048.0f) + RMS_EPS); }
#pragma unroll
            for (int i = 0; i < 8; ++i) { const int col = i * 256 + lane * 4; const f32x4 gg = *(const f32x4*)(p.in[I_GFFN] + col), s1 = *(const f32x4*)(sc + col), s0 = *(const f32x4*)(sh + col);
#pragma unroll
                for (int rr = 0; rr < 2; ++rr) { float hv[4], lo[4]; const int r = wid * 2 + rr;
#pragma unroll
                    for (int j = 0; j < 4; ++j) hv[j] = xv[rr][i][j] * rstd[rr] * gg[j] * (1.0f + s1[j]) + s0[j];
                    u32x2 wh; wh.x = cvt_pk_bf16(hv[0], hv[1]); wh.y = cvt_pk_bf16(hv[2], hv[3]);
                    lo[0] = hv[0] - bf_lo(wh.x); lo[1] = hv[1] - bf_hi(wh.x); lo[2] = hv[2] - bf_lo(wh.y); lo[3] = hv[3] - bf_hi(wh.y);
                    u32x2 wl; wl.x = cvt_pk_bf16(lo[0], lo[1]); wl.y = cvt_pk_bf16(lo[2], lo[3]);
                    const int ad = r * 4096 + ((((i * 32 + (lane >> 1)) ^ r)) * 16) + (lane & 1) * 8;
                    *(LAS u32x2*)(AH + ad) = wh; *(LAS u32x2*)(AL + ad) = wl;
                    *(unsigned*)(p.ws + WS_H8 + (size_t)(tb + rr) * DM + col) = pack_fp8x4(hv[0], hv[1], hv[2], hv[3]); } }
            __syncthreads();
            {
                const int kq = wid & 3, ng = wid >> 2, nb0 = ng * 3;
                f32x4 acc[3];
#pragma unroll
                for (int j = 0; j < 3; ++j) acc[j] = (f32x4){0.f, 0.f, 0.f, 0.f};
#pragma unroll 4
                for (int k16 = 0; k16 < 16; ++k16) { const int ks = kq * 16 + k16; const int ad = fr * 4096 + (((ks * 4 + fq) ^ fr) * 16);
                    const bf16x8 ah = *(const LAS bf16x8*)(AH + ad), al = *(const LAS bf16x8*)(AL + ad);
#pragma unroll
                    for (int j = 0; j < 3; ++j) { const int nb = nb0 + j; if (nb < 5) {
                        const bf16x8 wh = *(const bf16x8*)(WH + (size_t)(nb * 16 + fr) * DM + ks * 32 + fq * 8), wl = *(const bf16x8*)(WL + (size_t)(nb * 16 + fr) * DM + ks * 32 + fq * 8);
                        acc[j] = __builtin_amdgcn_mfma_f32_16x16x32_bf16(wh, ah, acc[j], 0, 0, 0); acc[j] = __builtin_amdgcn_mfma_f32_16x16x32_bf16(wl, ah, acc[j], 0, 0, 0); acc[j] = __builtin_amdgcn_mfma_f32_16x16x32_bf16(wh, al, acc[j], 0, 0, 0); } } }
#pragma unroll
                for (int j = 0; j < 3; ++j) { const int nb = nb0 + j; if (nb < 5) *(LAS f32x4*)(slab + (kq * 16 + fr) * 80 + nb * 16 + fq * 4) = acc[j]; }
            }
            __syncthreads();
            for (int o = tid; o < 1280; o += NTHREADS) lg[o] = (slab[o] + slab[1280 + o]) + (slab[2560 + o] + slab[3840 + o]);
            __syncthreads();
            if (tid < 16) {
                const int t = t0 + tid; const LAS float* L = lg + tid * 80;
                float gl[8]; int gi = 0; float gm = -INFINITY;
#pragma unroll
                for (int g = 0; g < 8; ++g) { gl[g] = L[g] + p.in[I_BRG][g]; if (gl[g] > gm) { gm = gl[g]; gi = g; } }
                float se = 0.f;
#pragma unroll
                for (int g = 0; g < 8; ++g) se += __expf(gl[g] - gm);
                const float gwt = 1.0f / se;
                float v1 = -INFINITY, v2 = -INFINITY; int i1 = 0, i2 = 0;
                for (int e = 0; e < 8; ++e) { const float v = L[8 + gi * 8 + e] + p.in[I_BRE][gi * 8 + e];
                    if (v > v1) { v2 = v1; i2 = i1; v1 = v; i1 = e; } else if (v > v2) { v2 = v; i2 = e; } }
                const float e2 = __expf(v2 - v1); const float p1 = gwt / (1.0f + e2), p2 = gwt * e2 / (1.0f + e2);
                const int ea = gi * 8 + i1, eb = gi * 8 + i2;
                const int pa = atomicAdd(cnt + ea, 1); const int pb = atomicAdd(cnt + eb, 1);
                ltok[ea * LCAP + pa] = t; lw[ea * LCAP + pa] = p1;
                ltok[eb * LCAP + pb] = t | 0x10000; lw[eb * LCAP + pb] = p2;
            }
            __syncthreads();
        }
    }
}

#define MOE_GLOAD(dst, ptr) asm volatile("global_load_dwordx4 %0, %1, off nt" : "=v"(dst) : "v"(ptr) : "memory")
template <bool UP>
__device__ void moe_gemm(const Params& p, LAS unsigned char* lds, const int rep) {
    constexpr int K = UP ? 2048 : 512, NKT = K / 32, NS = UP ? 8 : 16, LDW = UP ? 512 : 2048;
    constexpr int NSTA = 3, OFF_A = 0, OFF_B = NSTA * 16384;
    int tid = threadIdx.x; asm volatile("" : "+v"(tid));
    const int w = __builtin_amdgcn_readfirstlane(tid >> 6), l = tid & 63, r32 = l & 31, hi = l >> 5;
    LAS int* tab = (LAS int*)(lds + LDS_TAB);
    if (tid == 0) { const int* cnt = (const int*)(p.ws + WS_CNT); int s = 0, ro = 0; for (int e = 0; e < 64; ++e) { const int ce = cnt[e]; tab[e] = s; tab[80 + e] = ce; tab[160 + e] = ro; ro += ce; const int np = (ce + 511) >> 9; s += np > 0 ? np : 1; } tab[64] = s; }
    __syncthreads();
    const int total = __builtin_amdgcn_readfirstlane(tab[64]) * NS;
    const int q = (w & 3) * 8 + (l & 7), g = (w >> 2) * 8 + (l >> 3);
    const unsigned bwoff = (unsigned)(q * 256 + (((g >> 2) ^ (q & 3)) * 16) + (g & 3) * 4);
    const unsigned frag_sw = (unsigned)((r32 >> 2) & 3);
    const int* ltok = (const int*)(p.ws + WS_LTOK); const float* lw = (const float*)(p.ws + WS_LW);
    for (int unit = blockIdx.x; unit < total; unit += gridDim.x) {
        const int pm = unit / NS, ns = unit - pm * NS; int e = 0;
#pragma unroll 1
        for (int s = 32; s >= 1; s >>= 1) if (__builtin_amdgcn_readfirstlane(tab[e + s]) <= pm) e += s;
        const int mp = pm - __builtin_amdgcn_readfirstlane(tab[e]); const int cnt_e = __builtin_amdgcn_readfirstlane(tab[80 + e]), rowoff = __builtin_amdgcn_readfirstlane(tab[160 + e]);
        int nrows = cnt_e - mp * 512; nrows = nrows > 512 ? 512 : nrows; const bool two = nrows > 256;
        const char* abase = UP ? (const char*)(p.ws + WS_H8) : (const char*)(p.ws + WS_ACT8);
        unsigned aoff[2];
#pragma unroll
        for (int i = 0; i < 2; ++i) { const int row = (i * 8 + w) * 32 + (l >> 1); const int hs = (l & 1) ^ ((l >> 4) & 1);
            int src; if (UP) src = row < nrows ? (ltok[e * LCAP + mp * 512 + row] & 0xffff) : 0; else src = rowoff + mp * 512 + (row < nrows ? row : 0);
            aoff[i] = (unsigned)(src * K + hs * 16); }
        const float* bsrc = UP ? (q < 16 ? p.in[I_W1] : p.in[I_W3]) + (size_t)e * 2048 * 512 + ns * 64 + (q & 15) * 4 + (size_t)(2 * g) * LDW
                               : p.in[I_W2] + (size_t)e * 512 * 2048 + ns * 128 + q * 4 + (size_t)(2 * g) * LDW;
        f32x16 acc[2][4];
#pragma unroll
        for (int a = 0; a < 2; ++a)
#pragma unroll
            for (int b = 0; b < 4; ++b)
#pragma unroll
                for (int r = 0; r < 16; ++r) acc[a][b][r] = 0.f;
        f32x4 br[2][2];
#define MOE_ISSUE_B(j, t) do { const int tt_ = (t) < NKT ? (t) : NKT - 1; const float* bp_ = bsrc + (size_t)tt_ * 32 * LDW; MOE_GLOAD(br[j][0], bp_); MOE_GLOAD(br[j][1], bp_ + LDW); } while (0)
#define MOE_ISSUE_A(t, TWO) do { int tt_ = (t) < 0 ? 0 : (t); const int bi_ = (tt_ % NSTA); tt_ = tt_ < NKT ? tt_ : NKT - 1; const char* ap_ = abase + (size_t)tt_ * 32; \
        LAS unsigned char* ab_ = lds + OFF_A + bi_ * 16384 + w * 1024; \
        __builtin_amdgcn_global_load_lds((const unsigned*)(ap_ + aoff[0]), (LAS unsigned*)(ab_), 16, 0, 0); \
        if (TWO) __builtin_amdgcn_global_load_lds((const unsigned*)(ap_ + aoff[1]), (LAS unsigned*)(ab_ + 8192), 16, 0, 0); } while (0)
        const bool two_w = (256 + 32 * w) < nrows;
#define MOE_FRAGS(ks, TWO) do { const unsigned co_ = ((unsigned)((ks) * 2 + hi) ^ frag_sw) * 16u; \
            _Pragma("unroll") for (int nb = 0; nb < 4; ++nb) bf_[nb] = *(const LAS bf16x8*)(bb_ + nb * 2048 + co_); \
            { const unsigned ao_ = ((unsigned)(ks) ^ ((unsigned)(r32 >> 3) & 1u)) * 16u + (unsigned)hi * 8u; a0_ = fp8x8_to_bf16(*(const LAS u32x2*)(ab_ + ao_)); if (TWO) a1_ = fp8x8_to_bf16(*(const LAS u32x2*)(ab_ + 8192 + ao_)); } } while (0)
#define MOE_MMAS(TWO) do { \
            _Pragma("unroll") for (int nb = 0; nb < 4; ++nb) acc[0][nb] = __builtin_amdgcn_mfma_f32_32x32x16_bf16(bf_[nb], a0_, acc[0][nb], 0, 0, 0); \
            if (TWO) { _Pragma("unroll") for (int nb = 0; nb < 4; ++nb) acc[1][nb] = __builtin_amdgcn_mfma_f32_32x32x16_bf16(bf_[nb], a1_, acc[1][nb], 0, 0, 0); } } while (0)
#define MOE_ITER(jn, t, COMPUTE, TWO, WB, WA) do { \
        bf16x8 bf_[4], a0_, a1_; \
        const LAS unsigned char* ab_ = lds + OFF_A + (((t) + 3) % 3) * 16384 + w * 1024 + r32 * 32; const LAS unsigned char* bb_ = lds + OFF_B + ((t) & 1) * 8192 + r32 * 64; \
        if (COMPUTE) { MOE_FRAGS(0, TWO); } SBAR(); \
        asm volatile("s_waitcnt vmcnt(" WB ")" : "+v"(br[jn][0]), "+v"(br[jn][1]) :: "memory"); \
        { LAS unsigned char* bw_ = lds + OFF_B + (((t) + 1) & 1) * 8192 + bwoff; _Pragma("unroll") for (int jj = 0; jj < 4; ++jj) *(LAS unsigned*)(bw_ + jj * 64) = cvt_pk_bf16(br[jn][0][jj], br[jn][1][jj]); } \
        MOE_ISSUE_B(jn, (t) + 3); SBAR(); \
        if (COMPUTE) { MOE_MMAS(TWO); SBAR(); MOE_FRAGS(1, TWO); MOE_MMAS(TWO); } SBAR(); \
        asm volatile("s_waitcnt vmcnt(" WA ")" ::: "memory"); \
        asm volatile("s_waitcnt lgkmcnt(0)" ::: "memory"); __builtin_amdgcn_s_barrier(); asm volatile("" ::: "memory"); \
        MOE_ISSUE_A((t) + 3, TWO); \
        } while (0)
#define MOE_PIPE(TWO, WB, WA) do { \
        MOE_ISSUE_B(0, 0); MOE_ISSUE_A(0, TWO); MOE_ISSUE_B(1, 1); MOE_ISSUE_A(1, TWO); \
        MOE_ITER(0, -1, false, TWO, WB, WA); \
        _Pragma("unroll 1") for (int t = 0; t < NKT; t += 2) { MOE_ITER(1, t, true, TWO, WB, WA); MOE_ITER(0, t + 1, true, TWO, WB, WA); } \
          \
        asm volatile("s_waitcnt vmcnt(0)" : "+v"(br[0][0]), "+v"(br[0][1]), "+v"(br[1][0]), "+v"(br[1][1]) :: "memory"); \
        } while (0)
        if (two_w) MOE_PIPE(true, "6", "6"); else MOE_PIPE(false, "4", "5");
        asm volatile("s_waitcnt vmcnt(0)" ::: "memory");
        if constexpr (UP) {
#pragma unroll
            for (int mt = 0; mt < 2; ++mt) {
                const int rl = mt * 256 + 32 * w + r32;
                if (rl < nrows) {
                    const float gw = lw[e * LCAP + mp * 512 + rl] * 16.0f; unsigned char* orow = (unsigned char*)(p.ws + (rep ? WS_QLAT : WS_ACT8)) + (size_t)(rowoff + mp * 512 + rl) * 512 + ns * 64 + 4 * hi;
#pragma unroll
                    for (int nb = 0; nb < 2; ++nb)
#pragma unroll
                        for (int g4 = 0; g4 < 4; ++g4) { float o[4];
#pragma unroll
                            for (int j = 0; j < 4; ++j) { const float a = acc[mt][nb][g4 * 4 + j], u = acc[mt][nb + 2][g4 * 4 + j]; o[j] = a * sigmoidf_(a) * u * gw; }
                            *(unsigned*)(orow + nb * 32 + g4 * 8) = pack_fp8x4(o[0], o[1], o[2], o[3]); }
                }
            }
        } else {
#pragma unroll
            for (int mt = 0; mt < 2; ++mt) {
                const int rl = mt * 256 + 32 * w + r32;
                if (rl < nrows) {
                    const int ent = ltok[e * LCAP + mp * 512 + rl]; bf16_t* orow = (bf16_t*)(p.ws + WS_YS) + ((size_t)(ent >> 16) * NTOK + (ent & 0xffff)) * 2048 + ns * 128 + 4 * hi;
#pragma unroll
                    for (int nb = 0; nb < 4; ++nb)
#pragma unroll
                        for (int g4 = 0; g4 < 4; ++g4) { u32x2 pk; pk.x = cvt_pk_bf16(acc[mt][nb][g4 * 4] * 0.0625f, acc[mt][nb][g4 * 4 + 1] * 0.0625f); pk.y = cvt_pk_bf16(acc[mt][nb][g4 * 4 + 2] * 0.0625f, acc[mt][nb][g4 * 4 + 3] * 0.0625f); *(u32x2*)(orow + nb * 32 + g4 * 8) = pk; }
                }
            }
        }
        asm volatile("s_waitcnt vmcnt(0)" ::: "memory");
        __syncthreads();
    }
#undef MOE_ISSUE_A
#undef MOE_ISSUE_B
#undef MOE_ITER
#undef MOE_FRAGS
#undef MOE_MMAS
#undef MOE_PIPE
}


__device__ void ph11_combine(const Params& p) {
    const bf16_t* Y0 = (const bf16_t*)(p.ws + WS_YS); const bf16_t* Y1 = Y0 + (size_t)NTOK * 2048; const bf16_t* YM = (const bf16_t*)(p.ws + WS_MERGED); const float* mod = (const float*)(p.ws + WS_MOD);
    const size_t n8 = (size_t)NTOK * 2048 / 8;
    for (size_t i = (size_t)blockIdx.x * NTHREADS + threadIdx.x; i < n8; i += (size_t)gridDim.x * NTHREADS) {
        const size_t e0 = i * 8; const int col = (int)(e0 & 2047), b = (int)(e0 >> 22);
        const u32x4 a = *(const u32x4*)(Y0 + e0), c = *(const u32x4*)(Y1 + e0), m = *(const u32x4*)(YM + e0);
        const float* gt = mod + (size_t)b * 12288 + 10240 + col; const f32x4 g0 = *(const f32x4*)gt, g1 = *(const f32x4*)(gt + 4);
        const float* px = p.in[I_X] + e0; f32x4 o0 = *(const f32x4*)px, o1 = *(const f32x4*)(px + 4);
        o0[0] += bf_lo(m.x) + g0[0] * (bf_lo(a.x) + bf_lo(c.x)); o0[1] += bf_hi(m.x) + g0[1] * (bf_hi(a.x) + bf_hi(c.x)); o0[2] += bf_lo(m.y) + g0[2] * (bf_lo(a.y) + bf_lo(c.y)); o0[3] += bf_hi(m.y) + g0[3] * (bf_hi(a.y) + bf_hi(c.y));
        o1[0] += bf_lo(m.z) + g1[0] * (bf_lo(a.z) + bf_lo(c.z)); o1[1] += bf_hi(m.z) + g1[1] * (bf_hi(a.z) + bf_hi(c.z)); o1[2] += bf_lo(m.w) + g1[2] * (bf_lo(a.w) + bf_lo(c.w)); o1[3] += bf_hi(m.w) + g1[3] * (bf_hi(a.w) + bf_hi(c.w));
        float* po = p.out + e0; *(f32x4*)po = o0; *(f32x4*)(po + 4) = o1;
    }
}

__global__ void __launch_bounds__(NTHREADS, 2) mk_fwd(Params p) {
    extern __shared__ __attribute__((aligned(16))) unsigned char shm[];
    LAS unsigned char* lds = (LAS unsigned char*)shm;
    const int lo = p.ph_lo, hi = p.ph_hi;
    if (threadIdx.x < 4) ((LAS unsigned*)(lds + LDS_BARW))[threadIdx.x] = 0u;
    __syncthreads();
    XcdBarrier bar; bar.bar = (unsigned*)(p.ws + WS_BAR); bar.x = 0; bar.st = nullptr;
    if (hi - lo > 1) bar = xcd_barrier_post((unsigned*)(p.ws + WS_BAR), (volatile LAS unsigned*)(lds + LDS_BARW));
#ifndef SKIP_MASK
#define SKIP_MASK 0
#endif
#define IN(k) (!((SKIP_MASK >> (k)) & 1) && lo <= (k) && (k) < hi)
#define SEAM(k) do { if (IN(k) && IN((k) + 1)) xcd_barrier(bar); } while (0)
    const int G = gridDim.x, bx = blockIdx.x;
#ifndef REP_PHASE
#define REP_PHASE 0
#endif
#define RUN(k, ...) do { if (IN(k)) { { const int rep = 0; (void)rep; __VA_ARGS__ } if ((REP_PHASE >> (k)) & 1) { xcd_barrier(bar); { const int rep = 1; (void)rep; __VA_ARGS__ } } } SEAM(k); } while (0)
    RUN(0, ph0_prologue(p, lds););
    RUN(1, ph1_norm(p););
    RUN(2, EpiProj E{p.ws, p.in[I_BGATE]};
           { ProjOrder S; S.S.init(p.ws + WS_H, p.ws + WS_WIN + (size_t)2 * 256 * DM * 2, NTOK, 8 * 256, DM * 2, G, bx); S.fp8 = 0; S.Bfull = nullptr;
             pg8::gemm_phase<EpiProj, ProjOrder, false, false>(lds, DM * 2, S, E); }
           { ProjOrder S; S.S.init(p.ws + WS_HF8, p.ws + WS_WIN8, NTOK, 30 * 256, DM, G, (G - 1) - bx); S.fp8 = 1; S.Bfull = nullptr;
             pg8::gemm_phase<EpiProj, ProjOrder, false, true>(lds, DM, S, E, 0x79797979); });
    RUN(3, ph3_prep(p, lds, rep););
    RUN(4, ph4_attn(p, lds););
    RUN(5, DualOrder S; S.S0.init(p.ws + WS_OA8, p.ws + WS_WPA8, NTOK, DM, 1024, G, bx); S.S1.init(p.ws + WS_OB8, p.ws + WS_WPB8, NTOK, DM, 1024, G, bx);
           EpiGate12 E{EpiGate1{(const bf16_t*)(p.ws + WS_GATES), (float*)(p.ws + WS_T1)}, EpiGate2{(const bf16_t*)(p.ws + WS_GATES), (const float*)(p.ws + WS_T1), (bf16_t*)(p.ws + WS_MRG8)}};
           pg8::gemm_phase<EpiGate12, DualOrder, false, true>(lds, 1024, S, E, 0x79797979, 0x7c7c7c7c););
    RUN(6, pg8::StaticOrder S; S.init(p.ws + WS_MRG8, p.ws + WS_WO8, NTOK, DM, DM, G, bx); EpiWo E{(const float*)(p.ws + WS_MOD), (bf16_t*)(p.ws + WS_MERGED)};
           pg8::gemm_phase<EpiWo, pg8::StaticOrder, false, true>(lds, DM, S, E, 0x79797979, 0x7d7d7d7d););
    RUN(7, ph8_router(p, lds, rep););
    RUN(8, moe_gemm<true>(p, lds, rep););
    RUN(9, moe_gemm<false>(p, lds, rep););
    RUN(10, if (!rep) ph11_combine(p););
#undef RUN
#undef IN
#undef SEAM
}

constexpr int NPHASES = 11;
extern "C" void kernel_launch(void* const* d_in, const int* in_sizes, int n_in, void* d_out, int out_size, void* d_ws, size_t ws_size, hipStream_t stream) {
    static int grid = 0;
    if (grid == 0) {
        if (n_in != 25 || in_sizes[0] != NTOK * DM || out_size != NTOK * DM || ws_size < WS_END6) {
            fprintf(stderr, "kernel_launch: shape mismatch: n_in %d in0 %d out %d ws %zu (need %zu)\n", n_in, n_in > 0 ? in_sizes[0] : -1, out_size, ws_size, (size_t)WS_END6); grid = -1; return; }
        int dev = 0, cus = 0, per_cu = 0;
        if (hipGetDevice(&dev) != hipSuccess || hipDeviceGetAttribute(&cus, hipDeviceAttributeMultiprocessorCount, dev) != hipSuccess) { fprintf(stderr, "kernel_launch: device query failed\n"); grid = -1; return; }
        if (hipFuncSetAttribute((const void*)mk_fwd, hipFuncAttributeMaxDynamicSharedMemorySize, LDS_BYTES) != hipSuccess) { fprintf(stderr, "kernel_launch: hipFuncSetAttribute failed\n"); grid = -1; return; }
        if (hipOccupancyMaxActiveBlocksPerMultiprocessor(&per_cu, (const void*)mk_fwd, NTHREADS, LDS_BYTES) != hipSuccess || per_cu < 1) { fprintf(stderr, "kernel_launch: occupancy query says %d blocks per CU\n", per_cu); }
        (void)hipGetLastError();
        grid = cus;
    }
    if (grid < 0) return;
    if (hipMemsetAsync((char*)d_ws + WS_BAR, 0, WS_ZERO_BYTES, stream) != hipSuccess) { fprintf(stderr, "kernel_launch: memset failed\n"); return; }
    Params p; memset(&p, 0, sizeof(p));
    for (int i = 0; i < 25; ++i) p.in[i] = (const float*)d_in[i];
    p.out = (float*)d_out; p.ws = (unsigned char*)d_ws;
    unsigned char* ws = (unsigned char*)d_ws;
    auto job = [&](int j, const float* src, size_t dst_off, int K, int N, int ldd, int map, int nbatch, long sbatch, long dbatch) {
        TJob& J = p.jobs[j]; J.src = src; J.dst = (bf16_t*)(ws + dst_off); J.K = K; J.N = N; J.ldd = ldd; J.map = map; J.ntk = K / 64; J.ntn = (N + 127) / 128; J.nbatch = nbatch; J.sbatch = sbatch; J.dbatch = dbatch; J.ld = N; J.fp8 = 0; };
    job(0, p.in[I_WIN] + 512, WS_WIN, 2048, 1872, 2048, 4, 1, 0, 0); p.jobs[0].ld = DIN;
    job(1, p.in[I_WIN] + 5456, WS_WIN, 2048, 8, 2048, 5, 1, 0, 0); p.jobs[1].ld = DIN;
    job(2, p.in[I_WUK], WS_WUK, 128, 256, 128, 0, 8, 128L * 256, 256L * 128);
    job(3, p.in[I_WUV], WS_WUV, 256, 128, 256, 0, 8, 256L * 128, 128L * 256);
    job(4, p.in[I_WIN], WS_WIN8, 2048, 512, 2048, 0, 1, 0, 0); job(5, p.in[I_WIN] + 2384, WS_WIN8 + (size_t)512 * 2048, 2048, 3072, 2048, 0, 1, 0, 0); job(6, p.in[I_WIN] + 5464, WS_WIN8 + (size_t)3584 * 2048, 2048, 4096, 2048, 0, 1, 0, 0);
    for (int j = 4; j < 7; ++j) { p.jobs[j].ld = DIN; p.jobs[j].fp8 = 1; }
    job(7, p.in[I_WO], WS_WO8, 2048, 2048, 2048, 0, 1, 0, 0); p.jobs[7].fp8 = 1;
    job(8, p.in[I_WPA], WS_WPA8, 1024, 2048, 1024, 0, 1, 0, 0); p.jobs[8].fp8 = 1; job(9, p.in[I_WPB], WS_WPB8, 1024, 2048, 1024, 0, 1, 0, 0); p.jobs[9].fp8 = 1;
    int t0 = 0; for (int j = 0; j < NJOBS; ++j) { p.jobs[j].tile0 = t0; t0 += p.jobs[j].ntk * p.jobs[j].ntn * p.jobs[j].nbatch; }
    p.ntiles_total = t0;
#if MK_LAUNCHES == 1
    p.ph_lo = 0; p.ph_hi = NPHASES;
    hipLaunchKernelGGL(mk_fwd, dim3(grid), dim3(NTHREADS), LDS_BYTES, stream, p);
#else
    for (int k = 0; k < NPHASES; ++k) { p.ph_lo = k; p.ph_hi = k + 1; hipLaunchKernelGGL(mk_fwd, dim3(grid), dim3(NTHREADS), LDS_BYTES, stream, p); }
#endif
    const hipError_t le = hipPeekAtLastError();
    if (le != hipSuccess) fprintf(stderr, "kernel_launch: launch failed: %s\n", hipGetErrorName(le));
}
```

```cpp
#include <hip/hip_runtime.h>
#include <cstdio>
#include <cstdint>
#include <cstring>

#ifndef MK_LAUNCHES
#define MK_LAUNCHES 1
#endif

#define LAS __attribute__((address_space(3)))
typedef unsigned short bf16_t;
typedef short bf16x8 __attribute__((ext_vector_type(8)));
typedef short s16x4 __attribute__((ext_vector_type(4)));
typedef float f32x4 __attribute__((ext_vector_type(4)));
typedef float f32x16 __attribute__((ext_vector_type(16)));
typedef unsigned u32x4 __attribute__((ext_vector_type(4)));
typedef unsigned u32x2 __attribute__((ext_vector_type(2)));

constexpr int DM = 2048, NBATCH = 4, SEQ = 2048, NTOK = NBATCH * SEQ;
constexpr int DIN = 9560, DINP = 9728;
constexpr int NEXP = 64, DEXP = 512, LCAP = 8192;
constexpr float RMS_EPS = 1e-6f;
constexpr float LOG2E = 1.4426950408889634f;
constexpr int NTHREADS = 512;
constexpr int LDS_BYTES = 163840 - 1024;
constexpr int LDS_BARW = LDS_BYTES - 16;
constexpr int LDS_TAB = 131072;

constexpr size_t al256(size_t x) { return (x + 255) / 256 * 256; }
constexpr size_t WS_BAR = 0;
constexpr size_t WS_CNT = 16384;
constexpr size_t WS_ZERO_BYTES = 16384 + 4096;
constexpr size_t WS_MOD = WS_ZERO_BYTES;
constexpr size_t WS_H = al256(WS_MOD + (size_t)4 * 12288 * 4);
constexpr size_t WS_WIN = al256(WS_H + (size_t)NTOK * DM * 2);
constexpr size_t WS_WPA = al256(WS_WIN + (size_t)DINP * DM * 2);
constexpr size_t WS_WPB = al256(WS_WPA + (size_t)2048 * 1024 * 2);
constexpr size_t WS_WO = al256(WS_WPB + (size_t)2048 * 1024 * 2);
constexpr size_t WS_WUK = al256(WS_WO + (size_t)2048 * 2048 * 2);
constexpr size_t WS_WUV = al256(WS_WUK + (size_t)8 * 256 * 128 * 2);
constexpr size_t WS_W13 = al256(WS_WUV + (size_t)8 * 128 * 256 * 2);
constexpr size_t WS_W2 = al256(WS_W13 + (size_t)64 * 1024 * 2048 * 2);
constexpr size_t WS_QA = al256(WS_W2 + (size_t)64 * 2048 * 512 * 2);
constexpr size_t WS_CKV = al256(WS_QA + (size_t)NTOK * 1024 * 2);
constexpr size_t WS_KV = al256(WS_CKV + (size_t)NTOK * 256 * 4);
constexpr size_t WS_QIDX = al256(WS_KV + (size_t)NTOK * 256 * 2);
constexpr size_t WS_MISC = al256(WS_QIDX + (size_t)NTOK * 1024 * 2);
constexpr size_t WS_QB = al256(WS_MISC + (size_t)NTOK * 256 * 4);
constexpr size_t WS_KB = al256(WS_QB + (size_t)NTOK * 1024 * 2);
constexpr size_t WS_VB = al256(WS_KB + (size_t)NTOK * 1024 * 2);
constexpr size_t WS_GATES = al256(WS_VB + (size_t)NTOK * 1024 * 2);
constexpr size_t WS_QLAT = al256(WS_GATES + (size_t)NTOK * 4096 * 2);
constexpr size_t WS_MASK = al256(WS_QLAT + (size_t)NTOK * 2048 * 2);
constexpr size_t WS_CUM = al256(WS_MASK + (size_t)NTOK * 256);
constexpr size_t WS_OLAT = al256(WS_CUM + (size_t)4 * 8 * 2048 * 4);
constexpr size_t WS_OA = al256(WS_OLAT + (size_t)NTOK * 2048 * 2);
constexpr size_t WS_OB = al256(WS_OA + (size_t)NTOK * 1024 * 2);
constexpr size_t WS_T1 = al256(WS_OB + (size_t)NTOK * 1024 * 2);
constexpr size_t WS_MERGED = al256(WS_T1 + (size_t)NTOK * 2048 * 4);
constexpr size_t WS_LTOK = al256(WS_MERGED + (size_t)NTOK * 2048 * 2);
constexpr size_t WS_LW = al256(WS_LTOK + (size_t)NEXP * LCAP * 4);
constexpr size_t WS_ACT = al256(WS_LW + (size_t)NEXP * LCAP * 4);
constexpr size_t WS_HLO = al256(WS_ACT + (size_t)32768 * 512 * 2);
constexpr size_t WS_WRH = al256(WS_HLO + (size_t)NTOK * DM * 2);
constexpr size_t WS_WRL = al256(WS_WRH + (size_t)80 * DM * 2);
constexpr size_t WS_END = al256(WS_WRL + (size_t)80 * DM * 2);
constexpr size_t WS_KIDX = WS_END;
constexpr size_t WS_END2 = al256(WS_KIDX + (size_t)NTOK * 64 * 2);
constexpr size_t WS_H8 = WS_END2;
constexpr size_t WS_ACT8 = al256(WS_H8 + (size_t)NTOK * DM);
constexpr size_t WS_END3 = al256(WS_ACT8 + (size_t)16384 * 512);
constexpr size_t WS_HF8 = WS_END3;
constexpr size_t WS_WIN8 = al256(WS_HF8 + (size_t)NTOK * DM);
constexpr size_t WS_END4 = al256(WS_WIN8 + (size_t)7680 * DM);
constexpr size_t WS_MRG8 = WS_END4;
constexpr size_t WS_WO8 = al256(WS_MRG8 + (size_t)NTOK * DM);
constexpr size_t WS_END5 = al256(WS_WO8 + (size_t)2048 * 2048);
constexpr size_t WS_OA8 = WS_END5;
constexpr size_t WS_OB8 = al256(WS_OA8 + (size_t)NTOK * 1024);
constexpr size_t WS_WPA8 = al256(WS_OB8 + (size_t)NTOK * 1024);
constexpr size_t WS_WPB8 = al256(WS_WPA8 + (size_t)2048 * 1024);
constexpr size_t WS_END6 = al256(WS_WPB8 + (size_t)2048 * 1024);
constexpr size_t WS_YS = WS_T1;
constexpr size_t WS_HG = WS_QA;
static_assert(WS_HG + (size_t)32768 * DM * 2 <= WS_QLAT, "hg alias must fit in the dead region");

struct TJob { const float* src; bf16_t* dst; int K, N, ldd, map, ntk, ntn, nbatch, tile0; long sbatch, dbatch; int ld, fp8; };
constexpr int NJOBS = 10;
struct Params {
    const float* in[25];
    float* out;
    unsigned char* ws;
    TJob jobs[NJOBS];
    int ntiles_total;
    int ph_lo, ph_hi;
};
enum { I_X = 0, I_C, I_WADA, I_BADA, I_GMIX, I_WIN, I_BGATE, I_BFORGET, I_WUK, I_WUV, I_GQA, I_GKV, I_GQB, I_GKB, I_WPA, I_WPB, I_WO, I_GFFN, I_WRG, I_BRG, I_WRE, I_BRE, I_W1, I_W3, I_W2 };

__device__ __forceinline__ unsigned cvt_pk_bf16(float lo, float hi) { unsigned r; asm volatile("v_cvt_pk_bf16_f32 %0, %1, %2" : "=v"(r) : "v"(lo), "v"(hi)); return r; }
__device__ __forceinline__ float bf_lo(unsigned w) { return __uint_as_float(w << 16); }
__device__ __forceinline__ float bf_hi(unsigned w) { return __uint_as_float(w & 0xffff0000u); }
typedef float f32x2 __attribute__((ext_vector_type(2)));
__device__ __forceinline__ unsigned pack_fp8x4(float a, float b, float c, float d) { int w = __builtin_amdgcn_cvt_pk_fp8_f32(a, b, 0, false); w = __builtin_amdgcn_cvt_pk_fp8_f32(c, d, w, true); return (unsigned)w; }
__device__ __forceinline__ bf16x8 fp8x8_to_bf16(u32x2 v) {
    const f32x2 a = __builtin_amdgcn_cvt_pk_f32_fp8((int)v.x, false), b = __builtin_amdgcn_cvt_pk_f32_fp8((int)v.x, true), c = __builtin_amdgcn_cvt_pk_f32_fp8((int)v.y, false), d = __builtin_amdgcn_cvt_pk_f32_fp8((int)v.y, true);
    u32x4 w; w.x = cvt_pk_bf16(a.x, a.y); w.y = cvt_pk_bf16(b.x, b.y); w.z = cvt_pk_bf16(c.x, c.y); w.w = cvt_pk_bf16(d.x, d.y); return *reinterpret_cast<bf16x8*>(&w); }
__device__ __forceinline__ unsigned pack_u8x4(float a, float b, float c, float d) {
    unsigned w = 0; w = __builtin_amdgcn_cvt_pk_u8_f32(a * 255.f + 0.5f, 0, w); w = __builtin_amdgcn_cvt_pk_u8_f32(b * 255.f + 0.5f, 1, w); w = __builtin_amdgcn_cvt_pk_u8_f32(c * 255.f + 0.5f, 2, w); w = __builtin_amdgcn_cvt_pk_u8_f32(d * 255.f + 0.5f, 3, w); return w; }
__device__ __forceinline__ f32x4 unpack_u8x4(unsigned w) { return (f32x4){(float)(w & 0xffu), (float)((w >> 8) & 0xffu), (float)((w >> 16) & 0xffu), (float)(w >> 24)} * (1.0f / 255.0f); }
__device__ __forceinline__ float wave_sum(float v) {
#pragma unroll
    for (int o = 32; o >= 1; o >>= 1) v += __shfl_xor(v, o);
    return v;
}
__device__ __forceinline__ float sigmoidf_(float x) { return __builtin_amdgcn_rcpf(1.0f + __builtin_amdgcn_exp2f(-1.4426950408889634f * x)); }
__device__ __forceinline__ int crow(int r, int hi) { return (r & 3) + 8 * (r >> 2) + 4 * hi; }
#define SBAR() __builtin_amdgcn_sched_barrier(0)

#define XB_TMO      128
#define XB_XCNT(j)  (256  + 64 * (j))
#define XB_XSUB(j)  (1280 + 64 * (j))
#define XB_XGEN(j)  (2304 + 64 * (j))
#define XB_TOP      3328
#define XB_TOPGEN   3392
#define XCD_BAR_WORDS 3456
#define XB_SPIN_CAP (1u << 20)
__device__ __forceinline__ unsigned xb_ld(unsigned* p)              { return __hip_atomic_load(p, __ATOMIC_RELAXED, __HIP_MEMORY_SCOPE_AGENT); }
__device__ __forceinline__ unsigned xb_add(unsigned* p, unsigned v) { return __hip_atomic_fetch_add(p, v, __ATOMIC_RELAXED, __HIP_MEMORY_SCOPE_AGENT); }
__device__ __forceinline__ unsigned xb_xcc_id() { return (unsigned)__builtin_amdgcn_s_getreg((3 << 11) | 20) & 0xFu; }
#define XB_SPIN(cond, bar) do { unsigned _sp = 0; while (cond) { __builtin_amdgcn_s_sleep(1); \
    if ((++_sp & 255u) == 0u) { if (xb_ld(&(bar)[XB_TMO])) break; if (_sp > XB_SPIN_CAP) { atomicAdd(&(bar)[XB_TMO], 1u); break; } } } } while (0)
struct XcdBarrier { unsigned* bar; unsigned x; volatile LAS unsigned* st; };
__device__ __forceinline__ XcdBarrier xcd_barrier_post(unsigned* bar, volatile LAS unsigned* st) {
    XcdBarrier b; b.bar = bar; b.x = xb_xcc_id(); b.st = st;
    if (threadIdx.x == 0) (void)xb_add(&bar[XB_XCNT(b.x)], 1u);
    return b;
}
__device__ __forceinline__ void xcd_barrier_complete(unsigned* bar, unsigned x, unsigned& nloc, unsigned& nx) {
    const unsigned G = gridDim.x * gridDim.y * gridDim.z;
    unsigned sum, cnt, mine, sp = 0u;
    for (;;) {
        sum = 0u; cnt = 0u; mine = 0u;
#pragma unroll
        for (unsigned j = 0; j < 16; ++j) { const unsigned c = xb_ld(&bar[XB_XCNT(j)]); sum += c; cnt += (c > 0u) ? 1u : 0u; mine = (j == x) ? c : mine; }
        if (sum == G) break;
        __builtin_amdgcn_s_sleep(1);
        if ((++sp & 255u) == 0u) { if (xb_ld(&bar[XB_TMO])) break; if (sp > XB_SPIN_CAP) { atomicAdd(&bar[XB_TMO], 1u); break; } }
    }
    nloc = mine > 0u ? mine : 1u; nx = cnt > 0u ? cnt : 1u;
}
__device__ __forceinline__ void xcd_barrier(const XcdBarrier& b) {
    asm volatile("s_waitcnt vmcnt(0)" ::: "memory");
    __syncthreads();
    if (threadIdx.x == 0) {
        unsigned* bar = b.bar;
        __builtin_amdgcn_s_waitcnt(0);
        unsigned nloc = b.st[0], nx = b.st[1];
        if (nloc == 0u) { xcd_barrier_complete(bar, b.x, nloc, nx); b.st[0] = nloc; b.st[1] = nx; }
        const unsigned old = xb_add(&bar[XB_XSUB(b.x)], 1u);
        const unsigned gen = old / nloc;
        if (old + 1u == (gen + 1u) * nloc) {
            __builtin_amdgcn_fence(__ATOMIC_RELEASE, "agent");
            asm volatile("s_waitcnt vmcnt(0)" ::: "memory");
            const unsigned og = xb_add(&bar[XB_TOP], 1u);
            const unsigned tg = og / nx;
            if (og + 1u == (tg + 1u) * nx) xb_add(&bar[XB_TOPGEN], 1u);
            else XB_SPIN(xb_ld(&bar[XB_TOPGEN]) == tg, bar);
            __builtin_amdgcn_fence(__ATOMIC_ACQUIRE, "agent");
            xb_add(&bar[XB_XGEN(b.x)], 1u);
            asm volatile("s_waitcnt vmcnt(0)" ::: "memory");
        } else {
            XB_SPIN(xb_ld(&bar[XB_XGEN(b.x)]) == gen, bar);
            __builtin_amdgcn_fence(__ATOMIC_ACQUIRE, "agent");
            asm volatile("s_waitcnt vmcnt(0)" ::: "memory");
        }
    }
    __syncthreads();
}

namespace pg8 {
constexpr int BM = 256, BK = 64, HALF = 128, HTB = HALF * BK * 2, STAGE_BYTES = 8 * HTB, NXCD = 8, WGM = 8;
__host__ __device__ __forceinline__ int lds_byte(int r, int c) { const int st = (r >> 4) * 2 + (c >> 5), rr = r & 15, cc = c & 31, ob = rr * 64 + cc * 2; return st * 1024 + (ob ^ (((ob >> 9) & 1) << 5)); }
__host__ __device__ __forceinline__ void stage_rc(int b, int& R, int& C) { const int st = b / 1024, sb = b % 1024, swz = sb ^ (((sb >> 9) & 1) << 5); R = (st >> 1) * 16 + swz / 64; C = (st & 1) * 32 + (swz % 64) / 2; }
__host__ __device__ __forceinline__ int perm32(int rho) { const int n = rho >> 4, i = rho & 15; return 8 * (i >> 2) + 4 * n + (i & 3); }

struct Unit { int pm, pn; const char* a; const char* b; const int* gi; int nvalid; int aux; };

struct StaticOrder {
    int nM, nN, nwg, G, c, RS; const char* A; const char* Bt;
    __device__ void init(const void* A_, const void* Bt_, int M, int N, int RS_, int G_, int c_) { A = (const char*)A_; Bt = (const char*)Bt_; RS = RS_; nM = M / BM; nN = N / BM; nwg = nM * nN; G = G_; c = c_; }
    __device__ bool next(int i, Unit& u) const {
        const long L = (long)i * G + c; if (L >= nwg) return false;
        int wgid = (int)L; { const int q = nwg / NXCD, r = nwg % NXCD, xcd = wgid % NXCD, off = wgid / NXCD; wgid = (xcd < r ? xcd * (q + 1) : r * (q + 1) + (xcd - r) * q) + off; }
        const int nig = WGM * nN, gid = wgid / nig, fm = gid * WGM, gsz = (nM - fm) < WGM ? (nM - fm) : WGM;
        u.pm = fm + ((wgid % nig) % gsz); u.pn = (wgid % nig) / gsz;
        u.a = A + (size_t)u.pm * BM * RS; u.b = Bt + (size_t)u.pn * BM * RS; u.gi = nullptr; u.nvalid = BM; u.aux = 0; return true;
    }
};

typedef int i32x8 __attribute__((ext_vector_type(8)));
typedef int i32x4v __attribute__((ext_vector_type(4)));
template <class Epi, class Sched, bool GATHER, bool FP8 = false>
__device__ __forceinline__ void gemm_phase(LAS unsigned char* lds, const int RS, const Sched& S, const Epi& E, const int scale_b = 0x7f7f7f7f, const int scale_a = 0x7f7f7f7f) {
    int tid = threadIdx.x; asm volatile("" : "+v"(tid));
    const int wid = __builtin_amdgcn_readfirstlane(tid >> 6), lane = tid & 63, wr = wid >> 2, wc = wid & 3, fr = lane & 15, fq = lane >> 4;
    const int nt = RS / (BK * 2); const int K = RS;
    unsigned voffA[2], voffB[2]; int RA[2], CA[2];
#pragma unroll
    for (int i = 0; i < 2; ++i) { int R, C; stage_rc(tid * 16 + i * 8192, R, C); const int Rb = ((R & ~31) + perm32(R & 31));
        RA[i] = R; CA[i] = C; voffA[i] = (unsigned)(R * RS + C * 2); voffB[i] = (unsigned)(Rb * RS + C * 2); }
    const size_t kstep = (size_t)(BK * 2);
    const size_t hstep = (size_t)HALF * RS;
    const unsigned ldsw = (unsigned)wid * 1024u;
    const int aoff = lds_byte(wr * 64 + fr, fq * 8), boff = lds_byte(wc * 32 + fr, fq * 8);
    unsigned gA[2][2], gN[2][2];
#define PG8_SA(b, h) (((b) * 2 + (h)) * HTB)
#define PG8_SB(b, h) ((4 + (b) * 2 + (h)) * HTB)
#define PG8_STAGE(bufoff, gbase, voff) do { _Pragma("unroll") for (int _i = 0; _i < 2; ++_i) \
        __builtin_amdgcn_global_load_lds((const unsigned*)((const char*)(gbase) + (voff)[_i]), (LAS unsigned*)(lds + (bufoff) + ldsw + _i * 8192), 16, 0, 0); } while (0)
#define PG8_STAGE_A(bufoff, gp, h, NX) do { if constexpr (GATHER) { if (NX) PG8_STAGE(bufoff, gp, gN[h]); else PG8_STAGE(bufoff, gp, gA[h]); } else PG8_STAGE(bufoff, (gp) + (h) * hstep, voffA); } while (0)
#define PG8_LD8(p_) __builtin_shufflevector(*(const LAS i32x4v*)(p_), *(const LAS i32x4v*)((p_) + 1024), 0, 1, 2, 3, 4, 5, 6, 7)
#define PG8_LDA(dst, b, h) do { if constexpr (FP8) { _Pragma("unroll") for (int m = 0; m < 4; ++m) dst##8[m] = PG8_LD8(lds + PG8_SA(b, h) + aoff + m * 2048); } \
        else { _Pragma("unroll") for (int m = 0; m < 4; ++m) _Pragma("unroll") for (int k = 0; k < 2; ++k) dst[m][k] = *(const LAS bf16x8*)(lds + PG8_SA(b, h) + aoff + m * 2048 + k * 1024); } } while (0)
#define PG8_LDB(dst, b, h) do { if constexpr (FP8) { _Pragma("unroll") for (int n = 0; n < 2; ++n) dst##8[n] = PG8_LD8(lds + PG8_SB(b, h) + boff + n * 2048); } \
        else { _Pragma("unroll") for (int n = 0; n < 2; ++n) _Pragma("unroll") for (int k = 0; k < 2; ++k) dst[n][k] = *(const LAS bf16x8*)(lds + PG8_SB(b, h) + boff + n * 2048 + k * 1024); } } while (0)
#define PG8_MMA(ai, bj, At, Bt) do { __builtin_amdgcn_s_setprio(1); \
        if constexpr (FP8) { _Pragma("unroll") for (int m = 0; m < 4; ++m) _Pragma("unroll") for (int n = 0; n < 2; ++n) \
            asm volatile("v_mfma_scale_f32_16x16x128_f8f6f4 %0, %1, %2, %0, %3, %4 op_sel_hi:[0,0,0]" : "+v"(acc[ai][bj][m][n]) : "v"(Bt##8[n]), "v"(At##8[m]), "v"(sc_b), "v"(sc_a)); } \
        else { _Pragma("unroll") for (int m = 0; m < 4; ++m) _Pragma("unroll") for (int n = 0; n < 2; ++n) _Pragma("unroll") for (int k = 0; k < 2; ++k) \
            acc[ai][bj][m][n] = __builtin_amdgcn_mfma_f32_16x16x32_bf16(Bt[n][k], At[m][k], acc[ai][bj][m][n], 0, 0, 0); } \
        __builtin_amdgcn_s_setprio(0); } while (0)
#define PG8_WAIT_V(n) asm volatile("s_waitcnt vmcnt(" #n ")" ::: "memory")
#define PG8_WAIT_L(n) asm volatile("s_waitcnt lgkmcnt(" #n ")" ::: "memory")
#define PG8_BAR __builtin_amdgcn_s_barrier()
#define PG8_SCHED __builtin_amdgcn_sched_barrier(0)
#define PG8_GIDX(dst, u) do { if constexpr (GATHER) { _Pragma("unroll") for (int h = 0; h < 2; ++h) _Pragma("unroll") for (int i = 0; i < 2; ++i) { \
        const int rr = h * HALF + RA[i]; const int tok = rr < (u).nvalid ? (u).gi[rr] : 0; dst[h][i] = (unsigned)(tok * K + CA[i] * 2); } } } while (0)
    Unit cur, nxt; int ui = 0;
    if (!S.next(0, cur)) return;
    f32x4 acc[2][2][4][2];
#pragma unroll
    for (int a = 0; a < 2; ++a)
#pragma unroll
        for (int b = 0; b < 2; ++b)
#pragma unroll
            for (int m = 0; m < 4; ++m)
#pragma unroll
                for (int n = 0; n < 2; ++n) acc[a][b][m][n] = (f32x4){0.f, 0.f, 0.f, 0.f};
    const int sc_b = scale_b, sc_a = scale_a;
    bf16x8 At[4][2], B0[2][2], B1[2][2]; i32x8 At8[4], B08[2], B18[2];
    const char* cA = cur.a; const char* cB = cur.b;
    PG8_GIDX(gA, cur);
    PG8_STAGE(PG8_SB(0, 0), cB, voffB); PG8_STAGE_A(PG8_SA(0, 0), cA, 0, false); PG8_STAGE(PG8_SB(0, 1), cB + hstep, voffB); PG8_STAGE_A(PG8_SA(0, 1), cA, 1, false);
    if (wr == 1) PG8_BAR;
    PG8_WAIT_V(4); PG8_BAR;
    PG8_STAGE(PG8_SB(1, 0), cB + kstep, voffB); PG8_STAGE_A(PG8_SA(1, 0), cA + kstep, 0, false); PG8_STAGE(PG8_SB(1, 1), cB + hstep + kstep, voffB);
    PG8_WAIT_V(6); PG8_BAR;
    for (;;) {
        const bool has_next = S.next(ui + 1, nxt);
        const char* nA = has_next ? nxt.a : cA; const char* nB = has_next ? nxt.b : cB;
        if constexpr (GATHER) { if (has_next) { PG8_GIDX(gN, nxt); } else {
#pragma unroll
            for (int h = 0; h < 2; ++h)
#pragma unroll
                for (int i = 0; i < 2; ++i) gN[h][i] = gA[h][i]; } }
        for (int t = 0; t < nt; t += 2) {
            const bool last = (t == nt - 2);
            const char* a1 = cA + (size_t)(t + 1) * kstep;
            const char* a2 = last ? nA : cA + (size_t)(t + 2) * kstep; const char* b2 = last ? nB : cB + (size_t)(t + 2) * kstep;
            const char* a3 = a2 + kstep; const char* b3 = b2 + kstep;
            PG8_LDB(B0, 0, 0); PG8_SCHED; PG8_LDA(At, 0, 0); PG8_STAGE_A(PG8_SA(1, 1), a1, 1, false);
            PG8_WAIT_L(8); PG8_BAR; PG8_WAIT_L(0); PG8_MMA(0, 0, At, B0); PG8_BAR; PG8_SCHED;
            PG8_LDB(B1, 0, 1); PG8_STAGE(PG8_SB(0, 0), b2, voffB);
            PG8_BAR; PG8_WAIT_L(0); PG8_MMA(0, 1, At, B1); PG8_BAR;
            PG8_LDA(At, 0, 1); PG8_STAGE_A(PG8_SA(0, 0), a2, 0, last);
            PG8_BAR; PG8_WAIT_L(0); PG8_MMA(1, 0, At, B0); PG8_BAR; PG8_SCHED;
            PG8_STAGE(PG8_SB(0, 1), b2 + hstep, voffB);
            PG8_WAIT_V(6); PG8_BAR; PG8_MMA(1, 1, At, B1); PG8_BAR;
            PG8_LDB(B0, 1, 0); PG8_SCHED; PG8_LDA(At, 1, 0); PG8_STAGE_A(PG8_SA(0, 1), a2, 1, last);
            PG8_WAIT_L(8); PG8_BAR; PG8_WAIT_L(0); PG8_MMA(0, 0, At, B0); PG8_BAR; PG8_SCHED;
            PG8_LDB(B1, 1, 1); PG8_STAGE(PG8_SB(1, 0), b3, voffB);
            PG8_BAR; PG8_WAIT_L(0); PG8_MMA(0, 1, At, B1); PG8_BAR;
            PG8_LDA(At, 1, 1); PG8_STAGE_A(PG8_SA(1, 0), a3, 0, last);
            PG8_BAR; PG8_WAIT_L(0); PG8_MMA(1, 0, At, B0); PG8_BAR; PG8_SCHED;
            PG8_STAGE(PG8_SB(1, 1), b3 + hstep, voffB);
            PG8_WAIT_V(6); PG8_BAR; PG8_MMA(1, 1, At, B1); PG8_BAR;
        }
        bool keep_acc = false;
        if constexpr (FP8) asm volatile("s_nop 15\n\ts_nop 15" ::: "memory");
        if constexpr (Epi::DUAL) { if (cur.aux) { E.mid(acc, cur, wr, wc, fr, fq); keep_acc = true; } else E(acc, cur, wr, wc, fr, fq); } else E(acc, cur, wr, wc, fr, fq);
        if (!has_next) break;
        if (!keep_acc)
#pragma unroll
        for (int a = 0; a < 2; ++a)
#pragma unroll
            for (int b = 0; b < 2; ++b)
#pragma unroll
                for (int m = 0; m < 4; ++m)
#pragma unroll
                    for (int n = 0; n < 2; ++n) acc[a][b][m][n] = (f32x4){0.f, 0.f, 0.f, 0.f};
        cur = nxt; cA = nA; cB = nB; ++ui;
        if constexpr (GATHER) {
#pragma unroll
            for (int h = 0; h < 2; ++h)
#pragma unroll
                for (int i = 0; i < 2; ++i) gA[h][i] = gN[h][i]; }
    }
    PG8_WAIT_V(0);
    if (wr == 0) PG8_BAR;
    PG8_BAR;
#undef PG8_SA
#undef PG8_SB
#undef PG8_STAGE
#undef PG8_STAGE_A
#undef PG8_LDA
#undef PG8_LD8
#undef PG8_LDB
#undef PG8_MMA
#undef PG8_WAIT_V
#undef PG8_WAIT_L
#undef PG8_BAR
#undef PG8_SCHED
#undef PG8_GIDX
}
}
using pg8::Unit;

#define EPI_LOOP(...) { int fr_ = fr, fq_ = fq; asm volatile("" : "+v"(fr_), "+v"(fq_)); _Pragma("unroll") for (int ai = 0; ai < 2; ++ai) _Pragma("unroll") for (int m = 0; m < 4; ++m) _Pragma("unroll") for (int bj = 0; bj < 2; ++bj) { \
        const int trow = ai * 128 + wr * 64 + m * 16 + fr_; const int tcol = bj * 128 + wc * 32 + fq_ * 8; const f32x4 v0 = acc[ai][bj][m][0], v1 = acc[ai][bj][m][1]; __VA_ARGS__ } }

__device__ __forceinline__ u32x4 pack8(const f32x4 a, const f32x4 b) { u32x4 w; w.x = cvt_pk_bf16(a[0], a[1]); w.y = cvt_pk_bf16(a[2], a[3]); w.z = cvt_pk_bf16(b[0], b[1]); w.w = cvt_pk_bf16(b[2], b[3]); return w; }

struct EpiProj { static constexpr bool DUAL = false;
    unsigned char* ws; const float* b_gate;
    __device__ __forceinline__ void operator()(const f32x4 (&acc)[2][2][4][2], const Unit& u, int wr, int wc, int fr, int fq) const {
        const int pn = u.pn; const size_t row0 = (size_t)u.pm * 256;
        if (pn == 4 || pn == 9) {
            float* dst = (float*)(ws + (pn == 4 ? WS_CKV : WS_MISC));
            EPI_LOOP({ float* p = dst + (row0 + trow) * 256 + tcol; *(f32x4*)p = v0; *(f32x4*)(p + 4) = v1;
                if (pn == 9 && tcol < 64) *(u32x4*)((bf16_t*)(ws + WS_KIDX) + (row0 + trow) * 64 + tcol) = pack8(v0, v1); })
        } else if (pn < 22) {
            bf16_t* dst; int ct;
            if (pn < 4) { dst = (bf16_t*)(ws + WS_QA); ct = pn; } else if (pn < 9) { dst = (bf16_t*)(ws + WS_QIDX); ct = pn - 5; }
            else if (pn < 14) { dst = (bf16_t*)(ws + WS_QB); ct = pn - 10; } else if (pn < 18) { dst = (bf16_t*)(ws + WS_KB); ct = pn - 14; } else { dst = (bf16_t*)(ws + WS_VB); ct = pn - 18; }
            EPI_LOOP({ *(u32x4*)(dst + (row0 + trow) * 1024 + ct * 256 + tcol) = pack8(v0, v1); })
        } else {
            bf16_t* dst = (bf16_t*)(ws + WS_GATES); const int ct = pn - 22;
            EPI_LOOP({ const int col = ct * 256 + tcol; const f32x4 b0 = *(const f32x4*)(b_gate + col), b1 = *(const f32x4*)(b_gate + col + 4); f32x4 s0, s1;
                _Pragma("unroll") for (int j = 0; j < 4; ++j) { s0[j] = sigmoidf_(v0[j] + b0[j]); s1[j] = sigmoidf_(v1[j] + b1[j]); }
                u32x2 w8; w8.x = pack_u8x4(s0[0], s0[1], s0[2], s0[3]); w8.y = pack_u8x4(s1[0], s1[1], s1[2], s1[3]); *(u32x2*)((unsigned char*)dst + (row0 + trow) * 4096 + col) = w8; })
        }
    }
};
struct EpiGate1 { static constexpr bool DUAL = false;
    const bf16_t* gates; bf16_t* T1;
    __device__ __forceinline__ void operator()(const f32x4 (&acc)[2][2][4][2], const Unit& u, int wr, int wc, int fr, int fq) const {
        EPI_LOOP({ const size_t row = (size_t)u.pm * 256 + trow; const int col = u.pn * 256 + tcol; const u32x2 g = *(const u32x2*)((const unsigned char*)gates + row * 4096 + col);
            const f32x4 o0 = v0 * unpack_u8x4(g.x), o1 = v1 * unpack_u8x4(g.y);
            *(u32x4*)(T1 + row * 2048 + col) = pack8(o0, o1); })
    }
};
struct EpiGate2 { static constexpr bool DUAL = false;
    const bf16_t* gates; const bf16_t* T1; unsigned char* merged;
    __device__ __forceinline__ void operator()(const f32x4 (&acc)[2][2][4][2], const Unit& u, int wr, int wc, int fr, int fq) const {
        EPI_LOOP({ const size_t row = (size_t)u.pm * 256 + trow; const int col = u.pn * 256 + tcol; const u32x2 g = *(const u32x2*)((const unsigned char*)gates + row * 4096 + 2048 + col);
            const u32x4 t = *(const u32x4*)(T1 + row * 2048 + col);
            const f32x4 o0 = (f32x4){bf_lo(t.x), bf_hi(t.x), bf_lo(t.y), bf_hi(t.y)} + v0 * unpack_u8x4(g.x), o1 = (f32x4){bf_lo(t.z), bf_hi(t.z), bf_lo(t.w), bf_hi(t.w)} + v1 * unpack_u8x4(g.y);
            u32x2 w8; w8.x = pack_fp8x4(o0[0] * 4.f, o0[1] * 4.f, o0[2] * 4.f, o0[3] * 4.f); w8.y = pack_fp8x4(o1[0] * 4.f, o1[1] * 4.f, o1[2] * 4.f, o1[3] * 4.f);
            *(u32x2*)(merged + row * 2048 + col) = w8; })
    }
};
struct EpiWo { static constexpr bool DUAL = false;
    const float* mod; bf16_t* y;
    __device__ __forceinline__ void operator()(const f32x4 (&acc)[2][2][4][2], const Unit& u, int wr, int wc, int fr, int fq) const {
        const float* gt = mod + (size_t)(u.pm >> 3) * 12288 + 4096;
        EPI_LOOP({ const size_t row = (size_t)u.pm * 256 + trow; const int col = u.pn * 256 + tcol;
            const f32x4 g0 = *(const f32x4*)(gt + col), g1 = *(const f32x4*)(gt + col + 4);
            *(u32x4*)(y + row * 2048 + col) = pack8(g0 * v0, g1 * v1); })
    }
};
struct DualOrder {
    pg8::StaticOrder S0, S1;
    __device__ bool next(int i, Unit& u) const { const bool ok = (i & 1) ? S1.next(i >> 1, u) : S0.next(i >> 1, u); u.aux = (i & 1) ? 0 : 1; return ok; }
};
struct EpiGate12 { static constexpr bool DUAL = false;
    EpiGate1 e1; EpiGate2 e2;
    __device__ __forceinline__ void operator()(const f32x4 (&acc)[2][2][4][2], const Unit& u, int wr, int wc, int fr, int fq) const { if (u.aux) e1(acc, u, wr, wc, fr, fq); else e2(acc, u, wr, wc, fr, fq); }
};

struct ProjOrder {
    pg8::StaticOrder S; int fp8; const char* Bfull;
    __device__ bool next(int i, Unit& u) const {
        if (!S.next(i, u)) return false;
        if (fp8) { if (u.pn >= 2) u.pn += 8; } else u.pn += 2;
        return true;
    }
};
__device__ __forceinline__ int map_row(int map, int n) {
    if (map == 0) return n;
    if (map == 1) { if (n < 2384) return n; if (n < 5456) return n + 176; if (n < 5464) return n - 3072; return n + 168; }
    if (map == 4) return n + 512;
    return n + 2384;
}
__device__ void ph0_prologue(const Params& p, LAS unsigned char* lds) {
    const int tid = threadIdx.x, wid = tid >> 6, lane = tid & 63, G = gridDim.x, bx = blockIdx.x;
    if (bx < 192) {
        LAS float* sc = (LAS float*)lds;
        LAS float* red = (LAS float*)(lds + 32768);
        const float* c = p.in[I_C];
        for (int i = tid; i < 4 * 2048; i += NTHREADS) { const float v = c[i]; sc[i] = v / (1.0f + __expf(-v)); }
        __syncthreads();
        for (int item = bx; item < 192; item += G) {
            const int n0 = item * 64, cg = lane & 15, rs = lane >> 4;
            float acc[4][4];
#pragma unroll
            for (int b = 0; b < 4; ++b)
#pragma unroll
                for (int j = 0; j < 4; ++j) acc[b][j] = 0.f;
            const float* w = p.in[I_WADA] + n0 + cg * 4;
#pragma unroll 4
            for (int step = 0; step < 64; ++step) {
                const int k = step * 32 + wid * 4 + rs;
                const f32x4 wv = *(const f32x4*)(w + (size_t)k * 12288);
#pragma unroll
                for (int b = 0; b < 4; ++b) { const float s = sc[b * 2048 + k];
#pragma unroll
                    for (int j = 0; j < 4; ++j) acc[b][j] += s * wv[j]; }
            }
#pragma unroll
            for (int b = 0; b < 4; ++b)
#pragma unroll
                for (int j = 0; j < 4; ++j) { float v = acc[b][j]; v += __shfl_xor(v, 16); v += __shfl_xor(v, 32); acc[b][j] = v; }
            if (rs == 0) {
#pragma unroll
                for (int b = 0; b < 4; ++b)
#pragma unroll
                    for (int j = 0; j < 4; ++j) red[(wid * 16 + cg) * 16 + b * 4 + j] = acc[b][j]; }
            __syncthreads();
            if (tid < 256) { const int cg2 = tid >> 4, bj = tid & 15, b = bj >> 2, j = bj & 3; float s = 0.f;
#pragma unroll
                for (int w8 = 0; w8 < 8; ++w8) s += red[(w8 * 16 + cg2) * 16 + bj];
                const int n = n0 + cg2 * 4 + j; ((float*)(p.ws + WS_MOD))[b * 12288 + n] = s + p.in[I_BADA][n]; }
            __syncthreads();
        }
    }
    { u32x4* z = (u32x4*)(p.ws + WS_WIN + (size_t)2392 * 2048 * 2); const int n16 = 168 * 2048 * 2 / 16;
      for (int i = bx * NTHREADS + tid; i < n16; i += G * NTHREADS) z[i] = (u32x4){0u, 0u, 0u, 0u}; }
    { bf16_t* wh = (bf16_t*)(p.ws + WS_WRH); bf16_t* wl = (bf16_t*)(p.ws + WS_WRL);
      for (int i = bx * NTHREADS + tid; i < 80 * 2048; i += G * NTHREADS) { const int n = i >> 11, k = i & 2047;
          const float v = n < 8 ? p.in[I_WRG][k * 8 + n] : (n < 72 ? p.in[I_WRE][k * 64 + n - 8] : 0.f);
          const unsigned h = cvt_pk_bf16(v, 0.f) & 0xffffu; const unsigned l = cvt_pk_bf16(v - bf_lo(h), 0.f) & 0xffffu; wh[i] = (bf16_t)h; wl[i] = (bf16_t)l; } }
    LAS float* tile = (LAS float*)(lds + 65536);
    for (int ti = bx; ti < p.ntiles_total; ti += G) {
        int j = 0;
#pragma unroll 1
        for (int q = 1; q < NJOBS; ++q) if (ti >= p.jobs[q].tile0) j = q;
        const TJob& J = p.jobs[j];
        int l = ti - J.tile0; const int per = J.ntk * J.ntn; const int bt = l / per; l -= bt * per; const int tn = l / J.ntk, tk = l % J.ntk;
        const float* src = J.src + (size_t)bt * J.sbatch; bf16_t* dst = J.dst + (size_t)bt * J.dbatch;
        const int k0 = tk * 64, n0 = tn * 128;
        f32x4 v[4];
#pragma unroll
        for (int i = 0; i < 4; ++i) { const int r = (tid >> 5) + 16 * i, c4 = (tid & 31) * 4;
            v[i] = (f32x4){0.f, 0.f, 0.f, 0.f}; if (n0 + c4 < J.N) v[i] = *(const f32x4*)(src + (size_t)(k0 + r) * J.ld + n0 + c4); }
#pragma unroll
        for (int i = 0; i < 4; ++i) { const int r = (tid >> 5) + 16 * i, c4 = (tid & 31) * 4;
#pragma unroll
            for (int q = 0; q < 4; ++q) tile[r * 129 + c4 + q] = v[i][q]; }
        __syncthreads();
        { const int n = tid >> 2, kq = (tid & 3) * 16;
          if (n0 + n < J.N) { float f[16];
#pragma unroll
              for (int q = 0; q < 16; ++q) f[q] = tile[(kq + q) * 129 + n];
              u32x4 w0, w1; w0.x = cvt_pk_bf16(f[0], f[1]); w0.y = cvt_pk_bf16(f[2], f[3]); w0.z = cvt_pk_bf16(f[4], f[5]); w0.w = cvt_pk_bf16(f[6], f[7]);
              w1.x = cvt_pk_bf16(f[8], f[9]); w1.y = cvt_pk_bf16(f[10], f[11]); w1.z = cvt_pk_bf16(f[12], f[13]); w1.w = cvt_pk_bf16(f[14], f[15]);
              if (J.fp8) { u32x4 w8; w8.x = pack_fp8x4(f[0] * 64.f, f[1] * 64.f, f[2] * 64.f, f[3] * 64.f); w8.y = pack_fp8x4(f[4] * 64.f, f[5] * 64.f, f[6] * 64.f, f[7] * 64.f);
                  w8.z = pack_fp8x4(f[8] * 64.f, f[9] * 64.f, f[10] * 64.f, f[11] * 64.f); w8.w = pack_fp8x4(f[12] * 64.f, f[13] * 64.f, f[14] * 64.f, f[15] * 64.f);
                  *(u32x4*)((unsigned char*)dst + (size_t)(n0 + n) * J.ldd + k0 + kq) = w8; }
              else { bf16_t* d = dst + (size_t)map_row(J.map, n0 + n) * J.ldd + k0 + kq; *(u32x4*)d = w0; *(u32x4*)(d + 8) = w1; } } }
        __syncthreads();
    }
}

__device__ __forceinline__ void norm_row(const float* xr, const float* g, const float* sh, const float* sc, bf16_t* hr, unsigned char* h8, int lane, float (&hv)[32]) {
    f32x4 v[8]; float ss = 0.f;
#pragma unroll
    for (int i = 0; i < 8; ++i) { v[i] = *(const f32x4*)(xr + i * 256 + lane * 4); ss += v[i][0] * v[i][0] + v[i][1] * v[i][1] + v[i][2] * v[i][2] + v[i][3] * v[i][3]; }
    ss = wave_sum(ss);
    const float rstd = rsqrtf(ss * (1.0f / 2048.0f) + RMS_EPS);
#pragma unroll
    for (int i = 0; i < 8; ++i) { const int col = i * 256 + lane * 4; const f32x4 gg = *(const f32x4*)(g + col), s1 = *(const f32x4*)(sc + col), s0 = *(const f32x4*)(sh + col);
#pragma unroll
        for (int j = 0; j < 4; ++j) hv[i * 4 + j] = v[i][j] * rstd * gg[j] * (1.0f + s1[j]) + s0[j];
        u32x2 w; w.x = cvt_pk_bf16(hv[i * 4], hv[i * 4 + 1]); w.y = cvt_pk_bf16(hv[i * 4 + 2], hv[i * 4 + 3]); *(u32x2*)(hr + col) = w;
        if (h8) *(unsigned*)(h8 + col) = pack_fp8x4(hv[i * 4], hv[i * 4 + 1], hv[i * 4 + 2], hv[i * 4 + 3]); }
}
__device__ void ph1_norm(const Params& p) {
    const int lane = threadIdx.x & 63, gw = blockIdx.x * 8 + (threadIdx.x >> 6), nw = gridDim.x * 8;
    const float* mod = (const float*)(p.ws + WS_MOD);
    for (int t = gw; t < NTOK; t += nw) { const int b = t >> 11; float hv[32];
        norm_row(p.in[I_X] + (size_t)t * DM, p.in[I_GMIX], mod + b * 12288, mod + b * 12288 + 2048, (bf16_t*)(p.ws + WS_H) + (size_t)t * DM, (unsigned char*)(p.ws + WS_HF8) + (size_t)t * DM, lane, hv); }
}

template <int MB, int NB, int KS>
__device__ __forceinline__ void wave_gemm(const bf16_t* A, int lda, const bf16_t* Bt, int ldb, f32x4 (&acc)[MB][NB], int lane) {
    const int fr = lane & 15, fq = lane >> 4;
#pragma unroll
    for (int mb = 0; mb < MB; ++mb)
#pragma unroll
        for (int nb = 0; nb < NB; ++nb) acc[mb][nb] = (f32x4){0.f, 0.f, 0.f, 0.f};
#pragma unroll 1
    for (int ks = 0; ks < KS; ++ks) {
        bf16x8 af[MB];
#pragma unroll
        for (int mb = 0; mb < MB; ++mb) af[mb] = *(const bf16x8*)(A + (size_t)(mb * 16 + fr) * lda + ks * 32 + fq * 8);
#pragma unroll
        for (int nb = 0; nb < NB; ++nb) { const bf16x8 bf = *(const bf16x8*)(Bt + (size_t)(nb * 16 + fr) * ldb + ks * 32 + fq * 8);
#pragma unroll
            for (int mb = 0; mb < MB; ++mb) acc[mb][nb] = __builtin_amdgcn_mfma_f32_16x16x32_bf16(bf, af[mb], acc[mb][nb], 0, 0, 0); }
    }
}


__device__ __forceinline__ int wave_total_i32(int v) {
    v += __builtin_amdgcn_update_dpp(0, v, 0x111, 0xf, 0xf, true); v += __builtin_amdgcn_update_dpp(0, v, 0x112, 0xf, 0xf, true);
    v += __builtin_amdgcn_update_dpp(0, v, 0x114, 0xf, 0xf, true); v += __builtin_amdgcn_update_dpp(0, v, 0x118, 0xf, 0xf, true);
    v += __builtin_amdgcn_update_dpp(0, v, 0x142, 0xa, 0xf, false); v += __builtin_amdgcn_update_dpp(0, v, 0x143, 0xc, 0xf, false);
    return __builtin_amdgcn_readlane(v, 63);
}
template <int NI> __device__ __forceinline__ void topk_words2(const LAS float* srow0, const LAS float* srow1, int c, int lane, unsigned long long& w0, unsigned long long& w1) {
    unsigned ka[NI], kb[NI];
#pragma unroll
    for (int i = 0; i < NI; ++i) { unsigned u = 0u, x = 0u; if (i <= c) { u = __float_as_uint(srow0[i * 64 + lane]); u = (u & 0x80000000u) ? ~u : (u | 0x80000000u);
            x = __float_as_uint(srow1[i * 64 + lane]); x = (x & 0x80000000u) ? ~x : (x | 0x80000000u); } ka[i] = u; kb[i] = x; }
    unsigned va = 0u, vb = 0u; bool da = false, db = false;
#pragma unroll 1
    for (int bit = 31; bit >= 0; --bit) {
        const unsigned ca = va | (1u << bit), cb = vb | (1u << bit); int a0 = 0, a1 = 0, b0 = 0, b1 = 0;
#pragma unroll
        for (int i = 0; i < NI; i += 2) { a0 += (ka[i] >= ca) ? 1 : 0; a1 += (ka[i + 1] >= ca) ? 1 : 0; b0 += (kb[i] >= cb) ? 1 : 0; b1 += (kb[i + 1] >= cb) ? 1 : 0; }
        const int ta = wave_total_i32(a0 + a1), tb = wave_total_i32(b0 + b1);
        if (!da && ta >= 256) { va = ca; da = (ta == 256); }
        if (!db && tb >= 256) { vb = cb; db = (tb == 256); }
        if (da && db) break;
    }
    w0 = 0ull; w1 = 0ull;
#pragma unroll
    for (int i = 0; i < NI; ++i) { const unsigned long long ma = __ballot(ka[i] >= va), mb = __ballot(kb[i] >= vb); if (lane == i) { w0 = ma; w1 = mb; } if ((i & 3) == 3) SBAR(); }
}

__device__ void idx_item(const Params& p, LAS unsigned char* lds, int b, int c, int sub) {
    const int tid = threadIdx.x, wid = tid >> 6, lane = tid & 63, fr = lane & 15, fq = lane >> 4;
    constexpr int SCLD = 2052;
    LAS float* sc = (LAS float*)lds;
    const int q0 = c * 64 + sub * 16, nk = (c + 1) * 64, nkb = nk / 16;
    const bf16_t* qidx = (const bf16_t*)(p.ws + WS_QIDX) + (size_t)(b * SEQ + q0 + fr) * 1024;
    const float* misc = (const float*)(p.ws + WS_MISC);
    float wq[16];
    { const float* wp = misc + (size_t)(b * SEQ + q0 + fr) * 256 + 64;
#pragma unroll
      for (int i = 0; i < 4; ++i) { const f32x4 v = *(const f32x4*)(wp + i * 4); wq[i * 4] = v[0]; wq[i * 4 + 1] = v[1]; wq[i * 4 + 2] = v[2]; wq[i * 4 + 3] = v[3]; } }
#pragma unroll
    for (int hp = 0; hp < 2; ++hp) {
        bf16x8 qf[8][2];
#pragma unroll
        for (int h = 0; h < 8; ++h)
#pragma unroll
            for (int ks = 0; ks < 2; ++ks) qf[h][ks] = *(const bf16x8*)(qidx + (hp * 8 + h) * 64 + ks * 32 + fq * 8);
        const bf16_t* kbase = (const bf16_t*)(p.ws + WS_KIDX) + (size_t)(b * SEQ + fr) * 64 + fq * 8;
        bf16x8 kf[2];
        if (wid < nkb) { kf[0] = *(const bf16x8*)(kbase + (size_t)wid * 16 * 64); kf[1] = *(const bf16x8*)(kbase + (size_t)wid * 16 * 64 + 32); }
#pragma unroll 1
        for (int kb = wid; kb < nkb; kb += 8) {
            const int kn = kb + 8 < nkb ? kb + 8 : kb;
            const bf16x8 kn0 = *(const bf16x8*)(kbase + (size_t)kn * 16 * 64), kn1 = *(const bf16x8*)(kbase + (size_t)kn * 16 * 64 + 32);
            LAS f32x4* sp = (LAS f32x4*)(sc + fr * SCLD + kb * 16 + fq * 4);
            f32x4 s = {0.f, 0.f, 0.f, 0.f}; if (hp) s = *sp;
#pragma unroll
            for (int h = 0; h < 8; ++h) {
                f32x4 a = {0.f, 0.f, 0.f, 0.f};
                a = __builtin_amdgcn_mfma_f32_16x16x32_bf16(kf[0], qf[h][0], a, 0, 0, 0);
                a = __builtin_amdgcn_mfma_f32_16x16x32_bf16(kf[1], qf[h][1], a, 0, 0, 0);
#pragma unroll
                for (int j = 0; j < 4; ++j) s[j] += wq[hp * 8 + h] * fmaxf(a[j], 0.f);
            }
            *sp = s; kf[0] = kn0; kf[1] = kn1;
        }
    }
    __syncthreads();
    unsigned long long* mask = (unsigned long long*)(p.ws + WS_MASK);
    {
        const int ql = wid * 2; const size_t qg = (size_t)b * SEQ + q0 + ql;
        unsigned long long w0 = 0ull, w1 = 0ull;
        if (nk <= 256) { if (lane <= c) { w0 = ~0ull; w1 = ~0ull; } }
        else { const LAS float* s0 = sc + ql * SCLD; const LAS float* s1 = s0 + SCLD;
            if (c < 8) topk_words2<8>(s0, s1, c, lane, w0, w1); else if (c < 16) topk_words2<16>(s0, s1, c, lane, w0, w1);
            else if (c < 24) topk_words2<24>(s0, s1, c, lane, w0, w1); else topk_words2<32>(s0, s1, c, lane, w0, w1); }
        if (lane < 32) { mask[qg * 32 + lane] = w0; mask[(qg + 1) * 32 + lane] = w1; }
    }
    __syncthreads();
}
#ifndef REP_SUB
#define REP_SUB 15
#endif
__device__ void ph3_prep(const Params& p, LAS unsigned char* lds, const int rep) {
#define P3ON(bit) (!rep || ((REP_SUB) & (bit)))
    const int tid = threadIdx.x, wid = tid >> 6, lane = tid & 63, bx = blockIdx.x, G = gridDim.x;
    if (P3ON(1)) for (int it = bx; it < 256; it += G) {
        const int b = it >> 6, r = it & 63, cp = r >> 2, sub = r & 3;
        idx_item(p, lds, b, 31 - cp, sub); idx_item(p, lds, b, cp, sub);
    }
    const int gw = bx * 8 + wid, nw = G * 8;
    if (P3ON(2)) for (int it = gw; it < 2048; it += nw) {
        const int rt = it >> 3, h = it & 7, fr = lane & 15, fq = lane >> 4;
        f32x4 acc[2][16];
        wave_gemm<2, 16, 4>((const bf16_t*)(p.ws + WS_QA) + (size_t)rt * 32 * 1024 + h * 128, 1024, (const bf16_t*)(p.ws + WS_WUK) + (size_t)h * 256 * 128, 128, acc, lane);
#pragma unroll
        for (int mb = 0; mb < 2; ++mb) { float ss = 0.f;
#pragma unroll
            for (int nb = 0; nb < 16; ++nb)
#pragma unroll
                for (int j = 0; j < 4; ++j) ss += acc[mb][nb][j] * acc[mb][nb][j];
            ss += __shfl_xor(ss, 16); ss += __shfl_xor(ss, 32);
            const float rs = rsqrtf(ss * (1.0f / 256.0f) + RMS_EPS) * 0.0625f;
            bf16_t* o = (bf16_t*)(p.ws + WS_QLAT) + (size_t)(rt * 32 + mb * 16 + fr) * 2048 + h * 256;
#pragma unroll
            for (int nb = 0; nb < 16; ++nb) { const int col = nb * 16 + fq * 4; const f32x4 g = *(const f32x4*)(p.in[I_GQA] + col);
                u32x2 w; w.x = cvt_pk_bf16(acc[mb][nb][0] * rs * g[0], acc[mb][nb][1] * rs * g[1]); w.y = cvt_pk_bf16(acc[mb][nb][2] * rs * g[2], acc[mb][nb][3] * rs * g[3]); *(u32x2*)(o + col) = w; } }
    }
    if (P3ON(4))
#pragma unroll 4
    for (int t = gw; t < NTOK; t += nw) {
        { const f32x4 v = *(const f32x4*)((const float*)(p.ws + WS_CKV) + (size_t)t * 256 + lane * 4); float ss = wave_sum(v[0] * v[0] + v[1] * v[1] + v[2] * v[2] + v[3] * v[3]);
          const float rs = rsqrtf(ss * (1.0f / 256.0f) + RMS_EPS); const f32x4 g = *(const f32x4*)(p.in[I_GKV] + lane * 4);
          u32x2 w; w.x = cvt_pk_bf16(v[0] * rs * g[0], v[1] * rs * g[1]); w.y = cvt_pk_bf16(v[2] * rs * g[2], v[3] * rs * g[3]); *(u32x2*)((bf16_t*)(p.ws + WS_KV) + (size_t)t * 256 + lane * 4) = w; }
#pragma unroll
        for (int which = 0; which < 2; ++which) {
            bf16_t* row = (bf16_t*)(p.ws + (which ? WS_KB : WS_QB)) + (size_t)t * 1024 + lane * 16; const float* g = p.in[which ? I_GKB : I_GQB] + (lane & 7) * 16;
            u32x4 a = *(u32x4*)row, c2 = *(u32x4*)(row + 8); float f[16];
            f[0] = bf_lo(a.x); f[1] = bf_hi(a.x); f[2] = bf_lo(a.y); f[3] = bf_hi(a.y); f[4] = bf_lo(a.z); f[5] = bf_hi(a.z); f[6] = bf_lo(a.w); f[7] = bf_hi(a.w);
            f[8] = bf_lo(c2.x); f[9] = bf_hi(c2.x); f[10] = bf_lo(c2.y); f[11] = bf_hi(c2.y); f[12] = bf_lo(c2.z); f[13] = bf_hi(c2.z); f[14] = bf_lo(c2.w); f[15] = bf_hi(c2.w);
            float ss = 0.f;
#pragma unroll
            for (int j = 0; j < 16; ++j) ss += f[j] * f[j];
            ss += __shfl_xor(ss, 1); ss += __shfl_xor(ss, 2); ss += __shfl_xor(ss, 4);
            const float rs = rsqrtf(ss * (1.0f / 128.0f) + RMS_EPS) * (which ? 1.0f : 0.08838834764831845f);
#pragma unroll
            for (int j = 0; j < 16; ++j) f[j] *= rs * g[j];
            a.x = cvt_pk_bf16(f[0], f[1]); a.y = cvt_pk_bf16(f[2], f[3]); a.z = cvt_pk_bf16(f[4], f[5]); a.w = cvt_pk_bf16(f[6], f[7]);
            c2.x = cvt_pk_bf16(f[8], f[9]); c2.y = cvt_pk_bf16(f[10], f[11]); c2.z = cvt_pk_bf16(f[12], f[13]); c2.w = cvt_pk_bf16(f[14], f[15]);
            if (!rep) { *(u32x4*)row = a; *(u32x4*)(row + 8) = c2; } else if (a.x == 0x12345678u) *(u32x4*)row = c2;
        }
    }
    if (P3ON(8) && bx < NBATCH) {
        const int b = bx; const float* fp = (const float*)(p.ws + WS_MISC) + (size_t)(b * SEQ + 4 * tid) * 256 + 80;
        float ls[4][8];
#pragma unroll
        for (int j = 0; j < 4; ++j) { const f32x4 a = *(const f32x4*)(fp + j * 256), c4 = *(const f32x4*)(fp + j * 256 + 4);
#pragma unroll
            for (int h = 0; h < 8; ++h) { const float z = (h < 4 ? a[h & 3] : c4[h & 3]) + p.in[I_BFORGET][h]; ls[j][h] = fminf(z, 0.f) - log1pf(__expf(-fabsf(z))); } }
        LAS float* wt = (LAS float*)lds;
        float off[8];
#pragma unroll
        for (int h = 0; h < 8; ++h) { ls[1][h] += ls[0][h]; ls[2][h] += ls[1][h]; ls[3][h] += ls[2][h];
            float incl = ls[3][h];
#pragma unroll
            for (int o = 1; o < 64; o <<= 1) { const float t2 = __shfl_up(incl, o); if (lane >= o) incl += t2; }
            if (lane == 63) wt[wid * 8 + h] = incl;
            off[h] = incl - ls[3][h]; }
        __syncthreads();
#pragma unroll
        for (int h = 0; h < 8; ++h) { float wo = 0.f; for (int w8 = 0; w8 < wid; ++w8) wo += wt[w8 * 8 + h];
            float* cp = (float*)(p.ws + WS_CUM) + (size_t)(b * 8 + h) * SEQ + 4 * tid;
            *(f32x4*)cp = (f32x4){ls[0][h] + off[h] + wo, ls[1][h] + off[h] + wo, ls[2][h] + off[h] + wo, ls[3][h] + off[h] + wo}; }
        __syncthreads();
    }
}

template <int OFF> __device__ __forceinline__ s16x4 tr_read(int vb) { s16x4 r; asm volatile("ds_read_b64_tr_b16 %0, %1 offset:%2" : "=&v"(r) : "v"(vb), "i"(OFF) : "memory"); return r; }
__device__ __forceinline__ int v_rd_base(int lane) { return ((lane & 3) << 3) | (((lane >> 2) & 3) << 6) | (((lane >> 4) & 1) << 5) | (((lane >> 5) & 1) << 8); }
#define PK4(P, BASE, OUT) do { unsigned a0 = cvt_pk_bf16(P[BASE + 0], P[BASE + 1]), a1 = cvt_pk_bf16(P[BASE + 2], P[BASE + 3]);   \
    unsigned b0 = cvt_pk_bf16(P[BASE + 4], P[BASE + 5]), b1 = cvt_pk_bf16(P[BASE + 6], P[BASE + 7]);                              \
    auto r0 = __builtin_amdgcn_permlane32_swap(a0, b0, false, false); auto r1 = __builtin_amdgcn_permlane32_swap(a1, b1, false, false); \
    u32x4 w = {r0[0], r1[0], r0[1], r1[1]}; OUT = *reinterpret_cast<bf16x8*>(&w); } while (0)
#define PKV(L, H) (bf16x8){L[0], L[1], L[2], L[3], H[0], H[1], H[2], H[3]}
template <int NCB, int KS0, int D0> struct PvPairs { static __device__ __forceinline__ void run(f32x16* o, int vb, bf16x8 pa0, bf16x8 pa1) {
    constexpr int S = 2 * NCB * 512, H = NCB * 512;
    const s16x4 l00 = tr_read<D0 * 512 + KS0 * S>(vb), h00 = tr_read<D0 * 512 + KS0 * S + H>(vb), l01 = tr_read<D0 * 512 + (KS0 + 1) * S>(vb), h01 = tr_read<D0 * 512 + (KS0 + 1) * S + H>(vb);
    const s16x4 l10 = tr_read<(D0 + 1) * 512 + KS0 * S>(vb), h10 = tr_read<(D0 + 1) * 512 + KS0 * S + H>(vb), l11 = tr_read<(D0 + 1) * 512 + (KS0 + 1) * S>(vb), h11 = tr_read<(D0 + 1) * 512 + (KS0 + 1) * S + H>(vb);
    asm volatile("s_waitcnt lgkmcnt(0)" ::: "memory"); SBAR();
    o[D0] = __builtin_amdgcn_mfma_f32_32x32x16_bf16(pa0, PKV(l00, h00), o[D0], 0, 0, 0); o[D0 + 1] = __builtin_amdgcn_mfma_f32_32x32x16_bf16(pa0, PKV(l10, h10), o[D0 + 1], 0, 0, 0);
    o[D0] = __builtin_amdgcn_mfma_f32_32x32x16_bf16(pa1, PKV(l01, h01), o[D0], 0, 0, 0); o[D0 + 1] = __builtin_amdgcn_mfma_f32_32x32x16_bf16(pa1, PKV(l11, h11), o[D0 + 1], 0, 0, 0);
    if constexpr (D0 + 2 < NCB) PvPairs<NCB, KS0, D0 + 2>::run(o, vb, pa0, pa1); } };
__device__ __forceinline__ int swap23(int k) { return (k & ~0xC) | ((k & 4) << 1) | ((k & 8) >> 1); }
constexpr int FOX_STAGE = 33024;
constexpr int FOX_AL = 2 * FOX_STAGE, FOX_LI = FOX_AL + 1024;
__device__ void fox_item(const Params& p, LAS unsigned char* lds, int b, int h, int qb) {
    int tid = threadIdx.x; asm volatile("" : "+v"(tid));
    const int wid = __builtin_amdgcn_readfirstlane(tid >> 6), lane = tid & 63, r32 = lane & 31, hi = lane >> 5;
    const bf16_t* Q = (const bf16_t*)(p.ws + WS_QB);
    const char* Kg = (const char*)(p.ws + WS_KB) + ((size_t)b * SEQ * 1024 + h * 128) * 2; const char* Vg = (const char*)(p.ws + WS_VB) + ((size_t)b * SEQ * 1024 + h * 128) * 2;
    const float* cum = (const float*)(p.ws + WS_CUM) + (size_t)(b * 8 + h) * SEQ;
    const int qpos = qb * 256 + wid * 32 + r32;
    bf16x8 qr[8];
    { const bf16_t* qp = Q + (size_t)(b * SEQ + qpos) * 1024 + h * 128 + hi * 8;
#pragma unroll
      for (int d0 = 0; d0 < 8; ++d0) qr[d0] = *(const bf16x8*)(qp + d0 * 16); }
    const float cq = cum[qpos] * LOG2E;
    unsigned ksrc[2], vsrc[2];
#pragma unroll
    for (int i = 0; i < 2; ++i) { const int pos = (i * 512 + tid) * 16;
        { const int row = pos >> 8; const int cb = (pos & 255) ^ ((row & 7) << 4); ksrc[i] = (unsigned)(row * 2048 + cb); }
        { const int sub = pos >> 9, within = pos & 511; const int kk = (sub >> 2) * 8 + (within >> 6); const int c = (sub & 3) * 32 + ((within & 63) >> 1); vsrc[i] = (unsigned)(swap23(kk) * 2048 + c * 2); } }
    float m_reg = -1e30f, l_reg = 0.f; f32x16 o[4];
#pragma unroll
    for (int d = 0; d < 4; ++d)
#pragma unroll
        for (int r = 0; r < 16; ++r) o[d][r] = 0.f;
    LAS float* al_l = (LAS float*)(lds + FOX_AL) + wid * 32; LAS float* li_l = (LAS float*)(lds + FOX_LI) + wid * 32;
    const int ntiles = qb * 4 + 4, mylast = qb * 4 + (wid >> 1);
#define FOX_DMA(kt) do { LAS unsigned char* sb_ = lds + ((kt) & 1) * FOX_STAGE; const size_t go_ = (size_t)(kt) * 64 * 2048; \
        _Pragma("unroll") for (int i = 0; i < 2; ++i) { \
            __builtin_amdgcn_global_load_lds((const unsigned*)(Kg + go_ + ksrc[i]), (LAS unsigned*)(sb_ + 16384 + (i * 512 + wid * 64) * 16), 16, 0, 0); \
            __builtin_amdgcn_global_load_lds((const unsigned*)(Vg + go_ + vsrc[i]), (LAS unsigned*)(sb_ + (i * 512 + wid * 64) * 16), 16, 0, 0); } \
        if (wid == 0) __builtin_amdgcn_global_load_lds((const unsigned*)(cum + (kt) * 64 + lane), (LAS unsigned*)(sb_ + 32768), 4, 0, 0); } while (0)
    __syncthreads();
    FOX_DMA(0);
    for (int kt = 0; kt < ntiles; ++kt) {
        asm volatile("s_waitcnt vmcnt(0)" ::: "memory");
        __syncthreads();
        if (kt + 1 < ntiles) FOX_DMA(kt + 1);
        if (kt <= mylast) {
            const LAS unsigned char* sb = lds + (kt & 1) * FOX_STAGE; const LAS float* ck = (const LAS float*)(sb + 32768);
            const int vb = (int)(uintptr_t)sb + v_rd_base(lane);
            f32x16 p0, p1;
#pragma unroll
            for (int r = 0; r < 16; ++r) { p0[r] = 0.f; p1[r] = 0.f; }
            int fsw = (r32 & 7) << 4; asm volatile("" : "+v"(fsw));
#pragma unroll
            for (int d0 = 0; d0 < 8; ++d0) { const int cb = (d0 * 16 + hi * 8) * 2;
                const bf16x8 b0 = *(const LAS bf16x8*)(sb + 16384 + r32 * 256 + (cb ^ fsw));
                const bf16x8 b1 = *(const LAS bf16x8*)(sb + 16384 + (32 + r32) * 256 + (cb ^ fsw));
                p0 = __builtin_amdgcn_mfma_f32_32x32x16_bf16(b0, qr[d0], p0, 0, 0, 0); p1 = __builtin_amdgcn_mfma_f32_32x32x16_bf16(b1, qr[d0], p1, 0, 0, 0); }
            const bool diag = (kt * 64 + 63 > qb * 256 + wid * 32);
            float pmax = -INFINITY;
#pragma unroll
            for (int g4 = 0; g4 < 4; ++g4) { const f32x4 c0 = *(const LAS f32x4*)(ck + 8 * g4 + 4 * hi), c1 = *(const LAS f32x4*)(ck + 32 + 8 * g4 + 4 * hi);
#pragma unroll
                for (int j = 0; j < 4; ++j) { const int r = g4 * 4 + j; float t0 = fmaf(p0[r], LOG2E, cq) - c0[j] * LOG2E, t1 = fmaf(p1[r], LOG2E, cq) - c1[j] * LOG2E;
                    if (diag) { const int kp = kt * 64 + crow(r, hi); if (kp > qpos) t0 = -INFINITY; if (kp + 32 > qpos) t1 = -INFINITY; }
                    p0[r] = t0; p1[r] = t1; pmax = fmaxf(pmax, fmaxf(t0, t1)); } }
            { auto rr = __builtin_amdgcn_permlane32_swap(__float_as_uint(pmax), __float_as_uint(pmax), false, false); pmax = fmaxf(__uint_as_float(rr[0]), __uint_as_float(rr[1])); }
            const float mn = fmaxf(m_reg, pmax); const float alpha = __builtin_amdgcn_exp2f(m_reg - mn); m_reg = mn;
            float ps = 0.f;
#pragma unroll
            for (int r = 0; r < 16; ++r) { p0[r] = __builtin_amdgcn_exp2f(p0[r] - mn); p1[r] = __builtin_amdgcn_exp2f(p1[r] - mn); ps += p0[r] + p1[r]; }
            { auto rr = __builtin_amdgcn_permlane32_swap(__float_as_uint(ps), __float_as_uint(ps), false, false); ps = __uint_as_float(rr[0]) + __uint_as_float(rr[1]); }
            l_reg = l_reg * alpha + ps;
            if (__any(alpha < 1.f)) { if (hi == 0) al_l[r32] = alpha; asm volatile("s_waitcnt lgkmcnt(0)" ::: "memory");
#pragma unroll
                for (int r = 0; r < 16; ++r) { const float a = al_l[crow(r, hi)];
#pragma unroll
                    for (int d = 0; d < 4; ++d) o[d][r] *= a; } }
            bf16x8 pa0, pa1, pa2, pa3; PK4(p0, 0, pa0); PK4(p0, 8, pa1); PK4(p1, 0, pa2); PK4(p1, 8, pa3);
            PvPairs<4, 0, 0>::run(o, vb, pa0, pa1); PvPairs<4, 2, 0>::run(o, vb, pa2, pa3);
        }
    }
#undef FOX_DMA
    if (hi == 0) li_l[r32] = l_reg; asm volatile("s_waitcnt lgkmcnt(0)" ::: "memory");
    unsigned char* O8 = (unsigned char*)(p.ws + WS_OB8) + (size_t)(b * SEQ + qb * 256 + wid * 32) * 1024 + h * 128;
#pragma unroll
    for (int r = 0; r < 16; ++r) { const float rl = __builtin_amdgcn_rcpf(li_l[crow(r, hi)]); const int orow = crow(r, hi);
#pragma unroll
        for (int d0 = 0; d0 < 4; ++d0) O8[(size_t)orow * 1024 + d0 * 32 + r32] = (unsigned char)(pack_fp8x4(o[d0][r] * rl * 8.f, 0.f, 0.f, 0.f) & 0xffu); }
}

constexpr int DSA_STAGE = 32768;
constexpr int DSA_AL = 2 * DSA_STAGE, DSA_LI = DSA_AL + 1024, DSA_Q = DSA_LI + 1024;
__device__ void dsa_item(const Params& p, LAS unsigned char* lds, int b, int qt) {
    int tid = threadIdx.x; asm volatile("" : "+v"(tid));
    const int wid = __builtin_amdgcn_readfirstlane(tid >> 6), lane = tid & 63, r32 = lane & 31, hi = lane >> 5, h = wid;
    const char* KV = (const char*)(p.ws + WS_KV) + (size_t)b * SEQ * 512;
    const int qpos = qt * 32 + r32; const size_t qg = (size_t)b * SEQ + qpos;
    const unsigned* mask = (const unsigned*)(p.ws + WS_MASK) + qg * 64;
    bf16x8 qr[8];
    LAS unsigned char* qlds = lds + DSA_Q + wid * 8192 + lane * 16;
    __syncthreads();
    { const bf16_t* qp = (const bf16_t*)(p.ws + WS_QLAT) + qg * 2048 + h * 256 + hi * 8;
#pragma unroll
      for (int d0 = 0; d0 < 8; ++d0) qr[d0] = *(const bf16x8*)(qp + d0 * 16);
#pragma unroll
      for (int d0 = 8; d0 < 16; ++d0) *(LAS bf16x8*)(qlds + (d0 - 8) * 1024) = *(const bf16x8*)(qp + d0 * 16); }
    unsigned ksrc[2], vsrc[2];
#pragma unroll
    for (int i = 0; i < 2; ++i) { const int pos = (i * 512 + tid) * 16;
        { const int row = pos >> 9; const int cb = (pos & 511) ^ ((row & 15) << 4); ksrc[i] = (unsigned)(row * 512 + cb); }
        { const int sub = pos >> 9, within = pos & 511; const int kk = (sub >> 3) * 8 + (within >> 6); const int c = (sub & 7) * 32 + ((within & 63) >> 1); vsrc[i] = (unsigned)(swap23(kk) * 512 + c * 2); } }
    const float slopeL = exp2f(-(float)(h + 1)) * LOG2E;
    float m_reg = -1e30f, l_reg = 0.f; f32x16 o[8];
#pragma unroll
    for (int d = 0; d < 8; ++d)
#pragma unroll
        for (int r = 0; r < 16; ++r) o[d][r] = 0.f;
    LAS float* al_l = (LAS float*)(lds + DSA_AL) + wid * 32; LAS float* li_l = (LAS float*)(lds + DSA_LI) + wid * 32;
    const int ntiles = ((qt >> 1) + 1) * 2;
#define DSA_DMA(kt) do { LAS unsigned char* sb_ = lds + ((kt) & 1) * DSA_STAGE; const size_t go_ = (size_t)(kt) * 32 * 512; \
        _Pragma("unroll") for (int i = 0; i < 2; ++i) { \
            __builtin_amdgcn_global_load_lds((const unsigned*)(KV + go_ + ksrc[i]), (LAS unsigned*)(sb_ + 16384 + (i * 512 + wid * 64) * 16), 16, 0, 0); \
            __builtin_amdgcn_global_load_lds((const unsigned*)(KV + go_ + vsrc[i]), (LAS unsigned*)(sb_ + (i * 512 + wid * 64) * 16), 16, 0, 0); } } while (0)
    unsigned mw = mask[0];
    DSA_DMA(0);
    for (int kt = 0; kt < ntiles; ++kt) {
        asm volatile("s_waitcnt vmcnt(0)" ::: "memory");
        __syncthreads();
        const unsigned mcur = mw;
        if (kt + 1 < ntiles) { mw = mask[kt + 1]; DSA_DMA(kt + 1); }
        const LAS unsigned char* sb = lds + (kt & 1) * DSA_STAGE; const int vb = (int)(uintptr_t)sb + v_rd_base(lane);
        f32x16 pp;
#pragma unroll
        for (int r = 0; r < 16; ++r) pp[r] = 0.f;
        {
            const LAS unsigned char* kb_ = sb + 16384 + r32 * 512; int sw_ = (r32 & 15) << 4; asm volatile("" : "+v"(sw_));
#define DSA_KF(d0) (*(const LAS bf16x8*)(kb_ + ((((d0) * 16 + hi * 8) * 2) ^ sw_)))
#define DSA_QF(d0) ((d0) < 8 ? qr[(d0) & 7] : *(const LAS bf16x8*)(qlds + (((d0) - 8) & 7) * 1024))
            bf16x8 k0 = DSA_KF(0), k1 = DSA_KF(1), q0 = DSA_QF(0), q1 = DSA_QF(1);
#pragma unroll
            for (int d0 = 0; d0 < 16; d0 += 2) {
                bf16x8 nk0 = k0, nk1 = k1, nq0 = q0, nq1 = q1;
                if (d0 + 2 < 16) { nk0 = DSA_KF(d0 + 2); nk1 = DSA_KF(d0 + 3); nq0 = DSA_QF(d0 + 2); nq1 = DSA_QF(d0 + 3); }
                pp = __builtin_amdgcn_mfma_f32_32x32x16_bf16(k0, q0, pp, 0, 0, 0); pp = __builtin_amdgcn_mfma_f32_32x32x16_bf16(k1, q1, pp, 0, 0, 0);
                k0 = nk0; k1 = nk1; q0 = nq0; q1 = nq1; SBAR();
            }
#undef DSA_KF
#undef DSA_QF
        }
        const unsigned wsh = mcur >> (4 * hi);
        const float df = (float)(qpos - (kt * 32 + 4 * hi));
        float pmax = -INFINITY;
#pragma unroll
        for (int r = 0; r < 16; ++r) { const int cb = (r & 3) + 8 * (r >> 2); const float dd = df - (float)cb;
            float t = fmaf(-slopeL, fabsf(dd), pp[r] * LOG2E); if (!((wsh >> cb) & 1u)) t = -INFINITY; pp[r] = t; pmax = fmaxf(pmax, t); }
        { auto rr = __builtin_amdgcn_permlane32_swap(__float_as_uint(pmax), __float_as_uint(pmax), false, false); pmax = fmaxf(__uint_as_float(rr[0]), __uint_as_float(rr[1])); }
        const float mn = fmaxf(m_reg, pmax); const float alpha = __builtin_amdgcn_exp2f(m_reg - mn); m_reg = mn;
        float ps = 0.f;
#pragma unroll
        for (int r = 0; r < 16; ++r) { pp[r] = __builtin_amdgcn_exp2f(pp[r] - mn); ps += pp[r]; }
        { auto rr = __builtin_amdgcn_permlane32_swap(__float_as_uint(ps), __float_as_uint(ps), false, false); ps = __uint_as_float(rr[0]) + __uint_as_float(rr[1]); }
        l_reg = l_reg * alpha + ps;
        if (__any(alpha < 1.f)) { if (hi == 0) al_l[r32] = alpha; asm volatile("s_waitcnt lgkmcnt(0)" ::: "memory");
#pragma unroll
            for (int r = 0; r < 16; ++r) { const float a = al_l[crow(r, hi)];
#pragma unroll
                for (int d = 0; d < 8; ++d) o[d][r] *= a; } }
        bf16x8 pa0, pa1; PK4(pp, 0, pa0); PK4(pp, 8, pa1);
        PvPairs<8, 0, 0>::run(o, vb, pa0, pa1);
    }
#undef DSA_DMA
    if (hi == 0) li_l[r32] = l_reg; asm volatile("s_waitcnt lgkmcnt(0)" ::: "memory");
    float rl[16];
#pragma unroll
    for (int r = 0; r < 16; ++r) rl[r] = __builtin_amdgcn_rcpf(li_l[crow(r, hi)]);
    __syncthreads();
    LAS bf16_t* os = (LAS bf16_t*)(lds + wid * 16896);
#pragma unroll
    for (int r = 0; r < 16; ++r)
#pragma unroll
        for (int d0 = 0; d0 < 8; ++d0) os[crow(r, hi) * 264 + d0 * 32 + r32] = (bf16_t)(cvt_pk_bf16(o[d0][r] * rl[r], 0.f) & 0xffffu);
    asm volatile("s_waitcnt lgkmcnt(0)" ::: "memory");
    f32x16 ya[4];
#pragma unroll
    for (int nb = 0; nb < 4; ++nb)
#pragma unroll
        for (int r = 0; r < 16; ++r) ya[nb][r] = 0.f;
    const bf16_t* wv = (const bf16_t*)(p.ws + WS_WUV) + (size_t)(h * 128 + r32) * 256 + hi * 8;
#pragma unroll 4
    for (int ks = 0; ks < 16; ++ks) {
        const bf16x8 af = *(const LAS bf16x8*)(os + r32 * 264 + ks * 16 + hi * 8);
#pragma unroll
        for (int nb = 0; nb < 4; ++nb) { const bf16x8 wf = *(const bf16x8*)(wv + (size_t)nb * 32 * 256 + ks * 16); ya[nb] = __builtin_amdgcn_mfma_f32_32x32x16_bf16(wf, af, ya[nb], 0, 0, 0); }
    }
    unsigned char* O8 = (unsigned char*)(p.ws + WS_OA8) + ((size_t)b * SEQ + qt * 32 + r32) * 1024 + h * 128 + 4 * hi;
#pragma unroll
    for (int nb = 0; nb < 4; ++nb)
#pragma unroll
        for (int g4 = 0; g4 < 4; ++g4) *(unsigned*)(O8 + nb * 32 + g4 * 8) = pack_fp8x4(ya[nb][g4 * 4] * 8.f, ya[nb][g4 * 4 + 1] * 8.f, ya[nb][g4 * 4 + 2] * 8.f, ya[nb][g4 * 4 + 3] * 8.f);
}
__device__ void ph4_attn(const Params& p, LAS unsigned char* lds) {
    const int r = blockIdx.x;
    if (r < 256) { const int c = 31 - (r >> 3), w8 = r & 7, b = w8 >> 1, half = w8 & 1; dsa_item(p, lds, b, c * 2 + half); }
    int* qhead = (int*)(p.ws + WS_CNT) + 512;
    LAS int* slot = (LAS int*)(lds + LDS_BARW - 16);
    for (;;) {
        __syncthreads();
        if (threadIdx.x == 0) *slot = atomicAdd(qhead, 1);
        __syncthreads();
        const int it = __builtin_amdgcn_readfirstlane(*slot);
        if (it >= 256) break;
        const int qb = 7 - (it >> 5), bh = it & 31;
        fox_item(p, lds, bh >> 3, bh & 7, qb);
    }
}

__device__ void ph8_router(const Params& p, LAS unsigned char* lds, const int rep) {
    const int tid = threadIdx.x, wid = tid >> 6, lane = tid & 63, fr = lane & 15, fq = lane >> 4;
    const float* mod = (const float*)(p.ws + WS_MOD);
    int* cnt = (int*)(p.ws + WS_CNT) + rep * 256; int* ltok = rep ? (int*)(p.ws + WS_QLAT) : (int*)(p.ws + WS_LTOK); float* lw = rep ? (float*)(p.ws + WS_QLAT + (4u << 20)) : (float*)(p.ws + WS_LW);
    LAS unsigned char* AH = lds; LAS unsigned char* AL = lds + 65536;
    LAS float* slab = (LAS float*)(lds + 131072);
    LAS float* lg = (LAS float*)(lds + 131072 + 20480);
    const bf16_t* WH = (const bf16_t*)(p.ws + WS_WRH); const bf16_t* WL = (const bf16_t*)(p.ws + WS_WRL);
    for (int blk = blockIdx.x; blk < NTOK / 32; blk += gridDim.x) {
#pragma unroll 1
        for (int half = 0; half < 2; ++half) {
            const int t0 = blk * 32 + half * 16, tb = t0 + wid * 2, b = tb >> 11;
            const float* sh = mod + b * 12288 + 6144; const float* sc = mod + b * 12288 + 8192;
            f32x4 xv[2][8];
#pragma unroll
            for (int rr = 0; rr < 2; ++rr)
#pragma unroll
                for (int i = 0; i < 8; ++i) { const size_t eo = (size_t)(tb + rr) * DM + i * 256 + lane * 4; const u32x2 yb = *(const u32x2*)((const bf16_t*)(p.ws + WS_MERGED) + eo);
                    xv[rr][i] = *(const f32x4*)(p.in[I_X] + eo) + (f32x4){bf_lo(yb.x), bf_hi(yb.x), bf_lo(yb.y), bf_hi(yb.y)}; }
            float rstd[2];
#pragma unroll
            for (int rr = 0; rr < 2; ++rr) { float ss = 0.f;
#pragma unroll
                for (int i = 0; i < 8; ++i) ss += xv[rr][i][0] * xv[rr][i][0] + xv[rr][i][1] * xv[rr][i][1] + xv[rr][i][2] * xv[rr][i][2] + xv[rr][i][3] * xv[rr][i][3];
                rstd[rr] = rsqrtf(wave_sum(ss) * (1.0f / 2048.0f) + RMS_EPS); }
#pragma unroll
            for (int i = 0; i < 8; ++i) { const int col = i * 256 + lane * 4; const f32x4 gg = *(const f32x4*)(p.in[I_GFFN] + col), s1 = *(const f32x4*)(sc + col), s0 = *(const f32x4*)(sh + col);
#pragma unroll
                for (int rr = 0; rr < 2; ++rr) { float hv[4], lo[4]; const int r = wid * 2 + rr;
#pragma unroll
                    for (int j = 0; j < 4; ++j) hv[j] = xv[rr][i][j] * rstd[rr] * gg[j] * (1.0f + s1[j]) + s0[j];
                    u32x2 wh; wh.x = cvt_pk_bf16(hv[0], hv[1]); wh.y = cvt_pk_bf16(hv[2], hv[3]);
                    lo[0] = hv[0] - bf_lo(wh.x); lo[1] = hv[1] - bf_hi(wh.x); lo[2] = hv[2] - bf_lo(wh.y); lo[3] = hv[3] - bf_hi(wh.y);
                    u32x2 wl; wl.x = cvt_pk_bf16(lo[0], lo[1]); wl.y = cvt_pk_bf16(lo[2], lo[3]);
                    const int ad = r * 4096 + ((((i * 32 + (lane >> 1)) ^ r)) * 16) + (lane & 1) * 8;
                    *(LAS u32x2*)(AH + ad) = wh; *(LAS u32x2*)(AL + ad) = wl;
                    *(unsigned*)(p.ws + WS_H8 + (size_t)(tb + rr) * DM + col) = pack_fp8x4(hv[0], hv[1], hv[2], hv[3]); } }
            __syncthreads();
            {
                const int kq = wid & 3, ng = wid >> 2, nb0 = ng * 3;
                f32x4 acc[3];
#pragma unroll
                for (int j = 0; j < 3; ++j) acc[j] = (f32x4){0.f, 0.f, 0.f, 0.f};
#pragma unroll 4
                for (int k16 = 0; k16 < 16; ++k16) { const int ks = kq * 16 + k16; const int ad = fr * 4096 + (((ks * 4 + fq) ^ fr) * 16);
                    const bf16x8 ah = *(const LAS bf16x8*)(AH + ad), al = *(const LAS bf16x8*)(AL + ad);
#pragma unroll
                    for (int j = 0; j < 3; ++j) { const int nb = nb0 + j; if (nb < 5) {
                        const bf16x8 wh = *(const bf16x8*)(WH + (size_t)(nb * 16 + fr) * DM + ks * 32 + fq * 8), wl = *(const bf16x8*)(WL + (size_t)(nb * 16 + fr) * DM + ks * 32 + fq * 8);
                        acc[j] = __builtin_amdgcn_mfma_f32_16x16x32_bf16(wh, ah, acc[j], 0, 0, 0); acc[j] = __builtin_amdgcn_mfma_f32_16x16x32_bf16(wl, ah, acc[j], 0, 0, 0); acc[j] = __builtin_amdgcn_mfma_f32_16x16x32_bf16(wh, al, acc[j], 0, 0, 0); } } }
#pragma unroll
                for (int j = 0; j < 3; ++j) { const int nb = nb0 + j; if (nb < 5) *(LAS f32x4*)(slab + (kq * 16 + fr) * 80 + nb * 16 + fq * 4) = acc[j]; }
            }
            __syncthreads();
            for (int o = tid; o < 1280; o += NTHREADS) lg[o] = (slab[o] + slab[1280 + o]) + (slab[2560 + o] + slab[3840 + o]);
            __syncthreads();
            if (tid < 16) {
                const int t = t0 + tid; const LAS float* L = lg + tid * 80;
                float gl[8]; int gi = 0; float gm = -INFINITY;
#pragma unroll
                for (int g = 0; g < 8; ++g) { gl[g] = L[g] + p.in[I_BRG][g]; if (gl[g] > gm) { gm = gl[g]; gi = g; } }
                float se = 0.f;
#pragma unroll
                for (int g = 0; g < 8; ++g) se += __expf(gl[g] - gm);
                const float gwt = 1.0f / se;
                float v1 = -INFINITY, v2 = -INFINITY; int i1 = 0, i2 = 0;
                for (int e = 0; e < 8; ++e) { const float v = L[8 + gi * 8 + e] + p.in[I_BRE][gi * 8 + e];
                    if (v > v1) { v2 = v1; i2 = i1; v1 = v; i1 = e; } else if (v > v2) { v2 = v; i2 = e; } }
                const float e2 = __expf(v2 - v1); const float p1 = gwt / (1.0f + e2), p2 = gwt * e2 / (1.0f + e2);
                const int ea = gi * 8 + i1, eb = gi * 8 + i2;
                const int pa = atomicAdd(cnt + ea, 1); const int pb = atomicAdd(cnt + eb, 1);
                ltok[ea * LCAP + pa] = t; lw[ea * LCAP + pa] = p1;
                ltok[eb * LCAP + pb] = t | 0x10000; lw[eb * LCAP + pb] = p2;
            }
            __syncthreads();
        }
    }
}

#define MOE_GLOAD(dst, ptr) asm volatile("global_load_dwordx4 %0, %1, off nt" : "=v"(dst) : "v"(ptr) : "memory")
template <bool UP>
__device__ void moe_gemm(const Params& p, LAS unsigned char* lds, const int rep) {
    constexpr int K = UP ? 2048 : 512, NKT = K / 32, NS = UP ? 8 : 16, LDW = UP ? 512 : 2048;
    constexpr int NSTA = 3, OFF_A = 0, OFF_B = NSTA * 16384;
    int tid = threadIdx.x; asm volatile("" : "+v"(tid));
    const int w = __builtin_amdgcn_readfirstlane(tid >> 6), l = tid & 63, r32 = l & 31, hi = l >> 5;
    LAS int* tab = (LAS int*)(lds + LDS_TAB);
    if (tid == 0) { const int* cnt = (const int*)(p.ws + WS_CNT); int s = 0, ro = 0; for (int e = 0; e < 64; ++e) { const int ce = cnt[e]; tab[e] = s; tab[80 + e] = ce; tab[160 + e] = ro; ro += ce; const int np = (ce + 511) >> 9; s += np > 0 ? np : 1; } tab[64] = s; }
    __syncthreads();
    const int total = __builtin_amdgcn_readfirstlane(tab[64]) * NS;
    const int q = (w & 3) * 8 + (l & 7), g = (w >> 2) * 8 + (l >> 3);
    const unsigned bwoff = (unsigned)(q * 256 + (((g >> 2) ^ (q & 3)) * 16) + (g & 3) * 4);
    const unsigned frag_sw = (unsigned)((r32 >> 2) & 3);
    const int* ltok = (const int*)(p.ws + WS_LTOK); const float* lw = (const float*)(p.ws + WS_LW);
    for (int unit = blockIdx.x; unit < total; unit += gridDim.x) {
        const int pm = unit / NS, ns = unit - pm * NS; int e = 0;
#pragma unroll 1
        for (int s = 32; s >= 1; s >>= 1) if (__builtin_amdgcn_readfirstlane(tab[e + s]) <= pm) e += s;
        const int mp = pm - __builtin_amdgcn_readfirstlane(tab[e]); const int cnt_e = __builtin_amdgcn_readfirstlane(tab[80 + e]), rowoff = __builtin_amdgcn_readfirstlane(tab[160 + e]);
        int nrows = cnt_e - mp * 512; nrows = nrows > 512 ? 512 : nrows; const bool two = nrows > 256;
        const char* abase = UP ? (const char*)(p.ws + WS_H8) : (const char*)(p.ws + WS_ACT8);
        unsigned aoff[2];
#pragma unroll
        for (int i = 0; i < 2; ++i) { const int row = (i * 8 + w) * 32 + (l >> 1); const int hs = (l & 1) ^ ((l >> 4) & 1);
            int src; if (UP) src = row < nrows ? (ltok[e * LCAP + mp * 512 + row] & 0xffff) : 0; else src = rowoff + mp * 512 + (row < nrows ? row : 0);
            aoff[i] = (unsigned)(src * K + hs * 16); }
        const float* bsrc = UP ? (q < 16 ? p.in[I_W1] : p.in[I_W3]) + (size_t)e * 2048 * 512 + ns * 64 + (q & 15) * 4 + (size_t)(2 * g) * LDW
                               : p.in[I_W2] + (size_t)e * 512 * 2048 + ns * 128 + q * 4 + (size_t)(2 * g) * LDW;
        f32x16 acc[2][4];
#pragma unroll
        for (int a = 0; a < 2; ++a)
#pragma unroll
            for (int b = 0; b < 4; ++b)
#pragma unroll
                for (int r = 0; r < 16; ++r) acc[a][b][r] = 0.f;
        f32x4 br[2][2];
#define MOE_ISSUE_B(j, t) do { const int tt_ = (t) < NKT ? (t) : NKT - 1; const float* bp_ = bsrc + (size_t)tt_ * 32 * LDW; MOE_GLOAD(br[j][0], bp_); MOE_GLOAD(br[j][1], bp_ + LDW); } while (0)
#define MOE_ISSUE_A(t, TWO) do { int tt_ = (t) < 0 ? 0 : (t); const int bi_ = (tt_ % NSTA); tt_ = tt_ < NKT ? tt_ : NKT - 1; const char* ap_ = abase + (size_t)tt_ * 32; \
        LAS unsigned char* ab_ = lds + OFF_A + bi_ * 16384 + w * 1024; \
        __builtin_amdgcn_global_load_lds((const unsigned*)(ap_ + aoff[0]), (LAS unsigned*)(ab_), 16, 0, 0); \
        if (TWO) __builtin_amdgcn_global_load_lds((const unsigned*)(ap_ + aoff[1]), (LAS unsigned*)(ab_ + 8192), 16, 0, 0); } while (0)
        const bool two_w = (256 + 32 * w) < nrows;
#define MOE_FRAGS(ks, TWO) do { const unsigned co_ = ((unsigned)((ks) * 2 + hi) ^ frag_sw) * 16u; \
            _Pragma("unroll") for (int nb = 0; nb < 4; ++nb) bf_[nb] = *(const LAS bf16x8*)(bb_ + nb * 2048 + co_); \
            { const unsigned ao_ = ((unsigned)(ks) ^ ((unsigned)(r32 >> 3) & 1u)) * 16u + (unsigned)hi * 8u; a0_ = fp8x8_to_bf16(*(const LAS u32x2*)(ab_ + ao_)); if (TWO) a1_ = fp8x8_to_bf16(*(const LAS u32x2*)(ab_ + 8192 + ao_)); } } while (0)
#define MOE_MMAS(TWO) do { \
            _Pragma("unroll") for (int nb = 0; nb < 4; ++nb) acc[0][nb] = __builtin_amdgcn_mfma_f32_32x32x16_bf16(bf_[nb], a0_, acc[0][nb], 0, 0, 0); \
            if (TWO) { _Pragma("unroll") for (int nb = 0; nb < 4; ++nb) acc[1][nb] = __builtin_amdgcn_mfma_f32_32x32x16_bf16(bf_[nb], a1_, acc[1][nb], 0, 0, 0); } } while (0)
#define MOE_ITER(jn, t, COMPUTE, TWO, WB, WA) do { \
        bf16x8 bf_[4], a0_, a1_; \
        const LAS unsigned char* ab_ = lds + OFF_A + (((t) + 3) % 3) * 16384 + w * 1024 + r32 * 32; const LAS unsigned char* bb_ = lds + OFF_B + ((t) & 1) * 8192 + r32 * 64; \
        if (COMPUTE) { MOE_FRAGS(0, TWO); } SBAR(); \
        asm volatile("s_waitcnt vmcnt(" WB ")" : "+v"(br[jn][0]), "+v"(br[jn][1]) :: "memory"); \
        { LAS unsigned char* bw_ = lds + OFF_B + (((t) + 1) & 1) * 8192 + bwoff; _Pragma("unroll") for (int jj = 0; jj < 4; ++jj) *(LAS unsigned*)(bw_ + jj * 64) = cvt_pk_bf16(br[jn][0][jj], br[jn][1][jj]); } \
        MOE_ISSUE_B(jn, (t) + 3); SBAR(); \
        if (COMPUTE) { MOE_MMAS(TWO); SBAR(); MOE_FRAGS(1, TWO); MOE_MMAS(TWO); } SBAR(); \
        asm volatile("s_waitcnt vmcnt(" WA ")" ::: "memory"); \
        asm volatile("s_waitcnt lgkmcnt(0)" ::: "memory"); __builtin_amdgcn_s_barrier(); asm volatile("" ::: "memory"); \
        MOE_ISSUE_A((t) + 3, TWO); \
        } while (0)
#define MOE_PIPE(TWO, WB, WA) do { \
        MOE_ISSUE_B(0, 0); MOE_ISSUE_A(0, TWO); MOE_ISSUE_B(1, 1); MOE_ISSUE_A(1, TWO); \
        MOE_ITER(0, -1, false, TWO, WB, WA); \
        _Pragma("unroll 1") for (int t = 0; t < NKT; t += 2) { MOE_ITER(1, t, true, TWO, WB, WA); MOE_ITER(0, t + 1, true, TWO, WB, WA); } \
          \
        asm volatile("s_waitcnt vmcnt(0)" : "+v"(br[0][0]), "+v"(br[0][1]), "+v"(br[1][0]), "+v"(br[1][1]) :: "memory"); \
        } while (0)
        if (two_w) MOE_PIPE(true, "6", "6"); else MOE_PIPE(false, "4", "5");
        asm volatile("s_waitcnt vmcnt(0)" ::: "memory");
        if constexpr (UP) {
#pragma unroll
            for (int mt = 0; mt < 2; ++mt) {
                const int rl = mt * 256 + 32 * w + r32;
                if (rl < nrows) {
                    const float gw = lw[e * LCAP + mp * 512 + rl] * 16.0f; unsigned char* orow = (unsigned char*)(p.ws + (rep ? WS_QLAT : WS_ACT8)) + (size_t)(rowoff + mp * 512 + rl) * 512 + ns * 64 + 4 * hi;
#pragma unroll
                    for (int nb = 0; nb < 2; ++nb)
#pragma unroll
                        for (int g4 = 0; g4 < 4; ++g4) { float o[4];
#pragma unroll
                            for (int j = 0; j < 4; ++j) { const float a = acc[mt][nb][g4 * 4 + j], u = acc[mt][nb + 2][g4 * 4 + j]; o[j] = a * sigmoidf_(a) * u * gw; }
                            *(unsigned*)(orow + nb * 32 + g4 * 8) = pack_fp8x4(o[0], o[1], o[2], o[3]); }
                }
            }
        } else {
#pragma unroll
            for (int mt = 0; mt < 2; ++mt) {
                const int rl = mt * 256 + 32 * w + r32;
                if (rl < nrows) {
                    const int ent = ltok[e * LCAP + mp * 512 + rl]; unsigned char* orow = (unsigned char*)(p.ws + WS_YS) + ((size_t)(ent >> 16) * NTOK + (ent & 0xffff)) * 2048 + ns * 128 + 4 * hi;
#pragma unroll
                    for (int nb = 0; nb < 4; ++nb)
#pragma unroll
                        for (int g4 = 0; g4 < 4; ++g4) *(unsigned*)(orow + nb * 32 + g4 * 8) = pack_fp8x4(acc[mt][nb][g4 * 4], acc[mt][nb][g4 * 4 + 1], acc[mt][nb][g4 * 4 + 2], acc[mt][nb][g4 * 4 + 3]);
                }
            }
        }
        asm volatile("s_waitcnt vmcnt(0)" ::: "memory");
        __syncthreads();
    }
#undef MOE_ISSUE_A
#undef MOE_ISSUE_B
#undef MOE_ITER
#undef MOE_FRAGS
#undef MOE_MMAS
#undef MOE_PIPE
}


__device__ void ph11_combine(const Params& p) {
    const unsigned char* Y0 = (const unsigned char*)(p.ws + WS_YS); const unsigned char* Y1 = Y0 + (size_t)NTOK * 2048; const bf16_t* YM = (const bf16_t*)(p.ws + WS_MERGED); const float* mod = (const float*)(p.ws + WS_MOD);
    const size_t n8 = (size_t)NTOK * 2048 / 8;
    for (size_t i = (size_t)blockIdx.x * NTHREADS + threadIdx.x; i < n8; i += (size_t)gridDim.x * NTHREADS) {
        const size_t e0 = i * 8; const int col = (int)(e0 & 2047), b = (int)(e0 >> 22);
        const u32x2 a = *(const u32x2*)(Y0 + e0), c = *(const u32x2*)(Y1 + e0); const u32x4 m = *(const u32x4*)(YM + e0);
        const f32x2 a0 = __builtin_amdgcn_cvt_pk_f32_fp8((int)a.x, false), a1 = __builtin_amdgcn_cvt_pk_f32_fp8((int)a.x, true), a2 = __builtin_amdgcn_cvt_pk_f32_fp8((int)a.y, false), a3 = __builtin_amdgcn_cvt_pk_f32_fp8((int)a.y, true);
        const f32x2 c0 = __builtin_amdgcn_cvt_pk_f32_fp8((int)c.x, false), c1 = __builtin_amdgcn_cvt_pk_f32_fp8((int)c.x, true), c2 = __builtin_amdgcn_cvt_pk_f32_fp8((int)c.y, false), c3 = __builtin_amdgcn_cvt_pk_f32_fp8((int)c.y, true);
        const float* gt = mod + (size_t)b * 12288 + 10240 + col; const f32x4 g0 = *(const f32x4*)gt * 0.0625f, g1 = *(const f32x4*)(gt + 4) * 0.0625f;
        const float* px = p.in[I_X] + e0; f32x4 o0 = *(const f32x4*)px, o1 = *(const f32x4*)(px + 4);
        o0[0] += bf_lo(m.x) + g0[0] * (a0.x + c0.x); o0[1] += bf_hi(m.x) + g0[1] * (a0.y + c0.y); o0[2] += bf_lo(m.y) + g0[2] * (a1.x + c1.x); o0[3] += bf_hi(m.y) + g0[3] * (a1.y + c1.y);
        o1[0] += bf_lo(m.z) + g1[0] * (a2.x + c2.x); o1[1] += bf_hi(m.z) + g1[1] * (a2.y + c2.y); o1[2] += bf_lo(m.w) + g1[2] * (a3.x + c3.x); o1[3] += bf_hi(m.w) + g1[3] * (a3.y + c3.y);
        float* po = p.out + e0; *(f32x4*)po = o0; *(f32x4*)(po + 4) = o1;
    }
}

__global__ void __launch_bounds__(NTHREADS, 2) mk_fwd(Params p) {
    extern __shared__ __attribute__((aligned(16))) unsigned char shm[];
    LAS unsigned char* lds = (LAS unsigned char*)shm;
    const int lo = p.ph_lo, hi = p.ph_hi;
    if (threadIdx.x < 4) ((LAS unsigned*)(lds + LDS_BARW))[threadIdx.x] = 0u;
    __syncthreads();
    XcdBarrier bar; bar.bar = (unsigned*)(p.ws + WS_BAR); bar.x = 0; bar.st = nullptr;
    if (hi - lo > 1) bar = xcd_barrier_post((unsigned*)(p.ws + WS_BAR), (volatile LAS unsigned*)(lds + LDS_BARW));
#ifndef SKIP_MASK
#define SKIP_MASK 0
#endif
#define IN(k) (!((SKIP_MASK >> (k)) & 1) && lo <= (k) && (k) < hi)
#define SEAM(k) do { if (IN(k) && IN((k) + 1)) xcd_barrier(bar); } while (0)
    const int G = gridDim.x, bx = blockIdx.x;
#ifndef REP_PHASE
#define REP_PHASE 0
#endif
#define RUN(k, ...) do { if (IN(k)) { { const int rep = 0; (void)rep; __VA_ARGS__ } if ((REP_PHASE >> (k)) & 1) { xcd_barrier(bar); { const int rep = 1; (void)rep; __VA_ARGS__ } } } SEAM(k); } while (0)
    RUN(0, ph0_prologue(p, lds););
    RUN(1, ph1_norm(p););
    RUN(2, EpiProj E{p.ws, p.in[I_BGATE]};
           { ProjOrder S; S.S.init(p.ws + WS_H, p.ws + WS_WIN + (size_t)2 * 256 * DM * 2, NTOK, 8 * 256, DM * 2, G, bx); S.fp8 = 0; S.Bfull = nullptr;
             pg8::gemm_phase<EpiProj, ProjOrder, false, false>(lds, DM * 2, S, E); }
           { ProjOrder S; S.S.init(p.ws + WS_HF8, p.ws + WS_WIN8, NTOK, 30 * 256, DM, G, (G - 1) - bx); S.fp8 = 1; S.Bfull = nullptr;
             pg8::gemm_phase<EpiProj, ProjOrder, false, true>(lds, DM, S, E, 0x79797979); });
    RUN(3, ph3_prep(p, lds, rep););
    RUN(4, ph4_attn(p, lds););
    RUN(5, DualOrder S; S.S0.init(p.ws + WS_OA8, p.ws + WS_WPA8, NTOK, DM, 1024, G, bx); S.S1.init(p.ws + WS_OB8, p.ws + WS_WPB8, NTOK, DM, 1024, G, bx);
           EpiGate12 E{EpiGate1{(const bf16_t*)(p.ws + WS_GATES), (bf16_t*)(p.ws + WS_OA)}, EpiGate2{(const bf16_t*)(p.ws + WS_GATES), (const bf16_t*)(p.ws + WS_OA), (unsigned char*)(p.ws + WS_MRG8)}};
           pg8::gemm_phase<EpiGate12, DualOrder, false, true>(lds, 1024, S, E, 0x79797979, 0x7c7c7c7c););
    RUN(6, pg8::StaticOrder S; S.init(p.ws + WS_MRG8, p.ws + WS_WO8, NTOK, DM, DM, G, bx); EpiWo E{(const float*)(p.ws + WS_MOD), (bf16_t*)(p.ws + WS_MERGED)};
           pg8::gemm_phase<EpiWo, pg8::StaticOrder, false, true>(lds, DM, S, E, 0x79797979, 0x7d7d7d7d););
    RUN(7, ph8_router(p, lds, rep););
    RUN(8, moe_gemm<true>(p, lds, rep););
    RUN(9, moe_gemm<false>(p, lds, rep););
    RUN(10, if (!rep) ph11_combine(p););
#undef RUN
#undef IN
#undef SEAM
}

constexpr int NPHASES = 11;
extern "C" void kernel_launch(void* const* d_in, const int* in_sizes, int n_in, void* d_out, int out_size, void* d_ws, size_t ws_size, hipStream_t stream) {
    static int grid = 0;
    if (grid == 0) {
        if (n_in != 25 || in_sizes[0] != NTOK * DM || out_size != NTOK * DM || ws_size < WS_END6) {
            fprintf(stderr, "kernel_launch: shape mismatch: n_in %d in0 %d out %d ws %zu (need %zu)\n", n_in, n_in > 0 ? in_sizes[0] : -1, out_size, ws_size, (size_t)WS_END6); grid = -1; return; }
        int dev = 0, cus = 0, per_cu = 0;
        if (hipGetDevice(&dev) != hipSuccess || hipDeviceGetAttribute(&cus, hipDeviceAttributeMultiprocessorCount, dev) != hipSuccess) { fprintf(stderr, "kernel_launch: device query failed\n"); grid = -1; return; }
        if (hipFuncSetAttribute((const void*)mk_fwd, hipFuncAttributeMaxDynamicSharedMemorySize, LDS_BYTES) != hipSuccess) { fprintf(stderr, "kernel_launch: hipFuncSetAttribute failed\n"); grid = -1; return; }
        if (hipOccupancyMaxActiveBlocksPerMultiprocessor(&per_cu, (const void*)mk_fwd, NTHREADS, LDS_BYTES) != hipSuccess || per_cu < 1) { fprintf(stderr, "kernel_launch: occupancy query says %d blocks per CU\n", per_cu); }
        (void)hipGetLastError();
        grid = cus;
    }
    if (grid < 0) return;
    if (hipMemsetAsync((char*)d_ws + WS_BAR, 0, WS_ZERO_BYTES, stream) != hipSuccess) { fprintf(stderr, "kernel_launch: memset failed\n"); return; }
    Params p; memset(&p, 0, sizeof(p));
    for (int i = 0; i < 25; ++i) p.in[i] = (const float*)d_in[i];
    p.out = (float*)d_out; p.ws = (unsigned char*)d_ws;
    unsigned char* ws = (unsigned char*)d_ws;
    auto job = [&](int j, const float* src, size_t dst_off, int K, int N, int ldd, int map, int nbatch, long sbatch, long dbatch) {
        TJob& J = p.jobs[j]; J.src = src; J.dst = (bf16_t*)(ws + dst_off); J.K = K; J.N = N; J.ldd = ldd; J.map = map; J.ntk = K / 64; J.ntn = (N + 127) / 128; J.nbatch = nbatch; J.sbatch = sbatch; J.dbatch = dbatch; J.ld = N; J.fp8 = 0; };
    job(0, p.in[I_WIN] + 512, WS_WIN, 2048, 1872, 2048, 4, 1, 0, 0); p.jobs[0].ld = DIN;
    job(1, p.in[I_WIN] + 5456, WS_WIN, 2048, 8, 2048, 5, 1, 0, 0); p.jobs[1].ld = DIN;
    job(2, p.in[I_WUK], WS_WUK, 128, 256, 128, 0, 8, 128L * 256, 256L * 128);
    job(3, p.in[I_WUV], WS_WUV, 256, 128, 256, 0, 8, 256L * 128, 128L * 256);
    job(4, p.in[I_WIN], WS_WIN8, 2048, 512, 2048, 0, 1, 0, 0); job(5, p.in[I_WIN] + 2384, WS_WIN8 + (size_t)512 * 2048, 2048, 3072, 2048, 0, 1, 0, 0); job(6, p.in[I_WIN] + 5464, WS_WIN8 + (size_t)3584 * 2048, 2048, 4096, 2048, 0, 1, 0, 0);
    for (int j = 4; j < 7; ++j) { p.jobs[j].ld = DIN; p.jobs[j].fp8 = 1; }
    job(7, p.in[I_WO], WS_WO8, 2048, 2048, 2048, 0, 1, 0, 0); p.jobs[7].fp8 = 1;
    job(8, p.in[I_WPA], WS_WPA8, 1024, 2048, 1024, 0, 1, 0, 0); p.jobs[8].fp8 = 1; job(9, p.in[I_WPB], WS_WPB8, 1024, 2048, 1024, 0, 1, 0, 0); p.jobs[9].fp8 = 1;
    int t0 = 0; for (int j = 0; j < NJOBS; ++j) { p.jobs[j].tile0 = t0; t0 += p.jobs[j].ntk * p.jobs[j].ntn * p.jobs[j].nbatch; }
    p.ntiles_total = t0;
#if MK_LAUNCHES == 1
    p.ph_lo = 0; p.ph_hi = NPHASES;
    hipLaunchKernelGGL(mk_fwd, dim3(grid), dim3(NTHREADS), LDS_BYTES, stream, p);
#else
    for (int k = 0; k < NPHASES; ++k) { p.ph_lo = k; p.ph_hi = k + 1; hipLaunchKernelGGL(mk_fwd, dim3(grid), dim3(NTHREADS), LDS_BYTES, stream, p); }
#endif
    const hipError_t le = hipPeekAtLastError();
    if (le != hipSuccess) fprintf(stderr, "kernel_launch: launch failed: %s\n", hipGetErrorName(le));
}
```

```cpp
#include <hip/hip_runtime.h>
#include <cstdio>
#include <cstdint>
#include <cstring>

#ifndef MK_LAUNCHES
#define MK_LAUNCHES 1
#endif

#define LAS __attribute__((address_space(3)))
typedef unsigned short bf16_t;
typedef short bf16x8 __attribute__((ext_vector_type(8)));
typedef short s16x4 __attribute__((ext_vector_type(4)));
typedef float f32x4 __attribute__((ext_vector_type(4)));
typedef float f32x16 __attribute__((ext_vector_type(16)));
typedef unsigned u32x4 __attribute__((ext_vector_type(4)));
typedef unsigned u32x2 __attribute__((ext_vector_type(2)));

constexpr int DM = 2048, NBATCH = 4, SEQ = 2048, NTOK = NBATCH * SEQ;
constexpr int DIN = 9560, DINP = 9728;
constexpr int NEXP = 64, DEXP = 512, LCAP = 8192;
constexpr float RMS_EPS = 1e-6f;
constexpr float LOG2E = 1.4426950408889634f;
constexpr int NTHREADS = 512;
constexpr int LDS_BYTES = 163840 - 1024;
constexpr int LDS_BARW = LDS_BYTES - 16;
constexpr int LDS_TAB = 131072;

constexpr size_t al256(size_t x) { return (x + 255) / 256 * 256; }
constexpr size_t WS_BAR = 0;
constexpr size_t WS_CNT = 16384;
constexpr size_t WS_ZERO_BYTES = 16384 + 4096;
constexpr size_t WS_MOD = WS_ZERO_BYTES;
constexpr size_t WS_H = al256(WS_MOD + (size_t)4 * 12288 * 4);
constexpr size_t WS_WIN = al256(WS_H + (size_t)NTOK * DM * 2);
constexpr size_t WS_WPA = al256(WS_WIN + (size_t)DINP * DM * 2);
constexpr size_t WS_WPB = al256(WS_WPA + (size_t)2048 * 1024 * 2);
constexpr size_t WS_WO = al256(WS_WPB + (size_t)2048 * 1024 * 2);
constexpr size_t WS_WUK = al256(WS_WO + (size_t)2048 * 2048 * 2);
constexpr size_t WS_WUV = al256(WS_WUK + (size_t)8 * 256 * 128 * 2);
constexpr size_t WS_W13 = al256(WS_WUV + (size_t)8 * 128 * 256 * 2);
constexpr size_t WS_W2 = al256(WS_W13 + (size_t)64 * 1024 * 2048 * 2);
constexpr size_t WS_QA = al256(WS_W2 + (size_t)64 * 2048 * 512 * 2);
constexpr size_t WS_CKV = al256(WS_QA + (size_t)NTOK * 1024 * 2);
constexpr size_t WS_KV = al256(WS_CKV + (size_t)NTOK * 256 * 4);
constexpr size_t WS_QIDX = al256(WS_KV + (size_t)NTOK * 256 * 2);
constexpr size_t WS_MISC = al256(WS_QIDX + (size_t)NTOK * 1024 * 2);
constexpr size_t WS_QB = al256(WS_MISC + (size_t)NTOK * 256 * 4);
constexpr size_t WS_KB = al256(WS_QB + (size_t)NTOK * 1024 * 2);
constexpr size_t WS_VB = al256(WS_KB + (size_t)NTOK * 1024 * 2);
constexpr size_t WS_GATES = al256(WS_VB + (size_t)NTOK * 1024 * 2);
constexpr size_t WS_QLAT = al256(WS_GATES + (size_t)NTOK * 4096 * 2);
constexpr size_t WS_MASK = al256(WS_QLAT + (size_t)NTOK * 2048 * 2);
constexpr size_t WS_CUM = al256(WS_MASK + (size_t)NTOK * 256);
constexpr size_t WS_OLAT = al256(WS_CUM + (size_t)4 * 8 * 2048 * 4);
constexpr size_t WS_OA = al256(WS_OLAT + (size_t)NTOK * 2048 * 2);
constexpr size_t WS_OB = al256(WS_OA + (size_t)NTOK * 1024 * 2);
constexpr size_t WS_T1 = al256(WS_OB + (size_t)NTOK * 1024 * 2);
constexpr size_t WS_MERGED = al256(WS_T1 + (size_t)NTOK * 2048 * 4);
constexpr size_t WS_LTOK = al256(WS_MERGED + (size_t)NTOK * 2048 * 2);
constexpr size_t WS_LW = al256(WS_LTOK + (size_t)NEXP * LCAP * 4);
constexpr size_t WS_ACT = al256(WS_LW + (size_t)NEXP * LCAP * 4);
constexpr size_t WS_HLO = al256(WS_ACT + (size_t)32768 * 512 * 2);
constexpr size_t WS_WRH = al256(WS_HLO + (size_t)NTOK * DM * 2);
constexpr size_t WS_WRL = al256(WS_WRH + (size_t)80 * DM * 2);
constexpr size_t WS_END = al256(WS_WRL + (size_t)80 * DM * 2);
constexpr size_t WS_KIDX = WS_END;
constexpr size_t WS_END2 = al256(WS_KIDX + (size_t)NTOK * 64 * 2);
constexpr size_t WS_H8 = WS_END2;
constexpr size_t WS_ACT8 = al256(WS_H8 + (size_t)NTOK * DM);
constexpr size_t WS_END3 = al256(WS_ACT8 + (size_t)16384 * 512);
constexpr size_t WS_HF8 = WS_END3;
constexpr size_t WS_WIN8 = al256(WS_HF8 + (size_t)NTOK * DM);
constexpr size_t WS_END4 = al256(WS_WIN8 + (size_t)7680 * DM);
constexpr size_t WS_MRG8 = WS_END4;
constexpr size_t WS_WO8 = al256(WS_MRG8 + (size_t)NTOK * DM);
constexpr size_t WS_END5 = al256(WS_WO8 + (size_t)2048 * 2048);
constexpr size_t WS_OA8 = WS_END5;
constexpr size_t WS_OB8 = al256(WS_OA8 + (size_t)NTOK * 1024);
constexpr size_t WS_WPA8 = al256(WS_OB8 + (size_t)NTOK * 1024);
constexpr size_t WS_WPB8 = al256(WS_WPA8 + (size_t)2048 * 1024);
constexpr size_t WS_END6 = al256(WS_WPB8 + (size_t)2048 * 1024);
constexpr size_t WS_YS = WS_T1;
constexpr size_t WS_HG = WS_QA;
static_assert(WS_HG + (size_t)32768 * DM * 2 <= WS_QLAT, "hg alias must fit in the dead region");

struct TJob { const float* src; bf16_t* dst; int K, N, ldd, map, ntk, ntn, nbatch, tile0; long sbatch, dbatch; int ld, fp8; };
constexpr int NJOBS = 10;
struct Params {
    const float* in[25];
    float* out;
    unsigned char* ws;
    TJob jobs[NJOBS];
    int ntiles_total;
    int ph_lo, ph_hi;
};
enum { I_X = 0, I_C, I_WADA, I_BADA, I_GMIX, I_WIN, I_BGATE, I_BFORGET, I_WUK, I_WUV, I_GQA, I_GKV, I_GQB, I_GKB, I_WPA, I_WPB, I_WO, I_GFFN, I_WRG, I_BRG, I_WRE, I_BRE, I_W1, I_W3, I_W2 };

__device__ __forceinline__ unsigned cvt_pk_bf16(float lo, float hi) { unsigned r; asm volatile("v_cvt_pk_bf16_f32 %0, %1, %2" : "=v"(r) : "v"(lo), "v"(hi)); return r; }
__device__ __forceinline__ float bf_lo(unsigned w) { return __uint_as_float(w << 16); }
__device__ __forceinline__ float bf_hi(unsigned w) { return __uint_as_float(w & 0xffff0000u); }
typedef float f32x2 __attribute__((ext_vector_type(2)));
__device__ __forceinline__ unsigned pack_fp8x4(float a, float b, float c, float d) { int w = __builtin_amdgcn_cvt_pk_fp8_f32(a, b, 0, false); w = __builtin_amdgcn_cvt_pk_fp8_f32(c, d, w, true); return (unsigned)w; }
__device__ __forceinline__ bf16x8 fp8x8_to_bf16(u32x2 v) {
    const f32x2 a = __builtin_amdgcn_cvt_pk_f32_fp8((int)v.x, false), b = __builtin_amdgcn_cvt_pk_f32_fp8((int)v.x, true), c = __builtin_amdgcn_cvt_pk_f32_fp8((int)v.y, false), d = __builtin_amdgcn_cvt_pk_f32_fp8((int)v.y, true);
    u32x4 w; w.x = cvt_pk_bf16(a.x, a.y); w.y = cvt_pk_bf16(b.x, b.y); w.z = cvt_pk_bf16(c.x, c.y); w.w = cvt_pk_bf16(d.x, d.y); return *reinterpret_cast<bf16x8*>(&w); }
__device__ __forceinline__ unsigned pack_u8x4(float a, float b, float c, float d) {
    unsigned w = 0; w = __builtin_amdgcn_cvt_pk_u8_f32(a * 255.f + 0.5f, 0, w); w = __builtin_amdgcn_cvt_pk_u8_f32(b * 255.f + 0.5f, 1, w); w = __builtin_amdgcn_cvt_pk_u8_f32(c * 255.f + 0.5f, 2, w); w = __builtin_amdgcn_cvt_pk_u8_f32(d * 255.f + 0.5f, 3, w); return w; }
__device__ __forceinline__ f32x4 unpack_u8x4(unsigned w) { return (f32x4){(float)(w & 0xffu), (float)((w >> 8) & 0xffu), (float)((w >> 16) & 0xffu), (float)(w >> 24)} * (1.0f / 255.0f); }
__device__ __forceinline__ float wave_sum(float v) {
#pragma unroll
    for (int o = 32; o >= 1; o >>= 1) v += __shfl_xor(v, o);
    return v;
}
__device__ __forceinline__ float sigmoidf_(float x) { return __builtin_amdgcn_rcpf(1.0f + __builtin_amdgcn_exp2f(-1.4426950408889634f * x)); }
__device__ __forceinline__ int crow(int r, int hi) { return (r & 3) + 8 * (r >> 2) + 4 * hi; }
#define SBAR() __builtin_amdgcn_sched_barrier(0)

#define XB_TMO      128
#define XB_XCNT(j)  (256  + 64 * (j))
#define XB_XSUB(j)  (1280 + 64 * (j))
#define XB_XGEN(j)  (2304 + 64 * (j))
#define XB_TOP      3328
#define XB_TOPGEN   3392
#define XCD_BAR_WORDS 3456
#define XB_SPIN_CAP (1u << 20)
__device__ __forceinline__ unsigned xb_ld(unsigned* p)              { return __hip_atomic_load(p, __ATOMIC_RELAXED, __HIP_MEMORY_SCOPE_AGENT); }
__device__ __forceinline__ unsigned xb_add(unsigned* p, unsigned v) { return __hip_atomic_fetch_add(p, v, __ATOMIC_RELAXED, __HIP_MEMORY_SCOPE_AGENT); }
__device__ __forceinline__ unsigned xb_xcc_id() { return (unsigned)__builtin_amdgcn_s_getreg((3 << 11) | 20) & 0xFu; }
#define XB_SPIN(cond, bar) do { unsigned _sp = 0; while (cond) { __builtin_amdgcn_s_sleep(1); \
    if ((++_sp & 255u) == 0u) { if (xb_ld(&(bar)[XB_TMO])) break; if (_sp > XB_SPIN_CAP) { atomicAdd(&(bar)[XB_TMO], 1u); break; } } } } while (0)
struct XcdBarrier { unsigned* bar; unsigned x; volatile LAS unsigned* st; };
__device__ __forceinline__ XcdBarrier xcd_barrier_post(unsigned* bar, volatile LAS unsigned* st) {
    XcdBarrier b; b.bar = bar; b.x = xb_xcc_id(); b.st = st;
    if (threadIdx.x == 0) (void)xb_add(&bar[XB_XCNT(b.x)], 1u);
    return b;
}
__device__ __forceinline__ void xcd_barrier_complete(unsigned* bar, unsigned x, unsigned& nloc, unsigned& nx) {
    const unsigned G = gridDim.x * gridDim.y * gridDim.z;
    unsigned sum, cnt, mine, sp = 0u;
    for (;;) {
        sum = 0u; cnt = 0u; mine = 0u;
#pragma unroll
        for (unsigned j = 0; j < 16; ++j) { const unsigned c = xb_ld(&bar[XB_XCNT(j)]); sum += c; cnt += (c > 0u) ? 1u : 0u; mine = (j == x) ? c : mine; }
        if (sum == G) break;
        __builtin_amdgcn_s_sleep(1);
        if ((++sp & 255u) == 0u) { if (xb_ld(&bar[XB_TMO])) break; if (sp > XB_SPIN_CAP) { atomicAdd(&bar[XB_TMO], 1u); break; } }
    }
    nloc = mine > 0u ? mine : 1u; nx = cnt > 0u ? cnt : 1u;
}
__device__ __forceinline__ void xcd_barrier(const XcdBarrier& b) {
    asm volatile("s_waitcnt vmcnt(0)" ::: "memory");
    __syncthreads();
    if (threadIdx.x == 0) {
        unsigned* bar = b.bar;
        __builtin_amdgcn_s_waitcnt(0);
        unsigned nloc = b.st[0], nx = b.st[1];
        if (nloc == 0u) { xcd_barrier_complete(bar, b.x, nloc, nx); b.st[0] = nloc; b.st[1] = nx; }
        const unsigned old = xb_add(&bar[XB_XSUB(b.x)], 1u);
        const unsigned gen = old / nloc;
        if (old + 1u == (gen + 1u) * nloc) {
            __builtin_amdgcn_fence(__ATOMIC_RELEASE, "agent");
            asm volatile("s_waitcnt vmcnt(0)" ::: "memory");
            const unsigned og = xb_add(&bar[XB_TOP], 1u);
            const unsigned tg = og / nx;
            if (og + 1u == (tg + 1u) * nx) xb_add(&bar[XB_TOPGEN], 1u);
            else XB_SPIN(xb_ld(&bar[XB_TOPGEN]) == tg, bar);
            __builtin_amdgcn_fence(__ATOMIC_ACQUIRE, "agent");
            xb_add(&bar[XB_XGEN(b.x)], 1u);
            asm volatile("s_waitcnt vmcnt(0)" ::: "memory");
        } else {
            XB_SPIN(xb_ld(&bar[XB_XGEN(b.x)]) == gen, bar);
            __builtin_amdgcn_fence(__ATOMIC_ACQUIRE, "agent");
            asm volatile("s_waitcnt vmcnt(0)" ::: "memory");
        }
    }
    __syncthreads();
}

namespace pg8 {
constexpr int BM = 256, BK = 64, HALF = 128, HTB = HALF * BK * 2, STAGE_BYTES = 8 * HTB, NXCD = 8, WGM = 8;
__host__ __device__ __forceinline__ int lds_byte(int r, int c) { const int st = (r >> 4) * 2 + (c >> 5), rr = r & 15, cc = c & 31, ob = rr * 64 + cc * 2; return st * 1024 + (ob ^ (((ob >> 9) & 1) << 5)); }
__host__ __device__ __forceinline__ void stage_rc(int b, int& R, int& C) { const int st = b / 1024, sb = b % 1024, swz = sb ^ (((sb >> 9) & 1) << 5); R = (st >> 1) * 16 + swz / 64; C = (st & 1) * 32 + (swz % 64) / 2; }
__host__ __device__ __forceinline__ int perm32(int rho) { const int n = rho >> 4, i = rho & 15; return 8 * (i >> 2) + 4 * n + (i & 3); }

struct Unit { int pm, pn; const char* a; const char* b; const int* gi; int nvalid; int aux; };

struct StaticOrder {
    int nM, nN, nwg, G, c, RS; const char* A; const char* Bt;
    __device__ void init(const void* A_, const void* Bt_, int M, int N, int RS_, int G_, int c_) { A = (const char*)A_; Bt = (const char*)Bt_; RS = RS_; nM = M / BM; nN = N / BM; nwg = nM * nN; G = G_; c = c_; }
    __device__ bool next(int i, Unit& u) const {
        const long L = (long)i * G + c; if (L >= nwg) return false;
        int wgid = (int)L; { const int q = nwg / NXCD, r = nwg % NXCD, xcd = wgid % NXCD, off = wgid / NXCD; wgid = (xcd < r ? xcd * (q + 1) : r * (q + 1) + (xcd - r) * q) + off; }
        const int nig = WGM * nN, gid = wgid / nig, fm = gid * WGM, gsz = (nM - fm) < WGM ? (nM - fm) : WGM;
        u.pm = fm + ((wgid % nig) % gsz); u.pn = (wgid % nig) / gsz;
        u.a = A + (size_t)u.pm * BM * RS; u.b = Bt + (size_t)u.pn * BM * RS; u.gi = nullptr; u.nvalid = BM; u.aux = 0; return true;
    }
};

typedef int i32x8 __attribute__((ext_vector_type(8)));
typedef int i32x4v __attribute__((ext_vector_type(4)));
template <class Epi, class Sched, bool GATHER, bool FP8 = false>
__device__ __forceinline__ void gemm_phase(LAS unsigned char* lds, const int RS, const Sched& S, const Epi& E, const int scale_b = 0x7f7f7f7f, const int scale_a = 0x7f7f7f7f) {
    int tid = threadIdx.x; asm volatile("" : "+v"(tid));
    const int wid = __builtin_amdgcn_readfirstlane(tid >> 6), lane = tid & 63, wr = wid >> 2, wc = wid & 3, fr = lane & 15, fq = lane >> 4;
    const int nt = RS / (BK * 2); const int K = RS;
    unsigned voffA[2], voffB[2]; int RA[2], CA[2];
#pragma unroll
    for (int i = 0; i < 2; ++i) { int R, C; stage_rc(tid * 16 + i * 8192, R, C); const int Rb = ((R & ~31) + perm32(R & 31));
        RA[i] = R; CA[i] = C; voffA[i] = (unsigned)(R * RS + C * 2); voffB[i] = (unsigned)(Rb * RS + C * 2); }
    const size_t kstep = (size_t)(BK * 2);
    const size_t hstep = (size_t)HALF * RS;
    const unsigned ldsw = (unsigned)wid * 1024u;
    const int aoff = lds_byte(wr * 64 + fr, fq * 8), boff = lds_byte(wc * 32 + fr, fq * 8);
    unsigned gA[2][2], gN[2][2];
#define PG8_SA(b, h) (((b) * 2 + (h)) * HTB)
#define PG8_SB(b, h) ((4 + (b) * 2 + (h)) * HTB)
#define PG8_STAGE(bufoff, gbase, voff) do { _Pragma("unroll") for (int _i = 0; _i < 2; ++_i) \
        __builtin_amdgcn_global_load_lds((const unsigned*)((const char*)(gbase) + (voff)[_i]), (LAS unsigned*)(lds + (bufoff) + ldsw + _i * 8192), 16, 0, 0); } while (0)
#define PG8_STAGE_A(bufoff, gp, h, NX) do { if constexpr (GATHER) { if (NX) PG8_STAGE(bufoff, gp, gN[h]); else PG8_STAGE(bufoff, gp, gA[h]); } else PG8_STAGE(bufoff, (gp) + (h) * hstep, voffA); } while (0)
#define PG8_LD8(p_) __builtin_shufflevector(*(const LAS i32x4v*)(p_), *(const LAS i32x4v*)((p_) + 1024), 0, 1, 2, 3, 4, 5, 6, 7)
#define PG8_LDA(dst, b, h) do { if constexpr (FP8) { _Pragma("unroll") for (int m = 0; m < 4; ++m) dst##8[m] = PG8_LD8(lds + PG8_SA(b, h) + aoff + m * 2048); } \
        else { _Pragma("unroll") for (int m = 0; m < 4; ++m) _Pragma("unroll") for (int k = 0; k < 2; ++k) dst[m][k] = *(const LAS bf16x8*)(lds + PG8_SA(b, h) + aoff + m * 2048 + k * 1024); } } while (0)
#define PG8_LDB(dst, b, h) do { if constexpr (FP8) { _Pragma("unroll") for (int n = 0; n < 2; ++n) dst##8[n] = PG8_LD8(lds + PG8_SB(b, h) + boff + n * 2048); } \
        else { _Pragma("unroll") for (int n = 0; n < 2; ++n) _Pragma("unroll") for (int k = 0; k < 2; ++k) dst[n][k] = *(const LAS bf16x8*)(lds + PG8_SB(b, h) + boff + n * 2048 + k * 1024); } } while (0)
#define PG8_MMA(ai, bj, At, Bt) do { __builtin_amdgcn_s_setprio(1); \
        if constexpr (FP8) { _Pragma("unroll") for (int m = 0; m < 4; ++m) _Pragma("unroll") for (int n = 0; n < 2; ++n) \
            asm volatile("v_mfma_scale_f32_16x16x128_f8f6f4 %0, %1, %2, %0, %3, %4 op_sel_hi:[0,0,0]" : "+v"(acc[ai][bj][m][n]) : "v"(Bt##8[n]), "v"(At##8[m]), "v"(sc_b), "v"(sc_a)); } \
        else { _Pragma("unroll") for (int m = 0; m < 4; ++m) _Pragma("unroll") for (int n = 0; n < 2; ++n) _Pragma("unroll") for (int k = 0; k < 2; ++k) \
            acc[ai][bj][m][n] = __builtin_amdgcn_mfma_f32_16x16x32_bf16(Bt[n][k], At[m][k], acc[ai][bj][m][n], 0, 0, 0); } \
        __builtin_amdgcn_s_setprio(0); } while (0)
#define PG8_WAIT_V(n) asm volatile("s_waitcnt vmcnt(" #n ")" ::: "memory")
#define PG8_WAIT_L(n) asm volatile("s_waitcnt lgkmcnt(" #n ")" ::: "memory")
#define PG8_BAR __builtin_amdgcn_s_barrier()
#define PG8_SCHED __builtin_amdgcn_sched_barrier(0)
#define PG8_GIDX(dst, u) do { if constexpr (GATHER) { _Pragma("unroll") for (int h = 0; h < 2; ++h) _Pragma("unroll") for (int i = 0; i < 2; ++i) { \
        const int rr = h * HALF + RA[i]; const int tok = rr < (u).nvalid ? (u).gi[rr] : 0; dst[h][i] = (unsigned)(tok * K + CA[i] * 2); } } } while (0)
    Unit cur, nxt; int ui = 0;
    if (!S.next(0, cur)) return;
    f32x4 acc[2][2][4][2];
#pragma unroll
    for (int a = 0; a < 2; ++a)
#pragma unroll
        for (int b = 0; b < 2; ++b)
#pragma unroll
            for (int m = 0; m < 4; ++m)
#pragma unroll
                for (int n = 0; n < 2; ++n) acc[a][b][m][n] = (f32x4){0.f, 0.f, 0.f, 0.f};
    const int sc_b = scale_b, sc_a = scale_a;
    bf16x8 At[4][2], B0[2][2], B1[2][2]; i32x8 At8[4], B08[2], B18[2];
    const char* cA = cur.a; const char* cB = cur.b;
    PG8_GIDX(gA, cur);
    PG8_STAGE(PG8_SB(0, 0), cB, voffB); PG8_STAGE_A(PG8_SA(0, 0), cA, 0, false); PG8_STAGE(PG8_SB(0, 1), cB + hstep, voffB); PG8_STAGE_A(PG8_SA(0, 1), cA, 1, false);
    if (wr == 1) PG8_BAR;
    PG8_WAIT_V(4); PG8_BAR;
    PG8_STAGE(PG8_SB(1, 0), cB + kstep, voffB); PG8_STAGE_A(PG8_SA(1, 0), cA + kstep, 0, false); PG8_STAGE(PG8_SB(1, 1), cB + hstep + kstep, voffB);
    PG8_WAIT_V(6); PG8_BAR;
    for (;;) {
        const bool has_next = S.next(ui + 1, nxt);
        const char* nA = has_next ? nxt.a : cA; const char* nB = has_next ? nxt.b : cB;
        if constexpr (GATHER) { if (has_next) { PG8_GIDX(gN, nxt); } else {
#pragma unroll
            for (int h = 0; h < 2; ++h)
#pragma unroll
                for (int i = 0; i < 2; ++i) gN[h][i] = gA[h][i]; } }
        for (int t = 0; t < nt; t += 2) {
            const bool last = (t == nt - 2);
            const char* a1 = cA + (size_t)(t + 1) * kstep;
            const char* a2 = last ? nA : cA + (size_t)(t + 2) * kstep; const char* b2 = last ? nB : cB + (size_t)(t + 2) * kstep;
            const char* a3 = a2 + kstep; const char* b3 = b2 + kstep;
            PG8_LDB(B0, 0, 0); PG8_SCHED; PG8_LDA(At, 0, 0); PG8_STAGE_A(PG8_SA(1, 1), a1, 1, false);
            PG8_WAIT_L(8); PG8_BAR; PG8_WAIT_L(0); PG8_MMA(0, 0, At, B0); PG8_BAR; PG8_SCHED;
            PG8_LDB(B1, 0, 1); PG8_STAGE(PG8_SB(0, 0), b2, voffB);
            PG8_BAR; PG8_WAIT_L(0); PG8_MMA(0, 1, At, B1); PG8_BAR;
            PG8_LDA(At, 0, 1); PG8_STAGE_A(PG8_SA(0, 0), a2, 0, last);
            PG8_BAR; PG8_WAIT_L(0); PG8_MMA(1, 0, At, B0); PG8_BAR; PG8_SCHED;
            PG8_STAGE(PG8_SB(0, 1), b2 + hstep, voffB);
            PG8_WAIT_V(6); PG8_BAR; PG8_MMA(1, 1, At, B1); PG8_BAR;
            PG8_LDB(B0, 1, 0); PG8_SCHED; PG8_LDA(At, 1, 0); PG8_STAGE_A(PG8_SA(0, 1), a2, 1, last);
            PG8_WAIT_L(8); PG8_BAR; PG8_WAIT_L(0); PG8_MMA(0, 0, At, B0); PG8_BAR; PG8_SCHED;
            PG8_LDB(B1, 1, 1); PG8_STAGE(PG8_SB(1, 0), b3, voffB);
            PG8_BAR; PG8_WAIT_L(0); PG8_MMA(0, 1, At, B1); PG8_BAR;
            PG8_LDA(At, 1, 1); PG8_STAGE_A(PG8_SA(1, 0), a3, 0, last);
            PG8_BAR; PG8_WAIT_L(0); PG8_MMA(1, 0, At, B0); PG8_BAR; PG8_SCHED;
            PG8_STAGE(PG8_SB(1, 1), b3 + hstep, voffB);
            PG8_WAIT_V(6); PG8_BAR; PG8_MMA(1, 1, At, B1); PG8_BAR;
        }
        bool keep_acc = false;
        if constexpr (FP8) asm volatile("s_nop 15\n\ts_nop 15" ::: "memory");
        if constexpr (Epi::DUAL) { if (cur.aux) { E.mid(acc, cur, wr, wc, fr, fq); keep_acc = true; } else E(acc, cur, wr, wc, fr, fq); } else E(acc, cur, wr, wc, fr, fq);
        if (!has_next) break;
        if (!keep_acc)
#pragma unroll
        for (int a = 0; a < 2; ++a)
#pragma unroll
            for (int b = 0; b < 2; ++b)
#pragma unroll
                for (int m = 0; m < 4; ++m)
#pragma unroll
                    for (int n = 0; n < 2; ++n) acc[a][b][m][n] = (f32x4){0.f, 0.f, 0.f, 0.f};
        cur = nxt; cA = nA; cB = nB; ++ui;
        if constexpr (GATHER) {
#pragma unroll
            for (int h = 0; h < 2; ++h)
#pragma unroll
                for (int i = 0; i < 2; ++i) gA[h][i] = gN[h][i]; }
    }
    PG8_WAIT_V(0);
    if (wr == 0) PG8_BAR;
    PG8_BAR;
#undef PG8_SA
#undef PG8_SB
#undef PG8_STAGE
#undef PG8_STAGE_A
#undef PG8_LDA
#undef PG8_LD8
#undef PG8_LDB
#undef PG8_MMA
#undef PG8_WAIT_V
#undef PG8_WAIT_L
#undef PG8_BAR
#undef PG8_SCHED
#undef PG8_GIDX
}
}
using pg8::Unit;

#define EPI_LOOP(...) { int fr_ = fr, fq_ = fq; asm volatile("" : "+v"(fr_), "+v"(fq_)); _Pragma("unroll") for (int ai = 0; ai < 2; ++ai) _Pragma("unroll") for (int m = 0; m < 4; ++m) _Pragma("unroll") for (int bj = 0; bj < 2; ++bj) { \
        const int trow = ai * 128 + wr * 64 + m * 16 + fr_; const int tcol = bj * 128 + wc * 32 + fq_ * 8; const f32x4 v0 = acc[ai][bj][m][0], v1 = acc[ai][bj][m][1]; __VA_ARGS__ } }

__device__ __forceinline__ u32x4 pack8(const f32x4 a, const f32x4 b) { u32x4 w; w.x = cvt_pk_bf16(a[0], a[1]); w.y = cvt_pk_bf16(a[2], a[3]); w.z = cvt_pk_bf16(b[0], b[1]); w.w = cvt_pk_bf16(b[2], b[3]); return w; }

struct EpiProj { static constexpr bool DUAL = false;
    unsigned char* ws; const float* b_gate;
    __device__ __forceinline__ void operator()(const f32x4 (&acc)[2][2][4][2], const Unit& u, int wr, int wc, int fr, int fq) const {
        const int pn = u.pn; const size_t row0 = (size_t)u.pm * 256;
        if (pn == 4 || pn == 9) {
            float* dst = (float*)(ws + (pn == 4 ? WS_CKV : WS_MISC));
            EPI_LOOP({ float* p = dst + (row0 + trow) * 256 + tcol; *(f32x4*)p = v0; *(f32x4*)(p + 4) = v1;
                if (pn == 9 && tcol < 64) *(u32x4*)((bf16_t*)(ws + WS_KIDX) + (row0 + trow) * 64 + tcol) = pack8(v0, v1); })
        } else if (pn < 22) {
            bf16_t* dst; int ct;
            if (pn < 4) { dst = (bf16_t*)(ws + WS_QA); ct = pn; } else if (pn < 9) { dst = (bf16_t*)(ws + WS_QIDX); ct = pn - 5; }
            else if (pn < 14) { dst = (bf16_t*)(ws + WS_QB); ct = pn - 10; } else if (pn < 18) { dst = (bf16_t*)(ws + WS_KB); ct = pn - 14; } else { dst = (bf16_t*)(ws + WS_VB); ct = pn - 18; }
            EPI_LOOP({ *(u32x4*)(dst + (row0 + trow) * 1024 + ct * 256 + tcol) = pack8(v0, v1); })
        } else {
            bf16_t* dst = (bf16_t*)(ws + WS_GATES); const int ct = pn - 22;
            EPI_LOOP({ const int col = ct * 256 + tcol; const f32x4 b0 = *(const f32x4*)(b_gate + col), b1 = *(const f32x4*)(b_gate + col + 4); f32x4 s0, s1;
                _Pragma("unroll") for (int j = 0; j < 4; ++j) { s0[j] = sigmoidf_(v0[j] + b0[j]); s1[j] = sigmoidf_(v1[j] + b1[j]); }
                u32x2 w8; w8.x = pack_u8x4(s0[0], s0[1], s0[2], s0[3]); w8.y = pack_u8x4(s1[0], s1[1], s1[2], s1[3]); *(u32x2*)((unsigned char*)dst + (row0 + trow) * 4096 + col) = w8; })
        }
    }
};
struct EpiGate1 { static constexpr bool DUAL = false;
    const bf16_t* gates; bf16_t* T1;
    __device__ __forceinline__ void operator()(const f32x4 (&acc)[2][2][4][2], const Unit& u, int wr, int wc, int fr, int fq) const {
        EPI_LOOP({ const size_t row = (size_t)u.pm * 256 + trow; const int col = u.pn * 256 + tcol; const u32x2 g = *(const u32x2*)((const unsigned char*)gates + row * 4096 + col);
            const f32x4 o0 = v0 * unpack_u8x4(g.x), o1 = v1 * unpack_u8x4(g.y);
            *(u32x4*)(T1 + row * 2048 + col) = pack8(o0, o1); })
    }
};
struct EpiGate2 { static constexpr bool DUAL = false;
    const bf16_t* gates; const bf16_t* T1; unsigned char* merged;
    __device__ __forceinline__ void operator()(const f32x4 (&acc)[2][2][4][2], const Unit& u, int wr, int wc, int fr, int fq) const {
        EPI_LOOP({ const size_t row = (size_t)u.pm * 256 + trow; const int col = u.pn * 256 + tcol; const u32x2 g = *(const u32x2*)((const unsigned char*)gates + row * 4096 + 2048 + col);
            const u32x4 t = *(const u32x4*)(T1 + row * 2048 + col);
            const f32x4 o0 = (f32x4){bf_lo(t.x), bf_hi(t.x), bf_lo(t.y), bf_hi(t.y)} + v0 * unpack_u8x4(g.x), o1 = (f32x4){bf_lo(t.z), bf_hi(t.z), bf_lo(t.w), bf_hi(t.w)} + v1 * unpack_u8x4(g.y);
            u32x2 w8; w8.x = pack_fp8x4(o0[0] * 4.f, o0[1] * 4.f, o0[2] * 4.f, o0[3] * 4.f); w8.y = pack_fp8x4(o1[0] * 4.f, o1[1] * 4.f, o1[2] * 4.f, o1[3] * 4.f);
            *(u32x2*)(merged + row * 2048 + col) = w8; })
    }
};
struct EpiWo { static constexpr bool DUAL = false;
    const float* mod; bf16_t* y;
    __device__ __forceinline__ void operator()(const f32x4 (&acc)[2][2][4][2], const Unit& u, int wr, int wc, int fr, int fq) const {
        const float* gt = mod + (size_t)(u.pm >> 3) * 12288 + 4096;
        EPI_LOOP({ const size_t row = (size_t)u.pm * 256 + trow; const int col = u.pn * 256 + tcol;
            const f32x4 g0 = *(const f32x4*)(gt + col), g1 = *(const f32x4*)(gt + col + 4);
            *(u32x4*)(y + row * 2048 + col) = pack8(g0 * v0, g1 * v1); })
    }
};
struct DualOrder {
    pg8::StaticOrder S0, S1;
    __device__ bool next(int i, Unit& u) const { const bool ok = (i & 1) ? S1.next(i >> 1, u) : S0.next(i >> 1, u); u.aux = (i & 1) ? 0 : 1; return ok; }
};
struct EpiGate12 { static constexpr bool DUAL = false;
    EpiGate1 e1; EpiGate2 e2;
    __device__ __forceinline__ void operator()(const f32x4 (&acc)[2][2][4][2], const Unit& u, int wr, int wc, int fr, int fq) const { if (u.aux) e1(acc, u, wr, wc, fr, fq); else e2(acc, u, wr, wc, fr, fq); }
};

struct ProjOrder {
    pg8::StaticOrder S; int fp8; const char* Bfull;
    __device__ bool next(int i, Unit& u) const {
        if (!S.next(i, u)) return false;
        if (fp8) { if (u.pn >= 2) u.pn += 8; } else u.pn += 2;
        return true;
    }
};
__device__ __forceinline__ int map_row(int map, int n) {
    if (map == 0) return n;
    if (map == 1) { if (n < 2384) return n; if (n < 5456) return n + 176; if (n < 5464) return n - 3072; return n + 168; }
    if (map == 4) return n + 512;
    return n + 2384;
}
__device__ void ph0_prologue(const Params& p, LAS unsigned char* lds) {
    const int tid = threadIdx.x, wid = tid >> 6, lane = tid & 63, G = gridDim.x, bx = blockIdx.x;
    if (bx < 192) {
        LAS float* sc = (LAS float*)lds;
        LAS float* red = (LAS float*)(lds + 32768);
        const float* c = p.in[I_C];
        for (int i = tid; i < 4 * 2048; i += NTHREADS) { const float v = c[i]; sc[i] = v / (1.0f + __expf(-v)); }
        __syncthreads();
        for (int item = bx; item < 192; item += G) {
            const int n0 = item * 64, cg = lane & 15, rs = lane >> 4;
            float acc[4][4];
#pragma unroll
            for (int b = 0; b < 4; ++b)
#pragma unroll
                for (int j = 0; j < 4; ++j) acc[b][j] = 0.f;
            const float* w = p.in[I_WADA] + n0 + cg * 4;
#pragma unroll 4
            for (int step = 0; step < 64; ++step) {
                const int k = step * 32 + wid * 4 + rs;
                const f32x4 wv = *(const f32x4*)(w + (size_t)k * 12288);
#pragma unroll
                for (int b = 0; b < 4; ++b) { const float s = sc[b * 2048 + k];
#pragma unroll
                    for (int j = 0; j < 4; ++j) acc[b][j] += s * wv[j]; }
            }
#pragma unroll
            for (int b = 0; b < 4; ++b)
#pragma unroll
                for (int j = 0; j < 4; ++j) { float v = acc[b][j]; v += __shfl_xor(v, 16); v += __shfl_xor(v, 32); acc[b][j] = v; }
            if (rs == 0) {
#pragma unroll
                for (int b = 0; b < 4; ++b)
#pragma unroll
                    for (int j = 0; j < 4; ++j) red[(wid * 16 + cg) * 16 + b * 4 + j] = acc[b][j]; }
            __syncthreads();
            if (tid < 256) { const int cg2 = tid >> 4, bj = tid & 15, b = bj >> 2, j = bj & 3; float s = 0.f;
#pragma unroll
                for (int w8 = 0; w8 < 8; ++w8) s += red[(w8 * 16 + cg2) * 16 + bj];
                const int n = n0 + cg2 * 4 + j; ((float*)(p.ws + WS_MOD))[b * 12288 + n] = s + p.in[I_BADA][n]; }
            __syncthreads();
        }
    }
    { u32x4* z = (u32x4*)(p.ws + WS_WIN + (size_t)2392 * 2048 * 2); const int n16 = 168 * 2048 * 2 / 16;
      for (int i = bx * NTHREADS + tid; i < n16; i += G * NTHREADS) z[i] = (u32x4){0u, 0u, 0u, 0u}; }
    { bf16_t* wh = (bf16_t*)(p.ws + WS_WRH); bf16_t* wl = (bf16_t*)(p.ws + WS_WRL);
      for (int i = bx * NTHREADS + tid; i < 80 * 2048; i += G * NTHREADS) { const int n = i >> 11, k = i & 2047;
          const float v = n < 8 ? p.in[I_WRG][k * 8 + n] : (n < 72 ? p.in[I_WRE][k * 64 + n - 8] : 0.f);
          const unsigned h = cvt_pk_bf16(v, 0.f) & 0xffffu; const unsigned l = cvt_pk_bf16(v - bf_lo(h), 0.f) & 0xffffu; wh[i] = (bf16_t)h; wl[i] = (bf16_t)l; } }
    LAS float* tile = (LAS float*)(lds + 65536);
    for (int ti = bx; ti < p.ntiles_total; ti += G) {
        int j = 0;
#pragma unroll 1
        for (int q = 1; q < NJOBS; ++q) if (ti >= p.jobs[q].tile0) j = q;
        const TJob& J = p.jobs[j];
        int l = ti - J.tile0; const int per = J.ntk * J.ntn; const int bt = l / per; l -= bt * per; const int tn = l / J.ntk, tk = l % J.ntk;
        const float* src = J.src + (size_t)bt * J.sbatch; bf16_t* dst = J.dst + (size_t)bt * J.dbatch;
        const int k0 = tk * 64, n0 = tn * 128;
        f32x4 v[4];
#pragma unroll
        for (int i = 0; i < 4; ++i) { const int r = (tid >> 5) + 16 * i, c4 = (tid & 31) * 4;
            v[i] = (f32x4){0.f, 0.f, 0.f, 0.f}; if (n0 + c4 < J.N) v[i] = *(const f32x4*)(src + (size_t)(k0 + r) * J.ld + n0 + c4); }
#pragma unroll
        for (int i = 0; i < 4; ++i) { const int r = (tid >> 5) + 16 * i, c4 = (tid & 31) * 4;
#pragma unroll
            for (int q = 0; q < 4; ++q) tile[r * 129 + c4 + q] = v[i][q]; }
        __syncthreads();
        { const int n = tid >> 2, kq = (tid & 3) * 16;
          if (n0 + n < J.N) { float f[16];
#pragma unroll
              for (int q = 0; q < 16; ++q) f[q] = tile[(kq + q) * 129 + n];
              u32x4 w0, w1; w0.x = cvt_pk_bf16(f[0], f[1]); w0.y = cvt_pk_bf16(f[2], f[3]); w0.z = cvt_pk_bf16(f[4], f[5]); w0.w = cvt_pk_bf16(f[6], f[7]);
              w1.x = cvt_pk_bf16(f[8], f[9]); w1.y = cvt_pk_bf16(f[10], f[11]); w1.z = cvt_pk_bf16(f[12], f[13]); w1.w = cvt_pk_bf16(f[14], f[15]);
              if (J.fp8) { u32x4 w8; w8.x = pack_fp8x4(f[0] * 64.f, f[1] * 64.f, f[2] * 64.f, f[3] * 64.f); w8.y = pack_fp8x4(f[4] * 64.f, f[5] * 64.f, f[6] * 64.f, f[7] * 64.f);
                  w8.z = pack_fp8x4(f[8] * 64.f, f[9] * 64.f, f[10] * 64.f, f[11] * 64.f); w8.w = pack_fp8x4(f[12] * 64.f, f[13] * 64.f, f[14] * 64.f, f[15] * 64.f);
                  *(u32x4*)((unsigned char*)dst + (size_t)(n0 + n) * J.ldd + k0 + kq) = w8; }
              else { bf16_t* d = dst + (size_t)map_row(J.map, n0 + n) * J.ldd + k0 + kq; *(u32x4*)d = w0; *(u32x4*)(d + 8) = w1; } } }
        __syncthreads();
    }
}

__device__ __forceinline__ void norm_row(const float* xr, const float* g, const float* sh, const float* sc, bf16_t* hr, unsigned char* h8, int lane, float (&hv)[32]) {
    f32x4 v[8]; float ss = 0.f;
#pragma unroll
    for (int i = 0; i < 8; ++i) { v[i] = *(const f32x4*)(xr + i * 256 + lane * 4); ss += v[i][0] * v[i][0] + v[i][1] * v[i][1] + v[i][2] * v[i][2] + v[i][3] * v[i][3]; }
    ss = wave_sum(ss);
    const float rstd = rsqrtf(ss * (1.0f / 2048.0f) + RMS_EPS);
#pragma unroll
    for (int i = 0; i < 8; ++i) { const int col = i * 256 + lane * 4; const f32x4 gg = *(const f32x4*)(g + col), s1 = *(const f32x4*)(sc + col), s0 = *(const f32x4*)(sh + col);
#pragma unroll
        for (int j = 0; j < 4; ++j) hv[i * 4 + j] = v[i][j] * rstd * gg[j] * (1.0f + s1[j]) + s0[j];
        u32x2 w; w.x = cvt_pk_bf16(hv[i * 4], hv[i * 4 + 1]); w.y = cvt_pk_bf16(hv[i * 4 + 2], hv[i * 4 + 3]); *(u32x2*)(hr + col) = w;
        if (h8) *(unsigned*)(h8 + col) = pack_fp8x4(hv[i * 4], hv[i * 4 + 1], hv[i * 4 + 2], hv[i * 4 + 3]); }
}
__device__ void ph1_norm(const Params& p) {
    const int lane = threadIdx.x & 63, gw = blockIdx.x * 8 + (threadIdx.x >> 6), nw = gridDim.x * 8;
    const float* mod = (const float*)(p.ws + WS_MOD);
    for (int t = gw; t < NTOK; t += nw) { const int b = t >> 11; float hv[32];
        norm_row(p.in[I_X] + (size_t)t * DM, p.in[I_GMIX], mod + b * 12288, mod + b * 12288 + 2048, (bf16_t*)(p.ws + WS_H) + (size_t)t * DM, (unsigned char*)(p.ws + WS_HF8) + (size_t)t * DM, lane, hv); }
}

template <int MB, int NB, int KS>
__device__ __forceinline__ void wave_gemm(const bf16_t* A, int lda, const bf16_t* Bt, int ldb, f32x4 (&acc)[MB][NB], int lane) {
    const int fr = lane & 15, fq = lane >> 4;
#pragma unroll
    for (int mb = 0; mb < MB; ++mb)
#pragma unroll
        for (int nb = 0; nb < NB; ++nb) acc[mb][nb] = (f32x4){0.f, 0.f, 0.f, 0.f};
#pragma unroll 1
    for (int ks = 0; ks < KS; ++ks) {
        bf16x8 af[MB];
#pragma unroll
        for (int mb = 0; mb < MB; ++mb) af[mb] = *(const bf16x8*)(A + (size_t)(mb * 16 + fr) * lda + ks * 32 + fq * 8);
#pragma unroll
        for (int nb = 0; nb < NB; ++nb) { const bf16x8 bf = *(const bf16x8*)(Bt + (size_t)(nb * 16 + fr) * ldb + ks * 32 + fq * 8);
#pragma unroll
            for (int mb = 0; mb < MB; ++mb) acc[mb][nb] = __builtin_amdgcn_mfma_f32_16x16x32_bf16(bf, af[mb], acc[mb][nb], 0, 0, 0); }
    }
}


__device__ __forceinline__ int wave_total_i32(int v) {
    v += __builtin_amdgcn_update_dpp(0, v, 0x111, 0xf, 0xf, true); v += __builtin_amdgcn_update_dpp(0, v, 0x112, 0xf, 0xf, true);
    v += __builtin_amdgcn_update_dpp(0, v, 0x114, 0xf, 0xf, true); v += __builtin_amdgcn_update_dpp(0, v, 0x118, 0xf, 0xf, true);
    v += __builtin_amdgcn_update_dpp(0, v, 0x142, 0xa, 0xf, false); v += __builtin_amdgcn_update_dpp(0, v, 0x143, 0xc, 0xf, false);
    return __builtin_amdgcn_readlane(v, 63);
}
template <int NI> __device__ __forceinline__ void topk_words2(const LAS float* srow0, const LAS float* srow1, int c, int lane, unsigned long long& w0, unsigned long long& w1) {
    unsigned ka[NI], kb[NI];
#pragma unroll
    for (int i = 0; i < NI; ++i) { unsigned u = 0u, x = 0u; if (i <= c) { u = __float_as_uint(srow0[i * 64 + lane]); u = (u & 0x80000000u) ? ~u : (u | 0x80000000u);
            x = __float_as_uint(srow1[i * 64 + lane]); x = (x & 0x80000000u) ? ~x : (x | 0x80000000u); } ka[i] = u; kb[i] = x; }
    unsigned va = 0u, vb = 0u; bool da = false, db = false;
#pragma unroll 1
    for (int bit = 31; bit >= 0; --bit) {
        const unsigned ca = va | (1u << bit), cb = vb | (1u << bit); int a0 = 0, a1 = 0, b0 = 0, b1 = 0;
#pragma unroll
        for (int i = 0; i < NI; i += 2) { a0 += (ka[i] >= ca) ? 1 : 0; a1 += (ka[i + 1] >= ca) ? 1 : 0; b0 += (kb[i] >= cb) ? 1 : 0; b1 += (kb[i + 1] >= cb) ? 1 : 0; }
        const int ta = wave_total_i32(a0 + a1), tb = wave_total_i32(b0 + b1);
        if (!da && ta >= 256) { va = ca; da = (ta == 256); }
        if (!db && tb >= 256) { vb = cb; db = (tb == 256); }
        if (da && db) break;
    }
    w0 = 0ull; w1 = 0ull;
#pragma unroll
    for (int i = 0; i < NI; ++i) { const unsigned long long ma = __ballot(ka[i] >= va), mb = __ballot(kb[i] >= vb); if (lane == i) { w0 = ma; w1 = mb; } if ((i & 3) == 3) SBAR(); }
}

__device__ void idx_item(const Params& p, LAS unsigned char* lds, int b, int c, int sub) {
    const int tid = threadIdx.x, wid = tid >> 6, lane = tid & 63, fr = lane & 15, fq = lane >> 4;
    constexpr int SCLD = 2052;
    LAS float* sc = (LAS float*)lds;
    const int q0 = c * 64 + sub * 16, nk = (c + 1) * 64, nkb = nk / 16;
    const bf16_t* qidx = (const bf16_t*)(p.ws + WS_QIDX) + (size_t)(b * SEQ + q0 + fr) * 1024;
    const float* misc = (const float*)(p.ws + WS_MISC);
    float wq[16];
    { const float* wp = misc + (size_t)(b * SEQ + q0 + fr) * 256 + 64;
#pragma unroll
      for (int i = 0; i < 4; ++i) { const f32x4 v = *(const f32x4*)(wp + i * 4); wq[i * 4] = v[0]; wq[i * 4 + 1] = v[1]; wq[i * 4 + 2] = v[2]; wq[i * 4 + 3] = v[3]; } }
    {
        bf16x8 qf[16][2];
#pragma unroll
        for (int h = 0; h < 16; ++h)
#pragma unroll
            for (int ks = 0; ks < 2; ++ks) qf[h][ks] = *(const bf16x8*)(qidx + h * 64 + ks * 32 + fq * 8);
        const bf16_t* kbase = (const bf16_t*)(p.ws + WS_KIDX) + (size_t)(b * SEQ + fr) * 64 + fq * 8;
        bf16x8 kf[2];
        if (wid < nkb) { kf[0] = *(const bf16x8*)(kbase + (size_t)wid * 16 * 64); kf[1] = *(const bf16x8*)(kbase + (size_t)wid * 16 * 64 + 32); }
#pragma unroll 1
        for (int kb = wid; kb < nkb; kb += 8) {
            const int kn = kb + 8 < nkb ? kb + 8 : kb;
            const bf16x8 kn0 = *(const bf16x8*)(kbase + (size_t)kn * 16 * 64), kn1 = *(const bf16x8*)(kbase + (size_t)kn * 16 * 64 + 32);
            f32x4 s = {0.f, 0.f, 0.f, 0.f};
#pragma unroll
            for (int h = 0; h < 16; ++h) {
                f32x4 a = {0.f, 0.f, 0.f, 0.f};
                a = __builtin_amdgcn_mfma_f32_16x16x32_bf16(kf[0], qf[h][0], a, 0, 0, 0);
                a = __builtin_amdgcn_mfma_f32_16x16x32_bf16(kf[1], qf[h][1], a, 0, 0, 0);
#pragma unroll
                for (int j = 0; j < 4; ++j) s[j] += wq[h] * fmaxf(a[j], 0.f);
            }
            *(LAS f32x4*)(sc + fr * SCLD + kb * 16 + fq * 4) = s;
            kf[0] = kn0; kf[1] = kn1;
        }
    }
    __syncthreads();
    unsigned long long* mask = (unsigned long long*)(p.ws + WS_MASK);
    {
        const int ql = wid * 2; const size_t qg = (size_t)b * SEQ + q0 + ql;
        unsigned long long w0 = 0ull, w1 = 0ull;
        if (nk <= 256) { if (lane <= c) { w0 = ~0ull; w1 = ~0ull; } }
        else { const LAS float* s0 = sc + ql * SCLD; const LAS float* s1 = s0 + SCLD;
            if (c < 8) topk_words2<8>(s0, s1, c, lane, w0, w1); else if (c < 16) topk_words2<16>(s0, s1, c, lane, w0, w1);
            else if (c < 24) topk_words2<24>(s0, s1, c, lane, w0, w1); else topk_words2<32>(s0, s1, c, lane, w0, w1); }
        if (lane < 32) { mask[qg * 32 + lane] = w0; mask[(qg + 1) * 32 + lane] = w1; }
    }
    __syncthreads();
}
#ifndef REP_SUB
#define REP_SUB 15
#endif
__device__ void ph3_prep(const Params& p, LAS unsigned char* lds, const int rep) {
#define P3ON(bit) (!rep || ((REP_SUB) & (bit)))
    const int tid = threadIdx.x, wid = tid >> 6, lane = tid & 63, bx = blockIdx.x, G = gridDim.x;
    if (P3ON(1)) for (int it = bx; it < 256; it += G) {
        const int b = it >> 6, r = it & 63, cp = r >> 2, sub = r & 3;
        idx_item(p, lds, b, 31 - cp, sub); idx_item(p, lds, b, cp, sub);
    }
    const int gw = bx * 8 + wid, nw = G * 8;
    if (P3ON(2)) for (int it = gw; it < 2048; it += nw) {
        const int rt = it >> 3, h = it & 7, fr = lane & 15, fq = lane >> 4;
        f32x4 acc[2][16];
        wave_gemm<2, 16, 4>((const bf16_t*)(p.ws + WS_QA) + (size_t)rt * 32 * 1024 + h * 128, 1024, (const bf16_t*)(p.ws + WS_WUK) + (size_t)h * 256 * 128, 128, acc, lane);
#pragma unroll
        for (int mb = 0; mb < 2; ++mb) { float ss = 0.f;
#pragma unroll
            for (int nb = 0; nb < 16; ++nb)
#pragma unroll
                for (int j = 0; j < 4; ++j) ss += acc[mb][nb][j] * acc[mb][nb][j];
            ss += __shfl_xor(ss, 16); ss += __shfl_xor(ss, 32);
            const float rs = rsqrtf(ss * (1.0f / 256.0f) + RMS_EPS) * 0.0625f;
            bf16_t* o = (bf16_t*)(p.ws + WS_QLAT) + (size_t)(rt * 32 + mb * 16 + fr) * 2048 + h * 256;
#pragma unroll
            for (int nb = 0; nb < 16; ++nb) { const int col = nb * 16 + fq * 4; const f32x4 g = *(const f32x4*)(p.in[I_GQA] + col);
                u32x2 w; w.x = cvt_pk_bf16(acc[mb][nb][0] * rs * g[0], acc[mb][nb][1] * rs * g[1]); w.y = cvt_pk_bf16(acc[mb][nb][2] * rs * g[2], acc[mb][nb][3] * rs * g[3]); *(u32x2*)(o + col) = w; } }
    }
    if (P3ON(4))
#pragma unroll 4
    for (int t = gw; t < NTOK; t += nw) {
        { const f32x4 v = *(const f32x4*)((const float*)(p.ws + WS_CKV) + (size_t)t * 256 + lane * 4); float ss = wave_sum(v[0] * v[0] + v[1] * v[1] + v[2] * v[2] + v[3] * v[3]);
          const float rs = rsqrtf(ss * (1.0f / 256.0f) + RMS_EPS); const f32x4 g = *(const f32x4*)(p.in[I_GKV] + lane * 4);
          u32x2 w; w.x = cvt_pk_bf16(v[0] * rs * g[0], v[1] * rs * g[1]); w.y = cvt_pk_bf16(v[2] * rs * g[2], v[3] * rs * g[3]); *(u32x2*)((bf16_t*)(p.ws + WS_KV) + (size_t)t * 256 + lane * 4) = w; }
#pragma unroll
        for (int which = 0; which < 2; ++which) {
            bf16_t* row = (bf16_t*)(p.ws + (which ? WS_KB : WS_QB)) + (size_t)t * 1024 + lane * 16; const float* g = p.in[which ? I_GKB : I_GQB] + (lane & 7) * 16;
            u32x4 a = *(u32x4*)row, c2 = *(u32x4*)(row + 8); float f[16];
            f[0] = bf_lo(a.x); f[1] = bf_hi(a.x); f[2] = bf_lo(a.y); f[3] = bf_hi(a.y); f[4] = bf_lo(a.z); f[5] = bf_hi(a.z); f[6] = bf_lo(a.w); f[7] = bf_hi(a.w);
            f[8] = bf_lo(c2.x); f[9] = bf_hi(c2.x); f[10] = bf_lo(c2.y); f[11] = bf_hi(c2.y); f[12] = bf_lo(c2.z); f[13] = bf_hi(c2.z); f[14] = bf_lo(c2.w); f[15] = bf_hi(c2.w);
            float ss = 0.f;
#pragma unroll
            for (int j = 0; j < 16; ++j) ss += f[j] * f[j];
            ss += __shfl_xor(ss, 1); ss += __shfl_xor(ss, 2); ss += __shfl_xor(ss, 4);
            const float rs = rsqrtf(ss * (1.0f / 128.0f) + RMS_EPS) * (which ? 1.0f : 0.08838834764831845f);
#pragma unroll
            for (int j = 0; j < 16; ++j) f[j] *= rs * g[j];
            a.x = cvt_pk_bf16(f[0], f[1]); a.y = cvt_pk_bf16(f[2], f[3]); a.z = cvt_pk_bf16(f[4], f[5]); a.w = cvt_pk_bf16(f[6], f[7]);
            c2.x = cvt_pk_bf16(f[8], f[9]); c2.y = cvt_pk_bf16(f[10], f[11]); c2.z = cvt_pk_bf16(f[12], f[13]); c2.w = cvt_pk_bf16(f[14], f[15]);
            if (!rep) { *(u32x4*)row = a; *(u32x4*)(row + 8) = c2; } else if (a.x == 0x12345678u) *(u32x4*)row = c2;
        }
    }
    if (P3ON(8) && bx < NBATCH) {
        const int b = bx; const float* fp = (const float*)(p.ws + WS_MISC) + (size_t)(b * SEQ + 4 * tid) * 256 + 80;
        float ls[4][8];
#pragma unroll
        for (int j = 0; j < 4; ++j) { const f32x4 a = *(const f32x4*)(fp + j * 256), c4 = *(const f32x4*)(fp + j * 256 + 4);
#pragma unroll
            for (int h = 0; h < 8; ++h) { const float z = (h < 4 ? a[h & 3] : c4[h & 3]) + p.in[I_BFORGET][h]; ls[j][h] = fminf(z, 0.f) - log1pf(__expf(-fabsf(z))); } }
        LAS float* wt = (LAS float*)lds;
        float off[8];
#pragma unroll
        for (int h = 0; h < 8; ++h) { ls[1][h] += ls[0][h]; ls[2][h] += ls[1][h]; ls[3][h] += ls[2][h];
            float incl = ls[3][h];
#pragma unroll
            for (int o = 1; o < 64; o <<= 1) { const float t2 = __shfl_up(incl, o); if (lane >= o) incl += t2; }
            if (lane == 63) wt[wid * 8 + h] = incl;
            off[h] = incl - ls[3][h]; }
        __syncthreads();
#pragma unroll
        for (int h = 0; h < 8; ++h) { float wo = 0.f; for (int w8 = 0; w8 < wid; ++w8) wo += wt[w8 * 8 + h];
            float* cp = (float*)(p.ws + WS_CUM) + (size_t)(b * 8 + h) * SEQ + 4 * tid;
            *(f32x4*)cp = (f32x4){ls[0][h] + off[h] + wo, ls[1][h] + off[h] + wo, ls[2][h] + off[h] + wo, ls[3][h] + off[h] + wo}; }
        __syncthreads();
    }
}

template <int OFF> __device__ __forceinline__ s16x4 tr_read(int vb) { s16x4 r; asm volatile("ds_read_b64_tr_b16 %0, %1 offset:%2" : "=&v"(r) : "v"(vb), "i"(OFF) : "memory"); return r; }
__device__ __forceinline__ int v_rd_base(int lane) { return ((lane & 3) << 3) | (((lane >> 2) & 3) << 6) | (((lane >> 4) & 1) << 5) | (((lane >> 5) & 1) << 8); }
#define PK4(P, BASE, OUT) do { unsigned a0 = cvt_pk_bf16(P[BASE + 0], P[BASE + 1]), a1 = cvt_pk_bf16(P[BASE + 2], P[BASE + 3]);   \
    unsigned b0 = cvt_pk_bf16(P[BASE + 4], P[BASE + 5]), b1 = cvt_pk_bf16(P[BASE + 6], P[BASE + 7]);                              \
    auto r0 = __builtin_amdgcn_permlane32_swap(a0, b0, false, false); auto r1 = __builtin_amdgcn_permlane32_swap(a1, b1, false, false); \
    u32x4 w = {r0[0], r1[0], r0[1], r1[1]}; OUT = *reinterpret_cast<bf16x8*>(&w); } while (0)
#define PKV(L, H) (bf16x8){L[0], L[1], L[2], L[3], H[0], H[1], H[2], H[3]}
template <int NCB, int KS0, int D0> struct PvPairs { static __device__ __forceinline__ void run(f32x16* o, int vb, bf16x8 pa0, bf16x8 pa1) {
    constexpr int S = 2 * NCB * 512, H = NCB * 512;
    const s16x4 l00 = tr_read<D0 * 512 + KS0 * S>(vb), h00 = tr_read<D0 * 512 + KS0 * S + H>(vb), l01 = tr_read<D0 * 512 + (KS0 + 1) * S>(vb), h01 = tr_read<D0 * 512 + (KS0 + 1) * S + H>(vb);
    const s16x4 l10 = tr_read<(D0 + 1) * 512 + KS0 * S>(vb), h10 = tr_read<(D0 + 1) * 512 + KS0 * S + H>(vb), l11 = tr_read<(D0 + 1) * 512 + (KS0 + 1) * S>(vb), h11 = tr_read<(D0 + 1) * 512 + (KS0 + 1) * S + H>(vb);
    asm volatile("s_waitcnt lgkmcnt(0)" ::: "memory"); SBAR();
    o[D0] = __builtin_amdgcn_mfma_f32_32x32x16_bf16(pa0, PKV(l00, h00), o[D0], 0, 0, 0); o[D0 + 1] = __builtin_amdgcn_mfma_f32_32x32x16_bf16(pa0, PKV(l10, h10), o[D0 + 1], 0, 0, 0);
    o[D0] = __builtin_amdgcn_mfma_f32_32x32x16_bf16(pa1, PKV(l01, h01), o[D0], 0, 0, 0); o[D0 + 1] = __builtin_amdgcn_mfma_f32_32x32x16_bf16(pa1, PKV(l11, h11), o[D0 + 1], 0, 0, 0);
    if constexpr (D0 + 2 < NCB) PvPairs<NCB, KS0, D0 + 2>::run(o, vb, pa0, pa1); } };
__device__ __forceinline__ int swap23(int k) { return (k & ~0xC) | ((k & 4) << 1) | ((k & 8) >> 1); }
constexpr int FOX_STAGE = 33024;
constexpr int FOX_AL = 2 * FOX_STAGE, FOX_LI = FOX_AL + 1024;
__device__ void fox_item(const Params& p, LAS unsigned char* lds, int b, int h, int qb) {
    int tid = threadIdx.x; asm volatile("" : "+v"(tid));
    const int wid = __builtin_amdgcn_readfirstlane(tid >> 6), lane = tid & 63, r32 = lane & 31, hi = lane >> 5;
    const bf16_t* Q = (const bf16_t*)(p.ws + WS_QB);
    const char* Kg = (const char*)(p.ws + WS_KB) + ((size_t)b * SEQ * 1024 + h * 128) * 2; const char* Vg = (const char*)(p.ws + WS_VB) + ((size_t)b * SEQ * 1024 + h * 128) * 2;
    const float* cum = (const float*)(p.ws + WS_CUM) + (size_t)(b * 8 + h) * SEQ;
    const int qpos = qb * 256 + wid * 32 + r32;
    bf16x8 qr[8];
    { const bf16_t* qp = Q + (size_t)(b * SEQ + qpos) * 1024 + h * 128 + hi * 8;
#pragma unroll
      for (int d0 = 0; d0 < 8; ++d0) qr[d0] = *(const bf16x8*)(qp + d0 * 16); }
    const float cq = cum[qpos] * LOG2E;
    unsigned ksrc[2], vsrc[2];
#pragma unroll
    for (int i = 0; i < 2; ++i) { const int pos = (i * 512 + tid) * 16;
        { const int row = pos >> 8; const int cb = (pos & 255) ^ ((row & 7) << 4); ksrc[i] = (unsigned)(row * 2048 + cb); }
        { const int sub = pos >> 9, within = pos & 511; const int kk = (sub >> 2) * 8 + (within >> 6); const int c = (sub & 3) * 32 + ((within & 63) >> 1); vsrc[i] = (unsigned)(swap23(kk) * 2048 + c * 2); } }
    float m_reg = -1e30f, l_reg = 0.f; f32x16 o[4];
#pragma unroll
    for (int d = 0; d < 4; ++d)
#pragma unroll
        for (int r = 0; r < 16; ++r) o[d][r] = 0.f;
    LAS float* al_l = (LAS float*)(lds + FOX_AL) + wid * 32; LAS float* li_l = (LAS float*)(lds + FOX_LI) + wid * 32;
    const int ntiles = qb * 4 + 4, mylast = qb * 4 + (wid >> 1);
#define FOX_DMA(kt) do { LAS unsigned char* sb_ = lds + ((kt) & 1) * FOX_STAGE; const size_t go_ = (size_t)(kt) * 64 * 2048; \
        _Pragma("unroll") for (int i = 0; i < 2; ++i) { \
            __builtin_amdgcn_global_load_lds((const unsigned*)(Kg + go_ + ksrc[i]), (LAS unsigned*)(sb_ + 16384 + (i * 512 + wid * 64) * 16), 16, 0, 0); \
            __builtin_amdgcn_global_load_lds((const unsigned*)(Vg + go_ + vsrc[i]), (LAS unsigned*)(sb_ + (i * 512 + wid * 64) * 16), 16, 0, 0); } \
        if (wid == 0) __builtin_amdgcn_global_load_lds((const unsigned*)(cum + (kt) * 64 + lane), (LAS unsigned*)(sb_ + 32768), 4, 0, 0); } while (0)
    __syncthreads();
    FOX_DMA(0);
    for (int kt = 0; kt < ntiles; ++kt) {
        asm volatile("s_waitcnt vmcnt(0)" ::: "memory");
        __syncthreads();
        if (kt + 1 < ntiles) FOX_DMA(kt + 1);
        if (kt <= mylast) {
            const LAS unsigned char* sb = lds + (kt & 1) * FOX_STAGE; const LAS float* ck = (const LAS float*)(sb + 32768);
            const int vb = (int)(uintptr_t)sb + v_rd_base(lane);
            f32x16 p0, p1;
#pragma unroll
            for (int r = 0; r < 16; ++r) { p0[r] = 0.f; p1[r] = 0.f; }
            int fsw = (r32 & 7) << 4; asm volatile("" : "+v"(fsw));
#pragma unroll
            for (int d0 = 0; d0 < 8; ++d0) { const int cb = (d0 * 16 + hi * 8) * 2;
                const bf16x8 b0 = *(const LAS bf16x8*)(sb + 16384 + r32 * 256 + (cb ^ fsw));
                const bf16x8 b1 = *(const LAS bf16x8*)(sb + 16384 + (32 + r32) * 256 + (cb ^ fsw));
                p0 = __builtin_amdgcn_mfma_f32_32x32x16_bf16(b0, qr[d0], p0, 0, 0, 0); p1 = __builtin_amdgcn_mfma_f32_32x32x16_bf16(b1, qr[d0], p1, 0, 0, 0); }
            const bool diag = (kt * 64 + 63 > qb * 256 + wid * 32);
            float pmax = -INFINITY;
#pragma unroll
            for (int g4 = 0; g4 < 4; ++g4) { const f32x4 c0 = *(const LAS f32x4*)(ck + 8 * g4 + 4 * hi), c1 = *(const LAS f32x4*)(ck + 32 + 8 * g4 + 4 * hi);
#pragma unroll
                for (int j = 0; j < 4; ++j) { const int r = g4 * 4 + j; float t0 = fmaf(p0[r], LOG2E, cq) - c0[j] * LOG2E, t1 = fmaf(p1[r], LOG2E, cq) - c1[j] * LOG2E;
                    if (diag) { const int kp = kt * 64 + crow(r, hi); if (kp > qpos) t0 = -INFINITY; if (kp + 32 > qpos) t1 = -INFINITY; }
                    p0[r] = t0; p1[r] = t1; pmax = fmaxf(pmax, fmaxf(t0, t1)); } }
            { auto rr = __builtin_amdgcn_permlane32_swap(__float_as_uint(pmax), __float_as_uint(pmax), false, false); pmax = fmaxf(__uint_as_float(rr[0]), __uint_as_float(rr[1])); }
            const float mn = fmaxf(m_reg, pmax); const float alpha = __builtin_amdgcn_exp2f(m_reg - mn); m_reg = mn;
            float ps = 0.f;
#pragma unroll
            for (int r = 0; r < 16; ++r) { p0[r] = __builtin_amdgcn_exp2f(p0[r] - mn); p1[r] = __builtin_amdgcn_exp2f(p1[r] - mn); ps += p0[r] + p1[r]; }
            { auto rr = __builtin_amdgcn_permlane32_swap(__float_as_uint(ps), __float_as_uint(ps), false, false); ps = __uint_as_float(rr[0]) + __uint_as_float(rr[1]); }
            l_reg = l_reg * alpha + ps;
            if (__any(alpha < 1.f)) { if (hi == 0) al_l[r32] = alpha; asm volatile("s_waitcnt lgkmcnt(0)" ::: "memory");
#pragma unroll
                for (int r = 0; r < 16; ++r) { const float a = al_l[crow(r, hi)];
#pragma unroll
                    for (int d = 0; d < 4; ++d) o[d][r] *= a; } }
            bf16x8 pa0, pa1, pa2, pa3; PK4(p0, 0, pa0); PK4(p0, 8, pa1); PK4(p1, 0, pa2); PK4(p1, 8, pa3);
            PvPairs<4, 0, 0>::run(o, vb, pa0, pa1); PvPairs<4, 2, 0>::run(o, vb, pa2, pa3);
        }
    }
#undef FOX_DMA
    if (hi == 0) li_l[r32] = l_reg; asm volatile("s_waitcnt lgkmcnt(0)" ::: "memory");
    unsigned char* O8 = (unsigned char*)(p.ws + WS_OB8) + (size_t)(b * SEQ + qb * 256 + wid * 32) * 1024 + h * 128;
#pragma unroll
    for (int r = 0; r < 16; ++r) { const float rl = __builtin_amdgcn_rcpf(li_l[crow(r, hi)]); const int orow = crow(r, hi);
#pragma unroll
        for (int d0 = 0; d0 < 4; ++d0) O8[(size_t)orow * 1024 + d0 * 32 + r32] = (unsigned char)(pack_fp8x4(o[d0][r] * rl * 8.f, 0.f, 0.f, 0.f) & 0xffu); }
}

constexpr int DSA_STAGE = 32768;
constexpr int DSA_AL = 2 * DSA_STAGE, DSA_LI = DSA_AL + 1024, DSA_Q = DSA_LI + 1024;
__device__ void dsa_item(const Params& p, LAS unsigned char* lds, int b, int qt) {
    int tid = threadIdx.x; asm volatile("" : "+v"(tid));
    const int wid = __builtin_amdgcn_readfirstlane(tid >> 6), lane = tid & 63, r32 = lane & 31, hi = lane >> 5, h = wid;
    const char* KV = (const char*)(p.ws + WS_KV) + (size_t)b * SEQ * 512;
    const int qpos = qt * 32 + r32; const size_t qg = (size_t)b * SEQ + qpos;
    const unsigned* mask = (const unsigned*)(p.ws + WS_MASK) + qg * 64;
    bf16x8 qr[8];
    LAS unsigned char* qlds = lds + DSA_Q + wid * 8192 + lane * 16;
    __syncthreads();
    { const bf16_t* qp = (const bf16_t*)(p.ws + WS_QLAT) + qg * 2048 + h * 256 + hi * 8;
#pragma unroll
      for (int d0 = 0; d0 < 8; ++d0) qr[d0] = *(const bf16x8*)(qp + d0 * 16);
#pragma unroll
      for (int d0 = 8; d0 < 16; ++d0) *(LAS bf16x8*)(qlds + (d0 - 8) * 1024) = *(const bf16x8*)(qp + d0 * 16); }
    unsigned ksrc[2], vsrc[2];
#pragma unroll
    for (int i = 0; i < 2; ++i) { const int pos = (i * 512 + tid) * 16;
        { const int row = pos >> 9; const int cb = (pos & 511) ^ ((row & 15) << 4); ksrc[i] = (unsigned)(row * 512 + cb); }
        { const int sub = pos >> 9, within = pos & 511; const int kk = (sub >> 3) * 8 + (within >> 6); const int c = (sub & 7) * 32 + ((within & 63) >> 1); vsrc[i] = (unsigned)(swap23(kk) * 512 + c * 2); } }
    const float slopeL = exp2f(-(float)(h + 1)) * LOG2E;
    float m_reg = -1e30f, l_reg = 0.f; f32x16 o[8];
#pragma unroll
    for (int d = 0; d < 8; ++d)
#pragma unroll
        for (int r = 0; r < 16; ++r) o[d][r] = 0.f;
    LAS float* al_l = (LAS float*)(lds + DSA_AL) + wid * 32; LAS float* li_l = (LAS float*)(lds + DSA_LI) + wid * 32;
    const int ntiles = ((qt >> 1) + 1) * 2;
#define DSA_DMA(kt) do { LAS unsigned char* sb_ = lds + ((kt) & 1) * DSA_STAGE; const size_t go_ = (size_t)(kt) * 32 * 512; \
        _Pragma("unroll") for (int i = 0; i < 2; ++i) { \
            __builtin_amdgcn_global_load_lds((const unsigned*)(KV + go_ + ksrc[i]), (LAS unsigned*)(sb_ + 16384 + (i * 512 + wid * 64) * 16), 16, 0, 0); \
            __builtin_amdgcn_global_load_lds((const unsigned*)(KV + go_ + vsrc[i]), (LAS unsigned*)(sb_ + (i * 512 + wid * 64) * 16), 16, 0, 0); } } while (0)
    unsigned mw = mask[0];
    DSA_DMA(0);
    for (int kt = 0; kt < ntiles; ++kt) {
        asm volatile("s_waitcnt vmcnt(0)" ::: "memory");
        __syncthreads();
        const unsigned mcur = mw;
        if (kt + 1 < ntiles) { mw = mask[kt + 1]; DSA_DMA(kt + 1); }
        const LAS unsigned char* sb = lds + (kt & 1) * DSA_STAGE; const int vb = (int)(uintptr_t)sb + v_rd_base(lane);
        f32x16 pp;
#pragma unroll
        for (int r = 0; r < 16; ++r) pp[r] = 0.f;
        {
            const LAS unsigned char* kb_ = sb + 16384 + r32 * 512; int sw_ = (r32 & 15) << 4; asm volatile("" : "+v"(sw_));
#define DSA_KF(d0) (*(const LAS bf16x8*)(kb_ + ((((d0) * 16 + hi * 8) * 2) ^ sw_)))
#define DSA_QF(d0) ((d0) < 8 ? qr[(d0) & 7] : *(const LAS bf16x8*)(qlds + (((d0) - 8) & 7) * 1024))
            bf16x8 k0 = DSA_KF(0), k1 = DSA_KF(1), q0 = DSA_QF(0), q1 = DSA_QF(1);
#pragma unroll
            for (int d0 = 0; d0 < 16; d0 += 2) {
                bf16x8 nk0 = k0, nk1 = k1, nq0 = q0, nq1 = q1;
                if (d0 + 2 < 16) { nk0 = DSA_KF(d0 + 2); nk1 = DSA_KF(d0 + 3); nq0 = DSA_QF(d0 + 2); nq1 = DSA_QF(d0 + 3); }
                pp = __builtin_amdgcn_mfma_f32_32x32x16_bf16(k0, q0, pp, 0, 0, 0); pp = __builtin_amdgcn_mfma_f32_32x32x16_bf16(k1, q1, pp, 0, 0, 0);
                k0 = nk0; k1 = nk1; q0 = nq0; q1 = nq1; SBAR();
            }
#undef DSA_KF
#undef DSA_QF
        }
        const unsigned wsh = mcur >> (4 * hi);
        const float df = (float)(qpos - (kt * 32 + 4 * hi));
        float pmax = -INFINITY;
#pragma unroll
        for (int r = 0; r < 16; ++r) { const int cb = (r & 3) + 8 * (r >> 2); const float dd = df - (float)cb;
            float t = fmaf(-slopeL, fabsf(dd), pp[r] * LOG2E); if (!((wsh >> cb) & 1u)) t = -INFINITY; pp[r] = t; pmax = fmaxf(pmax, t); }
        { auto rr = __builtin_amdgcn_permlane32_swap(__float_as_uint(pmax), __float_as_uint(pmax), false, false); pmax = fmaxf(__uint_as_float(rr[0]), __uint_as_float(rr[1])); }
        const float mn = fmaxf(m_reg, pmax); const float alpha = __builtin_amdgcn_exp2f(m_reg - mn); m_reg = mn;
        float ps = 0.f;
#pragma unroll
        for (int r = 0; r < 16; ++r) { pp[r] = __builtin_amdgcn_exp2f(pp[r] - mn); ps += pp[r]; }
        { auto rr = __builtin_amdgcn_permlane32_swap(__float_as_uint(ps), __float_as_uint(ps), false, false); ps = __uint_as_float(rr[0]) + __uint_as_float(rr[1]); }
        l_reg = l_reg * alpha + ps;
        if (__any(alpha < 1.f)) { if (hi == 0) al_l[r32] = alpha; asm volatile("s_waitcnt lgkmcnt(0)" ::: "memory");
#pragma unroll
            for (int r = 0; r < 16; ++r) { const float a = al_l[crow(r, hi)];
#pragma unroll
                for (int d = 0; d < 8; ++d) o[d][r] *= a; } }
        bf16x8 pa0, pa1; PK4(pp, 0, pa0); PK4(pp, 8, pa1);
        PvPairs<8, 0, 0>::run(o, vb, pa0, pa1);
    }
#undef DSA_DMA
    if (hi == 0) li_l[r32] = l_reg; asm volatile("s_waitcnt lgkmcnt(0)" ::: "memory");
    float rl[16];
#pragma unroll
    for (int r = 0; r < 16; ++r) rl[r] = __builtin_amdgcn_rcpf(li_l[crow(r, hi)]);
    __syncthreads();
    LAS bf16_t* os = (LAS bf16_t*)(lds + wid * 16896);
#pragma unroll
    for (int r = 0; r < 16; ++r)
#pragma unroll
        for (int d0 = 0; d0 < 8; ++d0) os[crow(r, hi) * 264 + d0 * 32 + r32] = (bf16_t)(cvt_pk_bf16(o[d0][r] * rl[r], 0.f) & 0xffffu);
    asm volatile("s_waitcnt lgkmcnt(0)" ::: "memory");
    f32x16 ya[4];
#pragma unroll
    for (int nb = 0; nb < 4; ++nb)
#pragma unroll
        for (int r = 0; r < 16; ++r) ya[nb][r] = 0.f;
    const bf16_t* wv = (const bf16_t*)(p.ws + WS_WUV) + (size_t)(h * 128 + r32) * 256 + hi * 8;
#pragma unroll 4
    for (int ks = 0; ks < 16; ++ks) {
        const bf16x8 af = *(const LAS bf16x8*)(os + r32 * 264 + ks * 16 + hi * 8);
#pragma unroll
        for (int nb = 0; nb < 4; ++nb) { const bf16x8 wf = *(const bf16x8*)(wv + (size_t)nb * 32 * 256 + ks * 16); ya[nb] = __builtin_amdgcn_mfma_f32_32x32x16_bf16(wf, af, ya[nb], 0, 0, 0); }
    }
    unsigned char* O8 = (unsigned char*)(p.ws + WS_OA8) + ((size_t)b * SEQ + qt * 32 + r32) * 1024 + h * 128 + 4 * hi;
#pragma unroll
    for (int nb = 0; nb < 4; ++nb)
#pragma unroll
        for (int g4 = 0; g4 < 4; ++g4) *(unsigned*)(O8 + nb * 32 + g4 * 8) = pack_fp8x4(ya[nb][g4 * 4] * 8.f, ya[nb][g4 * 4 + 1] * 8.f, ya[nb][g4 * 4 + 2] * 8.f, ya[nb][g4 * 4 + 3] * 8.f);
}
__device__ void ph4_attn(const Params& p, LAS unsigned char* lds) {
    const int r = blockIdx.x;
    if (r < 256) { const int c = 31 - (r >> 3), w8 = r & 7, b = w8 >> 1, half = w8 & 1; dsa_item(p, lds, b, c * 2 + half); }
    int* qhead = (int*)(p.ws + WS_CNT) + 512;
    LAS int* slot = (LAS int*)(lds + LDS_BARW - 16);
    for (;;) {
        __syncthreads();
        if (threadIdx.x == 0) *slot = atomicAdd(qhead, 1);
        __syncthreads();
        const int it = __builtin_amdgcn_readfirstlane(*slot);
        if (it >= 256) break;
        const int qb = 7 - (it >> 5), bh = it & 31;
        fox_item(p, lds, bh >> 3, bh & 7, qb);
    }
}

__device__ void ph8_router(const Params& p, LAS unsigned char* lds, const int rep) {
    const int tid = threadIdx.x, wid = tid >> 6, lane = tid & 63, fr = lane & 15, fq = lane >> 4;
    const float* mod = (const float*)(p.ws + WS_MOD);
    int* cnt = (int*)(p.ws + WS_CNT) + rep * 256; int* ltok = rep ? (int*)(p.ws + WS_QLAT) : (int*)(p.ws + WS_LTOK); float* lw = rep ? (float*)(p.ws + WS_QLAT + (4u << 20)) : (float*)(p.ws + WS_LW);
    LAS unsigned char* AH = lds; LAS unsigned char* AL = lds + 65536;
    LAS float* slab = (LAS float*)(lds + 131072);
    LAS float* lg = (LAS float*)(lds + 131072 + 20480);
    const bf16_t* WH = (const bf16_t*)(p.ws + WS_WRH); const bf16_t* WL = (const bf16_t*)(p.ws + WS_WRL);
    for (int blk = blockIdx.x; blk < NTOK / 32; blk += gridDim.x) {
#pragma unroll 1
        for (int half = 0; half < 2; ++half) {
            const int t0 = blk * 32 + half * 16, tb = t0 + wid * 2, b = tb >> 11;
            const float* sh = mod + b * 12288 + 6144; const float* sc = mod + b * 12288 + 8192;
            f32x4 xv[2][8];
#pragma unroll
            for (int rr = 0; rr < 2; ++rr)
#pragma unroll
                for (int i = 0; i < 8; ++i) { const size_t eo = (size_t)(tb + rr) * DM + i * 256 + lane * 4; const u32x2 yb = *(const u32x2*)((const bf16_t*)(p.ws + WS_MERGED) + eo);
                    xv[rr][i] = *(const f32x4*)(p.in[I_X] + eo) + (f32x4){bf_lo(yb.x), bf_hi(yb.x), bf_lo(yb.y), bf_hi(yb.y)}; }
            float rstd[2];
#pragma unroll
            for (int rr = 0; rr < 2; ++rr) { float ss = 0.f;
#pragma unroll
                for (int i = 0; i < 8; ++i) ss += xv[rr][i][0] * xv[rr][i][0] + xv[rr][i][1] * xv[rr][i][1] + xv[rr][i][2] * xv[rr][i][2] + xv[rr][i][3] * xv[rr][i][3];
                rstd[rr] = rsqrtf(wave_sum(ss) * (1.0f / 2048.0f) + RMS_EPS); }
#pragma unroll
            for (int i = 0; i < 8; ++i) { const int col = i * 256 + lane * 4; const f32x4 gg = *(const f32x4*)(p.in[I_GFFN] + col), s1 = *(const f32x4*)(sc + col), s0 = *(const f32x4*)(sh + col);
#pragma unroll
                for (int rr = 0; rr < 2; ++rr) { float hv[4], lo[4]; const int r = wid * 2 + rr;
#pragma unroll
                    for (int j = 0; j < 4; ++j) hv[j] = xv[rr][i][j] * rstd[rr] * gg[j] * (1.0f + s1[j]) + s0[j];
                    u32x2 wh; wh.x = cvt_pk_bf16(hv[0], hv[1]); wh.y = cvt_pk_bf16(hv[2], hv[3]);
                    lo[0] = hv[0] - bf_lo(wh.x); lo[1] = hv[1] - bf_hi(wh.x); lo[2] = hv[2] - bf_lo(wh.y); lo[3] = hv[3] - bf_hi(wh.y);
                    u32x2 wl; wl.x = cvt_pk_bf16(lo[0], lo[1]); wl.y = cvt_pk_bf16(lo[2], lo[3]);
                    const int ad = r * 4096 + ((((i * 32 + (lane >> 1)) ^ r)) * 16) + (lane & 1) * 8;
                    *(LAS u32x2*)(AH + ad) = wh; *(LAS u32x2*)(AL + ad) = wl;
                    *(unsigned*)(p.ws + WS_H8 + (size_t)(tb + rr) * DM + col) = pack_fp8x4(hv[0], hv[1], hv[2], hv[3]); } }
            __syncthreads();
            {
                const int kq = wid & 3, ng = wid >> 2, nb0 = ng * 3;
                f32x4 acc[3];
#pragma unroll
                for (int j = 0; j < 3; ++j) acc[j] = (f32x4){0.f, 0.f, 0.f, 0.f};
#pragma unroll 4
                for (int k16 = 0; k16 < 16; ++k16) { const int ks = kq * 16 + k16; const int ad = fr * 4096 + (((ks * 4 + fq) ^ fr) * 16);
                    const bf16x8 ah = *(const LAS bf16x8*)(AH + ad), al = *(const LAS bf16x8*)(AL + ad);
#pragma unroll
                    for (int j = 0; j < 3; ++j) { const int nb = nb0 + j; if (nb < 5) {
                        const bf16x8 wh = *(const bf16x8*)(WH + (size_t)(nb * 16 + fr) * DM + ks * 32 + fq * 8), wl = *(const bf16x8*)(WL + (size_t)(nb * 16 + fr) * DM + ks * 32 + fq * 8);
                        acc[j] = __builtin_amdgcn_mfma_f32_16x16x32_bf16(wh, ah, acc[j], 0, 0, 0); acc[j] = __builtin_amdgcn_mfma_f32_16x16x32_bf16(wl, ah, acc[j], 0, 0, 0); acc[j] = __builtin_amdgcn_mfma_f32_16x16x32_bf16(wh, al, acc[j], 0, 0, 0); } } }
#pragma unroll
                for (int j = 0; j < 3; ++j) { const int nb = nb0 + j; if (nb < 5) *(LAS f32x4*)(slab + (kq * 16 + fr) * 80 + nb * 16 + fq * 4) = acc[j]; }
            }
            __syncthreads();
            for (int o = tid; o < 1280; o += NTHREADS) lg[o] = (slab[o] + slab[1280 + o]) + (slab[2560 + o] + slab[3840 + o]);
            __syncthreads();
            if (tid < 16) {
                const int t = t0 + tid; const LAS float* L = lg + tid * 80;
                float gl[8]; int gi = 0; float gm = -INFINITY;
#pragma unroll
                for (int g = 0; g < 8; ++g) { gl[g] = L[g] + p.in[I_BRG][g]; if (gl[g] > gm) { gm = gl[g]; gi = g; } }
                float se = 0.f;
#pragma unroll
                for (int g = 0; g < 8; ++g) se += __expf(gl[g] - gm);
                const float gwt = 1.0f / se;
                float v1 = -INFINITY, v2 = -INFINITY; int i1 = 0, i2 = 0;
                for (int e = 0; e < 8; ++e) { const float v = L[8 + gi * 8 + e] + p.in[I_BRE][gi * 8 + e];
                    if (v > v1) { v2 = v1; i2 = i1; v1 = v; i1 = e; } else if (v > v2) { v2 = v; i2 = e; } }
                const float e2 = __expf(v2 - v1); const float p1 = gwt / (1.0f + e2), p2 = gwt * e2 / (1.0f + e2);
                const int ea = gi * 8 + i1, eb = gi * 8 + i2;
                const int pa = atomicAdd(cnt + ea, 1); const int pb = atomicAdd(cnt + eb, 1);
                ltok[ea * LCAP + pa] = t; lw[ea * LCAP + pa] = p1;
                ltok[eb * LCAP + pb] = t | 0x10000; lw[eb * LCAP + pb] = p2;
            }
            __syncthreads();
        }
    }
}

#define MOE_GLOAD(dst, ptr) asm volatile("global_load_dwordx4 %0, %1, off nt" : "=v"(dst) : "v"(ptr) : "memory")
template <bool UP>
__device__ void moe_gemm(const Params& p, LAS unsigned char* lds, const int rep) {
    constexpr int K = UP ? 2048 : 512, NKT = K / 32, NS = UP ? 8 : 16, LDW = UP ? 512 : 2048;
    constexpr int NSTA = 3, OFF_A = 0, OFF_B = NSTA * 16384;
    int tid = threadIdx.x; asm volatile("" : "+v"(tid));
    const int w = __builtin_amdgcn_readfirstlane(tid >> 6), l = tid & 63, r32 = l & 31, hi = l >> 5;
    LAS int* tab = (LAS int*)(lds + LDS_TAB);
    if (tid == 0) { const int* cnt = (const int*)(p.ws + WS_CNT); int s = 0, ro = 0; for (int e = 0; e < 64; ++e) { const int ce = cnt[e]; tab[e] = s; tab[80 + e] = ce; tab[160 + e] = ro; ro += ce; const int np = (ce + 511) >> 9; s += np > 0 ? np : 1; } tab[64] = s; }
    __syncthreads();
    const int total = __builtin_amdgcn_readfirstlane(tab[64]) * NS;
    const int q = (w & 3) * 8 + (l & 7), g = (w >> 2) * 8 + (l >> 3);
    const unsigned bwoff = (unsigned)(q * 256 + (((g >> 2) ^ (q & 3)) * 16) + (g & 3) * 4);
    const unsigned frag_sw = (unsigned)((r32 >> 2) & 3);
    const int* ltok = (const int*)(p.ws + WS_LTOK); const float* lw = (const float*)(p.ws + WS_LW);
    for (int unit = blockIdx.x; unit < total; unit += gridDim.x) {
        const int pm = unit / NS, ns = unit - pm * NS; int e = 0;
#pragma unroll 1
        for (int s = 32; s >= 1; s >>= 1) if (__builtin_amdgcn_readfirstlane(tab[e + s]) <= pm) e += s;
        const int mp = pm - __builtin_amdgcn_readfirstlane(tab[e]); const int cnt_e = __builtin_amdgcn_readfirstlane(tab[80 + e]), rowoff = __builtin_amdgcn_readfirstlane(tab[160 + e]);
        int nrows = cnt_e - mp * 512; nrows = nrows > 512 ? 512 : nrows; const bool two = nrows > 256;
        const char* abase = UP ? (const char*)(p.ws + WS_H8) : (const char*)(p.ws + WS_ACT8);
        unsigned aoff[2];
#pragma unroll
        for (int i = 0; i < 2; ++i) { const int row = (i * 8 + w) * 32 + (l >> 1); const int hs = (l & 1) ^ ((l >> 4) & 1);
            int src; if (UP) src = row < nrows ? (ltok[e * LCAP + mp * 512 + row] & 0xffff) : 0; else src = rowoff + mp * 512 + (row < nrows ? row : 0);
            aoff[i] = (unsigned)(src * K + hs * 16); }
        const float* bsrc = UP ? (q < 16 ? p.in[I_W1] : p.in[I_W3]) + (size_t)e * 2048 * 512 + ns * 64 + (q & 15) * 4 + (size_t)(2 * g) * LDW
                               : p.in[I_W2] + (size_t)e * 512 * 2048 + ns * 128 + q * 4 + (size_t)(2 * g) * LDW;
        f32x16 acc[2][4];
#pragma unroll
        for (int a = 0; a < 2; ++a)
#pragma unroll
            for (int b = 0; b < 4; ++b)
#pragma unroll
                for (int r = 0; r < 16; ++r) acc[a][b][r] = 0.f;
        f32x4 br[2][2];
#define MOE_ISSUE_B(j, t) do { const int tt_ = (t) < NKT ? (t) : NKT - 1; const float* bp_ = bsrc + (size_t)tt_ * 32 * LDW; MOE_GLOAD(br[j][0], bp_); MOE_GLOAD(br[j][1], bp_ + LDW); } while (0)
#define MOE_ISSUE_A(t, TWO) do { int tt_ = (t) < 0 ? 0 : (t); const int bi_ = (tt_ % NSTA); tt_ = tt_ < NKT ? tt_ : NKT - 1; const char* ap_ = abase + (size_t)tt_ * 32; \
        LAS unsigned char* ab_ = lds + OFF_A + bi_ * 16384 + w * 1024; \
        __builtin_amdgcn_global_load_lds((const unsigned*)(ap_ + aoff[0]), (LAS unsigned*)(ab_), 16, 0, 0); \
        if (TWO) __builtin_amdgcn_global_load_lds((const unsigned*)(ap_ + aoff[1]), (LAS unsigned*)(ab_ + 8192), 16, 0, 0); } while (0)
        const bool two_w = (256 + 32 * w) < nrows;
#define MOE_FRAGS(ks, TWO) do { const unsigned co_ = ((unsigned)((ks) * 2 + hi) ^ frag_sw) * 16u; \
            _Pragma("unroll") for (int nb = 0; nb < 4; ++nb) bf_[nb] = *(const LAS bf16x8*)(bb_ + nb * 2048 + co_); \
            { const unsigned ao_ = ((unsigned)(ks) ^ ((unsigned)(r32 >> 3) & 1u)) * 16u + (unsigned)hi * 8u; a0_ = fp8x8_to_bf16(*(const LAS u32x2*)(ab_ + ao_)); if (TWO) a1_ = fp8x8_to_bf16(*(const LAS u32x2*)(ab_ + 8192 + ao_)); } } while (0)
#define MOE_MMAS(TWO) do { \
            _Pragma("unroll") for (int nb = 0; nb < 4; ++nb) acc[0][nb] = __builtin_amdgcn_mfma_f32_32x32x16_bf16(bf_[nb], a0_, acc[0][nb], 0, 0, 0); \
            if (TWO) { _Pragma("unroll") for (int nb = 0; nb < 4; ++nb) acc[1][nb] = __builtin_amdgcn_mfma_f32_32x32x16_bf16(bf_[nb], a1_, acc[1][nb], 0, 0, 0); } } while (0)
#define MOE_ITER(jn, t, COMPUTE, TWO, WB, WA) do { \
        bf16x8 bf_[4], a0_, a1_; \
        const LAS unsigned char* ab_ = lds + OFF_A + (((t) + 3) % 3) * 16384 + w * 1024 + r32 * 32; const LAS unsigned char* bb_ = lds + OFF_B + ((t) & 1) * 8192 + r32 * 64; \
        if (COMPUTE) { MOE_FRAGS(0, TWO); } SBAR(); \
        asm volatile("s_waitcnt vmcnt(" WB ")" : "+v"(br[jn][0]), "+v"(br[jn][1]) :: "memory"); \
        { LAS unsigned char* bw_ = lds + OFF_B + (((t) + 1) & 1) * 8192 + bwoff; _Pragma("unroll") for (int jj = 0; jj < 4; ++jj) *(LAS unsigned*)(bw_ + jj * 64) = cvt_pk_bf16(br[jn][0][jj], br[jn][1][jj]); } \
        MOE_ISSUE_B(jn, (t) + 3); SBAR(); \
        if (COMPUTE) { MOE_MMAS(TWO); SBAR(); MOE_FRAGS(1, TWO); MOE_MMAS(TWO); } SBAR(); \
        asm volatile("s_waitcnt vmcnt(" WA ")" ::: "memory"); \
        asm volatile("s_waitcnt lgkmcnt(0)" ::: "memory"); __builtin_amdgcn_s_barrier(); asm volatile("" ::: "memory"); \
        MOE_ISSUE_A((t) + 3, TWO); \
        } while (0)
#define MOE_PIPE(TWO, WB, WA) do { \
        MOE_ISSUE_B(0, 0); MOE_ISSUE_A(0, TWO); MOE_ISSUE_B(1, 1); MOE_ISSUE_A(1, TWO); \
        MOE_ITER(0, -1, false, TWO, WB, WA); \
        _Pragma("unroll 1") for (int t = 0; t < NKT; t += 2) { MOE_ITER(1, t, true, TWO, WB, WA); MOE_ITER(0, t + 1, true, TWO, WB, WA); } \
          \
        asm volatile("s_waitcnt vmcnt(0)" : "+v"(br[0][0]), "+v"(br[0][1]), "+v"(br[1][0]), "+v"(br[1][1]) :: "memory"); \
        } while (0)
        if (two_w) MOE_PIPE(true, "6", "6"); else MOE_PIPE(false, "4", "5");
        asm volatile("s_waitcnt vmcnt(0)" ::: "memory");
        if constexpr (UP) {
#pragma unroll
            for (int mt = 0; mt < 2; ++mt) {
                const int rl = mt * 256 + 32 * w + r32;
                if (rl < nrows) {
                    const float gw = lw[e * LCAP + mp * 512 + rl] * 16.0f; unsigned char* orow = (unsigned char*)(p.ws + (rep ? WS_QLAT : WS_ACT8)) + (size_t)(rowoff + mp * 512 + rl) * 512 + ns * 64 + 4 * hi;
#pragma unroll
                    for (int nb = 0; nb < 2; ++nb)
#pragma unroll
                        for (int g4 = 0; g4 < 4; ++g4) { float o[4];
#pragma unroll
                            for (int j = 0; j < 4; ++j) { const float a = acc[mt][nb][g4 * 4 + j], u = acc[mt][nb + 2][g4 * 4 + j]; o[j] = a * sigmoidf_(a) * u * gw; }
                            *(unsigned*)(orow + nb * 32 + g4 * 8) = pack_fp8x4(o[0], o[1], o[2], o[3]); }
                }
            }
        } else {
#pragma unroll
            for (int mt = 0; mt < 2; ++mt) {
                const int rl = mt * 256 + 32 * w + r32;
                if (rl < nrows) {
                    const int ent = ltok[e * LCAP + mp * 512 + rl]; unsigned char* orow = (unsigned char*)(p.ws + WS_YS) + ((size_t)(ent >> 16) * NTOK + (ent & 0xffff)) * 2048 + ns * 128 + 4 * hi;
#pragma unroll
                    for (int nb = 0; nb < 4; ++nb)
#pragma unroll
                        for (int g4 = 0; g4 < 4; ++g4) *(unsigned*)(orow + nb * 32 + g4 * 8) = pack_fp8x4(acc[mt][nb][g4 * 4], acc[mt][nb][g4 * 4 + 1], acc[mt][nb][g4 * 4 + 2], acc[mt][nb][g4 * 4 + 3]);
                }
            }
        }
        asm volatile("s_waitcnt vmcnt(0)" ::: "memory");
        __syncthreads();
    }
#undef MOE_ISSUE_A
#undef MOE_ISSUE_B
#undef MOE_ITER
#undef MOE_FRAGS
#undef MOE_MMAS
#undef MOE_PIPE
}


__device__ void ph11_combine(const Params& p) {
    const unsigned char* Y0 = (const unsigned char*)(p.ws + WS_YS); const unsigned char* Y1 = Y0 + (size_t)NTOK * 2048; const bf16_t* YM = (const bf16_t*)(p.ws + WS_MERGED); const float* mod = (const float*)(p.ws + WS_MOD);
    const size_t n8 = (size_t)NTOK * 2048 / 8;
    for (size_t i = (size_t)blockIdx.x * NTHREADS + threadIdx.x; i < n8; i += (size_t)gridDim.x * NTHREADS) {
        const size_t e0 = i * 8; const int col = (int)(e0 & 2047), b = (int)(e0 >> 22);
        const u32x2 a = *(const u32x2*)(Y0 + e0), c = *(const u32x2*)(Y1 + e0); const u32x4 m = *(const u32x4*)(YM + e0);
        const f32x2 a0 = __builtin_amdgcn_cvt_pk_f32_fp8((int)a.x, false), a1 = __builtin_amdgcn_cvt_pk_f32_fp8((int)a.x, true), a2 = __builtin_amdgcn_cvt_pk_f32_fp8((int)a.y, false), a3 = __builtin_amdgcn_cvt_pk_f32_fp8((int)a.y, true);
        const f32x2 c0 = __builtin_amdgcn_cvt_pk_f32_fp8((int)c.x, false), c1 = __builtin_amdgcn_cvt_pk_f32_fp8((int)c.x, true), c2 = __builtin_amdgcn_cvt_pk_f32_fp8((int)c.y, false), c3 = __builtin_amdgcn_cvt_pk_f32_fp8((int)c.y, true);
        const float* gt = mod + (size_t)b * 12288 + 10240 + col; const f32x4 g0 = *(const f32x4*)gt * 0.0625f, g1 = *(const f32x4*)(gt + 4) * 0.0625f;
        const float* px = p.in[I_X] + e0; f32x4 o0 = *(const f32x4*)px, o1 = *(const f32x4*)(px + 4);
        o0[0] += bf_lo(m.x) + g0[0] * (a0.x + c0.x); o0[1] += bf_hi(m.x) + g0[1] * (a0.y + c0.y); o0[2] += bf_lo(m.y) + g0[2] * (a1.x + c1.x); o0[3] += bf_hi(m.y) + g0[3] * (a1.y + c1.y);
        o1[0] += bf_lo(m.z) + g1[0] * (a2.x + c2.x); o1[1] += bf_hi(m.z) + g1[1] * (a2.y + c2.y); o1[2] += bf_lo(m.w) + g1[2] * (a3.x + c3.x); o1[3] += bf_hi(m.w) + g1[3] * (a3.y + c3.y);
        float* po = p.out + e0; *(f32x4*)po = o0; *(f32x4*)(po + 4) = o1;
    }
}

__global__ void __launch_bounds__(NTHREADS, 2) mk_fwd(Params p) {
    extern __shared__ __attribute__((aligned(16))) unsigned char shm[];
    LAS unsigned char* lds = (LAS unsigned char*)shm;
    const int lo = p.ph_lo, hi = p.ph_hi;
    if (threadIdx.x < 4) ((LAS unsigned*)(lds + LDS_BARW))[threadIdx.x] = 0u;
    __syncthreads();
    XcdBarrier bar; bar.bar = (unsigned*)(p.ws + WS_BAR); bar.x = 0; bar.st = nullptr;
    if (hi - lo > 1) bar = xcd_barrier_post((unsigned*)(p.ws + WS_BAR), (volatile LAS unsigned*)(lds + LDS_BARW));
#ifndef SKIP_MASK
#define SKIP_MASK 0
#endif
#define IN(k) (!((SKIP_MASK >> (k)) & 1) && lo <= (k) && (k) < hi)
#define SEAM(k) do { if (IN(k) && IN((k) + 1)) xcd_barrier(bar); } while (0)
    const int G = gridDim.x, bx = blockIdx.x;
#ifndef REP_PHASE
#define REP_PHASE 0
#endif
#define RUN(k, ...) do { if (IN(k)) { { const int rep = 0; (void)rep; __VA_ARGS__ } if ((REP_PHASE >> (k)) & 1) { xcd_barrier(bar); { const int rep = 1; (void)rep; __VA_ARGS__ } } } SEAM(k); } while (0)
    RUN(0, ph0_prologue(p, lds););
    RUN(1, ph1_norm(p););
    RUN(2, EpiProj E{p.ws, p.in[I_BGATE]};
           { ProjOrder S; S.S.init(p.ws + WS_H, p.ws + WS_WIN + (size_t)2 * 256 * DM * 2, NTOK, 8 * 256, DM * 2, G, bx); S.fp8 = 0; S.Bfull = nullptr;
             pg8::gemm_phase<EpiProj, ProjOrder, false, false>(lds, DM * 2, S, E); }
           { ProjOrder S; S.S.init(p.ws + WS_HF8, p.ws + WS_WIN8, NTOK, 30 * 256, DM, G, (G - 1) - bx); S.fp8 = 1; S.Bfull = nullptr;
             pg8::gemm_phase<EpiProj, ProjOrder, false, true>(lds, DM, S, E, 0x79797979); });
    RUN(3, ph3_prep(p, lds, rep););
    RUN(4, ph4_attn(p, lds););
    RUN(5, DualOrder S; S.S0.init(p.ws + WS_OA8, p.ws + WS_WPA8, NTOK, DM, 1024, G, bx); S.S1.init(p.ws + WS_OB8, p.ws + WS_WPB8, NTOK, DM, 1024, G, bx);
           EpiGate12 E{EpiGate1{(const bf16_t*)(p.ws + WS_GATES), (bf16_t*)(p.ws + WS_OA)}, EpiGate2{(const bf16_t*)(p.ws + WS_GATES), (const bf16_t*)(p.ws + WS_OA), (unsigned char*)(p.ws + WS_MRG8)}};
           pg8::gemm_phase<EpiGate12, DualOrder, false, true>(lds, 1024, S, E, 0x79797979, 0x7c7c7c7c););
    RUN(6, pg8::StaticOrder S; S.init(p.ws + WS_MRG8, p.ws + WS_WO8, NTOK, DM, DM, G, bx); EpiWo E{(const float*)(p.ws + WS_MOD), (bf16_t*)(p.ws + WS_MERGED)};
           pg8::gemm_phase<EpiWo, pg8::StaticOrder, false, true>(lds, DM, S, E, 0x79797979, 0x7d7d7d7d););
    RUN(7, ph8_router(p, lds, rep););
    RUN(8, moe_gemm<true>(p, lds, rep););
    RUN(9, moe_gemm<false>(p, lds, rep););
    RUN(10, if (!rep) ph11_combine(p););
#undef RUN
#undef IN
#undef SEAM
}

constexpr int NPHASES = 11;
extern "C" void kernel_launch(void* const* d_in, const int* in_sizes, int n_in, void* d_out, int out_size, void* d_ws, size_t ws_size, hipStream_t stream) {
    static int grid = 0;
    if (grid == 0) {
        if (n_in != 25 || in_sizes[0] != NTOK * DM || out_size != NTOK * DM || ws_size < WS_END6) {
            fprintf(stderr, "kernel_launch: shape mismatch: n_in %d in0 %d out %d ws %zu (need %zu)\n", n_in, n_in > 0 ? in_sizes[0] : -1, out_size, ws_size, (size_t)WS_END6); grid = -1; return; }
        int dev = 0, cus = 0, per_cu = 0;
        if (hipGetDevice(&dev) != hipSuccess || hipDeviceGetAttribute(&cus, hipDeviceAttributeMultiprocessorCount, dev) != hipSuccess) { fprintf(stderr, "kernel_launch: device query failed\n"); grid = -1; return; }
        if (hipFuncSetAttribute((const void*)mk_fwd, hipFuncAttributeMaxDynamicSharedMemorySize, LDS_BYTES) != hipSuccess) { fprintf(stderr, "kernel_launch: hipFuncSetAttribute failed\n"); grid = -1; return; }
        if (hipOccupancyMaxActiveBlocksPerMultiprocessor(&per_cu, (const void*)mk_fwd, NTHREADS, LDS_BYTES) != hipSuccess || per_cu < 1) { fprintf(stderr, "kernel_launch: occupancy query says %d blocks per CU\n", per_cu); }
        (void)hipGetLastError();
        grid = cus;
    }
    if (grid < 0) return;
    if (hipMemsetAsync((char*)d_ws + WS_BAR, 0, WS_ZERO_BYTES, stream) != hipSuccess) { fprintf(stderr, "kernel_launch: memset failed\n"); return; }
    Params p; memset(&p, 0, sizeof(p));
    for (int i = 0; i < 25; ++i) p.in[i] = (const float*)d_in[i];
    p.out = (float*)d_out; p.ws = (unsigned char*)d_ws;
    unsigned char* ws = (unsigned char*)d_ws;
    auto job = [&](int j, const float* src, size_t dst_off, int K, int N, int ldd, int map, int nbatch, long sbatch, long dbatch) {
        TJob& J = p.jobs[j]; J.src = src; J.dst = (bf16_t*)(ws + dst_off); J.K = K; J.N = N; J.ldd = ldd; J.map = map; J.ntk = K / 64; J.ntn = (N + 127) / 128; J.nbatch = nbatch; J.sbatch = sbatch; J.dbatch = dbatch; J.ld = N; J.fp8 = 0; };
    job(0, p.in[I_WIN] + 512, WS_WIN, 2048, 1872, 2048, 4, 1, 0, 0); p.jobs[0].ld = DIN;
    job(1, p.in[I_WIN] + 5456, WS_WIN, 2048, 8, 2048, 5, 1, 0, 0); p.jobs[1].ld = DIN;
    job(2, p.in[I_WUK], WS_WUK, 128, 256, 128, 0, 8, 128L * 256, 256L * 128);
    job(3, p.in[I_WUV], WS_WUV, 256, 128, 256, 0, 8, 256L * 128, 128L * 256);
    job(4, p.in[I_WIN], WS_WIN8, 2048, 512, 2048, 0, 1, 0, 0); job(5, p.in[I_WIN] + 2384, WS_WIN8 + (size_t)512 * 2048, 2048, 3072, 2048, 0, 1, 0, 0); job(6, p.in[I_WIN] + 5464, WS_WIN8 + (size_t)3584 * 2048, 2048, 4096, 2048, 0, 1, 0, 0);
    for (int j = 4; j < 7; ++j) { p.jobs[j].ld = DIN; p.jobs[j].fp8 = 1; }
    job(7, p.in[I_WO], WS_WO8, 2048, 2048, 2048, 0, 1, 0, 0); p.jobs[7].fp8 = 1;
    job(8, p.in[I_WPA], WS_WPA8, 1024, 2048, 1024, 0, 1, 0, 0); p.jobs[8].fp8 = 1; job(9, p.in[I_WPB], WS_WPB8, 1024, 2048, 1024, 0, 1, 0, 0); p.jobs[9].fp8 = 1;
    int t0 = 0; for (int j = 0; j < NJOBS; ++j) { p.jobs[j].tile0 = t0; t0 += p.jobs[j].ntk * p.jobs[j].ntn * p.jobs[j].nbatch; }
    p.ntiles_total = t0;
#if MK_LAUNCHES == 1
    p.ph_lo = 0; p.ph_hi = NPHASES;
    hipLaunchKernelGGL(mk_fwd, dim3(grid), dim3(NTHREADS), LDS_BYTES, stream, p);
#else
    for (int k = 0; k < NPHASES; ++k) { p.ph_lo = k; p.ph_hi = k + 1; hipLaunchKernelGGL(mk_fwd, dim3(grid), dim3(NTHREADS), LDS_BYTES, stream, p); }
#endif
    const hipError_t le = hipPeekAtLastError();
    if (le != hipSuccess) fprintf(stderr, "kernel_launch: launch failed: %s\n", hipGetErrorName(le));
}
```

```cpp
#include <hip/hip_runtime.h>
#include <cstdio>
#include <cstdint>
#include <cstring>

#ifndef MK_LAUNCHES
#define MK_LAUNCHES 1
#endif

#define LAS __attribute__((address_space(3)))
typedef unsigned short bf16_t;
typedef short bf16x8 __attribute__((ext_vector_type(8)));
typedef short s16x4 __attribute__((ext_vector_type(4)));
typedef float f32x4 __attribute__((ext_vector_type(4)));
typedef float f32x16 __attribute__((ext_vector_type(16)));
typedef unsigned u32x4 __attribute__((ext_vector_type(4)));
typedef unsigned u32x2 __attribute__((ext_vector_type(2)));

constexpr int DM = 2048, NBATCH = 4, SEQ = 2048, NTOK = NBATCH * SEQ;
constexpr int DIN = 9560, DINP = 9728;
constexpr int NEXP = 64, DEXP = 512, LCAP = 8192;
constexpr float RMS_EPS = 1e-6f;
constexpr float LOG2E = 1.4426950408889634f;
constexpr int NTHREADS = 512;
constexpr int LDS_BYTES = 163840 - 1024;
constexpr int LDS_BARW = LDS_BYTES - 16;
constexpr int LDS_TAB = 131072;

constexpr size_t al256(size_t x) { return (x + 255) / 256 * 256; }
constexpr size_t WS_BAR = 0;
constexpr size_t WS_CNT = 16384;
constexpr size_t WS_ZERO_BYTES = 16384 + 4096;
constexpr size_t WS_MOD = WS_ZERO_BYTES;
constexpr size_t WS_H = al256(WS_MOD + (size_t)4 * 12288 * 4);
constexpr size_t WS_WIN = al256(WS_H + (size_t)NTOK * DM * 2);
constexpr size_t WS_WPA = al256(WS_WIN + (size_t)DINP * DM * 2);
constexpr size_t WS_WPB = al256(WS_WPA + (size_t)2048 * 1024 * 2);
constexpr size_t WS_WO = al256(WS_WPB + (size_t)2048 * 1024 * 2);
constexpr size_t WS_WUK = al256(WS_WO + (size_t)2048 * 2048 * 2);
constexpr size_t WS_WUV = al256(WS_WUK + (size_t)8 * 256 * 128 * 2);
constexpr size_t WS_W13 = al256(WS_WUV + (size_t)8 * 128 * 256 * 2);
constexpr size_t WS_W2 = al256(WS_W13 + (size_t)64 * 1024 * 2048 * 2);
constexpr size_t WS_QA = al256(WS_W2 + (size_t)64 * 2048 * 512 * 2);
constexpr size_t WS_CKV = al256(WS_QA + (size_t)NTOK * 1024 * 2);
constexpr size_t WS_KV = al256(WS_CKV + (size_t)NTOK * 256 * 4);
constexpr size_t WS_QIDX = al256(WS_KV + (size_t)NTOK * 256 * 2);
constexpr size_t WS_MISC = al256(WS_QIDX + (size_t)NTOK * 1024 * 2);
constexpr size_t WS_QB = al256(WS_MISC + (size_t)NTOK * 256 * 4);
constexpr size_t WS_KB = al256(WS_QB + (size_t)NTOK * 1024 * 2);
constexpr size_t WS_VB = al256(WS_KB + (size_t)NTOK * 1024 * 2);
constexpr size_t WS_GATES = al256(WS_VB + (size_t)NTOK * 1024 * 2);
constexpr size_t WS_QLAT = al256(WS_GATES + (size_t)NTOK * 4096 * 2);
constexpr size_t WS_MASK = al256(WS_QLAT + (size_t)NTOK * 2048 * 2);
constexpr size_t WS_CUM = al256(WS_MASK + (size_t)NTOK * 256);
constexpr size_t WS_OLAT = al256(WS_CUM + (size_t)4 * 8 * 2048 * 4);
constexpr size_t WS_OA = al256(WS_OLAT + (size_t)NTOK * 2048 * 2);
constexpr size_t WS_OB = al256(WS_OA + (size_t)NTOK * 1024 * 2);
constexpr size_t WS_T1 = al256(WS_OB + (size_t)NTOK * 1024 * 2);
constexpr size_t WS_MERGED = al256(WS_T1 + (size_t)NTOK * 2048 * 4);
constexpr size_t WS_LTOK = al256(WS_MERGED + (size_t)NTOK * 2048 * 2);
constexpr size_t WS_LW = al256(WS_LTOK + (size_t)NEXP * LCAP * 4);
constexpr size_t WS_ACT = al256(WS_LW + (size_t)NEXP * LCAP * 4);
constexpr size_t WS_HLO = al256(WS_ACT + (size_t)32768 * 512 * 2);
constexpr size_t WS_WRH = al256(WS_HLO + (size_t)NTOK * DM * 2);
constexpr size_t WS_WRL = al256(WS_WRH + (size_t)80 * DM * 2);
constexpr size_t WS_END = al256(WS_WRL + (size_t)80 * DM * 2);
constexpr size_t WS_KIDX = WS_END;
constexpr size_t WS_END2 = al256(WS_KIDX + (size_t)NTOK * 64 * 2);
constexpr size_t WS_H8 = WS_END2;
constexpr size_t WS_ACT8 = al256(WS_H8 + (size_t)NTOK * DM);
constexpr size_t WS_END3 = al256(WS_ACT8 + (size_t)16384 * 512);
constexpr size_t WS_HF8 = WS_END3;
constexpr size_t WS_WIN8 = al256(WS_HF8 + (size_t)NTOK * DM);
constexpr size_t WS_END4 = al256(WS_WIN8 + (size_t)7680 * DM);
constexpr size_t WS_MRG8 = WS_END4;
constexpr size_t WS_WO8 = al256(WS_MRG8 + (size_t)NTOK * DM);
constexpr size_t WS_END5 = al256(WS_WO8 + (size_t)2048 * 2048);
constexpr size_t WS_OA8 = WS_END5;
constexpr size_t WS_OB8 = al256(WS_OA8 + (size_t)NTOK * 1024);
constexpr size_t WS_WPA8 = al256(WS_OB8 + (size_t)NTOK * 1024);
constexpr size_t WS_WPB8 = al256(WS_WPA8 + (size_t)2048 * 1024);
constexpr size_t WS_END6 = al256(WS_WPB8 + (size_t)2048 * 1024);
constexpr size_t WS_YS = WS_T1;
constexpr size_t WS_HG = WS_QA;
static_assert(WS_HG + (size_t)32768 * DM * 2 <= WS_QLAT, "hg alias must fit in the dead region");

struct TJob { const float* src; bf16_t* dst; int K, N, ldd, map, ntk, ntn, nbatch, tile0; long sbatch, dbatch; int ld, fp8; };
constexpr int NJOBS = 10;
struct Params {
    const float* in[25];
    float* out;
    unsigned char* ws;
    TJob jobs[NJOBS];
    int ntiles_total;
    int ph_lo, ph_hi;
};
enum { I_X = 0, I_C, I_WADA, I_BADA, I_GMIX, I_WIN, I_BGATE, I_BFORGET, I_WUK, I_WUV, I_GQA, I_GKV, I_GQB, I_GKB, I_WPA, I_WPB, I_WO, I_GFFN, I_WRG, I_BRG, I_WRE, I_BRE, I_W1, I_W3, I_W2 };

__device__ __forceinline__ unsigned cvt_pk_bf16(float lo, float hi) { unsigned r; asm volatile("v_cvt_pk_bf16_f32 %0, %1, %2" : "=v"(r) : "v"(lo), "v"(hi)); return r; }
__device__ __forceinline__ float bf_lo(unsigned w) { return __uint_as_float(w << 16); }
__device__ __forceinline__ float bf_hi(unsigned w) { return __uint_as_float(w & 0xffff0000u); }
typedef float f32x2 __attribute__((ext_vector_type(2)));
__device__ __forceinline__ unsigned pack_fp8x4(float a, float b, float c, float d) { int w = __builtin_amdgcn_cvt_pk_fp8_f32(a, b, 0, false); w = __builtin_amdgcn_cvt_pk_fp8_f32(c, d, w, true); return (unsigned)w; }
__device__ __forceinline__ bf16x8 fp8x8_to_bf16(u32x2 v) {
    const f32x2 a = __builtin_amdgcn_cvt_pk_f32_fp8((int)v.x, false), b = __builtin_amdgcn_cvt_pk_f32_fp8((int)v.x, true), c = __builtin_amdgcn_cvt_pk_f32_fp8((int)v.y, false), d = __builtin_amdgcn_cvt_pk_f32_fp8((int)v.y, true);
    u32x4 w; w.x = cvt_pk_bf16(a.x, a.y); w.y = cvt_pk_bf16(b.x, b.y); w.z = cvt_pk_bf16(c.x, c.y); w.w = cvt_pk_bf16(d.x, d.y); return *reinterpret_cast<bf16x8*>(&w); }
__device__ __forceinline__ unsigned pack_u8x4(float a, float b, float c, float d) {
    unsigned w = 0; w = __builtin_amdgcn_cvt_pk_u8_f32(a * 255.f + 0.5f, 0, w); w = __builtin_amdgcn_cvt_pk_u8_f32(b * 255.f + 0.5f, 1, w); w = __builtin_amdgcn_cvt_pk_u8_f32(c * 255.f + 0.5f, 2, w); w = __builtin_amdgcn_cvt_pk_u8_f32(d * 255.f + 0.5f, 3, w); return w; }
__device__ __forceinline__ f32x4 unpack_u8x4(unsigned w) { return (f32x4){(float)(w & 0xffu), (float)((w >> 8) & 0xffu), (float)((w >> 16) & 0xffu), (float)(w >> 24)} * (1.0f / 255.0f); }
__device__ __forceinline__ float wave_sum(float v) {
#pragma unroll
    for (int o = 32; o >= 1; o >>= 1) v += __shfl_xor(v, o);
    return v;
}
__device__ __forceinline__ float sigmoidf_(float x) { return __builtin_amdgcn_rcpf(1.0f + __builtin_amdgcn_exp2f(-1.4426950408889634f * x)); }
__device__ __forceinline__ int crow(int r, int hi) { return (r & 3) + 8 * (r >> 2) + 4 * hi; }
#define SBAR() __builtin_amdgcn_sched_barrier(0)

#define XB_TMO      128
#define XB_XCNT(j)  (256  + 64 * (j))
#define XB_XSUB(j)  (1280 + 64 * (j))
#define XB_XGEN(j)  (2304 + 64 * (j))
#define XB_TOP      3328
#define XB_TOPGEN   3392
#define XCD_BAR_WORDS 3456
#define XB_SPIN_CAP (1u << 20)
__device__ __forceinline__ unsigned xb_ld(unsigned* p)              { return __hip_atomic_load(p, __ATOMIC_RELAXED, __HIP_MEMORY_SCOPE_AGENT); }
__device__ __forceinline__ unsigned xb_add(unsigned* p, unsigned v) { return __hip_atomic_fetch_add(p, v, __ATOMIC_RELAXED, __HIP_MEMORY_SCOPE_AGENT); }
__device__ __forceinline__ unsigned xb_xcc_id() { return (unsigned)__builtin_amdgcn_s_getreg((3 << 11) | 20) & 0xFu; }
#define XB_SPIN(cond, bar) do { unsigned _sp = 0; while (cond) { __builtin_amdgcn_s_sleep(1); \
    if ((++_sp & 255u) == 0u) { if (xb_ld(&(bar)[XB_TMO])) break; if (_sp > XB_SPIN_CAP) { atomicAdd(&(bar)[XB_TMO], 1u); break; } } } } while (0)
struct XcdBarrier { unsigned* bar; unsigned x; volatile LAS unsigned* st; };
__device__ __forceinline__ XcdBarrier xcd_barrier_post(unsigned* bar, volatile LAS unsigned* st) {
    XcdBarrier b; b.bar = bar; b.x = xb_xcc_id(); b.st = st;
    if (threadIdx.x == 0) (void)xb_add(&bar[XB_XCNT(b.x)], 1u);
    return b;
}
__device__ __forceinline__ void xcd_barrier_complete(unsigned* bar, unsigned x, unsigned& nloc, unsigned& nx) {
    const unsigned G = gridDim.x * gridDim.y * gridDim.z;
    unsigned sum, cnt, mine, sp = 0u;
    for (;;) {
        sum = 0u; cnt = 0u; mine = 0u;
#pragma unroll
        for (unsigned j = 0; j < 16; ++j) { const unsigned c = xb_ld(&bar[XB_XCNT(j)]); sum += c; cnt += (c > 0u) ? 1u : 0u; mine = (j == x) ? c : mine; }
        if (sum == G) break;
        __builtin_amdgcn_s_sleep(1);
        if ((++sp & 255u) == 0u) { if (xb_ld(&bar[XB_TMO])) break; if (sp > XB_SPIN_CAP) { atomicAdd(&bar[XB_TMO], 1u); break; } }
    }
    nloc = mine > 0u ? mine : 1u; nx = cnt > 0u ? cnt : 1u;
}
__device__ __forceinline__ void xcd_barrier(const XcdBarrier& b) {
    asm volatile("s_waitcnt vmcnt(0)" ::: "memory");
    __syncthreads();
    if (threadIdx.x == 0) {
        unsigned* bar = b.bar;
        __builtin_amdgcn_s_waitcnt(0);
        unsigned nloc = b.st[0], nx = b.st[1];
        if (nloc == 0u) { xcd_barrier_complete(bar, b.x, nloc, nx); b.st[0] = nloc; b.st[1] = nx; }
        const unsigned old = xb_add(&bar[XB_XSUB(b.x)], 1u);
        const unsigned gen = old / nloc;
        if (old + 1u == (gen + 1u) * nloc) {
            __builtin_amdgcn_fence(__ATOMIC_RELEASE, "agent");
            asm volatile("s_waitcnt vmcnt(0)" ::: "memory");
            const unsigned og = xb_add(&bar[XB_TOP], 1u);
            const unsigned tg = og / nx;
            if (og + 1u == (tg + 1u) * nx) xb_add(&bar[XB_TOPGEN], 1u);
            else XB_SPIN(xb_ld(&bar[XB_TOPGEN]) == tg, bar);
            __builtin_amdgcn_fence(__ATOMIC_ACQUIRE, "agent");
            xb_add(&bar[XB_XGEN(b.x)], 1u);
            asm volatile("s_waitcnt vmcnt(0)" ::: "memory");
        } else {
            XB_SPIN(xb_ld(&bar[XB_XGEN(b.x)]) == gen, bar);
            __builtin_amdgcn_fence(__ATOMIC_ACQUIRE, "agent");
            asm volatile("s_waitcnt vmcnt(0)" ::: "memory");
        }
    }
    __syncthreads();
}

namespace pg8 {
constexpr int BM = 256, BK = 64, HALF = 128, HTB = HALF * BK * 2, STAGE_BYTES = 8 * HTB, NXCD = 8, WGM = 8;
__host__ __device__ __forceinline__ int lds_byte(int r, int c) { const int st = (r >> 4) * 2 + (c >> 5), rr = r & 15, cc = c & 31, ob = rr * 64 + cc * 2; return st * 1024 + (ob ^ (((ob >> 9) & 1) << 5)); }
__host__ __device__ __forceinline__ void stage_rc(int b, int& R, int& C) { const int st = b / 1024, sb = b % 1024, swz = sb ^ (((sb >> 9) & 1) << 5); R = (st >> 1) * 16 + swz / 64; C = (st & 1) * 32 + (swz % 64) / 2; }
__host__ __device__ __forceinline__ int perm32(int rho) { const int n = rho >> 4, i = rho & 15; return 8 * (i >> 2) + 4 * n + (i & 3); }

struct Unit { int pm, pn; const char* a; const char* b; const int* gi; int nvalid; int aux; };

struct StaticOrder {
    int nM, nN, nwg, G, c, RS; const char* A; const char* Bt;
    __device__ void init(const void* A_, const void* Bt_, int M, int N, int RS_, int G_, int c_) { A = (const char*)A_; Bt = (const char*)Bt_; RS = RS_; nM = M / BM; nN = N / BM; nwg = nM * nN; G = G_; c = c_; }
    __device__ bool next(int i, Unit& u) const {
        const long L = (long)i * G + c; if (L >= nwg) return false;
        int wgid = (int)L; { const int q = nwg / NXCD, r = nwg % NXCD, xcd = wgid % NXCD, off = wgid / NXCD; wgid = (xcd < r ? xcd * (q + 1) : r * (q + 1) + (xcd - r) * q) + off; }
        const int nig = WGM * nN, gid = wgid / nig, fm = gid * WGM, gsz = (nM - fm) < WGM ? (nM - fm) : WGM;
        u.pm = fm + ((wgid % nig) % gsz); u.pn = (wgid % nig) / gsz;
        u.a = A + (size_t)u.pm * BM * RS; u.b = Bt + (size_t)u.pn * BM * RS; u.gi = nullptr; u.nvalid = BM; u.aux = 0; return true;
    }
};

typedef int i32x8 __attribute__((ext_vector_type(8)));
typedef int i32x4v __attribute__((ext_vector_type(4)));
template <class Epi, class Sched, bool GATHER, bool FP8 = false>
__device__ __forceinline__ void gemm_phase(LAS unsigned char* lds, const int RS, const Sched& S, const Epi& E, const int scale_b = 0x7f7f7f7f, const int scale_a = 0x7f7f7f7f) {
    int tid = threadIdx.x; asm volatile("" : "+v"(tid));
    const int wid = __builtin_amdgcn_readfirstlane(tid >> 6), lane = tid & 63, wr = wid >> 2, wc = wid & 3, fr = lane & 15, fq = lane >> 4;
    const int nt = RS / (BK * 2); const int K = RS;
    unsigned voffA[2], voffB[2]; int RA[2], CA[2];
#pragma unroll
    for (int i = 0; i < 2; ++i) { int R, C; stage_rc(tid * 16 + i * 8192, R, C); const int Rb = ((R & ~31) + perm32(R & 31));
        RA[i] = R; CA[i] = C; voffA[i] = (unsigned)(R * RS + C * 2); voffB[i] = (unsigned)(Rb * RS + C * 2); }
    const size_t kstep = (size_t)(BK * 2);
    const size_t hstep = (size_t)HALF * RS;
    const unsigned ldsw = (unsigned)wid * 1024u;
    const int aoff = lds_byte(wr * 64 + fr, fq * 8), boff = lds_byte(wc * 32 + fr, fq * 8);
    unsigned gA[2][2], gN[2][2];
#define PG8_SA(b, h) (((b) * 2 + (h)) * HTB)
#define PG8_SB(b, h) ((4 + (b) * 2 + (h)) * HTB)
#define PG8_STAGE(bufoff, gbase, voff) do { _Pragma("unroll") for (int _i = 0; _i < 2; ++_i) \
        __builtin_amdgcn_global_load_lds((const unsigned*)((const char*)(gbase) + (voff)[_i]), (LAS unsigned*)(lds + (bufoff) + ldsw + _i * 8192), 16, 0, 0); } while (0)
#define PG8_STAGE_A(bufoff, gp, h, NX) do { if constexpr (GATHER) { if (NX) PG8_STAGE(bufoff, gp, gN[h]); else PG8_STAGE(bufoff, gp, gA[h]); } else PG8_STAGE(bufoff, (gp) + (h) * hstep, voffA); } while (0)
#define PG8_LD8(p_) __builtin_shufflevector(*(const LAS i32x4v*)(p_), *(const LAS i32x4v*)((p_) + 1024), 0, 1, 2, 3, 4, 5, 6, 7)
#define PG8_LDA(dst, b, h) do { if constexpr (FP8) { _Pragma("unroll") for (int m = 0; m < 4; ++m) dst##8[m] = PG8_LD8(lds + PG8_SA(b, h) + aoff + m * 2048); } \
        else { _Pragma("unroll") for (int m = 0; m < 4; ++m) _Pragma("unroll") for (int k = 0; k < 2; ++k) dst[m][k] = *(const LAS bf16x8*)(lds + PG8_SA(b, h) + aoff + m * 2048 + k * 1024); } } while (0)
#define PG8_LDB(dst, b, h) do { if constexpr (FP8) { _Pragma("unroll") for (int n = 0; n < 2; ++n) dst##8[n] = PG8_LD8(lds + PG8_SB(b, h) + boff + n * 2048); } \
        else { _Pragma("unroll") for (int n = 0; n < 2; ++n) _Pragma("unroll") for (int k = 0; k < 2; ++k) dst[n][k] = *(const LAS bf16x8*)(lds + PG8_SB(b, h) + boff + n * 2048 + k * 1024); } } while (0)
#define PG8_MMA(ai, bj, At, Bt) do { __builtin_amdgcn_s_setprio(1); \
        if constexpr (FP8) { _Pragma("unroll") for (int m = 0; m < 4; ++m) _Pragma("unroll") for (int n = 0; n < 2; ++n) \
            asm volatile("v_mfma_scale_f32_16x16x128_f8f6f4 %0, %1, %2, %0, %3, %4 op_sel_hi:[0,0,0]" : "+v"(acc[ai][bj][m][n]) : "v"(Bt##8[n]), "v"(At##8[m]), "v"(sc_b), "v"(sc_a)); } \
        else { _Pragma("unroll") for (int m = 0; m < 4; ++m) _Pragma("unroll") for (int n = 0; n < 2; ++n) _Pragma("unroll") for (int k = 0; k < 2; ++k) \
            acc[ai][bj][m][n] = __builtin_amdgcn_mfma_f32_16x16x32_bf16(Bt[n][k], At[m][k], acc[ai][bj][m][n], 0, 0, 0); } \
        __builtin_amdgcn_s_setprio(0); } while (0)
#define PG8_WAIT_V(n) asm volatile("s_waitcnt vmcnt(" #n ")" ::: "memory")
#define PG8_WAIT_L(n) asm volatile("s_waitcnt lgkmcnt(" #n ")" ::: "memory")
#define PG8_BAR __builtin_amdgcn_s_barrier()
#define PG8_SCHED __builtin_amdgcn_sched_barrier(0)
#define PG8_GIDX(dst, u) do { if constexpr (GATHER) { _Pragma("unroll") for (int h = 0; h < 2; ++h) _Pragma("unroll") for (int i = 0; i < 2; ++i) { \
        const int rr = h * HALF + RA[i]; const int tok = rr < (u).nvalid ? (u).gi[rr] : 0; dst[h][i] = (unsigned)(tok * K + CA[i] * 2); } } } while (0)
    Unit cur, nxt; int ui = 0;
    if (!S.next(0, cur)) return;
    f32x4 acc[2][2][4][2];
#pragma unroll
    for (int a = 0; a < 2; ++a)
#pragma unroll
        for (int b = 0; b < 2; ++b)
#pragma unroll
            for (int m = 0; m < 4; ++m)
#pragma unroll
                for (int n = 0; n < 2; ++n) acc[a][b][m][n] = (f32x4){0.f, 0.f, 0.f, 0.f};
    const int sc_b = scale_b, sc_a = scale_a;
    bf16x8 At[4][2], B0[2][2], B1[2][2]; i32x8 At8[4], B08[2], B18[2];
    const char* cA = cur.a; const char* cB = cur.b;
    PG8_GIDX(gA, cur);
    PG8_STAGE(PG8_SB(0, 0), cB, voffB); PG8_STAGE_A(PG8_SA(0, 0), cA, 0, false); PG8_STAGE(PG8_SB(0, 1), cB + hstep, voffB); PG8_STAGE_A(PG8_SA(0, 1), cA, 1, false);
    if (wr == 1) PG8_BAR;
    PG8_WAIT_V(4); PG8_BAR;
    PG8_STAGE(PG8_SB(1, 0), cB + kstep, voffB); PG8_STAGE_A(PG8_SA(1, 0), cA + kstep, 0, false); PG8_STAGE(PG8_SB(1, 1), cB + hstep + kstep, voffB);
    PG8_WAIT_V(6); PG8_BAR;
    for (;;) {
        const bool has_next = S.next(ui + 1, nxt);
        const char* nA = has_next ? nxt.a : cA; const char* nB = has_next ? nxt.b : cB;
        if constexpr (GATHER) { if (has_next) { PG8_GIDX(gN, nxt); } else {
#pragma unroll
            for (int h = 0; h < 2; ++h)
#pragma unroll
                for (int i = 0; i < 2; ++i) gN[h][i] = gA[h][i]; } }
        for (int t = 0; t < nt; t += 2) {
            const bool last = (t == nt - 2);
            const char* a1 = cA + (size_t)(t + 1) * kstep;
            const char* a2 = last ? nA : cA + (size_t)(t + 2) * kstep; const char* b2 = last ? nB : cB + (size_t)(t + 2) * kstep;
            const char* a3 = a2 + kstep; const char* b3 = b2 + kstep;
            PG8_LDB(B0, 0, 0); PG8_SCHED; PG8_LDA(At, 0, 0); PG8_STAGE_A(PG8_SA(1, 1), a1, 1, false);
            PG8_WAIT_L(8); PG8_BAR; PG8_WAIT_L(0); PG8_MMA(0, 0, At, B0); PG8_BAR; PG8_SCHED;
            PG8_LDB(B1, 0, 1); PG8_STAGE(PG8_SB(0, 0), b2, voffB);
            PG8_BAR; PG8_WAIT_L(0); PG8_MMA(0, 1, At, B1); PG8_BAR;
            PG8_LDA(At, 0, 1); PG8_STAGE_A(PG8_SA(0, 0), a2, 0, last);
            PG8_BAR; PG8_WAIT_L(0); PG8_MMA(1, 0, At, B0); PG8_BAR; PG8_SCHED;
            PG8_STAGE(PG8_SB(0, 1), b2 + hstep, voffB);
            PG8_WAIT_V(6); PG8_BAR; PG8_MMA(1, 1, At, B1); PG8_BAR;
            PG8_LDB(B0, 1, 0); PG8_SCHED; PG8_LDA(At, 1, 0); PG8_STAGE_A(PG8_SA(0, 1), a2, 1, last);
            PG8_WAIT_L(8); PG8_BAR; PG8_WAIT_L(0); PG8_MMA(0, 0, At, B0); PG8_BAR; PG8_SCHED;
            PG8_LDB(B1, 1, 1); PG8_STAGE(PG8_SB(1, 0), b3, voffB);
            PG8_BAR; PG8_WAIT_L(0); PG8_MMA(0, 1, At, B1); PG8_BAR;
            PG8_LDA(At, 1, 1); PG8_STAGE_A(PG8_SA(1, 0), a3, 0, last);
            PG8_BAR; PG8_WAIT_L(0); PG8_MMA(1, 0, At, B0); PG8_BAR; PG8_SCHED;
            PG8_STAGE(PG8_SB(1, 1), b3 + hstep, voffB);
            PG8_WAIT_V(6); PG8_BAR; PG8_MMA(1, 1, At, B1); PG8_BAR;
        }
        bool keep_acc = false;
        if constexpr (FP8) asm volatile("s_nop 15\n\ts_nop 15" ::: "memory");
        if constexpr (Epi::DUAL) { if (cur.aux) { E.mid(acc, cur, wr, wc, fr, fq); keep_acc = true; } else E(acc, cur, wr, wc, fr, fq); } else E(acc, cur, wr, wc, fr, fq);
        if (!has_next) break;
        if (!keep_acc)
#pragma unroll
        for (int a = 0; a < 2; ++a)
#pragma unroll
            for (int b = 0; b < 2; ++b)
#pragma unroll
                for (int m = 0; m < 4; ++m)
#pragma unroll
                    for (int n = 0; n < 2; ++n) acc[a][b][m][n] = (f32x4){0.f, 0.f, 0.f, 0.f};
        cur = nxt; cA = nA; cB = nB; ++ui;
        if constexpr (GATHER) {
#pragma unroll
            for (int h = 0; h < 2; ++h)
#pragma unroll
                for (int i = 0; i < 2; ++i) gA[h][i] = gN[h][i]; }
    }
    PG8_WAIT_V(0);
    if (wr == 0) PG8_BAR;
    PG8_BAR;
#undef PG8_SA
#undef PG8_SB
#undef PG8_STAGE
#undef PG8_STAGE_A
#undef PG8_LDA
#undef PG8_LD8
#undef PG8_LDB
#undef PG8_MMA
#undef PG8_WAIT_V
#undef PG8_WAIT_L
#undef PG8_BAR
#undef PG8_SCHED
#undef PG8_GIDX
}
}
using pg8::Unit;

#define EPI_LOOP(...) { int fr_ = fr, fq_ = fq; asm volatile("" : "+v"(fr_), "+v"(fq_)); _Pragma("unroll") for (int ai = 0; ai < 2; ++ai) _Pragma("unroll") for (int m = 0; m < 4; ++m) _Pragma("unroll") for (int bj = 0; bj < 2; ++bj) { \
        const int trow = ai * 128 + wr * 64 + m * 16 + fr_; const int tcol = bj * 128 + wc * 32 + fq_ * 8; const f32x4 v0 = acc[ai][bj][m][0], v1 = acc[ai][bj][m][1]; __VA_ARGS__ } }

__device__ __forceinline__ u32x4 pack8(const f32x4 a, const f32x4 b) { u32x4 w; w.x = cvt_pk_bf16(a[0], a[1]); w.y = cvt_pk_bf16(a[2], a[3]); w.z = cvt_pk_bf16(b[0], b[1]); w.w = cvt_pk_bf16(b[2], b[3]); return w; }

struct EpiProj { static constexpr bool DUAL = false;
    unsigned char* ws; const float* b_gate;
    __device__ __forceinline__ void operator()(const f32x4 (&acc)[2][2][4][2], const Unit& u, int wr, int wc, int fr, int fq) const {
        const int pn = u.pn; const size_t row0 = (size_t)u.pm * 256;
        if (pn == 4 || pn == 9) {
            float* dst = (float*)(ws + (pn == 4 ? WS_CKV : WS_MISC));
            EPI_LOOP({ float* p = dst + (row0 + trow) * 256 + tcol; *(f32x4*)p = v0; *(f32x4*)(p + 4) = v1;
                if (pn == 9 && tcol < 64) *(u32x4*)((bf16_t*)(ws + WS_KIDX) + (row0 + trow) * 64 + tcol) = pack8(v0, v1); })
        } else if (pn < 22) {
            bf16_t* dst; int ct;
            if (pn < 4) { dst = (bf16_t*)(ws + WS_QA); ct = pn; } else if (pn < 9) { dst = (bf16_t*)(ws + WS_QIDX); ct = pn - 5; }
            else if (pn < 14) { dst = (bf16_t*)(ws + WS_QB); ct = pn - 10; } else if (pn < 18) { dst = (bf16_t*)(ws + WS_KB); ct = pn - 14; } else { dst = (bf16_t*)(ws + WS_VB); ct = pn - 18; }
            EPI_LOOP({ *(u32x4*)(dst + (row0 + trow) * 1024 + ct * 256 + tcol) = pack8(v0, v1); })
        } else {
            bf16_t* dst = (bf16_t*)(ws + WS_GATES); const int ct = pn - 22;
            EPI_LOOP({ const int col = ct * 256 + tcol; const f32x4 b0 = *(const f32x4*)(b_gate + col), b1 = *(const f32x4*)(b_gate + col + 4); f32x4 s0, s1;
                _Pragma("unroll") for (int j = 0; j < 4; ++j) { s0[j] = sigmoidf_(v0[j] + b0[j]); s1[j] = sigmoidf_(v1[j] + b1[j]); }
                u32x2 w8; w8.x = pack_u8x4(s0[0], s0[1], s0[2], s0[3]); w8.y = pack_u8x4(s1[0], s1[1], s1[2], s1[3]); *(u32x2*)((unsigned char*)dst + (row0 + trow) * 4096 + col) = w8; })
        }
    }
};
struct EpiGate1 { static constexpr bool DUAL = false;
    const bf16_t* gates; bf16_t* T1;
    __device__ __forceinline__ void operator()(const f32x4 (&acc)[2][2][4][2], const Unit& u, int wr, int wc, int fr, int fq) const {
        EPI_LOOP({ const size_t row = (size_t)u.pm * 256 + trow; const int col = u.pn * 256 + tcol; const u32x2 g = *(const u32x2*)((const unsigned char*)gates + row * 4096 + col);
            const f32x4 o0 = v0 * unpack_u8x4(g.x), o1 = v1 * unpack_u8x4(g.y);
            *(u32x4*)(T1 + row * 2048 + col) = pack8(o0, o1); })
    }
};
struct EpiGate2 { static constexpr bool DUAL = false;
    const bf16_t* gates; const bf16_t* T1; unsigned char* merged;
    __device__ __forceinline__ void operator()(const f32x4 (&acc)[2][2][4][2], const Unit& u, int wr, int wc, int fr, int fq) const {
        EPI_LOOP({ const size_t row = (size_t)u.pm * 256 + trow; const int col = u.pn * 256 + tcol; const u32x2 g = *(const u32x2*)((const unsigned char*)gates + row * 4096 + 2048 + col);
            const u32x4 t = *(const u32x4*)(T1 + row * 2048 + col);
            const f32x4 o0 = (f32x4){bf_lo(t.x), bf_hi(t.x), bf_lo(t.y), bf_hi(t.y)} + v0 * unpack_u8x4(g.x), o1 = (f32x4){bf_lo(t.z), bf_hi(t.z), bf_lo(t.w), bf_hi(t.w)} + v1 * unpack_u8x4(g.y);
            u32x2 w8; w8.x = pack_fp8x4(o0[0] * 4.f, o0[1] * 4.f, o0[2] * 4.f, o0[3] * 4.f); w8.y = pack_fp8x4(o1[0] * 4.f, o1[1] * 4.f, o1[2] * 4.f, o1[3] * 4.f);
            *(u32x2*)(merged + row * 2048 + col) = w8; })
    }
};
struct EpiWo { static constexpr bool DUAL = false;
    const float* mod; bf16_t* y;
    __device__ __forceinline__ void operator()(const f32x4 (&acc)[2][2][4][2], const Unit& u, int wr, int wc, int fr, int fq) const {
        const float* gt = mod + (size_t)(u.pm >> 3) * 12288 + 4096;
        EPI_LOOP({ const size_t row = (size_t)u.pm * 256 + trow; const int col = u.pn * 256 + tcol;
            const f32x4 g0 = *(const f32x4*)(gt + col), g1 = *(const f32x4*)(gt + col + 4);
            *(u32x4*)(y + row * 2048 + col) = pack8(g0 * v0, g1 * v1); })
    }
};
struct DualOrder {
    pg8::StaticOrder S0, S1;
    __device__ bool next(int i, Unit& u) const { const bool ok = (i & 1) ? S1.next(i >> 1, u) : S0.next(i >> 1, u); u.aux = (i & 1) ? 0 : 1; return ok; }
};
struct EpiGate12 { static constexpr bool DUAL = false;
    EpiGate1 e1; EpiGate2 e2;
    __device__ __forceinline__ void operator()(const f32x4 (&acc)[2][2][4][2], const Unit& u, int wr, int wc, int fr, int fq) const { if (u.aux) e1(acc, u, wr, wc, fr, fq); else e2(acc, u, wr, wc, fr, fq); }
};

struct ProjOrder {
    pg8::StaticOrder S; int fp8; const char* Bfull;
    __device__ bool next(int i, Unit& u) const {
        if (!S.next(i, u)) return false;
        if (fp8) { if (u.pn >= 2) u.pn += 8; } else u.pn += 2;
        return true;
    }
};
__device__ __forceinline__ int map_row(int map, int n) {
    if (map == 0) return n;
    if (map == 1) { if (n < 2384) return n; if (n < 5456) return n + 176; if (n < 5464) return n - 3072; return n + 168; }
    if (map == 4) return n + 512;
    return n + 2384;
}
__device__ void ph0_prologue(const Params& p, LAS unsigned char* lds) {
    const int tid = threadIdx.x, wid = tid >> 6, lane = tid & 63, G = gridDim.x, bx = blockIdx.x;
    if (bx < 192) {
        LAS float* sc = (LAS float*)lds;
        LAS float* red = (LAS float*)(lds + 32768);
        const float* c = p.in[I_C];
        for (int i = tid; i < 4 * 2048; i += NTHREADS) { const float v = c[i]; sc[i] = v / (1.0f + __expf(-v)); }
        __syncthreads();
        for (int item = bx; item < 192; item += G) {
            const int n0 = item * 64, cg = lane & 15, rs = lane >> 4;
            float acc[4][4];
#pragma unroll
            for (int b = 0; b < 4; ++b)
#pragma unroll
                for (int j = 0; j < 4; ++j) acc[b][j] = 0.f;
            const float* w = p.in[I_WADA] + n0 + cg * 4;
#pragma unroll 4
            for (int step = 0; step < 64; ++step) {
                const int k = step * 32 + wid * 4 + rs;
                const f32x4 wv = *(const f32x4*)(w + (size_t)k * 12288);
#pragma unroll
                for (int b = 0; b < 4; ++b) { const float s = sc[b * 2048 + k];
#pragma unroll
                    for (int j = 0; j < 4; ++j) acc[b][j] += s * wv[j]; }
            }
#pragma unroll
            for (int b = 0; b < 4; ++b)
#pragma unroll
                for (int j = 0; j < 4; ++j) { float v = acc[b][j]; v += __shfl_xor(v, 16); v += __shfl_xor(v, 32); acc[b][j] = v; }
            if (rs == 0) {
#pragma unroll
                for (int b = 0; b < 4; ++b)
#pragma unroll
                    for (int j = 0; j < 4; ++j) red[(wid * 16 + cg) * 16 + b * 4 + j] = acc[b][j]; }
            __syncthreads();
            if (tid < 256) { const int cg2 = tid >> 4, bj = tid & 15, b = bj >> 2, j = bj & 3; float s = 0.f;
#pragma unroll
                for (int w8 = 0; w8 < 8; ++w8) s += red[(w8 * 16 + cg2) * 16 + bj];
                const int n = n0 + cg2 * 4 + j; ((float*)(p.ws + WS_MOD))[b * 12288 + n] = s + p.in[I_BADA][n]; }
            __syncthreads();
        }
    }
    { u32x4* z = (u32x4*)(p.ws + WS_WIN + (size_t)2392 * 2048 * 2); const int n16 = 168 * 2048 * 2 / 16;
      for (int i = bx * NTHREADS + tid; i < n16; i += G * NTHREADS) z[i] = (u32x4){0u, 0u, 0u, 0u}; }
    { bf16_t* wh = (bf16_t*)(p.ws + WS_WRH); bf16_t* wl = (bf16_t*)(p.ws + WS_WRL);
      for (int i = bx * NTHREADS + tid; i < 80 * 2048; i += G * NTHREADS) { const int n = i >> 11, k = i & 2047;
          const float v = n < 8 ? p.in[I_WRG][k * 8 + n] : (n < 72 ? p.in[I_WRE][k * 64 + n - 8] : 0.f);
          const unsigned h = cvt_pk_bf16(v, 0.f) & 0xffffu; const unsigned l = cvt_pk_bf16(v - bf_lo(h), 0.f) & 0xffffu; wh[i] = (bf16_t)h; wl[i] = (bf16_t)l; } }
    LAS float* tile = (LAS float*)(lds + 65536);
    for (int ti = bx; ti < p.ntiles_total; ti += G) {
        int j = 0;
#pragma unroll 1
        for (int q = 1; q < NJOBS; ++q) if (ti >= p.jobs[q].tile0) j = q;
        const TJob& J = p.jobs[j];
        int l = ti - J.tile0; const int per = J.ntk * J.ntn; const int bt = l / per; l -= bt * per; const int tn = l / J.ntk, tk = l % J.ntk;
        const float* src = J.src + (size_t)bt * J.sbatch; bf16_t* dst = J.dst + (size_t)bt * J.dbatch;
        const int k0 = tk * 64, n0 = tn * 128;
        f32x4 v[4];
#pragma unroll
        for (int i = 0; i < 4; ++i) { const int r = (tid >> 5) + 16 * i, c4 = (tid & 31) * 4;
            v[i] = (f32x4){0.f, 0.f, 0.f, 0.f}; if (n0 + c4 < J.N) v[i] = *(const f32x4*)(src + (size_t)(k0 + r) * J.ld + n0 + c4); }
#pragma unroll
        for (int i = 0; i < 4; ++i) { const int r = (tid >> 5) + 16 * i, c4 = (tid & 31) * 4;
#pragma unroll
            for (int q = 0; q < 4; ++q) tile[r * 129 + c4 + q] = v[i][q]; }
        __syncthreads();
        { const int n = tid >> 2, kq = (tid & 3) * 16;
          if (n0 + n < J.N) { float f[16];
#pragma unroll
              for (int q = 0; q < 16; ++q) f[q] = tile[(kq + q) * 129 + n];
              u32x4 w0, w1; w0.x = cvt_pk_bf16(f[0], f[1]); w0.y = cvt_pk_bf16(f[2], f[3]); w0.z = cvt_pk_bf16(f[4], f[5]); w0.w = cvt_pk_bf16(f[6], f[7]);
              w1.x = cvt_pk_bf16(f[8], f[9]); w1.y = cvt_pk_bf16(f[10], f[11]); w1.z = cvt_pk_bf16(f[12], f[13]); w1.w = cvt_pk_bf16(f[14], f[15]);
              if (J.fp8) { u32x4 w8; w8.x = pack_fp8x4(f[0] * 64.f, f[1] * 64.f, f[2] * 64.f, f[3] * 64.f); w8.y = pack_fp8x4(f[4] * 64.f, f[5] * 64.f, f[6] * 64.f, f[7] * 64.f);
                  w8.z = pack_fp8x4(f[8] * 64.f, f[9] * 64.f, f[10] * 64.f, f[11] * 64.f); w8.w = pack_fp8x4(f[12] * 64.f, f[13] * 64.f, f[14] * 64.f, f[15] * 64.f);
                  *(u32x4*)((unsigned char*)dst + (size_t)(n0 + n) * J.ldd + k0 + kq) = w8; }
              else { bf16_t* d = dst + (size_t)map_row(J.map, n0 + n) * J.ldd + k0 + kq; *(u32x4*)d = w0; *(u32x4*)(d + 8) = w1; } } }
        __syncthreads();
    }
}

__device__ __forceinline__ void norm_row(const float* xr, const float* g, const float* sh, const float* sc, bf16_t* hr, unsigned char* h8, int lane, float (&hv)[32]) {
    f32x4 v[8]; float ss = 0.f;
#pragma unroll
    for (int i = 0; i < 8; ++i) { v[i] = *(const f32x4*)(xr + i * 256 + lane * 4); ss += v[i][0] * v[i][0] + v[i][1] * v[i][1] + v[i][2] * v[i][2] + v[i][3] * v[i][3]; }
    ss = wave_sum(ss);
    const float rstd = rsqrtf(ss * (1.0f / 2048.0f) + RMS_EPS);
#pragma unroll
    for (int i = 0; i < 8; ++i) { const int col = i * 256 + lane * 4; const f32x4 gg = *(const f32x4*)(g + col), s1 = *(const f32x4*)(sc + col), s0 = *(const f32x4*)(sh + col);
#pragma unroll
        for (int j = 0; j < 4; ++j) hv[i * 4 + j] = v[i][j] * rstd * gg[j] * (1.0f + s1[j]) + s0[j];
        u32x2 w; w.x = cvt_pk_bf16(hv[i * 4], hv[i * 4 + 1]); w.y = cvt_pk_bf16(hv[i * 4 + 2], hv[i * 4 + 3]); *(u32x2*)(hr + col) = w;
        if (h8) *(unsigned*)(h8 + col) = pack_fp8x4(hv[i * 4], hv[i * 4 + 1], hv[i * 4 + 2], hv[i * 4 + 3]); }
}
__device__ void ph1_norm(const Params& p) {
    const int lane = threadIdx.x & 63, gw = blockIdx.x * 8 + (threadIdx.x >> 6), nw = gridDim.x * 8;
    const float* mod = (const float*)(p.ws + WS_MOD);
    for (int t = gw; t < NTOK; t += nw) { const int b = t >> 11; float hv[32];
        norm_row(p.in[I_X] + (size_t)t * DM, p.in[I_GMIX], mod + b * 12288, mod + b * 12288 + 2048, (bf16_t*)(p.ws + WS_H) + (size_t)t * DM, (unsigned char*)(p.ws + WS_HF8) + (size_t)t * DM, lane, hv); }
}

template <int MB, int NB, int KS>
__device__ __forceinline__ void wave_gemm(const bf16_t* A, int lda, const bf16_t* Bt, int ldb, f32x4 (&acc)[MB][NB], int lane) {
    const int fr = lane & 15, fq = lane >> 4;
#pragma unroll
    for (int mb = 0; mb < MB; ++mb)
#pragma unroll
        for (int nb = 0; nb < NB; ++nb) acc[mb][nb] = (f32x4){0.f, 0.f, 0.f, 0.f};
#pragma unroll 1
    for (int ks = 0; ks < KS; ++ks) {
        bf16x8 af[MB];
#pragma unroll
        for (int mb = 0; mb < MB; ++mb) af[mb] = *(const bf16x8*)(A + (size_t)(mb * 16 + fr) * lda + ks * 32 + fq * 8);
#pragma unroll
        for (int nb = 0; nb < NB; ++nb) { const bf16x8 bf = *(const bf16x8*)(Bt + (size_t)(nb * 16 + fr) * ldb + ks * 32 + fq * 8);
#pragma unroll
            for (int mb = 0; mb < MB; ++mb) acc[mb][nb] = __builtin_amdgcn_mfma_f32_16x16x32_bf16(bf, af[mb], acc[mb][nb], 0, 0, 0); }
    }
}


__device__ __forceinline__ int wave_total_i32(int v) {
    v += __builtin_amdgcn_update_dpp(0, v, 0x111, 0xf, 0xf, true); v += __builtin_amdgcn_update_dpp(0, v, 0x112, 0xf, 0xf, true);
    v += __builtin_amdgcn_update_dpp(0, v, 0x114, 0xf, 0xf, true); v += __builtin_amdgcn_update_dpp(0, v, 0x118, 0xf, 0xf, true);
    v += __builtin_amdgcn_update_dpp(0, v, 0x142, 0xa, 0xf, false); v += __builtin_amdgcn_update_dpp(0, v, 0x143, 0xc, 0xf, false);
    return __builtin_amdgcn_readlane(v, 63);
}
template <int NI> __device__ __forceinline__ void topk_words2(const LAS float* srow0, const LAS float* srow1, int c, int lane, unsigned long long& w0, unsigned long long& w1) {
    unsigned ka[NI], kb[NI];
#pragma unroll
    for (int i = 0; i < NI; ++i) { unsigned u = 0u, x = 0u; if (i <= c) { u = __float_as_uint(srow0[i * 64 + lane]); u = (u & 0x80000000u) ? ~u : (u | 0x80000000u);
            x = __float_as_uint(srow1[i * 64 + lane]); x = (x & 0x80000000u) ? ~x : (x | 0x80000000u); } ka[i] = u; kb[i] = x; }
    unsigned va = 0u, vb = 0u; bool da = false, db = false;
#pragma unroll 1
    for (int bit = 31; bit >= 0; --bit) {
        const unsigned ca = va | (1u << bit), cb = vb | (1u << bit); int a0 = 0, a1 = 0, b0 = 0, b1 = 0;
#pragma unroll
        for (int i = 0; i < NI; i += 2) { a0 += (ka[i] >= ca) ? 1 : 0; a1 += (ka[i + 1] >= ca) ? 1 : 0; b0 += (kb[i] >= cb) ? 1 : 0; b1 += (kb[i + 1] >= cb) ? 1 : 0; }
        const int ta = wave_total_i32(a0 + a1), tb = wave_total_i32(b0 + b1);
        if (!da && ta >= 256) { va = ca; da = (ta == 256); }
        if (!db && tb >= 256) { vb = cb; db = (tb == 256); }
        if (da && db) break;
    }
    w0 = 0ull; w1 = 0ull;
#pragma unroll
    for (int i = 0; i < NI; ++i) { const unsigned long long ma = __ballot(ka[i] >= va), mb = __ballot(kb[i] >= vb); if (lane == i) { w0 = ma; w1 = mb; } if ((i & 3) == 3) SBAR(); }
}

__device__ void idx_item(const Params& p, LAS unsigned char* lds, int b, int c, int sub) {
    const int tid = threadIdx.x, wid = tid >> 6, lane = tid & 63, fr = lane & 15, fq = lane >> 4;
    constexpr int SCLD = 2052;
    LAS float* sc = (LAS float*)lds;
    const int q0 = c * 64 + sub * 16, nk = (c + 1) * 64, nkb = nk / 16;
    const bf16_t* qidx = (const bf16_t*)(p.ws + WS_QIDX) + (size_t)(b * SEQ + q0 + fr) * 1024;
    const float* misc = (const float*)(p.ws + WS_MISC);
    float wq[16];
    { const float* wp = misc + (size_t)(b * SEQ + q0 + fr) * 256 + 64;
#pragma unroll
      for (int i = 0; i < 4; ++i) { const f32x4 v = *(const f32x4*)(wp + i * 4); wq[i * 4] = v[0]; wq[i * 4 + 1] = v[1]; wq[i * 4 + 2] = v[2]; wq[i * 4 + 3] = v[3]; } }
    {
        bf16x8 qf[16][2];
#pragma unroll
        for (int h = 0; h < 16; ++h)
#pragma unroll
            for (int ks = 0; ks < 2; ++ks) qf[h][ks] = *(const bf16x8*)(qidx + h * 64 + ks * 32 + fq * 8);
        const bf16_t* kbase = (const bf16_t*)(p.ws + WS_KIDX) + (size_t)(b * SEQ + fr) * 64 + fq * 8;
        bf16x8 kf[2];
        if (wid < nkb) { kf[0] = *(const bf16x8*)(kbase + (size_t)wid * 16 * 64); kf[1] = *(const bf16x8*)(kbase + (size_t)wid * 16 * 64 + 32); }
#pragma unroll 1
        for (int kb = wid; kb < nkb; kb += 8) {
            const int kn = kb + 8 < nkb ? kb + 8 : kb;
            const bf16x8 kn0 = *(const bf16x8*)(kbase + (size_t)kn * 16 * 64), kn1 = *(const bf16x8*)(kbase + (size_t)kn * 16 * 64 + 32);
            f32x4 s = {0.f, 0.f, 0.f, 0.f};
#pragma unroll
            for (int h = 0; h < 16; ++h) {
                f32x4 a = {0.f, 0.f, 0.f, 0.f};
                a = __builtin_amdgcn_mfma_f32_16x16x32_bf16(kf[0], qf[h][0], a, 0, 0, 0);
                a = __builtin_amdgcn_mfma_f32_16x16x32_bf16(kf[1], qf[h][1], a, 0, 0, 0);
#pragma unroll
                for (int j = 0; j < 4; ++j) s[j] += wq[h] * fmaxf(a[j], 0.f);
            }
            *(LAS f32x4*)(sc + fr * SCLD + kb * 16 + fq * 4) = s;
            kf[0] = kn0; kf[1] = kn1;
        }
    }
    __syncthreads();
    unsigned long long* mask = (unsigned long long*)(p.ws + WS_MASK);
    {
        const int ql = wid * 2; const size_t qg = (size_t)b * SEQ + q0 + ql;
        unsigned long long w0 = 0ull, w1 = 0ull;
        if (nk <= 256) { if (lane <= c) { w0 = ~0ull; w1 = ~0ull; } }
        else { const LAS float* s0 = sc + ql * SCLD; const LAS float* s1 = s0 + SCLD;
            if (c < 8) topk_words2<8>(s0, s1, c, lane, w0, w1); else if (c < 16) topk_words2<16>(s0, s1, c, lane, w0, w1);
            else if (c < 24) topk_words2<24>(s0, s1, c, lane, w0, w1); else topk_words2<32>(s0, s1, c, lane, w0, w1); }
        if (lane < 32) { mask[qg * 32 + lane] = w0; mask[(qg + 1) * 32 + lane] = w1; }
    }
    __syncthreads();
}
#ifndef REP_SUB
#define REP_SUB 15
#endif
__device__ void ph3_prep(const Params& p, LAS unsigned char* lds, const int rep) {
#define P3ON(bit) (!rep || ((REP_SUB) & (bit)))
    const int tid = threadIdx.x, wid = tid >> 6, lane = tid & 63, bx = blockIdx.x, G = gridDim.x;
    if (P3ON(1)) for (int it = bx; it < 256; it += G) {
        const int b = it >> 6, r = it & 63, cp = r >> 2, sub = r & 3;
        idx_item(p, lds, b, 31 - cp, sub); idx_item(p, lds, b, cp, sub);
    }
    const int gw = bx * 8 + wid, nw = G * 8;
    if (P3ON(2)) for (int it = gw; it < 2048; it += nw) {
        const int rt = it >> 3, h = it & 7, fr = lane & 15, fq = lane >> 4;
        f32x4 acc[2][16];
        wave_gemm<2, 16, 4>((const bf16_t*)(p.ws + WS_QA) + (size_t)rt * 32 * 1024 + h * 128, 1024, (const bf16_t*)(p.ws + WS_WUK) + (size_t)h * 256 * 128, 128, acc, lane);
#pragma unroll
        for (int mb = 0; mb < 2; ++mb) { float ss = 0.f;
#pragma unroll
            for (int nb = 0; nb < 16; ++nb)
#pragma unroll
                for (int j = 0; j < 4; ++j) ss += acc[mb][nb][j] * acc[mb][nb][j];
            ss += __shfl_xor(ss, 16); ss += __shfl_xor(ss, 32);
            const float rs = rsqrtf(ss * (1.0f / 256.0f) + RMS_EPS) * 0.0625f;
            bf16_t* o = (bf16_t*)(p.ws + WS_QLAT) + (size_t)(rt * 32 + mb * 16 + fr) * 2048 + h * 256;
#pragma unroll
            for (int nb = 0; nb < 16; ++nb) { const int col = nb * 16 + fq * 4; const f32x4 g = *(const f32x4*)(p.in[I_GQA] + col);
                u32x2 w; w.x = cvt_pk_bf16(acc[mb][nb][0] * rs * g[0], acc[mb][nb][1] * rs * g[1]); w.y = cvt_pk_bf16(acc[mb][nb][2] * rs * g[2], acc[mb][nb][3] * rs * g[3]); *(u32x2*)(o + col) = w; } }
    }
    if (P3ON(4))
#pragma unroll 4
    for (int t = gw; t < NTOK; t += nw) {
        { const f32x4 v = *(const f32x4*)((const float*)(p.ws + WS_CKV) + (size_t)t * 256 + lane * 4); float ss = wave_sum(v[0] * v[0] + v[1] * v[1] + v[2] * v[2] + v[3] * v[3]);
          const float rs = rsqrtf(ss * (1.0f / 256.0f) + RMS_EPS); const f32x4 g = *(const f32x4*)(p.in[I_GKV] + lane * 4);
          u32x2 w; w.x = cvt_pk_bf16(v[0] * rs * g[0], v[1] * rs * g[1]); w.y = cvt_pk_bf16(v[2] * rs * g[2], v[3] * rs * g[3]); *(u32x2*)((bf16_t*)(p.ws + WS_KV) + (size_t)t * 256 + lane * 4) = w; }
#pragma unroll
        for (int which = 1; which < 2; ++which) {
            bf16_t* row = (bf16_t*)(p.ws + (which ? WS_KB : WS_QB)) + (size_t)t * 1024 + lane * 16; const float* g = p.in[which ? I_GKB : I_GQB] + (lane & 7) * 16;
            u32x4 a = *(u32x4*)row, c2 = *(u32x4*)(row + 8); float f[16];
            f[0] = bf_lo(a.x); f[1] = bf_hi(a.x); f[2] = bf_lo(a.y); f[3] = bf_hi(a.y); f[4] = bf_lo(a.z); f[5] = bf_hi(a.z); f[6] = bf_lo(a.w); f[7] = bf_hi(a.w);
            f[8] = bf_lo(c2.x); f[9] = bf_hi(c2.x); f[10] = bf_lo(c2.y); f[11] = bf_hi(c2.y); f[12] = bf_lo(c2.z); f[13] = bf_hi(c2.z); f[14] = bf_lo(c2.w); f[15] = bf_hi(c2.w);
            float ss = 0.f;
#pragma unroll
            for (int j = 0; j < 16; ++j) ss += f[j] * f[j];
            ss += __shfl_xor(ss, 1); ss += __shfl_xor(ss, 2); ss += __shfl_xor(ss, 4);
            const float rs = rsqrtf(ss * (1.0f / 128.0f) + RMS_EPS) * (which ? 1.0f : 0.08838834764831845f);
#pragma unroll
            for (int j = 0; j < 16; ++j) f[j] *= rs * g[j];
            a.x = cvt_pk_bf16(f[0], f[1]); a.y = cvt_pk_bf16(f[2], f[3]); a.z = cvt_pk_bf16(f[4], f[5]); a.w = cvt_pk_bf16(f[6], f[7]);
            c2.x = cvt_pk_bf16(f[8], f[9]); c2.y = cvt_pk_bf16(f[10], f[11]); c2.z = cvt_pk_bf16(f[12], f[13]); c2.w = cvt_pk_bf16(f[14], f[15]);
            if (!rep) { *(u32x4*)row = a; *(u32x4*)(row + 8) = c2; } else if (a.x == 0x12345678u) *(u32x4*)row = c2;
        }
    }
    if (P3ON(8) && bx < NBATCH) {
        const int b = bx; const float* fp = (const float*)(p.ws + WS_MISC) + (size_t)(b * SEQ + 4 * tid) * 256 + 80;
        float ls[4][8];
#pragma unroll
        for (int j = 0; j < 4; ++j) { const f32x4 a = *(const f32x4*)(fp + j * 256), c4 = *(const f32x4*)(fp + j * 256 + 4);
#pragma unroll
            for (int h = 0; h < 8; ++h) { const float z = (h < 4 ? a[h & 3] : c4[h & 3]) + p.in[I_BFORGET][h]; ls[j][h] = fminf(z, 0.f) - log1pf(__expf(-fabsf(z))); } }
        LAS float* wt = (LAS float*)lds;
        float off[8];
#pragma unroll
        for (int h = 0; h < 8; ++h) { ls[1][h] += ls[0][h]; ls[2][h] += ls[1][h]; ls[3][h] += ls[2][h];
            float incl = ls[3][h];
#pragma unroll
            for (int o = 1; o < 64; o <<= 1) { const float t2 = __shfl_up(incl, o); if (lane >= o) incl += t2; }
            if (lane == 63) wt[wid * 8 + h] = incl;
            off[h] = incl - ls[3][h]; }
        __syncthreads();
#pragma unroll
        for (int h = 0; h < 8; ++h) { float wo = 0.f; for (int w8 = 0; w8 < wid; ++w8) wo += wt[w8 * 8 + h];
            float* cp = (float*)(p.ws + WS_CUM) + (size_t)(b * 8 + h) * SEQ + 4 * tid;
            *(f32x4*)cp = (f32x4){ls[0][h] + off[h] + wo, ls[1][h] + off[h] + wo, ls[2][h] + off[h] + wo, ls[3][h] + off[h] + wo}; }
        __syncthreads();
    }
}

template <int OFF> __device__ __forceinline__ s16x4 tr_read(int vb) { s16x4 r; asm volatile("ds_read_b64_tr_b16 %0, %1 offset:%2" : "=&v"(r) : "v"(vb), "i"(OFF) : "memory"); return r; }
__device__ __forceinline__ int v_rd_base(int lane) { return ((lane & 3) << 3) | (((lane >> 2) & 3) << 6) | (((lane >> 4) & 1) << 5) | (((lane >> 5) & 1) << 8); }
#define PK4(P, BASE, OUT) do { unsigned a0 = cvt_pk_bf16(P[BASE + 0], P[BASE + 1]), a1 = cvt_pk_bf16(P[BASE + 2], P[BASE + 3]);   \
    unsigned b0 = cvt_pk_bf16(P[BASE + 4], P[BASE + 5]), b1 = cvt_pk_bf16(P[BASE + 6], P[BASE + 7]);                              \
    auto r0 = __builtin_amdgcn_permlane32_swap(a0, b0, false, false); auto r1 = __builtin_amdgcn_permlane32_swap(a1, b1, false, false); \
    u32x4 w = {r0[0], r1[0], r0[1], r1[1]}; OUT = *reinterpret_cast<bf16x8*>(&w); } while (0)
#define PKV(L, H) (bf16x8){L[0], L[1], L[2], L[3], H[0], H[1], H[2], H[3]}
template <int NCB, int KS0, int D0> struct PvPairs { static __device__ __forceinline__ void run(f32x16* o, int vb, bf16x8 pa0, bf16x8 pa1) {
    constexpr int S = 2 * NCB * 512, H = NCB * 512;
    const s16x4 l00 = tr_read<D0 * 512 + KS0 * S>(vb), h00 = tr_read<D0 * 512 + KS0 * S + H>(vb), l01 = tr_read<D0 * 512 + (KS0 + 1) * S>(vb), h01 = tr_read<D0 * 512 + (KS0 + 1) * S + H>(vb);
    const s16x4 l10 = tr_read<(D0 + 1) * 512 + KS0 * S>(vb), h10 = tr_read<(D0 + 1) * 512 + KS0 * S + H>(vb), l11 = tr_read<(D0 + 1) * 512 + (KS0 + 1) * S>(vb), h11 = tr_read<(D0 + 1) * 512 + (KS0 + 1) * S + H>(vb);
    asm volatile("s_waitcnt lgkmcnt(0)" ::: "memory"); SBAR();
    o[D0] = __builtin_amdgcn_mfma_f32_32x32x16_bf16(pa0, PKV(l00, h00), o[D0], 0, 0, 0); o[D0 + 1] = __builtin_amdgcn_mfma_f32_32x32x16_bf16(pa0, PKV(l10, h10), o[D0 + 1], 0, 0, 0);
    o[D0] = __builtin_amdgcn_mfma_f32_32x32x16_bf16(pa1, PKV(l01, h01), o[D0], 0, 0, 0); o[D0 + 1] = __builtin_amdgcn_mfma_f32_32x32x16_bf16(pa1, PKV(l11, h11), o[D0 + 1], 0, 0, 0);
    if constexpr (D0 + 2 < NCB) PvPairs<NCB, KS0, D0 + 2>::run(o, vb, pa0, pa1); } };
__device__ __forceinline__ int swap23(int k) { return (k & ~0xC) | ((k & 4) << 1) | ((k & 8) >> 1); }
constexpr int FOX_STAGE = 33024;
constexpr int FOX_AL = 2 * FOX_STAGE, FOX_LI = FOX_AL + 1024;
__device__ void fox_item(const Params& p, LAS unsigned char* lds, int b, int h, int qb) {
    int tid = threadIdx.x; asm volatile("" : "+v"(tid));
    const int wid = __builtin_amdgcn_readfirstlane(tid >> 6), lane = tid & 63, r32 = lane & 31, hi = lane >> 5;
    const bf16_t* Q = (const bf16_t*)(p.ws + WS_QB);
    const char* Kg = (const char*)(p.ws + WS_KB) + ((size_t)b * SEQ * 1024 + h * 128) * 2; const char* Vg = (const char*)(p.ws + WS_VB) + ((size_t)b * SEQ * 1024 + h * 128) * 2;
    const float* cum = (const float*)(p.ws + WS_CUM) + (size_t)(b * 8 + h) * SEQ;
    const int qpos = qb * 256 + wid * 32 + r32;
    bf16x8 qr[8];
    { const bf16_t* qp = Q + (size_t)(b * SEQ + qpos) * 1024 + h * 128 + hi * 8;
#pragma unroll
      for (int d0 = 0; d0 < 8; ++d0) qr[d0] = *(const bf16x8*)(qp + d0 * 16);
      float ss = 0.f;
#pragma unroll
      for (int d0 = 0; d0 < 8; ++d0) { const u32x4 w = *reinterpret_cast<const u32x4*>(&qr[d0]);
#pragma unroll
          for (int j = 0; j < 4; ++j) { const float a = bf_lo(w[j]), c = bf_hi(w[j]); ss += a * a + c * c; } }
      ss += __shfl_xor(ss, 32);
      const float rs = rsqrtf(ss * (1.0f / 128.0f) + RMS_EPS) * 0.08838834764831845f;
      const float* g = p.in[I_GQB] + hi * 8;
#pragma unroll
      for (int d0 = 0; d0 < 8; ++d0) { u32x4 w = *reinterpret_cast<const u32x4*>(&qr[d0]); const f32x4 g0 = *(const f32x4*)(g + d0 * 16), g1 = *(const f32x4*)(g + d0 * 16 + 4);
          w[0] = cvt_pk_bf16(bf_lo(w[0]) * (rs * g0[0]), bf_hi(w[0]) * (rs * g0[1])); w[1] = cvt_pk_bf16(bf_lo(w[1]) * (rs * g0[2]), bf_hi(w[1]) * (rs * g0[3]));
          w[2] = cvt_pk_bf16(bf_lo(w[2]) * (rs * g1[0]), bf_hi(w[2]) * (rs * g1[1])); w[3] = cvt_pk_bf16(bf_lo(w[3]) * (rs * g1[2]), bf_hi(w[3]) * (rs * g1[3]));
          qr[d0] = *reinterpret_cast<bf16x8*>(&w); } }
    const float cq = cum[qpos] * LOG2E;
    unsigned ksrc[2], vsrc[2];
#pragma unroll
    for (int i = 0; i < 2; ++i) { const int pos = (i * 512 + tid) * 16;
        { const int row = pos >> 8; const int cb = (pos & 255) ^ ((row & 7) << 4); ksrc[i] = (unsigned)(row * 2048 + cb); }
        { const int sub = pos >> 9, within = pos & 511; const int kk = (sub >> 2) * 8 + (within >> 6); const int c = (sub & 3) * 32 + ((within & 63) >> 1); vsrc[i] = (unsigned)(swap23(kk) * 2048 + c * 2); } }
    float m_reg = -1e30f, l_reg = 0.f; f32x16 o[4];
#pragma unroll
    for (int d = 0; d < 4; ++d)
#pragma unroll
        for (int r = 0; r < 16; ++r) o[d][r] = 0.f;
    LAS float* al_l = (LAS float*)(lds + FOX_AL) + wid * 32; LAS float* li_l = (LAS float*)(lds + FOX_LI) + wid * 32;
    const int ntiles = qb * 4 + 4, mylast = qb * 4 + (wid >> 1);
#define FOX_DMA(kt) do { LAS unsigned char* sb_ = lds + ((kt) & 1) * FOX_STAGE; const size_t go_ = (size_t)(kt) * 64 * 2048; \
        _Pragma("unroll") for (int i = 0; i < 2; ++i) { \
            __builtin_amdgcn_global_load_lds((const unsigned*)(Kg + go_ + ksrc[i]), (LAS unsigned*)(sb_ + 16384 + (i * 512 + wid * 64) * 16), 16, 0, 0); \
            __builtin_amdgcn_global_load_lds((const unsigned*)(Vg + go_ + vsrc[i]), (LAS unsigned*)(sb_ + (i * 512 + wid * 64) * 16), 16, 0, 0); } \
        if (wid == 0) __builtin_amdgcn_global_load_lds((const unsigned*)(cum + (kt) * 64 + lane), (LAS unsigned*)(sb_ + 32768), 4, 0, 0); } while (0)
    __syncthreads();
    FOX_DMA(0);
    for (int kt = 0; kt < ntiles; ++kt) {
        asm volatile("s_waitcnt vmcnt(0)" ::: "memory");
        __syncthreads();
        if (kt + 1 < ntiles) FOX_DMA(kt + 1);
        if (kt <= mylast) {
            const LAS unsigned char* sb = lds + (kt & 1) * FOX_STAGE; const LAS float* ck = (const LAS float*)(sb + 32768);
            const int vb = (int)(uintptr_t)sb + v_rd_base(lane);
            f32x16 p0, p1;
#pragma unroll
            for (int r = 0; r < 16; ++r) { p0[r] = 0.f; p1[r] = 0.f; }
            int fsw = (r32 & 7) << 4; asm volatile("" : "+v"(fsw));
#pragma unroll
            for (int d0 = 0; d0 < 8; ++d0) { const int cb = (d0 * 16 + hi * 8) * 2;
                const bf16x8 b0 = *(const LAS bf16x8*)(sb + 16384 + r32 * 256 + (cb ^ fsw));
                const bf16x8 b1 = *(const LAS bf16x8*)(sb + 16384 + (32 + r32) * 256 + (cb ^ fsw));
                p0 = __builtin_amdgcn_mfma_f32_32x32x16_bf16(b0, qr[d0], p0, 0, 0, 0); p1 = __builtin_amdgcn_mfma_f32_32x32x16_bf16(b1, qr[d0], p1, 0, 0, 0); }
            const bool diag = (kt * 64 + 63 > qb * 256 + wid * 32);
            float pmax = -INFINITY;
#pragma unroll
            for (int g4 = 0; g4 < 4; ++g4) { const f32x4 c0 = *(const LAS f32x4*)(ck + 8 * g4 + 4 * hi), c1 = *(const LAS f32x4*)(ck + 32 + 8 * g4 + 4 * hi);
#pragma unroll
                for (int j = 0; j < 4; ++j) { const int r = g4 * 4 + j; float t0 = fmaf(p0[r], LOG2E, cq) - c0[j] * LOG2E, t1 = fmaf(p1[r], LOG2E, cq) - c1[j] * LOG2E;
                    if (diag) { const int kp = kt * 64 + crow(r, hi); if (kp > qpos) t0 = -INFINITY; if (kp + 32 > qpos) t1 = -INFINITY; }
                    p0[r] = t0; p1[r] = t1; pmax = fmaxf(pmax, fmaxf(t0, t1)); } }
            { auto rr = __builtin_amdgcn_permlane32_swap(__float_as_uint(pmax), __float_as_uint(pmax), false, false); pmax = fmaxf(__uint_as_float(rr[0]), __uint_as_float(rr[1])); }
            const float mn = fmaxf(m_reg, pmax); const float alpha = __builtin_amdgcn_exp2f(m_reg - mn); m_reg = mn;
            float ps = 0.f;
#pragma unroll
            for (int r = 0; r < 16; ++r) { p0[r] = __builtin_amdgcn_exp2f(p0[r] - mn); p1[r] = __builtin_amdgcn_exp2f(p1[r] - mn); ps += p0[r] + p1[r]; }
            { auto rr = __builtin_amdgcn_permlane32_swap(__float_as_uint(ps), __float_as_uint(ps), false, false); ps = __uint_as_float(rr[0]) + __uint_as_float(rr[1]); }
            l_reg = l_reg * alpha + ps;
            if (__any(alpha < 1.f)) { if (hi == 0) al_l[r32] = alpha; asm volatile("s_waitcnt lgkmcnt(0)" ::: "memory");
#pragma unroll
                for (int r = 0; r < 16; ++r) { const float a = al_l[crow(r, hi)];
#pragma unroll
                    for (int d = 0; d < 4; ++d) o[d][r] *= a; } }
            bf16x8 pa0, pa1, pa2, pa3; PK4(p0, 0, pa0); PK4(p0, 8, pa1); PK4(p1, 0, pa2); PK4(p1, 8, pa3);
            PvPairs<4, 0, 0>::run(o, vb, pa0, pa1); PvPairs<4, 2, 0>::run(o, vb, pa2, pa3);
        }
    }
#undef FOX_DMA
    if (hi == 0) li_l[r32] = l_reg; asm volatile("s_waitcnt lgkmcnt(0)" ::: "memory");
    unsigned char* O8 = (unsigned char*)(p.ws + WS_OB8) + (size_t)(b * SEQ + qb * 256 + wid * 32) * 1024 + h * 128;
#pragma unroll
    for (int r = 0; r < 16; ++r) { const float rl = __builtin_amdgcn_rcpf(li_l[crow(r, hi)]); const int orow = crow(r, hi);
#pragma unroll
        for (int d0 = 0; d0 < 4; ++d0) O8[(size_t)orow * 1024 + d0 * 32 + r32] = (unsigned char)(pack_fp8x4(o[d0][r] * rl * 8.f, 0.f, 0.f, 0.f) & 0xffu); }
}

constexpr int DSA_STAGE = 32768;
constexpr int DSA_AL = 2 * DSA_STAGE, DSA_LI = DSA_AL + 1024, DSA_Q = DSA_LI + 1024;
__device__ void dsa_item(const Params& p, LAS unsigned char* lds, int b, int qt) {
    int tid = threadIdx.x; asm volatile("" : "+v"(tid));
    const int wid = __builtin_amdgcn_readfirstlane(tid >> 6), lane = tid & 63, r32 = lane & 31, hi = lane >> 5, h = wid;
    const char* KV = (const char*)(p.ws + WS_KV) + (size_t)b * SEQ * 512;
    const int qpos = qt * 32 + r32; const size_t qg = (size_t)b * SEQ + qpos;
    const unsigned* mask = (const unsigned*)(p.ws + WS_MASK) + qg * 64;
    bf16x8 qr[8];
    LAS unsigned char* qlds = lds + DSA_Q + wid * 8192 + lane * 16;
    __syncthreads();
    { const bf16_t* qp = (const bf16_t*)(p.ws + WS_QLAT) + qg * 2048 + h * 256 + hi * 8;
#pragma unroll
      for (int d0 = 0; d0 < 8; ++d0) qr[d0] = *(const bf16x8*)(qp + d0 * 16);
#pragma unroll
      for (int d0 = 8; d0 < 16; ++d0) *(LAS bf16x8*)(qlds + (d0 - 8) * 1024) = *(const bf16x8*)(qp + d0 * 16); }
    unsigned ksrc[2], vsrc[2];
#pragma unroll
    for (int i = 0; i < 2; ++i) { const int pos = (i * 512 + tid) * 16;
        { const int row = pos >> 9; const int cb = (pos & 511) ^ ((row & 15) << 4); ksrc[i] = (unsigned)(row * 512 + cb); }
        { const int sub = pos >> 9, within = pos & 511; const int kk = (sub >> 3) * 8 + (within >> 6); const int c = (sub & 7) * 32 + ((within & 63) >> 1); vsrc[i] = (unsigned)(swap23(kk) * 512 + c * 2); } }
    const float slopeL = exp2f(-(float)(h + 1)) * LOG2E;
    float m_reg = -1e30f, l_reg = 0.f; f32x16 o[8];
#pragma unroll
    for (int d = 0; d < 8; ++d)
#pragma unroll
        for (int r = 0; r < 16; ++r) o[d][r] = 0.f;
    LAS float* al_l = (LAS float*)(lds + DSA_AL) + wid * 32; LAS float* li_l = (LAS float*)(lds + DSA_LI) + wid * 32;
    const int ntiles = ((qt >> 1) + 1) * 2;
#define DSA_DMA(kt) do { LAS unsigned char* sb_ = lds + ((kt) & 1) * DSA_STAGE; const size_t go_ = (size_t)(kt) * 32 * 512; \
        _Pragma("unroll") for (int i = 0; i < 2; ++i) { \
            __builtin_amdgcn_global_load_lds((const unsigned*)(KV + go_ + ksrc[i]), (LAS unsigned*)(sb_ + 16384 + (i * 512 + wid * 64) * 16), 16, 0, 0); \
            __builtin_amdgcn_global_load_lds((const unsigned*)(KV + go_ + vsrc[i]), (LAS unsigned*)(sb_ + (i * 512 + wid * 64) * 16), 16, 0, 0); } } while (0)
    unsigned mw = mask[0];
    DSA_DMA(0);
    for (int kt = 0; kt < ntiles; ++kt) {
        asm volatile("s_waitcnt vmcnt(0)" ::: "memory");
        __syncthreads();
        const unsigned mcur = mw;
        if (kt + 1 < ntiles) { mw = mask[kt + 1]; DSA_DMA(kt + 1); }
        const LAS unsigned char* sb = lds + (kt & 1) * DSA_STAGE; const int vb = (int)(uintptr_t)sb + v_rd_base(lane);
        f32x16 pp;
#pragma unroll
        for (int r = 0; r < 16; ++r) pp[r] = 0.f;
        {
            const LAS unsigned char* kb_ = sb + 16384 + r32 * 512; int sw_ = (r32 & 15) << 4; asm volatile("" : "+v"(sw_));
#define DSA_KF(d0) (*(const LAS bf16x8*)(kb_ + ((((d0) * 16 + hi * 8) * 2) ^ sw_)))
#define DSA_QF(d0) ((d0) < 8 ? qr[(d0) & 7] : *(const LAS bf16x8*)(qlds + (((d0) - 8) & 7) * 1024))
            bf16x8 k0 = DSA_KF(0), k1 = DSA_KF(1), q0 = DSA_QF(0), q1 = DSA_QF(1);
#pragma unroll
            for (int d0 = 0; d0 < 16; d0 += 2) {
                bf16x8 nk0 = k0, nk1 = k1, nq0 = q0, nq1 = q1;
                if (d0 + 2 < 16) { nk0 = DSA_KF(d0 + 2); nk1 = DSA_KF(d0 + 3); nq0 = DSA_QF(d0 + 2); nq1 = DSA_QF(d0 + 3); }
                pp = __builtin_amdgcn_mfma_f32_32x32x16_bf16(k0, q0, pp, 0, 0, 0); pp = __builtin_amdgcn_mfma_f32_32x32x16_bf16(k1, q1, pp, 0, 0, 0);
                k0 = nk0; k1 = nk1; q0 = nq0; q1 = nq1; SBAR();
            }
#undef DSA_KF
#undef DSA_QF
        }
        const unsigned wsh = mcur >> (4 * hi);
        const float df = (float)(qpos - (kt * 32 + 4 * hi));
        float pmax = -INFINITY;
#pragma unroll
        for (int r = 0; r < 16; ++r) { const int cb = (r & 3) + 8 * (r >> 2); const float dd = df - (float)cb;
            float t = fmaf(-slopeL, fabsf(dd), pp[r] * LOG2E); if (!((wsh >> cb) & 1u)) t = -INFINITY; pp[r] = t; pmax = fmaxf(pmax, t); }
        { auto rr = __builtin_amdgcn_permlane32_swap(__float_as_uint(pmax), __float_as_uint(pmax), false, false); pmax = fmaxf(__uint_as_float(rr[0]), __uint_as_float(rr[1])); }
        const float mn = fmaxf(m_reg, pmax); const float alpha = __builtin_amdgcn_exp2f(m_reg - mn); m_reg = mn;
        float ps = 0.f;
#pragma unroll
        for (int r = 0; r < 16; ++r) { pp[r] = __builtin_amdgcn_exp2f(pp[r] - mn); ps += pp[r]; }
        { auto rr = __builtin_amdgcn_permlane32_swap(__float_as_uint(ps), __float_as_uint(ps), false, false); ps = __uint_as_float(rr[0]) + __uint_as_float(rr[1]); }
        l_reg = l_reg * alpha + ps;
        if (__any(alpha < 1.f)) { if (hi == 0) al_l[r32] = alpha; asm volatile("s_waitcnt lgkmcnt(0)" ::: "memory");
#pragma unroll
            for (int r = 0; r < 16; ++r) { const float a = al_l[crow(r, hi)];
#pragma unroll
                for (int d = 0; d < 8; ++d) o[d][r] *= a; } }
        bf16x8 pa0, pa1; PK4(pp, 0, pa0); PK4(pp, 8, pa1);
        PvPairs<8, 0, 0>::run(o, vb, pa0, pa1);
    }
#undef DSA_DMA
    if (hi == 0) li_l[r32] = l_reg; asm volatile("s_waitcnt lgkmcnt(0)" ::: "memory");
    float rl[16];
#pragma unroll
    for (int r = 0; r < 16; ++r) rl[r] = __builtin_amdgcn_rcpf(li_l[crow(r, hi)]);
    __syncthreads();
    LAS bf16_t* os = (LAS bf16_t*)(lds + wid * 16896);
#pragma unroll
    for (int r = 0; r < 16; ++r)
#pragma unroll
        for (int d0 = 0; d0 < 8; ++d0) os[crow(r, hi) * 264 + d0 * 32 + r32] = (bf16_t)(cvt_pk_bf16(o[d0][r] * rl[r], 0.f) & 0xffffu);
    asm volatile("s_waitcnt lgkmcnt(0)" ::: "memory");
    f32x16 ya[4];
#pragma unroll
    for (int nb = 0; nb < 4; ++nb)
#pragma unroll
        for (int r = 0; r < 16; ++r) ya[nb][r] = 0.f;
    const bf16_t* wv = (const bf16_t*)(p.ws + WS_WUV) + (size_t)(h * 128 + r32) * 256 + hi * 8;
#pragma unroll 4
    for (int ks = 0; ks < 16; ++ks) {
        const bf16x8 af = *(const LAS bf16x8*)(os + r32 * 264 + ks * 16 + hi * 8);
#pragma unroll
        for (int nb = 0; nb < 4; ++nb) { const bf16x8 wf = *(const bf16x8*)(wv + (size_t)nb * 32 * 256 + ks * 16); ya[nb] = __builtin_amdgcn_mfma_f32_32x32x16_bf16(wf, af, ya[nb], 0, 0, 0); }
    }
    unsigned char* O8 = (unsigned char*)(p.ws + WS_OA8) + ((size_t)b * SEQ + qt * 32 + r32) * 1024 + h * 128 + 4 * hi;
#pragma unroll
    for (int nb = 0; nb < 4; ++nb)
#pragma unroll
        for (int g4 = 0; g4 < 4; ++g4) *(unsigned*)(O8 + nb * 32 + g4 * 8) = pack_fp8x4(ya[nb][g4 * 4] * 8.f, ya[nb][g4 * 4 + 1] * 8.f, ya[nb][g4 * 4 + 2] * 8.f, ya[nb][g4 * 4 + 3] * 8.f);
}
__device__ void ph4_attn(const Params& p, LAS unsigned char* lds) {
    const int r = blockIdx.x;
    if (r < 256) { const int c = 31 - (r >> 3), w8 = r & 7, b = w8 >> 1, half = w8 & 1; dsa_item(p, lds, b, c * 2 + half); }
    int* qhead = (int*)(p.ws + WS_CNT) + 512;
    LAS int* slot = (LAS int*)(lds + LDS_BARW - 16);
    for (;;) {
        __syncthreads();
        if (threadIdx.x == 0) *slot = atomicAdd(qhead, 1);
        __syncthreads();
        const int it = __builtin_amdgcn_readfirstlane(*slot);
        if (it >= 256) break;
        const int qb = 7 - (it >> 5), bh = it & 31;
        fox_item(p, lds, bh >> 3, bh & 7, qb);
    }
}

__device__ void ph8_router(const Params& p, LAS unsigned char* lds, const int rep) {
    const int tid = threadIdx.x, wid = tid >> 6, lane = tid & 63, fr = lane & 15, fq = lane >> 4;
    const float* mod = (const float*)(p.ws + WS_MOD);
    int* cnt = (int*)(p.ws + WS_CNT) + rep * 256; int* ltok = rep ? (int*)(p.ws + WS_QLAT) : (int*)(p.ws + WS_LTOK); float* lw = rep ? (float*)(p.ws + WS_QLAT + (4u << 20)) : (float*)(p.ws + WS_LW);
    LAS unsigned char* AH = lds; LAS unsigned char* AL = lds + 65536;
    LAS float* slab = (LAS float*)lds;
    LAS float* lg = (LAS float*)(lds + 131072);
    const bf16_t* WH = (const bf16_t*)(p.ws + WS_WRH); const bf16_t* WL = (const bf16_t*)(p.ws + WS_WRL);
    for (int blk = blockIdx.x; blk < NTOK / 32; blk += gridDim.x) {
        const int t0 = blk * 32, tb = t0 + wid * 4, b = tb >> 11;
        const float* sh = mod + b * 12288 + 6144; const float* sc = mod + b * 12288 + 8192;
        u32x2 keepH[4][4], keepL[4][4];
        f32x4 xa[2][8], xb[2][8]; u32x2 ya[2][8], yb[2][8];
#define RT_LOAD(X, Y, R0) _Pragma("unroll") for (int rr = 0; rr < 2; ++rr) _Pragma("unroll") for (int i = 0; i < 8; ++i) { const size_t eo = (size_t)(tb + R0 + rr) * DM + i * 256 + lane * 4; \
            Y[rr][i] = *(const u32x2*)((const bf16_t*)(p.ws + WS_MERGED) + eo); X[rr][i] = *(const f32x4*)(p.in[I_X] + eo); }
        RT_LOAD(xa, ya, 0) RT_LOAD(xb, yb, 2)
#define RT_ROWS(X, Y, R0) do { float rstd[2]; \
        _Pragma("unroll") for (int rr = 0; rr < 2; ++rr) { float ss = 0.f; \
            _Pragma("unroll") for (int i = 0; i < 8; ++i) { X[rr][i] += (f32x4){bf_lo(Y[rr][i].x), bf_hi(Y[rr][i].x), bf_lo(Y[rr][i].y), bf_hi(Y[rr][i].y)};        \
                ss += X[rr][i][0] * X[rr][i][0] + X[rr][i][1] * X[rr][i][1] + X[rr][i][2] * X[rr][i][2] + X[rr][i][3] * X[rr][i][3]; } \
            rstd[rr] = rsqrtf(wave_sum(ss) * (1.0f / 2048.0f) + RMS_EPS); } \
        _Pragma("unroll") for (int i = 0; i < 8; ++i) { int cl = lane * 4; asm volatile("" : "+v"(cl)); const int col = i * 256 + cl; const f32x4 gg = *(const f32x4*)(p.in[I_GFFN] + col), s1 = *(const f32x4*)(sc + col), s0 = *(const f32x4*)(sh + col); \
            _Pragma("unroll") for (int rr = 0; rr < 2; ++rr) { float hv[4], lo[4]; const int r = wid * 4 + R0 + rr; \
                _Pragma("unroll") for (int j = 0; j < 4; ++j) hv[j] = X[rr][i][j] * rstd[rr] * gg[j] * (1.0f + s1[j]) + s0[j]; \
                u32x2 wh; wh.x = cvt_pk_bf16(hv[0], hv[1]); wh.y = cvt_pk_bf16(hv[2], hv[3]); \
                lo[0] = hv[0] - bf_lo(wh.x); lo[1] = hv[1] - bf_hi(wh.x); lo[2] = hv[2] - bf_lo(wh.y); lo[3] = hv[3] - bf_hi(wh.y); \
                u32x2 wl; wl.x = cvt_pk_bf16(lo[0], lo[1]); wl.y = cvt_pk_bf16(lo[2], lo[3]); \
                if (i < 4) { int l1 = lane >> 1; asm volatile("" : "+v"(l1)); const int ad = r * 2048 + (((i * 32 + l1) ^ r) * 16) + (lane & 1) * 8; *(LAS u32x2*)(AH + ad) = wh; *(LAS u32x2*)(AL + ad) = wl; } \
                else { keepH[R0 + rr][i - 4] = wh; keepL[R0 + rr][i - 4] = wl; } \
                *(unsigned*)(p.ws + WS_H8 + (size_t)(tb + R0 + rr) * DM + col) = pack_fp8x4(hv[0], hv[1], hv[2], hv[3]); } } } while (0)
        RT_ROWS(xa, ya, 0); RT_ROWS(xb, yb, 2);
#undef RT_LOAD
#undef RT_ROWS
        const int kq = wid & 3, ng = wid >> 2, nb0 = ng * 3;
        f32x4 acc[2][3];
#pragma unroll
        for (int rb = 0; rb < 2; ++rb)
#pragma unroll
            for (int j = 0; j < 3; ++j) acc[rb][j] = (f32x4){0.f, 0.f, 0.f, 0.f};
#pragma unroll
        for (int kh = 0; kh < 2; ++kh) {
            if (kh == 1) {
#pragma unroll
                for (int r4 = 0; r4 < 4; ++r4)
#pragma unroll
                    for (int i = 0; i < 4; ++i) { const int r = wid * 4 + r4; int l1 = lane >> 1; asm volatile("" : "+v"(l1)); const int ad = r * 2048 + (((i * 32 + l1) ^ r) * 16) + (lane & 1) * 8;
                        *(LAS u32x2*)(AH + ad) = keepH[r4][i]; *(LAS u32x2*)(AL + ad) = keepL[r4][i]; }
            }
            __syncthreads();
#pragma unroll 2
            for (int k8 = 0; k8 < 8; ++k8) { const int ksl = kq * 8 + k8, ks = kh * 32 + ksl;
                bf16x8 ah[2], al[2];
#pragma unroll
                for (int rb = 0; rb < 2; ++rb) { const int r = rb * 16 + fr; const int ad = r * 2048 + (((ksl * 4 + fq) ^ r) * 16); ah[rb] = *(const LAS bf16x8*)(AH + ad); al[rb] = *(const LAS bf16x8*)(AL + ad); }
#pragma unroll
                for (int j = 0; j < 3; ++j) { const int nb = nb0 + j; if (nb < 5) {
                    const bf16x8 wh = *(const bf16x8*)(WH + (size_t)(nb * 16 + fr) * DM + ks * 32 + fq * 8), wl = *(const bf16x8*)(WL + (size_t)(nb * 16 + fr) * DM + ks * 32 + fq * 8);
#pragma unroll
                    for (int rb = 0; rb < 2; ++rb) {
                        acc[rb][j] = __builtin_amdgcn_mfma_f32_16x16x32_bf16(wh, ah[rb], acc[rb][j], 0, 0, 0); acc[rb][j] = __builtin_amdgcn_mfma_f32_16x16x32_bf16(wl, ah[rb], acc[rb][j], 0, 0, 0);
                        acc[rb][j] = __builtin_amdgcn_mfma_f32_16x16x32_bf16(wh, al[rb], acc[rb][j], 0, 0, 0); } } } }
            __syncthreads();
        }
#pragma unroll
        for (int rb = 0; rb < 2; ++rb)
#pragma unroll
            for (int j = 0; j < 3; ++j) { const int nb = nb0 + j; if (nb < 5) *(LAS f32x4*)(slab + (kq * 32 + rb * 16 + fr) * 80 + nb * 16 + fq * 4) = acc[rb][j]; }
        __syncthreads();
        for (int o = tid; o < 2560; o += NTHREADS) lg[o] = (slab[o] + slab[2560 + o]) + (slab[5120 + o] + slab[7680 + o]);
        __syncthreads();
        if (tid < 32) {
            const int t = t0 + tid; const LAS float* L = lg + tid * 80;
            float gl[8]; int gi = 0; float gm = -INFINITY;
#pragma unroll
            for (int g = 0; g < 8; ++g) { gl[g] = L[g] + p.in[I_BRG][g]; if (gl[g] > gm) { gm = gl[g]; gi = g; } }
            float se = 0.f;
#pragma unroll
            for (int g = 0; g < 8; ++g) se += __expf(gl[g] - gm);
            const float gwt = 1.0f / se;
            float v1 = -INFINITY, v2 = -INFINITY; int i1 = 0, i2 = 0;
            for (int e = 0; e < 8; ++e) { const float v = L[8 + gi * 8 + e] + p.in[I_BRE][gi * 8 + e];
                if (v > v1) { v2 = v1; i2 = i1; v1 = v; i1 = e; } else if (v > v2) { v2 = v; i2 = e; } }
            const float e2 = __expf(v2 - v1); const float p1 = gwt / (1.0f + e2), p2 = gwt * e2 / (1.0f + e2);
            const int ea = gi * 8 + i1, eb = gi * 8 + i2;
            const int pa = atomicAdd(cnt + ea, 1); const int pb = atomicAdd(cnt + eb, 1);
            ltok[ea * LCAP + pa] = t; lw[ea * LCAP + pa] = p1;
            ltok[eb * LCAP + pb] = t | 0x10000; lw[eb * LCAP + pb] = p2;
        }
        __syncthreads();
    }
}

#define MOE_GLOAD(dst, ptr) asm volatile("global_load_dwordx4 %0, %1, off nt" : "=v"(dst) : "v"(ptr) : "memory")
template <bool UP>
__device__ void moe_gemm(const Params& p, LAS unsigned char* lds, const int rep) {
    constexpr int K = UP ? 2048 : 512, NKT = K / 32, NS = UP ? 8 : 16, LDW = UP ? 512 : 2048;
    constexpr int NSTA = 3, OFF_A = 0, OFF_B = NSTA * 16384;
    int tid = threadIdx.x; asm volatile("" : "+v"(tid));
    const int w = __builtin_amdgcn_readfirstlane(tid >> 6), l = tid & 63, r32 = l & 31, hi = l >> 5;
    LAS int* tab = (LAS int*)(lds + LDS_TAB);
    if (tid == 0) { const int* cnt = (const int*)(p.ws + WS_CNT); int s = 0, ro = 0; for (int e = 0; e < 64; ++e) { const int ce = cnt[e]; tab[e] = s; tab[80 + e] = ce; tab[160 + e] = ro; ro += ce; const int np = (ce + 511) >> 9; s += np > 0 ? np : 1; } tab[64] = s; }
    __syncthreads();
    const int total = __builtin_amdgcn_readfirstlane(tab[64]) * NS;
    const int q = (w & 3) * 8 + (l & 7), g = (w >> 2) * 8 + (l >> 3);
    const unsigned bwoff = (unsigned)(q * 256 + (((g >> 2) ^ (q & 3)) * 16) + (g & 3) * 4);
    const unsigned frag_sw = (unsigned)((r32 >> 2) & 3);
    const int* ltok = (const int*)(p.ws + WS_LTOK); const float* lw = (const float*)(p.ws + WS_LW);
    for (int unit = blockIdx.x; unit < total; unit += gridDim.x) {
        const int pm = unit / NS, ns = unit - pm * NS; int e = 0;
#pragma unroll 1
        for (int s = 32; s >= 1; s >>= 1) if (__builtin_amdgcn_readfirstlane(tab[e + s]) <= pm) e += s;
        const int mp = pm - __builtin_amdgcn_readfirstlane(tab[e]); const int cnt_e = __builtin_amdgcn_readfirstlane(tab[80 + e]), rowoff = __builtin_amdgcn_readfirstlane(tab[160 + e]);
        int nrows = cnt_e - mp * 512; nrows = nrows > 512 ? 512 : nrows; const bool two = nrows > 256;
        const char* abase = UP ? (const char*)(p.ws + WS_H8) : (const char*)(p.ws + WS_ACT8);
        unsigned aoff[2];
#pragma unroll
        for (int i = 0; i < 2; ++i) { const int row = (i * 8 + w) * 32 + (l >> 1); const int hs = (l & 1) ^ ((l >> 4) & 1);
            int src; if (UP) src = row < nrows ? (ltok[e * LCAP + mp * 512 + row] & 0xffff) : 0; else src = rowoff + mp * 512 + (row < nrows ? row : 0);
            aoff[i] = (unsigned)(src * K + hs * 16); }
        const float* bsrc = UP ? (q < 16 ? p.in[I_W1] : p.in[I_W3]) + (size_t)e * 2048 * 512 + ns * 64 + (q & 15) * 4 + (size_t)(2 * g) * LDW
                               : p.in[I_W2] + (size_t)e * 512 * 2048 + ns * 128 + q * 4 + (size_t)(2 * g) * LDW;
        f32x16 acc[2][4];
#pragma unroll
        for (int a = 0; a < 2; ++a)
#pragma unroll
            for (int b = 0; b < 4; ++b)
#pragma unroll
                for (int r = 0; r < 16; ++r) acc[a][b][r] = 0.f;
        f32x4 br[2][2];
#define MOE_ISSUE_B(j, t) do { const int tt_ = (t) < NKT ? (t) : NKT - 1; const float* bp_ = bsrc + (size_t)tt_ * 32 * LDW; MOE_GLOAD(br[j][0], bp_); MOE_GLOAD(br[j][1], bp_ + LDW); } while (0)
#define MOE_ISSUE_A(t, TWO) do { int tt_ = (t) < 0 ? 0 : (t); const int bi_ = (tt_ % NSTA); tt_ = tt_ < NKT ? tt_ : NKT - 1; const char* ap_ = abase + (size_t)tt_ * 32; \
        LAS unsigned char* ab_ = lds + OFF_A + bi_ * 16384 + w * 1024; \
        __builtin_amdgcn_global_load_lds((const unsigned*)(ap_ + aoff[0]), (LAS unsigned*)(ab_), 16, 0, 0); \
        if (TWO) __builtin_amdgcn_global_load_lds((const unsigned*)(ap_ + aoff[1]), (LAS unsigned*)(ab_ + 8192), 16, 0, 0); } while (0)
        const bool two_w = (256 + 32 * w) < nrows;
#define MOE_FRAGS(ks, TWO) do { const unsigned co_ = ((unsigned)((ks) * 2 + hi) ^ frag_sw) * 16u; \
            _Pragma("unroll") for (int nb = 0; nb < 4; ++nb) bf_[nb] = *(const LAS bf16x8*)(bb_ + nb * 2048 + co_); \
            { const unsigned ao_ = ((unsigned)(ks) ^ ((unsigned)(r32 >> 3) & 1u)) * 16u + (unsigned)hi * 8u; a0_ = fp8x8_to_bf16(*(const LAS u32x2*)(ab_ + ao_)); if (TWO) a1_ = fp8x8_to_bf16(*(const LAS u32x2*)(ab_ + 8192 + ao_)); } } while (0)
#define MOE_MMAS(TWO) do { \
            _Pragma("unroll") for (int nb = 0; nb < 4; ++nb) acc[0][nb] = __builtin_amdgcn_mfma_f32_32x32x16_bf16(bf_[nb], a0_, acc[0][nb], 0, 0, 0); \
            if (TWO) { _Pragma("unroll") for (int nb = 0; nb < 4; ++nb) acc[1][nb] = __builtin_amdgcn_mfma_f32_32x32x16_bf16(bf_[nb], a1_, acc[1][nb], 0, 0, 0); } } while (0)
#define MOE_ITER(jn, t, COMPUTE, TWO, WB, WA) do { \
        bf16x8 bf_[4], a0_, a1_; \
        const LAS unsigned char* ab_ = lds + OFF_A + (((t) + 3) % 3) * 16384 + w * 1024 + r32 * 32; const LAS unsigned char* bb_ = lds + OFF_B + ((t) & 1) * 8192 + r32 * 64; \
        if (COMPUTE) { MOE_FRAGS(0, TWO); } SBAR(); \
        asm volatile("s_waitcnt vmcnt(" WB ")" : "+v"(br[jn][0]), "+v"(br[jn][1]) :: "memory"); \
        { LAS unsigned char* bw_ = lds + OFF_B + (((t) + 1) & 1) * 8192 + bwoff; _Pragma("unroll") for (int jj = 0; jj < 4; ++jj) *(LAS unsigned*)(bw_ + jj * 64) = cvt_pk_bf16(br[jn][0][jj], br[jn][1][jj]); } \
        MOE_ISSUE_B(jn, (t) + 3); SBAR(); \
        if (COMPUTE) { MOE_MMAS(TWO); SBAR(); MOE_FRAGS(1, TWO); MOE_MMAS(TWO); } SBAR(); \
        asm volatile("s_waitcnt vmcnt(" WA ")" ::: "memory"); \
        asm volatile("s_waitcnt lgkmcnt(0)" ::: "memory"); __builtin_amdgcn_s_barrier(); asm volatile("" ::: "memory"); \
        MOE_ISSUE_A((t) + 3, TWO); \
        } while (0)
#define MOE_PIPE(TWO, WB, WA) do { \
        MOE_ISSUE_B(0, 0); MOE_ISSUE_A(0, TWO); MOE_ISSUE_B(1, 1); MOE_ISSUE_A(1, TWO); \
        MOE_ITER(0, -1, false, TWO, WB, WA); \
        _Pragma("unroll 1") for (int t = 0; t < NKT; t += 2) { MOE_ITER(1, t, true, TWO, WB, WA); MOE_ITER(0, t + 1, true, TWO, WB, WA); } \
          \
        asm volatile("s_waitcnt vmcnt(0)" : "+v"(br[0][0]), "+v"(br[0][1]), "+v"(br[1][0]), "+v"(br[1][1]) :: "memory"); \
        } while (0)
        if (two_w) MOE_PIPE(true, "6", "6"); else MOE_PIPE(false, "4", "5");
        asm volatile("s_waitcnt vmcnt(0)" ::: "memory");
        if constexpr (UP) {
#pragma unroll
            for (int mt = 0; mt < 2; ++mt) {
                const int rl = mt * 256 + 32 * w + r32;
                if (rl < nrows) {
                    const float gw = lw[e * LCAP + mp * 512 + rl] * 16.0f; unsigned char* orow = (unsigned char*)(p.ws + (rep ? WS_QLAT : WS_ACT8)) + (size_t)(rowoff + mp * 512 + rl) * 512 + ns * 64 + 4 * hi;
#pragma unroll
                    for (int nb = 0; nb < 2; ++nb)
#pragma unroll
                        for (int g4 = 0; g4 < 4; ++g4) { float o[4];
#pragma unroll
                            for (int j = 0; j < 4; ++j) { const float a = acc[mt][nb][g4 * 4 + j], u = acc[mt][nb + 2][g4 * 4 + j]; o[j] = a * sigmoidf_(a) * u * gw; }
                            *(unsigned*)(orow + nb * 32 + g4 * 8) = pack_fp8x4(o[0], o[1], o[2], o[3]); }
                }
            }
        } else {
#pragma unroll
            for (int mt = 0; mt < 2; ++mt) {
                const int rl = mt * 256 + 32 * w + r32;
                if (rl < nrows) {
                    const int ent = ltok[e * LCAP + mp * 512 + rl]; unsigned char* orow = (unsigned char*)(p.ws + WS_YS) + ((size_t)(ent >> 16) * NTOK + (ent & 0xffff)) * 2048 + ns * 128 + 4 * hi;
#pragma unroll
                    for (int nb = 0; nb < 4; ++nb)
#pragma unroll
                        for (int g4 = 0; g4 < 4; ++g4) *(unsigned*)(orow + nb * 32 + g4 * 8) = pack_fp8x4(acc[mt][nb][g4 * 4], acc[mt][nb][g4 * 4 + 1], acc[mt][nb][g4 * 4 + 2], acc[mt][nb][g4 * 4 + 3]);
                }
            }
        }
        asm volatile("s_waitcnt vmcnt(0)" ::: "memory");
        __syncthreads();
    }
#undef MOE_ISSUE_A
#undef MOE_ISSUE_B
#undef MOE_ITER
#undef MOE_FRAGS
#undef MOE_MMAS
#undef MOE_PIPE
}


__device__ void ph11_combine(const Params& p) {
    const unsigned char* Y0 = (const unsigned char*)(p.ws + WS_YS); const unsigned char* Y1 = Y0 + (size_t)NTOK * 2048; const bf16_t* YM = (const bf16_t*)(p.ws + WS_MERGED); const float* mod = (const float*)(p.ws + WS_MOD);
    const size_t n8 = (size_t)NTOK * 2048 / 8;
    for (size_t i = (size_t)blockIdx.x * NTHREADS + threadIdx.x; i < n8; i += (size_t)gridDim.x * NTHREADS) {
        const size_t e0 = i * 8; const int col = (int)(e0 & 2047), b = (int)(e0 >> 22);
        const u32x2 a = *(const u32x2*)(Y0 + e0), c = *(const u32x2*)(Y1 + e0); const u32x4 m = *(const u32x4*)(YM + e0);
        const f32x2 a0 = __builtin_amdgcn_cvt_pk_f32_fp8((int)a.x, false), a1 = __builtin_amdgcn_cvt_pk_f32_fp8((int)a.x, true), a2 = __builtin_amdgcn_cvt_pk_f32_fp8((int)a.y, false), a3 = __builtin_amdgcn_cvt_pk_f32_fp8((int)a.y, true);
        const f32x2 c0 = __builtin_amdgcn_cvt_pk_f32_fp8((int)c.x, false), c1 = __builtin_amdgcn_cvt_pk_f32_fp8((int)c.x, true), c2 = __builtin_amdgcn_cvt_pk_f32_fp8((int)c.y, false), c3 = __builtin_amdgcn_cvt_pk_f32_fp8((int)c.y, true);
        const float* gt = mod + (size_t)b * 12288 + 10240 + col; const f32x4 g0 = *(const f32x4*)gt * 0.0625f, g1 = *(const f32x4*)(gt + 4) * 0.0625f;
        const float* px = p.in[I_X] + e0; f32x4 o0 = *(const f32x4*)px, o1 = *(const f32x4*)(px + 4);
        o0[0] += bf_lo(m.x) + g0[0] * (a0.x + c0.x); o0[1] += bf_hi(m.x) + g0[1] * (a0.y + c0.y); o0[2] += bf_lo(m.y) + g0[2] * (a1.x + c1.x); o0[3] += bf_hi(m.y) + g0[3] * (a1.y + c1.y);
        o1[0] += bf_lo(m.z) + g1[0] * (a2.x + c2.x); o1[1] += bf_hi(m.z) + g1[1] * (a2.y + c2.y); o1[2] += bf_lo(m.w) + g1[2] * (a3.x + c3.x); o1[3] += bf_hi(m.w) + g1[3] * (a3.y + c3.y);
        float* po = p.out + e0; *(f32x4*)po = o0; *(f32x4*)(po + 4) = o1;
    }
}

__global__ void __launch_bounds__(NTHREADS, 2) mk_fwd(Params p) {
    extern __shared__ __attribute__((aligned(16))) unsigned char shm[];
    LAS unsigned char* lds = (LAS unsigned char*)shm;
    const int lo = p.ph_lo, hi = p.ph_hi;
    if (threadIdx.x < 4) ((LAS unsigned*)(lds + LDS_BARW))[threadIdx.x] = 0u;
    __syncthreads();
    XcdBarrier bar; bar.bar = (unsigned*)(p.ws + WS_BAR); bar.x = 0; bar.st = nullptr;
    if (hi - lo > 1) bar = xcd_barrier_post((unsigned*)(p.ws + WS_BAR), (volatile LAS unsigned*)(lds + LDS_BARW));
#ifndef SKIP_MASK
#define SKIP_MASK 0
#endif
#define IN(k) (!((SKIP_MASK >> (k)) & 1) && lo <= (k) && (k) < hi)
#define SEAM(k) do { if (IN(k) && IN((k) + 1)) xcd_barrier(bar); } while (0)
    const int G = gridDim.x, bx = blockIdx.x;
#ifndef REP_PHASE
#define REP_PHASE 0
#endif
#define RUN(k, ...) do { if (IN(k)) { { const int rep = 0; (void)rep; __VA_ARGS__ } if ((REP_PHASE >> (k)) & 1) { xcd_barrier(bar); { const int rep = 1; (void)rep; __VA_ARGS__ } } } SEAM(k); } while (0)
    RUN(0, ph0_prologue(p, lds););
    RUN(1, ph1_norm(p););
    RUN(2, EpiProj E{p.ws, p.in[I_BGATE]};
           { ProjOrder S; S.S.init(p.ws + WS_H, p.ws + WS_WIN + (size_t)2 * 256 * DM * 2, NTOK, 8 * 256, DM * 2, G, bx); S.fp8 = 0; S.Bfull = nullptr;
             pg8::gemm_phase<EpiProj, ProjOrder, false, false>(lds, DM * 2, S, E); }
           { ProjOrder S; S.S.init(p.ws + WS_HF8, p.ws + WS_WIN8, NTOK, 30 * 256, DM, G, (G - 1) - bx); S.fp8 = 1; S.Bfull = nullptr;
             pg8::gemm_phase<EpiProj, ProjOrder, false, true>(lds, DM, S, E, 0x79797979); });
    RUN(3, ph3_prep(p, lds, rep););
    RUN(4, ph4_attn(p, lds););
    RUN(5, DualOrder S; S.S0.init(p.ws + WS_OA8, p.ws + WS_WPA8, NTOK, DM, 1024, G, bx); S.S1.init(p.ws + WS_OB8, p.ws + WS_WPB8, NTOK, DM, 1024, G, bx);
           EpiGate12 E{EpiGate1{(const bf16_t*)(p.ws + WS_GATES), (bf16_t*)(p.ws + WS_OA)}, EpiGate2{(const bf16_t*)(p.ws + WS_GATES), (const bf16_t*)(p.ws + WS_OA), (unsigned char*)(p.ws + WS_MRG8)}};
           pg8::gemm_phase<EpiGate12, DualOrder, false, true>(lds, 1024, S, E, 0x79797979, 0x7c7c7c7c););
    RUN(6, pg8::StaticOrder S; S.init(p.ws + WS_MRG8, p.ws + WS_WO8, NTOK, DM, DM, G, bx); EpiWo E{(const float*)(p.ws + WS_MOD), (bf16_t*)(p.ws + WS_MERGED)};
           pg8::gemm_phase<EpiWo, pg8::StaticOrder, false, true>(lds, DM, S, E, 0x79797979, 0x7d7d7d7d););
    RUN(7, ph8_router(p, lds, rep););
    RUN(8, moe_gemm<true>(p, lds, rep););
    RUN(9, moe_gemm<false>(p, lds, rep););
    RUN(10, if (!rep) ph11_combine(p););
#undef RUN
#undef IN
#undef SEAM
}

constexpr int NPHASES = 11;
extern "C" void kernel_launch(void* const* d_in, const int* in_sizes, int n_in, void* d_out, int out_size, void* d_ws, size_t ws_size, hipStream_t stream) {
    static int grid = 0;
    if (grid == 0) {
        if (n_in != 25 || in_sizes[0] != NTOK * DM || out_size != NTOK * DM || ws_size < WS_END6) {
            fprintf(stderr, "kernel_launch: shape mismatch: n_in %d in0 %d out %d ws %zu (need %zu)\n", n_in, n_in > 0 ? in_sizes[0] : -1, out_size, ws_size, (size_t)WS_END6); grid = -1; return; }
        int dev = 0, cus = 0, per_cu = 0;
        if (hipGetDevice(&dev) != hipSuccess || hipDeviceGetAttribute(&cus, hipDeviceAttributeMultiprocessorCount, dev) != hipSuccess) { fprintf(stderr, "kernel_launch: device query failed\n"); grid = -1; return; }
        if (hipFuncSetAttribute((const void*)mk_fwd, hipFuncAttributeMaxDynamicSharedMemorySize, LDS_BYTES) != hipSuccess) { fprintf(stderr, "kernel_launch: hipFuncSetAttribute failed\n"); grid = -1; return; }
        if (hipOccupancyMaxActiveBlocksPerMultiprocessor(&per_cu, (const void*)mk_fwd, NTHREADS, LDS_BYTES) != hipSuccess || per_cu < 1) { fprintf(stderr, "kernel_launch: occupancy query says %d blocks per CU\n", per_cu); }
        (void)hipGetLastError();
        grid = cus;
    }
    if (grid < 0) return;
    if (hipMemsetAsync((char*)d_ws + WS_BAR, 0, WS_ZERO_BYTES, stream) != hipSuccess) { fprintf(stderr, "kernel_launch: memset failed\n"); return; }
    Params p; memset(&p, 0, sizeof(p));
    for (int i = 0; i < 25; ++i) p.in[i] = (const float*)d_in[i];
    p.out = (float*)d_out; p.ws = (unsigned char*)d_ws;
    unsigned char* ws = (unsigned char*)d_ws;
    auto job = [&](int j, const float* src, size_t dst_off, int K, int N, int ldd, int map, int nbatch, long sbatch, long dbatch) {
        TJob& J = p.jobs[j]; J.src = src; J.dst = (bf16_t*)(ws + dst_off); J.K = K; J.N = N; J.ldd = ldd; J.map = map; J.ntk = K / 64; J.ntn = (N + 127) / 128; J.nbatch = nbatch; J.sbatch = sbatch; J.dbatch = dbatch; J.ld = N; J.fp8 = 0; };
    job(0, p.in[I_WIN] + 512, WS_WIN, 2048, 1872, 2048, 4, 1, 0, 0); p.jobs[0].ld = DIN;
    job(1, p.in[I_WIN] + 5456, WS_WIN, 2048, 8, 2048, 5, 1, 0, 0); p.jobs[1].ld = DIN;
    job(2, p.in[I_WUK], WS_WUK, 128, 256, 128, 0, 8, 128L * 256, 256L * 128);
    job(3, p.in[I_WUV], WS_WUV, 256, 128, 256, 0, 8, 256L * 128, 128L * 256);
    job(4, p.in[I_WIN], WS_WIN8, 2048, 512, 2048, 0, 1, 0, 0); job(5, p.in[I_WIN] + 2384, WS_WIN8 + (size_t)512 * 2048, 2048, 3072, 2048, 0, 1, 0, 0); job(6, p.in[I_WIN] + 5464, WS_WIN8 + (size_t)3584 * 2048, 2048, 4096, 2048, 0, 1, 0, 0);
    for (int j = 4; j < 7; ++j) { p.jobs[j].ld = DIN; p.jobs[j].fp8 = 1; }
    job(7, p.in[I_WO], WS_WO8, 2048, 2048, 2048, 0, 1, 0, 0); p.jobs[7].fp8 = 1;
    job(8, p.in[I_WPA], WS_WPA8, 1024, 2048, 1024, 0, 1, 0, 0); p.jobs[8].fp8 = 1; job(9, p.in[I_WPB], WS_WPB8, 1024, 2048, 1024, 0, 1, 0, 0); p.jobs[9].fp8 = 1;
    int t0 = 0; for (int j = 0; j < NJOBS; ++j) { p.jobs[j].tile0 = t0; t0 += p.jobs[j].ntk * p.jobs[j].ntn * p.jobs[j].nbatch; }
    p.ntiles_total = t0;
#if MK_LAUNCHES == 1
    p.ph_lo = 0; p.ph_hi = NPHASES;
    hipLaunchKernelGGL(mk_fwd, dim3(grid), dim3(NTHREADS), LDS_BYTES, stream, p);
#else
    for (int k = 0; k < NPHASES; ++k) { p.ph_lo = k; p.ph_hi = k + 1; hipLaunchKernelGGL(mk_fwd, dim3(grid), dim3(NTHREADS), LDS_BYTES, stream, p); }
#endif
    const hipError_t le = hipPeekAtLastError();
    if (le != hipSuccess) fprintf(stderr, "kernel_launch: launch failed: %s\n", hipGetErrorName(le));
}
```

```cpp
#include <hip/hip_runtime.h>
#include <cstdio>
#include <cstdint>
#include <cstring>

#ifndef MK_LAUNCHES
#define MK_LAUNCHES 1
#endif

#define LAS __attribute__((address_space(3)))
typedef unsigned short bf16_t;
typedef short bf16x8 __attribute__((ext_vector_type(8)));
typedef short s16x4 __attribute__((ext_vector_type(4)));
typedef float f32x4 __attribute__((ext_vector_type(4)));
typedef float f32x16 __attribute__((ext_vector_type(16)));
typedef unsigned u32x4 __attribute__((ext_vector_type(4)));
typedef unsigned u32x2 __attribute__((ext_vector_type(2)));

constexpr int DM = 2048, NBATCH = 4, SEQ = 2048, NTOK = NBATCH * SEQ;
constexpr int DIN = 9560, DINP = 9728;
constexpr int NEXP = 64, DEXP = 512, LCAP = 8192;
constexpr float RMS_EPS = 1e-6f;
constexpr float LOG2E = 1.4426950408889634f;
constexpr int NTHREADS = 512;
constexpr int LDS_BYTES = 163840 - 1024;
constexpr int LDS_BARW = LDS_BYTES - 16;
constexpr int LDS_TAB = 131072;

constexpr size_t al256(size_t x) { return (x + 255) / 256 * 256; }
constexpr size_t WS_BAR = 0;
constexpr size_t WS_CNT = 16384;
constexpr size_t WS_ZERO_BYTES = 16384 + 16384;
constexpr int NSUB = 16, SUBCAP = 512;
constexpr size_t WS_MOD = WS_ZERO_BYTES;
constexpr size_t WS_H = al256(WS_MOD + (size_t)4 * 12288 * 4);
constexpr size_t WS_WIN = al256(WS_H + (size_t)NTOK * DM * 2);
constexpr size_t WS_WPA = al256(WS_WIN + (size_t)DINP * DM * 2);
constexpr size_t WS_WPB = al256(WS_WPA + (size_t)2048 * 1024 * 2);
constexpr size_t WS_WO = al256(WS_WPB + (size_t)2048 * 1024 * 2);
constexpr size_t WS_WUK = al256(WS_WO + (size_t)2048 * 2048 * 2);
constexpr size_t WS_WUV = al256(WS_WUK + (size_t)8 * 256 * 128 * 2);
constexpr size_t WS_W13 = al256(WS_WUV + (size_t)8 * 128 * 256 * 2);
constexpr size_t WS_W2 = al256(WS_W13 + (size_t)64 * 1024 * 2048 * 2);
constexpr size_t WS_QA = al256(WS_W2 + (size_t)64 * 2048 * 512 * 2);
constexpr size_t WS_CKV = al256(WS_QA + (size_t)NTOK * 1024 * 2);
constexpr size_t WS_KV = al256(WS_CKV + (size_t)NTOK * 256 * 4);
constexpr size_t WS_QIDX = al256(WS_KV + (size_t)NTOK * 256 * 2);
constexpr size_t WS_MISC = al256(WS_QIDX + (size_t)NTOK * 1024 * 2);
constexpr size_t WS_QB = al256(WS_MISC + (size_t)NTOK * 256 * 4);
constexpr size_t WS_KB = al256(WS_QB + (size_t)NTOK * 1024 * 2);
constexpr size_t WS_VB = al256(WS_KB + (size_t)NTOK * 1024 * 2);
constexpr size_t WS_GATES = al256(WS_VB + (size_t)NTOK * 1024 * 2);
constexpr size_t WS_QLAT = al256(WS_GATES + (size_t)NTOK * 4096 * 2);
constexpr size_t WS_MASK = al256(WS_QLAT + (size_t)NTOK * 2048 * 2);
constexpr size_t WS_CUM = al256(WS_MASK + (size_t)NTOK * 256);
constexpr size_t WS_OLAT = al256(WS_CUM + (size_t)4 * 8 * 2048 * 4);
constexpr size_t WS_OA = al256(WS_OLAT + (size_t)NTOK * 2048 * 2);
constexpr size_t WS_OB = al256(WS_OA + (size_t)NTOK * 1024 * 2);
constexpr size_t WS_T1 = al256(WS_OB + (size_t)NTOK * 1024 * 2);
constexpr size_t WS_MERGED = al256(WS_T1 + (size_t)NTOK * 2048 * 4);
constexpr size_t WS_LTOK = al256(WS_MERGED + (size_t)NTOK * 2048 * 2);
constexpr size_t WS_LW = al256(WS_LTOK + (size_t)NEXP * LCAP * 4);
constexpr size_t WS_ACT = al256(WS_LW + (size_t)NEXP * LCAP * 4);
constexpr size_t WS_HLO = al256(WS_ACT + (size_t)32768 * 512 * 2);
constexpr size_t WS_WRH = al256(WS_HLO + (size_t)NTOK * DM * 2);
constexpr size_t WS_WRL = al256(WS_WRH + (size_t)80 * DM * 2);
constexpr size_t WS_END = al256(WS_WRL + (size_t)80 * DM * 2);
constexpr size_t WS_KIDX = WS_END;
constexpr size_t WS_END2 = al256(WS_KIDX + (size_t)NTOK * 64 * 2);
constexpr size_t WS_H8 = WS_END2;
constexpr size_t WS_ACT8 = al256(WS_H8 + (size_t)NTOK * DM);
constexpr size_t WS_END3 = al256(WS_ACT8 + (size_t)16384 * 512);
constexpr size_t WS_HF8 = WS_END3;
constexpr size_t WS_WIN8 = al256(WS_HF8 + (size_t)NTOK * DM);
constexpr size_t WS_END4 = al256(WS_WIN8 + (size_t)7680 * DM);
constexpr size_t WS_MRG8 = WS_END4;
constexpr size_t WS_WO8 = al256(WS_MRG8 + (size_t)NTOK * DM);
constexpr size_t WS_END5 = al256(WS_WO8 + (size_t)2048 * 2048);
constexpr size_t WS_OA8 = WS_END5;
constexpr size_t WS_OB8 = al256(WS_OA8 + (size_t)NTOK * 1024);
constexpr size_t WS_WPA8 = al256(WS_OB8 + (size_t)NTOK * 1024);
constexpr size_t WS_WPB8 = al256(WS_WPA8 + (size_t)2048 * 1024);
constexpr size_t WS_END6 = al256(WS_WPB8 + (size_t)2048 * 1024);
constexpr size_t WS_YS = WS_T1;
constexpr size_t WS_HG = WS_QA;
static_assert(WS_HG + (size_t)32768 * DM * 2 <= WS_QLAT, "hg alias must fit in the dead region");

struct TJob { const float* src; bf16_t* dst; int K, N, ldd, map, ntk, ntn, nbatch, tile0; long sbatch, dbatch; int ld, fp8; };
constexpr int NJOBS = 10;
struct Params {
    const float* in[25];
    float* out;
    unsigned char* ws;
    TJob jobs[NJOBS];
    int ntiles_total;
    int ph_lo, ph_hi;
};
enum { I_X = 0, I_C, I_WADA, I_BADA, I_GMIX, I_WIN, I_BGATE, I_BFORGET, I_WUK, I_WUV, I_GQA, I_GKV, I_GQB, I_GKB, I_WPA, I_WPB, I_WO, I_GFFN, I_WRG, I_BRG, I_WRE, I_BRE, I_W1, I_W3, I_W2 };

__device__ __forceinline__ unsigned cvt_pk_bf16(float lo, float hi) { unsigned r; asm volatile("v_cvt_pk_bf16_f32 %0, %1, %2" : "=v"(r) : "v"(lo), "v"(hi)); return r; }
__device__ __forceinline__ float bf_lo(unsigned w) { return __uint_as_float(w << 16); }
__device__ __forceinline__ float bf_hi(unsigned w) { return __uint_as_float(w & 0xffff0000u); }
typedef float f32x2 __attribute__((ext_vector_type(2)));
__device__ __forceinline__ unsigned pack_fp8x4(float a, float b, float c, float d) { int w = __builtin_amdgcn_cvt_pk_fp8_f32(a, b, 0, false); w = __builtin_amdgcn_cvt_pk_fp8_f32(c, d, w, true); return (unsigned)w; }
__device__ __forceinline__ bf16x8 fp8x8_to_bf16(u32x2 v) {
    const f32x2 a = __builtin_amdgcn_cvt_pk_f32_fp8((int)v.x, false), b = __builtin_amdgcn_cvt_pk_f32_fp8((int)v.x, true), c = __builtin_amdgcn_cvt_pk_f32_fp8((int)v.y, false), d = __builtin_amdgcn_cvt_pk_f32_fp8((int)v.y, true);
    u32x4 w; w.x = cvt_pk_bf16(a.x, a.y); w.y = cvt_pk_bf16(b.x, b.y); w.z = cvt_pk_bf16(c.x, c.y); w.w = cvt_pk_bf16(d.x, d.y); return *reinterpret_cast<bf16x8*>(&w); }
__device__ __forceinline__ unsigned pack_u8x4(float a, float b, float c, float d) {
    unsigned w = 0; w = __builtin_amdgcn_cvt_pk_u8_f32(a * 255.f + 0.5f, 0, w); w = __builtin_amdgcn_cvt_pk_u8_f32(b * 255.f + 0.5f, 1, w); w = __builtin_amdgcn_cvt_pk_u8_f32(c * 255.f + 0.5f, 2, w); w = __builtin_amdgcn_cvt_pk_u8_f32(d * 255.f + 0.5f, 3, w); return w; }
__device__ __forceinline__ f32x4 unpack_u8x4(unsigned w) { return (f32x4){(float)(w & 0xffu), (float)((w >> 8) & 0xffu), (float)((w >> 16) & 0xffu), (float)(w >> 24)} * (1.0f / 255.0f); }
__device__ __forceinline__ float wave_sum(float v) {
#pragma unroll
    for (int o = 32; o >= 1; o >>= 1) v += __shfl_xor(v, o);
    return v;
}
__device__ __forceinline__ float sigmoidf_(float x) { return __builtin_amdgcn_rcpf(1.0f + __builtin_amdgcn_exp2f(-1.4426950408889634f * x)); }
__device__ __forceinline__ int crow(int r, int hi) { return (r & 3) + 8 * (r >> 2) + 4 * hi; }
#define SBAR() __builtin_amdgcn_sched_barrier(0)

#define XB_TMO      128
#define XB_XCNT(j)  (256  + 64 * (j))
#define XB_XSUB(j)  (1280 + 64 * (j))
#define XB_XGEN(j)  (2304 + 64 * (j))
#define XB_TOP      3328
#define XB_TOPGEN   3392
#define XCD_BAR_WORDS 3456
#define XB_SPIN_CAP (1u << 20)
__device__ __forceinline__ unsigned xb_ld(unsigned* p)              { return __hip_atomic_load(p, __ATOMIC_RELAXED, __HIP_MEMORY_SCOPE_AGENT); }
__device__ __forceinline__ unsigned xb_add(unsigned* p, unsigned v) { return __hip_atomic_fetch_add(p, v, __ATOMIC_RELAXED, __HIP_MEMORY_SCOPE_AGENT); }
__device__ __forceinline__ unsigned xb_xcc_id() { return (unsigned)__builtin_amdgcn_s_getreg((3 << 11) | 20) & 0xFu; }
#define XB_SPIN(cond, bar) do { unsigned _sp = 0; while (cond) { __builtin_amdgcn_s_sleep(1); \
    if ((++_sp & 255u) == 0u) { if (xb_ld(&(bar)[XB_TMO])) break; if (_sp > XB_SPIN_CAP) { atomicAdd(&(bar)[XB_TMO], 1u); break; } } } } while (0)
struct XcdBarrier { unsigned* bar; unsigned x; volatile LAS unsigned* st; };
__device__ __forceinline__ XcdBarrier xcd_barrier_post(unsigned* bar, volatile LAS unsigned* st) {
    XcdBarrier b; b.bar = bar; b.x = xb_xcc_id(); b.st = st;
    if (threadIdx.x == 0) (void)xb_add(&bar[XB_XCNT(b.x)], 1u);
    return b;
}
__device__ __forceinline__ void xcd_barrier_complete(unsigned* bar, unsigned x, unsigned& nloc, unsigned& nx) {
    const unsigned G = gridDim.x * gridDim.y * gridDim.z;
    unsigned sum, cnt, mine, sp = 0u;
    for (;;) {
        sum = 0u; cnt = 0u; mine = 0u;
#pragma unroll
        for (unsigned j = 0; j < 16; ++j) { const unsigned c = xb_ld(&bar[XB_XCNT(j)]); sum += c; cnt += (c > 0u) ? 1u : 0u; mine = (j == x) ? c : mine; }
        if (sum == G) break;
        __builtin_amdgcn_s_sleep(1);
        if ((++sp & 255u) == 0u) { if (xb_ld(&bar[XB_TMO])) break; if (sp > XB_SPIN_CAP) { atomicAdd(&bar[XB_TMO], 1u); break; } }
    }
    nloc = mine > 0u ? mine : 1u; nx = cnt > 0u ? cnt : 1u;
}
__device__ __forceinline__ void xcd_barrier(const XcdBarrier& b) {
    asm volatile("s_waitcnt vmcnt(0)" ::: "memory");
    __syncthreads();
    if (threadIdx.x == 0) {
        unsigned* bar = b.bar;
        __builtin_amdgcn_s_waitcnt(0);
        unsigned nloc = b.st[0], nx = b.st[1];
        if (nloc == 0u) { xcd_barrier_complete(bar, b.x, nloc, nx); b.st[0] = nloc; b.st[1] = nx; }
        const unsigned old = xb_add(&bar[XB_XSUB(b.x)], 1u);
        const unsigned gen = old / nloc;
        if (old + 1u == (gen + 1u) * nloc) {
            __builtin_amdgcn_fence(__ATOMIC_RELEASE, "agent");
            asm volatile("s_waitcnt vmcnt(0)" ::: "memory");
            const unsigned og = xb_add(&bar[XB_TOP], 1u);
            const unsigned tg = og / nx;
            if (og + 1u == (tg + 1u) * nx) xb_add(&bar[XB_TOPGEN], 1u);
            else XB_SPIN(xb_ld(&bar[XB_TOPGEN]) == tg, bar);
            __builtin_amdgcn_fence(__ATOMIC_ACQUIRE, "agent");
            xb_add(&bar[XB_XGEN(b.x)], 1u);
            asm volatile("s_waitcnt vmcnt(0)" ::: "memory");
        } else {
            XB_SPIN(xb_ld(&bar[XB_XGEN(b.x)]) == gen, bar);
            __builtin_amdgcn_fence(__ATOMIC_ACQUIRE, "agent");
            asm volatile("s_waitcnt vmcnt(0)" ::: "memory");
        }
    }
    __syncthreads();
}

namespace pg8 {
constexpr int BM = 256, BK = 64, HALF = 128, HTB = HALF * BK * 2, STAGE_BYTES = 8 * HTB, NXCD = 8, WGM = 8;
__host__ __device__ __forceinline__ int lds_byte(int r, int c) { const int st = (r >> 4) * 2 + (c >> 5), rr = r & 15, cc = c & 31, ob = rr * 64 + cc * 2; return st * 1024 + (ob ^ (((ob >> 9) & 1) << 5)); }
__host__ __device__ __forceinline__ void stage_rc(int b, int& R, int& C) { const int st = b / 1024, sb = b % 1024, swz = sb ^ (((sb >> 9) & 1) << 5); R = (st >> 1) * 16 + swz / 64; C = (st & 1) * 32 + (swz % 64) / 2; }
__host__ __device__ __forceinline__ int perm32(int rho) { const int n = rho >> 4, i = rho & 15; return 8 * (i >> 2) + 4 * n + (i & 3); }

struct Unit { int pm, pn; const char* a; const char* b; const int* gi; int nvalid; int aux; };

struct StaticOrder {
    int nM, nN, nwg, G, c, RS; const char* A; const char* Bt;
    __device__ void init(const void* A_, const void* Bt_, int M, int N, int RS_, int G_, int c_) { A = (const char*)A_; Bt = (const char*)Bt_; RS = RS_; nM = M / BM; nN = N / BM; nwg = nM * nN; G = G_; c = c_; }
    __device__ bool next(int i, Unit& u) const {
        const long L = (long)i * G + c; if (L >= nwg) return false;
        int wgid = (int)L; { const int q = nwg / NXCD, r = nwg % NXCD, xcd = wgid % NXCD, off = wgid / NXCD; wgid = (xcd < r ? xcd * (q + 1) : r * (q + 1) + (xcd - r) * q) + off; }
        const int nig = WGM * nN, gid = wgid / nig, fm = gid * WGM, gsz = (nM - fm) < WGM ? (nM - fm) : WGM;
        u.pm = fm + ((wgid % nig) % gsz); u.pn = (wgid % nig) / gsz;
        u.a = A + (size_t)u.pm * BM * RS; u.b = Bt + (size_t)u.pn * BM * RS; u.gi = nullptr; u.nvalid = BM; u.aux = 0; return true;
    }
};

typedef int i32x8 __attribute__((ext_vector_type(8)));
typedef int i32x4v __attribute__((ext_vector_type(4)));
template <class Epi, class Sched, bool GATHER, bool FP8 = false>
__device__ __forceinline__ void gemm_phase(LAS unsigned char* lds, const int RS, const Sched& S, const Epi& E, const int scale_b = 0x7f7f7f7f, const int scale_a = 0x7f7f7f7f) {
    int tid = threadIdx.x; asm volatile("" : "+v"(tid));
    const int wid = __builtin_amdgcn_readfirstlane(tid >> 6), lane = tid & 63, wr = wid >> 2, wc = wid & 3, fr = lane & 15, fq = lane >> 4;
    const int nt = RS / (BK * 2); const int K = RS;
    unsigned voffA[2], voffB[2]; int RA[2], CA[2];
#pragma unroll
    for (int i = 0; i < 2; ++i) { int R, C; stage_rc(tid * 16 + i * 8192, R, C); const int Rb = ((R & ~31) + perm32(R & 31));
        RA[i] = R; CA[i] = C; voffA[i] = (unsigned)(R * RS + C * 2); voffB[i] = (unsigned)(Rb * RS + C * 2); }
    const size_t kstep = (size_t)(BK * 2);
    const size_t hstep = (size_t)HALF * RS;
    const unsigned ldsw = (unsigned)wid * 1024u;
    const int aoff = lds_byte(wr * 64 + fr, fq * 8), boff = lds_byte(wc * 32 + fr, fq * 8);
    unsigned gA[2][2], gN[2][2];
#define PG8_SA(b, h) (((b) * 2 + (h)) * HTB)
#define PG8_SB(b, h) ((4 + (b) * 2 + (h)) * HTB)
#define PG8_STAGE(bufoff, gbase, voff) do { _Pragma("unroll") for (int _i = 0; _i < 2; ++_i) \
        __builtin_amdgcn_global_load_lds((const unsigned*)((const char*)(gbase) + (voff)[_i]), (LAS unsigned*)(lds + (bufoff) + ldsw + _i * 8192), 16, 0, 0); } while (0)
#define PG8_STAGE_A(bufoff, gp, h, NX) do { if constexpr (GATHER) { if (NX) PG8_STAGE(bufoff, gp, gN[h]); else PG8_STAGE(bufoff, gp, gA[h]); } else PG8_STAGE(bufoff, (gp) + (h) * hstep, voffA); } while (0)
#define PG8_LD8(p_) __builtin_shufflevector(*(const LAS i32x4v*)(p_), *(const LAS i32x4v*)((p_) + 1024), 0, 1, 2, 3, 4, 5, 6, 7)
#define PG8_LDA(dst, b, h) do { if constexpr (FP8) { _Pragma("unroll") for (int m = 0; m < 4; ++m) dst##8[m] = PG8_LD8(lds + PG8_SA(b, h) + aoff + m * 2048); } \
        else { _Pragma("unroll") for (int m = 0; m < 4; ++m) _Pragma("unroll") for (int k = 0; k < 2; ++k) dst[m][k] = *(const LAS bf16x8*)(lds + PG8_SA(b, h) + aoff + m * 2048 + k * 1024); } } while (0)
#define PG8_LDB(dst, b, h) do { if constexpr (FP8) { _Pragma("unroll") for (int n = 0; n < 2; ++n) dst##8[n] = PG8_LD8(lds + PG8_SB(b, h) + boff + n * 2048); } \
        else { _Pragma("unroll") for (int n = 0; n < 2; ++n) _Pragma("unroll") for (int k = 0; k < 2; ++k) dst[n][k] = *(const LAS bf16x8*)(lds + PG8_SB(b, h) + boff + n * 2048 + k * 1024); } } while (0)
#define PG8_MMA(ai, bj, At, Bt) do { __builtin_amdgcn_s_setprio(1); \
        if constexpr (FP8) { _Pragma("unroll") for (int m = 0; m < 4; ++m) _Pragma("unroll") for (int n = 0; n < 2; ++n) \
            asm volatile("v_mfma_scale_f32_16x16x128_f8f6f4 %0, %1, %2, %0, %3, %4 op_sel_hi:[0,0,0]" : "+v"(acc[ai][bj][m][n]) : "v"(Bt##8[n]), "v"(At##8[m]), "v"(sc_b), "v"(sc_a)); } \
        else { _Pragma("unroll") for (int m = 0; m < 4; ++m) _Pragma("unroll") for (int n = 0; n < 2; ++n) _Pragma("unroll") for (int k = 0; k < 2; ++k) \
            acc[ai][bj][m][n] = __builtin_amdgcn_mfma_f32_16x16x32_bf16(Bt[n][k], At[m][k], acc[ai][bj][m][n], 0, 0, 0); } \
        __builtin_amdgcn_s_setprio(0); } while (0)
#define PG8_WAIT_V(n) asm volatile("s_waitcnt vmcnt(" #n ")" ::: "memory")
#define PG8_WAIT_L(n) asm volatile("s_waitcnt lgkmcnt(" #n ")" ::: "memory")
#define PG8_BAR __builtin_amdgcn_s_barrier()
#define PG8_SCHED __builtin_amdgcn_sched_barrier(0)
#define PG8_GIDX(dst, u) do { if constexpr (GATHER) { _Pragma("unroll") for (int h = 0; h < 2; ++h) _Pragma("unroll") for (int i = 0; i < 2; ++i) { \
        const int rr = h * HALF + RA[i]; const int tok = rr < (u).nvalid ? (u).gi[rr] : 0; dst[h][i] = (unsigned)(tok * K + CA[i] * 2); } } } while (0)
    Unit cur, nxt; int ui = 0;
    if (!S.next(0, cur)) return;
    f32x4 acc[2][2][4][2];
#pragma unroll
    for (int a = 0; a < 2; ++a)
#pragma unroll
        for (int b = 0; b < 2; ++b)
#pragma unroll
            for (int m = 0; m < 4; ++m)
#pragma unroll
                for (int n = 0; n < 2; ++n) acc[a][b][m][n] = (f32x4){0.f, 0.f, 0.f, 0.f};
    const int sc_b = scale_b, sc_a = scale_a;
    bf16x8 At[4][2], B0[2][2], B1[2][2]; i32x8 At8[4], B08[2], B18[2];
    const char* cA = cur.a; const char* cB = cur.b;
    PG8_GIDX(gA, cur);
    PG8_STAGE(PG8_SB(0, 0), cB, voffB); PG8_STAGE_A(PG8_SA(0, 0), cA, 0, false); PG8_STAGE(PG8_SB(0, 1), cB + hstep, voffB); PG8_STAGE_A(PG8_SA(0, 1), cA, 1, false);
    if (wr == 1) PG8_BAR;
    PG8_WAIT_V(4); PG8_BAR;
    PG8_STAGE(PG8_SB(1, 0), cB + kstep, voffB); PG8_STAGE_A(PG8_SA(1, 0), cA + kstep, 0, false); PG8_STAGE(PG8_SB(1, 1), cB + hstep + kstep, voffB);
    PG8_WAIT_V(6); PG8_BAR;
    for (;;) {
        const bool has_next = S.next(ui + 1, nxt);
        const char* nA = has_next ? nxt.a : cA; const char* nB = has_next ? nxt.b : cB;
        if constexpr (GATHER) { if (has_next) { PG8_GIDX(gN, nxt); } else {
#pragma unroll
            for (int h = 0; h < 2; ++h)
#pragma unroll
                for (int i = 0; i < 2; ++i) gN[h][i] = gA[h][i]; } }
        for (int t = 0; t < nt; t += 2) {
            const bool last = (t == nt - 2);
            const char* a1 = cA + (size_t)(t + 1) * kstep;
            const char* a2 = last ? nA : cA + (size_t)(t + 2) * kstep; const char* b2 = last ? nB : cB + (size_t)(t + 2) * kstep;
            const char* a3 = a2 + kstep; const char* b3 = b2 + kstep;
            PG8_LDB(B0, 0, 0); PG8_SCHED; PG8_LDA(At, 0, 0); PG8_STAGE_A(PG8_SA(1, 1), a1, 1, false);
            PG8_WAIT_L(8); PG8_BAR; PG8_WAIT_L(0); PG8_MMA(0, 0, At, B0); PG8_BAR; PG8_SCHED;
            PG8_LDB(B1, 0, 1); PG8_STAGE(PG8_SB(0, 0), b2, voffB);
            PG8_BAR; PG8_WAIT_L(0); PG8_MMA(0, 1, At, B1); PG8_BAR;
            PG8_LDA(At, 0, 1); PG8_STAGE_A(PG8_SA(0, 0), a2, 0, last);
            PG8_BAR; PG8_WAIT_L(0); PG8_MMA(1, 0, At, B0); PG8_BAR; PG8_SCHED;
            PG8_STAGE(PG8_SB(0, 1), b2 + hstep, voffB);
            PG8_WAIT_V(6); PG8_BAR; PG8_MMA(1, 1, At, B1); PG8_BAR;
            PG8_LDB(B0, 1, 0); PG8_SCHED; PG8_LDA(At, 1, 0); PG8_STAGE_A(PG8_SA(0, 1), a2, 1, last);
            PG8_WAIT_L(8); PG8_BAR; PG8_WAIT_L(0); PG8_MMA(0, 0, At, B0); PG8_BAR; PG8_SCHED;
            PG8_LDB(B1, 1, 1); PG8_STAGE(PG8_SB(1, 0), b3, voffB);
            PG8_BAR; PG8_WAIT_L(0); PG8_MMA(0, 1, At, B1); PG8_BAR;
            PG8_LDA(At, 1, 1); PG8_STAGE_A(PG8_SA(1, 0), a3, 0, last);
            PG8_BAR; PG8_WAIT_L(0); PG8_MMA(1, 0, At, B0); PG8_BAR; PG8_SCHED;
            PG8_STAGE(PG8_SB(1, 1), b3 + hstep, voffB);
            PG8_WAIT_V(6); PG8_BAR; PG8_MMA(1, 1, At, B1); PG8_BAR;
        }
        bool keep_acc = false;
        if constexpr (FP8) asm volatile("s_nop 15\n\ts_nop 15" ::: "memory");
        if constexpr (Epi::DUAL) { if (cur.aux) { E.mid(acc, cur, wr, wc, fr, fq); keep_acc = true; } else E(acc, cur, wr, wc, fr, fq); } else E(acc, cur, wr, wc, fr, fq);
        if (!has_next) break;
        if (!keep_acc)
#pragma unroll
        for (int a = 0; a < 2; ++a)
#pragma unroll
            for (int b = 0; b < 2; ++b)
#pragma unroll
                for (int m = 0; m < 4; ++m)
#pragma unroll
                    for (int n = 0; n < 2; ++n) acc[a][b][m][n] = (f32x4){0.f, 0.f, 0.f, 0.f};
        cur = nxt; cA = nA; cB = nB; ++ui;
        if constexpr (GATHER) {
#pragma unroll
            for (int h = 0; h < 2; ++h)
#pragma unroll
                for (int i = 0; i < 2; ++i) gA[h][i] = gN[h][i]; }
    }
    PG8_WAIT_V(0);
    if (wr == 0) PG8_BAR;
    PG8_BAR;
#undef PG8_SA
#undef PG8_SB
#undef PG8_STAGE
#undef PG8_STAGE_A
#undef PG8_LDA
#undef PG8_LD8
#undef PG8_LDB
#undef PG8_MMA
#undef PG8_WAIT_V
#undef PG8_WAIT_L
#undef PG8_BAR
#undef PG8_SCHED
#undef PG8_GIDX
}
}
using pg8::Unit;

#define EPI_LOOP(...) { int fr_ = fr, fq_ = fq; asm volatile("" : "+v"(fr_), "+v"(fq_)); _Pragma("unroll") for (int ai = 0; ai < 2; ++ai) _Pragma("unroll") for (int m = 0; m < 4; ++m) _Pragma("unroll") for (int bj = 0; bj < 2; ++bj) { \
        const int trow = ai * 128 + wr * 64 + m * 16 + fr_; const int tcol = bj * 128 + wc * 32 + fq_ * 8; const f32x4 v0 = acc[ai][bj][m][0], v1 = acc[ai][bj][m][1]; __VA_ARGS__ } }

__device__ __forceinline__ u32x4 pack8(const f32x4 a, const f32x4 b) { u32x4 w; w.x = cvt_pk_bf16(a[0], a[1]); w.y = cvt_pk_bf16(a[2], a[3]); w.z = cvt_pk_bf16(b[0], b[1]); w.w = cvt_pk_bf16(b[2], b[3]); return w; }

struct EpiProj { static constexpr bool DUAL = false;
    unsigned char* ws; const float* b_gate;
    __device__ __forceinline__ void operator()(const f32x4 (&acc)[2][2][4][2], const Unit& u, int wr, int wc, int fr, int fq) const {
        const int pn = u.pn; const size_t row0 = (size_t)u.pm * 256;
        if (pn == 4 || pn == 9) {
            float* dst = (float*)(ws + (pn == 4 ? WS_CKV : WS_MISC));
            EPI_LOOP({ float* p = dst + (row0 + trow) * 256 + tcol; *(f32x4*)p = v0; *(f32x4*)(p + 4) = v1;
                if (pn == 9 && tcol < 64) *(u32x4*)((bf16_t*)(ws + WS_KIDX) + (row0 + trow) * 64 + tcol) = pack8(v0, v1); })
        } else if (pn < 22) {
            bf16_t* dst; int ct;
            if (pn < 4) { dst = (bf16_t*)(ws + WS_QA); ct = pn; } else if (pn < 9) { dst = (bf16_t*)(ws + WS_QIDX); ct = pn - 5; }
            else if (pn < 14) { dst = (bf16_t*)(ws + WS_QB); ct = pn - 10; } else if (pn < 18) { dst = (bf16_t*)(ws + WS_KB); ct = pn - 14; } else { dst = (bf16_t*)(ws + WS_VB); ct = pn - 18; }
            EPI_LOOP({ *(u32x4*)(dst + (row0 + trow) * 1024 + ct * 256 + tcol) = pack8(v0, v1); })
        } else {
            bf16_t* dst = (bf16_t*)(ws + WS_GATES); const int ct = pn - 22;
            EPI_LOOP({ const int col = ct * 256 + tcol; const f32x4 b0 = *(const f32x4*)(b_gate + col), b1 = *(const f32x4*)(b_gate + col + 4); f32x4 s0, s1;
                _Pragma("unroll") for (int j = 0; j < 4; ++j) { s0[j] = sigmoidf_(v0[j] + b0[j]); s1[j] = sigmoidf_(v1[j] + b1[j]); }
                u32x2 w8; w8.x = pack_u8x4(s0[0], s0[1], s0[2], s0[3]); w8.y = pack_u8x4(s1[0], s1[1], s1[2], s1[3]); *(u32x2*)((unsigned char*)dst + (row0 + trow) * 4096 + col) = w8; })
        }
    }
};
struct EpiGate1 { static constexpr bool DUAL = false;
    const bf16_t* gates; bf16_t* T1;
    __device__ __forceinline__ void operator()(const f32x4 (&acc)[2][2][4][2], const Unit& u, int wr, int wc, int fr, int fq) const {
        EPI_LOOP({ const size_t row = (size_t)u.pm * 256 + trow; const int col = u.pn * 256 + tcol; const u32x2 g = *(const u32x2*)((const unsigned char*)gates + row * 4096 + col);
            const f32x4 o0 = v0 * unpack_u8x4(g.x), o1 = v1 * unpack_u8x4(g.y);
            *(u32x4*)(T1 + row * 2048 + col) = pack8(o0, o1); })
    }
};
struct EpiGate2 { static constexpr bool DUAL = false;
    const bf16_t* gates; const bf16_t* T1; unsigned char* merged;
    __device__ __forceinline__ void operator()(const f32x4 (&acc)[2][2][4][2], const Unit& u, int wr, int wc, int fr, int fq) const {
        EPI_LOOP({ const size_t row = (size_t)u.pm * 256 + trow; const int col = u.pn * 256 + tcol; const u32x2 g = *(const u32x2*)((const unsigned char*)gates + row * 4096 + 2048 + col);
            const u32x4 t = *(const u32x4*)(T1 + row * 2048 + col);
            const f32x4 o0 = (f32x4){bf_lo(t.x), bf_hi(t.x), bf_lo(t.y), bf_hi(t.y)} + v0 * unpack_u8x4(g.x), o1 = (f32x4){bf_lo(t.z), bf_hi(t.z), bf_lo(t.w), bf_hi(t.w)} + v1 * unpack_u8x4(g.y);
            u32x2 w8; w8.x = pack_fp8x4(o0[0] * 4.f, o0[1] * 4.f, o0[2] * 4.f, o0[3] * 4.f); w8.y = pack_fp8x4(o1[0] * 4.f, o1[1] * 4.f, o1[2] * 4.f, o1[3] * 4.f);
            *(u32x2*)(merged + row * 2048 + col) = w8; })
    }
};
struct EpiWo { static constexpr bool DUAL = false;
    const float* mod; bf16_t* y;
    __device__ __forceinline__ void operator()(const f32x4 (&acc)[2][2][4][2], const Unit& u, int wr, int wc, int fr, int fq) const {
        const float* gt = mod + (size_t)(u.pm >> 3) * 12288 + 4096;
        EPI_LOOP({ const size_t row = (size_t)u.pm * 256 + trow; const int col = u.pn * 256 + tcol;
            const f32x4 g0 = *(const f32x4*)(gt + col), g1 = *(const f32x4*)(gt + col + 4);
            *(u32x4*)(y + row * 2048 + col) = pack8(g0 * v0, g1 * v1); })
    }
};
struct DualOrder {
    pg8::StaticOrder S0, S1;
    __device__ bool next(int i, Unit& u) const { const bool ok = (i & 1) ? S1.next(i >> 1, u) : S0.next(i >> 1, u); u.aux = (i & 1) ? 0 : 1; return ok; }
};
struct EpiGate12 { static constexpr bool DUAL = false;
    EpiGate1 e1; EpiGate2 e2;
    __device__ __forceinline__ void operator()(const f32x4 (&acc)[2][2][4][2], const Unit& u, int wr, int wc, int fr, int fq) const { if (u.aux) e1(acc, u, wr, wc, fr, fq); else e2(acc, u, wr, wc, fr, fq); }
};

struct ProjOrder {
    pg8::StaticOrder S; int fp8; const char* Bfull;
    __device__ bool next(int i, Unit& u) const {
        if (!S.next(i, u)) return false;
        if (fp8) { if (u.pn >= 2) u.pn += 8; } else u.pn += 2;
        return true;
    }
};
__device__ __forceinline__ int map_row(int map, int n) {
    if (map == 0) return n;
    if (map == 1) { if (n < 2384) return n; if (n < 5456) return n + 176; if (n < 5464) return n - 3072; return n + 168; }
    if (map == 4) return n + 512;
    return n + 2384;
}
__device__ void ph0_prologue(const Params& p, LAS unsigned char* lds) {
    const int tid = threadIdx.x, wid = tid >> 6, lane = tid & 63, G = gridDim.x, bx = blockIdx.x;
    if (bx < 192) {
        LAS float* sc = (LAS float*)lds;
        LAS float* red = (LAS float*)(lds + 32768);
        const float* c = p.in[I_C];
        for (int i = tid; i < 4 * 2048; i += NTHREADS) { const float v = c[i]; sc[i] = v / (1.0f + __expf(-v)); }
        __syncthreads();
        for (int item = bx; item < 192; item += G) {
            const int n0 = item * 64, cg = lane & 15, rs = lane >> 4;
            float acc[4][4];
#pragma unroll
            for (int b = 0; b < 4; ++b)
#pragma unroll
                for (int j = 0; j < 4; ++j) acc[b][j] = 0.f;
            const float* w = p.in[I_WADA] + n0 + cg * 4;
#pragma unroll 4
            for (int step = 0; step < 64; ++step) {
                const int k = step * 32 + wid * 4 + rs;
                const f32x4 wv = *(const f32x4*)(w + (size_t)k * 12288);
#pragma unroll
                for (int b = 0; b < 4; ++b) { const float s = sc[b * 2048 + k];
#pragma unroll
                    for (int j = 0; j < 4; ++j) acc[b][j] += s * wv[j]; }
            }
#pragma unroll
            for (int b = 0; b < 4; ++b)
#pragma unroll
                for (int j = 0; j < 4; ++j) { float v = acc[b][j]; v += __shfl_xor(v, 16); v += __shfl_xor(v, 32); acc[b][j] = v; }
            if (rs == 0) {
#pragma unroll
                for (int b = 0; b < 4; ++b)
#pragma unroll
                    for (int j = 0; j < 4; ++j) red[(wid * 16 + cg) * 16 + b * 4 + j] = acc[b][j]; }
            __syncthreads();
            if (tid < 256) { const int cg2 = tid >> 4, bj = tid & 15, b = bj >> 2, j = bj & 3; float s = 0.f;
#pragma unroll
                for (int w8 = 0; w8 < 8; ++w8) s += red[(w8 * 16 + cg2) * 16 + bj];
                const int n = n0 + cg2 * 4 + j; ((float*)(p.ws + WS_MOD))[b * 12288 + n] = s + p.in[I_BADA][n]; }
            __syncthreads();
        }
    }
    { u32x4* z = (u32x4*)(p.ws + WS_WIN + (size_t)2392 * 2048 * 2); const int n16 = 168 * 2048 * 2 / 16;
      for (int i = bx * NTHREADS + tid; i < n16; i += G * NTHREADS) z[i] = (u32x4){0u, 0u, 0u, 0u}; }
    { bf16_t* wh = (bf16_t*)(p.ws + WS_WRH); bf16_t* wl = (bf16_t*)(p.ws + WS_WRL);
      for (int i = bx * NTHREADS + tid; i < 80 * 2048; i += G * NTHREADS) { const int n = i >> 11, k = i & 2047;
          const float v = n < 8 ? p.in[I_WRG][k * 8 + n] : (n < 72 ? p.in[I_WRE][k * 64 + n - 8] : 0.f);
          const unsigned h = cvt_pk_bf16(v, 0.f) & 0xffffu; const unsigned l = cvt_pk_bf16(v - bf_lo(h), 0.f) & 0xffffu; wh[i] = (bf16_t)h; wl[i] = (bf16_t)l; } }
    LAS float* tile = (LAS float*)(lds + 65536);
    for (int ti = bx; ti < p.ntiles_total; ti += G) {
        int j = 0;
#pragma unroll 1
        for (int q = 1; q < NJOBS; ++q) if (ti >= p.jobs[q].tile0) j = q;
        const TJob& J = p.jobs[j];
        int l = ti - J.tile0; const int per = J.ntk * J.ntn; const int bt = l / per; l -= bt * per; const int tn = l / J.ntk, tk = l % J.ntk;
        const float* src = J.src + (size_t)bt * J.sbatch; bf16_t* dst = J.dst + (size_t)bt * J.dbatch;
        const int k0 = tk * 64, n0 = tn * 128;
        f32x4 v[4];
#pragma unroll
        for (int i = 0; i < 4; ++i) { const int r = (tid >> 5) + 16 * i, c4 = (tid & 31) * 4;
            v[i] = (f32x4){0.f, 0.f, 0.f, 0.f}; if (n0 + c4 < J.N) v[i] = *(const f32x4*)(src + (size_t)(k0 + r) * J.ld + n0 + c4); }
#pragma unroll
        for (int i = 0; i < 4; ++i) { const int r = (tid >> 5) + 16 * i, c4 = (tid & 31) * 4;
#pragma unroll
            for (int q = 0; q < 4; ++q) tile[r * 129 + c4 + q] = v[i][q]; }
        __syncthreads();
        { const int n = tid >> 2, kq = (tid & 3) * 16;
          if (n0 + n < J.N) { float f[16];
#pragma unroll
              for (int q = 0; q < 16; ++q) f[q] = tile[(kq + q) * 129 + n];
              u32x4 w0, w1; w0.x = cvt_pk_bf16(f[0], f[1]); w0.y = cvt_pk_bf16(f[2], f[3]); w0.z = cvt_pk_bf16(f[4], f[5]); w0.w = cvt_pk_bf16(f[6], f[7]);
              w1.x = cvt_pk_bf16(f[8], f[9]); w1.y = cvt_pk_bf16(f[10], f[11]); w1.z = cvt_pk_bf16(f[12], f[13]); w1.w = cvt_pk_bf16(f[14], f[15]);
              if (J.fp8) { u32x4 w8; w8.x = pack_fp8x4(f[0] * 64.f, f[1] * 64.f, f[2] * 64.f, f[3] * 64.f); w8.y = pack_fp8x4(f[4] * 64.f, f[5] * 64.f, f[6] * 64.f, f[7] * 64.f);
                  w8.z = pack_fp8x4(f[8] * 64.f, f[9] * 64.f, f[10] * 64.f, f[11] * 64.f); w8.w = pack_fp8x4(f[12] * 64.f, f[13] * 64.f, f[14] * 64.f, f[15] * 64.f);
                  *(u32x4*)((unsigned char*)dst + (size_t)(n0 + n) * J.ldd + k0 + kq) = w8; }
              else { bf16_t* d = dst + (size_t)map_row(J.map, n0 + n) * J.ldd + k0 + kq; *(u32x4*)d = w0; *(u32x4*)(d + 8) = w1; } } }
        __syncthreads();
    }
}

__device__ __forceinline__ void norm_row(const float* xr, const float* g, const float* sh, const float* sc, bf16_t* hr, unsigned char* h8, int lane, float (&hv)[32]) {
    f32x4 v[8]; float ss = 0.f;
#pragma unroll
    for (int i = 0; i < 8; ++i) { v[i] = *(const f32x4*)(xr + i * 256 + lane * 4); ss += v[i][0] * v[i][0] + v[i][1] * v[i][1] + v[i][2] * v[i][2] + v[i][3] * v[i][3]; }
    ss = wave_sum(ss);
    const float rstd = rsqrtf(ss * (1.0f / 2048.0f) + RMS_EPS);
#pragma unroll
    for (int i = 0; i < 8; ++i) { const int col = i * 256 + lane * 4; const f32x4 gg = *(const f32x4*)(g + col), s1 = *(const f32x4*)(sc + col), s0 = *(const f32x4*)(sh + col);
#pragma unroll
        for (int j = 0; j < 4; ++j) hv[i * 4 + j] = v[i][j] * rstd * gg[j] * (1.0f + s1[j]) + s0[j];
        u32x2 w; w.x = cvt_pk_bf16(hv[i * 4], hv[i * 4 + 1]); w.y = cvt_pk_bf16(hv[i * 4 + 2], hv[i * 4 + 3]); *(u32x2*)(hr + col) = w;
        if (h8) *(unsigned*)(h8 + col) = pack_fp8x4(hv[i * 4], hv[i * 4 + 1], hv[i * 4 + 2], hv[i * 4 + 3]); }
}
__device__ void ph1_norm(const Params& p) {
    const int lane = threadIdx.x & 63, gw = blockIdx.x * 8 + (threadIdx.x >> 6), nw = gridDim.x * 8;
    const float* mod = (const float*)(p.ws + WS_MOD);
    for (int t = gw; t < NTOK; t += nw) { const int b = t >> 11; float hv[32];
        norm_row(p.in[I_X] + (size_t)t * DM, p.in[I_GMIX], mod + b * 12288, mod + b * 12288 + 2048, (bf16_t*)(p.ws + WS_H) + (size_t)t * DM, (unsigned char*)(p.ws + WS_HF8) + (size_t)t * DM, lane, hv); }
}

template <int MB, int NB, int KS>
__device__ __forceinline__ void wave_gemm(const bf16_t* A, int lda, const bf16_t* Bt, int ldb, f32x4 (&acc)[MB][NB], int lane) {
    const int fr = lane & 15, fq = lane >> 4;
#pragma unroll
    for (int mb = 0; mb < MB; ++mb)
#pragma unroll
        for (int nb = 0; nb < NB; ++nb) acc[mb][nb] = (f32x4){0.f, 0.f, 0.f, 0.f};
#pragma unroll 1
    for (int ks = 0; ks < KS; ++ks) {
        bf16x8 af[MB];
#pragma unroll
        for (int mb = 0; mb < MB; ++mb) af[mb] = *(const bf16x8*)(A + (size_t)(mb * 16 + fr) * lda + ks * 32 + fq * 8);
#pragma unroll
        for (int nb = 0; nb < NB; ++nb) { const bf16x8 bf = *(const bf16x8*)(Bt + (size_t)(nb * 16 + fr) * ldb + ks * 32 + fq * 8);
#pragma unroll
            for (int mb = 0; mb < MB; ++mb) acc[mb][nb] = __builtin_amdgcn_mfma_f32_16x16x32_bf16(bf, af[mb], acc[mb][nb], 0, 0, 0); }
    }
}


__device__ __forceinline__ int wave_total_i32(int v) {
    v += __builtin_amdgcn_update_dpp(0, v, 0x111, 0xf, 0xf, true); v += __builtin_amdgcn_update_dpp(0, v, 0x112, 0xf, 0xf, true);
    v += __builtin_amdgcn_update_dpp(0, v, 0x114, 0xf, 0xf, true); v += __builtin_amdgcn_update_dpp(0, v, 0x118, 0xf, 0xf, true);
    v += __builtin_amdgcn_update_dpp(0, v, 0x142, 0xa, 0xf, false); v += __builtin_amdgcn_update_dpp(0, v, 0x143, 0xc, 0xf, false);
    return __builtin_amdgcn_readlane(v, 63);
}
template <int NI> __device__ __forceinline__ void topk_words2(const LAS float* srow0, const LAS float* srow1, int c, int lane, unsigned long long& w0, unsigned long long& w1) {
    unsigned ka[NI], kb[NI];
#pragma unroll
    for (int i = 0; i < NI; ++i) { unsigned u = 0u, x = 0u; if (i <= c) { u = __float_as_uint(srow0[i * 64 + lane]); u = (u & 0x80000000u) ? ~u : (u | 0x80000000u);
            x = __float_as_uint(srow1[i * 64 + lane]); x = (x & 0x80000000u) ? ~x : (x | 0x80000000u); } ka[i] = u; kb[i] = x; }
    unsigned va = 0u, vb = 0u; bool da = false, db = false;
#pragma unroll 1
    for (int bit = 31; bit >= 0; --bit) {
        const unsigned ca = va | (1u << bit), cb = vb | (1u << bit); int a0 = 0, a1 = 0, b0 = 0, b1 = 0;
#pragma unroll
        for (int i = 0; i < NI; i += 2) { a0 += (ka[i] >= ca) ? 1 : 0; a1 += (ka[i + 1] >= ca) ? 1 : 0; b0 += (kb[i] >= cb) ? 1 : 0; b1 += (kb[i + 1] >= cb) ? 1 : 0; }
        const int ta = wave_total_i32(a0 + a1), tb = wave_total_i32(b0 + b1);
        if (!da && ta >= 256) { va = ca; da = (ta == 256); }
        if (!db && tb >= 256) { vb = cb; db = (tb == 256); }
        if (da && db) break;
    }
    w0 = 0ull; w1 = 0ull;
#pragma unroll
    for (int i = 0; i < NI; ++i) { const unsigned long long ma = __ballot(ka[i] >= va), mb = __ballot(kb[i] >= vb); if (lane == i) { w0 = ma; w1 = mb; } if ((i & 3) == 3) SBAR(); }
}

__device__ void idx_item(const Params& p, LAS unsigned char* lds, int b, int c, int sub) {
    const int tid = threadIdx.x, wid = tid >> 6, lane = tid & 63, fr = lane & 15, fq = lane >> 4;
    constexpr int SCLD = 2052;
    LAS float* sc = (LAS float*)lds;
    const int q0 = c * 64 + sub * 16, nk = (c + 1) * 64, nkb = nk / 16;
    const bf16_t* qidx = (const bf16_t*)(p.ws + WS_QIDX) + (size_t)(b * SEQ + q0 + fr) * 1024;
    const float* misc = (const float*)(p.ws + WS_MISC);
    float wq[16];
    { const float* wp = misc + (size_t)(b * SEQ + q0 + fr) * 256 + 64;
#pragma unroll
      for (int i = 0; i < 4; ++i) { const f32x4 v = *(const f32x4*)(wp + i * 4); wq[i * 4] = v[0]; wq[i * 4 + 1] = v[1]; wq[i * 4 + 2] = v[2]; wq[i * 4 + 3] = v[3]; } }
    {
        bf16x8 qf[16][2];
#pragma unroll
        for (int h = 0; h < 16; ++h)
#pragma unroll
            for (int ks = 0; ks < 2; ++ks) qf[h][ks] = *(const bf16x8*)(qidx + h * 64 + ks * 32 + fq * 8);
        const bf16_t* kbase = (const bf16_t*)(p.ws + WS_KIDX) + (size_t)(b * SEQ + fr) * 64 + fq * 8;
        bf16x8 kf[2];
        if (wid < nkb) { kf[0] = *(const bf16x8*)(kbase + (size_t)wid * 16 * 64); kf[1] = *(const bf16x8*)(kbase + (size_t)wid * 16 * 64 + 32); }
#pragma unroll 1
        for (int kb = wid; kb < nkb; kb += 8) {
            const int kn = kb + 8 < nkb ? kb + 8 : kb;
            const bf16x8 kn0 = *(const bf16x8*)(kbase + (size_t)kn * 16 * 64), kn1 = *(const bf16x8*)(kbase + (size_t)kn * 16 * 64 + 32);
            f32x4 s = {0.f, 0.f, 0.f, 0.f};
#pragma unroll
            for (int h = 0; h < 16; ++h) {
                f32x4 a = {0.f, 0.f, 0.f, 0.f};
                a = __builtin_amdgcn_mfma_f32_16x16x32_bf16(kf[0], qf[h][0], a, 0, 0, 0);
                a = __builtin_amdgcn_mfma_f32_16x16x32_bf16(kf[1], qf[h][1], a, 0, 0, 0);
#pragma unroll
                for (int j = 0; j < 4; ++j) s[j] += wq[h] * fmaxf(a[j], 0.f);
            }
            *(LAS f32x4*)(sc + fr * SCLD + kb * 16 + fq * 4) = s;
            kf[0] = kn0; kf[1] = kn1;
        }
    }
    __syncthreads();
    unsigned long long* mask = (unsigned long long*)(p.ws + WS_MASK);
    {
        const int ql = wid * 2; const size_t qg = (size_t)b * SEQ + q0 + ql;
        unsigned long long w0 = 0ull, w1 = 0ull;
        if (nk <= 256) { if (lane <= c) { w0 = ~0ull; w1 = ~0ull; } }
        else { const LAS float* s0 = sc + ql * SCLD; const LAS float* s1 = s0 + SCLD;
            if (c < 8) topk_words2<8>(s0, s1, c, lane, w0, w1); else if (c < 16) topk_words2<16>(s0, s1, c, lane, w0, w1);
            else if (c < 24) topk_words2<24>(s0, s1, c, lane, w0, w1); else topk_words2<32>(s0, s1, c, lane, w0, w1); }
        if (lane < 32) { mask[qg * 32 + lane] = w0; mask[(qg + 1) * 32 + lane] = w1; }
    }
    __syncthreads();
}
#ifndef REP_SUB
#define REP_SUB 15
#endif
__device__ void ph3_prep(const Params& p, LAS unsigned char* lds, const int rep) {
#define P3ON(bit) (!rep || ((REP_SUB) & (bit)))
    const int tid = threadIdx.x, wid = tid >> 6, lane = tid & 63, bx = blockIdx.x, G = gridDim.x;
    if (P3ON(1)) for (int it = bx; it < 256; it += G) {
        const int b = it >> 6, r = it & 63, cp = r >> 2, sub = r & 3;
        idx_item(p, lds, b, 31 - cp, sub); idx_item(p, lds, b, cp, sub);
    }
    const int gw = bx * 8 + wid, nw = G * 8;
    if (P3ON(2)) for (int it = gw; it < 2048; it += nw) {
        const int rt = it >> 3, h = it & 7, fr = lane & 15, fq = lane >> 4;
        f32x4 acc[2][16];
        wave_gemm<2, 16, 4>((const bf16_t*)(p.ws + WS_QA) + (size_t)rt * 32 * 1024 + h * 128, 1024, (const bf16_t*)(p.ws + WS_WUK) + (size_t)h * 256 * 128, 128, acc, lane);
#pragma unroll
        for (int mb = 0; mb < 2; ++mb) { float ss = 0.f;
#pragma unroll
            for (int nb = 0; nb < 16; ++nb)
#pragma unroll
                for (int j = 0; j < 4; ++j) ss += acc[mb][nb][j] * acc[mb][nb][j];
            ss += __shfl_xor(ss, 16); ss += __shfl_xor(ss, 32);
            const float rs = rsqrtf(ss * (1.0f / 256.0f) + RMS_EPS) * 0.0625f;
            bf16_t* o = (bf16_t*)(p.ws + WS_QLAT) + (size_t)(rt * 32 + mb * 16 + fr) * 2048 + h * 256;
#pragma unroll
            for (int nb = 0; nb < 16; ++nb) { const int col = nb * 16 + fq * 4; const f32x4 g = *(const f32x4*)(p.in[I_GQA] + col);
                u32x2 w; w.x = cvt_pk_bf16(acc[mb][nb][0] * rs * g[0], acc[mb][nb][1] * rs * g[1]); w.y = cvt_pk_bf16(acc[mb][nb][2] * rs * g[2], acc[mb][nb][3] * rs * g[3]); *(u32x2*)(o + col) = w; } }
    }
    if (P3ON(4))
#pragma unroll 4
    for (int t = gw; t < NTOK; t += nw) {
        { const f32x4 v = *(const f32x4*)((const float*)(p.ws + WS_CKV) + (size_t)t * 256 + lane * 4); float ss = wave_sum(v[0] * v[0] + v[1] * v[1] + v[2] * v[2] + v[3] * v[3]);
          const float rs = rsqrtf(ss * (1.0f / 256.0f) + RMS_EPS); const f32x4 g = *(const f32x4*)(p.in[I_GKV] + lane * 4);
          u32x2 w; w.x = cvt_pk_bf16(v[0] * rs * g[0], v[1] * rs * g[1]); w.y = cvt_pk_bf16(v[2] * rs * g[2], v[3] * rs * g[3]); *(u32x2*)((bf16_t*)(p.ws + WS_KV) + (size_t)t * 256 + lane * 4) = w; }
#pragma unroll
        for (int which = 1; which < 2; ++which) {
            bf16_t* row = (bf16_t*)(p.ws + (which ? WS_KB : WS_QB)) + (size_t)t * 1024 + lane * 16; const float* g = p.in[which ? I_GKB : I_GQB] + (lane & 7) * 16;
            u32x4 a = *(u32x4*)row, c2 = *(u32x4*)(row + 8); float f[16];
            f[0] = bf_lo(a.x); f[1] = bf_hi(a.x); f[2] = bf_lo(a.y); f[3] = bf_hi(a.y); f[4] = bf_lo(a.z); f[5] = bf_hi(a.z); f[6] = bf_lo(a.w); f[7] = bf_hi(a.w);
            f[8] = bf_lo(c2.x); f[9] = bf_hi(c2.x); f[10] = bf_lo(c2.y); f[11] = bf_hi(c2.y); f[12] = bf_lo(c2.z); f[13] = bf_hi(c2.z); f[14] = bf_lo(c2.w); f[15] = bf_hi(c2.w);
            float ss = 0.f;
#pragma unroll
            for (int j = 0; j < 16; ++j) ss += f[j] * f[j];
            ss += __shfl_xor(ss, 1); ss += __shfl_xor(ss, 2); ss += __shfl_xor(ss, 4);
            const float rs = rsqrtf(ss * (1.0f / 128.0f) + RMS_EPS) * (which ? 1.0f : 0.08838834764831845f);
#pragma unroll
            for (int j = 0; j < 16; ++j) f[j] *= rs * g[j];
            a.x = cvt_pk_bf16(f[0], f[1]); a.y = cvt_pk_bf16(f[2], f[3]); a.z = cvt_pk_bf16(f[4], f[5]); a.w = cvt_pk_bf16(f[6], f[7]);
            c2.x = cvt_pk_bf16(f[8], f[9]); c2.y = cvt_pk_bf16(f[10], f[11]); c2.z = cvt_pk_bf16(f[12], f[13]); c2.w = cvt_pk_bf16(f[14], f[15]);
            if (!rep) { *(u32x4*)row = a; *(u32x4*)(row + 8) = c2; } else if (a.x == 0x12345678u) *(u32x4*)row = c2;
        }
    }
    if (P3ON(8) && bx < NBATCH) {
        const int b = bx; const float* fp = (const float*)(p.ws + WS_MISC) + (size_t)(b * SEQ + 4 * tid) * 256 + 80;
        float ls[4][8];
#pragma unroll
        for (int j = 0; j < 4; ++j) { const f32x4 a = *(const f32x4*)(fp + j * 256), c4 = *(const f32x4*)(fp + j * 256 + 4);
#pragma unroll
            for (int h = 0; h < 8; ++h) { const float z = (h < 4 ? a[h & 3] : c4[h & 3]) + p.in[I_BFORGET][h]; ls[j][h] = fminf(z, 0.f) - log1pf(__expf(-fabsf(z))); } }
        LAS float* wt = (LAS float*)lds;
        float off[8];
#pragma unroll
        for (int h = 0; h < 8; ++h) { ls[1][h] += ls[0][h]; ls[2][h] += ls[1][h]; ls[3][h] += ls[2][h];
            float incl = ls[3][h];
#pragma unroll
            for (int o = 1; o < 64; o <<= 1) { const float t2 = __shfl_up(incl, o); if (lane >= o) incl += t2; }
            if (lane == 63) wt[wid * 8 + h] = incl;
            off[h] = incl - ls[3][h]; }
        __syncthreads();
#pragma unroll
        for (int h = 0; h < 8; ++h) { float wo = 0.f; for (int w8 = 0; w8 < wid; ++w8) wo += wt[w8 * 8 + h];
            float* cp = (float*)(p.ws + WS_CUM) + (size_t)(b * 8 + h) * SEQ + 4 * tid;
            *(f32x4*)cp = (f32x4){ls[0][h] + off[h] + wo, ls[1][h] + off[h] + wo, ls[2][h] + off[h] + wo, ls[3][h] + off[h] + wo}; }
        __syncthreads();
    }
}

template <int OFF> __device__ __forceinline__ s16x4 tr_read(int vb) { s16x4 r; asm volatile("ds_read_b64_tr_b16 %0, %1 offset:%2" : "=&v"(r) : "v"(vb), "i"(OFF) : "memory"); return r; }
__device__ __forceinline__ int v_rd_base(int lane) { return ((lane & 3) << 3) | (((lane >> 2) & 3) << 6) | (((lane >> 4) & 1) << 5) | (((lane >> 5) & 1) << 8); }
#define PK4(P, BASE, OUT) do { unsigned a0 = cvt_pk_bf16(P[BASE + 0], P[BASE + 1]), a1 = cvt_pk_bf16(P[BASE + 2], P[BASE + 3]);   \
    unsigned b0 = cvt_pk_bf16(P[BASE + 4], P[BASE + 5]), b1 = cvt_pk_bf16(P[BASE + 6], P[BASE + 7]);                              \
    auto r0 = __builtin_amdgcn_permlane32_swap(a0, b0, false, false); auto r1 = __builtin_amdgcn_permlane32_swap(a1, b1, false, false); \
    u32x4 w = {r0[0], r1[0], r0[1], r1[1]}; OUT = *reinterpret_cast<bf16x8*>(&w); } while (0)
#define PKV(L, H) (bf16x8){L[0], L[1], L[2], L[3], H[0], H[1], H[2], H[3]}
template <int NCB, int KS0, int D0> struct PvPairs { static __device__ __forceinline__ void run(f32x16* o, int vb, bf16x8 pa0, bf16x8 pa1) {
    constexpr int S = 2 * NCB * 512, H = NCB * 512;
    const s16x4 l00 = tr_read<D0 * 512 + KS0 * S>(vb), h00 = tr_read<D0 * 512 + KS0 * S + H>(vb), l01 = tr_read<D0 * 512 + (KS0 + 1) * S>(vb), h01 = tr_read<D0 * 512 + (KS0 + 1) * S + H>(vb);
    const s16x4 l10 = tr_read<(D0 + 1) * 512 + KS0 * S>(vb), h10 = tr_read<(D0 + 1) * 512 + KS0 * S + H>(vb), l11 = tr_read<(D0 + 1) * 512 + (KS0 + 1) * S>(vb), h11 = tr_read<(D0 + 1) * 512 + (KS0 + 1) * S + H>(vb);
    asm volatile("s_waitcnt lgkmcnt(0)" ::: "memory"); SBAR();
    o[D0] = __builtin_amdgcn_mfma_f32_32x32x16_bf16(pa0, PKV(l00, h00), o[D0], 0, 0, 0); o[D0 + 1] = __builtin_amdgcn_mfma_f32_32x32x16_bf16(pa0, PKV(l10, h10), o[D0 + 1], 0, 0, 0);
    o[D0] = __builtin_amdgcn_mfma_f32_32x32x16_bf16(pa1, PKV(l01, h01), o[D0], 0, 0, 0); o[D0 + 1] = __builtin_amdgcn_mfma_f32_32x32x16_bf16(pa1, PKV(l11, h11), o[D0 + 1], 0, 0, 0);
    if constexpr (D0 + 2 < NCB) PvPairs<NCB, KS0, D0 + 2>::run(o, vb, pa0, pa1); } };
__device__ __forceinline__ int swap23(int k) { return (k & ~0xC) | ((k & 4) << 1) | ((k & 8) >> 1); }
constexpr int FOX_STAGE = 33024;
constexpr int FOX_AL = 2 * FOX_STAGE, FOX_LI = FOX_AL + 1024;
__device__ void fox_item(const Params& p, LAS unsigned char* lds, int b, int h, int qb) {
    int tid = threadIdx.x; asm volatile("" : "+v"(tid));
    const int wid = __builtin_amdgcn_readfirstlane(tid >> 6), lane = tid & 63, r32 = lane & 31, hi = lane >> 5;
    const bf16_t* Q = (const bf16_t*)(p.ws + WS_QB);
    const char* Kg = (const char*)(p.ws + WS_KB) + ((size_t)b * SEQ * 1024 + h * 128) * 2; const char* Vg = (const char*)(p.ws + WS_VB) + ((size_t)b * SEQ * 1024 + h * 128) * 2;
    const float* cum = (const float*)(p.ws + WS_CUM) + (size_t)(b * 8 + h) * SEQ;
    const int qpos = qb * 256 + wid * 32 + r32;
    bf16x8 qr[8];
    { const bf16_t* qp = Q + (size_t)(b * SEQ + qpos) * 1024 + h * 128 + hi * 8;
#pragma unroll
      for (int d0 = 0; d0 < 8; ++d0) qr[d0] = *(const bf16x8*)(qp + d0 * 16);
      float ss = 0.f;
#pragma unroll
      for (int d0 = 0; d0 < 8; ++d0) { const u32x4 w = *reinterpret_cast<const u32x4*>(&qr[d0]);
#pragma unroll
          for (int j = 0; j < 4; ++j) { const float a = bf_lo(w[j]), c = bf_hi(w[j]); ss += a * a + c * c; } }
      ss += __shfl_xor(ss, 32);
      const float rs = rsqrtf(ss * (1.0f / 128.0f) + RMS_EPS) * 0.08838834764831845f;
      const float* g = p.in[I_GQB] + hi * 8;
#pragma unroll
      for (int d0 = 0; d0 < 8; ++d0) { u32x4 w = *reinterpret_cast<const u32x4*>(&qr[d0]); const f32x4 g0 = *(const f32x4*)(g + d0 * 16), g1 = *(const f32x4*)(g + d0 * 16 + 4);
          w[0] = cvt_pk_bf16(bf_lo(w[0]) * (rs * g0[0]), bf_hi(w[0]) * (rs * g0[1])); w[1] = cvt_pk_bf16(bf_lo(w[1]) * (rs * g0[2]), bf_hi(w[1]) * (rs * g0[3]));
          w[2] = cvt_pk_bf16(bf_lo(w[2]) * (rs * g1[0]), bf_hi(w[2]) * (rs * g1[1])); w[3] = cvt_pk_bf16(bf_lo(w[3]) * (rs * g1[2]), bf_hi(w[3]) * (rs * g1[3]));
          qr[d0] = *reinterpret_cast<bf16x8*>(&w); } }
    const float cq = cum[qpos] * LOG2E;
    unsigned ksrc[2], vsrc[2];
#pragma unroll
    for (int i = 0; i < 2; ++i) { const int pos = (i * 512 + tid) * 16;
        { const int row = pos >> 8; const int cb = (pos & 255) ^ ((row & 7) << 4); ksrc[i] = (unsigned)(row * 2048 + cb); }
        { const int sub = pos >> 9, within = pos & 511; const int kk = (sub >> 2) * 8 + (within >> 6); const int c = (sub & 3) * 32 + ((within & 63) >> 1); vsrc[i] = (unsigned)(swap23(kk) * 2048 + c * 2); } }
    float m_reg = -1e30f, l_reg = 0.f; f32x16 o[4];
#pragma unroll
    for (int d = 0; d < 4; ++d)
#pragma unroll
        for (int r = 0; r < 16; ++r) o[d][r] = 0.f;
    LAS float* al_l = (LAS float*)(lds + FOX_AL) + wid * 32; LAS float* li_l = (LAS float*)(lds + FOX_LI) + wid * 32;
    const int ntiles = qb * 4 + 4, mylast = qb * 4 + (wid >> 1);
#define FOX_DMA(kt) do { LAS unsigned char* sb_ = lds + ((kt) & 1) * FOX_STAGE; const size_t go_ = (size_t)(kt) * 64 * 2048; \
        _Pragma("unroll") for (int i = 0; i < 2; ++i) { \
            __builtin_amdgcn_global_load_lds((const unsigned*)(Kg + go_ + ksrc[i]), (LAS unsigned*)(sb_ + 16384 + (i * 512 + wid * 64) * 16), 16, 0, 0); \
            __builtin_amdgcn_global_load_lds((const unsigned*)(Vg + go_ + vsrc[i]), (LAS unsigned*)(sb_ + (i * 512 + wid * 64) * 16), 16, 0, 0); } \
        if (wid == 0) __builtin_amdgcn_global_load_lds((const unsigned*)(cum + (kt) * 64 + lane), (LAS unsigned*)(sb_ + 32768), 4, 0, 0); } while (0)
    __syncthreads();
    FOX_DMA(0);
    for (int kt = 0; kt < ntiles; ++kt) {
        asm volatile("s_waitcnt vmcnt(0)" ::: "memory");
        __syncthreads();
        if (kt + 1 < ntiles) FOX_DMA(kt + 1);
        if (kt <= mylast) {
            const LAS unsigned char* sb = lds + (kt & 1) * FOX_STAGE; const LAS float* ck = (const LAS float*)(sb + 32768);
            const int vb = (int)(uintptr_t)sb + v_rd_base(lane);
            f32x16 p0, p1;
#pragma unroll
            for (int r = 0; r < 16; ++r) { p0[r] = 0.f; p1[r] = 0.f; }
            int fsw = (r32 & 7) << 4; asm volatile("" : "+v"(fsw));
#pragma unroll
            for (int d0 = 0; d0 < 8; ++d0) { const int cb = (d0 * 16 + hi * 8) * 2;
                const bf16x8 b0 = *(const LAS bf16x8*)(sb + 16384 + r32 * 256 + (cb ^ fsw));
                const bf16x8 b1 = *(const LAS bf16x8*)(sb + 16384 + (32 + r32) * 256 + (cb ^ fsw));
                p0 = __builtin_amdgcn_mfma_f32_32x32x16_bf16(b0, qr[d0], p0, 0, 0, 0); p1 = __builtin_amdgcn_mfma_f32_32x32x16_bf16(b1, qr[d0], p1, 0, 0, 0); }
            const bool diag = (kt * 64 + 63 > qb * 256 + wid * 32);
            float pmax = -INFINITY;
#pragma unroll
            for (int g4 = 0; g4 < 4; ++g4) { const f32x4 c0 = *(const LAS f32x4*)(ck + 8 * g4 + 4 * hi), c1 = *(const LAS f32x4*)(ck + 32 + 8 * g4 + 4 * hi);
#pragma unroll
                for (int j = 0; j < 4; ++j) { const int r = g4 * 4 + j; float t0 = fmaf(p0[r], LOG2E, cq) - c0[j] * LOG2E, t1 = fmaf(p1[r], LOG2E, cq) - c1[j] * LOG2E;
                    if (diag) { const int kp = kt * 64 + crow(r, hi); if (kp > qpos) t0 = -INFINITY; if (kp + 32 > qpos) t1 = -INFINITY; }
                    p0[r] = t0; p1[r] = t1; pmax = fmaxf(pmax, fmaxf(t0, t1)); } }
            { auto rr = __builtin_amdgcn_permlane32_swap(__float_as_uint(pmax), __float_as_uint(pmax), false, false); pmax = fmaxf(__uint_as_float(rr[0]), __uint_as_float(rr[1])); }
            const float mn = fmaxf(m_reg, pmax); const float alpha = __builtin_amdgcn_exp2f(m_reg - mn); m_reg = mn;
            float ps = 0.f;
#pragma unroll
            for (int r = 0; r < 16; ++r) { p0[r] = __builtin_amdgcn_exp2f(p0[r] - mn); p1[r] = __builtin_amdgcn_exp2f(p1[r] - mn); ps += p0[r] + p1[r]; }
            { auto rr = __builtin_amdgcn_permlane32_swap(__float_as_uint(ps), __float_as_uint(ps), false, false); ps = __uint_as_float(rr[0]) + __uint_as_float(rr[1]); }
            l_reg = l_reg * alpha + ps;
            if (__any(alpha < 1.f)) { if (hi == 0) al_l[r32] = alpha; asm volatile("s_waitcnt lgkmcnt(0)" ::: "memory");
#pragma unroll
                for (int r = 0; r < 16; ++r) { const float a = al_l[crow(r, hi)];
#pragma unroll
                    for (int d = 0; d < 4; ++d) o[d][r] *= a; } }
            bf16x8 pa0, pa1, pa2, pa3; PK4(p0, 0, pa0); PK4(p0, 8, pa1); PK4(p1, 0, pa2); PK4(p1, 8, pa3);
            PvPairs<4, 0, 0>::run(o, vb, pa0, pa1); PvPairs<4, 2, 0>::run(o, vb, pa2, pa3);
        }
    }
#undef FOX_DMA
    if (hi == 0) li_l[r32] = l_reg; asm volatile("s_waitcnt lgkmcnt(0)" ::: "memory");
    unsigned char* O8 = (unsigned char*)(p.ws + WS_OB8) + (size_t)(b * SEQ + qb * 256 + wid * 32) * 1024 + h * 128;
#pragma unroll
    for (int r = 0; r < 16; ++r) { const float rl = __builtin_amdgcn_rcpf(li_l[crow(r, hi)]); const int orow = crow(r, hi);
#pragma unroll
        for (int d0 = 0; d0 < 4; ++d0) O8[(size_t)orow * 1024 + d0 * 32 + r32] = (unsigned char)(pack_fp8x4(o[d0][r] * rl * 8.f, 0.f, 0.f, 0.f) & 0xffu); }
}

constexpr int DSA_STAGE = 32768;
constexpr int DSA_AL = 2 * DSA_STAGE, DSA_LI = DSA_AL + 1024, DSA_Q = DSA_LI + 1024;
__device__ void dsa_item(const Params& p, LAS unsigned char* lds, int b, int qt) {
    int tid = threadIdx.x; asm volatile("" : "+v"(tid));
    const int wid = __builtin_amdgcn_readfirstlane(tid >> 6), lane = tid & 63, r32 = lane & 31, hi = lane >> 5, h = wid;
    const char* KV = (const char*)(p.ws + WS_KV) + (size_t)b * SEQ * 512;
    const int qpos = qt * 32 + r32; const size_t qg = (size_t)b * SEQ + qpos;
    const unsigned* mask = (const unsigned*)(p.ws + WS_MASK) + qg * 64;
    bf16x8 qr[8];
    LAS unsigned char* qlds = lds + DSA_Q + wid * 8192 + lane * 16;
    __syncthreads();
    { const bf16_t* qp = (const bf16_t*)(p.ws + WS_QLAT) + qg * 2048 + h * 256 + hi * 8;
#pragma unroll
      for (int d0 = 0; d0 < 8; ++d0) qr[d0] = *(const bf16x8*)(qp + d0 * 16);
#pragma unroll
      for (int d0 = 8; d0 < 16; ++d0) *(LAS bf16x8*)(qlds + (d0 - 8) * 1024) = *(const bf16x8*)(qp + d0 * 16); }
    unsigned ksrc[2], vsrc[2];
#pragma unroll
    for (int i = 0; i < 2; ++i) { const int pos = (i * 512 + tid) * 16;
        { const int row = pos >> 9; const int cb = (pos & 511) ^ ((row & 15) << 4); ksrc[i] = (unsigned)(row * 512 + cb); }
        { const int sub = pos >> 9, within = pos & 511; const int kk = (sub >> 3) * 8 + (within >> 6); const int c = (sub & 7) * 32 + ((within & 63) >> 1); vsrc[i] = (unsigned)(swap23(kk) * 512 + c * 2); } }
    const float slopeL = exp2f(-(float)(h + 1)) * LOG2E;
    float m_reg = -1e30f, l_reg = 0.f; f32x16 o[8];
#pragma unroll
    for (int d = 0; d < 8; ++d)
#pragma unroll
        for (int r = 0; r < 16; ++r) o[d][r] = 0.f;
    LAS float* al_l = (LAS float*)(lds + DSA_AL) + wid * 32; LAS float* li_l = (LAS float*)(lds + DSA_LI) + wid * 32;
    const int ntiles = ((qt >> 1) + 1) * 2;
#define DSA_DMA(kt) do { LAS unsigned char* sb_ = lds + ((kt) & 1) * DSA_STAGE; const size_t go_ = (size_t)(kt) * 32 * 512; \
        _Pragma("unroll") for (int i = 0; i < 2; ++i) { \
            __builtin_amdgcn_global_load_lds((const unsigned*)(KV + go_ + ksrc[i]), (LAS unsigned*)(sb_ + 16384 + (i * 512 + wid * 64) * 16), 16, 0, 0); \
            __builtin_amdgcn_global_load_lds((const unsigned*)(KV + go_ + vsrc[i]), (LAS unsigned*)(sb_ + (i * 512 + wid * 64) * 16), 16, 0, 0); } } while (0)
    unsigned mw = mask[0];
    DSA_DMA(0);
    for (int kt = 0; kt < ntiles; ++kt) {
        asm volatile("s_waitcnt vmcnt(0)" ::: "memory");
        __syncthreads();
        const unsigned mcur = mw;
        if (kt + 1 < ntiles) { mw = mask[kt + 1]; DSA_DMA(kt + 1); }
        const LAS unsigned char* sb = lds + (kt & 1) * DSA_STAGE; const int vb = (int)(uintptr_t)sb + v_rd_base(lane);
        f32x16 pp;
#pragma unroll
        for (int r = 0; r < 16; ++r) pp[r] = 0.f;
        {
            const LAS unsigned char* kb_ = sb + 16384 + r32 * 512; int sw_ = (r32 & 15) << 4; asm volatile("" : "+v"(sw_));
#define DSA_KF(d0) (*(const LAS bf16x8*)(kb_ + ((((d0) * 16 + hi * 8) * 2) ^ sw_)))
#define DSA_QF(d0) ((d0) < 8 ? qr[(d0) & 7] : *(const LAS bf16x8*)(qlds + (((d0) - 8) & 7) * 1024))
            bf16x8 k0 = DSA_KF(0), k1 = DSA_KF(1), q0 = DSA_QF(0), q1 = DSA_QF(1);
#pragma unroll
            for (int d0 = 0; d0 < 16; d0 += 2) {
                bf16x8 nk0 = k0, nk1 = k1, nq0 = q0, nq1 = q1;
                if (d0 + 2 < 16) { nk0 = DSA_KF(d0 + 2); nk1 = DSA_KF(d0 + 3); nq0 = DSA_QF(d0 + 2); nq1 = DSA_QF(d0 + 3); }
                pp = __builtin_amdgcn_mfma_f32_32x32x16_bf16(k0, q0, pp, 0, 0, 0); pp = __builtin_amdgcn_mfma_f32_32x32x16_bf16(k1, q1, pp, 0, 0, 0);
                k0 = nk0; k1 = nk1; q0 = nq0; q1 = nq1; SBAR();
            }
#undef DSA_KF
#undef DSA_QF
        }
        const unsigned wsh = mcur >> (4 * hi);
        const float df = (float)(qpos - (kt * 32 + 4 * hi));
        float pmax = -INFINITY;
#pragma unroll
        for (int r = 0; r < 16; ++r) { const int cb = (r & 3) + 8 * (r >> 2); const float dd = df - (float)cb;
            float t = fmaf(-slopeL, fabsf(dd), pp[r] * LOG2E); if (!((wsh >> cb) & 1u)) t = -INFINITY; pp[r] = t; pmax = fmaxf(pmax, t); }
        { auto rr = __builtin_amdgcn_permlane32_swap(__float_as_uint(pmax), __float_as_uint(pmax), false, false); pmax = fmaxf(__uint_as_float(rr[0]), __uint_as_float(rr[1])); }
        const float mn = fmaxf(m_reg, pmax); const float alpha = __builtin_amdgcn_exp2f(m_reg - mn); m_reg = mn;
        float ps = 0.f;
#pragma unroll
        for (int r = 0; r < 16; ++r) { pp[r] = __builtin_amdgcn_exp2f(pp[r] - mn); ps += pp[r]; }
        { auto rr = __builtin_amdgcn_permlane32_swap(__float_as_uint(ps), __float_as_uint(ps), false, false); ps = __uint_as_float(rr[0]) + __uint_as_float(rr[1]); }
        l_reg = l_reg * alpha + ps;
        if (__any(alpha < 1.f)) { if (hi == 0) al_l[r32] = alpha; asm volatile("s_waitcnt lgkmcnt(0)" ::: "memory");
#pragma unroll
            for (int r = 0; r < 16; ++r) { const float a = al_l[crow(r, hi)];
#pragma unroll
                for (int d = 0; d < 8; ++d) o[d][r] *= a; } }
        bf16x8 pa0, pa1; PK4(pp, 0, pa0); PK4(pp, 8, pa1);
        PvPairs<8, 0, 0>::run(o, vb, pa0, pa1);
    }
#undef DSA_DMA
    if (hi == 0) li_l[r32] = l_reg; asm volatile("s_waitcnt lgkmcnt(0)" ::: "memory");
    float rl[16];
#pragma unroll
    for (int r = 0; r < 16; ++r) rl[r] = __builtin_amdgcn_rcpf(li_l[crow(r, hi)]);
    __syncthreads();
    LAS bf16_t* os = (LAS bf16_t*)(lds + wid * 16896);
#pragma unroll
    for (int r = 0; r < 16; ++r)
#pragma unroll
        for (int d0 = 0; d0 < 8; ++d0) os[crow(r, hi) * 264 + d0 * 32 + r32] = (bf16_t)(cvt_pk_bf16(o[d0][r] * rl[r], 0.f) & 0xffffu);
    asm volatile("s_waitcnt lgkmcnt(0)" ::: "memory");
    f32x16 ya[4];
#pragma unroll
    for (int nb = 0; nb < 4; ++nb)
#pragma unroll
        for (int r = 0; r < 16; ++r) ya[nb][r] = 0.f;
    const bf16_t* wv = (const bf16_t*)(p.ws + WS_WUV) + (size_t)(h * 128 + r32) * 256 + hi * 8;
#pragma unroll 4
    for (int ks = 0; ks < 16; ++ks) {
        const bf16x8 af = *(const LAS bf16x8*)(os + r32 * 264 + ks * 16 + hi * 8);
#pragma unroll
        for (int nb = 0; nb < 4; ++nb) { const bf16x8 wf = *(const bf16x8*)(wv + (size_t)nb * 32 * 256 + ks * 16); ya[nb] = __builtin_amdgcn_mfma_f32_32x32x16_bf16(wf, af, ya[nb], 0, 0, 0); }
    }
    unsigned char* O8 = (unsigned char*)(p.ws + WS_OA8) + ((size_t)b * SEQ + qt * 32 + r32) * 1024 + h * 128 + 4 * hi;
#pragma unroll
    for (int nb = 0; nb < 4; ++nb)
#pragma unroll
        for (int g4 = 0; g4 < 4; ++g4) *(unsigned*)(O8 + nb * 32 + g4 * 8) = pack_fp8x4(ya[nb][g4 * 4] * 8.f, ya[nb][g4 * 4 + 1] * 8.f, ya[nb][g4 * 4 + 2] * 8.f, ya[nb][g4 * 4 + 3] * 8.f);
}
__device__ void ph4_attn(const Params& p, LAS unsigned char* lds) {
    const int r = blockIdx.x;
    if (r < 256) { const int c = 31 - (r >> 3), w8 = r & 7, b = w8 >> 1, half = w8 & 1; dsa_item(p, lds, b, c * 2 + half); }
    int* qhead = (int*)(p.ws + WS_CNT) + 2048;
    LAS int* slot = (LAS int*)(lds + LDS_BARW - 16);
    for (;;) {
        __syncthreads();
        if (threadIdx.x == 0) *slot = atomicAdd(qhead, 1);
        __syncthreads();
        const int it = __builtin_amdgcn_readfirstlane(*slot);
        if (it >= 256) break;
        const int qb = 7 - (it >> 5), bh = it & 31;
        fox_item(p, lds, bh >> 3, bh & 7, qb);
    }
}

__device__ void ph8_router(const Params& p, LAS unsigned char* lds, const int rep) {
    const int tid = threadIdx.x, wid = tid >> 6, lane = tid & 63, fr = lane & 15, fq = lane >> 4;
    const float* mod = (const float*)(p.ws + WS_MOD);
    int* cnt = (int*)(p.ws + WS_CNT) + rep * 1024; int* ltok = rep ? (int*)(p.ws + WS_QLAT) : (int*)(p.ws + WS_LTOK); float* lw = rep ? (float*)(p.ws + WS_QLAT + (4u << 20)) : (float*)(p.ws + WS_LW);
    LAS unsigned char* AH = lds; LAS unsigned char* AL = lds + 65536;
    LAS float* slab = (LAS float*)lds;
    LAS float* lg = (LAS float*)(lds + 131072);
    const bf16_t* WH = (const bf16_t*)(p.ws + WS_WRH); const bf16_t* WL = (const bf16_t*)(p.ws + WS_WRL);
    for (int blk = blockIdx.x; blk < NTOK / 32; blk += gridDim.x) {
        const int t0 = blk * 32, tb = t0 + wid * 4, b = tb >> 11;
        const float* sh = mod + b * 12288 + 6144; const float* sc = mod + b * 12288 + 8192;
        u32x2 keepH[4][4], keepL[4][4];
        f32x4 xa[2][8], xb[2][8]; u32x2 ya[2][8], yb[2][8];
#define RT_LOAD(X, Y, R0) _Pragma("unroll") for (int rr = 0; rr < 2; ++rr) _Pragma("unroll") for (int i = 0; i < 8; ++i) { const size_t eo = (size_t)(tb + R0 + rr) * DM + i * 256 + lane * 4; \
            Y[rr][i] = *(const u32x2*)((const bf16_t*)(p.ws + WS_MERGED) + eo); X[rr][i] = *(const f32x4*)(p.in[I_X] + eo); }
        RT_LOAD(xa, ya, 0) RT_LOAD(xb, yb, 2)
#define RT_ROWS(X, Y, R0) do { float rstd[2]; \
        _Pragma("unroll") for (int rr = 0; rr < 2; ++rr) { float ss = 0.f; \
            _Pragma("unroll") for (int i = 0; i < 8; ++i) { X[rr][i] += (f32x4){bf_lo(Y[rr][i].x), bf_hi(Y[rr][i].x), bf_lo(Y[rr][i].y), bf_hi(Y[rr][i].y)};        \
                ss += X[rr][i][0] * X[rr][i][0] + X[rr][i][1] * X[rr][i][1] + X[rr][i][2] * X[rr][i][2] + X[rr][i][3] * X[rr][i][3]; } \
            rstd[rr] = rsqrtf(wave_sum(ss) * (1.0f / 2048.0f) + RMS_EPS); } \
        _Pragma("unroll") for (int i = 0; i < 8; ++i) { int cl = lane * 4; asm volatile("" : "+v"(cl)); const int col = i * 256 + cl; const f32x4 gg = *(const f32x4*)(p.in[I_GFFN] + col), s1 = *(const f32x4*)(sc + col), s0 = *(const f32x4*)(sh + col); \
            _Pragma("unroll") for (int rr = 0; rr < 2; ++rr) { float hv[4], lo[4]; const int r = wid * 4 + R0 + rr; \
                _Pragma("unroll") for (int j = 0; j < 4; ++j) hv[j] = X[rr][i][j] * rstd[rr] * gg[j] * (1.0f + s1[j]) + s0[j]; \
                u32x2 wh; wh.x = cvt_pk_bf16(hv[0], hv[1]); wh.y = cvt_pk_bf16(hv[2], hv[3]); \
                lo[0] = hv[0] - bf_lo(wh.x); lo[1] = hv[1] - bf_hi(wh.x); lo[2] = hv[2] - bf_lo(wh.y); lo[3] = hv[3] - bf_hi(wh.y); \
                u32x2 wl; wl.x = cvt_pk_bf16(lo[0], lo[1]); wl.y = cvt_pk_bf16(lo[2], lo[3]); \
                if (i < 4) { int l1 = lane >> 1; asm volatile("" : "+v"(l1)); const int ad = r * 2048 + (((i * 32 + l1) ^ r) * 16) + (lane & 1) * 8; *(LAS u32x2*)(AH + ad) = wh; *(LAS u32x2*)(AL + ad) = wl; } \
                else { keepH[R0 + rr][i - 4] = wh; keepL[R0 + rr][i - 4] = wl; } \
                *(unsigned*)(p.ws + WS_H8 + (size_t)(tb + R0 + rr) * DM + col) = pack_fp8x4(hv[0], hv[1], hv[2], hv[3]); } } } while (0)
        RT_ROWS(xa, ya, 0); RT_ROWS(xb, yb, 2);
#undef RT_LOAD
#undef RT_ROWS
        const int kq = wid & 3, ng = wid >> 2, nb0 = ng * 3;
        f32x4 acc[2][3];
#pragma unroll
        for (int rb = 0; rb < 2; ++rb)
#pragma unroll
            for (int j = 0; j < 3; ++j) acc[rb][j] = (f32x4){0.f, 0.f, 0.f, 0.f};
#pragma unroll
        for (int kh = 0; kh < 2; ++kh) {
            if (kh == 1) {
#pragma unroll
                for (int r4 = 0; r4 < 4; ++r4)
#pragma unroll
                    for (int i = 0; i < 4; ++i) { const int r = wid * 4 + r4; int l1 = lane >> 1; asm volatile("" : "+v"(l1)); const int ad = r * 2048 + (((i * 32 + l1) ^ r) * 16) + (lane & 1) * 8;
                        *(LAS u32x2*)(AH + ad) = keepH[r4][i]; *(LAS u32x2*)(AL + ad) = keepL[r4][i]; }
            }
            __syncthreads();
#pragma unroll 2
            for (int k8 = 0; k8 < 8; ++k8) { const int ksl = kq * 8 + k8, ks = kh * 32 + ksl;
                bf16x8 ah[2], al[2];
#pragma unroll
                for (int rb = 0; rb < 2; ++rb) { const int r = rb * 16 + fr; const int ad = r * 2048 + (((ksl * 4 + fq) ^ r) * 16); ah[rb] = *(const LAS bf16x8*)(AH + ad); al[rb] = *(const LAS bf16x8*)(AL + ad); }
#pragma unroll
                for (int j = 0; j < 3; ++j) { const int nb = nb0 + j; if (nb < 5) {
                    const bf16x8 wh = *(const bf16x8*)(WH + (size_t)(nb * 16 + fr) * DM + ks * 32 + fq * 8), wl = *(const bf16x8*)(WL + (size_t)(nb * 16 + fr) * DM + ks * 32 + fq * 8);
#pragma unroll
                    for (int rb = 0; rb < 2; ++rb) {
                        acc[rb][j] = __builtin_amdgcn_mfma_f32_16x16x32_bf16(wh, ah[rb], acc[rb][j], 0, 0, 0); acc[rb][j] = __builtin_amdgcn_mfma_f32_16x16x32_bf16(wl, ah[rb], acc[rb][j], 0, 0, 0);
                        acc[rb][j] = __builtin_amdgcn_mfma_f32_16x16x32_bf16(wh, al[rb], acc[rb][j], 0, 0, 0); } } } }
            __syncthreads();
        }
#pragma unroll
        for (int rb = 0; rb < 2; ++rb)
#pragma unroll
            for (int j = 0; j < 3; ++j) { const int nb = nb0 + j; if (nb < 5) *(LAS f32x4*)(slab + (kq * 32 + rb * 16 + fr) * 80 + nb * 16 + fq * 4) = acc[rb][j]; }
        __syncthreads();
        for (int o = tid; o < 2560; o += NTHREADS) lg[o] = (slab[o] + slab[2560 + o]) + (slab[5120 + o] + slab[7680 + o]);
        __syncthreads();
        if (tid < 32) {
            const int t = t0 + tid; const LAS float* L = lg + tid * 80;
            float gl[8]; int gi = 0; float gm = -INFINITY;
#pragma unroll
            for (int g = 0; g < 8; ++g) { gl[g] = L[g] + p.in[I_BRG][g]; if (gl[g] > gm) { gm = gl[g]; gi = g; } }
            float se = 0.f;
#pragma unroll
            for (int g = 0; g < 8; ++g) se += __expf(gl[g] - gm);
            const float gwt = 1.0f / se;
            float v1 = -INFINITY, v2 = -INFINITY; int i1 = 0, i2 = 0;
            for (int e = 0; e < 8; ++e) { const float v = L[8 + gi * 8 + e] + p.in[I_BRE][gi * 8 + e];
                if (v > v1) { v2 = v1; i2 = i1; v1 = v; i1 = e; } else if (v > v2) { v2 = v; i2 = e; } }
            const float e2 = __expf(v2 - v1); const float p1 = gwt / (1.0f + e2), p2 = gwt * e2 / (1.0f + e2);
            const int ea = gi * 8 + i1, eb = gi * 8 + i2;
            const int sub = blk & (NSUB - 1);
            const int pa = sub * SUBCAP + atomicAdd(cnt + sub * 64 + ea, 1); const int pb = sub * SUBCAP + atomicAdd(cnt + sub * 64 + eb, 1);
            ltok[ea * LCAP + pa] = t; lw[ea * LCAP + pa] = p1;
            ltok[eb * LCAP + pb] = t | 0x10000; lw[eb * LCAP + pb] = p2;
        }
        __syncthreads();
    }
}

#define MOE_GLOAD(dst, ptr) asm volatile("global_load_dwordx4 %0, %1, off nt" : "=v"(dst) : "v"(ptr) : "memory")
__device__ __forceinline__ int list_pos(const LAS int* pre, int r) { int s = 0;
#pragma unroll
    for (int k = NSUB / 2; k >= 1; k >>= 1) if (pre[s + k] <= r) s += k;
    return s * SUBCAP + (r - pre[s]); }
template <bool UP>
__device__ void moe_gemm(const Params& p, LAS unsigned char* lds, const int rep) {
    constexpr int K = UP ? 2048 : 512, NKT = K / 32, NS = UP ? 8 : 16, LDW = UP ? 512 : 2048;
    constexpr int NSTA = 3, OFF_A = 0, OFF_B = NSTA * 16384;
    int tid = threadIdx.x; asm volatile("" : "+v"(tid));
    const int w = __builtin_amdgcn_readfirstlane(tid >> 6), l = tid & 63, r32 = l & 31, hi = l >> 5;
    LAS int* tab = (LAS int*)(lds + LDS_TAB);
    if (tid < 64) { const int* cnt = (const int*)(p.ws + WS_CNT); int s = 0; for (int sub = 0; sub < NSUB; ++sub) { tab[256 + tid * 17 + sub] = s; s += cnt[sub * 64 + tid]; } tab[256 + tid * 17 + NSUB] = s; tab[80 + tid] = s; }
    __syncthreads();
    if (tid == 0) { int s = 0, ro = 0; for (int e = 0; e < 64; ++e) { const int ce = tab[80 + e]; tab[e] = s; tab[160 + e] = ro; ro += ce; const int np = (ce + 511) >> 9; s += np > 0 ? np : 1; } tab[64] = s; }
    __syncthreads();
    const int total = __builtin_amdgcn_readfirstlane(tab[64]) * NS;
    const int q = (w & 3) * 8 + (l & 7), g = (w >> 2) * 8 + (l >> 3);
    const unsigned bwoff = (unsigned)(q * 256 + (((g >> 2) ^ (q & 3)) * 16) + (g & 3) * 4);
    const unsigned frag_sw = (unsigned)((r32 >> 2) & 3);
    const int* ltok = (const int*)(p.ws + WS_LTOK); const float* lw = (const float*)(p.ws + WS_LW);
    for (int unit = blockIdx.x; unit < total; unit += gridDim.x) {
        const int pm = unit / NS, ns = unit - pm * NS; int e = 0;
#pragma unroll 1
        for (int s = 32; s >= 1; s >>= 1) if (__builtin_amdgcn_readfirstlane(tab[e + s]) <= pm) e += s;
        const int mp = pm - __builtin_amdgcn_readfirstlane(tab[e]); const int cnt_e = __builtin_amdgcn_readfirstlane(tab[80 + e]), rowoff = __builtin_amdgcn_readfirstlane(tab[160 + e]);
        int nrows = cnt_e - mp * 512; nrows = nrows > 512 ? 512 : nrows; const bool two = nrows > 256;
        const char* abase = UP ? (const char*)(p.ws + WS_H8) : (const char*)(p.ws + WS_ACT8);
        unsigned aoff[2];
#pragma unroll
        for (int i = 0; i < 2; ++i) { const int row = (i * 8 + w) * 32 + (l >> 1); const int hs = (l & 1) ^ ((l >> 4) & 1);
            int src; if (UP) src = row < nrows ? (ltok[e * LCAP + list_pos(tab + 256 + e * 17, mp * 512 + row)] & 0xffff) : 0; else src = rowoff + mp * 512 + (row < nrows ? row : 0);
            aoff[i] = (unsigned)(src * K + hs * 16); }
        const float* bsrc = UP ? (q < 16 ? p.in[I_W1] : p.in[I_W3]) + (size_t)e * 2048 * 512 + ns * 64 + (q & 15) * 4 + (size_t)(2 * g) * LDW
                               : p.in[I_W2] + (size_t)e * 512 * 2048 + ns * 128 + q * 4 + (size_t)(2 * g) * LDW;
        f32x16 acc[2][4];
#pragma unroll
        for (int a = 0; a < 2; ++a)
#pragma unroll
            for (int b = 0; b < 4; ++b)
#pragma unroll
                for (int r = 0; r < 16; ++r) acc[a][b][r] = 0.f;
        f32x4 br[2][2];
#define MOE_ISSUE_B(j, t) do { const int tt_ = (t) < NKT ? (t) : NKT - 1; const float* bp_ = bsrc + (size_t)tt_ * 32 * LDW; MOE_GLOAD(br[j][0], bp_); MOE_GLOAD(br[j][1], bp_ + LDW); } while (0)
#define MOE_ISSUE_A(t, TWO) do { int tt_ = (t) < 0 ? 0 : (t); const int bi_ = (tt_ % NSTA); tt_ = tt_ < NKT ? tt_ : NKT - 1; const char* ap_ = abase + (size_t)tt_ * 32; \
        LAS unsigned char* ab_ = lds + OFF_A + bi_ * 16384 + w * 1024; \
        __builtin_amdgcn_global_load_lds((const unsigned*)(ap_ + aoff[0]), (LAS unsigned*)(ab_), 16, 0, 0); \
        if (TWO) __builtin_amdgcn_global_load_lds((const unsigned*)(ap_ + aoff[1]), (LAS unsigned*)(ab_ + 8192), 16, 0, 0); } while (0)
        const bool two_w = (256 + 32 * w) < nrows;
#define MOE_FRAGS(ks, TWO) do { const unsigned co_ = ((unsigned)((ks) * 2 + hi) ^ frag_sw) * 16u; \
            _Pragma("unroll") for (int nb = 0; nb < 4; ++nb) bf_[nb] = *(const LAS bf16x8*)(bb_ + nb * 2048 + co_); \
            { const unsigned ao_ = ((unsigned)(ks) ^ ((unsigned)(r32 >> 3) & 1u)) * 16u + (unsigned)hi * 8u; a0_ = fp8x8_to_bf16(*(const LAS u32x2*)(ab_ + ao_)); if (TWO) a1_ = fp8x8_to_bf16(*(const LAS u32x2*)(ab_ + 8192 + ao_)); } } while (0)
#define MOE_MMAS(TWO) do { \
            _Pragma("unroll") for (int nb = 0; nb < 4; ++nb) acc[0][nb] = __builtin_amdgcn_mfma_f32_32x32x16_bf16(bf_[nb], a0_, acc[0][nb], 0, 0, 0); \
            if (TWO) { _Pragma("unroll") for (int nb = 0; nb < 4; ++nb) acc[1][nb] = __builtin_amdgcn_mfma_f32_32x32x16_bf16(bf_[nb], a1_, acc[1][nb], 0, 0, 0); } } while (0)
#define MOE_ITER(jn, t, COMPUTE, TWO, WB, WA) do { \
        bf16x8 bf_[4], a0_, a1_; \
        const LAS unsigned char* ab_ = lds + OFF_A + (((t) + 3) % 3) * 16384 + w * 1024 + r32 * 32; const LAS unsigned char* bb_ = lds + OFF_B + ((t) & 1) * 8192 + r32 * 64; \
        if (COMPUTE) { MOE_FRAGS(0, TWO); } SBAR(); \
        asm volatile("s_waitcnt vmcnt(" WB ")" : "+v"(br[jn][0]), "+v"(br[jn][1]) :: "memory"); \
        { LAS unsigned char* bw_ = lds + OFF_B + (((t) + 1) & 1) * 8192 + bwoff; _Pragma("unroll") for (int jj = 0; jj < 4; ++jj) *(LAS unsigned*)(bw_ + jj * 64) = cvt_pk_bf16(br[jn][0][jj], br[jn][1][jj]); } \
        MOE_ISSUE_B(jn, (t) + 3); SBAR(); \
        if (COMPUTE) { MOE_MMAS(TWO); SBAR(); MOE_FRAGS(1, TWO); MOE_MMAS(TWO); } SBAR(); \
        asm volatile("s_waitcnt vmcnt(" WA ")" ::: "memory"); \
        asm volatile("s_waitcnt lgkmcnt(0)" ::: "memory"); __builtin_amdgcn_s_barrier(); asm volatile("" ::: "memory"); \
        MOE_ISSUE_A((t) + 3, TWO); \
        } while (0)
#define MOE_PIPE(TWO, WB, WA) do { \
        MOE_ISSUE_B(0, 0); MOE_ISSUE_A(0, TWO); MOE_ISSUE_B(1, 1); MOE_ISSUE_A(1, TWO); \
        MOE_ITER(0, -1, false, TWO, WB, WA); \
        _Pragma("unroll 1") for (int t = 0; t < NKT; t += 2) { MOE_ITER(1, t, true, TWO, WB, WA); MOE_ITER(0, t + 1, true, TWO, WB, WA); } \
          \
        asm volatile("s_waitcnt vmcnt(0)" : "+v"(br[0][0]), "+v"(br[0][1]), "+v"(br[1][0]), "+v"(br[1][1]) :: "memory"); \
        } while (0)
        if (two_w) MOE_PIPE(true, "6", "6"); else MOE_PIPE(false, "4", "5");
        asm volatile("s_waitcnt vmcnt(0)" ::: "memory");
        if constexpr (UP) {
#pragma unroll
            for (int mt = 0; mt < 2; ++mt) {
                const int rl = mt * 256 + 32 * w + r32;
                if (rl < nrows) {
                    const float gw = lw[e * LCAP + list_pos(tab + 256 + e * 17, mp * 512 + rl)] * 16.0f; unsigned char* orow = (unsigned char*)(p.ws + (rep ? WS_QLAT : WS_ACT8)) + (size_t)(rowoff + mp * 512 + rl) * 512 + ns * 64 + 4 * hi;
#pragma unroll
                    for (int nb = 0; nb < 2; ++nb)
#pragma unroll
                        for (int g4 = 0; g4 < 4; ++g4) { float o[4];
#pragma unroll
                            for (int j = 0; j < 4; ++j) { const float a = acc[mt][nb][g4 * 4 + j], u = acc[mt][nb + 2][g4 * 4 + j]; o[j] = a * sigmoidf_(a) * u * gw; }
                            *(unsigned*)(orow + nb * 32 + g4 * 8) = pack_fp8x4(o[0], o[1], o[2], o[3]); }
                }
            }
        } else {
#pragma unroll
            for (int mt = 0; mt < 2; ++mt) {
                const int rl = mt * 256 + 32 * w + r32;
                if (rl < nrows) {
                    const int ent = ltok[e * LCAP + list_pos(tab + 256 + e * 17, mp * 512 + rl)]; unsigned char* orow = (unsigned char*)(p.ws + WS_YS) + ((size_t)(ent >> 16) * NTOK + (ent & 0xffff)) * 2048 + ns * 128 + 4 * hi;
#pragma unroll
                    for (int nb = 0; nb < 4; ++nb)
#pragma unroll
                        for (int g4 = 0; g4 < 4; ++g4) *(unsigned*)(orow + nb * 32 + g4 * 8) = pack_fp8x4(acc[mt][nb][g4 * 4], acc[mt][nb][g4 * 4 + 1], acc[mt][nb][g4 * 4 + 2], acc[mt][nb][g4 * 4 + 3]);
                }
            }
        }
        asm volatile("s_waitcnt vmcnt(0)" ::: "memory");
        __syncthreads();
    }
#undef MOE_ISSUE_A
#undef MOE_ISSUE_B
#undef MOE_ITER
#undef MOE_FRAGS
#undef MOE_MMAS
#undef MOE_PIPE
}


__device__ void ph11_combine(const Params& p) {
    const unsigned char* Y0 = (const unsigned char*)(p.ws + WS_YS); const unsigned char* Y1 = Y0 + (size_t)NTOK * 2048; const bf16_t* YM = (const bf16_t*)(p.ws + WS_MERGED); const float* mod = (const float*)(p.ws + WS_MOD);
    const size_t n8 = (size_t)NTOK * 2048 / 8;
    for (size_t i = (size_t)blockIdx.x * NTHREADS + threadIdx.x; i < n8; i += (size_t)gridDim.x * NTHREADS) {
        const size_t e0 = i * 8; const int col = (int)(e0 & 2047), b = (int)(e0 >> 22);
        const u32x2 a = *(const u32x2*)(Y0 + e0), c = *(const u32x2*)(Y1 + e0); const u32x4 m = *(const u32x4*)(YM + e0);
        const f32x2 a0 = __builtin_amdgcn_cvt_pk_f32_fp8((int)a.x, false), a1 = __builtin_amdgcn_cvt_pk_f32_fp8((int)a.x, true), a2 = __builtin_amdgcn_cvt_pk_f32_fp8((int)a.y, false), a3 = __builtin_amdgcn_cvt_pk_f32_fp8((int)a.y, true);
        const f32x2 c0 = __builtin_amdgcn_cvt_pk_f32_fp8((int)c.x, false), c1 = __builtin_amdgcn_cvt_pk_f32_fp8((int)c.x, true), c2 = __builtin_amdgcn_cvt_pk_f32_fp8((int)c.y, false), c3 = __builtin_amdgcn_cvt_pk_f32_fp8((int)c.y, true);
        const float* gt = mod + (size_t)b * 12288 + 10240 + col; const f32x4 g0 = *(const f32x4*)gt * 0.0625f, g1 = *(const f32x4*)(gt + 4) * 0.0625f;
        const float* px = p.in[I_X] + e0; f32x4 o0 = *(const f32x4*)px, o1 = *(const f32x4*)(px + 4);
        o0[0] += bf_lo(m.x) + g0[0] * (a0.x + c0.x); o0[1] += bf_hi(m.x) + g0[1] * (a0.y + c0.y); o0[2] += bf_lo(m.y) + g0[2] * (a1.x + c1.x); o0[3] += bf_hi(m.y) + g0[3] * (a1.y + c1.y);
        o1[0] += bf_lo(m.z) + g1[0] * (a2.x + c2.x); o1[1] += bf_hi(m.z) + g1[1] * (a2.y + c2.y); o1[2] += bf_lo(m.w) + g1[2] * (a3.x + c3.x); o1[3] += bf_hi(m.w) + g1[3] * (a3.y + c3.y);
        float* po = p.out + e0; *(f32x4*)po = o0; *(f32x4*)(po + 4) = o1;
    }
}

__global__ void __launch_bounds__(NTHREADS, 2) mk_fwd(Params p) {
    extern __shared__ __attribute__((aligned(16))) unsigned char shm[];
    LAS unsigned char* lds = (LAS unsigned char*)shm;
    const int lo = p.ph_lo, hi = p.ph_hi;
    if (threadIdx.x < 4) ((LAS unsigned*)(lds + LDS_BARW))[threadIdx.x] = 0u;
    __syncthreads();
    XcdBarrier bar; bar.bar = (unsigned*)(p.ws + WS_BAR); bar.x = 0; bar.st = nullptr;
    if (hi - lo > 1) bar = xcd_barrier_post((unsigned*)(p.ws + WS_BAR), (volatile LAS unsigned*)(lds + LDS_BARW));
#ifndef SKIP_MASK
#define SKIP_MASK 0
#endif
#define IN(k) (!((SKIP_MASK >> (k)) & 1) && lo <= (k) && (k) < hi)
#define SEAM(k) do { if (IN(k) && IN((k) + 1)) xcd_barrier(bar); } while (0)
    const int G = gridDim.x, bx = blockIdx.x;
#ifndef REP_PHASE
#define REP_PHASE 0
#endif
#define RUN(k, ...) do { if (IN(k)) { { const int rep = 0; (void)rep; __VA_ARGS__ } if ((REP_PHASE >> (k)) & 1) { xcd_barrier(bar); { const int rep = 1; (void)rep; __VA_ARGS__ } } } SEAM(k); } while (0)
    RUN(0, ph0_prologue(p, lds););
    RUN(1, ph1_norm(p););
    RUN(2, EpiProj E{p.ws, p.in[I_BGATE]};
           { ProjOrder S; S.S.init(p.ws + WS_H, p.ws + WS_WIN + (size_t)2 * 256 * DM * 2, NTOK, 8 * 256, DM * 2, G, bx); S.fp8 = 0; S.Bfull = nullptr;
             pg8::gemm_phase<EpiProj, ProjOrder, false, false>(lds, DM * 2, S, E); }
           { ProjOrder S; S.S.init(p.ws + WS_HF8, p.ws + WS_WIN8, NTOK, 30 * 256, DM, G, (G - 1) - bx); S.fp8 = 1; S.Bfull = nullptr;
             pg8::gemm_phase<EpiProj, ProjOrder, false, true>(lds, DM, S, E, 0x79797979); });
    RUN(3, ph3_prep(p, lds, rep););
    RUN(4, ph4_attn(p, lds););
    RUN(5, DualOrder S; S.S0.init(p.ws + WS_OA8, p.ws + WS_WPA8, NTOK, DM, 1024, G, bx); S.S1.init(p.ws + WS_OB8, p.ws + WS_WPB8, NTOK, DM, 1024, G, bx);
           EpiGate12 E{EpiGate1{(const bf16_t*)(p.ws + WS_GATES), (bf16_t*)(p.ws + WS_OA)}, EpiGate2{(const bf16_t*)(p.ws + WS_GATES), (const bf16_t*)(p.ws + WS_OA), (unsigned char*)(p.ws + WS_MRG8)}};
           pg8::gemm_phase<EpiGate12, DualOrder, false, true>(lds, 1024, S, E, 0x79797979, 0x7c7c7c7c););
    RUN(6, pg8::StaticOrder S; S.init(p.ws + WS_MRG8, p.ws + WS_WO8, NTOK, DM, DM, G, bx); EpiWo E{(const float*)(p.ws + WS_MOD), (bf16_t*)(p.ws + WS_MERGED)};
           pg8::gemm_phase<EpiWo, pg8::StaticOrder, false, true>(lds, DM, S, E, 0x79797979, 0x7d7d7d7d););
    RUN(7, ph8_router(p, lds, rep););
    RUN(8, moe_gemm<true>(p, lds, rep););
    RUN(9, moe_gemm<false>(p, lds, rep););
    RUN(10, if (!rep) ph11_combine(p););
#undef RUN
#undef IN
#undef SEAM
}

constexpr int NPHASES = 11;
extern "C" void kernel_launch(void* const* d_in, const int* in_sizes, int n_in, void* d_out, int out_size, void* d_ws, size_t ws_size, hipStream_t stream) {
    static int grid = 0;
    if (grid == 0) {
        if (n_in != 25 || in_sizes[0] != NTOK * DM || out_size != NTOK * DM || ws_size < WS_END6) {
            fprintf(stderr, "kernel_launch: shape mismatch: n_in %d in0 %d out %d ws %zu (need %zu)\n", n_in, n_in > 0 ? in_sizes[0] : -1, out_size, ws_size, (size_t)WS_END6); grid = -1; return; }
        int dev = 0, cus = 0, per_cu = 0;
        if (hipGetDevice(&dev) != hipSuccess || hipDeviceGetAttribute(&cus, hipDeviceAttributeMultiprocessorCount, dev) != hipSuccess) { fprintf(stderr, "kernel_launch: device query failed\n"); grid = -1; return; }
        if (hipFuncSetAttribute((const void*)mk_fwd, hipFuncAttributeMaxDynamicSharedMemorySize, LDS_BYTES) != hipSuccess) { fprintf(stderr, "kernel_launch: hipFuncSetAttribute failed\n"); grid = -1; return; }
        if (hipOccupancyMaxActiveBlocksPerMultiprocessor(&per_cu, (const void*)mk_fwd, NTHREADS, LDS_BYTES) != hipSuccess || per_cu < 1) { fprintf(stderr, "kernel_launch: occupancy query says %d blocks per CU\n", per_cu); }
        (void)hipGetLastError();
        grid = cus;
    }
    if (grid < 0) return;
    if (hipMemsetAsync((char*)d_ws + WS_BAR, 0, WS_ZERO_BYTES, stream) != hipSuccess) { fprintf(stderr, "kernel_launch: memset failed\n"); return; }
    Params p; memset(&p, 0, sizeof(p));
    for (int i = 0; i < 25; ++i) p.in[i] = (const float*)d_in[i];
    p.out = (float*)d_out; p.ws = (unsigned char*)d_ws;
    unsigned char* ws = (unsigned char*)d_ws;
    auto job = [&](int j, const float* src, size_t dst_off, int K, int N, int ldd, int map, int nbatch, long sbatch, long dbatch) {
        TJob& J = p.jobs[j]; J.src = src; J.dst = (bf16_t*)(ws + dst_off); J.K = K; J.N = N; J.ldd = ldd; J.map = map; J.ntk = K / 64; J.ntn = (N + 127) / 128; J.nbatch = nbatch; J.sbatch = sbatch; J.dbatch = dbatch; J.ld = N; J.fp8 = 0; };
    job(0, p.in[I_WIN] + 512, WS_WIN, 2048, 1872, 2048, 4, 1, 0, 0); p.jobs[0].ld = DIN;
    job(1, p.in[I_WIN] + 5456, WS_WIN, 2048, 8, 2048, 5, 1, 0, 0); p.jobs[1].ld = DIN;
    job(2, p.in[I_WUK], WS_WUK, 128, 256, 128, 0, 8, 128L * 256, 256L * 128);
    job(3, p.in[I_WUV], WS_WUV, 256, 128, 256, 0, 8, 256L * 128, 128L * 256);
    job(4, p.in[I_WIN], WS_WIN8, 2048, 512, 2048, 0, 1, 0, 0); job(5, p.in[I_WIN] + 2384, WS_WIN8 + (size_t)512 * 2048, 2048, 3072, 2048, 0, 1, 0, 0); job(6, p.in[I_WIN] + 5464, WS_WIN8 + (size_t)3584 * 2048, 2048, 4096, 2048, 0, 1, 0, 0);
    for (int j = 4; j < 7; ++j) { p.jobs[j].ld = DIN; p.jobs[j].fp8 = 1; }
    job(7, p.in[I_WO], WS_WO8, 2048, 2048, 2048, 0, 1, 0, 0); p.jobs[7].fp8 = 1;
    job(8, p.in[I_WPA], WS_WPA8, 1024, 2048, 1024, 0, 1, 0, 0); p.jobs[8].fp8 = 1; job(9, p.in[I_WPB], WS_WPB8, 1024, 2048, 1024, 0, 1, 0, 0); p.jobs[9].fp8 = 1;
    int t0 = 0; for (int j = 0; j < NJOBS; ++j) { p.jobs[j].tile0 = t0; t0 += p.jobs[j].ntk * p.jobs[j].ntn * p.jobs[j].nbatch; }
    p.ntiles_total = t0;
#if MK_LAUNCHES == 1
    p.ph_lo = 0; p.ph_hi = NPHASES;
    hipLaunchKernelGGL(mk_fwd, dim3(grid), dim3(NTHREADS), LDS_BYTES, stream, p);
#else
    for (int k = 0; k < NPHASES; ++k) { p.ph_lo = k; p.ph_hi = k + 1; hipLaunchKernelGGL(mk_fwd, dim3(grid), dim3(NTHREADS), LDS_BYTES, stream, p); }
#endif
    const hipError_t le = hipPeekAtLastError();
    if (le != hipSuccess) fprintf(stderr, "kernel_launch: launch failed: %s\n", hipGetErrorName(le));
}
```

```cpp
#include <hip/hip_runtime.h>
#include <cstdio>
#include <cstdint>
#include <cstring>

#ifndef MK_LAUNCHES
#define MK_LAUNCHES 1
#endif

#define LAS __attribute__((address_space(3)))
typedef unsigned short bf16_t;
typedef short bf16x8 __attribute__((ext_vector_type(8)));
typedef short s16x4 __attribute__((ext_vector_type(4)));
typedef float f32x4 __attribute__((ext_vector_type(4)));
typedef float f32x16 __attribute__((ext_vector_type(16)));
typedef unsigned u32x4 __attribute__((ext_vector_type(4)));
typedef unsigned u32x2 __attribute__((ext_vector_type(2)));

constexpr int DM = 2048, NBATCH = 4, SEQ = 2048, NTOK = NBATCH * SEQ;
constexpr int DIN = 9560, DINP = 9728;
constexpr int NEXP = 64, DEXP = 512, LCAP = 8192;
constexpr float RMS_EPS = 1e-6f;
constexpr float LOG2E = 1.4426950408889634f;
constexpr int NTHREADS = 512;
constexpr int LDS_BYTES = 163840 - 1024;
constexpr int LDS_BARW = LDS_BYTES - 16;
constexpr int LDS_TAB = 131072;

constexpr size_t al256(size_t x) { return (x + 255) / 256 * 256; }
constexpr size_t WS_BAR = 0;
constexpr size_t WS_CNT = 16384;
constexpr size_t WS_ZERO_BYTES = 16384 + 16384;
constexpr int NSUB = 16, SUBCAP = 512;
constexpr size_t WS_MOD = WS_ZERO_BYTES;
constexpr size_t WS_H = al256(WS_MOD + (size_t)4 * 12288 * 4);
constexpr size_t WS_WIN = al256(WS_H + (size_t)NTOK * DM * 2);
constexpr size_t WS_WPA = al256(WS_WIN + (size_t)DINP * DM * 2);
constexpr size_t WS_WPB = al256(WS_WPA + (size_t)2048 * 1024 * 2);
constexpr size_t WS_WO = al256(WS_WPB + (size_t)2048 * 1024 * 2);
constexpr size_t WS_WUK = al256(WS_WO + (size_t)2048 * 2048 * 2);
constexpr size_t WS_WUV = al256(WS_WUK + (size_t)8 * 256 * 128 * 2);
constexpr size_t WS_W13 = al256(WS_WUV + (size_t)8 * 128 * 256 * 2);
constexpr size_t WS_W2 = al256(WS_W13 + (size_t)64 * 1024 * 2048 * 2);
constexpr size_t WS_QA = al256(WS_W2 + (size_t)64 * 2048 * 512 * 2);
constexpr size_t WS_CKV = al256(WS_QA + (size_t)NTOK * 1024 * 2);
constexpr size_t WS_KV = al256(WS_CKV + (size_t)NTOK * 256 * 4);
constexpr size_t WS_QIDX = al256(WS_KV + (size_t)NTOK * 256 * 2);
constexpr size_t WS_MISC = al256(WS_QIDX + (size_t)NTOK * 1024 * 2);
constexpr size_t WS_QB = al256(WS_MISC + (size_t)NTOK * 256 * 4);
constexpr size_t WS_KB = al256(WS_QB + (size_t)NTOK * 1024 * 2);
constexpr size_t WS_VB = al256(WS_KB + (size_t)NTOK * 1024 * 2);
constexpr size_t WS_GATES = al256(WS_VB + (size_t)NTOK * 1024 * 2);
constexpr size_t WS_QLAT = al256(WS_GATES + (size_t)NTOK * 4096 * 2);
constexpr size_t WS_MASK = al256(WS_QLAT + (size_t)NTOK * 2048 * 2);
constexpr size_t WS_CUM = al256(WS_MASK + (size_t)NTOK * 256);
constexpr size_t WS_OLAT = al256(WS_CUM + (size_t)4 * 8 * 2048 * 4);
constexpr size_t WS_OA = al256(WS_OLAT + (size_t)NTOK * 2048 * 2);
constexpr size_t WS_OB = al256(WS_OA + (size_t)NTOK * 1024 * 2);
constexpr size_t WS_T1 = al256(WS_OB + (size_t)NTOK * 1024 * 2);
constexpr size_t WS_MERGED = al256(WS_T1 + (size_t)NTOK * 2048 * 4);
constexpr size_t WS_LTOK = al256(WS_MERGED + (size_t)NTOK * 2048 * 2);
constexpr size_t WS_LW = al256(WS_LTOK + (size_t)NEXP * LCAP * 4);
constexpr size_t WS_ACT = al256(WS_LW + (size_t)NEXP * LCAP * 4);
constexpr size_t WS_HLO = al256(WS_ACT + (size_t)32768 * 512 * 2);
constexpr size_t WS_WRH = al256(WS_HLO + (size_t)NTOK * DM * 2);
constexpr size_t WS_WRL = al256(WS_WRH + (size_t)80 * DM * 2);
constexpr size_t WS_END = al256(WS_WRL + (size_t)80 * DM * 2);
constexpr size_t WS_KIDX = WS_END;
constexpr size_t WS_END2 = al256(WS_KIDX + (size_t)NTOK * 64 * 2);
constexpr size_t WS_H8 = WS_END2;
constexpr size_t WS_ACT8 = al256(WS_H8 + (size_t)NTOK * DM);
constexpr size_t WS_END3 = al256(WS_ACT8 + (size_t)16384 * 512);
constexpr size_t WS_HF8 = WS_END3;
constexpr size_t WS_WIN8 = al256(WS_HF8 + (size_t)NTOK * DM);
constexpr size_t WS_END4 = al256(WS_WIN8 + (size_t)7680 * DM);
constexpr size_t WS_MRG8 = WS_END4;
constexpr size_t WS_WO8 = al256(WS_MRG8 + (size_t)NTOK * DM);
constexpr size_t WS_END5 = al256(WS_WO8 + (size_t)2048 * 2048);
constexpr size_t WS_OA8 = WS_END5;
constexpr size_t WS_OB8 = al256(WS_OA8 + (size_t)NTOK * 1024);
constexpr size_t WS_WPA8 = al256(WS_OB8 + (size_t)NTOK * 1024);
constexpr size_t WS_WPB8 = al256(WS_WPA8 + (size_t)2048 * 1024);
constexpr size_t WS_END6 = al256(WS_WPB8 + (size_t)2048 * 1024);
constexpr size_t WS_YS = WS_T1;
constexpr size_t WS_HG = WS_QA;
static_assert(WS_HG + (size_t)32768 * DM * 2 <= WS_QLAT, "hg alias must fit in the dead region");

struct TJob { const float* src; bf16_t* dst; int K, N, ldd, map, ntk, ntn, nbatch, tile0; long sbatch, dbatch; int ld, fp8; };
constexpr int NJOBS = 10;
struct Params {
    const float* in[25];
    float* out;
    unsigned char* ws;
    TJob jobs[NJOBS];
    int ntiles_total;
    int ph_lo, ph_hi;
};
enum { I_X = 0, I_C, I_WADA, I_BADA, I_GMIX, I_WIN, I_BGATE, I_BFORGET, I_WUK, I_WUV, I_GQA, I_GKV, I_GQB, I_GKB, I_WPA, I_WPB, I_WO, I_GFFN, I_WRG, I_BRG, I_WRE, I_BRE, I_W1, I_W3, I_W2 };

__device__ __forceinline__ unsigned cvt_pk_bf16(float lo, float hi) { unsigned r; asm volatile("v_cvt_pk_bf16_f32 %0, %1, %2" : "=v"(r) : "v"(lo), "v"(hi)); return r; }
__device__ __forceinline__ float bf_lo(unsigned w) { return __uint_as_float(w << 16); }
__device__ __forceinline__ float bf_hi(unsigned w) { return __uint_as_float(w & 0xffff0000u); }
typedef float f32x2 __attribute__((ext_vector_type(2)));
__device__ __forceinline__ unsigned pack_fp8x4(float a, float b, float c, float d) { int w = __builtin_amdgcn_cvt_pk_fp8_f32(a, b, 0, false); w = __builtin_amdgcn_cvt_pk_fp8_f32(c, d, w, true); return (unsigned)w; }
__device__ __forceinline__ bf16x8 fp8x8_to_bf16(u32x2 v) {
    const f32x2 a = __builtin_amdgcn_cvt_pk_f32_fp8((int)v.x, false), b = __builtin_amdgcn_cvt_pk_f32_fp8((int)v.x, true), c = __builtin_amdgcn_cvt_pk_f32_fp8((int)v.y, false), d = __builtin_amdgcn_cvt_pk_f32_fp8((int)v.y, true);
    u32x4 w; w.x = cvt_pk_bf16(a.x, a.y); w.y = cvt_pk_bf16(b.x, b.y); w.z = cvt_pk_bf16(c.x, c.y); w.w = cvt_pk_bf16(d.x, d.y); return *reinterpret_cast<bf16x8*>(&w); }
__device__ __forceinline__ unsigned pack_u8x4(float a, float b, float c, float d) {
    unsigned w = 0; w = __builtin_amdgcn_cvt_pk_u8_f32(a * 255.f + 0.5f, 0, w); w = __builtin_amdgcn_cvt_pk_u8_f32(b * 255.f + 0.5f, 1, w); w = __builtin_amdgcn_cvt_pk_u8_f32(c * 255.f + 0.5f, 2, w); w = __builtin_amdgcn_cvt_pk_u8_f32(d * 255.f + 0.5f, 3, w); return w; }
__device__ __forceinline__ f32x4 unpack_u8x4(unsigned w) { return (f32x4){(float)(w & 0xffu), (float)((w >> 8) & 0xffu), (float)((w >> 16) & 0xffu), (float)(w >> 24)} * (1.0f / 255.0f); }
__device__ __forceinline__ float wave_sum(float v) {
#pragma unroll
    for (int o = 32; o >= 1; o >>= 1) v += __shfl_xor(v, o);
    return v;
}
__device__ __forceinline__ float sigmoidf_(float x) { return __builtin_amdgcn_rcpf(1.0f + __builtin_amdgcn_exp2f(-1.4426950408889634f * x)); }
__device__ __forceinline__ int crow(int r, int hi) { return (r & 3) + 8 * (r >> 2) + 4 * hi; }
#define SBAR() __builtin_amdgcn_sched_barrier(0)

#define XB_TMO      128
#define XB_XCNT(j)  (256  + 64 * (j))
#define XB_XSUB(j)  (1280 + 64 * (j))
#define XB_XGEN(j)  (2304 + 64 * (j))
#define XB_TOP      3328
#define XB_TOPGEN   3392
#define XCD_BAR_WORDS 3456
#define XB_SPIN_CAP (1u << 20)
__device__ __forceinline__ unsigned xb_ld(unsigned* p)              { return __hip_atomic_load(p, __ATOMIC_RELAXED, __HIP_MEMORY_SCOPE_AGENT); }
__device__ __forceinline__ unsigned xb_add(unsigned* p, unsigned v) { return __hip_atomic_fetch_add(p, v, __ATOMIC_RELAXED, __HIP_MEMORY_SCOPE_AGENT); }
__device__ __forceinline__ unsigned xb_xcc_id() { return (unsigned)__builtin_amdgcn_s_getreg((3 << 11) | 20) & 0xFu; }
#define XB_SPIN(cond, bar) do { unsigned _sp = 0; while (cond) { __builtin_amdgcn_s_sleep(1); \
    if ((++_sp & 255u) == 0u) { if (xb_ld(&(bar)[XB_TMO])) break; if (_sp > XB_SPIN_CAP) { atomicAdd(&(bar)[XB_TMO], 1u); break; } } } } while (0)
struct XcdBarrier { unsigned* bar; unsigned x; volatile LAS unsigned* st; };
__device__ __forceinline__ XcdBarrier xcd_barrier_post(unsigned* bar, volatile LAS unsigned* st) {
    XcdBarrier b; b.bar = bar; b.x = xb_xcc_id(); b.st = st;
    if (threadIdx.x == 0) (void)xb_add(&bar[XB_XCNT(b.x)], 1u);
    return b;
}
__device__ __forceinline__ void xcd_barrier_complete(unsigned* bar, unsigned x, unsigned& nloc, unsigned& nx) {
    const unsigned G = gridDim.x * gridDim.y * gridDim.z;
    unsigned sum, cnt, mine, sp = 0u;
    for (;;) {
        sum = 0u; cnt = 0u; mine = 0u;
#pragma unroll
        for (unsigned j = 0; j < 16; ++j) { const unsigned c = xb_ld(&bar[XB_XCNT(j)]); sum += c; cnt += (c > 0u) ? 1u : 0u; mine = (j == x) ? c : mine; }
        if (sum == G) break;
        __builtin_amdgcn_s_sleep(1);
        if ((++sp & 255u) == 0u) { if (xb_ld(&bar[XB_TMO])) break; if (sp > XB_SPIN_CAP) { atomicAdd(&bar[XB_TMO], 1u); break; } }
    }
    nloc = mine > 0u ? mine : 1u; nx = cnt > 0u ? cnt : 1u;
}
__device__ __forceinline__ void xcd_barrier(const XcdBarrier& b) {
    asm volatile("s_waitcnt vmcnt(0)" ::: "memory");
    __syncthreads();
    if (threadIdx.x == 0) {
        unsigned* bar = b.bar;
        __builtin_amdgcn_s_waitcnt(0);
        unsigned nloc = b.st[0], nx = b.st[1];
        if (nloc == 0u) { xcd_barrier_complete(bar, b.x, nloc, nx); b.st[0] = nloc; b.st[1] = nx; }
        const unsigned old = xb_add(&bar[XB_XSUB(b.x)], 1u);
        const unsigned gen = old / nloc;
        if (old + 1u == (gen + 1u) * nloc) {
            __builtin_amdgcn_fence(__ATOMIC_RELEASE, "agent");
            asm volatile("s_waitcnt vmcnt(0)" ::: "memory");
            const unsigned og = xb_add(&bar[XB_TOP], 1u);
            const unsigned tg = og / nx;
            if (og + 1u == (tg + 1u) * nx) xb_add(&bar[XB_TOPGEN], 1u);
            else XB_SPIN(xb_ld(&bar[XB_TOPGEN]) == tg, bar);
            __builtin_amdgcn_fence(__ATOMIC_ACQUIRE, "agent");
            xb_add(&bar[XB_XGEN(b.x)], 1u);
            asm volatile("s_waitcnt vmcnt(0)" ::: "memory");
        } else {
            XB_SPIN(xb_ld(&bar[XB_XGEN(b.x)]) == gen, bar);
            __builtin_amdgcn_fence(__ATOMIC_ACQUIRE, "agent");
            asm volatile("s_waitcnt vmcnt(0)" ::: "memory");
        }
    }
    __syncthreads();
}

namespace pg8 {
constexpr int BM = 256, BK = 64, HALF = 128, HTB = HALF * BK * 2, STAGE_BYTES = 8 * HTB, NXCD = 8, WGM = 8;
__host__ __device__ __forceinline__ int lds_byte(int r, int c) { const int st = (r >> 4) * 2 + (c >> 5), rr = r & 15, cc = c & 31, ob = rr * 64 + cc * 2; return st * 1024 + (ob ^ (((ob >> 9) & 1) << 5)); }
__host__ __device__ __forceinline__ void stage_rc(int b, int& R, int& C) { const int st = b / 1024, sb = b % 1024, swz = sb ^ (((sb >> 9) & 1) << 5); R = (st >> 1) * 16 + swz / 64; C = (st & 1) * 32 + (swz % 64) / 2; }
__host__ __device__ __forceinline__ int perm32(int rho) { const int n = rho >> 4, i = rho & 15; return 8 * (i >> 2) + 4 * n + (i & 3); }

struct Unit { int pm, pn; const char* a; const char* b; const int* gi; int nvalid; int aux; };

struct StaticOrder {
    int nM, nN, nwg, G, c, RS; const char* A; const char* Bt;
    __device__ void init(const void* A_, const void* Bt_, int M, int N, int RS_, int G_, int c_) { A = (const char*)A_; Bt = (const char*)Bt_; RS = RS_; nM = M / BM; nN = N / BM; nwg = nM * nN; G = G_; c = c_; }
    __device__ bool next(int i, Unit& u) const {
        const long L = (long)i * G + c; if (L >= nwg) return false;
        int wgid = (int)L; { const int q = nwg / NXCD, r = nwg % NXCD, xcd = wgid % NXCD, off = wgid / NXCD; wgid = (xcd < r ? xcd * (q + 1) : r * (q + 1) + (xcd - r) * q) + off; }
        const int nig = WGM * nN, gid = wgid / nig, fm = gid * WGM, gsz = (nM - fm) < WGM ? (nM - fm) : WGM;
        u.pm = fm + ((wgid % nig) % gsz); u.pn = (wgid % nig) / gsz;
        u.a = A + (size_t)u.pm * BM * RS; u.b = Bt + (size_t)u.pn * BM * RS; u.gi = nullptr; u.nvalid = BM; u.aux = 0; return true;
    }
};

typedef int i32x8 __attribute__((ext_vector_type(8)));
typedef int i32x4v __attribute__((ext_vector_type(4)));
template <class Epi, class Sched, bool GATHER, bool FP8 = false>
__device__ __forceinline__ void gemm_phase(LAS unsigned char* lds, const int RS, const Sched& S, const Epi& E, const int scale_b = 0x7f7f7f7f, const int scale_a = 0x7f7f7f7f) {
    int tid = threadIdx.x; asm volatile("" : "+v"(tid));
    const int wid = __builtin_amdgcn_readfirstlane(tid >> 6), lane = tid & 63, wr = wid >> 2, wc = wid & 3, fr = lane & 15, fq = lane >> 4;
    const int nt = RS / (BK * 2); const int K = RS;
    unsigned voffA[2], voffB[2]; int RA[2], CA[2];
#pragma unroll
    for (int i = 0; i < 2; ++i) { int R, C; stage_rc(tid * 16 + i * 8192, R, C); const int Rb = ((R & ~31) + perm32(R & 31));
        RA[i] = R; CA[i] = C; voffA[i] = (unsigned)(R * RS + C * 2); voffB[i] = (unsigned)(Rb * RS + C * 2); }
    const size_t kstep = (size_t)(BK * 2);
    const size_t hstep = (size_t)HALF * RS;
    const unsigned ldsw = (unsigned)wid * 1024u;
    const int aoff = lds_byte(wr * 64 + fr, fq * 8), boff = lds_byte(wc * 32 + fr, fq * 8);
    unsigned gA[2][2], gN[2][2];
#define PG8_SA(b, h) (((b) * 2 + (h)) * HTB)
#define PG8_SB(b, h) ((4 + (b) * 2 + (h)) * HTB)
#define PG8_STAGE(bufoff, gbase, voff) do { _Pragma("unroll") for (int _i = 0; _i < 2; ++_i) \
        __builtin_amdgcn_global_load_lds((const unsigned*)((const char*)(gbase) + (voff)[_i]), (LAS unsigned*)(lds + (bufoff) + ldsw + _i * 8192), 16, 0, 0); } while (0)
#define PG8_STAGE_A(bufoff, gp, h, NX) do { if constexpr (GATHER) { if (NX) PG8_STAGE(bufoff, gp, gN[h]); else PG8_STAGE(bufoff, gp, gA[h]); } else PG8_STAGE(bufoff, (gp) + (h) * hstep, voffA); } while (0)
#define PG8_LD8(p_) __builtin_shufflevector(*(const LAS i32x4v*)(p_), *(const LAS i32x4v*)((p_) + 1024), 0, 1, 2, 3, 4, 5, 6, 7)
#define PG8_LDA(dst, b, h) do { if constexpr (FP8) { _Pragma("unroll") for (int m = 0; m < 4; ++m) dst##8[m] = PG8_LD8(lds + PG8_SA(b, h) + aoff + m * 2048); } \
        else { _Pragma("unroll") for (int m = 0; m < 4; ++m) _Pragma("unroll") for (int k = 0; k < 2; ++k) dst[m][k] = *(const LAS bf16x8*)(lds + PG8_SA(b, h) + aoff + m * 2048 + k * 1024); } } while (0)
#define PG8_LDB(dst, b, h) do { if constexpr (FP8) { _Pragma("unroll") for (int n = 0; n < 2; ++n) dst##8[n] = PG8_LD8(lds + PG8_SB(b, h) + boff + n * 2048); } \
        else { _Pragma("unroll") for (int n = 0; n < 2; ++n) _Pragma("unroll") for (int k = 0; k < 2; ++k) dst[n][k] = *(const LAS bf16x8*)(lds + PG8_SB(b, h) + boff + n * 2048 + k * 1024); } } while (0)
#define PG8_MMA(ai, bj, At, Bt) do { __builtin_amdgcn_s_setprio(1); \
        if constexpr (FP8) { _Pragma("unroll") for (int m = 0; m < 4; ++m) _Pragma("unroll") for (int n = 0; n < 2; ++n) \
            asm volatile("v_mfma_scale_f32_16x16x128_f8f6f4 %0, %1, %2, %0, %3, %4 op_sel_hi:[0,0,0]" : "+v"(acc[ai][bj][m][n]) : "v"(Bt##8[n]), "v"(At##8[m]), "v"(sc_b), "v"(sc_a)); } \
        else { _Pragma("unroll") for (int m = 0; m < 4; ++m) _Pragma("unroll") for (int n = 0; n < 2; ++n) _Pragma("unroll") for (int k = 0; k < 2; ++k) \
            acc[ai][bj][m][n] = __builtin_amdgcn_mfma_f32_16x16x32_bf16(Bt[n][k], At[m][k], acc[ai][bj][m][n], 0, 0, 0); } \
        __builtin_amdgcn_s_setprio(0); } while (0)
#define PG8_WAIT_V(n) asm volatile("s_waitcnt vmcnt(" #n ")" ::: "memory")
#define PG8_WAIT_L(n) asm volatile("s_waitcnt lgkmcnt(" #n ")" ::: "memory")
#define PG8_BAR __builtin_amdgcn_s_barrier()
#define PG8_SCHED __builtin_amdgcn_sched_barrier(0)
#define PG8_GIDX(dst, u) do { if constexpr (GATHER) { _Pragma("unroll") for (int h = 0; h < 2; ++h) _Pragma("unroll") for (int i = 0; i < 2; ++i) { \
        const int rr = h * HALF + RA[i]; const int tok = rr < (u).nvalid ? (u).gi[rr] : 0; dst[h][i] = (unsigned)(tok * K + CA[i] * 2); } } } while (0)
    Unit cur, nxt; int ui = 0;
    if (!S.next(0, cur)) return;
    f32x4 acc[2][2][4][2];
#pragma unroll
    for (int a = 0; a < 2; ++a)
#pragma unroll
        for (int b = 0; b < 2; ++b)
#pragma unroll
            for (int m = 0; m < 4; ++m)
#pragma unroll
                for (int n = 0; n < 2; ++n) acc[a][b][m][n] = (f32x4){0.f, 0.f, 0.f, 0.f};
    const int sc_b = scale_b, sc_a = scale_a;
    bf16x8 At[4][2], B0[2][2], B1[2][2]; i32x8 At8[4], B08[2], B18[2];
    const char* cA = cur.a; const char* cB = cur.b;
    PG8_GIDX(gA, cur);
    PG8_STAGE(PG8_SB(0, 0), cB, voffB); PG8_STAGE_A(PG8_SA(0, 0), cA, 0, false); PG8_STAGE(PG8_SB(0, 1), cB + hstep, voffB); PG8_STAGE_A(PG8_SA(0, 1), cA, 1, false);
    if (wr == 1) PG8_BAR;
    PG8_WAIT_V(4); PG8_BAR;
    PG8_STAGE(PG8_SB(1, 0), cB + kstep, voffB); PG8_STAGE_A(PG8_SA(1, 0), cA + kstep, 0, false); PG8_STAGE(PG8_SB(1, 1), cB + hstep + kstep, voffB);
    PG8_WAIT_V(6); PG8_BAR;
    for (;;) {
        const bool has_next = S.next(ui + 1, nxt);
        const char* nA = has_next ? nxt.a : cA; const char* nB = has_next ? nxt.b : cB;
        if constexpr (GATHER) { if (has_next) { PG8_GIDX(gN, nxt); } else {
#pragma unroll
            for (int h = 0; h < 2; ++h)
#pragma unroll
                for (int i = 0; i < 2; ++i) gN[h][i] = gA[h][i]; } }
        for (int t = 0; t < nt; t += 2) {
            const bool last = (t == nt - 2);
            const char* a1 = cA + (size_t)(t + 1) * kstep;
            const char* a2 = last ? nA : cA + (size_t)(t + 2) * kstep; const char* b2 = last ? nB : cB + (size_t)(t + 2) * kstep;
            const char* a3 = a2 + kstep; const char* b3 = b2 + kstep;
            PG8_LDB(B0, 0, 0); PG8_SCHED; PG8_LDA(At, 0, 0); PG8_STAGE_A(PG8_SA(1, 1), a1, 1, false);
            PG8_WAIT_L(8); PG8_BAR; PG8_WAIT_L(0); PG8_MMA(0, 0, At, B0); PG8_BAR; PG8_SCHED;
            PG8_LDB(B1, 0, 1); PG8_STAGE(PG8_SB(0, 0), b2, voffB);
            PG8_BAR; PG8_WAIT_L(0); PG8_MMA(0, 1, At, B1); PG8_BAR;
            PG8_LDA(At, 0, 1); PG8_STAGE_A(PG8_SA(0, 0), a2, 0, last);
            PG8_BAR; PG8_WAIT_L(0); PG8_MMA(1, 0, At, B0); PG8_BAR; PG8_SCHED;
            PG8_STAGE(PG8_SB(0, 1), b2 + hstep, voffB);
            PG8_WAIT_V(6); PG8_BAR; PG8_MMA(1, 1, At, B1); PG8_BAR;
            PG8_LDB(B0, 1, 0); PG8_SCHED; PG8_LDA(At, 1, 0); PG8_STAGE_A(PG8_SA(0, 1), a2, 1, last);
            PG8_WAIT_L(8); PG8_BAR; PG8_WAIT_L(0); PG8_MMA(0, 0, At, B0); PG8_BAR; PG8_SCHED;
            PG8_LDB(B1, 1, 1); PG8_STAGE(PG8_SB(1, 0), b3, voffB);
            PG8_BAR; PG8_WAIT_L(0); PG8_MMA(0, 1, At, B1); PG8_BAR;
            PG8_LDA(At, 1, 1); PG8_STAGE_A(PG8_SA(1, 0), a3, 0, last);
            PG8_BAR; PG8_WAIT_L(0); PG8_MMA(1, 0, At, B0); PG8_BAR; PG8_SCHED;
            PG8_STAGE(PG8_SB(1, 1), b3 + hstep, voffB);
            PG8_WAIT_V(6); PG8_BAR; PG8_MMA(1, 1, At, B1); PG8_BAR;
        }
        bool keep_acc = false;
        if constexpr (FP8) asm volatile("s_nop 15\n\ts_nop 15" ::: "memory");
        if constexpr (Epi::DUAL) { if (cur.aux) { E.mid(acc, cur, wr, wc, fr, fq); keep_acc = true; } else E(acc, cur, wr, wc, fr, fq); } else E(acc, cur, wr, wc, fr, fq);
        if (!has_next) break;
        if (!keep_acc)
#pragma unroll
        for (int a = 0; a < 2; ++a)
#pragma unroll
            for (int b = 0; b < 2; ++b)
#pragma unroll
                for (int m = 0; m < 4; ++m)
#pragma unroll
                    for (int n = 0; n < 2; ++n) acc[a][b][m][n] = (f32x4){0.f, 0.f, 0.f, 0.f};
        cur = nxt; cA = nA; cB = nB; ++ui;
        if constexpr (GATHER) {
#pragma unroll
            for (int h = 0; h < 2; ++h)
#pragma unroll
                for (int i = 0; i < 2; ++i) gA[h][i] = gN[h][i]; }
    }
    PG8_WAIT_V(0);
    if (wr == 0) PG8_BAR;
    PG8_BAR;
#undef PG8_SA
#undef PG8_SB
#undef PG8_STAGE
#undef PG8_STAGE_A
#undef PG8_LDA
#undef PG8_LD8
#undef PG8_LDB
#undef PG8_MMA
#undef PG8_WAIT_V
#undef PG8_WAIT_L
#undef PG8_BAR
#undef PG8_SCHED
#undef PG8_GIDX
}
}
using pg8::Unit;

#define EPI_LOOP(...) { int fr_ = fr, fq_ = fq; asm volatile("" : "+v"(fr_), "+v"(fq_)); _Pragma("unroll") for (int ai = 0; ai < 2; ++ai) _Pragma("unroll") for (int m = 0; m < 4; ++m) _Pragma("unroll") for (int bj = 0; bj < 2; ++bj) { \
        const int trow = ai * 128 + wr * 64 + m * 16 + fr_; const int tcol = bj * 128 + wc * 32 + fq_ * 8; const f32x4 v0 = acc[ai][bj][m][0], v1 = acc[ai][bj][m][1]; __VA_ARGS__ } }

__device__ __forceinline__ u32x4 pack8(const f32x4 a, const f32x4 b) { u32x4 w; w.x = cvt_pk_bf16(a[0], a[1]); w.y = cvt_pk_bf16(a[2], a[3]); w.z = cvt_pk_bf16(b[0], b[1]); w.w = cvt_pk_bf16(b[2], b[3]); return w; }

struct EpiProj { static constexpr bool DUAL = false;
    unsigned char* ws; const float* b_gate;
    __device__ __forceinline__ void operator()(const f32x4 (&acc)[2][2][4][2], const Unit& u, int wr, int wc, int fr, int fq) const {
        const int pn = u.pn; const size_t row0 = (size_t)u.pm * 256;
        if (pn == 4 || pn == 9) {
            float* dst = (float*)(ws + (pn == 4 ? WS_CKV : WS_MISC));
            EPI_LOOP({ float* p = dst + (row0 + trow) * 256 + tcol; *(f32x4*)p = v0; *(f32x4*)(p + 4) = v1;
                if (pn == 9 && tcol < 64) *(u32x4*)((bf16_t*)(ws + WS_KIDX) + (row0 + trow) * 64 + tcol) = pack8(v0, v1); })
        } else if (pn < 22) {
            bf16_t* dst; int ct;
            if (pn < 4) { dst = (bf16_t*)(ws + WS_QA); ct = pn; } else if (pn < 9) { dst = (bf16_t*)(ws + WS_QIDX); ct = pn - 5; }
            else if (pn < 14) { dst = (bf16_t*)(ws + WS_QB); ct = pn - 10; } else if (pn < 18) { dst = (bf16_t*)(ws + WS_KB); ct = pn - 14; } else { dst = (bf16_t*)(ws + WS_VB); ct = pn - 18; }
            EPI_LOOP({ *(u32x4*)(dst + (row0 + trow) * 1024 + ct * 256 + tcol) = pack8(v0, v1); })
        } else {
            bf16_t* dst = (bf16_t*)(ws + WS_GATES); const int ct = pn - 22;
            EPI_LOOP({ const int col = ct * 256 + tcol; const f32x4 b0 = *(const f32x4*)(b_gate + col), b1 = *(const f32x4*)(b_gate + col + 4); f32x4 s0, s1;
                _Pragma("unroll") for (int j = 0; j < 4; ++j) { s0[j] = sigmoidf_(v0[j] + b0[j]); s1[j] = sigmoidf_(v1[j] + b1[j]); }
                u32x2 w8; w8.x = pack_u8x4(s0[0], s0[1], s0[2], s0[3]); w8.y = pack_u8x4(s1[0], s1[1], s1[2], s1[3]); *(u32x2*)((unsigned char*)dst + (row0 + trow) * 4096 + col) = w8; })
        }
    }
};
struct EpiGate1 { static constexpr bool DUAL = false;
    const bf16_t* gates; bf16_t* T1;
    __device__ __forceinline__ void operator()(const f32x4 (&acc)[2][2][4][2], const Unit& u, int wr, int wc, int fr, int fq) const {
        EPI_LOOP({ const size_t row = (size_t)u.pm * 256 + trow; const int col = u.pn * 256 + tcol; const u32x2 g = *(const u32x2*)((const unsigned char*)gates + row * 4096 + col);
            const f32x4 o0 = v0 * unpack_u8x4(g.x), o1 = v1 * unpack_u8x4(g.y);
            *(u32x4*)(T1 + row * 2048 + col) = pack8(o0, o1); })
    }
};
struct EpiGate2 { static constexpr bool DUAL = false;
    const bf16_t* gates; const bf16_t* T1; unsigned char* merged;
    __device__ __forceinline__ void operator()(const f32x4 (&acc)[2][2][4][2], const Unit& u, int wr, int wc, int fr, int fq) const {
        EPI_LOOP({ const size_t row = (size_t)u.pm * 256 + trow; const int col = u.pn * 256 + tcol; const u32x2 g = *(const u32x2*)((const unsigned char*)gates + row * 4096 + 2048 + col);
            const u32x4 t = *(const u32x4*)(T1 + row * 2048 + col);
            const f32x4 o0 = (f32x4){bf_lo(t.x), bf_hi(t.x), bf_lo(t.y), bf_hi(t.y)} + v0 * unpack_u8x4(g.x), o1 = (f32x4){bf_lo(t.z), bf_hi(t.z), bf_lo(t.w), bf_hi(t.w)} + v1 * unpack_u8x4(g.y);
            u32x2 w8; w8.x = pack_fp8x4(o0[0] * 4.f, o0[1] * 4.f, o0[2] * 4.f, o0[3] * 4.f); w8.y = pack_fp8x4(o1[0] * 4.f, o1[1] * 4.f, o1[2] * 4.f, o1[3] * 4.f);
            *(u32x2*)(merged + row * 2048 + col) = w8; })
    }
};
struct EpiWo { static constexpr bool DUAL = false;
    const float* mod; bf16_t* y;
    __device__ __forceinline__ void operator()(const f32x4 (&acc)[2][2][4][2], const Unit& u, int wr, int wc, int fr, int fq) const {
        const float* gt = mod + (size_t)(u.pm >> 3) * 12288 + 4096;
        EPI_LOOP({ const size_t row = (size_t)u.pm * 256 + trow; const int col = u.pn * 256 + tcol;
            const f32x4 g0 = *(const f32x4*)(gt + col), g1 = *(const f32x4*)(gt + col + 4);
            *(u32x4*)(y + row * 2048 + col) = pack8(g0 * v0, g1 * v1); })
    }
};
struct DualOrder {
    pg8::StaticOrder S0, S1;
    __device__ bool next(int i, Unit& u) const { const bool ok = (i & 1) ? S1.next(i >> 1, u) : S0.next(i >> 1, u); u.aux = (i & 1) ? 0 : 1; return ok; }
};
struct EpiGate12 { static constexpr bool DUAL = false;
    EpiGate1 e1; EpiGate2 e2;
    __device__ __forceinline__ void operator()(const f32x4 (&acc)[2][2][4][2], const Unit& u, int wr, int wc, int fr, int fq) const { if (u.aux) e1(acc, u, wr, wc, fr, fq); else e2(acc, u, wr, wc, fr, fq); }
};

struct ProjOrder {
    pg8::StaticOrder S; int fp8; const char* Bfull;
    __device__ bool next(int i, Unit& u) const {
        if (!S.next(i, u)) return false;
        if (fp8) { if (u.pn >= 2) u.pn += 8; } else u.pn += 2;
        return true;
    }
};
__device__ __forceinline__ int map_row(int map, int n) {
    if (map == 0) return n;
    if (map == 1) { if (n < 2384) return n; if (n < 5456) return n + 176; if (n < 5464) return n - 3072; return n + 168; }
    if (map == 4) return n + 512;
    return n + 2384;
}
__device__ void ph0_prologue(const Params& p, LAS unsigned char* lds) {
    const int tid = threadIdx.x, wid = tid >> 6, lane = tid & 63, G = gridDim.x, bx = blockIdx.x;
    if (bx < 192) {
        LAS float* sc = (LAS float*)lds;
        LAS float* red = (LAS float*)(lds + 32768);
        const float* c = p.in[I_C];
        for (int i = tid; i < 4 * 2048; i += NTHREADS) { const float v = c[i]; sc[i] = v / (1.0f + __expf(-v)); }
        __syncthreads();
        for (int item = bx; item < 192; item += G) {
            const int n0 = item * 64, cg = lane & 15, rs = lane >> 4;
            float acc[4][4];
#pragma unroll
            for (int b = 0; b < 4; ++b)
#pragma unroll
                for (int j = 0; j < 4; ++j) acc[b][j] = 0.f;
            const float* w = p.in[I_WADA] + n0 + cg * 4;
#pragma unroll 4
            for (int step = 0; step < 64; ++step) {
                const int k = step * 32 + wid * 4 + rs;
                const f32x4 wv = *(const f32x4*)(w + (size_t)k * 12288);
#pragma unroll
                for (int b = 0; b < 4; ++b) { const float s = sc[b * 2048 + k];
#pragma unroll
                    for (int j = 0; j < 4; ++j) acc[b][j] += s * wv[j]; }
            }
#pragma unroll
            for (int b = 0; b < 4; ++b)
#pragma unroll
                for (int j = 0; j < 4; ++j) { float v = acc[b][j]; v += __shfl_xor(v, 16); v += __shfl_xor(v, 32); acc[b][j] = v; }
            if (rs == 0) {
#pragma unroll
                for (int b = 0; b < 4; ++b)
#pragma unroll
                    for (int j = 0; j < 4; ++j) red[(wid * 16 + cg) * 16 + b * 4 + j] = acc[b][j]; }
            __syncthreads();
            if (tid < 256) { const int cg2 = tid >> 4, bj = tid & 15, b = bj >> 2, j = bj & 3; float s = 0.f;
#pragma unroll
                for (int w8 = 0; w8 < 8; ++w8) s += red[(w8 * 16 + cg2) * 16 + bj];
                const int n = n0 + cg2 * 4 + j; ((float*)(p.ws + WS_MOD))[b * 12288 + n] = s + p.in[I_BADA][n]; }
            __syncthreads();
        }
    }
    { u32x4* z = (u32x4*)(p.ws + WS_WIN + (size_t)2392 * 2048 * 2); const int n16 = 168 * 2048 * 2 / 16;
      for (int i = bx * NTHREADS + tid; i < n16; i += G * NTHREADS) z[i] = (u32x4){0u, 0u, 0u, 0u}; }
    { bf16_t* wh = (bf16_t*)(p.ws + WS_WRH); bf16_t* wl = (bf16_t*)(p.ws + WS_WRL);
      for (int i = bx * NTHREADS + tid; i < 80 * 2048; i += G * NTHREADS) { const int n = i >> 11, k = i & 2047;
          const float v = n < 8 ? p.in[I_WRG][k * 8 + n] : (n < 72 ? p.in[I_WRE][k * 64 + n - 8] : 0.f);
          const unsigned h = cvt_pk_bf16(v, 0.f) & 0xffffu; const unsigned l = cvt_pk_bf16(v - bf_lo(h), 0.f) & 0xffffu; wh[i] = (bf16_t)h; wl[i] = (bf16_t)l; } }
    LAS float* tile0 = (LAS float*)(lds + 65536);
    f32x4 v[4];
#define T_DECODE(ti_) int j_ = 0; _Pragma("unroll 1") for (int q = 1; q < NJOBS; ++q) if ((ti_) >= p.jobs[q].tile0) j_ = q; const TJob& J = p.jobs[j_]; \
        int l_ = (ti_) - J.tile0; const int per_ = J.ntk * J.ntn; const int bt_ = l_ / per_; l_ -= bt_ * per_; const int tn_ = l_ / J.ntk, tk_ = l_ % J.ntk; const int k0 = tk_ * 64, n0 = tn_ * 128;
#define T_LOAD(ti_) do { T_DECODE(ti_) const float* src = J.src + (size_t)bt_ * J.sbatch; \
        _Pragma("unroll") for (int i = 0; i < 4; ++i) { const int r = (tid >> 5) + 16 * i, c4 = (tid & 31) * 4; \
            v[i] = (f32x4){0.f, 0.f, 0.f, 0.f}; if (n0 + c4 < J.N) v[i] = *(const f32x4*)(src + (size_t)(k0 + r) * J.ld + n0 + c4); } } while (0)
    if (bx < p.ntiles_total) T_LOAD(bx);
    int it = 0;
    for (int ti = bx; ti < p.ntiles_total; ti += G, ++it) {
        LAS float* tile = tile0 + (it & 1) * (64 * 129);
#pragma unroll
        for (int i = 0; i < 4; ++i) { const int r = (tid >> 5) + 16 * i, c4 = (tid & 31) * 4;
#pragma unroll
            for (int q = 0; q < 4; ++q) tile[r * 129 + c4 + q] = v[i][q]; }
        __syncthreads();
        if (ti + G < p.ntiles_total) T_LOAD(ti + G);
        { T_DECODE(ti) bf16_t* dst = J.dst + (size_t)bt_ * J.dbatch;
          const int n = tid >> 2, kq = (tid & 3) * 16;
          if (n0 + n < J.N) { float f[16];
#pragma unroll
              for (int q = 0; q < 16; ++q) f[q] = tile[(kq + q) * 129 + n];
              if (J.fp8) { u32x4 w8; w8.x = pack_fp8x4(f[0] * 64.f, f[1] * 64.f, f[2] * 64.f, f[3] * 64.f); w8.y = pack_fp8x4(f[4] * 64.f, f[5] * 64.f, f[6] * 64.f, f[7] * 64.f);
                  w8.z = pack_fp8x4(f[8] * 64.f, f[9] * 64.f, f[10] * 64.f, f[11] * 64.f); w8.w = pack_fp8x4(f[12] * 64.f, f[13] * 64.f, f[14] * 64.f, f[15] * 64.f);
                  *(u32x4*)((unsigned char*)dst + (size_t)(n0 + n) * J.ldd + k0 + kq) = w8; }
              else { u32x4 w0, w1; w0.x = cvt_pk_bf16(f[0], f[1]); w0.y = cvt_pk_bf16(f[2], f[3]); w0.z = cvt_pk_bf16(f[4], f[5]); w0.w = cvt_pk_bf16(f[6], f[7]);
                  w1.x = cvt_pk_bf16(f[8], f[9]); w1.y = cvt_pk_bf16(f[10], f[11]); w1.z = cvt_pk_bf16(f[12], f[13]); w1.w = cvt_pk_bf16(f[14], f[15]);
                  bf16_t* d = dst + (size_t)map_row(J.map, n0 + n) * J.ldd + k0 + kq; *(u32x4*)d = w0; *(u32x4*)(d + 8) = w1; } } }
    }
#undef T_LOAD
#undef T_DECODE
    __syncthreads();
}

__device__ __forceinline__ void norm_row(const float* xr, const float* g, const float* sh, const float* sc, bf16_t* hr, unsigned char* h8, int lane, float (&hv)[32]) {
    f32x4 v[8]; float ss = 0.f;
#pragma unroll
    for (int i = 0; i < 8; ++i) { v[i] = *(const f32x4*)(xr + i * 256 + lane * 4); ss += v[i][0] * v[i][0] + v[i][1] * v[i][1] + v[i][2] * v[i][2] + v[i][3] * v[i][3]; }
    ss = wave_sum(ss);
    const float rstd = rsqrtf(ss * (1.0f / 2048.0f) + RMS_EPS);
#pragma unroll
    for (int i = 0; i < 8; ++i) { const int col = i * 256 + lane * 4; const f32x4 gg = *(const f32x4*)(g + col), s1 = *(const f32x4*)(sc + col), s0 = *(const f32x4*)(sh + col);
#pragma unroll
        for (int j = 0; j < 4; ++j) hv[i * 4 + j] = v[i][j] * rstd * gg[j] * (1.0f + s1[j]) + s0[j];
        u32x2 w; w.x = cvt_pk_bf16(hv[i * 4], hv[i * 4 + 1]); w.y = cvt_pk_bf16(hv[i * 4 + 2], hv[i * 4 + 3]); *(u32x2*)(hr + col) = w;
        if (h8) *(unsigned*)(h8 + col) = pack_fp8x4(hv[i * 4], hv[i * 4 + 1], hv[i * 4 + 2], hv[i * 4 + 3]); }
}
__device__ void ph1_norm(const Params& p) {
    const int lane = threadIdx.x & 63, gw = blockIdx.x * 8 + (threadIdx.x >> 6), nw = gridDim.x * 8;
    const float* mod = (const float*)(p.ws + WS_MOD);
    for (int t = gw; t < NTOK; t += nw) { const int b = t >> 11; float hv[32];
        norm_row(p.in[I_X] + (size_t)t * DM, p.in[I_GMIX], mod + b * 12288, mod + b * 12288 + 2048, (bf16_t*)(p.ws + WS_H) + (size_t)t * DM, (unsigned char*)(p.ws + WS_HF8) + (size_t)t * DM, lane, hv); }
}

template <int MB, int NB, int KS>
__device__ __forceinline__ void wave_gemm(const bf16_t* A, int lda, const bf16_t* Bt, int ldb, f32x4 (&acc)[MB][NB], int lane) {
    const int fr = lane & 15, fq = lane >> 4;
#pragma unroll
    for (int mb = 0; mb < MB; ++mb)
#pragma unroll
        for (int nb = 0; nb < NB; ++nb) acc[mb][nb] = (f32x4){0.f, 0.f, 0.f, 0.f};
#pragma unroll 1
    for (int ks = 0; ks < KS; ++ks) {
        bf16x8 af[MB];
#pragma unroll
        for (int mb = 0; mb < MB; ++mb) af[mb] = *(const bf16x8*)(A + (size_t)(mb * 16 + fr) * lda + ks * 32 + fq * 8);
#pragma unroll
        for (int nb = 0; nb < NB; ++nb) { const bf16x8 bf = *(const bf16x8*)(Bt + (size_t)(nb * 16 + fr) * ldb + ks * 32 + fq * 8);
#pragma unroll
            for (int mb = 0; mb < MB; ++mb) acc[mb][nb] = __builtin_amdgcn_mfma_f32_16x16x32_bf16(bf, af[mb], acc[mb][nb], 0, 0, 0); }
    }
}


__device__ __forceinline__ int wave_total_i32(int v) {
    v += __builtin_amdgcn_update_dpp(0, v, 0x111, 0xf, 0xf, true); v += __builtin_amdgcn_update_dpp(0, v, 0x112, 0xf, 0xf, true);
    v += __builtin_amdgcn_update_dpp(0, v, 0x114, 0xf, 0xf, true); v += __builtin_amdgcn_update_dpp(0, v, 0x118, 0xf, 0xf, true);
    v += __builtin_amdgcn_update_dpp(0, v, 0x142, 0xa, 0xf, false); v += __builtin_amdgcn_update_dpp(0, v, 0x143, 0xc, 0xf, false);
    return __builtin_amdgcn_readlane(v, 63);
}
template <int NI> __device__ __forceinline__ void topk_words2(const LAS float* srow0, const LAS float* srow1, int c, int lane, unsigned long long& w0, unsigned long long& w1) {
    unsigned ka[NI], kb[NI];
#pragma unroll
    for (int i = 0; i < NI; ++i) { unsigned u = 0u, x = 0u; if (i <= c) { u = __float_as_uint(srow0[i * 64 + lane]); u = (u & 0x80000000u) ? ~u : (u | 0x80000000u);
            x = __float_as_uint(srow1[i * 64 + lane]); x = (x & 0x80000000u) ? ~x : (x | 0x80000000u); } ka[i] = u; kb[i] = x; }
    unsigned va = 0u, vb = 0u; bool da = false, db = false;
#pragma unroll 1
    for (int bit = 31; bit >= 0; --bit) {
        const unsigned ca = va | (1u << bit), cb = vb | (1u << bit); int a0 = 0, a1 = 0, b0 = 0, b1 = 0;
#pragma unroll
        for (int i = 0; i < NI; i += 2) { a0 += (ka[i] >= ca) ? 1 : 0; a1 += (ka[i + 1] >= ca) ? 1 : 0; b0 += (kb[i] >= cb) ? 1 : 0; b1 += (kb[i + 1] >= cb) ? 1 : 0; }
        const int ta = wave_total_i32(a0 + a1), tb = wave_total_i32(b0 + b1);
        if (!da && ta >= 256) { va = ca; da = (ta == 256); }
        if (!db && tb >= 256) { vb = cb; db = (tb == 256); }
        if (da && db) break;
    }
    w0 = 0ull; w1 = 0ull;
#pragma unroll
    for (int i = 0; i < NI; ++i) { const unsigned long long ma = __ballot(ka[i] >= va), mb = __ballot(kb[i] >= vb); if (lane == i) { w0 = ma; w1 = mb; } if ((i & 3) == 3) SBAR(); }
}

__device__ void idx_item(const Params& p, LAS unsigned char* lds, int b, int c, int sub) {
    const int tid = threadIdx.x, wid = tid >> 6, lane = tid & 63, fr = lane & 15, fq = lane >> 4;
    constexpr int SCLD = 2052;
    LAS float* sc = (LAS float*)lds;
    const int q0 = c * 64 + sub * 16, nk = (c + 1) * 64, nkb = nk / 16;
    const bf16_t* qidx = (const bf16_t*)(p.ws + WS_QIDX) + (size_t)(b * SEQ + q0 + fr) * 1024;
    const float* misc = (const float*)(p.ws + WS_MISC);
    float wq[16];
    { const float* wp = misc + (size_t)(b * SEQ + q0 + fr) * 256 + 64;
#pragma unroll
      for (int i = 0; i < 4; ++i) { const f32x4 v = *(const f32x4*)(wp + i * 4); wq[i * 4] = v[0]; wq[i * 4 + 1] = v[1]; wq[i * 4 + 2] = v[2]; wq[i * 4 + 3] = v[3]; } }
    {
        bf16x8 qf[16][2];
#pragma unroll
        for (int h = 0; h < 16; ++h)
#pragma unroll
            for (int ks = 0; ks < 2; ++ks) qf[h][ks] = *(const bf16x8*)(qidx + h * 64 + ks * 32 + fq * 8);
        const bf16_t* kbase = (const bf16_t*)(p.ws + WS_KIDX) + (size_t)(b * SEQ + fr) * 64 + fq * 8;
        bf16x8 kf[2];
        if (wid < nkb) { kf[0] = *(const bf16x8*)(kbase + (size_t)wid * 16 * 64); kf[1] = *(const bf16x8*)(kbase + (size_t)wid * 16 * 64 + 32); }
#pragma unroll 1
        for (int kb = wid; kb < nkb; kb += 8) {
            const int kn = kb + 8 < nkb ? kb + 8 : kb;
            const bf16x8 kn0 = *(const bf16x8*)(kbase + (size_t)kn * 16 * 64), kn1 = *(const bf16x8*)(kbase + (size_t)kn * 16 * 64 + 32);
            f32x4 s = {0.f, 0.f, 0.f, 0.f};
#pragma unroll
            for (int h = 0; h < 16; ++h) {
                f32x4 a = {0.f, 0.f, 0.f, 0.f};
                a = __builtin_amdgcn_mfma_f32_16x16x32_bf16(kf[0], qf[h][0], a, 0, 0, 0);
                a = __builtin_amdgcn_mfma_f32_16x16x32_bf16(kf[1], qf[h][1], a, 0, 0, 0);
#pragma unroll
                for (int j = 0; j < 4; ++j) s[j] += wq[h] * fmaxf(a[j], 0.f);
            }
            *(LAS f32x4*)(sc + fr * SCLD + kb * 16 + fq * 4) = s;
            kf[0] = kn0; kf[1] = kn1;
        }
    }
    __syncthreads();
    unsigned long long* mask = (unsigned long long*)(p.ws + WS_MASK);
    {
        const int ql = wid * 2; const size_t qg = (size_t)b * SEQ + q0 + ql;
        unsigned long long w0 = 0ull, w1 = 0ull;
        if (nk <= 256) { if (lane <= c) { w0 = ~0ull; w1 = ~0ull; } }
        else { const LAS float* s0 = sc + ql * SCLD; const LAS float* s1 = s0 + SCLD;
            if (c < 8) topk_words2<8>(s0, s1, c, lane, w0, w1); else if (c < 16) topk_words2<16>(s0, s1, c, lane, w0, w1);
            else if (c < 24) topk_words2<24>(s0, s1, c, lane, w0, w1); else topk_words2<32>(s0, s1, c, lane, w0, w1); }
        if (lane < 32) { mask[qg * 32 + lane] = w0; mask[(qg + 1) * 32 + lane] = w1; }
    }
    __syncthreads();
}
#ifndef REP_SUB
#define REP_SUB 15
#endif
__device__ void ph3_prep(const Params& p, LAS unsigned char* lds, const int rep) {
#define P3ON(bit) (!rep || ((REP_SUB) & (bit)))
    const int tid = threadIdx.x, wid = tid >> 6, lane = tid & 63, bx = blockIdx.x, G = gridDim.x;
    if (P3ON(1)) for (int it = bx; it < 256; it += G) {
        const int b = it >> 6, r = it & 63, cp = r >> 2, sub = r & 3;
        idx_item(p, lds, b, 31 - cp, sub); idx_item(p, lds, b, cp, sub);
    }
    const int gw = bx * 8 + wid, nw = G * 8;
    if (P3ON(2)) for (int it = gw; it < 2048; it += nw) {
        const int rt = it >> 3, h = it & 7, fr = lane & 15, fq = lane >> 4;
        f32x4 acc[2][16];
        wave_gemm<2, 16, 4>((const bf16_t*)(p.ws + WS_QA) + (size_t)rt * 32 * 1024 + h * 128, 1024, (const bf16_t*)(p.ws + WS_WUK) + (size_t)h * 256 * 128, 128, acc, lane);
#pragma unroll
        for (int mb = 0; mb < 2; ++mb) { float ss = 0.f;
#pragma unroll
            for (int nb = 0; nb < 16; ++nb)
#pragma unroll
                for (int j = 0; j < 4; ++j) ss += acc[mb][nb][j] * acc[mb][nb][j];
            ss += __shfl_xor(ss, 16); ss += __shfl_xor(ss, 32);
            const float rs = rsqrtf(ss * (1.0f / 256.0f) + RMS_EPS) * 0.0625f;
            bf16_t* o = (bf16_t*)(p.ws + WS_QLAT) + (size_t)(rt * 32 + mb * 16 + fr) * 2048 + h * 256;
#pragma unroll
            for (int nb = 0; nb < 16; ++nb) { const int col = nb * 16 + fq * 4; const f32x4 g = *(const f32x4*)(p.in[I_GQA] + col);
                u32x2 w; w.x = cvt_pk_bf16(acc[mb][nb][0] * rs * g[0], acc[mb][nb][1] * rs * g[1]); w.y = cvt_pk_bf16(acc[mb][nb][2] * rs * g[2], acc[mb][nb][3] * rs * g[3]); *(u32x2*)(o + col) = w; } }
    }
    if (P3ON(4))
#pragma unroll 4
    for (int t = gw; t < NTOK; t += nw) {
        { const f32x4 v = *(const f32x4*)((const float*)(p.ws + WS_CKV) + (size_t)t * 256 + lane * 4); float ss = wave_sum(v[0] * v[0] + v[1] * v[1] + v[2] * v[2] + v[3] * v[3]);
          const float rs = rsqrtf(ss * (1.0f / 256.0f) + RMS_EPS); const f32x4 g = *(const f32x4*)(p.in[I_GKV] + lane * 4);
          u32x2 w; w.x = cvt_pk_bf16(v[0] * rs * g[0], v[1] * rs * g[1]); w.y = cvt_pk_bf16(v[2] * rs * g[2], v[3] * rs * g[3]); *(u32x2*)((bf16_t*)(p.ws + WS_KV) + (size_t)t * 256 + lane * 4) = w; }
#pragma unroll
        for (int which = 1; which < 2; ++which) {
            bf16_t* row = (bf16_t*)(p.ws + (which ? WS_KB : WS_QB)) + (size_t)t * 1024 + lane * 16; const float* g = p.in[which ? I_GKB : I_GQB] + (lane & 7) * 16;
            u32x4 a = *(u32x4*)row, c2 = *(u32x4*)(row + 8); float f[16];
            f[0] = bf_lo(a.x); f[1] = bf_hi(a.x); f[2] = bf_lo(a.y); f[3] = bf_hi(a.y); f[4] = bf_lo(a.z); f[5] = bf_hi(a.z); f[6] = bf_lo(a.w); f[7] = bf_hi(a.w);
            f[8] = bf_lo(c2.x); f[9] = bf_hi(c2.x); f[10] = bf_lo(c2.y); f[11] = bf_hi(c2.y); f[12] = bf_lo(c2.z); f[13] = bf_hi(c2.z); f[14] = bf_lo(c2.w); f[15] = bf_hi(c2.w);
            float ss = 0.f;
#pragma unroll
            for (int j = 0; j < 16; ++j) ss += f[j] * f[j];
            ss += __shfl_xor(ss, 1); ss += __shfl_xor(ss, 2); ss += __shfl_xor(ss, 4);
            const float rs = rsqrtf(ss * (1.0f / 128.0f) + RMS_EPS) * (which ? 1.0f : 0.08838834764831845f);
#pragma unroll
            for (int j = 0; j < 16; ++j) f[j] *= rs * g[j];
            a.x = cvt_pk_bf16(f[0], f[1]); a.y = cvt_pk_bf16(f[2], f[3]); a.z = cvt_pk_bf16(f[4], f[5]); a.w = cvt_pk_bf16(f[6], f[7]);
            c2.x = cvt_pk_bf16(f[8], f[9]); c2.y = cvt_pk_bf16(f[10], f[11]); c2.z = cvt_pk_bf16(f[12], f[13]); c2.w = cvt_pk_bf16(f[14], f[15]);
            if (!rep) { *(u32x4*)row = a; *(u32x4*)(row + 8) = c2; } else if (a.x == 0x12345678u) *(u32x4*)row = c2;
        }
    }
    if (P3ON(8) && bx < NBATCH) {
        const int b = bx; const float* fp = (const float*)(p.ws + WS_MISC) + (size_t)(b * SEQ + 4 * tid) * 256 + 80;
        float ls[4][8];
#pragma unroll
        for (int j = 0; j < 4; ++j) { const f32x4 a = *(const f32x4*)(fp + j * 256), c4 = *(const f32x4*)(fp + j * 256 + 4);
#pragma unroll
            for (int h = 0; h < 8; ++h) { const float z = (h < 4 ? a[h & 3] : c4[h & 3]) + p.in[I_BFORGET][h]; ls[j][h] = fminf(z, 0.f) - log1pf(__expf(-fabsf(z))); } }
        LAS float* wt = (LAS float*)lds;
        float off[8];
#pragma unroll
        for (int h = 0; h < 8; ++h) { ls[1][h] += ls[0][h]; ls[2][h] += ls[1][h]; ls[3][h] += ls[2][h];
            float incl = ls[3][h];
#pragma unroll
            for (int o = 1; o < 64; o <<= 1) { const float t2 = __shfl_up(incl, o); if (lane >= o) incl += t2; }
            if (lane == 63) wt[wid * 8 + h] = incl;
            off[h] = incl - ls[3][h]; }
        __syncthreads();
#pragma unroll
        for (int h = 0; h < 8; ++h) { float wo = 0.f; for (int w8 = 0; w8 < wid; ++w8) wo += wt[w8 * 8 + h];
            float* cp = (float*)(p.ws + WS_CUM) + (size_t)(b * 8 + h) * SEQ + 4 * tid;
            *(f32x4*)cp = (f32x4){ls[0][h] + off[h] + wo, ls[1][h] + off[h] + wo, ls[2][h] + off[h] + wo, ls[3][h] + off[h] + wo}; }
        __syncthreads();
    }
}

template <int OFF> __device__ __forceinline__ s16x4 tr_read(int vb) { s16x4 r; asm volatile("ds_read_b64_tr_b16 %0, %1 offset:%2" : "=&v"(r) : "v"(vb), "i"(OFF) : "memory"); return r; }
__device__ __forceinline__ int v_rd_base(int lane) { return ((lane & 3) << 3) | (((lane >> 2) & 3) << 6) | (((lane >> 4) & 1) << 5) | (((lane >> 5) & 1) << 8); }
#define PK4(P, BASE, OUT) do { unsigned a0 = cvt_pk_bf16(P[BASE + 0], P[BASE + 1]), a1 = cvt_pk_bf16(P[BASE + 2], P[BASE + 3]);   \
    unsigned b0 = cvt_pk_bf16(P[BASE + 4], P[BASE + 5]), b1 = cvt_pk_bf16(P[BASE + 6], P[BASE + 7]);                              \
    auto r0 = __builtin_amdgcn_permlane32_swap(a0, b0, false, false); auto r1 = __builtin_amdgcn_permlane32_swap(a1, b1, false, false); \
    u32x4 w = {r0[0], r1[0], r0[1], r1[1]}; OUT = *reinterpret_cast<bf16x8*>(&w); } while (0)
#define PKV(L, H) (bf16x8){L[0], L[1], L[2], L[3], H[0], H[1], H[2], H[3]}
template <int NCB, int KS0, int D0> struct PvPairs { static __device__ __forceinline__ void run(f32x16* o, int vb, bf16x8 pa0, bf16x8 pa1) {
    constexpr int S = 2 * NCB * 512, H = NCB * 512;
    const s16x4 l00 = tr_read<D0 * 512 + KS0 * S>(vb), h00 = tr_read<D0 * 512 + KS0 * S + H>(vb), l01 = tr_read<D0 * 512 + (KS0 + 1) * S>(vb), h01 = tr_read<D0 * 512 + (KS0 + 1) * S + H>(vb);
    const s16x4 l10 = tr_read<(D0 + 1) * 512 + KS0 * S>(vb), h10 = tr_read<(D0 + 1) * 512 + KS0 * S + H>(vb), l11 = tr_read<(D0 + 1) * 512 + (KS0 + 1) * S>(vb), h11 = tr_read<(D0 + 1) * 512 + (KS0 + 1) * S + H>(vb);
    asm volatile("s_waitcnt lgkmcnt(0)" ::: "memory"); SBAR();
    o[D0] = __builtin_amdgcn_mfma_f32_32x32x16_bf16(pa0, PKV(l00, h00), o[D0], 0, 0, 0); o[D0 + 1] = __builtin_amdgcn_mfma_f32_32x32x16_bf16(pa0, PKV(l10, h10), o[D0 + 1], 0, 0, 0);
    o[D0] = __builtin_amdgcn_mfma_f32_32x32x16_bf16(pa1, PKV(l01, h01), o[D0], 0, 0, 0); o[D0 + 1] = __builtin_amdgcn_mfma_f32_32x32x16_bf16(pa1, PKV(l11, h11), o[D0 + 1], 0, 0, 0);
    if constexpr (D0 + 2 < NCB) PvPairs<NCB, KS0, D0 + 2>::run(o, vb, pa0, pa1); } };
__device__ __forceinline__ int swap23(int k) { return (k & ~0xC) | ((k & 4) << 1) | ((k & 8) >> 1); }
constexpr int FOX_STAGE = 33024;
constexpr int FOX_AL = 2 * FOX_STAGE, FOX_LI = FOX_AL + 1024;
__device__ void fox_item(const Params& p, LAS unsigned char* lds, int b, int h, int qb) {
    int tid = threadIdx.x; asm volatile("" : "+v"(tid));
    const int wid = __builtin_amdgcn_readfirstlane(tid >> 6), lane = tid & 63, r32 = lane & 31, hi = lane >> 5;
    const bf16_t* Q = (const bf16_t*)(p.ws + WS_QB);
    const char* Kg = (const char*)(p.ws + WS_KB) + ((size_t)b * SEQ * 1024 + h * 128) * 2; const char* Vg = (const char*)(p.ws + WS_VB) + ((size_t)b * SEQ * 1024 + h * 128) * 2;
    const float* cum = (const float*)(p.ws + WS_CUM) + (size_t)(b * 8 + h) * SEQ;
    const int qpos = qb * 256 + wid * 32 + r32;
    bf16x8 qr[8];
    { const bf16_t* qp = Q + (size_t)(b * SEQ + qpos) * 1024 + h * 128 + hi * 8;
#pragma unroll
      for (int d0 = 0; d0 < 8; ++d0) qr[d0] = *(const bf16x8*)(qp + d0 * 16);
      float ss = 0.f;
#pragma unroll
      for (int d0 = 0; d0 < 8; ++d0) { const u32x4 w = *reinterpret_cast<const u32x4*>(&qr[d0]);
#pragma unroll
          for (int j = 0; j < 4; ++j) { const float a = bf_lo(w[j]), c = bf_hi(w[j]); ss += a * a + c * c; } }
      ss += __shfl_xor(ss, 32);
      const float rs = rsqrtf(ss * (1.0f / 128.0f) + RMS_EPS) * 0.08838834764831845f;
      const float* g = p.in[I_GQB] + hi * 8;
#pragma unroll
      for (int d0 = 0; d0 < 8; ++d0) { u32x4 w = *reinterpret_cast<const u32x4*>(&qr[d0]); const f32x4 g0 = *(const f32x4*)(g + d0 * 16), g1 = *(const f32x4*)(g + d0 * 16 + 4);
          w[0] = cvt_pk_bf16(bf_lo(w[0]) * (rs * g0[0]), bf_hi(w[0]) * (rs * g0[1])); w[1] = cvt_pk_bf16(bf_lo(w[1]) * (rs * g0[2]), bf_hi(w[1]) * (rs * g0[3]));
          w[2] = cvt_pk_bf16(bf_lo(w[2]) * (rs * g1[0]), bf_hi(w[2]) * (rs * g1[1])); w[3] = cvt_pk_bf16(bf_lo(w[3]) * (rs * g1[2]), bf_hi(w[3]) * (rs * g1[3]));
          qr[d0] = *reinterpret_cast<bf16x8*>(&w); } }
    const float cq = cum[qpos] * LOG2E;
    unsigned ksrc[2], vsrc[2];
#pragma unroll
    for (int i = 0; i < 2; ++i) { const int pos = (i * 512 + tid) * 16;
        { const int row = pos >> 8; const int cb = (pos & 255) ^ ((row & 7) << 4); ksrc[i] = (unsigned)(row * 2048 + cb); }
        { const int sub = pos >> 9, within = pos & 511; const int kk = (sub >> 2) * 8 + (within >> 6); const int c = (sub & 3) * 32 + ((within & 63) >> 1); vsrc[i] = (unsigned)(swap23(kk) * 2048 + c * 2); } }
    float m_reg = -1e30f, l_reg = 0.f; f32x16 o[4];
#pragma unroll
    for (int d = 0; d < 4; ++d)
#pragma unroll
        for (int r = 0; r < 16; ++r) o[d][r] = 0.f;
    LAS float* al_l = (LAS float*)(lds + FOX_AL) + wid * 32; LAS float* li_l = (LAS float*)(lds + FOX_LI) + wid * 32;
    const int ntiles = qb * 4 + 4, mylast = qb * 4 + (wid >> 1);
#define FOX_DMA(kt) do { LAS unsigned char* sb_ = lds + ((kt) & 1) * FOX_STAGE; const size_t go_ = (size_t)(kt) * 64 * 2048; \
        _Pragma("unroll") for (int i = 0; i < 2; ++i) { \
            __builtin_amdgcn_global_load_lds((const unsigned*)(Kg + go_ + ksrc[i]), (LAS unsigned*)(sb_ + 16384 + (i * 512 + wid * 64) * 16), 16, 0, 0); \
            __builtin_amdgcn_global_load_lds((const unsigned*)(Vg + go_ + vsrc[i]), (LAS unsigned*)(sb_ + (i * 512 + wid * 64) * 16), 16, 0, 0); } \
        if (wid == 0) __builtin_amdgcn_global_load_lds((const unsigned*)(cum + (kt) * 64 + lane), (LAS unsigned*)(sb_ + 32768), 4, 0, 0); } while (0)
    __syncthreads();
    FOX_DMA(0);
    for (int kt = 0; kt < ntiles; ++kt) {
        asm volatile("s_waitcnt vmcnt(0)" ::: "memory");
        __syncthreads();
        if (kt + 1 < ntiles) FOX_DMA(kt + 1);
        if (kt <= mylast) {
            const LAS unsigned char* sb = lds + (kt & 1) * FOX_STAGE; const LAS float* ck = (const LAS float*)(sb + 32768);
            const int vb = (int)(uintptr_t)sb + v_rd_base(lane);
            f32x16 p0, p1;
#pragma unroll
            for (int r = 0; r < 16; ++r) { p0[r] = 0.f; p1[r] = 0.f; }
            int fsw = (r32 & 7) << 4; asm volatile("" : "+v"(fsw));
#pragma unroll
            for (int d0 = 0; d0 < 8; ++d0) { const int cb = (d0 * 16 + hi * 8) * 2;
                const bf16x8 b0 = *(const LAS bf16x8*)(sb + 16384 + r32 * 256 + (cb ^ fsw));
                const bf16x8 b1 = *(const LAS bf16x8*)(sb + 16384 + (32 + r32) * 256 + (cb ^ fsw));
                p0 = __builtin_amdgcn_mfma_f32_32x32x16_bf16(b0, qr[d0], p0, 0, 0, 0); p1 = __builtin_amdgcn_mfma_f32_32x32x16_bf16(b1, qr[d0], p1, 0, 0, 0); }
            const bool diag = (kt * 64 + 63 > qb * 256 + wid * 32);
            float pmax = -INFINITY;
#pragma unroll
            for (int g4 = 0; g4 < 4; ++g4) { const f32x4 c0 = *(const LAS f32x4*)(ck + 8 * g4 + 4 * hi), c1 = *(const LAS f32x4*)(ck + 32 + 8 * g4 + 4 * hi);
#pragma unroll
                for (int j = 0; j < 4; ++j) { const int r = g4 * 4 + j; float t0 = fmaf(p0[r], LOG2E, cq) - c0[j] * LOG2E, t1 = fmaf(p1[r], LOG2E, cq) - c1[j] * LOG2E;
                    if (diag) { const int kp = kt * 64 + crow(r, hi); if (kp > qpos) t0 = -INFINITY; if (kp + 32 > qpos) t1 = -INFINITY; }
                    p0[r] = t0; p1[r] = t1; pmax = fmaxf(pmax, fmaxf(t0, t1)); } }
            { auto rr = __builtin_amdgcn_permlane32_swap(__float_as_uint(pmax), __float_as_uint(pmax), false, false); pmax = fmaxf(__uint_as_float(rr[0]), __uint_as_float(rr[1])); }
            const float mn = fmaxf(m_reg, pmax); const float alpha = __builtin_amdgcn_exp2f(m_reg - mn); m_reg = mn;
            float ps = 0.f;
#pragma unroll
            for (int r = 0; r < 16; ++r) { p0[r] = __builtin_amdgcn_exp2f(p0[r] - mn); p1[r] = __builtin_amdgcn_exp2f(p1[r] - mn); ps += p0[r] + p1[r]; }
            { auto rr = __builtin_amdgcn_permlane32_swap(__float_as_uint(ps), __float_as_uint(ps), false, false); ps = __uint_as_float(rr[0]) + __uint_as_float(rr[1]); }
            l_reg = l_reg * alpha + ps;
            if (__any(alpha < 1.f)) { if (hi == 0) al_l[r32] = alpha; asm volatile("s_waitcnt lgkmcnt(0)" ::: "memory");
#pragma unroll
                for (int r = 0; r < 16; ++r) { const float a = al_l[crow(r, hi)];
#pragma unroll
                    for (int d = 0; d < 4; ++d) o[d][r] *= a; } }
            bf16x8 pa0, pa1, pa2, pa3; PK4(p0, 0, pa0); PK4(p0, 8, pa1); PK4(p1, 0, pa2); PK4(p1, 8, pa3);
            PvPairs<4, 0, 0>::run(o, vb, pa0, pa1); PvPairs<4, 2, 0>::run(o, vb, pa2, pa3);
        }
    }
#undef FOX_DMA
    if (hi == 0) li_l[r32] = l_reg; asm volatile("s_waitcnt lgkmcnt(0)" ::: "memory");
    unsigned char* O8 = (unsigned char*)(p.ws + WS_OB8) + (size_t)(b * SEQ + qb * 256 + wid * 32) * 1024 + h * 128;
#pragma unroll
    for (int r = 0; r < 16; ++r) { const float rl = __builtin_amdgcn_rcpf(li_l[crow(r, hi)]); const int orow = crow(r, hi);
#pragma unroll
        for (int d0 = 0; d0 < 4; ++d0) O8[(size_t)orow * 1024 + d0 * 32 + r32] = (unsigned char)(pack_fp8x4(o[d0][r] * rl * 8.f, 0.f, 0.f, 0.f) & 0xffu); }
}

constexpr int DSA_STAGE = 32768;
constexpr int DSA_AL = 2 * DSA_STAGE, DSA_LI = DSA_AL + 1024, DSA_Q = DSA_LI + 1024;
__device__ void dsa_item(const Params& p, LAS unsigned char* lds, int b, int qt) {
    int tid = threadIdx.x; asm volatile("" : "+v"(tid));
    const int wid = __builtin_amdgcn_readfirstlane(tid >> 6), lane = tid & 63, r32 = lane & 31, hi = lane >> 5, h = wid;
    const char* KV = (const char*)(p.ws + WS_KV) + (size_t)b * SEQ * 512;
    const int qpos = qt * 32 + r32; const size_t qg = (size_t)b * SEQ + qpos;
    const unsigned* mask = (const unsigned*)(p.ws + WS_MASK) + qg * 64;
    bf16x8 qr[8];
    LAS unsigned char* qlds = lds + DSA_Q + wid * 8192 + lane * 16;
    __syncthreads();
    { const bf16_t* qp = (const bf16_t*)(p.ws + WS_QLAT) + qg * 2048 + h * 256 + hi * 8;
#pragma unroll
      for (int d0 = 0; d0 < 8; ++d0) qr[d0] = *(const bf16x8*)(qp + d0 * 16);
#pragma unroll
      for (int d0 = 8; d0 < 16; ++d0) *(LAS bf16x8*)(qlds + (d0 - 8) * 1024) = *(const bf16x8*)(qp + d0 * 16); }
    unsigned ksrc[2], vsrc[2];
#pragma unroll
    for (int i = 0; i < 2; ++i) { const int pos = (i * 512 + tid) * 16;
        { const int row = pos >> 9; const int cb = (pos & 511) ^ ((row & 15) << 4); ksrc[i] = (unsigned)(row * 512 + cb); }
        { const int sub = pos >> 9, within = pos & 511; const int kk = (sub >> 3) * 8 + (within >> 6); const int c = (sub & 7) * 32 + ((within & 63) >> 1); vsrc[i] = (unsigned)(swap23(kk) * 512 + c * 2); } }
    const float slopeL = exp2f(-(float)(h + 1)) * LOG2E;
    float m_reg = -1e30f, l_reg = 0.f; f32x16 o[8];
#pragma unroll
    for (int d = 0; d < 8; ++d)
#pragma unroll
        for (int r = 0; r < 16; ++r) o[d][r] = 0.f;
    LAS float* al_l = (LAS float*)(lds + DSA_AL) + wid * 32; LAS float* li_l = (LAS float*)(lds + DSA_LI) + wid * 32;
    const int ntiles = ((qt >> 1) + 1) * 2;
#define DSA_DMA(kt) do { LAS unsigned char* sb_ = lds + ((kt) & 1) * DSA_STAGE; const size_t go_ = (size_t)(kt) * 32 * 512; \
        _Pragma("unroll") for (int i = 0; i < 2; ++i) { \
            __builtin_amdgcn_global_load_lds((const unsigned*)(KV + go_ + ksrc[i]), (LAS unsigned*)(sb_ + 16384 + (i * 512 + wid * 64) * 16), 16, 0, 0); \
            __builtin_amdgcn_global_load_lds((const unsigned*)(KV + go_ + vsrc[i]), (LAS unsigned*)(sb_ + (i * 512 + wid * 64) * 16), 16, 0, 0); } } while (0)
    unsigned mw = mask[0];
    DSA_DMA(0);
    for (int kt = 0; kt < ntiles; ++kt) {
        asm volatile("s_waitcnt vmcnt(0)" ::: "memory");
        __syncthreads();
        const unsigned mcur = mw;
        if (kt + 1 < ntiles) { mw = mask[kt + 1]; DSA_DMA(kt + 1); }
        const LAS unsigned char* sb = lds + (kt & 1) * DSA_STAGE; const int vb = (int)(uintptr_t)sb + v_rd_base(lane);
        f32x16 pp;
#pragma unroll
        for (int r = 0; r < 16; ++r) pp[r] = 0.f;
        {
            const LAS unsigned char* kb_ = sb + 16384 + r32 * 512; int sw_ = (r32 & 15) << 4; asm volatile("" : "+v"(sw_));
#define DSA_KF(d0) (*(const LAS bf16x8*)(kb_ + ((((d0) * 16 + hi * 8) * 2) ^ sw_)))
#define DSA_QF(d0) ((d0) < 8 ? qr[(d0) & 7] : *(const LAS bf16x8*)(qlds + (((d0) - 8) & 7) * 1024))
            bf16x8 k0 = DSA_KF(0), k1 = DSA_KF(1), q0 = DSA_QF(0), q1 = DSA_QF(1);
#pragma unroll
            for (int d0 = 0; d0 < 16; d0 += 2) {
                bf16x8 nk0 = k0, nk1 = k1, nq0 = q0, nq1 = q1;
                if (d0 + 2 < 16) { nk0 = DSA_KF(d0 + 2); nk1 = DSA_KF(d0 + 3); nq0 = DSA_QF(d0 + 2); nq1 = DSA_QF(d0 + 3); }
                pp = __builtin_amdgcn_mfma_f32_32x32x16_bf16(k0, q0, pp, 0, 0, 0); pp = __builtin_amdgcn_mfma_f32_32x32x16_bf16(k1, q1, pp, 0, 0, 0);
                k0 = nk0; k1 = nk1; q0 = nq0; q1 = nq1; SBAR();
            }
#undef DSA_KF
#undef DSA_QF
        }
        const unsigned wsh = mcur >> (4 * hi);
        const float df = (float)(qpos - (kt * 32 + 4 * hi));
        float pmax = -INFINITY;
#pragma unroll
        for (int r = 0; r < 16; ++r) { const int cb = (r & 3) + 8 * (r >> 2); const float dd = df - (float)cb;
            float t = fmaf(-slopeL, fabsf(dd), pp[r] * LOG2E); if (!((wsh >> cb) & 1u)) t = -INFINITY; pp[r] = t; pmax = fmaxf(pmax, t); }
        { auto rr = __builtin_amdgcn_permlane32_swap(__float_as_uint(pmax), __float_as_uint(pmax), false, false); pmax = fmaxf(__uint_as_float(rr[0]), __uint_as_float(rr[1])); }
        const float mn = fmaxf(m_reg, pmax); const float alpha = __builtin_amdgcn_exp2f(m_reg - mn); m_reg = mn;
        float ps = 0.f;
#pragma unroll
        for (int r = 0; r < 16; ++r) { pp[r] = __builtin_amdgcn_exp2f(pp[r] - mn); ps += pp[r]; }
        { auto rr = __builtin_amdgcn_permlane32_swap(__float_as_uint(ps), __float_as_uint(ps), false, false); ps = __uint_as_float(rr[0]) + __uint_as_float(rr[1]); }
        l_reg = l_reg * alpha + ps;
        if (__any(alpha < 1.f)) { if (hi == 0) al_l[r32] = alpha; asm volatile("s_waitcnt lgkmcnt(0)" ::: "memory");
#pragma unroll
            for (int r = 0; r < 16; ++r) { const float a = al_l[crow(r, hi)];
#pragma unroll
                for (int d = 0; d < 8; ++d) o[d][r] *= a; } }
        bf16x8 pa0, pa1; PK4(pp, 0, pa0); PK4(pp, 8, pa1);
        PvPairs<8, 0, 0>::run(o, vb, pa0, pa1);
    }
#undef DSA_DMA
    if (hi == 0) li_l[r32] = l_reg; asm volatile("s_waitcnt lgkmcnt(0)" ::: "memory");
    float rl[16];
#pragma unroll
    for (int r = 0; r < 16; ++r) rl[r] = __builtin_amdgcn_rcpf(li_l[crow(r, hi)]);
    __syncthreads();
    LAS bf16_t* os = (LAS bf16_t*)(lds + wid * 16896);
#pragma unroll
    for (int r = 0; r < 16; ++r)
#pragma unroll
        for (int d0 = 0; d0 < 8; ++d0) os[crow(r, hi) * 264 + d0 * 32 + r32] = (bf16_t)(cvt_pk_bf16(o[d0][r] * rl[r], 0.f) & 0xffffu);
    asm volatile("s_waitcnt lgkmcnt(0)" ::: "memory");
    f32x16 ya[4];
#pragma unroll
    for (int nb = 0; nb < 4; ++nb)
#pragma unroll
        for (int r = 0; r < 16; ++r) ya[nb][r] = 0.f;
    const bf16_t* wv = (const bf16_t*)(p.ws + WS_WUV) + (size_t)(h * 128 + r32) * 256 + hi * 8;
#pragma unroll 4
    for (int ks = 0; ks < 16; ++ks) {
        const bf16x8 af = *(const LAS bf16x8*)(os + r32 * 264 + ks * 16 + hi * 8);
#pragma unroll
        for (int nb = 0; nb < 4; ++nb) { const bf16x8 wf = *(const bf16x8*)(wv + (size_t)nb * 32 * 256 + ks * 16); ya[nb] = __builtin_amdgcn_mfma_f32_32x32x16_bf16(wf, af, ya[nb], 0, 0, 0); }
    }
    unsigned char* O8 = (unsigned char*)(p.ws + WS_OA8) + ((size_t)b * SEQ + qt * 32 + r32) * 1024 + h * 128 + 4 * hi;
#pragma unroll
    for (int nb = 0; nb < 4; ++nb)
#pragma unroll
        for (int g4 = 0; g4 < 4; ++g4) *(unsigned*)(O8 + nb * 32 + g4 * 8) = pack_fp8x4(ya[nb][g4 * 4] * 8.f, ya[nb][g4 * 4 + 1] * 8.f, ya[nb][g4 * 4 + 2] * 8.f, ya[nb][g4 * 4 + 3] * 8.f);
}
__device__ void ph4_attn(const Params& p, LAS unsigned char* lds) {
    const int r = blockIdx.x;
    if (r < 256) { const int c = 31 - (r >> 3), w8 = r & 7, b = w8 >> 1, half = w8 & 1; dsa_item(p, lds, b, c * 2 + half); }
    int* qhead = (int*)(p.ws + WS_CNT) + 2048;
    LAS int* slot = (LAS int*)(lds + LDS_BARW - 16);
    for (;;) {
        __syncthreads();
        if (threadIdx.x == 0) *slot = atomicAdd(qhead, 1);
        __syncthreads();
        const int it = __builtin_amdgcn_readfirstlane(*slot);
        if (it >= 256) break;
        const int qb = 7 - (it >> 5), bh = it & 31;
        fox_item(p, lds, bh >> 3, bh & 7, qb);
    }
}

__device__ void ph8_router(const Params& p, LAS unsigned char* lds, const int rep) {
    const int tid = threadIdx.x, wid = tid >> 6, lane = tid & 63, fr = lane & 15, fq = lane >> 4;
    const float* mod = (const float*)(p.ws + WS_MOD);
    int* cnt = (int*)(p.ws + WS_CNT) + rep * 1024; int* ltok = rep ? (int*)(p.ws + WS_QLAT) : (int*)(p.ws + WS_LTOK); float* lw = rep ? (float*)(p.ws + WS_QLAT + (4u << 20)) : (float*)(p.ws + WS_LW);
    LAS unsigned char* AH = lds; LAS unsigned char* AL = lds + 65536;
    LAS float* slab = (LAS float*)lds;
    LAS float* lg = (LAS float*)(lds + 131072);
    const bf16_t* WH = (const bf16_t*)(p.ws + WS_WRH); const bf16_t* WL = (const bf16_t*)(p.ws + WS_WRL);
    for (int blk = blockIdx.x; blk < NTOK / 32; blk += gridDim.x) {
        const int t0 = blk * 32, tb = t0 + wid * 4, b = tb >> 11;
        const float* sh = mod + b * 12288 + 6144; const float* sc = mod + b * 12288 + 8192;
        u32x2 keepH[4][4], keepL[4][4];
        f32x4 xa[2][8], xb[2][8]; u32x2 ya[2][8], yb[2][8];
#define RT_LOAD(X, Y, R0) _Pragma("unroll") for (int rr = 0; rr < 2; ++rr) _Pragma("unroll") for (int i = 0; i < 8; ++i) { const size_t eo = (size_t)(tb + R0 + rr) * DM + i * 256 + lane * 4; \
            Y[rr][i] = *(const u32x2*)((const bf16_t*)(p.ws + WS_MERGED) + eo); X[rr][i] = *(const f32x4*)(p.in[I_X] + eo); }
        RT_LOAD(xa, ya, 0) RT_LOAD(xb, yb, 2)
#define RT_ROWS(X, Y, R0) do { float rstd[2]; \
        _Pragma("unroll") for (int rr = 0; rr < 2; ++rr) { float ss = 0.f; \
            _Pragma("unroll") for (int i = 0; i < 8; ++i) { X[rr][i] += (f32x4){bf_lo(Y[rr][i].x), bf_hi(Y[rr][i].x), bf_lo(Y[rr][i].y), bf_hi(Y[rr][i].y)};        \
                ss += X[rr][i][0] * X[rr][i][0] + X[rr][i][1] * X[rr][i][1] + X[rr][i][2] * X[rr][i][2] + X[rr][i][3] * X[rr][i][3]; } \
            rstd[rr] = rsqrtf(wave_sum(ss) * (1.0f / 2048.0f) + RMS_EPS); } \
        _Pragma("unroll") for (int i = 0; i < 8; ++i) { int cl = lane * 4; asm volatile("" : "+v"(cl)); const int col = i * 256 + cl; const f32x4 gg = *(const f32x4*)(p.in[I_GFFN] + col), s1 = *(const f32x4*)(sc + col), s0 = *(const f32x4*)(sh + col); \
            _Pragma("unroll") for (int rr = 0; rr < 2; ++rr) { float hv[4], lo[4]; const int r = wid * 4 + R0 + rr; \
                _Pragma("unroll") for (int j = 0; j < 4; ++j) hv[j] = X[rr][i][j] * rstd[rr] * gg[j] * (1.0f + s1[j]) + s0[j]; \
                u32x2 wh; wh.x = cvt_pk_bf16(hv[0], hv[1]); wh.y = cvt_pk_bf16(hv[2], hv[3]); \
                lo[0] = hv[0] - bf_lo(wh.x); lo[1] = hv[1] - bf_hi(wh.x); lo[2] = hv[2] - bf_lo(wh.y); lo[3] = hv[3] - bf_hi(wh.y); \
                u32x2 wl; wl.x = cvt_pk_bf16(lo[0], lo[1]); wl.y = cvt_pk_bf16(lo[2], lo[3]); \
                if (i < 4) { int l1 = lane >> 1; asm volatile("" : "+v"(l1)); const int ad = r * 2048 + (((i * 32 + l1) ^ r) * 16) + (lane & 1) * 8; *(LAS u32x2*)(AH + ad) = wh; *(LAS u32x2*)(AL + ad) = wl; } \
                else { keepH[R0 + rr][i - 4] = wh; keepL[R0 + rr][i - 4] = wl; } \
                *(unsigned*)(p.ws + WS_H8 + (size_t)(tb + R0 + rr) * DM + col) = pack_fp8x4(hv[0], hv[1], hv[2], hv[3]); } } } while (0)
        RT_ROWS(xa, ya, 0); RT_ROWS(xb, yb, 2);
#undef RT_LOAD
#undef RT_ROWS
        const int kq = wid & 3, ng = wid >> 2, nb0 = ng * 3;
        f32x4 acc[2][3];
#pragma unroll
        for (int rb = 0; rb < 2; ++rb)
#pragma unroll
            for (int j = 0; j < 3; ++j) acc[rb][j] = (f32x4){0.f, 0.f, 0.f, 0.f};
#pragma unroll
        for (int kh = 0; kh < 2; ++kh) {
            if (kh == 1) {
#pragma unroll
                for (int r4 = 0; r4 < 4; ++r4)
#pragma unroll
                    for (int i = 0; i < 4; ++i) { const int r = wid * 4 + r4; int l1 = lane >> 1; asm volatile("" : "+v"(l1)); const int ad = r * 2048 + (((i * 32 + l1) ^ r) * 16) + (lane & 1) * 8;
                        *(LAS u32x2*)(AH + ad) = keepH[r4][i]; *(LAS u32x2*)(AL + ad) = keepL[r4][i]; }
            }
            __syncthreads();
#pragma unroll 2
            for (int k8 = 0; k8 < 8; ++k8) { const int ksl = kq * 8 + k8, ks = kh * 32 + ksl;
                bf16x8 ah[2], al[2];
#pragma unroll
                for (int rb = 0; rb < 2; ++rb) { const int r = rb * 16 + fr; const int ad = r * 2048 + (((ksl * 4 + fq) ^ r) * 16); ah[rb] = *(const LAS bf16x8*)(AH + ad); al[rb] = *(const LAS bf16x8*)(AL + ad); }
#pragma unroll
                for (int j = 0; j < 3; ++j) { const int nb = nb0 + j; if (nb < 5) {
                    const bf16x8 wh = *(const bf16x8*)(WH + (size_t)(nb * 16 + fr) * DM + ks * 32 + fq * 8), wl = *(const bf16x8*)(WL + (size_t)(nb * 16 + fr) * DM + ks * 32 + fq * 8);
#pragma unroll
                    for (int rb = 0; rb < 2; ++rb) {
                        acc[rb][j] = __builtin_amdgcn_mfma_f32_16x16x32_bf16(wh, ah[rb], acc[rb][j], 0, 0, 0); acc[rb][j] = __builtin_amdgcn_mfma_f32_16x16x32_bf16(wl, ah[rb], acc[rb][j], 0, 0, 0);
                        acc[rb][j] = __builtin_amdgcn_mfma_f32_16x16x32_bf16(wh, al[rb], acc[rb][j], 0, 0, 0); } } } }
            __syncthreads();
        }
#pragma unroll
        for (int rb = 0; rb < 2; ++rb)
#pragma unroll
            for (int j = 0; j < 3; ++j) { const int nb = nb0 + j; if (nb < 5) *(LAS f32x4*)(slab + (kq * 32 + rb * 16 + fr) * 80 + nb * 16 + fq * 4) = acc[rb][j]; }
        __syncthreads();
        for (int o = tid; o < 2560; o += NTHREADS) lg[o] = (slab[o] + slab[2560 + o]) + (slab[5120 + o] + slab[7680 + o]);
        __syncthreads();
        if (tid < 32) {
            const int t = t0 + tid; const LAS float* L = lg + tid * 80;
            float gl[8]; int gi = 0; float gm = -INFINITY;
#pragma unroll
            for (int g = 0; g < 8; ++g) { gl[g] = L[g] + p.in[I_BRG][g]; if (gl[g] > gm) { gm = gl[g]; gi = g; } }
            float se = 0.f;
#pragma unroll
            for (int g = 0; g < 8; ++g) se += __expf(gl[g] - gm);
            const float gwt = 1.0f / se;
            float v1 = -INFINITY, v2 = -INFINITY; int i1 = 0, i2 = 0;
            for (int e = 0; e < 8; ++e) { const float v = L[8 + gi * 8 + e] + p.in[I_BRE][gi * 8 + e];
                if (v > v1) { v2 = v1; i2 = i1; v1 = v; i1 = e; } else if (v > v2) { v2 = v; i2 = e; } }
            const float e2 = __expf(v2 - v1); const float p1 = gwt / (1.0f + e2), p2 = gwt * e2 / (1.0f + e2);
            const int ea = gi * 8 + i1, eb = gi * 8 + i2;
            const int sub = blk & (NSUB - 1);
            const int pa = sub * SUBCAP + atomicAdd(cnt + sub * 64 + ea, 1); const int pb = sub * SUBCAP + atomicAdd(cnt + sub * 64 + eb, 1);
            ltok[ea * LCAP + pa] = t; lw[ea * LCAP + pa] = p1;
            ltok[eb * LCAP + pb] = t | 0x10000; lw[eb * LCAP + pb] = p2;
        }
        __syncthreads();
    }
}

#define MOE_GLOAD(dst, ptr) asm volatile("global_load_dwordx4 %0, %1, off nt" : "=v"(dst) : "v"(ptr) : "memory")
__device__ __forceinline__ int list_pos(const LAS int* pre, int r) { int s = 0;
#pragma unroll
    for (int k = NSUB / 2; k >= 1; k >>= 1) if (pre[s + k] <= r) s += k;
    return s * SUBCAP + (r - pre[s]); }
template <bool UP>
__device__ void moe_gemm(const Params& p, LAS unsigned char* lds, const int rep) {
    constexpr int K = UP ? 2048 : 512, NKT = K / 32, NS = UP ? 8 : 16, LDW = UP ? 512 : 2048;
    constexpr int NSTA = 3, OFF_A = 0, OFF_B = NSTA * 16384;
    int tid = threadIdx.x; asm volatile("" : "+v"(tid));
    const int w = __builtin_amdgcn_readfirstlane(tid >> 6), l = tid & 63, r32 = l & 31, hi = l >> 5;
    LAS int* tab = (LAS int*)(lds + LDS_TAB);
    if (tid < 64) { const int* cnt = (const int*)(p.ws + WS_CNT); int s = 0; for (int sub = 0; sub < NSUB; ++sub) { tab[256 + tid * 17 + sub] = s; s += cnt[sub * 64 + tid]; } tab[256 + tid * 17 + NSUB] = s; tab[80 + tid] = s; }
    __syncthreads();
    if (tid == 0) { int s = 0, ro = 0; for (int e = 0; e < 64; ++e) { const int ce = tab[80 + e]; tab[e] = s; tab[160 + e] = ro; ro += ce; const int np = (ce + 511) >> 9; s += np > 0 ? np : 1; } tab[64] = s; }
    __syncthreads();
    const int total = __builtin_amdgcn_readfirstlane(tab[64]) * NS;
    const int q = (w & 3) * 8 + (l & 7), g = (w >> 2) * 8 + (l >> 3);
    const unsigned bwoff = (unsigned)(q * 256 + (((g >> 2) ^ (q & 3)) * 16) + (g & 3) * 4);
    const unsigned frag_sw = (unsigned)((r32 >> 2) & 3);
    const int* ltok = (const int*)(p.ws + WS_LTOK); const float* lw = (const float*)(p.ws + WS_LW);
    for (int unit = blockIdx.x; unit < total; unit += gridDim.x) {
        const int pm = unit / NS, ns = unit - pm * NS; int e = 0;
#pragma unroll 1
        for (int s = 32; s >= 1; s >>= 1) if (__builtin_amdgcn_readfirstlane(tab[e + s]) <= pm) e += s;
        const int mp = pm - __builtin_amdgcn_readfirstlane(tab[e]); const int cnt_e = __builtin_amdgcn_readfirstlane(tab[80 + e]), rowoff = __builtin_amdgcn_readfirstlane(tab[160 + e]);
        int nrows = cnt_e - mp * 512; nrows = nrows > 512 ? 512 : nrows; const bool two = nrows > 256;
        const char* abase = UP ? (const char*)(p.ws + WS_H8) : (const char*)(p.ws + WS_ACT8);
        unsigned aoff[2];
#pragma unroll
        for (int i = 0; i < 2; ++i) { const int row = (i * 8 + w) * 32 + (l >> 1); const int hs = (l & 1) ^ ((l >> 4) & 1);
            int src; if (UP) src = row < nrows ? (ltok[e * LCAP + list_pos(tab + 256 + e * 17, mp * 512 + row)] & 0xffff) : 0; else src = rowoff + mp * 512 + (row < nrows ? row : 0);
            aoff[i] = (unsigned)(src * K + hs * 16); }
        const float* bsrc = UP ? (q < 16 ? p.in[I_W1] : p.in[I_W3]) + (size_t)e * 2048 * 512 + ns * 64 + (q & 15) * 4 + (size_t)(2 * g) * LDW
                               : p.in[I_W2] + (size_t)e * 512 * 2048 + ns * 128 + q * 4 + (size_t)(2 * g) * LDW;
        f32x16 acc[2][4];
#pragma unroll
        for (int a = 0; a < 2; ++a)
#pragma unroll
            for (int b = 0; b < 4; ++b)
#pragma unroll
                for (int r = 0; r < 16; ++r) acc[a][b][r] = 0.f;
        f32x4 br[2][2];
#define MOE_ISSUE_B(j, t) do { const int tt_ = (t) < NKT ? (t) : NKT - 1; const float* bp_ = bsrc + (size_t)tt_ * 32 * LDW; MOE_GLOAD(br[j][0], bp_); MOE_GLOAD(br[j][1], bp_ + LDW); } while (0)
#define MOE_ISSUE_A(t, TWO) do { int tt_ = (t) < 0 ? 0 : (t); const int bi_ = (tt_ % NSTA); tt_ = tt_ < NKT ? tt_ : NKT - 1; const char* ap_ = abase + (size_t)tt_ * 32; \
        LAS unsigned char* ab_ = lds + OFF_A + bi_ * 16384 + w * 1024; \
        __builtin_amdgcn_global_load_lds((const unsigned*)(ap_ + aoff[0]), (LAS unsigned*)(ab_), 16, 0, 0); \
        if (TWO) __builtin_amdgcn_global_load_lds((const unsigned*)(ap_ + aoff[1]), (LAS unsigned*)(ab_ + 8192), 16, 0, 0); } while (0)
        const bool two_w = (256 + 32 * w) < nrows;
#define MOE_FRAGS(ks, TWO) do { const unsigned co_ = ((unsigned)((ks) * 2 + hi) ^ frag_sw) * 16u; \
            _Pragma("unroll") for (int nb = 0; nb < 4; ++nb) bf_[nb] = *(const LAS bf16x8*)(bb_ + nb * 2048 + co_); \
            { const unsigned ao_ = ((unsigned)(ks) ^ ((unsigned)(r32 >> 3) & 1u)) * 16u + (unsigned)hi * 8u; a0_ = fp8x8_to_bf16(*(const LAS u32x2*)(ab_ + ao_)); if (TWO) a1_ = fp8x8_to_bf16(*(const LAS u32x2*)(ab_ + 8192 + ao_)); } } while (0)
#define MOE_MMAS(TWO) do { \
            _Pragma("unroll") for (int nb = 0; nb < 4; ++nb) acc[0][nb] = __builtin_amdgcn_mfma_f32_32x32x16_bf16(bf_[nb], a0_, acc[0][nb], 0, 0, 0); \
            if (TWO) { _Pragma("unroll") for (int nb = 0; nb < 4; ++nb) acc[1][nb] = __builtin_amdgcn_mfma_f32_32x32x16_bf16(bf_[nb], a1_, acc[1][nb], 0, 0, 0); } } while (0)
#define MOE_ITER(jn, t, COMPUTE, TWO, WB, WA) do { \
        bf16x8 bf_[4], a0_, a1_; \
        const LAS unsigned char* ab_ = lds + OFF_A + (((t) + 3) % 3) * 16384 + w * 1024 + r32 * 32; const LAS unsigned char* bb_ = lds + OFF_B + ((t) & 1) * 8192 + r32 * 64; \
        if (COMPUTE) { MOE_FRAGS(0, TWO); } SBAR(); \
        asm volatile("s_waitcnt vmcnt(" WB ")" : "+v"(br[jn][0]), "+v"(br[jn][1]) :: "memory"); \
        { LAS unsigned char* bw_ = lds + OFF_B + (((t) + 1) & 1) * 8192 + bwoff; _Pragma("unroll") for (int jj = 0; jj < 4; ++jj) *(LAS unsigned*)(bw_ + jj * 64) = cvt_pk_bf16(br[jn][0][jj], br[jn][1][jj]); } \
        MOE_ISSUE_B(jn, (t) + 3); SBAR(); \
        if (COMPUTE) { MOE_MMAS(TWO); SBAR(); MOE_FRAGS(1, TWO); MOE_MMAS(TWO); } SBAR(); \
        asm volatile("s_waitcnt vmcnt(" WA ")" ::: "memory"); \
        asm volatile("s_waitcnt lgkmcnt(0)" ::: "memory"); __builtin_amdgcn_s_barrier(); asm volatile("" ::: "memory"); \
        MOE_ISSUE_A((t) + 3, TWO); \
        } while (0)
#define MOE_PIPE(TWO, WB, WA) do { \
        MOE_ISSUE_B(0, 0); MOE_ISSUE_A(0, TWO); MOE_ISSUE_B(1, 1); MOE_ISSUE_A(1, TWO); \
        MOE_ITER(0, -1, false, TWO, WB, WA); \
        _Pragma("unroll 1") for (int t = 0; t < NKT; t += 2) { MOE_ITER(1, t, true, TWO, WB, WA); MOE_ITER(0, t + 1, true, TWO, WB, WA); } \
          \
        asm volatile("s_waitcnt vmcnt(0)" : "+v"(br[0][0]), "+v"(br[0][1]), "+v"(br[1][0]), "+v"(br[1][1]) :: "memory"); \
        } while (0)
        if (two_w) MOE_PIPE(true, "6", "6"); else MOE_PIPE(false, "4", "5");
        asm volatile("s_waitcnt vmcnt(0)" ::: "memory");
        if constexpr (UP) {
#pragma unroll
            for (int mt = 0; mt < 2; ++mt) {
                const int rl = mt * 256 + 32 * w + r32;
                if (rl < nrows) {
                    const float gw = lw[e * LCAP + list_pos(tab + 256 + e * 17, mp * 512 + rl)] * 16.0f; unsigned char* orow = (unsigned char*)(p.ws + (rep ? WS_QLAT : WS_ACT8)) + (size_t)(rowoff + mp * 512 + rl) * 512 + ns * 64 + 4 * hi;
#pragma unroll
                    for (int nb = 0; nb < 2; ++nb)
#pragma unroll
                        for (int g4 = 0; g4 < 4; ++g4) { float o[4];
#pragma unroll
                            for (int j = 0; j < 4; ++j) { const float a = acc[mt][nb][g4 * 4 + j], u = acc[mt][nb + 2][g4 * 4 + j]; o[j] = a * sigmoidf_(a) * u * gw; }
                            *(unsigned*)(orow + nb * 32 + g4 * 8) = pack_fp8x4(o[0], o[1], o[2], o[3]); }
                }
            }
        } else {
#pragma unroll
            for (int mt = 0; mt < 2; ++mt) {
                const int rl = mt * 256 + 32 * w + r32;
                if (rl < nrows) {
                    const int ent = ltok[e * LCAP + list_pos(tab + 256 + e * 17, mp * 512 + rl)]; unsigned char* orow = (unsigned char*)(p.ws + WS_YS) + ((size_t)(ent >> 16) * NTOK + (ent & 0xffff)) * 2048 + ns * 128 + 4 * hi;
#pragma unroll
                    for (int nb = 0; nb < 4; ++nb)
#pragma unroll
                        for (int g4 = 0; g4 < 4; ++g4) *(unsigned*)(orow + nb * 32 + g4 * 8) = pack_fp8x4(acc[mt][nb][g4 * 4], acc[mt][nb][g4 * 4 + 1], acc[mt][nb][g4 * 4 + 2], acc[mt][nb][g4 * 4 + 3]);
                }
            }
        }
        asm volatile("s_waitcnt vmcnt(0)" ::: "memory");
        __syncthreads();
    }
#undef MOE_ISSUE_A
#undef MOE_ISSUE_B
#undef MOE_ITER
#undef MOE_FRAGS
#undef MOE_MMAS
#undef MOE_PIPE
}


__device__ void ph11_combine(const Params& p) {
    const unsigned char* Y0 = (const unsigned char*)(p.ws + WS_YS); const unsigned char* Y1 = Y0 + (size_t)NTOK * 2048; const bf16_t* YM = (const bf16_t*)(p.ws + WS_MERGED); const float* mod = (const float*)(p.ws + WS_MOD);
    const size_t n8 = (size_t)NTOK * 2048 / 8;
    for (size_t i = (size_t)blockIdx.x * NTHREADS + threadIdx.x; i < n8; i += (size_t)gridDim.x * NTHREADS) {
        const size_t e0 = i * 8; const int col = (int)(e0 & 2047), b = (int)(e0 >> 22);
        const u32x2 a = *(const u32x2*)(Y0 + e0), c = *(const u32x2*)(Y1 + e0); const u32x4 m = *(const u32x4*)(YM + e0);
        const f32x2 a0 = __builtin_amdgcn_cvt_pk_f32_fp8((int)a.x, false), a1 = __builtin_amdgcn_cvt_pk_f32_fp8((int)a.x, true), a2 = __builtin_amdgcn_cvt_pk_f32_fp8((int)a.y, false), a3 = __builtin_amdgcn_cvt_pk_f32_fp8((int)a.y, true);
        const f32x2 c0 = __builtin_amdgcn_cvt_pk_f32_fp8((int)c.x, false), c1 = __builtin_amdgcn_cvt_pk_f32_fp8((int)c.x, true), c2 = __builtin_amdgcn_cvt_pk_f32_fp8((int)c.y, false), c3 = __builtin_amdgcn_cvt_pk_f32_fp8((int)c.y, true);
        const float* gt = mod + (size_t)b * 12288 + 10240 + col; const f32x4 g0 = *(const f32x4*)gt * 0.0625f, g1 = *(const f32x4*)(gt + 4) * 0.0625f;
        const float* px = p.in[I_X] + e0; f32x4 o0 = *(const f32x4*)px, o1 = *(const f32x4*)(px + 4);
        o0[0] += bf_lo(m.x) + g0[0] * (a0.x + c0.x); o0[1] += bf_hi(m.x) + g0[1] * (a0.y + c0.y); o0[2] += bf_lo(m.y) + g0[2] * (a1.x + c1.x); o0[3] += bf_hi(m.y) + g0[3] * (a1.y + c1.y);
        o1[0] += bf_lo(m.z) + g1[0] * (a2.x + c2.x); o1[1] += bf_hi(m.z) + g1[1] * (a2.y + c2.y); o1[2] += bf_lo(m.w) + g1[2] * (a3.x + c3.x); o1[3] += bf_hi(m.w) + g1[3] * (a3.y + c3.y);
        float* po = p.out + e0; *(f32x4*)po = o0; *(f32x4*)(po + 4) = o1;
    }
}

__global__ void __launch_bounds__(NTHREADS, 2) mk_fwd(Params p) {
    extern __shared__ __attribute__((aligned(16))) unsigned char shm[];
    LAS unsigned char* lds = (LAS unsigned char*)shm;
    const int lo = p.ph_lo, hi = p.ph_hi;
    if (threadIdx.x < 4) ((LAS unsigned*)(lds + LDS_BARW))[threadIdx.x] = 0u;
    __syncthreads();
    XcdBarrier bar; bar.bar = (unsigned*)(p.ws + WS_BAR); bar.x = 0; bar.st = nullptr;
    if (hi - lo > 1) bar = xcd_barrier_post((unsigned*)(p.ws + WS_BAR), (volatile LAS unsigned*)(lds + LDS_BARW));
#ifndef SKIP_MASK
#define SKIP_MASK 0
#endif
#define IN(k) (!((SKIP_MASK >> (k)) & 1) && lo <= (k) && (k) < hi)
#define SEAM(k) do { if (IN(k) && IN((k) + 1)) xcd_barrier(bar); } while (0)
    const int G = gridDim.x, bx = blockIdx.x;
#ifndef REP_PHASE
#define REP_PHASE 0
#endif
#define RUN(k, ...) do { if (IN(k)) { { const int rep = 0; (void)rep; __VA_ARGS__ } if ((REP_PHASE >> (k)) & 1) { xcd_barrier(bar); { const int rep = 1; (void)rep; __VA_ARGS__ } } } SEAM(k); } while (0)
    RUN(0, ph0_prologue(p, lds););
    RUN(1, ph1_norm(p););
    RUN(2, EpiProj E{p.ws, p.in[I_BGATE]};
           { ProjOrder S; S.S.init(p.ws + WS_H, p.ws + WS_WIN + (size_t)2 * 256 * DM * 2, NTOK, 8 * 256, DM * 2, G, bx); S.fp8 = 0; S.Bfull = nullptr;
             pg8::gemm_phase<EpiProj, ProjOrder, false, false>(lds, DM * 2, S, E); }
           { ProjOrder S; S.S.init(p.ws + WS_HF8, p.ws + WS_WIN8, NTOK, 30 * 256, DM, G, (G - 1) - bx); S.fp8 = 1; S.Bfull = nullptr;
             pg8::gemm_phase<EpiProj, ProjOrder, false, true>(lds, DM, S, E, 0x79797979); });
    RUN(3, ph3_prep(p, lds, rep););
    RUN(4, ph4_attn(p, lds););
    RUN(5, DualOrder S; S.S0.init(p.ws + WS_OA8, p.ws + WS_WPA8, NTOK, DM, 1024, G, bx); S.S1.init(p.ws + WS_OB8, p.ws + WS_WPB8, NTOK, DM, 1024, G, bx);
           EpiGate12 E{EpiGate1{(const bf16_t*)(p.ws + WS_GATES), (bf16_t*)(p.ws + WS_OA)}, EpiGate2{(const bf16_t*)(p.ws + WS_GATES), (const bf16_t*)(p.ws + WS_OA), (unsigned char*)(p.ws + WS_MRG8)}};
           pg8::gemm_phase<EpiGate12, DualOrder, false, true>(lds, 1024, S, E, 0x79797979, 0x7c7c7c7c););
    RUN(6, pg8::StaticOrder S; S.init(p.ws + WS_MRG8, p.ws + WS_WO8, NTOK, DM, DM, G, bx); EpiWo E{(const float*)(p.ws + WS_MOD), (bf16_t*)(p.ws + WS_MERGED)};
           pg8::gemm_phase<EpiWo, pg8::StaticOrder, false, true>(lds, DM, S, E, 0x79797979, 0x7d7d7d7d););
    RUN(7, ph8_router(p, lds, rep););
    RUN(8, moe_gemm<true>(p, lds, rep););
    RUN(9, moe_gemm<false>(p, lds, rep););
    RUN(10, if (!rep) ph11_combine(p););
#undef RUN
#undef IN
#undef SEAM
}

constexpr int NPHASES = 11;
extern "C" void kernel_launch(void* const* d_in, const int* in_sizes, int n_in, void* d_out, int out_size, void* d_ws, size_t ws_size, hipStream_t stream) {
    static int grid = 0;
    if (grid == 0) {
        if (n_in != 25 || in_sizes[0] != NTOK * DM || out_size != NTOK * DM || ws_size < WS_END6) {
            fprintf(stderr, "kernel_launch: shape mismatch: n_in %d in0 %d out %d ws %zu (need %zu)\n", n_in, n_in > 0 ? in_sizes[0] : -1, out_size, ws_size, (size_t)WS_END6); grid = -1; return; }
        int dev = 0, cus = 0, per_cu = 0;
        if (hipGetDevice(&dev) != hipSuccess || hipDeviceGetAttribute(&cus, hipDeviceAttributeMultiprocessorCount, dev) != hipSuccess) { fprintf(stderr, "kernel_launch: device query failed\n"); grid = -1; return; }
        if (hipFuncSetAttribute((const void*)mk_fwd, hipFuncAttributeMaxDynamicSharedMemorySize, LDS_BYTES) != hipSuccess) { fprintf(stderr, "kernel_launch: hipFuncSetAttribute failed\n"); grid = -1; return; }
        if (hipOccupancyMaxActiveBlocksPerMultiprocessor(&per_cu, (const void*)mk_fwd, NTHREADS, LDS_BYTES) != hipSuccess || per_cu < 1) { fprintf(stderr, "kernel_launch: occupancy query says %d blocks per CU\n", per_cu); }
        (void)hipGetLastError();
        grid = cus;
    }
    if (grid < 0) return;
    if (hipMemsetAsync((char*)d_ws + WS_BAR, 0, WS_ZERO_BYTES, stream) != hipSuccess) { fprintf(stderr, "kernel_launch: memset failed\n"); return; }
    Params p; memset(&p, 0, sizeof(p));
    for (int i = 0; i < 25; ++i) p.in[i] = (const float*)d_in[i];
    p.out = (float*)d_out; p.ws = (unsigned char*)d_ws;
    unsigned char* ws = (unsigned char*)d_ws;
    auto job = [&](int j, const float* src, size_t dst_off, int K, int N, int ldd, int map, int nbatch, long sbatch, long dbatch) {
        TJob& J = p.jobs[j]; J.src = src; J.dst = (bf16_t*)(ws + dst_off); J.K = K; J.N = N; J.ldd = ldd; J.map = map; J.ntk = K / 64; J.ntn = (N + 127) / 128; J.nbatch = nbatch; J.sbatch = sbatch; J.dbatch = dbatch; J.ld = N; J.fp8 = 0; };
    job(0, p.in[I_WIN] + 512, WS_WIN, 2048, 1872, 2048, 4, 1, 0, 0); p.jobs[0].ld = DIN;
    job(1, p.in[I_WIN] + 5456, WS_WIN, 2048, 8, 2048, 5, 1, 0, 0); p.jobs[1].ld = DIN;
    job(2, p.in[I_WUK], WS_WUK, 128, 256, 128, 0, 8, 128L * 256, 256L * 128);
    job(3, p.in[I_WUV], WS_WUV, 256, 128, 256, 0, 8, 256L * 128, 128L * 256);
    job(4, p.in[I_WIN], WS_WIN8, 2048, 512, 2048, 0, 1, 0, 0); job(5, p.in[I_WIN] + 2384, WS_WIN8 + (size_t)512 * 2048, 2048, 3072, 2048, 0, 1, 0, 0); job(6, p.in[I_WIN] + 5464, WS_WIN8 + (size_t)3584 * 2048, 2048, 4096, 2048, 0, 1, 0, 0);
    for (int j = 4; j < 7; ++j) { p.jobs[j].ld = DIN; p.jobs[j].fp8 = 1; }
    job(7, p.in[I_WO], WS_WO8, 2048, 2048, 2048, 0, 1, 0, 0); p.jobs[7].fp8 = 1;
    job(8, p.in[I_WPA], WS_WPA8, 1024, 2048, 1024, 0, 1, 0, 0); p.jobs[8].fp8 = 1; job(9, p.in[I_WPB], WS_WPB8, 1024, 2048, 1024, 0, 1, 0, 0); p.jobs[9].fp8 = 1;
    int t0 = 0; for (int j = 0; j < NJOBS; ++j) { p.jobs[j].tile0 = t0; t0 += p.jobs[j].ntk * p.jobs[j].ntn * p.jobs[j].nbatch; }
    p.ntiles_total = t0;
#if MK_LAUNCHES == 1
    p.ph_lo = 0; p.ph_hi = NPHASES;
    hipLaunchKernelGGL(mk_fwd, dim3(grid), dim3(NTHREADS), LDS_BYTES, stream, p);
#else
    for (int k = 0; k < NPHASES; ++k) { p.ph_lo = k; p.ph_hi = k + 1; hipLaunchKernelGGL(mk_fwd, dim3(grid), dim3(NTHREADS), LDS_BYTES, stream, p); }
#endif
    const hipError_t le = hipPeekAtLastError();
    if (le != hipSuccess) fprintf(stderr, "kernel_launch: launch failed: %s\n", hipGetErrorName(le));
}
```

```cpp
#include <hip/hip_runtime.h>
#include <cstdio>
#include <cstdint>
#include <cstring>

#ifndef MK_LAUNCHES
#define MK_LAUNCHES 1
#endif

#define LAS __attribute__((address_space(3)))
typedef unsigned short bf16_t;
typedef short bf16x8 __attribute__((ext_vector_type(8)));
typedef short s16x4 __attribute__((ext_vector_type(4)));
typedef float f32x4 __attribute__((ext_vector_type(4)));
typedef float f32x16 __attribute__((ext_vector_type(16)));
typedef unsigned u32x4 __attribute__((ext_vector_type(4)));
typedef unsigned u32x2 __attribute__((ext_vector_type(2)));

constexpr int DM = 2048, NBATCH = 4, SEQ = 2048, NTOK = NBATCH * SEQ;
constexpr int DIN = 9560, DINP = 9728;
constexpr int NEXP = 64, DEXP = 512, LCAP = 8192;
constexpr float RMS_EPS = 1e-6f;
constexpr float LOG2E = 1.4426950408889634f;
constexpr int NTHREADS = 512;
constexpr int LDS_BYTES = 163840 - 1024;
constexpr int LDS_BARW = LDS_BYTES - 16;
constexpr int LDS_TAB = 131072;

constexpr size_t al256(size_t x) { return (x + 255) / 256 * 256; }
constexpr size_t WS_BAR = 0;
constexpr size_t WS_CNT = 16384;
constexpr size_t WS_ZERO_BYTES = 16384 + 16384;
constexpr int NSUB = 16, SUBCAP = 512;
constexpr size_t WS_MOD = WS_ZERO_BYTES;
constexpr size_t WS_H = al256(WS_MOD + (size_t)4 * 12288 * 4);
constexpr size_t WS_WIN = al256(WS_H + (size_t)NTOK * DM * 2);
constexpr size_t WS_WPA = al256(WS_WIN + (size_t)DINP * DM * 2);
constexpr size_t WS_WPB = al256(WS_WPA + (size_t)2048 * 1024 * 2);
constexpr size_t WS_WO = al256(WS_WPB + (size_t)2048 * 1024 * 2);
constexpr size_t WS_WUK = al256(WS_WO + (size_t)2048 * 2048 * 2);
constexpr size_t WS_WUV = al256(WS_WUK + (size_t)8 * 256 * 128 * 2);
constexpr size_t WS_W13 = al256(WS_WUV + (size_t)8 * 128 * 256 * 2);
constexpr size_t WS_W2 = al256(WS_W13 + (size_t)64 * 1024 * 2048 * 2);
constexpr size_t WS_QA = al256(WS_W2 + (size_t)64 * 2048 * 512 * 2);
constexpr size_t WS_CKV = al256(WS_QA + (size_t)NTOK * 1024 * 2);
constexpr size_t WS_KV = al256(WS_CKV + (size_t)NTOK * 256 * 4);
constexpr size_t WS_QIDX = al256(WS_KV + (size_t)NTOK * 256 * 2);
constexpr size_t WS_MISC = al256(WS_QIDX + (size_t)NTOK * 1024 * 2);
constexpr size_t WS_QB = al256(WS_MISC + (size_t)NTOK * 256 * 4);
constexpr size_t WS_KB = al256(WS_QB + (size_t)NTOK * 1024 * 2);
constexpr size_t WS_VB = al256(WS_KB + (size_t)NTOK * 1024 * 2);
constexpr size_t WS_GATES = al256(WS_VB + (size_t)NTOK * 1024 * 2);
constexpr size_t WS_QLAT = al256(WS_GATES + (size_t)NTOK * 4096 * 2);
constexpr size_t WS_MASK = al256(WS_QLAT + (size_t)NTOK * 2048 * 2);
constexpr size_t WS_CUM = al256(WS_MASK + (size_t)NTOK * 256);
constexpr size_t WS_OLAT = al256(WS_CUM + (size_t)4 * 8 * 2048 * 4);
constexpr size_t WS_OA = al256(WS_OLAT + (size_t)NTOK * 2048 * 2);
constexpr size_t WS_OB = al256(WS_OA + (size_t)NTOK * 1024 * 2);
constexpr size_t WS_T1 = al256(WS_OB + (size_t)NTOK * 1024 * 2);
constexpr size_t WS_MERGED = al256(WS_T1 + (size_t)NTOK * 2048 * 4);
constexpr size_t WS_LTOK = al256(WS_MERGED + (size_t)NTOK * 2048 * 2);
constexpr size_t WS_LW = al256(WS_LTOK + (size_t)NEXP * LCAP * 4);
constexpr size_t WS_ACT = al256(WS_LW + (size_t)NEXP * LCAP * 4);
constexpr size_t WS_HLO = al256(WS_ACT + (size_t)32768 * 512 * 2);
constexpr size_t WS_WRH = al256(WS_HLO + (size_t)NTOK * DM * 2);
constexpr size_t WS_WRL = al256(WS_WRH + (size_t)80 * DM * 2);
constexpr size_t WS_END = al256(WS_WRL + (size_t)80 * DM * 2);
constexpr size_t WS_KIDX = WS_END;
constexpr size_t WS_END2 = al256(WS_KIDX + (size_t)NTOK * 64 * 2);
constexpr size_t WS_H8 = WS_END2;
constexpr size_t WS_ACT8 = al256(WS_H8 + (size_t)NTOK * DM);
constexpr size_t WS_END3 = al256(WS_ACT8 + (size_t)16384 * 512);
constexpr size_t WS_HF8 = WS_END3;
constexpr size_t WS_WIN8 = al256(WS_HF8 + (size_t)NTOK * DM);
constexpr size_t WS_END4 = al256(WS_WIN8 + (size_t)7680 * DM);
constexpr size_t WS_MRG8 = WS_END4;
constexpr size_t WS_WO8 = al256(WS_MRG8 + (size_t)NTOK * DM);
constexpr size_t WS_END5 = al256(WS_WO8 + (size_t)2048 * 2048);
constexpr size_t WS_OA8 = WS_END5;
constexpr size_t WS_OB8 = al256(WS_OA8 + (size_t)NTOK * 1024);
constexpr size_t WS_WPA8 = al256(WS_OB8 + (size_t)NTOK * 1024);
constexpr size_t WS_WPB8 = al256(WS_WPA8 + (size_t)2048 * 1024);
constexpr size_t WS_END6 = al256(WS_WPB8 + (size_t)2048 * 1024);
constexpr size_t WS_YS = WS_T1;
constexpr size_t WS_HG = WS_QA;
static_assert(WS_HG + (size_t)32768 * DM * 2 <= WS_QLAT, "hg alias must fit in the dead region");

struct TJob { const float* src; bf16_t* dst; int K, N, ldd, map, ntk, ntn, nbatch, tile0; long sbatch, dbatch; int ld, fp8; };
constexpr int NJOBS = 10;
struct Params {
    const float* in[25];
    float* out;
    unsigned char* ws;
    TJob jobs[NJOBS];
    int ntiles_total;
    int ph_lo, ph_hi;
};
enum { I_X = 0, I_C, I_WADA, I_BADA, I_GMIX, I_WIN, I_BGATE, I_BFORGET, I_WUK, I_WUV, I_GQA, I_GKV, I_GQB, I_GKB, I_WPA, I_WPB, I_WO, I_GFFN, I_WRG, I_BRG, I_WRE, I_BRE, I_W1, I_W3, I_W2 };

__device__ __forceinline__ unsigned cvt_pk_bf16(float lo, float hi) { unsigned r; asm volatile("v_cvt_pk_bf16_f32 %0, %1, %2" : "=v"(r) : "v"(lo), "v"(hi)); return r; }
__device__ __forceinline__ float bf_lo(unsigned w) { return __uint_as_float(w << 16); }
__device__ __forceinline__ float bf_hi(unsigned w) { return __uint_as_float(w & 0xffff0000u); }
typedef float f32x2 __attribute__((ext_vector_type(2)));
__device__ __forceinline__ unsigned pack_fp8x4(float a, float b, float c, float d) { int w = __builtin_amdgcn_cvt_pk_fp8_f32(a, b, 0, false); w = __builtin_amdgcn_cvt_pk_fp8_f32(c, d, w, true); return (unsigned)w; }
__device__ __forceinline__ bf16x8 fp8x8_to_bf16(u32x2 v) {
    const f32x2 a = __builtin_amdgcn_cvt_pk_f32_fp8((int)v.x, false), b = __builtin_amdgcn_cvt_pk_f32_fp8((int)v.x, true), c = __builtin_amdgcn_cvt_pk_f32_fp8((int)v.y, false), d = __builtin_amdgcn_cvt_pk_f32_fp8((int)v.y, true);
    u32x4 w; w.x = cvt_pk_bf16(a.x, a.y); w.y = cvt_pk_bf16(b.x, b.y); w.z = cvt_pk_bf16(c.x, c.y); w.w = cvt_pk_bf16(d.x, d.y); return *reinterpret_cast<bf16x8*>(&w); }
__device__ __forceinline__ unsigned pack_u8x4(float a, float b, float c, float d) {
    unsigned w = 0; w = __builtin_amdgcn_cvt_pk_u8_f32(a * 255.f + 0.5f, 0, w); w = __builtin_amdgcn_cvt_pk_u8_f32(b * 255.f + 0.5f, 1, w); w = __builtin_amdgcn_cvt_pk_u8_f32(c * 255.f + 0.5f, 2, w); w = __builtin_amdgcn_cvt_pk_u8_f32(d * 255.f + 0.5f, 3, w); return w; }
__device__ __forceinline__ f32x4 unpack_u8x4(unsigned w) { return (f32x4){(float)(w & 0xffu), (float)((w >> 8) & 0xffu), (float)((w >> 16) & 0xffu), (float)(w >> 24)} * (1.0f / 255.0f); }
__device__ __forceinline__ float wave_sum(float v) {
#pragma unroll
    for (int o = 32; o >= 1; o >>= 1) v += __shfl_xor(v, o);
    return v;
}
__device__ __forceinline__ float sigmoidf_(float x) { return __builtin_amdgcn_rcpf(1.0f + __builtin_amdgcn_exp2f(-1.4426950408889634f * x)); }
__device__ __forceinline__ int crow(int r, int hi) { return (r & 3) + 8 * (r >> 2) + 4 * hi; }
#define SBAR() __builtin_amdgcn_sched_barrier(0)

#define XB_TMO      128
#define XB_XCNT(j)  (256  + 64 * (j))
#define XB_XSUB(j)  (1280 + 64 * (j))
#define XB_XGEN(j)  (2304 + 64 * (j))
#define XB_TOP      3328
#define XB_TOPGEN   3392
#define XCD_BAR_WORDS 3456
#define XB_SPIN_CAP (1u << 20)
__device__ __forceinline__ unsigned xb_ld(unsigned* p)              { return __hip_atomic_load(p, __ATOMIC_RELAXED, __HIP_MEMORY_SCOPE_AGENT); }
__device__ __forceinline__ unsigned xb_add(unsigned* p, unsigned v) { return __hip_atomic_fetch_add(p, v, __ATOMIC_RELAXED, __HIP_MEMORY_SCOPE_AGENT); }
__device__ __forceinline__ unsigned xb_xcc_id() { return (unsigned)__builtin_amdgcn_s_getreg((3 << 11) | 20) & 0xFu; }
#define XB_SPIN(cond, bar) do { unsigned _sp = 0; while (cond) { __builtin_amdgcn_s_sleep(1); \
    if ((++_sp & 255u) == 0u) { if (xb_ld(&(bar)[XB_TMO])) break; if (_sp > XB_SPIN_CAP) { atomicAdd(&(bar)[XB_TMO], 1u); break; } } } } while (0)
struct XcdBarrier { unsigned* bar; unsigned x; volatile LAS unsigned* st; };
__device__ __forceinline__ XcdBarrier xcd_barrier_post(unsigned* bar, volatile LAS unsigned* st) {
    XcdBarrier b; b.bar = bar; b.x = xb_xcc_id(); b.st = st;
    if (threadIdx.x == 0) (void)xb_add(&bar[XB_XCNT(b.x)], 1u);
    return b;
}
__device__ __forceinline__ void xcd_barrier_complete(unsigned* bar, unsigned x, unsigned& nloc, unsigned& nx) {
    const unsigned G = gridDim.x * gridDim.y * gridDim.z;
    unsigned sum, cnt, mine, sp = 0u;
    for (;;) {
        sum = 0u; cnt = 0u; mine = 0u;
#pragma unroll
        for (unsigned j = 0; j < 16; ++j) { const unsigned c = xb_ld(&bar[XB_XCNT(j)]); sum += c; cnt += (c > 0u) ? 1u : 0u; mine = (j == x) ? c : mine; }
        if (sum == G) break;
        __builtin_amdgcn_s_sleep(1);
        if ((++sp & 255u) == 0u) { if (xb_ld(&bar[XB_TMO])) break; if (sp > XB_SPIN_CAP) { atomicAdd(&bar[XB_TMO], 1u); break; } }
    }
    nloc = mine > 0u ? mine : 1u; nx = cnt > 0u ? cnt : 1u;
}
__device__ __forceinline__ void xcd_barrier(const XcdBarrier& b) {
    asm volatile("s_waitcnt vmcnt(0)" ::: "memory");
    __syncthreads();
    if (threadIdx.x == 0) {
        unsigned* bar = b.bar;
        __builtin_amdgcn_s_waitcnt(0);
        unsigned nloc = b.st[0], nx = b.st[1];
        if (nloc == 0u) { xcd_barrier_complete(bar, b.x, nloc, nx); b.st[0] = nloc; b.st[1] = nx; }
        const unsigned old = xb_add(&bar[XB_XSUB(b.x)], 1u);
        const unsigned gen = old / nloc;
        if (old + 1u == (gen + 1u) * nloc) {
            __builtin_amdgcn_fence(__ATOMIC_RELEASE, "agent");
            asm volatile("s_waitcnt vmcnt(0)" ::: "memory");
            const unsigned og = xb_add(&bar[XB_TOP], 1u);
            const unsigned tg = og / nx;
            if (og + 1u == (tg + 1u) * nx) xb_add(&bar[XB_TOPGEN], 1u);
            else XB_SPIN(xb_ld(&bar[XB_TOPGEN]) == tg, bar);
            __builtin_amdgcn_fence(__ATOMIC_ACQUIRE, "agent");
            xb_add(&bar[XB_XGEN(b.x)], 1u);
            asm volatile("s_waitcnt vmcnt(0)" ::: "memory");
        } else {
            XB_SPIN(xb_ld(&bar[XB_XGEN(b.x)]) == gen, bar);
            __builtin_amdgcn_fence(__ATOMIC_ACQUIRE, "agent");
            asm volatile("s_waitcnt vmcnt(0)" ::: "memory");
        }
    }
    __syncthreads();
}

namespace pg8 {
constexpr int BM = 256, BK = 64, HALF = 128, HTB = HALF * BK * 2, STAGE_BYTES = 8 * HTB, NXCD = 8, WGM = 8;
__host__ __device__ __forceinline__ int lds_byte(int r, int c) { const int st = (r >> 4) * 2 + (c >> 5), rr = r & 15, cc = c & 31, ob = rr * 64 + cc * 2; return st * 1024 + (ob ^ (((ob >> 9) & 1) << 5)); }
__host__ __device__ __forceinline__ void stage_rc(int b, int& R, int& C) { const int st = b / 1024, sb = b % 1024, swz = sb ^ (((sb >> 9) & 1) << 5); R = (st >> 1) * 16 + swz / 64; C = (st & 1) * 32 + (swz % 64) / 2; }
__host__ __device__ __forceinline__ int perm32(int rho) { const int n = rho >> 4, i = rho & 15; return 8 * (i >> 2) + 4 * n + (i & 3); }

struct Unit { int pm, pn; const char* a; const char* b; const int* gi; int nvalid; int aux; };

struct StaticOrder {
    int nM, nN, nwg, G, c, RS; const char* A; const char* Bt;
    __device__ void init(const void* A_, const void* Bt_, int M, int N, int RS_, int G_, int c_) { A = (const char*)A_; Bt = (const char*)Bt_; RS = RS_; nM = M / BM; nN = N / BM; nwg = nM * nN; G = G_; c = c_; }
    __device__ bool next(int i, Unit& u) const {
        const long L = (long)i * G + c; if (L >= nwg) return false;
        int wgid = (int)L; { const int q = nwg / NXCD, r = nwg % NXCD, xcd = wgid % NXCD, off = wgid / NXCD; wgid = (xcd < r ? xcd * (q + 1) : r * (q + 1) + (xcd - r) * q) + off; }
        const int nig = WGM * nN, gid = wgid / nig, fm = gid * WGM, gsz = (nM - fm) < WGM ? (nM - fm) : WGM;
        u.pm = fm + ((wgid % nig) % gsz); u.pn = (wgid % nig) / gsz;
        u.a = A + (size_t)u.pm * BM * RS; u.b = Bt + (size_t)u.pn * BM * RS; u.gi = nullptr; u.nvalid = BM; u.aux = 0; return true;
    }
};

typedef int i32x8 __attribute__((ext_vector_type(8)));
typedef int i32x4v __attribute__((ext_vector_type(4)));
template <class Epi, class Sched, bool GATHER, bool FP8 = false>
__device__ __forceinline__ void gemm_phase(LAS unsigned char* lds, const int RS, const Sched& S, const Epi& E, const int scale_b = 0x7f7f7f7f, const int scale_a = 0x7f7f7f7f) {
    int tid = threadIdx.x; asm volatile("" : "+v"(tid));
    const int wid = __builtin_amdgcn_readfirstlane(tid >> 6), lane = tid & 63, wr = wid >> 2, wc = wid & 3, fr = lane & 15, fq = lane >> 4;
    const int nt = RS / (BK * 2); const int K = RS;
    unsigned voffA[2], voffB[2]; int RA[2], CA[2];
#pragma unroll
    for (int i = 0; i < 2; ++i) { int R, C; stage_rc(tid * 16 + i * 8192, R, C); const int Rb = ((R & ~31) + perm32(R & 31));
        RA[i] = R; CA[i] = C; voffA[i] = (unsigned)(R * RS + C * 2); voffB[i] = (unsigned)(Rb * RS + C * 2); }
    const size_t kstep = (size_t)(BK * 2);
    const size_t hstep = (size_t)HALF * RS;
    const unsigned ldsw = (unsigned)wid * 1024u;
    const int aoff = lds_byte(wr * 64 + fr, fq * 8), boff = lds_byte(wc * 32 + fr, fq * 8);
    unsigned gA[2][2], gN[2][2];
#define PG8_SA(b, h) (((b) * 2 + (h)) * HTB)
#define PG8_SB(b, h) ((4 + (b) * 2 + (h)) * HTB)
#define PG8_STAGE(bufoff, gbase, voff) do { _Pragma("unroll") for (int _i = 0; _i < 2; ++_i) \
        __builtin_amdgcn_global_load_lds((const unsigned*)((const char*)(gbase) + (voff)[_i]), (LAS unsigned*)(lds + (bufoff) + ldsw + _i * 8192), 16, 0, 0); } while (0)
#define PG8_STAGE_A(bufoff, gp, h, NX) do { if constexpr (GATHER) { if (NX) PG8_STAGE(bufoff, gp, gN[h]); else PG8_STAGE(bufoff, gp, gA[h]); } else PG8_STAGE(bufoff, (gp) + (h) * hstep, voffA); } while (0)
#define PG8_LD8(p_) __builtin_shufflevector(*(const LAS i32x4v*)(p_), *(const LAS i32x4v*)((p_) + 1024), 0, 1, 2, 3, 4, 5, 6, 7)
#define PG8_LDA(dst, b, h) do { if constexpr (FP8) { _Pragma("unroll") for (int m = 0; m < 4; ++m) dst##8[m] = PG8_LD8(lds + PG8_SA(b, h) + aoff + m * 2048); } \
        else { _Pragma("unroll") for (int m = 0; m < 4; ++m) _Pragma("unroll") for (int k = 0; k < 2; ++k) dst[m][k] = *(const LAS bf16x8*)(lds + PG8_SA(b, h) + aoff + m * 2048 + k * 1024); } } while (0)
#define PG8_LDB(dst, b, h) do { if constexpr (FP8) { _Pragma("unroll") for (int n = 0; n < 2; ++n) dst##8[n] = PG8_LD8(lds + PG8_SB(b, h) + boff + n * 2048); } \
        else { _Pragma("unroll") for (int n = 0; n < 2; ++n) _Pragma("unroll") for (int k = 0; k < 2; ++k) dst[n][k] = *(const LAS bf16x8*)(lds + PG8_SB(b, h) + boff + n * 2048 + k * 1024); } } while (0)
#define PG8_MMA(ai, bj, At, Bt) do { __builtin_amdgcn_s_setprio(1); \
        if constexpr (FP8) { _Pragma("unroll") for (int m = 0; m < 4; ++m) _Pragma("unroll") for (int n = 0; n < 2; ++n) \
            asm volatile("v_mfma_scale_f32_16x16x128_f8f6f4 %0, %1, %2, %0, %3, %4 op_sel_hi:[0,0,0]" : "+v"(acc[ai][bj][m][n]) : "v"(Bt##8[n]), "v"(At##8[m]), "v"(sc_b), "v"(sc_a)); } \
        else { _Pragma("unroll") for (int m = 0; m < 4; ++m) _Pragma("unroll") for (int n = 0; n < 2; ++n) _Pragma("unroll") for (int k = 0; k < 2; ++k) \
            acc[ai][bj][m][n] = __builtin_amdgcn_mfma_f32_16x16x32_bf16(Bt[n][k], At[m][k], acc[ai][bj][m][n], 0, 0, 0); } \
        __builtin_amdgcn_s_setprio(0); } while (0)
#define PG8_WAIT_V(n) asm volatile("s_waitcnt vmcnt(" #n ")" ::: "memory")
#define PG8_WAIT_L(n) asm volatile("s_waitcnt lgkmcnt(" #n ")" ::: "memory")
#define PG8_BAR __builtin_amdgcn_s_barrier()
#define PG8_SCHED __builtin_amdgcn_sched_barrier(0)
#define PG8_GIDX(dst, u) do { if constexpr (GATHER) { _Pragma("unroll") for (int h = 0; h < 2; ++h) _Pragma("unroll") for (int i = 0; i < 2; ++i) { \
        const int rr = h * HALF + RA[i]; const int tok = rr < (u).nvalid ? (u).gi[rr] : 0; dst[h][i] = (unsigned)(tok * K + CA[i] * 2); } } } while (0)
    Unit cur, nxt; int ui = 0;
    if (!S.next(0, cur)) return;
    f32x4 acc[2][2][4][2];
#pragma unroll
    for (int a = 0; a < 2; ++a)
#pragma unroll
        for (int b = 0; b < 2; ++b)
#pragma unroll
            for (int m = 0; m < 4; ++m)
#pragma unroll
                for (int n = 0; n < 2; ++n) acc[a][b][m][n] = (f32x4){0.f, 0.f, 0.f, 0.f};
    const int sc_b = scale_b, sc_a = scale_a;
    bf16x8 At[4][2], B0[2][2], B1[2][2]; i32x8 At8[4], B08[2], B18[2];
    const char* cA = cur.a; const char* cB = cur.b;
    PG8_GIDX(gA, cur);
    PG8_STAGE(PG8_SB(0, 0), cB, voffB); PG8_STAGE_A(PG8_SA(0, 0), cA, 0, false); PG8_STAGE(PG8_SB(0, 1), cB + hstep, voffB); PG8_STAGE_A(PG8_SA(0, 1), cA, 1, false);
    if (wr == 1) PG8_BAR;
    PG8_WAIT_V(4); PG8_BAR;
    PG8_STAGE(PG8_SB(1, 0), cB + kstep, voffB); PG8_STAGE_A(PG8_SA(1, 0), cA + kstep, 0, false); PG8_STAGE(PG8_SB(1, 1), cB + hstep + kstep, voffB);
    PG8_WAIT_V(6); PG8_BAR;
    for (;;) {
        const bool has_next = S.next(ui + 1, nxt);
        const char* nA = has_next ? nxt.a : cA; const char* nB = has_next ? nxt.b : cB;
        if constexpr (GATHER) { if (has_next) { PG8_GIDX(gN, nxt); } else {
#pragma unroll
            for (int h = 0; h < 2; ++h)
#pragma unroll
                for (int i = 0; i < 2; ++i) gN[h][i] = gA[h][i]; } }
        for (int t = 0; t < nt; t += 2) {
            const bool last = (t == nt - 2);
            const char* a1 = cA + (size_t)(t + 1) * kstep;
            const char* a2 = last ? nA : cA + (size_t)(t + 2) * kstep; const char* b2 = last ? nB : cB + (size_t)(t + 2) * kstep;
            const char* a3 = a2 + kstep; const char* b3 = b2 + kstep;
            PG8_LDB(B0, 0, 0); PG8_SCHED; PG8_LDA(At, 0, 0); PG8_STAGE_A(PG8_SA(1, 1), a1, 1, false);
            PG8_WAIT_L(8); PG8_BAR; PG8_WAIT_L(0); PG8_MMA(0, 0, At, B0); PG8_BAR; PG8_SCHED;
            PG8_LDB(B1, 0, 1); PG8_STAGE(PG8_SB(0, 0), b2, voffB);
            PG8_BAR; PG8_WAIT_L(0); PG8_MMA(0, 1, At, B1); PG8_BAR;
            PG8_LDA(At, 0, 1); PG8_STAGE_A(PG8_SA(0, 0), a2, 0, last);
            PG8_BAR; PG8_WAIT_L(0); PG8_MMA(1, 0, At, B0); PG8_BAR; PG8_SCHED;
            PG8_STAGE(PG8_SB(0, 1), b2 + hstep, voffB);
            PG8_WAIT_V(6); PG8_BAR; PG8_MMA(1, 1, At, B1); PG8_BAR;
            PG8_LDB(B0, 1, 0); PG8_SCHED; PG8_LDA(At, 1, 0); PG8_STAGE_A(PG8_SA(0, 1), a2, 1, last);
            PG8_WAIT_L(8); PG8_BAR; PG8_WAIT_L(0); PG8_MMA(0, 0, At, B0); PG8_BAR; PG8_SCHED;
            PG8_LDB(B1, 1, 1); PG8_STAGE(PG8_SB(1, 0), b3, voffB);
            PG8_BAR; PG8_WAIT_L(0); PG8_MMA(0, 1, At, B1); PG8_BAR;
            PG8_LDA(At, 1, 1); PG8_STAGE_A(PG8_SA(1, 0), a3, 0, last);
            PG8_BAR; PG8_WAIT_L(0); PG8_MMA(1, 0, At, B0); PG8_BAR; PG8_SCHED;
            PG8_STAGE(PG8_SB(1, 1), b3 + hstep, voffB);
            PG8_WAIT_V(6); PG8_BAR; PG8_MMA(1, 1, At, B1); PG8_BAR;
        }
        bool keep_acc = false;
        if constexpr (FP8) asm volatile("s_nop 15\n\ts_nop 15" ::: "memory");
        if constexpr (Epi::DUAL) { if (cur.aux) { E.mid(acc, cur, wr, wc, fr, fq); keep_acc = true; } else E(acc, cur, wr, wc, fr, fq); } else E(acc, cur, wr, wc, fr, fq);
        if (!has_next) break;
        if (!keep_acc)
#pragma unroll
        for (int a = 0; a < 2; ++a)
#pragma unroll
            for (int b = 0; b < 2; ++b)
#pragma unroll
                for (int m = 0; m < 4; ++m)
#pragma unroll
                    for (int n = 0; n < 2; ++n) acc[a][b][m][n] = (f32x4){0.f, 0.f, 0.f, 0.f};
        cur = nxt; cA = nA; cB = nB; ++ui;
        if constexpr (GATHER) {
#pragma unroll
            for (int h = 0; h < 2; ++h)
#pragma unroll
                for (int i = 0; i < 2; ++i) gA[h][i] = gN[h][i]; }
    }
    PG8_WAIT_V(0);
    if (wr == 0) PG8_BAR;
    PG8_BAR;
#undef PG8_SA
#undef PG8_SB
#undef PG8_STAGE
#undef PG8_STAGE_A
#undef PG8_LDA
#undef PG8_LD8
#undef PG8_LDB
#undef PG8_MMA
#undef PG8_WAIT_V
#undef PG8_WAIT_L
#undef PG8_BAR
#undef PG8_SCHED
#undef PG8_GIDX
}
}
using pg8::Unit;

#define EPI_LOOP(...) { int fr_ = fr, fq_ = fq; asm volatile("" : "+v"(fr_), "+v"(fq_)); _Pragma("unroll") for (int ai = 0; ai < 2; ++ai) _Pragma("unroll") for (int m = 0; m < 4; ++m) _Pragma("unroll") for (int bj = 0; bj < 2; ++bj) { \
        const int trow = ai * 128 + wr * 64 + m * 16 + fr_; const int tcol = bj * 128 + wc * 32 + fq_ * 8; const f32x4 v0 = acc[ai][bj][m][0], v1 = acc[ai][bj][m][1]; __VA_ARGS__ } }

__device__ __forceinline__ u32x4 pack8(const f32x4 a, const f32x4 b) { u32x4 w; w.x = cvt_pk_bf16(a[0], a[1]); w.y = cvt_pk_bf16(a[2], a[3]); w.z = cvt_pk_bf16(b[0], b[1]); w.w = cvt_pk_bf16(b[2], b[3]); return w; }

struct EpiProj { static constexpr bool DUAL = false;
    unsigned char* ws; const float* b_gate;
    __device__ __forceinline__ void operator()(const f32x4 (&acc)[2][2][4][2], const Unit& u, int wr, int wc, int fr, int fq) const {
        const int pn = u.pn; const size_t row0 = (size_t)u.pm * 256;
        if (pn == 4 || pn == 9) {
            float* dst = (float*)(ws + (pn == 4 ? WS_CKV : WS_MISC));
            EPI_LOOP({ float* p = dst + (row0 + trow) * 256 + tcol; *(f32x4*)p = v0; *(f32x4*)(p + 4) = v1;
                if (pn == 9 && tcol < 64) *(u32x4*)((bf16_t*)(ws + WS_KIDX) + (row0 + trow) * 64 + tcol) = pack8(v0, v1); })
        } else if (pn < 22) {
            bf16_t* dst; int ct;
            if (pn < 4) { dst = (bf16_t*)(ws + WS_QA); ct = pn; } else if (pn < 9) { dst = (bf16_t*)(ws + WS_QIDX); ct = pn - 5; }
            else if (pn < 14) { dst = (bf16_t*)(ws + WS_QB); ct = pn - 10; } else if (pn < 18) { dst = (bf16_t*)(ws + WS_KB); ct = pn - 14; } else { dst = (bf16_t*)(ws + WS_VB); ct = pn - 18; }
            EPI_LOOP({ *(u32x4*)(dst + (row0 + trow) * 1024 + ct * 256 + tcol) = pack8(v0, v1); })
        } else {
            bf16_t* dst = (bf16_t*)(ws + WS_GATES); const int ct = pn - 22;
            EPI_LOOP({ const int col = ct * 256 + tcol; const f32x4 b0 = *(const f32x4*)(b_gate + col), b1 = *(const f32x4*)(b_gate + col + 4); f32x4 s0, s1;
                _Pragma("unroll") for (int j = 0; j < 4; ++j) { s0[j] = sigmoidf_(v0[j] + b0[j]); s1[j] = sigmoidf_(v1[j] + b1[j]); }
                u32x2 w8; w8.x = pack_u8x4(s0[0], s0[1], s0[2], s0[3]); w8.y = pack_u8x4(s1[0], s1[1], s1[2], s1[3]); *(u32x2*)((unsigned char*)dst + (row0 + trow) * 4096 + col) = w8; })
        }
    }
};
struct EpiGate1 { static constexpr bool DUAL = false;
    const bf16_t* gates; bf16_t* T1;
    __device__ __forceinline__ void operator()(const f32x4 (&acc)[2][2][4][2], const Unit& u, int wr, int wc, int fr, int fq) const {
        EPI_LOOP({ const size_t row = (size_t)u.pm * 256 + trow; const int col = u.pn * 256 + tcol; const u32x2 g = *(const u32x2*)((const unsigned char*)gates + row * 4096 + col);
            const f32x4 o0 = v0 * unpack_u8x4(g.x), o1 = v1 * unpack_u8x4(g.y);
            *(u32x4*)(T1 + row * 2048 + col) = pack8(o0, o1); })
    }
};
struct EpiGate2 { static constexpr bool DUAL = false;
    const bf16_t* gates; const bf16_t* T1; unsigned char* merged;
    __device__ __forceinline__ void operator()(const f32x4 (&acc)[2][2][4][2], const Unit& u, int wr, int wc, int fr, int fq) const {
        EPI_LOOP({ const size_t row = (size_t)u.pm * 256 + trow; const int col = u.pn * 256 + tcol; const u32x2 g = *(const u32x2*)((const unsigned char*)gates + row * 4096 + 2048 + col);
            const u32x4 t = *(const u32x4*)(T1 + row * 2048 + col);
            const f32x4 o0 = (f32x4){bf_lo(t.x), bf_hi(t.x), bf_lo(t.y), bf_hi(t.y)} + v0 * unpack_u8x4(g.x), o1 = (f32x4){bf_lo(t.z), bf_hi(t.z), bf_lo(t.w), bf_hi(t.w)} + v1 * unpack_u8x4(g.y);
            u32x2 w8; w8.x = pack_fp8x4(o0[0] * 4.f, o0[1] * 4.f, o0[2] * 4.f, o0[3] * 4.f); w8.y = pack_fp8x4(o1[0] * 4.f, o1[1] * 4.f, o1[2] * 4.f, o1[3] * 4.f);
            *(u32x2*)(merged + row * 2048 + col) = w8; })
    }
};
struct EpiWo { static constexpr bool DUAL = false;
    const float* mod; bf16_t* y;
    __device__ __forceinline__ void operator()(const f32x4 (&acc)[2][2][4][2], const Unit& u, int wr, int wc, int fr, int fq) const {
        const float* gt = mod + (size_t)(u.pm >> 3) * 12288 + 4096;
        EPI_LOOP({ const size_t row = (size_t)u.pm * 256 + trow; const int col = u.pn * 256 + tcol;
            const f32x4 g0 = *(const f32x4*)(gt + col), g1 = *(const f32x4*)(gt + col + 4);
            *(u32x4*)(y + row * 2048 + col) = pack8(g0 * v0, g1 * v1); })
    }
};
struct DualOrder {
    pg8::StaticOrder S0, S1;
    __device__ bool next(int i, Unit& u) const { const bool ok = (i & 1) ? S1.next(i >> 1, u) : S0.next(i >> 1, u); u.aux = (i & 1) ? 0 : 1; return ok; }
};
struct EpiGate12 { static constexpr bool DUAL = false;
    EpiGate1 e1; EpiGate2 e2;
    __device__ __forceinline__ void operator()(const f32x4 (&acc)[2][2][4][2], const Unit& u, int wr, int wc, int fr, int fq) const { if (u.aux) e1(acc, u, wr, wc, fr, fq); else e2(acc, u, wr, wc, fr, fq); }
};

struct ProjOrder {
    pg8::StaticOrder S; int fp8; const char* Bfull;
    __device__ bool next(int i, Unit& u) const {
        if (!S.next(i, u)) return false;
        if (fp8) { if (u.pn >= 2) u.pn += 8; } else u.pn += 2;
        return true;
    }
};
__device__ __forceinline__ int map_row(int map, int n) {
    if (map == 0) return n;
    if (map == 1) { if (n < 2384) return n; if (n < 5456) return n + 176; if (n < 5464) return n - 3072; return n + 168; }
    if (map == 4) return n + 512;
    return n + 2384;
}
__device__ void ph0_prologue(const Params& p, LAS unsigned char* lds) {
    const int tid = threadIdx.x, wid = tid >> 6, lane = tid & 63, G = gridDim.x, bx = blockIdx.x;
    if (bx < 192) {
        LAS float* sc = (LAS float*)lds;
        LAS float* red = (LAS float*)(lds + 32768);
        const float* c = p.in[I_C];
        for (int i = tid; i < 4 * 2048; i += NTHREADS) { const float v = c[i]; sc[i] = v / (1.0f + __expf(-v)); }
        __syncthreads();
        for (int item = bx; item < 192; item += G) {
            const int n0 = item * 64, cg = lane & 15, rs = lane >> 4;
            float acc[4][4];
#pragma unroll
            for (int b = 0; b < 4; ++b)
#pragma unroll
                for (int j = 0; j < 4; ++j) acc[b][j] = 0.f;
            const float* w = p.in[I_WADA] + n0 + cg * 4;
#pragma unroll 4
            for (int step = 0; step < 64; ++step) {
                const int k = step * 32 + wid * 4 + rs;
                const f32x4 wv = *(const f32x4*)(w + (size_t)k * 12288);
#pragma unroll
                for (int b = 0; b < 4; ++b) { const float s = sc[b * 2048 + k];
#pragma unroll
                    for (int j = 0; j < 4; ++j) acc[b][j] += s * wv[j]; }
            }
#pragma unroll
            for (int b = 0; b < 4; ++b)
#pragma unroll
                for (int j = 0; j < 4; ++j) { float v = acc[b][j]; v += __shfl_xor(v, 16); v += __shfl_xor(v, 32); acc[b][j] = v; }
            if (rs == 0) {
#pragma unroll
                for (int b = 0; b < 4; ++b)
#pragma unroll
                    for (int j = 0; j < 4; ++j) red[(wid * 16 + cg) * 16 + b * 4 + j] = acc[b][j]; }
            __syncthreads();
            if (tid < 256) { const int cg2 = tid >> 4, bj = tid & 15, b = bj >> 2, j = bj & 3; float s = 0.f;
#pragma unroll
                for (int w8 = 0; w8 < 8; ++w8) s += red[(w8 * 16 + cg2) * 16 + bj];
                const int n = n0 + cg2 * 4 + j; ((float*)(p.ws + WS_MOD))[b * 12288 + n] = s + p.in[I_BADA][n]; }
            __syncthreads();
        }
    }
    { u32x4* z = (u32x4*)(p.ws + WS_WIN + (size_t)2392 * 2048 * 2); const int n16 = 168 * 2048 * 2 / 16;
      for (int i = bx * NTHREADS + tid; i < n16; i += G * NTHREADS) z[i] = (u32x4){0u, 0u, 0u, 0u}; }
    { bf16_t* wh = (bf16_t*)(p.ws + WS_WRH); bf16_t* wl = (bf16_t*)(p.ws + WS_WRL);
      for (int i = bx * NTHREADS + tid; i < 80 * 2048; i += G * NTHREADS) { const int n = i >> 11, k = i & 2047;
          const float v = n < 8 ? p.in[I_WRG][k * 8 + n] : (n < 72 ? p.in[I_WRE][k * 64 + n - 8] : 0.f);
          const unsigned h = cvt_pk_bf16(v, 0.f) & 0xffffu; const unsigned l = cvt_pk_bf16(v - bf_lo(h), 0.f) & 0xffffu; wh[i] = (bf16_t)h; wl[i] = (bf16_t)l; } }
    LAS float* tile0 = (LAS float*)(lds + 65536);
    f32x4 v[4];
#define T_DECODE(ti_) int j_ = 0; _Pragma("unroll 1") for (int q = 1; q < NJOBS; ++q) if ((ti_) >= p.jobs[q].tile0) j_ = q; const TJob& J = p.jobs[j_]; \
        int l_ = (ti_) - J.tile0; const int per_ = J.ntk * J.ntn; const int bt_ = l_ / per_; l_ -= bt_ * per_; const int tn_ = l_ / J.ntk, tk_ = l_ % J.ntk; const int k0 = tk_ * 64, n0 = tn_ * 128;
#define T_LOAD(ti_) do { T_DECODE(ti_) const float* src = J.src + (size_t)bt_ * J.sbatch; \
        _Pragma("unroll") for (int i = 0; i < 4; ++i) { const int r = (tid >> 5) + 16 * i, c4 = (tid & 31) * 4; \
            v[i] = (f32x4){0.f, 0.f, 0.f, 0.f}; if (n0 + c4 < J.N) v[i] = *(const f32x4*)(src + (size_t)(k0 + r) * J.ld + n0 + c4); } } while (0)
    if (bx < p.ntiles_total) T_LOAD(bx);
    int it = 0;
    for (int ti = bx; ti < p.ntiles_total; ti += G, ++it) {
        LAS float* tile = tile0 + (it & 1) * (64 * 129);
#pragma unroll
        for (int i = 0; i < 4; ++i) { const int r = (tid >> 5) + 16 * i, c4 = (tid & 31) * 4;
#pragma unroll
            for (int q = 0; q < 4; ++q) tile[r * 129 + c4 + q] = v[i][q]; }
        __syncthreads();
        if (ti + G < p.ntiles_total) T_LOAD(ti + G);
        { T_DECODE(ti) bf16_t* dst = J.dst + (size_t)bt_ * J.dbatch;
          const int n = tid >> 2, kq = (tid & 3) * 16;
          if (n0 + n < J.N) { float f[16];
#pragma unroll
              for (int q = 0; q < 16; ++q) f[q] = tile[(kq + q) * 129 + n];
              if (J.fp8) { u32x4 w8; w8.x = pack_fp8x4(f[0] * 64.f, f[1] * 64.f, f[2] * 64.f, f[3] * 64.f); w8.y = pack_fp8x4(f[4] * 64.f, f[5] * 64.f, f[6] * 64.f, f[7] * 64.f);
                  w8.z = pack_fp8x4(f[8] * 64.f, f[9] * 64.f, f[10] * 64.f, f[11] * 64.f); w8.w = pack_fp8x4(f[12] * 64.f, f[13] * 64.f, f[14] * 64.f, f[15] * 64.f);
                  *(u32x4*)((unsigned char*)dst + (size_t)(n0 + n) * J.ldd + k0 + kq) = w8; }
              else { u32x4 w0, w1; w0.x = cvt_pk_bf16(f[0], f[1]); w0.y = cvt_pk_bf16(f[2], f[3]); w0.z = cvt_pk_bf16(f[4], f[5]); w0.w = cvt_pk_bf16(f[6], f[7]);
                  w1.x = cvt_pk_bf16(f[8], f[9]); w1.y = cvt_pk_bf16(f[10], f[11]); w1.z = cvt_pk_bf16(f[12], f[13]); w1.w = cvt_pk_bf16(f[14], f[15]);
                  bf16_t* d = dst + (size_t)map_row(J.map, n0 + n) * J.ldd + k0 + kq; *(u32x4*)d = w0; *(u32x4*)(d + 8) = w1; } } }
    }
#undef T_LOAD
#undef T_DECODE
    __syncthreads();
}

__device__ __forceinline__ void norm_row(const float* xr, const float* g, const float* sh, const float* sc, bf16_t* hr, unsigned char* h8, int lane, float (&hv)[32]) {
    f32x4 v[8]; float ss = 0.f;
#pragma unroll
    for (int i = 0; i < 8; ++i) { v[i] = *(const f32x4*)(xr + i * 256 + lane * 4); ss += v[i][0] * v[i][0] + v[i][1] * v[i][1] + v[i][2] * v[i][2] + v[i][3] * v[i][3]; }
    ss = wave_sum(ss);
    const float rstd = rsqrtf(ss * (1.0f / 2048.0f) + RMS_EPS);
#pragma unroll
    for (int i = 0; i < 8; ++i) { const int col = i * 256 + lane * 4; const f32x4 gg = *(const f32x4*)(g + col), s1 = *(const f32x4*)(sc + col), s0 = *(const f32x4*)(sh + col);
#pragma unroll
        for (int j = 0; j < 4; ++j) hv[i * 4 + j] = v[i][j] * rstd * gg[j] * (1.0f + s1[j]) + s0[j];
        u32x2 w; w.x = cvt_pk_bf16(hv[i * 4], hv[i * 4 + 1]); w.y = cvt_pk_bf16(hv[i * 4 + 2], hv[i * 4 + 3]); *(u32x2*)(hr + col) = w;
        if (h8) *(unsigned*)(h8 + col) = pack_fp8x4(hv[i * 4], hv[i * 4 + 1], hv[i * 4 + 2], hv[i * 4 + 3]); }
}
__device__ void ph1_norm(const Params& p) {
    const int lane = threadIdx.x & 63, gw = blockIdx.x * 8 + (threadIdx.x >> 6), nw = gridDim.x * 8;
    const float* mod = (const float*)(p.ws + WS_MOD);
    for (int t = gw; t < NTOK; t += nw) { const int b = t >> 11; float hv[32];
        norm_row(p.in[I_X] + (size_t)t * DM, p.in[I_GMIX], mod + b * 12288, mod + b * 12288 + 2048, (bf16_t*)(p.ws + WS_H) + (size_t)t * DM, (unsigned char*)(p.ws + WS_HF8) + (size_t)t * DM, lane, hv); }
}

template <int MB, int NB, int KS>
__device__ __forceinline__ void wave_gemm(const bf16_t* A, int lda, const bf16_t* Bt, int ldb, f32x4 (&acc)[MB][NB], int lane) {
    const int fr = lane & 15, fq = lane >> 4;
#pragma unroll
    for (int mb = 0; mb < MB; ++mb)
#pragma unroll
        for (int nb = 0; nb < NB; ++nb) acc[mb][nb] = (f32x4){0.f, 0.f, 0.f, 0.f};
#pragma unroll 1
    for (int ks = 0; ks < KS; ++ks) {
        bf16x8 af[MB];
#pragma unroll
        for (int mb = 0; mb < MB; ++mb) af[mb] = *(const bf16x8*)(A + (size_t)(mb * 16 + fr) * lda + ks * 32 + fq * 8);
#pragma unroll
        for (int nb = 0; nb < NB; ++nb) { const bf16x8 bf = *(const bf16x8*)(Bt + (size_t)(nb * 16 + fr) * ldb + ks * 32 + fq * 8);
#pragma unroll
            for (int mb = 0; mb < MB; ++mb) acc[mb][nb] = __builtin_amdgcn_mfma_f32_16x16x32_bf16(bf, af[mb], acc[mb][nb], 0, 0, 0); }
    }
}


__device__ __forceinline__ int wave_total_i32(int v) {
    v += __builtin_amdgcn_update_dpp(0, v, 0x111, 0xf, 0xf, true); v += __builtin_amdgcn_update_dpp(0, v, 0x112, 0xf, 0xf, true);
    v += __builtin_amdgcn_update_dpp(0, v, 0x114, 0xf, 0xf, true); v += __builtin_amdgcn_update_dpp(0, v, 0x118, 0xf, 0xf, true);
    v += __builtin_amdgcn_update_dpp(0, v, 0x142, 0xa, 0xf, false); v += __builtin_amdgcn_update_dpp(0, v, 0x143, 0xc, 0xf, false);
    return __builtin_amdgcn_readlane(v, 63);
}
template <int NI> __device__ __forceinline__ void topk_words2(const LAS float* srow0, const LAS float* srow1, int c, int lane, unsigned long long& w0, unsigned long long& w1) {
    unsigned ka[NI], kb[NI];
#pragma unroll
    for (int i = 0; i < NI; ++i) { unsigned u = 0u, x = 0u; if (i <= c) { u = __float_as_uint(srow0[i * 64 + lane]); u = (u & 0x80000000u) ? ~u : (u | 0x80000000u);
            x = __float_as_uint(srow1[i * 64 + lane]); x = (x & 0x80000000u) ? ~x : (x | 0x80000000u); } ka[i] = u; kb[i] = x; }
    unsigned va = 0u, vb = 0u; bool da = false, db = false;
#pragma unroll 1
    for (int bit = 31; bit >= 0; --bit) {
        const unsigned ca = va | (1u << bit), cb = vb | (1u << bit); int a0 = 0, a1 = 0, b0 = 0, b1 = 0;
#pragma unroll
        for (int i = 0; i < NI; i += 2) { a0 += (ka[i] >= ca) ? 1 : 0; a1 += (ka[i + 1] >= ca) ? 1 : 0; b0 += (kb[i] >= cb) ? 1 : 0; b1 += (kb[i + 1] >= cb) ? 1 : 0; }
        const int ta = wave_total_i32(a0 + a1), tb = wave_total_i32(b0 + b1);
        if (!da && ta >= 256) { va = ca; da = (ta == 256); }
        if (!db && tb >= 256) { vb = cb; db = (tb == 256); }
        if (da && db) break;
    }
    w0 = 0ull; w1 = 0ull;
#pragma unroll
    for (int i = 0; i < NI; ++i) { const unsigned long long ma = __ballot(ka[i] >= va), mb = __ballot(kb[i] >= vb); if (lane == i) { w0 = ma; w1 = mb; } if ((i & 3) == 3) SBAR(); }
}

__device__ void idx_item(const Params& p, LAS unsigned char* lds, int b, int c, int sub) {
    const int tid = threadIdx.x, wid = tid >> 6, lane = tid & 63, fr = lane & 15, fq = lane >> 4;
    constexpr int SCLD = 2052;
    LAS float* sc = (LAS float*)lds;
    const int q0 = c * 64 + sub * 16, nk = (c + 1) * 64, nkb = nk / 16;
    const bf16_t* qidx = (const bf16_t*)(p.ws + WS_QIDX) + (size_t)(b * SEQ + q0 + fr) * 1024;
    const float* misc = (const float*)(p.ws + WS_MISC);
    float wq[16];
    { const float* wp = misc + (size_t)(b * SEQ + q0 + fr) * 256 + 64;
#pragma unroll
      for (int i = 0; i < 4; ++i) { const f32x4 v = *(const f32x4*)(wp + i * 4); wq[i * 4] = v[0]; wq[i * 4 + 1] = v[1]; wq[i * 4 + 2] = v[2]; wq[i * 4 + 3] = v[3]; } }
    {
        bf16x8 qf[16][2];
#pragma unroll
        for (int h = 0; h < 16; ++h)
#pragma unroll
            for (int ks = 0; ks < 2; ++ks) qf[h][ks] = *(const bf16x8*)(qidx + h * 64 + ks * 32 + fq * 8);
        const bf16_t* kbase = (const bf16_t*)(p.ws + WS_KIDX) + (size_t)(b * SEQ + fr) * 64 + fq * 8;
        bf16x8 kf[2];
        if (wid < nkb) { kf[0] = *(const bf16x8*)(kbase + (size_t)wid * 16 * 64); kf[1] = *(const bf16x8*)(kbase + (size_t)wid * 16 * 64 + 32); }
#pragma unroll 1
        for (int kb = wid; kb < nkb; kb += 8) {
            const int kn = kb + 8 < nkb ? kb + 8 : kb;
            const bf16x8 kn0 = *(const bf16x8*)(kbase + (size_t)kn * 16 * 64), kn1 = *(const bf16x8*)(kbase + (size_t)kn * 16 * 64 + 32);
            f32x4 s = {0.f, 0.f, 0.f, 0.f};
#pragma unroll
            for (int h = 0; h < 16; ++h) {
                f32x4 a = {0.f, 0.f, 0.f, 0.f};
                a = __builtin_amdgcn_mfma_f32_16x16x32_bf16(kf[0], qf[h][0], a, 0, 0, 0);
                a = __builtin_amdgcn_mfma_f32_16x16x32_bf16(kf[1], qf[h][1], a, 0, 0, 0);
#pragma unroll
                for (int j = 0; j < 4; ++j) s[j] += wq[h] * fmaxf(a[j], 0.f);
            }
            *(LAS f32x4*)(sc + fr * SCLD + kb * 16 + fq * 4) = s;
            kf[0] = kn0; kf[1] = kn1;
        }
    }
    __syncthreads();
    unsigned long long* mask = (unsigned long long*)(p.ws + WS_MASK);
    {
        const int ql = wid * 2; const size_t qg = (size_t)b * SEQ + q0 + ql;
        unsigned long long w0 = 0ull, w1 = 0ull;
        if (nk <= 256) { if (lane <= c) { w0 = ~0ull; w1 = ~0ull; } }
        else { const LAS float* s0 = sc + ql * SCLD; const LAS float* s1 = s0 + SCLD;
            if (c < 8) topk_words2<8>(s0, s1, c, lane, w0, w1); else if (c < 16) topk_words2<16>(s0, s1, c, lane, w0, w1);
            else if (c < 24) topk_words2<24>(s0, s1, c, lane, w0, w1); else topk_words2<32>(s0, s1, c, lane, w0, w1); }
        if (lane < 32) { mask[qg * 32 + lane] = w0; mask[(qg + 1) * 32 + lane] = w1; }
    }
    __syncthreads();
}
#ifndef REP_SUB
#define REP_SUB 15
#endif
__device__ void ph3_prep(const Params& p, LAS unsigned char* lds, const int rep) {
#define P3ON(bit) (!rep || ((REP_SUB) & (bit)))
    const int tid = threadIdx.x, wid = tid >> 6, lane = tid & 63, bx = blockIdx.x, G = gridDim.x;
    if (P3ON(1)) for (int it = bx; it < 256; it += G) {
        const int b = it >> 6, r = it & 63, cp = r >> 2, sub = r & 3;
        idx_item(p, lds, b, 31 - cp, sub); idx_item(p, lds, b, cp, sub);
    }
    const int gw = bx * 8 + wid, nw = G * 8;
    if (P3ON(2)) for (int it = bx; it < 256; it += G) {
        const int h = it & 7, rt = (it >> 3) * 8 + wid, fr = lane & 15, fq = lane >> 4;
        const bf16_t* A = (const bf16_t*)(p.ws + WS_QA) + (size_t)rt * 32 * 1024 + h * 128;
        bf16x8 af[2][4];
#pragma unroll
        for (int mb = 0; mb < 2; ++mb)
#pragma unroll
            for (int ks = 0; ks < 4; ++ks) af[mb][ks] = *(const bf16x8*)(A + (size_t)(mb * 16 + fr) * 1024 + ks * 32 + fq * 8);
        __syncthreads();
        { const bf16_t* W = (const bf16_t*)(p.ws + WS_WUK) + (size_t)h * 256 * 128;
#pragma unroll
          for (int i = 0; i < 8; ++i) { const int c = i * 512 + tid, n = c >> 4, ch = c & 15; *(LAS u32x4*)(lds + n * 256 + ((ch ^ (n & 15)) * 16)) = *(const u32x4*)(W + n * 128 + ch * 8); } }
        __syncthreads();
        f32x4 acc[2][16];
#pragma unroll
        for (int mb = 0; mb < 2; ++mb)
#pragma unroll
            for (int nb = 0; nb < 16; ++nb) acc[mb][nb] = (f32x4){0.f, 0.f, 0.f, 0.f};
#pragma unroll
        for (int ks = 0; ks < 4; ++ks) {
#pragma unroll
            for (int nb = 0; nb < 16; ++nb) { const bf16x8 bf = *(const LAS bf16x8*)(lds + (nb * 16 + fr) * 256 + (((ks * 4 + fq) ^ fr) * 16));
#pragma unroll
                for (int mb = 0; mb < 2; ++mb) acc[mb][nb] = __builtin_amdgcn_mfma_f32_16x16x32_bf16(bf, af[mb][ks], acc[mb][nb], 0, 0, 0);
                if ((nb & 7) == 7) SBAR(); } }
#pragma unroll
        for (int mb = 0; mb < 2; ++mb) { float ss = 0.f;
#pragma unroll
            for (int nb = 0; nb < 16; ++nb)
#pragma unroll
                for (int j = 0; j < 4; ++j) ss += acc[mb][nb][j] * acc[mb][nb][j];
            ss += __shfl_xor(ss, 16); ss += __shfl_xor(ss, 32);
            const float rs = rsqrtf(ss * (1.0f / 256.0f) + RMS_EPS) * 0.0625f;
            bf16_t* o = (bf16_t*)(p.ws + WS_QLAT) + (size_t)(rt * 32 + mb * 16 + fr) * 2048 + h * 256;
#pragma unroll
            for (int nb = 0; nb < 16; ++nb) { const int col = nb * 16 + fq * 4; const f32x4 g = *(const f32x4*)(p.in[I_GQA] + col);
                u32x2 w; w.x = cvt_pk_bf16(acc[mb][nb][0] * rs * g[0], acc[mb][nb][1] * rs * g[1]); w.y = cvt_pk_bf16(acc[mb][nb][2] * rs * g[2], acc[mb][nb][3] * rs * g[3]); *(u32x2*)(o + col) = w; } }
    }
    if (P3ON(4))
#pragma unroll 4
    for (int t = gw; t < NTOK; t += nw) {
        { const f32x4 v = *(const f32x4*)((const float*)(p.ws + WS_CKV) + (size_t)t * 256 + lane * 4); float ss = wave_sum(v[0] * v[0] + v[1] * v[1] + v[2] * v[2] + v[3] * v[3]);
          const float rs = rsqrtf(ss * (1.0f / 256.0f) + RMS_EPS); const f32x4 g = *(const f32x4*)(p.in[I_GKV] + lane * 4);
          u32x2 w; w.x = cvt_pk_bf16(v[0] * rs * g[0], v[1] * rs * g[1]); w.y = cvt_pk_bf16(v[2] * rs * g[2], v[3] * rs * g[3]); *(u32x2*)((bf16_t*)(p.ws + WS_KV) + (size_t)t * 256 + lane * 4) = w; }
#pragma unroll
        for (int which = 1; which < 2; ++which) {
            bf16_t* row = (bf16_t*)(p.ws + (which ? WS_KB : WS_QB)) + (size_t)t * 1024 + lane * 16; const float* g = p.in[which ? I_GKB : I_GQB] + (lane & 7) * 16;
            u32x4 a = *(u32x4*)row, c2 = *(u32x4*)(row + 8); float f[16];
            f[0] = bf_lo(a.x); f[1] = bf_hi(a.x); f[2] = bf_lo(a.y); f[3] = bf_hi(a.y); f[4] = bf_lo(a.z); f[5] = bf_hi(a.z); f[6] = bf_lo(a.w); f[7] = bf_hi(a.w);
            f[8] = bf_lo(c2.x); f[9] = bf_hi(c2.x); f[10] = bf_lo(c2.y); f[11] = bf_hi(c2.y); f[12] = bf_lo(c2.z); f[13] = bf_hi(c2.z); f[14] = bf_lo(c2.w); f[15] = bf_hi(c2.w);
            float ss = 0.f;
#pragma unroll
            for (int j = 0; j < 16; ++j) ss += f[j] * f[j];
            ss += __shfl_xor(ss, 1); ss += __shfl_xor(ss, 2); ss += __shfl_xor(ss, 4);
            const float rs = rsqrtf(ss * (1.0f / 128.0f) + RMS_EPS) * (which ? 1.0f : 0.08838834764831845f);
#pragma unroll
            for (int j = 0; j < 16; ++j) f[j] *= rs * g[j];
            a.x = cvt_pk_bf16(f[0], f[1]); a.y = cvt_pk_bf16(f[2], f[3]); a.z = cvt_pk_bf16(f[4], f[5]); a.w = cvt_pk_bf16(f[6], f[7]);
            c2.x = cvt_pk_bf16(f[8], f[9]); c2.y = cvt_pk_bf16(f[10], f[11]); c2.z = cvt_pk_bf16(f[12], f[13]); c2.w = cvt_pk_bf16(f[14], f[15]);
            if (!rep) { *(u32x4*)row = a; *(u32x4*)(row + 8) = c2; } else if (a.x == 0x12345678u) *(u32x4*)row = c2;
        }
    }
    if (P3ON(8)) for (int it = bx; it < NBATCH * 8; it += G) {
        const int b = it >> 3, h = it & 7; const float* fp = (const float*)(p.ws + WS_MISC) + (size_t)(b * SEQ + 4 * tid) * 256 + 80 + h;
        const float bf = p.in[I_BFORGET][h];
        float ls[4];
#pragma unroll
        for (int j = 0; j < 4; ++j) { const float z = fp[j * 256] + bf; ls[j] = fminf(z, 0.f) - log1pf(__expf(-fabsf(z))); }
        __syncthreads();
        LAS float* wt = (LAS float*)lds;
        ls[1] += ls[0]; ls[2] += ls[1]; ls[3] += ls[2];
        float incl = ls[3];
#pragma unroll
        for (int o = 1; o < 64; o <<= 1) { const float t2 = __shfl_up(incl, o); if (lane >= o) incl += t2; }
        if (lane == 63) wt[wid] = incl;
        const float off = incl - ls[3];
        __syncthreads();
        float wo = 0.f; for (int w8 = 0; w8 < wid; ++w8) wo += wt[w8];
        float* cp = (float*)(p.ws + WS_CUM) + (size_t)(b * 8 + h) * SEQ + 4 * tid;
        *(f32x4*)cp = (f32x4){ls[0] + off + wo, ls[1] + off + wo, ls[2] + off + wo, ls[3] + off + wo};
        __syncthreads();
    }
}

template <int OFF> __device__ __forceinline__ s16x4 tr_read(int vb) { s16x4 r; asm volatile("ds_read_b64_tr_b16 %0, %1 offset:%2" : "=&v"(r) : "v"(vb), "i"(OFF) : "memory"); return r; }
__device__ __forceinline__ int v_rd_base(int lane) { return ((lane & 3) << 3) | (((lane >> 2) & 3) << 6) | (((lane >> 4) & 1) << 5) | (((lane >> 5) & 1) << 8); }
#define PK4(P, BASE, OUT) do { unsigned a0 = cvt_pk_bf16(P[BASE + 0], P[BASE + 1]), a1 = cvt_pk_bf16(P[BASE + 2], P[BASE + 3]);   \
    unsigned b0 = cvt_pk_bf16(P[BASE + 4], P[BASE + 5]), b1 = cvt_pk_bf16(P[BASE + 6], P[BASE + 7]);                              \
    auto r0 = __builtin_amdgcn_permlane32_swap(a0, b0, false, false); auto r1 = __builtin_amdgcn_permlane32_swap(a1, b1, false, false); \
    u32x4 w = {r0[0], r1[0], r0[1], r1[1]}; OUT = *reinterpret_cast<bf16x8*>(&w); } while (0)
#define PKV(L, H) (bf16x8){L[0], L[1], L[2], L[3], H[0], H[1], H[2], H[3]}
template <int NCB, int KS0, int D0> struct PvPairs { static __device__ __forceinline__ void run(f32x16* o, int vb, bf16x8 pa0, bf16x8 pa1) {
    constexpr int S = 2 * NCB * 512, H = NCB * 512;
    const s16x4 l00 = tr_read<D0 * 512 + KS0 * S>(vb), h00 = tr_read<D0 * 512 + KS0 * S + H>(vb), l01 = tr_read<D0 * 512 + (KS0 + 1) * S>(vb), h01 = tr_read<D0 * 512 + (KS0 + 1) * S + H>(vb);
    const s16x4 l10 = tr_read<(D0 + 1) * 512 + KS0 * S>(vb), h10 = tr_read<(D0 + 1) * 512 + KS0 * S + H>(vb), l11 = tr_read<(D0 + 1) * 512 + (KS0 + 1) * S>(vb), h11 = tr_read<(D0 + 1) * 512 + (KS0 + 1) * S + H>(vb);
    asm volatile("s_waitcnt lgkmcnt(0)" ::: "memory"); SBAR();
    o[D0] = __builtin_amdgcn_mfma_f32_32x32x16_bf16(pa0, PKV(l00, h00), o[D0], 0, 0, 0); o[D0 + 1] = __builtin_amdgcn_mfma_f32_32x32x16_bf16(pa0, PKV(l10, h10), o[D0 + 1], 0, 0, 0);
    o[D0] = __builtin_amdgcn_mfma_f32_32x32x16_bf16(pa1, PKV(l01, h01), o[D0], 0, 0, 0); o[D0 + 1] = __builtin_amdgcn_mfma_f32_32x32x16_bf16(pa1, PKV(l11, h11), o[D0 + 1], 0, 0, 0);
    if constexpr (D0 + 2 < NCB) PvPairs<NCB, KS0, D0 + 2>::run(o, vb, pa0, pa1); } };
__device__ __forceinline__ int swap23(int k) { return (k & ~0xC) | ((k & 4) << 1) | ((k & 8) >> 1); }
constexpr int FOX_STAGE = 33024;
constexpr int FOX_AL = 2 * FOX_STAGE, FOX_LI = FOX_AL + 1024;
__device__ void fox_item(const Params& p, LAS unsigned char* lds, int b, int h, int qb) {
    int tid = threadIdx.x; asm volatile("" : "+v"(tid));
    const int wid = __builtin_amdgcn_readfirstlane(tid >> 6), lane = tid & 63, r32 = lane & 31, hi = lane >> 5;
    const bf16_t* Q = (const bf16_t*)(p.ws + WS_QB);
    const char* Kg = (const char*)(p.ws + WS_KB) + ((size_t)b * SEQ * 1024 + h * 128) * 2; const char* Vg = (const char*)(p.ws + WS_VB) + ((size_t)b * SEQ * 1024 + h * 128) * 2;
    const float* cum = (const float*)(p.ws + WS_CUM) + (size_t)(b * 8 + h) * SEQ;
    const int qpos = qb * 256 + wid * 32 + r32;
    bf16x8 qr[8];
    { const bf16_t* qp = Q + (size_t)(b * SEQ + qpos) * 1024 + h * 128 + hi * 8;
#pragma unroll
      for (int d0 = 0; d0 < 8; ++d0) qr[d0] = *(const bf16x8*)(qp + d0 * 16);
      float ss = 0.f;
#pragma unroll
      for (int d0 = 0; d0 < 8; ++d0) { const u32x4 w = *reinterpret_cast<const u32x4*>(&qr[d0]);
#pragma unroll
          for (int j = 0; j < 4; ++j) { const float a = bf_lo(w[j]), c = bf_hi(w[j]); ss += a * a + c * c; } }
      ss += __shfl_xor(ss, 32);
      const float rs = rsqrtf(ss * (1.0f / 128.0f) + RMS_EPS) * 0.08838834764831845f;
      const float* g = p.in[I_GQB] + hi * 8;
#pragma unroll
      for (int d0 = 0; d0 < 8; ++d0) { u32x4 w = *reinterpret_cast<const u32x4*>(&qr[d0]); const f32x4 g0 = *(const f32x4*)(g + d0 * 16), g1 = *(const f32x4*)(g + d0 * 16 + 4);
          w[0] = cvt_pk_bf16(bf_lo(w[0]) * (rs * g0[0]), bf_hi(w[0]) * (rs * g0[1])); w[1] = cvt_pk_bf16(bf_lo(w[1]) * (rs * g0[2]), bf_hi(w[1]) * (rs * g0[3]));
          w[2] = cvt_pk_bf16(bf_lo(w[2]) * (rs * g1[0]), bf_hi(w[2]) * (rs * g1[1])); w[3] = cvt_pk_bf16(bf_lo(w[3]) * (rs * g1[2]), bf_hi(w[3]) * (rs * g1[3]));
          qr[d0] = *reinterpret_cast<bf16x8*>(&w); } }
    const float cq = cum[qpos] * LOG2E;
    unsigned ksrc[2], vsrc[2];
#pragma unroll
    for (int i = 0; i < 2; ++i) { const int pos = (i * 512 + tid) * 16;
        { const int row = pos >> 8; const int cb = (pos & 255) ^ ((row & 7) << 4); ksrc[i] = (unsigned)(row * 2048 + cb); }
        { const int sub = pos >> 9, within = pos & 511; const int kk = (sub >> 2) * 8 + (within >> 6); const int c = (sub & 3) * 32 + ((within & 63) >> 1); vsrc[i] = (unsigned)(swap23(kk) * 2048 + c * 2); } }
    float m_reg = -1e30f, l_reg = 0.f; f32x16 o[4];
#pragma unroll
    for (int d = 0; d < 4; ++d)
#pragma unroll
        for (int r = 0; r < 16; ++r) o[d][r] = 0.f;
    LAS float* al_l = (LAS float*)(lds + FOX_AL) + wid * 32; LAS float* li_l = (LAS float*)(lds + FOX_LI) + wid * 32;
    const int ntiles = qb * 4 + 4, mylast = qb * 4 + (wid >> 1);
#define FOX_DMA(kt) do { LAS unsigned char* sb_ = lds + ((kt) & 1) * FOX_STAGE; const size_t go_ = (size_t)(kt) * 64 * 2048; \
        _Pragma("unroll") for (int i = 0; i < 2; ++i) { \
            __builtin_amdgcn_global_load_lds((const unsigned*)(Kg + go_ + ksrc[i]), (LAS unsigned*)(sb_ + 16384 + (i * 512 + wid * 64) * 16), 16, 0, 0); \
            __builtin_amdgcn_global_load_lds((const unsigned*)(Vg + go_ + vsrc[i]), (LAS unsigned*)(sb_ + (i * 512 + wid * 64) * 16), 16, 0, 0); } \
        if (wid == 0) __builtin_amdgcn_global_load_lds((const unsigned*)(cum + (kt) * 64 + lane), (LAS unsigned*)(sb_ + 32768), 4, 0, 0); } while (0)
    __syncthreads();
    FOX_DMA(0);
    for (int kt = 0; kt < ntiles; ++kt) {
        asm volatile("s_waitcnt vmcnt(0)" ::: "memory");
        __syncthreads();
        if (kt + 1 < ntiles) FOX_DMA(kt + 1);
        if (kt <= mylast) {
            const LAS unsigned char* sb = lds + (kt & 1) * FOX_STAGE; const LAS float* ck = (const LAS float*)(sb + 32768);
            const int vb = (int)(uintptr_t)sb + v_rd_base(lane);
            f32x16 p0, p1;
#pragma unroll
            for (int r = 0; r < 16; ++r) { p0[r] = 0.f; p1[r] = 0.f; }
            int fsw = (r32 & 7) << 4; asm volatile("" : "+v"(fsw));
#pragma unroll
            for (int d0 = 0; d0 < 8; ++d0) { const int cb = (d0 * 16 + hi * 8) * 2;
                const bf16x8 b0 = *(const LAS bf16x8*)(sb + 16384 + r32 * 256 + (cb ^ fsw));
                const bf16x8 b1 = *(const LAS bf16x8*)(sb + 16384 + (32 + r32) * 256 + (cb ^ fsw));
                p0 = __builtin_amdgcn_mfma_f32_32x32x16_bf16(b0, qr[d0], p0, 0, 0, 0); p1 = __builtin_amdgcn_mfma_f32_32x32x16_bf16(b1, qr[d0], p1, 0, 0, 0); }
            const bool diag = (kt * 64 + 63 > qb * 256 + wid * 32);
            float pmax = -INFINITY;
#pragma unroll
            for (int g4 = 0; g4 < 4; ++g4) { const f32x4 c0 = *(const LAS f32x4*)(ck + 8 * g4 + 4 * hi), c1 = *(const LAS f32x4*)(ck + 32 + 8 * g4 + 4 * hi);
#pragma unroll
                for (int j = 0; j < 4; ++j) { const int r = g4 * 4 + j; float t0 = fmaf(p0[r], LOG2E, cq) - c0[j] * LOG2E, t1 = fmaf(p1[r], LOG2E, cq) - c1[j] * LOG2E;
                    if (diag) { const int kp = kt * 64 + crow(r, hi); if (kp > qpos) t0 = -INFINITY; if (kp + 32 > qpos) t1 = -INFINITY; }
                    p0[r] = t0; p1[r] = t1; pmax = fmaxf(pmax, fmaxf(t0, t1)); } }
            { auto rr = __builtin_amdgcn_permlane32_swap(__float_as_uint(pmax), __float_as_uint(pmax), false, false); pmax = fmaxf(__uint_as_float(rr[0]), __uint_as_float(rr[1])); }
            const float mn = fmaxf(m_reg, pmax); const float alpha = __builtin_amdgcn_exp2f(m_reg - mn); m_reg = mn;
            float ps = 0.f;
#pragma unroll
            for (int r = 0; r < 16; ++r) { p0[r] = __builtin_amdgcn_exp2f(p0[r] - mn); p1[r] = __builtin_amdgcn_exp2f(p1[r] - mn); ps += p0[r] + p1[r]; }
            { auto rr = __builtin_amdgcn_permlane32_swap(__float_as_uint(ps), __float_as_uint(ps), false, false); ps = __uint_as_float(rr[0]) + __uint_as_float(rr[1]); }
            l_reg = l_reg * alpha + ps;
            if (__any(alpha < 1.f)) { if (hi == 0) al_l[r32] = alpha; asm volatile("s_waitcnt lgkmcnt(0)" ::: "memory");
#pragma unroll
                for (int r = 0; r < 16; ++r) { const float a = al_l[crow(r, hi)];
#pragma unroll
                    for (int d = 0; d < 4; ++d) o[d][r] *= a; } }
            bf16x8 pa0, pa1, pa2, pa3; PK4(p0, 0, pa0); PK4(p0, 8, pa1); PK4(p1, 0, pa2); PK4(p1, 8, pa3);
            PvPairs<4, 0, 0>::run(o, vb, pa0, pa1); PvPairs<4, 2, 0>::run(o, vb, pa2, pa3);
        }
    }
#undef FOX_DMA
    if (hi == 0) li_l[r32] = l_reg; asm volatile("s_waitcnt lgkmcnt(0)" ::: "memory");
    unsigned char* O8 = (unsigned char*)(p.ws + WS_OB8) + (size_t)(b * SEQ + qb * 256 + wid * 32) * 1024 + h * 128;
#pragma unroll
    for (int r = 0; r < 16; ++r) { const float rl = __builtin_amdgcn_rcpf(li_l[crow(r, hi)]); const int orow = crow(r, hi);
#pragma unroll
        for (int d0 = 0; d0 < 4; ++d0) O8[(size_t)orow * 1024 + d0 * 32 + r32] = (unsigned char)(pack_fp8x4(o[d0][r] * rl * 8.f, 0.f, 0.f, 0.f) & 0xffu); }
}

constexpr int DSA_STAGE = 32768;
constexpr int DSA_AL = 2 * DSA_STAGE, DSA_LI = DSA_AL + 1024, DSA_Q = DSA_LI + 1024;
__device__ void dsa_item(const Params& p, LAS unsigned char* lds, int b, int qt) {
    int tid = threadIdx.x; asm volatile("" : "+v"(tid));
    const int wid = __builtin_amdgcn_readfirstlane(tid >> 6), lane = tid & 63, r32 = lane & 31, hi = lane >> 5, h = wid;
    const char* KV = (const char*)(p.ws + WS_KV) + (size_t)b * SEQ * 512;
    const int qpos = qt * 32 + r32; const size_t qg = (size_t)b * SEQ + qpos;
    const unsigned* mask = (const unsigned*)(p.ws + WS_MASK) + qg * 64;
    bf16x8 qr[8];
    LAS unsigned char* qlds = lds + DSA_Q + wid * 8192 + lane * 16;
    __syncthreads();
    { const bf16_t* qp = (const bf16_t*)(p.ws + WS_QLAT) + qg * 2048 + h * 256 + hi * 8;
#pragma unroll
      for (int d0 = 0; d0 < 8; ++d0) qr[d0] = *(const bf16x8*)(qp + d0 * 16);
#pragma unroll
      for (int d0 = 8; d0 < 16; ++d0) *(LAS bf16x8*)(qlds + (d0 - 8) * 1024) = *(const bf16x8*)(qp + d0 * 16); }
    unsigned ksrc[2], vsrc[2];
#pragma unroll
    for (int i = 0; i < 2; ++i) { const int pos = (i * 512 + tid) * 16;
        { const int row = pos >> 9; const int cb = (pos & 511) ^ ((row & 15) << 4); ksrc[i] = (unsigned)(row * 512 + cb); }
        { const int sub = pos >> 9, within = pos & 511; const int kk = (sub >> 3) * 8 + (within >> 6); const int c = (sub & 7) * 32 + ((within & 63) >> 1); vsrc[i] = (unsigned)(swap23(kk) * 512 + c * 2); } }
    const float slopeL = exp2f(-(float)(h + 1)) * LOG2E;
    float m_reg = -1e30f, l_reg = 0.f; f32x16 o[8];
#pragma unroll
    for (int d = 0; d < 8; ++d)
#pragma unroll
        for (int r = 0; r < 16; ++r) o[d][r] = 0.f;
    LAS float* al_l = (LAS float*)(lds + DSA_AL) + wid * 32; LAS float* li_l = (LAS float*)(lds + DSA_LI) + wid * 32;
    const int ntiles = ((qt >> 1) + 1) * 2;
#define DSA_DMA(kt) do { LAS unsigned char* sb_ = lds + ((kt) & 1) * DSA_STAGE; const size_t go_ = (size_t)(kt) * 32 * 512; \
        _Pragma("unroll") for (int i = 0; i < 2; ++i) { \
            __builtin_amdgcn_global_load_lds((const unsigned*)(KV + go_ + ksrc[i]), (LAS unsigned*)(sb_ + 16384 + (i * 512 + wid * 64) * 16), 16, 0, 0); \
            __builtin_amdgcn_global_load_lds((const unsigned*)(KV + go_ + vsrc[i]), (LAS unsigned*)(sb_ + (i * 512 + wid * 64) * 16), 16, 0, 0); } } while (0)
    unsigned mw = mask[0];
    DSA_DMA(0);
    for (int kt = 0; kt < ntiles; ++kt) {
        asm volatile("s_waitcnt vmcnt(0)" ::: "memory");
        __syncthreads();
        const unsigned mcur = mw;
        if (kt + 1 < ntiles) { mw = mask[kt + 1]; DSA_DMA(kt + 1); }
        const LAS unsigned char* sb = lds + (kt & 1) * DSA_STAGE; const int vb = (int)(uintptr_t)sb + v_rd_base(lane);
        f32x16 pp;
#pragma unroll
        for (int r = 0; r < 16; ++r) pp[r] = 0.f;
        {
            const LAS unsigned char* kb_ = sb + 16384 + r32 * 512; int sw_ = (r32 & 15) << 4; asm volatile("" : "+v"(sw_));
#define DSA_KF(d0) (*(const LAS bf16x8*)(kb_ + ((((d0) * 16 + hi * 8) * 2) ^ sw_)))
#define DSA_QF(d0) ((d0) < 8 ? qr[(d0) & 7] : *(const LAS bf16x8*)(qlds + (((d0) - 8) & 7) * 1024))
            bf16x8 k0 = DSA_KF(0), k1 = DSA_KF(1), q0 = DSA_QF(0), q1 = DSA_QF(1);
#pragma unroll
            for (int d0 = 0; d0 < 16; d0 += 2) {
                bf16x8 nk0 = k0, nk1 = k1, nq0 = q0, nq1 = q1;
                if (d0 + 2 < 16) { nk0 = DSA_KF(d0 + 2); nk1 = DSA_KF(d0 + 3); nq0 = DSA_QF(d0 + 2); nq1 = DSA_QF(d0 + 3); }
                pp = __builtin_amdgcn_mfma_f32_32x32x16_bf16(k0, q0, pp, 0, 0, 0); pp = __builtin_amdgcn_mfma_f32_32x32x16_bf16(k1, q1, pp, 0, 0, 0);
                k0 = nk0; k1 = nk1; q0 = nq0; q1 = nq1; SBAR();
            }
#undef DSA_KF
#undef DSA_QF
        }
        const unsigned wsh = mcur >> (4 * hi);
        const float df = (float)(qpos - (kt * 32 + 4 * hi));
        float pmax = -INFINITY;
#pragma unroll
        for (int r = 0; r < 16; ++r) { const int cb = (r & 3) + 8 * (r >> 2); const float dd = df - (float)cb;
            float t = fmaf(-slopeL, fabsf(dd), pp[r] * LOG2E); if (!((wsh >> cb) & 1u)) t = -INFINITY; pp[r] = t; pmax = fmaxf(pmax, t); }
        { auto rr = __builtin_amdgcn_permlane32_swap(__float_as_uint(pmax), __float_as_uint(pmax), false, false); pmax = fmaxf(__uint_as_float(rr[0]), __uint_as_float(rr[1])); }
        const float mn = fmaxf(m_reg, pmax); const float alpha = __builtin_amdgcn_exp2f(m_reg - mn); m_reg = mn;
        float ps = 0.f;
#pragma unroll
        for (int r = 0; r < 16; ++r) { pp[r] = __builtin_amdgcn_exp2f(pp[r] - mn); ps += pp[r]; }
        { auto rr = __builtin_amdgcn_permlane32_swap(__float_as_uint(ps), __float_as_uint(ps), false, false); ps = __uint_as_float(rr[0]) + __uint_as_float(rr[1]); }
        l_reg = l_reg * alpha + ps;
        if (__any(alpha < 1.f)) { if (hi == 0) al_l[r32] = alpha; asm volatile("s_waitcnt lgkmcnt(0)" ::: "memory");
#pragma unroll
            for (int r = 0; r < 16; ++r) { const float a = al_l[crow(r, hi)];
#pragma unroll
                for (int d = 0; d < 8; ++d) o[d][r] *= a; } }
        bf16x8 pa0, pa1; PK4(pp, 0, pa0); PK4(pp, 8, pa1);
        PvPairs<8, 0, 0>::run(o, vb, pa0, pa1);
    }
#undef DSA_DMA
    if (hi == 0) li_l[r32] = l_reg; asm volatile("s_waitcnt lgkmcnt(0)" ::: "memory");
    float rl[16];
#pragma unroll
    for (int r = 0; r < 16; ++r) rl[r] = __builtin_amdgcn_rcpf(li_l[crow(r, hi)]);
    __syncthreads();
    LAS bf16_t* os = (LAS bf16_t*)(lds + wid * 16896);
#pragma unroll
    for (int r = 0; r < 16; ++r)
#pragma unroll
        for (int d0 = 0; d0 < 8; ++d0) os[crow(r, hi) * 264 + d0 * 32 + r32] = (bf16_t)(cvt_pk_bf16(o[d0][r] * rl[r], 0.f) & 0xffffu);
    asm volatile("s_waitcnt lgkmcnt(0)" ::: "memory");
    f32x16 ya[4];
#pragma unroll
    for (int nb = 0; nb < 4; ++nb)
#pragma unroll
        for (int r = 0; r < 16; ++r) ya[nb][r] = 0.f;
    const bf16_t* wv = (const bf16_t*)(p.ws + WS_WUV) + (size_t)(h * 128 + r32) * 256 + hi * 8;
#pragma unroll 4
    for (int ks = 0; ks < 16; ++ks) {
        const bf16x8 af = *(const LAS bf16x8*)(os + r32 * 264 + ks * 16 + hi * 8);
#pragma unroll
        for (int nb = 0; nb < 4; ++nb) { const bf16x8 wf = *(const bf16x8*)(wv + (size_t)nb * 32 * 256 + ks * 16); ya[nb] = __builtin_amdgcn_mfma_f32_32x32x16_bf16(wf, af, ya[nb], 0, 0, 0); }
    }
    unsigned char* O8 = (unsigned char*)(p.ws + WS_OA8) + ((size_t)b * SEQ + qt * 32 + r32) * 1024 + h * 128 + 4 * hi;
#pragma unroll
    for (int nb = 0; nb < 4; ++nb)
#pragma unroll
        for (int g4 = 0; g4 < 4; ++g4) *(unsigned*)(O8 + nb * 32 + g4 * 8) = pack_fp8x4(ya[nb][g4 * 4] * 8.f, ya[nb][g4 * 4 + 1] * 8.f, ya[nb][g4 * 4 + 2] * 8.f, ya[nb][g4 * 4 + 3] * 8.f);
}
__device__ void ph4_attn(const Params& p, LAS unsigned char* lds) {
    const int r = blockIdx.x;
    if (r < 256) { const int c = 31 - (r >> 3), w8 = r & 7, b = w8 >> 1, half = w8 & 1; dsa_item(p, lds, b, c * 2 + half); }
    int* qhead = (int*)(p.ws + WS_CNT) + 2048;
    LAS int* slot = (LAS int*)(lds + LDS_BARW - 16);
    for (;;) {
        __syncthreads();
        if (threadIdx.x == 0) *slot = atomicAdd(qhead, 1);
        __syncthreads();
        const int it = __builtin_amdgcn_readfirstlane(*slot);
        if (it >= 256) break;
        const int qb = 7 - (it >> 5), bh = it & 31;
        fox_item(p, lds, bh >> 3, bh & 7, qb);
    }
}

__device__ void ph8_router(const Params& p, LAS unsigned char* lds, const int rep) {
    const int tid = threadIdx.x, wid = tid >> 6, lane = tid & 63, fr = lane & 15, fq = lane >> 4;
    const float* mod = (const float*)(p.ws + WS_MOD);
    int* cnt = (int*)(p.ws + WS_CNT) + rep * 1024; int* ltok = rep ? (int*)(p.ws + WS_QLAT) : (int*)(p.ws + WS_LTOK); float* lw = rep ? (float*)(p.ws + WS_QLAT + (4u << 20)) : (float*)(p.ws + WS_LW);
    LAS unsigned char* AH = lds; LAS unsigned char* AL = lds + 65536;
    LAS float* slab = (LAS float*)lds;
    LAS float* lg = (LAS float*)(lds + 131072);
    const bf16_t* WH = (const bf16_t*)(p.ws + WS_WRH); const bf16_t* WL = (const bf16_t*)(p.ws + WS_WRL);
    for (int blk = blockIdx.x; blk < NTOK / 32; blk += gridDim.x) {
        const int t0 = blk * 32, tb = t0 + wid * 4, b = tb >> 11;
        const float* sh = mod + b * 12288 + 6144; const float* sc = mod + b * 12288 + 8192;
        u32x2 keepH[4][4], keepL[4][4];
        f32x4 xa[2][8], xb[2][8]; u32x2 ya[2][8], yb[2][8];
#define RT_LOAD(X, Y, R0) _Pragma("unroll") for (int rr = 0; rr < 2; ++rr) _Pragma("unroll") for (int i = 0; i < 8; ++i) { const size_t eo = (size_t)(tb + R0 + rr) * DM + i * 256 + lane * 4; \
            Y[rr][i] = *(const u32x2*)((const bf16_t*)(p.ws + WS_MERGED) + eo); X[rr][i] = *(const f32x4*)(p.in[I_X] + eo); }
        RT_LOAD(xa, ya, 0) RT_LOAD(xb, yb, 2)
#define RT_ROWS(X, Y, R0) do { float rstd[2]; \
        _Pragma("unroll") for (int rr = 0; rr < 2; ++rr) { float ss = 0.f; \
            _Pragma("unroll") for (int i = 0; i < 8; ++i) { X[rr][i] += (f32x4){bf_lo(Y[rr][i].x), bf_hi(Y[rr][i].x), bf_lo(Y[rr][i].y), bf_hi(Y[rr][i].y)};        \
                ss += X[rr][i][0] * X[rr][i][0] + X[rr][i][1] * X[rr][i][1] + X[rr][i][2] * X[rr][i][2] + X[rr][i][3] * X[rr][i][3]; } \
            rstd[rr] = rsqrtf(wave_sum(ss) * (1.0f / 2048.0f) + RMS_EPS); } \
        _Pragma("unroll") for (int i = 0; i < 8; ++i) { int cl = lane * 4; asm volatile("" : "+v"(cl)); const int col = i * 256 + cl; const f32x4 gg = *(const f32x4*)(p.in[I_GFFN] + col), s1 = *(const f32x4*)(sc + col), s0 = *(const f32x4*)(sh + col); \
            _Pragma("unroll") for (int rr = 0; rr < 2; ++rr) { float hv[4], lo[4]; const int r = wid * 4 + R0 + rr; \
                _Pragma("unroll") for (int j = 0; j < 4; ++j) hv[j] = X[rr][i][j] * rstd[rr] * gg[j] * (1.0f + s1[j]) + s0[j]; \
                u32x2 wh; wh.x = cvt_pk_bf16(hv[0], hv[1]); wh.y = cvt_pk_bf16(hv[2], hv[3]); \
                lo[0] = hv[0] - bf_lo(wh.x); lo[1] = hv[1] - bf_hi(wh.x); lo[2] = hv[2] - bf_lo(wh.y); lo[3] = hv[3] - bf_hi(wh.y); \
                u32x2 wl; wl.x = cvt_pk_bf16(lo[0], lo[1]); wl.y = cvt_pk_bf16(lo[2], lo[3]); \
                if (i < 4) { int l1 = lane >> 1; asm volatile("" : "+v"(l1)); const int ad = r * 2048 + (((i * 32 + l1) ^ r) * 16) + (lane & 1) * 8; *(LAS u32x2*)(AH + ad) = wh; *(LAS u32x2*)(AL + ad) = wl; } \
                else { keepH[R0 + rr][i - 4] = wh; keepL[R0 + rr][i - 4] = wl; } \
                *(unsigned*)(p.ws + WS_H8 + (size_t)(tb + R0 + rr) * DM + col) = pack_fp8x4(hv[0], hv[1], hv[2], hv[3]); } } } while (0)
        RT_ROWS(xa, ya, 0); RT_ROWS(xb, yb, 2);
#undef RT_LOAD
#undef RT_ROWS
        const int kq = wid & 3, ng = wid >> 2, nb0 = ng * 3;
        f32x4 acc[2][3];
#pragma unroll
        for (int rb = 0; rb < 2; ++rb)
#pragma unroll
            for (int j = 0; j < 3; ++j) acc[rb][j] = (f32x4){0.f, 0.f, 0.f, 0.f};
#pragma unroll
        for (int kh = 0; kh < 2; ++kh) {
            if (kh == 1) {
#pragma unroll
                for (int r4 = 0; r4 < 4; ++r4)
#pragma unroll
                    for (int i = 0; i < 4; ++i) { const int r = wid * 4 + r4; int l1 = lane >> 1; asm volatile("" : "+v"(l1)); const int ad = r * 2048 + (((i * 32 + l1) ^ r) * 16) + (lane & 1) * 8;
                        *(LAS u32x2*)(AH + ad) = keepH[r4][i]; *(LAS u32x2*)(AL + ad) = keepL[r4][i]; }
            }
            __syncthreads();
#pragma unroll 2
            for (int k8 = 0; k8 < 8; ++k8) { const int ksl = kq * 8 + k8, ks = kh * 32 + ksl;
                bf16x8 ah[2], al[2];
#pragma unroll
                for (int rb = 0; rb < 2; ++rb) { const int r = rb * 16 + fr; const int ad = r * 2048 + (((ksl * 4 + fq) ^ r) * 16); ah[rb] = *(const LAS bf16x8*)(AH + ad); al[rb] = *(const LAS bf16x8*)(AL + ad); }
#pragma unroll
                for (int j = 0; j < 3; ++j) { const int nb = nb0 + j; if (nb < 5) {
                    const bf16x8 wh = *(const bf16x8*)(WH + (size_t)(nb * 16 + fr) * DM + ks * 32 + fq * 8), wl = *(const bf16x8*)(WL + (size_t)(nb * 16 + fr) * DM + ks * 32 + fq * 8);
#pragma unroll
                    for (int rb = 0; rb < 2; ++rb) {
                        acc[rb][j] = __builtin_amdgcn_mfma_f32_16x16x32_bf16(wh, ah[rb], acc[rb][j], 0, 0, 0); acc[rb][j] = __builtin_amdgcn_mfma_f32_16x16x32_bf16(wl, ah[rb], acc[rb][j], 0, 0, 0);
                        acc[rb][j] = __builtin_amdgcn_mfma_f32_16x16x32_bf16(wh, al[rb], acc[rb][j], 0, 0, 0); } } } }
            __syncthreads();
        }
#pragma unroll
        for (int rb = 0; rb < 2; ++rb)
#pragma unroll
            for (int j = 0; j < 3; ++j) { const int nb = nb0 + j; if (nb < 5) *(LAS f32x4*)(slab + (kq * 32 + rb * 16 + fr) * 80 + nb * 16 + fq * 4) = acc[rb][j]; }
        __syncthreads();
        for (int o = tid; o < 2560; o += NTHREADS) lg[o] = (slab[o] + slab[2560 + o]) + (slab[5120 + o] + slab[7680 + o]);
        __syncthreads();
        if (tid < 32) {
            const int t = t0 + tid; const LAS float* L = lg + tid * 80;
            float gl[8]; int gi = 0; float gm = -INFINITY;
#pragma unroll
            for (int g = 0; g < 8; ++g) { gl[g] = L[g] + p.in[I_BRG][g]; if (gl[g] > gm) { gm = gl[g]; gi = g; } }
            float se = 0.f;
#pragma unroll
            for (int g = 0; g < 8; ++g) se += __expf(gl[g] - gm);
            const float gwt = 1.0f / se;
            float v1 = -INFINITY, v2 = -INFINITY; int i1 = 0, i2 = 0;
            for (int e = 0; e < 8; ++e) { const float v = L[8 + gi * 8 + e] + p.in[I_BRE][gi * 8 + e];
                if (v > v1) { v2 = v1; i2 = i1; v1 = v; i1 = e; } else if (v > v2) { v2 = v; i2 = e; } }
            const float e2 = __expf(v2 - v1); const float p1 = gwt / (1.0f + e2), p2 = gwt * e2 / (1.0f + e2);
            const int ea = gi * 8 + i1, eb = gi * 8 + i2;
            const int sub = blk & (NSUB - 1);
            const int pa = sub * SUBCAP + atomicAdd(cnt + sub * 64 + ea, 1); const int pb = sub * SUBCAP + atomicAdd(cnt + sub * 64 + eb, 1);
            ltok[ea * LCAP + pa] = t; lw[ea * LCAP + pa] = p1;
            ltok[eb * LCAP + pb] = t | 0x10000; lw[eb * LCAP + pb] = p2;
        }
        __syncthreads();
    }
}

#define MOE_GLOAD(dst, ptr) asm volatile("global_load_dwordx4 %0, %1, off nt" : "=v"(dst) : "v"(ptr) : "memory")
__device__ __forceinline__ int list_pos(const LAS int* pre, int r) { int s = 0;
#pragma unroll
    for (int k = NSUB / 2; k >= 1; k >>= 1) if (pre[s + k] <= r) s += k;
    return s * SUBCAP + (r - pre[s]); }
template <bool UP>
__device__ void moe_gemm(const Params& p, LAS unsigned char* lds, const int rep) {
    constexpr int K = UP ? 2048 : 512, NKT = K / 32, NS = UP ? 8 : 16, LDW = UP ? 512 : 2048;
    constexpr int NSTA = 3, OFF_A = 0, OFF_B = NSTA * 16384;
    int tid = threadIdx.x; asm volatile("" : "+v"(tid));
    const int w = __builtin_amdgcn_readfirstlane(tid >> 6), l = tid & 63, r32 = l & 31, hi = l >> 5;
    LAS int* tab = (LAS int*)(lds + LDS_TAB);
    if (tid < 64) { const int* cnt = (const int*)(p.ws + WS_CNT); int s = 0; for (int sub = 0; sub < NSUB; ++sub) { tab[256 + tid * 17 + sub] = s; s += cnt[sub * 64 + tid]; } tab[256 + tid * 17 + NSUB] = s; tab[80 + tid] = s; }
    __syncthreads();
    if (tid == 0) { int s = 0, ro = 0; for (int e = 0; e < 64; ++e) { const int ce = tab[80 + e]; tab[e] = s; tab[160 + e] = ro; ro += ce; const int np = (ce + 511) >> 9; s += np > 0 ? np : 1; } tab[64] = s; }
    __syncthreads();
    const int total = __builtin_amdgcn_readfirstlane(tab[64]) * NS;
    const int q = (w & 3) * 8 + (l & 7), g = (w >> 2) * 8 + (l >> 3);
    const unsigned bwoff = (unsigned)(q * 256 + (((g >> 2) ^ (q & 3)) * 16) + (g & 3) * 4);
    const unsigned frag_sw = (unsigned)((r32 >> 2) & 3);
    const int* ltok = (const int*)(p.ws + WS_LTOK); const float* lw = (const float*)(p.ws + WS_LW);
    for (int unit = blockIdx.x; unit < total; unit += gridDim.x) {
        const int pm = unit / NS, ns = unit - pm * NS; int e = 0;
#pragma unroll 1
        for (int s = 32; s >= 1; s >>= 1) if (__builtin_amdgcn_readfirstlane(tab[e + s]) <= pm) e += s;
        const int mp = pm - __builtin_amdgcn_readfirstlane(tab[e]); const int cnt_e = __builtin_amdgcn_readfirstlane(tab[80 + e]), rowoff = __builtin_amdgcn_readfirstlane(tab[160 + e]);
        int nrows = cnt_e - mp * 512; nrows = nrows > 512 ? 512 : nrows; const bool two = nrows > 256;
        const char* abase = UP ? (const char*)(p.ws + WS_H8) : (const char*)(p.ws + WS_ACT8);
        unsigned aoff[2];
#pragma unroll
        for (int i = 0; i < 2; ++i) { const int row = (i * 8 + w) * 32 + (l >> 1); const int hs = (l & 1) ^ ((l >> 4) & 1);
            int src; if (UP) src = row < nrows ? (ltok[e * LCAP + list_pos(tab + 256 + e * 17, mp * 512 + row)] & 0xffff) : 0; else src = rowoff + mp * 512 + (row < nrows ? row : 0);
            aoff[i] = (unsigned)(src * K + hs * 16); }
        const float* bsrc = UP ? (q < 16 ? p.in[I_W1] : p.in[I_W3]) + (size_t)e * 2048 * 512 + ns * 64 + (q & 15) * 4 + (size_t)(2 * g) * LDW
                               : p.in[I_W2] + (size_t)e * 512 * 2048 + ns * 128 + q * 4 + (size_t)(2 * g) * LDW;
        f32x16 acc[2][4];
#pragma unroll
        for (int a = 0; a < 2; ++a)
#pragma unroll
            for (int b = 0; b < 4; ++b)
#pragma unroll
                for (int r = 0; r < 16; ++r) acc[a][b][r] = 0.f;
        f32x4 br[2][2];
#define MOE_ISSUE_B(j, t) do { const int tt_ = (t) < NKT ? (t) : NKT - 1; const float* bp_ = bsrc + (size_t)tt_ * 32 * LDW; MOE_GLOAD(br[j][0], bp_); MOE_GLOAD(br[j][1], bp_ + LDW); } while (0)
#define MOE_ISSUE_A(t, TWO) do { int tt_ = (t) < 0 ? 0 : (t); const int bi_ = (tt_ % NSTA); tt_ = tt_ < NKT ? tt_ : NKT - 1; const char* ap_ = abase + (size_t)tt_ * 32; \
        LAS unsigned char* ab_ = lds + OFF_A + bi_ * 16384 + w * 1024; \
        __builtin_amdgcn_global_load_lds((const unsigned*)(ap_ + aoff[0]), (LAS unsigned*)(ab_), 16, 0, 0); \
        if (TWO) __builtin_amdgcn_global_load_lds((const unsigned*)(ap_ + aoff[1]), (LAS unsigned*)(ab_ + 8192), 16, 0, 0); } while (0)
        const bool two_w = (256 + 32 * w) < nrows;
#define MOE_FRAGS(ks, TWO) do { const unsigned co_ = ((unsigned)((ks) * 2 + hi) ^ frag_sw) * 16u; \
            _Pragma("unroll") for (int nb = 0; nb < 4; ++nb) bf_[nb] = *(const LAS bf16x8*)(bb_ + nb * 2048 + co_); \
            { const unsigned ao_ = ((unsigned)(ks) ^ ((unsigned)(r32 >> 3) & 1u)) * 16u + (unsigned)hi * 8u; a0_ = fp8x8_to_bf16(*(const LAS u32x2*)(ab_ + ao_)); if (TWO) a1_ = fp8x8_to_bf16(*(const LAS u32x2*)(ab_ + 8192 + ao_)); } } while (0)
#define MOE_MMAS(TWO) do { \
            _Pragma("unroll") for (int nb = 0; nb < 4; ++nb) acc[0][nb] = __builtin_amdgcn_mfma_f32_32x32x16_bf16(bf_[nb], a0_, acc[0][nb], 0, 0, 0); \
            if (TWO) { _Pragma("unroll") for (int nb = 0; nb < 4; ++nb) acc[1][nb] = __builtin_amdgcn_mfma_f32_32x32x16_bf16(bf_[nb], a1_, acc[1][nb], 0, 0, 0); } } while (0)
#define MOE_ITER(jn, t, COMPUTE, TWO, WB, WA) do { \
        bf16x8 bf_[4], a0_, a1_; \
        const LAS unsigned char* ab_ = lds + OFF_A + (((t) + 3) % 3) * 16384 + w * 1024 + r32 * 32; const LAS unsigned char* bb_ = lds + OFF_B + ((t) & 1) * 8192 + r32 * 64; \
        if (COMPUTE) { MOE_FRAGS(0, TWO); } SBAR(); \
        asm volatile("s_waitcnt vmcnt(" WB ")" : "+v"(br[jn][0]), "+v"(br[jn][1]) :: "memory"); \
        { LAS unsigned char* bw_ = lds + OFF_B + (((t) + 1) & 1) * 8192 + bwoff; _Pragma("unroll") for (int jj = 0; jj < 4; ++jj) *(LAS unsigned*)(bw_ + jj * 64) = cvt_pk_bf16(br[jn][0][jj], br[jn][1][jj]); } \
        MOE_ISSUE_B(jn, (t) + 3); SBAR(); \
        if (COMPUTE) { MOE_MMAS(TWO); SBAR(); MOE_FRAGS(1, TWO); MOE_MMAS(TWO); } SBAR(); \
        asm volatile("s_waitcnt vmcnt(" WA ")" ::: "memory"); \
        asm volatile("s_waitcnt lgkmcnt(0)" ::: "memory"); __builtin_amdgcn_s_barrier(); asm volatile("" ::: "memory"); \
        MOE_ISSUE_A((t) + 3, TWO); \
        } while (0)
#define MOE_PIPE(TWO, WB, WA) do { \
        MOE_ISSUE_B(0, 0); MOE_ISSUE_A(0, TWO); MOE_ISSUE_B(1, 1); MOE_ISSUE_A(1, TWO); \
        MOE_ITER(0, -1, false, TWO, WB, WA); \
        _Pragma("unroll 1") for (int t = 0; t < NKT; t += 2) { MOE_ITER(1, t, true, TWO, WB, WA); MOE_ITER(0, t + 1, true, TWO, WB, WA); } \
          \
        asm volatile("s_waitcnt vmcnt(0)" : "+v"(br[0][0]), "+v"(br[0][1]), "+v"(br[1][0]), "+v"(br[1][1]) :: "memory"); \
        } while (0)
        if (two_w) MOE_PIPE(true, "6", "6"); else MOE_PIPE(false, "4", "5");
        asm volatile("s_waitcnt vmcnt(0)" ::: "memory");
        if constexpr (UP) {
#pragma unroll
            for (int mt = 0; mt < 2; ++mt) {
                const int rl = mt * 256 + 32 * w + r32;
                if (rl < nrows) {
                    const float gw = lw[e * LCAP + list_pos(tab + 256 + e * 17, mp * 512 + rl)] * 16.0f; unsigned char* orow = (unsigned char*)(p.ws + (rep ? WS_QLAT : WS_ACT8)) + (size_t)(rowoff + mp * 512 + rl) * 512 + ns * 64 + 4 * hi;
#pragma unroll
                    for (int nb = 0; nb < 2; ++nb)
#pragma unroll
                        for (int g4 = 0; g4 < 4; ++g4) { float o[4];
#pragma unroll
                            for (int j = 0; j < 4; ++j) { const float a = acc[mt][nb][g4 * 4 + j], u = acc[mt][nb + 2][g4 * 4 + j]; o[j] = a * sigmoidf_(a) * u * gw; }
                            *(unsigned*)(orow + nb * 32 + g4 * 8) = pack_fp8x4(o[0], o[1], o[2], o[3]); }
                }
            }
        } else {
#pragma unroll
            for (int mt = 0; mt < 2; ++mt) {
                const int rl = mt * 256 + 32 * w + r32;
                if (rl < nrows) {
                    const int ent = ltok[e * LCAP + list_pos(tab + 256 + e * 17, mp * 512 + rl)]; unsigned char* orow = (unsigned char*)(p.ws + WS_YS) + ((size_t)(ent >> 16) * NTOK + (ent & 0xffff)) * 2048 + ns * 128 + 4 * hi;
#pragma unroll
                    for (int nb = 0; nb < 4; ++nb)
#pragma unroll
                        for (int g4 = 0; g4 < 4; ++g4) *(unsigned*)(orow + nb * 32 + g4 * 8) = pack_fp8x4(acc[mt][nb][g4 * 4], acc[mt][nb][g4 * 4 + 1], acc[mt][nb][g4 * 4 + 2], acc[mt][nb][g4 * 4 + 3]);
                }
            }
        }
        asm volatile("s_waitcnt vmcnt(0)" ::: "memory");
        __syncthreads();
    }
#undef MOE_ISSUE_A
#undef MOE_ISSUE_B
#undef MOE_ITER
#undef MOE_FRAGS
#undef MOE_MMAS
#undef MOE_PIPE
}


__device__ void ph11_combine(const Params& p) {
    const unsigned char* Y0 = (const unsigned char*)(p.ws + WS_YS); const unsigned char* Y1 = Y0 + (size_t)NTOK * 2048; const bf16_t* YM = (const bf16_t*)(p.ws + WS_MERGED); const float* mod = (const float*)(p.ws + WS_MOD);
    const size_t n8 = (size_t)NTOK * 2048 / 8;
    for (size_t i = (size_t)blockIdx.x * NTHREADS + threadIdx.x; i < n8; i += (size_t)gridDim.x * NTHREADS) {
        const size_t e0 = i * 8; const int col = (int)(e0 & 2047), b = (int)(e0 >> 22);
        const u32x2 a = *(const u32x2*)(Y0 + e0), c = *(const u32x2*)(Y1 + e0); const u32x4 m = *(const u32x4*)(YM + e0);
        const f32x2 a0 = __builtin_amdgcn_cvt_pk_f32_fp8((int)a.x, false), a1 = __builtin_amdgcn_cvt_pk_f32_fp8((int)a.x, true), a2 = __builtin_amdgcn_cvt_pk_f32_fp8((int)a.y, false), a3 = __builtin_amdgcn_cvt_pk_f32_fp8((int)a.y, true);
        const f32x2 c0 = __builtin_amdgcn_cvt_pk_f32_fp8((int)c.x, false), c1 = __builtin_amdgcn_cvt_pk_f32_fp8((int)c.x, true), c2 = __builtin_amdgcn_cvt_pk_f32_fp8((int)c.y, false), c3 = __builtin_amdgcn_cvt_pk_f32_fp8((int)c.y, true);
        const float* gt = mod + (size_t)b * 12288 + 10240 + col; const f32x4 g0 = *(const f32x4*)gt * 0.0625f, g1 = *(const f32x4*)(gt + 4) * 0.0625f;
        const float* px = p.in[I_X] + e0; f32x4 o0 = *(const f32x4*)px, o1 = *(const f32x4*)(px + 4);
        o0[0] += bf_lo(m.x) + g0[0] * (a0.x + c0.x); o0[1] += bf_hi(m.x) + g0[1] * (a0.y + c0.y); o0[2] += bf_lo(m.y) + g0[2] * (a1.x + c1.x); o0[3] += bf_hi(m.y) + g0[3] * (a1.y + c1.y);
        o1[0] += bf_lo(m.z) + g1[0] * (a2.x + c2.x); o1[1] += bf_hi(m.z) + g1[1] * (a2.y + c2.y); o1[2] += bf_lo(m.w) + g1[2] * (a3.x + c3.x); o1[3] += bf_hi(m.w) + g1[3] * (a3.y + c3.y);
        float* po = p.out + e0; *(f32x4*)po = o0; *(f32x4*)(po + 4) = o1;
    }
}

__global__ void __launch_bounds__(NTHREADS, 2) mk_fwd(Params p) {
    extern __shared__ __attribute__((aligned(16))) unsigned char shm[];
    LAS unsigned char* lds = (LAS unsigned char*)shm;
    const int lo = p.ph_lo, hi = p.ph_hi;
    if (threadIdx.x < 4) ((LAS unsigned*)(lds + LDS_BARW))[threadIdx.x] = 0u;
    __syncthreads();
    XcdBarrier bar; bar.bar = (unsigned*)(p.ws + WS_BAR); bar.x = 0; bar.st = nullptr;
    if (hi - lo > 1) bar = xcd_barrier_post((unsigned*)(p.ws + WS_BAR), (volatile LAS unsigned*)(lds + LDS_BARW));
#ifndef SKIP_MASK
#define SKIP_MASK 0
#endif
#define IN(k) (!((SKIP_MASK >> (k)) & 1) && lo <= (k) && (k) < hi)
#define SEAM(k) do { if (IN(k) && IN((k) + 1)) xcd_barrier(bar); } while (0)
    const int G = gridDim.x, bx = blockIdx.x;
#ifndef REP_PHASE
#define REP_PHASE 0
#endif
#define RUN(k, ...) do { if (IN(k)) { { const int rep = 0; (void)rep; __VA_ARGS__ } if ((REP_PHASE >> (k)) & 1) { xcd_barrier(bar); { const int rep = 1; (void)rep; __VA_ARGS__ } } } SEAM(k); } while (0)
    RUN(0, ph0_prologue(p, lds););
    RUN(1, ph1_norm(p););
    RUN(2, EpiProj E{p.ws, p.in[I_BGATE]};
           { ProjOrder S; S.S.init(p.ws + WS_H, p.ws + WS_WIN + (size_t)2 * 256 * DM * 2, NTOK, 8 * 256, DM * 2, G, bx); S.fp8 = 0; S.Bfull = nullptr;
             pg8::gemm_phase<EpiProj, ProjOrder, false, false>(lds, DM * 2, S, E); }
           { ProjOrder S; S.S.init(p.ws + WS_HF8, p.ws + WS_WIN8, NTOK, 30 * 256, DM, G, (G - 1) - bx); S.fp8 = 1; S.Bfull = nullptr;
             pg8::gemm_phase<EpiProj, ProjOrder, false, true>(lds, DM, S, E, 0x79797979); });
    RUN(3, ph3_prep(p, lds, rep););
    RUN(4, ph4_attn(p, lds););
    RUN(5, DualOrder S; S.S0.init(p.ws + WS_OA8, p.ws + WS_WPA8, NTOK, DM, 1024, G, bx); S.S1.init(p.ws + WS_OB8, p.ws + WS_WPB8, NTOK, DM, 1024, G, bx);
           EpiGate12 E{EpiGate1{(const bf16_t*)(p.ws + WS_GATES), (bf16_t*)(p.ws + WS_OA)}, EpiGate2{(const bf16_t*)(p.ws + WS_GATES), (const bf16_t*)(p.ws + WS_OA), (unsigned char*)(p.ws + WS_MRG8)}};
           pg8::gemm_phase<EpiGate12, DualOrder, false, true>(lds, 1024, S, E, 0x79797979, 0x7c7c7c7c););
    RUN(6, pg8::StaticOrder S; S.init(p.ws + WS_MRG8, p.ws + WS_WO8, NTOK, DM, DM, G, bx); EpiWo E{(const float*)(p.ws + WS_MOD), (bf16_t*)(p.ws + WS_MERGED)};
           pg8::gemm_phase<EpiWo, pg8::StaticOrder, false, true>(lds, DM, S, E, 0x79797979, 0x7d7d7d7d););
    RUN(7, ph8_router(p, lds, rep););
    RUN(8, moe_gemm<true>(p, lds, rep););
    RUN(9, moe_gemm<false>(p, lds, rep););
    RUN(10, if (!rep) ph11_combine(p););
#undef RUN
#undef IN
#undef SEAM
}

constexpr int NPHASES = 11;
extern "C" void kernel_launch(void* const* d_in, const int* in_sizes, int n_in, void* d_out, int out_size, void* d_ws, size_t ws_size, hipStream_t stream) {
    static int grid = 0;
    if (grid == 0) {
        if (n_in != 25 || in_sizes[0] != NTOK * DM || out_size != NTOK * DM || ws_size < WS_END6) {
            fprintf(stderr, "kernel_launch: shape mismatch: n_in %d in0 %d out %d ws %zu (need %zu)\n", n_in, n_in > 0 ? in_sizes[0] : -1, out_size, ws_size, (size_t)WS_END6); grid = -1; return; }
        int dev = 0, cus = 0, per_cu = 0;
        if (hipGetDevice(&dev) != hipSuccess || hipDeviceGetAttribute(&cus, hipDeviceAttributeMultiprocessorCount, dev) != hipSuccess) { fprintf(stderr, "kernel_launch: device query failed\n"); grid = -1; return; }
        if (hipFuncSetAttribute((const void*)mk_fwd, hipFuncAttributeMaxDynamicSharedMemorySize, LDS_BYTES) != hipSuccess) { fprintf(stderr, "kernel_launch: hipFuncSetAttribute failed\n"); grid = -1; return; }
        if (hipOccupancyMaxActiveBlocksPerMultiprocessor(&per_cu, (const void*)mk_fwd, NTHREADS, LDS_BYTES) != hipSuccess || per_cu < 1) { fprintf(stderr, "kernel_launch: occupancy query says %d blocks per CU\n", per_cu); }
        (void)hipGetLastError();
        grid = cus;
    }
    if (grid < 0) return;
    if (hipMemsetAsync((char*)d_ws + WS_BAR, 0, WS_ZERO_BYTES, stream) != hipSuccess) { fprintf(stderr, "kernel_launch: memset failed\n"); return; }
    Params p; memset(&p, 0, sizeof(p));
    for (int i = 0; i < 25; ++i) p.in[i] = (const float*)d_in[i];
    p.out = (float*)d_out; p.ws = (unsigned char*)d_ws;
    unsigned char* ws = (unsigned char*)d_ws;
    auto job = [&](int j, const float* src, size_t dst_off, int K, int N, int ldd, int map, int nbatch, long sbatch, long dbatch) {
        TJob& J = p.jobs[j]; J.src = src; J.dst = (bf16_t*)(ws + dst_off); J.K = K; J.N = N; J.ldd = ldd; J.map = map; J.ntk = K / 64; J.ntn = (N + 127) / 128; J.nbatch = nbatch; J.sbatch = sbatch; J.dbatch = dbatch; J.ld = N; J.fp8 = 0; };
    job(0, p.in[I_WIN] + 512, WS_WIN, 2048, 1872, 2048, 4, 1, 0, 0); p.jobs[0].ld = DIN;
    job(1, p.in[I_WIN] + 5456, WS_WIN, 2048, 8, 2048, 5, 1, 0, 0); p.jobs[1].ld = DIN;
    job(2, p.in[I_WUK], WS_WUK, 128, 256, 128, 0, 8, 128L * 256, 256L * 128);
    job(3, p.in[I_WUV], WS_WUV, 256, 128, 256, 0, 8, 256L * 128, 128L * 256);
    job(4, p.in[I_WIN], WS_WIN8, 2048, 512, 2048, 0, 1, 0, 0); job(5, p.in[I_WIN] + 2384, WS_WIN8 + (size_t)512 * 2048, 2048, 3072, 2048, 0, 1, 0, 0); job(6, p.in[I_WIN] + 5464, WS_WIN8 + (size_t)3584 * 2048, 2048, 4096, 2048, 0, 1, 0, 0);
    for (int j = 4; j < 7; ++j) { p.jobs[j].ld = DIN; p.jobs[j].fp8 = 1; }
    job(7, p.in[I_WO], WS_WO8, 2048, 2048, 2048, 0, 1, 0, 0); p.jobs[7].fp8 = 1;
    job(8, p.in[I_WPA], WS_WPA8, 1024, 2048, 1024, 0, 1, 0, 0); p.jobs[8].fp8 = 1; job(9, p.in[I_WPB], WS_WPB8, 1024, 2048, 1024, 0, 1, 0, 0); p.jobs[9].fp8 = 1;
    int t0 = 0; for (int j = 0; j < NJOBS; ++j) { p.jobs[j].tile0 = t0; t0 += p.jobs[j].ntk * p.jobs[j].ntn * p.jobs[j].nbatch; }
    p.ntiles_total = t0;
#if MK_LAUNCHES == 1
    p.ph_lo = 0; p.ph_hi = NPHASES;
    hipLaunchKernelGGL(mk_fwd, dim3(grid), dim3(NTHREADS), LDS_BYTES, stream, p);
#else
    for (int k = 0; k < NPHASES; ++k) { p.ph_lo = k; p.ph_hi = k + 1; hipLaunchKernelGGL(mk_fwd, dim3(grid), dim3(NTHREADS), LDS_BYTES, stream, p); }
#endif
    const hipError_t le = hipPeekAtLastError();
    if (le != hipSuccess) fprintf(stderr, "kernel_launch: launch failed: %s\n", hipGetErrorName(le));
}
```
